# Optimizing an MI355X kernel written in HIP

```python
import math
import jax
import jax.numpy as jnp
from jax import lax
import numpy as np

D_MODEL = 1024
BATCH = 4
SEQ = 4096
DEPTH = 2

HEAD_DIM = 64
Q_BLOCK = 128
SB_HEADS = 8
NSA_HEADS = 8
NSA_KV_GROUPS = 2
CMP_BLOCK = 32
CMP_STRIDE = 16
CMP_HIDDEN = 128
SLC_BLOCK = 64
SLC_TOPN = 16
WINDOW = 512
FORCE_SCORE = 1e6
SB_W = SB_HEADS * HEAD_DIM
NSA_QW = NSA_HEADS * HEAD_DIM
NSA_KVW = NSA_KV_GROUPS * HEAD_DIM
ATTN_IN = 3 * SB_W + NSA_QW + 6 * NSA_KVW + 3 * NSA_HEADS
ATTN_OUT = SB_W + NSA_QW
SSM_EXPAND = 2
SSM_INNER = SSM_EXPAND * D_MODEL
SSM_HEAD_DIM = 64
SSM_HEADS = SSM_INNER // SSM_HEAD_DIM
SSM_GROUPS = 4
SSM_STATE = 128
SSM_CONV = 4
SSM_CHUNK = 256
SSM_CONV_DIM = SSM_INNER + 2 * SSM_GROUPS * SSM_STATE
SSM_IN = SSM_INNER + SSM_CONV_DIM + SSM_HEADS
N_EXPERTS = 32
TOP_K = 4
D_EXPERT = D_MODEL
SWIGLU_LIMIT = 7.0
SWIGLU_ALPHA = 1.702
MOE_BLOCK = 256
EPS = 1e-6

kernel_name = 'hybrid_sb_nsa_ssd_moe_block'


def rms_norm(x, gain):
    xf = x.astype(jnp.float32)
    y = xf * lax.rsqrt(jnp.mean(xf * xf, axis=-1, keepdims=True) + EPS)
    return (y * gain.astype(jnp.float32)).astype(x.dtype)


def alibi_slopes(n):
    return jnp.asarray(2.0 ** (-8.0 * np.arange(1, n + 1) / n), jnp.float32)


def masked_softmax(s, mask):
    s = jnp.where(mask, s, -jnp.inf)
    m = jnp.max(s, axis=-1, keepdims=True)
    m = jnp.where(jnp.isfinite(m), m, 0.0)
    p = jnp.exp(s - m)
    return p / jnp.maximum(jnp.sum(p, axis=-1, keepdims=True), 1e-30)


def stick_breaking_attention(q, k, v):
    b, s, h, dh = q.shape
    scale = dh ** -0.5
    outs = []
    for i in range(s // Q_BLOCK):
        q0, end = i * Q_BLOCK, (i + 1) * Q_BLOCK
        logits = jnp.einsum('bqhd,bkhd->bhqk', q[:, q0:end], k[:, :end]).astype(jnp.float32) * scale
        causal = jnp.arange(end)[None, :] < jnp.arange(q0, end)[:, None]
        log_beta = jax.nn.log_sigmoid(logits)
        log_keep = jnp.where(causal, jax.nn.log_sigmoid(-logits), 0.0)
        acc = lax.cumsum(log_keep, axis=3, reverse=True) - log_keep
        w = jnp.where(causal, jnp.exp(log_beta + acc), 0.0)
        outs.append(jnp.einsum('bhqk,bkhd->bqhd', w, v[:, :end]))
    return jnp.concatenate(outs, axis=1)


def compress_blocks(kv, pe, w1, w2):
    b, s, g, dh = kv.shape
    n_cmp = (s - CMP_BLOCK) // CMP_STRIDE + 1
    idx = np.arange(n_cmp)[:, None] * CMP_STRIDE + np.arange(CMP_BLOCK)[None, :]
    blocks = kv[:, idx] + pe[:, None, :]
    flat = jnp.swapaxes(blocks, 2, 3).reshape(b, n_cmp, g, CMP_BLOCK * dh)
    return jax.nn.silu(flat @ w1) @ w2


def nsa_attention(q, kc, vc, ks, vs, kw, vw, gates, q_norm, k_norm, pe_k, pe_v, w1_k, w2_k, w1_v, w2_v):
    b, s, h, dh = q.shape
    g = NSA_KV_GROUPS
    r = h // g
    scale = dh ** -0.5
    slopes = alibi_slopes(h).reshape(g, r)
    qg = (rms_norm(q, q_norm).astype(jnp.float32) * scale).reshape(b, s, g, r, dh)
    tpos = jnp.arange(s)

    k_cmp = rms_norm(compress_blocks(kc, pe_k, w1_k, w2_k), k_norm[0])
    v_cmp = compress_blocks(vc, pe_v, w1_v, w2_v)
    n_cmp = k_cmp.shape[1]
    cmp_start = np.arange(n_cmp) * CMP_STRIDE
    cmp_end = jnp.asarray(cmp_start + CMP_BLOCK - 1)
    mask_c = cmp_end[None, :] <= tpos[:, None]
    dist_c = (tpos[:, None] - cmp_end[None, :]).astype(jnp.float32)
    sc = jnp.einsum('bsgrd,bngd->bgrsn', qg, k_cmp) - slopes[:, :, None, None] * dist_c
    p_c = masked_softmax(sc, mask_c)
    o_c = jnp.einsum('bgrsn,bngd->bsgrd', p_c, v_cmp)

    n_slc = s // SLC_BLOCK
    n_sel = min(SLC_TOPN, n_slc)
    slc_start = np.arange(n_slc) * SLC_BLOCK
    overlap = ((cmp_start[:, None] < slc_start[None, :] + SLC_BLOCK)
               & (cmp_start[:, None] + CMP_BLOCK > slc_start[None, :])).astype(np.float32)
    p_slc = jnp.einsum('bgsn,nj->bgsj', jnp.sum(p_c, axis=2), jnp.asarray(overlap))
    jblk = jnp.arange(n_slc)
    valid = jblk[None, :] * SLC_BLOCK <= tpos[:, None]
    cur = tpos[:, None] // SLC_BLOCK
    forced = (jblk[None, :] == 0) | (jblk[None, :] == cur) | (jblk[None, :] == cur - 1)
    score = jnp.where(valid, jnp.where(forced, FORCE_SCORE, p_slc), -FORCE_SCORE)
    _, sel = lax.top_k(score, n_sel)

    k_sb = jnp.transpose(rms_norm(ks, k_norm[1]).reshape(b, n_slc, SLC_BLOCK, g, dh), (0, 3, 1, 2, 4))
    v_sb = jnp.transpose(vs.reshape(b, n_slc, SLC_BLOCK, g, dh), (0, 3, 1, 2, 4))
    nc = s // Q_BLOCK
    bi = jnp.arange(b)[:, None, None, None]
    gi = jnp.arange(g)[None, :, None, None]
    offs = jnp.arange(SLC_BLOCK)

    def selected_block(args):
        qc, ic, tc = args
        kb = k_sb[bi, gi, ic]
        vb = v_sb[bi, gi, ic]
        pos = ic[..., None] * SLC_BLOCK + offs
        tq = tc[None, None, :, None, None]
        mask = (pos <= tq)[:, :, None]
        dist = (tq - pos).astype(jnp.float32)[:, :, None]
        ss = jnp.einsum('bqgrd,bgqnld->bgrqnl', qc, kb) - slopes[None, :, :, None, None, None] * dist
        shp = ss.shape
        p = masked_softmax(ss.reshape(shp[:4] + (-1,)), jnp.broadcast_to(mask, shp).reshape(shp[:4] + (-1,)))
        return jnp.einsum('bgrqnl,bgqnld->bqgrd', p.reshape(shp), vb)

    q_ch = jnp.swapaxes(qg.reshape(b, nc, Q_BLOCK, g, r, dh), 0, 1)
    i_ch = jnp.transpose(sel.reshape(b, g, nc, Q_BLOCK, n_sel), (2, 0, 1, 3, 4))
    t_ch = jnp.arange(s, dtype=jnp.int32).reshape(nc, Q_BLOCK)
    o_s = jnp.swapaxes(lax.map(selected_block, (q_ch, i_ch, t_ch)), 0, 1).reshape(b, s, g, r, dh)

    k_w = jnp.pad(rms_norm(kw, k_norm[2]), ((0, 0), (WINDOW, 0), (0, 0), (0, 0)))
    v_w = jnp.pad(vw, ((0, 0), (WINDOW, 0), (0, 0), (0, 0)))
    widx = np.arange(nc)[:, None] * Q_BLOCK + np.arange(Q_BLOCK + WINDOW)[None, :]
    spos = widx - WINDOW
    tq = np.arange(nc)[:, None] * Q_BLOCK + np.arange(Q_BLOCK)[None, :]
    mask_w = ((spos[:, None, :] <= tq[:, :, None]) & (spos[:, None, :] > tq[:, :, None] - WINDOW)
              & (spos[:, None, :] >= 0))
    dist_w = jnp.asarray((tq[:, :, None] - spos[:, None, :]).astype(np.float32))
    qb = qg.reshape(b, nc, Q_BLOCK, g, r, dh)
    sw = jnp.einsum('bnqgrd,bnkgd->bgrnqk', qb, k_w[:, widx]) - slopes[:, :, None, None, None] * dist_w
    p_w = masked_softmax(sw, jnp.asarray(mask_w))
    o_w = jnp.einsum('bgrnqk,bnkgd->bnqgrd', p_w, v_w[:, widx]).reshape(b, s, g, r, dh)

    gt = jax.nn.sigmoid(gates.astype(jnp.float32)).reshape(b, s, g, r, 3, 1)
    o = gt[..., 0, :] * o_c + gt[..., 1, :] * o_s + gt[..., 2, :] * o_w
    return o.reshape(b, s, h, dh)


def attention_mixer(u, w_in, w_out, q_norm, k_norm, pe_k, pe_v, w1_k, w2_k, w1_v, w2_v):
    b, s, _ = u.shape
    proj = u @ w_in
    splits = [int(v) for v in np.cumsum([SB_W, SB_W, SB_W, NSA_QW] + [NSA_KVW] * 6)]
    sb_q, sb_k, sb_v, nq, kc, vc, ks, vs, kw, vw, gates = jnp.split(proj, splits, axis=-1)
    hs = lambda a, n: a.reshape(b, s, n, HEAD_DIM)
    o_sb = stick_breaking_attention(hs(sb_q, SB_HEADS), hs(sb_k, SB_HEADS), hs(sb_v, SB_HEADS))
    g = NSA_KV_GROUPS
    o_nsa = nsa_attention(hs(nq, NSA_HEADS), hs(kc, g), hs(vc, g), hs(ks, g), hs(vs, g), hs(kw, g), hs(vw, g),
                          gates, q_norm, k_norm, pe_k, pe_v, w1_k, w2_k, w1_v, w2_v)
    o = jnp.concatenate([o_sb.reshape(b, s, SB_W), o_nsa.reshape(b, s, NSA_QW)], axis=-1).astype(u.dtype)
    return o @ w_out


def ssd_chunked(x, dt, a, bm, cm):
    b, s, h, p = x.shape
    g, n = bm.shape[-2], bm.shape[-1]
    r = h // g
    chunk = math.gcd(s, SSM_CHUNK)
    nc = s // chunk
    xd = (x.astype(jnp.float32) * dt[..., None]).reshape(b, nc, chunk, g, r, p)
    cs = jnp.cumsum((dt * a).reshape(b, nc, chunk, g, r), axis=2)
    bm = bm.astype(jnp.float32).reshape(b, nc, chunk, g, n)
    cm = cm.astype(jnp.float32).reshape(b, nc, chunk, g, n)
    causal = jnp.tril(jnp.ones((chunk, chunk), bool))[None, None, :, :, None, None]
    seg = jnp.where(causal, cs[:, :, :, None] - cs[:, :, None, :], -jnp.inf)
    cb = jnp.einsum('bclgn,bcsgn->bclsg', cm, bm)
    y_diag = jnp.einsum('bclsgr,bcsgrp->bclgrp', cb[..., None] * jnp.exp(seg), xd)
    states = jnp.einsum('bclgn,bclgrp->bcgrpn', bm, xd * jnp.exp(cs[:, :, -1:] - cs)[..., None])
    chunk_decay = jnp.exp(cs[:, :, -1])

    def carry_state(hstate, inp):
        st, dec = inp
        return hstate * dec[..., None, None] + st, hstate

    _, prev = lax.scan(carry_state, jnp.zeros((b, g, r, p, n), jnp.float32),
                       (jnp.moveaxis(states, 1, 0), jnp.moveaxis(chunk_decay, 1, 0)))
    prev = jnp.moveaxis(prev, 0, 1)
    y_off = jnp.einsum('bclgn,bcgrpn->bclgrp', cm, prev) * jnp.exp(cs)[..., None]
    return (y_diag + y_off).reshape(b, s, h, p)


def mamba2_mixer(u, w_in, conv_w, conv_b, dt_bias, a_log, d_skip, norm_g, w_out):
    b, s, _ = u.shape
    zxbcdt = u @ w_in
    z, xbc, dt = jnp.split(zxbcdt, [SSM_INNER, SSM_INNER + SSM_CONV_DIM], axis=-1)
    xbc = lax.conv_general_dilated(xbc, conv_w[:, None, :], window_strides=(1,), padding=[(SSM_CONV - 1, 0)],
                                   dimension_numbers=('NWC', 'WIO', 'NWC'), feature_group_count=SSM_CONV_DIM)
    xbc = jax.nn.silu(xbc + conv_b)
    xs, bm, cm = jnp.split(xbc, [SSM_INNER, SSM_INNER + SSM_GROUPS * SSM_STATE], axis=-1)
    xs = xs.reshape(b, s, SSM_HEADS, SSM_HEAD_DIM)
    bm = bm.reshape(b, s, SSM_GROUPS, SSM_STATE)
    cm = cm.reshape(b, s, SSM_GROUPS, SSM_STATE)
    dt = jax.nn.softplus(dt.astype(jnp.float32) + dt_bias.astype(jnp.float32))
    a = -jnp.exp(a_log.astype(jnp.float32))
    y = ssd_chunked(xs, dt, a, bm, cm) + xs.astype(jnp.float32) * d_skip.astype(jnp.float32)[:, None]
    y = y.reshape(b, s, SSM_INNER) * jax.nn.silu(z.astype(jnp.float32))
    y = rms_norm(y.reshape(b, s, SSM_GROUPS, SSM_INNER // SSM_GROUPS), jnp.ones((), jnp.float32))
    y = (y.reshape(b, s, SSM_INNER) * norm_g).astype(u.dtype)
    return y @ w_out


def moe_ffn(h, w_router, b_router, w_gu, b_gu, w_down, b_down):
    b, s, d = h.shape
    n_tok = b * s
    tok = h.reshape(n_tok, d)
    logits = (tok @ w_router + b_router).astype(jnp.float32)
    top_logit, top_e = lax.top_k(logits, TOP_K)
    top_w = jax.nn.softmax(top_logit, axis=-1)
    n_rows = n_tok * TOP_K
    flat_e = top_e.reshape(n_rows)
    flat_t = jnp.repeat(jnp.arange(n_tok, dtype=jnp.int32), TOP_K)
    flat_w = top_w.reshape(n_rows)
    order = jnp.argsort(flat_e)
    sorted_e = flat_e[order]
    counts = jnp.bincount(flat_e, length=N_EXPERTS)
    padded = (counts + MOE_BLOCK - 1) // MOE_BLOCK * MOE_BLOCK
    pad_end = jnp.cumsum(padded)
    pad_start = pad_end - padded
    grp_start = jnp.cumsum(counts) - counts
    slot = pad_start[sorted_e] + jnp.arange(n_rows) - grp_start[sorted_e]
    n_slots = (n_rows + MOE_BLOCK - 1) // MOE_BLOCK * MOE_BLOCK + N_EXPERTS * MOE_BLOCK
    slot_tok = jnp.full((n_slots,), n_tok, jnp.int32).at[slot].set(flat_t[order])
    slot_w = jnp.zeros((n_slots,), jnp.float32).at[slot].set(flat_w[order])
    n_blocks = n_slots // MOE_BLOCK
    blk_e = jnp.minimum(jnp.searchsorted(pad_end, jnp.arange(n_blocks) * MOE_BLOCK, side='right'), N_EXPERTS - 1)
    tok_pad = jnp.concatenate([tok, jnp.zeros((1, d), tok.dtype)], axis=0)
    xs = tok_pad[slot_tok].reshape(n_blocks, MOE_BLOCK, d)

    def expert_block(args):
        xb, e = args
        gu = xb @ w_gu[e] + b_gu[e]
        gate = jnp.minimum(gu[:, :D_EXPERT], SWIGLU_LIMIT)
        up = jnp.clip(gu[:, D_EXPERT:], -SWIGLU_LIMIT, SWIGLU_LIMIT)
        act = (up + 1.0) * gate * jax.nn.sigmoid(SWIGLU_ALPHA * gate)
        return act @ w_down[e] + b_down[e]

    ys = lax.map(expert_block, (xs, blk_e)).reshape(n_slots, d) * slot_w[:, None]
    out = jax.ops.segment_sum(ys, slot_tok, num_segments=n_tok + 1)[:n_tok]
    return out.reshape(b, s, d).astype(h.dtype)


def setup_inputs(seed: int = 0) -> dict:
    key = jax.random.key(seed)
    ks = iter(jax.random.split(key, 40))
    nrm = lambda shape, sc: jax.random.normal(next(ks), shape, jnp.float32) * sc
    D = D_MODEL
    ne, no = (DEPTH + 1) // 2, DEPTH // 2
    fk = CMP_BLOCK * HEAD_DIM
    dt0 = jnp.exp(jax.random.uniform(next(ks), (no, SSM_HEADS), jnp.float32, math.log(1e-3), math.log(1e-1)))
    return {
        'x': nrm((BATCH, SEQ, D), 1.0),
        'c': nrm((BATCH, D), 1.0),
        'ada_w': nrm((DEPTH, D, 6 * D), 0.5 * D ** -0.5),
        'ada_b': nrm((DEPTH, 6 * D), 0.05),
        'norm_mix': 1.0 + nrm((DEPTH, D), 0.05),
        'norm_ffn': 1.0 + nrm((DEPTH, D), 0.05),
        'attn_w_in': nrm((ne, D, ATTN_IN), D ** -0.5),
        'attn_w_out': nrm((ne, ATTN_OUT, D), ATTN_OUT ** -0.5),
        'nsa_q_norm': 1.0 + nrm((ne, HEAD_DIM), 0.05),
        'nsa_k_norm': 1.0 + nrm((ne, 3, HEAD_DIM), 0.05),
        'cmp_pe_k': nrm((ne, CMP_BLOCK, HEAD_DIM), 0.1),
        'cmp_pe_v': nrm((ne, CMP_BLOCK, HEAD_DIM), 0.1),
        'cmp_w1_k': nrm((ne, fk, CMP_HIDDEN), fk ** -0.5),
        'cmp_w2_k': nrm((ne, CMP_HIDDEN, HEAD_DIM), CMP_HIDDEN ** -0.5),
        'cmp_w1_v': nrm((ne, fk, CMP_HIDDEN), fk ** -0.5),
        'cmp_w2_v': nrm((ne, CMP_HIDDEN, HEAD_DIM), CMP_HIDDEN ** -0.5),
        'ssm_w_in': nrm((no, D, SSM_IN), D ** -0.5),
        'ssm_conv_w': nrm((no, SSM_CONV, SSM_CONV_DIM), SSM_CONV ** -0.5),
        'ssm_conv_b': nrm((no, SSM_CONV_DIM), 0.02),
        'ssm_dt_bias': dt0 + jnp.log(-jnp.expm1(-dt0)),
        'ssm_a_log': jnp.log(jax.random.uniform(next(ks), (no, SSM_HEADS), jnp.float32, 1.0, 16.0)),
        'ssm_d': 1.0 + nrm((no, SSM_HEADS), 0.05),
        'ssm_norm': 1.0 + nrm((no, SSM_INNER), 0.05),
        'ssm_w_out': nrm((no, SSM_INNER, D), SSM_INNER ** -0.5),
        'router_w': nrm((DEPTH, D, N_EXPERTS), D ** -0.5),
        'router_b': nrm((DEPTH, N_EXPERTS), 0.01),
        'moe_w_gu': nrm((DEPTH, N_EXPERTS, D, 2 * D_EXPERT), D ** -0.5),
        'moe_b_gu': nrm((DEPTH, N_EXPERTS, 2 * D_EXPERT), 0.02),
        'moe_w_down': nrm((DEPTH, N_EXPERTS, D_EXPERT, D), D_EXPERT ** -0.5),
        'moe_b_down': nrm((DEPTH, N_EXPERTS, D), 0.02),
    }


def reference(x, c, ada_w, ada_b, norm_mix, norm_ffn, attn_w_in, attn_w_out, nsa_q_norm, nsa_k_norm,
              cmp_pe_k, cmp_pe_v, cmp_w1_k, cmp_w2_k, cmp_w1_v, cmp_w2_v, ssm_w_in, ssm_conv_w, ssm_conv_b,
              ssm_dt_bias, ssm_a_log, ssm_d, ssm_norm, ssm_w_out, router_w, router_b, moe_w_gu, moe_b_gu,
              moe_w_down, moe_b_down):
    h = x
    cond = jax.nn.silu(c)
    for layer in range(DEPTH):
        mod = (cond @ ada_w[layer] + ada_b[layer])[:, None, :]
        sh1, sc1, g1, sh2, sc2, g2 = jnp.split(mod, 6, axis=-1)
        u = rms_norm(h, norm_mix[layer]) * (1.0 + sc1) + sh1
        i = layer // 2
        if layer % 2 == 0:
            mix = attention_mixer(u, attn_w_in[i], attn_w_out[i], nsa_q_norm[i], nsa_k_norm[i], cmp_pe_k[i],
                                  cmp_pe_v[i], cmp_w1_k[i], cmp_w2_k[i], cmp_w1_v[i], cmp_w2_v[i])
        else:
            mix = mamba2_mixer(u, ssm_w_in[i], ssm_conv_w[i], ssm_conv_b[i], ssm_dt_bias[i], ssm_a_log[i],
                               ssm_d[i], ssm_norm[i], ssm_w_out[i])
        h = h + g1 * mix
        u = rms_norm(h, norm_ffn[layer]) * (1.0 + sc2) + sh2
        h = h + g2 * moe_ffn(u, router_w[layer], router_b[layer], moe_w_gu[layer], moe_b_gu[layer],
                             moe_w_down[layer], moe_b_down[layer])
    return h
```

```cpp
#include <hip/hip_runtime.h>
#include <cstdio>
#include <cstdint>

namespace {
constexpr int D = 1024, NB = 4, S = 4096, T = NB * S;
constexpr int ATTN_IN = 2840;
constexpr int OFF_SBQ = 0, OFF_SBK = 512, OFF_SBV = 1024, OFF_NQ = 1536, OFF_KC = 2048, OFF_VC = 2176, OFF_KS = 2304, OFF_VS = 2432,
              OFF_KW = 2560, OFF_VW = 2688, OFF_GATE = 2816;
constexpr int NCMP = 255;
constexpr int SSM_IN = 5152, SSM_INNER = 2048, CONV_DIM = 3072;
constexpr int NE = 32, MAXROWS = 65536 + 32 * 64, MAXTILES = MAXROWS / 64;
constexpr float EPS = 1e-6f;

__device__ __forceinline__ float siluf(float v) { return v / (1.f + expf(-v)); }
__device__ __forceinline__ float logsig(float x) { return fminf(x, 0.f) - log1pf(expf(-fabsf(x))); }
__device__ __forceinline__ float wave_sum(float v) {
#pragma unroll
    for (int o = 32; o > 0; o >>= 1) v += __shfl_xor(v, o);
    return v;
}
__device__ __forceinline__ float wave_max(float v) {
#pragma unroll
    for (int o = 32; o > 0; o >>= 1) v = fmaxf(v, __shfl_xor(v, o));
    return v;
}

__global__ __launch_bounds__(256) void k_mod(const float* __restrict__ c, const float* __restrict__ ada_w, const float* __restrict__ ada_b, float* __restrict__ mod) {
    __shared__ float cs[4][1024];
    for (int i = threadIdx.x; i < 4096; i += 256) cs[i >> 10][i & 1023] = siluf(c[i]);
    __syncthreads();
    const int idx = blockIdx.x * 256 + threadIdx.x, l = idx / 6144, j = idx % 6144;
    const float* w = ada_w + (size_t)l * 1024 * 6144 + j;
    float a0 = 0.f, a1 = 0.f, a2 = 0.f, a3 = 0.f;
    for (int i = 0; i < 1024; ++i) { const float wv = w[(size_t)i * 6144]; a0 += cs[0][i] * wv; a1 += cs[1][i] * wv; a2 += cs[2][i] * wv; a3 += cs[3][i] * wv; }
    const float bb = ada_b[l * 6144 + j];
    mod[(l * 4 + 0) * 6144 + j] = a0 + bb; mod[(l * 4 + 1) * 6144 + j] = a1 + bb; mod[(l * 4 + 2) * 6144 + j] = a2 + bb; mod[(l * 4 + 3) * 6144 + j] = a3 + bb;
}

__global__ __launch_bounds__(256) void k_norm_mod(const float* __restrict__ h, const float* __restrict__ gain, const float* __restrict__ modl, int sc_off, int sh_off, float* __restrict__ u) {
    __shared__ float red[4];
    const int t = blockIdx.x, b = t / S, tid = threadIdx.x;
    const float4 v = ((const float4*)(h + (size_t)t * D))[tid];
    float ss = wave_sum(v.x * v.x + v.y * v.y + v.z * v.z + v.w * v.w);
    if ((tid & 63) == 0) red[tid >> 6] = ss;
    __syncthreads();
    const float r = rsqrtf((red[0] + red[1] + red[2] + red[3]) * (1.f / 1024.f) + EPS);
    const float* m = modl + (size_t)b * 6144;
    const int j = tid * 4;
    float4 o;
    o.x = v.x * r * gain[j + 0] * (1.f + m[sc_off + j + 0]) + m[sh_off + j + 0];
    o.y = v.y * r * gain[j + 1] * (1.f + m[sc_off + j + 1]) + m[sh_off + j + 1];
    o.z = v.z * r * gain[j + 2] * (1.f + m[sc_off + j + 2]) + m[sh_off + j + 2];
    o.w = v.w * r * gain[j + 3] * (1.f + m[sc_off + j + 3]) + m[sh_off + j + 3];
    ((float4*)(u + (size_t)t * D))[tid] = o;
}

__global__ __launch_bounds__(256) void k_resid(const float* __restrict__ hin, const float* __restrict__ mix, const float* __restrict__ modl, int g_off, float* __restrict__ hout) {
    const int t = blockIdx.x, b = t / S, j = threadIdx.x * 4;
    const float4 a = ((const float4*)(hin + (size_t)t * D))[threadIdx.x], m = ((const float4*)(mix + (size_t)t * D))[threadIdx.x];
    const float* g = modl + (size_t)b * 6144 + g_off + j;
    float4 o; o.x = a.x + g[0] * m.x; o.y = a.y + g[1] * m.y; o.z = a.z + g[2] * m.z; o.w = a.w + g[3] * m.w;
    ((float4*)(hout + (size_t)t * D))[threadIdx.x] = o;
}

__global__ __launch_bounds__(256) void k_sgemm(const float* __restrict__ A, int lda, const float* __restrict__ B, int ldb, float* __restrict__ C, int ldc, int M, int N, int K) {
    __shared__ float As[16][68];
    __shared__ float Bs[16][68];
    const int tid = threadIdx.x, tx = tid & 15, ty = tid >> 4, m0 = blockIdx.y * 64, n0 = blockIdx.x * 64;
    float acc[4][4];
#pragma unroll
    for (int i = 0; i < 4; ++i)
#pragma unroll
        for (int j = 0; j < 4; ++j) acc[i][j] = 0.f;
    const int ar = tid >> 2, ac = (tid & 3) * 4, br = tid >> 4, bc = (tid & 15) * 4;
    for (int k0 = 0; k0 < K; k0 += 16) {
        const float4 av = *(const float4*)(A + (size_t)(m0 + ar) * lda + k0 + ac);
        float4 bv = make_float4(0.f, 0.f, 0.f, 0.f);
        if (n0 + bc < N) bv = *(const float4*)(B + (size_t)(k0 + br) * ldb + n0 + bc);
        As[ac + 0][ar] = av.x; As[ac + 1][ar] = av.y; As[ac + 2][ar] = av.z; As[ac + 3][ar] = av.w;
        *(float4*)&Bs[br][bc] = bv;
        __syncthreads();
#pragma unroll
        for (int kk = 0; kk < 16; ++kk) {
            const float4 a = *(const float4*)&As[kk][ty * 4], b = *(const float4*)&Bs[kk][tx * 4];
            const float aa[4] = {a.x, a.y, a.z, a.w}, bb[4] = {b.x, b.y, b.z, b.w};
#pragma unroll
            for (int i = 0; i < 4; ++i)
#pragma unroll
                for (int j = 0; j < 4; ++j) acc[i][j] += aa[i] * bb[j];
        }
        __syncthreads();
    }
    if (n0 + tx * 4 < N) {
#pragma unroll
        for (int i = 0; i < 4; ++i) *(float4*)(C + (size_t)(m0 + ty * 4 + i) * ldc + n0 + tx * 4) = make_float4(acc[i][0], acc[i][1], acc[i][2], acc[i][3]);
    }
}

__global__ __launch_bounds__(64) void k_sb_attn(const float* __restrict__ proj, float* __restrict__ o) {
    const int qt = blockIdx.x, bh = blockIdx.y, b = bh >> 3, hh = bh & 7, t = qt * 64 + threadIdx.x;
    const float* base = proj + (size_t)b * S * ATTN_IN;
    float q[64], acc[64];
    {
        const float4* qp = (const float4*)(base + (size_t)t * ATTN_IN + OFF_SBQ + hh * 64);
#pragma unroll
        for (int d = 0; d < 16; ++d) { const float4 v = qp[d]; q[4 * d] = v.x; q[4 * d + 1] = v.y; q[4 * d + 2] = v.z; q[4 * d + 3] = v.w; }
    }
#pragma unroll
    for (int d = 0; d < 64; ++d) acc[d] = 0.f;
    float run = 0.f;
    for (int j = qt * 64 + 62; j >= 0; --j) {
        const float* kr = base + (size_t)j * ATTN_IN + OFF_SBK + hh * 64;
        float dot = 0.f;
#pragma unroll
        for (int d = 0; d < 64; ++d) dot += q[d] * kr[d];
        const float logit = dot * 0.125f;
        if (j < t) {
            const float w = expf(logsig(logit) + run);
            run += logsig(-logit);
            const float* vr = base + (size_t)j * ATTN_IN + OFF_SBV + hh * 64;
#pragma unroll
            for (int d = 0; d < 64; ++d) acc[d] += w * vr[d];
        }
    }
    float4* op = (float4*)(o + (size_t)(b * S + t) * D + hh * 64);
#pragma unroll
    for (int d = 0; d < 16; ++d) op[d] = make_float4(acc[4 * d], acc[4 * d + 1], acc[4 * d + 2], acc[4 * d + 3]);
}

__global__ __launch_bounds__(64) void k_nsa_prep(const float* __restrict__ proj, const float* __restrict__ q_norm, const float* __restrict__ k_norm, float* __restrict__ qn, float* __restrict__ kn) {
    const int t = blockIdx.x, idx = blockIdx.y, lane = threadIdx.x;
    int col; const float* gain; float* dst; float sc = 1.f;
    if (idx < 8) { col = OFF_NQ + idx * 64; gain = q_norm; dst = qn + ((size_t)t * 8 + idx) * 64; sc = 0.125f; }
    else if (idx < 10) { col = OFF_KS + (idx - 8) * 64; gain = k_norm + 64; dst = kn + ((size_t)t * 4 + (idx - 8)) * 64; }
    else { col = OFF_KW + (idx - 10) * 64; gain = k_norm + 128; dst = kn + ((size_t)t * 4 + 2 + (idx - 10)) * 64; }
    const float v = proj[(size_t)t * ATTN_IN + col + lane];
    const float r = rsqrtf(wave_sum(v * v) * (1.f / 64.f) + EPS);
    dst[lane] = v * r * gain[lane] * sc;
}

__global__ __launch_bounds__(128) void k_cmp(const float* __restrict__ proj, const float* __restrict__ pe_k, const float* __restrict__ pe_v, const float* __restrict__ w1k, const float* __restrict__ w2k,
                                             const float* __restrict__ w1v, const float* __restrict__ w2v, const float* __restrict__ k_norm, float* __restrict__ kcmp, float* __restrict__ vcmp) {
    __shared__ float flat[2048];
    __shared__ float hid[128];
    const int n = blockIdx.x, b = blockIdx.y >> 1, g = blockIdx.y & 1, kv = blockIdx.z, tid = threadIdx.x;
    const int col = kv ? OFF_VC : OFF_KC; const float* pe = kv ? pe_v : pe_k; const float* w1 = kv ? w1v : w1k; const float* w2 = kv ? w2v : w2k;
    for (int i = tid; i < 2048; i += 128) { const int l = i >> 6, d = i & 63; flat[i] = proj[(size_t)(b * S + n * 16 + l) * ATTN_IN + col + g * 64 + d] + pe[l * 64 + d]; }
    __syncthreads();
    float a = 0.f;
    for (int i = 0; i < 2048; ++i) a += flat[i] * w1[(size_t)i * 128 + tid];
    hid[tid] = siluf(a);
    __syncthreads();
    if (tid < 64) {
        float o = 0.f;
        for (int j = 0; j < 128; ++j) o += hid[j] * w2[j * 64 + tid];
        float* dst = (kv ? vcmp : kcmp) + (((size_t)b * NCMP + n) * 2 + g) * 64;
        if (kv == 0) { const float r = rsqrtf(wave_sum(o * o) * (1.f / 64.f) + EPS); o = o * r * k_norm[tid]; }
        dst[tid] = o;
    }
}

__global__ __launch_bounds__(256) void k_nsa(const float* __restrict__ proj, const float* __restrict__ qn, const float* __restrict__ kn, const float* __restrict__ kcmp, const float* __restrict__ vcmp, float* __restrict__ o) {
    __shared__ float sc[4][1024];
    __shared__ float pslc[4][64];
    const int t = blockIdx.x, b = blockIdx.y >> 1, g = blockIdx.y & 1, r = threadIdx.x >> 6, lane = threadIdx.x & 63, hh = g * 4 + r;
    const float slope = exp2f(-(float)(hh + 1));
    float q[64];
    {
        const float4* qp = (const float4*)(qn + ((size_t)(b * S + t) * 8 + hh) * 64);
#pragma unroll
        for (int d = 0; d < 16; ++d) { const float4 v = qp[d]; q[4 * d] = v.x; q[4 * d + 1] = v.y; q[4 * d + 2] = v.z; q[4 * d + 3] = v.w; }
    }
    float* s = sc[r];
    const int ncv = t >= 31 ? (t - 31) / 16 + 1 : 0;
    float m = -INFINITY;
    for (int n = lane; n < ncv; n += 64) {
        const float4* kp = (const float4*)(kcmp + (((size_t)b * NCMP + n) * 2 + g) * 64);
        float dot = 0.f;
#pragma unroll
        for (int d = 0; d < 16; ++d) { const float4 v = kp[d]; dot += q[4 * d] * v.x + q[4 * d + 1] * v.y + q[4 * d + 2] * v.z + q[4 * d + 3] * v.w; }
        const float v = dot - slope * (float)(t - (n * 16 + 31));
        s[n] = v; m = fmaxf(m, v);
    }
    m = wave_max(m);
    float sum = 0.f;
    for (int n = lane; n < ncv; n += 64) { const float p = expf(s[n] - m); s[n] = p; sum += p; }
    sum = wave_sum(sum);
    const float inv = 1.f / fmaxf(sum, 1e-30f);
    for (int n = lane; n < ncv; n += 64) s[n] *= inv;
    __builtin_amdgcn_s_waitcnt(0);
    float oc = 0.f;
    for (int n = 0; n < ncv; ++n) oc += s[n] * vcmp[(((size_t)b * NCMP + n) * 2 + g) * 64 + lane];
    {
        float ps = 0.f;
        const int lo = max(0, 4 * lane - 1), hi = min(4 * lane + 3, ncv - 1);
        for (int n = lo; n <= hi; ++n) ps += s[n];
        pslc[r][lane] = ps;
    }
    __syncthreads();
    unsigned long long selmask;
    {
        const float ps = (pslc[0][lane] + pslc[1][lane]) + (pslc[2][lane] + pslc[3][lane]);
        const int cur = t >> 6;
        const bool valid = lane * 64 <= t, forced = (lane == 0) || (lane == cur) || (lane == cur - 1);
        const float score = valid ? (forced ? 1e6f : ps) : -1e6f;
        int rank = 0;
        for (int i = 0; i < 64; ++i) { const float si = __shfl(score, i); rank += (si > score || (si == score && i < lane)) ? 1 : 0; }
        selmask = __ballot(rank < 16);
    }
    __syncthreads();
    float os = 0.f;
    {
        int ns = 0; float mm = -INFINITY;
        for (unsigned long long mk = selmask; mk; mk &= mk - 1) {
            const int jb = __builtin_ctzll(mk), pos = jb * 64 + lane;
            float v = -INFINITY;
            if (pos <= t) {
                const float4* kp = (const float4*)(kn + ((size_t)(b * S + pos) * 4 + g) * 64);
                float dot = 0.f;
#pragma unroll
                for (int d = 0; d < 16; ++d) { const float4 kv = kp[d]; dot += q[4 * d] * kv.x + q[4 * d + 1] * kv.y + q[4 * d + 2] * kv.z + q[4 * d + 3] * kv.w; }
                v = dot - slope * (float)(t - pos);
            }
            s[ns * 64 + lane] = v; mm = fmaxf(mm, v); ++ns;
        }
        mm = wave_max(mm);
        float sm = 0.f;
        for (int i = 0; i < ns; ++i) { const float p = expf(s[i * 64 + lane] - mm); s[i * 64 + lane] = p; sm += p; }
        sm = wave_sum(sm);
        const float iv = 1.f / fmaxf(sm, 1e-30f);
        __builtin_amdgcn_s_waitcnt(0);
        int i = 0;
        for (unsigned long long mk = selmask; mk; mk &= mk - 1, ++i) {
            const int jb = __builtin_ctzll(mk);
            if (jb * 64 > t) continue;
            const int cntk = min(64, t - jb * 64 + 1);
            for (int k = 0; k < cntk; ++k) os += s[i * 64 + k] * proj[(size_t)(b * S + jb * 64 + k) * ATTN_IN + OFF_VS + g * 64 + lane];
        }
        os *= iv;
    }
    __syncthreads();
    float ow = 0.f;
    {
        const int s0 = max(0, t - 511), nk = t - s0 + 1;
        float mm = -INFINITY;
        for (int k = lane; k < nk; k += 64) {
            const int pos = s0 + k;
            const float4* kp = (const float4*)(kn + ((size_t)(b * S + pos) * 4 + 2 + g) * 64);
            float dot = 0.f;
#pragma unroll
            for (int d = 0; d < 16; ++d) { const float4 kv = kp[d]; dot += q[4 * d] * kv.x + q[4 * d + 1] * kv.y + q[4 * d + 2] * kv.z + q[4 * d + 3] * kv.w; }
            const float v = dot - slope * (float)(t - pos);
            s[k] = v; mm = fmaxf(mm, v);
        }
        mm = wave_max(mm);
        float sm = 0.f;
        for (int k = lane; k < nk; k += 64) { const float p = expf(s[k] - mm); s[k] = p; sm += p; }
        sm = wave_sum(sm);
        const float iv = 1.f / fmaxf(sm, 1e-30f);
        __builtin_amdgcn_s_waitcnt(0);
        for (int k = 0; k < nk; ++k) ow += s[k] * proj[(size_t)(b * S + s0 + k) * ATTN_IN + OFF_VW + g * 64 + lane];
        ow *= iv;
    }
    const float* gp = proj + (size_t)(b * S + t) * ATTN_IN + OFF_GATE + hh * 3;
    const float g0 = 1.f / (1.f + expf(-gp[0])), g1 = 1.f / (1.f + expf(-gp[1])), g2 = 1.f / (1.f + expf(-gp[2]));
    o[(size_t)(b * S + t) * D + 512 + hh * 64 + lane] = g0 * oc + g1 * os + g2 * ow;
}

__global__ __launch_bounds__(64) void k_router(const float* __restrict__ u, const float* __restrict__ wr, const float* __restrict__ br, int* __restrict__ cnt, int* __restrict__ tok_e, float* __restrict__ tok_w, int* __restrict__ tok_pos) {
    const int t = blockIdx.x, lane = threadIdx.x, e = lane & 31, half = lane >> 5;
    const float* ur = u + (size_t)t * D + half * 512;
    const float* w = wr + (size_t)half * 512 * 32 + e;
    float a = 0.f;
    for (int i = 0; i < 512; ++i) a += ur[i] * w[i * 32];
    a += __shfl_xor(a, 32);
    float logit = a + br[e];
    float tl[4]; int te[4];
#pragma unroll
    for (int k = 0; k < 4; ++k) {
        float bv = logit; int bi = e;
#pragma unroll
        for (int o = 16; o > 0; o >>= 1) { const float ov = __shfl_xor(bv, o); const int oi = __shfl_xor(bi, o); if (ov > bv || (ov == bv && oi < bi)) { bv = ov; bi = oi; } }
        tl[k] = bv; te[k] = bi;
        if (e == bi) logit = -INFINITY;
    }
    if (lane < 4) {
        const float e0 = 1.f, e1 = expf(tl[1] - tl[0]), e2 = expf(tl[2] - tl[0]), e3 = expf(tl[3] - tl[0]);
        const float inv = 1.f / (e0 + e1 + e2 + e3);
        const float wv = (lane == 0 ? e0 : lane == 1 ? e1 : lane == 2 ? e2 : e3) * inv;
        const int ev = lane == 0 ? te[0] : lane == 1 ? te[1] : lane == 2 ? te[2] : te[3];
        tok_e[t * 4 + lane] = ev; tok_w[t * 4 + lane] = wv; tok_pos[t * 4 + lane] = atomicAdd(&cnt[ev], 1);
    }
}
__global__ void k_moe_plan(const int* __restrict__ cnt, int* __restrict__ rowbase, int* __restrict__ tile_e, int* __restrict__ ntiles) {
    if (threadIdx.x == 0) {
        int base = 0;
        for (int e = 0; e < NE; ++e) { rowbase[e] = base; const int nt = (cnt[e] + 63) / 64; for (int i = 0; i < nt; ++i) tile_e[base / 64 + i] = e; base += nt * 64; }
        ntiles[0] = base / 64;
    }
}
__global__ __launch_bounds__(256) void k_moe_scatter(const int* __restrict__ tok_e, const int* __restrict__ tok_pos, const int* __restrict__ rowbase, int* __restrict__ row_tok, int* __restrict__ tok_row) {
    const int i = blockIdx.x * 256 + threadIdx.x;
    const int row = rowbase[tok_e[i]] + tok_pos[i];
    row_tok[row] = i >> 2; tok_row[i] = row;
}
__global__ __launch_bounds__(256) void k_moe_gu(const float* __restrict__ u, const int* __restrict__ row_tok, const int* __restrict__ tile_e, const int* __restrict__ ntiles, const float* __restrict__ wgu, const float* __restrict__ bgu, float* __restrict__ act) {
    if ((int)blockIdx.y >= ntiles[0]) return;
    __shared__ float As[16][68];
    __shared__ float Bg[16][68];
    __shared__ float Bu[16][68];
    const int tid = threadIdx.x, tx = tid & 15, ty = tid >> 4, m0 = blockIdx.y * 64, n0 = blockIdx.x * 64, e = tile_e[blockIdx.y];
    const float* B = wgu + (size_t)e * 1024 * 2048;
    float ag[4][4], au[4][4];
#pragma unroll
    for (int i = 0; i < 4; ++i)
#pragma unroll
        for (int j = 0; j < 4; ++j) { ag[i][j] = 0.f; au[i][j] = 0.f; }
    const int ar = tid >> 2, ac = (tid & 3) * 4, br = tid >> 4, bc = (tid & 15) * 4;
    const int tok = row_tok[m0 + ar];
    for (int k0 = 0; k0 < 1024; k0 += 16) {
        float4 av = make_float4(0.f, 0.f, 0.f, 0.f);
        if (tok >= 0) av = *(const float4*)(u + (size_t)tok * D + k0 + ac);
        const float4 bg = *(const float4*)(B + (size_t)(k0 + br) * 2048 + n0 + bc), bu = *(const float4*)(B + (size_t)(k0 + br) * 2048 + 1024 + n0 + bc);
        As[ac + 0][ar] = av.x; As[ac + 1][ar] = av.y; As[ac + 2][ar] = av.z; As[ac + 3][ar] = av.w;
        *(float4*)&Bg[br][bc] = bg; *(float4*)&Bu[br][bc] = bu;
        __syncthreads();
#pragma unroll
        for (int kk = 0; kk < 16; ++kk) {
            const float4 a = *(const float4*)&As[kk][ty * 4], b1 = *(const float4*)&Bg[kk][tx * 4], b2 = *(const float4*)&Bu[kk][tx * 4];
            const float aa[4] = {a.x, a.y, a.z, a.w}, bb1[4] = {b1.x, b1.y, b1.z, b1.w}, bb2[4] = {b2.x, b2.y, b2.z, b2.w};
#pragma unroll
            for (int i = 0; i < 4; ++i)
#pragma unroll
                for (int j = 0; j < 4; ++j) { ag[i][j] += aa[i] * bb1[j]; au[i][j] += aa[i] * bb2[j]; }
        }
        __syncthreads();
    }
    const float* bb = bgu + (size_t)e * 2048;
#pragma unroll
    for (int i = 0; i < 4; ++i) {
        float r[4];
#pragma unroll
        for (int j = 0; j < 4; ++j) {
            const int col = n0 + tx * 4 + j;
            const float gate = fminf(ag[i][j] + bb[col], 7.f), up = fminf(fmaxf(au[i][j] + bb[1024 + col], -7.f), 7.f);
            r[j] = (up + 1.f) * gate * (1.f / (1.f + expf(-1.702f * gate)));
        }
        *(float4*)(act + (size_t)(m0 + ty * 4 + i) * D + n0 + tx * 4) = make_float4(r[0], r[1], r[2], r[3]);
    }
}
__global__ __launch_bounds__(256) void k_moe_down(const float* __restrict__ act, const int* __restrict__ tile_e, const int* __restrict__ ntiles, const float* __restrict__ wd, const float* __restrict__ bd, float* __restrict__ y) {
    if ((int)blockIdx.y >= ntiles[0]) return;
    __shared__ float As[16][68];
    __shared__ float Bs[16][68];
    const int tid = threadIdx.x, tx = tid & 15, ty = tid >> 4, m0 = blockIdx.y * 64, n0 = blockIdx.x * 64, e = tile_e[blockIdx.y];
    const float* B = wd + (size_t)e * 1024 * 1024;
    float acc[4][4];
#pragma unroll
    for (int i = 0; i < 4; ++i)
#pragma unroll
        for (int j = 0; j < 4; ++j) acc[i][j] = 0.f;
    const int ar = tid >> 2, ac = (tid & 3) * 4, br = tid >> 4, bc = (tid & 15) * 4;
    for (int k0 = 0; k0 < 1024; k0 += 16) {
        const float4 av = *(const float4*)(act + (size_t)(m0 + ar) * D + k0 + ac);
        const float4 bv = *(const float4*)(B + (size_t)(k0 + br) * 1024 + n0 + bc);
        As[ac + 0][ar] = av.x; As[ac + 1][ar] = av.y; As[ac + 2][ar] = av.z; As[ac + 3][ar] = av.w;
        *(float4*)&Bs[br][bc] = bv;
        __syncthreads();
#pragma unroll
        for (int kk = 0; kk < 16; ++kk) {
            const float4 a = *(const float4*)&As[kk][ty * 4], b = *(const float4*)&Bs[kk][tx * 4];
            const float aa[4] = {a.x, a.y, a.z, a.w}, bb[4] = {b.x, b.y, b.z, b.w};
#pragma unroll
            for (int i = 0; i < 4; ++i)
#pragma unroll
                for (int j = 0; j < 4; ++j) acc[i][j] += aa[i] * bb[j];
        }
        __syncthreads();
    }
    const float* bb = bd + (size_t)e * 1024 + n0 + tx * 4;
#pragma unroll
    for (int i = 0; i < 4; ++i) *(float4*)(y + (size_t)(m0 + ty * 4 + i) * D + n0 + tx * 4) = make_float4(acc[i][0] + bb[0], acc[i][1] + bb[1], acc[i][2] + bb[2], acc[i][3] + bb[3]);
}
__global__ __launch_bounds__(256) void k_moe_combine(const float* __restrict__ hin, const float* __restrict__ y, const int* __restrict__ tok_row, const float* __restrict__ tok_w, const float* __restrict__ modl, int g_off, float* __restrict__ hout) {
    const int t = blockIdx.x, b = t / S, j = threadIdx.x * 4;
    float4 s = make_float4(0.f, 0.f, 0.f, 0.f);
#pragma unroll
    for (int k = 0; k < 4; ++k) {
        const float w = tok_w[t * 4 + k]; const float4 v = ((const float4*)(y + (size_t)tok_row[t * 4 + k] * D))[threadIdx.x];
        s.x += w * v.x; s.y += w * v.y; s.z += w * v.z; s.w += w * v.w;
    }
    const float4 a = ((const float4*)(hin + (size_t)t * D))[threadIdx.x];
    const float* g = modl + (size_t)b * 6144 + g_off + j;
    ((float4*)(hout + (size_t)t * D))[threadIdx.x] = make_float4(a.x + g[0] * s.x, a.y + g[1] * s.y, a.z + g[2] * s.z, a.w + g[3] * s.w);
}

__global__ __launch_bounds__(256) void k_conv(const float* __restrict__ zx, const float* __restrict__ cw, const float* __restrict__ cb, float* __restrict__ xc) {
    const int t = blockIdx.x, tt = t % S, ch = blockIdx.y * 1024 + threadIdx.x * 4;
    float4 a = *(const float4*)(cb + ch);
#pragma unroll
    for (int w = 0; w < 4; ++w) {
        if (tt - 3 + w < 0) continue;
        const float4 x = *(const float4*)(zx + (size_t)(t - 3 + w) * SSM_IN + 2048 + ch), k = *(const float4*)(cw + w * CONV_DIM + ch);
        a.x += x.x * k.x; a.y += x.y * k.y; a.z += x.z * k.z; a.w += x.w * k.w;
    }
    *(float4*)(xc + (size_t)t * CONV_DIM + ch) = make_float4(siluf(a.x), siluf(a.y), siluf(a.z), siluf(a.w));
}
__global__ __launch_bounds__(256) void k_ssd(const float* __restrict__ zx, const float* __restrict__ xc, const float* __restrict__ dt_bias, const float* __restrict__ a_log, const float* __restrict__ dskip, float* __restrict__ ys) {
    const int b = blockIdx.x >> 5, hh = blockIdx.x & 31, g = hh >> 3, p = threadIdx.x >> 2, c4 = threadIdx.x & 3;
    const float a = -expf(a_log[hh]), dtb = dt_bias[hh], dsk = dskip[hh];
    float st[32];
#pragma unroll
    for (int i = 0; i < 32; ++i) st[i] = 0.f;
    for (int tt = 0; tt < S; ++tt) {
        const size_t t = (size_t)b * S + tt;
        const float raw = zx[t * SSM_IN + 5120 + hh] + dtb;
        const float dt = raw > 20.f ? raw : log1pf(expf(raw));
        const float dA = expf(dt * a);
        const float xv = xc[t * CONV_DIM + hh * 64 + p];
        const float xd = xv * dt;
        const float4* Bp = (const float4*)(xc + t * CONV_DIM + 2048 + g * 128 + c4 * 32);
        const float4* Cp = (const float4*)(xc + t * CONV_DIM + 2560 + g * 128 + c4 * 32);
        float y = 0.f;
#pragma unroll
        for (int i = 0; i < 8; ++i) {
            const float4 bv = Bp[i], cv = Cp[i];
            st[4 * i + 0] = st[4 * i + 0] * dA + xd * bv.x; y += cv.x * st[4 * i + 0];
            st[4 * i + 1] = st[4 * i + 1] * dA + xd * bv.y; y += cv.y * st[4 * i + 1];
            st[4 * i + 2] = st[4 * i + 2] * dA + xd * bv.z; y += cv.z * st[4 * i + 2];
            st[4 * i + 3] = st[4 * i + 3] * dA + xd * bv.w; y += cv.w * st[4 * i + 3];
        }
        y += __shfl_xor(y, 1); y += __shfl_xor(y, 2);
        if (c4 == 0) ys[t * SSM_INNER + hh * 64 + p] = y + xv * dsk;
    }
}
__global__ __launch_bounds__(128) void k_gate_norm(const float* __restrict__ ys, const float* __restrict__ zx, const float* __restrict__ norm_g, float* __restrict__ yn) {
    __shared__ float red[2];
    const int t = blockIdx.x, ch = blockIdx.y * 512 + threadIdx.x * 4;
    const float4 y = *(const float4*)(ys + (size_t)t * SSM_INNER + ch), z = *(const float4*)(zx + (size_t)t * SSM_IN + ch);
    float4 v = make_float4(y.x * siluf(z.x), y.y * siluf(z.y), y.z * siluf(z.z), y.w * siluf(z.w));
    const float ss = wave_sum(v.x * v.x + v.y * v.y + v.z * v.z + v.w * v.w);
    if ((threadIdx.x & 63) == 0) red[threadIdx.x >> 6] = ss;
    __syncthreads();
    const float r = rsqrtf((red[0] + red[1]) * (1.f / 512.f) + EPS);
    const float4 gn = *(const float4*)(norm_g + ch);
    *(float4*)(yn + (size_t)t * SSM_INNER + ch) = make_float4(v.x * r * gn.x, v.y * r * gn.y, v.z * r * gn.z, v.w * r * gn.w);
}
}

extern "C" void kernel_launch(void* const* d_in, const int* in_sizes, int n_in, void* d_out, int out_size, void* d_ws, size_t ws_size, hipStream_t stream) {
    const float* x = (const float*)d_in[0]; const float* c = (const float*)d_in[1]; const float* ada_w = (const float*)d_in[2]; const float* ada_b = (const float*)d_in[3];
    const float* norm_mix = (const float*)d_in[4]; const float* norm_ffn = (const float*)d_in[5]; const float* attn_w_in = (const float*)d_in[6]; const float* attn_w_out = (const float*)d_in[7];
    const float* q_norm = (const float*)d_in[8]; const float* k_norm = (const float*)d_in[9]; const float* pe_k = (const float*)d_in[10]; const float* pe_v = (const float*)d_in[11];
    const float* w1k = (const float*)d_in[12]; const float* w2k = (const float*)d_in[13]; const float* w1v = (const float*)d_in[14]; const float* w2v = (const float*)d_in[15];
    const float* ssm_w_in = (const float*)d_in[16]; const float* conv_w = (const float*)d_in[17]; const float* conv_b = (const float*)d_in[18]; const float* dt_bias = (const float*)d_in[19];
    const float* a_log = (const float*)d_in[20]; const float* ssm_d = (const float*)d_in[21]; const float* ssm_norm = (const float*)d_in[22]; const float* ssm_w_out = (const float*)d_in[23];
    const float* router_w = (const float*)d_in[24]; const float* router_b = (const float*)d_in[25]; const float* w_gu = (const float*)d_in[26]; const float* b_gu = (const float*)d_in[27];
    const float* w_down = (const float*)d_in[28]; const float* b_down = (const float*)d_in[29];
    float* out = (float*)d_out;

    char* wp = (char*)d_ws; size_t off = 0;
    auto alloc = [&](size_t bytes) { void* p = wp + off; off += (bytes + 255) & ~(size_t)255; return p; };
    float* mod = (float*)alloc(2 * 4 * 6144 * 4);
    float* u = (float*)alloc((size_t)T * D * 4);
    float* big = (float*)alloc((size_t)T * SSM_IN * 4);
    float* oatt = (float*)alloc((size_t)T * SSM_INNER * 4);
    float* mix = (float*)alloc((size_t)T * D * 4);
    float* hA = (float*)alloc((size_t)T * D * 4);
    float* hB = (float*)alloc((size_t)T * D * 4);
    float* qn = (float*)alloc((size_t)T * 8 * 64 * 4);
    float* kn = (float*)alloc((size_t)T * 4 * 64 * 4);
    float* kcmp = (float*)alloc((size_t)NB * NCMP * 2 * 64 * 4);
    float* vcmp = (float*)alloc((size_t)NB * NCMP * 2 * 64 * 4);
    float* act = (float*)alloc((size_t)MAXROWS * D * 4);
    float* yb = (float*)alloc((size_t)MAXROWS * D * 4);
    float* xc = (float*)alloc((size_t)T * CONV_DIM * 4);
    float* yn = (float*)alloc((size_t)T * SSM_INNER * 4);
    int* cnt = (int*)alloc(256);
    int* rowbase = (int*)alloc(256);
    int* ntiles = (int*)alloc(256);
    int* tile_e = (int*)alloc(MAXTILES * 4);
    int* tok_e = (int*)alloc((size_t)T * 4 * 4);
    float* tok_w = (float*)alloc((size_t)T * 4 * 4);
    int* tok_pos = (int*)alloc((size_t)T * 4 * 4);
    int* tok_row = (int*)alloc((size_t)T * 4 * 4);
    int* row_tok = (int*)alloc((size_t)MAXROWS * 4);
    if (off > ws_size) { fprintf(stderr, "workspace too small: need %zu have %zu\n", off, ws_size); return; }

    k_mod<<<2 * 6144 / 256, 256, 0, stream>>>(c, ada_w, ada_b, mod);

    auto moe = [&](int l, const float* hin, float* hout) {
        const float* modl = mod + (size_t)l * 4 * 6144;
        k_norm_mod<<<T, 256, 0, stream>>>(hin, norm_ffn + l * D, modl, 4096, 3072, u);
        (void)hipMemsetAsync(cnt, 0, 256, stream);
        (void)hipMemsetAsync(row_tok, 0xFF, (size_t)MAXROWS * 4, stream);
        k_router<<<T, 64, 0, stream>>>(u, router_w + (size_t)l * D * NE, router_b + l * NE, cnt, tok_e, tok_w, tok_pos);
        k_moe_plan<<<1, 64, 0, stream>>>(cnt, rowbase, tile_e, ntiles);
        k_moe_scatter<<<T * 4 / 256, 256, 0, stream>>>(tok_e, tok_pos, rowbase, row_tok, tok_row);
        k_moe_gu<<<dim3(16, MAXTILES), 256, 0, stream>>>(u, row_tok, tile_e, ntiles, w_gu + (size_t)l * NE * 1024 * 2048, b_gu + (size_t)l * NE * 2048, act);
        k_moe_down<<<dim3(16, MAXTILES), 256, 0, stream>>>(act, tile_e, ntiles, w_down + (size_t)l * NE * 1024 * 1024, b_down + (size_t)l * NE * 1024, yb);
        k_moe_combine<<<T, 256, 0, stream>>>(hin, yb, tok_row, tok_w, modl, 5120, hout);
    };

    k_norm_mod<<<T, 256, 0, stream>>>(x, norm_mix, mod, 1024, 0, u);
    k_sgemm<<<dim3((ATTN_IN + 63) / 64, T / 64), 256, 0, stream>>>(u, D, attn_w_in, ATTN_IN, big, ATTN_IN, T, ATTN_IN, D);
    k_sb_attn<<<dim3(S / 64, NB * 8), 64, 0, stream>>>(big, oatt);
    k_nsa_prep<<<dim3(T, 12), 64, 0, stream>>>(big, q_norm, k_norm, qn, kn);
    k_cmp<<<dim3(NCMP, NB * 2, 2), 128, 0, stream>>>(big, pe_k, pe_v, w1k, w2k, w1v, w2v, k_norm, kcmp, vcmp);
    k_nsa<<<dim3(S, NB * 2), 256, 0, stream>>>(big, qn, kn, kcmp, vcmp, oatt);
    k_sgemm<<<dim3(D / 64, T / 64), 256, 0, stream>>>(oatt, D, attn_w_out, D, mix, D, T, D, D);
    k_resid<<<T, 256, 0, stream>>>(x, mix, mod, 2048, hA);
    moe(0, hA, hB);
    const float* mod1 = mod + (size_t)4 * 6144;
    k_norm_mod<<<T, 256, 0, stream>>>(hB, norm_mix + D, mod1, 1024, 0, u);
    k_sgemm<<<dim3((SSM_IN + 63) / 64, T / 64), 256, 0, stream>>>(u, D, ssm_w_in, SSM_IN, big, SSM_IN, T, SSM_IN, D);
    k_conv<<<dim3(T, 3), 256, 0, stream>>>(big, conv_w, conv_b, xc);
    k_ssd<<<NB * 32, 256, 0, stream>>>(big, xc, dt_bias, a_log, ssm_d, oatt);
    k_gate_norm<<<dim3(T, 4), 128, 0, stream>>>(oatt, big, ssm_norm, yn);
    k_sgemm<<<dim3(D / 64, T / 64), 256, 0, stream>>>(yn, SSM_INNER, ssm_w_out, D, mix, D, T, D, SSM_INNER);
    k_resid<<<T, 256, 0, stream>>>(hB, mix, mod1, 2048, hA);
    moe(1, hA, out);
}
```

```cpp
#include <hip/hip_runtime.h>
#include <cstdio>
#include <cstdint>

#define LAS __attribute__((address_space(3)))
#define GAS __attribute__((address_space(1)))
typedef unsigned short bf16_t;
typedef short bf16x8 __attribute__((ext_vector_type(8)));
typedef float f32x4 __attribute__((ext_vector_type(4)));
typedef unsigned u32x4 __attribute__((ext_vector_type(4)));
typedef unsigned u32x2 __attribute__((ext_vector_type(2)));

namespace {
constexpr int D = 1024, NB = 4, S = 4096, T = NB * S;
constexpr int ATTN_IN = 2840, PROJ_LD = 3072;
constexpr int OFF_SBQ = 0, OFF_SBK = 512, OFF_SBV = 1024, OFF_NQ = 1536, OFF_KC = 2048, OFF_VC = 2176, OFF_KS = 2304, OFF_VS = 2432,
              OFF_KW = 2560, OFF_VW = 2688, OFF_GATE = 2816;
constexpr int NCMP = 255;
constexpr int SSM_IN = 5152, SSM_INNER = 2048, CONV_DIM = 3072, ZX_LD = 5120;
constexpr int NE = 32, CAP = 16384, MAXTILES = 288;
constexpr float EPS = 1e-6f;
constexpr int NWAVES = 8, NTHREADS = 512;

constexpr size_t al4k(size_t x) { return (x + 4095) & ~(size_t)4095; }
constexpr size_t WS_CTL = 0, CTL_BYTES = 1u << 20;
constexpr int CW_CNT = 256;
constexpr int CW_BAR = 4096;
constexpr size_t CTL_MOD = 65536;
constexpr size_t WS_WIN = CTL_BYTES;
constexpr size_t WS_WOUT = WS_WIN + (size_t)3072 * 1024 * 2;
constexpr size_t WS_WSIN = WS_WOUT + (size_t)1024 * 1024 * 2;
constexpr size_t WS_WSOUT = WS_WSIN + (size_t)5120 * 1024 * 2;
constexpr size_t WS_WGU = WS_WSOUT + (size_t)1024 * 2048 * 2;
constexpr size_t WS_WDN = WS_WGU + (size_t)2 * 32 * 2048 * 1024 * 2;
constexpr size_t WS_U = WS_WDN + (size_t)2 * 32 * 1024 * 1024 * 2;
constexpr size_t WS_BIG = WS_U + (size_t)T * 1024 * 2;
constexpr size_t WS_O = WS_BIG + (size_t)T * 5120 * 2;
constexpr size_t WS_H1 = WS_O + (size_t)T * 2048 * 2;
constexpr size_t WS_H2 = WS_H1 + (size_t)T * 1024 * 4;
constexpr size_t WS_QN = WS_H2 + (size_t)T * 1024 * 4;
constexpr size_t WS_KN = WS_QN + (size_t)T * 512 * 4;
constexpr size_t WS_KCMP = WS_KN + (size_t)T * 256 * 4;
constexpr size_t WS_VCMP = WS_KCMP + al4k((size_t)NB * NCMP * 2 * 64 * 4);
constexpr size_t WS_ACT = WS_VCMP + al4k((size_t)NB * NCMP * 2 * 64 * 4);
constexpr size_t WS_Y = WS_ACT + (size_t)MAXTILES * 256 * 1024 * 2;
constexpr size_t WS_TOKE = WS_Y + (size_t)MAXTILES * 256 * 1024 * 2;
constexpr size_t WS_TOKW = WS_TOKE + (size_t)T * 16;
constexpr size_t WS_TOKP = WS_TOKW + (size_t)T * 16;
constexpr size_t WS_SLOT = WS_TOKP + (size_t)T * 16;
constexpr size_t WS_XC = WS_SLOT + (size_t)NE * CAP * 4;
constexpr size_t WS_YS = WS_XC + (size_t)T * 3072 * 4;
constexpr size_t WS_DT = WS_YS + (size_t)T * 2048 * 4;
constexpr size_t WS_MODF = WS_DT + (size_t)T * 32 * 4;
constexpr size_t WS_END = WS_MODF + (size_t)2 * 4 * 6144 * 4;

constexpr int RING_BYTES = 131072;
constexpr int TAB_OFF = RING_BYTES;
constexpr int XB_OFF = RING_BYTES + 1024;
constexpr int LDS_BYTES = 147456;

struct Params { const float* in[30]; float* out; unsigned char* ws; };

__device__ __forceinline__ float siluf(float v) { return v / (1.f + expf(-v)); }
__device__ __forceinline__ float logsig(float x) { return fminf(x, 0.f) - log1pf(expf(-fabsf(x))); }
__device__ __forceinline__ float wave_sum(float v) {
#pragma unroll
    for (int o = 32; o > 0; o >>= 1) v += __shfl_xor(v, o);
    return v;
}
__device__ __forceinline__ float wave_max(float v) {
#pragma unroll
    for (int o = 32; o > 0; o >>= 1) v = fmaxf(v, __shfl_xor(v, o));
    return v;
}
__device__ __forceinline__ unsigned f2bf(float f) { unsigned u = __builtin_bit_cast(unsigned, f); return (u + 0x7fffu + ((u >> 16) & 1u)) >> 16; }
__device__ __forceinline__ unsigned pk2(float lo, float hi) { return f2bf(lo) | (f2bf(hi) << 16); }
__device__ __forceinline__ float bf2f(bf16_t v) { return __uint_as_float((unsigned)v << 16); }
__device__ __forceinline__ float bflo(unsigned w) { return __uint_as_float(w << 16); }
__device__ __forceinline__ float bfhi(unsigned w) { return __uint_as_float(w & 0xffff0000u); }
#define LDS_WAIT() asm volatile("s_waitcnt lgkmcnt(0)" ::: "memory")

#define XB_TMO      128
#define XB_XCNT(j)  (256  + 64 * (j))
#define XB_XSUB(j)  (1280 + 64 * (j))
#define XB_XGEN(j)  (2304 + 64 * (j))
#define XB_TOP      3328
#define XB_TOPGEN   3392
#define XCD_BAR_WORDS 3456
#define XB_SPIN_CAP (1u << 18)
__device__ __forceinline__ unsigned xb_ld(unsigned* p)              { return __hip_atomic_load(p, __ATOMIC_RELAXED, __HIP_MEMORY_SCOPE_AGENT); }
__device__ __forceinline__ unsigned xb_add(unsigned* p, unsigned v) { return __hip_atomic_fetch_add(p, v, __ATOMIC_RELAXED, __HIP_MEMORY_SCOPE_AGENT); }
__device__ __forceinline__ unsigned xb_xcc_id() { return (unsigned)__builtin_amdgcn_s_getreg((3 << 11) | 20) & 0xFu; }
#define XB_SPIN(cond, bar) do { unsigned _sp = 0; while (cond) { __builtin_amdgcn_s_sleep(1); \
    if ((++_sp & 255u) == 0u) { if (xb_ld(&(bar)[XB_TMO])) break; if (_sp > XB_SPIN_CAP) { atomicAdd(&(bar)[XB_TMO], 1u); break; } } } } while (0)
struct XcdBarrier { unsigned* bar; unsigned x; volatile LAS unsigned* st; };
__device__ __forceinline__ XcdBarrier xcd_barrier_post(unsigned* bar, volatile LAS unsigned* st) {
    XcdBarrier b; b.bar = bar; b.x = xb_xcc_id(); b.st = st;
    if (threadIdx.x == 0) (void)xb_add(&bar[XB_XCNT(b.x)], 1u);
    return b;
}
__device__ __forceinline__ void xcd_barrier_complete(unsigned* bar, unsigned x, unsigned& nloc, unsigned& nx) {
    const unsigned G = gridDim.x * gridDim.y * gridDim.z;
    unsigned sum, cnt, mine, sp = 0u;
    for (;;) {
        sum = 0u; cnt = 0u; mine = 0u;
#pragma unroll
        for (unsigned j = 0; j < 16; ++j) { const unsigned c = xb_ld(&bar[XB_XCNT(j)]); sum += c; cnt += (c > 0u) ? 1u : 0u; mine = (j == x) ? c : mine; }
        if (sum == G) break;
        __builtin_amdgcn_s_sleep(1);
        if ((++sp & 255u) == 0u) { if (xb_ld(&bar[XB_TMO])) break; if (sp > XB_SPIN_CAP) { atomicAdd(&bar[XB_TMO], 1u); break; } }
    }
    nloc = mine > 0u ? mine : 1u; nx = cnt > 0u ? cnt : 1u;
}
__device__ __forceinline__ void xcd_barrier(const XcdBarrier& b) {
    asm volatile("s_waitcnt vmcnt(0)" ::: "memory");
    __syncthreads();
    if (threadIdx.x == 0) {
        unsigned* bar = b.bar;
        __builtin_amdgcn_s_waitcnt(0);
        unsigned nloc = b.st[0], nx = b.st[1];
        if (nloc == 0u) { xcd_barrier_complete(bar, b.x, nloc, nx); b.st[0] = nloc; b.st[1] = nx; }
        const unsigned old = xb_add(&bar[XB_XSUB(b.x)], 1u);
        const unsigned gen = old / nloc;
        if (old + 1u == (gen + 1u) * nloc) {
            __builtin_amdgcn_fence(__ATOMIC_RELEASE, "agent");
            asm volatile("s_waitcnt vmcnt(0)" ::: "memory");
            const unsigned og = xb_add(&bar[XB_TOP], 1u);
            const unsigned tg = og / nx;
            if (og + 1u == (tg + 1u) * nx) xb_add(&bar[XB_TOPGEN], 1u);
            else XB_SPIN(xb_ld(&bar[XB_TOPGEN]) == tg, bar);
            __builtin_amdgcn_fence(__ATOMIC_ACQUIRE, "agent");
            xb_add(&bar[XB_XGEN(b.x)], 1u);
            asm volatile("s_waitcnt vmcnt(0)" ::: "memory");
        } else {
            XB_SPIN(xb_ld(&bar[XB_XGEN(b.x)]) == gen, bar);
            __builtin_amdgcn_fence(__ATOMIC_ACQUIRE, "agent");
            asm volatile("s_waitcnt vmcnt(0)" ::: "memory");
        }
    }
    __syncthreads();
}

namespace pg8 {
constexpr int BM = 256, BK = 64, HALF = 128, HTB = HALF * BK * 2, STAGE_BYTES = 8 * HTB;
__device__ __forceinline__ int lds_byte(int r, int c) { const int st = (r >> 4) * 2 + (c >> 5), rr = r & 15, cc = c & 31, ob = rr * 64 + cc * 2; return st * 1024 + (ob ^ (((ob >> 9) & 1) << 5)); }
__device__ __forceinline__ void stage_rc(int b, int& R, int& C) { const int st = b / 1024, sb = b % 1024, swz = sb ^ (((sb >> 9) & 1) << 5); R = (st >> 1) * 16 + swz / 64; C = (st & 1) * 32 + (swz % 64) / 2; }
__device__ __forceinline__ int perm32(int rho) { const int n = rho >> 4, i = rho & 15; return 8 * (i >> 2) + 4 * n + (i & 3); }
struct Unit { int pm, pn, e; };
struct Gemm { const bf16_t* A; const bf16_t* Bt; int K; };
__device__ __forceinline__ unsigned cvt_pk_bf16(float lo, float hi) { unsigned r; asm volatile("v_cvt_pk_bf16_f32 %0, %1, %2" : "=v"(r) : "v"(lo), "v"(hi)); return r; }

struct DenseOrder {
    int nM, nN, nwg, G, c;
    __device__ void init(int M, int N, int G_, int c_) { nM = M / BM; nN = N / BM; nwg = nM * nN; G = G_; c = c_; }
    __device__ bool next(int i, Unit& u) const {
        const long L = (long)i * G + c; if (L >= nwg) return false;
        int wgid = (int)L; { const int q = nwg / 8, r = nwg % 8, xcd = wgid % 8, off = wgid / 8; wgid = (xcd < r ? xcd * (q + 1) : r * (q + 1) + (xcd - r) * q) + off; }
        const int nig = 8 * nN, gid = wgid / nig, fm = gid * 8, gsz = (nM - fm) < 8 ? (nM - fm) : 8;
        u.pm = fm + ((wgid % nig) % gsz); u.pn = (wgid % nig) / gsz; u.e = 0; return true;
    }
    __device__ __forceinline__ unsigned arow(const Unit& u, int r) const { return (unsigned)(u.pm * BM + r); }
};
struct MoeOrder {
    const LAS int* tb; const LAS int* cn; const int* slot_tok; int shift, G, c; bool gather;
    __device__ bool next(int i, Unit& u) const {
        const int L = i * G + c, tile = L >> shift; if (tile >= tb[NE]) return false;
        int e = 0; while (tb[e + 1] <= tile) ++e;
        u.pm = tile; u.pn = (e << shift) + (L & ((1 << shift) - 1)); u.e = e; return true;
    }
    __device__ __forceinline__ unsigned arow(const Unit& u, int r) const {
        if (!gather) return (unsigned)(u.pm * BM + r);
        const int pos = (u.pm - tb[u.e]) * BM + r;
        return pos < cn[u.e] ? (unsigned)slot_tok[u.e * CAP + pos] : 0u;
    }
};

struct EpiBf16 {
    static constexpr bool PERM = true;
    bf16_t* O; int ldc;
    __device__ __forceinline__ void operator()(const f32x4 (&acc)[2][2][4][2], const Unit& u, int wr, int wc, int fr, int fq) const {
        const int row0 = u.pm * BM + wr * 64 + fr, col0 = u.pn * BM + wc * 32 + 8 * fq;
#pragma unroll
        for (int ai = 0; ai < 2; ++ai)
#pragma unroll
            for (int m = 0; m < 4; ++m) { bf16_t* rowp = O + (size_t)(row0 + ai * HALF + m * 16) * ldc + col0;
#pragma unroll
                for (int bj = 0; bj < 2; ++bj) { const f32x4 v0 = acc[ai][bj][m][0], v1 = acc[ai][bj][m][1];
                    u32x4 w; w.x = cvt_pk_bf16(v0[0], v0[1]); w.y = cvt_pk_bf16(v0[2], v0[3]); w.z = cvt_pk_bf16(v1[0], v1[1]); w.w = cvt_pk_bf16(v1[2], v1[3]);
                    *(u32x4*)(rowp + bj * HALF) = w; } }
    }
};
struct EpiResid {
    static constexpr bool PERM = false;
    const float* base; float* out; const float* g;
    __device__ __forceinline__ void operator()(const f32x4 (&acc)[2][2][4][2], const Unit& u, int wr, int wc, int fr, int fq) const {
        const int row0 = u.pm * BM + wr * 64 + fr, col0 = u.pn * BM + wc * 32 + 4 * fq;
        const float* gb = g + (size_t)((u.pm * BM) / S) * 6144 + col0;
        f32x4 gv[2][2];
#pragma unroll
        for (int bj = 0; bj < 2; ++bj)
#pragma unroll
            for (int n = 0; n < 2; ++n) gv[bj][n] = *(const f32x4*)(gb + bj * HALF + n * 16);
#pragma unroll
        for (int ai = 0; ai < 2; ++ai)
#pragma unroll
            for (int m = 0; m < 4; ++m) { const size_t off = (size_t)(row0 + ai * HALF + m * 16) * D + col0;
#pragma unroll
                for (int bj = 0; bj < 2; ++bj)
#pragma unroll
                    for (int n = 0; n < 2; ++n) { const f32x4 bs = *(const f32x4*)(base + off + bj * HALF + n * 16);
                        *(f32x4*)(out + off + bj * HALF + n * 16) = bs + gv[bj][n] * acc[ai][bj][m][n]; } }
    }
};
struct EpiGu {
    static constexpr bool PERM = true;
    bf16_t* act; const float* bgu;
    __device__ __forceinline__ void operator()(const f32x4 (&acc)[2][2][4][2], const Unit& u, int wr, int wc, int fr, int fq) const {
        const int row0 = u.pm * BM + wr * 64 + fr, col0 = (u.pn & 7) * HALF + wc * 32 + 8 * fq;
        const float* bb = bgu + (size_t)u.e * 2048 + col0;
        const f32x4 bg0 = *(const f32x4*)(bb), bg1 = *(const f32x4*)(bb + 4), bu0 = *(const f32x4*)(bb + 1024), bu1 = *(const f32x4*)(bb + 1028);
#pragma unroll
        for (int ai = 0; ai < 2; ++ai)
#pragma unroll
            for (int m = 0; m < 4; ++m) {
                float r[8];
#pragma unroll
                for (int n = 0; n < 2; ++n) { const f32x4 gt = acc[ai][0][m][n] + (n ? bg1 : bg0), up = acc[ai][1][m][n] + (n ? bu1 : bu0);
#pragma unroll
                    for (int j = 0; j < 4; ++j) { const float gg = fminf(gt[j], 7.f), uu = fminf(fmaxf(up[j], -7.f), 7.f);
                        r[n * 4 + j] = (uu + 1.f) * gg * __builtin_amdgcn_rcpf(1.f + __expf(-1.702f * gg)); } }
                u32x4 w; w.x = cvt_pk_bf16(r[0], r[1]); w.y = cvt_pk_bf16(r[2], r[3]); w.z = cvt_pk_bf16(r[4], r[5]); w.w = cvt_pk_bf16(r[6], r[7]);
                *(u32x4*)(act + (size_t)(row0 + ai * HALF + m * 16) * D + col0) = w; }
    }
};
struct EpiDown {
    static constexpr bool PERM = true;
    bf16_t* y; const float* bd;
    __device__ __forceinline__ void operator()(const f32x4 (&acc)[2][2][4][2], const Unit& u, int wr, int wc, int fr, int fq) const {
        const int row0 = u.pm * BM + wr * 64 + fr, col0 = (u.pn & 3) * BM + wc * 32 + 8 * fq;
        const float* bb = bd + (size_t)u.e * 1024 + col0;
        f32x4 bv[2][2];
#pragma unroll
        for (int bj = 0; bj < 2; ++bj)
#pragma unroll
            for (int n = 0; n < 2; ++n) bv[bj][n] = *(const f32x4*)(bb + bj * HALF + 4 * n);
#pragma unroll
        for (int ai = 0; ai < 2; ++ai)
#pragma unroll
            for (int m = 0; m < 4; ++m) { bf16_t* rowp = y + (size_t)(row0 + ai * HALF + m * 16) * D + col0;
#pragma unroll
                for (int bj = 0; bj < 2; ++bj) { const f32x4 v0 = acc[ai][bj][m][0] + bv[bj][0], v1 = acc[ai][bj][m][1] + bv[bj][1];
                    u32x4 w; w.x = cvt_pk_bf16(v0[0], v0[1]); w.y = cvt_pk_bf16(v0[2], v0[3]); w.z = cvt_pk_bf16(v1[0], v1[1]); w.w = cvt_pk_bf16(v1[2], v1[3]);
                    *(u32x4*)(rowp + bj * HALF) = w; } }
    }
};

template <class Epi, class Sched>
__device__ __forceinline__ void gemm_phase(LAS unsigned char* lds, const Gemm g, const Sched& S, const Epi& E) {
    const int tid = threadIdx.x, wid = __builtin_amdgcn_readfirstlane(tid >> 6), lane = tid & 63, wr = wid >> 2, wc = wid & 3, fr = lane & 15, fq = lane >> 4;
    const int K = g.K, nt = K / BK;
    int RA[2], CA[2]; unsigned voffB[2];
#pragma unroll
    for (int i = 0; i < 2; ++i) { int R, C; stage_rc(tid * 16 + i * 8192, R, C); const int Rb = Epi::PERM ? ((R & ~31) + perm32(R & 31)) : R;
        RA[i] = R; CA[i] = C; voffB[i] = (unsigned)(Rb * K + C) * 2u; }
    const size_t kstep = (size_t)(BK * 2);
    const size_t hstep = (size_t)HALF * K * 2;
    const size_t tstep = 2 * hstep;
    const unsigned ldsw = (unsigned)wid * 1024u;
    const int aoff = lds_byte(wr * 64 + fr, fq * 8), boff = lds_byte(wc * 32 + fr, fq * 8);
#define PG8_SA(b, h) (((b) * 2 + (h)) * HTB)
#define PG8_SB(b, h) ((4 + (b) * 2 + (h)) * HTB)
#define PG8_STAGE(bufoff, gbase, voff) do { _Pragma("unroll") for (int _i = 0; _i < 2; ++_i) \
        __builtin_amdgcn_global_load_lds((const unsigned*)((const char*)(gbase) + (voff)[_i]), (LAS unsigned*)(lds + (bufoff) + ldsw + _i * 8192), 16, 0, 0); } while (0)
#define PG8_LDA(dst, b, h) do { _Pragma("unroll") for (int m = 0; m < 4; ++m) _Pragma("unroll") for (int k = 0; k < 2; ++k) dst[m][k] = *(const LAS bf16x8*)(lds + PG8_SA(b, h) + aoff + m * 2048 + k * 1024); } while (0)
#define PG8_LDB(dst, b, h) do { _Pragma("unroll") for (int n = 0; n < 2; ++n) _Pragma("unroll") for (int k = 0; k < 2; ++k) dst[n][k] = *(const LAS bf16x8*)(lds + PG8_SB(b, h) + boff + n * 2048 + k * 1024); } while (0)
#define PG8_MMA(ai, bj, At, Bt) do { __builtin_amdgcn_s_setprio(1); _Pragma("unroll") for (int m = 0; m < 4; ++m) _Pragma("unroll") for (int n = 0; n < 2; ++n) _Pragma("unroll") for (int k = 0; k < 2; ++k) \
        acc[ai][bj][m][n] = __builtin_amdgcn_mfma_f32_16x16x32_bf16(Bt[n][k], At[m][k], acc[ai][bj][m][n], 0, 0, 0); __builtin_amdgcn_s_setprio(0); } while (0)
#define PG8_WAIT_V(n) asm volatile("s_waitcnt vmcnt(" #n ")" ::: "memory")
#define PG8_WAIT_L(n) asm volatile("s_waitcnt lgkmcnt(" #n ")" ::: "memory")
#define PG8_BAR __builtin_amdgcn_s_barrier()
#define PG8_SCHED __builtin_amdgcn_sched_barrier(0)
#define PG8_AOFF(dst, u) do { _Pragma("unroll") for (int _h = 0; _h < 2; ++_h) _Pragma("unroll") for (int _i = 0; _i < 2; ++_i) dst[_h][_i] = (S.arow(u, _h * HALF + RA[_i]) * (unsigned)K + (unsigned)CA[_i]) * 2u; } while (0)
    Unit cur, nxt; int ui = 0;
    if (!S.next(0, cur)) return;
    f32x4 acc[2][2][4][2];
#pragma unroll
    for (int a = 0; a < 2; ++a)
#pragma unroll
        for (int b = 0; b < 2; ++b)
#pragma unroll
            for (int m = 0; m < 4; ++m)
#pragma unroll
                for (int n = 0; n < 2; ++n) acc[a][b][m][n] = (f32x4){0.f, 0.f, 0.f, 0.f};
    bf16x8 At[4][2], B0[2][2], B1[2][2];
    unsigned va[2][2], vn[2][2];
    PG8_AOFF(va, cur);
    const char* Ab = (const char*)g.A;
    const char* cB = (const char*)g.Bt + (size_t)cur.pn * tstep;
    PG8_STAGE(PG8_SB(0, 0), cB, voffB); PG8_STAGE(PG8_SB(0, 1), cB + hstep, voffB); PG8_STAGE(PG8_SA(0, 0), Ab, va[0]); PG8_STAGE(PG8_SA(0, 1), Ab, va[1]);
    if (wr == 1) PG8_BAR;
    PG8_WAIT_V(2); PG8_BAR;
    PG8_STAGE(PG8_SB(1, 0), cB + kstep, voffB); PG8_STAGE(PG8_SA(1, 0), Ab + kstep, va[0]); PG8_STAGE(PG8_SB(1, 1), cB + hstep + kstep, voffB);
    PG8_WAIT_V(6); PG8_BAR;
    for (;;) {
        const bool has_next = S.next(ui + 1, nxt);
        if (has_next) { PG8_AOFF(vn, nxt); }
        else {
#pragma unroll
            for (int h = 0; h < 2; ++h)
#pragma unroll
                for (int i = 0; i < 2; ++i) vn[h][i] = va[h][i]; }
        const char* nB = has_next ? (const char*)g.Bt + (size_t)nxt.pn * tstep : cB;
        for (int t = 0; t < nt; t += 2) {
            const bool last = (t == nt - 2);
            const char* a1 = Ab + (size_t)(t + 1) * kstep;
            const char* a2 = last ? Ab : Ab + (size_t)(t + 2) * kstep; const char* b2 = last ? nB : cB + (size_t)(t + 2) * kstep;
            const char* a3 = a2 + kstep; const char* b3 = b2 + kstep;
            unsigned o2[2][2];
#pragma unroll
            for (int h = 0; h < 2; ++h)
#pragma unroll
                for (int i = 0; i < 2; ++i) o2[h][i] = last ? vn[h][i] : va[h][i];
            PG8_LDB(B0, 0, 0); PG8_LDB(B1, 0, 1); PG8_SCHED; PG8_LDA(At, 0, 0); PG8_STAGE(PG8_SA(1, 1), a1, va[1]);
            PG8_WAIT_V(8); PG8_WAIT_L(0); PG8_BAR; PG8_MMA(0, 0, At, B0); PG8_MMA(0, 1, At, B1); PG8_BAR; PG8_SCHED;
            PG8_LDA(At, 0, 1); PG8_STAGE(PG8_SB(0, 0), b2, voffB); PG8_STAGE(PG8_SB(0, 1), b2 + hstep, voffB); PG8_STAGE(PG8_SA(0, 0), a2, o2[0]);
            PG8_WAIT_V(8); PG8_WAIT_L(0); PG8_BAR; PG8_MMA(1, 0, At, B0); PG8_MMA(1, 1, At, B1); PG8_BAR; PG8_SCHED;
            PG8_LDB(B0, 1, 0); PG8_LDB(B1, 1, 1); PG8_SCHED; PG8_LDA(At, 1, 0); PG8_STAGE(PG8_SA(0, 1), a2, o2[1]);
            PG8_WAIT_V(8); PG8_WAIT_L(0); PG8_BAR; PG8_MMA(0, 0, At, B0); PG8_MMA(0, 1, At, B1); PG8_BAR; PG8_SCHED;
            PG8_LDA(At, 1, 1); PG8_STAGE(PG8_SB(1, 0), b3, voffB); PG8_STAGE(PG8_SB(1, 1), b3 + hstep, voffB); PG8_STAGE(PG8_SA(1, 0), a3, o2[0]);
            PG8_WAIT_V(8); PG8_WAIT_L(0); PG8_BAR; PG8_MMA(1, 0, At, B0); PG8_MMA(1, 1, At, B1); PG8_BAR; PG8_SCHED;
        }
        if (wr == 0) PG8_BAR;
        E(acc, cur, wr, wc, fr, fq);
        if (!has_next) break;
#pragma unroll
        for (int a = 0; a < 2; ++a)
#pragma unroll
            for (int b = 0; b < 2; ++b)
#pragma unroll
                for (int m = 0; m < 4; ++m)
#pragma unroll
                    for (int n = 0; n < 2; ++n) acc[a][b][m][n] = (f32x4){0.f, 0.f, 0.f, 0.f};
        cur = nxt; cB = nB; ++ui;
#pragma unroll
        for (int h = 0; h < 2; ++h)
#pragma unroll
            for (int i = 0; i < 2; ++i) va[h][i] = vn[h][i];
        if (wr == 1) PG8_BAR;
    }
    PG8_WAIT_V(0);
    PG8_BAR;
#undef PG8_SA
#undef PG8_SB
#undef PG8_STAGE
#undef PG8_LDA
#undef PG8_LDB
#undef PG8_MMA
#undef PG8_WAIT_V
#undef PG8_WAIT_L
#undef PG8_BAR
#undef PG8_SCHED
#undef PG8_AOFF
}
}

struct Ctx {
    LAS unsigned char* lds; unsigned char* ws;
    int tid, lane, wave, gw, ngw, G, bid;
};

__device__ __forceinline__ void transpose_item(const float* W, int ldw, int K, int nvalid, int k0, int n0, bf16_t* WT, int row0, LAS float* scr, int lane) {
    const int nn = n0 + (lane & 31);
#pragma unroll 8
    for (int i = 0; i < 32; ++i) { const int kk = 2 * i + (lane >> 5); scr[kk * 33 + (lane & 31)] = nn < nvalid ? W[(size_t)(k0 + kk) * ldw + nn] : 0.f; }
    LDS_WAIT(); asm volatile("" ::: "memory");
    const int c = lane & 7;
#pragma unroll
    for (int j = 0; j < 4; ++j) { const int n = (lane >> 3) + 8 * j; const LAS float* s = scr + (8 * c) * 33 + n;
        u32x4 o; o.x = pk2(s[0 * 33], s[1 * 33]); o.y = pk2(s[2 * 33], s[3 * 33]); o.z = pk2(s[4 * 33], s[5 * 33]); o.w = pk2(s[6 * 33], s[7 * 33]);
        *(u32x4*)(WT + (size_t)(row0 + n) * K + k0 + 8 * c) = o; }
    LDS_WAIT(); asm volatile("" ::: "memory");
}
__device__ __forceinline__ void ph_prologue(const Params& p, const Ctx& X) {
    LAS float* scr = (LAS float*)(X.lds + X.wave * 16384);
    unsigned char* ws = X.ws;
    constexpr int I_MOD = 2 * 96 * 8;
    constexpr int I_WIN = 16 * 96, I_WOUT = 16 * 32, I_WSIN = 16 * 160, I_WSOUT = 32 * 32, I_GU = 64 * 1024, I_DN = 64 * 512;
    constexpr int NITEMS = I_MOD + I_WIN + I_WOUT + I_WSIN + I_WSOUT + I_GU + I_DN;
    for (int it = X.gw; it < NITEMS; it += X.ngw) {
        int r = it;
        if (r < I_MOD) {
            const int kp = r & 7, jb = (r >> 3) % 96, l = r / (8 * 96), j = jb * 64 + X.lane;
            const float* w = p.in[2] + (size_t)l * 1024 * 6144 + (size_t)(kp * 128) * 6144 + j;
            const float* c = p.in[1] + kp * 128;
            float a0 = 0.f, a1 = 0.f, a2 = 0.f, a3 = 0.f;
#pragma unroll 8
            for (int i = 0; i < 128; ++i) { const float wv = w[(size_t)i * 6144];
                a0 += siluf(c[i]) * wv; a1 += siluf(c[1024 + i]) * wv; a2 += siluf(c[2048 + i]) * wv; a3 += siluf(c[3072 + i]) * wv; }
            if (kp == 0) { const float bb = p.in[3][l * 6144 + j]; a0 += bb; a1 += bb; a2 += bb; a3 += bb; }
            unsigned long long* mq = (unsigned long long*)(ws + CTL_MOD) + (size_t)l * 4 * 6144 + j;
            atomicAdd(mq, (unsigned long long)__double2ll_rn((double)a0 * 1099511627776.0)); atomicAdd(mq + 6144, (unsigned long long)__double2ll_rn((double)a1 * 1099511627776.0));
            atomicAdd(mq + 2 * 6144, (unsigned long long)__double2ll_rn((double)a2 * 1099511627776.0)); atomicAdd(mq + 3 * 6144, (unsigned long long)__double2ll_rn((double)a3 * 1099511627776.0));
            continue;
        }
        r -= I_MOD;
        if (r < I_WIN) { const int kb = r / 96, nb = r % 96; transpose_item(p.in[6], ATTN_IN, 1024, ATTN_IN, kb * 64, nb * 32, (bf16_t*)(ws + WS_WIN), nb * 32, scr, X.lane); continue; } r -= I_WIN;
        if (r < I_WOUT) { const int kb = r / 32, nb = r % 32; transpose_item(p.in[7], 1024, 1024, 1024, kb * 64, nb * 32, (bf16_t*)(ws + WS_WOUT), nb * 32, scr, X.lane); continue; } r -= I_WOUT;
        if (r < I_WSIN) { const int kb = r / 160, nb = r % 160; transpose_item(p.in[16], SSM_IN, 1024, SSM_IN, kb * 64, nb * 32, (bf16_t*)(ws + WS_WSIN), nb * 32, scr, X.lane); continue; } r -= I_WSIN;
        if (r < I_WSOUT) { const int kb = r / 32, nb = r % 32; transpose_item(p.in[23], 1024, 2048, 1024, kb * 64, nb * 32, (bf16_t*)(ws + WS_WSOUT), nb * 32, scr, X.lane); continue; } r -= I_WSOUT;
        if (r < I_GU) { const int m = r >> 10, q = r & 1023, kb = q >> 6, nb = q & 63, n0 = nb * 32;
            const int row0 = ((n0 & 1023) >> 7) * 256 + (n0 >> 10) * 128 + (n0 & 127);
            transpose_item(p.in[26] + (size_t)m * 1024 * 2048, 2048, 1024, 2048, kb * 64, n0, (bf16_t*)(ws + WS_WGU) + (size_t)m * 2048 * 1024, row0, scr, X.lane); continue; } r -= I_GU;
        { const int m = r >> 9, q = r & 511, kb = q >> 5, nb = q & 31;
            transpose_item(p.in[28] + (size_t)m * 1024 * 1024, 1024, 1024, 1024, kb * 64, nb * 32, (bf16_t*)(ws + WS_WDN) + (size_t)m * 1024 * 1024, nb * 32, scr, X.lane); }
    }
}

struct Row { f32x4 v[4]; };
__device__ __forceinline__ void row_load(Row& r, const float* p, int lane) {
#pragma unroll
    for (int j = 0; j < 4; ++j) r.v[j] = ((const f32x4*)p)[64 * j + lane];
}
__device__ __forceinline__ void row_store(const Row& r, float* p, int lane) {
#pragma unroll
    for (int j = 0; j < 4; ++j) ((f32x4*)p)[64 * j + lane] = r.v[j];
}
template <class PV>
__device__ __forceinline__ void row_norm_mod(const Row& r, Row& o, const float* gain, PV sc, PV sh, int lane) {
    float ss = 0.f;
#pragma unroll
    for (int j = 0; j < 4; ++j) ss += (r.v[j].x * r.v[j].x + r.v[j].y * r.v[j].y) + (r.v[j].z * r.v[j].z + r.v[j].w * r.v[j].w);
    const float rs = rsqrtf(wave_sum(ss) * (1.f / 1024.f) + EPS);
#pragma unroll
    for (int j = 0; j < 4; ++j) { const f32x4 g = ((const f32x4*)gain)[64 * j + lane], a = sc[64 * j + lane], b = sh[64 * j + lane];
        o.v[j] = r.v[j] * rs * g * (a + 1.f) + b; }
}
__device__ __forceinline__ void row_store_bf16(const Row& r, bf16_t* p, int lane) {
#pragma unroll
    for (int j = 0; j < 4; ++j) { u32x2 w; w.x = pk2(r.v[j].x, r.v[j].y); w.y = pk2(r.v[j].z, r.v[j].w); ((u32x2*)p)[64 * j + lane] = w; }
}
__device__ __forceinline__ void row_store_lds(const Row& r, LAS float* p, int lane) {
#pragma unroll
    for (int j = 0; j < 4; ++j) ((LAS f32x4*)p)[64 * j + lane] = r.v[j];
}
__device__ __forceinline__ void skinny4(const LAS float* scr, const float* W, int ldw, int col0, int lane, float (&acc)[4]) {
    const int e = lane & 31, half = lane >> 5;
    acc[0] = acc[1] = acc[2] = acc[3] = 0.f;
    const float* w = W + (size_t)(half * 512) * ldw + col0 + e;
    const LAS float* s = scr + half * 512;
#pragma unroll 2
    for (int i = 0; i < 512; i += 4) {
        const float w0 = w[(size_t)i * ldw], w1 = w[(size_t)(i + 1) * ldw], w2 = w[(size_t)(i + 2) * ldw], w3 = w[(size_t)(i + 3) * ldw];
#pragma unroll
        for (int tk = 0; tk < 4; ++tk) { const f32x4 x = *(const LAS f32x4*)(s + tk * 1024 + i); acc[tk] += (x.x * w0 + x.y * w1) + (x.z * w2 + x.w * w3); }
    }
#pragma unroll
    for (int tk = 0; tk < 4; ++tk) acc[tk] += __shfl_xor(acc[tk], 32);
}
__device__ __forceinline__ void route_token(float logit, int t, int l, const Ctx& X) {
    const int lane = X.lane, e = lane & 31;
    float tl[4]; int te[4];
#pragma unroll
    for (int k = 0; k < 4; ++k) {
        float bv = logit; int bi = e;
#pragma unroll
        for (int o = 16; o > 0; o >>= 1) { const float ov = __shfl_xor(bv, o); const int oi = __shfl_xor(bi, o); if (ov > bv || (ov == bv && oi < bi)) { bv = ov; bi = oi; } }
        tl[k] = bv; te[k] = bi;
        if (e == bi) logit = -INFINITY;
    }
    if (lane < 4) {
        const float e1 = expf(tl[1] - tl[0]), e2 = expf(tl[2] - tl[0]), e3 = expf(tl[3] - tl[0]);
        const float inv = 1.f / (1.f + e1 + e2 + e3);
        const float wv = (lane == 0 ? 1.f : lane == 1 ? e1 : lane == 2 ? e2 : e3) * inv;
        const int ev = lane == 0 ? te[0] : lane == 1 ? te[1] : lane == 2 ? te[2] : te[3];
        unsigned* cnt = (unsigned*)(X.ws + WS_CTL) + CW_CNT + l * 32;
        const int pos = (int)atomicAdd(&cnt[ev], 1u);
        ((int*)(X.ws + WS_TOKE))[t * 4 + lane] = ev; ((float*)(X.ws + WS_TOKW))[t * 4 + lane] = wv; ((int*)(X.ws + WS_TOKP))[t * 4 + lane] = pos;
        ((int*)(X.ws + WS_SLOT))[ev * CAP + pos] = t;
    }
}

__device__ __forceinline__ float modq2f(long long q) { return (float)((double)q * 9.094947017729282e-13); }
__device__ __forceinline__ void ph_norm0(const Params& p, const Ctx& X) {
    const long long* mq = (const long long*)(X.ws + CTL_MOD);
    float* modf = (float*)(X.ws + WS_MODF);
    for (int i = X.bid * NTHREADS + X.tid; i < 2 * 4 * 6144; i += X.G * NTHREADS) modf[i] = modq2f(mq[i]);
    LAS float* tab = (LAS float*)X.lds;
    for (int i = X.tid; i < 4 * 2048; i += NTHREADS) tab[i] = modq2f(mq[(size_t)(i >> 11) * 6144 + (i & 2047)]);
    __syncthreads();
    for (int t = X.gw; t < T; t += X.ngw) {
        Row r, o; row_load(r, p.in[0] + (size_t)t * D, X.lane);
        const LAS float* m = tab + (t / S) * 2048;
        row_norm_mod(r, o, p.in[4], (const LAS f32x4*)(m + 1024), (const LAS f32x4*)m, X.lane);
        row_store_bf16(o, (bf16_t*)(X.ws + WS_U) + (size_t)t * D, X.lane);
    }
}
__device__ __forceinline__ void ph_router(const Params& p, const Ctx& X, int l, const float* h) {
    const float* mod = (const float*)(X.ws + WS_MODF) + (size_t)l * 4 * 6144;
    LAS float* scr = (LAS float*)(X.lds + X.wave * 16384);
    for (int g4 = X.gw; g4 < T / 4; g4 += X.ngw) {
#pragma unroll
        for (int tk = 0; tk < 4; ++tk) { const int t = g4 * 4 + tk;
            Row r, o; row_load(r, h + (size_t)t * D, X.lane);
            const float* m = mod + (size_t)(t / S) * 6144;
            row_norm_mod(r, o, p.in[5] + l * D, (const f32x4*)(m + 4096), (const f32x4*)(m + 3072), X.lane);
            row_store_bf16(o, (bf16_t*)(X.ws + WS_U) + (size_t)t * D, X.lane);
            row_store_lds(o, scr + tk * 1024, X.lane); }
        LDS_WAIT();
        float acc[4]; skinny4(scr, p.in[24] + (size_t)l * D * NE, NE, 0, X.lane, acc);
        const float bias = p.in[25][l * NE + (X.lane & 31)];
#pragma unroll
        for (int tk = 0; tk < 4; ++tk) route_token(acc[tk] + bias, g4 * 4 + tk, l, X);
        LDS_WAIT();
    }
}
__device__ __forceinline__ void moe_table(const Ctx& X, int l) {
    LAS int* tb = (LAS int*)(X.lds + TAB_OFF);
    if (X.tid == 0) {
        const unsigned* cnt = (const unsigned*)(X.ws + WS_CTL) + CW_CNT + l * 32;
        int base = 0;
        for (int e = 0; e < NE; ++e) { const int c = (int)__hip_atomic_load(cnt + e, __ATOMIC_RELAXED, __HIP_MEMORY_SCOPE_AGENT); tb[e] = base; tb[40 + e] = c; base += (c + 255) >> 8; }
        tb[NE] = base;
    }
    __syncthreads();
}
template <int MODE>
__device__ __forceinline__ void ph_combine(const Params& p, const Ctx& X, int l, const float* h, float* hn) {
    moe_table(X, l);
    const LAS int* tb = (const LAS int*)(X.lds + TAB_OFF);
    const float* mod = (const float*)(X.ws + WS_MODF) + (size_t)l * 4 * 6144;
    const float* mod1 = (const float*)(X.ws + WS_MODF) + (size_t)4 * 6144;
    const bf16_t* y = (const bf16_t*)(X.ws + WS_Y);
    LAS float* scr = (LAS float*)(X.lds + X.wave * 16384);
    for (int g4 = X.gw; g4 < T / 4; g4 += X.ngw) {
#pragma unroll
        for (int tk = 0; tk < 4; ++tk) { const int t = g4 * 4 + tk;
            Row r; row_load(r, h + (size_t)t * D, X.lane);
            const float* g2 = mod + (size_t)(t / S) * 6144 + 5120;
            Row s;
#pragma unroll
            for (int j = 0; j < 4; ++j) s.v[j] = (f32x4){0.f, 0.f, 0.f, 0.f};
#pragma unroll
            for (int k = 0; k < 4; ++k) {
                const int e = ((const int*)(X.ws + WS_TOKE))[t * 4 + k], pos = ((const int*)(X.ws + WS_TOKP))[t * 4 + k]; const float w = ((const float*)(X.ws + WS_TOKW))[t * 4 + k];
                const bf16_t* yr = y + (size_t)(tb[e] * 256 + pos) * D;
#pragma unroll
                for (int j = 0; j < 4; ++j) { const u32x2 q = ((const u32x2*)yr)[64 * j + X.lane];
                    s.v[j].x += w * bflo(q.x); s.v[j].y += w * bfhi(q.x); s.v[j].z += w * bflo(q.y); s.v[j].w += w * bfhi(q.y); }
            }
#pragma unroll
            for (int j = 0; j < 4; ++j) r.v[j] = r.v[j] + ((const f32x4*)g2)[64 * j + X.lane] * s.v[j];
            row_store(r, hn + (size_t)t * D, X.lane);
            if (MODE == 0) {
                Row o; const float* m = mod1 + (size_t)(t / S) * 6144;
                row_norm_mod(r, o, p.in[4] + D, (const f32x4*)(m + 1024), (const f32x4*)m, X.lane);
                row_store_bf16(o, (bf16_t*)(X.ws + WS_U) + (size_t)t * D, X.lane);
                row_store_lds(o, scr + tk * 1024, X.lane);
            }
        }
        if (MODE == 0) {
            LDS_WAIT();
            float acc[4]; skinny4(scr, p.in[16], SSM_IN, 5120, X.lane, acc);
            if (X.lane < 32) {
#pragma unroll
                for (int tk = 0; tk < 4; ++tk) ((float*)(X.ws + WS_DT))[(size_t)(g4 * 4 + tk) * 32 + X.lane] = acc[tk];
            }
            LDS_WAIT();
        }
    }
}

__device__ __forceinline__ void ld64bf(const bf16_t* p, float (&q)[64]) {
#pragma unroll
    for (int i = 0; i < 8; ++i) { const u32x4 w = ((const u32x4*)p)[i];
        q[8 * i] = bflo(w.x); q[8 * i + 1] = bfhi(w.x); q[8 * i + 2] = bflo(w.y); q[8 * i + 3] = bfhi(w.y); q[8 * i + 4] = bflo(w.z); q[8 * i + 5] = bfhi(w.z); q[8 * i + 6] = bflo(w.w); q[8 * i + 7] = bfhi(w.w); }
}
__device__ __forceinline__ float dot64bf(const bf16_t* p, const float (&q)[64]) {
    float d = 0.f;
#pragma unroll
    for (int i = 0; i < 8; ++i) { const u32x4 w = ((const u32x4*)p)[i];
        d += q[8 * i] * bflo(w.x) + q[8 * i + 1] * bfhi(w.x) + q[8 * i + 2] * bflo(w.y) + q[8 * i + 3] * bfhi(w.y) + q[8 * i + 4] * bflo(w.z) + q[8 * i + 5] * bfhi(w.z) + q[8 * i + 6] * bflo(w.w) + q[8 * i + 7] * bfhi(w.w); }
    return d;
}
__device__ __forceinline__ float dot64f(const float* p, const float (&q)[64]) {
    float d = 0.f;
#pragma unroll
    for (int i = 0; i < 16; ++i) { const f32x4 w = ((const f32x4*)p)[i]; d += (q[4 * i] * w.x + q[4 * i + 1] * w.y) + (q[4 * i + 2] * w.z + q[4 * i + 3] * w.w); }
    return d;
}
__device__ __forceinline__ void sb_unit(const Ctx& X, int qt, int bh) {
    const int b = bh >> 3, hh = bh & 7, t = qt * 64 + X.lane;
    const bf16_t* base = (const bf16_t*)(X.ws + WS_BIG) + (size_t)b * S * PROJ_LD;
    float q[64], acc[64];
    ld64bf(base + (size_t)t * PROJ_LD + OFF_SBQ + hh * 64, q);
#pragma unroll
    for (int d = 0; d < 64; ++d) acc[d] = 0.f;
    float run = 0.f;
    for (int j = qt * 64 + 62; j >= 0; --j) {
        const bf16_t* kr = base + (size_t)j * PROJ_LD + OFF_SBK + hh * 64;
        const float logit = dot64bf(kr, q) * 0.125f;
        if (j < t) {
            const float w = expf(logsig(logit) + run);
            run += logsig(-logit);
            const bf16_t* vr = base + (size_t)j * PROJ_LD + OFF_SBV + hh * 64;
#pragma unroll
            for (int i = 0; i < 8; ++i) { const u32x4 v = ((const u32x4*)vr)[i];
                acc[8 * i] += w * bflo(v.x); acc[8 * i + 1] += w * bfhi(v.x); acc[8 * i + 2] += w * bflo(v.y); acc[8 * i + 3] += w * bfhi(v.y);
                acc[8 * i + 4] += w * bflo(v.z); acc[8 * i + 5] += w * bfhi(v.z); acc[8 * i + 6] += w * bflo(v.w); acc[8 * i + 7] += w * bfhi(v.w); }
        }
    }
    bf16_t* op = (bf16_t*)(X.ws + WS_O) + (size_t)(b * S + t) * D + hh * 64;
#pragma unroll
    for (int i = 0; i < 8; ++i) { u32x4 w; w.x = pk2(acc[8 * i], acc[8 * i + 1]); w.y = pk2(acc[8 * i + 2], acc[8 * i + 3]); w.z = pk2(acc[8 * i + 4], acc[8 * i + 5]); w.w = pk2(acc[8 * i + 6], acc[8 * i + 7]);
        ((u32x4*)op)[i] = w; }
}
__device__ __forceinline__ void ph_attn_a(const Params& p, const Ctx& X) {
    const bf16_t* proj = (const bf16_t*)(X.ws + WS_BIG);
    {
        LAS float* flat = (LAS float*)X.lds; LAS float* part = flat + 2048; LAS float* hid = part + 512;
        for (int it = X.bid; it < NCMP * 8 * 2; it += X.G) {
            const int n = it % NCMP, bg = (it / NCMP) & 7, kv = it / (NCMP * 8), b = bg >> 1, g = bg & 1;
            const int col = kv ? OFF_VC : OFF_KC; const float* pe = kv ? p.in[11] : p.in[10]; const float* w1 = kv ? p.in[14] : p.in[12]; const float* w2 = kv ? p.in[15] : p.in[13];
            for (int i = X.tid; i < 2048; i += NTHREADS) { const int l = i >> 6, d = i & 63; flat[i] = bf2f(proj[(size_t)(b * S + n * 16 + l) * PROJ_LD + col + g * 64 + d]) + pe[l * 64 + d]; }
            __syncthreads();
            { const int j = X.tid & 127, part_i = X.tid >> 7; float a = 0.f;
              for (int i = part_i * 512; i < part_i * 512 + 512; ++i) a += flat[i] * w1[(size_t)i * 128 + j];
              part[part_i * 128 + j] = a; }
            __syncthreads();
            if (X.tid < 128) hid[X.tid] = siluf((part[X.tid] + part[128 + X.tid]) + (part[256 + X.tid] + part[384 + X.tid]));
            __syncthreads();
            if (X.tid < 64) {
                float o = 0.f;
                for (int j = 0; j < 128; ++j) o += hid[j] * w2[j * 64 + X.tid];
                float* dst = (float*)(X.ws + (kv ? WS_VCMP : WS_KCMP)) + (((size_t)b * NCMP + n) * 2 + g) * 64;
                if (kv == 0) { const float r = rsqrtf(wave_sum(o * o) * (1.f / 64.f) + EPS); o = o * r * p.in[9][X.tid]; }
                dst[X.tid] = o;
            }
            __syncthreads();
        }
    }
    for (int it = X.gw; it < T * 12; it += X.ngw) {
        const int t = it / 12, idx = it % 12, lane = X.lane;
        int col; const float* gain; float* dst; float sc = 1.f;
        if (idx < 8) { col = OFF_NQ + idx * 64; gain = p.in[8]; dst = (float*)(X.ws + WS_QN) + ((size_t)t * 8 + idx) * 64; sc = 0.125f; }
        else if (idx < 10) { col = OFF_KS + (idx - 8) * 64; gain = p.in[9] + 64; dst = (float*)(X.ws + WS_KN) + ((size_t)t * 4 + (idx - 8)) * 64; }
        else { col = OFF_KW + (idx - 10) * 64; gain = p.in[9] + 128; dst = (float*)(X.ws + WS_KN) + ((size_t)t * 4 + 2 + (idx - 10)) * 64; }
        const float v = bf2f(proj[(size_t)t * PROJ_LD + col + lane]);
        const float r = rsqrtf(wave_sum(v * v) * (1.f / 64.f) + EPS);
        dst[lane] = v * r * gain[lane] * sc;
    }
    for (int it = X.gw; it < 64 * 32; it += X.ngw) sb_unit(X, 63 - (it >> 5), it & 31);
}
__device__ __forceinline__ void ph_nsa(const Params& p, const Ctx& X) {
    const bf16_t* proj = (const bf16_t*)(X.ws + WS_BIG);
    const float* qn = (const float*)(X.ws + WS_QN); const float* kn = (const float*)(X.ws + WS_KN);
    const float* kcmp = (const float*)(X.ws + WS_KCMP); const float* vcmp = (const float*)(X.ws + WS_VCMP);
    const int hb = X.tid >> 8, r = (X.tid >> 6) & 3, lane = X.lane;
    LAS float* s = (LAS float*)X.lds + (hb * 4 + r) * 1024;
    LAS float* pslc = (LAS float*)X.lds + 8192 + hb * 256;
    for (int it = X.bid; it < S * 8 / 2; it += X.G) {
        const int vb = it * 2 + hb, t = vb & (S - 1), bg = vb >> 12, b = bg >> 1, g = bg & 1, hh = g * 4 + r;
        const float slope = exp2f(-(float)(hh + 1));
        float q[64];
        {
            const f32x4* qp = (const f32x4*)(qn + ((size_t)(b * S + t) * 8 + hh) * 64);
#pragma unroll
            for (int d = 0; d < 16; ++d) { const f32x4 v = qp[d]; q[4 * d] = v.x; q[4 * d + 1] = v.y; q[4 * d + 2] = v.z; q[4 * d + 3] = v.w; }
        }
        const int ncv = t >= 31 ? (t - 31) / 16 + 1 : 0;
        float m = -INFINITY;
        for (int n = lane; n < ncv; n += 64) {
            const float v = dot64f(kcmp + (((size_t)b * NCMP + n) * 2 + g) * 64, q) - slope * (float)(t - (n * 16 + 31));
            s[n] = v; m = fmaxf(m, v);
        }
        m = wave_max(m);
        float sum = 0.f;
        for (int n = lane; n < ncv; n += 64) { const float pp = expf(s[n] - m); s[n] = pp; sum += pp; }
        sum = wave_sum(sum);
        const float inv = 1.f / fmaxf(sum, 1e-30f);
        for (int n = lane; n < ncv; n += 64) s[n] *= inv;
        LDS_WAIT();
        float oc = 0.f;
        for (int n = 0; n < ncv; ++n) oc += s[n] * vcmp[(((size_t)b * NCMP + n) * 2 + g) * 64 + lane];
        {
            float ps = 0.f;
            const int lo = max(0, 4 * lane - 1), hi = min(4 * lane + 3, ncv - 1);
            for (int n = lo; n <= hi; ++n) ps += s[n];
            pslc[r * 64 + lane] = ps;
        }
        __syncthreads();
        unsigned long long selmask;
        {
            const float ps = (pslc[lane] + pslc[64 + lane]) + (pslc[128 + lane] + pslc[192 + lane]);
            const int cur = t >> 6;
            const bool valid = lane * 64 <= t, forced = (lane == 0) || (lane == cur) || (lane == cur - 1);
            const float score = valid ? (forced ? 1e6f : ps) : -1e6f;
            int rank = 0;
            for (int i = 0; i < 64; ++i) { const float si = __shfl(score, i); rank += (si > score || (si == score && i < lane)) ? 1 : 0; }
            selmask = __ballot(rank < 16);
        }
        __syncthreads();
        float os = 0.f;
        {
            int ns = 0; float mm = -INFINITY;
            for (unsigned long long mk = selmask; mk; mk &= mk - 1) {
                const int jb = __builtin_ctzll(mk), pos = jb * 64 + lane;
                float v = -INFINITY;
                if (pos <= t) v = dot64f(kn + ((size_t)(b * S + pos) * 4 + g) * 64, q) - slope * (float)(t - pos);
                s[ns * 64 + lane] = v; mm = fmaxf(mm, v); ++ns;
            }
            mm = wave_max(mm);
            float sm = 0.f;
            for (int i = 0; i < ns; ++i) { const float pp = expf(s[i * 64 + lane] - mm); s[i * 64 + lane] = pp; sm += pp; }
            sm = wave_sum(sm);
            const float iv = 1.f / fmaxf(sm, 1e-30f);
            LDS_WAIT();
            int i = 0;
            for (unsigned long long mk = selmask; mk; mk &= mk - 1, ++i) {
                const int jb = __builtin_ctzll(mk);
                if (jb * 64 > t) continue;
                const int cntk = min(64, t - jb * 64 + 1);
                for (int k = 0; k < cntk; ++k) os += s[i * 64 + k] * bf2f(proj[(size_t)(b * S + jb * 64 + k) * PROJ_LD + OFF_VS + g * 64 + lane]);
            }
            os *= iv;
        }
        float ow = 0.f;
        {
            const int s0 = max(0, t - 511), nk = t - s0 + 1;
            float mm = -INFINITY;
            for (int k = lane; k < nk; k += 64) {
                const int pos = s0 + k;
                const float v = dot64f(kn + ((size_t)(b * S + pos) * 4 + 2 + g) * 64, q) - slope * (float)(t - pos);
                s[k] = v; mm = fmaxf(mm, v);
            }
            mm = wave_max(mm);
            float sm = 0.f;
            for (int k = lane; k < nk; k += 64) { const float pp = expf(s[k] - mm); s[k] = pp; sm += pp; }
            sm = wave_sum(sm);
            const float iv = 1.f / fmaxf(sm, 1e-30f);
            LDS_WAIT();
            for (int k = 0; k < nk; ++k) ow += s[k] * bf2f(proj[(size_t)(b * S + s0 + k) * PROJ_LD + OFF_VW + g * 64 + lane]);
            ow *= iv;
        }
        const bf16_t* gp = proj + (size_t)(b * S + t) * PROJ_LD + OFF_GATE + hh * 3;
        const float g0 = 1.f / (1.f + expf(-bf2f(gp[0]))), g1 = 1.f / (1.f + expf(-bf2f(gp[1]))), g2 = 1.f / (1.f + expf(-bf2f(gp[2])));
        ((bf16_t*)(X.ws + WS_O))[(size_t)(b * S + t) * D + 512 + hh * 64 + lane] = (bf16_t)f2bf(g0 * oc + g1 * os + g2 * ow);
        LDS_WAIT();
    }
}

__device__ __forceinline__ void ph_conv(const Params& p, const Ctx& X) {
    const bf16_t* zx = (const bf16_t*)(X.ws + WS_BIG); float* xc = (float*)(X.ws + WS_XC);
    const float* cw = p.in[17]; const float* cb = p.in[18];
    for (size_t i = (size_t)X.bid * NTHREADS + X.tid; i < (size_t)T * (CONV_DIM / 4); i += (size_t)X.G * NTHREADS) {
        const int t = (int)(i / (CONV_DIM / 4)), ch = (int)(i % (CONV_DIM / 4)) * 4, tt = t & (S - 1);
        f32x4 a = *(const f32x4*)(cb + ch);
#pragma unroll
        for (int w = 0; w < 4; ++w) {
            if (tt - 3 + w < 0) continue;
            const u32x2 q = *(const u32x2*)(zx + (size_t)(t - 3 + w) * ZX_LD + 2048 + ch); const f32x4 k = *(const f32x4*)(cw + w * CONV_DIM + ch);
            a.x += bflo(q.x) * k.x; a.y += bfhi(q.x) * k.y; a.z += bflo(q.y) * k.z; a.w += bfhi(q.y) * k.w;
        }
        *(f32x4*)(xc + (size_t)t * CONV_DIM + ch) = (f32x4){siluf(a.x), siluf(a.y), siluf(a.z), siluf(a.w)};
    }
}
__device__ __forceinline__ void ph_ssd(const Params& p, const Ctx& X) {
    const float* xc = (const float*)(X.ws + WS_XC); const float* dtr = (const float*)(X.ws + WS_DT); float* ys = (float*)(X.ws + WS_YS);
    const int vb = X.bid * 2 + (X.tid >> 8);
    if (vb >= NB * 32) return;
    const int b = vb >> 5, hh = vb & 31, g = hh >> 3, tl = X.tid & 255, pp = tl >> 2, c4 = tl & 3;
    const float a = -expf(p.in[20][hh]), dtb = p.in[19][hh], dsk = p.in[21][hh];
    float st[32];
#pragma unroll
    for (int i = 0; i < 32; ++i) st[i] = 0.f;
    for (int tt = 0; tt < S; ++tt) {
        const size_t t = (size_t)b * S + tt;
        const float raw = dtr[t * 32 + hh] + dtb;
        const float dt = raw > 20.f ? raw : log1pf(expf(raw));
        const float dA = expf(dt * a);
        const float xv = xc[t * CONV_DIM + hh * 64 + pp];
        const float xd = xv * dt;
        const f32x4* Bp = (const f32x4*)(xc + t * CONV_DIM + 2048 + g * 128 + c4 * 32);
        const f32x4* Cp = (const f32x4*)(xc + t * CONV_DIM + 2560 + g * 128 + c4 * 32);
        float y = 0.f;
#pragma unroll
        for (int i = 0; i < 8; ++i) {
            const f32x4 bv = Bp[i], cv = Cp[i];
            st[4 * i + 0] = st[4 * i + 0] * dA + xd * bv.x; y += cv.x * st[4 * i + 0];
            st[4 * i + 1] = st[4 * i + 1] * dA + xd * bv.y; y += cv.y * st[4 * i + 1];
            st[4 * i + 2] = st[4 * i + 2] * dA + xd * bv.z; y += cv.z * st[4 * i + 2];
            st[4 * i + 3] = st[4 * i + 3] * dA + xd * bv.w; y += cv.w * st[4 * i + 3];
        }
        y += __shfl_xor(y, 1); y += __shfl_xor(y, 2);
        if (c4 == 0) ys[t * SSM_INNER + hh * 64 + pp] = y + xv * dsk;
    }
}
__device__ __forceinline__ void ph_gate_norm(const Params& p, const Ctx& X) {
    const bf16_t* zx = (const bf16_t*)(X.ws + WS_BIG); const float* ys = (const float*)(X.ws + WS_YS); bf16_t* yn = (bf16_t*)(X.ws + WS_O);
    for (int it = X.gw; it < T * 4; it += X.ngw) {
        const int t = it >> 2, ch = (it & 3) * 512 + X.lane * 8;
        const f32x4 y0 = *(const f32x4*)(ys + (size_t)t * SSM_INNER + ch), y1 = *(const f32x4*)(ys + (size_t)t * SSM_INNER + ch + 4);
        const u32x4 z = *(const u32x4*)(zx + (size_t)t * ZX_LD + ch);
        float v[8] = {y0.x * siluf(bflo(z.x)), y0.y * siluf(bfhi(z.x)), y0.z * siluf(bflo(z.y)), y0.w * siluf(bfhi(z.y)),
                      y1.x * siluf(bflo(z.z)), y1.y * siluf(bfhi(z.z)), y1.z * siluf(bflo(z.w)), y1.w * siluf(bfhi(z.w))};
        float ss = 0.f;
#pragma unroll
        for (int i = 0; i < 8; ++i) ss += v[i] * v[i];
        const float r = rsqrtf(wave_sum(ss) * (1.f / 512.f) + EPS);
        const f32x4 g0 = *(const f32x4*)(p.in[22] + ch), g1 = *(const f32x4*)(p.in[22] + ch + 4);
        u32x4 w; w.x = pk2(v[0] * r * g0.x, v[1] * r * g0.y); w.y = pk2(v[2] * r * g0.z, v[3] * r * g0.w); w.z = pk2(v[4] * r * g1.x, v[5] * r * g1.y); w.w = pk2(v[6] * r * g1.z, v[7] * r * g1.w);
        *(u32x4*)(yn + (size_t)t * SSM_INNER + ch) = w;
    }
}

__device__ __forceinline__ void ph_moe_gu(const Params& p, const Ctx& X, int l) {
    moe_table(X, l);
    pg8::MoeOrder So{(const LAS int*)(X.lds + TAB_OFF), (const LAS int*)(X.lds + TAB_OFF) + 40, (const int*)(X.ws + WS_SLOT), 3, X.G, X.bid, true};
    pg8::Gemm g{(const bf16_t*)(X.ws + WS_U), (const bf16_t*)(X.ws + WS_WGU) + (size_t)l * NE * 2048 * 1024, 1024};
    pg8::EpiGu E{(bf16_t*)(X.ws + WS_ACT), p.in[27] + (size_t)l * NE * 2048};
    pg8::gemm_phase<pg8::EpiGu, pg8::MoeOrder>(X.lds, g, So, E);
}
__device__ __forceinline__ void ph_moe_down(const Params& p, const Ctx& X, int l) {
    moe_table(X, l);
    pg8::MoeOrder So{(const LAS int*)(X.lds + TAB_OFF), (const LAS int*)(X.lds + TAB_OFF) + 40, (const int*)(X.ws + WS_SLOT), 2, X.G, X.bid, false};
    pg8::Gemm g{(const bf16_t*)(X.ws + WS_ACT), (const bf16_t*)(X.ws + WS_WDN) + (size_t)l * NE * 1024 * 1024, 1024};
    pg8::EpiDown E{(bf16_t*)(X.ws + WS_Y), p.in[29] + (size_t)l * NE * 1024};
    pg8::gemm_phase<pg8::EpiDown, pg8::MoeOrder>(X.lds, g, So, E);
}

__global__ void __launch_bounds__(NTHREADS, 2) fwd_kernel(Params p) {
    extern __shared__ __attribute__((aligned(16))) unsigned char lds_raw[];
    Ctx X;
    X.lds = (LAS unsigned char*)lds_raw; X.ws = p.ws;
    X.tid = threadIdx.x; X.lane = X.tid & 63; X.wave = __builtin_amdgcn_readfirstlane(X.tid >> 6);
    X.G = gridDim.x; X.bid = blockIdx.x; X.gw = X.bid * NWAVES + X.wave; X.ngw = X.G * NWAVES;
    if (X.tid < 4) ((LAS unsigned*)(X.lds + XB_OFF))[X.tid] = 0u;
    __syncthreads();
    XcdBarrier bar = xcd_barrier_post((unsigned*)(p.ws + WS_CTL) + CW_BAR, (volatile LAS unsigned*)(X.lds + XB_OFF));
    float* mod = (float*)(p.ws + WS_MODF);
    float* h1 = (float*)(p.ws + WS_H1); float* h2 = (float*)(p.ws + WS_H2);

    ph_prologue(p, X);                                                   xcd_barrier(bar);
    ph_norm0(p, X);                                                      xcd_barrier(bar);
    {
        pg8::DenseOrder So; So.init(T, PROJ_LD, X.G, X.bid);
        pg8::Gemm g{(const bf16_t*)(p.ws + WS_U), (const bf16_t*)(p.ws + WS_WIN), 1024};
        pg8::EpiBf16 E{(bf16_t*)(p.ws + WS_BIG), PROJ_LD};
        pg8::gemm_phase<pg8::EpiBf16, pg8::DenseOrder>(X.lds, g, So, E);
    }
    xcd_barrier(bar);
    ph_attn_a(p, X);                                                     xcd_barrier(bar);
    ph_nsa(p, X);                                                        xcd_barrier(bar);
    {
        pg8::DenseOrder So; So.init(T, D, X.G, X.bid);
        pg8::Gemm g{(const bf16_t*)(p.ws + WS_O), (const bf16_t*)(p.ws + WS_WOUT), 1024};
        pg8::EpiResid E{p.in[0], h1, mod + 2048};
        pg8::gemm_phase<pg8::EpiResid, pg8::DenseOrder>(X.lds, g, So, E);
    }
    xcd_barrier(bar);
    ph_router(p, X, 0, h1);                                              xcd_barrier(bar);
    ph_moe_gu(p, X, 0);                                                  xcd_barrier(bar);
    ph_moe_down(p, X, 0);                                                xcd_barrier(bar);
    ph_combine<0>(p, X, 0, h1, h2);                                      xcd_barrier(bar);
    {
        pg8::DenseOrder So; So.init(T, ZX_LD, X.G, X.bid);
        pg8::Gemm g{(const bf16_t*)(p.ws + WS_U), (const bf16_t*)(p.ws + WS_WSIN), 1024};
        pg8::EpiBf16 E{(bf16_t*)(p.ws + WS_BIG), ZX_LD};
        pg8::gemm_phase<pg8::EpiBf16, pg8::DenseOrder>(X.lds, g, So, E);
    }
    xcd_barrier(bar);
    ph_conv(p, X);                                                       xcd_barrier(bar);
    ph_ssd(p, X);                                                        xcd_barrier(bar);
    ph_gate_norm(p, X);                                                  xcd_barrier(bar);
    {
        pg8::DenseOrder So; So.init(T, D, X.G, X.bid);
        pg8::Gemm g{(const bf16_t*)(p.ws + WS_O), (const bf16_t*)(p.ws + WS_WSOUT), 2048};
        pg8::EpiResid E{h2, h1, mod + 4 * 6144 + 2048};
        pg8::gemm_phase<pg8::EpiResid, pg8::DenseOrder>(X.lds, g, So, E);
    }
    xcd_barrier(bar);
    ph_router(p, X, 1, h1);                                              xcd_barrier(bar);
    ph_moe_gu(p, X, 1);                                                  xcd_barrier(bar);
    ph_moe_down(p, X, 1);                                                xcd_barrier(bar);
    ph_combine<1>(p, X, 1, h1, p.out);
}
}

extern "C" void kernel_launch(void* const* d_in, const int* in_sizes, int n_in, void* d_out, int out_size, void* d_ws, size_t ws_size, hipStream_t stream) {
    static int grid = 0;
    if (grid == 0) {
        if (n_in != 30 || out_size != T * D || ws_size < WS_END) { fprintf(stderr, "kernel_launch: unexpected shapes / workspace (%d inputs, out %d, ws %zu < %zu)\n", n_in, out_size, ws_size, (size_t)WS_END); grid = -1; return; }
        int dev = 0, cus = 0, per_cu = 0;
        if (hipGetDevice(&dev) != hipSuccess || hipDeviceGetAttribute(&cus, hipDeviceAttributeMultiprocessorCount, dev) != hipSuccess) { grid = -1; return; }
        if (hipFuncSetAttribute((const void*)fwd_kernel, hipFuncAttributeMaxDynamicSharedMemorySize, LDS_BYTES) != hipSuccess) { fprintf(stderr, "kernel_launch: hipFuncSetAttribute failed\n"); grid = -1; return; }
        if (hipOccupancyMaxActiveBlocksPerMultiprocessor(&per_cu, (const void*)fwd_kernel, NTHREADS, LDS_BYTES) != hipSuccess || per_cu < 1) { fprintf(stderr, "kernel_launch: occupancy query reports %d\n", per_cu); }
        (void)hipGetLastError();
        grid = cus;
    }
    if (grid < 0) return;
    if (hipMemsetAsync((char*)d_ws + WS_CTL, 0, CTL_BYTES, stream) != hipSuccess) return;
    Params p{};
    for (int i = 0; i < 30; ++i) p.in[i] = (const float*)d_in[i];
    p.out = (float*)d_out; p.ws = (unsigned char*)d_ws;
    hipLaunchKernelGGL(fwd_kernel, dim3(grid), dim3(NTHREADS), LDS_BYTES, stream, p);
}
```

```cpp
#include <hip/hip_runtime.h>
#include <cstdio>
#include <cstdint>

#define LAS __attribute__((address_space(3)))
#define GAS __attribute__((address_space(1)))
typedef unsigned short bf16_t;
typedef short bf16x8 __attribute__((ext_vector_type(8)));
typedef float f32x4 __attribute__((ext_vector_type(4)));
typedef unsigned u32x4 __attribute__((ext_vector_type(4)));
typedef unsigned u32x2 __attribute__((ext_vector_type(2)));

namespace {
constexpr int D = 1024, NB = 4, S = 4096, T = NB * S;
constexpr int ATTN_IN = 2840, PROJ_LD = 3072;
constexpr int OFF_SBQ = 0, OFF_SBK = 512, OFF_SBV = 1024, OFF_NQ = 1536, OFF_KC = 2048, OFF_VC = 2176, OFF_KS = 2304, OFF_VS = 2432,
              OFF_KW = 2560, OFF_VW = 2688, OFF_GATE = 2816;
constexpr int NCMP = 255;
constexpr int SSM_IN = 5152, SSM_INNER = 2048, CONV_DIM = 3072, ZX_LD = 5120;
constexpr int NE = 32, CAP = 16384, MAXTILES = 288;
constexpr float EPS = 1e-6f;
constexpr int NWAVES = 8, NTHREADS = 512;

constexpr size_t al4k(size_t x) { return (x + 4095) & ~(size_t)4095; }
constexpr size_t WS_CTL = 0, CTL_BYTES = 1u << 20;
constexpr int CW_CNT = 256;
constexpr int CW_BAR = 4096;
constexpr size_t CTL_MOD = 65536;
constexpr size_t WS_WIN = CTL_BYTES;
constexpr size_t WS_WOUT = WS_WIN + (size_t)3072 * 1024 * 2;
constexpr size_t WS_WSIN = WS_WOUT + (size_t)1024 * 1024 * 2;
constexpr size_t WS_WSOUT = WS_WSIN + (size_t)5120 * 1024 * 2;
constexpr size_t WS_WGU = WS_WSOUT + (size_t)1024 * 2048 * 2;
constexpr size_t WS_WDN = WS_WGU + (size_t)2 * 32 * 2048 * 1024 * 2;
constexpr size_t WS_U = WS_WDN + (size_t)2 * 32 * 1024 * 1024 * 2;
constexpr size_t WS_BIG = WS_U + (size_t)T * 1024 * 2;
constexpr size_t WS_O = WS_BIG + (size_t)T * 5120 * 2;
constexpr size_t WS_H1 = WS_O + (size_t)T * 2048 * 2;
constexpr size_t WS_H2 = WS_H1 + (size_t)T * 1024 * 4;
constexpr size_t WS_QN = WS_H2 + (size_t)T * 1024 * 4;
constexpr size_t WS_KN = WS_QN + (size_t)T * 512 * 4;
constexpr size_t WS_KCMP = WS_KN + (size_t)T * 256 * 4;
constexpr size_t WS_VCMP = WS_KCMP + al4k((size_t)NB * NCMP * 2 * 64 * 4);
constexpr size_t WS_ACT = WS_VCMP + al4k((size_t)NB * NCMP * 2 * 64 * 4);
constexpr size_t WS_Y = WS_ACT + (size_t)MAXTILES * 256 * 1024 * 2;
constexpr size_t WS_TOKE = WS_Y + (size_t)MAXTILES * 256 * 1024 * 2;
constexpr size_t WS_TOKW = WS_TOKE + (size_t)T * 16;
constexpr size_t WS_TOKP = WS_TOKW + (size_t)T * 16;
constexpr size_t WS_SLOT = WS_TOKP + (size_t)T * 16;
constexpr size_t WS_XC = WS_SLOT + (size_t)NE * CAP * 4;
constexpr size_t WS_YS = WS_XC + (size_t)T * 3072 * 4;
constexpr size_t WS_DT = WS_YS + (size_t)T * 2048 * 4;
constexpr size_t WS_MODF = WS_DT + (size_t)T * 32 * 4;
constexpr size_t WS_WV = WS_MODF + (size_t)2 * 4 * 6144 * 4;
constexpr size_t WS_VT = WS_WV + (size_t)768 * 1024 * 2;
constexpr size_t WS_END = WS_VT + (size_t)768 * T * 2;

constexpr int RING_BYTES = 131072;
constexpr int TAB_OFF = RING_BYTES;
constexpr int XB_OFF = RING_BYTES + 1024;
constexpr int LDS_BYTES = 147456;

struct Params { const float* in[30]; float* out; unsigned char* ws; };

__device__ __forceinline__ float siluf(float v) { return v / (1.f + expf(-v)); }
__device__ __forceinline__ float logsig(float x) { return fminf(x, 0.f) - log1pf(expf(-fabsf(x))); }
__device__ __forceinline__ float wave_sum(float v) {
#pragma unroll
    for (int o = 32; o > 0; o >>= 1) v += __shfl_xor(v, o);
    return v;
}
__device__ __forceinline__ float wave_max(float v) {
#pragma unroll
    for (int o = 32; o > 0; o >>= 1) v = fmaxf(v, __shfl_xor(v, o));
    return v;
}
__device__ __forceinline__ unsigned f2bf(float f) { unsigned u = __builtin_bit_cast(unsigned, f); return (u + 0x7fffu + ((u >> 16) & 1u)) >> 16; }
__device__ __forceinline__ unsigned pk2(float lo, float hi) { return f2bf(lo) | (f2bf(hi) << 16); }
__device__ __forceinline__ float bf2f(bf16_t v) { return __uint_as_float((unsigned)v << 16); }
__device__ __forceinline__ float bflo(unsigned w) { return __uint_as_float(w << 16); }
__device__ __forceinline__ float bfhi(unsigned w) { return __uint_as_float(w & 0xffff0000u); }
#define LDS_WAIT() asm volatile("s_waitcnt lgkmcnt(0)" ::: "memory")

#define XB_TMO      128
#define XB_XCNT(j)  (256  + 64 * (j))
#define XB_XSUB(j)  (1280 + 64 * (j))
#define XB_XGEN(j)  (2304 + 64 * (j))
#define XB_TOP      3328
#define XB_TOPGEN   3392
#define XCD_BAR_WORDS 3456
#define XB_SPIN_CAP (1u << 18)
__device__ __forceinline__ unsigned xb_ld(unsigned* p)              { return __hip_atomic_load(p, __ATOMIC_RELAXED, __HIP_MEMORY_SCOPE_AGENT); }
__device__ __forceinline__ unsigned xb_add(unsigned* p, unsigned v) { return __hip_atomic_fetch_add(p, v, __ATOMIC_RELAXED, __HIP_MEMORY_SCOPE_AGENT); }
__device__ __forceinline__ unsigned xb_xcc_id() { return (unsigned)__builtin_amdgcn_s_getreg((3 << 11) | 20) & 0xFu; }
#define XB_SPIN(cond, bar) do { unsigned _sp = 0; while (cond) { __builtin_amdgcn_s_sleep(1); \
    if ((++_sp & 255u) == 0u) { if (xb_ld(&(bar)[XB_TMO])) break; if (_sp > XB_SPIN_CAP) { atomicAdd(&(bar)[XB_TMO], 1u); break; } } } } while (0)
struct XcdBarrier { unsigned* bar; unsigned x; volatile LAS unsigned* st; };
__device__ __forceinline__ XcdBarrier xcd_barrier_post(unsigned* bar, volatile LAS unsigned* st) {
    XcdBarrier b; b.bar = bar; b.x = xb_xcc_id(); b.st = st;
    if (threadIdx.x == 0) (void)xb_add(&bar[XB_XCNT(b.x)], 1u);
    return b;
}
__device__ __forceinline__ void xcd_barrier_complete(unsigned* bar, unsigned x, unsigned& nloc, unsigned& nx) {
    const unsigned G = gridDim.x * gridDim.y * gridDim.z;
    unsigned sum, cnt, mine, sp = 0u;
    for (;;) {
        sum = 0u; cnt = 0u; mine = 0u;
#pragma unroll
        for (unsigned j = 0; j < 16; ++j) { const unsigned c = xb_ld(&bar[XB_XCNT(j)]); sum += c; cnt += (c > 0u) ? 1u : 0u; mine = (j == x) ? c : mine; }
        if (sum == G) break;
        __builtin_amdgcn_s_sleep(1);
        if ((++sp & 255u) == 0u) { if (xb_ld(&bar[XB_TMO])) break; if (sp > XB_SPIN_CAP) { atomicAdd(&bar[XB_TMO], 1u); break; } }
    }
    nloc = mine > 0u ? mine : 1u; nx = cnt > 0u ? cnt : 1u;
}
__device__ __forceinline__ void xcd_barrier(const XcdBarrier& b) {
    asm volatile("s_waitcnt vmcnt(0)" ::: "memory");
    __syncthreads();
    if (threadIdx.x == 0) {
        unsigned* bar = b.bar;
        __builtin_amdgcn_s_waitcnt(0);
        unsigned nloc = b.st[0], nx = b.st[1];
        if (nloc == 0u) { xcd_barrier_complete(bar, b.x, nloc, nx); b.st[0] = nloc; b.st[1] = nx; }
        const unsigned old = xb_add(&bar[XB_XSUB(b.x)], 1u);
        const unsigned gen = old / nloc;
        if (old + 1u == (gen + 1u) * nloc) {
            __builtin_amdgcn_fence(__ATOMIC_RELEASE, "agent");
            asm volatile("s_waitcnt vmcnt(0)" ::: "memory");
            const unsigned og = xb_add(&bar[XB_TOP], 1u);
            const unsigned tg = og / nx;
            if (og + 1u == (tg + 1u) * nx) xb_add(&bar[XB_TOPGEN], 1u);
            else XB_SPIN(xb_ld(&bar[XB_TOPGEN]) == tg, bar);
            __builtin_amdgcn_fence(__ATOMIC_ACQUIRE, "agent");
            xb_add(&bar[XB_XGEN(b.x)], 1u);
            asm volatile("s_waitcnt vmcnt(0)" ::: "memory");
        } else {
            XB_SPIN(xb_ld(&bar[XB_XGEN(b.x)]) == gen, bar);
            __builtin_amdgcn_fence(__ATOMIC_ACQUIRE, "agent");
            asm volatile("s_waitcnt vmcnt(0)" ::: "memory");
        }
    }
    __syncthreads();
}

namespace pg8 {
constexpr int BM = 256, BK = 64, HALF = 128, HTB = HALF * BK * 2, STAGE_BYTES = 8 * HTB;
__device__ __forceinline__ int lds_byte(int r, int c) { const int st = (r >> 4) * 2 + (c >> 5), rr = r & 15, cc = c & 31, ob = rr * 64 + cc * 2; return st * 1024 + (ob ^ (((ob >> 9) & 1) << 5)); }
__device__ __forceinline__ void stage_rc(int b, int& R, int& C) { const int st = b / 1024, sb = b % 1024, swz = sb ^ (((sb >> 9) & 1) << 5); R = (st >> 1) * 16 + swz / 64; C = (st & 1) * 32 + (swz % 64) / 2; }
__device__ __forceinline__ int perm32(int rho) { const int n = rho >> 4, i = rho & 15; return 8 * (i >> 2) + 4 * n + (i & 3); }
struct Unit { int pm, pn, e; };
struct Gemm { const bf16_t* A; const bf16_t* Bt; int K; };
__device__ __forceinline__ unsigned cvt_pk_bf16(float lo, float hi) { unsigned r; asm volatile("v_cvt_pk_bf16_f32 %0, %1, %2" : "=v"(r) : "v"(lo), "v"(hi)); return r; }

struct DenseOrder {
    int nM, nN, nwg, G, c;
    __device__ void init(int M, int N, int G_, int c_) { nM = M / BM; nN = N / BM; nwg = nM * nN; G = G_; c = c_; }
    __device__ bool next(int i, Unit& u) const {
        const long L = (long)i * G + c; if (L >= nwg) return false;
        int wgid = (int)L; { const int q = nwg / 8, r = nwg % 8, xcd = wgid % 8, off = wgid / 8; wgid = (xcd < r ? xcd * (q + 1) : r * (q + 1) + (xcd - r) * q) + off; }
        const int nig = 8 * nN, gid = wgid / nig, fm = gid * 8, gsz = (nM - fm) < 8 ? (nM - fm) : 8;
        u.pm = fm + ((wgid % nig) % gsz); u.pn = (wgid % nig) / gsz; u.e = 0; return true;
    }
    __device__ __forceinline__ unsigned arow(const Unit& u, int r) const { return (unsigned)(u.pm * BM + r); }
};
struct MoeOrder {
    const LAS int* tb; const LAS int* cn; const int* slot_tok; int shift, G, c; bool gather;
    __device__ bool next(int i, Unit& u) const {
        const int L = i * G + c, tile = L >> shift; if (tile >= tb[NE]) return false;
        int e = 0; while (tb[e + 1] <= tile) ++e;
        u.pm = tile; u.pn = (e << shift) + (L & ((1 << shift) - 1)); u.e = e; return true;
    }
    __device__ __forceinline__ unsigned arow(const Unit& u, int r) const {
        if (!gather) return (unsigned)(u.pm * BM + r);
        const int pos = (u.pm - tb[u.e]) * BM + r;
        return pos < cn[u.e] ? (unsigned)slot_tok[u.e * CAP + pos] : 0u;
    }
};

struct EpiBf16 {
    static constexpr bool PERM = true;
    bf16_t* O; int ldc;
    __device__ __forceinline__ void operator()(const f32x4 (&acc)[2][2][4][2], const Unit& u, int wr, int wc, int fr, int fq) const {
        const int row0 = u.pm * BM + wr * 64 + fr, col0 = u.pn * BM + wc * 32 + 8 * fq;
#pragma unroll
        for (int ai = 0; ai < 2; ++ai)
#pragma unroll
            for (int m = 0; m < 4; ++m) { bf16_t* rowp = O + (size_t)(row0 + ai * HALF + m * 16) * ldc + col0;
#pragma unroll
                for (int bj = 0; bj < 2; ++bj) { const f32x4 v0 = acc[ai][bj][m][0], v1 = acc[ai][bj][m][1];
                    u32x4 w; w.x = cvt_pk_bf16(v0[0], v0[1]); w.y = cvt_pk_bf16(v0[2], v0[3]); w.z = cvt_pk_bf16(v1[0], v1[1]); w.w = cvt_pk_bf16(v1[2], v1[3]);
                    *(u32x4*)(rowp + bj * HALF) = w; } }
    }
};
struct EpiResid {
    static constexpr bool PERM = false;
    const float* base; float* out; const float* g;
    __device__ __forceinline__ void operator()(const f32x4 (&acc)[2][2][4][2], const Unit& u, int wr, int wc, int fr, int fq) const {
        const int row0 = u.pm * BM + wr * 64 + fr, col0 = u.pn * BM + wc * 32 + 4 * fq;
        const float* gb = g + (size_t)((u.pm * BM) / S) * 6144 + col0;
        f32x4 gv[2][2];
#pragma unroll
        for (int bj = 0; bj < 2; ++bj)
#pragma unroll
            for (int n = 0; n < 2; ++n) gv[bj][n] = *(const f32x4*)(gb + bj * HALF + n * 16);
#pragma unroll
        for (int ai = 0; ai < 2; ++ai)
#pragma unroll
            for (int m = 0; m < 4; ++m) { const size_t off = (size_t)(row0 + ai * HALF + m * 16) * D + col0;
#pragma unroll
                for (int bj = 0; bj < 2; ++bj)
#pragma unroll
                    for (int n = 0; n < 2; ++n) { const f32x4 bs = *(const f32x4*)(base + off + bj * HALF + n * 16);
                        *(f32x4*)(out + off + bj * HALF + n * 16) = bs + gv[bj][n] * acc[ai][bj][m][n]; } }
    }
};
struct EpiGu {
    static constexpr bool PERM = true;
    bf16_t* act; const float* bgu;
    __device__ __forceinline__ void operator()(const f32x4 (&acc)[2][2][4][2], const Unit& u, int wr, int wc, int fr, int fq) const {
        const int row0 = u.pm * BM + wr * 64 + fr, col0 = (u.pn & 7) * HALF + wc * 32 + 8 * fq;
        const float* bb = bgu + (size_t)u.e * 2048 + col0;
        const f32x4 bg0 = *(const f32x4*)(bb), bg1 = *(const f32x4*)(bb + 4), bu0 = *(const f32x4*)(bb + 1024), bu1 = *(const f32x4*)(bb + 1028);
#pragma unroll
        for (int ai = 0; ai < 2; ++ai)
#pragma unroll
            for (int m = 0; m < 4; ++m) {
                float r[8];
#pragma unroll
                for (int n = 0; n < 2; ++n) { const f32x4 gt = acc[ai][0][m][n] + (n ? bg1 : bg0), up = acc[ai][1][m][n] + (n ? bu1 : bu0);
#pragma unroll
                    for (int j = 0; j < 4; ++j) { const float gg = fminf(gt[j], 7.f), uu = fminf(fmaxf(up[j], -7.f), 7.f);
                        r[n * 4 + j] = (uu + 1.f) * gg * __builtin_amdgcn_rcpf(1.f + __expf(-1.702f * gg)); } }
                u32x4 w; w.x = cvt_pk_bf16(r[0], r[1]); w.y = cvt_pk_bf16(r[2], r[3]); w.z = cvt_pk_bf16(r[4], r[5]); w.w = cvt_pk_bf16(r[6], r[7]);
                *(u32x4*)(act + (size_t)(row0 + ai * HALF + m * 16) * D + col0) = w; }
    }
};
struct EpiDown {
    static constexpr bool PERM = true;
    bf16_t* y; const float* bd;
    __device__ __forceinline__ void operator()(const f32x4 (&acc)[2][2][4][2], const Unit& u, int wr, int wc, int fr, int fq) const {
        const int row0 = u.pm * BM + wr * 64 + fr, col0 = (u.pn & 3) * BM + wc * 32 + 8 * fq;
        const float* bb = bd + (size_t)u.e * 1024 + col0;
        f32x4 bv[2][2];
#pragma unroll
        for (int bj = 0; bj < 2; ++bj)
#pragma unroll
            for (int n = 0; n < 2; ++n) bv[bj][n] = *(const f32x4*)(bb + bj * HALF + 4 * n);
#pragma unroll
        for (int ai = 0; ai < 2; ++ai)
#pragma unroll
            for (int m = 0; m < 4; ++m) { bf16_t* rowp = y + (size_t)(row0 + ai * HALF + m * 16) * D + col0;
#pragma unroll
                for (int bj = 0; bj < 2; ++bj) { const f32x4 v0 = acc[ai][bj][m][0] + bv[bj][0], v1 = acc[ai][bj][m][1] + bv[bj][1];
                    u32x4 w; w.x = cvt_pk_bf16(v0[0], v0[1]); w.y = cvt_pk_bf16(v0[2], v0[3]); w.z = cvt_pk_bf16(v1[0], v1[1]); w.w = cvt_pk_bf16(v1[2], v1[3]);
                    *(u32x4*)(rowp + bj * HALF) = w; } }
    }
};

template <class Epi, class Sched>
__device__ __forceinline__ void gemm_phase(LAS unsigned char* lds, const Gemm g, const Sched& S, const Epi& E) {
    const int tid = threadIdx.x, wid = __builtin_amdgcn_readfirstlane(tid >> 6), lane = tid & 63, wr = wid >> 2, wc = wid & 3, fr = lane & 15, fq = lane >> 4;
    const int K = g.K, nt = K / BK;
    int RA[2], CA[2]; unsigned voffB[2];
#pragma unroll
    for (int i = 0; i < 2; ++i) { int R, C; stage_rc(tid * 16 + i * 8192, R, C); const int Rb = Epi::PERM ? ((R & ~31) + perm32(R & 31)) : R;
        RA[i] = R; CA[i] = C; voffB[i] = (unsigned)(Rb * K + C) * 2u; }
    const size_t kstep = (size_t)(BK * 2);
    const size_t hstep = (size_t)HALF * K * 2;
    const size_t tstep = 2 * hstep;
    const unsigned ldsw = (unsigned)wid * 1024u;
    const int aoff = lds_byte(wr * 64 + fr, fq * 8), boff = lds_byte(wc * 32 + fr, fq * 8);
#define PG8_SA(b, h) (((b) * 2 + (h)) * HTB)
#define PG8_SB(b, h) ((4 + (b) * 2 + (h)) * HTB)
#define PG8_STAGE(bufoff, gbase, voff) do { _Pragma("unroll") for (int _i = 0; _i < 2; ++_i) \
        __builtin_amdgcn_global_load_lds((const unsigned*)((const char*)(gbase) + (voff)[_i]), (LAS unsigned*)(lds + (bufoff) + ldsw + _i * 8192), 16, 0, 0); } while (0)
#define PG8_LDA(dst, b, h) do { _Pragma("unroll") for (int m = 0; m < 4; ++m) _Pragma("unroll") for (int k = 0; k < 2; ++k) dst[m][k] = *(const LAS bf16x8*)(lds + PG8_SA(b, h) + aoff + m * 2048 + k * 1024); } while (0)
#define PG8_LDB(dst, b, h) do { _Pragma("unroll") for (int n = 0; n < 2; ++n) _Pragma("unroll") for (int k = 0; k < 2; ++k) dst[n][k] = *(const LAS bf16x8*)(lds + PG8_SB(b, h) + boff + n * 2048 + k * 1024); } while (0)
#define PG8_MMA(ai, bj, At, Bt) do { __builtin_amdgcn_s_setprio(1); _Pragma("unroll") for (int m = 0; m < 4; ++m) _Pragma("unroll") for (int n = 0; n < 2; ++n) _Pragma("unroll") for (int k = 0; k < 2; ++k) \
        acc[ai][bj][m][n] = __builtin_amdgcn_mfma_f32_16x16x32_bf16(Bt[n][k], At[m][k], acc[ai][bj][m][n], 0, 0, 0); __builtin_amdgcn_s_setprio(0); } while (0)
#define PG8_WAIT_V(n) asm volatile("s_waitcnt vmcnt(" #n ")" ::: "memory")
#define PG8_WAIT_L(n) asm volatile("s_waitcnt lgkmcnt(" #n ")" ::: "memory")
#define PG8_BAR __builtin_amdgcn_s_barrier()
#define PG8_SCHED __builtin_amdgcn_sched_barrier(0)
#define PG8_AOFF(dst, u) do { _Pragma("unroll") for (int _h = 0; _h < 2; ++_h) _Pragma("unroll") for (int _i = 0; _i < 2; ++_i) dst[_h][_i] = (S.arow(u, _h * HALF + RA[_i]) * (unsigned)K + (unsigned)CA[_i]) * 2u; } while (0)
    Unit cur, nxt; int ui = 0;
    if (!S.next(0, cur)) return;
    f32x4 acc[2][2][4][2];
#pragma unroll
    for (int a = 0; a < 2; ++a)
#pragma unroll
        for (int b = 0; b < 2; ++b)
#pragma unroll
            for (int m = 0; m < 4; ++m)
#pragma unroll
                for (int n = 0; n < 2; ++n) acc[a][b][m][n] = (f32x4){0.f, 0.f, 0.f, 0.f};
    bf16x8 At[4][2], B0[2][2], B1[2][2];
    unsigned va[2][2], vn[2][2];
    PG8_AOFF(va, cur);
    const char* Ab = (const char*)g.A;
    const char* cB = (const char*)g.Bt + (size_t)cur.pn * tstep;
    PG8_STAGE(PG8_SB(0, 0), cB, voffB); PG8_STAGE(PG8_SB(0, 1), cB + hstep, voffB); PG8_STAGE(PG8_SA(0, 0), Ab, va[0]); PG8_STAGE(PG8_SA(0, 1), Ab, va[1]);
    if (wr == 1) PG8_BAR;
    PG8_WAIT_V(2); PG8_BAR;
    PG8_STAGE(PG8_SB(1, 0), cB + kstep, voffB); PG8_STAGE(PG8_SA(1, 0), Ab + kstep, va[0]); PG8_STAGE(PG8_SB(1, 1), cB + hstep + kstep, voffB);
    PG8_WAIT_V(6); PG8_BAR;
    for (;;) {
        const bool has_next = S.next(ui + 1, nxt);
        if (has_next) { PG8_AOFF(vn, nxt); }
        else {
#pragma unroll
            for (int h = 0; h < 2; ++h)
#pragma unroll
                for (int i = 0; i < 2; ++i) vn[h][i] = va[h][i]; }
        const char* nB = has_next ? (const char*)g.Bt + (size_t)nxt.pn * tstep : cB;
        for (int t = 0; t < nt; t += 2) {
            const bool last = (t == nt - 2);
            const char* a1 = Ab + (size_t)(t + 1) * kstep;
            const char* a2 = last ? Ab : Ab + (size_t)(t + 2) * kstep; const char* b2 = last ? nB : cB + (size_t)(t + 2) * kstep;
            const char* a3 = a2 + kstep; const char* b3 = b2 + kstep;
            unsigned o2[2][2];
#pragma unroll
            for (int h = 0; h < 2; ++h)
#pragma unroll
                for (int i = 0; i < 2; ++i) o2[h][i] = last ? vn[h][i] : va[h][i];
            PG8_LDB(B0, 0, 0); PG8_LDB(B1, 0, 1); PG8_SCHED; PG8_LDA(At, 0, 0); PG8_STAGE(PG8_SA(1, 1), a1, va[1]);
            PG8_WAIT_V(8); PG8_WAIT_L(0); PG8_BAR; PG8_MMA(0, 0, At, B0); PG8_MMA(0, 1, At, B1); PG8_BAR; PG8_SCHED;
            PG8_LDA(At, 0, 1); PG8_STAGE(PG8_SB(0, 0), b2, voffB); PG8_STAGE(PG8_SB(0, 1), b2 + hstep, voffB); PG8_STAGE(PG8_SA(0, 0), a2, o2[0]);
            PG8_WAIT_V(8); PG8_WAIT_L(0); PG8_BAR; PG8_MMA(1, 0, At, B0); PG8_MMA(1, 1, At, B1); PG8_BAR; PG8_SCHED;
            PG8_LDB(B0, 1, 0); PG8_LDB(B1, 1, 1); PG8_SCHED; PG8_LDA(At, 1, 0); PG8_STAGE(PG8_SA(0, 1), a2, o2[1]);
            PG8_WAIT_V(8); PG8_WAIT_L(0); PG8_BAR; PG8_MMA(0, 0, At, B0); PG8_MMA(0, 1, At, B1); PG8_BAR; PG8_SCHED;
            PG8_LDA(At, 1, 1); PG8_STAGE(PG8_SB(1, 0), b3, voffB); PG8_STAGE(PG8_SB(1, 1), b3 + hstep, voffB); PG8_STAGE(PG8_SA(1, 0), a3, o2[0]);
            PG8_WAIT_V(8); PG8_WAIT_L(0); PG8_BAR; PG8_MMA(1, 0, At, B0); PG8_MMA(1, 1, At, B1); PG8_BAR; PG8_SCHED;
        }
        if (wr == 0) PG8_BAR;
        E(acc, cur, wr, wc, fr, fq);
        if (!has_next) break;
#pragma unroll
        for (int a = 0; a < 2; ++a)
#pragma unroll
            for (int b = 0; b < 2; ++b)
#pragma unroll
                for (int m = 0; m < 4; ++m)
#pragma unroll
                    for (int n = 0; n < 2; ++n) acc[a][b][m][n] = (f32x4){0.f, 0.f, 0.f, 0.f};
        cur = nxt; cB = nB; ++ui;
#pragma unroll
        for (int h = 0; h < 2; ++h)
#pragma unroll
            for (int i = 0; i < 2; ++i) va[h][i] = vn[h][i];
        if (wr == 1) PG8_BAR;
    }
    PG8_WAIT_V(0);
    PG8_BAR;
#undef PG8_SA
#undef PG8_SB
#undef PG8_STAGE
#undef PG8_LDA
#undef PG8_LDB
#undef PG8_MMA
#undef PG8_WAIT_V
#undef PG8_WAIT_L
#undef PG8_BAR
#undef PG8_SCHED
#undef PG8_AOFF
}
}

struct Ctx {
    LAS unsigned char* lds; unsigned char* ws;
    int tid, lane, wave, gw, ngw, G, bid;
};

__device__ __forceinline__ void transpose_item(const float* W, int ldw, int K, int nvalid, int k0, int n0, bf16_t* WT, int row0, LAS float* scr, int lane) {
    const int nn = n0 + (lane & 31);
#pragma unroll 8
    for (int i = 0; i < 32; ++i) { const int kk = 2 * i + (lane >> 5); scr[kk * 33 + (lane & 31)] = nn < nvalid ? W[(size_t)(k0 + kk) * ldw + nn] : 0.f; }
    LDS_WAIT(); asm volatile("" ::: "memory");
    const int c = lane & 7;
#pragma unroll
    for (int j = 0; j < 4; ++j) { const int n = (lane >> 3) + 8 * j; const LAS float* s = scr + (8 * c) * 33 + n;
        u32x4 o; o.x = pk2(s[0 * 33], s[1 * 33]); o.y = pk2(s[2 * 33], s[3 * 33]); o.z = pk2(s[4 * 33], s[5 * 33]); o.w = pk2(s[6 * 33], s[7 * 33]);
        *(u32x4*)(WT + (size_t)(row0 + n) * K + k0 + 8 * c) = o; }
    LDS_WAIT(); asm volatile("" ::: "memory");
}
__device__ __forceinline__ void ph_prologue(const Params& p, const Ctx& X) {
    LAS float* scr = (LAS float*)(X.lds + X.wave * 16384);
    unsigned char* ws = X.ws;
    constexpr int I_MOD = 2 * 96 * 8;
    constexpr int I_WIN = 16 * 96, I_WV = 16 * 24, I_WOUT = 16 * 32, I_WSIN = 16 * 160, I_WSOUT = 32 * 32, I_GU = 64 * 1024, I_DN = 64 * 512;
    constexpr int NITEMS = I_MOD + I_WIN + I_WV + I_WOUT + I_WSIN + I_WSOUT + I_GU + I_DN;
    for (int it = X.gw; it < NITEMS; it += X.ngw) {
        int r = it;
        if (r < I_MOD) {
            const int kp = r & 7, jb = (r >> 3) % 96, l = r / (8 * 96), j = jb * 64 + X.lane;
            const float* w = p.in[2] + (size_t)l * 1024 * 6144 + (size_t)(kp * 128) * 6144 + j;
            const float* c = p.in[1] + kp * 128;
            float a0 = 0.f, a1 = 0.f, a2 = 0.f, a3 = 0.f;
#pragma unroll 8
            for (int i = 0; i < 128; ++i) { const float wv = w[(size_t)i * 6144];
                a0 += siluf(c[i]) * wv; a1 += siluf(c[1024 + i]) * wv; a2 += siluf(c[2048 + i]) * wv; a3 += siluf(c[3072 + i]) * wv; }
            if (kp == 0) { const float bb = p.in[3][l * 6144 + j]; a0 += bb; a1 += bb; a2 += bb; a3 += bb; }
            unsigned long long* mq = (unsigned long long*)(ws + CTL_MOD) + (size_t)l * 4 * 6144 + j;
            atomicAdd(mq, (unsigned long long)__double2ll_rn((double)a0 * 1099511627776.0)); atomicAdd(mq + 6144, (unsigned long long)__double2ll_rn((double)a1 * 1099511627776.0));
            atomicAdd(mq + 2 * 6144, (unsigned long long)__double2ll_rn((double)a2 * 1099511627776.0)); atomicAdd(mq + 3 * 6144, (unsigned long long)__double2ll_rn((double)a3 * 1099511627776.0));
            continue;
        }
        r -= I_MOD;
        if (r < I_WIN) { const int kb = r / 96, nb = r % 96; transpose_item(p.in[6], ATTN_IN, 1024, ATTN_IN, kb * 64, nb * 32, (bf16_t*)(ws + WS_WIN), nb * 32, scr, X.lane); continue; } r -= I_WIN;
        if (r < I_WV) { const int kb = r / 24, nb = r % 24, r0 = nb * 32, src = r0 < 512 ? OFF_SBV + r0 : (r0 < 640 ? OFF_VS + (r0 - 512) : OFF_VW + (r0 - 640));
            transpose_item(p.in[6], ATTN_IN, 1024, ATTN_IN, kb * 64, src, (bf16_t*)(ws + WS_WV), r0, scr, X.lane); continue; } r -= I_WV;
        if (r < I_WOUT) { const int kb = r / 32, nb = r % 32; transpose_item(p.in[7], 1024, 1024, 1024, kb * 64, nb * 32, (bf16_t*)(ws + WS_WOUT), nb * 32, scr, X.lane); continue; } r -= I_WOUT;
        if (r < I_WSIN) { const int kb = r / 160, nb = r % 160; transpose_item(p.in[16], SSM_IN, 1024, SSM_IN, kb * 64, nb * 32, (bf16_t*)(ws + WS_WSIN), nb * 32, scr, X.lane); continue; } r -= I_WSIN;
        if (r < I_WSOUT) { const int kb = r / 32, nb = r % 32; transpose_item(p.in[23], 1024, 2048, 1024, kb * 64, nb * 32, (bf16_t*)(ws + WS_WSOUT), nb * 32, scr, X.lane); continue; } r -= I_WSOUT;
        if (r < I_GU) { const int m = r >> 10, q = r & 1023, kb = q >> 6, nb = q & 63, n0 = nb * 32;
            const int row0 = ((n0 & 1023) >> 7) * 256 + (n0 >> 10) * 128 + (n0 & 127);
            transpose_item(p.in[26] + (size_t)m * 1024 * 2048, 2048, 1024, 2048, kb * 64, n0, (bf16_t*)(ws + WS_WGU) + (size_t)m * 2048 * 1024, row0, scr, X.lane); continue; } r -= I_GU;
        { const int m = r >> 9, q = r & 511, kb = q >> 5, nb = q & 31;
            transpose_item(p.in[28] + (size_t)m * 1024 * 1024, 1024, 1024, 1024, kb * 64, nb * 32, (bf16_t*)(ws + WS_WDN) + (size_t)m * 1024 * 1024, nb * 32, scr, X.lane); }
    }
}

struct Row { f32x4 v[4]; };
__device__ __forceinline__ void row_load(Row& r, const float* p, int lane) {
#pragma unroll
    for (int j = 0; j < 4; ++j) r.v[j] = ((const f32x4*)p)[64 * j + lane];
}
__device__ __forceinline__ void row_store(const Row& r, float* p, int lane) {
#pragma unroll
    for (int j = 0; j < 4; ++j) ((f32x4*)p)[64 * j + lane] = r.v[j];
}
template <class PV>
__device__ __forceinline__ void row_norm_mod(const Row& r, Row& o, const float* gain, PV sc, PV sh, int lane) {
    float ss = 0.f;
#pragma unroll
    for (int j = 0; j < 4; ++j) ss += (r.v[j].x * r.v[j].x + r.v[j].y * r.v[j].y) + (r.v[j].z * r.v[j].z + r.v[j].w * r.v[j].w);
    const float rs = rsqrtf(wave_sum(ss) * (1.f / 1024.f) + EPS);
#pragma unroll
    for (int j = 0; j < 4; ++j) { const f32x4 g = ((const f32x4*)gain)[64 * j + lane], a = sc[64 * j + lane], b = sh[64 * j + lane];
        o.v[j] = r.v[j] * rs * g * (a + 1.f) + b; }
}
__device__ __forceinline__ void row_store_bf16(const Row& r, bf16_t* p, int lane) {
#pragma unroll
    for (int j = 0; j < 4; ++j) { u32x2 w; w.x = pk2(r.v[j].x, r.v[j].y); w.y = pk2(r.v[j].z, r.v[j].w); ((u32x2*)p)[64 * j + lane] = w; }
}
__device__ __forceinline__ void row_store_lds(const Row& r, LAS float* p, int lane) {
#pragma unroll
    for (int j = 0; j < 4; ++j) ((LAS f32x4*)p)[64 * j + lane] = r.v[j];
}
__device__ __forceinline__ void skinny4(const LAS float* scr, const float* W, int ldw, int col0, int lane, float (&acc)[4]) {
    const int e = lane & 31, half = lane >> 5;
    acc[0] = acc[1] = acc[2] = acc[3] = 0.f;
    const float* w = W + (size_t)(half * 512) * ldw + col0 + e;
    const LAS float* s = scr + half * 512;
#pragma unroll 2
    for (int i = 0; i < 512; i += 4) {
        const float w0 = w[(size_t)i * ldw], w1 = w[(size_t)(i + 1) * ldw], w2 = w[(size_t)(i + 2) * ldw], w3 = w[(size_t)(i + 3) * ldw];
#pragma unroll
        for (int tk = 0; tk < 4; ++tk) { const f32x4 x = *(const LAS f32x4*)(s + tk * 1024 + i); acc[tk] += (x.x * w0 + x.y * w1) + (x.z * w2 + x.w * w3); }
    }
#pragma unroll
    for (int tk = 0; tk < 4; ++tk) acc[tk] += __shfl_xor(acc[tk], 32);
}
__device__ __forceinline__ void route_token(float logit, int t, int l, const Ctx& X) {
    const int lane = X.lane, e = lane & 31;
    float tl[4]; int te[4];
#pragma unroll
    for (int k = 0; k < 4; ++k) {
        float bv = logit; int bi = e;
#pragma unroll
        for (int o = 16; o > 0; o >>= 1) { const float ov = __shfl_xor(bv, o); const int oi = __shfl_xor(bi, o); if (ov > bv || (ov == bv && oi < bi)) { bv = ov; bi = oi; } }
        tl[k] = bv; te[k] = bi;
        if (e == bi) logit = -INFINITY;
    }
    if (lane < 4) {
        const float e1 = expf(tl[1] - tl[0]), e2 = expf(tl[2] - tl[0]), e3 = expf(tl[3] - tl[0]);
        const float inv = 1.f / (1.f + e1 + e2 + e3);
        const float wv = (lane == 0 ? 1.f : lane == 1 ? e1 : lane == 2 ? e2 : e3) * inv;
        const int ev = lane == 0 ? te[0] : lane == 1 ? te[1] : lane == 2 ? te[2] : te[3];
        unsigned* cnt = (unsigned*)(X.ws + WS_CTL) + CW_CNT + l * 32;
        const int pos = (int)atomicAdd(&cnt[ev], 1u);
        ((int*)(X.ws + WS_TOKE))[t * 4 + lane] = ev; ((float*)(X.ws + WS_TOKW))[t * 4 + lane] = wv; ((int*)(X.ws + WS_TOKP))[t * 4 + lane] = pos;
        ((int*)(X.ws + WS_SLOT))[ev * CAP + pos] = t;
    }
}

__device__ __forceinline__ float modq2f(long long q) { return (float)((double)q * 9.094947017729282e-13); }
__device__ __forceinline__ void ph_norm0(const Params& p, const Ctx& X) {
    const long long* mq = (const long long*)(X.ws + CTL_MOD);
    float* modf = (float*)(X.ws + WS_MODF);
    for (int i = X.bid * NTHREADS + X.tid; i < 2 * 4 * 6144; i += X.G * NTHREADS) modf[i] = modq2f(mq[i]);
    LAS float* tab = (LAS float*)X.lds;
    for (int i = X.tid; i < 4 * 2048; i += NTHREADS) tab[i] = modq2f(mq[(size_t)(i >> 11) * 6144 + (i & 2047)]);
    __syncthreads();
    for (int t = X.gw; t < T; t += X.ngw) {
        Row r, o; row_load(r, p.in[0] + (size_t)t * D, X.lane);
        const LAS float* m = tab + (t / S) * 2048;
        row_norm_mod(r, o, p.in[4], (const LAS f32x4*)(m + 1024), (const LAS f32x4*)m, X.lane);
        row_store_bf16(o, (bf16_t*)(X.ws + WS_U) + (size_t)t * D, X.lane);
    }
}
__device__ __forceinline__ void ph_router(const Params& p, const Ctx& X, int l, const float* h) {
    const float* mod = (const float*)(X.ws + WS_MODF) + (size_t)l * 4 * 6144;
    LAS float* scr = (LAS float*)(X.lds + X.wave * 16384);
    for (int g4 = X.gw; g4 < T / 4; g4 += X.ngw) {
#pragma unroll
        for (int tk = 0; tk < 4; ++tk) { const int t = g4 * 4 + tk;
            Row r, o; row_load(r, h + (size_t)t * D, X.lane);
            const float* m = mod + (size_t)(t / S) * 6144;
            row_norm_mod(r, o, p.in[5] + l * D, (const f32x4*)(m + 4096), (const f32x4*)(m + 3072), X.lane);
            row_store_bf16(o, (bf16_t*)(X.ws + WS_U) + (size_t)t * D, X.lane);
            row_store_lds(o, scr + tk * 1024, X.lane); }
        LDS_WAIT();
        float acc[4]; skinny4(scr, p.in[24] + (size_t)l * D * NE, NE, 0, X.lane, acc);
        const float bias = p.in[25][l * NE + (X.lane & 31)];
#pragma unroll
        for (int tk = 0; tk < 4; ++tk) route_token(acc[tk] + bias, g4 * 4 + tk, l, X);
        LDS_WAIT();
    }
}
__device__ __forceinline__ void moe_table(const Ctx& X, int l) {
    LAS int* tb = (LAS int*)(X.lds + TAB_OFF);
    if (X.tid == 0) {
        const unsigned* cnt = (const unsigned*)(X.ws + WS_CTL) + CW_CNT + l * 32;
        int base = 0;
        for (int e = 0; e < NE; ++e) { const int c = (int)__hip_atomic_load(cnt + e, __ATOMIC_RELAXED, __HIP_MEMORY_SCOPE_AGENT); tb[e] = base; tb[40 + e] = c; base += (c + 255) >> 8; }
        tb[NE] = base;
    }
    __syncthreads();
}
template <int MODE>
__device__ __forceinline__ void ph_combine(const Params& p, const Ctx& X, int l, const float* h, float* hn) {
    moe_table(X, l);
    const LAS int* tb = (const LAS int*)(X.lds + TAB_OFF);
    const float* mod = (const float*)(X.ws + WS_MODF) + (size_t)l * 4 * 6144;
    const float* mod1 = (const float*)(X.ws + WS_MODF) + (size_t)4 * 6144;
    const bf16_t* y = (const bf16_t*)(X.ws + WS_Y);
    LAS float* scr = (LAS float*)(X.lds + X.wave * 16384);
    for (int g4 = X.gw; g4 < T / 4; g4 += X.ngw) {
#pragma unroll
        for (int tk = 0; tk < 4; ++tk) { const int t = g4 * 4 + tk;
            Row r; row_load(r, h + (size_t)t * D, X.lane);
            const float* g2 = mod + (size_t)(t / S) * 6144 + 5120;
            Row s;
#pragma unroll
            for (int j = 0; j < 4; ++j) s.v[j] = (f32x4){0.f, 0.f, 0.f, 0.f};
#pragma unroll
            for (int k = 0; k < 4; ++k) {
                const int e = ((const int*)(X.ws + WS_TOKE))[t * 4 + k], pos = ((const int*)(X.ws + WS_TOKP))[t * 4 + k]; const float w = ((const float*)(X.ws + WS_TOKW))[t * 4 + k];
                const bf16_t* yr = y + (size_t)(tb[e] * 256 + pos) * D;
#pragma unroll
                for (int j = 0; j < 4; ++j) { const u32x2 q = ((const u32x2*)yr)[64 * j + X.lane];
                    s.v[j].x += w * bflo(q.x); s.v[j].y += w * bfhi(q.x); s.v[j].z += w * bflo(q.y); s.v[j].w += w * bfhi(q.y); }
            }
#pragma unroll
            for (int j = 0; j < 4; ++j) r.v[j] = r.v[j] + ((const f32x4*)g2)[64 * j + X.lane] * s.v[j];
            row_store(r, hn + (size_t)t * D, X.lane);
            if (MODE == 0) {
                Row o; const float* m = mod1 + (size_t)(t / S) * 6144;
                row_norm_mod(r, o, p.in[4] + D, (const f32x4*)(m + 1024), (const f32x4*)m, X.lane);
                row_store_bf16(o, (bf16_t*)(X.ws + WS_U) + (size_t)t * D, X.lane);
                row_store_lds(o, scr + tk * 1024, X.lane);
            }
        }
        if (MODE == 0) {
            LDS_WAIT();
            float acc[4]; skinny4(scr, p.in[16], SSM_IN, 5120, X.lane, acc);
            if (X.lane < 32) {
#pragma unroll
                for (int tk = 0; tk < 4; ++tk) ((float*)(X.ws + WS_DT))[(size_t)(g4 * 4 + tk) * 32 + X.lane] = acc[tk];
            }
            LDS_WAIT();
        }
    }
}

__device__ __forceinline__ void ld64bf(const bf16_t* p, float (&q)[64]) {
#pragma unroll
    for (int i = 0; i < 8; ++i) { const u32x4 w = ((const u32x4*)p)[i];
        q[8 * i] = bflo(w.x); q[8 * i + 1] = bfhi(w.x); q[8 * i + 2] = bflo(w.y); q[8 * i + 3] = bfhi(w.y); q[8 * i + 4] = bflo(w.z); q[8 * i + 5] = bfhi(w.z); q[8 * i + 6] = bflo(w.w); q[8 * i + 7] = bfhi(w.w); }
}
__device__ __forceinline__ float dot64bf(const bf16_t* p, const float (&q)[64]) {
    float d = 0.f;
#pragma unroll
    for (int i = 0; i < 8; ++i) { const u32x4 w = ((const u32x4*)p)[i];
        d += q[8 * i] * bflo(w.x) + q[8 * i + 1] * bfhi(w.x) + q[8 * i + 2] * bflo(w.y) + q[8 * i + 3] * bfhi(w.y) + q[8 * i + 4] * bflo(w.z) + q[8 * i + 5] * bfhi(w.z) + q[8 * i + 6] * bflo(w.w) + q[8 * i + 7] * bfhi(w.w); }
    return d;
}
__device__ __forceinline__ float dot64f(const float* p, const float (&q)[64]) {
    float d = 0.f;
#pragma unroll
    for (int i = 0; i < 16; ++i) { const f32x4 w = ((const f32x4*)p)[i]; d += (q[4 * i] * w.x + q[4 * i + 1] * w.y) + (q[4 * i + 2] * w.z + q[4 * i + 3] * w.w); }
    return d;
}
__device__ __forceinline__ void sb_unit(const Ctx& X, int qt, int bh) {
    const int b = bh >> 3, hh = bh & 7, t = qt * 64 + X.lane;
    const bf16_t* base = (const bf16_t*)(X.ws + WS_BIG) + (size_t)b * S * PROJ_LD;
    float q[64], acc[64];
    ld64bf(base + (size_t)t * PROJ_LD + OFF_SBQ + hh * 64, q);
#pragma unroll
    for (int d = 0; d < 64; ++d) acc[d] = 0.f;
    float run = 0.f;
    for (int j = qt * 64 + 62; j >= 0; --j) {
        const bf16_t* kr = base + (size_t)j * PROJ_LD + OFF_SBK + hh * 64;
        const float logit = dot64bf(kr, q) * 0.125f;
        if (j < t) {
            const float w = expf(logsig(logit) + run);
            run += logsig(-logit);
            const bf16_t* vr = base + (size_t)j * PROJ_LD + OFF_SBV + hh * 64;
#pragma unroll
            for (int i = 0; i < 8; ++i) { const u32x4 v = ((const u32x4*)vr)[i];
                acc[8 * i] += w * bflo(v.x); acc[8 * i + 1] += w * bfhi(v.x); acc[8 * i + 2] += w * bflo(v.y); acc[8 * i + 3] += w * bfhi(v.y);
                acc[8 * i + 4] += w * bflo(v.z); acc[8 * i + 5] += w * bfhi(v.z); acc[8 * i + 6] += w * bflo(v.w); acc[8 * i + 7] += w * bfhi(v.w); }
        }
    }
    bf16_t* op = (bf16_t*)(X.ws + WS_O) + (size_t)(b * S + t) * D + hh * 64;
#pragma unroll
    for (int i = 0; i < 8; ++i) { u32x4 w; w.x = pk2(acc[8 * i], acc[8 * i + 1]); w.y = pk2(acc[8 * i + 2], acc[8 * i + 3]); w.z = pk2(acc[8 * i + 4], acc[8 * i + 5]); w.w = pk2(acc[8 * i + 6], acc[8 * i + 7]);
        ((u32x4*)op)[i] = w; }
}

typedef float f32x16 __attribute__((ext_vector_type(16)));
__device__ __forceinline__ int pi32(int r) { return (r & 0x13) | ((r & 4) << 1) | ((r & 8) >> 1); }
__device__ __forceinline__ void sb_attn_unit(const Ctx& X, int bh, int qb) {
    const int b = bh >> 3, h = bh & 7, q0 = qb * 256, lane = X.lane, w = X.wave, ql = lane & 31, hf = lane >> 5;
    const bf16_t* proj = (const bf16_t*)(X.ws + WS_BIG) + (size_t)b * S * PROJ_LD;
    const bf16_t* vt = (const bf16_t*)(X.ws + WS_VT) + (size_t)(h * 64) * T + (size_t)b * S;
    const int tq = q0 + 32 * w + ql;
    bf16x8 qf[4];
#pragma unroll
    for (int s = 0; s < 4; ++s) qf[s] = *(const bf16x8*)(proj + (size_t)tq * PROJ_LD + OFF_SBQ + h * 64 + 16 * s + 8 * hf);
    f32x16 o0, o1;
#pragma unroll
    for (int i = 0; i < 16; ++i) { o0[i] = 0.f; o1[i] = 0.f; }
    float run = 0.f;
    const int nblk = 4 * qb + 4, jw = (q0 + 32 * w + 30) >> 6;
    const float CS = 0.125f * 1.4426950408889634f;
    const bf16_t* kg = proj + (size_t)lane * PROJ_LD + OFF_SBK + h * 64 + 8 * w;
    const bf16_t* vg = vt + (size_t)lane * T + 8 * w;
    LAS unsigned char* buf0 = X.lds;
    const int stoff = w * 1024 + lane * 16;
    u32x4 kreg = *(const u32x4*)(kg + (size_t)(64 * (nblk - 1)) * PROJ_LD), vreg = *(const u32x4*)(vg + 64 * (nblk - 1));
    *(LAS u32x4*)(buf0 + stoff) = kreg; *(LAS u32x4*)(buf0 + 8192 + stoff) = vreg;
    __syncthreads();
    const int krow = pi32(ql) * 16;
    for (int j = nblk - 1; j >= 0; --j) {
        LAS unsigned char* buf = buf0 + (((nblk - 1 - j) & 1) ? 16384 : 0);
        LAS unsigned char* nbuf = buf0 + (((nblk - 1 - j) & 1) ? 0 : 16384);
        if (j > 0) { kreg = *(const u32x4*)(kg + (size_t)(64 * (j - 1)) * PROJ_LD); vreg = *(const u32x4*)(vg + 64 * (j - 1)); }
        if (j <= jw) {
#pragma unroll
            for (int kt = 1; kt >= 0; --kt) {
                f32x16 sc;
#pragma unroll
                for (int i = 0; i < 16; ++i) sc[i] = 0.f;
#pragma unroll
                for (int s = 0; s < 4; ++s) { const bf16x8 kf = *(const LAS bf16x8*)(buf + (2 * s + hf) * 1024 + kt * 512 + krow); sc = __builtin_amdgcn_mfma_f32_32x32x16_bf16(kf, qf[s], sc, 0, 0, 0); }
                const int pos0 = 64 * j + 32 * kt + 8 * hf;
                float lk[16], lb[16];
                float a1 = 0.f, a0 = 0.f;
#pragma unroll
                for (int i = 0; i < 16; ++i) {
                    const float xx = sc[i] * CS, e = __builtin_amdgcn_exp2f(-fabsf(xx)), sp = fmaxf(xx, 0.f) + __builtin_amdgcn_logf(1.f + e);
                    const bool valid = (pos0 + 16 * (i >> 3) + (i & 7)) < tq;
                    lk[i] = valid ? -sp : 0.f; lb[i] = valid ? xx - sp : -INFINITY;
                    if (i >= 8) a1 += lk[i]; else a0 += lk[i];
                }
                const float p1 = __shfl_xor(a1, 32), p0 = __shfl_xor(a0, 32);
                const float hi1 = hf ? a1 : p1, lo1 = hf ? p1 : a1, hi0 = hf ? a0 : p0, lo0 = hf ? p0 : a0;
                float acc = hf ? run : run + hi1;
#pragma unroll
                for (int i = 15; i >= 8; --i) { const float t = lb[i] + acc; acc += lk[i]; lb[i] = __builtin_amdgcn_exp2f(t); }
                acc = hf ? run + hi1 + lo1 : run + hi1 + lo1 + hi0;
#pragma unroll
                for (int i = 7; i >= 0; --i) { const float t = lb[i] + acc; acc += lk[i]; lb[i] = __builtin_amdgcn_exp2f(t); }
                run += (hi1 + lo1) + (hi0 + lo0);
#pragma unroll
                for (int a = 0; a < 2; ++a) {
                    u32x4 pw; pw.x = pk2(lb[8 * a], lb[8 * a + 1]); pw.y = pk2(lb[8 * a + 2], lb[8 * a + 3]); pw.z = pk2(lb[8 * a + 4], lb[8 * a + 5]); pw.w = pk2(lb[8 * a + 6], lb[8 * a + 7]);
                    const bf16x8 pf = __builtin_bit_cast(bf16x8, pw);
                    const bf16x8 v0 = *(const LAS bf16x8*)(buf + 8192 + (4 * kt + 2 * a + hf) * 1024 + ql * 16);
                    const bf16x8 v1 = *(const LAS bf16x8*)(buf + 8192 + (4 * kt + 2 * a + hf) * 1024 + 512 + ql * 16);
                    o0 = __builtin_amdgcn_mfma_f32_32x32x16_bf16(v0, pf, o0, 0, 0, 0);
                    o1 = __builtin_amdgcn_mfma_f32_32x32x16_bf16(v1, pf, o1, 0, 0, 0);
                }
            }
        }
        if (j > 0) { *(LAS u32x4*)(nbuf + stoff) = kreg; *(LAS u32x4*)(nbuf + 8192 + stoff) = vreg; }
        __syncthreads();
    }
    bf16_t* op = (bf16_t*)(X.ws + WS_O) + (size_t)(b * S + tq) * D + h * 64 + 4 * hf;
#pragma unroll
    for (int g4 = 0; g4 < 4; ++g4) {
        u32x2 w0; w0.x = pk2(o0[4 * g4], o0[4 * g4 + 1]); w0.y = pk2(o0[4 * g4 + 2], o0[4 * g4 + 3]); *(u32x2*)(op + 8 * g4) = w0;
        u32x2 w1; w1.x = pk2(o1[4 * g4], o1[4 * g4 + 1]); w1.y = pk2(o1[4 * g4 + 2], o1[4 * g4 + 3]); *(u32x2*)(op + 32 + 8 * g4) = w1;
    }
}
__device__ __forceinline__ void ph_sb(const Ctx& X) {
    for (int pr = X.bid; pr < 256; pr += X.G) { const int bh = pr >> 3, qa = pr & 7; sb_attn_unit(X, bh, 15 - qa); sb_attn_unit(X, bh, qa); }
}
__device__ __forceinline__ void ph_attn_a(const Params& p, const Ctx& X) {
    const bf16_t* proj = (const bf16_t*)(X.ws + WS_BIG);
    {
        LAS float* flat = (LAS float*)X.lds; LAS float* part = flat + 2048; LAS float* hid = part + 512;
        for (int it = X.bid; it < NCMP * 8 * 2; it += X.G) {
            const int n = it % NCMP, bg = (it / NCMP) & 7, kv = it / (NCMP * 8), b = bg >> 1, g = bg & 1;
            const int col = kv ? OFF_VC : OFF_KC; const float* pe = kv ? p.in[11] : p.in[10]; const float* w1 = kv ? p.in[14] : p.in[12]; const float* w2 = kv ? p.in[15] : p.in[13];
            for (int i = X.tid; i < 2048; i += NTHREADS) { const int l = i >> 6, d = i & 63; flat[i] = bf2f(proj[(size_t)(b * S + n * 16 + l) * PROJ_LD + col + g * 64 + d]) + pe[l * 64 + d]; }
            __syncthreads();
            { const int j = X.tid & 127, part_i = X.tid >> 7; float a = 0.f;
              for (int i = part_i * 512; i < part_i * 512 + 512; ++i) a += flat[i] * w1[(size_t)i * 128 + j];
              part[part_i * 128 + j] = a; }
            __syncthreads();
            if (X.tid < 128) hid[X.tid] = siluf((part[X.tid] + part[128 + X.tid]) + (part[256 + X.tid] + part[384 + X.tid]));
            __syncthreads();
            if (X.tid < 64) {
                float o = 0.f;
                for (int j = 0; j < 128; ++j) o += hid[j] * w2[j * 64 + X.tid];
                float* dst = (float*)(X.ws + (kv ? WS_VCMP : WS_KCMP)) + (((size_t)b * NCMP + n) * 2 + g) * 64;
                if (kv == 0) { const float r = rsqrtf(wave_sum(o * o) * (1.f / 64.f) + EPS); o = o * r * p.in[9][X.tid]; }
                dst[X.tid] = o;
            }
            __syncthreads();
        }
    }
    for (int it = X.gw; it < T * 12; it += X.ngw) {
        const int t = it / 12, idx = it % 12, lane = X.lane;
        int col; const float* gain; float* dst; float sc = 1.f;
        if (idx < 8) { col = OFF_NQ + idx * 64; gain = p.in[8]; dst = (float*)(X.ws + WS_QN) + ((size_t)t * 8 + idx) * 64; sc = 0.125f; }
        else if (idx < 10) { col = OFF_KS + (idx - 8) * 64; gain = p.in[9] + 64; dst = (float*)(X.ws + WS_KN) + ((size_t)t * 4 + (idx - 8)) * 64; }
        else { col = OFF_KW + (idx - 10) * 64; gain = p.in[9] + 128; dst = (float*)(X.ws + WS_KN) + ((size_t)t * 4 + 2 + (idx - 10)) * 64; }
        const float v = bf2f(proj[(size_t)t * PROJ_LD + col + lane]);
        const float r = rsqrtf(wave_sum(v * v) * (1.f / 64.f) + EPS);
        dst[lane] = v * r * gain[lane] * sc;
    }
}
__device__ __forceinline__ void ph_nsa(const Params& p, const Ctx& X) {
    const bf16_t* proj = (const bf16_t*)(X.ws + WS_BIG);
    const float* qn = (const float*)(X.ws + WS_QN); const float* kn = (const float*)(X.ws + WS_KN);
    const float* kcmp = (const float*)(X.ws + WS_KCMP); const float* vcmp = (const float*)(X.ws + WS_VCMP);
    const int hb = X.tid >> 8, r = (X.tid >> 6) & 3, lane = X.lane;
    LAS float* s = (LAS float*)X.lds + (hb * 4 + r) * 1024;
    LAS float* pslc = (LAS float*)X.lds + 8192 + hb * 256;
    for (int it = X.bid; it < S * 8 / 2; it += X.G) {
        const int vb = it * 2 + hb, t = vb & (S - 1), bg = vb >> 12, b = bg >> 1, g = bg & 1, hh = g * 4 + r;
        const float slope = exp2f(-(float)(hh + 1));
        float q[64];
        {
            const f32x4* qp = (const f32x4*)(qn + ((size_t)(b * S + t) * 8 + hh) * 64);
#pragma unroll
            for (int d = 0; d < 16; ++d) { const f32x4 v = qp[d]; q[4 * d] = v.x; q[4 * d + 1] = v.y; q[4 * d + 2] = v.z; q[4 * d + 3] = v.w; }
        }
        const int ncv = t >= 31 ? (t - 31) / 16 + 1 : 0;
        float m = -INFINITY;
        for (int n = lane; n < ncv; n += 64) {
            const float v = dot64f(kcmp + (((size_t)b * NCMP + n) * 2 + g) * 64, q) - slope * (float)(t - (n * 16 + 31));
            s[n] = v; m = fmaxf(m, v);
        }
        m = wave_max(m);
        float sum = 0.f;
        for (int n = lane; n < ncv; n += 64) { const float pp = expf(s[n] - m); s[n] = pp; sum += pp; }
        sum = wave_sum(sum);
        const float inv = 1.f / fmaxf(sum, 1e-30f);
        for (int n = lane; n < ncv; n += 64) s[n] *= inv;
        LDS_WAIT();
        float oc = 0.f;
        for (int n = 0; n < ncv; ++n) oc += s[n] * vcmp[(((size_t)b * NCMP + n) * 2 + g) * 64 + lane];
        {
            float ps = 0.f;
            const int lo = max(0, 4 * lane - 1), hi = min(4 * lane + 3, ncv - 1);
            for (int n = lo; n <= hi; ++n) ps += s[n];
            pslc[r * 64 + lane] = ps;
        }
        __syncthreads();
        unsigned long long selmask;
        {
            const float ps = (pslc[lane] + pslc[64 + lane]) + (pslc[128 + lane] + pslc[192 + lane]);
            const int cur = t >> 6;
            const bool valid = lane * 64 <= t, forced = (lane == 0) || (lane == cur) || (lane == cur - 1);
            const float score = valid ? (forced ? 1e6f : ps) : -1e6f;
            int rank = 0;
            for (int i = 0; i < 64; ++i) { const float si = __shfl(score, i); rank += (si > score || (si == score && i < lane)) ? 1 : 0; }
            selmask = __ballot(rank < 16);
        }
        __syncthreads();
        float os = 0.f;
        {
            int ns = 0; float mm = -INFINITY;
            for (unsigned long long mk = selmask; mk; mk &= mk - 1) {
                const int jb = __builtin_ctzll(mk), pos = jb * 64 + lane;
                float v = -INFINITY;
                if (pos <= t) v = dot64f(kn + ((size_t)(b * S + pos) * 4 + g) * 64, q) - slope * (float)(t - pos);
                s[ns * 64 + lane] = v; mm = fmaxf(mm, v); ++ns;
            }
            mm = wave_max(mm);
            float sm = 0.f;
            for (int i = 0; i < ns; ++i) { const float pp = expf(s[i * 64 + lane] - mm); s[i * 64 + lane] = pp; sm += pp; }
            sm = wave_sum(sm);
            const float iv = 1.f / fmaxf(sm, 1e-30f);
            LDS_WAIT();
            int i = 0;
            for (unsigned long long mk = selmask; mk; mk &= mk - 1, ++i) {
                const int jb = __builtin_ctzll(mk);
                if (jb * 64 > t) continue;
                const int cntk = min(64, t - jb * 64 + 1);
                for (int k = 0; k < cntk; ++k) os += s[i * 64 + k] * bf2f(proj[(size_t)(b * S + jb * 64 + k) * PROJ_LD + OFF_VS + g * 64 + lane]);
            }
            os *= iv;
        }
        float ow = 0.f;
        {
            const int s0 = max(0, t - 511), nk = t - s0 + 1;
            float mm = -INFINITY;
            for (int k = lane; k < nk; k += 64) {
                const int pos = s0 + k;
                const float v = dot64f(kn + ((size_t)(b * S + pos) * 4 + 2 + g) * 64, q) - slope * (float)(t - pos);
                s[k] = v; mm = fmaxf(mm, v);
            }
            mm = wave_max(mm);
            float sm = 0.f;
            for (int k = lane; k < nk; k += 64) { const float pp = expf(s[k] - mm); s[k] = pp; sm += pp; }
            sm = wave_sum(sm);
            const float iv = 1.f / fmaxf(sm, 1e-30f);
            LDS_WAIT();
            for (int k = 0; k < nk; ++k) ow += s[k] * bf2f(proj[(size_t)(b * S + s0 + k) * PROJ_LD + OFF_VW + g * 64 + lane]);
            ow *= iv;
        }
        const bf16_t* gp = proj + (size_t)(b * S + t) * PROJ_LD + OFF_GATE + hh * 3;
        const float g0 = 1.f / (1.f + expf(-bf2f(gp[0]))), g1 = 1.f / (1.f + expf(-bf2f(gp[1]))), g2 = 1.f / (1.f + expf(-bf2f(gp[2])));
        ((bf16_t*)(X.ws + WS_O))[(size_t)(b * S + t) * D + 512 + hh * 64 + lane] = (bf16_t)f2bf(g0 * oc + g1 * os + g2 * ow);
        LDS_WAIT();
    }
}

__device__ __forceinline__ void ph_conv(const Params& p, const Ctx& X) {
    const bf16_t* zx = (const bf16_t*)(X.ws + WS_BIG); float* xc = (float*)(X.ws + WS_XC);
    const float* cw = p.in[17]; const float* cb = p.in[18];
    for (size_t i = (size_t)X.bid * NTHREADS + X.tid; i < (size_t)T * (CONV_DIM / 4); i += (size_t)X.G * NTHREADS) {
        const int t = (int)(i / (CONV_DIM / 4)), ch = (int)(i % (CONV_DIM / 4)) * 4, tt = t & (S - 1);
        f32x4 a = *(const f32x4*)(cb + ch);
#pragma unroll
        for (int w = 0; w < 4; ++w) {
            if (tt - 3 + w < 0) continue;
            const u32x2 q = *(const u32x2*)(zx + (size_t)(t - 3 + w) * ZX_LD + 2048 + ch); const f32x4 k = *(const f32x4*)(cw + w * CONV_DIM + ch);
            a.x += bflo(q.x) * k.x; a.y += bfhi(q.x) * k.y; a.z += bflo(q.y) * k.z; a.w += bfhi(q.y) * k.w;
        }
        *(f32x4*)(xc + (size_t)t * CONV_DIM + ch) = (f32x4){siluf(a.x), siluf(a.y), siluf(a.z), siluf(a.w)};
    }
}
__device__ __forceinline__ void ph_ssd(const Params& p, const Ctx& X) {
    const float* xc = (const float*)(X.ws + WS_XC); const float* dtr = (const float*)(X.ws + WS_DT); float* ys = (float*)(X.ws + WS_YS);
    const int vb = X.bid * 2 + (X.tid >> 8);
    if (vb >= NB * 32) return;
    const int b = vb >> 5, hh = vb & 31, g = hh >> 3, tl = X.tid & 255, pp = tl >> 2, c4 = tl & 3;
    const float a = -expf(p.in[20][hh]), dtb = p.in[19][hh], dsk = p.in[21][hh];
    float st[32];
#pragma unroll
    for (int i = 0; i < 32; ++i) st[i] = 0.f;
    for (int tt = 0; tt < S; ++tt) {
        const size_t t = (size_t)b * S + tt;
        const float raw = dtr[t * 32 + hh] + dtb;
        const float dt = raw > 20.f ? raw : log1pf(expf(raw));
        const float dA = expf(dt * a);
        const float xv = xc[t * CONV_DIM + hh * 64 + pp];
        const float xd = xv * dt;
        const f32x4* Bp = (const f32x4*)(xc + t * CONV_DIM + 2048 + g * 128 + c4 * 32);
        const f32x4* Cp = (const f32x4*)(xc + t * CONV_DIM + 2560 + g * 128 + c4 * 32);
        float y = 0.f;
#pragma unroll
        for (int i = 0; i < 8; ++i) {
            const f32x4 bv = Bp[i], cv = Cp[i];
            st[4 * i + 0] = st[4 * i + 0] * dA + xd * bv.x; y += cv.x * st[4 * i + 0];
            st[4 * i + 1] = st[4 * i + 1] * dA + xd * bv.y; y += cv.y * st[4 * i + 1];
            st[4 * i + 2] = st[4 * i + 2] * dA + xd * bv.z; y += cv.z * st[4 * i + 2];
            st[4 * i + 3] = st[4 * i + 3] * dA + xd * bv.w; y += cv.w * st[4 * i + 3];
        }
        y += __shfl_xor(y, 1); y += __shfl_xor(y, 2);
        if (c4 == 0) ys[t * SSM_INNER + hh * 64 + pp] = y + xv * dsk;
    }
}
__device__ __forceinline__ void ph_gate_norm(const Params& p, const Ctx& X) {
    const bf16_t* zx = (const bf16_t*)(X.ws + WS_BIG); const float* ys = (const float*)(X.ws + WS_YS); bf16_t* yn = (bf16_t*)(X.ws + WS_O);
    for (int it = X.gw; it < T * 4; it += X.ngw) {
        const int t = it >> 2, ch = (it & 3) * 512 + X.lane * 8;
        const f32x4 y0 = *(const f32x4*)(ys + (size_t)t * SSM_INNER + ch), y1 = *(const f32x4*)(ys + (size_t)t * SSM_INNER + ch + 4);
        const u32x4 z = *(const u32x4*)(zx + (size_t)t * ZX_LD + ch);
        float v[8] = {y0.x * siluf(bflo(z.x)), y0.y * siluf(bfhi(z.x)), y0.z * siluf(bflo(z.y)), y0.w * siluf(bfhi(z.y)),
                      y1.x * siluf(bflo(z.z)), y1.y * siluf(bfhi(z.z)), y1.z * siluf(bflo(z.w)), y1.w * siluf(bfhi(z.w))};
        float ss = 0.f;
#pragma unroll
        for (int i = 0; i < 8; ++i) ss += v[i] * v[i];
        const float r = rsqrtf(wave_sum(ss) * (1.f / 512.f) + EPS);
        const f32x4 g0 = *(const f32x4*)(p.in[22] + ch), g1 = *(const f32x4*)(p.in[22] + ch + 4);
        u32x4 w; w.x = pk2(v[0] * r * g0.x, v[1] * r * g0.y); w.y = pk2(v[2] * r * g0.z, v[3] * r * g0.w); w.z = pk2(v[4] * r * g1.x, v[5] * r * g1.y); w.w = pk2(v[6] * r * g1.z, v[7] * r * g1.w);
        *(u32x4*)(yn + (size_t)t * SSM_INNER + ch) = w;
    }
}

__device__ __forceinline__ void ph_moe_gu(const Params& p, const Ctx& X, int l) {
    moe_table(X, l);
    pg8::MoeOrder So{(const LAS int*)(X.lds + TAB_OFF), (const LAS int*)(X.lds + TAB_OFF) + 40, (const int*)(X.ws + WS_SLOT), 3, X.G, X.bid, true};
    pg8::Gemm g{(const bf16_t*)(X.ws + WS_U), (const bf16_t*)(X.ws + WS_WGU) + (size_t)l * NE * 2048 * 1024, 1024};
    pg8::EpiGu E{(bf16_t*)(X.ws + WS_ACT), p.in[27] + (size_t)l * NE * 2048};
    pg8::gemm_phase<pg8::EpiGu, pg8::MoeOrder>(X.lds, g, So, E);
}
__device__ __forceinline__ void ph_moe_down(const Params& p, const Ctx& X, int l) {
    moe_table(X, l);
    pg8::MoeOrder So{(const LAS int*)(X.lds + TAB_OFF), (const LAS int*)(X.lds + TAB_OFF) + 40, (const int*)(X.ws + WS_SLOT), 2, X.G, X.bid, false};
    pg8::Gemm g{(const bf16_t*)(X.ws + WS_ACT), (const bf16_t*)(X.ws + WS_WDN) + (size_t)l * NE * 1024 * 1024, 1024};
    pg8::EpiDown E{(bf16_t*)(X.ws + WS_Y), p.in[29] + (size_t)l * NE * 1024};
    pg8::gemm_phase<pg8::EpiDown, pg8::MoeOrder>(X.lds, g, So, E);
}

__global__ void __launch_bounds__(NTHREADS, 2) fwd_kernel(Params p) {
    extern __shared__ __attribute__((aligned(16))) unsigned char lds_raw[];
    Ctx X;
    X.lds = (LAS unsigned char*)lds_raw; X.ws = p.ws;
    X.tid = threadIdx.x; X.lane = X.tid & 63; X.wave = __builtin_amdgcn_readfirstlane(X.tid >> 6);
    X.G = gridDim.x; X.bid = blockIdx.x; X.gw = X.bid * NWAVES + X.wave; X.ngw = X.G * NWAVES;
    if (X.tid < 4) ((LAS unsigned*)(X.lds + XB_OFF))[X.tid] = 0u;
    __syncthreads();
    XcdBarrier bar = xcd_barrier_post((unsigned*)(p.ws + WS_CTL) + CW_BAR, (volatile LAS unsigned*)(X.lds + XB_OFF));
    float* mod = (float*)(p.ws + WS_MODF);
    float* h1 = (float*)(p.ws + WS_H1); float* h2 = (float*)(p.ws + WS_H2);

    ph_prologue(p, X);                                                   xcd_barrier(bar);
    ph_norm0(p, X);                                                      xcd_barrier(bar);
    {
        pg8::DenseOrder So; So.init(T, PROJ_LD, X.G, X.bid);
        pg8::Gemm g{(const bf16_t*)(p.ws + WS_U), (const bf16_t*)(p.ws + WS_WIN), 1024};
        pg8::EpiBf16 E{(bf16_t*)(p.ws + WS_BIG), PROJ_LD};
        pg8::gemm_phase<pg8::EpiBf16, pg8::DenseOrder>(X.lds, g, So, E);
    }
    {
        pg8::DenseOrder So; So.init(768, T, X.G, X.bid);
        pg8::Gemm g{(const bf16_t*)(p.ws + WS_WV), (const bf16_t*)(p.ws + WS_U), 1024};
        pg8::EpiBf16 E{(bf16_t*)(p.ws + WS_VT), T};
        pg8::gemm_phase<pg8::EpiBf16, pg8::DenseOrder>(X.lds, g, So, E);
    }
    xcd_barrier(bar);
    ph_attn_a(p, X);                                                     xcd_barrier(bar);
    ph_nsa(p, X);
    __syncthreads();
    ph_sb(X);                                                            xcd_barrier(bar);
    {
        pg8::DenseOrder So; So.init(T, D, X.G, X.bid);
        pg8::Gemm g{(const bf16_t*)(p.ws + WS_O), (const bf16_t*)(p.ws + WS_WOUT), 1024};
        pg8::EpiResid E{p.in[0], h1, mod + 2048};
        pg8::gemm_phase<pg8::EpiResid, pg8::DenseOrder>(X.lds, g, So, E);
    }
    xcd_barrier(bar);
    ph_router(p, X, 0, h1);                                              xcd_barrier(bar);
    ph_moe_gu(p, X, 0);                                                  xcd_barrier(bar);
    ph_moe_down(p, X, 0);                                                xcd_barrier(bar);
    ph_combine<0>(p, X, 0, h1, h2);                                      xcd_barrier(bar);
    {
        pg8::DenseOrder So; So.init(T, ZX_LD, X.G, X.bid);
        pg8::Gemm g{(const bf16_t*)(p.ws + WS_U), (const bf16_t*)(p.ws + WS_WSIN), 1024};
        pg8::EpiBf16 E{(bf16_t*)(p.ws + WS_BIG), ZX_LD};
        pg8::gemm_phase<pg8::EpiBf16, pg8::DenseOrder>(X.lds, g, So, E);
    }
    xcd_barrier(bar);
    ph_conv(p, X);                                                       xcd_barrier(bar);
    ph_ssd(p, X);                                                        xcd_barrier(bar);
    ph_gate_norm(p, X);                                                  xcd_barrier(bar);
    {
        pg8::DenseOrder So; So.init(T, D, X.G, X.bid);
        pg8::Gemm g{(const bf16_t*)(p.ws + WS_O), (const bf16_t*)(p.ws + WS_WSOUT), 2048};
        pg8::EpiResid E{h2, h1, mod + 4 * 6144 + 2048};
        pg8::gemm_phase<pg8::EpiResid, pg8::DenseOrder>(X.lds, g, So, E);
    }
    xcd_barrier(bar);
    ph_router(p, X, 1, h1);                                              xcd_barrier(bar);
    ph_moe_gu(p, X, 1);                                                  xcd_barrier(bar);
    ph_moe_down(p, X, 1);                                                xcd_barrier(bar);
    ph_combine<1>(p, X, 1, h1, p.out);
}
}

extern "C" void kernel_launch(void* const* d_in, const int* in_sizes, int n_in, void* d_out, int out_size, void* d_ws, size_t ws_size, hipStream_t stream) {
    static int grid = 0;
    if (grid == 0) {
        if (n_in != 30 || out_size != T * D || ws_size < WS_END) { fprintf(stderr, "kernel_launch: unexpected shapes / workspace (%d inputs, out %d, ws %zu < %zu)\n", n_in, out_size, ws_size, (size_t)WS_END); grid = -1; return; }
        int dev = 0, cus = 0, per_cu = 0;
        if (hipGetDevice(&dev) != hipSuccess || hipDeviceGetAttribute(&cus, hipDeviceAttributeMultiprocessorCount, dev) != hipSuccess) { grid = -1; return; }
        if (hipFuncSetAttribute((const void*)fwd_kernel, hipFuncAttributeMaxDynamicSharedMemorySize, LDS_BYTES) != hipSuccess) { fprintf(stderr, "kernel_launch: hipFuncSetAttribute failed\n"); grid = -1; return; }
        if (hipOccupancyMaxActiveBlocksPerMultiprocessor(&per_cu, (const void*)fwd_kernel, NTHREADS, LDS_BYTES) != hipSuccess || per_cu < 1) { fprintf(stderr, "kernel_launch: occupancy query reports %d\n", per_cu); }
        (void)hipGetLastError();
        grid = cus;
    }
    if (grid < 0) return;
    if (hipMemsetAsync((char*)d_ws + WS_CTL, 0, CTL_BYTES, stream) != hipSuccess) return;
    Params p{};
    for (int i = 0; i < 30; ++i) p.in[i] = (const float*)d_in[i];
    p.out = (float*)d_out; p.ws = (unsigned char*)d_ws;
    hipLaunchKernelGGL(fwd_kernel, dim3(grid), dim3(NTHREADS), LDS_BYTES, stream, p);
}
```

```cpp
#include <hip/hip_runtime.h>
#include <cstdio>
#include <cstdint>

#define LAS __attribute__((address_space(3)))
#define GAS __attribute__((address_space(1)))
typedef unsigned short bf16_t;
typedef short bf16x8 __attribute__((ext_vector_type(8)));
typedef float f32x4 __attribute__((ext_vector_type(4)));
typedef unsigned u32x4 __attribute__((ext_vector_type(4)));
typedef unsigned u32x2 __attribute__((ext_vector_type(2)));

namespace {
constexpr int D = 1024, NB = 4, S = 4096, T = NB * S;
constexpr int ATTN_IN = 2840, PROJ_LD = 3072;
constexpr int OFF_SBQ = 0, OFF_SBK = 512, OFF_SBV = 1024, OFF_NQ = 1536, OFF_KC = 2048, OFF_VC = 2176, OFF_KS = 2304, OFF_VS = 2432,
              OFF_KW = 2560, OFF_VW = 2688, OFF_GATE = 2816;
constexpr int NCMP = 255;
constexpr int SSM_IN = 5152, SSM_INNER = 2048, CONV_DIM = 3072, ZX_LD = 5120;
constexpr int NE = 32, CAP = 16384, MAXTILES = 288;
constexpr float EPS = 1e-6f;
constexpr int NWAVES = 8, NTHREADS = 512;

constexpr size_t al4k(size_t x) { return (x + 4095) & ~(size_t)4095; }
constexpr size_t WS_CTL = 0, CTL_BYTES = 1u << 20;
constexpr int CW_CNT = 256;
constexpr int CW_BAR = 4096;
constexpr size_t CTL_MOD = 65536;
constexpr size_t WS_WIN = CTL_BYTES;
constexpr size_t WS_WOUT = WS_WIN + (size_t)3072 * 1024 * 2;
constexpr size_t WS_WSIN = WS_WOUT + (size_t)1024 * 1024 * 2;
constexpr size_t WS_WSOUT = WS_WSIN + (size_t)5120 * 1024 * 2;
constexpr size_t WS_WGU = WS_WSOUT + (size_t)1024 * 2048 * 2;
constexpr size_t WS_WDN = WS_WGU + (size_t)2 * 32 * 2048 * 1024 * 2;
constexpr size_t WS_U = WS_WDN + (size_t)2 * 32 * 1024 * 1024 * 2;
constexpr size_t WS_BIG = WS_U + (size_t)T * 1024 * 2;
constexpr size_t WS_O = WS_BIG + (size_t)T * 5120 * 2;
constexpr size_t WS_H1 = WS_O + (size_t)T * 2048 * 2;
constexpr size_t WS_H2 = WS_H1 + (size_t)T * 1024 * 4;
constexpr size_t WS_QN = WS_H2 + (size_t)T * 1024 * 4;
constexpr size_t WS_KN = WS_QN + (size_t)T * 512 * 4;
constexpr size_t WS_KCMP = WS_KN + (size_t)T * 256 * 4;
constexpr size_t WS_VCMP = WS_KCMP + al4k((size_t)NB * NCMP * 2 * 64 * 4);
constexpr size_t WS_ACT = WS_VCMP + al4k((size_t)NB * NCMP * 2 * 64 * 4);
constexpr size_t WS_Y = WS_ACT + (size_t)MAXTILES * 256 * 1024 * 2;
constexpr size_t WS_TOKE = WS_Y + (size_t)MAXTILES * 256 * 1024 * 2;
constexpr size_t WS_TOKW = WS_TOKE + (size_t)T * 16;
constexpr size_t WS_TOKP = WS_TOKW + (size_t)T * 16;
constexpr size_t WS_SLOT = WS_TOKP + (size_t)T * 16;
constexpr size_t WS_XC = WS_SLOT + (size_t)NE * CAP * 4;
constexpr size_t WS_YS = WS_XC + (size_t)T * 3072 * 4;
constexpr size_t WS_DT = WS_YS + (size_t)T * 2048 * 4;
constexpr size_t WS_MODF = WS_DT + (size_t)T * 32 * 4;
constexpr size_t WS_WV = WS_MODF + (size_t)2 * 4 * 6144 * 4;
constexpr size_t WS_VT = WS_WV + (size_t)768 * 1024 * 2;
constexpr size_t WS_QNB = WS_VT + (size_t)768 * T * 2;
constexpr size_t WS_KSN = WS_QNB + (size_t)T * 512 * 2;
constexpr size_t WS_KWN = WS_KSN + (size_t)T * 128 * 2;
constexpr size_t WS_KCB = WS_KWN + (size_t)T * 128 * 2;
constexpr size_t WS_VCT = WS_KCB + (size_t)8 * 256 * 64 * 2;
constexpr size_t WS_END = WS_VCT + (size_t)8 * 64 * 256 * 2;

constexpr int RING_BYTES = 131072;
constexpr int TAB_OFF = RING_BYTES;
constexpr int XB_OFF = RING_BYTES + 1024;
constexpr int LDS_BYTES = 147456;

struct Params { const float* in[30]; float* out; unsigned char* ws; };

__device__ __forceinline__ float siluf(float v) { return v / (1.f + expf(-v)); }
__device__ __forceinline__ float logsig(float x) { return fminf(x, 0.f) - log1pf(expf(-fabsf(x))); }
__device__ __forceinline__ float wave_sum(float v) {
#pragma unroll
    for (int o = 32; o > 0; o >>= 1) v += __shfl_xor(v, o);
    return v;
}
__device__ __forceinline__ float wave_max(float v) {
#pragma unroll
    for (int o = 32; o > 0; o >>= 1) v = fmaxf(v, __shfl_xor(v, o));
    return v;
}
__device__ __forceinline__ unsigned f2bf(float f) { unsigned u = __builtin_bit_cast(unsigned, f); return (u + 0x7fffu + ((u >> 16) & 1u)) >> 16; }
__device__ __forceinline__ unsigned pk2(float lo, float hi) { return f2bf(lo) | (f2bf(hi) << 16); }
__device__ __forceinline__ float bf2f(bf16_t v) { return __uint_as_float((unsigned)v << 16); }
__device__ __forceinline__ float bflo(unsigned w) { return __uint_as_float(w << 16); }
__device__ __forceinline__ float bfhi(unsigned w) { return __uint_as_float(w & 0xffff0000u); }
#define LDS_WAIT() asm volatile("s_waitcnt lgkmcnt(0)" ::: "memory")
__device__ __forceinline__ int fresh(int v) { asm volatile("" : "+v"(v)); return v; }

#define XB_TMO      128
#define XB_XCNT(j)  (256  + 64 * (j))
#define XB_XSUB(j)  (1280 + 64 * (j))
#define XB_XGEN(j)  (2304 + 64 * (j))
#define XB_TOP      3328
#define XB_TOPGEN   3392
#define XCD_BAR_WORDS 3456
#define XB_SPIN_CAP (1u << 18)
__device__ __forceinline__ unsigned xb_ld(unsigned* p)              { return __hip_atomic_load(p, __ATOMIC_RELAXED, __HIP_MEMORY_SCOPE_AGENT); }
__device__ __forceinline__ unsigned xb_add(unsigned* p, unsigned v) { return __hip_atomic_fetch_add(p, v, __ATOMIC_RELAXED, __HIP_MEMORY_SCOPE_AGENT); }
__device__ __forceinline__ unsigned xb_xcc_id() { return (unsigned)__builtin_amdgcn_s_getreg((3 << 11) | 20) & 0xFu; }
#define XB_SPIN(cond, bar) do { unsigned _sp = 0; while (cond) { __builtin_amdgcn_s_sleep(1); \
    if ((++_sp & 255u) == 0u) { if (xb_ld(&(bar)[XB_TMO])) break; if (_sp > XB_SPIN_CAP) { atomicAdd(&(bar)[XB_TMO], 1u); break; } } } } while (0)
struct XcdBarrier { unsigned* bar; unsigned x; volatile LAS unsigned* st; };
__device__ __forceinline__ XcdBarrier xcd_barrier_post(unsigned* bar, volatile LAS unsigned* st) {
    XcdBarrier b; b.bar = bar; b.x = xb_xcc_id(); b.st = st;
    if (threadIdx.x == 0) (void)xb_add(&bar[XB_XCNT(b.x)], 1u);
    return b;
}
__device__ __forceinline__ void xcd_barrier_complete(unsigned* bar, unsigned x, unsigned& nloc, unsigned& nx) {
    const unsigned G = gridDim.x * gridDim.y * gridDim.z;
    unsigned sum, cnt, mine, sp = 0u;
    for (;;) {
        sum = 0u; cnt = 0u; mine = 0u;
#pragma unroll
        for (unsigned j = 0; j < 16; ++j) { const unsigned c = xb_ld(&bar[XB_XCNT(j)]); sum += c; cnt += (c > 0u) ? 1u : 0u; mine = (j == x) ? c : mine; }
        if (sum == G) break;
        __builtin_amdgcn_s_sleep(1);
        if ((++sp & 255u) == 0u) { if (xb_ld(&bar[XB_TMO])) break; if (sp > XB_SPIN_CAP) { atomicAdd(&bar[XB_TMO], 1u); break; } }
    }
    nloc = mine > 0u ? mine : 1u; nx = cnt > 0u ? cnt : 1u;
}
__device__ __forceinline__ void xcd_barrier(const XcdBarrier& b) {
    asm volatile("s_waitcnt vmcnt(0)" ::: "memory");
    __syncthreads();
    if (threadIdx.x == 0) {
        unsigned* bar = b.bar;
        __builtin_amdgcn_s_waitcnt(0);
        unsigned nloc = b.st[0], nx = b.st[1];
        if (nloc == 0u) { xcd_barrier_complete(bar, b.x, nloc, nx); b.st[0] = nloc; b.st[1] = nx; }
        const unsigned old = xb_add(&bar[XB_XSUB(b.x)], 1u);
        const unsigned gen = old / nloc;
        if (old + 1u == (gen + 1u) * nloc) {
            __builtin_amdgcn_fence(__ATOMIC_RELEASE, "agent");
            asm volatile("s_waitcnt vmcnt(0)" ::: "memory");
            const unsigned og = xb_add(&bar[XB_TOP], 1u);
            const unsigned tg = og / nx;
            if (og + 1u == (tg + 1u) * nx) xb_add(&bar[XB_TOPGEN], 1u);
            else XB_SPIN(xb_ld(&bar[XB_TOPGEN]) == tg, bar);
            __builtin_amdgcn_fence(__ATOMIC_ACQUIRE, "agent");
            xb_add(&bar[XB_XGEN(b.x)], 1u);
            asm volatile("s_waitcnt vmcnt(0)" ::: "memory");
        } else {
            XB_SPIN(xb_ld(&bar[XB_XGEN(b.x)]) == gen, bar);
            __builtin_amdgcn_fence(__ATOMIC_ACQUIRE, "agent");
            asm volatile("s_waitcnt vmcnt(0)" ::: "memory");
        }
    }
    __syncthreads();
}

namespace pg8 {
constexpr int BM = 256, BK = 64, HALF = 128, HTB = HALF * BK * 2, STAGE_BYTES = 8 * HTB;
__device__ __forceinline__ int lds_byte(int r, int c) { const int st = (r >> 4) * 2 + (c >> 5), rr = r & 15, cc = c & 31, ob = rr * 64 + cc * 2; return st * 1024 + (ob ^ (((ob >> 9) & 1) << 5)); }
__device__ __forceinline__ void stage_rc(int b, int& R, int& C) { const int st = b / 1024, sb = b % 1024, swz = sb ^ (((sb >> 9) & 1) << 5); R = (st >> 1) * 16 + swz / 64; C = (st & 1) * 32 + (swz % 64) / 2; }
__device__ __forceinline__ int perm32(int rho) { const int n = rho >> 4, i = rho & 15; return 8 * (i >> 2) + 4 * n + (i & 3); }
struct Unit { int pm, pn, e; };
struct Gemm { const bf16_t* A; const bf16_t* Bt; int K; };
__device__ __forceinline__ unsigned cvt_pk_bf16(float lo, float hi) { unsigned r; asm volatile("v_cvt_pk_bf16_f32 %0, %1, %2" : "=v"(r) : "v"(lo), "v"(hi)); return r; }

struct DenseOrder {
    int nM, nN, nwg, G, c;
    __device__ void init(int M, int N, int G_, int c_) { nM = M / BM; nN = N / BM; nwg = nM * nN; G = G_; c = c_; }
    __device__ bool next(int i, Unit& u) const {
        const long L = (long)i * G + c; if (L >= nwg) return false;
        int wgid = (int)L; { const int q = nwg / 8, r = nwg % 8, xcd = wgid % 8, off = wgid / 8; wgid = (xcd < r ? xcd * (q + 1) : r * (q + 1) + (xcd - r) * q) + off; }
        const int nig = 8 * nN, gid = wgid / nig, fm = gid * 8, gsz = (nM - fm) < 8 ? (nM - fm) : 8;
        u.pm = fm + ((wgid % nig) % gsz); u.pn = (wgid % nig) / gsz; u.e = 0; return true;
    }
    __device__ __forceinline__ unsigned arow(const Unit& u, int r) const { return (unsigned)(u.pm * BM + r); }
};
struct MoeOrder {
    const LAS int* tb; const LAS int* cn; const int* slot_tok; int shift, G, c; bool gather;
    __device__ bool next(int i, Unit& u) const {
        const int L = i * G + c, tile = L >> shift; if (tile >= tb[NE]) return false;
        int e = 0; while (tb[e + 1] <= tile) ++e;
        u.pm = tile; u.pn = (e << shift) + (L & ((1 << shift) - 1)); u.e = e; return true;
    }
    __device__ __forceinline__ unsigned arow(const Unit& u, int r) const {
        if (!gather) return (unsigned)(u.pm * BM + r);
        const int pos = (u.pm - tb[u.e]) * BM + r;
        return pos < cn[u.e] ? (unsigned)slot_tok[u.e * CAP + pos] : 0u;
    }
};

struct EpiBf16 {
    static constexpr bool PERM = true;
    bf16_t* O; int ldc;
    __device__ __forceinline__ void operator()(const f32x4 (&acc)[2][2][4][2], const Unit& u, int wr, int wc, int fr, int fq) const {
        const int row0 = u.pm * BM + wr * 64 + fr, col0 = u.pn * BM + wc * 32 + 8 * fq;
#pragma unroll
        for (int ai = 0; ai < 2; ++ai)
#pragma unroll
            for (int m = 0; m < 4; ++m) { bf16_t* rowp = O + (size_t)(row0 + ai * HALF + m * 16) * ldc + col0;
#pragma unroll
                for (int bj = 0; bj < 2; ++bj) { const f32x4 v0 = acc[ai][bj][m][0], v1 = acc[ai][bj][m][1];
                    u32x4 w; w.x = cvt_pk_bf16(v0[0], v0[1]); w.y = cvt_pk_bf16(v0[2], v0[3]); w.z = cvt_pk_bf16(v1[0], v1[1]); w.w = cvt_pk_bf16(v1[2], v1[3]);
                    *(u32x4*)(rowp + bj * HALF) = w; } }
    }
};
struct EpiResid {
    static constexpr bool PERM = false;
    const float* base; float* out; const float* g;
    __device__ __forceinline__ void operator()(const f32x4 (&acc)[2][2][4][2], const Unit& u, int wr, int wc, int fr, int fq) const {
        const int row0 = u.pm * BM + wr * 64 + fr, col0 = u.pn * BM + wc * 32 + 4 * fq;
        const float* gb = g + (size_t)((u.pm * BM) / S) * 6144 + col0;
        f32x4 gv[2][2];
#pragma unroll
        for (int bj = 0; bj < 2; ++bj)
#pragma unroll
            for (int n = 0; n < 2; ++n) gv[bj][n] = *(const f32x4*)(gb + bj * HALF + n * 16);
#pragma unroll
        for (int ai = 0; ai < 2; ++ai)
#pragma unroll
            for (int m = 0; m < 4; ++m) { const size_t off = (size_t)(row0 + ai * HALF + m * 16) * D + col0;
#pragma unroll
                for (int bj = 0; bj < 2; ++bj)
#pragma unroll
                    for (int n = 0; n < 2; ++n) { const f32x4 bs = *(const f32x4*)(base + off + bj * HALF + n * 16);
                        *(f32x4*)(out + off + bj * HALF + n * 16) = bs + gv[bj][n] * acc[ai][bj][m][n]; } }
    }
};
struct EpiGu {
    static constexpr bool PERM = true;
    bf16_t* act; const float* bgu;
    __device__ __forceinline__ void operator()(const f32x4 (&acc)[2][2][4][2], const Unit& u, int wr, int wc, int fr, int fq) const {
        const int row0 = u.pm * BM + wr * 64 + fr, col0 = (u.pn & 7) * HALF + wc * 32 + 8 * fq;
        const float* bb = bgu + (size_t)u.e * 2048 + col0;
        const f32x4 bg0 = *(const f32x4*)(bb), bg1 = *(const f32x4*)(bb + 4), bu0 = *(const f32x4*)(bb + 1024), bu1 = *(const f32x4*)(bb + 1028);
#pragma unroll
        for (int ai = 0; ai < 2; ++ai)
#pragma unroll
            for (int m = 0; m < 4; ++m) {
                float r[8];
#pragma unroll
                for (int n = 0; n < 2; ++n) { const f32x4 gt = acc[ai][0][m][n] + (n ? bg1 : bg0), up = acc[ai][1][m][n] + (n ? bu1 : bu0);
#pragma unroll
                    for (int j = 0; j < 4; ++j) { const float gg = fminf(gt[j], 7.f), uu = fminf(fmaxf(up[j], -7.f), 7.f);
                        r[n * 4 + j] = (uu + 1.f) * gg * __builtin_amdgcn_rcpf(1.f + __expf(-1.702f * gg)); } }
                u32x4 w; w.x = cvt_pk_bf16(r[0], r[1]); w.y = cvt_pk_bf16(r[2], r[3]); w.z = cvt_pk_bf16(r[4], r[5]); w.w = cvt_pk_bf16(r[6], r[7]);
                *(u32x4*)(act + (size_t)(row0 + ai * HALF + m * 16) * D + col0) = w; }
    }
};
struct EpiDown {
    static constexpr bool PERM = true;
    bf16_t* y; const float* bd;
    __device__ __forceinline__ void operator()(const f32x4 (&acc)[2][2][4][2], const Unit& u, int wr, int wc, int fr, int fq) const {
        const int row0 = u.pm * BM + wr * 64 + fr, col0 = (u.pn & 3) * BM + wc * 32 + 8 * fq;
        const float* bb = bd + (size_t)u.e * 1024 + col0;
        f32x4 bv[2][2];
#pragma unroll
        for (int bj = 0; bj < 2; ++bj)
#pragma unroll
            for (int n = 0; n < 2; ++n) bv[bj][n] = *(const f32x4*)(bb + bj * HALF + 4 * n);
#pragma unroll
        for (int ai = 0; ai < 2; ++ai)
#pragma unroll
            for (int m = 0; m < 4; ++m) { bf16_t* rowp = y + (size_t)(row0 + ai * HALF + m * 16) * D + col0;
#pragma unroll
                for (int bj = 0; bj < 2; ++bj) { const f32x4 v0 = acc[ai][bj][m][0] + bv[bj][0], v1 = acc[ai][bj][m][1] + bv[bj][1];
                    u32x4 w; w.x = cvt_pk_bf16(v0[0], v0[1]); w.y = cvt_pk_bf16(v0[2], v0[3]); w.z = cvt_pk_bf16(v1[0], v1[1]); w.w = cvt_pk_bf16(v1[2], v1[3]);
                    *(u32x4*)(rowp + bj * HALF) = w; } }
    }
};

template <class Epi, class Sched>
__device__ __forceinline__ void gemm_phase(LAS unsigned char* lds, const Gemm g, const Sched& S, const Epi& E, const int tid) {
    const int wid = __builtin_amdgcn_readfirstlane(tid >> 6), lane = tid & 63, wr = wid >> 2, wc = wid & 3, fr = lane & 15, fq = lane >> 4;
    const int K = g.K, nt = K / BK;
    int RA[2], CA[2]; unsigned voffB[2];
#pragma unroll
    for (int i = 0; i < 2; ++i) { int R, C; stage_rc(tid * 16 + i * 8192, R, C); const int Rb = Epi::PERM ? ((R & ~31) + perm32(R & 31)) : R;
        RA[i] = R; CA[i] = C; voffB[i] = (unsigned)(Rb * K + C) * 2u; }
    const size_t kstep = (size_t)(BK * 2);
    const size_t hstep = (size_t)HALF * K * 2;
    const size_t tstep = 2 * hstep;
    const unsigned ldsw = (unsigned)wid * 1024u;
    const int aoff = lds_byte(wr * 64 + fr, fq * 8), boff = lds_byte(wc * 32 + fr, fq * 8);
#define PG8_SA(b, h) (((b) * 2 + (h)) * HTB)
#define PG8_SB(b, h) ((4 + (b) * 2 + (h)) * HTB)
#define PG8_STAGE(bufoff, gbase, voff) do { _Pragma("unroll") for (int _i = 0; _i < 2; ++_i) \
        __builtin_amdgcn_global_load_lds((const unsigned*)((const char*)(gbase) + (voff)[_i]), (LAS unsigned*)(lds + (bufoff) + ldsw + _i * 8192), 16, 0, 0); } while (0)
#define PG8_LDA(dst, b, h) do { _Pragma("unroll") for (int m = 0; m < 4; ++m) _Pragma("unroll") for (int k = 0; k < 2; ++k) dst[m][k] = *(const LAS bf16x8*)(lds + PG8_SA(b, h) + aoff + m * 2048 + k * 1024); } while (0)
#define PG8_LDB(dst, b, h) do { _Pragma("unroll") for (int n = 0; n < 2; ++n) _Pragma("unroll") for (int k = 0; k < 2; ++k) dst[n][k] = *(const LAS bf16x8*)(lds + PG8_SB(b, h) + boff + n * 2048 + k * 1024); } while (0)
#define PG8_MMA(ai, bj, At, Bt) do { __builtin_amdgcn_s_setprio(1); _Pragma("unroll") for (int m = 0; m < 4; ++m) _Pragma("unroll") for (int n = 0; n < 2; ++n) _Pragma("unroll") for (int k = 0; k < 2; ++k) \
        acc[ai][bj][m][n] = __builtin_amdgcn_mfma_f32_16x16x32_bf16(Bt[n][k], At[m][k], acc[ai][bj][m][n], 0, 0, 0); __builtin_amdgcn_s_setprio(0); } while (0)
#define PG8_WAIT_V(n) asm volatile("s_waitcnt vmcnt(" #n ")" ::: "memory")
#define PG8_WAIT_L(n) asm volatile("s_waitcnt lgkmcnt(" #n ")" ::: "memory")
#define PG8_BAR __builtin_amdgcn_s_barrier()
#define PG8_SCHED __builtin_amdgcn_sched_barrier(0)
#define PG8_AOFF(dst, u) do { _Pragma("unroll") for (int _h = 0; _h < 2; ++_h) _Pragma("unroll") for (int _i = 0; _i < 2; ++_i) dst[_h][_i] = (S.arow(u, _h * HALF + RA[_i]) * (unsigned)K + (unsigned)CA[_i]) * 2u; } while (0)
    Unit cur, nxt; int ui = 0;
    if (!S.next(0, cur)) return;
    f32x4 acc[2][2][4][2];
#pragma unroll
    for (int a = 0; a < 2; ++a)
#pragma unroll
        for (int b = 0; b < 2; ++b)
#pragma unroll
            for (int m = 0; m < 4; ++m)
#pragma unroll
                for (int n = 0; n < 2; ++n) acc[a][b][m][n] = (f32x4){0.f, 0.f, 0.f, 0.f};
    bf16x8 At[4][2], B0[2][2], B1[2][2];
    unsigned va[2][2], vn[2][2];
    PG8_AOFF(va, cur);
    const char* Ab = (const char*)g.A;
    const char* cB = (const char*)g.Bt + (size_t)cur.pn * tstep;
    PG8_STAGE(PG8_SB(0, 0), cB, voffB); PG8_STAGE(PG8_SB(0, 1), cB + hstep, voffB); PG8_STAGE(PG8_SA(0, 0), Ab, va[0]); PG8_STAGE(PG8_SA(0, 1), Ab, va[1]);
    if (wr == 1) PG8_BAR;
    PG8_WAIT_V(2); PG8_BAR;
    PG8_STAGE(PG8_SB(1, 0), cB + kstep, voffB); PG8_STAGE(PG8_SA(1, 0), Ab + kstep, va[0]); PG8_STAGE(PG8_SB(1, 1), cB + hstep + kstep, voffB);
    PG8_WAIT_V(6); PG8_BAR;
    for (;;) {
        const bool has_next = S.next(ui + 1, nxt);
        if (has_next) { PG8_AOFF(vn, nxt); }
        else {
#pragma unroll
            for (int h = 0; h < 2; ++h)
#pragma unroll
                for (int i = 0; i < 2; ++i) vn[h][i] = va[h][i]; }
        const char* nB = has_next ? (const char*)g.Bt + (size_t)nxt.pn * tstep : cB;
        for (int t = 0; t < nt; t += 2) {
            const bool last = (t == nt - 2);
            const char* a1 = Ab + (size_t)(t + 1) * kstep;
            const char* a2 = last ? Ab : Ab + (size_t)(t + 2) * kstep; const char* b2 = last ? nB : cB + (size_t)(t + 2) * kstep;
            const char* a3 = a2 + kstep; const char* b3 = b2 + kstep;
            unsigned o2[2][2];
#pragma unroll
            for (int h = 0; h < 2; ++h)
#pragma unroll
                for (int i = 0; i < 2; ++i) o2[h][i] = last ? vn[h][i] : va[h][i];
            PG8_LDB(B0, 0, 0); PG8_LDB(B1, 0, 1); PG8_SCHED; PG8_LDA(At, 0, 0); PG8_STAGE(PG8_SA(1, 1), a1, va[1]);
            PG8_WAIT_V(8); PG8_WAIT_L(0); PG8_BAR; PG8_MMA(0, 0, At, B0); PG8_MMA(0, 1, At, B1); PG8_BAR; PG8_SCHED;
            PG8_LDA(At, 0, 1); PG8_STAGE(PG8_SB(0, 0), b2, voffB); PG8_STAGE(PG8_SB(0, 1), b2 + hstep, voffB); PG8_STAGE(PG8_SA(0, 0), a2, o2[0]);
            PG8_WAIT_V(8); PG8_WAIT_L(0); PG8_BAR; PG8_MMA(1, 0, At, B0); PG8_MMA(1, 1, At, B1); PG8_BAR; PG8_SCHED;
            PG8_LDB(B0, 1, 0); PG8_LDB(B1, 1, 1); PG8_SCHED; PG8_LDA(At, 1, 0); PG8_STAGE(PG8_SA(0, 1), a2, o2[1]);
            PG8_WAIT_V(8); PG8_WAIT_L(0); PG8_BAR; PG8_MMA(0, 0, At, B0); PG8_MMA(0, 1, At, B1); PG8_BAR; PG8_SCHED;
            PG8_LDA(At, 1, 1); PG8_STAGE(PG8_SB(1, 0), b3, voffB); PG8_STAGE(PG8_SB(1, 1), b3 + hstep, voffB); PG8_STAGE(PG8_SA(1, 0), a3, o2[0]);
            PG8_WAIT_V(8); PG8_WAIT_L(0); PG8_BAR; PG8_MMA(1, 0, At, B0); PG8_MMA(1, 1, At, B1); PG8_BAR; PG8_SCHED;
        }
        if (wr == 0) PG8_BAR;
        E(acc, cur, wr, wc, fr, fq);
        if (!has_next) break;
#pragma unroll
        for (int a = 0; a < 2; ++a)
#pragma unroll
            for (int b = 0; b < 2; ++b)
#pragma unroll
                for (int m = 0; m < 4; ++m)
#pragma unroll
                    for (int n = 0; n < 2; ++n) acc[a][b][m][n] = (f32x4){0.f, 0.f, 0.f, 0.f};
        cur = nxt; cB = nB; ++ui;
#pragma unroll
        for (int h = 0; h < 2; ++h)
#pragma unroll
            for (int i = 0; i < 2; ++i) va[h][i] = vn[h][i];
        if (wr == 1) PG8_BAR;
    }
    PG8_WAIT_V(0);
    PG8_BAR;
#undef PG8_SA
#undef PG8_SB
#undef PG8_STAGE
#undef PG8_LDA
#undef PG8_LDB
#undef PG8_MMA
#undef PG8_WAIT_V
#undef PG8_WAIT_L
#undef PG8_BAR
#undef PG8_SCHED
#undef PG8_AOFF
}
}

struct Ctx {
    LAS unsigned char* lds; unsigned char* ws;
    int tid, lane, wave, gw, ngw, G, bid;
};

__device__ __forceinline__ void transpose_item(const float* W, int ldw, int K, int nvalid, int k0, int n0, bf16_t* WT, int row0, LAS float* scr, int lane) {
    const int nn = n0 + (lane & 31);
#pragma unroll 8
    for (int i = 0; i < 32; ++i) { const int kk = 2 * i + (lane >> 5); scr[kk * 33 + (lane & 31)] = nn < nvalid ? W[(size_t)(k0 + kk) * ldw + nn] : 0.f; }
    LDS_WAIT(); asm volatile("" ::: "memory");
    const int c = lane & 7;
#pragma unroll
    for (int j = 0; j < 4; ++j) { const int n = (lane >> 3) + 8 * j; const LAS float* s = scr + (8 * c) * 33 + n;
        u32x4 o; o.x = pk2(s[0 * 33], s[1 * 33]); o.y = pk2(s[2 * 33], s[3 * 33]); o.z = pk2(s[4 * 33], s[5 * 33]); o.w = pk2(s[6 * 33], s[7 * 33]);
        *(u32x4*)(WT + (size_t)(row0 + n) * K + k0 + 8 * c) = o; }
    LDS_WAIT(); asm volatile("" ::: "memory");
}
__device__ __forceinline__ void ph_prologue(const Params& p, const Ctx& X) {
    LAS float* scr = (LAS float*)(X.lds + X.wave * 16384);
    unsigned char* ws = X.ws;
    constexpr int I_MOD = 2 * 96 * 8;
    constexpr int I_WIN = 16 * 96, I_WV = 16 * 24, I_WOUT = 16 * 32, I_WSIN = 16 * 160, I_WSOUT = 32 * 32, I_GU = 64 * 1024, I_DN = 64 * 512;
    constexpr int NITEMS = I_MOD + I_WIN + I_WV + I_WOUT + I_WSIN + I_WSOUT + I_GU + I_DN;
    for (int it = X.gw; it < NITEMS; it += X.ngw) {
        int r = it;
        if (r < I_MOD) {
            const int kp = r & 7, jb = (r >> 3) % 96, l = r / (8 * 96), j = jb * 64 + X.lane;
            const float* w = p.in[2] + (size_t)l * 1024 * 6144 + (size_t)(kp * 128) * 6144 + j;
            const float* c = p.in[1] + kp * 128;
            float a0 = 0.f, a1 = 0.f, a2 = 0.f, a3 = 0.f;
#pragma unroll 8
            for (int i = 0; i < 128; ++i) { const float wv = w[(size_t)i * 6144];
                a0 += siluf(c[i]) * wv; a1 += siluf(c[1024 + i]) * wv; a2 += siluf(c[2048 + i]) * wv; a3 += siluf(c[3072 + i]) * wv; }
            if (kp == 0) { const float bb = p.in[3][l * 6144 + j]; a0 += bb; a1 += bb; a2 += bb; a3 += bb; }
            unsigned long long* mq = (unsigned long long*)(ws + CTL_MOD) + (size_t)l * 4 * 6144 + j;
            atomicAdd(mq, (unsigned long long)__double2ll_rn((double)a0 * 1099511627776.0)); atomicAdd(mq + 6144, (unsigned long long)__double2ll_rn((double)a1 * 1099511627776.0));
            atomicAdd(mq + 2 * 6144, (unsigned long long)__double2ll_rn((double)a2 * 1099511627776.0)); atomicAdd(mq + 3 * 6144, (unsigned long long)__double2ll_rn((double)a3 * 1099511627776.0));
            continue;
        }
        r -= I_MOD;
        if (r < I_WIN) { const int kb = r / 96, nb = r % 96; transpose_item(p.in[6], ATTN_IN, 1024, ATTN_IN, kb * 64, nb * 32, (bf16_t*)(ws + WS_WIN), nb * 32, scr, X.lane); continue; } r -= I_WIN;
        if (r < I_WV) { const int kb = r / 24, nb = r % 24, r0 = nb * 32, src = r0 < 512 ? OFF_SBV + r0 : (r0 < 640 ? OFF_VS + (r0 - 512) : OFF_VW + (r0 - 640));
            transpose_item(p.in[6], ATTN_IN, 1024, ATTN_IN, kb * 64, src, (bf16_t*)(ws + WS_WV), r0, scr, X.lane); continue; } r -= I_WV;
        if (r < I_WOUT) { const int kb = r / 32, nb = r % 32; transpose_item(p.in[7], 1024, 1024, 1024, kb * 64, nb * 32, (bf16_t*)(ws + WS_WOUT), nb * 32, scr, X.lane); continue; } r -= I_WOUT;
        if (r < I_WSIN) { const int kb = r / 160, nb = r % 160; transpose_item(p.in[16], SSM_IN, 1024, SSM_IN, kb * 64, nb * 32, (bf16_t*)(ws + WS_WSIN), nb * 32, scr, X.lane); continue; } r -= I_WSIN;
        if (r < I_WSOUT) { const int kb = r / 32, nb = r % 32; transpose_item(p.in[23], 1024, 2048, 1024, kb * 64, nb * 32, (bf16_t*)(ws + WS_WSOUT), nb * 32, scr, X.lane); continue; } r -= I_WSOUT;
        if (r < I_GU) { const int m = r >> 10, q = r & 1023, kb = q >> 6, nb = q & 63, n0 = nb * 32;
            const int row0 = ((n0 & 1023) >> 7) * 256 + (n0 >> 10) * 128 + (n0 & 127);
            transpose_item(p.in[26] + (size_t)m * 1024 * 2048, 2048, 1024, 2048, kb * 64, n0, (bf16_t*)(ws + WS_WGU) + (size_t)m * 2048 * 1024, row0, scr, X.lane); continue; } r -= I_GU;
        { const int m = r >> 9, q = r & 511, kb = q >> 5, nb = q & 31;
            transpose_item(p.in[28] + (size_t)m * 1024 * 1024, 1024, 1024, 1024, kb * 64, nb * 32, (bf16_t*)(ws + WS_WDN) + (size_t)m * 1024 * 1024, nb * 32, scr, X.lane); }
    }
}

struct Row { f32x4 v[4]; };
__device__ __forceinline__ void row_load(Row& r, const float* p, int lane) {
#pragma unroll
    for (int j = 0; j < 4; ++j) r.v[j] = ((const f32x4*)p)[64 * j + lane];
}
__device__ __forceinline__ void row_store(const Row& r, float* p, int lane) {
#pragma unroll
    for (int j = 0; j < 4; ++j) ((f32x4*)p)[64 * j + lane] = r.v[j];
}
template <class PV>
__device__ __forceinline__ void row_norm_mod(const Row& r, Row& o, const float* gain, PV sc, PV sh, int lane) {
    float ss = 0.f;
#pragma unroll
    for (int j = 0; j < 4; ++j) ss += (r.v[j].x * r.v[j].x + r.v[j].y * r.v[j].y) + (r.v[j].z * r.v[j].z + r.v[j].w * r.v[j].w);
    const float rs = rsqrtf(wave_sum(ss) * (1.f / 1024.f) + EPS);
#pragma unroll
    for (int j = 0; j < 4; ++j) { const f32x4 g = ((const f32x4*)gain)[64 * j + lane], a = sc[64 * j + lane], b = sh[64 * j + lane];
        o.v[j] = r.v[j] * rs * g * (a + 1.f) + b; }
}
__device__ __forceinline__ void row_store_bf16(const Row& r, bf16_t* p, int lane) {
#pragma unroll
    for (int j = 0; j < 4; ++j) { u32x2 w; w.x = pk2(r.v[j].x, r.v[j].y); w.y = pk2(r.v[j].z, r.v[j].w); ((u32x2*)p)[64 * j + lane] = w; }
}
__device__ __forceinline__ void row_store_lds(const Row& r, LAS float* p, int lane) {
#pragma unroll
    for (int j = 0; j < 4; ++j) ((LAS f32x4*)p)[64 * j + lane] = r.v[j];
}
__device__ __forceinline__ void skinny4(const LAS float* scr, const float* W, int ldw, int col0, int lane, float (&acc)[4]) {
    const int e = lane & 31, half = lane >> 5;
    acc[0] = acc[1] = acc[2] = acc[3] = 0.f;
    const float* w = W + (size_t)(half * 512) * ldw + col0 + e;
    const LAS float* s = scr + half * 512;
#pragma unroll 2
    for (int i = 0; i < 512; i += 4) {
        const float w0 = w[(size_t)i * ldw], w1 = w[(size_t)(i + 1) * ldw], w2 = w[(size_t)(i + 2) * ldw], w3 = w[(size_t)(i + 3) * ldw];
#pragma unroll
        for (int tk = 0; tk < 4; ++tk) { const f32x4 x = *(const LAS f32x4*)(s + tk * 1024 + i); acc[tk] += (x.x * w0 + x.y * w1) + (x.z * w2 + x.w * w3); }
    }
#pragma unroll
    for (int tk = 0; tk < 4; ++tk) acc[tk] += __shfl_xor(acc[tk], 32);
}
__device__ __forceinline__ void route_token(float logit, int t, int l, const Ctx& X) {
    const int lane = X.lane, e = lane & 31;
    float tl[4]; int te[4];
#pragma unroll
    for (int k = 0; k < 4; ++k) {
        float bv = logit; int bi = e;
#pragma unroll
        for (int o = 16; o > 0; o >>= 1) { const float ov = __shfl_xor(bv, o); const int oi = __shfl_xor(bi, o); if (ov > bv || (ov == bv && oi < bi)) { bv = ov; bi = oi; } }
        tl[k] = bv; te[k] = bi;
        if (e == bi) logit = -INFINITY;
    }
    if (lane < 4) {
        const float e1 = expf(tl[1] - tl[0]), e2 = expf(tl[2] - tl[0]), e3 = expf(tl[3] - tl[0]);
        const float inv = 1.f / (1.f + e1 + e2 + e3);
        const float wv = (lane == 0 ? 1.f : lane == 1 ? e1 : lane == 2 ? e2 : e3) * inv;
        const int ev = lane == 0 ? te[0] : lane == 1 ? te[1] : lane == 2 ? te[2] : te[3];
        unsigned* cnt = (unsigned*)(X.ws + WS_CTL) + CW_CNT + l * 32;
        const int pos = (int)atomicAdd(&cnt[ev], 1u);
        ((int*)(X.ws + WS_TOKE))[t * 4 + lane] = ev; ((float*)(X.ws + WS_TOKW))[t * 4 + lane] = wv; ((int*)(X.ws + WS_TOKP))[t * 4 + lane] = pos;
        ((int*)(X.ws + WS_SLOT))[ev * CAP + pos] = t;
    }
}

__device__ __forceinline__ float modq2f(long long q) { return (float)((double)q * 9.094947017729282e-13); }
__device__ __forceinline__ void ph_norm0(const Params& p, const Ctx& X) {
    const long long* mq = (const long long*)(X.ws + CTL_MOD);
    float* modf = (float*)(X.ws + WS_MODF);
    for (int i = X.bid * NTHREADS + X.tid; i < 2 * 4 * 6144; i += X.G * NTHREADS) modf[i] = modq2f(mq[i]);
    LAS float* tab = (LAS float*)X.lds;
    for (int i = X.tid; i < 4 * 2048; i += NTHREADS) tab[i] = modq2f(mq[(size_t)(i >> 11) * 6144 + (i & 2047)]);
    __syncthreads();
    for (int t = X.gw; t < T; t += X.ngw) {
        Row r, o; row_load(r, p.in[0] + (size_t)t * D, X.lane);
        const LAS float* m = tab + (t / S) * 2048;
        row_norm_mod(r, o, p.in[4], (const LAS f32x4*)(m + 1024), (const LAS f32x4*)m, X.lane);
        row_store_bf16(o, (bf16_t*)(X.ws + WS_U) + (size_t)t * D, X.lane);
    }
}
__device__ __forceinline__ void ph_router(const Params& p, const Ctx& X, int l, const float* h) {
    const float* mod = (const float*)(X.ws + WS_MODF) + (size_t)l * 4 * 6144;
    LAS float* scr = (LAS float*)(X.lds + X.wave * 16384);
    for (int g4 = X.gw; g4 < T / 4; g4 += X.ngw) {
#pragma unroll
        for (int tk = 0; tk < 4; ++tk) { const int t = g4 * 4 + tk;
            Row r, o; row_load(r, h + (size_t)t * D, X.lane);
            const float* m = mod + (size_t)(t / S) * 6144;
            row_norm_mod(r, o, p.in[5] + l * D, (const f32x4*)(m + 4096), (const f32x4*)(m + 3072), X.lane);
            row_store_bf16(o, (bf16_t*)(X.ws + WS_U) + (size_t)t * D, X.lane);
            row_store_lds(o, scr + tk * 1024, X.lane); }
        LDS_WAIT();
        float acc[4]; skinny4(scr, p.in[24] + (size_t)l * D * NE, NE, 0, X.lane, acc);
        const float bias = p.in[25][l * NE + (X.lane & 31)];
#pragma unroll
        for (int tk = 0; tk < 4; ++tk) route_token(acc[tk] + bias, g4 * 4 + tk, l, X);
        LDS_WAIT();
    }
}
__device__ __forceinline__ void moe_table(const Ctx& X, int l) {
    LAS int* tb = (LAS int*)(X.lds + TAB_OFF);
    if (X.tid == 0) {
        const unsigned* cnt = (const unsigned*)(X.ws + WS_CTL) + CW_CNT + l * 32;
        int base = 0;
        for (int e = 0; e < NE; ++e) { const int c = (int)__hip_atomic_load(cnt + e, __ATOMIC_RELAXED, __HIP_MEMORY_SCOPE_AGENT); tb[e] = base; tb[40 + e] = c; base += (c + 255) >> 8; }
        tb[NE] = base;
    }
    __syncthreads();
}
template <int MODE>
__device__ __forceinline__ void ph_combine(const Params& p, const Ctx& X, int l, const float* h, float* hn) {
    moe_table(X, l);
    const LAS int* tb = (const LAS int*)(X.lds + TAB_OFF);
    const float* mod = (const float*)(X.ws + WS_MODF) + (size_t)l * 4 * 6144;
    const float* mod1 = (const float*)(X.ws + WS_MODF) + (size_t)4 * 6144;
    const bf16_t* y = (const bf16_t*)(X.ws + WS_Y);
    LAS float* scr = (LAS float*)(X.lds + X.wave * 16384);
    for (int g4 = X.gw; g4 < T / 4; g4 += X.ngw) {
#pragma unroll
        for (int tk = 0; tk < 4; ++tk) { const int t = g4 * 4 + tk;
            Row r; row_load(r, h + (size_t)t * D, X.lane);
            const float* g2 = mod + (size_t)(t / S) * 6144 + 5120;
            Row s;
#pragma unroll
            for (int j = 0; j < 4; ++j) s.v[j] = (f32x4){0.f, 0.f, 0.f, 0.f};
#pragma unroll
            for (int k = 0; k < 4; ++k) {
                const int e = ((const int*)(X.ws + WS_TOKE))[t * 4 + k], pos = ((const int*)(X.ws + WS_TOKP))[t * 4 + k]; const float w = ((const float*)(X.ws + WS_TOKW))[t * 4 + k];
                const bf16_t* yr = y + (size_t)(tb[e] * 256 + pos) * D;
#pragma unroll
                for (int j = 0; j < 4; ++j) { const u32x2 q = ((const u32x2*)yr)[64 * j + X.lane];
                    s.v[j].x += w * bflo(q.x); s.v[j].y += w * bfhi(q.x); s.v[j].z += w * bflo(q.y); s.v[j].w += w * bfhi(q.y); }
            }
#pragma unroll
            for (int j = 0; j < 4; ++j) r.v[j] = r.v[j] + ((const f32x4*)g2)[64 * j + X.lane] * s.v[j];
            row_store(r, hn + (size_t)t * D, X.lane);
            if (MODE == 0) {
                Row o; const float* m = mod1 + (size_t)(t / S) * 6144;
                row_norm_mod(r, o, p.in[4] + D, (const f32x4*)(m + 1024), (const f32x4*)m, X.lane);
                row_store_bf16(o, (bf16_t*)(X.ws + WS_U) + (size_t)t * D, X.lane);
                row_store_lds(o, scr + tk * 1024, X.lane);
            }
        }
        if (MODE == 0) {
            LDS_WAIT();
            float acc[4]; skinny4(scr, p.in[16], SSM_IN, 5120, X.lane, acc);
            if (X.lane < 32) {
#pragma unroll
                for (int tk = 0; tk < 4; ++tk) ((float*)(X.ws + WS_DT))[(size_t)(g4 * 4 + tk) * 32 + X.lane] = acc[tk];
            }
            LDS_WAIT();
        }
    }
}

__device__ __forceinline__ void ld64bf(const bf16_t* p, float (&q)[64]) {
#pragma unroll
    for (int i = 0; i < 8; ++i) { const u32x4 w = ((const u32x4*)p)[i];
        q[8 * i] = bflo(w.x); q[8 * i + 1] = bfhi(w.x); q[8 * i + 2] = bflo(w.y); q[8 * i + 3] = bfhi(w.y); q[8 * i + 4] = bflo(w.z); q[8 * i + 5] = bfhi(w.z); q[8 * i + 6] = bflo(w.w); q[8 * i + 7] = bfhi(w.w); }
}
__device__ __forceinline__ float dot64bf(const bf16_t* p, const float (&q)[64]) {
    float d = 0.f;
#pragma unroll
    for (int i = 0; i < 8; ++i) { const u32x4 w = ((const u32x4*)p)[i];
        d += q[8 * i] * bflo(w.x) + q[8 * i + 1] * bfhi(w.x) + q[8 * i + 2] * bflo(w.y) + q[8 * i + 3] * bfhi(w.y) + q[8 * i + 4] * bflo(w.z) + q[8 * i + 5] * bfhi(w.z) + q[8 * i + 6] * bflo(w.w) + q[8 * i + 7] * bfhi(w.w); }
    return d;
}
__device__ __forceinline__ float dot64f(const float* p, const float (&q)[64]) {
    float d = 0.f;
#pragma unroll
    for (int i = 0; i < 16; ++i) { const f32x4 w = ((const f32x4*)p)[i]; d += (q[4 * i] * w.x + q[4 * i + 1] * w.y) + (q[4 * i + 2] * w.z + q[4 * i + 3] * w.w); }
    return d;
}
__device__ __forceinline__ void sb_unit(const Ctx& X, int qt, int bh) {
    const int b = bh >> 3, hh = bh & 7, t = qt * 64 + X.lane;
    const bf16_t* base = (const bf16_t*)(X.ws + WS_BIG) + (size_t)b * S * PROJ_LD;
    float q[64], acc[64];
    ld64bf(base + (size_t)t * PROJ_LD + OFF_SBQ + hh * 64, q);
#pragma unroll
    for (int d = 0; d < 64; ++d) acc[d] = 0.f;
    float run = 0.f;
    for (int j = qt * 64 + 62; j >= 0; --j) {
        const bf16_t* kr = base + (size_t)j * PROJ_LD + OFF_SBK + hh * 64;
        const float logit = dot64bf(kr, q) * 0.125f;
        if (j < t) {
            const float w = expf(logsig(logit) + run);
            run += logsig(-logit);
            const bf16_t* vr = base + (size_t)j * PROJ_LD + OFF_SBV + hh * 64;
#pragma unroll
            for (int i = 0; i < 8; ++i) { const u32x4 v = ((const u32x4*)vr)[i];
                acc[8 * i] += w * bflo(v.x); acc[8 * i + 1] += w * bfhi(v.x); acc[8 * i + 2] += w * bflo(v.y); acc[8 * i + 3] += w * bfhi(v.y);
                acc[8 * i + 4] += w * bflo(v.z); acc[8 * i + 5] += w * bfhi(v.z); acc[8 * i + 6] += w * bflo(v.w); acc[8 * i + 7] += w * bfhi(v.w); }
        }
    }
    bf16_t* op = (bf16_t*)(X.ws + WS_O) + (size_t)(b * S + t) * D + hh * 64;
#pragma unroll
    for (int i = 0; i < 8; ++i) { u32x4 w; w.x = pk2(acc[8 * i], acc[8 * i + 1]); w.y = pk2(acc[8 * i + 2], acc[8 * i + 3]); w.z = pk2(acc[8 * i + 4], acc[8 * i + 5]); w.w = pk2(acc[8 * i + 6], acc[8 * i + 7]);
        ((u32x4*)op)[i] = w; }
}

typedef float f32x16 __attribute__((ext_vector_type(16)));
__device__ __forceinline__ int pi32(int r) { return (r & 0x13) | ((r & 4) << 1) | ((r & 8) >> 1); }
__device__ __forceinline__ void sb_attn_unit(const Ctx& X, int bh, int qb) {
    const int b = bh >> 3, h = bh & 7, q0 = qb * 256, lane = fresh(X.lane), w = X.wave, ql = lane & 31, hf = lane >> 5;
    const bf16_t* proj = (const bf16_t*)(X.ws + WS_BIG) + (size_t)b * S * PROJ_LD;
    const bf16_t* vt = (const bf16_t*)(X.ws + WS_VT) + (size_t)(h * 64) * T + (size_t)b * S;
    const int tq = q0 + 32 * w + ql;
    bf16x8 qf[4];
#pragma unroll
    for (int s = 0; s < 4; ++s) qf[s] = *(const bf16x8*)(proj + (size_t)tq * PROJ_LD + OFF_SBQ + h * 64 + 16 * s + 8 * hf);
    f32x16 o0, o1;
#pragma unroll
    for (int i = 0; i < 16; ++i) { o0[i] = 0.f; o1[i] = 0.f; }
    float run = 0.f;
    const int nblk = 4 * qb + 4, jw = (q0 + 32 * w + 30) >> 6;
    const float CS = 0.125f * 1.4426950408889634f;
    const bf16_t* kg = proj + (size_t)lane * PROJ_LD + OFF_SBK + h * 64 + 8 * w;
    const bf16_t* vg = vt + (size_t)lane * T + 8 * w;
    LAS unsigned char* buf0 = X.lds;
    const int stoff = w * 1024 + lane * 16;
    u32x4 kreg = *(const u32x4*)(kg + (size_t)(64 * (nblk - 1)) * PROJ_LD), vreg = *(const u32x4*)(vg + 64 * (nblk - 1));
    *(LAS u32x4*)(buf0 + stoff) = kreg; *(LAS u32x4*)(buf0 + 8192 + stoff) = vreg;
    __syncthreads();
    const int krow = pi32(ql) * 16;
    for (int j = nblk - 1; j >= 0; --j) {
        LAS unsigned char* buf = buf0 + (((nblk - 1 - j) & 1) ? 16384 : 0);
        LAS unsigned char* nbuf = buf0 + (((nblk - 1 - j) & 1) ? 0 : 16384);
        if (j > 0) { kreg = *(const u32x4*)(kg + (size_t)(64 * (j - 1)) * PROJ_LD); vreg = *(const u32x4*)(vg + 64 * (j - 1)); }
        if (j <= jw) {
#pragma unroll
            for (int kt = 1; kt >= 0; --kt) {
                f32x16 sc;
#pragma unroll
                for (int i = 0; i < 16; ++i) sc[i] = 0.f;
#pragma unroll
                for (int s = 0; s < 4; ++s) { const bf16x8 kf = *(const LAS bf16x8*)(buf + (2 * s + hf) * 1024 + kt * 512 + krow); sc = __builtin_amdgcn_mfma_f32_32x32x16_bf16(kf, qf[s], sc, 0, 0, 0); }
                const int pos0 = 64 * j + 32 * kt + 8 * hf;
                float lk[16], lb[16];
                float a1 = 0.f, a0 = 0.f;
#pragma unroll
                for (int i = 0; i < 16; ++i) {
                    const float xx = sc[i] * CS, e = __builtin_amdgcn_exp2f(-fabsf(xx)), sp = fmaxf(xx, 0.f) + __builtin_amdgcn_logf(1.f + e);
                    const bool valid = (pos0 + 16 * (i >> 3) + (i & 7)) < tq;
                    lk[i] = valid ? -sp : 0.f; lb[i] = valid ? xx - sp : -INFINITY;
                    if (i >= 8) a1 += lk[i]; else a0 += lk[i];
                }
                const float p1 = __shfl_xor(a1, 32), p0 = __shfl_xor(a0, 32);
                const float hi1 = hf ? a1 : p1, lo1 = hf ? p1 : a1, hi0 = hf ? a0 : p0, lo0 = hf ? p0 : a0;
                float acc = hf ? run : run + hi1;
#pragma unroll
                for (int i = 15; i >= 8; --i) { const float t = lb[i] + acc; acc += lk[i]; lb[i] = __builtin_amdgcn_exp2f(t); }
                acc = hf ? run + hi1 + lo1 : run + hi1 + lo1 + hi0;
#pragma unroll
                for (int i = 7; i >= 0; --i) { const float t = lb[i] + acc; acc += lk[i]; lb[i] = __builtin_amdgcn_exp2f(t); }
                run += (hi1 + lo1) + (hi0 + lo0);
#pragma unroll
                for (int a = 0; a < 2; ++a) {
                    u32x4 pw; pw.x = pk2(lb[8 * a], lb[8 * a + 1]); pw.y = pk2(lb[8 * a + 2], lb[8 * a + 3]); pw.z = pk2(lb[8 * a + 4], lb[8 * a + 5]); pw.w = pk2(lb[8 * a + 6], lb[8 * a + 7]);
                    const bf16x8 pf = __builtin_bit_cast(bf16x8, pw);
                    const bf16x8 v0 = *(const LAS bf16x8*)(buf + 8192 + (4 * kt + 2 * a + hf) * 1024 + ql * 16);
                    const bf16x8 v1 = *(const LAS bf16x8*)(buf + 8192 + (4 * kt + 2 * a + hf) * 1024 + 512 + ql * 16);
                    o0 = __builtin_amdgcn_mfma_f32_32x32x16_bf16(v0, pf, o0, 0, 0, 0);
                    o1 = __builtin_amdgcn_mfma_f32_32x32x16_bf16(v1, pf, o1, 0, 0, 0);
                }
            }
        }
        if (j > 0) { *(LAS u32x4*)(nbuf + stoff) = kreg; *(LAS u32x4*)(nbuf + 8192 + stoff) = vreg; }
        __syncthreads();
    }
    bf16_t* op = (bf16_t*)(X.ws + WS_O) + (size_t)(b * S + fresh(tq)) * D + h * 64 + 4 * hf;
#pragma unroll
    for (int g4 = 0; g4 < 4; ++g4) {
        u32x2 w0; w0.x = pk2(o0[4 * g4], o0[4 * g4 + 1]); w0.y = pk2(o0[4 * g4 + 2], o0[4 * g4 + 3]); *(u32x2*)(op + 8 * g4) = w0;
        u32x2 w1; w1.x = pk2(o1[4 * g4], o1[4 * g4 + 1]); w1.y = pk2(o1[4 * g4 + 2], o1[4 * g4 + 3]); *(u32x2*)(op + 32 + 8 * g4) = w1;
    }
}
__device__ __forceinline__ void ph_sb(const Ctx& X) {
    for (int pr = X.bid; pr < 256; pr += X.G)
#pragma unroll 1
        for (int u = 0; u < 2; ++u) { const int bh = pr >> 3, qa = pr & 7; sb_attn_unit(X, bh, u ? qa : 15 - qa); }
}
__device__ __forceinline__ void ph_attn_a(const Params& p, const Ctx& X) {
    const bf16_t* proj = (const bf16_t*)(X.ws + WS_BIG);
    {
        LAS float* flat = (LAS float*)X.lds; LAS float* part = flat + 2048; LAS float* hid = part + 512;
        for (int it = X.bid; it < NCMP * 8 * 2; it += X.G) {
            const int n = it % NCMP, bg = (it / NCMP) & 7, kv = it / (NCMP * 8), b = bg >> 1, g = bg & 1;
            const int col = kv ? OFF_VC : OFF_KC; const float* pe = kv ? p.in[11] : p.in[10]; const float* w1 = kv ? p.in[14] : p.in[12]; const float* w2 = kv ? p.in[15] : p.in[13];
            for (int i = X.tid; i < 2048; i += NTHREADS) { const int l = i >> 6, d = i & 63; flat[i] = bf2f(proj[(size_t)(b * S + n * 16 + l) * PROJ_LD + col + g * 64 + d]) + pe[l * 64 + d]; }
            __syncthreads();
            { const int j = X.tid & 127, part_i = X.tid >> 7; float a = 0.f;
              for (int i = part_i * 512; i < part_i * 512 + 512; ++i) a += flat[i] * w1[(size_t)i * 128 + j];
              part[part_i * 128 + j] = a; }
            __syncthreads();
            if (X.tid < 128) hid[X.tid] = siluf((part[X.tid] + part[128 + X.tid]) + (part[256 + X.tid] + part[384 + X.tid]));
            __syncthreads();
            if (X.tid < 64) {
                float o = 0.f;
                for (int j = 0; j < 128; ++j) o += hid[j] * w2[j * 64 + X.tid];
                if (kv == 0) { const float r = rsqrtf(wave_sum(o * o) * (1.f / 64.f) + EPS); o = o * r * p.in[9][X.tid];
                    ((bf16_t*)(X.ws + WS_KCB))[((size_t)bg * 256 + n) * 64 + X.tid] = (bf16_t)f2bf(o);
                    if (n == 0) ((bf16_t*)(X.ws + WS_KCB))[((size_t)bg * 256 + 255) * 64 + X.tid] = 0; }
                else { ((bf16_t*)(X.ws + WS_VCT))[((size_t)bg * 64 + X.tid) * 256 + n] = (bf16_t)f2bf(o);
                    if (n == 0) ((bf16_t*)(X.ws + WS_VCT))[((size_t)bg * 64 + X.tid) * 256 + 255] = 0; }
            }
            __syncthreads();
        }
    }
    for (int it = X.gw; it < T * 12; it += X.ngw) {
        const int t = it / 12, idx = it % 12, lane = X.lane;
        int col; const float* gain; bf16_t* dst; float sc = 1.f;
        if (idx < 8) { col = OFF_NQ + idx * 64; gain = p.in[8]; dst = (bf16_t*)(X.ws + WS_QNB) + (size_t)t * 512 + idx * 64; sc = 0.125f * 1.4426950408889634f; }
        else if (idx < 10) { col = OFF_KS + (idx - 8) * 64; gain = p.in[9] + 64; dst = (bf16_t*)(X.ws + WS_KSN) + (size_t)t * 128 + (idx - 8) * 64; }
        else { col = OFF_KW + (idx - 10) * 64; gain = p.in[9] + 128; dst = (bf16_t*)(X.ws + WS_KWN) + (size_t)t * 128 + (idx - 10) * 64; }
        const float v = bf2f(proj[(size_t)t * PROJ_LD + col + lane]);
        const float r = rsqrtf(wave_sum(v * v) * (1.f / 64.f) + EPS);
        dst[lane] = (bf16_t)f2bf(v * r * gain[lane] * sc);
    }
}
struct NsaSt { f32x16 o0, o1; float m, l; };
template <int MODE>
__device__ __forceinline__ void nsa_flash(const Ctx& X, const bf16_t* kg, const bf16_t* vg, int jlo, int jhi, const bf16x8 (&qf)[4], int tq, float slope2,
                                          unsigned long long mymask, unsigned long long wavemask, NsaSt& st) {
    const int lane = fresh(X.lane), w = X.wave, ql = lane & 31, hf = lane >> 5;
    LAS unsigned char* buf0 = X.lds;
    const int stoff = w * 1024 + lane * 16, krow = pi32(ql) * 16;
    u32x4 kreg = *(const u32x4*)(kg + (size_t)(64 * jlo) * 128), vreg = *(const u32x4*)(vg + 64 * jlo);
    *(LAS u32x4*)(buf0 + stoff) = kreg; *(LAS u32x4*)(buf0 + 8192 + stoff) = vreg;
    __syncthreads();
    for (int j = jlo; j <= jhi; ++j) {
        LAS unsigned char* buf = buf0 + (((j - jlo) & 1) ? 16384 : 0);
        LAS unsigned char* nbuf = buf0 + (((j - jlo) & 1) ? 0 : 16384);
        if (j < jhi) { kreg = *(const u32x4*)(kg + (size_t)(64 * (j + 1)) * 128); vreg = *(const u32x4*)(vg + 64 * (j + 1)); }
        if (MODE == 1 || ((wavemask >> j) & 1ull)) {
            f32x16 s0, s1;
#pragma unroll
            for (int i = 0; i < 16; ++i) { s0[i] = 0.f; s1[i] = 0.f; }
#pragma unroll
            for (int s = 0; s < 4; ++s) {
                const bf16x8 k0 = *(const LAS bf16x8*)(buf + (2 * s + hf) * 1024 + krow), k1 = *(const LAS bf16x8*)(buf + (2 * s + hf) * 1024 + 512 + krow);
                s0 = __builtin_amdgcn_mfma_f32_32x32x16_bf16(k0, qf[s], s0, 0, 0, 0); s1 = __builtin_amdgcn_mfma_f32_32x32x16_bf16(k1, qf[s], s1, 0, 0, 0);
            }
            const bool sel = MODE == 1 || ((mymask >> j) & 1ull);
            const int d0 = tq - (64 * j + 8 * hf);
            float mb = -INFINITY;
#pragma unroll
            for (int i = 0; i < 16; ++i) {
                const int da = d0 - (16 * (i >> 3) + (i & 7)), db = da - 32;
                const bool va = sel && da >= 0 && (MODE == 0 || da < 512), vb = sel && db >= 0 && (MODE == 0 || db < 512);
                s0[i] = va ? s0[i] - slope2 * (float)da : -INFINITY; s1[i] = vb ? s1[i] - slope2 * (float)db : -INFINITY;
                mb = fmaxf(mb, fmaxf(s0[i], s1[i]));
            }
            mb = fmaxf(mb, __shfl_xor(mb, 32));
            const float mn = fmaxf(st.m, mb), ms = mn == -INFINITY ? 0.f : mn, alpha = __builtin_amdgcn_exp2f(st.m - ms);
            st.m = mn;
            float ls = 0.f;
#pragma unroll
            for (int i = 0; i < 16; ++i) { s0[i] = __builtin_amdgcn_exp2f(s0[i] - ms); s1[i] = __builtin_amdgcn_exp2f(s1[i] - ms); ls += s0[i] + s1[i]; }
            st.l = st.l * alpha + ls;
#pragma unroll
            for (int i = 0; i < 16; ++i) { st.o0[i] *= alpha; st.o1[i] *= alpha; }
#pragma unroll
            for (int kt = 0; kt < 2; ++kt)
#pragma unroll
                for (int a = 0; a < 2; ++a) {
                    u32x4 pw;
                    if (kt == 0) { pw.x = pk2(s0[8 * a], s0[8 * a + 1]); pw.y = pk2(s0[8 * a + 2], s0[8 * a + 3]); pw.z = pk2(s0[8 * a + 4], s0[8 * a + 5]); pw.w = pk2(s0[8 * a + 6], s0[8 * a + 7]); }
                    else { pw.x = pk2(s1[8 * a], s1[8 * a + 1]); pw.y = pk2(s1[8 * a + 2], s1[8 * a + 3]); pw.z = pk2(s1[8 * a + 4], s1[8 * a + 5]); pw.w = pk2(s1[8 * a + 6], s1[8 * a + 7]); }
                    const bf16x8 pf = __builtin_bit_cast(bf16x8, pw);
                    const bf16x8 v0 = *(const LAS bf16x8*)(buf + 8192 + (4 * kt + 2 * a + hf) * 1024 + ql * 16);
                    const bf16x8 v1 = *(const LAS bf16x8*)(buf + 8192 + (4 * kt + 2 * a + hf) * 1024 + 512 + ql * 16);
                    st.o0 = __builtin_amdgcn_mfma_f32_32x32x16_bf16(v0, pf, st.o0, 0, 0, 0);
                    st.o1 = __builtin_amdgcn_mfma_f32_32x32x16_bf16(v1, pf, st.o1, 0, 0, 0);
                }
        }
        if (j < jhi) { *(LAS u32x4*)(nbuf + stoff) = kreg; *(LAS u32x4*)(nbuf + 8192 + stoff) = vreg; }
        __syncthreads();
    }
}
__device__ __forceinline__ void nsa_unit(const Ctx& X, int bg, int qb) {
    const int b = bg >> 1, g = bg & 1, lane = fresh(X.lane), w = X.wave, ql = lane & 31, hf = lane >> 5, r = ql >> 3, hh = g * 4 + r;
    const int t0 = 64 * qb, tq = t0 + 8 * w + (ql & 7);
    const float slope2 = exp2f(-(float)(hh + 1)) * 1.4426950408889634f;
    const bf16_t* proj = (const bf16_t*)(X.ws + WS_BIG);
    bf16x8 qf[4];
    { const bf16_t* qp = (const bf16_t*)(X.ws + WS_QNB) + (size_t)(b * S + tq) * 512 + hh * 64 + 8 * hf;
#pragma unroll
      for (int s = 0; s < 4; ++s) qf[s] = *(const bf16x8*)(qp + 16 * s); }
    float gate[3];
    { const bf16_t* gp = proj + (size_t)(b * S + tq) * PROJ_LD + OFF_GATE + hh * 3;
#pragma unroll
      for (int i = 0; i < 3; ++i) gate[i] = 1.f / (1.f + __expf(-bf2f(gp[i]))); }
    f32x16 of0, of1;
#pragma unroll
    for (int i = 0; i < 16; ++i) { of0[i] = 0.f; of1[i] = 0.f; }
    NsaSt st;
    LAS float* pacc = (LAS float*)(X.lds + 65536) + w * 2048;
    {
        const int ncm = t0 + 63 >= 31 ? (t0 + 63 - 31) / 16 + 1 : 0, nt = (ncm + 31) >> 5, ncv = tq >= 31 ? (tq - 31) / 16 + 1 : 0;
        {
            const bf16_t* kc = (const bf16_t*)(X.ws + WS_KCB) + (size_t)bg * 256 * 64; const bf16_t* vc = (const bf16_t*)(X.ws + WS_VCT) + (size_t)bg * 64 * 256;
            const int tidf = fresh(X.tid);
#pragma unroll
            for (int i = 0; i < 4; ++i) { const int pidx = tidf + NTHREADS * i;
                *(LAS u32x4*)(X.lds + (pidx >> 8) * 4096 + (pidx & 255) * 16) = *(const u32x4*)(kc + (size_t)(pidx & 255) * 64 + 8 * (pidx >> 8));
                *(LAS u32x4*)(X.lds + 32768 + (pidx >> 6) * 1024 + (pidx & 63) * 16) = *(const u32x4*)(vc + (size_t)(pidx & 63) * 256 + 8 * (pidx >> 6)); }
#pragma unroll
            for (int i = 0; i < 8; ++i) *(LAS f32x4*)(pacc + (i * 64 + lane) * 4) = (f32x4){0.f, 0.f, 0.f, 0.f};
        }
        __syncthreads();
        const int krow = pi32(ql) * 16;
        float ml = -INFINITY, ll = 0.f;
        for (int kt = 0; kt < nt; ++kt) {
            f32x16 sc;
#pragma unroll
            for (int i = 0; i < 16; ++i) sc[i] = 0.f;
#pragma unroll
            for (int s = 0; s < 4; ++s) { const bf16x8 kf = *(const LAS bf16x8*)(X.lds + (2 * s + hf) * 4096 + kt * 512 + krow); sc = __builtin_amdgcn_mfma_f32_32x32x16_bf16(kf, qf[s], sc, 0, 0, 0); }
            float tm = -INFINITY;
#pragma unroll
            for (int i = 0; i < 16; ++i) { const int n = 32 * kt + 16 * (i >> 3) + 8 * hf + (i & 7);
                sc[i] = n < ncv ? sc[i] - slope2 * (float)(tq - (16 * n + 31)) : -INFINITY; tm = fmaxf(tm, sc[i]); }
            const float mn = fmaxf(ml, tm), ms = mn == -INFINITY ? 0.f : mn;
            float ls = 0.f;
#pragma unroll
            for (int i = 0; i < 16; ++i) ls += __builtin_amdgcn_exp2f(sc[i] - ms);
            ll = ll * __builtin_amdgcn_exp2f(ml - ms) + ls; ml = mn;
        }
        float ms, inv;
        { const float mo = __shfl_xor(ml, 32), lo = __shfl_xor(ll, 32), mt = fmaxf(ml, mo); ms = mt == -INFINITY ? 0.f : mt;
          const float lt = ll * __builtin_amdgcn_exp2f(ml - ms) + lo * __builtin_amdgcn_exp2f(mo - ms); inv = lt > 0.f ? 1.f / lt : 0.f; }
#pragma unroll
        for (int i = 0; i < 16; ++i) { st.o0[i] = 0.f; st.o1[i] = 0.f; }
        float carry = 0.f;
        for (int kt = 0; kt < nt; ++kt) {
            f32x16 sc;
#pragma unroll
            for (int i = 0; i < 16; ++i) sc[i] = 0.f;
#pragma unroll
            for (int s = 0; s < 4; ++s) { const bf16x8 kf = *(const LAS bf16x8*)(X.lds + (2 * s + hf) * 4096 + kt * 512 + krow); sc = __builtin_amdgcn_mfma_f32_32x32x16_bf16(kf, qf[s], sc, 0, 0, 0); }
#pragma unroll
            for (int i = 0; i < 16; ++i) { const int n = 32 * kt + 16 * (i >> 3) + 8 * hf + (i & 7);
                sc[i] = n < ncv ? __builtin_amdgcn_exp2f(sc[i] - slope2 * (float)(tq - (16 * n + 31)) - ms) * inv : 0.f; }
            const float pa0 = __shfl_xor(sc[7], 32), pa1 = __shfl_xor(sc[15], 32);
            const float prev0 = hf ? pa0 : carry, prev1 = hf ? pa1 : pa0;
            carry = pa1;
            {
                typedef float f32x2 __attribute__((ext_vector_type(2)));
                f32x2 e0, e1;
                e0.x = prev0 + ((sc[0] + sc[1]) + (sc[2] + sc[3])); e0.y = sc[3] + ((sc[4] + sc[5]) + (sc[6] + sc[7]));
                e1.x = prev1 + ((sc[8] + sc[9]) + (sc[10] + sc[11])); e1.y = sc[11] + ((sc[12] + sc[13]) + (sc[14] + sc[15]));
                *(LAS f32x2*)(pacc + ql * 64 + 8 * kt + 2 * hf) = e0; *(LAS f32x2*)(pacc + ql * 64 + 8 * kt + 4 + 2 * hf) = e1;
            }
#pragma unroll
            for (int a = 0; a < 2; ++a) {
                u32x4 pw; pw.x = pk2(sc[8 * a], sc[8 * a + 1]); pw.y = pk2(sc[8 * a + 2], sc[8 * a + 3]); pw.z = pk2(sc[8 * a + 4], sc[8 * a + 5]); pw.w = pk2(sc[8 * a + 6], sc[8 * a + 7]);
                const bf16x8 pf = __builtin_bit_cast(bf16x8, pw);
                const bf16x8 v0 = *(const LAS bf16x8*)(X.lds + 32768 + (4 * kt + 2 * a + hf) * 1024 + ql * 16);
                const bf16x8 v1 = *(const LAS bf16x8*)(X.lds + 32768 + (4 * kt + 2 * a + hf) * 1024 + 512 + ql * 16);
                st.o0 = __builtin_amdgcn_mfma_f32_32x32x16_bf16(v0, pf, st.o0, 0, 0, 0);
                st.o1 = __builtin_amdgcn_mfma_f32_32x32x16_bf16(v1, pf, st.o1, 0, 0, 0);
            }
        }
#pragma unroll
        for (int i = 0; i < 16; ++i) { of0[i] = gate[0] * st.o0[i]; of1[i] = gate[0] * st.o1[i]; }
    }
    unsigned long long mymask = 0ull, wavemask = 0ull;
    LDS_WAIT();
    for (int q8 = 0; q8 < 8; ++q8) {
        const int t = t0 + 8 * w + q8;
        const float ps = (pacc[(0 * 8 + q8) * 64 + lane] + pacc[(1 * 8 + q8) * 64 + lane]) + (pacc[(2 * 8 + q8) * 64 + lane] + pacc[(3 * 8 + q8) * 64 + lane]);
        const bool valid = lane * 64 <= t, forced = (lane == 0) || (lane == qb) || (lane == qb - 1);
        const float score = valid ? (forced ? 1e6f : ps) : -1e6f;
        int rank = 0;
#pragma unroll 4
        for (int i = 0; i < 64; ++i) { const float si = __builtin_amdgcn_readlane(score, i); rank += (si > score || (si == score && i < lane)) ? 1 : 0; }
        const unsigned long long mk = __ballot(rank < 16);
        wavemask |= mk; if ((ql & 7) == q8) mymask = mk;
    }
    __syncthreads();
    {
#pragma unroll
        for (int i = 0; i < 16; ++i) { st.o0[i] = 0.f; st.o1[i] = 0.f; }
        st.m = -INFINITY; st.l = 0.f;
        const int lf = fresh(lane);
        const bf16_t* kg = (const bf16_t*)(X.ws + WS_KSN) + ((size_t)b * S + lf) * 128 + g * 64 + 8 * w;
        const bf16_t* vg = (const bf16_t*)(X.ws + WS_VT) + (size_t)(512 + g * 64 + lf) * T + (size_t)b * S + 8 * w;
        nsa_flash<0>(X, kg, vg, 0, qb, qf, tq, slope2, mymask, wavemask, st);
        const float lt = st.l + __shfl_xor(st.l, 32), sc = gate[1] / fmaxf(lt, 1e-30f);
#pragma unroll
        for (int i = 0; i < 16; ++i) { of0[i] += sc * st.o0[i]; of1[i] += sc * st.o1[i]; }
    }
    {
#pragma unroll
        for (int i = 0; i < 16; ++i) { st.o0[i] = 0.f; st.o1[i] = 0.f; }
        st.m = -INFINITY; st.l = 0.f;
        const int lf = fresh(lane);
        const bf16_t* kg = (const bf16_t*)(X.ws + WS_KWN) + ((size_t)b * S + lf) * 128 + g * 64 + 8 * w;
        const bf16_t* vg = (const bf16_t*)(X.ws + WS_VT) + (size_t)(640 + g * 64 + lf) * T + (size_t)b * S + 8 * w;
        nsa_flash<1>(X, kg, vg, qb >= 8 ? qb - 8 : 0, qb, qf, tq, slope2, 0ull, 0ull, st);
        const float lt = st.l + __shfl_xor(st.l, 32), sc = gate[2] / fmaxf(lt, 1e-30f);
#pragma unroll
        for (int i = 0; i < 16; ++i) { of0[i] += sc * st.o0[i]; of1[i] += sc * st.o1[i]; }
    }
    bf16_t* op = (bf16_t*)(X.ws + WS_O) + (size_t)(b * S + fresh(tq)) * D + 512 + hh * 64 + 4 * hf;
#pragma unroll
    for (int g4 = 0; g4 < 4; ++g4) {
        u32x2 w0; w0.x = pk2(of0[4 * g4], of0[4 * g4 + 1]); w0.y = pk2(of0[4 * g4 + 2], of0[4 * g4 + 3]); *(u32x2*)(op + 8 * g4) = w0;
        u32x2 w1; w1.x = pk2(of1[4 * g4], of1[4 * g4 + 1]); w1.y = pk2(of1[4 * g4 + 2], of1[4 * g4 + 3]); *(u32x2*)(op + 32 + 8 * g4) = w1;
    }
}
__device__ __forceinline__ void ph_nsa(const Params& p, const Ctx& X) {
    for (int pr = X.bid; pr < 256; pr += X.G)
#pragma unroll 1
        for (int u = 0; u < 2; ++u) { const int bg = pr >> 5, qa = pr & 31; nsa_unit(X, bg, u ? qa : 63 - qa); }
}

__device__ __forceinline__ void ph_conv(const Params& p, const Ctx& X) {
    const bf16_t* zx = (const bf16_t*)(X.ws + WS_BIG); float* xc = (float*)(X.ws + WS_XC);
    const float* cw = p.in[17]; const float* cb = p.in[18];
    for (size_t i = (size_t)X.bid * NTHREADS + X.tid; i < (size_t)T * (CONV_DIM / 4); i += (size_t)X.G * NTHREADS) {
        const int t = (int)(i / (CONV_DIM / 4)), ch = (int)(i % (CONV_DIM / 4)) * 4, tt = t & (S - 1);
        f32x4 a = *(const f32x4*)(cb + ch);
#pragma unroll
        for (int w = 0; w < 4; ++w) {
            if (tt - 3 + w < 0) continue;
            const u32x2 q = *(const u32x2*)(zx + (size_t)(t - 3 + w) * ZX_LD + 2048 + ch); const f32x4 k = *(const f32x4*)(cw + w * CONV_DIM + ch);
            a.x += bflo(q.x) * k.x; a.y += bfhi(q.x) * k.y; a.z += bflo(q.y) * k.z; a.w += bfhi(q.y) * k.w;
        }
        *(f32x4*)(xc + (size_t)t * CONV_DIM + ch) = (f32x4){siluf(a.x), siluf(a.y), siluf(a.z), siluf(a.w)};
    }
}
__device__ __forceinline__ void ph_ssd(const Params& p, const Ctx& X) {
    const float* xc = (const float*)(X.ws + WS_XC); const float* dtr = (const float*)(X.ws + WS_DT); float* ys = (float*)(X.ws + WS_YS);
    const int vb = X.bid * 2 + (X.tid >> 8);
    if (vb >= NB * 32) return;
    const int b = vb >> 5, hh = vb & 31, g = hh >> 3, tl = X.tid & 255, pp = tl >> 2, c4 = tl & 3;
    const float a = -expf(p.in[20][hh]), dtb = p.in[19][hh], dsk = p.in[21][hh];
    float st[32];
#pragma unroll
    for (int i = 0; i < 32; ++i) st[i] = 0.f;
    for (int tt = 0; tt < S; ++tt) {
        const size_t t = (size_t)b * S + tt;
        const float raw = dtr[t * 32 + hh] + dtb;
        const float dt = raw > 20.f ? raw : log1pf(expf(raw));
        const float dA = expf(dt * a);
        const float xv = xc[t * CONV_DIM + hh * 64 + pp];
        const float xd = xv * dt;
        const f32x4* Bp = (const f32x4*)(xc + t * CONV_DIM + 2048 + g * 128 + c4 * 32);
        const f32x4* Cp = (const f32x4*)(xc + t * CONV_DIM + 2560 + g * 128 + c4 * 32);
        float y = 0.f;
#pragma unroll
        for (int i = 0; i < 8; ++i) {
            const f32x4 bv = Bp[i], cv = Cp[i];
            st[4 * i + 0] = st[4 * i + 0] * dA + xd * bv.x; y += cv.x * st[4 * i + 0];
            st[4 * i + 1] = st[4 * i + 1] * dA + xd * bv.y; y += cv.y * st[4 * i + 1];
            st[4 * i + 2] = st[4 * i + 2] * dA + xd * bv.z; y += cv.z * st[4 * i + 2];
            st[4 * i + 3] = st[4 * i + 3] * dA + xd * bv.w; y += cv.w * st[4 * i + 3];
        }
        y += __shfl_xor(y, 1); y += __shfl_xor(y, 2);
        if (c4 == 0) ys[t * SSM_INNER + hh * 64 + pp] = y + xv * dsk;
    }
}
__device__ __forceinline__ void ph_gate_norm(const Params& p, const Ctx& X) {
    const bf16_t* zx = (const bf16_t*)(X.ws + WS_BIG); const float* ys = (const float*)(X.ws + WS_YS); bf16_t* yn = (bf16_t*)(X.ws + WS_O);
    for (int it = X.gw; it < T * 4; it += X.ngw) {
        const int t = it >> 2, ch = (it & 3) * 512 + X.lane * 8;
        const f32x4 y0 = *(const f32x4*)(ys + (size_t)t * SSM_INNER + ch), y1 = *(const f32x4*)(ys + (size_t)t * SSM_INNER + ch + 4);
        const u32x4 z = *(const u32x4*)(zx + (size_t)t * ZX_LD + ch);
        float v[8] = {y0.x * siluf(bflo(z.x)), y0.y * siluf(bfhi(z.x)), y0.z * siluf(bflo(z.y)), y0.w * siluf(bfhi(z.y)),
                      y1.x * siluf(bflo(z.z)), y1.y * siluf(bfhi(z.z)), y1.z * siluf(bflo(z.w)), y1.w * siluf(bfhi(z.w))};
        float ss = 0.f;
#pragma unroll
        for (int i = 0; i < 8; ++i) ss += v[i] * v[i];
        const float r = rsqrtf(wave_sum(ss) * (1.f / 512.f) + EPS);
        const f32x4 g0 = *(const f32x4*)(p.in[22] + ch), g1 = *(const f32x4*)(p.in[22] + ch + 4);
        u32x4 w; w.x = pk2(v[0] * r * g0.x, v[1] * r * g0.y); w.y = pk2(v[2] * r * g0.z, v[3] * r * g0.w); w.z = pk2(v[4] * r * g1.x, v[5] * r * g1.y); w.w = pk2(v[6] * r * g1.z, v[7] * r * g1.w);
        *(u32x4*)(yn + (size_t)t * SSM_INNER + ch) = w;
    }
}

__device__ __forceinline__ void ph_moe_gu(const Params& p, const Ctx& X, int l) {
    moe_table(X, l);
    pg8::MoeOrder So{(const LAS int*)(X.lds + TAB_OFF), (const LAS int*)(X.lds + TAB_OFF) + 40, (const int*)(X.ws + WS_SLOT), 3, X.G, X.bid, true};
    pg8::Gemm g{(const bf16_t*)(X.ws + WS_U), (const bf16_t*)(X.ws + WS_WGU) + (size_t)l * NE * 2048 * 1024, 1024};
    pg8::EpiGu E{(bf16_t*)(X.ws + WS_ACT), p.in[27] + (size_t)l * NE * 2048};
    pg8::gemm_phase<pg8::EpiGu, pg8::MoeOrder>(X.lds, g, So, E, X.tid);
}
__device__ __forceinline__ void ph_moe_down(const Params& p, const Ctx& X, int l) {
    moe_table(X, l);
    pg8::MoeOrder So{(const LAS int*)(X.lds + TAB_OFF), (const LAS int*)(X.lds + TAB_OFF) + 40, (const int*)(X.ws + WS_SLOT), 2, X.G, X.bid, false};
    pg8::Gemm g{(const bf16_t*)(X.ws + WS_ACT), (const bf16_t*)(X.ws + WS_WDN) + (size_t)l * NE * 1024 * 1024, 1024};
    pg8::EpiDown E{(bf16_t*)(X.ws + WS_Y), p.in[29] + (size_t)l * NE * 1024};
    pg8::gemm_phase<pg8::EpiDown, pg8::MoeOrder>(X.lds, g, So, E, X.tid);
}

__global__ void __launch_bounds__(NTHREADS, 2) fwd_kernel(Params p) {
    extern __shared__ __attribute__((aligned(16))) unsigned char lds_raw[];
    Ctx X;
    X.lds = (LAS unsigned char*)lds_raw; X.ws = p.ws;
    X.tid = threadIdx.x; X.lane = X.tid & 63; X.wave = __builtin_amdgcn_readfirstlane(X.tid >> 6);
    X.G = gridDim.x; X.bid = blockIdx.x; X.gw = X.bid * NWAVES + X.wave; X.ngw = X.G * NWAVES;
    if (X.tid < 4) ((LAS unsigned*)(X.lds + XB_OFF))[X.tid] = 0u;
    __syncthreads();
    XcdBarrier bar = xcd_barrier_post((unsigned*)(p.ws + WS_CTL) + CW_BAR, (volatile LAS unsigned*)(X.lds + XB_OFF));
#define PHASE_BEGIN Ctx Y = X; { unsigned char* w_ = p.ws; asm volatile("" : "+s"(w_)); Y.ws = w_; int t_ = threadIdx.x; asm volatile("" : "+v"(t_)); Y.tid = t_; Y.lane = t_ & 63; \
    Y.wave = __builtin_amdgcn_readfirstlane(t_ >> 6); Y.gw = Y.bid * NWAVES + Y.wave; }
#define WSF(off) ((float*)(Y.ws + (off)))
#define WSB(off) ((bf16_t*)(Y.ws + (off)))
    { PHASE_BEGIN ph_prologue(p, Y); }                                    xcd_barrier(bar);
    { PHASE_BEGIN ph_norm0(p, Y); }                                       xcd_barrier(bar);
    {
        PHASE_BEGIN
        pg8::DenseOrder So; So.init(T, PROJ_LD, X.G, X.bid);
        pg8::Gemm g{WSB(WS_U), WSB(WS_WIN), 1024};
        pg8::EpiBf16 E{WSB(WS_BIG), PROJ_LD};
        pg8::gemm_phase<pg8::EpiBf16, pg8::DenseOrder>(X.lds, g, So, E, Y.tid);
    }
    {
        PHASE_BEGIN
        pg8::DenseOrder So; So.init(768, T, X.G, X.bid);
        pg8::Gemm g{WSB(WS_WV), WSB(WS_U), 1024};
        pg8::EpiBf16 E{WSB(WS_VT), T};
        pg8::gemm_phase<pg8::EpiBf16, pg8::DenseOrder>(X.lds, g, So, E, Y.tid);
    }
    xcd_barrier(bar);
    { PHASE_BEGIN ph_attn_a(p, Y); }                                      xcd_barrier(bar);
    { PHASE_BEGIN ph_nsa(p, Y); }
    __syncthreads();
    { PHASE_BEGIN ph_sb(Y); }                                             xcd_barrier(bar);
    {
        PHASE_BEGIN
        pg8::DenseOrder So; So.init(T, D, X.G, X.bid);
        pg8::Gemm g{WSB(WS_O), WSB(WS_WOUT), 1024};
        pg8::EpiResid E{p.in[0], WSF(WS_H1), WSF(WS_MODF) + 2048};
        pg8::gemm_phase<pg8::EpiResid, pg8::DenseOrder>(X.lds, g, So, E, Y.tid);
    }
    xcd_barrier(bar);
    { PHASE_BEGIN ph_router(p, Y, 0, WSF(WS_H1)); }                       xcd_barrier(bar);
    { PHASE_BEGIN ph_moe_gu(p, Y, 0); }                                   xcd_barrier(bar);
    { PHASE_BEGIN ph_moe_down(p, Y, 0); }                                 xcd_barrier(bar);
    { PHASE_BEGIN ph_combine<0>(p, Y, 0, WSF(WS_H1), WSF(WS_H2)); }       xcd_barrier(bar);
    {
        PHASE_BEGIN
        pg8::DenseOrder So; So.init(T, ZX_LD, X.G, X.bid);
        pg8::Gemm g{WSB(WS_U), WSB(WS_WSIN), 1024};
        pg8::EpiBf16 E{WSB(WS_BIG), ZX_LD};
        pg8::gemm_phase<pg8::EpiBf16, pg8::DenseOrder>(X.lds, g, So, E, Y.tid);
    }
    xcd_barrier(bar);
    { PHASE_BEGIN ph_conv(p, Y); }                                        xcd_barrier(bar);
    { PHASE_BEGIN ph_ssd(p, Y); }                                         xcd_barrier(bar);
    { PHASE_BEGIN ph_gate_norm(p, Y); }                                   xcd_barrier(bar);
    {
        PHASE_BEGIN
        pg8::DenseOrder So; So.init(T, D, X.G, X.bid);
        pg8::Gemm g{WSB(WS_O), WSB(WS_WSOUT), 2048};
        pg8::EpiResid E{WSF(WS_H2), WSF(WS_H1), WSF(WS_MODF) + 4 * 6144 + 2048};
        pg8::gemm_phase<pg8::EpiResid, pg8::DenseOrder>(X.lds, g, So, E, Y.tid);
    }
    xcd_barrier(bar);
    { PHASE_BEGIN ph_router(p, Y, 1, WSF(WS_H1)); }                       xcd_barrier(bar);
    { PHASE_BEGIN ph_moe_gu(p, Y, 1); }                                   xcd_barrier(bar);
    { PHASE_BEGIN ph_moe_down(p, Y, 1); }                                 xcd_barrier(bar);
    { PHASE_BEGIN ph_combine<1>(p, Y, 1, WSF(WS_H1), p.out); }
#undef PHASE_BEGIN
#undef WSF
#undef WSB
}
}

extern "C" void kernel_launch(void* const* d_in, const int* in_sizes, int n_in, void* d_out, int out_size, void* d_ws, size_t ws_size, hipStream_t stream) {
    static int grid = 0;
    if (grid == 0) {
        if (n_in != 30 || out_size != T * D || ws_size < WS_END) { fprintf(stderr, "kernel_launch: unexpected shapes / workspace (%d inputs, out %d, ws %zu < %zu)\n", n_in, out_size, ws_size, (size_t)WS_END); grid = -1; return; }
        int dev = 0, cus = 0, per_cu = 0;
        if (hipGetDevice(&dev) != hipSuccess || hipDeviceGetAttribute(&cus, hipDeviceAttributeMultiprocessorCount, dev) != hipSuccess) { grid = -1; return; }
        if (hipFuncSetAttribute((const void*)fwd_kernel, hipFuncAttributeMaxDynamicSharedMemorySize, LDS_BYTES) != hipSuccess) { fprintf(stderr, "kernel_launch: hipFuncSetAttribute failed\n"); grid = -1; return; }
        if (hipOccupancyMaxActiveBlocksPerMultiprocessor(&per_cu, (const void*)fwd_kernel, NTHREADS, LDS_BYTES) != hipSuccess || per_cu < 1) { fprintf(stderr, "kernel_launch: occupancy query reports %d\n", per_cu); }
        (void)hipGetLastError();
        grid = cus;
    }
    if (grid < 0) return;
    if (hipMemsetAsync((char*)d_ws + WS_CTL, 0, CTL_BYTES, stream) != hipSuccess) return;
    Params p{};
    for (int i = 0; i < 30; ++i) p.in[i] = (const float*)d_in[i];
    p.out = (float*)d_out; p.ws = (unsigned char*)d_ws;
    hipLaunchKernelGGL(fwd_kernel, dim3(grid), dim3(NTHREADS), LDS_BYTES, stream, p);
}
```

```cpp
#include <hip/hip_runtime.h>
#include <cstdio>
#include <cstdint>

#define LAS __attribute__((address_space(3)))
#define GAS __attribute__((address_space(1)))
typedef unsigned short bf16_t;
typedef short bf16x8 __attribute__((ext_vector_type(8)));
typedef float f32x4 __attribute__((ext_vector_type(4)));
typedef unsigned u32x4 __attribute__((ext_vector_type(4)));
typedef unsigned u32x2 __attribute__((ext_vector_type(2)));

namespace {
constexpr int D = 1024, NB = 4, S = 4096, T = NB * S;
constexpr int ATTN_IN = 2840, PROJ_LD = 3072;
constexpr int OFF_SBQ = 0, OFF_SBK = 512, OFF_SBV = 1024, OFF_NQ = 1536, OFF_KC = 2048, OFF_VC = 2176, OFF_KS = 2304, OFF_VS = 2432,
              OFF_KW = 2560, OFF_VW = 2688, OFF_GATE = 2816;
constexpr int NCMP = 255;
constexpr int SSM_IN = 5152, SSM_INNER = 2048, CONV_DIM = 3072, ZX_LD = 5120;
constexpr int NE = 32, CAP = 16384, MAXTILES = 288;
constexpr float EPS = 1e-6f;
constexpr int NWAVES = 8, NTHREADS = 512;

constexpr size_t al4k(size_t x) { return (x + 4095) & ~(size_t)4095; }
constexpr size_t WS_CTL = 0, CTL_BYTES = 1u << 20;
constexpr int CW_CNT = 256;
constexpr int CW_BAR = 4096;
constexpr size_t CTL_MOD = 65536;
constexpr size_t WS_WIN = CTL_BYTES;
constexpr size_t WS_WOUT = WS_WIN + (size_t)3072 * 1024 * 2;
constexpr size_t WS_WSIN = WS_WOUT + (size_t)1024 * 1024 * 2;
constexpr size_t WS_WSOUT = WS_WSIN + (size_t)5120 * 1024 * 2;
constexpr size_t WS_WGU = WS_WSOUT + (size_t)1024 * 2048 * 2;
constexpr size_t WS_WDN = WS_WGU + (size_t)2 * 32 * 2048 * 1024 * 2;
constexpr size_t WS_U = WS_WDN + (size_t)2 * 32 * 1024 * 1024 * 2;
constexpr size_t WS_BIG = WS_U + (size_t)T * 1024 * 2;
constexpr size_t WS_O = WS_BIG + (size_t)T * 5120 * 2;
constexpr size_t WS_H1 = WS_O + (size_t)T * 2048 * 2;
constexpr size_t WS_H2 = WS_H1 + (size_t)T * 1024 * 4;
constexpr size_t WS_QN = WS_H2 + (size_t)T * 1024 * 4;
constexpr size_t WS_KN = WS_QN + (size_t)T * 512 * 4;
constexpr size_t WS_KCMP = WS_KN + (size_t)T * 256 * 4;
constexpr size_t WS_VCMP = WS_KCMP + al4k((size_t)NB * NCMP * 2 * 64 * 4);
constexpr size_t WS_ACT = WS_VCMP + al4k((size_t)NB * NCMP * 2 * 64 * 4);
constexpr size_t WS_Y = WS_ACT + (size_t)MAXTILES * 256 * 1024 * 2;
constexpr size_t WS_TOKE = WS_Y + (size_t)MAXTILES * 256 * 1024 * 2;
constexpr size_t WS_TOKW = WS_TOKE + (size_t)T * 16;
constexpr size_t WS_TOKP = WS_TOKW + (size_t)T * 16;
constexpr size_t WS_SLOT = WS_TOKP + (size_t)T * 16;
constexpr size_t WS_XC = WS_SLOT + (size_t)NE * CAP * 4;
constexpr size_t WS_YS = WS_XC + (size_t)T * 3072 * 4;
constexpr size_t WS_DT = WS_YS + (size_t)T * 2048 * 4;
constexpr size_t WS_MODF = WS_DT + (size_t)T * 32 * 4;
constexpr size_t WS_WV = WS_MODF + (size_t)2 * 4 * 6144 * 4;
constexpr size_t WS_VT = WS_WV + (size_t)768 * 1024 * 2;
constexpr size_t WS_QNB = WS_VT + (size_t)768 * T * 2;
constexpr size_t WS_KSN = WS_QNB + (size_t)T * 512 * 2;
constexpr size_t WS_KWN = WS_KSN + (size_t)T * 128 * 2;
constexpr size_t WS_KCB = WS_KWN + (size_t)T * 128 * 2;
constexpr size_t WS_VCT = WS_KCB + (size_t)8 * 256 * 64 * 2;
constexpr size_t WS_DT2 = WS_VCT + (size_t)8 * 64 * 256 * 2;
constexpr size_t WS_CS = WS_DT2 + (size_t)NB * 32 * S * 4;
constexpr size_t WS_DEC = WS_CS + (size_t)NB * 32 * S * 4;
constexpr size_t WS_END = WS_DEC + al4k((size_t)NB * 16 * 32 * 4);
constexpr size_t WS_ZBC = WS_BIG, WS_XT = WS_XC, WS_XCT = WS_XC + (size_t)3072 * T * 2, WS_ST = WS_YS, WS_PB = WS_YS + (size_t)NB * 16 * 32 * 8192 * 4, WS_BCM = WS_QN;
static_assert(WS_XCT + (size_t)2560 * T * 2 <= WS_YS && WS_PB + (size_t)NB * 16 * 32 * 8192 * 2 <= WS_DT && (size_t)T * 1024 * 2 <= (size_t)T * 512 * 4, "layer-1 overlays");

constexpr int RING_BYTES = 131072;
constexpr int TAB_OFF = RING_BYTES;
constexpr int XB_OFF = RING_BYTES + 1024;
constexpr int LDS_BYTES = 147456;

struct Params { const float* in[30]; float* out; unsigned char* ws; };

__device__ __forceinline__ float siluf(float v) { return v / (1.f + expf(-v)); }
__device__ __forceinline__ float logsig(float x) { return fminf(x, 0.f) - log1pf(expf(-fabsf(x))); }
__device__ __forceinline__ float wave_sum(float v) {
#pragma unroll
    for (int o = 32; o > 0; o >>= 1) v += __shfl_xor(v, o);
    return v;
}
__device__ __forceinline__ float wave_max(float v) {
#pragma unroll
    for (int o = 32; o > 0; o >>= 1) v = fmaxf(v, __shfl_xor(v, o));
    return v;
}
__device__ __forceinline__ unsigned f2bf(float f) { unsigned u = __builtin_bit_cast(unsigned, f); return (u + 0x7fffu + ((u >> 16) & 1u)) >> 16; }
__device__ __forceinline__ unsigned pk2(float lo, float hi) { return f2bf(lo) | (f2bf(hi) << 16); }
__device__ __forceinline__ float bf2f(bf16_t v) { return __uint_as_float((unsigned)v << 16); }
__device__ __forceinline__ float bflo(unsigned w) { return __uint_as_float(w << 16); }
__device__ __forceinline__ float bfhi(unsigned w) { return __uint_as_float(w & 0xffff0000u); }
#define LDS_WAIT() asm volatile("s_waitcnt lgkmcnt(0)" ::: "memory")
__device__ __forceinline__ int fresh(int v) { asm volatile("" : "+v"(v)); return v; }

#define XB_TMO      128
#define XB_XCNT(j)  (256  + 64 * (j))
#define XB_XSUB(j)  (1280 + 64 * (j))
#define XB_XGEN(j)  (2304 + 64 * (j))
#define XB_TOP      3328
#define XB_TOPGEN   3392
#define XCD_BAR_WORDS 3456
#define XB_SPIN_CAP (1u << 18)
__device__ __forceinline__ unsigned xb_ld(unsigned* p)              { return __hip_atomic_load(p, __ATOMIC_RELAXED, __HIP_MEMORY_SCOPE_AGENT); }
__device__ __forceinline__ unsigned xb_add(unsigned* p, unsigned v) { return __hip_atomic_fetch_add(p, v, __ATOMIC_RELAXED, __HIP_MEMORY_SCOPE_AGENT); }
__device__ __forceinline__ unsigned xb_xcc_id() { return (unsigned)__builtin_amdgcn_s_getreg((3 << 11) | 20) & 0xFu; }
#define XB_SPIN(cond, bar) do { unsigned _sp = 0; while (cond) { __builtin_amdgcn_s_sleep(1); \
    if ((++_sp & 255u) == 0u) { if (xb_ld(&(bar)[XB_TMO])) break; if (_sp > XB_SPIN_CAP) { atomicAdd(&(bar)[XB_TMO], 1u); break; } } } } while (0)
struct XcdBarrier { unsigned* bar; unsigned x; volatile LAS unsigned* st; };
__device__ __forceinline__ XcdBarrier xcd_barrier_post(unsigned* bar, volatile LAS unsigned* st) {
    XcdBarrier b; b.bar = bar; b.x = xb_xcc_id(); b.st = st;
    if (threadIdx.x == 0) (void)xb_add(&bar[XB_XCNT(b.x)], 1u);
    return b;
}
__device__ __forceinline__ void xcd_barrier_complete(unsigned* bar, unsigned x, unsigned& nloc, unsigned& nx) {
    const unsigned G = gridDim.x * gridDim.y * gridDim.z;
    unsigned sum, cnt, mine, sp = 0u;
    for (;;) {
        sum = 0u; cnt = 0u; mine = 0u;
#pragma unroll
        for (unsigned j = 0; j < 16; ++j) { const unsigned c = xb_ld(&bar[XB_XCNT(j)]); sum += c; cnt += (c > 0u) ? 1u : 0u; mine = (j == x) ? c : mine; }
        if (sum == G) break;
        __builtin_amdgcn_s_sleep(1);
        if ((++sp & 255u) == 0u) { if (xb_ld(&bar[XB_TMO])) break; if (sp > XB_SPIN_CAP) { atomicAdd(&bar[XB_TMO], 1u); break; } }
    }
    nloc = mine > 0u ? mine : 1u; nx = cnt > 0u ? cnt : 1u;
}
__device__ __forceinline__ void xcd_barrier(const XcdBarrier& b) {
    asm volatile("s_waitcnt vmcnt(0)" ::: "memory");
    __syncthreads();
    if (threadIdx.x == 0) {
        unsigned* bar = b.bar;
        __builtin_amdgcn_s_waitcnt(0);
        unsigned nloc = b.st[0], nx = b.st[1];
        if (nloc == 0u) { xcd_barrier_complete(bar, b.x, nloc, nx); b.st[0] = nloc; b.st[1] = nx; }
        const unsigned old = xb_add(&bar[XB_XSUB(b.x)], 1u);
        const unsigned gen = old / nloc;
        if (old + 1u == (gen + 1u) * nloc) {
            __builtin_amdgcn_fence(__ATOMIC_RELEASE, "agent");
            asm volatile("s_waitcnt vmcnt(0)" ::: "memory");
            const unsigned og = xb_add(&bar[XB_TOP], 1u);
            const unsigned tg = og / nx;
            if (og + 1u == (tg + 1u) * nx) xb_add(&bar[XB_TOPGEN], 1u);
            else XB_SPIN(xb_ld(&bar[XB_TOPGEN]) == tg, bar);
            __builtin_amdgcn_fence(__ATOMIC_ACQUIRE, "agent");
            xb_add(&bar[XB_XGEN(b.x)], 1u);
            asm volatile("s_waitcnt vmcnt(0)" ::: "memory");
        } else {
            XB_SPIN(xb_ld(&bar[XB_XGEN(b.x)]) == gen, bar);
            __builtin_amdgcn_fence(__ATOMIC_ACQUIRE, "agent");
            asm volatile("s_waitcnt vmcnt(0)" ::: "memory");
        }
    }
    __syncthreads();
}

namespace pg8 {
constexpr int BM = 256, BK = 64, HALF = 128, HTB = HALF * BK * 2, STAGE_BYTES = 8 * HTB;
__device__ __forceinline__ int lds_byte(int r, int c) { const int st = (r >> 4) * 2 + (c >> 5), rr = r & 15, cc = c & 31, ob = rr * 64 + cc * 2; return st * 1024 + (ob ^ (((ob >> 9) & 1) << 5)); }
__device__ __forceinline__ void stage_rc(int b, int& R, int& C) { const int st = b / 1024, sb = b % 1024, swz = sb ^ (((sb >> 9) & 1) << 5); R = (st >> 1) * 16 + swz / 64; C = (st & 1) * 32 + (swz % 64) / 2; }
__device__ __forceinline__ int perm32(int rho) { const int n = rho >> 4, i = rho & 15; return 8 * (i >> 2) + 4 * n + (i & 3); }
struct Unit { int pm, pn, e; };
struct Gemm { const bf16_t* A; const bf16_t* Bt; int K; };
__device__ __forceinline__ unsigned cvt_pk_bf16(float lo, float hi) { unsigned r; asm volatile("v_cvt_pk_bf16_f32 %0, %1, %2" : "=v"(r) : "v"(lo), "v"(hi)); return r; }

struct DenseOrder {
    int nM, nN, nwg, G, c;
    __device__ void init(int M, int N, int G_, int c_) { nM = M / BM; nN = N / BM; nwg = nM * nN; G = G_; c = c_; }
    __device__ bool next(int i, Unit& u) const {
        const long L = (long)i * G + c; if (L >= nwg) return false;
        int wgid = (int)L; { const int q = nwg / 8, r = nwg % 8, xcd = wgid % 8, off = wgid / 8; wgid = (xcd < r ? xcd * (q + 1) : r * (q + 1) + (xcd - r) * q) + off; }
        const int nig = 8 * nN, gid = wgid / nig, fm = gid * 8, gsz = (nM - fm) < 8 ? (nM - fm) : 8;
        u.pm = fm + ((wgid % nig) % gsz); u.pn = (wgid % nig) / gsz; u.e = 0; return true;
    }
    __device__ __forceinline__ unsigned arow(const Unit& u, int r) const { return (unsigned)(u.pm * BM + r); }
};
struct MoeOrder {
    const LAS int* tb; const LAS int* cn; const int* slot_tok; int shift, G, c; bool gather;
    __device__ bool next(int i, Unit& u) const {
        const int L = i * G + c, tile = L >> shift; if (tile >= tb[NE]) return false;
        int e = 0; while (tb[e + 1] <= tile) ++e;
        u.pm = tile; u.pn = (e << shift) + (L & ((1 << shift) - 1)); u.e = e; return true;
    }
    __device__ __forceinline__ unsigned arow(const Unit& u, int r) const {
        if (!gather) return (unsigned)(u.pm * BM + r);
        const int pos = (u.pm - tb[u.e]) * BM + r;
        return pos < cn[u.e] ? (unsigned)slot_tok[u.e * CAP + pos] : 0u;
    }
};

struct EpiBf16 {
    static constexpr bool PERM = true;
    bf16_t* O; int ldc;
    __device__ __forceinline__ void operator()(const f32x4 (&acc)[2][2][4][2], const Unit& u, int wr, int wc, int fr, int fq) const {
        const int row0 = u.pm * BM + wr * 64 + fr, col0 = u.pn * BM + wc * 32 + 8 * fq;
#pragma unroll
        for (int ai = 0; ai < 2; ++ai)
#pragma unroll
            for (int m = 0; m < 4; ++m) { bf16_t* rowp = O + (size_t)(row0 + ai * HALF + m * 16) * ldc + col0;
#pragma unroll
                for (int bj = 0; bj < 2; ++bj) { const f32x4 v0 = acc[ai][bj][m][0], v1 = acc[ai][bj][m][1];
                    u32x4 w; w.x = cvt_pk_bf16(v0[0], v0[1]); w.y = cvt_pk_bf16(v0[2], v0[3]); w.z = cvt_pk_bf16(v1[0], v1[1]); w.w = cvt_pk_bf16(v1[2], v1[3]);
                    *(u32x4*)(rowp + bj * HALF) = w; } }
    }
};
struct EpiResid {
    static constexpr bool PERM = false;
    const float* base; float* out; const float* g;
    __device__ __forceinline__ void operator()(const f32x4 (&acc)[2][2][4][2], const Unit& u, int wr, int wc, int fr, int fq) const {
        const int row0 = u.pm * BM + wr * 64 + fr, col0 = u.pn * BM + wc * 32 + 4 * fq;
        const float* gb = g + (size_t)((u.pm * BM) / S) * 6144 + col0;
        f32x4 gv[2][2];
#pragma unroll
        for (int bj = 0; bj < 2; ++bj)
#pragma unroll
            for (int n = 0; n < 2; ++n) gv[bj][n] = *(const f32x4*)(gb + bj * HALF + n * 16);
#pragma unroll
        for (int ai = 0; ai < 2; ++ai)
#pragma unroll
            for (int m = 0; m < 4; ++m) { const size_t off = (size_t)(row0 + ai * HALF + m * 16) * D + col0;
#pragma unroll
                for (int bj = 0; bj < 2; ++bj)
#pragma unroll
                    for (int n = 0; n < 2; ++n) { const f32x4 bs = *(const f32x4*)(base + off + bj * HALF + n * 16);
                        *(f32x4*)(out + off + bj * HALF + n * 16) = bs + gv[bj][n] * acc[ai][bj][m][n]; } }
    }
};
struct EpiGu {
    static constexpr bool PERM = true;
    bf16_t* act; const float* bgu;
    __device__ __forceinline__ void operator()(const f32x4 (&acc)[2][2][4][2], const Unit& u, int wr, int wc, int fr, int fq) const {
        const int row0 = u.pm * BM + wr * 64 + fr, col0 = (u.pn & 7) * HALF + wc * 32 + 8 * fq;
        const float* bb = bgu + (size_t)u.e * 2048 + col0;
        const f32x4 bg0 = *(const f32x4*)(bb), bg1 = *(const f32x4*)(bb + 4), bu0 = *(const f32x4*)(bb + 1024), bu1 = *(const f32x4*)(bb + 1028);
#pragma unroll
        for (int ai = 0; ai < 2; ++ai)
#pragma unroll
            for (int m = 0; m < 4; ++m) {
                float r[8];
#pragma unroll
                for (int n = 0; n < 2; ++n) { const f32x4 gt = acc[ai][0][m][n] + (n ? bg1 : bg0), up = acc[ai][1][m][n] + (n ? bu1 : bu0);
#pragma unroll
                    for (int j = 0; j < 4; ++j) { const float gg = fminf(gt[j], 7.f), uu = fminf(fmaxf(up[j], -7.f), 7.f);
                        r[n * 4 + j] = (uu + 1.f) * gg * __builtin_amdgcn_rcpf(1.f + __expf(-1.702f * gg)); } }
                u32x4 w; w.x = cvt_pk_bf16(r[0], r[1]); w.y = cvt_pk_bf16(r[2], r[3]); w.z = cvt_pk_bf16(r[4], r[5]); w.w = cvt_pk_bf16(r[6], r[7]);
                *(u32x4*)(act + (size_t)(row0 + ai * HALF + m * 16) * D + col0) = w; }
    }
};
struct EpiDown {
    static constexpr bool PERM = true;
    bf16_t* y; const float* bd;
    __device__ __forceinline__ void operator()(const f32x4 (&acc)[2][2][4][2], const Unit& u, int wr, int wc, int fr, int fq) const {
        const int row0 = u.pm * BM + wr * 64 + fr, col0 = (u.pn & 3) * BM + wc * 32 + 8 * fq;
        const float* bb = bd + (size_t)u.e * 1024 + col0;
        f32x4 bv[2][2];
#pragma unroll
        for (int bj = 0; bj < 2; ++bj)
#pragma unroll
            for (int n = 0; n < 2; ++n) bv[bj][n] = *(const f32x4*)(bb + bj * HALF + 4 * n);
#pragma unroll
        for (int ai = 0; ai < 2; ++ai)
#pragma unroll
            for (int m = 0; m < 4; ++m) { bf16_t* rowp = y + (size_t)(row0 + ai * HALF + m * 16) * D + col0;
#pragma unroll
                for (int bj = 0; bj < 2; ++bj) { const f32x4 v0 = acc[ai][bj][m][0] + bv[bj][0], v1 = acc[ai][bj][m][1] + bv[bj][1];
                    u32x4 w; w.x = cvt_pk_bf16(v0[0], v0[1]); w.y = cvt_pk_bf16(v0[2], v0[3]); w.z = cvt_pk_bf16(v1[0], v1[1]); w.w = cvt_pk_bf16(v1[2], v1[3]);
                    *(u32x4*)(rowp + bj * HALF) = w; } }
    }
};

template <class Epi, class Sched>
__device__ __forceinline__ void gemm_phase(LAS unsigned char* lds, const Gemm g, const Sched& S, const Epi& E, const int tid) {
    const int wid = __builtin_amdgcn_readfirstlane(tid >> 6), lane = tid & 63, wr = wid >> 2, wc = wid & 3, fr = lane & 15, fq = lane >> 4;
    const int K = g.K, nt = K / BK;
    int RA[2], CA[2]; unsigned voffB[2];
#pragma unroll
    for (int i = 0; i < 2; ++i) { int R, C; stage_rc(tid * 16 + i * 8192, R, C); const int Rb = Epi::PERM ? ((R & ~31) + perm32(R & 31)) : R;
        RA[i] = R; CA[i] = C; voffB[i] = (unsigned)(Rb * K + C) * 2u; }
    const size_t kstep = (size_t)(BK * 2);
    const size_t hstep = (size_t)HALF * K * 2;
    const size_t tstep = 2 * hstep;
    const unsigned ldsw = (unsigned)wid * 1024u;
    const int aoff = lds_byte(wr * 64 + fr, fq * 8), boff = lds_byte(wc * 32 + fr, fq * 8);
#define PG8_SA(b, h) (((b) * 2 + (h)) * HTB)
#define PG8_SB(b, h) ((4 + (b) * 2 + (h)) * HTB)
#define PG8_STAGE(bufoff, gbase, voff) do { _Pragma("unroll") for (int _i = 0; _i < 2; ++_i) \
        __builtin_amdgcn_global_load_lds((const unsigned*)((const char*)(gbase) + (voff)[_i]), (LAS unsigned*)(lds + (bufoff) + ldsw + _i * 8192), 16, 0, 0); } while (0)
#define PG8_LDA(dst, b, h) do { _Pragma("unroll") for (int m = 0; m < 4; ++m) _Pragma("unroll") for (int k = 0; k < 2; ++k) dst[m][k] = *(const LAS bf16x8*)(lds + PG8_SA(b, h) + aoff + m * 2048 + k * 1024); } while (0)
#define PG8_LDB(dst, b, h) do { _Pragma("unroll") for (int n = 0; n < 2; ++n) _Pragma("unroll") for (int k = 0; k < 2; ++k) dst[n][k] = *(const LAS bf16x8*)(lds + PG8_SB(b, h) + boff + n * 2048 + k * 1024); } while (0)
#define PG8_MMA(ai, bj, At, Bt) do { __builtin_amdgcn_s_setprio(1); _Pragma("unroll") for (int m = 0; m < 4; ++m) _Pragma("unroll") for (int n = 0; n < 2; ++n) _Pragma("unroll") for (int k = 0; k < 2; ++k) \
        acc[ai][bj][m][n] = __builtin_amdgcn_mfma_f32_16x16x32_bf16(Bt[n][k], At[m][k], acc[ai][bj][m][n], 0, 0, 0); __builtin_amdgcn_s_setprio(0); } while (0)
#define PG8_WAIT_V(n) asm volatile("s_waitcnt vmcnt(" #n ")" ::: "memory")
#define PG8_WAIT_L(n) asm volatile("s_waitcnt lgkmcnt(" #n ")" ::: "memory")
#define PG8_BAR __builtin_amdgcn_s_barrier()
#define PG8_SCHED __builtin_amdgcn_sched_barrier(0)
#define PG8_AOFF(dst, u) do { _Pragma("unroll") for (int _h = 0; _h < 2; ++_h) _Pragma("unroll") for (int _i = 0; _i < 2; ++_i) dst[_h][_i] = (S.arow(u, _h * HALF + RA[_i]) * (unsigned)K + (unsigned)CA[_i]) * 2u; } while (0)
    Unit cur, nxt; int ui = 0;
    if (!S.next(0, cur)) return;
    f32x4 acc[2][2][4][2];
#pragma unroll
    for (int a = 0; a < 2; ++a)
#pragma unroll
        for (int b = 0; b < 2; ++b)
#pragma unroll
            for (int m = 0; m < 4; ++m)
#pragma unroll
                for (int n = 0; n < 2; ++n) acc[a][b][m][n] = (f32x4){0.f, 0.f, 0.f, 0.f};
    bf16x8 At[4][2], B0[2][2], B1[2][2];
    unsigned va[2][2], vn[2][2];
    PG8_AOFF(va, cur);
    const char* Ab = (const char*)g.A;
    const char* cB = (const char*)g.Bt + (size_t)cur.pn * tstep;
    PG8_STAGE(PG8_SB(0, 0), cB, voffB); PG8_STAGE(PG8_SB(0, 1), cB + hstep, voffB); PG8_STAGE(PG8_SA(0, 0), Ab, va[0]); PG8_STAGE(PG8_SA(0, 1), Ab, va[1]);
    if (wr == 1) PG8_BAR;
    PG8_WAIT_V(2); PG8_BAR;
    PG8_STAGE(PG8_SB(1, 0), cB + kstep, voffB); PG8_STAGE(PG8_SA(1, 0), Ab + kstep, va[0]); PG8_STAGE(PG8_SB(1, 1), cB + hstep + kstep, voffB);
    PG8_WAIT_V(6); PG8_BAR;
    for (;;) {
        const bool has_next = S.next(ui + 1, nxt);
        if (has_next) { PG8_AOFF(vn, nxt); }
        else {
#pragma unroll
            for (int h = 0; h < 2; ++h)
#pragma unroll
                for (int i = 0; i < 2; ++i) vn[h][i] = va[h][i]; }
        const char* nB = has_next ? (const char*)g.Bt + (size_t)nxt.pn * tstep : cB;
        for (int t = 0; t < nt; t += 2) {
            const bool last = (t == nt - 2);
            const char* a1 = Ab + (size_t)(t + 1) * kstep;
            const char* a2 = last ? Ab : Ab + (size_t)(t + 2) * kstep; const char* b2 = last ? nB : cB + (size_t)(t + 2) * kstep;
            const char* a3 = a2 + kstep; const char* b3 = b2 + kstep;
            unsigned o2[2][2];
#pragma unroll
            for (int h = 0; h < 2; ++h)
#pragma unroll
                for (int i = 0; i < 2; ++i) o2[h][i] = last ? vn[h][i] : va[h][i];
            PG8_LDB(B0, 0, 0); PG8_LDB(B1, 0, 1); PG8_SCHED; PG8_LDA(At, 0, 0); PG8_STAGE(PG8_SA(1, 1), a1, va[1]);
            PG8_WAIT_V(8); PG8_WAIT_L(0); PG8_BAR; PG8_MMA(0, 0, At, B0); PG8_MMA(0, 1, At, B1); PG8_BAR; PG8_SCHED;
            PG8_LDA(At, 0, 1); PG8_STAGE(PG8_SB(0, 0), b2, voffB); PG8_STAGE(PG8_SB(0, 1), b2 + hstep, voffB); PG8_STAGE(PG8_SA(0, 0), a2, o2[0]);
            PG8_WAIT_V(8); PG8_WAIT_L(0); PG8_BAR; PG8_MMA(1, 0, At, B0); PG8_MMA(1, 1, At, B1); PG8_BAR; PG8_SCHED;
            PG8_LDB(B0, 1, 0); PG8_LDB(B1, 1, 1); PG8_SCHED; PG8_LDA(At, 1, 0); PG8_STAGE(PG8_SA(0, 1), a2, o2[1]);
            PG8_WAIT_V(8); PG8_WAIT_L(0); PG8_BAR; PG8_MMA(0, 0, At, B0); PG8_MMA(0, 1, At, B1); PG8_BAR; PG8_SCHED;
            PG8_LDA(At, 1, 1); PG8_STAGE(PG8_SB(1, 0), b3, voffB); PG8_STAGE(PG8_SB(1, 1), b3 + hstep, voffB); PG8_STAGE(PG8_SA(1, 0), a3, o2[0]);
            PG8_WAIT_V(8); PG8_WAIT_L(0); PG8_BAR; PG8_MMA(1, 0, At, B0); PG8_MMA(1, 1, At, B1); PG8_BAR; PG8_SCHED;
        }
        if (wr == 0) PG8_BAR;
        E(acc, cur, wr, wc, fr, fq);
        if (!has_next) break;
#pragma unroll
        for (int a = 0; a < 2; ++a)
#pragma unroll
            for (int b = 0; b < 2; ++b)
#pragma unroll
                for (int m = 0; m < 4; ++m)
#pragma unroll
                    for (int n = 0; n < 2; ++n) acc[a][b][m][n] = (f32x4){0.f, 0.f, 0.f, 0.f};
        cur = nxt; cB = nB; ++ui;
#pragma unroll
        for (int h = 0; h < 2; ++h)
#pragma unroll
            for (int i = 0; i < 2; ++i) va[h][i] = vn[h][i];
        if (wr == 1) PG8_BAR;
    }
    PG8_WAIT_V(0);
    PG8_BAR;
#undef PG8_SA
#undef PG8_SB
#undef PG8_STAGE
#undef PG8_LDA
#undef PG8_LDB
#undef PG8_MMA
#undef PG8_WAIT_V
#undef PG8_WAIT_L
#undef PG8_BAR
#undef PG8_SCHED
#undef PG8_AOFF
}
}

struct Ctx {
    LAS unsigned char* lds; unsigned char* ws;
    int tid, lane, wave, gw, ngw, G, bid;
};

__device__ __forceinline__ void transpose_item(const float* W, int ldw, int K, int nvalid, int k0, int n0, bf16_t* WT, int row0, LAS float* scr, int lane) {
    const int nn = n0 + (lane & 31);
#pragma unroll 8
    for (int i = 0; i < 32; ++i) { const int kk = 2 * i + (lane >> 5); scr[kk * 33 + (lane & 31)] = nn < nvalid ? W[(size_t)(k0 + kk) * ldw + nn] : 0.f; }
    LDS_WAIT(); asm volatile("" ::: "memory");
    const int c = lane & 7;
#pragma unroll
    for (int j = 0; j < 4; ++j) { const int n = (lane >> 3) + 8 * j; const LAS float* s = scr + (8 * c) * 33 + n;
        u32x4 o; o.x = pk2(s[0 * 33], s[1 * 33]); o.y = pk2(s[2 * 33], s[3 * 33]); o.z = pk2(s[4 * 33], s[5 * 33]); o.w = pk2(s[6 * 33], s[7 * 33]);
        *(u32x4*)(WT + (size_t)(row0 + n) * K + k0 + 8 * c) = o; }
    LDS_WAIT(); asm volatile("" ::: "memory");
}
__device__ __forceinline__ void ph_prologue(const Params& p, const Ctx& X) {
    LAS float* scr = (LAS float*)(X.lds + X.wave * 16384);
    unsigned char* ws = X.ws;
    constexpr int I_MOD = 2 * 96 * 8;
    constexpr int I_WIN = 16 * 96, I_WV = 16 * 24, I_WOUT = 16 * 32, I_WSIN = 16 * 160, I_WSOUT = 32 * 32, I_GU = 64 * 1024, I_DN = 64 * 512;
    constexpr int NITEMS = I_MOD + I_WIN + I_WV + I_WOUT + I_WSIN + I_WSOUT + I_GU + I_DN;
    for (int it = X.gw; it < NITEMS; it += X.ngw) {
        int r = it;
        if (r < I_MOD) {
            const int kp = r & 7, jb = (r >> 3) % 96, l = r / (8 * 96), j = jb * 64 + X.lane;
            const float* w = p.in[2] + (size_t)l * 1024 * 6144 + (size_t)(kp * 128) * 6144 + j;
            const float* c = p.in[1] + kp * 128;
            float a0 = 0.f, a1 = 0.f, a2 = 0.f, a3 = 0.f;
#pragma unroll 8
            for (int i = 0; i < 128; ++i) { const float wv = w[(size_t)i * 6144];
                a0 += siluf(c[i]) * wv; a1 += siluf(c[1024 + i]) * wv; a2 += siluf(c[2048 + i]) * wv; a3 += siluf(c[3072 + i]) * wv; }
            if (kp == 0) { const float bb = p.in[3][l * 6144 + j]; a0 += bb; a1 += bb; a2 += bb; a3 += bb; }
            unsigned long long* mq = (unsigned long long*)(ws + CTL_MOD) + (size_t)l * 4 * 6144 + j;
            atomicAdd(mq, (unsigned long long)__double2ll_rn((double)a0 * 1099511627776.0)); atomicAdd(mq + 6144, (unsigned long long)__double2ll_rn((double)a1 * 1099511627776.0));
            atomicAdd(mq + 2 * 6144, (unsigned long long)__double2ll_rn((double)a2 * 1099511627776.0)); atomicAdd(mq + 3 * 6144, (unsigned long long)__double2ll_rn((double)a3 * 1099511627776.0));
            continue;
        }
        r -= I_MOD;
        if (r < I_WIN) { const int kb = r / 96, nb = r % 96; transpose_item(p.in[6], ATTN_IN, 1024, ATTN_IN, kb * 64, nb * 32, (bf16_t*)(ws + WS_WIN), nb * 32, scr, X.lane); continue; } r -= I_WIN;
        if (r < I_WV) { const int kb = r / 24, nb = r % 24, r0 = nb * 32, src = r0 < 512 ? OFF_SBV + r0 : (r0 < 640 ? OFF_VS + (r0 - 512) : OFF_VW + (r0 - 640));
            transpose_item(p.in[6], ATTN_IN, 1024, ATTN_IN, kb * 64, src, (bf16_t*)(ws + WS_WV), r0, scr, X.lane); continue; } r -= I_WV;
        if (r < I_WOUT) { const int kb = r / 32, nb = r % 32; transpose_item(p.in[7], 1024, 1024, 1024, kb * 64, nb * 32, (bf16_t*)(ws + WS_WOUT), nb * 32, scr, X.lane); continue; } r -= I_WOUT;
        if (r < I_WSIN) { const int kb = r / 160, nb = r % 160, n0 = nb * 32, row0 = n0 < 2048 ? n0 : (n0 < 4096 ? n0 + 1024 : n0 - 2048);
            transpose_item(p.in[16], SSM_IN, 1024, SSM_IN, kb * 64, n0, (bf16_t*)(ws + WS_WSIN), row0, scr, X.lane); continue; } r -= I_WSIN;
        if (r < I_WSOUT) { const int kb = r / 32, nb = r % 32; transpose_item(p.in[23], 1024, 2048, 1024, kb * 64, nb * 32, (bf16_t*)(ws + WS_WSOUT), nb * 32, scr, X.lane); continue; } r -= I_WSOUT;
        if (r < I_GU) { const int m = r >> 10, q = r & 1023, kb = q >> 6, nb = q & 63, n0 = nb * 32;
            const int row0 = ((n0 & 1023) >> 7) * 256 + (n0 >> 10) * 128 + (n0 & 127);
            transpose_item(p.in[26] + (size_t)m * 1024 * 2048, 2048, 1024, 2048, kb * 64, n0, (bf16_t*)(ws + WS_WGU) + (size_t)m * 2048 * 1024, row0, scr, X.lane); continue; } r -= I_GU;
        { const int m = r >> 9, q = r & 511, kb = q >> 5, nb = q & 31;
            transpose_item(p.in[28] + (size_t)m * 1024 * 1024, 1024, 1024, 1024, kb * 64, nb * 32, (bf16_t*)(ws + WS_WDN) + (size_t)m * 1024 * 1024, nb * 32, scr, X.lane); }
    }
}

struct Row { f32x4 v[4]; };
__device__ __forceinline__ void row_load(Row& r, const float* p, int lane) {
#pragma unroll
    for (int j = 0; j < 4; ++j) r.v[j] = ((const f32x4*)p)[64 * j + lane];
}
__device__ __forceinline__ void row_store(const Row& r, float* p, int lane) {
#pragma unroll
    for (int j = 0; j < 4; ++j) ((f32x4*)p)[64 * j + lane] = r.v[j];
}
template <class PV>
__device__ __forceinline__ void row_norm_mod(const Row& r, Row& o, const float* gain, PV sc, PV sh, int lane) {
    float ss = 0.f;
#pragma unroll
    for (int j = 0; j < 4; ++j) ss += (r.v[j].x * r.v[j].x + r.v[j].y * r.v[j].y) + (r.v[j].z * r.v[j].z + r.v[j].w * r.v[j].w);
    const float rs = rsqrtf(wave_sum(ss) * (1.f / 1024.f) + EPS);
#pragma unroll
    for (int j = 0; j < 4; ++j) { const f32x4 g = ((const f32x4*)gain)[64 * j + lane], a = sc[64 * j + lane], b = sh[64 * j + lane];
        o.v[j] = r.v[j] * rs * g * (a + 1.f) + b; }
}
__device__ __forceinline__ void row_store_bf16(const Row& r, bf16_t* p, int lane) {
#pragma unroll
    for (int j = 0; j < 4; ++j) { u32x2 w; w.x = pk2(r.v[j].x, r.v[j].y); w.y = pk2(r.v[j].z, r.v[j].w); ((u32x2*)p)[64 * j + lane] = w; }
}
__device__ __forceinline__ void row_store_lds(const Row& r, LAS float* p, int lane) {
#pragma unroll
    for (int j = 0; j < 4; ++j) ((LAS f32x4*)p)[64 * j + lane] = r.v[j];
}
__device__ __forceinline__ void skinny4(const LAS float* scr, const float* W, int ldw, int col0, int lane, float (&acc)[4]) {
    const int e = lane & 31, half = lane >> 5;
    acc[0] = acc[1] = acc[2] = acc[3] = 0.f;
    const float* w = W + (size_t)(half * 512) * ldw + col0 + e;
    const LAS float* s = scr + half * 512;
#pragma unroll 2
    for (int i = 0; i < 512; i += 4) {
        const float w0 = w[(size_t)i * ldw], w1 = w[(size_t)(i + 1) * ldw], w2 = w[(size_t)(i + 2) * ldw], w3 = w[(size_t)(i + 3) * ldw];
#pragma unroll
        for (int tk = 0; tk < 4; ++tk) { const f32x4 x = *(const LAS f32x4*)(s + tk * 1024 + i); acc[tk] += (x.x * w0 + x.y * w1) + (x.z * w2 + x.w * w3); }
    }
#pragma unroll
    for (int tk = 0; tk < 4; ++tk) acc[tk] += __shfl_xor(acc[tk], 32);
}
__device__ __forceinline__ void route_token(float logit, int t, int l, const Ctx& X) {
    const int lane = X.lane, e = lane & 31;
    float tl[4]; int te[4];
#pragma unroll
    for (int k = 0; k < 4; ++k) {
        float bv = logit; int bi = e;
#pragma unroll
        for (int o = 16; o > 0; o >>= 1) { const float ov = __shfl_xor(bv, o); const int oi = __shfl_xor(bi, o); if (ov > bv || (ov == bv && oi < bi)) { bv = ov; bi = oi; } }
        tl[k] = bv; te[k] = bi;
        if (e == bi) logit = -INFINITY;
    }
    if (lane < 4) {
        const float e1 = expf(tl[1] - tl[0]), e2 = expf(tl[2] - tl[0]), e3 = expf(tl[3] - tl[0]);
        const float inv = 1.f / (1.f + e1 + e2 + e3);
        const float wv = (lane == 0 ? 1.f : lane == 1 ? e1 : lane == 2 ? e2 : e3) * inv;
        const int ev = lane == 0 ? te[0] : lane == 1 ? te[1] : lane == 2 ? te[2] : te[3];
        unsigned* cnt = (unsigned*)(X.ws + WS_CTL) + CW_CNT + l * 32;
        const int pos = (int)atomicAdd(&cnt[ev], 1u);
        ((int*)(X.ws + WS_TOKE))[t * 4 + lane] = ev; ((float*)(X.ws + WS_TOKW))[t * 4 + lane] = wv; ((int*)(X.ws + WS_TOKP))[t * 4 + lane] = pos;
        ((int*)(X.ws + WS_SLOT))[ev * CAP + pos] = t;
    }
}

__device__ __forceinline__ float modq2f(long long q) { return (float)((double)q * 9.094947017729282e-13); }
__device__ __forceinline__ void ph_norm0(const Params& p, const Ctx& X) {
    const long long* mq = (const long long*)(X.ws + CTL_MOD);
    float* modf = (float*)(X.ws + WS_MODF);
    for (int i = X.bid * NTHREADS + X.tid; i < 2 * 4 * 6144; i += X.G * NTHREADS) modf[i] = modq2f(mq[i]);
    LAS float* tab = (LAS float*)X.lds;
    for (int i = X.tid; i < 4 * 2048; i += NTHREADS) tab[i] = modq2f(mq[(size_t)(i >> 11) * 6144 + (i & 2047)]);
    __syncthreads();
    for (int t = X.gw; t < T; t += X.ngw) {
        Row r, o; row_load(r, p.in[0] + (size_t)t * D, X.lane);
        const LAS float* m = tab + (t / S) * 2048;
        row_norm_mod(r, o, p.in[4], (const LAS f32x4*)(m + 1024), (const LAS f32x4*)m, X.lane);
        row_store_bf16(o, (bf16_t*)(X.ws + WS_U) + (size_t)t * D, X.lane);
    }
}
__device__ __forceinline__ void ph_router(const Params& p, const Ctx& X, int l, const float* h) {
    const float* mod = (const float*)(X.ws + WS_MODF) + (size_t)l * 4 * 6144;
    LAS float* scr = (LAS float*)(X.lds + X.wave * 16384);
    for (int g4 = X.gw; g4 < T / 4; g4 += X.ngw) {
#pragma unroll
        for (int tk = 0; tk < 4; ++tk) { const int t = g4 * 4 + tk;
            Row r, o; row_load(r, h + (size_t)t * D, X.lane);
            const float* m = mod + (size_t)(t / S) * 6144;
            row_norm_mod(r, o, p.in[5] + l * D, (const f32x4*)(m + 4096), (const f32x4*)(m + 3072), X.lane);
            row_store_bf16(o, (bf16_t*)(X.ws + WS_U) + (size_t)t * D, X.lane);
            row_store_lds(o, scr + tk * 1024, X.lane); }
        LDS_WAIT();
        float acc[4]; skinny4(scr, p.in[24] + (size_t)l * D * NE, NE, 0, X.lane, acc);
        const float bias = p.in[25][l * NE + (X.lane & 31)];
#pragma unroll
        for (int tk = 0; tk < 4; ++tk) route_token(acc[tk] + bias, g4 * 4 + tk, l, X);
        LDS_WAIT();
    }
}
__device__ __forceinline__ void moe_table(const Ctx& X, int l) {
    LAS int* tb = (LAS int*)(X.lds + TAB_OFF);
    if (X.tid == 0) {
        const unsigned* cnt = (const unsigned*)(X.ws + WS_CTL) + CW_CNT + l * 32;
        int base = 0;
        for (int e = 0; e < NE; ++e) { const int c = (int)__hip_atomic_load(cnt + e, __ATOMIC_RELAXED, __HIP_MEMORY_SCOPE_AGENT); tb[e] = base; tb[40 + e] = c; base += (c + 255) >> 8; }
        tb[NE] = base;
    }
    __syncthreads();
}
template <int MODE>
__device__ __forceinline__ void ph_combine(const Params& p, const Ctx& X, int l, const float* h, float* hn) {
    moe_table(X, l);
    const LAS int* tb = (const LAS int*)(X.lds + TAB_OFF);
    const float* mod = (const float*)(X.ws + WS_MODF) + (size_t)l * 4 * 6144;
    const float* mod1 = (const float*)(X.ws + WS_MODF) + (size_t)4 * 6144;
    const bf16_t* y = (const bf16_t*)(X.ws + WS_Y);
    LAS float* scr = (LAS float*)(X.lds + X.wave * 16384);
    for (int g4 = X.gw; g4 < T / 4; g4 += X.ngw) {
#pragma unroll
        for (int tk = 0; tk < 4; ++tk) { const int t = g4 * 4 + tk;
            Row r; row_load(r, h + (size_t)t * D, X.lane);
            const float* g2 = mod + (size_t)(t / S) * 6144 + 5120;
            Row s;
#pragma unroll
            for (int j = 0; j < 4; ++j) s.v[j] = (f32x4){0.f, 0.f, 0.f, 0.f};
#pragma unroll
            for (int k = 0; k < 4; ++k) {
                const int e = ((const int*)(X.ws + WS_TOKE))[t * 4 + k], pos = ((const int*)(X.ws + WS_TOKP))[t * 4 + k]; const float w = ((const float*)(X.ws + WS_TOKW))[t * 4 + k];
                const bf16_t* yr = y + (size_t)(tb[e] * 256 + pos) * D;
#pragma unroll
                for (int j = 0; j < 4; ++j) { const u32x2 q = ((const u32x2*)yr)[64 * j + X.lane];
                    s.v[j].x += w * bflo(q.x); s.v[j].y += w * bfhi(q.x); s.v[j].z += w * bflo(q.y); s.v[j].w += w * bfhi(q.y); }
            }
#pragma unroll
            for (int j = 0; j < 4; ++j) r.v[j] = r.v[j] + ((const f32x4*)g2)[64 * j + X.lane] * s.v[j];
            row_store(r, hn + (size_t)t * D, X.lane);
            if (MODE == 0) {
                Row o; const float* m = mod1 + (size_t)(t / S) * 6144;
                row_norm_mod(r, o, p.in[4] + D, (const f32x4*)(m + 1024), (const f32x4*)m, X.lane);
                row_store_bf16(o, (bf16_t*)(X.ws + WS_U) + (size_t)t * D, X.lane);
                row_store_lds(o, scr + tk * 1024, X.lane);
            }
        }
        if (MODE == 0) {
            LDS_WAIT();
            float acc[4]; skinny4(scr, p.in[16], SSM_IN, 5120, X.lane, acc);
            if (X.lane < 32) {
#pragma unroll
                for (int tk = 0; tk < 4; ++tk) ((float*)(X.ws + WS_DT))[(size_t)(g4 * 4 + tk) * 32 + X.lane] = acc[tk];
            }
            LDS_WAIT();
        }
    }
}

__device__ __forceinline__ void ld64bf(const bf16_t* p, float (&q)[64]) {
#pragma unroll
    for (int i = 0; i < 8; ++i) { const u32x4 w = ((const u32x4*)p)[i];
        q[8 * i] = bflo(w.x); q[8 * i + 1] = bfhi(w.x); q[8 * i + 2] = bflo(w.y); q[8 * i + 3] = bfhi(w.y); q[8 * i + 4] = bflo(w.z); q[8 * i + 5] = bfhi(w.z); q[8 * i + 6] = bflo(w.w); q[8 * i + 7] = bfhi(w.w); }
}
__device__ __forceinline__ float dot64bf(const bf16_t* p, const float (&q)[64]) {
    float d = 0.f;
#pragma unroll
    for (int i = 0; i < 8; ++i) { const u32x4 w = ((const u32x4*)p)[i];
        d += q[8 * i] * bflo(w.x) + q[8 * i + 1] * bfhi(w.x) + q[8 * i + 2] * bflo(w.y) + q[8 * i + 3] * bfhi(w.y) + q[8 * i + 4] * bflo(w.z) + q[8 * i + 5] * bfhi(w.z) + q[8 * i + 6] * bflo(w.w) + q[8 * i + 7] * bfhi(w.w); }
    return d;
}
__device__ __forceinline__ float dot64f(const float* p, const float (&q)[64]) {
    float d = 0.f;
#pragma unroll
    for (int i = 0; i < 16; ++i) { const f32x4 w = ((const f32x4*)p)[i]; d += (q[4 * i] * w.x + q[4 * i + 1] * w.y) + (q[4 * i + 2] * w.z + q[4 * i + 3] * w.w); }
    return d;
}
__device__ __forceinline__ void sb_unit(const Ctx& X, int qt, int bh) {
    const int b = bh >> 3, hh = bh & 7, t = qt * 64 + X.lane;
    const bf16_t* base = (const bf16_t*)(X.ws + WS_BIG) + (size_t)b * S * PROJ_LD;
    float q[64], acc[64];
    ld64bf(base + (size_t)t * PROJ_LD + OFF_SBQ + hh * 64, q);
#pragma unroll
    for (int d = 0; d < 64; ++d) acc[d] = 0.f;
    float run = 0.f;
    for (int j = qt * 64 + 62; j >= 0; --j) {
        const bf16_t* kr = base + (size_t)j * PROJ_LD + OFF_SBK + hh * 64;
        const float logit = dot64bf(kr, q) * 0.125f;
        if (j < t) {
            const float w = expf(logsig(logit) + run);
            run += logsig(-logit);
            const bf16_t* vr = base + (size_t)j * PROJ_LD + OFF_SBV + hh * 64;
#pragma unroll
            for (int i = 0; i < 8; ++i) { const u32x4 v = ((const u32x4*)vr)[i];
                acc[8 * i] += w * bflo(v.x); acc[8 * i + 1] += w * bfhi(v.x); acc[8 * i + 2] += w * bflo(v.y); acc[8 * i + 3] += w * bfhi(v.y);
                acc[8 * i + 4] += w * bflo(v.z); acc[8 * i + 5] += w * bfhi(v.z); acc[8 * i + 6] += w * bflo(v.w); acc[8 * i + 7] += w * bfhi(v.w); }
        }
    }
    bf16_t* op = (bf16_t*)(X.ws + WS_O) + (size_t)(b * S + t) * D + hh * 64;
#pragma unroll
    for (int i = 0; i < 8; ++i) { u32x4 w; w.x = pk2(acc[8 * i], acc[8 * i + 1]); w.y = pk2(acc[8 * i + 2], acc[8 * i + 3]); w.z = pk2(acc[8 * i + 4], acc[8 * i + 5]); w.w = pk2(acc[8 * i + 6], acc[8 * i + 7]);
        ((u32x4*)op)[i] = w; }
}

typedef float f32x16 __attribute__((ext_vector_type(16)));
__device__ __forceinline__ int pi32(int r) { return (r & 0x13) | ((r & 4) << 1) | ((r & 8) >> 1); }
__device__ __forceinline__ void sb_attn_unit(const Ctx& X, int bh, int qb) {
    const int b = bh >> 3, h = bh & 7, q0 = qb * 256, lane = fresh(X.lane), w = X.wave, ql = lane & 31, hf = lane >> 5;
    const bf16_t* proj = (const bf16_t*)(X.ws + WS_BIG) + (size_t)b * S * PROJ_LD;
    const bf16_t* vt = (const bf16_t*)(X.ws + WS_VT) + (size_t)(h * 64) * T + (size_t)b * S;
    const int tq = q0 + 32 * w + ql;
    bf16x8 qf[4];
#pragma unroll
    for (int s = 0; s < 4; ++s) qf[s] = *(const bf16x8*)(proj + (size_t)tq * PROJ_LD + OFF_SBQ + h * 64 + 16 * s + 8 * hf);
    f32x16 o0, o1;
#pragma unroll
    for (int i = 0; i < 16; ++i) { o0[i] = 0.f; o1[i] = 0.f; }
    float run = 0.f;
    const int nblk = 4 * qb + 4, jw = (q0 + 32 * w + 30) >> 6;
    const float CS = 0.125f * 1.4426950408889634f;
    const bf16_t* kg = proj + (size_t)lane * PROJ_LD + OFF_SBK + h * 64 + 8 * w;
    const bf16_t* vg = vt + (size_t)lane * T + 8 * w;
    LAS unsigned char* buf0 = X.lds;
    const int stoff = w * 1024 + lane * 16;
    u32x4 kreg = *(const u32x4*)(kg + (size_t)(64 * (nblk - 1)) * PROJ_LD), vreg = *(const u32x4*)(vg + 64 * (nblk - 1));
    *(LAS u32x4*)(buf0 + stoff) = kreg; *(LAS u32x4*)(buf0 + 8192 + stoff) = vreg;
    __syncthreads();
    const int krow = pi32(ql) * 16;
    for (int j = nblk - 1; j >= 0; --j) {
        LAS unsigned char* buf = buf0 + (((nblk - 1 - j) & 1) ? 16384 : 0);
        LAS unsigned char* nbuf = buf0 + (((nblk - 1 - j) & 1) ? 0 : 16384);
        if (j > 0) { kreg = *(const u32x4*)(kg + (size_t)(64 * (j - 1)) * PROJ_LD); vreg = *(const u32x4*)(vg + 64 * (j - 1)); }
        if (j <= jw) {
#pragma unroll
            for (int kt = 1; kt >= 0; --kt) {
                f32x16 sc;
#pragma unroll
                for (int i = 0; i < 16; ++i) sc[i] = 0.f;
#pragma unroll
                for (int s = 0; s < 4; ++s) { const bf16x8 kf = *(const LAS bf16x8*)(buf + (2 * s + hf) * 1024 + kt * 512 + krow); sc = __builtin_amdgcn_mfma_f32_32x32x16_bf16(kf, qf[s], sc, 0, 0, 0); }
                const int pos0 = 64 * j + 32 * kt + 8 * hf;
                float lk[16], lb[16];
                float a1 = 0.f, a0 = 0.f;
#pragma unroll
                for (int i = 0; i < 16; ++i) {
                    const float xx = sc[i] * CS, e = __builtin_amdgcn_exp2f(-fabsf(xx)), sp = fmaxf(xx, 0.f) + __builtin_amdgcn_logf(1.f + e);
                    const bool valid = (pos0 + 16 * (i >> 3) + (i & 7)) < tq;
                    lk[i] = valid ? -sp : 0.f; lb[i] = valid ? xx - sp : -INFINITY;
                    if (i >= 8) a1 += lk[i]; else a0 += lk[i];
                }
                const float p1 = __shfl_xor(a1, 32), p0 = __shfl_xor(a0, 32);
                const float hi1 = hf ? a1 : p1, lo1 = hf ? p1 : a1, hi0 = hf ? a0 : p0, lo0 = hf ? p0 : a0;
                float acc = hf ? run : run + hi1;
#pragma unroll
                for (int i = 15; i >= 8; --i) { const float t = lb[i] + acc; acc += lk[i]; lb[i] = __builtin_amdgcn_exp2f(t); }
                acc = hf ? run + hi1 + lo1 : run + hi1 + lo1 + hi0;
#pragma unroll
                for (int i = 7; i >= 0; --i) { const float t = lb[i] + acc; acc += lk[i]; lb[i] = __builtin_amdgcn_exp2f(t); }
                run += (hi1 + lo1) + (hi0 + lo0);
#pragma unroll
                for (int a = 0; a < 2; ++a) {
                    u32x4 pw; pw.x = pk2(lb[8 * a], lb[8 * a + 1]); pw.y = pk2(lb[8 * a + 2], lb[8 * a + 3]); pw.z = pk2(lb[8 * a + 4], lb[8 * a + 5]); pw.w = pk2(lb[8 * a + 6], lb[8 * a + 7]);
                    const bf16x8 pf = __builtin_bit_cast(bf16x8, pw);
                    const bf16x8 v0 = *(const LAS bf16x8*)(buf + 8192 + (4 * kt + 2 * a + hf) * 1024 + ql * 16);
                    const bf16x8 v1 = *(const LAS bf16x8*)(buf + 8192 + (4 * kt + 2 * a + hf) * 1024 + 512 + ql * 16);
                    o0 = __builtin_amdgcn_mfma_f32_32x32x16_bf16(v0, pf, o0, 0, 0, 0);
                    o1 = __builtin_amdgcn_mfma_f32_32x32x16_bf16(v1, pf, o1, 0, 0, 0);
                }
            }
        }
        if (j > 0) { *(LAS u32x4*)(nbuf + stoff) = kreg; *(LAS u32x4*)(nbuf + 8192 + stoff) = vreg; }
        __syncthreads();
    }
    bf16_t* op = (bf16_t*)(X.ws + WS_O) + (size_t)(b * S + fresh(tq)) * D + h * 64 + 4 * hf;
#pragma unroll
    for (int g4 = 0; g4 < 4; ++g4) {
        u32x2 w0; w0.x = pk2(o0[4 * g4], o0[4 * g4 + 1]); w0.y = pk2(o0[4 * g4 + 2], o0[4 * g4 + 3]); *(u32x2*)(op + 8 * g4) = w0;
        u32x2 w1; w1.x = pk2(o1[4 * g4], o1[4 * g4 + 1]); w1.y = pk2(o1[4 * g4 + 2], o1[4 * g4 + 3]); *(u32x2*)(op + 32 + 8 * g4) = w1;
    }
}
__device__ __forceinline__ void ph_sb(const Ctx& X) {
    for (int pr = X.bid; pr < 256; pr += X.G)
#pragma unroll 1
        for (int u = 0; u < 2; ++u) { const int bh = pr >> 3, qa = pr & 7; sb_attn_unit(X, bh, u ? qa : 15 - qa); }
}
__device__ __forceinline__ void ph_attn_a(const Params& p, const Ctx& X) {
    const bf16_t* proj = (const bf16_t*)(X.ws + WS_BIG);
    {
        LAS float* flat = (LAS float*)X.lds; LAS float* part = flat + 2048; LAS float* hid = part + 512;
        for (int it = X.bid; it < NCMP * 8 * 2; it += X.G) {
            const int n = it % NCMP, bg = (it / NCMP) & 7, kv = it / (NCMP * 8), b = bg >> 1, g = bg & 1;
            const int col = kv ? OFF_VC : OFF_KC; const float* pe = kv ? p.in[11] : p.in[10]; const float* w1 = kv ? p.in[14] : p.in[12]; const float* w2 = kv ? p.in[15] : p.in[13];
            for (int i = X.tid; i < 2048; i += NTHREADS) { const int l = i >> 6, d = i & 63; flat[i] = bf2f(proj[(size_t)(b * S + n * 16 + l) * PROJ_LD + col + g * 64 + d]) + pe[l * 64 + d]; }
            __syncthreads();
            { const int j = X.tid & 127, part_i = X.tid >> 7; float a = 0.f;
              for (int i = part_i * 512; i < part_i * 512 + 512; ++i) a += flat[i] * w1[(size_t)i * 128 + j];
              part[part_i * 128 + j] = a; }
            __syncthreads();
            if (X.tid < 128) hid[X.tid] = siluf((part[X.tid] + part[128 + X.tid]) + (part[256 + X.tid] + part[384 + X.tid]));
            __syncthreads();
            if (X.tid < 64) {
                float o = 0.f;
                for (int j = 0; j < 128; ++j) o += hid[j] * w2[j * 64 + X.tid];
                if (kv == 0) { const float r = rsqrtf(wave_sum(o * o) * (1.f / 64.f) + EPS); o = o * r * p.in[9][X.tid];
                    ((bf16_t*)(X.ws + WS_KCB))[((size_t)bg * 256 + n) * 64 + X.tid] = (bf16_t)f2bf(o);
                    if (n == 0) ((bf16_t*)(X.ws + WS_KCB))[((size_t)bg * 256 + 255) * 64 + X.tid] = 0; }
                else { ((bf16_t*)(X.ws + WS_VCT))[((size_t)bg * 64 + X.tid) * 256 + n] = (bf16_t)f2bf(o);
                    if (n == 0) ((bf16_t*)(X.ws + WS_VCT))[((size_t)bg * 64 + X.tid) * 256 + 255] = 0; }
            }
            __syncthreads();
        }
    }
    for (int it = X.gw; it < T * 12; it += X.ngw) {
        const int t = it / 12, idx = it % 12, lane = X.lane;
        int col; const float* gain; bf16_t* dst; float sc = 1.f;
        if (idx < 8) { col = OFF_NQ + idx * 64; gain = p.in[8]; dst = (bf16_t*)(X.ws + WS_QNB) + (size_t)t * 512 + idx * 64; sc = 0.125f * 1.4426950408889634f; }
        else if (idx < 10) { col = OFF_KS + (idx - 8) * 64; gain = p.in[9] + 64; dst = (bf16_t*)(X.ws + WS_KSN) + (size_t)t * 128 + (idx - 8) * 64; }
        else { col = OFF_KW + (idx - 10) * 64; gain = p.in[9] + 128; dst = (bf16_t*)(X.ws + WS_KWN) + (size_t)t * 128 + (idx - 10) * 64; }
        const float v = bf2f(proj[(size_t)t * PROJ_LD + col + lane]);
        const float r = rsqrtf(wave_sum(v * v) * (1.f / 64.f) + EPS);
        dst[lane] = (bf16_t)f2bf(v * r * gain[lane] * sc);
    }
}
struct NsaSt { f32x16 o0, o1; float m, l; };
template <int MODE>
__device__ __forceinline__ void nsa_flash(const Ctx& X, const bf16_t* kg, const bf16_t* vg, int jlo, int jhi, const bf16x8 (&qf)[4], int tq, float slope2,
                                          unsigned long long mymask, unsigned long long wavemask, NsaSt& st) {
    const int lane = fresh(X.lane), w = X.wave, ql = lane & 31, hf = lane >> 5;
    LAS unsigned char* buf0 = X.lds;
    const int stoff = w * 1024 + lane * 16, krow = pi32(ql) * 16;
    u32x4 kreg = *(const u32x4*)(kg + (size_t)(64 * jlo) * 128), vreg = *(const u32x4*)(vg + 64 * jlo);
    *(LAS u32x4*)(buf0 + stoff) = kreg; *(LAS u32x4*)(buf0 + 8192 + stoff) = vreg;
    __syncthreads();
    for (int j = jlo; j <= jhi; ++j) {
        LAS unsigned char* buf = buf0 + (((j - jlo) & 1) ? 16384 : 0);
        LAS unsigned char* nbuf = buf0 + (((j - jlo) & 1) ? 0 : 16384);
        if (j < jhi) { kreg = *(const u32x4*)(kg + (size_t)(64 * (j + 1)) * 128); vreg = *(const u32x4*)(vg + 64 * (j + 1)); }
        if (MODE == 1 || ((wavemask >> j) & 1ull)) {
            f32x16 s0, s1;
#pragma unroll
            for (int i = 0; i < 16; ++i) { s0[i] = 0.f; s1[i] = 0.f; }
#pragma unroll
            for (int s = 0; s < 4; ++s) {
                const bf16x8 k0 = *(const LAS bf16x8*)(buf + (2 * s + hf) * 1024 + krow), k1 = *(const LAS bf16x8*)(buf + (2 * s + hf) * 1024 + 512 + krow);
                s0 = __builtin_amdgcn_mfma_f32_32x32x16_bf16(k0, qf[s], s0, 0, 0, 0); s1 = __builtin_amdgcn_mfma_f32_32x32x16_bf16(k1, qf[s], s1, 0, 0, 0);
            }
            const bool sel = MODE == 1 || ((mymask >> j) & 1ull);
            const int d0 = tq - (64 * j + 8 * hf);
            float mb = -INFINITY;
#pragma unroll
            for (int i = 0; i < 16; ++i) {
                const int da = d0 - (16 * (i >> 3) + (i & 7)), db = da - 32;
                const bool va = sel && da >= 0 && (MODE == 0 || da < 512), vb = sel && db >= 0 && (MODE == 0 || db < 512);
                s0[i] = va ? s0[i] - slope2 * (float)da : -INFINITY; s1[i] = vb ? s1[i] - slope2 * (float)db : -INFINITY;
                mb = fmaxf(mb, fmaxf(s0[i], s1[i]));
            }
            mb = fmaxf(mb, __shfl_xor(mb, 32));
            const float mn = fmaxf(st.m, mb), ms = mn == -INFINITY ? 0.f : mn, alpha = __builtin_amdgcn_exp2f(st.m - ms);
            st.m = mn;
            float ls = 0.f;
#pragma unroll
            for (int i = 0; i < 16; ++i) { s0[i] = __builtin_amdgcn_exp2f(s0[i] - ms); s1[i] = __builtin_amdgcn_exp2f(s1[i] - ms); ls += s0[i] + s1[i]; }
            st.l = st.l * alpha + ls;
#pragma unroll
            for (int i = 0; i < 16; ++i) { st.o0[i] *= alpha; st.o1[i] *= alpha; }
#pragma unroll
            for (int kt = 0; kt < 2; ++kt)
#pragma unroll
                for (int a = 0; a < 2; ++a) {
                    u32x4 pw;
                    if (kt == 0) { pw.x = pk2(s0[8 * a], s0[8 * a + 1]); pw.y = pk2(s0[8 * a + 2], s0[8 * a + 3]); pw.z = pk2(s0[8 * a + 4], s0[8 * a + 5]); pw.w = pk2(s0[8 * a + 6], s0[8 * a + 7]); }
                    else { pw.x = pk2(s1[8 * a], s1[8 * a + 1]); pw.y = pk2(s1[8 * a + 2], s1[8 * a + 3]); pw.z = pk2(s1[8 * a + 4], s1[8 * a + 5]); pw.w = pk2(s1[8 * a + 6], s1[8 * a + 7]); }
                    const bf16x8 pf = __builtin_bit_cast(bf16x8, pw);
                    const bf16x8 v0 = *(const LAS bf16x8*)(buf + 8192 + (4 * kt + 2 * a + hf) * 1024 + ql * 16);
                    const bf16x8 v1 = *(const LAS bf16x8*)(buf + 8192 + (4 * kt + 2 * a + hf) * 1024 + 512 + ql * 16);
                    st.o0 = __builtin_amdgcn_mfma_f32_32x32x16_bf16(v0, pf, st.o0, 0, 0, 0);
                    st.o1 = __builtin_amdgcn_mfma_f32_32x32x16_bf16(v1, pf, st.o1, 0, 0, 0);
                }
        }
        if (j < jhi) { *(LAS u32x4*)(nbuf + stoff) = kreg; *(LAS u32x4*)(nbuf + 8192 + stoff) = vreg; }
        __syncthreads();
    }
}
__device__ __forceinline__ void nsa_unit(const Ctx& X, int bg, int qb) {
    const int b = bg >> 1, g = bg & 1, lane = fresh(X.lane), w = X.wave, ql = lane & 31, hf = lane >> 5, r = ql >> 3, hh = g * 4 + r;
    const int t0 = 64 * qb, tq = t0 + 8 * w + (ql & 7);
    const float slope2 = exp2f(-(float)(hh + 1)) * 1.4426950408889634f;
    const bf16_t* proj = (const bf16_t*)(X.ws + WS_BIG);
    bf16x8 qf[4];
    { const bf16_t* qp = (const bf16_t*)(X.ws + WS_QNB) + (size_t)(b * S + tq) * 512 + hh * 64 + 8 * hf;
#pragma unroll
      for (int s = 0; s < 4; ++s) qf[s] = *(const bf16x8*)(qp + 16 * s); }
    float gate[3];
    { const bf16_t* gp = proj + (size_t)(b * S + tq) * PROJ_LD + OFF_GATE + hh * 3;
#pragma unroll
      for (int i = 0; i < 3; ++i) gate[i] = 1.f / (1.f + __expf(-bf2f(gp[i]))); }
    f32x16 of0, of1;
#pragma unroll
    for (int i = 0; i < 16; ++i) { of0[i] = 0.f; of1[i] = 0.f; }
    NsaSt st;
    LAS float* pacc = (LAS float*)(X.lds + 65536) + w * 2048;
    {
        const int ncm = t0 + 63 >= 31 ? (t0 + 63 - 31) / 16 + 1 : 0, nt = (ncm + 31) >> 5, ncv = tq >= 31 ? (tq - 31) / 16 + 1 : 0;
        {
            const bf16_t* kc = (const bf16_t*)(X.ws + WS_KCB) + (size_t)bg * 256 * 64; const bf16_t* vc = (const bf16_t*)(X.ws + WS_VCT) + (size_t)bg * 64 * 256;
            const int tidf = fresh(X.tid);
#pragma unroll
            for (int i = 0; i < 4; ++i) { const int pidx = tidf + NTHREADS * i;
                *(LAS u32x4*)(X.lds + (pidx >> 8) * 4096 + (pidx & 255) * 16) = *(const u32x4*)(kc + (size_t)(pidx & 255) * 64 + 8 * (pidx >> 8));
                *(LAS u32x4*)(X.lds + 32768 + (pidx >> 6) * 1024 + (pidx & 63) * 16) = *(const u32x4*)(vc + (size_t)(pidx & 63) * 256 + 8 * (pidx >> 6)); }
#pragma unroll
            for (int i = 0; i < 8; ++i) *(LAS f32x4*)(pacc + (i * 64 + lane) * 4) = (f32x4){0.f, 0.f, 0.f, 0.f};
        }
        __syncthreads();
        const int krow = pi32(ql) * 16;
        float ml = -INFINITY, ll = 0.f;
        for (int kt = 0; kt < nt; ++kt) {
            f32x16 sc;
#pragma unroll
            for (int i = 0; i < 16; ++i) sc[i] = 0.f;
#pragma unroll
            for (int s = 0; s < 4; ++s) { const bf16x8 kf = *(const LAS bf16x8*)(X.lds + (2 * s + hf) * 4096 + kt * 512 + krow); sc = __builtin_amdgcn_mfma_f32_32x32x16_bf16(kf, qf[s], sc, 0, 0, 0); }
            float tm = -INFINITY;
#pragma unroll
            for (int i = 0; i < 16; ++i) { const int n = 32 * kt + 16 * (i >> 3) + 8 * hf + (i & 7);
                sc[i] = n < ncv ? sc[i] - slope2 * (float)(tq - (16 * n + 31)) : -INFINITY; tm = fmaxf(tm, sc[i]); }
            const float mn = fmaxf(ml, tm), ms = mn == -INFINITY ? 0.f : mn;
            float ls = 0.f;
#pragma unroll
            for (int i = 0; i < 16; ++i) ls += __builtin_amdgcn_exp2f(sc[i] - ms);
            ll = ll * __builtin_amdgcn_exp2f(ml - ms) + ls; ml = mn;
        }
        float ms, inv;
        { const float mo = __shfl_xor(ml, 32), lo = __shfl_xor(ll, 32), mt = fmaxf(ml, mo); ms = mt == -INFINITY ? 0.f : mt;
          const float lt = ll * __builtin_amdgcn_exp2f(ml - ms) + lo * __builtin_amdgcn_exp2f(mo - ms); inv = lt > 0.f ? 1.f / lt : 0.f; }
#pragma unroll
        for (int i = 0; i < 16; ++i) { st.o0[i] = 0.f; st.o1[i] = 0.f; }
        float carry = 0.f;
        for (int kt = 0; kt < nt; ++kt) {
            f32x16 sc;
#pragma unroll
            for (int i = 0; i < 16; ++i) sc[i] = 0.f;
#pragma unroll
            for (int s = 0; s < 4; ++s) { const bf16x8 kf = *(const LAS bf16x8*)(X.lds + (2 * s + hf) * 4096 + kt * 512 + krow); sc = __builtin_amdgcn_mfma_f32_32x32x16_bf16(kf, qf[s], sc, 0, 0, 0); }
#pragma unroll
            for (int i = 0; i < 16; ++i) { const int n = 32 * kt + 16 * (i >> 3) + 8 * hf + (i & 7);
                sc[i] = n < ncv ? __builtin_amdgcn_exp2f(sc[i] - slope2 * (float)(tq - (16 * n + 31)) - ms) * inv : 0.f; }
            const float pa0 = __shfl_xor(sc[7], 32), pa1 = __shfl_xor(sc[15], 32);
            const float prev0 = hf ? pa0 : carry, prev1 = hf ? pa1 : pa0;
            carry = pa1;
            {
                typedef float f32x2 __attribute__((ext_vector_type(2)));
                f32x2 e0, e1;
                e0.x = prev0 + ((sc[0] + sc[1]) + (sc[2] + sc[3])); e0.y = sc[3] + ((sc[4] + sc[5]) + (sc[6] + sc[7]));
                e1.x = prev1 + ((sc[8] + sc[9]) + (sc[10] + sc[11])); e1.y = sc[11] + ((sc[12] + sc[13]) + (sc[14] + sc[15]));
                *(LAS f32x2*)(pacc + ql * 64 + 8 * kt + 2 * hf) = e0; *(LAS f32x2*)(pacc + ql * 64 + 8 * kt + 4 + 2 * hf) = e1;
            }
#pragma unroll
            for (int a = 0; a < 2; ++a) {
                u32x4 pw; pw.x = pk2(sc[8 * a], sc[8 * a + 1]); pw.y = pk2(sc[8 * a + 2], sc[8 * a + 3]); pw.z = pk2(sc[8 * a + 4], sc[8 * a + 5]); pw.w = pk2(sc[8 * a + 6], sc[8 * a + 7]);
                const bf16x8 pf = __builtin_bit_cast(bf16x8, pw);
                const bf16x8 v0 = *(const LAS bf16x8*)(X.lds + 32768 + (4 * kt + 2 * a + hf) * 1024 + ql * 16);
                const bf16x8 v1 = *(const LAS bf16x8*)(X.lds + 32768 + (4 * kt + 2 * a + hf) * 1024 + 512 + ql * 16);
                st.o0 = __builtin_amdgcn_mfma_f32_32x32x16_bf16(v0, pf, st.o0, 0, 0, 0);
                st.o1 = __builtin_amdgcn_mfma_f32_32x32x16_bf16(v1, pf, st.o1, 0, 0, 0);
            }
        }
#pragma unroll
        for (int i = 0; i < 16; ++i) { of0[i] = gate[0] * st.o0[i]; of1[i] = gate[0] * st.o1[i]; }
    }
    unsigned long long mymask = 0ull, wavemask = 0ull;
    LDS_WAIT();
    for (int q8 = 0; q8 < 8; ++q8) {
        const int t = t0 + 8 * w + q8;
        const float ps = (pacc[(0 * 8 + q8) * 64 + lane] + pacc[(1 * 8 + q8) * 64 + lane]) + (pacc[(2 * 8 + q8) * 64 + lane] + pacc[(3 * 8 + q8) * 64 + lane]);
        const bool valid = lane * 64 <= t, forced = (lane == 0) || (lane == qb) || (lane == qb - 1);
        const float score = valid ? (forced ? 1e6f : ps) : -1e6f;
        int rank = 0;
#pragma unroll 4
        for (int i = 0; i < 64; ++i) { const float si = __builtin_amdgcn_readlane(score, i); rank += (si > score || (si == score && i < lane)) ? 1 : 0; }
        const unsigned long long mk = __ballot(rank < 16);
        wavemask |= mk; if ((ql & 7) == q8) mymask = mk;
    }
    __syncthreads();
    {
#pragma unroll
        for (int i = 0; i < 16; ++i) { st.o0[i] = 0.f; st.o1[i] = 0.f; }
        st.m = -INFINITY; st.l = 0.f;
        const int lf = fresh(lane);
        const bf16_t* kg = (const bf16_t*)(X.ws + WS_KSN) + ((size_t)b * S + lf) * 128 + g * 64 + 8 * w;
        const bf16_t* vg = (const bf16_t*)(X.ws + WS_VT) + (size_t)(512 + g * 64 + lf) * T + (size_t)b * S + 8 * w;
        nsa_flash<0>(X, kg, vg, 0, qb, qf, tq, slope2, mymask, wavemask, st);
        const float lt = st.l + __shfl_xor(st.l, 32), sc = gate[1] / fmaxf(lt, 1e-30f);
#pragma unroll
        for (int i = 0; i < 16; ++i) { of0[i] += sc * st.o0[i]; of1[i] += sc * st.o1[i]; }
    }
    {
#pragma unroll
        for (int i = 0; i < 16; ++i) { st.o0[i] = 0.f; st.o1[i] = 0.f; }
        st.m = -INFINITY; st.l = 0.f;
        const int lf = fresh(lane);
        const bf16_t* kg = (const bf16_t*)(X.ws + WS_KWN) + ((size_t)b * S + lf) * 128 + g * 64 + 8 * w;
        const bf16_t* vg = (const bf16_t*)(X.ws + WS_VT) + (size_t)(640 + g * 64 + lf) * T + (size_t)b * S + 8 * w;
        nsa_flash<1>(X, kg, vg, qb >= 8 ? qb - 8 : 0, qb, qf, tq, slope2, 0ull, 0ull, st);
        const float lt = st.l + __shfl_xor(st.l, 32), sc = gate[2] / fmaxf(lt, 1e-30f);
#pragma unroll
        for (int i = 0; i < 16; ++i) { of0[i] += sc * st.o0[i]; of1[i] += sc * st.o1[i]; }
    }
    bf16_t* op = (bf16_t*)(X.ws + WS_O) + (size_t)(b * S + fresh(tq)) * D + 512 + hh * 64 + 4 * hf;
#pragma unroll
    for (int g4 = 0; g4 < 4; ++g4) {
        u32x2 w0; w0.x = pk2(of0[4 * g4], of0[4 * g4 + 1]); w0.y = pk2(of0[4 * g4 + 2], of0[4 * g4 + 3]); *(u32x2*)(op + 8 * g4) = w0;
        u32x2 w1; w1.x = pk2(of1[4 * g4], of1[4 * g4 + 1]); w1.y = pk2(of1[4 * g4 + 2], of1[4 * g4 + 3]); *(u32x2*)(op + 32 + 8 * g4) = w1;
    }
}
__device__ __forceinline__ void ph_nsa(const Params& p, const Ctx& X) {
    for (int pr = X.bid; pr < 256; pr += X.G)
#pragma unroll 1
        for (int u = 0; u < 2; ++u) { const int bg = pr >> 5, qa = pr & 31; nsa_unit(X, bg, u ? qa : 63 - qa); }
}

__device__ __forceinline__ float silu_fast(float v) { return v * __builtin_amdgcn_rcpf(1.f + __expf(-v)); }
__device__ __forceinline__ void ph_ssd1(const Params& p, const Ctx& X) {
    const float* cw = p.in[17]; const float* cb = p.in[18];
    LAS float* wl = (LAS float*)X.lds;
    for (int unit = X.bid; unit < 256; unit += X.G) {
        const int b = unit >> 6, c = (unit >> 2) & 15, g = unit & 3, tl0 = c * 256, lane = fresh(X.lane), w = X.wave, ql = lane & 31, hf = lane >> 5;
        const size_t t0 = (size_t)b * S + tl0;
        {
            const int h = g * 8 + w;
            const float a = -expf(p.in[20][h]), dtb = p.in[19][h];
            const float* dr = (const float*)(X.ws + WS_DT) + (t0 + 4 * lane) * 32 + h;
            float dt[4], cs[4];
#pragma unroll
            for (int k = 0; k < 4; ++k) { const float raw = dr[k * 32] + dtb; dt[k] = raw > 20.f ? raw : log1pf(expf(raw)); }
            cs[0] = dt[0] * a; cs[1] = cs[0] + dt[1] * a; cs[2] = cs[1] + dt[2] * a; cs[3] = cs[2] + dt[3] * a;
            float incl = cs[3];
#pragma unroll
            for (int o = 1; o < 64; o <<= 1) { const float u = __shfl_up(incl, o); if (lane >= o) incl += u; }
            const float excl = incl - cs[3], last = __shfl(incl, 63);
#pragma unroll
            for (int k = 0; k < 4; ++k) cs[k] += excl;
            *(f32x4*)((float*)(X.ws + WS_DT2) + (size_t)(b * 32 + h) * S + tl0 + 4 * lane) = (f32x4){dt[0], dt[1], dt[2], dt[3]};
            *(f32x4*)((float*)(X.ws + WS_CS) + (size_t)(b * 32 + h) * S + tl0 + 4 * lane) = (f32x4){cs[0], cs[1], cs[2], cs[3]};
            *(LAS f32x4*)(wl + w * 256 + 4 * lane) = (f32x4){dt[0] * __expf(last - cs[0]), dt[1] * __expf(last - cs[1]), dt[2] * __expf(last - cs[2]), dt[3] * __expf(last - cs[3])};
            if (lane == 63) ((float*)(X.ws + WS_DEC))[(b * 16 + c) * 32 + h] = __expf(last);
        }
        {
            const bf16_t* xt = (const bf16_t*)(X.ws + WS_XT); bf16_t* xct = (bf16_t*)(X.ws + WS_XCT);
            const int tidf = fresh(X.tid);
            for (int k = 0; k < 40; ++k) {
                const int it = tidf + NTHREADS * k, chl = it >> 5, seg = it & 31;
                const int chg = chl < 512 ? g * 512 + chl : 2048 + g * 128 + (chl - 512);
                const int rin = chl < 512 ? 1024 + g * 512 + chl : g * 128 + (chl - 512);
                const bf16_t* src = xt + (size_t)rin * T + t0 + 8 * seg;
                const u32x4 cur = *(const u32x4*)src;
                u32x4 prv = (u32x4){0u, 0u, 0u, 0u};
                if (tl0 + 8 * seg >= 8) prv = *(const u32x4*)(src - 8);
                const float x[11] = {bfhi(prv.z), bflo(prv.w), bfhi(prv.w), bflo(cur.x), bfhi(cur.x), bflo(cur.y), bfhi(cur.y), bflo(cur.z), bfhi(cur.z), bflo(cur.w), bfhi(cur.w)};
                const float w0 = cw[chg], w1 = cw[CONV_DIM + chg], w2 = cw[2 * CONV_DIM + chg], w3 = cw[3 * CONV_DIM + chg], bb = cb[chg];
                float o[8];
#pragma unroll
                for (int j = 0; j < 8; ++j) o[j] = silu_fast(bb + w0 * x[j] + w1 * x[j + 1] + w2 * x[j + 2] + w3 * x[j + 3]);
                u32x4 ov; ov.x = pk2(o[0], o[1]); ov.y = pk2(o[2], o[3]); ov.z = pk2(o[4], o[5]); ov.w = pk2(o[6], o[7]);
                *(u32x4*)(xct + (size_t)chg * T + t0 + 8 * seg) = ov;
            }
            const bf16_t* zbc = (const bf16_t*)(X.ws + WS_ZBC); bf16_t* bcm = (bf16_t*)(X.ws + WS_BCM);
            for (int k = 0; k < 16; ++k) {
                const int it = tidf + NTHREADS * k, l = it >> 5, c8 = it & 31;
                const int col = (c8 < 16 ? g * 128 + 8 * c8 : 512 + g * 128 + 8 * (c8 - 16));
                float acc[8];
                { const f32x4 b0 = *(const f32x4*)(cb + 2048 + col), b1 = *(const f32x4*)(cb + 2048 + col + 4); acc[0] = b0.x; acc[1] = b0.y; acc[2] = b0.z; acc[3] = b0.w; acc[4] = b1.x; acc[5] = b1.y; acc[6] = b1.z; acc[7] = b1.w; }
#pragma unroll
                for (int ww = 0; ww < 4; ++ww) {
                    if (tl0 + l - 3 + ww < 0) continue;
                    const u32x4 q = *(const u32x4*)(zbc + (t0 + l - 3 + ww) * 3072 + 2048 + col);
                    const f32x4 k0 = *(const f32x4*)(cw + ww * CONV_DIM + 2048 + col), k1 = *(const f32x4*)(cw + ww * CONV_DIM + 2048 + col + 4);
                    acc[0] += bflo(q.x) * k0.x; acc[1] += bfhi(q.x) * k0.y; acc[2] += bflo(q.y) * k0.z; acc[3] += bfhi(q.y) * k0.w;
                    acc[4] += bflo(q.z) * k1.x; acc[5] += bfhi(q.z) * k1.y; acc[6] += bflo(q.w) * k1.z; acc[7] += bfhi(q.w) * k1.w;
                }
                u32x4 ov; ov.x = pk2(silu_fast(acc[0]), silu_fast(acc[1])); ov.y = pk2(silu_fast(acc[2]), silu_fast(acc[3])); ov.z = pk2(silu_fast(acc[4]), silu_fast(acc[5])); ov.w = pk2(silu_fast(acc[6]), silu_fast(acc[7]));
                *(u32x4*)(bcm + (t0 + l) * 1024 + col) = ov;
            }
        }
        __syncthreads();
        {
            const int h = g * 8 + w, lf = fresh(lane);
            const bf16_t* xa = (const bf16_t*)(X.ws + WS_XCT) + (size_t)(h * 64 + (lf & 31)) * T + t0 + 8 * (lf >> 5);
            const bf16_t* xb = (const bf16_t*)(X.ws + WS_XCT) + (size_t)(2048 + g * 128 + (lf & 31)) * T + t0 + 8 * (lf >> 5);
            f32x16 acc[2][4];
#pragma unroll
            for (int pt = 0; pt < 2; ++pt)
#pragma unroll
                for (int nt = 0; nt < 4; ++nt)
#pragma unroll
                    for (int i = 0; i < 16; ++i) acc[pt][nt][i] = 0.f;
            for (int ks = 0; ks < 16; ++ks) {
                const f32x4 wa = *(const LAS f32x4*)(wl + w * 256 + 16 * ks + 8 * hf), wb = *(const LAS f32x4*)(wl + w * 256 + 16 * ks + 8 * hf + 4);
                bf16x8 af[2];
#pragma unroll
                for (int pt = 0; pt < 2; ++pt) { const u32x4 q = *(const u32x4*)(xa + (size_t)(32 * pt) * T + 16 * ks);
                    u32x4 o; o.x = pk2(bflo(q.x) * wa.x, bfhi(q.x) * wa.y); o.y = pk2(bflo(q.y) * wa.z, bfhi(q.y) * wa.w); o.z = pk2(bflo(q.z) * wb.x, bfhi(q.z) * wb.y); o.w = pk2(bflo(q.w) * wb.z, bfhi(q.w) * wb.w);
                    af[pt] = __builtin_bit_cast(bf16x8, o); }
#pragma unroll
                for (int nt = 0; nt < 4; ++nt) { const bf16x8 bfr = *(const bf16x8*)(xb + (size_t)(32 * nt) * T + 16 * ks);
                    acc[0][nt] = __builtin_amdgcn_mfma_f32_32x32x16_bf16(af[0], bfr, acc[0][nt], 0, 0, 0); acc[1][nt] = __builtin_amdgcn_mfma_f32_32x32x16_bf16(af[1], bfr, acc[1][nt], 0, 0, 0); }
            }
            float* st = (float*)(X.ws + WS_ST) + ((size_t)(b * 16 + c) * 32 + h) * 8192 + ql;
#pragma unroll
            for (int pt = 0; pt < 2; ++pt)
#pragma unroll
                for (int nt = 0; nt < 4; ++nt)
#pragma unroll
                    for (int i = 0; i < 16; ++i) st[(32 * pt + 8 * (i >> 2) + 4 * hf + (i & 3)) * 128 + 32 * nt] = acc[pt][nt][i];
        }
        __syncthreads();
    }
}
__device__ __forceinline__ void ph_ssd2(const Ctx& X) {
    const float* st = (const float*)(X.ws + WS_ST); const float* dec = (const float*)(X.ws + WS_DEC); bf16_t* pb = (bf16_t*)(X.ws + WS_PB);
    for (int e = X.bid * NTHREADS + X.tid; e < NB * 32 * 2048; e += X.G * NTHREADS) {
        const int b = e >> 16, h = (e >> 11) & 31, q4 = (e & 2047) * 4;
        f32x4 hs = (f32x4){0.f, 0.f, 0.f, 0.f};
        for (int c = 0; c < 16; ++c) {
            const size_t o = ((size_t)(b * 16 + c) * 32 + h) * 8192 + q4;
            u32x2 wv; wv.x = pk2(hs.x, hs.y); wv.y = pk2(hs.z, hs.w); *(u32x2*)(pb + o) = wv;
            hs = hs * dec[(b * 16 + c) * 32 + h] + *(const f32x4*)(st + o);
        }
    }
}
__device__ __forceinline__ void ph_ssd3(const Params& p, const Ctx& X) {
    LAS float* dtl = (LAS float*)X.lds; LAS float* csl = dtl + 2048;
    for (int unit = X.bid; unit < 256; unit += X.G) {
        const int b = unit >> 6, c = (unit >> 2) & 15, g = unit & 3, tl0 = c * 256, lane = fresh(X.lane), w = X.wave, ql = lane & 31, hf = lane >> 5, lq = 32 * w + ql;
        const size_t t0 = (size_t)b * S + tl0;
        { const int tidf = fresh(X.tid), h8 = tidf >> 6, l4 = (tidf & 63) * 4;
          *(LAS f32x4*)(dtl + h8 * 256 + l4) = *(const f32x4*)((const float*)(X.ws + WS_DT2) + (size_t)(b * 32 + g * 8 + h8) * S + tl0 + l4);
          *(LAS f32x4*)(csl + h8 * 256 + l4) = *(const f32x4*)((const float*)(X.ws + WS_CS) + (size_t)(b * 32 + g * 8 + h8) * S + tl0 + l4); }
        __syncthreads();
        const bf16_t* bcm = (const bf16_t*)(X.ws + WS_BCM);
        bf16x8 cf[8];
#pragma unroll
        for (int ks = 0; ks < 8; ++ks) cf[ks] = *(const bf16x8*)(bcm + (t0 + lq) * 1024 + 512 + g * 128 + 16 * ks + 8 * hf);
        float ss = 0.f;
#pragma unroll 1
        for (int pass = 0; pass < 4; ++pass) {
            f32x16 acc[2][2];
#pragma unroll
            for (int hh = 0; hh < 2; ++hh) {
                const int h8 = pass * 2 + hh;
                const bf16_t* pbp = (const bf16_t*)(X.ws + WS_PB) + ((size_t)(b * 16 + c) * 32 + g * 8 + h8) * 8192 + (size_t)ql * 128 + 8 * hf;
#pragma unroll
                for (int pt = 0; pt < 2; ++pt) {
#pragma unroll
                    for (int i = 0; i < 16; ++i) acc[hh][pt][i] = 0.f;
#pragma unroll
                    for (int ks = 0; ks < 8; ++ks) acc[hh][pt] = __builtin_amdgcn_mfma_f32_32x32x16_bf16(*(const bf16x8*)(pbp + pt * 4096 + 16 * ks), cf[ks], acc[hh][pt], 0, 0, 0);
                }
                const float e = __expf(csl[h8 * 256 + lq]);
#pragma unroll
                for (int i = 0; i < 16; ++i) { acc[hh][0][i] *= e; acc[hh][1][i] *= e; }
            }
            for (int st = 0; st <= w; ++st) {
                f32x16 G;
#pragma unroll
                for (int i = 0; i < 16; ++i) G[i] = 0.f;
                { const int lf2 = fresh(lane); const bf16_t* bp = bcm + (t0 + 32 * st + pi32(lf2 & 31)) * 1024 + g * 128 + 8 * (lf2 >> 5);
#pragma unroll
                  for (int ks = 0; ks < 8; ++ks) G = __builtin_amdgcn_mfma_f32_32x32x16_bf16(*(const bf16x8*)(bp + 16 * ks), cf[ks], G, 0, 0, 0); }
                const int s0 = 32 * st + 8 * hf;
#pragma unroll
                for (int hh = 0; hh < 2; ++hh) {
                    const int h8 = pass * 2 + hh, h = g * 8 + h8;
                    const float cl = csl[h8 * 256 + lq], dsk = p.in[21][h];
                    float m[16];
#pragma unroll
                    for (int a2 = 0; a2 < 2; ++a2) {
                        const f32x4 d0 = *(const LAS f32x4*)(dtl + h8 * 256 + s0 + 16 * a2), d1 = *(const LAS f32x4*)(dtl + h8 * 256 + s0 + 16 * a2 + 4);
                        const f32x4 c0 = *(const LAS f32x4*)(csl + h8 * 256 + s0 + 16 * a2), c1 = *(const LAS f32x4*)(csl + h8 * 256 + s0 + 16 * a2 + 4);
                        const float dd[8] = {d0.x, d0.y, d0.z, d0.w, d1.x, d1.y, d1.z, d1.w}, cc[8] = {c0.x, c0.y, c0.z, c0.w, c1.x, c1.y, c1.z, c1.w};
#pragma unroll
                        for (int j = 0; j < 8; ++j) { const int sidx = s0 + 16 * a2 + j;
                            float v = G[8 * a2 + j] * dd[j] * __expf(fminf(cl - cc[j], 0.f));
                            if (st == w) { v = sidx > lq ? 0.f : v; v += sidx == lq ? dsk : 0.f; }
                            m[8 * a2 + j] = v; }
                    }
                    const bf16_t* xp = (const bf16_t*)(X.ws + WS_XCT) + (size_t)(h * 64 + ql) * T + t0 + 32 * st + 8 * hf;
#pragma unroll
                    for (int a2 = 0; a2 < 2; ++a2) {
                        u32x4 pw; pw.x = pk2(m[8 * a2], m[8 * a2 + 1]); pw.y = pk2(m[8 * a2 + 2], m[8 * a2 + 3]); pw.z = pk2(m[8 * a2 + 4], m[8 * a2 + 5]); pw.w = pk2(m[8 * a2 + 6], m[8 * a2 + 7]);
                        const bf16x8 pf = __builtin_bit_cast(bf16x8, pw);
                        acc[hh][0] = __builtin_amdgcn_mfma_f32_32x32x16_bf16(*(const bf16x8*)(xp + 16 * a2), pf, acc[hh][0], 0, 0, 0);
                        acc[hh][1] = __builtin_amdgcn_mfma_f32_32x32x16_bf16(*(const bf16x8*)(xp + (size_t)32 * T + 16 * a2), pf, acc[hh][1], 0, 0, 0);
                    }
                }
            }
            const int lqf = fresh(lane);
            bf16_t* yrow = (bf16_t*)(X.ws + WS_O) + (t0 + 32 * w + (lqf & 31)) * SSM_INNER + g * 512 + 4 * (lqf >> 5);
            const bf16_t* zrow = (const bf16_t*)(X.ws + WS_ZBC) + (t0 + 32 * w + (lqf & 31)) * 3072 + g * 512 + 4 * (lqf >> 5);
#pragma unroll
            for (int hh = 0; hh < 2; ++hh)
#pragma unroll
                for (int pt = 0; pt < 2; ++pt)
#pragma unroll
                    for (int g4 = 0; g4 < 4; ++g4) {
                        const int co = (pass * 2 + hh) * 64 + 32 * pt + 8 * g4;
                        const u32x2 zq = *(const u32x2*)(zrow + co);
                        const float v0 = acc[hh][pt][4 * g4] * silu_fast(bflo(zq.x)), v1 = acc[hh][pt][4 * g4 + 1] * silu_fast(bfhi(zq.x)), v2 = acc[hh][pt][4 * g4 + 2] * silu_fast(bflo(zq.y)), v3 = acc[hh][pt][4 * g4 + 3] * silu_fast(bfhi(zq.y));
                        ss += (v0 * v0 + v1 * v1) + (v2 * v2 + v3 * v3);
                        u32x2 o; o.x = pk2(v0, v1); o.y = pk2(v2, v3); *(u32x2*)(yrow + co) = o;
                    }
        }
        ss += __shfl_xor(ss, 32);
        const float rs = rsqrtf(ss * (1.f / 512.f) + EPS);
        asm volatile("s_waitcnt vmcnt(0)" ::: "memory");
        const int lqf = fresh(lane);
        bf16_t* yrow = (bf16_t*)(X.ws + WS_O) + (t0 + 32 * w + (lqf & 31)) * SSM_INNER + g * 512 + 4 * (lqf >> 5);
        const float* ng = p.in[22] + g * 512 + 4 * (lqf >> 5);
#pragma unroll 4
        for (int k = 0; k < 64; ++k) {
            const int co = 8 * k;
            const u32x2 q = *(const u32x2*)(yrow + co); const f32x4 gn = *(const f32x4*)(ng + co);
            u32x2 o; o.x = pk2(bflo(q.x) * rs * gn.x, bfhi(q.x) * rs * gn.y); o.y = pk2(bflo(q.y) * rs * gn.z, bfhi(q.y) * rs * gn.w); *(u32x2*)(yrow + co) = o;
        }
        __syncthreads();
    }
}

__device__ __forceinline__ void ph_moe_gu(const Params& p, const Ctx& X, int l) {
    moe_table(X, l);
    pg8::MoeOrder So{(const LAS int*)(X.lds + TAB_OFF), (const LAS int*)(X.lds + TAB_OFF) + 40, (const int*)(X.ws + WS_SLOT), 3, X.G, X.bid, true};
    pg8::Gemm g{(const bf16_t*)(X.ws + WS_U), (const bf16_t*)(X.ws + WS_WGU) + (size_t)l * NE * 2048 * 1024, 1024};
    pg8::EpiGu E{(bf16_t*)(X.ws + WS_ACT), p.in[27] + (size_t)l * NE * 2048};
    pg8::gemm_phase<pg8::EpiGu, pg8::MoeOrder>(X.lds, g, So, E, X.tid);
}
__device__ __forceinline__ void ph_moe_down(const Params& p, const Ctx& X, int l) {
    moe_table(X, l);
    pg8::MoeOrder So{(const LAS int*)(X.lds + TAB_OFF), (const LAS int*)(X.lds + TAB_OFF) + 40, (const int*)(X.ws + WS_SLOT), 2, X.G, X.bid, false};
    pg8::Gemm g{(const bf16_t*)(X.ws + WS_ACT), (const bf16_t*)(X.ws + WS_WDN) + (size_t)l * NE * 1024 * 1024, 1024};
    pg8::EpiDown E{(bf16_t*)(X.ws + WS_Y), p.in[29] + (size_t)l * NE * 1024};
    pg8::gemm_phase<pg8::EpiDown, pg8::MoeOrder>(X.lds, g, So, E, X.tid);
}

__global__ void __launch_bounds__(NTHREADS, 2) fwd_kernel(Params p) {
    extern __shared__ __attribute__((aligned(16))) unsigned char lds_raw[];
    Ctx X;
    X.lds = (LAS unsigned char*)lds_raw; X.ws = p.ws;
    X.tid = threadIdx.x; X.lane = X.tid & 63; X.wave = __builtin_amdgcn_readfirstlane(X.tid >> 6);
    X.G = gridDim.x; X.bid = blockIdx.x; X.gw = X.bid * NWAVES + X.wave; X.ngw = X.G * NWAVES;
    if (X.tid < 4) ((LAS unsigned*)(X.lds + XB_OFF))[X.tid] = 0u;
    __syncthreads();
    XcdBarrier bar = xcd_barrier_post((unsigned*)(p.ws + WS_CTL) + CW_BAR, (volatile LAS unsigned*)(X.lds + XB_OFF));
#define PHASE_BEGIN Ctx Y = X; { GAS unsigned char* w_ = (GAS unsigned char*)p.ws; asm volatile("" : "+s"(w_)); Y.ws = (unsigned char*)w_; int t_ = threadIdx.x; asm volatile("" : "+v"(t_)); Y.tid = t_; Y.lane = t_ & 63; \
    Y.wave = __builtin_amdgcn_readfirstlane(t_ >> 6); Y.gw = Y.bid * NWAVES + Y.wave; }
#define WSF(off) ((float*)(Y.ws + (off)))
#define WSB(off) ((bf16_t*)(Y.ws + (off)))
    { PHASE_BEGIN ph_prologue(p, Y); }                                    xcd_barrier(bar);
    { PHASE_BEGIN ph_norm0(p, Y); }                                       xcd_barrier(bar);
    {
        PHASE_BEGIN
        pg8::DenseOrder So; So.init(T, PROJ_LD, X.G, X.bid);
        pg8::Gemm g{WSB(WS_U), WSB(WS_WIN), 1024};
        pg8::EpiBf16 E{WSB(WS_BIG), PROJ_LD};
        pg8::gemm_phase<pg8::EpiBf16, pg8::DenseOrder>(X.lds, g, So, E, Y.tid);
    }
    {
        PHASE_BEGIN
        pg8::DenseOrder So; So.init(768, T, X.G, X.bid);
        pg8::Gemm g{WSB(WS_WV), WSB(WS_U), 1024};
        pg8::EpiBf16 E{WSB(WS_VT), T};
        pg8::gemm_phase<pg8::EpiBf16, pg8::DenseOrder>(X.lds, g, So, E, Y.tid);
    }
    xcd_barrier(bar);
    { PHASE_BEGIN ph_attn_a(p, Y); }                                      xcd_barrier(bar);
    { PHASE_BEGIN ph_nsa(p, Y); }
    __syncthreads();
    { PHASE_BEGIN ph_sb(Y); }                                             xcd_barrier(bar);
    {
        PHASE_BEGIN
        pg8::DenseOrder So; So.init(T, D, X.G, X.bid);
        pg8::Gemm g{WSB(WS_O), WSB(WS_WOUT), 1024};
        pg8::EpiResid E{p.in[0], WSF(WS_H1), WSF(WS_MODF) + 2048};
        pg8::gemm_phase<pg8::EpiResid, pg8::DenseOrder>(X.lds, g, So, E, Y.tid);
    }
    xcd_barrier(bar);
    { PHASE_BEGIN ph_router(p, Y, 0, WSF(WS_H1)); }                       xcd_barrier(bar);
    { PHASE_BEGIN ph_moe_gu(p, Y, 0); }                                   xcd_barrier(bar);
    { PHASE_BEGIN ph_moe_down(p, Y, 0); }                                 xcd_barrier(bar);
    { PHASE_BEGIN ph_combine<0>(p, Y, 0, WSF(WS_H1), WSF(WS_H2)); }       xcd_barrier(bar);
    {
        PHASE_BEGIN
        pg8::DenseOrder So; So.init(T, 3072, X.G, X.bid);
        pg8::Gemm g{WSB(WS_U), WSB(WS_WSIN), 1024};
        pg8::EpiBf16 E{WSB(WS_ZBC), 3072};
        pg8::gemm_phase<pg8::EpiBf16, pg8::DenseOrder>(X.lds, g, So, E, Y.tid);
    }
    {
        PHASE_BEGIN
        pg8::DenseOrder So; So.init(3072, T, X.G, X.bid);
        pg8::Gemm g{WSB(WS_WSIN) + (size_t)2048 * 1024, WSB(WS_U), 1024};
        pg8::EpiBf16 E{WSB(WS_XT), T};
        pg8::gemm_phase<pg8::EpiBf16, pg8::DenseOrder>(X.lds, g, So, E, Y.tid);
    }
    xcd_barrier(bar);
    { PHASE_BEGIN ph_ssd1(p, Y); }                                        xcd_barrier(bar);
    { PHASE_BEGIN ph_ssd2(Y); }                                           xcd_barrier(bar);
    { PHASE_BEGIN ph_ssd3(p, Y); }                                        xcd_barrier(bar);
    {
        PHASE_BEGIN
        pg8::DenseOrder So; So.init(T, D, X.G, X.bid);
        pg8::Gemm g{WSB(WS_O), WSB(WS_WSOUT), 2048};
        pg8::EpiResid E{WSF(WS_H2), WSF(WS_H1), WSF(WS_MODF) + 4 * 6144 + 2048};
        pg8::gemm_phase<pg8::EpiResid, pg8::DenseOrder>(X.lds, g, So, E, Y.tid);
    }
    xcd_barrier(bar);
    { PHASE_BEGIN ph_router(p, Y, 1, WSF(WS_H1)); }                       xcd_barrier(bar);
    { PHASE_BEGIN ph_moe_gu(p, Y, 1); }                                   xcd_barrier(bar);
    { PHASE_BEGIN ph_moe_down(p, Y, 1); }                                 xcd_barrier(bar);
    { PHASE_BEGIN ph_combine<1>(p, Y, 1, WSF(WS_H1), p.out); }
#undef PHASE_BEGIN
#undef WSF
#undef WSB
}
}

extern "C" void kernel_launch(void* const* d_in, const int* in_sizes, int n_in, void* d_out, int out_size, void* d_ws, size_t ws_size, hipStream_t stream) {
    static int grid = 0;
    if (grid == 0) {
        if (n_in != 30 || out_size != T * D || ws_size < WS_END) { fprintf(stderr, "kernel_launch: unexpected shapes / workspace (%d inputs, out %d, ws %zu < %zu)\n", n_in, out_size, ws_size, (size_t)WS_END); grid = -1; return; }
        int dev = 0, cus = 0, per_cu = 0;
        if (hipGetDevice(&dev) != hipSuccess || hipDeviceGetAttribute(&cus, hipDeviceAttributeMultiprocessorCount, dev) != hipSuccess) { grid = -1; return; }
        if (hipFuncSetAttribute((const void*)fwd_kernel, hipFuncAttributeMaxDynamicSharedMemorySize, LDS_BYTES) != hipSuccess) { fprintf(stderr, "kernel_launch: hipFuncSetAttribute failed\n"); grid = -1; return; }
        if (hipOccupancyMaxActiveBlocksPerMultiprocessor(&per_cu, (const void*)fwd_kernel, NTHREADS, LDS_BYTES) != hipSuccess || per_cu < 1) { fprintf(stderr, "kernel_launch: occupancy query reports %d\n", per_cu); }
        (void)hipGetLastError();
        grid = cus;
    }
    if (grid < 0) return;
    if (hipMemsetAsync((char*)d_ws + WS_CTL, 0, CTL_BYTES, stream) != hipSuccess) return;
    Params p{};
    for (int i = 0; i < 30; ++i) p.in[i] = (const float*)d_in[i];
    p.out = (float*)d_out; p.ws = (unsigned char*)d_ws;
    hipLaunchKernelGGL(fwd_kernel, dim3(grid), dim3(NTHREADS), LDS_BYTES, stream, p);
}
```

```cpp
#include <hip/hip_runtime.h>
#include <cstdio>
#include <cstdint>

#define LAS __attribute__((address_space(3)))
#define GAS __attribute__((address_space(1)))
typedef unsigned short bf16_t;
typedef short bf16x8 __attribute__((ext_vector_type(8)));
typedef float f32x4 __attribute__((ext_vector_type(4)));
typedef unsigned u32x4 __attribute__((ext_vector_type(4)));
typedef unsigned u32x2 __attribute__((ext_vector_type(2)));

namespace {
constexpr int D = 1024, NB = 4, S = 4096, T = NB * S;
constexpr int ATTN_IN = 2840, PROJ_LD = 3072;
constexpr int OFF_SBQ = 0, OFF_SBK = 512, OFF_SBV = 1024, OFF_NQ = 1536, OFF_KC = 2048, OFF_VC = 2176, OFF_KS = 2304, OFF_VS = 2432,
              OFF_KW = 2560, OFF_VW = 2688, OFF_GATE = 2816;
constexpr int NCMP = 255;
constexpr int SSM_IN = 5152, SSM_INNER = 2048, CONV_DIM = 3072, ZX_LD = 5120;
constexpr int NE = 32, CAP = 16384, MAXTILES = 288;
constexpr float EPS = 1e-6f;
constexpr int NWAVES = 8, NTHREADS = 512;

constexpr size_t al4k(size_t x) { return (x + 4095) & ~(size_t)4095; }
constexpr size_t WS_CTL = 0, CTL_BYTES = 1u << 20;
constexpr int CW_CNT = 256;
constexpr int CW_BAR = 4096;
constexpr size_t CTL_MOD = 65536;
constexpr size_t WS_WIN = CTL_BYTES;
constexpr size_t WS_WOUT = WS_WIN + (size_t)3072 * 1024 * 2;
constexpr size_t WS_WSIN = WS_WOUT + (size_t)1024 * 1024 * 2;
constexpr size_t WS_WSOUT = WS_WSIN + (size_t)5120 * 1024 * 2;
constexpr size_t WS_WGU = WS_WSOUT + (size_t)1024 * 2048 * 2;
constexpr size_t WS_WDN = WS_WGU + (size_t)2 * 32 * 2048 * 1024 * 2;
constexpr size_t WS_U = WS_WDN + (size_t)2 * 32 * 1024 * 1024 * 2;
constexpr size_t WS_BIG = WS_U + (size_t)T * 1024 * 2;
constexpr size_t WS_O = WS_BIG + (size_t)T * 5120 * 2;
constexpr size_t WS_H1 = WS_O + (size_t)T * 2048 * 2;
constexpr size_t WS_H2 = WS_H1 + (size_t)T * 1024 * 4;
constexpr size_t WS_QN = WS_H2 + (size_t)T * 1024 * 4;
constexpr size_t WS_KN = WS_QN + (size_t)T * 512 * 4;
constexpr size_t WS_KCMP = WS_KN + (size_t)T * 256 * 4;
constexpr size_t WS_VCMP = WS_KCMP + al4k((size_t)NB * NCMP * 2 * 64 * 4);
constexpr size_t WS_ACT = WS_VCMP + al4k((size_t)NB * NCMP * 2 * 64 * 4);
constexpr size_t WS_Y = WS_ACT + (size_t)MAXTILES * 256 * 1024 * 2;
constexpr size_t WS_TOKE = WS_Y + (size_t)MAXTILES * 256 * 1024 * 2;
constexpr size_t WS_TOKW = WS_TOKE + (size_t)T * 16;
constexpr size_t WS_TOKP = WS_TOKW + (size_t)T * 16;
constexpr size_t WS_SLOT = WS_TOKP + (size_t)T * 16;
constexpr size_t WS_XC = WS_SLOT + (size_t)NE * CAP * 4;
constexpr size_t WS_YS = WS_XC + (size_t)T * 3072 * 4;
constexpr size_t WS_DT = WS_YS + (size_t)T * 2048 * 4;
constexpr size_t WS_MODF = WS_DT + (size_t)T * 32 * 4;
constexpr size_t WS_WV = WS_MODF + (size_t)2 * 4 * 6144 * 4;
constexpr size_t WS_VT = WS_WV + (size_t)768 * 1024 * 2;
constexpr size_t WS_QNB = WS_VT + (size_t)768 * T * 2;
constexpr size_t WS_KSN = WS_QNB + (size_t)T * 512 * 2;
constexpr size_t WS_KWN = WS_KSN + (size_t)T * 128 * 2;
constexpr size_t WS_KCB = WS_KWN + (size_t)T * 128 * 2;
constexpr size_t WS_VCT = WS_KCB + (size_t)8 * 256 * 64 * 2;
constexpr size_t WS_DT2 = WS_VCT + (size_t)8 * 64 * 256 * 2;
constexpr size_t WS_CS = WS_DT2 + (size_t)NB * 32 * S * 4;
constexpr size_t WS_DEC = WS_CS + (size_t)NB * 32 * S * 4;
constexpr size_t WS_W1T = WS_DEC + al4k((size_t)NB * 16 * 32 * 4);
constexpr size_t WS_END = WS_W1T + (size_t)2 * 128 * 2048 * 2;
constexpr size_t WS_ZBC = WS_BIG, WS_XT = WS_XC, WS_XCT = WS_XC + (size_t)3072 * T * 2, WS_ST = WS_YS, WS_PB = WS_YS + (size_t)NB * 16 * 32 * 8192 * 4, WS_BCM = WS_QN;
static_assert(WS_XCT + (size_t)2560 * T * 2 <= WS_YS && WS_PB + (size_t)NB * 16 * 32 * 8192 * 2 <= WS_DT && (size_t)T * 1024 * 2 <= (size_t)T * 512 * 4, "layer-1 overlays");

constexpr int RING_BYTES = 131072;
constexpr int TAB_OFF = RING_BYTES;
constexpr int XB_OFF = RING_BYTES + 1024;
constexpr int LDS_BYTES = 147456;

struct Params { const float* in[30]; float* out; unsigned char* ws; };

__device__ __forceinline__ float siluf(float v) { return v / (1.f + expf(-v)); }
__device__ __forceinline__ float logsig(float x) { return fminf(x, 0.f) - log1pf(expf(-fabsf(x))); }
__device__ __forceinline__ float wave_sum(float v) {
#pragma unroll
    for (int o = 32; o > 0; o >>= 1) v += __shfl_xor(v, o);
    return v;
}
__device__ __forceinline__ float wave_max(float v) {
#pragma unroll
    for (int o = 32; o > 0; o >>= 1) v = fmaxf(v, __shfl_xor(v, o));
    return v;
}
__device__ __forceinline__ unsigned f2bf(float f) { unsigned u = __builtin_bit_cast(unsigned, f); return (u + 0x7fffu + ((u >> 16) & 1u)) >> 16; }
__device__ __forceinline__ unsigned pk2(float lo, float hi) { return f2bf(lo) | (f2bf(hi) << 16); }
__device__ __forceinline__ float bf2f(bf16_t v) { return __uint_as_float((unsigned)v << 16); }
__device__ __forceinline__ float bflo(unsigned w) { return __uint_as_float(w << 16); }
__device__ __forceinline__ float bfhi(unsigned w) { return __uint_as_float(w & 0xffff0000u); }
#define LDS_WAIT() asm volatile("s_waitcnt lgkmcnt(0)" ::: "memory")
__device__ __forceinline__ int fresh(int v) { asm volatile("" : "+v"(v)); return v; }

#define XB_TMO      128
#define XB_XCNT(j)  (256  + 64 * (j))
#define XB_XSUB(j)  (1280 + 64 * (j))
#define XB_XGEN(j)  (2304 + 64 * (j))
#define XB_TOP      3328
#define XB_TOPGEN   3392
#define XCD_BAR_WORDS 3456
#define XB_SPIN_CAP (1u << 18)
__device__ __forceinline__ unsigned xb_ld(unsigned* p)              { return __hip_atomic_load(p, __ATOMIC_RELAXED, __HIP_MEMORY_SCOPE_AGENT); }
__device__ __forceinline__ unsigned xb_add(unsigned* p, unsigned v) { return __hip_atomic_fetch_add(p, v, __ATOMIC_RELAXED, __HIP_MEMORY_SCOPE_AGENT); }
__device__ __forceinline__ unsigned xb_xcc_id() { return (unsigned)__builtin_amdgcn_s_getreg((3 << 11) | 20) & 0xFu; }
#define XB_SPIN(cond, bar) do { unsigned _sp = 0; while (cond) { __builtin_amdgcn_s_sleep(1); \
    if ((++_sp & 255u) == 0u) { if (xb_ld(&(bar)[XB_TMO])) break; if (_sp > XB_SPIN_CAP) { atomicAdd(&(bar)[XB_TMO], 1u); break; } } } } while (0)
struct XcdBarrier { unsigned* bar; unsigned x; volatile LAS unsigned* st; };
__device__ __forceinline__ XcdBarrier xcd_barrier_post(unsigned* bar, volatile LAS unsigned* st) {
    XcdBarrier b; b.bar = bar; b.x = xb_xcc_id(); b.st = st;
    if (threadIdx.x == 0) (void)xb_add(&bar[XB_XCNT(b.x)], 1u);
    return b;
}
__device__ __forceinline__ void xcd_barrier_complete(unsigned* bar, unsigned x, unsigned& nloc, unsigned& nx) {
    const unsigned G = gridDim.x * gridDim.y * gridDim.z;
    unsigned sum, cnt, mine, sp = 0u;
    for (;;) {
        sum = 0u; cnt = 0u; mine = 0u;
#pragma unroll
        for (unsigned j = 0; j < 16; ++j) { const unsigned c = xb_ld(&bar[XB_XCNT(j)]); sum += c; cnt += (c > 0u) ? 1u : 0u; mine = (j == x) ? c : mine; }
        if (sum == G) break;
        __builtin_amdgcn_s_sleep(1);
        if ((++sp & 255u) == 0u) { if (xb_ld(&bar[XB_TMO])) break; if (sp > XB_SPIN_CAP) { atomicAdd(&bar[XB_TMO], 1u); break; } }
    }
    nloc = mine > 0u ? mine : 1u; nx = cnt > 0u ? cnt : 1u;
}
__device__ __forceinline__ void xcd_barrier(const XcdBarrier& b) {
    asm volatile("s_waitcnt vmcnt(0)" ::: "memory");
    __syncthreads();
    if (threadIdx.x == 0) {
        unsigned* bar = b.bar;
        __builtin_amdgcn_s_waitcnt(0);
        unsigned nloc = b.st[0], nx = b.st[1];
        if (nloc == 0u) { xcd_barrier_complete(bar, b.x, nloc, nx); b.st[0] = nloc; b.st[1] = nx; }
        const unsigned old = xb_add(&bar[XB_XSUB(b.x)], 1u);
        const unsigned gen = old / nloc;
        if (old + 1u == (gen + 1u) * nloc) {
            __builtin_amdgcn_fence(__ATOMIC_RELEASE, "agent");
            asm volatile("s_waitcnt vmcnt(0)" ::: "memory");
            const unsigned og = xb_add(&bar[XB_TOP], 1u);
            const unsigned tg = og / nx;
            if (og + 1u == (tg + 1u) * nx) xb_add(&bar[XB_TOPGEN], 1u);
            else XB_SPIN(xb_ld(&bar[XB_TOPGEN]) == tg, bar);
            __builtin_amdgcn_fence(__ATOMIC_ACQUIRE, "agent");
            xb_add(&bar[XB_XGEN(b.x)], 1u);
            asm volatile("s_waitcnt vmcnt(0)" ::: "memory");
        } else {
            XB_SPIN(xb_ld(&bar[XB_XGEN(b.x)]) == gen, bar);
            __builtin_amdgcn_fence(__ATOMIC_ACQUIRE, "agent");
            asm volatile("s_waitcnt vmcnt(0)" ::: "memory");
        }
    }
    __syncthreads();
}

namespace pg8 {
constexpr int BM = 256, BK = 64, HALF = 128, HTB = HALF * BK * 2, STAGE_BYTES = 8 * HTB;
__device__ __forceinline__ int lds_byte(int r, int c) { const int st = (r >> 4) * 2 + (c >> 5), rr = r & 15, cc = c & 31, ob = rr * 64 + cc * 2; return st * 1024 + (ob ^ (((ob >> 9) & 1) << 5)); }
__device__ __forceinline__ void stage_rc(int b, int& R, int& C) { const int st = b / 1024, sb = b % 1024, swz = sb ^ (((sb >> 9) & 1) << 5); R = (st >> 1) * 16 + swz / 64; C = (st & 1) * 32 + (swz % 64) / 2; }
__device__ __forceinline__ int perm32(int rho) { const int n = rho >> 4, i = rho & 15; return 8 * (i >> 2) + 4 * n + (i & 3); }
struct Unit { int pm, pn, e; };
struct Gemm { const bf16_t* A; const bf16_t* Bt; int K; };
__device__ __forceinline__ unsigned cvt_pk_bf16(float lo, float hi) { unsigned r; asm volatile("v_cvt_pk_bf16_f32 %0, %1, %2" : "=v"(r) : "v"(lo), "v"(hi)); return r; }

struct DenseOrder {
    int nM, nN, nwg, G, c;
    __device__ void init(int M, int N, int G_, int c_) { nM = M / BM; nN = N / BM; nwg = nM * nN; G = G_; c = c_; }
    __device__ bool next(int i, Unit& u) const {
        const long L = (long)i * G + c; if (L >= nwg) return false;
        int wgid = (int)L; { const int q = nwg / 8, r = nwg % 8, xcd = wgid % 8, off = wgid / 8; wgid = (xcd < r ? xcd * (q + 1) : r * (q + 1) + (xcd - r) * q) + off; }
        const int nig = 8 * nN, gid = wgid / nig, fm = gid * 8, gsz = (nM - fm) < 8 ? (nM - fm) : 8;
        u.pm = fm + ((wgid % nig) % gsz); u.pn = (wgid % nig) / gsz; u.e = 0; return true;
    }
    __device__ __forceinline__ unsigned arow(const Unit& u, int r) const { return (unsigned)(u.pm * BM + r); }
};
struct MoeOrder {
    const LAS int* tb; const LAS int* cn; const int* slot_tok; int shift, G, c; bool gather;
    __device__ bool next(int i, Unit& u) const {
        const int L = i * G + c, tile = L >> shift; if (tile >= tb[NE]) return false;
        int e = 0; while (tb[e + 1] <= tile) ++e;
        u.pm = tile; u.pn = (e << shift) + (L & ((1 << shift) - 1)); u.e = e; return true;
    }
    __device__ __forceinline__ unsigned arow(const Unit& u, int r) const {
        if (!gather) return (unsigned)(u.pm * BM + r);
        const int pos = (u.pm - tb[u.e]) * BM + r;
        return pos < cn[u.e] ? (unsigned)slot_tok[u.e * CAP + pos] : 0u;
    }
};

struct EpiBf16 {
    static constexpr bool PERM = true;
    bf16_t* O; int ldc;
    __device__ __forceinline__ void operator()(const f32x4 (&acc)[2][2][4][2], const Unit& u, int wr, int wc, int fr, int fq) const {
        const int row0 = u.pm * BM + wr * 64 + fr, col0 = u.pn * BM + wc * 32 + 8 * fq;
#pragma unroll
        for (int ai = 0; ai < 2; ++ai)
#pragma unroll
            for (int m = 0; m < 4; ++m) { bf16_t* rowp = O + (size_t)(row0 + ai * HALF + m * 16) * ldc + col0;
#pragma unroll
                for (int bj = 0; bj < 2; ++bj) { const f32x4 v0 = acc[ai][bj][m][0], v1 = acc[ai][bj][m][1];
                    u32x4 w; w.x = cvt_pk_bf16(v0[0], v0[1]); w.y = cvt_pk_bf16(v0[2], v0[3]); w.z = cvt_pk_bf16(v1[0], v1[1]); w.w = cvt_pk_bf16(v1[2], v1[3]);
                    *(u32x4*)(rowp + bj * HALF) = w; } }
    }
};
struct EpiResid {
    static constexpr bool PERM = false;
    const float* base; float* out; const float* g;
    __device__ __forceinline__ void operator()(const f32x4 (&acc)[2][2][4][2], const Unit& u, int wr, int wc, int fr, int fq) const {
        const int row0 = u.pm * BM + wr * 64 + fr, col0 = u.pn * BM + wc * 32 + 4 * fq;
        const float* gb = g + (size_t)((u.pm * BM) / S) * 6144 + col0;
        f32x4 gv[2][2];
#pragma unroll
        for (int bj = 0; bj < 2; ++bj)
#pragma unroll
            for (int n = 0; n < 2; ++n) gv[bj][n] = *(const f32x4*)(gb + bj * HALF + n * 16);
#pragma unroll
        for (int ai = 0; ai < 2; ++ai)
#pragma unroll
            for (int m = 0; m < 4; ++m) { const size_t off = (size_t)(row0 + ai * HALF + m * 16) * D + col0;
#pragma unroll
                for (int bj = 0; bj < 2; ++bj)
#pragma unroll
                    for (int n = 0; n < 2; ++n) { const f32x4 bs = *(const f32x4*)(base + off + bj * HALF + n * 16);
                        *(f32x4*)(out + off + bj * HALF + n * 16) = bs + gv[bj][n] * acc[ai][bj][m][n]; } }
    }
};
struct EpiGu {
    static constexpr bool PERM = true;
    bf16_t* act; const float* bgu;
    __device__ __forceinline__ void operator()(const f32x4 (&acc)[2][2][4][2], const Unit& u, int wr, int wc, int fr, int fq) const {
        const int row0 = u.pm * BM + wr * 64 + fr, col0 = (u.pn & 7) * HALF + wc * 32 + 8 * fq;
        const float* bb = bgu + (size_t)u.e * 2048 + col0;
        const f32x4 bg0 = *(const f32x4*)(bb), bg1 = *(const f32x4*)(bb + 4), bu0 = *(const f32x4*)(bb + 1024), bu1 = *(const f32x4*)(bb + 1028);
#pragma unroll
        for (int ai = 0; ai < 2; ++ai)
#pragma unroll
            for (int m = 0; m < 4; ++m) {
                float r[8];
#pragma unroll
                for (int n = 0; n < 2; ++n) { const f32x4 gt = acc[ai][0][m][n] + (n ? bg1 : bg0), up = acc[ai][1][m][n] + (n ? bu1 : bu0);
#pragma unroll
                    for (int j = 0; j < 4; ++j) { const float gg = fminf(gt[j], 7.f), uu = fminf(fmaxf(up[j], -7.f), 7.f);
                        r[n * 4 + j] = (uu + 1.f) * gg * __builtin_amdgcn_rcpf(1.f + __expf(-1.702f * gg)); } }
                u32x4 w; w.x = cvt_pk_bf16(r[0], r[1]); w.y = cvt_pk_bf16(r[2], r[3]); w.z = cvt_pk_bf16(r[4], r[5]); w.w = cvt_pk_bf16(r[6], r[7]);
                *(u32x4*)(act + (size_t)(row0 + ai * HALF + m * 16) * D + col0) = w; }
    }
};
struct EpiDown {
    static constexpr bool PERM = true;
    bf16_t* y; const float* bd;
    __device__ __forceinline__ void operator()(const f32x4 (&acc)[2][2][4][2], const Unit& u, int wr, int wc, int fr, int fq) const {
        const int row0 = u.pm * BM + wr * 64 + fr, col0 = (u.pn & 3) * BM + wc * 32 + 8 * fq;
        const float* bb = bd + (size_t)u.e * 1024 + col0;
        f32x4 bv[2][2];
#pragma unroll
        for (int bj = 0; bj < 2; ++bj)
#pragma unroll
            for (int n = 0; n < 2; ++n) bv[bj][n] = *(const f32x4*)(bb + bj * HALF + 4 * n);
#pragma unroll
        for (int ai = 0; ai < 2; ++ai)
#pragma unroll
            for (int m = 0; m < 4; ++m) { bf16_t* rowp = y + (size_t)(row0 + ai * HALF + m * 16) * D + col0;
#pragma unroll
                for (int bj = 0; bj < 2; ++bj) { const f32x4 v0 = acc[ai][bj][m][0] + bv[bj][0], v1 = acc[ai][bj][m][1] + bv[bj][1];
                    u32x4 w; w.x = cvt_pk_bf16(v0[0], v0[1]); w.y = cvt_pk_bf16(v0[2], v0[3]); w.z = cvt_pk_bf16(v1[0], v1[1]); w.w = cvt_pk_bf16(v1[2], v1[3]);
                    *(u32x4*)(rowp + bj * HALF) = w; } }
    }
};

template <class Epi, class Sched>
__device__ __forceinline__ void gemm_phase(LAS unsigned char* lds, const Gemm g, const Sched& S, const Epi& E, const int tid) {
    const int wid = __builtin_amdgcn_readfirstlane(tid >> 6), lane = tid & 63, wr = wid >> 2, wc = wid & 3, fr = lane & 15, fq = lane >> 4;
    const int K = g.K, nt = K / BK;
    int RA[2], CA[2]; unsigned voffB[2];
#pragma unroll
    for (int i = 0; i < 2; ++i) { int R, C; stage_rc(tid * 16 + i * 8192, R, C); const int Rb = Epi::PERM ? ((R & ~31) + perm32(R & 31)) : R;
        RA[i] = R; CA[i] = C; voffB[i] = (unsigned)(Rb * K + C) * 2u; }
    const size_t kstep = (size_t)(BK * 2);
    const size_t hstep = (size_t)HALF * K * 2;
    const size_t tstep = 2 * hstep;
    const unsigned ldsw = (unsigned)wid * 1024u;
    const int aoff = lds_byte(wr * 64 + fr, fq * 8), boff = lds_byte(wc * 32 + fr, fq * 8);
#define PG8_SA(b, h) (((b) * 2 + (h)) * HTB)
#define PG8_SB(b, h) ((4 + (b) * 2 + (h)) * HTB)
#define PG8_STAGE(bufoff, gbase, voff) do { _Pragma("unroll") for (int _i = 0; _i < 2; ++_i) \
        __builtin_amdgcn_global_load_lds((const unsigned*)((const char*)(gbase) + (voff)[_i]), (LAS unsigned*)(lds + (bufoff) + ldsw + _i * 8192), 16, 0, 0); } while (0)
#define PG8_LDA(dst, b, h) do { _Pragma("unroll") for (int m = 0; m < 4; ++m) _Pragma("unroll") for (int k = 0; k < 2; ++k) dst[m][k] = *(const LAS bf16x8*)(lds + PG8_SA(b, h) + aoff + m * 2048 + k * 1024); } while (0)
#define PG8_LDB(dst, b, h) do { _Pragma("unroll") for (int n = 0; n < 2; ++n) _Pragma("unroll") for (int k = 0; k < 2; ++k) dst[n][k] = *(const LAS bf16x8*)(lds + PG8_SB(b, h) + boff + n * 2048 + k * 1024); } while (0)
#define PG8_MMA(ai, bj, At, Bt) do { __builtin_amdgcn_s_setprio(1); _Pragma("unroll") for (int m = 0; m < 4; ++m) _Pragma("unroll") for (int n = 0; n < 2; ++n) _Pragma("unroll") for (int k = 0; k < 2; ++k) \
        acc[ai][bj][m][n] = __builtin_amdgcn_mfma_f32_16x16x32_bf16(Bt[n][k], At[m][k], acc[ai][bj][m][n], 0, 0, 0); __builtin_amdgcn_s_setprio(0); } while (0)
#define PG8_WAIT_V(n) asm volatile("s_waitcnt vmcnt(" #n ")" ::: "memory")
#define PG8_WAIT_L(n) asm volatile("s_waitcnt lgkmcnt(" #n ")" ::: "memory")
#define PG8_BAR __builtin_amdgcn_s_barrier()
#define PG8_SCHED __builtin_amdgcn_sched_barrier(0)
#define PG8_AOFF(dst, u) do { _Pragma("unroll") for (int _h = 0; _h < 2; ++_h) _Pragma("unroll") for (int _i = 0; _i < 2; ++_i) dst[_h][_i] = (S.arow(u, _h * HALF + RA[_i]) * (unsigned)K + (unsigned)CA[_i]) * 2u; } while (0)
    Unit cur, nxt; int ui = 0;
    if (!S.next(0, cur)) return;
    f32x4 acc[2][2][4][2];
#pragma unroll
    for (int a = 0; a < 2; ++a)
#pragma unroll
        for (int b = 0; b < 2; ++b)
#pragma unroll
            for (int m = 0; m < 4; ++m)
#pragma unroll
                for (int n = 0; n < 2; ++n) acc[a][b][m][n] = (f32x4){0.f, 0.f, 0.f, 0.f};
    bf16x8 At[4][2], B0[2][2], B1[2][2];
    unsigned va[2][2], vn[2][2];
    PG8_AOFF(va, cur);
    const char* Ab = (const char*)g.A;
    const char* cB = (const char*)g.Bt + (size_t)cur.pn * tstep;
    PG8_STAGE(PG8_SB(0, 0), cB, voffB); PG8_STAGE(PG8_SB(0, 1), cB + hstep, voffB); PG8_STAGE(PG8_SA(0, 0), Ab, va[0]); PG8_STAGE(PG8_SA(0, 1), Ab, va[1]);
    if (wr == 1) PG8_BAR;
    PG8_WAIT_V(2); PG8_BAR;
    PG8_STAGE(PG8_SB(1, 0), cB + kstep, voffB); PG8_STAGE(PG8_SA(1, 0), Ab + kstep, va[0]); PG8_STAGE(PG8_SB(1, 1), cB + hstep + kstep, voffB);
    PG8_WAIT_V(6); PG8_BAR;
    for (;;) {
        const bool has_next = S.next(ui + 1, nxt);
        if (has_next) { PG8_AOFF(vn, nxt); }
        else {
#pragma unroll
            for (int h = 0; h < 2; ++h)
#pragma unroll
                for (int i = 0; i < 2; ++i) vn[h][i] = va[h][i]; }
        const char* nB = has_next ? (const char*)g.Bt + (size_t)nxt.pn * tstep : cB;
        for (int t = 0; t < nt; t += 2) {
            const bool last = (t == nt - 2);
            const char* a1 = Ab + (size_t)(t + 1) * kstep;
            const char* a2 = last ? Ab : Ab + (size_t)(t + 2) * kstep; const char* b2 = last ? nB : cB + (size_t)(t + 2) * kstep;
            const char* a3 = a2 + kstep; const char* b3 = b2 + kstep;
            unsigned o2[2][2];
#pragma unroll
            for (int h = 0; h < 2; ++h)
#pragma unroll
                for (int i = 0; i < 2; ++i) o2[h][i] = last ? vn[h][i] : va[h][i];
            PG8_LDB(B0, 0, 0); PG8_LDB(B1, 0, 1); PG8_SCHED; PG8_LDA(At, 0, 0); PG8_STAGE(PG8_SA(1, 1), a1, va[1]);
            PG8_WAIT_V(8); PG8_WAIT_L(0); PG8_BAR; PG8_MMA(0, 0, At, B0); PG8_MMA(0, 1, At, B1); PG8_BAR; PG8_SCHED;
            PG8_LDA(At, 0, 1); PG8_STAGE(PG8_SB(0, 0), b2, voffB); PG8_STAGE(PG8_SB(0, 1), b2 + hstep, voffB); PG8_STAGE(PG8_SA(0, 0), a2, o2[0]);
            PG8_WAIT_V(8); PG8_WAIT_L(0); PG8_BAR; PG8_MMA(1, 0, At, B0); PG8_MMA(1, 1, At, B1); PG8_BAR; PG8_SCHED;
            PG8_LDB(B0, 1, 0); PG8_LDB(B1, 1, 1); PG8_SCHED; PG8_LDA(At, 1, 0); PG8_STAGE(PG8_SA(0, 1), a2, o2[1]);
            PG8_WAIT_V(8); PG8_WAIT_L(0); PG8_BAR; PG8_MMA(0, 0, At, B0); PG8_MMA(0, 1, At, B1); PG8_BAR; PG8_SCHED;
            PG8_LDA(At, 1, 1); PG8_STAGE(PG8_SB(1, 0), b3, voffB); PG8_STAGE(PG8_SB(1, 1), b3 + hstep, voffB); PG8_STAGE(PG8_SA(1, 0), a3, o2[0]);
            PG8_WAIT_V(8); PG8_WAIT_L(0); PG8_BAR; PG8_MMA(1, 0, At, B0); PG8_MMA(1, 1, At, B1); PG8_BAR; PG8_SCHED;
        }
        if (wr == 0) PG8_BAR;
        E(acc, cur, wr, wc, fr, fq);
        if (!has_next) break;
#pragma unroll
        for (int a = 0; a < 2; ++a)
#pragma unroll
            for (int b = 0; b < 2; ++b)
#pragma unroll
                for (int m = 0; m < 4; ++m)
#pragma unroll
                    for (int n = 0; n < 2; ++n) acc[a][b][m][n] = (f32x4){0.f, 0.f, 0.f, 0.f};
        cur = nxt; cB = nB; ++ui;
#pragma unroll
        for (int h = 0; h < 2; ++h)
#pragma unroll
            for (int i = 0; i < 2; ++i) va[h][i] = vn[h][i];
        if (wr == 1) PG8_BAR;
    }
    PG8_WAIT_V(0);
    PG8_BAR;
#undef PG8_SA
#undef PG8_SB
#undef PG8_STAGE
#undef PG8_LDA
#undef PG8_LDB
#undef PG8_MMA
#undef PG8_WAIT_V
#undef PG8_WAIT_L
#undef PG8_BAR
#undef PG8_SCHED
#undef PG8_AOFF
}
}

struct Ctx {
    LAS unsigned char* lds; unsigned char* ws;
    int tid, lane, wave, gw, ngw, G, bid;
};

__device__ __forceinline__ void transpose_item(const float* W, int ldw, int K, int nvalid, int k0, int n0, bf16_t* WT, int row0, LAS float* scr, int lane) {
    const int nn = n0 + (lane & 31);
#pragma unroll 8
    for (int i = 0; i < 32; ++i) { const int kk = 2 * i + (lane >> 5); scr[kk * 33 + (lane & 31)] = nn < nvalid ? W[(size_t)(k0 + kk) * ldw + nn] : 0.f; }
    LDS_WAIT(); asm volatile("" ::: "memory");
    const int c = lane & 7;
#pragma unroll
    for (int j = 0; j < 4; ++j) { const int n = (lane >> 3) + 8 * j; const LAS float* s = scr + (8 * c) * 33 + n;
        u32x4 o; o.x = pk2(s[0 * 33], s[1 * 33]); o.y = pk2(s[2 * 33], s[3 * 33]); o.z = pk2(s[4 * 33], s[5 * 33]); o.w = pk2(s[6 * 33], s[7 * 33]);
        *(u32x4*)(WT + (size_t)(row0 + n) * K + k0 + 8 * c) = o; }
    LDS_WAIT(); asm volatile("" ::: "memory");
}
__device__ __forceinline__ void ph_prologue(const Params& p, const Ctx& X) {
    LAS float* scr = (LAS float*)(X.lds + X.wave * 16384);
    unsigned char* ws = X.ws;
    constexpr int I_MOD = 2 * 96 * 8;
    constexpr int I_W1 = 2 * 32 * 4, I_WIN = 16 * 96, I_WV = 16 * 24, I_WOUT = 16 * 32, I_WSIN = 16 * 160, I_WSOUT = 32 * 32, I_GU = 64 * 1024, I_DN = 64 * 512;
    constexpr int NITEMS = I_MOD + I_W1 + I_WIN + I_WV + I_WOUT + I_WSIN + I_WSOUT + I_GU + I_DN;
    for (int it = X.gw; it < NITEMS; it += X.ngw) {
        int r = it;
        if (r < I_MOD) {
            const int kp = r & 7, jb = (r >> 3) % 96, l = r / (8 * 96), j = jb * 64 + X.lane;
            const float* w = p.in[2] + (size_t)l * 1024 * 6144 + (size_t)(kp * 128) * 6144 + j;
            const float* c = p.in[1] + kp * 128;
            float a0 = 0.f, a1 = 0.f, a2 = 0.f, a3 = 0.f;
#pragma unroll 8
            for (int i = 0; i < 128; ++i) { const float wv = w[(size_t)i * 6144];
                a0 += siluf(c[i]) * wv; a1 += siluf(c[1024 + i]) * wv; a2 += siluf(c[2048 + i]) * wv; a3 += siluf(c[3072 + i]) * wv; }
            if (kp == 0) { const float bb = p.in[3][l * 6144 + j]; a0 += bb; a1 += bb; a2 += bb; a3 += bb; }
            unsigned long long* mq = (unsigned long long*)(ws + CTL_MOD) + (size_t)l * 4 * 6144 + j;
            atomicAdd(mq, (unsigned long long)__double2ll_rn((double)a0 * 1099511627776.0)); atomicAdd(mq + 6144, (unsigned long long)__double2ll_rn((double)a1 * 1099511627776.0));
            atomicAdd(mq + 2 * 6144, (unsigned long long)__double2ll_rn((double)a2 * 1099511627776.0)); atomicAdd(mq + 3 * 6144, (unsigned long long)__double2ll_rn((double)a3 * 1099511627776.0));
            continue;
        }
        r -= I_MOD;
        if (r < I_W1) { const int kv = r >> 7, q = r & 127, kb = q >> 2, nb = q & 3;
            transpose_item(kv ? p.in[14] : p.in[12], 128, 2048, 128, kb * 64, nb * 32, (bf16_t*)(ws + WS_W1T) + (size_t)kv * 128 * 2048, nb * 32, scr, X.lane); continue; } r -= I_W1;
        if (r < I_WIN) { const int kb = r / 96, nb = r % 96; transpose_item(p.in[6], ATTN_IN, 1024, ATTN_IN, kb * 64, nb * 32, (bf16_t*)(ws + WS_WIN), nb * 32, scr, X.lane); continue; } r -= I_WIN;
        if (r < I_WV) { const int kb = r / 24, nb = r % 24, r0 = nb * 32, src = r0 < 512 ? OFF_SBV + r0 : (r0 < 640 ? OFF_VS + (r0 - 512) : OFF_VW + (r0 - 640));
            transpose_item(p.in[6], ATTN_IN, 1024, ATTN_IN, kb * 64, src, (bf16_t*)(ws + WS_WV), r0, scr, X.lane); continue; } r -= I_WV;
        if (r < I_WOUT) { const int kb = r / 32, nb = r % 32; transpose_item(p.in[7], 1024, 1024, 1024, kb * 64, nb * 32, (bf16_t*)(ws + WS_WOUT), nb * 32, scr, X.lane); continue; } r -= I_WOUT;
        if (r < I_WSIN) { const int kb = r / 160, nb = r % 160, n0 = nb * 32, row0 = n0 < 2048 ? n0 : (n0 < 4096 ? n0 + 1024 : n0 - 2048);
            transpose_item(p.in[16], SSM_IN, 1024, SSM_IN, kb * 64, n0, (bf16_t*)(ws + WS_WSIN), row0, scr, X.lane); continue; } r -= I_WSIN;
        if (r < I_WSOUT) { const int kb = r / 32, nb = r % 32; transpose_item(p.in[23], 1024, 2048, 1024, kb * 64, nb * 32, (bf16_t*)(ws + WS_WSOUT), nb * 32, scr, X.lane); continue; } r -= I_WSOUT;
        if (r < I_GU) { const int m = r >> 10, q = r & 1023, kb = q >> 6, nb = q & 63, n0 = nb * 32;
            const int row0 = ((n0 & 1023) >> 7) * 256 + (n0 >> 10) * 128 + (n0 & 127);
            transpose_item(p.in[26] + (size_t)m * 1024 * 2048, 2048, 1024, 2048, kb * 64, n0, (bf16_t*)(ws + WS_WGU) + (size_t)m * 2048 * 1024, row0, scr, X.lane); continue; } r -= I_GU;
        { const int m = r >> 9, q = r & 511, kb = q >> 5, nb = q & 31;
            transpose_item(p.in[28] + (size_t)m * 1024 * 1024, 1024, 1024, 1024, kb * 64, nb * 32, (bf16_t*)(ws + WS_WDN) + (size_t)m * 1024 * 1024, nb * 32, scr, X.lane); }
    }
}

struct Row { f32x4 v[4]; };
__device__ __forceinline__ void row_load(Row& r, const float* p, int lane) {
#pragma unroll
    for (int j = 0; j < 4; ++j) r.v[j] = ((const f32x4*)p)[64 * j + lane];
}
__device__ __forceinline__ void row_store(const Row& r, float* p, int lane) {
#pragma unroll
    for (int j = 0; j < 4; ++j) ((f32x4*)p)[64 * j + lane] = r.v[j];
}
template <class PV>
__device__ __forceinline__ void row_norm_mod(const Row& r, Row& o, const float* gain, PV sc, PV sh, int lane) {
    float ss = 0.f;
#pragma unroll
    for (int j = 0; j < 4; ++j) ss += (r.v[j].x * r.v[j].x + r.v[j].y * r.v[j].y) + (r.v[j].z * r.v[j].z + r.v[j].w * r.v[j].w);
    const float rs = rsqrtf(wave_sum(ss) * (1.f / 1024.f) + EPS);
#pragma unroll
    for (int j = 0; j < 4; ++j) { const f32x4 g = ((const f32x4*)gain)[64 * j + lane], a = sc[64 * j + lane], b = sh[64 * j + lane];
        o.v[j] = r.v[j] * rs * g * (a + 1.f) + b; }
}
__device__ __forceinline__ void row_store_bf16(const Row& r, bf16_t* p, int lane) {
#pragma unroll
    for (int j = 0; j < 4; ++j) { u32x2 w; w.x = pk2(r.v[j].x, r.v[j].y); w.y = pk2(r.v[j].z, r.v[j].w); ((u32x2*)p)[64 * j + lane] = w; }
}
__device__ __forceinline__ void row_store_lds(const Row& r, LAS float* p, int lane) {
#pragma unroll
    for (int j = 0; j < 4; ++j) ((LAS f32x4*)p)[64 * j + lane] = r.v[j];
}
__device__ __forceinline__ void skinny4(const LAS float* scr, const float* W, int ldw, int col0, int lane, float (&acc)[4]) {
    const int e = lane & 31, half = lane >> 5;
    acc[0] = acc[1] = acc[2] = acc[3] = 0.f;
    const float* w = W + (size_t)(half * 512) * ldw + col0 + e;
    const LAS float* s = scr + half * 512;
#pragma unroll 2
    for (int i = 0; i < 512; i += 4) {
        const float w0 = w[(size_t)i * ldw], w1 = w[(size_t)(i + 1) * ldw], w2 = w[(size_t)(i + 2) * ldw], w3 = w[(size_t)(i + 3) * ldw];
#pragma unroll
        for (int tk = 0; tk < 4; ++tk) { const f32x4 x = *(const LAS f32x4*)(s + tk * 1024 + i); acc[tk] += (x.x * w0 + x.y * w1) + (x.z * w2 + x.w * w3); }
    }
#pragma unroll
    for (int tk = 0; tk < 4; ++tk) acc[tk] += __shfl_xor(acc[tk], 32);
}
__device__ __forceinline__ void route_token(float logit, int t, int l, const Ctx& X) {
    const int lane = X.lane, e = lane & 31;
    float tl[4]; int te[4];
#pragma unroll
    for (int k = 0; k < 4; ++k) {
        float bv = logit; int bi = e;
#pragma unroll
        for (int o = 16; o > 0; o >>= 1) { const float ov = __shfl_xor(bv, o); const int oi = __shfl_xor(bi, o); if (ov > bv || (ov == bv && oi < bi)) { bv = ov; bi = oi; } }
        tl[k] = bv; te[k] = bi;
        if (e == bi) logit = -INFINITY;
    }
    if (lane < 4) {
        const float e1 = expf(tl[1] - tl[0]), e2 = expf(tl[2] - tl[0]), e3 = expf(tl[3] - tl[0]);
        const float inv = 1.f / (1.f + e1 + e2 + e3);
        const float wv = (lane == 0 ? 1.f : lane == 1 ? e1 : lane == 2 ? e2 : e3) * inv;
        const int ev = lane == 0 ? te[0] : lane == 1 ? te[1] : lane == 2 ? te[2] : te[3];
        unsigned* cnt = (unsigned*)(X.ws + WS_CTL) + CW_CNT + l * 32;
        const int pos = (int)atomicAdd(&cnt[ev], 1u);
        ((int*)(X.ws + WS_TOKE))[t * 4 + lane] = ev; ((float*)(X.ws + WS_TOKW))[t * 4 + lane] = wv; ((int*)(X.ws + WS_TOKP))[t * 4 + lane] = pos;
        ((int*)(X.ws + WS_SLOT))[ev * CAP + pos] = t;
    }
}

__device__ __forceinline__ float modq2f(long long q) { return (float)((double)q * 9.094947017729282e-13); }
__device__ __forceinline__ void ph_norm0(const Params& p, const Ctx& X) {
    const long long* mq = (const long long*)(X.ws + CTL_MOD);
    float* modf = (float*)(X.ws + WS_MODF);
    for (int i = X.bid * NTHREADS + X.tid; i < 2 * 4 * 6144; i += X.G * NTHREADS) modf[i] = modq2f(mq[i]);
    LAS float* tab = (LAS float*)X.lds;
    for (int i = X.tid; i < 4 * 2048; i += NTHREADS) tab[i] = modq2f(mq[(size_t)(i >> 11) * 6144 + (i & 2047)]);
    __syncthreads();
    for (int t = X.gw; t < T; t += X.ngw) {
        Row r, o; row_load(r, p.in[0] + (size_t)t * D, X.lane);
        const LAS float* m = tab + (t / S) * 2048;
        row_norm_mod(r, o, p.in[4], (const LAS f32x4*)(m + 1024), (const LAS f32x4*)m, X.lane);
        row_store_bf16(o, (bf16_t*)(X.ws + WS_U) + (size_t)t * D, X.lane);
    }
}
__device__ __forceinline__ void ph_router(const Params& p, const Ctx& X, int l, const float* h) {
    const float* mod = (const float*)(X.ws + WS_MODF) + (size_t)l * 4 * 6144;
    LAS float* scr = (LAS float*)(X.lds + X.wave * 16384);
    for (int g4 = X.gw; g4 < T / 4; g4 += X.ngw) {
#pragma unroll
        for (int tk = 0; tk < 4; ++tk) { const int t = g4 * 4 + tk;
            Row r, o; row_load(r, h + (size_t)t * D, X.lane);
            const float* m = mod + (size_t)(t / S) * 6144;
            row_norm_mod(r, o, p.in[5] + l * D, (const f32x4*)(m + 4096), (const f32x4*)(m + 3072), X.lane);
            row_store_bf16(o, (bf16_t*)(X.ws + WS_U) + (size_t)t * D, X.lane);
            row_store_lds(o, scr + tk * 1024, X.lane); }
        LDS_WAIT();
        float acc[4]; skinny4(scr, p.in[24] + (size_t)l * D * NE, NE, 0, X.lane, acc);
        const float bias = p.in[25][l * NE + (X.lane & 31)];
#pragma unroll
        for (int tk = 0; tk < 4; ++tk) route_token(acc[tk] + bias, g4 * 4 + tk, l, X);
        LDS_WAIT();
    }
}
__device__ __forceinline__ void moe_table(const Ctx& X, int l) {
    LAS int* tb = (LAS int*)(X.lds + TAB_OFF);
    if (X.tid == 0) {
        const unsigned* cnt = (const unsigned*)(X.ws + WS_CTL) + CW_CNT + l * 32;
        int base = 0;
        for (int e = 0; e < NE; ++e) { const int c = (int)__hip_atomic_load(cnt + e, __ATOMIC_RELAXED, __HIP_MEMORY_SCOPE_AGENT); tb[e] = base; tb[40 + e] = c; base += (c + 255) >> 8; }
        tb[NE] = base;
    }
    __syncthreads();
}
template <int MODE>
__device__ __forceinline__ void ph_combine(const Params& p, const Ctx& X, int l, const float* h, float* hn) {
    moe_table(X, l);
    const LAS int* tb = (const LAS int*)(X.lds + TAB_OFF);
    const float* mod = (const float*)(X.ws + WS_MODF) + (size_t)l * 4 * 6144;
    const float* mod1 = (const float*)(X.ws + WS_MODF) + (size_t)4 * 6144;
    const bf16_t* y = (const bf16_t*)(X.ws + WS_Y);
    LAS float* scr = (LAS float*)(X.lds + X.wave * 16384);
    for (int g4 = X.gw; g4 < T / 4; g4 += X.ngw) {
#pragma unroll
        for (int tk = 0; tk < 4; ++tk) { const int t = g4 * 4 + tk;
            Row r; row_load(r, h + (size_t)t * D, X.lane);
            const float* g2 = mod + (size_t)(t / S) * 6144 + 5120;
            Row s;
#pragma unroll
            for (int j = 0; j < 4; ++j) s.v[j] = (f32x4){0.f, 0.f, 0.f, 0.f};
#pragma unroll
            for (int k = 0; k < 4; ++k) {
                const int e = ((const int*)(X.ws + WS_TOKE))[t * 4 + k], pos = ((const int*)(X.ws + WS_TOKP))[t * 4 + k]; const float w = ((const float*)(X.ws + WS_TOKW))[t * 4 + k];
                const bf16_t* yr = y + (size_t)(tb[e] * 256 + pos) * D;
#pragma unroll
                for (int j = 0; j < 4; ++j) { const u32x2 q = ((const u32x2*)yr)[64 * j + X.lane];
                    s.v[j].x += w * bflo(q.x); s.v[j].y += w * bfhi(q.x); s.v[j].z += w * bflo(q.y); s.v[j].w += w * bfhi(q.y); }
            }
#pragma unroll
            for (int j = 0; j < 4; ++j) r.v[j] = r.v[j] + ((const f32x4*)g2)[64 * j + X.lane] * s.v[j];
            row_store(r, hn + (size_t)t * D, X.lane);
            if (MODE == 0) {
                Row o; const float* m = mod1 + (size_t)(t / S) * 6144;
                row_norm_mod(r, o, p.in[4] + D, (const f32x4*)(m + 1024), (const f32x4*)m, X.lane);
                row_store_bf16(o, (bf16_t*)(X.ws + WS_U) + (size_t)t * D, X.lane);
                row_store_lds(o, scr + tk * 1024, X.lane);
            }
        }
        if (MODE == 0) {
            LDS_WAIT();
            float acc[4]; skinny4(scr, p.in[16], SSM_IN, 5120, X.lane, acc);
            if (X.lane < 32) {
#pragma unroll
                for (int tk = 0; tk < 4; ++tk) ((float*)(X.ws + WS_DT))[(size_t)(g4 * 4 + tk) * 32 + X.lane] = acc[tk];
            }
            LDS_WAIT();
        }
    }
}

__device__ __forceinline__ void ld64bf(const bf16_t* p, float (&q)[64]) {
#pragma unroll
    for (int i = 0; i < 8; ++i) { const u32x4 w = ((const u32x4*)p)[i];
        q[8 * i] = bflo(w.x); q[8 * i + 1] = bfhi(w.x); q[8 * i + 2] = bflo(w.y); q[8 * i + 3] = bfhi(w.y); q[8 * i + 4] = bflo(w.z); q[8 * i + 5] = bfhi(w.z); q[8 * i + 6] = bflo(w.w); q[8 * i + 7] = bfhi(w.w); }
}
__device__ __forceinline__ float dot64bf(const bf16_t* p, const float (&q)[64]) {
    float d = 0.f;
#pragma unroll
    for (int i = 0; i < 8; ++i) { const u32x4 w = ((const u32x4*)p)[i];
        d += q[8 * i] * bflo(w.x) + q[8 * i + 1] * bfhi(w.x) + q[8 * i + 2] * bflo(w.y) + q[8 * i + 3] * bfhi(w.y) + q[8 * i + 4] * bflo(w.z) + q[8 * i + 5] * bfhi(w.z) + q[8 * i + 6] * bflo(w.w) + q[8 * i + 7] * bfhi(w.w); }
    return d;
}
__device__ __forceinline__ float dot64f(const float* p, const float (&q)[64]) {
    float d = 0.f;
#pragma unroll
    for (int i = 0; i < 16; ++i) { const f32x4 w = ((const f32x4*)p)[i]; d += (q[4 * i] * w.x + q[4 * i + 1] * w.y) + (q[4 * i + 2] * w.z + q[4 * i + 3] * w.w); }
    return d;
}
__device__ __forceinline__ void sb_unit(const Ctx& X, int qt, int bh) {
    const int b = bh >> 3, hh = bh & 7, t = qt * 64 + X.lane;
    const bf16_t* base = (const bf16_t*)(X.ws + WS_BIG) + (size_t)b * S * PROJ_LD;
    float q[64], acc[64];
    ld64bf(base + (size_t)t * PROJ_LD + OFF_SBQ + hh * 64, q);
#pragma unroll
    for (int d = 0; d < 64; ++d) acc[d] = 0.f;
    float run = 0.f;
    for (int j = qt * 64 + 62; j >= 0; --j) {
        const bf16_t* kr = base + (size_t)j * PROJ_LD + OFF_SBK + hh * 64;
        const float logit = dot64bf(kr, q) * 0.125f;
        if (j < t) {
            const float w = expf(logsig(logit) + run);
            run += logsig(-logit);
            const bf16_t* vr = base + (size_t)j * PROJ_LD + OFF_SBV + hh * 64;
#pragma unroll
            for (int i = 0; i < 8; ++i) { const u32x4 v = ((const u32x4*)vr)[i];
                acc[8 * i] += w * bflo(v.x); acc[8 * i + 1] += w * bfhi(v.x); acc[8 * i + 2] += w * bflo(v.y); acc[8 * i + 3] += w * bfhi(v.y);
                acc[8 * i + 4] += w * bflo(v.z); acc[8 * i + 5] += w * bfhi(v.z); acc[8 * i + 6] += w * bflo(v.w); acc[8 * i + 7] += w * bfhi(v.w); }
        }
    }
    bf16_t* op = (bf16_t*)(X.ws + WS_O) + (size_t)(b * S + t) * D + hh * 64;
#pragma unroll
    for (int i = 0; i < 8; ++i) { u32x4 w; w.x = pk2(acc[8 * i], acc[8 * i + 1]); w.y = pk2(acc[8 * i + 2], acc[8 * i + 3]); w.z = pk2(acc[8 * i + 4], acc[8 * i + 5]); w.w = pk2(acc[8 * i + 6], acc[8 * i + 7]);
        ((u32x4*)op)[i] = w; }
}

typedef float f32x16 __attribute__((ext_vector_type(16)));
__device__ __forceinline__ int pi32(int r) { return (r & 0x13) | ((r & 4) << 1) | ((r & 8) >> 1); }
__device__ __forceinline__ void sb_attn_unit(const Ctx& X, int bh, int qb) {
    const int b = bh >> 3, h = bh & 7, q0 = qb * 256, lane = fresh(X.lane), w = X.wave, ql = lane & 31, hf = lane >> 5;
    const bf16_t* proj = (const bf16_t*)(X.ws + WS_BIG) + (size_t)b * S * PROJ_LD;
    const bf16_t* vt = (const bf16_t*)(X.ws + WS_VT) + (size_t)(h * 64) * T + (size_t)b * S;
    const int tq = q0 + 32 * w + ql;
    bf16x8 qf[4];
#pragma unroll
    for (int s = 0; s < 4; ++s) qf[s] = *(const bf16x8*)(proj + (size_t)tq * PROJ_LD + OFF_SBQ + h * 64 + 16 * s + 8 * hf);
    f32x16 o0, o1;
#pragma unroll
    for (int i = 0; i < 16; ++i) { o0[i] = 0.f; o1[i] = 0.f; }
    float run = 0.f;
    const int nblk = 4 * qb + 4, jw = (q0 + 32 * w + 30) >> 6;
    const float CS = 0.125f * 1.4426950408889634f;
    const bf16_t* kg = proj + (size_t)lane * PROJ_LD + OFF_SBK + h * 64 + 8 * w;
    const bf16_t* vg = vt + (size_t)lane * T + 8 * w;
    LAS unsigned char* buf0 = X.lds;
    const int stoff = w * 1024 + lane * 16;
    u32x4 kreg = *(const u32x4*)(kg + (size_t)(64 * (nblk - 1)) * PROJ_LD), vreg = *(const u32x4*)(vg + 64 * (nblk - 1));
    *(LAS u32x4*)(buf0 + stoff) = kreg; *(LAS u32x4*)(buf0 + 8192 + stoff) = vreg;
    __syncthreads();
    const int krow = pi32(ql) * 16;
    for (int j = nblk - 1; j >= 0; --j) {
        LAS unsigned char* buf = buf0 + (((nblk - 1 - j) & 1) ? 16384 : 0);
        LAS unsigned char* nbuf = buf0 + (((nblk - 1 - j) & 1) ? 0 : 16384);
        if (j > 0) { kreg = *(const u32x4*)(kg + (size_t)(64 * (j - 1)) * PROJ_LD); vreg = *(const u32x4*)(vg + 64 * (j - 1)); }
        if (j <= jw) {
#pragma unroll
            for (int kt = 1; kt >= 0; --kt) {
                f32x16 sc;
#pragma unroll
                for (int i = 0; i < 16; ++i) sc[i] = 0.f;
#pragma unroll
                for (int s = 0; s < 4; ++s) { const bf16x8 kf = *(const LAS bf16x8*)(buf + (2 * s + hf) * 1024 + kt * 512 + krow); sc = __builtin_amdgcn_mfma_f32_32x32x16_bf16(kf, qf[s], sc, 0, 0, 0); }
                const int pos0 = 64 * j + 32 * kt + 8 * hf;
                float lk[16], lb[16];
                float a1 = 0.f, a0 = 0.f;
#pragma unroll
                for (int i = 0; i < 16; ++i) {
                    const float xx = sc[i] * CS, e = __builtin_amdgcn_exp2f(-fabsf(xx)), sp = fmaxf(xx, 0.f) + __builtin_amdgcn_logf(1.f + e);
                    const bool valid = (pos0 + 16 * (i >> 3) + (i & 7)) < tq;
                    lk[i] = valid ? -sp : 0.f; lb[i] = valid ? xx - sp : -INFINITY;
                    if (i >= 8) a1 += lk[i]; else a0 += lk[i];
                }
                const float p1 = __shfl_xor(a1, 32), p0 = __shfl_xor(a0, 32);
                const float hi1 = hf ? a1 : p1, lo1 = hf ? p1 : a1, hi0 = hf ? a0 : p0, lo0 = hf ? p0 : a0;
                float acc = hf ? run : run + hi1;
#pragma unroll
                for (int i = 15; i >= 8; --i) { const float t = lb[i] + acc; acc += lk[i]; lb[i] = __builtin_amdgcn_exp2f(t); }
                acc = hf ? run + hi1 + lo1 : run + hi1 + lo1 + hi0;
#pragma unroll
                for (int i = 7; i >= 0; --i) { const float t = lb[i] + acc; acc += lk[i]; lb[i] = __builtin_amdgcn_exp2f(t); }
                run += (hi1 + lo1) + (hi0 + lo0);
#pragma unroll
                for (int a = 0; a < 2; ++a) {
                    u32x4 pw; pw.x = pk2(lb[8 * a], lb[8 * a + 1]); pw.y = pk2(lb[8 * a + 2], lb[8 * a + 3]); pw.z = pk2(lb[8 * a + 4], lb[8 * a + 5]); pw.w = pk2(lb[8 * a + 6], lb[8 * a + 7]);
                    const bf16x8 pf = __builtin_bit_cast(bf16x8, pw);
                    const bf16x8 v0 = *(const LAS bf16x8*)(buf + 8192 + (4 * kt + 2 * a + hf) * 1024 + ql * 16);
                    const bf16x8 v1 = *(const LAS bf16x8*)(buf + 8192 + (4 * kt + 2 * a + hf) * 1024 + 512 + ql * 16);
                    o0 = __builtin_amdgcn_mfma_f32_32x32x16_bf16(v0, pf, o0, 0, 0, 0);
                    o1 = __builtin_amdgcn_mfma_f32_32x32x16_bf16(v1, pf, o1, 0, 0, 0);
                }
            }
        }
        if (j > 0) { *(LAS u32x4*)(nbuf + stoff) = kreg; *(LAS u32x4*)(nbuf + 8192 + stoff) = vreg; }
        __syncthreads();
    }
    bf16_t* op = (bf16_t*)(X.ws + WS_O) + (size_t)(b * S + fresh(tq)) * D + h * 64 + 4 * hf;
#pragma unroll
    for (int g4 = 0; g4 < 4; ++g4) {
        u32x2 w0; w0.x = pk2(o0[4 * g4], o0[4 * g4 + 1]); w0.y = pk2(o0[4 * g4 + 2], o0[4 * g4 + 3]); *(u32x2*)(op + 8 * g4) = w0;
        u32x2 w1; w1.x = pk2(o1[4 * g4], o1[4 * g4 + 1]); w1.y = pk2(o1[4 * g4 + 2], o1[4 * g4 + 3]); *(u32x2*)(op + 32 + 8 * g4) = w1;
    }
}
__device__ __forceinline__ void ph_sb(const Ctx& X) {
    for (int pr = X.bid; pr < 256; pr += X.G)
#pragma unroll 1
        for (int u = 0; u < 2; ++u) { const int bh = pr >> 3, qa = pr & 7; sb_attn_unit(X, bh, u ? qa : 15 - qa); }
}
__device__ __forceinline__ void ph_attn_a(const Params& p, const Ctx& X) {
    const bf16_t* proj = (const bf16_t*)(X.ws + WS_BIG);
    for (int unit = X.bid; unit < 128; unit += X.G) {
        const int kv = unit >> 6, bg = (unit >> 3) & 7, ntile = unit & 7, b = bg >> 1, g = bg & 1, lane = fresh(X.lane), w = X.wave, ql = lane & 31, hf = lane >> 5;
        const int n = min(32 * ntile + ql, NCMP - 1);
        const float* pe = kv ? p.in[11] : p.in[10];
        const bf16_t* w1t = (const bf16_t*)(X.ws + WS_W1T) + (size_t)kv * 128 * 2048;
        const bf16_t* arow = proj + (size_t)(b * S + n * 16) * PROJ_LD + (kv ? OFF_VC : OFF_KC) + g * 64;
        f32x16 acc[4];
#pragma unroll
        for (int ct = 0; ct < 4; ++ct)
#pragma unroll
            for (int i = 0; i < 16; ++i) acc[ct][i] = 0.f;
        for (int ks = 0; ks < 16; ++ks) {
            const int k0 = 256 * w + 16 * ks + 8 * hf, l = k0 >> 6, d = k0 & 63;
            const u32x4 q = *(const u32x4*)(arow + (size_t)l * PROJ_LD + d);
            const f32x4 e0 = *(const f32x4*)(pe + k0), e1 = *(const f32x4*)(pe + k0 + 4);
            u32x4 o; o.x = pk2(bflo(q.x) + e0.x, bfhi(q.x) + e0.y); o.y = pk2(bflo(q.y) + e0.z, bfhi(q.y) + e0.w); o.z = pk2(bflo(q.z) + e1.x, bfhi(q.z) + e1.y); o.w = pk2(bflo(q.w) + e1.z, bfhi(q.w) + e1.w);
            const bf16x8 af = __builtin_bit_cast(bf16x8, o);
#pragma unroll
            for (int ct = 0; ct < 4; ++ct) acc[ct] = __builtin_amdgcn_mfma_f32_32x32x16_bf16(af, *(const bf16x8*)(w1t + (size_t)(32 * ct + ql) * 2048 + k0), acc[ct], 0, 0, 0);
        }
        LAS float* part = (LAS float*)X.lds;
#pragma unroll
        for (int ct = 0; ct < 4; ++ct)
#pragma unroll
            for (int i = 0; i < 16; ++i) part[w * 4096 + (8 * (i >> 2) + 4 * hf + (i & 3)) * 128 + 32 * ct + ql] = acc[ct][i];
        __syncthreads();
        LAS float* hid = part;
        {
            const int tidf = fresh(X.tid);
#pragma unroll
            for (int k = 0; k < 8; ++k) { const int e = tidf + NTHREADS * k; float v = 0.f;
#pragma unroll
                for (int ww = 0; ww < 8; ++ww) v += part[ww * 4096 + e];
                hid[e] = siluf(v); }
        }
        __syncthreads();
        {
            const int tidf = fresh(X.tid), row = tidf >> 4, c4 = (tidf & 15) * 4;
            const float* w2 = kv ? p.in[15] : p.in[13];
            f32x4 o = (f32x4){0.f, 0.f, 0.f, 0.f};
            for (int j = 0; j < 128; ++j) o = o + *(const f32x4*)(w2 + j * 64 + c4) * hid[row * 128 + j];
            const int nn = 32 * ntile + row;
            if (kv == 0) {
                float ssq = (o.x * o.x + o.y * o.y) + (o.z * o.z + o.w * o.w);
                ssq += __shfl_xor(ssq, 1); ssq += __shfl_xor(ssq, 2); ssq += __shfl_xor(ssq, 4); ssq += __shfl_xor(ssq, 8);
                const float r = rsqrtf(ssq * (1.f / 64.f) + EPS); const f32x4 gn = *(const f32x4*)(p.in[9] + c4);
                o = o * r * gn;
                if (nn >= NCMP) o = (f32x4){0.f, 0.f, 0.f, 0.f};
                u32x2 wv; wv.x = pk2(o.x, o.y); wv.y = pk2(o.z, o.w);
                *(u32x2*)((bf16_t*)(X.ws + WS_KCB) + ((size_t)bg * 256 + nn) * 64 + c4) = wv;
            } else {
                if (nn >= NCMP) o = (f32x4){0.f, 0.f, 0.f, 0.f};
                bf16_t* vt = (bf16_t*)(X.ws + WS_VCT) + ((size_t)bg * 64 + c4) * 256 + nn;
                vt[0] = (bf16_t)f2bf(o.x); vt[256] = (bf16_t)f2bf(o.y); vt[512] = (bf16_t)f2bf(o.z); vt[768] = (bf16_t)f2bf(o.w);
            }
        }
        __syncthreads();
    }
    for (int t2 = X.gw; t2 < T / 2; t2 += X.ngw) {
        const int lane = fresh(X.lane), sub = lane & 7;
#pragma unroll
        for (int k = 0; k < 2; ++k) {
            const int t = 2 * t2 + k;
            const u32x4 q = *(const u32x4*)(proj + (size_t)t * PROJ_LD + OFF_NQ + 8 * lane);
            float v[8] = {bflo(q.x), bfhi(q.x), bflo(q.y), bfhi(q.y), bflo(q.z), bfhi(q.z), bflo(q.w), bfhi(q.w)};
            float ssq = 0.f;
#pragma unroll
            for (int i = 0; i < 8; ++i) ssq += v[i] * v[i];
            ssq += __shfl_xor(ssq, 1); ssq += __shfl_xor(ssq, 2); ssq += __shfl_xor(ssq, 4);
            const float r = rsqrtf(ssq * (1.f / 64.f) + EPS) * (0.125f * 1.4426950408889634f);
            const f32x4 g0 = *(const f32x4*)(p.in[8] + 8 * sub), g1 = *(const f32x4*)(p.in[8] + 8 * sub + 4);
            u32x4 o; o.x = pk2(v[0] * r * g0.x, v[1] * r * g0.y); o.y = pk2(v[2] * r * g0.z, v[3] * r * g0.w); o.z = pk2(v[4] * r * g1.x, v[5] * r * g1.y); o.w = pk2(v[6] * r * g1.z, v[7] * r * g1.w);
            *(u32x4*)((bf16_t*)(X.ws + WS_QNB) + (size_t)t * 512 + 8 * lane) = o;
        }
        {
            const int t = 2 * t2 + (lane >> 5), l32 = lane & 31, isw = l32 >> 4, c = 8 * (l32 & 15);
            const u32x4 q = *(const u32x4*)(proj + (size_t)t * PROJ_LD + (isw ? OFF_KW : OFF_KS) + c);
            float v[8] = {bflo(q.x), bfhi(q.x), bflo(q.y), bfhi(q.y), bflo(q.z), bfhi(q.z), bflo(q.w), bfhi(q.w)};
            float ssq = 0.f;
#pragma unroll
            for (int i = 0; i < 8; ++i) ssq += v[i] * v[i];
            ssq += __shfl_xor(ssq, 1); ssq += __shfl_xor(ssq, 2); ssq += __shfl_xor(ssq, 4);
            const float r = rsqrtf(ssq * (1.f / 64.f) + EPS);
            const float* gn = p.in[9] + (isw ? 128 : 64) + 8 * sub;
            const f32x4 g0 = *(const f32x4*)gn, g1 = *(const f32x4*)(gn + 4);
            u32x4 o; o.x = pk2(v[0] * r * g0.x, v[1] * r * g0.y); o.y = pk2(v[2] * r * g0.z, v[3] * r * g0.w); o.z = pk2(v[4] * r * g1.x, v[5] * r * g1.y); o.w = pk2(v[6] * r * g1.z, v[7] * r * g1.w);
            *(u32x4*)((bf16_t*)(X.ws + (isw ? WS_KWN : WS_KSN)) + (size_t)t * 128 + c) = o;
        }
    }
}
struct NsaSt { f32x16 o0, o1; float m, l; };
template <int MODE>
__device__ __forceinline__ void nsa_flash(const Ctx& X, const bf16_t* kg, const bf16_t* vg, int jlo, int jhi, const bf16x8 (&qf)[4], int tq, float slope2,
                                          unsigned long long mymask, unsigned long long wavemask, NsaSt& st) {
    const int lane = fresh(X.lane), w = X.wave, ql = lane & 31, hf = lane >> 5;
    LAS unsigned char* buf0 = X.lds;
    const int stoff = w * 1024 + lane * 16, krow = pi32(ql) * 16;
    u32x4 kreg = *(const u32x4*)(kg + (size_t)(64 * jlo) * 128), vreg = *(const u32x4*)(vg + 64 * jlo);
    *(LAS u32x4*)(buf0 + stoff) = kreg; *(LAS u32x4*)(buf0 + 8192 + stoff) = vreg;
    __syncthreads();
    for (int j = jlo; j <= jhi; ++j) {
        LAS unsigned char* buf = buf0 + (((j - jlo) & 1) ? 16384 : 0);
        LAS unsigned char* nbuf = buf0 + (((j - jlo) & 1) ? 0 : 16384);
        if (j < jhi) { kreg = *(const u32x4*)(kg + (size_t)(64 * (j + 1)) * 128); vreg = *(const u32x4*)(vg + 64 * (j + 1)); }
        if (MODE == 1 || ((wavemask >> j) & 1ull)) {
            f32x16 s0, s1;
#pragma unroll
            for (int i = 0; i < 16; ++i) { s0[i] = 0.f; s1[i] = 0.f; }
#pragma unroll
            for (int s = 0; s < 4; ++s) {
                const bf16x8 k0 = *(const LAS bf16x8*)(buf + (2 * s + hf) * 1024 + krow), k1 = *(const LAS bf16x8*)(buf + (2 * s + hf) * 1024 + 512 + krow);
                s0 = __builtin_amdgcn_mfma_f32_32x32x16_bf16(k0, qf[s], s0, 0, 0, 0); s1 = __builtin_amdgcn_mfma_f32_32x32x16_bf16(k1, qf[s], s1, 0, 0, 0);
            }
            const bool sel = MODE == 1 || ((mymask >> j) & 1ull);
            const int d0 = tq - (64 * j + 8 * hf);
            float mb = -INFINITY;
#pragma unroll
            for (int i = 0; i < 16; ++i) {
                const int da = d0 - (16 * (i >> 3) + (i & 7)), db = da - 32;
                const bool va = sel && da >= 0 && (MODE == 0 || da < 512), vb = sel && db >= 0 && (MODE == 0 || db < 512);
                s0[i] = va ? s0[i] - slope2 * (float)da : -INFINITY; s1[i] = vb ? s1[i] - slope2 * (float)db : -INFINITY;
                mb = fmaxf(mb, fmaxf(s0[i], s1[i]));
            }
            mb = fmaxf(mb, __shfl_xor(mb, 32));
            const float mn = fmaxf(st.m, mb), ms = mn == -INFINITY ? 0.f : mn, alpha = __builtin_amdgcn_exp2f(st.m - ms);
            st.m = mn;
            float ls = 0.f;
#pragma unroll
            for (int i = 0; i < 16; ++i) { s0[i] = __builtin_amdgcn_exp2f(s0[i] - ms); s1[i] = __builtin_amdgcn_exp2f(s1[i] - ms); ls += s0[i] + s1[i]; }
            st.l = st.l * alpha + ls;
#pragma unroll
            for (int i = 0; i < 16; ++i) { st.o0[i] *= alpha; st.o1[i] *= alpha; }
#pragma unroll
            for (int kt = 0; kt < 2; ++kt)
#pragma unroll
                for (int a = 0; a < 2; ++a) {
                    u32x4 pw;
                    if (kt == 0) { pw.x = pk2(s0[8 * a], s0[8 * a + 1]); pw.y = pk2(s0[8 * a + 2], s0[8 * a + 3]); pw.z = pk2(s0[8 * a + 4], s0[8 * a + 5]); pw.w = pk2(s0[8 * a + 6], s0[8 * a + 7]); }
                    else { pw.x = pk2(s1[8 * a], s1[8 * a + 1]); pw.y = pk2(s1[8 * a + 2], s1[8 * a + 3]); pw.z = pk2(s1[8 * a + 4], s1[8 * a + 5]); pw.w = pk2(s1[8 * a + 6], s1[8 * a + 7]); }
                    const bf16x8 pf = __builtin_bit_cast(bf16x8, pw);
                    const bf16x8 v0 = *(const LAS bf16x8*)(buf + 8192 + (4 * kt + 2 * a + hf) * 1024 + ql * 16);
                    const bf16x8 v1 = *(const LAS bf16x8*)(buf + 8192 + (4 * kt + 2 * a + hf) * 1024 + 512 + ql * 16);
                    st.o0 = __builtin_amdgcn_mfma_f32_32x32x16_bf16(v0, pf, st.o0, 0, 0, 0);
                    st.o1 = __builtin_amdgcn_mfma_f32_32x32x16_bf16(v1, pf, st.o1, 0, 0, 0);
                }
        }
        if (j < jhi) { *(LAS u32x4*)(nbuf + stoff) = kreg; *(LAS u32x4*)(nbuf + 8192 + stoff) = vreg; }
        __syncthreads();
    }
}
__device__ __forceinline__ void nsa_unit(const Ctx& X, int bg, int qb) {
    const int b = bg >> 1, g = bg & 1, lane = fresh(X.lane), w = X.wave, ql = lane & 31, hf = lane >> 5, r = ql >> 3, hh = g * 4 + r;
    const int t0 = 64 * qb, tq = t0 + 8 * w + (ql & 7);
    const float slope2 = exp2f(-(float)(hh + 1)) * 1.4426950408889634f;
    const bf16_t* proj = (const bf16_t*)(X.ws + WS_BIG);
    bf16x8 qf[4];
    { const bf16_t* qp = (const bf16_t*)(X.ws + WS_QNB) + (size_t)(b * S + tq) * 512 + hh * 64 + 8 * hf;
#pragma unroll
      for (int s = 0; s < 4; ++s) qf[s] = *(const bf16x8*)(qp + 16 * s); }
    float gate[3];
    { const bf16_t* gp = proj + (size_t)(b * S + tq) * PROJ_LD + OFF_GATE + hh * 3;
#pragma unroll
      for (int i = 0; i < 3; ++i) gate[i] = 1.f / (1.f + __expf(-bf2f(gp[i]))); }
    f32x16 of0, of1;
#pragma unroll
    for (int i = 0; i < 16; ++i) { of0[i] = 0.f; of1[i] = 0.f; }
    NsaSt st;
    LAS float* pacc = (LAS float*)(X.lds + 65536) + w * 2048;
    {
        const int ncm = t0 + 63 >= 31 ? (t0 + 63 - 31) / 16 + 1 : 0, nt = (ncm + 31) >> 5, ncv = tq >= 31 ? (tq - 31) / 16 + 1 : 0;
        {
            const bf16_t* kc = (const bf16_t*)(X.ws + WS_KCB) + (size_t)bg * 256 * 64; const bf16_t* vc = (const bf16_t*)(X.ws + WS_VCT) + (size_t)bg * 64 * 256;
            const int tidf = fresh(X.tid);
#pragma unroll
            for (int i = 0; i < 4; ++i) { const int pidx = tidf + NTHREADS * i;
                *(LAS u32x4*)(X.lds + (pidx >> 8) * 4096 + (pidx & 255) * 16) = *(const u32x4*)(kc + (size_t)(pidx & 255) * 64 + 8 * (pidx >> 8));
                *(LAS u32x4*)(X.lds + 32768 + (pidx >> 6) * 1024 + (pidx & 63) * 16) = *(const u32x4*)(vc + (size_t)(pidx & 63) * 256 + 8 * (pidx >> 6)); }
#pragma unroll
            for (int i = 0; i < 8; ++i) *(LAS f32x4*)(pacc + (i * 64 + lane) * 4) = (f32x4){0.f, 0.f, 0.f, 0.f};
        }
        __syncthreads();
        const int krow = pi32(ql) * 16;
        float ml = -INFINITY, ll = 0.f;
        for (int kt = 0; kt < nt; ++kt) {
            f32x16 sc;
#pragma unroll
            for (int i = 0; i < 16; ++i) sc[i] = 0.f;
#pragma unroll
            for (int s = 0; s < 4; ++s) { const bf16x8 kf = *(const LAS bf16x8*)(X.lds + (2 * s + hf) * 4096 + kt * 512 + krow); sc = __builtin_amdgcn_mfma_f32_32x32x16_bf16(kf, qf[s], sc, 0, 0, 0); }
            float tm = -INFINITY;
#pragma unroll
            for (int i = 0; i < 16; ++i) { const int n = 32 * kt + 16 * (i >> 3) + 8 * hf + (i & 7);
                sc[i] = n < ncv ? sc[i] - slope2 * (float)(tq - (16 * n + 31)) : -INFINITY; tm = fmaxf(tm, sc[i]); }
            const float mn = fmaxf(ml, tm), ms = mn == -INFINITY ? 0.f : mn;
            float ls = 0.f;
#pragma unroll
            for (int i = 0; i < 16; ++i) ls += __builtin_amdgcn_exp2f(sc[i] - ms);
            ll = ll * __builtin_amdgcn_exp2f(ml - ms) + ls; ml = mn;
        }
        float ms, inv;
        { const float mo = __shfl_xor(ml, 32), lo = __shfl_xor(ll, 32), mt = fmaxf(ml, mo); ms = mt == -INFINITY ? 0.f : mt;
          const float lt = ll * __builtin_amdgcn_exp2f(ml - ms) + lo * __builtin_amdgcn_exp2f(mo - ms); inv = lt > 0.f ? 1.f / lt : 0.f; }
#pragma unroll
        for (int i = 0; i < 16; ++i) { st.o0[i] = 0.f; st.o1[i] = 0.f; }
        float carry = 0.f;
        for (int kt = 0; kt < nt; ++kt) {
            f32x16 sc;
#pragma unroll
            for (int i = 0; i < 16; ++i) sc[i] = 0.f;
#pragma unroll
            for (int s = 0; s < 4; ++s) { const bf16x8 kf = *(const LAS bf16x8*)(X.lds + (2 * s + hf) * 4096 + kt * 512 + krow); sc = __builtin_amdgcn_mfma_f32_32x32x16_bf16(kf, qf[s], sc, 0, 0, 0); }
#pragma unroll
            for (int i = 0; i < 16; ++i) { const int n = 32 * kt + 16 * (i >> 3) + 8 * hf + (i & 7);
                sc[i] = n < ncv ? __builtin_amdgcn_exp2f(sc[i] - slope2 * (float)(tq - (16 * n + 31)) - ms) * inv : 0.f; }
            const float pa0 = __shfl_xor(sc[7], 32), pa1 = __shfl_xor(sc[15], 32);
            const float prev0 = hf ? pa0 : carry, prev1 = hf ? pa1 : pa0;
            carry = pa1;
            {
                typedef float f32x2 __attribute__((ext_vector_type(2)));
                f32x2 e0, e1;
                e0.x = prev0 + ((sc[0] + sc[1]) + (sc[2] + sc[3])); e0.y = sc[3] + ((sc[4] + sc[5]) + (sc[6] + sc[7]));
                e1.x = prev1 + ((sc[8] + sc[9]) + (sc[10] + sc[11])); e1.y = sc[11] + ((sc[12] + sc[13]) + (sc[14] + sc[15]));
                *(LAS f32x2*)(pacc + ql * 64 + 8 * kt + 2 * hf) = e0; *(LAS f32x2*)(pacc + ql * 64 + 8 * kt + 4 + 2 * hf) = e1;
            }
#pragma unroll
            for (int a = 0; a < 2; ++a) {
                u32x4 pw; pw.x = pk2(sc[8 * a], sc[8 * a + 1]); pw.y = pk2(sc[8 * a + 2], sc[8 * a + 3]); pw.z = pk2(sc[8 * a + 4], sc[8 * a + 5]); pw.w = pk2(sc[8 * a + 6], sc[8 * a + 7]);
                const bf16x8 pf = __builtin_bit_cast(bf16x8, pw);
                const bf16x8 v0 = *(const LAS bf16x8*)(X.lds + 32768 + (4 * kt + 2 * a + hf) * 1024 + ql * 16);
                const bf16x8 v1 = *(const LAS bf16x8*)(X.lds + 32768 + (4 * kt + 2 * a + hf) * 1024 + 512 + ql * 16);
                st.o0 = __builtin_amdgcn_mfma_f32_32x32x16_bf16(v0, pf, st.o0, 0, 0, 0);
                st.o1 = __builtin_amdgcn_mfma_f32_32x32x16_bf16(v1, pf, st.o1, 0, 0, 0);
            }
        }
#pragma unroll
        for (int i = 0; i < 16; ++i) { of0[i] = gate[0] * st.o0[i]; of1[i] = gate[0] * st.o1[i]; }
    }
    unsigned long long mymask = 0ull, wavemask = 0ull;
    LDS_WAIT();
    for (int q8 = 0; q8 < 8; ++q8) {
        const int t = t0 + 8 * w + q8;
        const float ps = (pacc[(0 * 8 + q8) * 64 + lane] + pacc[(1 * 8 + q8) * 64 + lane]) + (pacc[(2 * 8 + q8) * 64 + lane] + pacc[(3 * 8 + q8) * 64 + lane]);
        const bool valid = lane * 64 <= t, forced = (lane == 0) || (lane == qb) || (lane == qb - 1);
        const float score = valid ? (forced ? 1e6f : ps) : -1e6f;
        int rank = 0;
#pragma unroll 4
        for (int i = 0; i < 64; ++i) { const float si = __builtin_amdgcn_readlane(score, i); rank += (si > score || (si == score && i < lane)) ? 1 : 0; }
        const unsigned long long mk = __ballot(rank < 16);
        wavemask |= mk; if ((ql & 7) == q8) mymask = mk;
    }
    __syncthreads();
    {
#pragma unroll
        for (int i = 0; i < 16; ++i) { st.o0[i] = 0.f; st.o1[i] = 0.f; }
        st.m = -INFINITY; st.l = 0.f;
        const int lf = fresh(lane);
        const bf16_t* kg = (const bf16_t*)(X.ws + WS_KSN) + ((size_t)b * S + lf) * 128 + g * 64 + 8 * w;
        const bf16_t* vg = (const bf16_t*)(X.ws + WS_VT) + (size_t)(512 + g * 64 + lf) * T + (size_t)b * S + 8 * w;
        nsa_flash<0>(X, kg, vg, 0, qb, qf, tq, slope2, mymask, wavemask, st);
        const float lt = st.l + __shfl_xor(st.l, 32), sc = gate[1] / fmaxf(lt, 1e-30f);
#pragma unroll
        for (int i = 0; i < 16; ++i) { of0[i] += sc * st.o0[i]; of1[i] += sc * st.o1[i]; }
    }
    {
#pragma unroll
        for (int i = 0; i < 16; ++i) { st.o0[i] = 0.f; st.o1[i] = 0.f; }
        st.m = -INFINITY; st.l = 0.f;
        const int lf = fresh(lane);
        const bf16_t* kg = (const bf16_t*)(X.ws + WS_KWN) + ((size_t)b * S + lf) * 128 + g * 64 + 8 * w;
        const bf16_t* vg = (const bf16_t*)(X.ws + WS_VT) + (size_t)(640 + g * 64 + lf) * T + (size_t)b * S + 8 * w;
        nsa_flash<1>(X, kg, vg, qb >= 8 ? qb - 8 : 0, qb, qf, tq, slope2, 0ull, 0ull, st);
        const float lt = st.l + __shfl_xor(st.l, 32), sc = gate[2] / fmaxf(lt, 1e-30f);
#pragma unroll
        for (int i = 0; i < 16; ++i) { of0[i] += sc * st.o0[i]; of1[i] += sc * st.o1[i]; }
    }
    bf16_t* op = (bf16_t*)(X.ws + WS_O) + (size_t)(b * S + fresh(tq)) * D + 512 + hh * 64 + 4 * hf;
#pragma unroll
    for (int g4 = 0; g4 < 4; ++g4) {
        u32x2 w0; w0.x = pk2(of0[4 * g4], of0[4 * g4 + 1]); w0.y = pk2(of0[4 * g4 + 2], of0[4 * g4 + 3]); *(u32x2*)(op + 8 * g4) = w0;
        u32x2 w1; w1.x = pk2(of1[4 * g4], of1[4 * g4 + 1]); w1.y = pk2(of1[4 * g4 + 2], of1[4 * g4 + 3]); *(u32x2*)(op + 32 + 8 * g4) = w1;
    }
}
__device__ __forceinline__ void ph_nsa(const Params& p, const Ctx& X) {
    for (int pr = X.bid; pr < 256; pr += X.G)
#pragma unroll 1
        for (int u = 0; u < 2; ++u) { const int bg = pr >> 5, qa = pr & 31; nsa_unit(X, bg, u ? qa : 63 - qa); }
}

__device__ __forceinline__ float silu_fast(float v) { return v * __builtin_amdgcn_rcpf(1.f + __expf(-v)); }
__device__ __forceinline__ void ph_ssd1(const Params& p, const Ctx& X) {
    const float* cw = p.in[17]; const float* cb = p.in[18];
    LAS float* wl = (LAS float*)X.lds;
    for (int unit = X.bid; unit < 256; unit += X.G) {
        const int b = unit >> 6, c = (unit >> 2) & 15, g = unit & 3, tl0 = c * 256, lane = fresh(X.lane), w = X.wave, ql = lane & 31, hf = lane >> 5;
        const size_t t0 = (size_t)b * S + tl0;
        {
            const int h = g * 8 + w;
            const float a = -expf(p.in[20][h]), dtb = p.in[19][h];
            const float* dr = (const float*)(X.ws + WS_DT) + (t0 + 4 * lane) * 32 + h;
            float dt[4], cs[4];
#pragma unroll
            for (int k = 0; k < 4; ++k) { const float raw = dr[k * 32] + dtb; dt[k] = raw > 20.f ? raw : log1pf(expf(raw)); }
            cs[0] = dt[0] * a; cs[1] = cs[0] + dt[1] * a; cs[2] = cs[1] + dt[2] * a; cs[3] = cs[2] + dt[3] * a;
            float incl = cs[3];
#pragma unroll
            for (int o = 1; o < 64; o <<= 1) { const float u = __shfl_up(incl, o); if (lane >= o) incl += u; }
            const float excl = incl - cs[3], last = __shfl(incl, 63);
#pragma unroll
            for (int k = 0; k < 4; ++k) cs[k] += excl;
            *(f32x4*)((float*)(X.ws + WS_DT2) + (size_t)(b * 32 + h) * S + tl0 + 4 * lane) = (f32x4){dt[0], dt[1], dt[2], dt[3]};
            *(f32x4*)((float*)(X.ws + WS_CS) + (size_t)(b * 32 + h) * S + tl0 + 4 * lane) = (f32x4){cs[0], cs[1], cs[2], cs[3]};
            *(LAS f32x4*)(wl + w * 256 + 4 * lane) = (f32x4){dt[0] * __expf(last - cs[0]), dt[1] * __expf(last - cs[1]), dt[2] * __expf(last - cs[2]), dt[3] * __expf(last - cs[3])};
            if (lane == 63) ((float*)(X.ws + WS_DEC))[(b * 16 + c) * 32 + h] = __expf(last);
        }
        {
            const bf16_t* xt = (const bf16_t*)(X.ws + WS_XT); bf16_t* xct = (bf16_t*)(X.ws + WS_XCT);
            const int tidf = fresh(X.tid);
            for (int k = 0; k < 40; ++k) {
                const int it = tidf + NTHREADS * k, chl = it >> 5, seg = it & 31;
                const int chg = chl < 512 ? g * 512 + chl : 2048 + g * 128 + (chl - 512);
                const int rin = chl < 512 ? 1024 + g * 512 + chl : g * 128 + (chl - 512);
                const bf16_t* src = xt + (size_t)rin * T + t0 + 8 * seg;
                const u32x4 cur = *(const u32x4*)src;
                u32x4 prv = (u32x4){0u, 0u, 0u, 0u};
                if (tl0 + 8 * seg >= 8) prv = *(const u32x4*)(src - 8);
                const float x[11] = {bfhi(prv.z), bflo(prv.w), bfhi(prv.w), bflo(cur.x), bfhi(cur.x), bflo(cur.y), bfhi(cur.y), bflo(cur.z), bfhi(cur.z), bflo(cur.w), bfhi(cur.w)};
                const float w0 = cw[chg], w1 = cw[CONV_DIM + chg], w2 = cw[2 * CONV_DIM + chg], w3 = cw[3 * CONV_DIM + chg], bb = cb[chg];
                float o[8];
#pragma unroll
                for (int j = 0; j < 8; ++j) o[j] = silu_fast(bb + w0 * x[j] + w1 * x[j + 1] + w2 * x[j + 2] + w3 * x[j + 3]);
                u32x4 ov; ov.x = pk2(o[0], o[1]); ov.y = pk2(o[2], o[3]); ov.z = pk2(o[4], o[5]); ov.w = pk2(o[6], o[7]);
                *(u32x4*)(xct + (size_t)chg * T + t0 + 8 * seg) = ov;
            }
            const bf16_t* zbc = (const bf16_t*)(X.ws + WS_ZBC); bf16_t* bcm = (bf16_t*)(X.ws + WS_BCM);
            for (int k = 0; k < 16; ++k) {
                const int it = tidf + NTHREADS * k, l = it >> 5, c8 = it & 31;
                const int col = (c8 < 16 ? g * 128 + 8 * c8 : 512 + g * 128 + 8 * (c8 - 16));
                float acc[8];
                { const f32x4 b0 = *(const f32x4*)(cb + 2048 + col), b1 = *(const f32x4*)(cb + 2048 + col + 4); acc[0] = b0.x; acc[1] = b0.y; acc[2] = b0.z; acc[3] = b0.w; acc[4] = b1.x; acc[5] = b1.y; acc[6] = b1.z; acc[7] = b1.w; }
#pragma unroll
                for (int ww = 0; ww < 4; ++ww) {
                    if (tl0 + l - 3 + ww < 0) continue;
                    const u32x4 q = *(const u32x4*)(zbc + (t0 + l - 3 + ww) * 3072 + 2048 + col);
                    const f32x4 k0 = *(const f32x4*)(cw + ww * CONV_DIM + 2048 + col), k1 = *(const f32x4*)(cw + ww * CONV_DIM + 2048 + col + 4);
                    acc[0] += bflo(q.x) * k0.x; acc[1] += bfhi(q.x) * k0.y; acc[2] += bflo(q.y) * k0.z; acc[3] += bfhi(q.y) * k0.w;
                    acc[4] += bflo(q.z) * k1.x; acc[5] += bfhi(q.z) * k1.y; acc[6] += bflo(q.w) * k1.z; acc[7] += bfhi(q.w) * k1.w;
                }
                u32x4 ov; ov.x = pk2(silu_fast(acc[0]), silu_fast(acc[1])); ov.y = pk2(silu_fast(acc[2]), silu_fast(acc[3])); ov.z = pk2(silu_fast(acc[4]), silu_fast(acc[5])); ov.w = pk2(silu_fast(acc[6]), silu_fast(acc[7]));
                *(u32x4*)(bcm + (t0 + l) * 1024 + col) = ov;
            }
        }
        __syncthreads();
        {
            const int h = g * 8 + w, lf = fresh(lane);
            const bf16_t* xa = (const bf16_t*)(X.ws + WS_XCT) + (size_t)(h * 64 + (lf & 31)) * T + t0 + 8 * (lf >> 5);
            const bf16_t* xb = (const bf16_t*)(X.ws + WS_XCT) + (size_t)(2048 + g * 128 + (lf & 31)) * T + t0 + 8 * (lf >> 5);
            f32x16 acc[2][4];
#pragma unroll
            for (int pt = 0; pt < 2; ++pt)
#pragma unroll
                for (int nt = 0; nt < 4; ++nt)
#pragma unroll
                    for (int i = 0; i < 16; ++i) acc[pt][nt][i] = 0.f;
            for (int ks = 0; ks < 16; ++ks) {
                const f32x4 wa = *(const LAS f32x4*)(wl + w * 256 + 16 * ks + 8 * hf), wb = *(const LAS f32x4*)(wl + w * 256 + 16 * ks + 8 * hf + 4);
                bf16x8 af[2];
#pragma unroll
                for (int pt = 0; pt < 2; ++pt) { const u32x4 q = *(const u32x4*)(xa + (size_t)(32 * pt) * T + 16 * ks);
                    u32x4 o; o.x = pk2(bflo(q.x) * wa.x, bfhi(q.x) * wa.y); o.y = pk2(bflo(q.y) * wa.z, bfhi(q.y) * wa.w); o.z = pk2(bflo(q.z) * wb.x, bfhi(q.z) * wb.y); o.w = pk2(bflo(q.w) * wb.z, bfhi(q.w) * wb.w);
                    af[pt] = __builtin_bit_cast(bf16x8, o); }
#pragma unroll
                for (int nt = 0; nt < 4; ++nt) { const bf16x8 bfr = *(const bf16x8*)(xb + (size_t)(32 * nt) * T + 16 * ks);
                    acc[0][nt] = __builtin_amdgcn_mfma_f32_32x32x16_bf16(af[0], bfr, acc[0][nt], 0, 0, 0); acc[1][nt] = __builtin_amdgcn_mfma_f32_32x32x16_bf16(af[1], bfr, acc[1][nt], 0, 0, 0); }
            }
            float* st = (float*)(X.ws + WS_ST) + ((size_t)(b * 16 + c) * 32 + h) * 8192 + ql;
#pragma unroll
            for (int pt = 0; pt < 2; ++pt)
#pragma unroll
                for (int nt = 0; nt < 4; ++nt)
#pragma unroll
                    for (int i = 0; i < 16; ++i) st[(32 * pt + 8 * (i >> 2) + 4 * hf + (i & 3)) * 128 + 32 * nt] = acc[pt][nt][i];
        }
        __syncthreads();
    }
}
__device__ __forceinline__ void ph_ssd2(const Ctx& X) {
    const float* st = (const float*)(X.ws + WS_ST); const float* dec = (const float*)(X.ws + WS_DEC); bf16_t* pb = (bf16_t*)(X.ws + WS_PB);
    for (int e = X.bid * NTHREADS + X.tid; e < NB * 32 * 2048; e += X.G * NTHREADS) {
        const int b = e >> 16, h = (e >> 11) & 31, q4 = (e & 2047) * 4;
        f32x4 hs = (f32x4){0.f, 0.f, 0.f, 0.f};
        for (int c = 0; c < 16; ++c) {
            const size_t o = ((size_t)(b * 16 + c) * 32 + h) * 8192 + q4;
            u32x2 wv; wv.x = pk2(hs.x, hs.y); wv.y = pk2(hs.z, hs.w); *(u32x2*)(pb + o) = wv;
            hs = hs * dec[(b * 16 + c) * 32 + h] + *(const f32x4*)(st + o);
        }
    }
}
__device__ __forceinline__ void ph_ssd3(const Params& p, const Ctx& X) {
    LAS float* dtl = (LAS float*)X.lds; LAS float* csl = dtl + 2048;
    for (int unit = X.bid; unit < 256; unit += X.G) {
        const int b = unit >> 6, c = (unit >> 2) & 15, g = unit & 3, tl0 = c * 256, lane = fresh(X.lane), w = X.wave, ql = lane & 31, hf = lane >> 5, lq = 32 * w + ql;
        const size_t t0 = (size_t)b * S + tl0;
        { const int tidf = fresh(X.tid), h8 = tidf >> 6, l4 = (tidf & 63) * 4;
          *(LAS f32x4*)(dtl + h8 * 256 + l4) = *(const f32x4*)((const float*)(X.ws + WS_DT2) + (size_t)(b * 32 + g * 8 + h8) * S + tl0 + l4);
          *(LAS f32x4*)(csl + h8 * 256 + l4) = *(const f32x4*)((const float*)(X.ws + WS_CS) + (size_t)(b * 32 + g * 8 + h8) * S + tl0 + l4); }
        __syncthreads();
        const bf16_t* bcm = (const bf16_t*)(X.ws + WS_BCM);
        bf16x8 cf[8];
#pragma unroll
        for (int ks = 0; ks < 8; ++ks) cf[ks] = *(const bf16x8*)(bcm + (t0 + lq) * 1024 + 512 + g * 128 + 16 * ks + 8 * hf);
        float ss = 0.f;
#pragma unroll 1
        for (int pass = 0; pass < 4; ++pass) {
            f32x16 acc[2][2];
#pragma unroll
            for (int hh = 0; hh < 2; ++hh) {
                const int h8 = pass * 2 + hh;
                const bf16_t* pbp = (const bf16_t*)(X.ws + WS_PB) + ((size_t)(b * 16 + c) * 32 + g * 8 + h8) * 8192 + (size_t)ql * 128 + 8 * hf;
#pragma unroll
                for (int pt = 0; pt < 2; ++pt) {
#pragma unroll
                    for (int i = 0; i < 16; ++i) acc[hh][pt][i] = 0.f;
#pragma unroll
                    for (int ks = 0; ks < 8; ++ks) acc[hh][pt] = __builtin_amdgcn_mfma_f32_32x32x16_bf16(*(const bf16x8*)(pbp + pt * 4096 + 16 * ks), cf[ks], acc[hh][pt], 0, 0, 0);
                }
                const float e = __expf(csl[h8 * 256 + lq]);
#pragma unroll
                for (int i = 0; i < 16; ++i) { acc[hh][0][i] *= e; acc[hh][1][i] *= e; }
            }
            for (int st = 0; st <= w; ++st) {
                f32x16 G;
#pragma unroll
                for (int i = 0; i < 16; ++i) G[i] = 0.f;
                { const int lf2 = fresh(lane); const bf16_t* bp = bcm + (t0 + 32 * st + pi32(lf2 & 31)) * 1024 + g * 128 + 8 * (lf2 >> 5);
#pragma unroll
                  for (int ks = 0; ks < 8; ++ks) G = __builtin_amdgcn_mfma_f32_32x32x16_bf16(*(const bf16x8*)(bp + 16 * ks), cf[ks], G, 0, 0, 0); }
                const int s0 = 32 * st + 8 * hf;
#pragma unroll
                for (int hh = 0; hh < 2; ++hh) {
                    const int h8 = pass * 2 + hh, h = g * 8 + h8;
                    const float cl = csl[h8 * 256 + lq], dsk = p.in[21][h];
                    float m[16];
#pragma unroll
                    for (int a2 = 0; a2 < 2; ++a2) {
                        const f32x4 d0 = *(const LAS f32x4*)(dtl + h8 * 256 + s0 + 16 * a2), d1 = *(const LAS f32x4*)(dtl + h8 * 256 + s0 + 16 * a2 + 4);
                        const f32x4 c0 = *(const LAS f32x4*)(csl + h8 * 256 + s0 + 16 * a2), c1 = *(const LAS f32x4*)(csl + h8 * 256 + s0 + 16 * a2 + 4);
                        const float dd[8] = {d0.x, d0.y, d0.z, d0.w, d1.x, d1.y, d1.z, d1.w}, cc[8] = {c0.x, c0.y, c0.z, c0.w, c1.x, c1.y, c1.z, c1.w};
#pragma unroll
                        for (int j = 0; j < 8; ++j) { const int sidx = s0 + 16 * a2 + j;
                            float v = G[8 * a2 + j] * dd[j] * __expf(fminf(cl - cc[j], 0.f));
                            if (st == w) { v = sidx > lq ? 0.f : v; v += sidx == lq ? dsk : 0.f; }
                            m[8 * a2 + j] = v; }
                    }
                    const bf16_t* xp = (const bf16_t*)(X.ws + WS_XCT) + (size_t)(h * 64 + ql) * T + t0 + 32 * st + 8 * hf;
#pragma unroll
                    for (int a2 = 0; a2 < 2; ++a2) {
                        u32x4 pw; pw.x = pk2(m[8 * a2], m[8 * a2 + 1]); pw.y = pk2(m[8 * a2 + 2], m[8 * a2 + 3]); pw.z = pk2(m[8 * a2 + 4], m[8 * a2 + 5]); pw.w = pk2(m[8 * a2 + 6], m[8 * a2 + 7]);
                        const bf16x8 pf = __builtin_bit_cast(bf16x8, pw);
                        acc[hh][0] = __builtin_amdgcn_mfma_f32_32x32x16_bf16(*(const bf16x8*)(xp + 16 * a2), pf, acc[hh][0], 0, 0, 0);
                        acc[hh][1] = __builtin_amdgcn_mfma_f32_32x32x16_bf16(*(const bf16x8*)(xp + (size_t)32 * T + 16 * a2), pf, acc[hh][1], 0, 0, 0);
                    }
                }
            }
            const int lqf = fresh(lane);
            bf16_t* yrow = (bf16_t*)(X.ws + WS_O) + (t0 + 32 * w + (lqf & 31)) * SSM_INNER + g * 512 + 4 * (lqf >> 5);
            const bf16_t* zrow = (const bf16_t*)(X.ws + WS_ZBC) + (t0 + 32 * w + (lqf & 31)) * 3072 + g * 512 + 4 * (lqf >> 5);
#pragma unroll
            for (int hh = 0; hh < 2; ++hh)
#pragma unroll
                for (int pt = 0; pt < 2; ++pt)
#pragma unroll
                    for (int g4 = 0; g4 < 4; ++g4) {
                        const int co = (pass * 2 + hh) * 64 + 32 * pt + 8 * g4;
                        const u32x2 zq = *(const u32x2*)(zrow + co);
                        const float v0 = acc[hh][pt][4 * g4] * silu_fast(bflo(zq.x)), v1 = acc[hh][pt][4 * g4 + 1] * silu_fast(bfhi(zq.x)), v2 = acc[hh][pt][4 * g4 + 2] * silu_fast(bflo(zq.y)), v3 = acc[hh][pt][4 * g4 + 3] * silu_fast(bfhi(zq.y));
                        ss += (v0 * v0 + v1 * v1) + (v2 * v2 + v3 * v3);
                        u32x2 o; o.x = pk2(v0, v1); o.y = pk2(v2, v3); *(u32x2*)(yrow + co) = o;
                    }
        }
        ss += __shfl_xor(ss, 32);
        const float rs = rsqrtf(ss * (1.f / 512.f) + EPS);
        asm volatile("s_waitcnt vmcnt(0)" ::: "memory");
        const int lqf = fresh(lane);
        bf16_t* yrow = (bf16_t*)(X.ws + WS_O) + (t0 + 32 * w + (lqf & 31)) * SSM_INNER + g * 512 + 4 * (lqf >> 5);
        const float* ng = p.in[22] + g * 512 + 4 * (lqf >> 5);
#pragma unroll 4
        for (int k = 0; k < 64; ++k) {
            const int co = 8 * k;
            const u32x2 q = *(const u32x2*)(yrow + co); const f32x4 gn = *(const f32x4*)(ng + co);
            u32x2 o; o.x = pk2(bflo(q.x) * rs * gn.x, bfhi(q.x) * rs * gn.y); o.y = pk2(bflo(q.y) * rs * gn.z, bfhi(q.y) * rs * gn.w); *(u32x2*)(yrow + co) = o;
        }
        __syncthreads();
    }
}

__device__ __forceinline__ void ph_moe_gu(const Params& p, const Ctx& X, int l) {
    moe_table(X, l);
    pg8::MoeOrder So{(const LAS int*)(X.lds + TAB_OFF), (const LAS int*)(X.lds + TAB_OFF) + 40, (const int*)(X.ws + WS_SLOT), 3, X.G, X.bid, true};
    pg8::Gemm g{(const bf16_t*)(X.ws + WS_U), (const bf16_t*)(X.ws + WS_WGU) + (size_t)l * NE * 2048 * 1024, 1024};
    pg8::EpiGu E{(bf16_t*)(X.ws + WS_ACT), p.in[27] + (size_t)l * NE * 2048};
    pg8::gemm_phase<pg8::EpiGu, pg8::MoeOrder>(X.lds, g, So, E, X.tid);
}
__device__ __forceinline__ void ph_moe_down(const Params& p, const Ctx& X, int l) {
    moe_table(X, l);
    pg8::MoeOrder So{(const LAS int*)(X.lds + TAB_OFF), (const LAS int*)(X.lds + TAB_OFF) + 40, (const int*)(X.ws + WS_SLOT), 2, X.G, X.bid, false};
    pg8::Gemm g{(const bf16_t*)(X.ws + WS_ACT), (const bf16_t*)(X.ws + WS_WDN) + (size_t)l * NE * 1024 * 1024, 1024};
    pg8::EpiDown E{(bf16_t*)(X.ws + WS_Y), p.in[29] + (size_t)l * NE * 1024};
    pg8::gemm_phase<pg8::EpiDown, pg8::MoeOrder>(X.lds, g, So, E, X.tid);
}

__global__ void __launch_bounds__(NTHREADS, 2) fwd_kernel(Params p) {
    extern __shared__ __attribute__((aligned(16))) unsigned char lds_raw[];
    Ctx X;
    X.lds = (LAS unsigned char*)lds_raw; X.ws = p.ws;
    X.tid = threadIdx.x; X.lane = X.tid & 63; X.wave = __builtin_amdgcn_readfirstlane(X.tid >> 6);
    X.G = gridDim.x; X.bid = blockIdx.x; X.gw = X.bid * NWAVES + X.wave; X.ngw = X.G * NWAVES;
    if (X.tid < 4) ((LAS unsigned*)(X.lds + XB_OFF))[X.tid] = 0u;
    __syncthreads();
    XcdBarrier bar = xcd_barrier_post((unsigned*)(p.ws + WS_CTL) + CW_BAR, (volatile LAS unsigned*)(X.lds + XB_OFF));
#define PHASE_BEGIN Ctx Y = X; { GAS unsigned char* w_ = (GAS unsigned char*)p.ws; asm volatile("" : "+s"(w_)); Y.ws = (unsigned char*)w_; int t_ = threadIdx.x; asm volatile("" : "+v"(t_)); Y.tid = t_; Y.lane = t_ & 63; \
    Y.wave = __builtin_amdgcn_readfirstlane(t_ >> 6); Y.gw = Y.bid * NWAVES + Y.wave; }
#define WSF(off) ((float*)(Y.ws + (off)))
#define WSB(off) ((bf16_t*)(Y.ws + (off)))
    { PHASE_BEGIN ph_prologue(p, Y); }                                    xcd_barrier(bar);
    { PHASE_BEGIN ph_norm0(p, Y); }                                       xcd_barrier(bar);
    {
        PHASE_BEGIN
        pg8::DenseOrder So; So.init(T, PROJ_LD, X.G, X.bid);
        pg8::Gemm g{WSB(WS_U), WSB(WS_WIN), 1024};
        pg8::EpiBf16 E{WSB(WS_BIG), PROJ_LD};
        pg8::gemm_phase<pg8::EpiBf16, pg8::DenseOrder>(X.lds, g, So, E, Y.tid);
    }
    {
        PHASE_BEGIN
        pg8::DenseOrder So; So.init(768, T, X.G, X.bid);
        pg8::Gemm g{WSB(WS_WV), WSB(WS_U), 1024};
        pg8::EpiBf16 E{WSB(WS_VT), T};
        pg8::gemm_phase<pg8::EpiBf16, pg8::DenseOrder>(X.lds, g, So, E, Y.tid);
    }
    xcd_barrier(bar);
    { PHASE_BEGIN ph_attn_a(p, Y); }                                      xcd_barrier(bar);
    { PHASE_BEGIN ph_nsa(p, Y); }
    __syncthreads();
    { PHASE_BEGIN ph_sb(Y); }                                             xcd_barrier(bar);
    {
        PHASE_BEGIN
        pg8::DenseOrder So; So.init(T, D, X.G, X.bid);
        pg8::Gemm g{WSB(WS_O), WSB(WS_WOUT), 1024};
        pg8::EpiResid E{p.in[0], WSF(WS_H1), WSF(WS_MODF) + 2048};
        pg8::gemm_phase<pg8::EpiResid, pg8::DenseOrder>(X.lds, g, So, E, Y.tid);
    }
    xcd_barrier(bar);
    { PHASE_BEGIN ph_router(p, Y, 0, WSF(WS_H1)); }                       xcd_barrier(bar);
    { PHASE_BEGIN ph_moe_gu(p, Y, 0); }                                   xcd_barrier(bar);
    { PHASE_BEGIN ph_moe_down(p, Y, 0); }                                 xcd_barrier(bar);
    { PHASE_BEGIN ph_combine<0>(p, Y, 0, WSF(WS_H1), WSF(WS_H2)); }       xcd_barrier(bar);
    {
        PHASE_BEGIN
        pg8::DenseOrder So; So.init(T, 3072, X.G, X.bid);
        pg8::Gemm g{WSB(WS_U), WSB(WS_WSIN), 1024};
        pg8::EpiBf16 E{WSB(WS_ZBC), 3072};
        pg8::gemm_phase<pg8::EpiBf16, pg8::DenseOrder>(X.lds, g, So, E, Y.tid);
    }
    {
        PHASE_BEGIN
        pg8::DenseOrder So; So.init(3072, T, X.G, X.bid);
        pg8::Gemm g{WSB(WS_WSIN) + (size_t)2048 * 1024, WSB(WS_U), 1024};
        pg8::EpiBf16 E{WSB(WS_XT), T};
        pg8::gemm_phase<pg8::EpiBf16, pg8::DenseOrder>(X.lds, g, So, E, Y.tid);
    }
    xcd_barrier(bar);
    { PHASE_BEGIN ph_ssd1(p, Y); }                                        xcd_barrier(bar);
    { PHASE_BEGIN ph_ssd2(Y); }                                           xcd_barrier(bar);
    { PHASE_BEGIN ph_ssd3(p, Y); }                                        xcd_barrier(bar);
    {
        PHASE_BEGIN
        pg8::DenseOrder So; So.init(T, D, X.G, X.bid);
        pg8::Gemm g{WSB(WS_O), WSB(WS_WSOUT), 2048};
        pg8::EpiResid E{WSF(WS_H2), WSF(WS_H1), WSF(WS_MODF) + 4 * 6144 + 2048};
        pg8::gemm_phase<pg8::EpiResid, pg8::DenseOrder>(X.lds, g, So, E, Y.tid);
    }
    xcd_barrier(bar);
    { PHASE_BEGIN ph_router(p, Y, 1, WSF(WS_H1)); }                       xcd_barrier(bar);
    { PHASE_BEGIN ph_moe_gu(p, Y, 1); }                                   xcd_barrier(bar);
    { PHASE_BEGIN ph_moe_down(p, Y, 1); }                                 xcd_barrier(bar);
    { PHASE_BEGIN ph_combine<1>(p, Y, 1, WSF(WS_H1), p.out); }
#undef PHASE_BEGIN
#undef WSF
#undef WSB
}
}

extern "C" void kernel_launch(void* const* d_in, const int* in_sizes, int n_in, void* d_out, int out_size, void* d_ws, size_t ws_size, hipStream_t stream) {
    static int grid = 0;
    if (grid == 0) {
        if (n_in != 30 || out_size != T * D || ws_size < WS_END) { fprintf(stderr, "kernel_launch: unexpected shapes / workspace (%d inputs, out %d, ws %zu < %zu)\n", n_in, out_size, ws_size, (size_t)WS_END); grid = -1; return; }
        int dev = 0, cus = 0, per_cu = 0;
        if (hipGetDevice(&dev) != hipSuccess || hipDeviceGetAttribute(&cus, hipDeviceAttributeMultiprocessorCount, dev) != hipSuccess) { grid = -1; return; }
        if (hipFuncSetAttribute((const void*)fwd_kernel, hipFuncAttributeMaxDynamicSharedMemorySize, LDS_BYTES) != hipSuccess) { fprintf(stderr, "kernel_launch: hipFuncSetAttribute failed\n"); grid = -1; return; }
        if (hipOccupancyMaxActiveBlocksPerMultiprocessor(&per_cu, (const void*)fwd_kernel, NTHREADS, LDS_BYTES) != hipSuccess || per_cu < 1) { fprintf(stderr, "kernel_launch: occupancy query reports %d\n", per_cu); }
        (void)hipGetLastError();
        grid = cus;
    }
    if (grid < 0) return;
    if (hipMemsetAsync((char*)d_ws + WS_CTL, 0, CTL_BYTES, stream) != hipSuccess) return;
    Params p{};
    for (int i = 0; i < 30; ++i) p.in[i] = (const float*)d_in[i];
    p.out = (float*)d_out; p.ws = (unsigned char*)d_ws;
    hipLaunchKernelGGL(fwd_kernel, dim3(grid), dim3(NTHREADS), LDS_BYTES, stream, p);
}
```

```cpp
#include <hip/hip_runtime.h>
#include <cstdio>
#include <cstdint>

#define LAS __attribute__((address_space(3)))
#define GAS __attribute__((address_space(1)))
typedef unsigned short bf16_t;
typedef short bf16x8 __attribute__((ext_vector_type(8)));
typedef float f32x4 __attribute__((ext_vector_type(4)));
typedef unsigned u32x4 __attribute__((ext_vector_type(4)));
typedef unsigned u32x2 __attribute__((ext_vector_type(2)));
typedef float f32x16 __attribute__((ext_vector_type(16)));

namespace {
constexpr int D = 1024, NB = 4, S = 4096, T = NB * S;
constexpr int ATTN_IN = 2840, PROJ_LD = 3072;
constexpr int OFF_SBQ = 0, OFF_SBK = 512, OFF_SBV = 1024, OFF_NQ = 1536, OFF_KC = 2048, OFF_VC = 2176, OFF_KS = 2304, OFF_VS = 2432,
              OFF_KW = 2560, OFF_VW = 2688, OFF_GATE = 2816;
constexpr int NCMP = 255;
constexpr int SSM_IN = 5152, SSM_INNER = 2048, CONV_DIM = 3072, ZX_LD = 5120;
constexpr int NE = 32, CAP = 16384, MAXTILES = 288;
constexpr float EPS = 1e-6f;
constexpr int NWAVES = 8, NTHREADS = 512;

constexpr size_t al4k(size_t x) { return (x + 4095) & ~(size_t)4095; }
constexpr size_t WS_CTL = 0, CTL_BYTES = 1u << 20;
constexpr int CW_CNT = 256;
constexpr int CW_BAR = 4096;
constexpr size_t CTL_MOD = 65536;
constexpr size_t WS_WIN = CTL_BYTES;
constexpr size_t WS_WOUT = WS_WIN + (size_t)3072 * 1024 * 2;
constexpr size_t WS_WSIN = WS_WOUT + (size_t)1024 * 1024 * 2;
constexpr size_t WS_WSOUT = WS_WSIN + (size_t)5120 * 1024 * 2;
constexpr size_t WS_WGU = WS_WSOUT + (size_t)1024 * 2048 * 2;
constexpr size_t WS_WDN = WS_WGU + (size_t)2 * 32 * 2048 * 1024 * 2;
constexpr size_t WS_U = WS_WDN + (size_t)2 * 32 * 1024 * 1024 * 2;
constexpr size_t WS_BIG = WS_U + (size_t)T * 1024 * 2;
constexpr size_t WS_O = WS_BIG + (size_t)T * 5120 * 2;
constexpr size_t WS_H1 = WS_O + (size_t)T * 2048 * 2;
constexpr size_t WS_H2 = WS_H1 + (size_t)T * 1024 * 4;
constexpr size_t WS_QN = WS_H2 + (size_t)T * 1024 * 4;
constexpr size_t WS_KN = WS_QN + (size_t)T * 512 * 4;
constexpr size_t WS_KCMP = WS_KN + (size_t)T * 256 * 4;
constexpr size_t WS_VCMP = WS_KCMP + al4k((size_t)NB * NCMP * 2 * 64 * 4);
constexpr size_t WS_ACT = WS_VCMP + al4k((size_t)NB * NCMP * 2 * 64 * 4);
constexpr size_t WS_Y = WS_ACT + (size_t)MAXTILES * 256 * 1024 * 2;
constexpr size_t WS_TOKE = WS_Y + (size_t)MAXTILES * 256 * 1024 * 2;
constexpr size_t WS_TOKW = WS_TOKE + (size_t)T * 16;
constexpr size_t WS_TOKP = WS_TOKW + (size_t)T * 16;
constexpr size_t WS_SLOT = WS_TOKP + (size_t)T * 16;
constexpr size_t WS_XC = WS_SLOT + (size_t)NE * CAP * 4;
constexpr size_t WS_YS = WS_XC + (size_t)T * 3072 * 4;
constexpr size_t WS_DT = WS_YS + (size_t)T * 2048 * 4;
constexpr size_t WS_MODF = WS_DT + (size_t)T * 32 * 4;
constexpr size_t WS_WV = WS_MODF + (size_t)2 * 4 * 6144 * 4;
constexpr size_t WS_VT = WS_WV + (size_t)768 * 1024 * 2;
constexpr size_t WS_QNB = WS_VT + (size_t)768 * T * 2;
constexpr size_t WS_KSN = WS_QNB + (size_t)T * 512 * 2;
constexpr size_t WS_KWN = WS_KSN + (size_t)T * 128 * 2;
constexpr size_t WS_KCB = WS_KWN + (size_t)T * 128 * 2;
constexpr size_t WS_VCT = WS_KCB + (size_t)8 * 256 * 64 * 2;
constexpr size_t WS_DT2 = WS_VCT + (size_t)8 * 64 * 256 * 2;
constexpr size_t WS_CS = WS_DT2 + (size_t)NB * 32 * S * 4;
constexpr size_t WS_DEC = WS_CS + (size_t)NB * 32 * S * 4;
constexpr size_t WS_W1T = WS_DEC + al4k((size_t)NB * 16 * 32 * 4);
constexpr size_t WS_SKW = WS_W1T + (size_t)2 * 128 * 2048 * 2;
constexpr size_t WS_END = WS_SKW + (size_t)3 * 2 * 32 * 1024 * 2;
constexpr size_t WS_ZBC = WS_BIG, WS_XT = WS_XC, WS_XCT = WS_XC + (size_t)3072 * T * 2, WS_ST = WS_YS, WS_PB = WS_YS + (size_t)NB * 16 * 32 * 8192 * 4, WS_BCM = WS_QN;
static_assert(WS_XCT + (size_t)2560 * T * 2 <= WS_YS && WS_PB + (size_t)NB * 16 * 32 * 8192 * 2 <= WS_DT && (size_t)T * 1024 * 2 <= (size_t)T * 512 * 4, "layer-1 overlays");

constexpr int RING_BYTES = 131072;
constexpr int EXTRA_OFF = RING_BYTES;
constexpr int TAB_OFF = 151552;
constexpr int XB_OFF = 152576;
constexpr int LDS_BYTES = 153600;

struct Params { const float* in[30]; float* out; unsigned char* ws; };

__device__ __forceinline__ float siluf(float v) { return v / (1.f + expf(-v)); }
__device__ __forceinline__ float logsig(float x) { return fminf(x, 0.f) - log1pf(expf(-fabsf(x))); }
__device__ __forceinline__ float wave_sum(float v) {
#pragma unroll
    for (int o = 32; o > 0; o >>= 1) v += __shfl_xor(v, o);
    return v;
}
__device__ __forceinline__ float wave_max(float v) {
#pragma unroll
    for (int o = 32; o > 0; o >>= 1) v = fmaxf(v, __shfl_xor(v, o));
    return v;
}
__device__ __forceinline__ unsigned f2bf(float f) { unsigned u = __builtin_bit_cast(unsigned, f); return (u + 0x7fffu + ((u >> 16) & 1u)) >> 16; }
typedef float f32x2_t __attribute__((ext_vector_type(2))); typedef __bf16 bf16x2_t __attribute__((ext_vector_type(2)));
__device__ __forceinline__ unsigned pk2(float lo, float hi) { f32x2_t v = {lo, hi}; bf16x2_t b = __builtin_convertvector(v, bf16x2_t); return __builtin_bit_cast(unsigned, b); }
__device__ __forceinline__ float bf2f(bf16_t v) { return __uint_as_float((unsigned)v << 16); }
__device__ __forceinline__ float bflo(unsigned w) { return __uint_as_float(w << 16); }
__device__ __forceinline__ float bfhi(unsigned w) { return __uint_as_float(w & 0xffff0000u); }
#define LDS_WAIT() asm volatile("s_waitcnt lgkmcnt(0)" ::: "memory")
__device__ __forceinline__ int fresh(int v) { asm volatile("" : "+v"(v)); return v; }
__device__ __forceinline__ int sfresh(int v) { asm volatile("" : "+s"(v)); return v; }

#define XB_TMO      128
#define XB_XCNT(j)  (256  + 64 * (j))
#define XB_XSUB(j)  (1280 + 64 * (j))
#define XB_XGEN(j)  (2304 + 64 * (j))
#define XB_TOP      3328
#define XB_TOPGEN   3392
#define XCD_BAR_WORDS 3456
#define XB_SPIN_CAP (1u << 18)
__device__ __forceinline__ unsigned xb_ld(unsigned* p)              { return __hip_atomic_load(p, __ATOMIC_RELAXED, __HIP_MEMORY_SCOPE_AGENT); }
__device__ __forceinline__ unsigned xb_add(unsigned* p, unsigned v) { return __hip_atomic_fetch_add(p, v, __ATOMIC_RELAXED, __HIP_MEMORY_SCOPE_AGENT); }
__device__ __forceinline__ unsigned xb_xcc_id() { return (unsigned)__builtin_amdgcn_s_getreg((3 << 11) | 20) & 0xFu; }
#define XB_SPIN(cond, bar) do { unsigned _sp = 0; while (cond) { __builtin_amdgcn_s_sleep(1); \
    if ((++_sp & 255u) == 0u) { if (xb_ld(&(bar)[XB_TMO])) break; if (_sp > XB_SPIN_CAP) { atomicAdd(&(bar)[XB_TMO], 1u); break; } } } } while (0)
struct XcdBarrier { unsigned* bar; unsigned x; volatile LAS unsigned* st; };
__device__ __forceinline__ XcdBarrier xcd_barrier_post(unsigned* bar, volatile LAS unsigned* st) {
    XcdBarrier b; b.bar = bar; b.x = xb_xcc_id(); b.st = st;
    if (threadIdx.x == 0) (void)xb_add(&bar[XB_XCNT(b.x)], 1u);
    return b;
}
__device__ __forceinline__ void xcd_barrier_complete(unsigned* bar, unsigned x, unsigned& nloc, unsigned& nx) {
    const unsigned G = gridDim.x * gridDim.y * gridDim.z;
    unsigned sum, cnt, mine, sp = 0u;
    for (;;) {
        sum = 0u; cnt = 0u; mine = 0u;
#pragma unroll
        for (unsigned j = 0; j < 16; ++j) { const unsigned c = xb_ld(&bar[XB_XCNT(j)]); sum += c; cnt += (c > 0u) ? 1u : 0u; mine = (j == x) ? c : mine; }
        if (sum == G) break;
        __builtin_amdgcn_s_sleep(1);
        if ((++sp & 255u) == 0u) { if (xb_ld(&bar[XB_TMO])) break; if (sp > XB_SPIN_CAP) { atomicAdd(&bar[XB_TMO], 1u); break; } }
    }
    nloc = mine > 0u ? mine : 1u; nx = cnt > 0u ? cnt : 1u;
}
__device__ __forceinline__ void xcd_barrier(const XcdBarrier& b) {
    asm volatile("s_waitcnt vmcnt(0)" ::: "memory");
    __syncthreads();
    if (threadIdx.x == 0) {
        unsigned* bar = b.bar;
        __builtin_amdgcn_s_waitcnt(0);
        unsigned nloc = b.st[0], nx = b.st[1];
        if (nloc == 0u) { xcd_barrier_complete(bar, b.x, nloc, nx); b.st[0] = nloc; b.st[1] = nx; }
        const unsigned old = xb_add(&bar[XB_XSUB(b.x)], 1u);
        const unsigned gen = old / nloc;
        if (old + 1u == (gen + 1u) * nloc) {
            __builtin_amdgcn_fence(__ATOMIC_RELEASE, "agent");
            asm volatile("s_waitcnt vmcnt(0)" ::: "memory");
            const unsigned og = xb_add(&bar[XB_TOP], 1u);
            const unsigned tg = og / nx;
            if (og + 1u == (tg + 1u) * nx) xb_add(&bar[XB_TOPGEN], 1u);
            else XB_SPIN(xb_ld(&bar[XB_TOPGEN]) == tg, bar);
            __builtin_amdgcn_fence(__ATOMIC_ACQUIRE, "agent");
            xb_add(&bar[XB_XGEN(b.x)], 1u);
            asm volatile("s_waitcnt vmcnt(0)" ::: "memory");
        } else {
            XB_SPIN(xb_ld(&bar[XB_XGEN(b.x)]) == gen, bar);
            __builtin_amdgcn_fence(__ATOMIC_ACQUIRE, "agent");
            asm volatile("s_waitcnt vmcnt(0)" ::: "memory");
        }
    }
    __syncthreads();
}

namespace pg8 {
constexpr int BM = 256, BK = 64, HALF = 128, HTB = HALF * BK * 2, STAGE_BYTES = 8 * HTB;
__device__ __forceinline__ int lds_byte(int r, int c) { const int st = (r >> 4) * 2 + (c >> 5), rr = r & 15, cc = c & 31, ob = rr * 64 + cc * 2; return st * 1024 + (ob ^ (((ob >> 9) & 1) << 5)); }
__device__ __forceinline__ void stage_rc(int b, int& R, int& C) { const int st = b / 1024, sb = b % 1024, swz = sb ^ (((sb >> 9) & 1) << 5); R = (st >> 1) * 16 + swz / 64; C = (st & 1) * 32 + (swz % 64) / 2; }
__device__ __forceinline__ int perm32(int rho) { const int n = rho >> 4, i = rho & 15; return 8 * (i >> 2) + 4 * n + (i & 3); }
struct Unit { int pm, pn, e; };
struct Gemm { const bf16_t* A; const bf16_t* Bt; int K; };
__device__ __forceinline__ unsigned cvt_pk_bf16(float lo, float hi) { unsigned r; asm volatile("v_cvt_pk_bf16_f32 %0, %1, %2" : "=v"(r) : "v"(lo), "v"(hi)); return r; }

struct DenseOrder {
    int nM, nN, nwg, G, c;
    __device__ void init(int M, int N, int G_, int c_) { nM = M / BM; nN = N / BM; nwg = nM * nN; G = G_; c = c_; }
    __device__ bool next(int i, Unit& u) const {
        const long L = (long)i * G + c; if (L >= nwg) return false;
        int wgid = (int)L; { const int q = nwg / 8, r = nwg % 8, xcd = wgid % 8, off = wgid / 8; wgid = (xcd < r ? xcd * (q + 1) : r * (q + 1) + (xcd - r) * q) + off; }
        const int nig = 8 * nN, gid = wgid / nig, fm = gid * 8, gsz = (nM - fm) < 8 ? (nM - fm) : 8;
        u.pm = fm + ((wgid % nig) % gsz); u.pn = (wgid % nig) / gsz; u.e = 0; return true;
    }
    __device__ __forceinline__ unsigned arow(const Unit& u, int r) const { return (unsigned)(u.pm * BM + r); }
};
struct MoeOrder {
    const LAS int* tb; const LAS int* cn; const int* slot_tok; int shift, G, c; bool gather;
    __device__ bool next(int i, Unit& u) const {
        const int L = i * G + c, tile = L >> shift; if (tile >= tb[NE]) return false;
        int e = 0; while (tb[e + 1] <= tile) ++e;
        u.pm = tile; u.pn = (e << shift) + (L & ((1 << shift) - 1)); u.e = e; return true;
    }
    __device__ __forceinline__ unsigned arow(const Unit& u, int r) const {
        if (!gather) return (unsigned)(u.pm * BM + r);
        const int pos = (u.pm - tb[u.e]) * BM + r;
        return pos < cn[u.e] ? (unsigned)slot_tok[u.e * CAP + pos] : 0u;
    }
};

struct EpiBf16 {
    static constexpr bool PERM = true;
    bf16_t* O; int ldc;
    __device__ __forceinline__ void operator()(const f32x4 (&acc)[2][2][4][2], const Unit& u, int wr, int wc, int fr, int fq) const {
        const int row0 = u.pm * BM + wr * 64 + fr, col0 = u.pn * BM + wc * 32 + 8 * fq;
#pragma unroll
        for (int ai = 0; ai < 2; ++ai)
#pragma unroll
            for (int m = 0; m < 4; ++m) { bf16_t* rowp = O + (size_t)(row0 + ai * HALF + m * 16) * ldc + col0;
#pragma unroll
                for (int bj = 0; bj < 2; ++bj) { const f32x4 v0 = acc[ai][bj][m][0], v1 = acc[ai][bj][m][1];
                    u32x4 w; w.x = cvt_pk_bf16(v0[0], v0[1]); w.y = cvt_pk_bf16(v0[2], v0[3]); w.z = cvt_pk_bf16(v1[0], v1[1]); w.w = cvt_pk_bf16(v1[2], v1[3]);
                    *(u32x4*)(rowp + bj * HALF) = w; } }
    }
};
struct EpiResid {
    static constexpr bool PERM = false;
    const float* base; float* out; const float* g;
    __device__ __forceinline__ void operator()(const f32x4 (&acc)[2][2][4][2], const Unit& u, int wr, int wc, int fr, int fq) const {
        const int row0 = u.pm * BM + wr * 64 + fr, col0 = u.pn * BM + wc * 32 + 4 * fq;
        const float* gb = g + (size_t)((u.pm * BM) / S) * 6144 + col0;
        f32x4 gv[2][2];
#pragma unroll
        for (int bj = 0; bj < 2; ++bj)
#pragma unroll
            for (int n = 0; n < 2; ++n) gv[bj][n] = *(const f32x4*)(gb + bj * HALF + n * 16);
#pragma unroll
        for (int ai = 0; ai < 2; ++ai)
#pragma unroll
            for (int m = 0; m < 4; ++m) { const size_t off = (size_t)(row0 + ai * HALF + m * 16) * D + col0;
#pragma unroll
                for (int bj = 0; bj < 2; ++bj)
#pragma unroll
                    for (int n = 0; n < 2; ++n) { const f32x4 bs = *(const f32x4*)(base + off + bj * HALF + n * 16);
                        *(f32x4*)(out + off + bj * HALF + n * 16) = bs + gv[bj][n] * acc[ai][bj][m][n]; } }
    }
};
struct EpiGu {
    static constexpr bool PERM = true;
    bf16_t* act; const float* bgu;
    __device__ __forceinline__ void operator()(const f32x4 (&acc)[2][2][4][2], const Unit& u, int wr, int wc, int fr, int fq) const {
        const int row0 = u.pm * BM + wr * 64 + fr, col0 = (u.pn & 7) * HALF + wc * 32 + 8 * fq;
        const float* bb = bgu + (size_t)u.e * 2048 + col0;
        const f32x4 bg0 = *(const f32x4*)(bb), bg1 = *(const f32x4*)(bb + 4), bu0 = *(const f32x4*)(bb + 1024), bu1 = *(const f32x4*)(bb + 1028);
#pragma unroll
        for (int ai = 0; ai < 2; ++ai)
#pragma unroll
            for (int m = 0; m < 4; ++m) {
                float r[8];
#pragma unroll
                for (int n = 0; n < 2; ++n) { const f32x4 gt = acc[ai][0][m][n] + (n ? bg1 : bg0), up = acc[ai][1][m][n] + (n ? bu1 : bu0);
#pragma unroll
                    for (int j = 0; j < 4; ++j) { const float gg = fminf(gt[j], 7.f), uu = fminf(fmaxf(up[j], -7.f), 7.f);
                        r[n * 4 + j] = (uu + 1.f) * gg * __builtin_amdgcn_rcpf(1.f + __expf(-1.702f * gg)); } }
                u32x4 w; w.x = cvt_pk_bf16(r[0], r[1]); w.y = cvt_pk_bf16(r[2], r[3]); w.z = cvt_pk_bf16(r[4], r[5]); w.w = cvt_pk_bf16(r[6], r[7]);
                *(u32x4*)(act + (size_t)(row0 + ai * HALF + m * 16) * D + col0) = w; }
    }
};
struct EpiDown {
    static constexpr bool PERM = true;
    bf16_t* y; const float* bd;
    __device__ __forceinline__ void operator()(const f32x4 (&acc)[2][2][4][2], const Unit& u, int wr, int wc, int fr, int fq) const {
        const int row0 = u.pm * BM + wr * 64 + fr, col0 = (u.pn & 3) * BM + wc * 32 + 8 * fq;
        const float* bb = bd + (size_t)u.e * 1024 + col0;
        f32x4 bv[2][2];
#pragma unroll
        for (int bj = 0; bj < 2; ++bj)
#pragma unroll
            for (int n = 0; n < 2; ++n) bv[bj][n] = *(const f32x4*)(bb + bj * HALF + 4 * n);
#pragma unroll
        for (int ai = 0; ai < 2; ++ai)
#pragma unroll
            for (int m = 0; m < 4; ++m) { bf16_t* rowp = y + (size_t)(row0 + ai * HALF + m * 16) * D + col0;
#pragma unroll
                for (int bj = 0; bj < 2; ++bj) { const f32x4 v0 = acc[ai][bj][m][0] + bv[bj][0], v1 = acc[ai][bj][m][1] + bv[bj][1];
                    u32x4 w; w.x = cvt_pk_bf16(v0[0], v0[1]); w.y = cvt_pk_bf16(v0[2], v0[3]); w.z = cvt_pk_bf16(v1[0], v1[1]); w.w = cvt_pk_bf16(v1[2], v1[3]);
                    *(u32x4*)(rowp + bj * HALF) = w; } }
    }
};

template <class Epi, class Sched>
__device__ __forceinline__ void gemm_phase(LAS unsigned char* lds, const Gemm g, const Sched& S, const Epi& E, const int tid) {
    const int wid = __builtin_amdgcn_readfirstlane(tid >> 6), lane = tid & 63, wr = wid >> 2, wc = wid & 3, fr = lane & 15, fq = lane >> 4;
    const int K = g.K, nt = K / BK;
    int RA[2], CA[2]; unsigned voffB[2];
#pragma unroll
    for (int i = 0; i < 2; ++i) { int R, C; stage_rc(tid * 16 + i * 8192, R, C); const int Rb = Epi::PERM ? ((R & ~31) + perm32(R & 31)) : R;
        RA[i] = R; CA[i] = C; voffB[i] = (unsigned)(Rb * K + C) * 2u; }
    const size_t kstep = (size_t)(BK * 2);
    const size_t hstep = (size_t)HALF * K * 2;
    const size_t tstep = 2 * hstep;
    const unsigned ldsw = (unsigned)wid * 1024u;
    const int aoff = lds_byte(wr * 64 + fr, fq * 8), boff = lds_byte(wc * 32 + fr, fq * 8);
#define PG8_SA(b, h) (((b) * 2 + (h)) * HTB)
#define PG8_SB(b, h) ((4 + (b) * 2 + (h)) * HTB)
#define PG8_STAGE(bufoff, gbase, voff) do { _Pragma("unroll") for (int _i = 0; _i < 2; ++_i) \
        __builtin_amdgcn_global_load_lds((const unsigned*)((const char*)(gbase) + (voff)[_i]), (LAS unsigned*)(lds + (bufoff) + ldsw + _i * 8192), 16, 0, 0); } while (0)
#define PG8_LDA(dst, b, h) do { _Pragma("unroll") for (int m = 0; m < 4; ++m) _Pragma("unroll") for (int k = 0; k < 2; ++k) dst[m][k] = *(const LAS bf16x8*)(lds + PG8_SA(b, h) + aoff + m * 2048 + k * 1024); } while (0)
#define PG8_LDB(dst, b, h) do { _Pragma("unroll") for (int n = 0; n < 2; ++n) _Pragma("unroll") for (int k = 0; k < 2; ++k) dst[n][k] = *(const LAS bf16x8*)(lds + PG8_SB(b, h) + boff + n * 2048 + k * 1024); } while (0)
#define PG8_MMA(ai, bj, At, Bt) do { __builtin_amdgcn_s_setprio(1); _Pragma("unroll") for (int m = 0; m < 4; ++m) _Pragma("unroll") for (int n = 0; n < 2; ++n) _Pragma("unroll") for (int k = 0; k < 2; ++k) \
        acc[ai][bj][m][n] = __builtin_amdgcn_mfma_f32_16x16x32_bf16(Bt[n][k], At[m][k], acc[ai][bj][m][n], 0, 0, 0); __builtin_amdgcn_s_setprio(0); } while (0)
#define PG8_WAIT_V(n) asm volatile("s_waitcnt vmcnt(" #n ")" ::: "memory")
#define PG8_WAIT_L(n) asm volatile("s_waitcnt lgkmcnt(" #n ")" ::: "memory")
#define PG8_BAR __builtin_amdgcn_s_barrier()
#define PG8_SCHED __builtin_amdgcn_sched_barrier(0)
#define PG8_AOFF(dst, u) do { _Pragma("unroll") for (int _h = 0; _h < 2; ++_h) _Pragma("unroll") for (int _i = 0; _i < 2; ++_i) dst[_h][_i] = (S.arow(u, _h * HALF + RA[_i]) * (unsigned)K + (unsigned)CA[_i]) * 2u; } while (0)
    Unit cur, nxt; int ui = 0;
    if (!S.next(0, cur)) return;
    f32x4 acc[2][2][4][2];
#pragma unroll
    for (int a = 0; a < 2; ++a)
#pragma unroll
        for (int b = 0; b < 2; ++b)
#pragma unroll
            for (int m = 0; m < 4; ++m)
#pragma unroll
                for (int n = 0; n < 2; ++n) acc[a][b][m][n] = (f32x4){0.f, 0.f, 0.f, 0.f};
    bf16x8 At[4][2], B0[2][2], B1[2][2];
    unsigned va[2][2], vn[2][2];
    PG8_AOFF(va, cur);
    const char* Ab = (const char*)g.A;
    const char* cB = (const char*)g.Bt + (size_t)cur.pn * tstep;
    PG8_STAGE(PG8_SB(0, 0), cB, voffB); PG8_STAGE(PG8_SB(0, 1), cB + hstep, voffB); PG8_STAGE(PG8_SA(0, 0), Ab, va[0]); PG8_STAGE(PG8_SA(0, 1), Ab, va[1]);
    if (wr == 1) PG8_BAR;
    PG8_WAIT_V(2); PG8_BAR;
    PG8_STAGE(PG8_SB(1, 0), cB + kstep, voffB); PG8_STAGE(PG8_SA(1, 0), Ab + kstep, va[0]); PG8_STAGE(PG8_SB(1, 1), cB + hstep + kstep, voffB);
    PG8_WAIT_V(6); PG8_BAR;
    for (;;) {
        const bool has_next = S.next(ui + 1, nxt);
        if (has_next) { PG8_AOFF(vn, nxt); }
        else {
#pragma unroll
            for (int h = 0; h < 2; ++h)
#pragma unroll
                for (int i = 0; i < 2; ++i) vn[h][i] = va[h][i]; }
        const char* nB = has_next ? (const char*)g.Bt + (size_t)nxt.pn * tstep : cB;
        for (int t = 0; t < nt; t += 2) {
            const bool last = (t == nt - 2);
            const char* a1 = Ab + (size_t)(t + 1) * kstep;
            const char* a2 = last ? Ab : Ab + (size_t)(t + 2) * kstep; const char* b2 = last ? nB : cB + (size_t)(t + 2) * kstep;
            const char* a3 = a2 + kstep; const char* b3 = b2 + kstep;
            unsigned o2[2][2];
#pragma unroll
            for (int h = 0; h < 2; ++h)
#pragma unroll
                for (int i = 0; i < 2; ++i) o2[h][i] = last ? vn[h][i] : va[h][i];
            PG8_LDB(B0, 0, 0); PG8_LDB(B1, 0, 1); PG8_SCHED; PG8_LDA(At, 0, 0); PG8_STAGE(PG8_SA(1, 1), a1, va[1]);
            PG8_WAIT_V(8); PG8_WAIT_L(0); PG8_BAR; PG8_MMA(0, 0, At, B0); PG8_MMA(0, 1, At, B1); PG8_BAR; PG8_SCHED;
            PG8_LDA(At, 0, 1); PG8_STAGE(PG8_SB(0, 0), b2, voffB); PG8_STAGE(PG8_SB(0, 1), b2 + hstep, voffB); PG8_STAGE(PG8_SA(0, 0), a2, o2[0]);
            PG8_WAIT_V(8); PG8_WAIT_L(0); PG8_BAR; PG8_MMA(1, 0, At, B0); PG8_MMA(1, 1, At, B1); PG8_BAR; PG8_SCHED;
            PG8_LDB(B0, 1, 0); PG8_LDB(B1, 1, 1); PG8_SCHED; PG8_LDA(At, 1, 0); PG8_STAGE(PG8_SA(0, 1), a2, o2[1]);
            PG8_WAIT_V(8); PG8_WAIT_L(0); PG8_BAR; PG8_MMA(0, 0, At, B0); PG8_MMA(0, 1, At, B1); PG8_BAR; PG8_SCHED;
            PG8_LDA(At, 1, 1); PG8_STAGE(PG8_SB(1, 0), b3, voffB); PG8_STAGE(PG8_SB(1, 1), b3 + hstep, voffB); PG8_STAGE(PG8_SA(1, 0), a3, o2[0]);
            PG8_WAIT_V(8); PG8_WAIT_L(0); PG8_BAR; PG8_MMA(1, 0, At, B0); PG8_MMA(1, 1, At, B1); PG8_BAR; PG8_SCHED;
        }
        if (wr == 0) PG8_BAR;
        E(acc, cur, wr, wc, fr, fq);
        if (!has_next) break;
#pragma unroll
        for (int a = 0; a < 2; ++a)
#pragma unroll
            for (int b = 0; b < 2; ++b)
#pragma unroll
                for (int m = 0; m < 4; ++m)
#pragma unroll
                    for (int n = 0; n < 2; ++n) acc[a][b][m][n] = (f32x4){0.f, 0.f, 0.f, 0.f};
        cur = nxt; cB = nB; ++ui;
#pragma unroll
        for (int h = 0; h < 2; ++h)
#pragma unroll
            for (int i = 0; i < 2; ++i) va[h][i] = vn[h][i];
        if (wr == 1) PG8_BAR;
    }
    PG8_WAIT_V(0);
    PG8_BAR;
#undef PG8_SA
#undef PG8_SB
#undef PG8_STAGE
#undef PG8_LDA
#undef PG8_LDB
#undef PG8_MMA
#undef PG8_WAIT_V
#undef PG8_WAIT_L
#undef PG8_BAR
#undef PG8_SCHED
#undef PG8_AOFF
}
}

#ifndef PROBE_SUB
#define PROBE_SUB 0
#endif
struct Ctx {
    LAS unsigned char* lds; unsigned char* ws;
    int tid, lane, wave, gw, ngw, G, bid;
    mutable unsigned long long sub, subt;
};
#define SUB_BEGIN(X, id) do { if (PROBE_SUB == (id)) (X).subt = __builtin_amdgcn_s_memrealtime(); } while (0)
#define SUB_END(X, id) do { if (PROBE_SUB == (id)) (X).sub += __builtin_amdgcn_s_memrealtime() - (X).subt; } while (0)

__device__ __forceinline__ void transpose_item(const float* W, int ldw, int K, int nvalid, int k0, int n0, bf16_t* WT, int row0, LAS float* scr, int lane) {
    const int c4 = (lane & 7) * 4, kr = lane >> 3;
    f32x4 v[8];
#pragma unroll
    for (int i = 0; i < 8; ++i) v[i] = (n0 + c4 < nvalid) ? *(const f32x4*)(W + (size_t)(k0 + kr + 8 * i) * ldw + n0 + c4) : (f32x4){0.f, 0.f, 0.f, 0.f};
#pragma unroll
    for (int i = 0; i < 8; ++i) { LAS float* d = scr + (kr + 8 * i) * 33 + c4; d[0] = v[i].x; d[1] = v[i].y; d[2] = v[i].z; d[3] = v[i].w; }
    LDS_WAIT(); asm volatile("" ::: "memory");
    const int c = lane & 7;
#pragma unroll
    for (int j = 0; j < 4; ++j) { const int n = (lane >> 3) + 8 * j; const LAS float* s = scr + (8 * c) * 33 + n;
        u32x4 o; o.x = pk2(s[0 * 33], s[1 * 33]); o.y = pk2(s[2 * 33], s[3 * 33]); o.z = pk2(s[4 * 33], s[5 * 33]); o.w = pk2(s[6 * 33], s[7 * 33]);
        *(u32x4*)(WT + (size_t)(row0 + n) * K + k0 + 8 * c) = o; }
    LDS_WAIT(); asm volatile("" ::: "memory");
}
__device__ __forceinline__ void ph_prologue(const Params& p, const Ctx& X) {
    LAS float* scr = (LAS float*)(X.lds + X.wave * 16384);
    unsigned char* ws = X.ws;
    constexpr int I_MOD = 2 * 96 * 8;
    constexpr int I_SK = 3 * 16, I_W1 = 2 * 32 * 4, I_WIN = 16 * 96, I_WV = 16 * 24, I_WOUT = 16 * 32, I_WSIN = 16 * 160, I_WSOUT = 32 * 32, I_GU = 64 * 1024, I_DN = 64 * 512;
    constexpr int NITEMS = I_MOD + I_SK + I_W1 + I_WIN + I_WV + I_WOUT + I_WSIN + I_WSOUT + I_GU + I_DN;
    for (int it = X.gw; it < NITEMS; it += X.ngw) {
        int r = it;
        if (r < I_MOD) {
            const int kp = r & 7, jb = (r >> 3) % 96, l = r / (8 * 96), j = jb * 64 + X.lane;
            const float* w = p.in[2] + (size_t)l * 1024 * 6144 + (size_t)(kp * 128) * 6144 + j;
            const float* c = p.in[1] + kp * 128;
            float a0 = 0.f, a1 = 0.f, a2 = 0.f, a3 = 0.f;
#pragma unroll 8
            for (int i = 0; i < 128; ++i) { const float wv = w[(size_t)i * 6144];
                a0 += siluf(c[i]) * wv; a1 += siluf(c[1024 + i]) * wv; a2 += siluf(c[2048 + i]) * wv; a3 += siluf(c[3072 + i]) * wv; }
            if (kp == 0) { const float bb = p.in[3][l * 6144 + j]; a0 += bb; a1 += bb; a2 += bb; a3 += bb; }
            unsigned long long* mq = (unsigned long long*)(ws + CTL_MOD) + (size_t)l * 4 * 6144 + j;
            atomicAdd(mq, (unsigned long long)__double2ll_rn((double)a0 * 1099511627776.0)); atomicAdd(mq + 6144, (unsigned long long)__double2ll_rn((double)a1 * 1099511627776.0));
            atomicAdd(mq + 2 * 6144, (unsigned long long)__double2ll_rn((double)a2 * 1099511627776.0)); atomicAdd(mq + 3 * 6144, (unsigned long long)__double2ll_rn((double)a3 * 1099511627776.0));
            continue;
        }
        r -= I_MOD;
        if (r < I_SK) {
            const int m = r >> 4, kb = r & 15, k0 = kb * 64;
            const float* W = m < 2 ? p.in[24] + (size_t)m * D * NE : p.in[16] + 5120; const int ldw = m < 2 ? NE : SSM_IN;
#pragma unroll 8
            for (int i = 0; i < 32; ++i) { const int kk = 2 * i + (X.lane >> 5); scr[kk * 33 + (X.lane & 31)] = W[(size_t)(k0 + kk) * ldw + (X.lane & 31)]; }
            LDS_WAIT(); asm volatile("" ::: "memory");
            const int c = X.lane & 7;
#pragma unroll
            for (int j = 0; j < 4; ++j) { const int n = (X.lane >> 3) + 8 * j; const LAS float* sp = scr + (8 * c) * 33 + n;
                float v[8]; unsigned hi[8];
#pragma unroll
                for (int q = 0; q < 8; ++q) { v[q] = sp[q * 33]; hi[q] = f2bf(v[q]); v[q] -= __uint_as_float(hi[q] << 16); }
                u32x4 oh, ol; oh.x = hi[0] | (hi[1] << 16); oh.y = hi[2] | (hi[3] << 16); oh.z = hi[4] | (hi[5] << 16); oh.w = hi[6] | (hi[7] << 16);
                ol.x = pk2(v[0], v[1]); ol.y = pk2(v[2], v[3]); ol.z = pk2(v[4], v[5]); ol.w = pk2(v[6], v[7]);
                bf16_t* dst = (bf16_t*)(ws + WS_SKW) + (size_t)m * 2 * 32 * 1024 + (size_t)n * 1024 + k0 + 8 * c;
                *(u32x4*)dst = oh; *(u32x4*)(dst + 32 * 1024) = ol; }
            LDS_WAIT(); asm volatile("" ::: "memory");
            continue; }
        r -= I_SK;
        if (r < I_W1) { const int kv = r >> 7, q = r & 127, kb = q >> 2, nb = q & 3;
            transpose_item(kv ? p.in[14] : p.in[12], 128, 2048, 128, kb * 64, nb * 32, (bf16_t*)(ws + WS_W1T) + (size_t)kv * 128 * 2048, nb * 32, scr, X.lane); continue; } r -= I_W1;
        if (r < I_WIN) { const int kb = r / 96, nb = r % 96; transpose_item(p.in[6], ATTN_IN, 1024, ATTN_IN, kb * 64, nb * 32, (bf16_t*)(ws + WS_WIN), nb * 32, scr, X.lane); continue; } r -= I_WIN;
        if (r < I_WV) { const int kb = r / 24, nb = r % 24, r0 = nb * 32, src = r0 < 512 ? OFF_SBV + r0 : (r0 < 640 ? OFF_VS + (r0 - 512) : OFF_VW + (r0 - 640));
            transpose_item(p.in[6], ATTN_IN, 1024, ATTN_IN, kb * 64, src, (bf16_t*)(ws + WS_WV), r0, scr, X.lane); continue; } r -= I_WV;
        if (r < I_WOUT) { const int kb = r / 32, nb = r % 32; transpose_item(p.in[7], 1024, 1024, 1024, kb * 64, nb * 32, (bf16_t*)(ws + WS_WOUT), nb * 32, scr, X.lane); continue; } r -= I_WOUT;
        if (r < I_WSIN) { const int kb = r / 160, nb = r % 160, n0 = nb * 32, row0 = n0 < 2048 ? n0 : (n0 < 4096 ? n0 + 1024 : n0 - 2048);
            transpose_item(p.in[16], SSM_IN, 1024, SSM_IN, kb * 64, n0, (bf16_t*)(ws + WS_WSIN), row0, scr, X.lane); continue; } r -= I_WSIN;
        if (r < I_WSOUT) { const int kb = r / 32, nb = r % 32; transpose_item(p.in[23], 1024, 2048, 1024, kb * 64, nb * 32, (bf16_t*)(ws + WS_WSOUT), nb * 32, scr, X.lane); continue; } r -= I_WSOUT;
        if (r < I_GU) { const int m = r >> 10, q = r & 1023, kb = q >> 6, nb = q & 63, n0 = nb * 32;
            const int row0 = ((n0 & 1023) >> 7) * 256 + (n0 >> 10) * 128 + (n0 & 127);
            transpose_item(p.in[26] + (size_t)m * 1024 * 2048, 2048, 1024, 2048, kb * 64, n0, (bf16_t*)(ws + WS_WGU) + (size_t)m * 2048 * 1024, row0, scr, X.lane); continue; } r -= I_GU;
        { const int m = r >> 9, q = r & 511, kb = q >> 5, nb = q & 31;
            transpose_item(p.in[28] + (size_t)m * 1024 * 1024, 1024, 1024, 1024, kb * 64, nb * 32, (bf16_t*)(ws + WS_WDN) + (size_t)m * 1024 * 1024, nb * 32, scr, X.lane); }
    }
}

struct Row { f32x4 v[4]; };
__device__ __forceinline__ void row_load(Row& r, const float* p, int lane) {
#pragma unroll
    for (int j = 0; j < 4; ++j) r.v[j] = ((const f32x4*)p)[64 * j + lane];
}
__device__ __forceinline__ void row_store(const Row& r, float* p, int lane) {
#pragma unroll
    for (int j = 0; j < 4; ++j) ((f32x4*)p)[64 * j + lane] = r.v[j];
}
template <class PV>
__device__ __forceinline__ void row_norm_mod(const Row& r, Row& o, const float* gain, PV sc, PV sh, int lane) {
    float ss = 0.f;
#pragma unroll
    for (int j = 0; j < 4; ++j) ss += (r.v[j].x * r.v[j].x + r.v[j].y * r.v[j].y) + (r.v[j].z * r.v[j].z + r.v[j].w * r.v[j].w);
    const float rs = rsqrtf(wave_sum(ss) * (1.f / 1024.f) + EPS);
#pragma unroll
    for (int j = 0; j < 4; ++j) { const f32x4 g = ((const f32x4*)gain)[64 * j + lane], a = sc[64 * j + lane], b = sh[64 * j + lane];
        o.v[j] = r.v[j] * rs * g * (a + 1.f) + b; }
}
__device__ __forceinline__ void row_store_bf16(const Row& r, bf16_t* p, int lane) {
#pragma unroll
    for (int j = 0; j < 4; ++j) { u32x2 w; w.x = pk2(r.v[j].x, r.v[j].y); w.y = pk2(r.v[j].z, r.v[j].w); ((u32x2*)p)[64 * j + lane] = w; }
}
__device__ __forceinline__ void row_store_lds(const Row& r, LAS float* p, int lane) {
#pragma unroll
    for (int j = 0; j < 4; ++j) ((LAS f32x4*)p)[64 * j + lane] = r.v[j];
}
__device__ __forceinline__ float modq2f(long long q) { return (float)((double)q * 9.094947017729282e-13); }
__device__ __forceinline__ void ph_norm0(const Params& p, const Ctx& X) {
    const long long* mq = (const long long*)(X.ws + CTL_MOD);
    float* modf = (float*)(X.ws + WS_MODF);
    for (int i = X.bid * NTHREADS + X.tid; i < 2 * 4 * 6144; i += X.G * NTHREADS) modf[i] = modq2f(mq[i]);
    LAS float* tab = (LAS float*)X.lds;
    for (int i = X.tid; i < 4 * 2048; i += NTHREADS) tab[i] = modq2f(mq[(size_t)(i >> 11) * 6144 + (i & 2047)]);
    __syncthreads();
    for (int t = X.gw; t < T; t += X.ngw) {
        Row r, o; row_load(r, p.in[0] + (size_t)t * D, X.lane);
        const LAS float* m = tab + (t / S) * 2048;
        row_norm_mod(r, o, p.in[4], (const LAS f32x4*)(m + 1024), (const LAS f32x4*)m, X.lane);
        row_store_bf16(o, (bf16_t*)(X.ws + WS_U) + (size_t)t * D, X.lane);
    }
}
__device__ __forceinline__ void route_select(float logit, int lane, LAS unsigned* lcnt, int& ev, float& wv, int& lpos) {
    const int e = lane & 31;
    float tl[4]; int te[4];
#pragma unroll
    for (int k = 0; k < 4; ++k) {
        float bv = logit; int bi = e;
#pragma unroll
        for (int o = 16; o > 0; o >>= 1) { const float ov = __shfl_xor(bv, o); const int oi = __shfl_xor(bi, o); if (ov > bv || (ov == bv && oi < bi)) { bv = ov; bi = oi; } }
        tl[k] = bv; te[k] = bi;
        if (e == bi) logit = -INFINITY;
    }
    ev = 0; wv = 0.f; lpos = 0;
    if (e < 4) {
        const float e1 = expf(tl[1] - tl[0]), e2 = expf(tl[2] - tl[0]), e3 = expf(tl[3] - tl[0]);
        const float inv = 1.f / (1.f + e1 + e2 + e3);
        wv = (e == 0 ? 1.f : e == 1 ? e1 : e == 2 ? e2 : e3) * inv;
        ev = e == 0 ? te[0] : e == 1 ? te[1] : e == 2 ? te[2] : te[3];
        lpos = (int)__hip_atomic_fetch_add(&lcnt[ev], 1u, __ATOMIC_RELAXED, __HIP_MEMORY_SCOPE_WORKGROUP);
    }
}
__device__ __forceinline__ void moe_table(const Ctx& X, int l) {
    LAS int* tb = (LAS int*)(X.lds + TAB_OFF);
    if (X.wave == 0) {
        const unsigned* cnt = (const unsigned*)(X.ws + WS_CTL) + CW_CNT + l * 32 * 32;
        const int e = X.lane & 31;
        const int c = (int)__hip_atomic_load(cnt + e * 32, __ATOMIC_RELAXED, __HIP_MEMORY_SCOPE_AGENT), nt = (c + 255) >> 8;
        int incl = nt;
#pragma unroll
        for (int o = 1; o < 32; o <<= 1) { const int u = __shfl_up(incl, o); if (e >= o) incl += u; }
        if (X.lane < 32) { tb[e] = incl - nt; tb[40 + e] = c; if (e == 31) tb[NE] = incl; }
    }
    __syncthreads();
}
template <int MODE>
__device__ __forceinline__ void ph_token(const Params& p, const Ctx& X, int l, const float* h, float* hn) {
    if (MODE != 0) moe_table(X, l);
    const LAS int* tb = (const LAS int*)(X.lds + TAB_OFF);
    const float* modl = (const float*)(X.ws + WS_MODF) + (size_t)l * 4 * 6144;
    const float* modn = (const float*)(X.ws + WS_MODF) + (size_t)(MODE == 1 ? 1 : l) * 4 * 6144;
    const float* gain = MODE == 1 ? p.in[4] + D : p.in[5] + l * D;
    const int sc_off = MODE == 1 ? 1024 : 4096, sh_off = MODE == 1 ? 0 : 3072;
    const bf16_t* y = (const bf16_t*)(X.ws + WS_Y);
    LAS float* rsl = (LAS float*)X.lds;
    LAS float* part = (LAS float*)(X.lds + 1024);
    if (MODE == 0 && X.tid < 32) ((LAS unsigned*)(X.lds + 1024 + 65536))[X.tid] = 0u;
    for (int tile = X.bid; tile < T / 64; tile += X.G) {
        const int lane = fresh(X.lane), w = X.wave, tb0 = tile * 64, bb = tb0 / S;
        int pe_ = 0, pp_ = 0; float pw_ = 0.f;
        if (MODE != 0 && lane < 32) { const int idx = (tb0 + 8 * w) * 4 + lane; pe_ = ((const int*)(X.ws + WS_TOKE))[idx]; pp_ = ((const int*)(X.ws + WS_TOKP))[idx]; pw_ = ((const float*)(X.ws + WS_TOKW))[idx]; }
#pragma unroll 1
        for (int k2 = 0; k2 < 4; ++k2) {
            Row r[2];
#pragma unroll
            for (int u = 0; u < 2; ++u) row_load(r[u], h + (size_t)(tb0 + 8 * w + 2 * k2 + u) * D, lane);
            if (MODE != 0) {
                const float* g2 = modl + (size_t)bb * 6144 + 5120;
                Row sacc[2];
#pragma unroll
                for (int u = 0; u < 2; ++u) {
#pragma unroll
                    for (int j = 0; j < 4; ++j) sacc[u].v[j] = (f32x4){0.f, 0.f, 0.f, 0.f};
#pragma unroll
                    for (int kk = 0; kk < 4; ++kk) {
                        const int sl = (2 * k2 + u) * 4 + kk;
                        const int e = __shfl(pe_, sl), pos = __shfl(pp_, sl); const float wt = __shfl(pw_, sl);
                        const bf16_t* yr = y + (size_t)(tb[e] * 256 + pos) * D;
#pragma unroll
                        for (int j = 0; j < 4; ++j) { const u32x2 q = ((const u32x2*)yr)[64 * j + lane];
                            sacc[u].v[j].x += wt * bflo(q.x); sacc[u].v[j].y += wt * bfhi(q.x); sacc[u].v[j].z += wt * bflo(q.y); sacc[u].v[j].w += wt * bfhi(q.y); }
                    }
                }
#pragma unroll
                for (int u = 0; u < 2; ++u) {
#pragma unroll
                    for (int j = 0; j < 4; ++j) r[u].v[j] = r[u].v[j] + ((const f32x4*)g2)[64 * j + lane] * sacc[u].v[j];
                    row_store(r[u], hn + (size_t)(tb0 + 8 * w + 2 * k2 + u) * D, lane);
                }
            }
            if (MODE != 2) {
                const float* m = modn + (size_t)bb * 6144;
#pragma unroll
                for (int u = 0; u < 2; ++u) {
                    float ssq = 0.f;
#pragma unroll
                    for (int j = 0; j < 4; ++j) ssq += (r[u].v[j].x * r[u].v[j].x + r[u].v[j].y * r[u].v[j].y) + (r[u].v[j].z * r[u].v[j].z + r[u].v[j].w * r[u].v[j].w);
                    const float rs = rsqrtf(wave_sum(ssq) * (1.f / 1024.f) + EPS);
                    Row o;
#pragma unroll
                    for (int j = 0; j < 4; ++j) { const f32x4 g = ((const f32x4*)gain)[64 * j + lane], a = ((const f32x4*)(m + sc_off))[64 * j + lane], b = ((const f32x4*)(m + sh_off))[64 * j + lane];
                        o.v[j] = r[u].v[j] * rs * g * (a + 1.f) + b; }
                    row_store_bf16(o, (bf16_t*)(X.ws + WS_U) + (size_t)(tb0 + 8 * w + 2 * k2 + u) * D, lane);
                    if (lane == 0) rsl[8 * w + 2 * k2 + u] = rs;
                }
            }
        }
        if (MODE == 2) continue;
        __syncthreads();
        {
            const int ql = lane & 31, hf = lane >> 5;
            const float* src = MODE == 0 ? h : hn;
            const float* m = modn + (size_t)bb * 6144;
            const bf16_t* wh = (const bf16_t*)(X.ws + WS_SKW) + (size_t)(MODE == 0 ? l : 2) * 2 * 32 * 1024 + (size_t)ql * 1024;
            const float rs0 = rsl[ql], rs1 = rsl[32 + ql];
            f32x16 acc0, acc1;
#pragma unroll
            for (int i = 0; i < 16; ++i) { acc0[i] = 0.f; acc1[i] = 0.f; }
#pragma unroll 2
            for (int ks = 0; ks < 8; ++ks) {
                const int k0 = 128 * w + 16 * ks + 8 * hf;
                float ca[8], cb[8];
                { const f32x4 g0 = *(const f32x4*)(gain + k0), g1 = *(const f32x4*)(gain + k0 + 4), a0 = *(const f32x4*)(m + sc_off + k0), a1 = *(const f32x4*)(m + sc_off + k0 + 4),
                              b0 = *(const f32x4*)(m + sh_off + k0), b1 = *(const f32x4*)(m + sh_off + k0 + 4);
                  ca[0] = g0.x * (1.f + a0.x); ca[1] = g0.y * (1.f + a0.y); ca[2] = g0.z * (1.f + a0.z); ca[3] = g0.w * (1.f + a0.w);
                  ca[4] = g1.x * (1.f + a1.x); ca[5] = g1.y * (1.f + a1.y); ca[6] = g1.z * (1.f + a1.z); ca[7] = g1.w * (1.f + a1.w);
                  cb[0] = b0.x; cb[1] = b0.y; cb[2] = b0.z; cb[3] = b0.w; cb[4] = b1.x; cb[5] = b1.y; cb[6] = b1.z; cb[7] = b1.w; }
                const bf16x8 whi = *(const bf16x8*)(wh + k0), wlo = *(const bf16x8*)(wh + 32 * 1024 + k0);
#pragma unroll
                for (int mt = 0; mt < 2; ++mt) {
                    const float* xr = src + (size_t)(tb0 + 32 * mt + ql) * D + k0;
                    const f32x4 x0 = *(const f32x4*)xr, x1 = *(const f32x4*)(xr + 4);
                    const float rs = mt ? rs1 : rs0;
                    const float xv[8] = {x0.x, x0.y, x0.z, x0.w, x1.x, x1.y, x1.z, x1.w};
                    float u[8]; unsigned hi[8];
#pragma unroll
                    for (int q = 0; q < 8; ++q) { u[q] = xv[q] * rs * ca[q] + cb[q]; hi[q] = f2bf(u[q]); u[q] -= __uint_as_float(hi[q] << 16); }
                    u32x4 oh, ol; oh.x = hi[0] | (hi[1] << 16); oh.y = hi[2] | (hi[3] << 16); oh.z = hi[4] | (hi[5] << 16); oh.w = hi[6] | (hi[7] << 16);
                    ol.x = pk2(u[0], u[1]); ol.y = pk2(u[2], u[3]); ol.z = pk2(u[4], u[5]); ol.w = pk2(u[6], u[7]);
                    const bf16x8 ah = __builtin_bit_cast(bf16x8, oh), al = __builtin_bit_cast(bf16x8, ol);
                    if (mt == 0) { acc0 = __builtin_amdgcn_mfma_f32_32x32x16_bf16(ah, whi, acc0, 0, 0, 0); acc0 = __builtin_amdgcn_mfma_f32_32x32x16_bf16(al, whi, acc0, 0, 0, 0); acc0 = __builtin_amdgcn_mfma_f32_32x32x16_bf16(ah, wlo, acc0, 0, 0, 0); }
                    else { acc1 = __builtin_amdgcn_mfma_f32_32x32x16_bf16(ah, whi, acc1, 0, 0, 0); acc1 = __builtin_amdgcn_mfma_f32_32x32x16_bf16(al, whi, acc1, 0, 0, 0); acc1 = __builtin_amdgcn_mfma_f32_32x32x16_bf16(ah, wlo, acc1, 0, 0, 0); }
                }
            }
#pragma unroll
            for (int i = 0; i < 16; ++i) { const int row = 8 * (i >> 2) + 4 * hf + (i & 3); part[(w * 64 + row) * 32 + ql] = acc0[i]; part[(w * 64 + 32 + row) * 32 + ql] = acc1[i]; }
        }
        __syncthreads();
        {
            const int e = lane & 31, hf = lane >> 5;
            LAS unsigned* lcnt = (LAS unsigned*)(X.lds + 1024 + 65536);
            int ev[4], lp[4]; float wv[4];
#pragma unroll
            for (int k = 0; k < 4; ++k) {
                const int tl = 8 * w + 4 * hf + k;
                float v = 0.f;
#pragma unroll
                for (int ww = 0; ww < 8; ++ww) v += part[(ww * 64 + tl) * 32 + e];
                if (MODE == 0) route_select(v + p.in[25][l * NE + e], lane, lcnt, ev[k], wv[k], lp[k]);
                else ((float*)(X.ws + WS_DT))[(size_t)(tb0 + tl) * 32 + e] = v;
            }
            if (MODE == 0) {
                __syncthreads();
                if (X.tid < 32) { const unsigned n = lcnt[X.tid]; unsigned* cnt = (unsigned*)(X.ws + WS_CTL) + CW_CNT + (l * 32 + X.tid) * 32;
                    lcnt[32 + X.tid] = n ? atomicAdd(cnt, n) : 0u; }
                __syncthreads();
                if (e < 4) {
#pragma unroll
                    for (int k = 0; k < 4; ++k) { const int t = tb0 + 8 * w + 4 * hf + k, pos = (int)lcnt[32 + ev[k]] + lp[k];
                        ((int*)(X.ws + WS_TOKE))[t * 4 + e] = ev[k]; ((float*)(X.ws + WS_TOKW))[t * 4 + e] = wv[k]; ((int*)(X.ws + WS_TOKP))[t * 4 + e] = pos;
                        ((int*)(X.ws + WS_SLOT))[ev[k] * CAP + pos] = t; }
                }
            }
        }
        __syncthreads();
        if (MODE == 0 && X.tid < 32) ((LAS unsigned*)(X.lds + 1024 + 65536))[X.tid] = 0u;
    }
}

__device__ __forceinline__ void ld64bf(const bf16_t* p, float (&q)[64]) {
#pragma unroll
    for (int i = 0; i < 8; ++i) { const u32x4 w = ((const u32x4*)p)[i];
        q[8 * i] = bflo(w.x); q[8 * i + 1] = bfhi(w.x); q[8 * i + 2] = bflo(w.y); q[8 * i + 3] = bfhi(w.y); q[8 * i + 4] = bflo(w.z); q[8 * i + 5] = bfhi(w.z); q[8 * i + 6] = bflo(w.w); q[8 * i + 7] = bfhi(w.w); }
}
__device__ __forceinline__ float dot64bf(const bf16_t* p, const float (&q)[64]) {
    float d = 0.f;
#pragma unroll
    for (int i = 0; i < 8; ++i) { const u32x4 w = ((const u32x4*)p)[i];
        d += q[8 * i] * bflo(w.x) + q[8 * i + 1] * bfhi(w.x) + q[8 * i + 2] * bflo(w.y) + q[8 * i + 3] * bfhi(w.y) + q[8 * i + 4] * bflo(w.z) + q[8 * i + 5] * bfhi(w.z) + q[8 * i + 6] * bflo(w.w) + q[8 * i + 7] * bfhi(w.w); }
    return d;
}
__device__ __forceinline__ float dot64f(const float* p, const float (&q)[64]) {
    float d = 0.f;
#pragma unroll
    for (int i = 0; i < 16; ++i) { const f32x4 w = ((const f32x4*)p)[i]; d += (q[4 * i] * w.x + q[4 * i + 1] * w.y) + (q[4 * i + 2] * w.z + q[4 * i + 3] * w.w); }
    return d;
}
__device__ __forceinline__ void sb_unit(const Ctx& X, int qt, int bh) {
    const int b = bh >> 3, hh = bh & 7, t = qt * 64 + X.lane;
    const bf16_t* base = (const bf16_t*)(X.ws + WS_BIG) + (size_t)b * S * PROJ_LD;
    float q[64], acc[64];
    ld64bf(base + (size_t)t * PROJ_LD + OFF_SBQ + hh * 64, q);
#pragma unroll
    for (int d = 0; d < 64; ++d) acc[d] = 0.f;
    float run = 0.f;
    for (int j = qt * 64 + 62; j >= 0; --j) {
        const bf16_t* kr = base + (size_t)j * PROJ_LD + OFF_SBK + hh * 64;
        const float logit = dot64bf(kr, q) * 0.125f;
        if (j < t) {
            const float w = expf(logsig(logit) + run);
            run += logsig(-logit);
            const bf16_t* vr = base + (size_t)j * PROJ_LD + OFF_SBV + hh * 64;
#pragma unroll
            for (int i = 0; i < 8; ++i) { const u32x4 v = ((const u32x4*)vr)[i];
                acc[8 * i] += w * bflo(v.x); acc[8 * i + 1] += w * bfhi(v.x); acc[8 * i + 2] += w * bflo(v.y); acc[8 * i + 3] += w * bfhi(v.y);
                acc[8 * i + 4] += w * bflo(v.z); acc[8 * i + 5] += w * bfhi(v.z); acc[8 * i + 6] += w * bflo(v.w); acc[8 * i + 7] += w * bfhi(v.w); }
        }
    }
    bf16_t* op = (bf16_t*)(X.ws + WS_O) + (size_t)(b * S + t) * D + hh * 64;
#pragma unroll
    for (int i = 0; i < 8; ++i) { u32x4 w; w.x = pk2(acc[8 * i], acc[8 * i + 1]); w.y = pk2(acc[8 * i + 2], acc[8 * i + 3]); w.z = pk2(acc[8 * i + 4], acc[8 * i + 5]); w.w = pk2(acc[8 * i + 6], acc[8 * i + 7]);
        ((u32x4*)op)[i] = w; }
}

#define DMA16(gptr, ldsptr) __builtin_amdgcn_global_load_lds((const unsigned*)(gptr), (LAS unsigned*)(ldsptr), 16, 0, 0)
#define RING_WAIT_BAR(rem) do { if ((rem) >= 2) asm volatile("s_waitcnt vmcnt(4)\n\ts_barrier" ::: "memory"); else if ((rem) == 1) asm volatile("s_waitcnt vmcnt(2)\n\ts_barrier" ::: "memory"); \
                                else asm volatile("s_waitcnt vmcnt(0)\n\ts_barrier" ::: "memory"); } while (0)
__device__ __forceinline__ int pi32(int r) { return (r & 0x13) | ((r & 4) << 1) | ((r & 8) >> 1); }
__device__ __forceinline__ void sb_attn_unit(const Ctx& X, int bh, int qb) {
    const int b = bh >> 3, h = bh & 7, q0 = qb * 256, lane = fresh(X.lane), w = X.wave, ql = lane & 31, hf = lane >> 5;
    const bf16_t* proj = (const bf16_t*)(X.ws + WS_BIG) + (size_t)b * S * PROJ_LD;
    const bf16_t* vt = (const bf16_t*)(X.ws + WS_VT) + (size_t)(h * 64) * T + (size_t)b * S;
    const int tq = q0 + 32 * w + ql;
    bf16x8 qf[4];
#pragma unroll
    for (int s = 0; s < 4; ++s) qf[s] = *(const bf16x8*)(proj + (size_t)tq * PROJ_LD + OFF_SBQ + h * 64 + 16 * s + 8 * hf);
    f32x16 o0, o1;
#pragma unroll
    for (int i = 0; i < 16; ++i) { o0[i] = 0.f; o1[i] = 0.f; }
    float run = 1.f;
    const int nblk = 4 * qb + 4, jw = (q0 + 32 * w + 30) >> 6;
    const float CS = 0.125f * 1.4426950408889634f;
    const bf16_t* kg = proj + (size_t)lane * PROJ_LD + OFF_SBK + h * 64 + 8 * w;
    const bf16_t* vg = vt + (size_t)lane * T + 8 * w;
    LAS unsigned char* ring = X.lds + w * 1024;
    const int krow = pi32(ql) * 16;
    asm volatile("s_waitcnt vmcnt(0)" ::: "memory");
#pragma unroll
    for (int d = 0; d < 3; ++d) if (d < nblk) { DMA16(kg + (size_t)(64 * (nblk - 1 - d)) * PROJ_LD, ring + d * 16384); DMA16(vg + 64 * (nblk - 1 - d), ring + d * 16384 + 8192); }
    for (int j = nblk - 1; j >= 0; --j) {
        RING_WAIT_BAR(j);
        if (j >= 3) { const int sl = (nblk - 1 - (j - 3)) & 3; DMA16(kg + (size_t)(64 * (j - 3)) * PROJ_LD, ring + sl * 16384); DMA16(vg + 64 * (j - 3), ring + sl * 16384 + 8192); }
        LAS unsigned char* buf = X.lds + ((nblk - 1 - j) & 3) * 16384;
        if (j <= jw) {
            const bool diag = 64 * j + 63 >= q0 + 32 * w;
#pragma unroll
            for (int kt = 1; kt >= 0; --kt) {
                f32x16 sc;
#pragma unroll
                for (int i = 0; i < 16; ++i) sc[i] = 0.f;
#pragma unroll
                for (int s = 0; s < 4; ++s) { const bf16x8 kf = *(const LAS bf16x8*)(buf + (2 * s + hf) * 1024 + kt * 512 + krow); sc = __builtin_amdgcn_mfma_f32_32x32x16_bf16(kf, qf[s], sc, 0, 0, 0); }
                f32x16 ee = sc * (-CS), be, kp;
#pragma unroll
                for (int i = 0; i < 16; ++i) ee[i] = __builtin_amdgcn_exp2f(ee[i]);
                be = ee + 1.f;
#pragma unroll
                for (int i = 0; i < 16; ++i) be[i] = __builtin_amdgcn_rcpf(be[i]);
                kp = ee * be;
                if (diag) {
                    const int pos0 = 64 * j + 32 * kt + 8 * hf;
#pragma unroll
                    for (int i = 0; i < 16; ++i) { const bool valid = (pos0 + 16 * (i >> 3) + (i & 7)) < tq; be[i] = valid ? be[i] : 0.f; kp[i] = valid ? kp[i] : 1.f; }
                }
                float l1 = 1.f, l0 = 1.f;
#pragma unroll
                for (int i = 15; i >= 8; --i) { const float t = be[i] * l1; l1 *= kp[i]; be[i] = t; }
#pragma unroll
                for (int i = 7; i >= 0; --i) { const float t = be[i] * l0; l0 *= kp[i]; be[i] = t; }
                const float p1 = __shfl_xor(l1, 32), p0 = __shfl_xor(l0, 32);
                const float hi1 = hf ? l1 : p1, lo1 = hf ? p1 : l1, hi0 = hf ? l0 : p0, lo0 = hf ? p0 : l0;
                const float r1 = run * hi1, r2 = r1 * lo1, r3 = r2 * hi0;
                const float pre_up = hf ? run : r1, pre_lo = hf ? r2 : r3;
                run = r3 * lo0;
#pragma unroll
                for (int a = 0; a < 2; ++a) {
                    const float pre = a ? pre_up : pre_lo;
                    u32x4 pw; pw.x = pk2(be[8 * a] * pre, be[8 * a + 1] * pre); pw.y = pk2(be[8 * a + 2] * pre, be[8 * a + 3] * pre); pw.z = pk2(be[8 * a + 4] * pre, be[8 * a + 5] * pre); pw.w = pk2(be[8 * a + 6] * pre, be[8 * a + 7] * pre);
                    const bf16x8 pf = __builtin_bit_cast(bf16x8, pw);
                    const bf16x8 v0 = *(const LAS bf16x8*)(buf + 8192 + (4 * kt + 2 * a + hf) * 1024 + ql * 16);
                    const bf16x8 v1 = *(const LAS bf16x8*)(buf + 8192 + (4 * kt + 2 * a + hf) * 1024 + 512 + ql * 16);
                    o0 = __builtin_amdgcn_mfma_f32_32x32x16_bf16(v0, pf, o0, 0, 0, 0);
                    o1 = __builtin_amdgcn_mfma_f32_32x32x16_bf16(v1, pf, o1, 0, 0, 0);
                }
            }
        }
    }
    asm volatile("s_barrier" ::: "memory");
    bf16_t* op = (bf16_t*)(X.ws + WS_O) + (size_t)(b * S + fresh(tq)) * D + h * 64 + 4 * hf;
#pragma unroll
    for (int g4 = 0; g4 < 4; ++g4) {
        u32x2 w0; w0.x = pk2(o0[4 * g4], o0[4 * g4 + 1]); w0.y = pk2(o0[4 * g4 + 2], o0[4 * g4 + 3]); *(u32x2*)(op + 8 * g4) = w0;
        u32x2 w1; w1.x = pk2(o1[4 * g4], o1[4 * g4 + 1]); w1.y = pk2(o1[4 * g4 + 2], o1[4 * g4 + 3]); *(u32x2*)(op + 32 + 8 * g4) = w1;
    }
}
__device__ __forceinline__ void ph_sb(const Ctx& X) {
    for (int pr = X.bid; pr < 256; pr += X.G)
#pragma unroll 1
        for (int u = 0; u < 2; ++u) { const int bh = pr >> 3, qa = pr & 7; sb_attn_unit(X, bh, u ? qa : 15 - qa); }
}
__device__ __forceinline__ void ph_attn_a(const Params& p, const Ctx& X) {
    const bf16_t* proj = (const bf16_t*)(X.ws + WS_BIG);
    for (int unit = X.bid; unit < 128; unit += X.G) {
        const int kv = unit >> 6, bg = (unit >> 3) & 7, ntile = unit & 7, b = bg >> 1, g = bg & 1, lane = fresh(X.lane), w = X.wave, ql = lane & 31, hf = lane >> 5;
        const int n = min(32 * ntile + ql, NCMP - 1);
        const float* pe = kv ? p.in[11] : p.in[10];
        const bf16_t* w1t = (const bf16_t*)(X.ws + WS_W1T) + (size_t)kv * 128 * 2048;
        const bf16_t* arow = proj + (size_t)(b * S + n * 16) * PROJ_LD + (kv ? OFF_VC : OFF_KC) + g * 64;
        f32x16 acc[4];
#pragma unroll
        for (int ct = 0; ct < 4; ++ct)
#pragma unroll
            for (int i = 0; i < 16; ++i) acc[ct][i] = 0.f;
        for (int ks = 0; ks < 16; ++ks) {
            const int k0 = 256 * w + 16 * ks + 8 * hf, l = k0 >> 6, d = k0 & 63;
            const u32x4 q = *(const u32x4*)(arow + (size_t)l * PROJ_LD + d);
            const f32x4 e0 = *(const f32x4*)(pe + k0), e1 = *(const f32x4*)(pe + k0 + 4);
            u32x4 o; o.x = pk2(bflo(q.x) + e0.x, bfhi(q.x) + e0.y); o.y = pk2(bflo(q.y) + e0.z, bfhi(q.y) + e0.w); o.z = pk2(bflo(q.z) + e1.x, bfhi(q.z) + e1.y); o.w = pk2(bflo(q.w) + e1.z, bfhi(q.w) + e1.w);
            const bf16x8 af = __builtin_bit_cast(bf16x8, o);
#pragma unroll
            for (int ct = 0; ct < 4; ++ct) acc[ct] = __builtin_amdgcn_mfma_f32_32x32x16_bf16(af, *(const bf16x8*)(w1t + (size_t)(32 * ct + ql) * 2048 + k0), acc[ct], 0, 0, 0);
        }
        LAS float* part = (LAS float*)X.lds;
#pragma unroll
        for (int ct = 0; ct < 4; ++ct)
#pragma unroll
            for (int i = 0; i < 16; ++i) part[w * 4096 + (8 * (i >> 2) + 4 * hf + (i & 3)) * 128 + 32 * ct + ql] = acc[ct][i];
        __syncthreads();
        LAS float* hid = part;
        {
            const int tidf = fresh(X.tid);
#pragma unroll
            for (int k = 0; k < 8; ++k) { const int e = tidf + NTHREADS * k; float v = 0.f;
#pragma unroll
                for (int ww = 0; ww < 8; ++ww) v += part[ww * 4096 + e];
                hid[e] = siluf(v); }
        }
        __syncthreads();
        {
            const int tidf = fresh(X.tid), row = tidf >> 4, c4 = (tidf & 15) * 4;
            const float* w2 = kv ? p.in[15] : p.in[13];
            f32x4 o = (f32x4){0.f, 0.f, 0.f, 0.f};
            for (int j = 0; j < 128; ++j) o = o + *(const f32x4*)(w2 + j * 64 + c4) * hid[row * 128 + j];
            const int nn = 32 * ntile + row;
            if (kv == 0) {
                float ssq = (o.x * o.x + o.y * o.y) + (o.z * o.z + o.w * o.w);
                ssq += __shfl_xor(ssq, 1); ssq += __shfl_xor(ssq, 2); ssq += __shfl_xor(ssq, 4); ssq += __shfl_xor(ssq, 8);
                const float r = rsqrtf(ssq * (1.f / 64.f) + EPS); const f32x4 gn = *(const f32x4*)(p.in[9] + c4);
                o = o * r * gn;
                if (nn >= NCMP) o = (f32x4){0.f, 0.f, 0.f, 0.f};
                u32x2 wv; wv.x = pk2(o.x, o.y); wv.y = pk2(o.z, o.w);
                *(u32x2*)((bf16_t*)(X.ws + WS_KCB) + ((size_t)bg * 256 + nn) * 64 + c4) = wv;
            } else {
                if (nn >= NCMP) o = (f32x4){0.f, 0.f, 0.f, 0.f};
                bf16_t* vt = (bf16_t*)(X.ws + WS_VCT) + ((size_t)bg * 64 + c4) * 256 + nn;
                vt[0] = (bf16_t)f2bf(o.x); vt[256] = (bf16_t)f2bf(o.y); vt[512] = (bf16_t)f2bf(o.z); vt[768] = (bf16_t)f2bf(o.w);
            }
        }
        __syncthreads();
    }
    for (int t2 = X.gw; t2 < T / 2; t2 += X.ngw) {
        const int lane = fresh(X.lane), sub = lane & 7;
#pragma unroll
        for (int k = 0; k < 2; ++k) {
            const int t = 2 * t2 + k;
            const u32x4 q = *(const u32x4*)(proj + (size_t)t * PROJ_LD + OFF_NQ + 8 * lane);
            float v[8] = {bflo(q.x), bfhi(q.x), bflo(q.y), bfhi(q.y), bflo(q.z), bfhi(q.z), bflo(q.w), bfhi(q.w)};
            float ssq = 0.f;
#pragma unroll
            for (int i = 0; i < 8; ++i) ssq += v[i] * v[i];
            ssq += __shfl_xor(ssq, 1); ssq += __shfl_xor(ssq, 2); ssq += __shfl_xor(ssq, 4);
            const float r = rsqrtf(ssq * (1.f / 64.f) + EPS) * (0.125f * 1.4426950408889634f);
            const f32x4 g0 = *(const f32x4*)(p.in[8] + 8 * sub), g1 = *(const f32x4*)(p.in[8] + 8 * sub + 4);
            u32x4 o; o.x = pk2(v[0] * r * g0.x, v[1] * r * g0.y); o.y = pk2(v[2] * r * g0.z, v[3] * r * g0.w); o.z = pk2(v[4] * r * g1.x, v[5] * r * g1.y); o.w = pk2(v[6] * r * g1.z, v[7] * r * g1.w);
            *(u32x4*)((bf16_t*)(X.ws + WS_QNB) + (size_t)t * 512 + 8 * lane) = o;
        }
        {
            const int t = 2 * t2 + (lane >> 5), l32 = lane & 31, isw = l32 >> 4, c = 8 * (l32 & 15);
            const u32x4 q = *(const u32x4*)(proj + (size_t)t * PROJ_LD + (isw ? OFF_KW : OFF_KS) + c);
            float v[8] = {bflo(q.x), bfhi(q.x), bflo(q.y), bfhi(q.y), bflo(q.z), bfhi(q.z), bflo(q.w), bfhi(q.w)};
            float ssq = 0.f;
#pragma unroll
            for (int i = 0; i < 8; ++i) ssq += v[i] * v[i];
            ssq += __shfl_xor(ssq, 1); ssq += __shfl_xor(ssq, 2); ssq += __shfl_xor(ssq, 4);
            const float r = rsqrtf(ssq * (1.f / 64.f) + EPS);
            const float* gn = p.in[9] + (isw ? 128 : 64) + 8 * sub;
            const f32x4 g0 = *(const f32x4*)gn, g1 = *(const f32x4*)(gn + 4);
            u32x4 o; o.x = pk2(v[0] * r * g0.x, v[1] * r * g0.y); o.y = pk2(v[2] * r * g0.z, v[3] * r * g0.w); o.z = pk2(v[4] * r * g1.x, v[5] * r * g1.y); o.w = pk2(v[6] * r * g1.z, v[7] * r * g1.w);
            *(u32x4*)((bf16_t*)(X.ws + (isw ? WS_KWN : WS_KSN)) + (size_t)t * 128 + c) = o;
        }
    }
}
struct NsaSt { f32x16 o0, o1; float m, l; };
template <int MODE>
__device__ __forceinline__ void nsa_flash(const Ctx& X, const bf16_t* kg, const bf16_t* vg, int jlo, int jhi, const bf16x8 (&qf)[4], int tq, float slope2,
                                          unsigned long long mymask, unsigned long long wavemask, NsaSt& st) {
    const int lane = fresh(X.lane), w = X.wave, ql = lane & 31, hf = lane >> 5;
    LAS unsigned char* ring = X.lds + w * 1024;
    const int krow = pi32(ql) * 16, nb = jhi - jlo + 1;
    asm volatile("s_waitcnt vmcnt(0)" ::: "memory");
#pragma unroll
    for (int d = 0; d < 3; ++d) if (d < nb) { DMA16(kg + (size_t)(64 * (jhi - d)) * 128, ring + d * 16384); DMA16(vg + 64 * (jhi - d), ring + d * 16384 + 8192); }
    f32x16 sl;
#pragma unroll
    for (int i = 0; i < 16; ++i) sl[i] = slope2 * (float)(16 * (i >> 3) + (i & 7));
    const float k32 = slope2 * 32.f;
    for (int j = jhi; j >= jlo; --j) {
        RING_WAIT_BAR(j - jlo);
        if (j - jlo >= 3) { const int sl = (jhi - (j - 3)) & 3; DMA16(kg + (size_t)(64 * (j - 3)) * 128, ring + sl * 16384); DMA16(vg + 64 * (j - 3), ring + sl * 16384 + 8192); }
        LAS unsigned char* buf = X.lds + ((jhi - j) & 3) * 16384;
        if (MODE == 1 || ((wavemask >> j) & 1ull)) {
            f32x16 s0, s1;
#pragma unroll
            for (int i = 0; i < 16; ++i) { s0[i] = 0.f; s1[i] = 0.f; }
#pragma unroll
            for (int s = 0; s < 4; ++s) {
                const bf16x8 k0 = *(const LAS bf16x8*)(buf + (2 * s + hf) * 1024 + krow), k1 = *(const LAS bf16x8*)(buf + (2 * s + hf) * 1024 + 512 + krow);
                s0 = __builtin_amdgcn_mfma_f32_32x32x16_bf16(k0, qf[s], s0, 0, 0, 0); s1 = __builtin_amdgcn_mfma_f32_32x32x16_bf16(k1, qf[s], s1, 0, 0, 0);
            }
            const int d0 = tq - (64 * j + 8 * hf);
            if (j == jhi || (MODE == 1 && j == jlo)) {
#pragma unroll
                for (int i = 0; i < 16; ++i) {
                    const int da = d0 - (16 * (i >> 3) + (i & 7)), db = da - 32;
                    s0[i] = (da >= 0 && (MODE == 0 || da < 512)) ? s0[i] : -INFINITY; s1[i] = (db >= 0 && (MODE == 0 || db < 512)) ? s1[i] : -INFINITY;
                }
            }
            s0 = s0 + sl; s1 = s1 + sl;
            float mb0 = fmaxf(s0[0], s0[1]), mb1 = fmaxf(s1[0], s1[1]);
#pragma unroll
            for (int i = 2; i < 16; ++i) { mb0 = fmaxf(mb0, s0[i]); mb1 = fmaxf(mb1, s1[i]); }
            const float base = slope2 * (float)d0;
            const bool sel = MODE == 1 || ((mymask >> j) & 1ull);
            float mb = fmaxf(mb0, mb1 + k32) - base;
            mb = sel ? mb : -INFINITY;
            mb = fmaxf(mb, __shfl_xor(mb, 32));
            const float mn = fmaxf(st.m, mb), ms = mn == -INFINITY ? 0.f : mn;
            if (__any(mn > st.m)) {
                const float alpha = __builtin_amdgcn_exp2f(st.m - ms);
                st.l *= alpha;
#pragma unroll
                for (int i = 0; i < 16; ++i) { st.o0[i] *= alpha; st.o1[i] *= alpha; }
                st.m = mn;
            }
            const float off0 = sel ? ms + base : INFINITY, off1 = off0 - k32;
            s0 = s0 - off0; s1 = s1 - off1;
            float ls = 0.f;
#pragma unroll
            for (int i = 0; i < 16; ++i) { s0[i] = __builtin_amdgcn_exp2f(s0[i]); s1[i] = __builtin_amdgcn_exp2f(s1[i]); ls += s0[i] + s1[i]; }
            st.l += ls;
#pragma unroll
            for (int kt = 0; kt < 2; ++kt)
#pragma unroll
                for (int a = 0; a < 2; ++a) {
                    u32x4 pw;
                    if (kt == 0) { pw.x = pk2(s0[8 * a], s0[8 * a + 1]); pw.y = pk2(s0[8 * a + 2], s0[8 * a + 3]); pw.z = pk2(s0[8 * a + 4], s0[8 * a + 5]); pw.w = pk2(s0[8 * a + 6], s0[8 * a + 7]); }
                    else { pw.x = pk2(s1[8 * a], s1[8 * a + 1]); pw.y = pk2(s1[8 * a + 2], s1[8 * a + 3]); pw.z = pk2(s1[8 * a + 4], s1[8 * a + 5]); pw.w = pk2(s1[8 * a + 6], s1[8 * a + 7]); }
                    const bf16x8 pf = __builtin_bit_cast(bf16x8, pw);
                    const bf16x8 v0 = *(const LAS bf16x8*)(buf + 8192 + (4 * kt + 2 * a + hf) * 1024 + ql * 16);
                    const bf16x8 v1 = *(const LAS bf16x8*)(buf + 8192 + (4 * kt + 2 * a + hf) * 1024 + 512 + ql * 16);
                    st.o0 = __builtin_amdgcn_mfma_f32_32x32x16_bf16(v0, pf, st.o0, 0, 0, 0);
                    st.o1 = __builtin_amdgcn_mfma_f32_32x32x16_bf16(v1, pf, st.o1, 0, 0, 0);
                }
        }
    }
    asm volatile("s_barrier" ::: "memory");
}
__device__ __forceinline__ void nsa_unit(const Ctx& X, int bg, int qb) {
    const int b = bg >> 1, g = bg & 1, lane = fresh(X.lane), w = X.wave, ql = lane & 31, hf = lane >> 5, r = ql >> 3, hh = g * 4 + r;
    const int t0 = 64 * qb, tq = t0 + 8 * w + (ql & 7);
    const float slope2 = exp2f(-(float)(hh + 1)) * 1.4426950408889634f;
    const bf16_t* proj = (const bf16_t*)(X.ws + WS_BIG);
    bf16x8 qf[4];
    { const bf16_t* qp = (const bf16_t*)(X.ws + WS_QNB) + (size_t)(b * S + tq) * 512 + hh * 64 + 8 * hf;
#pragma unroll
      for (int s = 0; s < 4; ++s) qf[s] = *(const bf16x8*)(qp + 16 * s); }
    float gate[3];
    { const bf16_t* gp = proj + (size_t)(b * S + tq) * PROJ_LD + OFF_GATE + hh * 3;
#pragma unroll
      for (int i = 0; i < 3; ++i) gate[i] = 1.f / (1.f + __expf(-bf2f(gp[i]))); }
    f32x16 of0, of1;
#pragma unroll
    for (int i = 0; i < 16; ++i) { of0[i] = 0.f; of1[i] = 0.f; }
    NsaSt st;
    LAS float* pacc = (LAS float*)(X.lds + 65536) + w * 2048;
    {
        const int ncm = t0 + 63 >= 31 ? (t0 + 63 - 31) / 16 + 1 : 0, nt = (ncm + 31) >> 5, ncv = tq >= 31 ? (tq - 31) / 16 + 1 : 0;
        {
            const bf16_t* kc = (const bf16_t*)(X.ws + WS_KCB) + (size_t)bg * 256 * 64; const bf16_t* vc = (const bf16_t*)(X.ws + WS_VCT) + (size_t)bg * 64 * 256;
            const int tidf = fresh(X.tid);
#pragma unroll
            for (int i = 0; i < 4; ++i) { const int pidx = tidf + NTHREADS * i;
                *(LAS u32x4*)(X.lds + (pidx >> 8) * 4096 + (pidx & 255) * 16) = *(const u32x4*)(kc + (size_t)(pidx & 255) * 64 + 8 * (pidx >> 8));
                *(LAS u32x4*)(X.lds + 32768 + (pidx >> 6) * 1024 + (pidx & 63) * 16) = *(const u32x4*)(vc + (size_t)(pidx & 63) * 256 + 8 * (pidx >> 6)); }
#pragma unroll
            for (int i = 0; i < 8; ++i) *(LAS f32x4*)(pacc + (i * 64 + lane) * 4) = (f32x4){0.f, 0.f, 0.f, 0.f};
        }
        __syncthreads();
        const int krow = pi32(ql) * 16;
        float ml = -INFINITY, ll = 0.f;
        for (int kt = 0; kt < nt; ++kt) {
            f32x16 sc;
#pragma unroll
            for (int i = 0; i < 16; ++i) sc[i] = 0.f;
#pragma unroll
            for (int s = 0; s < 4; ++s) { const bf16x8 kf = *(const LAS bf16x8*)(X.lds + (2 * s + hf) * 4096 + kt * 512 + krow); sc = __builtin_amdgcn_mfma_f32_32x32x16_bf16(kf, qf[s], sc, 0, 0, 0); }
            float tm = -INFINITY;
#pragma unroll
            for (int i = 0; i < 16; ++i) { const int n = 32 * kt + 16 * (i >> 3) + 8 * hf + (i & 7);
                sc[i] = n < ncv ? sc[i] - slope2 * (float)(tq - (16 * n + 31)) : -INFINITY; tm = fmaxf(tm, sc[i]); }
            const float mn = fmaxf(ml, tm), ms = mn == -INFINITY ? 0.f : mn;
            float ls = 0.f;
#pragma unroll
            for (int i = 0; i < 16; ++i) ls += __builtin_amdgcn_exp2f(sc[i] - ms);
            ll = ll * __builtin_amdgcn_exp2f(ml - ms) + ls; ml = mn;
        }
        float ms, inv;
        { const float mo = __shfl_xor(ml, 32), lo = __shfl_xor(ll, 32), mt = fmaxf(ml, mo); ms = mt == -INFINITY ? 0.f : mt;
          const float lt = ll * __builtin_amdgcn_exp2f(ml - ms) + lo * __builtin_amdgcn_exp2f(mo - ms); inv = lt > 0.f ? 1.f / lt : 0.f; }
#pragma unroll
        for (int i = 0; i < 16; ++i) { st.o0[i] = 0.f; st.o1[i] = 0.f; }
        float carry = 0.f;
        for (int kt = 0; kt < nt; ++kt) {
            f32x16 sc;
#pragma unroll
            for (int i = 0; i < 16; ++i) sc[i] = 0.f;
#pragma unroll
            for (int s = 0; s < 4; ++s) { const bf16x8 kf = *(const LAS bf16x8*)(X.lds + (2 * s + hf) * 4096 + kt * 512 + krow); sc = __builtin_amdgcn_mfma_f32_32x32x16_bf16(kf, qf[s], sc, 0, 0, 0); }
#pragma unroll
            for (int i = 0; i < 16; ++i) { const int n = 32 * kt + 16 * (i >> 3) + 8 * hf + (i & 7);
                sc[i] = n < ncv ? __builtin_amdgcn_exp2f(sc[i] - slope2 * (float)(tq - (16 * n + 31)) - ms) * inv : 0.f; }
            const float pa0 = __shfl_xor(sc[7], 32), pa1 = __shfl_xor(sc[15], 32);
            const float prev0 = hf ? pa0 : carry, prev1 = hf ? pa1 : pa0;
            carry = pa1;
            {
                typedef float f32x2 __attribute__((ext_vector_type(2)));
                f32x2 e0, e1;
                e0.x = prev0 + ((sc[0] + sc[1]) + (sc[2] + sc[3])); e0.y = sc[3] + ((sc[4] + sc[5]) + (sc[6] + sc[7]));
                e1.x = prev1 + ((sc[8] + sc[9]) + (sc[10] + sc[11])); e1.y = sc[11] + ((sc[12] + sc[13]) + (sc[14] + sc[15]));
                *(LAS f32x2*)(pacc + ql * 64 + 8 * kt + 2 * hf) = e0; *(LAS f32x2*)(pacc + ql * 64 + 8 * kt + 4 + 2 * hf) = e1;
            }
#pragma unroll
            for (int a = 0; a < 2; ++a) {
                u32x4 pw; pw.x = pk2(sc[8 * a], sc[8 * a + 1]); pw.y = pk2(sc[8 * a + 2], sc[8 * a + 3]); pw.z = pk2(sc[8 * a + 4], sc[8 * a + 5]); pw.w = pk2(sc[8 * a + 6], sc[8 * a + 7]);
                const bf16x8 pf = __builtin_bit_cast(bf16x8, pw);
                const bf16x8 v0 = *(const LAS bf16x8*)(X.lds + 32768 + (4 * kt + 2 * a + hf) * 1024 + ql * 16);
                const bf16x8 v1 = *(const LAS bf16x8*)(X.lds + 32768 + (4 * kt + 2 * a + hf) * 1024 + 512 + ql * 16);
                st.o0 = __builtin_amdgcn_mfma_f32_32x32x16_bf16(v0, pf, st.o0, 0, 0, 0);
                st.o1 = __builtin_amdgcn_mfma_f32_32x32x16_bf16(v1, pf, st.o1, 0, 0, 0);
            }
        }
#pragma unroll
        for (int i = 0; i < 16; ++i) { of0[i] = gate[0] * st.o0[i]; of1[i] = gate[0] * st.o1[i]; }
    }
    unsigned long long mymask = 0ull, wavemask = 0ull;
    LDS_WAIT();
    for (int q8 = 0; q8 < 8; ++q8) {
        const int t = t0 + 8 * w + q8;
        const float ps = (pacc[(0 * 8 + q8) * 64 + lane] + pacc[(1 * 8 + q8) * 64 + lane]) + (pacc[(2 * 8 + q8) * 64 + lane] + pacc[(3 * 8 + q8) * 64 + lane]);
        const bool valid = lane * 64 <= t, forced = (lane == 0) || (lane == qb) || (lane == qb - 1);
        const float score = valid ? (forced ? 1e6f : ps) : -1e6f;
        int rank = 0;
#pragma unroll 4
        for (int i = 0; i < 64; ++i) { const float si = __builtin_amdgcn_readlane(score, i); rank += (si > score || (si == score && i < lane)) ? 1 : 0; }
        const unsigned long long mk = __ballot(rank < 16);
        wavemask |= mk; if ((ql & 7) == q8) mymask = mk;
    }
    __syncthreads();
    {
#pragma unroll
        for (int i = 0; i < 16; ++i) { st.o0[i] = 0.f; st.o1[i] = 0.f; }
        st.m = -INFINITY; st.l = 0.f;
        const int lf = fresh(lane);
        const bf16_t* kg = (const bf16_t*)(X.ws + WS_KSN) + ((size_t)b * S + lf) * 128 + g * 64 + 8 * w;
        const bf16_t* vg = (const bf16_t*)(X.ws + WS_VT) + (size_t)(512 + g * 64 + lf) * T + (size_t)b * S + 8 * w;
        nsa_flash<0>(X, kg, vg, 0, qb, qf, tq, slope2, mymask, wavemask, st);
        const float lt = st.l + __shfl_xor(st.l, 32), sc = gate[1] / fmaxf(lt, 1e-30f);
#pragma unroll
        for (int i = 0; i < 16; ++i) { of0[i] += sc * st.o0[i]; of1[i] += sc * st.o1[i]; }
    }
    {
#pragma unroll
        for (int i = 0; i < 16; ++i) { st.o0[i] = 0.f; st.o1[i] = 0.f; }
        st.m = -INFINITY; st.l = 0.f;
        const int lf = fresh(lane);
        const bf16_t* kg = (const bf16_t*)(X.ws + WS_KWN) + ((size_t)b * S + lf) * 128 + g * 64 + 8 * w;
        const bf16_t* vg = (const bf16_t*)(X.ws + WS_VT) + (size_t)(640 + g * 64 + lf) * T + (size_t)b * S + 8 * w;
        nsa_flash<1>(X, kg, vg, qb >= 8 ? qb - 8 : 0, qb, qf, tq, slope2, 0ull, 0ull, st);
        const float lt = st.l + __shfl_xor(st.l, 32), sc = gate[2] / fmaxf(lt, 1e-30f);
#pragma unroll
        for (int i = 0; i < 16; ++i) { of0[i] += sc * st.o0[i]; of1[i] += sc * st.o1[i]; }
    }
    bf16_t* op = (bf16_t*)(X.ws + WS_O) + (size_t)(b * S + fresh(tq)) * D + 512 + hh * 64 + 4 * hf;
#pragma unroll
    for (int g4 = 0; g4 < 4; ++g4) {
        u32x2 w0; w0.x = pk2(of0[4 * g4], of0[4 * g4 + 1]); w0.y = pk2(of0[4 * g4 + 2], of0[4 * g4 + 3]); *(u32x2*)(op + 8 * g4) = w0;
        u32x2 w1; w1.x = pk2(of1[4 * g4], of1[4 * g4 + 1]); w1.y = pk2(of1[4 * g4 + 2], of1[4 * g4 + 3]); *(u32x2*)(op + 32 + 8 * g4) = w1;
    }
}
__device__ __forceinline__ void ph_nsa(const Params& p, const Ctx& X) {
    for (int pr = X.bid; pr < 256; pr += X.G)
#pragma unroll 1
        for (int u = 0; u < 2; ++u) { const int bg = pr >> 5, qa = pr & 31; nsa_unit(X, bg, u ? qa : 63 - qa); }
}

__device__ __forceinline__ float silu_fast(float v) { return v * __builtin_amdgcn_rcpf(1.f + __expf(-v)); }
constexpr int S1_WL = RING_BYTES + 4096;
__device__ __forceinline__ void ph_ssd1(const Params& p, const Ctx& X) {
    const float* cw = p.in[17]; const float* cb = p.in[18];
    LAS float* wl = (LAS float*)(X.lds + S1_WL);
    LAS unsigned char* ldsB = X.lds;
    LAS unsigned char* ldsX = X.lds + 65536;
    for (int unit = X.bid; unit < 256; unit += X.G) {
        const int b = unit >> 6, c = (unit >> 2) & 15, g = unit & 3, tl0 = c * 256, lane = fresh(X.lane), w = X.wave, ql = lane & 31, hf = lane >> 5;
        const size_t t0 = (size_t)b * S + tl0;
        {
            const int h = g * 8 + w;
            const float a = -expf(p.in[20][h]), dtb = p.in[19][h];
            const float* dr = (const float*)(X.ws + WS_DT) + (t0 + 4 * lane) * 32 + h;
            float dt[4], cs[4];
#pragma unroll
            for (int k = 0; k < 4; ++k) { const float raw = dr[k * 32] + dtb; dt[k] = raw > 20.f ? raw : log1pf(expf(raw)); }
            cs[0] = dt[0] * a; cs[1] = cs[0] + dt[1] * a; cs[2] = cs[1] + dt[2] * a; cs[3] = cs[2] + dt[3] * a;
            float incl = cs[3];
#pragma unroll
            for (int o = 1; o < 64; o <<= 1) { const float u = __shfl_up(incl, o); if (lane >= o) incl += u; }
            const float excl = incl - cs[3], last = __shfl(incl, 63);
#pragma unroll
            for (int k = 0; k < 4; ++k) cs[k] += excl;
            *(f32x4*)((float*)(X.ws + WS_DT2) + (size_t)(b * 32 + h) * S + tl0 + 4 * lane) = (f32x4){dt[0], dt[1], dt[2], dt[3]};
            *(f32x4*)((float*)(X.ws + WS_CS) + (size_t)(b * 32 + h) * S + tl0 + 4 * lane) = (f32x4){cs[0], cs[1], cs[2], cs[3]};
            *(LAS f32x4*)(wl + w * 256 + 4 * lane) = (f32x4){dt[0] * __expf(last - cs[0]), dt[1] * __expf(last - cs[1]), dt[2] * __expf(last - cs[2]), dt[3] * __expf(last - cs[3])};
            if (lane == 63) ((float*)(X.ws + WS_DEC))[(b * 16 + c) * 32 + h] = __expf(last);
        }
        const bf16_t* xt = (const bf16_t*)(X.ws + WS_XT); bf16_t* xct = (bf16_t*)(X.ws + WS_XCT);
        const int tidf = fresh(X.tid);
#define CONV8(rin, chg, seg, o) do { const bf16_t* src_ = xt + (size_t)(rin) * T + t0 + 8 * (seg); const u32x4 cur_ = *(const u32x4*)src_; u32x4 prv_ = (u32x4){0u, 0u, 0u, 0u}; \
            if (tl0 + 8 * (seg) >= 8) prv_ = *(const u32x4*)(src_ - 8); \
            const float x_[11] = {bfhi(prv_.z), bflo(prv_.w), bfhi(prv_.w), bflo(cur_.x), bfhi(cur_.x), bflo(cur_.y), bfhi(cur_.y), bflo(cur_.z), bfhi(cur_.z), bflo(cur_.w), bfhi(cur_.w)}; \
            const float w0_ = cw[chg], w1_ = cw[CONV_DIM + (chg)], w2_ = cw[2 * CONV_DIM + (chg)], w3_ = cw[3 * CONV_DIM + (chg)], bb_ = cb[chg]; \
            _Pragma("unroll") for (int j_ = 0; j_ < 8; ++j_) o[j_] = silu_fast(bb_ + w0_ * x_[j_] + w1_ * x_[j_ + 1] + w2_ * x_[j_ + 2] + w3_ * x_[j_ + 3]); } while (0)
        {
#pragma unroll
            for (int k = 0; k < 8; ++k) {
                const int it = tidf + NTHREADS * k, n = it >> 5, seg = it & 31, chg = 2048 + g * 128 + n;
                float o[8]; CONV8(g * 128 + n, chg, seg, o);
                u32x4 ov; ov.x = pk2(o[0], o[1]); ov.y = pk2(o[2], o[3]); ov.z = pk2(o[4], o[5]); ov.w = pk2(o[6], o[7]);
                *(u32x4*)(xct + (size_t)chg * T + t0 + 8 * seg) = ov;
                *(LAS u32x4*)(ldsB + seg * 2048 + n * 16) = ov;
            }
            const bf16_t* zbc = (const bf16_t*)(X.ws + WS_ZBC); bf16_t* bcm = (bf16_t*)(X.ws + WS_BCM);
#pragma unroll 4
            for (int k = 0; k < 16; ++k) {
                const int it = tidf + NTHREADS * k, l = it >> 5, c8 = it & 31;
                const int col = (c8 < 16 ? g * 128 + 8 * c8 : 512 + g * 128 + 8 * (c8 - 16));
                float acc[8];
                { const f32x4 b0 = *(const f32x4*)(cb + 2048 + col), b1 = *(const f32x4*)(cb + 2048 + col + 4); acc[0] = b0.x; acc[1] = b0.y; acc[2] = b0.z; acc[3] = b0.w; acc[4] = b1.x; acc[5] = b1.y; acc[6] = b1.z; acc[7] = b1.w; }
#pragma unroll
                for (int ww = 0; ww < 4; ++ww) {
                    if (tl0 + l - 3 + ww < 0) continue;
                    const u32x4 q = *(const u32x4*)(zbc + (t0 + l - 3 + ww) * 3072 + 2048 + col);
                    const f32x4 k0 = *(const f32x4*)(cw + ww * CONV_DIM + 2048 + col), k1 = *(const f32x4*)(cw + ww * CONV_DIM + 2048 + col + 4);
                    acc[0] += bflo(q.x) * k0.x; acc[1] += bfhi(q.x) * k0.y; acc[2] += bflo(q.y) * k0.z; acc[3] += bfhi(q.y) * k0.w;
                    acc[4] += bflo(q.z) * k1.x; acc[5] += bfhi(q.z) * k1.y; acc[6] += bflo(q.w) * k1.z; acc[7] += bfhi(q.w) * k1.w;
                }
                u32x4 ov; ov.x = pk2(silu_fast(acc[0]), silu_fast(acc[1])); ov.y = pk2(silu_fast(acc[2]), silu_fast(acc[3])); ov.z = pk2(silu_fast(acc[4]), silu_fast(acc[5])); ov.w = pk2(silu_fast(acc[6]), silu_fast(acc[7]));
                *(u32x4*)(bcm + (t0 + l) * 1024 + col) = ov;
            }
        }
#pragma unroll 1
        for (int hg = 0; hg < 4; ++hg) {
            __syncthreads();
#pragma unroll
            for (int k = 0; k < 8; ++k) {
                const int it = tidf + NTHREADS * k, chl = it >> 5, seg = it & 31, h8 = 2 * hg + (chl >> 6), chg = g * 512 + h8 * 64 + (chl & 63);
                float o[8]; CONV8(1024 + chg, chg, seg, o);
                u32x4 ov; ov.x = pk2(o[0], o[1]); ov.y = pk2(o[2], o[3]); ov.z = pk2(o[4], o[5]); ov.w = pk2(o[6], o[7]);
                *(u32x4*)(xct + (size_t)chg * T + t0 + 8 * seg) = ov;
                const f32x4 wa = *(const LAS f32x4*)(wl + h8 * 256 + 8 * seg), wb = *(const LAS f32x4*)(wl + h8 * 256 + 8 * seg + 4);
                u32x4 os; os.x = pk2(o[0] * wa.x, o[1] * wa.y); os.y = pk2(o[2] * wa.z, o[3] * wa.w); os.z = pk2(o[4] * wb.x, o[5] * wb.y); os.w = pk2(o[6] * wb.z, o[7] * wb.w);
                *(LAS u32x4*)(ldsX + (chl >> 6) * 32768 + seg * 1024 + (chl & 63) * 16) = os;
            }
            __syncthreads();
            {
                const int hl = w >> 2, pt = (w >> 1) & 1, nt0 = 2 * (w & 1), h = g * 8 + 2 * hg + hl;
                f32x16 acc0, acc1;
#pragma unroll
                for (int i = 0; i < 16; ++i) { acc0[i] = 0.f; acc1[i] = 0.f; }
#pragma unroll 4
                for (int ks = 0; ks < 16; ++ks) {
                    const bf16x8 af = *(const LAS bf16x8*)(ldsX + hl * 32768 + (2 * ks + hf) * 1024 + (32 * pt + ql) * 16);
                    const bf16x8 b0 = *(const LAS bf16x8*)(ldsB + (2 * ks + hf) * 2048 + (32 * nt0 + ql) * 16), b1 = *(const LAS bf16x8*)(ldsB + (2 * ks + hf) * 2048 + (32 * nt0 + 32 + ql) * 16);
                    acc0 = __builtin_amdgcn_mfma_f32_32x32x16_bf16(af, b0, acc0, 0, 0, 0); acc1 = __builtin_amdgcn_mfma_f32_32x32x16_bf16(af, b1, acc1, 0, 0, 0);
                }
                float* st = (float*)(X.ws + WS_ST) + ((size_t)(b * 16 + c) * 32 + h) * 8192 + 32 * nt0 + ql;
#pragma unroll
                for (int i = 0; i < 16; ++i) { const int pr = 32 * pt + 8 * (i >> 2) + 4 * hf + (i & 3); st[pr * 128] = acc0[i]; st[pr * 128 + 32] = acc1[i]; }
            }
        }
#undef CONV8
        __syncthreads();
    }
}
__device__ __forceinline__ void ph_ssd2(const Ctx& X) {
    const float* st = (const float*)(X.ws + WS_ST); const float* dec = (const float*)(X.ws + WS_DEC); bf16_t* pb = (bf16_t*)(X.ws + WS_PB);
    for (int e = X.bid * NTHREADS + X.tid; e < NB * 32 * 2048; e += X.G * NTHREADS) {
        const int b = e >> 16, h = (e >> 11) & 31, q4 = (e & 2047) * 4;
        f32x4 hs = (f32x4){0.f, 0.f, 0.f, 0.f};
        for (int c = 0; c < 16; ++c) {
            const size_t o = ((size_t)(b * 16 + c) * 32 + h) * 8192 + q4;
            u32x2 wv; wv.x = pk2(hs.x, hs.y); wv.y = pk2(hs.z, hs.w); *(u32x2*)(pb + o) = wv;
            hs = hs * dec[(b * 16 + c) * 32 + h] + *(const f32x4*)(st + o);
        }
    }
}
constexpr int S3_STG = 49152;
__device__ __forceinline__ void ph_ssd3(const Params& p, const Ctx& X) {
    LAS float* dtl = (LAS float*)(X.lds + 2 * S3_STG); LAS float* csl = dtl + 2048;
    constexpr int S3_TILE = 2 * S3_STG + 16384;
    static_assert(S3_TILE + 8 * 4096 <= TAB_OFF, "ssd3 LDS map");
    for (int unit = X.bid; unit < 256; unit += X.G) {
        const int b = unit >> 6, c = (unit >> 2) & 15, g = unit & 3, tl0 = c * 256, lane = fresh(X.lane), w = X.wave, ql = lane & 31, hf = lane >> 5, lq = 32 * w + ql;
        const size_t t0 = (size_t)b * S + tl0;
        LAS unsigned char* tile = X.lds + S3_TILE + w * 4096;
        const bf16_t* xg = (const bf16_t*)(X.ws + WS_XCT) + (size_t)(g * 512 + lane) * T + t0;
        const bf16_t* pg = (const bf16_t*)(X.ws + WS_PB) + ((size_t)(b * 16 + c) * 32 + g * 8) * 8192 + (size_t)lane * 128;
#define S3_ISSUE(h8, sbase) do { _Pragma("unroll") for (int cc_ = 0; cc_ < 4; ++cc_) DMA16(xg + (size_t)((h8) * 64) * T + 8 * (4 * w + cc_), X.lds + (sbase) + (4 * w + cc_) * 1024); \
            _Pragma("unroll") for (int cc_ = 0; cc_ < 2; ++cc_) DMA16(pg + (size_t)(h8) * 8192 + 8 * (2 * w + cc_), X.lds + (sbase) + 32768 + (2 * w + cc_) * 1024); } while (0)
        asm volatile("s_waitcnt vmcnt(0)" ::: "memory");
        S3_ISSUE(0, 0);
        { const int tidf = fresh(X.tid), h8 = tidf >> 6, l4 = (tidf & 63) * 4;
          *(LAS f32x4*)(dtl + h8 * 256 + l4) = *(const f32x4*)((const float*)(X.ws + WS_DT2) + (size_t)(b * 32 + g * 8 + h8) * S + tl0 + l4);
          *(LAS f32x4*)(csl + h8 * 256 + l4) = *(const f32x4*)((const float*)(X.ws + WS_CS) + (size_t)(b * 32 + g * 8 + h8) * S + tl0 + l4); }
        const bf16_t* bcm = (const bf16_t*)(X.ws + WS_BCM);
        u32x4 gp[8][2];
        {
        bf16x8 cf[8];
#pragma unroll
        for (int ks = 0; ks < 8; ++ks) cf[ks] = *(const bf16x8*)(bcm + (t0 + lq) * 1024 + 512 + g * 128 + 16 * ks + 8 * hf);
#pragma unroll
        for (int st = 0; st < 8; ++st) {
            if (st <= w) {
                f32x16 G;
#pragma unroll
                for (int i = 0; i < 16; ++i) G[i] = 0.f;
                const bf16_t* bp = bcm + (t0 + 32 * st + pi32(ql)) * 1024 + g * 128 + 8 * hf;
#pragma unroll
                for (int ks = 0; ks < 8; ++ks) G = __builtin_amdgcn_mfma_f32_32x32x16_bf16(*(const bf16x8*)(bp + 16 * ks), cf[ks], G, 0, 0, 0);
#pragma unroll
                for (int a2 = 0; a2 < 2; ++a2) { gp[st][a2].x = pk2(G[8 * a2], G[8 * a2 + 1]); gp[st][a2].y = pk2(G[8 * a2 + 2], G[8 * a2 + 3]); gp[st][a2].z = pk2(G[8 * a2 + 4], G[8 * a2 + 5]); gp[st][a2].w = pk2(G[8 * a2 + 6], G[8 * a2 + 7]); }
            } else { gp[st][0] = (u32x4){0u, 0u, 0u, 0u}; gp[st][1] = (u32x4){0u, 0u, 0u, 0u}; }
        }
        }
        float ss = 0.f;
        bf16_t* yrow = (bf16_t*)(X.ws + WS_O) + (t0 + 32 * w + (lane >> 1)) * SSM_INNER + g * 512 + 32 * (lane & 1);
        const bf16_t* zdma = (const bf16_t*)(X.ws + WS_ZBC) + (t0 + 32 * w + (lane >> 3)) * 3072 + g * 512 + 8 * ((lane & 7) ^ (lane >> 3));
        LAS unsigned char* trw = tile + (lane >> 1) * 128;
        LAS unsigned char* tac = tile + ql * 128 + 8 * hf;
#pragma unroll 1
        for (int h8 = 0; h8 < 8; ++h8) {
            const int sb = (h8 & 1) * S3_STG;
            asm volatile("s_waitcnt vmcnt(0) lgkmcnt(0)\n\ts_barrier" ::: "memory");
            if (h8 < 7) S3_ISSUE(h8 + 1, ((h8 + 1) & 1) * S3_STG);
#pragma unroll
            for (int k = 0; k < 4; ++k) DMA16(zdma + (size_t)(8 * k) * 3072 + h8 * 64, tile + k * 1024);
            f32x16 acc0, acc1;
#pragma unroll
            for (int i = 0; i < 16; ++i) { acc0[i] = 0.f; acc1[i] = 0.f; }
            {
                const LAS unsigned char* pp = X.lds + sb + 32768 + hf * 1024 + ql * 16;
                const bf16_t* cp = bcm + (t0 + 32 * w + (fresh(lane) & 31)) * 1024 + 512 + g * 128 + 8 * hf;
#pragma unroll
                for (int ks = 0; ks < 8; ++ks) { const bf16x8 cfk = *(const bf16x8*)(cp + 16 * ks);
                                                 acc0 = __builtin_amdgcn_mfma_f32_32x32x16_bf16(*(const LAS bf16x8*)(pp + ks * 2048), cfk, acc0, 0, 0, 0);
                                                 acc1 = __builtin_amdgcn_mfma_f32_32x32x16_bf16(*(const LAS bf16x8*)(pp + ks * 2048 + 512), cfk, acc1, 0, 0, 0); }
                const float e = __expf(csl[h8 * 256 + lq]);
#pragma unroll
                for (int i = 0; i < 16; ++i) { acc0[i] *= e; acc1[i] *= e; }
            }
            const float cl = csl[h8 * 256 + lq], dsk = p.in[21][g * 8 + h8];
#pragma unroll
            for (int st = 0; st < 8; ++st) {
                if (st <= w) {
                    const int s0 = 32 * st + 8 * hf;
#pragma unroll
                    for (int a2 = 0; a2 < 2; ++a2) {
                        const f32x4 d0 = *(const LAS f32x4*)(dtl + h8 * 256 + s0 + 16 * a2), d1 = *(const LAS f32x4*)(dtl + h8 * 256 + s0 + 16 * a2 + 4);
                        const f32x4 c0 = *(const LAS f32x4*)(csl + h8 * 256 + s0 + 16 * a2), c1 = *(const LAS f32x4*)(csl + h8 * 256 + s0 + 16 * a2 + 4);
                        const float dd[8] = {d0.x, d0.y, d0.z, d0.w, d1.x, d1.y, d1.z, d1.w}, cc[8] = {c0.x, c0.y, c0.z, c0.w, c1.x, c1.y, c1.z, c1.w};
                        const unsigned gw[4] = {gp[st][a2].x, gp[st][a2].y, gp[st][a2].z, gp[st][a2].w};
                        float m[8];
#pragma unroll
                        for (int j = 0; j < 8; ++j) { const int sidx = s0 + 16 * a2 + j;
                            const float gv = (j & 1) ? bfhi(gw[j >> 1]) : bflo(gw[j >> 1]);
                            float v = gv * dd[j] * __expf(fminf(cl - cc[j], 0.f));
                            if (st == w) { v = sidx > lq ? 0.f : v; v += sidx == lq ? dsk : 0.f; }
                            m[j] = v; }
                        u32x4 pw; pw.x = pk2(m[0], m[1]); pw.y = pk2(m[2], m[3]); pw.z = pk2(m[4], m[5]); pw.w = pk2(m[6], m[7]);
                        const bf16x8 pf = __builtin_bit_cast(bf16x8, pw);
                        const LAS unsigned char* xp = X.lds + sb + (4 * st + 2 * a2 + hf) * 1024 + ql * 16;
                        acc0 = __builtin_amdgcn_mfma_f32_32x32x16_bf16(*(const LAS bf16x8*)xp, pf, acc0, 0, 0, 0);
                        acc1 = __builtin_amdgcn_mfma_f32_32x32x16_bf16(*(const LAS bf16x8*)(xp + 512), pf, acc1, 0, 0, 0);
                        __builtin_amdgcn_sched_barrier(0);
                    }
                }
            }
            asm volatile("s_waitcnt vmcnt(0)" ::: "memory");
#pragma unroll
            for (int pt = 0; pt < 2; ++pt)
#pragma unroll
                for (int g4 = 0; g4 < 4; ++g4) {
                    const u32x2 z2 = *(const LAS u32x2*)(tac + (((4 * pt + g4) ^ (ql & 7)) * 16));
                    const float a0 = pt ? acc1[4 * g4] : acc0[4 * g4], a1 = pt ? acc1[4 * g4 + 1] : acc0[4 * g4 + 1], a2v = pt ? acc1[4 * g4 + 2] : acc0[4 * g4 + 2], a3 = pt ? acc1[4 * g4 + 3] : acc0[4 * g4 + 3];
                    const float v0 = a0 * silu_fast(bflo(z2.x)), v1 = a1 * silu_fast(bfhi(z2.x)), v2 = a2v * silu_fast(bflo(z2.y)), v3 = a3 * silu_fast(bfhi(z2.y));
                    ss += (v0 * v0 + v1 * v1) + (v2 * v2 + v3 * v3);
                    u32x2 o; o.x = pk2(v0, v1); o.y = pk2(v2, v3); *(LAS u32x2*)(tac + (((4 * pt + g4) ^ (ql & 7)) * 16)) = o;
                }
#pragma unroll
            for (int k = 0; k < 4; ++k) *(u32x4*)(yrow + h8 * 64 + 8 * k) = *(const LAS u32x4*)(trw + (((4 * (lane & 1) + k) ^ ((lane >> 1) & 7)) * 16));
        }
#undef S3_ISSUE
        ss += __shfl_xor(ss, 32);
        const float rs = rsqrtf(ss * (1.f / 512.f) + EPS);
        asm volatile("s_waitcnt vmcnt(0)" ::: "memory");
        {
            const int lf = fresh(lane);
            bf16_t* yb = (bf16_t*)(X.ws + WS_O) + (t0 + 32 * w) * SSM_INNER + g * 512 + 8 * lf;
            const f32x4 g0 = *(const f32x4*)(p.in[22] + g * 512 + 8 * lf), g1 = *(const f32x4*)(p.in[22] + g * 512 + 8 * lf + 4);
#pragma unroll 1
            for (int r0 = 0; r0 < 32; r0 += 8) {
                u32x4 q[8];
#pragma unroll
                for (int k = 0; k < 8; ++k) q[k] = *(const u32x4*)(yb + (size_t)(r0 + k) * SSM_INNER);
#pragma unroll
                for (int k = 0; k < 8; ++k) {
                    const float rk = __shfl(rs, r0 + k);
                    u32x4 o; o.x = pk2(bflo(q[k].x) * rk * g0.x, bfhi(q[k].x) * rk * g0.y); o.y = pk2(bflo(q[k].y) * rk * g0.z, bfhi(q[k].y) * rk * g0.w);
                    o.z = pk2(bflo(q[k].z) * rk * g1.x, bfhi(q[k].z) * rk * g1.y); o.w = pk2(bflo(q[k].w) * rk * g1.z, bfhi(q[k].w) * rk * g1.w);
                    *(u32x4*)(yb + (size_t)(r0 + k) * SSM_INNER) = o;
                }
            }
        }
        asm volatile("s_waitcnt lgkmcnt(0)\n\ts_barrier" ::: "memory");
    }
}

__device__ __forceinline__ void ph_moe_gu(const Params& p, const Ctx& X, int l) {
    moe_table(X, l);
    pg8::MoeOrder So{(const LAS int*)(X.lds + TAB_OFF), (const LAS int*)(X.lds + TAB_OFF) + 40, (const int*)(X.ws + WS_SLOT), 3, X.G, X.bid, true};
    pg8::Gemm g{(const bf16_t*)(X.ws + WS_U), (const bf16_t*)(X.ws + WS_WGU) + (size_t)l * NE * 2048 * 1024, 1024};
    pg8::EpiGu E{(bf16_t*)(X.ws + WS_ACT), p.in[27] + (size_t)l * NE * 2048};
    pg8::gemm_phase<pg8::EpiGu, pg8::MoeOrder>(X.lds, g, So, E, X.tid);
}
__device__ __forceinline__ void ph_moe_down(const Params& p, const Ctx& X, int l) {
    moe_table(X, l);
    pg8::MoeOrder So{(const LAS int*)(X.lds + TAB_OFF), (const LAS int*)(X.lds + TAB_OFF) + 40, (const int*)(X.ws + WS_SLOT), 2, X.G, X.bid, false};
    pg8::Gemm g{(const bf16_t*)(X.ws + WS_ACT), (const bf16_t*)(X.ws + WS_WDN) + (size_t)l * NE * 1024 * 1024, 1024};
    pg8::EpiDown E{(bf16_t*)(X.ws + WS_Y), p.in[29] + (size_t)l * NE * 1024};
    pg8::gemm_phase<pg8::EpiDown, pg8::MoeOrder>(X.lds, g, So, E, X.tid);
}

#ifndef PROBE_MASK
#define PROBE_MASK 0u
#endif
#ifndef PROBE_MULT
#define PROBE_MULT 8
#endif
__global__ void __launch_bounds__(NTHREADS, 2) fwd_kernel(Params p) {
    extern __shared__ __attribute__((aligned(16))) unsigned char lds_raw[];
    Ctx X;
    X.lds = (LAS unsigned char*)lds_raw; X.ws = p.ws;
    X.tid = threadIdx.x; X.lane = X.tid & 63; X.wave = __builtin_amdgcn_readfirstlane(X.tid >> 6);
    X.G = gridDim.x; X.bid = blockIdx.x; X.gw = X.bid * NWAVES + X.wave; X.ngw = X.G * NWAVES; X.sub = 0ull; X.subt = 0ull;
    if (X.tid < 4) ((LAS unsigned*)(X.lds + XB_OFF))[X.tid] = 0u;
    __syncthreads();
    XcdBarrier bar = xcd_barrier_post((unsigned*)(p.ws + WS_CTL) + CW_BAR, (volatile LAS unsigned*)(X.lds + XB_OFF));
#define PHASE_BEGIN Ctx Y = X; { GAS unsigned char* w_ = (GAS unsigned char*)p.ws; asm volatile("" : "+s"(w_)); Y.ws = (unsigned char*)w_; int t_ = threadIdx.x; asm volatile("" : "+v"(t_)); Y.tid = t_; Y.lane = t_ & 63; \
    Y.wave = __builtin_amdgcn_readfirstlane(t_ >> 6); Y.gw = Y.bid * NWAVES + Y.wave; }
#define WSF(off) ((float*)(Y.ws + (off)))
#define WSB(off) ((bf16_t*)(Y.ws + (off)))
#define PROBE_LDS(i) (((volatile LAS unsigned long long*)(X.lds + 150528))[2 * X.wave + (i)])
    if (PROBE_MASK || PROBE_SUB) { if (X.lane == 0) { PROBE_LDS(0) = __builtin_amdgcn_s_memrealtime(); PROBE_LDS(1) = 0ull; } }
#define PB(k) do { if (PROBE_MASK) { if (X.lane == 0) { const unsigned long long n_ = __builtin_amdgcn_s_memrealtime(); if ((PROBE_MASK >> (k)) & 1u) PROBE_LDS(1) += n_ - PROBE_LDS(0); PROBE_LDS(0) = n_; } } } while (0)
    { PHASE_BEGIN ph_prologue(p, Y); }                                    xcd_barrier(bar); PB(0);
    { PHASE_BEGIN ph_norm0(p, Y); }                                       xcd_barrier(bar); PB(1);
    {
        PHASE_BEGIN
        pg8::DenseOrder So; So.init(T, PROJ_LD, X.G, X.bid);
        pg8::Gemm g{WSB(WS_U), WSB(WS_WIN), 1024};
        pg8::EpiBf16 E{WSB(WS_BIG), PROJ_LD};
        pg8::gemm_phase<pg8::EpiBf16, pg8::DenseOrder>(X.lds, g, So, E, Y.tid);
    }
    {
        PHASE_BEGIN
        pg8::DenseOrder So; So.init(768, T, X.G, X.bid);
        pg8::Gemm g{WSB(WS_WV), WSB(WS_U), 1024};
        pg8::EpiBf16 E{WSB(WS_VT), T};
        pg8::gemm_phase<pg8::EpiBf16, pg8::DenseOrder>(X.lds, g, So, E, Y.tid);
    }
    xcd_barrier(bar); PB(2);
    { PHASE_BEGIN ph_attn_a(p, Y); }                                      xcd_barrier(bar); PB(3);
    { PHASE_BEGIN ph_nsa(p, Y); if (PROBE_SUB && X.lane == 0) PROBE_LDS(1) += Y.sub; }
    __syncthreads(); PB(19);
    { PHASE_BEGIN ph_sb(Y); if (PROBE_SUB && X.lane == 0) PROBE_LDS(1) += Y.sub; }                                             xcd_barrier(bar); PB(4);
    {
        PHASE_BEGIN
        pg8::DenseOrder So; So.init(T, D, X.G, X.bid);
        pg8::Gemm g{WSB(WS_O), WSB(WS_WOUT), 1024};
        pg8::EpiResid E{p.in[0], WSF(WS_H1), WSF(WS_MODF) + 2048};
        pg8::gemm_phase<pg8::EpiResid, pg8::DenseOrder>(X.lds, g, So, E, Y.tid);
    }
    xcd_barrier(bar); PB(5);
    { PHASE_BEGIN ph_token<0>(p, Y, 0, WSF(WS_H1), nullptr); }                       xcd_barrier(bar); PB(6);
    { PHASE_BEGIN ph_moe_gu(p, Y, 0); }                                   xcd_barrier(bar); PB(7);
    { PHASE_BEGIN ph_moe_down(p, Y, 0); }                                 xcd_barrier(bar); PB(8);
    { PHASE_BEGIN ph_token<1>(p, Y, 0, WSF(WS_H1), WSF(WS_H2)); }       xcd_barrier(bar); PB(9);
    {
        PHASE_BEGIN
        pg8::DenseOrder So; So.init(T, 3072, X.G, X.bid);
        pg8::Gemm g{WSB(WS_U), WSB(WS_WSIN), 1024};
        pg8::EpiBf16 E{WSB(WS_ZBC), 3072};
        pg8::gemm_phase<pg8::EpiBf16, pg8::DenseOrder>(X.lds, g, So, E, Y.tid);
    }
    {
        PHASE_BEGIN
        pg8::DenseOrder So; So.init(3072, T, X.G, X.bid);
        pg8::Gemm g{WSB(WS_WSIN) + (size_t)2048 * 1024, WSB(WS_U), 1024};
        pg8::EpiBf16 E{WSB(WS_XT), T};
        pg8::gemm_phase<pg8::EpiBf16, pg8::DenseOrder>(X.lds, g, So, E, Y.tid);
    }
    xcd_barrier(bar); PB(10);
    { PHASE_BEGIN ph_ssd1(p, Y); if (PROBE_SUB && X.lane == 0) PROBE_LDS(1) += Y.sub; }                                        xcd_barrier(bar); PB(11);
    { PHASE_BEGIN ph_ssd2(Y); }                                           xcd_barrier(bar); PB(12);
    { PHASE_BEGIN ph_ssd3(p, Y); if (PROBE_SUB && X.lane == 0) PROBE_LDS(1) += Y.sub; }                                        xcd_barrier(bar); PB(13);
    {
        PHASE_BEGIN
        pg8::DenseOrder So; So.init(T, D, X.G, X.bid);
        pg8::Gemm g{WSB(WS_O), WSB(WS_WSOUT), 2048};
        pg8::EpiResid E{WSF(WS_H2), WSF(WS_H1), WSF(WS_MODF) + 4 * 6144 + 2048};
        pg8::gemm_phase<pg8::EpiResid, pg8::DenseOrder>(X.lds, g, So, E, Y.tid);
    }
    xcd_barrier(bar); PB(14);
    { PHASE_BEGIN ph_token<0>(p, Y, 1, WSF(WS_H1), nullptr); }                       xcd_barrier(bar); PB(15);
    { PHASE_BEGIN ph_moe_gu(p, Y, 1); }                                   xcd_barrier(bar); PB(16);
    { PHASE_BEGIN ph_moe_down(p, Y, 1); }                                 xcd_barrier(bar); PB(17);
    { PHASE_BEGIN ph_token<2>(p, Y, 1, WSF(WS_H1), p.out); } PB(18);
    if (PROBE_MASK || PROBE_SUB) { asm volatile("s_waitcnt lgkmcnt(0)" ::: "memory"); const unsigned long long acc_ = PROBE_LDS(1); const unsigned long long t_end = __builtin_amdgcn_s_memrealtime() + (unsigned long long)PROBE_MULT * (unsigned long long)__builtin_amdgcn_readfirstlane((unsigned)acc_); while (__builtin_amdgcn_s_memrealtime() < t_end) __builtin_amdgcn_s_sleep(8); }
#undef PB
#undef PROBE_LDS
#undef PHASE_BEGIN
#undef WSF
#undef WSB
}
}

extern "C" void kernel_launch(void* const* d_in, const int* in_sizes, int n_in, void* d_out, int out_size, void* d_ws, size_t ws_size, hipStream_t stream) {
    static int grid = 0;
    if (grid == 0) {
        if (n_in != 30 || out_size != T * D || ws_size < WS_END) { fprintf(stderr, "kernel_launch: unexpected shapes / workspace (%d inputs, out %d, ws %zu < %zu)\n", n_in, out_size, ws_size, (size_t)WS_END); grid = -1; return; }
        int dev = 0, cus = 0, per_cu = 0;
        if (hipGetDevice(&dev) != hipSuccess || hipDeviceGetAttribute(&cus, hipDeviceAttributeMultiprocessorCount, dev) != hipSuccess) { grid = -1; return; }
        if (hipFuncSetAttribute((const void*)fwd_kernel, hipFuncAttributeMaxDynamicSharedMemorySize, LDS_BYTES) != hipSuccess) { fprintf(stderr, "kernel_launch: hipFuncSetAttribute failed\n"); grid = -1; return; }
        if (hipOccupancyMaxActiveBlocksPerMultiprocessor(&per_cu, (const void*)fwd_kernel, NTHREADS, LDS_BYTES) != hipSuccess || per_cu < 1) { fprintf(stderr, "kernel_launch: occupancy query reports %d\n", per_cu); }
        (void)hipGetLastError();
        grid = cus;
    }
    if (grid < 0) return;
    if (hipMemsetAsync((char*)d_ws + WS_CTL, 0, CTL_BYTES, stream) != hipSuccess) return;
    Params p{};
    for (int i = 0; i < 30; ++i) p.in[i] = (const float*)d_in[i];
    p.out = (float*)d_out; p.ws = (unsigned char*)d_ws;
    hipLaunchKernelGGL(fwd_kernel, dim3(grid), dim3(NTHREADS), LDS_BYTES, stream, p);
}
```

```cpp
#include <hip/hip_runtime.h>
#include <cstdio>
#include <cstdint>

#define LAS __attribute__((address_space(3)))
#define GAS __attribute__((address_space(1)))
typedef unsigned short bf16_t;
typedef short bf16x8 __attribute__((ext_vector_type(8)));
typedef float f32x4 __attribute__((ext_vector_type(4)));
typedef unsigned u32x4 __attribute__((ext_vector_type(4)));
typedef unsigned u32x2 __attribute__((ext_vector_type(2)));
typedef float f32x16 __attribute__((ext_vector_type(16)));

namespace {
constexpr int D = 1024, NB = 4, S = 4096, T = NB * S;
constexpr int ATTN_IN = 2840, PROJ_LD = 3072;
constexpr int OFF_SBQ = 0, OFF_SBK = 512, OFF_SBV = 1024, OFF_NQ = 1536, OFF_KC = 2048, OFF_VC = 2176, OFF_KS = 2304, OFF_VS = 2432,
              OFF_KW = 2560, OFF_VW = 2688, OFF_GATE = 2816;
constexpr int NCMP = 255;
constexpr int SSM_IN = 5152, SSM_INNER = 2048, CONV_DIM = 3072, ZX_LD = 5120;
constexpr int NE = 32, CAP = 16384, MAXTILES = 288;
constexpr float EPS = 1e-6f;
constexpr int NWAVES = 8, NTHREADS = 512;

constexpr size_t al4k(size_t x) { return (x + 4095) & ~(size_t)4095; }
constexpr size_t WS_CTL = 0, CTL_BYTES = 1u << 20;
constexpr int CW_CNT = 256;
constexpr int CW_BAR = 4096;
constexpr size_t CTL_MOD = 65536;
constexpr size_t WS_WIN = CTL_BYTES;
constexpr size_t WS_WOUT = WS_WIN + (size_t)3072 * 1024 * 2;
constexpr size_t WS_WSIN = WS_WOUT + (size_t)1024 * 1024 * 2;
constexpr size_t WS_WSOUT = WS_WSIN + (size_t)5120 * 1024 * 2;
constexpr size_t WS_WGU = WS_WSOUT + (size_t)1024 * 2048 * 2;
constexpr size_t WS_WDN = WS_WGU + (size_t)2 * 32 * 2048 * 1024 * 2;
constexpr size_t WS_U = WS_WDN + (size_t)2 * 32 * 1024 * 1024 * 2;
constexpr size_t WS_BIG = WS_U + (size_t)T * 1024 * 2;
constexpr size_t WS_O = WS_BIG + (size_t)T * 5120 * 2;
constexpr size_t WS_H1 = WS_O + (size_t)T * 2048 * 2;
constexpr size_t WS_H2 = WS_H1 + (size_t)T * 1024 * 4;
constexpr size_t WS_QN = WS_H2 + (size_t)T * 1024 * 4;
constexpr size_t WS_KN = WS_QN + (size_t)T * 512 * 4;
constexpr size_t WS_KCMP = WS_KN + (size_t)T * 256 * 4;
constexpr size_t WS_VCMP = WS_KCMP + al4k((size_t)NB * NCMP * 2 * 64 * 4);
constexpr size_t WS_ACT = WS_VCMP + al4k((size_t)NB * NCMP * 2 * 64 * 4);
constexpr size_t WS_Y = WS_ACT + (size_t)MAXTILES * 256 * 1024 * 2;
constexpr size_t WS_TOKE = WS_Y + (size_t)MAXTILES * 256 * 1024 * 2;
constexpr size_t WS_TOKW = WS_TOKE + (size_t)T * 16;
constexpr size_t WS_TOKP = WS_TOKW + (size_t)T * 16;
constexpr size_t WS_SLOT = WS_TOKP + (size_t)T * 16;
constexpr size_t WS_XC = WS_SLOT + (size_t)NE * CAP * 4;
constexpr size_t WS_YS = WS_XC + (size_t)T * 3072 * 4;
constexpr size_t WS_DT = WS_YS + (size_t)T * 2048 * 4;
constexpr size_t WS_MODF = WS_DT + (size_t)T * 32 * 4;
constexpr size_t WS_WV = WS_MODF + (size_t)2 * 4 * 6144 * 4;
constexpr size_t WS_VT = WS_WV + (size_t)768 * 1024 * 2;
constexpr size_t WS_QNB = WS_VT + (size_t)768 * T * 2;
constexpr size_t WS_KSN = WS_QNB + (size_t)T * 512 * 2;
constexpr size_t WS_KWN = WS_KSN + (size_t)T * 128 * 2;
constexpr size_t WS_KCB = WS_KWN + (size_t)T * 128 * 2;
constexpr size_t WS_VCT = WS_KCB + (size_t)8 * 256 * 64 * 2;
constexpr size_t WS_DT2 = WS_VCT + (size_t)8 * 64 * 256 * 2;
constexpr size_t WS_CS = WS_DT2 + (size_t)NB * 32 * S * 4;
constexpr size_t WS_DEC = WS_CS + (size_t)NB * 32 * S * 4;
constexpr size_t WS_W1T = WS_DEC + al4k((size_t)NB * 16 * 32 * 4);
constexpr size_t WS_SKW = WS_W1T + (size_t)2 * 128 * 2048 * 2;
constexpr size_t WS_END = WS_SKW + (size_t)3 * 2 * 32 * 1024 * 2;
constexpr size_t WS_ZBC = WS_BIG, WS_XT = WS_XC, WS_XCT = WS_XC + (size_t)3072 * T * 2, WS_ST = WS_YS, WS_PB = WS_YS + (size_t)NB * 16 * 32 * 8192 * 4, WS_BCM = WS_QN;
static_assert(WS_XCT + (size_t)2560 * T * 2 <= WS_YS && WS_PB + (size_t)NB * 16 * 32 * 8192 * 2 <= WS_DT && (size_t)T * 1024 * 2 <= (size_t)T * 512 * 4, "layer-1 overlays");

constexpr int RING_BYTES = 131072;
constexpr int EXTRA_OFF = RING_BYTES;
constexpr int TAB_OFF = 151552;
constexpr int XB_OFF = 152576;
constexpr int LDS_BYTES = 153600;

struct Params { const float* in[30]; float* out; unsigned char* ws; };

__device__ __forceinline__ float siluf(float v) { return v / (1.f + expf(-v)); }
__device__ __forceinline__ float logsig(float x) { return fminf(x, 0.f) - log1pf(expf(-fabsf(x))); }
__device__ __forceinline__ float wave_sum(float v) {
#pragma unroll
    for (int o = 32; o > 0; o >>= 1) v += __shfl_xor(v, o);
    return v;
}
__device__ __forceinline__ float wave_max(float v) {
#pragma unroll
    for (int o = 32; o > 0; o >>= 1) v = fmaxf(v, __shfl_xor(v, o));
    return v;
}
__device__ __forceinline__ unsigned f2bf(float f) { unsigned u = __builtin_bit_cast(unsigned, f); return (u + 0x7fffu + ((u >> 16) & 1u)) >> 16; }
typedef float f32x2_t __attribute__((ext_vector_type(2))); typedef __bf16 bf16x2_t __attribute__((ext_vector_type(2)));
__device__ __forceinline__ unsigned pk2(float lo, float hi) { f32x2_t v = {lo, hi}; bf16x2_t b = __builtin_convertvector(v, bf16x2_t); return __builtin_bit_cast(unsigned, b); }
__device__ __forceinline__ float bf2f(bf16_t v) { return __uint_as_float((unsigned)v << 16); }
__device__ __forceinline__ float bflo(unsigned w) { return __uint_as_float(w << 16); }
__device__ __forceinline__ float bfhi(unsigned w) { return __uint_as_float(w & 0xffff0000u); }
#define LDS_WAIT() asm volatile("s_waitcnt lgkmcnt(0)" ::: "memory")
__device__ __forceinline__ int fresh(int v) { asm volatile("" : "+v"(v)); return v; }
__device__ __forceinline__ int sfresh(int v) { asm volatile("" : "+s"(v)); return v; }

#define XB_TMO      128
#define XB_XCNT(j)  (256  + 64 * (j))
#define XB_XSUB(j)  (1280 + 64 * (j))
#define XB_XGEN(j)  (2304 + 64 * (j))
#define XB_TOP      3328
#define XB_TOPGEN   3392
#define XCD_BAR_WORDS 3456
#define XB_SPIN_CAP (1u << 18)
__device__ __forceinline__ unsigned xb_ld(unsigned* p)              { return __hip_atomic_load(p, __ATOMIC_RELAXED, __HIP_MEMORY_SCOPE_AGENT); }
__device__ __forceinline__ unsigned xb_add(unsigned* p, unsigned v) { return __hip_atomic_fetch_add(p, v, __ATOMIC_RELAXED, __HIP_MEMORY_SCOPE_AGENT); }
__device__ __forceinline__ unsigned xb_xcc_id() { return (unsigned)__builtin_amdgcn_s_getreg((3 << 11) | 20) & 0xFu; }
#define XB_SPIN(cond, bar) do { unsigned _sp = 0; while (cond) { __builtin_amdgcn_s_sleep(1); \
    if ((++_sp & 255u) == 0u) { if (xb_ld(&(bar)[XB_TMO])) break; if (_sp > XB_SPIN_CAP) { atomicAdd(&(bar)[XB_TMO], 1u); break; } } } } while (0)
struct XcdBarrier { unsigned* bar; unsigned x; volatile LAS unsigned* st; };
__device__ __forceinline__ XcdBarrier xcd_barrier_post(unsigned* bar, volatile LAS unsigned* st) {
    XcdBarrier b; b.bar = bar; b.x = xb_xcc_id(); b.st = st;
    if (threadIdx.x == 0) (void)xb_add(&bar[XB_XCNT(b.x)], 1u);
    return b;
}
__device__ __forceinline__ void xcd_barrier_complete(unsigned* bar, unsigned x, unsigned& nloc, unsigned& nx) {
    const unsigned G = gridDim.x * gridDim.y * gridDim.z;
    unsigned sum, cnt, mine, sp = 0u;
    for (;;) {
        sum = 0u; cnt = 0u; mine = 0u;
#pragma unroll
        for (unsigned j = 0; j < 16; ++j) { const unsigned c = xb_ld(&bar[XB_XCNT(j)]); sum += c; cnt += (c > 0u) ? 1u : 0u; mine = (j == x) ? c : mine; }
        if (sum == G) break;
        __builtin_amdgcn_s_sleep(1);
        if ((++sp & 255u) == 0u) { if (xb_ld(&bar[XB_TMO])) break; if (sp > XB_SPIN_CAP) { atomicAdd(&bar[XB_TMO], 1u); break; } }
    }
    nloc = mine > 0u ? mine : 1u; nx = cnt > 0u ? cnt : 1u;
}
__device__ __forceinline__ void xcd_barrier(const XcdBarrier& b) {
    asm volatile("s_waitcnt vmcnt(0)" ::: "memory");
    __syncthreads();
    if (threadIdx.x == 0) {
        unsigned* bar = b.bar;
        __builtin_amdgcn_s_waitcnt(0);
        unsigned nloc = b.st[0], nx = b.st[1];
        if (nloc == 0u) { xcd_barrier_complete(bar, b.x, nloc, nx); b.st[0] = nloc; b.st[1] = nx; }
        const unsigned old = xb_add(&bar[XB_XSUB(b.x)], 1u);
        const unsigned gen = old / nloc;
        if (old + 1u == (gen + 1u) * nloc) {
            __builtin_amdgcn_fence(__ATOMIC_RELEASE, "agent");
            asm volatile("s_waitcnt vmcnt(0)" ::: "memory");
            const unsigned og = xb_add(&bar[XB_TOP], 1u);
            const unsigned tg = og / nx;
            if (og + 1u == (tg + 1u) * nx) xb_add(&bar[XB_TOPGEN], 1u);
            else XB_SPIN(xb_ld(&bar[XB_TOPGEN]) == tg, bar);
            __builtin_amdgcn_fence(__ATOMIC_ACQUIRE, "agent");
            xb_add(&bar[XB_XGEN(b.x)], 1u);
            asm volatile("s_waitcnt vmcnt(0)" ::: "memory");
        } else {
            XB_SPIN(xb_ld(&bar[XB_XGEN(b.x)]) == gen, bar);
            __builtin_amdgcn_fence(__ATOMIC_ACQUIRE, "agent");
            asm volatile("s_waitcnt vmcnt(0)" ::: "memory");
        }
    }
    __syncthreads();
}

namespace pg8 {
constexpr int BM = 256, BK = 64, HALF = 128, HTB = HALF * BK * 2, STAGE_BYTES = 8 * HTB;
__device__ __forceinline__ int lds_byte(int r, int c) { const int st = (r >> 4) * 2 + (c >> 5), rr = r & 15, cc = c & 31, ob = rr * 64 + cc * 2; return st * 1024 + (ob ^ (((ob >> 9) & 1) << 5)); }
__device__ __forceinline__ void stage_rc(int b, int& R, int& C) { const int st = b / 1024, sb = b % 1024, swz = sb ^ (((sb >> 9) & 1) << 5); R = (st >> 1) * 16 + swz / 64; C = (st & 1) * 32 + (swz % 64) / 2; }
__device__ __forceinline__ int perm32(int rho) { const int n = rho >> 4, i = rho & 15; return 8 * (i >> 2) + 4 * n + (i & 3); }
struct Unit { int pm, pn, e; };
struct Gemm { const bf16_t* A; const bf16_t* Bt; int K; };
__device__ __forceinline__ unsigned cvt_pk_bf16(float lo, float hi) { unsigned r; asm volatile("v_cvt_pk_bf16_f32 %0, %1, %2" : "=v"(r) : "v"(lo), "v"(hi)); return r; }

struct DenseOrder {
    int nM, nN, nwg, G, c;
    __device__ void init(int M, int N, int G_, int c_) { nM = M / BM; nN = N / BM; nwg = nM * nN; G = G_; c = c_; }
    __device__ bool next(int i, Unit& u) const {
        const long L = (long)i * G + c; if (L >= nwg) return false;
        int wgid = (int)L; { const int q = nwg / 8, r = nwg % 8, xcd = wgid % 8, off = wgid / 8; wgid = (xcd < r ? xcd * (q + 1) : r * (q + 1) + (xcd - r) * q) + off; }
        const int nig = 8 * nN, gid = wgid / nig, fm = gid * 8, gsz = (nM - fm) < 8 ? (nM - fm) : 8;
        u.pm = fm + ((wgid % nig) % gsz); u.pn = (wgid % nig) / gsz; u.e = 0; return true;
    }
    __device__ __forceinline__ unsigned arow(const Unit& u, int r) const { return (unsigned)(u.pm * BM + r); }
};
struct MoeOrder {
    const LAS int* tb; const LAS int* cn; const int* slot_tok; int shift, G, c; bool gather;
    __device__ bool next(int i, Unit& u) const {
        const int L = i * G + c, tile = L >> shift; if (tile >= tb[NE]) return false;
        int e = 0; while (tb[e + 1] <= tile) ++e;
        u.pm = tile; u.pn = (e << shift) + (L & ((1 << shift) - 1)); u.e = e; return true;
    }
    __device__ __forceinline__ unsigned arow(const Unit& u, int r) const {
        if (!gather) return (unsigned)(u.pm * BM + r);
        const int pos = (u.pm - tb[u.e]) * BM + r;
        return pos < cn[u.e] ? (unsigned)slot_tok[u.e * CAP + pos] : 0u;
    }
};

struct EpiBf16 {
    static constexpr bool PERM = true;
    bf16_t* O; int ldc;
    __device__ __forceinline__ void operator()(const f32x4 (&acc)[2][2][4][2], const Unit& u, int wr, int wc, int fr, int fq) const {
        const int row0 = u.pm * BM + wr * 64 + fr, col0 = u.pn * BM + wc * 32 + 8 * fq;
#pragma unroll
        for (int ai = 0; ai < 2; ++ai)
#pragma unroll
            for (int m = 0; m < 4; ++m) { bf16_t* rowp = O + (size_t)(row0 + ai * HALF + m * 16) * ldc + col0;
#pragma unroll
                for (int bj = 0; bj < 2; ++bj) { const f32x4 v0 = acc[ai][bj][m][0], v1 = acc[ai][bj][m][1];
                    u32x4 w; w.x = cvt_pk_bf16(v0[0], v0[1]); w.y = cvt_pk_bf16(v0[2], v0[3]); w.z = cvt_pk_bf16(v1[0], v1[1]); w.w = cvt_pk_bf16(v1[2], v1[3]);
                    *(u32x4*)(rowp + bj * HALF) = w; } }
    }
};
struct EpiResid {
    static constexpr bool PERM = false;
    const float* base; float* out; const float* g;
    __device__ __forceinline__ void operator()(const f32x4 (&acc)[2][2][4][2], const Unit& u, int wr, int wc, int fr, int fq) const {
        const int row0 = u.pm * BM + wr * 64 + fr, col0 = u.pn * BM + wc * 32 + 4 * fq;
        const float* gb = g + (size_t)((u.pm * BM) / S) * 6144 + col0;
        f32x4 gv[2][2];
#pragma unroll
        for (int bj = 0; bj < 2; ++bj)
#pragma unroll
            for (int n = 0; n < 2; ++n) gv[bj][n] = *(const f32x4*)(gb + bj * HALF + n * 16);
#pragma unroll
        for (int ai = 0; ai < 2; ++ai)
#pragma unroll
            for (int m = 0; m < 4; ++m) { const size_t off = (size_t)(row0 + ai * HALF + m * 16) * D + col0;
#pragma unroll
                for (int bj = 0; bj < 2; ++bj)
#pragma unroll
                    for (int n = 0; n < 2; ++n) { const f32x4 bs = *(const f32x4*)(base + off + bj * HALF + n * 16);
                        *(f32x4*)(out + off + bj * HALF + n * 16) = bs + gv[bj][n] * acc[ai][bj][m][n]; } }
    }
};
struct EpiGu {
    static constexpr bool PERM = true;
    bf16_t* act; const float* bgu;
    __device__ __forceinline__ void operator()(const f32x4 (&acc)[2][2][4][2], const Unit& u, int wr, int wc, int fr, int fq) const {
        const int row0 = u.pm * BM + wr * 64 + fr, col0 = (u.pn & 7) * HALF + wc * 32 + 8 * fq;
        const float* bb = bgu + (size_t)u.e * 2048 + col0;
        const f32x4 bg0 = *(const f32x4*)(bb), bg1 = *(const f32x4*)(bb + 4), bu0 = *(const f32x4*)(bb + 1024), bu1 = *(const f32x4*)(bb + 1028);
#pragma unroll
        for (int ai = 0; ai < 2; ++ai)
#pragma unroll
            for (int m = 0; m < 4; ++m) {
                float r[8];
#pragma unroll
                for (int n = 0; n < 2; ++n) { const f32x4 gt = acc[ai][0][m][n] + (n ? bg1 : bg0), up = acc[ai][1][m][n] + (n ? bu1 : bu0);
#pragma unroll
                    for (int j = 0; j < 4; ++j) { const float gg = fminf(gt[j], 7.f), uu = fminf(fmaxf(up[j], -7.f), 7.f);
                        r[n * 4 + j] = (uu + 1.f) * gg * __builtin_amdgcn_rcpf(1.f + __expf(-1.702f * gg)); } }
                u32x4 w; w.x = cvt_pk_bf16(r[0], r[1]); w.y = cvt_pk_bf16(r[2], r[3]); w.z = cvt_pk_bf16(r[4], r[5]); w.w = cvt_pk_bf16(r[6], r[7]);
                *(u32x4*)(act + (size_t)(row0 + ai * HALF + m * 16) * D + col0) = w; }
    }
};
struct EpiDown {
    static constexpr bool PERM = true;
    bf16_t* y; const float* bd;
    __device__ __forceinline__ void operator()(const f32x4 (&acc)[2][2][4][2], const Unit& u, int wr, int wc, int fr, int fq) const {
        const int row0 = u.pm * BM + wr * 64 + fr, col0 = (u.pn & 3) * BM + wc * 32 + 8 * fq;
        const float* bb = bd + (size_t)u.e * 1024 + col0;
        f32x4 bv[2][2];
#pragma unroll
        for (int bj = 0; bj < 2; ++bj)
#pragma unroll
            for (int n = 0; n < 2; ++n) bv[bj][n] = *(const f32x4*)(bb + bj * HALF + 4 * n);
#pragma unroll
        for (int ai = 0; ai < 2; ++ai)
#pragma unroll
            for (int m = 0; m < 4; ++m) { bf16_t* rowp = y + (size_t)(row0 + ai * HALF + m * 16) * D + col0;
#pragma unroll
                for (int bj = 0; bj < 2; ++bj) { const f32x4 v0 = acc[ai][bj][m][0] + bv[bj][0], v1 = acc[ai][bj][m][1] + bv[bj][1];
                    u32x4 w; w.x = cvt_pk_bf16(v0[0], v0[1]); w.y = cvt_pk_bf16(v0[2], v0[3]); w.z = cvt_pk_bf16(v1[0], v1[1]); w.w = cvt_pk_bf16(v1[2], v1[3]);
                    *(u32x4*)(rowp + bj * HALF) = w; } }
    }
};

template <class Epi, class Sched>
__device__ __forceinline__ void gemm_phase(LAS unsigned char* lds, const Gemm g, const Sched& S, const Epi& E, const int tid) {
    const int wid = __builtin_amdgcn_readfirstlane(tid >> 6), lane = tid & 63, wr = wid >> 2, wc = wid & 3, fr = lane & 15, fq = lane >> 4;
    const int K = g.K, nt = K / BK;
    int RA[2], CA[2]; unsigned voffB[2];
#pragma unroll
    for (int i = 0; i < 2; ++i) { int R, C; stage_rc(tid * 16 + i * 8192, R, C); const int Rb = Epi::PERM ? ((R & ~31) + perm32(R & 31)) : R;
        RA[i] = R; CA[i] = C; voffB[i] = (unsigned)(Rb * K + C) * 2u; }
    const size_t kstep = (size_t)(BK * 2);
    const size_t hstep = (size_t)HALF * K * 2;
    const size_t tstep = 2 * hstep;
    const unsigned ldsw = (unsigned)wid * 1024u;
    const int aoff = lds_byte(wr * 64 + fr, fq * 8), boff = lds_byte(wc * 32 + fr, fq * 8);
#define PG8_SA(b, h) (((b) * 2 + (h)) * HTB)
#define PG8_SB(b, h) ((4 + (b) * 2 + (h)) * HTB)
#define PG8_STAGE(bufoff, gbase, voff) do { _Pragma("unroll") for (int _i = 0; _i < 2; ++_i) \
        __builtin_amdgcn_global_load_lds((const unsigned*)((const char*)(gbase) + (voff)[_i]), (LAS unsigned*)(lds + (bufoff) + ldsw + _i * 8192), 16, 0, 0); } while (0)
#define PG8_LDA(dst, b, h) do { _Pragma("unroll") for (int m = 0; m < 4; ++m) _Pragma("unroll") for (int k = 0; k < 2; ++k) dst[m][k] = *(const LAS bf16x8*)(lds + PG8_SA(b, h) + aoff + m * 2048 + k * 1024); } while (0)
#define PG8_LDB(dst, b, h) do { _Pragma("unroll") for (int n = 0; n < 2; ++n) _Pragma("unroll") for (int k = 0; k < 2; ++k) dst[n][k] = *(const LAS bf16x8*)(lds + PG8_SB(b, h) + boff + n * 2048 + k * 1024); } while (0)
#define PG8_MMA(ai, bj, At, Bt) do { __builtin_amdgcn_s_setprio(1); _Pragma("unroll") for (int m = 0; m < 4; ++m) _Pragma("unroll") for (int n = 0; n < 2; ++n) _Pragma("unroll") for (int k = 0; k < 2; ++k) \
        acc[ai][bj][m][n] = __builtin_amdgcn_mfma_f32_16x16x32_bf16(Bt[n][k], At[m][k], acc[ai][bj][m][n], 0, 0, 0); __builtin_amdgcn_s_setprio(0); } while (0)
#define PG8_WAIT_V(n) asm volatile("s_waitcnt vmcnt(" #n ")" ::: "memory")
#define PG8_WAIT_L(n) asm volatile("s_waitcnt lgkmcnt(" #n ")" ::: "memory")
#define PG8_BAR __builtin_amdgcn_s_barrier()
#define PG8_SCHED __builtin_amdgcn_sched_barrier(0)
#define PG8_AOFF(dst, u) do { _Pragma("unroll") for (int _h = 0; _h < 2; ++_h) _Pragma("unroll") for (int _i = 0; _i < 2; ++_i) dst[_h][_i] = (S.arow(u, _h * HALF + RA[_i]) * (unsigned)K + (unsigned)CA[_i]) * 2u; } while (0)
    Unit cur, nxt; int ui = 0;
    if (!S.next(0, cur)) return;
    f32x4 acc[2][2][4][2];
#pragma unroll
    for (int a = 0; a < 2; ++a)
#pragma unroll
        for (int b = 0; b < 2; ++b)
#pragma unroll
            for (int m = 0; m < 4; ++m)
#pragma unroll
                for (int n = 0; n < 2; ++n) acc[a][b][m][n] = (f32x4){0.f, 0.f, 0.f, 0.f};
    bf16x8 At[4][2], B0[2][2], B1[2][2];
    unsigned va[2][2], vn[2][2];
    PG8_AOFF(va, cur);
    const char* Ab = (const char*)g.A;
    const char* cB = (const char*)g.Bt + (size_t)cur.pn * tstep;
    PG8_STAGE(PG8_SB(0, 0), cB, voffB); PG8_STAGE(PG8_SB(0, 1), cB + hstep, voffB); PG8_STAGE(PG8_SA(0, 0), Ab, va[0]); PG8_STAGE(PG8_SA(0, 1), Ab, va[1]);
    if (wr == 1) PG8_BAR;
    PG8_WAIT_V(2); PG8_BAR;
    PG8_STAGE(PG8_SB(1, 0), cB + kstep, voffB); PG8_STAGE(PG8_SA(1, 0), Ab + kstep, va[0]); PG8_STAGE(PG8_SB(1, 1), cB + hstep + kstep, voffB);
    PG8_WAIT_V(6); PG8_BAR;
    for (;;) {
        const bool has_next = S.next(ui + 1, nxt);
        if (has_next) { PG8_AOFF(vn, nxt); }
        else {
#pragma unroll
            for (int h = 0; h < 2; ++h)
#pragma unroll
                for (int i = 0; i < 2; ++i) vn[h][i] = va[h][i]; }
        const char* nB = has_next ? (const char*)g.Bt + (size_t)nxt.pn * tstep : cB;
        for (int t = 0; t < nt; t += 2) {
            const bool last = (t == nt - 2);
            const char* a1 = Ab + (size_t)(t + 1) * kstep;
            const char* a2 = last ? Ab : Ab + (size_t)(t + 2) * kstep; const char* b2 = last ? nB : cB + (size_t)(t + 2) * kstep;
            const char* a3 = a2 + kstep; const char* b3 = b2 + kstep;
            unsigned o2[2][2];
#pragma unroll
            for (int h = 0; h < 2; ++h)
#pragma unroll
                for (int i = 0; i < 2; ++i) o2[h][i] = last ? vn[h][i] : va[h][i];
            PG8_LDB(B0, 0, 0); PG8_LDB(B1, 0, 1); PG8_SCHED; PG8_LDA(At, 0, 0); PG8_STAGE(PG8_SA(1, 1), a1, va[1]);
            PG8_WAIT_V(8); PG8_WAIT_L(0); PG8_BAR; PG8_MMA(0, 0, At, B0); PG8_MMA(0, 1, At, B1); PG8_BAR; PG8_SCHED;
            PG8_LDA(At, 0, 1); PG8_STAGE(PG8_SB(0, 0), b2, voffB); PG8_STAGE(PG8_SB(0, 1), b2 + hstep, voffB); PG8_STAGE(PG8_SA(0, 0), a2, o2[0]);
            PG8_WAIT_V(8); PG8_WAIT_L(0); PG8_BAR; PG8_MMA(1, 0, At, B0); PG8_MMA(1, 1, At, B1); PG8_BAR; PG8_SCHED;
            PG8_LDB(B0, 1, 0); PG8_LDB(B1, 1, 1); PG8_SCHED; PG8_LDA(At, 1, 0); PG8_STAGE(PG8_SA(0, 1), a2, o2[1]);
            PG8_WAIT_V(8); PG8_WAIT_L(0); PG8_BAR; PG8_MMA(0, 0, At, B0); PG8_MMA(0, 1, At, B1); PG8_BAR; PG8_SCHED;
            PG8_LDA(At, 1, 1); PG8_STAGE(PG8_SB(1, 0), b3, voffB); PG8_STAGE(PG8_SB(1, 1), b3 + hstep, voffB); PG8_STAGE(PG8_SA(1, 0), a3, o2[0]);
            PG8_WAIT_V(8); PG8_WAIT_L(0); PG8_BAR; PG8_MMA(1, 0, At, B0); PG8_MMA(1, 1, At, B1); PG8_BAR; PG8_SCHED;
        }
        if (wr == 0) PG8_BAR;
        E(acc, cur, wr, wc, fr, fq);
        if (!has_next) break;
#pragma unroll
        for (int a = 0; a < 2; ++a)
#pragma unroll
            for (int b = 0; b < 2; ++b)
#pragma unroll
                for (int m = 0; m < 4; ++m)
#pragma unroll
                    for (int n = 0; n < 2; ++n) acc[a][b][m][n] = (f32x4){0.f, 0.f, 0.f, 0.f};
        cur = nxt; cB = nB; ++ui;
#pragma unroll
        for (int h = 0; h < 2; ++h)
#pragma unroll
            for (int i = 0; i < 2; ++i) va[h][i] = vn[h][i];
        if (wr == 1) PG8_BAR;
    }
    PG8_WAIT_V(0);
    PG8_BAR;
#undef PG8_SA
#undef PG8_SB
#undef PG8_STAGE
#undef PG8_LDA
#undef PG8_LDB
#undef PG8_MMA
#undef PG8_WAIT_V
#undef PG8_WAIT_L
#undef PG8_BAR
#undef PG8_SCHED
#undef PG8_AOFF
}
}

#ifndef PROBE_SUB
#define PROBE_SUB 0
#endif
struct Ctx {
    LAS unsigned char* lds; unsigned char* ws;
    int tid, lane, wave, gw, ngw, G, bid;
    mutable unsigned long long sub, subt;
};
#define SUB_BEGIN(X, id) do { if (PROBE_SUB == (id)) (X).subt = __builtin_amdgcn_s_memrealtime(); } while (0)
#define SUB_END(X, id) do { if (PROBE_SUB == (id)) (X).sub += __builtin_amdgcn_s_memrealtime() - (X).subt; } while (0)

__device__ __forceinline__ void transpose_item(const float* W, int ldw, int K, int nvalid, int k0, int n0, bf16_t* WT, int row0, LAS float* scr, int lane) {
    const int c4 = (lane & 7) * 4, kr = lane >> 3;
    f32x4 v[8];
#pragma unroll
    for (int i = 0; i < 8; ++i) v[i] = (n0 + c4 < nvalid) ? *(const f32x4*)(W + (size_t)(k0 + kr + 8 * i) * ldw + n0 + c4) : (f32x4){0.f, 0.f, 0.f, 0.f};
#pragma unroll
    for (int i = 0; i < 8; ++i) { LAS float* d = scr + (kr + 8 * i) * 33 + c4; d[0] = v[i].x; d[1] = v[i].y; d[2] = v[i].z; d[3] = v[i].w; }
    LDS_WAIT(); asm volatile("" ::: "memory");
    const int c = lane & 7;
#pragma unroll
    for (int j = 0; j < 4; ++j) { const int n = (lane >> 3) + 8 * j; const LAS float* s = scr + (8 * c) * 33 + n;
        u32x4 o; o.x = pk2(s[0 * 33], s[1 * 33]); o.y = pk2(s[2 * 33], s[3 * 33]); o.z = pk2(s[4 * 33], s[5 * 33]); o.w = pk2(s[6 * 33], s[7 * 33]);
        *(u32x4*)(WT + (size_t)(row0 + n) * K + k0 + 8 * c) = o; }
    LDS_WAIT(); asm volatile("" ::: "memory");
}
__device__ __forceinline__ void ph_prologue(const Params& p, const Ctx& X) {
    LAS float* scr = (LAS float*)(X.lds + X.wave * 16384);
    unsigned char* ws = X.ws;
    constexpr int I_MOD = 2 * 96 * 8;
    constexpr int I_SK = 3 * 16, I_W1 = 2 * 32 * 4, I_WIN = 16 * 96, I_WV = 16 * 24, I_WOUT = 16 * 32, I_WSIN = 16 * 160, I_WSOUT = 32 * 32, I_GU = 64 * 1024, I_DN = 64 * 512;
    constexpr int NITEMS = I_MOD + I_SK + I_W1 + I_WIN + I_WV + I_WOUT + I_WSIN + I_WSOUT + I_GU + I_DN;
    for (int it = X.gw; it < NITEMS; it += X.ngw) {
        int r = it;
        if (r < I_MOD) {
            const int kp = r & 7, jb = (r >> 3) % 96, l = r / (8 * 96), j = jb * 64 + X.lane;
            const float* w = p.in[2] + (size_t)l * 1024 * 6144 + (size_t)(kp * 128) * 6144 + j;
            const float* c = p.in[1] + kp * 128;
            float a0 = 0.f, a1 = 0.f, a2 = 0.f, a3 = 0.f;
#pragma unroll 8
            for (int i = 0; i < 128; ++i) { const float wv = w[(size_t)i * 6144];
                a0 += siluf(c[i]) * wv; a1 += siluf(c[1024 + i]) * wv; a2 += siluf(c[2048 + i]) * wv; a3 += siluf(c[3072 + i]) * wv; }
            if (kp == 0) { const float bb = p.in[3][l * 6144 + j]; a0 += bb; a1 += bb; a2 += bb; a3 += bb; }
            unsigned long long* mq = (unsigned long long*)(ws + CTL_MOD) + (size_t)l * 4 * 6144 + j;
            atomicAdd(mq, (unsigned long long)__double2ll_rn((double)a0 * 1099511627776.0)); atomicAdd(mq + 6144, (unsigned long long)__double2ll_rn((double)a1 * 1099511627776.0));
            atomicAdd(mq + 2 * 6144, (unsigned long long)__double2ll_rn((double)a2 * 1099511627776.0)); atomicAdd(mq + 3 * 6144, (unsigned long long)__double2ll_rn((double)a3 * 1099511627776.0));
            continue;
        }
        r -= I_MOD;
        if (r < I_SK) {
            const int m = r >> 4, kb = r & 15, k0 = kb * 64;
            const float* W = m < 2 ? p.in[24] + (size_t)m * D * NE : p.in[16] + 5120; const int ldw = m < 2 ? NE : SSM_IN;
#pragma unroll 8
            for (int i = 0; i < 32; ++i) { const int kk = 2 * i + (X.lane >> 5); scr[kk * 33 + (X.lane & 31)] = W[(size_t)(k0 + kk) * ldw + (X.lane & 31)]; }
            LDS_WAIT(); asm volatile("" ::: "memory");
            const int c = X.lane & 7;
#pragma unroll
            for (int j = 0; j < 4; ++j) { const int n = (X.lane >> 3) + 8 * j; const LAS float* sp = scr + (8 * c) * 33 + n;
                float v[8]; unsigned hi[8];
#pragma unroll
                for (int q = 0; q < 8; ++q) { v[q] = sp[q * 33]; hi[q] = f2bf(v[q]); v[q] -= __uint_as_float(hi[q] << 16); }
                u32x4 oh, ol; oh.x = hi[0] | (hi[1] << 16); oh.y = hi[2] | (hi[3] << 16); oh.z = hi[4] | (hi[5] << 16); oh.w = hi[6] | (hi[7] << 16);
                ol.x = pk2(v[0], v[1]); ol.y = pk2(v[2], v[3]); ol.z = pk2(v[4], v[5]); ol.w = pk2(v[6], v[7]);
                bf16_t* dst = (bf16_t*)(ws + WS_SKW) + (size_t)m * 2 * 32 * 1024 + (size_t)n * 1024 + k0 + 8 * c;
                *(u32x4*)dst = oh; *(u32x4*)(dst + 32 * 1024) = ol; }
            LDS_WAIT(); asm volatile("" ::: "memory");
            continue; }
        r -= I_SK;
        if (r < I_W1) { const int kv = r >> 7, q = r & 127, kb = q >> 2, nb = q & 3;
            transpose_item(kv ? p.in[14] : p.in[12], 128, 2048, 128, kb * 64, nb * 32, (bf16_t*)(ws + WS_W1T) + (size_t)kv * 128 * 2048, nb * 32, scr, X.lane); continue; } r -= I_W1;
        if (r < I_WIN) { const int kb = r / 96, nb = r % 96; transpose_item(p.in[6], ATTN_IN, 1024, ATTN_IN, kb * 64, nb * 32, (bf16_t*)(ws + WS_WIN), nb * 32, scr, X.lane); continue; } r -= I_WIN;
        if (r < I_WV) { const int kb = r / 24, nb = r % 24, r0 = nb * 32, src = r0 < 512 ? OFF_SBV + r0 : (r0 < 640 ? OFF_VS + (r0 - 512) : OFF_VW + (r0 - 640));
            transpose_item(p.in[6], ATTN_IN, 1024, ATTN_IN, kb * 64, src, (bf16_t*)(ws + WS_WV), r0, scr, X.lane); continue; } r -= I_WV;
        if (r < I_WOUT) { const int kb = r / 32, nb = r % 32; transpose_item(p.in[7], 1024, 1024, 1024, kb * 64, nb * 32, (bf16_t*)(ws + WS_WOUT), nb * 32, scr, X.lane); continue; } r -= I_WOUT;
        if (r < I_WSIN) { const int kb = r / 160, nb = r % 160, n0 = nb * 32, row0 = n0 < 2048 ? n0 : (n0 < 4096 ? n0 + 1024 : n0 - 2048);
            transpose_item(p.in[16], SSM_IN, 1024, SSM_IN, kb * 64, n0, (bf16_t*)(ws + WS_WSIN), row0, scr, X.lane); continue; } r -= I_WSIN;
        if (r < I_WSOUT) { const int kb = r / 32, nb = r % 32; transpose_item(p.in[23], 1024, 2048, 1024, kb * 64, nb * 32, (bf16_t*)(ws + WS_WSOUT), nb * 32, scr, X.lane); continue; } r -= I_WSOUT;
        if (r < I_GU) { const int m = r >> 10, q = r & 1023, kb = q >> 6, nb = q & 63, n0 = nb * 32;
            const int row0 = ((n0 & 1023) >> 7) * 256 + (n0 >> 10) * 128 + (n0 & 127);
            transpose_item(p.in[26] + (size_t)m * 1024 * 2048, 2048, 1024, 2048, kb * 64, n0, (bf16_t*)(ws + WS_WGU) + (size_t)m * 2048 * 1024, row0, scr, X.lane); continue; } r -= I_GU;
        { const int m = r >> 9, q = r & 511, kb = q >> 5, nb = q & 31;
            transpose_item(p.in[28] + (size_t)m * 1024 * 1024, 1024, 1024, 1024, kb * 64, nb * 32, (bf16_t*)(ws + WS_WDN) + (size_t)m * 1024 * 1024, nb * 32, scr, X.lane); }
    }
}

struct Row { f32x4 v[4]; };
__device__ __forceinline__ void row_load(Row& r, const float* p, int lane) {
#pragma unroll
    for (int j = 0; j < 4; ++j) r.v[j] = ((const f32x4*)p)[64 * j + lane];
}
__device__ __forceinline__ void row_store(const Row& r, float* p, int lane) {
#pragma unroll
    for (int j = 0; j < 4; ++j) ((f32x4*)p)[64 * j + lane] = r.v[j];
}
template <class PV>
__device__ __forceinline__ void row_norm_mod(const Row& r, Row& o, const float* gain, PV sc, PV sh, int lane) {
    float ss = 0.f;
#pragma unroll
    for (int j = 0; j < 4; ++j) ss += (r.v[j].x * r.v[j].x + r.v[j].y * r.v[j].y) + (r.v[j].z * r.v[j].z + r.v[j].w * r.v[j].w);
    const float rs = rsqrtf(wave_sum(ss) * (1.f / 1024.f) + EPS);
#pragma unroll
    for (int j = 0; j < 4; ++j) { const f32x4 g = ((const f32x4*)gain)[64 * j + lane], a = sc[64 * j + lane], b = sh[64 * j + lane];
        o.v[j] = r.v[j] * rs * g * (a + 1.f) + b; }
}
__device__ __forceinline__ void row_store_bf16(const Row& r, bf16_t* p, int lane) {
#pragma unroll
    for (int j = 0; j < 4; ++j) { u32x2 w; w.x = pk2(r.v[j].x, r.v[j].y); w.y = pk2(r.v[j].z, r.v[j].w); ((u32x2*)p)[64 * j + lane] = w; }
}
__device__ __forceinline__ void row_store_lds(const Row& r, LAS float* p, int lane) {
#pragma unroll
    for (int j = 0; j < 4; ++j) ((LAS f32x4*)p)[64 * j + lane] = r.v[j];
}
__device__ __forceinline__ float modq2f(long long q) { return (float)((double)q * 9.094947017729282e-13); }
__device__ __forceinline__ void ph_norm0(const Params& p, const Ctx& X) {
    const long long* mq = (const long long*)(X.ws + CTL_MOD);
    float* modf = (float*)(X.ws + WS_MODF);
    for (int i = X.bid * NTHREADS + X.tid; i < 2 * 4 * 6144; i += X.G * NTHREADS) modf[i] = modq2f(mq[i]);
    LAS float* tab = (LAS float*)X.lds;
    for (int i = X.tid; i < 4 * 2048; i += NTHREADS) tab[i] = modq2f(mq[(size_t)(i >> 11) * 6144 + (i & 2047)]);
    __syncthreads();
    for (int t = X.gw; t < T; t += X.ngw) {
        Row r, o; row_load(r, p.in[0] + (size_t)t * D, X.lane);
        const LAS float* m = tab + (t / S) * 2048;
        row_norm_mod(r, o, p.in[4], (const LAS f32x4*)(m + 1024), (const LAS f32x4*)m, X.lane);
        row_store_bf16(o, (bf16_t*)(X.ws + WS_U) + (size_t)t * D, X.lane);
    }
}
__device__ __forceinline__ void route_select(float logit, int lane, LAS unsigned* lcnt, int& ev, float& wv, int& lpos) {
    const int e = lane & 31;
    float tl[4]; int te[4];
#pragma unroll
    for (int k = 0; k < 4; ++k) {
        float bv = logit; int bi = e;
#pragma unroll
        for (int o = 16; o > 0; o >>= 1) { const float ov = __shfl_xor(bv, o); const int oi = __shfl_xor(bi, o); if (ov > bv || (ov == bv && oi < bi)) { bv = ov; bi = oi; } }
        tl[k] = bv; te[k] = bi;
        if (e == bi) logit = -INFINITY;
    }
    ev = 0; wv = 0.f; lpos = 0;
    if (e < 4) {
        const float e1 = expf(tl[1] - tl[0]), e2 = expf(tl[2] - tl[0]), e3 = expf(tl[3] - tl[0]);
        const float inv = 1.f / (1.f + e1 + e2 + e3);
        wv = (e == 0 ? 1.f : e == 1 ? e1 : e == 2 ? e2 : e3) * inv;
        ev = e == 0 ? te[0] : e == 1 ? te[1] : e == 2 ? te[2] : te[3];
        lpos = (int)__hip_atomic_fetch_add(&lcnt[ev], 1u, __ATOMIC_RELAXED, __HIP_MEMORY_SCOPE_WORKGROUP);
    }
}
__device__ __forceinline__ void moe_table(const Ctx& X, int l) {
    LAS int* tb = (LAS int*)(X.lds + TAB_OFF);
    if (X.wave == 0) {
        const unsigned* cnt = (const unsigned*)(X.ws + WS_CTL) + CW_CNT + l * 32 * 32;
        const int e = X.lane & 31;
        const int c = (int)__hip_atomic_load(cnt + e * 32, __ATOMIC_RELAXED, __HIP_MEMORY_SCOPE_AGENT), nt = (c + 255) >> 8;
        int incl = nt;
#pragma unroll
        for (int o = 1; o < 32; o <<= 1) { const int u = __shfl_up(incl, o); if (e >= o) incl += u; }
        if (X.lane < 32) { tb[e] = incl - nt; tb[40 + e] = c; if (e == 31) tb[NE] = incl; }
    }
    __syncthreads();
}
template <int MODE>
__device__ __forceinline__ void ph_token(const Params& p, const Ctx& X, int l, const float* h, float* hn) {
    if (MODE != 0) moe_table(X, l);
    const LAS int* tb = (const LAS int*)(X.lds + TAB_OFF);
    const float* modl = (const float*)(X.ws + WS_MODF) + (size_t)l * 4 * 6144;
    const float* modn = (const float*)(X.ws + WS_MODF) + (size_t)(MODE == 1 ? 1 : l) * 4 * 6144;
    const float* gain = MODE == 1 ? p.in[4] + D : p.in[5] + l * D;
    const int sc_off = MODE == 1 ? 1024 : 4096, sh_off = MODE == 1 ? 0 : 3072;
    const bf16_t* y = (const bf16_t*)(X.ws + WS_Y);
    LAS float* rsl = (LAS float*)X.lds;
    LAS float* part = (LAS float*)(X.lds + 1024);
    if (MODE == 0 && X.tid < 32) ((LAS unsigned*)(X.lds + 1024 + 65536))[X.tid] = 0u;
    for (int tile = X.bid; tile < T / 64; tile += X.G) {
        const int lane = fresh(X.lane), w = X.wave, tb0 = tile * 64, bb = tb0 / S;
        int pe_ = 0, pp_ = 0; float pw_ = 0.f;
        if (MODE != 0 && lane < 32) { const int idx = (tb0 + 8 * w) * 4 + lane; pe_ = ((const int*)(X.ws + WS_TOKE))[idx]; pp_ = ((const int*)(X.ws + WS_TOKP))[idx]; pw_ = ((const float*)(X.ws + WS_TOKW))[idx]; }
#pragma unroll 1
        for (int k2 = 0; k2 < 4; ++k2) {
            Row r[2];
#pragma unroll
            for (int u = 0; u < 2; ++u) row_load(r[u], h + (size_t)(tb0 + 8 * w + 2 * k2 + u) * D, lane);
            if (MODE != 0) {
                const float* g2 = modl + (size_t)bb * 6144 + 5120;
                Row sacc[2];
#pragma unroll
                for (int u = 0; u < 2; ++u) {
#pragma unroll
                    for (int j = 0; j < 4; ++j) sacc[u].v[j] = (f32x4){0.f, 0.f, 0.f, 0.f};
#pragma unroll
                    for (int kk = 0; kk < 4; ++kk) {
                        const int sl = (2 * k2 + u) * 4 + kk;
                        const int e = __shfl(pe_, sl), pos = __shfl(pp_, sl); const float wt = __shfl(pw_, sl);
                        const bf16_t* yr = y + (size_t)(tb[e] * 256 + pos) * D;
#pragma unroll
                        for (int j = 0; j < 4; ++j) { const u32x2 q = ((const u32x2*)yr)[64 * j + lane];
                            sacc[u].v[j].x += wt * bflo(q.x); sacc[u].v[j].y += wt * bfhi(q.x); sacc[u].v[j].z += wt * bflo(q.y); sacc[u].v[j].w += wt * bfhi(q.y); }
                    }
                }
#pragma unroll
                for (int u = 0; u < 2; ++u) {
#pragma unroll
                    for (int j = 0; j < 4; ++j) r[u].v[j] = r[u].v[j] + ((const f32x4*)g2)[64 * j + lane] * sacc[u].v[j];
                    row_store(r[u], hn + (size_t)(tb0 + 8 * w + 2 * k2 + u) * D, lane);
                }
            }
            if (MODE != 2) {
                const float* m = modn + (size_t)bb * 6144;
#pragma unroll
                for (int u = 0; u < 2; ++u) {
                    float ssq = 0.f;
#pragma unroll
                    for (int j = 0; j < 4; ++j) ssq += (r[u].v[j].x * r[u].v[j].x + r[u].v[j].y * r[u].v[j].y) + (r[u].v[j].z * r[u].v[j].z + r[u].v[j].w * r[u].v[j].w);
                    const float rs = rsqrtf(wave_sum(ssq) * (1.f / 1024.f) + EPS);
                    Row o;
#pragma unroll
                    for (int j = 0; j < 4; ++j) { const f32x4 g = ((const f32x4*)gain)[64 * j + lane], a = ((const f32x4*)(m + sc_off))[64 * j + lane], b = ((const f32x4*)(m + sh_off))[64 * j + lane];
                        o.v[j] = r[u].v[j] * rs * g * (a + 1.f) + b; }
                    row_store_bf16(o, (bf16_t*)(X.ws + WS_U) + (size_t)(tb0 + 8 * w + 2 * k2 + u) * D, lane);
                    if (lane == 0) rsl[8 * w + 2 * k2 + u] = rs;
                }
            }
        }
        if (MODE == 2) continue;
        __syncthreads();
        {
            const int ql = lane & 31, hf = lane >> 5;
            const float* src = MODE == 0 ? h : hn;
            const float* m = modn + (size_t)bb * 6144;
            const bf16_t* wh = (const bf16_t*)(X.ws + WS_SKW) + (size_t)(MODE == 0 ? l : 2) * 2 * 32 * 1024 + (size_t)ql * 1024;
            const float rs0 = rsl[ql], rs1 = rsl[32 + ql];
            f32x16 acc0, acc1;
#pragma unroll
            for (int i = 0; i < 16; ++i) { acc0[i] = 0.f; acc1[i] = 0.f; }
#pragma unroll 2
            for (int ks = 0; ks < 8; ++ks) {
                const int k0 = 128 * w + 16 * ks + 8 * hf;
                float ca[8], cb[8];
                { const f32x4 g0 = *(const f32x4*)(gain + k0), g1 = *(const f32x4*)(gain + k0 + 4), a0 = *(const f32x4*)(m + sc_off + k0), a1 = *(const f32x4*)(m + sc_off + k0 + 4),
                              b0 = *(const f32x4*)(m + sh_off + k0), b1 = *(const f32x4*)(m + sh_off + k0 + 4);
                  ca[0] = g0.x * (1.f + a0.x); ca[1] = g0.y * (1.f + a0.y); ca[2] = g0.z * (1.f + a0.z); ca[3] = g0.w * (1.f + a0.w);
                  ca[4] = g1.x * (1.f + a1.x); ca[5] = g1.y * (1.f + a1.y); ca[6] = g1.z * (1.f + a1.z); ca[7] = g1.w * (1.f + a1.w);
                  cb[0] = b0.x; cb[1] = b0.y; cb[2] = b0.z; cb[3] = b0.w; cb[4] = b1.x; cb[5] = b1.y; cb[6] = b1.z; cb[7] = b1.w; }
                const bf16x8 whi = *(const bf16x8*)(wh + k0), wlo = *(const bf16x8*)(wh + 32 * 1024 + k0);
#pragma unroll
                for (int mt = 0; mt < 2; ++mt) {
                    const float* xr = src + (size_t)(tb0 + 32 * mt + ql) * D + k0;
                    const f32x4 x0 = *(const f32x4*)xr, x1 = *(const f32x4*)(xr + 4);
                    const float rs = mt ? rs1 : rs0;
                    const float xv[8] = {x0.x, x0.y, x0.z, x0.w, x1.x, x1.y, x1.z, x1.w};
                    float u[8]; unsigned hi[8];
#pragma unroll
                    for (int q = 0; q < 8; ++q) { u[q] = xv[q] * rs * ca[q] + cb[q]; hi[q] = f2bf(u[q]); u[q] -= __uint_as_float(hi[q] << 16); }
                    u32x4 oh, ol; oh.x = hi[0] | (hi[1] << 16); oh.y = hi[2] | (hi[3] << 16); oh.z = hi[4] | (hi[5] << 16); oh.w = hi[6] | (hi[7] << 16);
                    ol.x = pk2(u[0], u[1]); ol.y = pk2(u[2], u[3]); ol.z = pk2(u[4], u[5]); ol.w = pk2(u[6], u[7]);
                    const bf16x8 ah = __builtin_bit_cast(bf16x8, oh), al = __builtin_bit_cast(bf16x8, ol);
                    if (mt == 0) { acc0 = __builtin_amdgcn_mfma_f32_32x32x16_bf16(ah, whi, acc0, 0, 0, 0); acc0 = __builtin_amdgcn_mfma_f32_32x32x16_bf16(al, whi, acc0, 0, 0, 0); acc0 = __builtin_amdgcn_mfma_f32_32x32x16_bf16(ah, wlo, acc0, 0, 0, 0); }
                    else { acc1 = __builtin_amdgcn_mfma_f32_32x32x16_bf16(ah, whi, acc1, 0, 0, 0); acc1 = __builtin_amdgcn_mfma_f32_32x32x16_bf16(al, whi, acc1, 0, 0, 0); acc1 = __builtin_amdgcn_mfma_f32_32x32x16_bf16(ah, wlo, acc1, 0, 0, 0); }
                }
            }
#pragma unroll
            for (int i = 0; i < 16; ++i) { const int row = 8 * (i >> 2) + 4 * hf + (i & 3); part[(w * 64 + row) * 32 + ql] = acc0[i]; part[(w * 64 + 32 + row) * 32 + ql] = acc1[i]; }
        }
        __syncthreads();
        {
            const int e = lane & 31, hf = lane >> 5;
            LAS unsigned* lcnt = (LAS unsigned*)(X.lds + 1024 + 65536);
            int ev[4], lp[4]; float wv[4];
#pragma unroll
            for (int k = 0; k < 4; ++k) {
                const int tl = 8 * w + 4 * hf + k;
                float v = 0.f;
#pragma unroll
                for (int ww = 0; ww < 8; ++ww) v += part[(ww * 64 + tl) * 32 + e];
                if (MODE == 0) route_select(v + p.in[25][l * NE + e], lane, lcnt, ev[k], wv[k], lp[k]);
                else ((float*)(X.ws + WS_DT))[(size_t)(tb0 + tl) * 32 + e] = v;
            }
            if (MODE == 0) {
                __syncthreads();
                if (X.tid < 32) { const unsigned n = lcnt[X.tid]; unsigned* cnt = (unsigned*)(X.ws + WS_CTL) + CW_CNT + (l * 32 + X.tid) * 32;
                    lcnt[32 + X.tid] = n ? atomicAdd(cnt, n) : 0u; }
                __syncthreads();
                if (e < 4) {
#pragma unroll
                    for (int k = 0; k < 4; ++k) { const int t = tb0 + 8 * w + 4 * hf + k, pos = (int)lcnt[32 + ev[k]] + lp[k];
                        ((int*)(X.ws + WS_TOKE))[t * 4 + e] = ev[k]; ((float*)(X.ws + WS_TOKW))[t * 4 + e] = wv[k]; ((int*)(X.ws + WS_TOKP))[t * 4 + e] = pos;
                        ((int*)(X.ws + WS_SLOT))[ev[k] * CAP + pos] = t; }
                }
            }
        }
        __syncthreads();
        if (MODE == 0 && X.tid < 32) ((LAS unsigned*)(X.lds + 1024 + 65536))[X.tid] = 0u;
    }
}

__device__ __forceinline__ void ld64bf(const bf16_t* p, float (&q)[64]) {
#pragma unroll
    for (int i = 0; i < 8; ++i) { const u32x4 w = ((const u32x4*)p)[i];
        q[8 * i] = bflo(w.x); q[8 * i + 1] = bfhi(w.x); q[8 * i + 2] = bflo(w.y); q[8 * i + 3] = bfhi(w.y); q[8 * i + 4] = bflo(w.z); q[8 * i + 5] = bfhi(w.z); q[8 * i + 6] = bflo(w.w); q[8 * i + 7] = bfhi(w.w); }
}
__device__ __forceinline__ float dot64bf(const bf16_t* p, const float (&q)[64]) {
    float d = 0.f;
#pragma unroll
    for (int i = 0; i < 8; ++i) { const u32x4 w = ((const u32x4*)p)[i];
        d += q[8 * i] * bflo(w.x) + q[8 * i + 1] * bfhi(w.x) + q[8 * i + 2] * bflo(w.y) + q[8 * i + 3] * bfhi(w.y) + q[8 * i + 4] * bflo(w.z) + q[8 * i + 5] * bfhi(w.z) + q[8 * i + 6] * bflo(w.w) + q[8 * i + 7] * bfhi(w.w); }
    return d;
}
__device__ __forceinline__ float dot64f(const float* p, const float (&q)[64]) {
    float d = 0.f;
#pragma unroll
    for (int i = 0; i < 16; ++i) { const f32x4 w = ((const f32x4*)p)[i]; d += (q[4 * i] * w.x + q[4 * i + 1] * w.y) + (q[4 * i + 2] * w.z + q[4 * i + 3] * w.w); }
    return d;
}
__device__ __forceinline__ void sb_unit(const Ctx& X, int qt, int bh) {
    const int b = bh >> 3, hh = bh & 7, t = qt * 64 + X.lane;
    const bf16_t* base = (const bf16_t*)(X.ws + WS_BIG) + (size_t)b * S * PROJ_LD;
    float q[64], acc[64];
    ld64bf(base + (size_t)t * PROJ_LD + OFF_SBQ + hh * 64, q);
#pragma unroll
    for (int d = 0; d < 64; ++d) acc[d] = 0.f;
    float run = 0.f;
    for (int j = qt * 64 + 62; j >= 0; --j) {
        const bf16_t* kr = base + (size_t)j * PROJ_LD + OFF_SBK + hh * 64;
        const float logit = dot64bf(kr, q) * 0.125f;
        if (j < t) {
            const float w = expf(logsig(logit) + run);
            run += logsig(-logit);
            const bf16_t* vr = base + (size_t)j * PROJ_LD + OFF_SBV + hh * 64;
#pragma unroll
            for (int i = 0; i < 8; ++i) { const u32x4 v = ((const u32x4*)vr)[i];
                acc[8 * i] += w * bflo(v.x); acc[8 * i + 1] += w * bfhi(v.x); acc[8 * i + 2] += w * bflo(v.y); acc[8 * i + 3] += w * bfhi(v.y);
                acc[8 * i + 4] += w * bflo(v.z); acc[8 * i + 5] += w * bfhi(v.z); acc[8 * i + 6] += w * bflo(v.w); acc[8 * i + 7] += w * bfhi(v.w); }
        }
    }
    bf16_t* op = (bf16_t*)(X.ws + WS_O) + (size_t)(b * S + t) * D + hh * 64;
#pragma unroll
    for (int i = 0; i < 8; ++i) { u32x4 w; w.x = pk2(acc[8 * i], acc[8 * i + 1]); w.y = pk2(acc[8 * i + 2], acc[8 * i + 3]); w.z = pk2(acc[8 * i + 4], acc[8 * i + 5]); w.w = pk2(acc[8 * i + 6], acc[8 * i + 7]);
        ((u32x4*)op)[i] = w; }
}

#define DMA16(gptr, ldsptr) __builtin_amdgcn_global_load_lds((const unsigned*)(gptr), (LAS unsigned*)(ldsptr), 16, 0, 0)
#define RING2_WAIT_BAR(q, nb) do { const int issued_ = (q) + 6 < (nb) ? (q) + 6 : (nb); const int need_ = (q) + 2 < (nb) ? (q) + 2 : (nb); const int fl_ = issued_ - need_; \
        if (fl_ >= 4) asm volatile("s_waitcnt vmcnt(8)\n\ts_barrier" ::: "memory"); else if (fl_ == 3) asm volatile("s_waitcnt vmcnt(6)\n\ts_barrier" ::: "memory"); \
        else if (fl_ == 2) asm volatile("s_waitcnt vmcnt(4)\n\ts_barrier" ::: "memory"); else if (fl_ == 1) asm volatile("s_waitcnt vmcnt(2)\n\ts_barrier" ::: "memory"); \
        else asm volatile("s_waitcnt vmcnt(0)\n\ts_barrier" ::: "memory"); } while (0)
__device__ __forceinline__ int pi32(int r) { return (r & 0x13) | ((r & 4) << 1) | ((r & 8) >> 1); }
__device__ __forceinline__ void sb_attn_unit(const Ctx& X, int bh, int qb) {
    const int b = bh >> 3, h = bh & 7, q0 = qb * 256, lane = fresh(X.lane), w = X.wave, ql = lane & 31, hf = lane >> 5;
    const bf16_t* proj = (const bf16_t*)(X.ws + WS_BIG) + (size_t)b * S * PROJ_LD;
    const bf16_t* vt = (const bf16_t*)(X.ws + WS_VT) + (size_t)(h * 64) * T + (size_t)b * S;
    const int tq = q0 + 32 * w + ql;
    bf16x8 qf[4];
#pragma unroll
    for (int s = 0; s < 4; ++s) qf[s] = *(const bf16x8*)(proj + (size_t)tq * PROJ_LD + OFF_SBQ + h * 64 + 16 * s + 8 * hf);
    f32x16 o0, o1;
#pragma unroll
    for (int i = 0; i < 16; ++i) { o0[i] = 0.f; o1[i] = 0.f; }
    float run = 1.f;
    const int nblk = 4 * qb + 4, jw = (q0 + 32 * w + 30) >> 6;
    const float CS = 0.125f * 1.4426950408889634f;
    const bf16_t* kg = proj + (size_t)lane * PROJ_LD + OFF_SBK + h * 64 + 8 * w;
    const bf16_t* vg = vt + (size_t)lane * T + 8 * w;
    LAS unsigned char* ring = X.lds + w * 1024;
    const int krow = pi32(ql) * 16;
    asm volatile("s_waitcnt vmcnt(0)" ::: "memory");
#pragma unroll
    for (int d = 0; d < 6; ++d) if (d < nblk) { DMA16(kg + (size_t)(64 * (nblk - 1 - d)) * PROJ_LD, ring + d * 16384); DMA16(vg + 64 * (nblk - 1 - d), ring + d * 16384 + 8192); }
    for (int q = 0; q < nblk; ++q) {
        const int j = nblk - 1 - q;
        if ((q & 1) == 0) {
            SUB_BEGIN(X, 11);
            RING2_WAIT_BAR(q, nblk);
            SUB_END(X, 11);
#pragma unroll
            for (int d = 6; d < 8; ++d) if (q + d < nblk) { const int jj = nblk - 1 - (q + d), sl = (q + d) & 7; DMA16(kg + (size_t)(64 * jj) * PROJ_LD, ring + sl * 16384); DMA16(vg + 64 * jj, ring + sl * 16384 + 8192); }
        }
        LAS unsigned char* buf = X.lds + (q & 7) * 16384;
        SUB_BEGIN(X, 12);
        if (j <= jw) {
            const bool diag = 64 * j + 63 >= q0 + 32 * w;
#pragma unroll
            for (int kt = 1; kt >= 0; --kt) {
                f32x16 sc;
#pragma unroll
                for (int i = 0; i < 16; ++i) sc[i] = 0.f;
#pragma unroll
                for (int s = 0; s < 4; ++s) { const bf16x8 kf = *(const LAS bf16x8*)(buf + (2 * s + hf) * 1024 + kt * 512 + krow); sc = __builtin_amdgcn_mfma_f32_32x32x16_bf16(kf, qf[s], sc, 0, 0, 0); }
                f32x16 ee = sc * (-CS), be, kp;
#pragma unroll
                for (int i = 0; i < 16; ++i) ee[i] = __builtin_amdgcn_exp2f(ee[i]);
                be = ee + 1.f;
#pragma unroll
                for (int i = 0; i < 16; ++i) be[i] = __builtin_amdgcn_rcpf(be[i]);
                kp = ee * be;
                if (diag) {
                    asm volatile("; diagonal block: masks" ::: "memory");
                    const int pos0 = 64 * j + 32 * kt + 8 * hf;
#pragma unroll
                    for (int i = 0; i < 16; ++i) { const bool valid = (pos0 + 16 * (i >> 3) + (i & 7)) < tq; be[i] = valid ? be[i] : 0.f; kp[i] = valid ? kp[i] : 1.f; }
                }
                float l1 = 1.f, l0 = 1.f;
#pragma unroll
                for (int i = 15; i >= 8; --i) { const float t = be[i] * l1; l1 *= kp[i]; be[i] = t; }
#pragma unroll
                for (int i = 7; i >= 0; --i) { const float t = be[i] * l0; l0 *= kp[i]; be[i] = t; }
                const float p1 = __shfl_xor(l1, 32), p0 = __shfl_xor(l0, 32);
                const float hi1 = hf ? l1 : p1, lo1 = hf ? p1 : l1, hi0 = hf ? l0 : p0, lo0 = hf ? p0 : l0;
                const float r1 = run * hi1, r2 = r1 * lo1, r3 = r2 * hi0;
                const float pre_up = hf ? run : r1, pre_lo = hf ? r2 : r3;
                run = r3 * lo0;
#pragma unroll
                for (int a = 0; a < 2; ++a) {
                    const float pre = a ? pre_up : pre_lo;
                    u32x4 pw; pw.x = pk2(be[8 * a] * pre, be[8 * a + 1] * pre); pw.y = pk2(be[8 * a + 2] * pre, be[8 * a + 3] * pre); pw.z = pk2(be[8 * a + 4] * pre, be[8 * a + 5] * pre); pw.w = pk2(be[8 * a + 6] * pre, be[8 * a + 7] * pre);
                    const bf16x8 pf = __builtin_bit_cast(bf16x8, pw);
                    const bf16x8 v0 = *(const LAS bf16x8*)(buf + 8192 + (4 * kt + 2 * a + hf) * 1024 + ql * 16);
                    const bf16x8 v1 = *(const LAS bf16x8*)(buf + 8192 + (4 * kt + 2 * a + hf) * 1024 + 512 + ql * 16);
                    o0 = __builtin_amdgcn_mfma_f32_32x32x16_bf16(v0, pf, o0, 0, 0, 0);
                    o1 = __builtin_amdgcn_mfma_f32_32x32x16_bf16(v1, pf, o1, 0, 0, 0);
                }
            }
        }
        SUB_END(X, 12);
    }
    asm volatile("s_barrier" ::: "memory");
    bf16_t* op = (bf16_t*)(X.ws + WS_O) + (size_t)(b * S + fresh(tq)) * D + h * 64 + 4 * hf;
#pragma unroll
    for (int g4 = 0; g4 < 4; ++g4) {
        u32x2 w0; w0.x = pk2(o0[4 * g4], o0[4 * g4 + 1]); w0.y = pk2(o0[4 * g4 + 2], o0[4 * g4 + 3]); *(u32x2*)(op + 8 * g4) = w0;
        u32x2 w1; w1.x = pk2(o1[4 * g4], o1[4 * g4 + 1]); w1.y = pk2(o1[4 * g4 + 2], o1[4 * g4 + 3]); *(u32x2*)(op + 32 + 8 * g4) = w1;
    }
}
__device__ __forceinline__ void ph_sb(const Ctx& X) {
    for (int pr = X.bid; pr < 256; pr += X.G)
#pragma unroll 1
        for (int u = 0; u < 2; ++u) { const int bh = pr >> 3, qa = pr & 7; sb_attn_unit(X, bh, u ? qa : 15 - qa); }
}
__device__ __forceinline__ void ph_attn_a(const Params& p, const Ctx& X) {
    const bf16_t* proj = (const bf16_t*)(X.ws + WS_BIG);
    for (int unit = X.bid; unit < 128; unit += X.G) {
        const int kv = unit >> 6, bg = (unit >> 3) & 7, ntile = unit & 7, b = bg >> 1, g = bg & 1, lane = fresh(X.lane), w = X.wave, ql = lane & 31, hf = lane >> 5;
        const int n = min(32 * ntile + ql, NCMP - 1);
        const float* pe = kv ? p.in[11] : p.in[10];
        const bf16_t* w1t = (const bf16_t*)(X.ws + WS_W1T) + (size_t)kv * 128 * 2048;
        const bf16_t* arow = proj + (size_t)(b * S + n * 16) * PROJ_LD + (kv ? OFF_VC : OFF_KC) + g * 64;
        f32x16 acc[4];
#pragma unroll
        for (int ct = 0; ct < 4; ++ct)
#pragma unroll
            for (int i = 0; i < 16; ++i) acc[ct][i] = 0.f;
        for (int ks = 0; ks < 16; ++ks) {
            const int k0 = 256 * w + 16 * ks + 8 * hf, l = k0 >> 6, d = k0 & 63;
            const u32x4 q = *(const u32x4*)(arow + (size_t)l * PROJ_LD + d);
            const f32x4 e0 = *(const f32x4*)(pe + k0), e1 = *(const f32x4*)(pe + k0 + 4);
            u32x4 o; o.x = pk2(bflo(q.x) + e0.x, bfhi(q.x) + e0.y); o.y = pk2(bflo(q.y) + e0.z, bfhi(q.y) + e0.w); o.z = pk2(bflo(q.z) + e1.x, bfhi(q.z) + e1.y); o.w = pk2(bflo(q.w) + e1.z, bfhi(q.w) + e1.w);
            const bf16x8 af = __builtin_bit_cast(bf16x8, o);
#pragma unroll
            for (int ct = 0; ct < 4; ++ct) acc[ct] = __builtin_amdgcn_mfma_f32_32x32x16_bf16(af, *(const bf16x8*)(w1t + (size_t)(32 * ct + ql) * 2048 + k0), acc[ct], 0, 0, 0);
        }
        LAS float* part = (LAS float*)X.lds;
#pragma unroll
        for (int ct = 0; ct < 4; ++ct)
#pragma unroll
            for (int i = 0; i < 16; ++i) part[w * 4096 + (8 * (i >> 2) + 4 * hf + (i & 3)) * 128 + 32 * ct + ql] = acc[ct][i];
        __syncthreads();
        LAS float* hid = part;
        {
            const int tidf = fresh(X.tid);
#pragma unroll
            for (int k = 0; k < 8; ++k) { const int e = tidf + NTHREADS * k; float v = 0.f;
#pragma unroll
                for (int ww = 0; ww < 8; ++ww) v += part[ww * 4096 + e];
                hid[e] = siluf(v); }
        }
        __syncthreads();
        {
            const int tidf = fresh(X.tid), row = tidf >> 4, c4 = (tidf & 15) * 4;
            const float* w2 = kv ? p.in[15] : p.in[13];
            f32x4 o = (f32x4){0.f, 0.f, 0.f, 0.f};
            for (int j = 0; j < 128; ++j) o = o + *(const f32x4*)(w2 + j * 64 + c4) * hid[row * 128 + j];
            const int nn = 32 * ntile + row;
            if (kv == 0) {
                float ssq = (o.x * o.x + o.y * o.y) + (o.z * o.z + o.w * o.w);
                ssq += __shfl_xor(ssq, 1); ssq += __shfl_xor(ssq, 2); ssq += __shfl_xor(ssq, 4); ssq += __shfl_xor(ssq, 8);
                const float r = rsqrtf(ssq * (1.f / 64.f) + EPS); const f32x4 gn = *(const f32x4*)(p.in[9] + c4);
                o = o * r * gn;
                if (nn >= NCMP) o = (f32x4){0.f, 0.f, 0.f, 0.f};
                u32x2 wv; wv.x = pk2(o.x, o.y); wv.y = pk2(o.z, o.w);
                *(u32x2*)((bf16_t*)(X.ws + WS_KCB) + ((size_t)bg * 256 + nn) * 64 + c4) = wv;
            } else {
                if (nn >= NCMP) o = (f32x4){0.f, 0.f, 0.f, 0.f};
                bf16_t* vt = (bf16_t*)(X.ws + WS_VCT) + ((size_t)bg * 64 + c4) * 256 + nn;
                vt[0] = (bf16_t)f2bf(o.x); vt[256] = (bf16_t)f2bf(o.y); vt[512] = (bf16_t)f2bf(o.z); vt[768] = (bf16_t)f2bf(o.w);
            }
        }
        __syncthreads();
    }
    for (int t2 = X.gw; t2 < T / 2; t2 += X.ngw) {
        const int lane = fresh(X.lane), sub = lane & 7;
#pragma unroll
        for (int k = 0; k < 2; ++k) {
            const int t = 2 * t2 + k;
            const u32x4 q = *(const u32x4*)(proj + (size_t)t * PROJ_LD + OFF_NQ + 8 * lane);
            float v[8] = {bflo(q.x), bfhi(q.x), bflo(q.y), bfhi(q.y), bflo(q.z), bfhi(q.z), bflo(q.w), bfhi(q.w)};
            float ssq = 0.f;
#pragma unroll
            for (int i = 0; i < 8; ++i) ssq += v[i] * v[i];
            ssq += __shfl_xor(ssq, 1); ssq += __shfl_xor(ssq, 2); ssq += __shfl_xor(ssq, 4);
            const float r = rsqrtf(ssq * (1.f / 64.f) + EPS) * (0.125f * 1.4426950408889634f);
            const f32x4 g0 = *(const f32x4*)(p.in[8] + 8 * sub), g1 = *(const f32x4*)(p.in[8] + 8 * sub + 4);
            u32x4 o; o.x = pk2(v[0] * r * g0.x, v[1] * r * g0.y); o.y = pk2(v[2] * r * g0.z, v[3] * r * g0.w); o.z = pk2(v[4] * r * g1.x, v[5] * r * g1.y); o.w = pk2(v[6] * r * g1.z, v[7] * r * g1.w);
            *(u32x4*)((bf16_t*)(X.ws + WS_QNB) + (size_t)t * 512 + 8 * lane) = o;
        }
        {
            const int t = 2 * t2 + (lane >> 5), l32 = lane & 31, isw = l32 >> 4, c = 8 * (l32 & 15);
            const u32x4 q = *(const u32x4*)(proj + (size_t)t * PROJ_LD + (isw ? OFF_KW : OFF_KS) + c);
            float v[8] = {bflo(q.x), bfhi(q.x), bflo(q.y), bfhi(q.y), bflo(q.z), bfhi(q.z), bflo(q.w), bfhi(q.w)};
            float ssq = 0.f;
#pragma unroll
            for (int i = 0; i < 8; ++i) ssq += v[i] * v[i];
            ssq += __shfl_xor(ssq, 1); ssq += __shfl_xor(ssq, 2); ssq += __shfl_xor(ssq, 4);
            const float r = rsqrtf(ssq * (1.f / 64.f) + EPS);
            const float* gn = p.in[9] + (isw ? 128 : 64) + 8 * sub;
            const f32x4 g0 = *(const f32x4*)gn, g1 = *(const f32x4*)(gn + 4);
            u32x4 o; o.x = pk2(v[0] * r * g0.x, v[1] * r * g0.y); o.y = pk2(v[2] * r * g0.z, v[3] * r * g0.w); o.z = pk2(v[4] * r * g1.x, v[5] * r * g1.y); o.w = pk2(v[6] * r * g1.z, v[7] * r * g1.w);
            *(u32x4*)((bf16_t*)(X.ws + (isw ? WS_KWN : WS_KSN)) + (size_t)t * 128 + c) = o;
        }
    }
}
struct NsaSt { f32x16 o0, o1; float m, l; };
template <int MODE>
__device__ __forceinline__ void nsa_flash(const Ctx& X, const bf16_t* kg, const bf16_t* vg, int jlo, int jhi, const bf16x8 (&qf)[4], int tq, float slope2,
                                          unsigned long long mymask, unsigned long long wavemask, NsaSt& st) {
    const int lane = fresh(X.lane), w = X.wave, ql = lane & 31, hf = lane >> 5;
    LAS unsigned char* ring = X.lds + w * 1024;
    const int krow = pi32(ql) * 16, nb = jhi - jlo + 1;
    asm volatile("s_waitcnt vmcnt(0)" ::: "memory");
#pragma unroll
    for (int d = 0; d < 6; ++d) if (d < nb) { DMA16(kg + (size_t)(64 * (jhi - d)) * 128, ring + d * 16384); DMA16(vg + 64 * (jhi - d), ring + d * 16384 + 8192); }
    f32x16 sl;
#pragma unroll
    for (int i = 0; i < 16; ++i) sl[i] = slope2 * (float)(16 * (i >> 3) + (i & 7));
    const float k32 = slope2 * 32.f;
    for (int q = 0; q < nb; ++q) {
        const int j = jhi - q;
        if ((q & 1) == 0) {
            RING2_WAIT_BAR(q, nb);
#pragma unroll
            for (int d = 6; d < 8; ++d) if (q + d < nb) { const int jj = jhi - (q + d), sl2 = (q + d) & 7; DMA16(kg + (size_t)(64 * jj) * 128, ring + sl2 * 16384); DMA16(vg + 64 * jj, ring + sl2 * 16384 + 8192); }
        }
        LAS unsigned char* buf = X.lds + (q & 7) * 16384;
        if (MODE == 1 || ((wavemask >> j) & 1ull)) {
            f32x16 s0, s1;
#pragma unroll
            for (int i = 0; i < 16; ++i) { s0[i] = 0.f; s1[i] = 0.f; }
#pragma unroll
            for (int s = 0; s < 4; ++s) {
                const bf16x8 k0 = *(const LAS bf16x8*)(buf + (2 * s + hf) * 1024 + krow), k1 = *(const LAS bf16x8*)(buf + (2 * s + hf) * 1024 + 512 + krow);
                s0 = __builtin_amdgcn_mfma_f32_32x32x16_bf16(k0, qf[s], s0, 0, 0, 0); s1 = __builtin_amdgcn_mfma_f32_32x32x16_bf16(k1, qf[s], s1, 0, 0, 0);
            }
            const int d0 = tq - (64 * j + 8 * hf);
            if (j == jhi || (MODE == 1 && j == jlo)) {
                asm volatile("; boundary block: masks" ::: "memory");
#pragma unroll
                for (int i = 0; i < 16; ++i) {
                    const int da = d0 - (16 * (i >> 3) + (i & 7)), db = da - 32;
                    s0[i] = (da >= 0 && (MODE == 0 || da < 512)) ? s0[i] : -INFINITY; s1[i] = (db >= 0 && (MODE == 0 || db < 512)) ? s1[i] : -INFINITY;
                }
            }
            s0 = s0 + sl; s1 = s1 + sl;
            float mb0 = fmaxf(s0[0], s0[1]), mb1 = fmaxf(s1[0], s1[1]);
#pragma unroll
            for (int i = 2; i < 16; ++i) { mb0 = fmaxf(mb0, s0[i]); mb1 = fmaxf(mb1, s1[i]); }
            const float base = slope2 * (float)d0;
            const bool sel = MODE == 1 || ((mymask >> j) & 1ull);
            float mb = fmaxf(mb0, mb1 + k32) - base;
            mb = sel ? mb : -INFINITY;
            mb = fmaxf(mb, __shfl_xor(mb, 32));
            const float mn = fmaxf(st.m, mb), ms = mn == -INFINITY ? 0.f : mn;
            if (__any(mn > st.m)) {
                const float alpha = __builtin_amdgcn_exp2f(st.m - ms);
                st.l *= alpha;
#pragma unroll
                for (int i = 0; i < 16; ++i) { st.o0[i] *= alpha; st.o1[i] *= alpha; }
                st.m = mn;
            }
            const float off0 = sel ? ms + base : INFINITY, off1 = off0 - k32;
            s0 = s0 - off0; s1 = s1 - off1;
            float ls = 0.f;
#pragma unroll
            for (int i = 0; i < 16; ++i) { s0[i] = __builtin_amdgcn_exp2f(s0[i]); s1[i] = __builtin_amdgcn_exp2f(s1[i]); ls += s0[i] + s1[i]; }
            st.l += ls;
#pragma unroll
            for (int kt = 0; kt < 2; ++kt)
#pragma unroll
                for (int a = 0; a < 2; ++a) {
                    u32x4 pw;
                    if (kt == 0) { pw.x = pk2(s0[8 * a], s0[8 * a + 1]); pw.y = pk2(s0[8 * a + 2], s0[8 * a + 3]); pw.z = pk2(s0[8 * a + 4], s0[8 * a + 5]); pw.w = pk2(s0[8 * a + 6], s0[8 * a + 7]); }
                    else { pw.x = pk2(s1[8 * a], s1[8 * a + 1]); pw.y = pk2(s1[8 * a + 2], s1[8 * a + 3]); pw.z = pk2(s1[8 * a + 4], s1[8 * a + 5]); pw.w = pk2(s1[8 * a + 6], s1[8 * a + 7]); }
                    const bf16x8 pf = __builtin_bit_cast(bf16x8, pw);
                    const bf16x8 v0 = *(const LAS bf16x8*)(buf + 8192 + (4 * kt + 2 * a + hf) * 1024 + ql * 16);
                    const bf16x8 v1 = *(const LAS bf16x8*)(buf + 8192 + (4 * kt + 2 * a + hf) * 1024 + 512 + ql * 16);
                    st.o0 = __builtin_amdgcn_mfma_f32_32x32x16_bf16(v0, pf, st.o0, 0, 0, 0);
                    st.o1 = __builtin_amdgcn_mfma_f32_32x32x16_bf16(v1, pf, st.o1, 0, 0, 0);
                }
        }
    }
    asm volatile("s_barrier" ::: "memory");
}
__device__ __forceinline__ void nsa_unit(const Ctx& X, int bg, int qb) {
    const int b = bg >> 1, g = bg & 1, lane = fresh(X.lane), w = X.wave, ql = lane & 31, hf = lane >> 5, r = ql >> 3, hh = g * 4 + r;
    const int t0 = 64 * qb, tq = t0 + 8 * w + (ql & 7);
    const float slope2 = exp2f(-(float)(hh + 1)) * 1.4426950408889634f;
    const bf16_t* proj = (const bf16_t*)(X.ws + WS_BIG);
    bf16x8 qf[4];
    { const bf16_t* qp = (const bf16_t*)(X.ws + WS_QNB) + (size_t)(b * S + tq) * 512 + hh * 64 + 8 * hf;
#pragma unroll
      for (int s = 0; s < 4; ++s) qf[s] = *(const bf16x8*)(qp + 16 * s); }
    float gate[3];
    { const bf16_t* gp = proj + (size_t)(b * S + tq) * PROJ_LD + OFF_GATE + hh * 3;
#pragma unroll
      for (int i = 0; i < 3; ++i) gate[i] = 1.f / (1.f + __expf(-bf2f(gp[i]))); }
    f32x16 of0, of1;
#pragma unroll
    for (int i = 0; i < 16; ++i) { of0[i] = 0.f; of1[i] = 0.f; }
    NsaSt st;
    LAS float* pacc = (LAS float*)(X.lds + 65536) + w * 2048;
    {
        const int ncm = t0 + 63 >= 31 ? (t0 + 63 - 31) / 16 + 1 : 0, nt = (ncm + 31) >> 5, ncv = tq >= 31 ? (tq - 31) / 16 + 1 : 0;
        {
            const bf16_t* kc = (const bf16_t*)(X.ws + WS_KCB) + (size_t)bg * 256 * 64; const bf16_t* vc = (const bf16_t*)(X.ws + WS_VCT) + (size_t)bg * 64 * 256;
            const int tidf = fresh(X.tid);
#pragma unroll
            for (int i = 0; i < 4; ++i) { const int pidx = tidf + NTHREADS * i;
                *(LAS u32x4*)(X.lds + (pidx >> 8) * 4096 + (pidx & 255) * 16) = *(const u32x4*)(kc + (size_t)(pidx & 255) * 64 + 8 * (pidx >> 8));
                *(LAS u32x4*)(X.lds + 32768 + (pidx >> 6) * 1024 + (pidx & 63) * 16) = *(const u32x4*)(vc + (size_t)(pidx & 63) * 256 + 8 * (pidx >> 6)); }
#pragma unroll
            for (int i = 0; i < 8; ++i) *(LAS f32x4*)(pacc + (i * 64 + lane) * 4) = (f32x4){0.f, 0.f, 0.f, 0.f};
        }
        __syncthreads();
        const int krow = pi32(ql) * 16;
        float ml = -INFINITY, ll = 0.f;
        for (int kt = 0; kt < nt; ++kt) {
            f32x16 sc;
#pragma unroll
            for (int i = 0; i < 16; ++i) sc[i] = 0.f;
#pragma unroll
            for (int s = 0; s < 4; ++s) { const bf16x8 kf = *(const LAS bf16x8*)(X.lds + (2 * s + hf) * 4096 + kt * 512 + krow); sc = __builtin_amdgcn_mfma_f32_32x32x16_bf16(kf, qf[s], sc, 0, 0, 0); }
            float tm = -INFINITY;
#pragma unroll
            for (int i = 0; i < 16; ++i) { const int n = 32 * kt + 16 * (i >> 3) + 8 * hf + (i & 7);
                sc[i] = n < ncv ? sc[i] - slope2 * (float)(tq - (16 * n + 31)) : -INFINITY; tm = fmaxf(tm, sc[i]); }
            const float mn = fmaxf(ml, tm), ms = mn == -INFINITY ? 0.f : mn;
            float ls = 0.f;
#pragma unroll
            for (int i = 0; i < 16; ++i) ls += __builtin_amdgcn_exp2f(sc[i] - ms);
            ll = ll * __builtin_amdgcn_exp2f(ml - ms) + ls; ml = mn;
        }
        float ms, inv;
        { const float mo = __shfl_xor(ml, 32), lo = __shfl_xor(ll, 32), mt = fmaxf(ml, mo); ms = mt == -INFINITY ? 0.f : mt;
          const float lt = ll * __builtin_amdgcn_exp2f(ml - ms) + lo * __builtin_amdgcn_exp2f(mo - ms); inv = lt > 0.f ? 1.f / lt : 0.f; }
#pragma unroll
        for (int i = 0; i < 16; ++i) { st.o0[i] = 0.f; st.o1[i] = 0.f; }
        float carry = 0.f;
        for (int kt = 0; kt < nt; ++kt) {
            f32x16 sc;
#pragma unroll
            for (int i = 0; i < 16; ++i) sc[i] = 0.f;
#pragma unroll
            for (int s = 0; s < 4; ++s) { const bf16x8 kf = *(const LAS bf16x8*)(X.lds + (2 * s + hf) * 4096 + kt * 512 + krow); sc = __builtin_amdgcn_mfma_f32_32x32x16_bf16(kf, qf[s], sc, 0, 0, 0); }
#pragma unroll
            for (int i = 0; i < 16; ++i) { const int n = 32 * kt + 16 * (i >> 3) + 8 * hf + (i & 7);
                sc[i] = n < ncv ? __builtin_amdgcn_exp2f(sc[i] - slope2 * (float)(tq - (16 * n + 31)) - ms) * inv : 0.f; }
            const float pa0 = __shfl_xor(sc[7], 32), pa1 = __shfl_xor(sc[15], 32);
            const float prev0 = hf ? pa0 : carry, prev1 = hf ? pa1 : pa0;
            carry = pa1;
            {
                typedef float f32x2 __attribute__((ext_vector_type(2)));
                f32x2 e0, e1;
                e0.x = prev0 + ((sc[0] + sc[1]) + (sc[2] + sc[3])); e0.y = sc[3] + ((sc[4] + sc[5]) + (sc[6] + sc[7]));
                e1.x = prev1 + ((sc[8] + sc[9]) + (sc[10] + sc[11])); e1.y = sc[11] + ((sc[12] + sc[13]) + (sc[14] + sc[15]));
                *(LAS f32x2*)(pacc + ql * 64 + 8 * kt + 2 * hf) = e0; *(LAS f32x2*)(pacc + ql * 64 + 8 * kt + 4 + 2 * hf) = e1;
            }
#pragma unroll
            for (int a = 0; a < 2; ++a) {
                u32x4 pw; pw.x = pk2(sc[8 * a], sc[8 * a + 1]); pw.y = pk2(sc[8 * a + 2], sc[8 * a + 3]); pw.z = pk2(sc[8 * a + 4], sc[8 * a + 5]); pw.w = pk2(sc[8 * a + 6], sc[8 * a + 7]);
                const bf16x8 pf = __builtin_bit_cast(bf16x8, pw);
                const bf16x8 v0 = *(const LAS bf16x8*)(X.lds + 32768 + (4 * kt + 2 * a + hf) * 1024 + ql * 16);
                const bf16x8 v1 = *(const LAS bf16x8*)(X.lds + 32768 + (4 * kt + 2 * a + hf) * 1024 + 512 + ql * 16);
                st.o0 = __builtin_amdgcn_mfma_f32_32x32x16_bf16(v0, pf, st.o0, 0, 0, 0);
                st.o1 = __builtin_amdgcn_mfma_f32_32x32x16_bf16(v1, pf, st.o1, 0, 0, 0);
            }
        }
#pragma unroll
        for (int i = 0; i < 16; ++i) { of0[i] = gate[0] * st.o0[i]; of1[i] = gate[0] * st.o1[i]; }
    }
    unsigned long long mymask = 0ull, wavemask = 0ull;
    LDS_WAIT();
    for (int q8 = 0; q8 < 8; ++q8) {
        const int t = t0 + 8 * w + q8;
        const float ps = (pacc[(0 * 8 + q8) * 64 + lane] + pacc[(1 * 8 + q8) * 64 + lane]) + (pacc[(2 * 8 + q8) * 64 + lane] + pacc[(3 * 8 + q8) * 64 + lane]);
        const bool valid = lane * 64 <= t, forced = (lane == 0) || (lane == qb) || (lane == qb - 1);
        const float score = valid ? (forced ? 1e6f : ps) : -1e6f;
        int rank = 0;
#pragma unroll 4
        for (int i = 0; i < 64; ++i) { const float si = __builtin_amdgcn_readlane(score, i); rank += (si > score || (si == score && i < lane)) ? 1 : 0; }
        const unsigned long long mk = __ballot(rank < 16);
        wavemask |= mk; if ((ql & 7) == q8) mymask = mk;
    }
    __syncthreads();
    {
#pragma unroll
        for (int i = 0; i < 16; ++i) { st.o0[i] = 0.f; st.o1[i] = 0.f; }
        st.m = -INFINITY; st.l = 0.f;
        const int lf = fresh(lane);
        const bf16_t* kg = (const bf16_t*)(X.ws + WS_KSN) + ((size_t)b * S + lf) * 128 + g * 64 + 8 * w;
        const bf16_t* vg = (const bf16_t*)(X.ws + WS_VT) + (size_t)(512 + g * 64 + lf) * T + (size_t)b * S + 8 * w;
        nsa_flash<0>(X, kg, vg, 0, qb, qf, tq, slope2, mymask, wavemask, st);
        const float lt = st.l + __shfl_xor(st.l, 32), sc = gate[1] / fmaxf(lt, 1e-30f);
#pragma unroll
        for (int i = 0; i < 16; ++i) { of0[i] += sc * st.o0[i]; of1[i] += sc * st.o1[i]; }
    }
    {
#pragma unroll
        for (int i = 0; i < 16; ++i) { st.o0[i] = 0.f; st.o1[i] = 0.f; }
        st.m = -INFINITY; st.l = 0.f;
        const int lf = fresh(lane);
        const bf16_t* kg = (const bf16_t*)(X.ws + WS_KWN) + ((size_t)b * S + lf) * 128 + g * 64 + 8 * w;
        const bf16_t* vg = (const bf16_t*)(X.ws + WS_VT) + (size_t)(640 + g * 64 + lf) * T + (size_t)b * S + 8 * w;
        nsa_flash<1>(X, kg, vg, qb >= 8 ? qb - 8 : 0, qb, qf, tq, slope2, 0ull, 0ull, st);
        const float lt = st.l + __shfl_xor(st.l, 32), sc = gate[2] / fmaxf(lt, 1e-30f);
#pragma unroll
        for (int i = 0; i < 16; ++i) { of0[i] += sc * st.o0[i]; of1[i] += sc * st.o1[i]; }
    }
    bf16_t* op = (bf16_t*)(X.ws + WS_O) + (size_t)(b * S + fresh(tq)) * D + 512 + hh * 64 + 4 * hf;
#pragma unroll
    for (int g4 = 0; g4 < 4; ++g4) {
        u32x2 w0; w0.x = pk2(of0[4 * g4], of0[4 * g4 + 1]); w0.y = pk2(of0[4 * g4 + 2], of0[4 * g4 + 3]); *(u32x2*)(op + 8 * g4) = w0;
        u32x2 w1; w1.x = pk2(of1[4 * g4], of1[4 * g4 + 1]); w1.y = pk2(of1[4 * g4 + 2], of1[4 * g4 + 3]); *(u32x2*)(op + 32 + 8 * g4) = w1;
    }
}
__device__ __forceinline__ void ph_nsa(const Params& p, const Ctx& X) {
    for (int pr = X.bid; pr < 256; pr += X.G)
#pragma unroll 1
        for (int u = 0; u < 2; ++u) { const int bg = pr >> 5, qa = pr & 31; nsa_unit(X, bg, u ? qa : 63 - qa); }
}

__device__ __forceinline__ float silu_fast(float v) { return v * __builtin_amdgcn_rcpf(1.f + __expf(-v)); }
constexpr int S1_WL = RING_BYTES + 4096;
__device__ __forceinline__ void ph_ssd1(const Params& p, const Ctx& X) {
    const float* cw = p.in[17]; const float* cb = p.in[18];
    LAS float* wl = (LAS float*)(X.lds + S1_WL);
    LAS unsigned char* ldsB = X.lds;
    LAS unsigned char* ldsX = X.lds + 65536;
    for (int unit = X.bid; unit < 256; unit += X.G) {
        const int b = unit >> 6, c = (unit >> 2) & 15, g = unit & 3, tl0 = c * 256, lane = fresh(X.lane), w = X.wave, ql = lane & 31, hf = lane >> 5;
        const size_t t0 = (size_t)b * S + tl0;
        {
            const int h = g * 8 + w;
            const float a = -expf(p.in[20][h]), dtb = p.in[19][h];
            const float* dr = (const float*)(X.ws + WS_DT) + (t0 + 4 * lane) * 32 + h;
            float dt[4], cs[4];
#pragma unroll
            for (int k = 0; k < 4; ++k) { const float raw = dr[k * 32] + dtb; dt[k] = raw > 20.f ? raw : log1pf(expf(raw)); }
            cs[0] = dt[0] * a; cs[1] = cs[0] + dt[1] * a; cs[2] = cs[1] + dt[2] * a; cs[3] = cs[2] + dt[3] * a;
            float incl = cs[3];
#pragma unroll
            for (int o = 1; o < 64; o <<= 1) { const float u = __shfl_up(incl, o); if (lane >= o) incl += u; }
            const float excl = incl - cs[3], last = __shfl(incl, 63);
#pragma unroll
            for (int k = 0; k < 4; ++k) cs[k] += excl;
            *(f32x4*)((float*)(X.ws + WS_DT2) + (size_t)(b * 32 + h) * S + tl0 + 4 * lane) = (f32x4){dt[0], dt[1], dt[2], dt[3]};
            *(f32x4*)((float*)(X.ws + WS_CS) + (size_t)(b * 32 + h) * S + tl0 + 4 * lane) = (f32x4){cs[0], cs[1], cs[2], cs[3]};
            *(LAS f32x4*)(wl + w * 256 + 4 * lane) = (f32x4){dt[0] * __expf(last - cs[0]), dt[1] * __expf(last - cs[1]), dt[2] * __expf(last - cs[2]), dt[3] * __expf(last - cs[3])};
            if (lane == 63) ((float*)(X.ws + WS_DEC))[(b * 16 + c) * 32 + h] = __expf(last);
        }
        const bf16_t* xt = (const bf16_t*)(X.ws + WS_XT); bf16_t* xct = (bf16_t*)(X.ws + WS_XCT);
        const int tidf = fresh(X.tid);
#define CONV8(rin, chg, seg, o) do { const bf16_t* src_ = xt + (size_t)(rin) * T + t0 + 8 * (seg); const u32x4 cur_ = *(const u32x4*)src_; u32x4 prv_ = (u32x4){0u, 0u, 0u, 0u}; \
            if (tl0 + 8 * (seg) >= 8) prv_ = *(const u32x4*)(src_ - 8); \
            const float x_[11] = {bfhi(prv_.z), bflo(prv_.w), bfhi(prv_.w), bflo(cur_.x), bfhi(cur_.x), bflo(cur_.y), bfhi(cur_.y), bflo(cur_.z), bfhi(cur_.z), bflo(cur_.w), bfhi(cur_.w)}; \
            const float w0_ = cw[chg], w1_ = cw[CONV_DIM + (chg)], w2_ = cw[2 * CONV_DIM + (chg)], w3_ = cw[3 * CONV_DIM + (chg)], bb_ = cb[chg]; \
            _Pragma("unroll") for (int j_ = 0; j_ < 8; ++j_) o[j_] = silu_fast(bb_ + w0_ * x_[j_] + w1_ * x_[j_ + 1] + w2_ * x_[j_ + 2] + w3_ * x_[j_ + 3]); } while (0)
        {
#pragma unroll
            for (int k = 0; k < 8; ++k) {
                const int it = tidf + NTHREADS * k, n = it >> 5, seg = it & 31, chg = 2048 + g * 128 + n;
                float o[8]; CONV8(g * 128 + n, chg, seg, o);
                u32x4 ov; ov.x = pk2(o[0], o[1]); ov.y = pk2(o[2], o[3]); ov.z = pk2(o[4], o[5]); ov.w = pk2(o[6], o[7]);
                *(u32x4*)(xct + (size_t)chg * T + t0 + 8 * seg) = ov;
                *(LAS u32x4*)(ldsB + seg * 2048 + n * 16) = ov;
            }
            const bf16_t* zbc = (const bf16_t*)(X.ws + WS_ZBC); bf16_t* bcm = (bf16_t*)(X.ws + WS_BCM);
#pragma unroll 4
            for (int k = 0; k < 16; ++k) {
                const int it = tidf + NTHREADS * k, l = it >> 5, c8 = it & 31;
                const int col = (c8 < 16 ? g * 128 + 8 * c8 : 512 + g * 128 + 8 * (c8 - 16));
                float acc[8];
                { const f32x4 b0 = *(const f32x4*)(cb + 2048 + col), b1 = *(const f32x4*)(cb + 2048 + col + 4); acc[0] = b0.x; acc[1] = b0.y; acc[2] = b0.z; acc[3] = b0.w; acc[4] = b1.x; acc[5] = b1.y; acc[6] = b1.z; acc[7] = b1.w; }
#pragma unroll
                for (int ww = 0; ww < 4; ++ww) {
                    if (tl0 + l - 3 + ww < 0) continue;
                    const u32x4 q = *(const u32x4*)(zbc + (t0 + l - 3 + ww) * 3072 + 2048 + col);
                    const f32x4 k0 = *(const f32x4*)(cw + ww * CONV_DIM + 2048 + col), k1 = *(const f32x4*)(cw + ww * CONV_DIM + 2048 + col + 4);
                    acc[0] += bflo(q.x) * k0.x; acc[1] += bfhi(q.x) * k0.y; acc[2] += bflo(q.y) * k0.z; acc[3] += bfhi(q.y) * k0.w;
                    acc[4] += bflo(q.z) * k1.x; acc[5] += bfhi(q.z) * k1.y; acc[6] += bflo(q.w) * k1.z; acc[7] += bfhi(q.w) * k1.w;
                }
                u32x4 ov; ov.x = pk2(silu_fast(acc[0]), silu_fast(acc[1])); ov.y = pk2(silu_fast(acc[2]), silu_fast(acc[3])); ov.z = pk2(silu_fast(acc[4]), silu_fast(acc[5])); ov.w = pk2(silu_fast(acc[6]), silu_fast(acc[7]));
                *(u32x4*)(bcm + (t0 + l) * 1024 + col) = ov;
            }
        }
#pragma unroll 1
        for (int hg = 0; hg < 4; ++hg) {
            __syncthreads();
#pragma unroll
            for (int k = 0; k < 8; ++k) {
                const int it = tidf + NTHREADS * k, chl = it >> 5, seg = it & 31, h8 = 2 * hg + (chl >> 6), chg = g * 512 + h8 * 64 + (chl & 63);
                float o[8]; CONV8(1024 + chg, chg, seg, o);
                u32x4 ov; ov.x = pk2(o[0], o[1]); ov.y = pk2(o[2], o[3]); ov.z = pk2(o[4], o[5]); ov.w = pk2(o[6], o[7]);
                *(u32x4*)(xct + (size_t)chg * T + t0 + 8 * seg) = ov;
                const f32x4 wa = *(const LAS f32x4*)(wl + h8 * 256 + 8 * seg), wb = *(const LAS f32x4*)(wl + h8 * 256 + 8 * seg + 4);
                u32x4 os; os.x = pk2(o[0] * wa.x, o[1] * wa.y); os.y = pk2(o[2] * wa.z, o[3] * wa.w); os.z = pk2(o[4] * wb.x, o[5] * wb.y); os.w = pk2(o[6] * wb.z, o[7] * wb.w);
                *(LAS u32x4*)(ldsX + (chl >> 6) * 32768 + seg * 1024 + (chl & 63) * 16) = os;
            }
            __syncthreads();
            {
                const int hl = w >> 2, pt = (w >> 1) & 1, nt0 = 2 * (w & 1), h = g * 8 + 2 * hg + hl;
                f32x16 acc0, acc1;
#pragma unroll
                for (int i = 0; i < 16; ++i) { acc0[i] = 0.f; acc1[i] = 0.f; }
#pragma unroll 4
                for (int ks = 0; ks < 16; ++ks) {
                    const bf16x8 af = *(const LAS bf16x8*)(ldsX + hl * 32768 + (2 * ks + hf) * 1024 + (32 * pt + ql) * 16);
                    const bf16x8 b0 = *(const LAS bf16x8*)(ldsB + (2 * ks + hf) * 2048 + (32 * nt0 + ql) * 16), b1 = *(const LAS bf16x8*)(ldsB + (2 * ks + hf) * 2048 + (32 * nt0 + 32 + ql) * 16);
                    acc0 = __builtin_amdgcn_mfma_f32_32x32x16_bf16(af, b0, acc0, 0, 0, 0); acc1 = __builtin_amdgcn_mfma_f32_32x32x16_bf16(af, b1, acc1, 0, 0, 0);
                }
                float* st = (float*)(X.ws + WS_ST) + ((size_t)(b * 16 + c) * 32 + h) * 8192 + 32 * nt0 + ql;
#pragma unroll
                for (int i = 0; i < 16; ++i) { const int pr = 32 * pt + 8 * (i >> 2) + 4 * hf + (i & 3); st[pr * 128] = acc0[i]; st[pr * 128 + 32] = acc1[i]; }
            }
        }
#undef CONV8
        __syncthreads();
    }
}
__device__ __forceinline__ void ph_ssd2(const Ctx& X) {
    const float* st = (const float*)(X.ws + WS_ST); const float* dec = (const float*)(X.ws + WS_DEC); bf16_t* pb = (bf16_t*)(X.ws + WS_PB);
    for (int e = X.bid * NTHREADS + X.tid; e < NB * 32 * 2048; e += X.G * NTHREADS) {
        const int b = e >> 16, h = (e >> 11) & 31, q4 = (e & 2047) * 4;
        f32x4 hs = (f32x4){0.f, 0.f, 0.f, 0.f};
        for (int c = 0; c < 16; ++c) {
            const size_t o = ((size_t)(b * 16 + c) * 32 + h) * 8192 + q4;
            u32x2 wv; wv.x = pk2(hs.x, hs.y); wv.y = pk2(hs.z, hs.w); *(u32x2*)(pb + o) = wv;
            hs = hs * dec[(b * 16 + c) * 32 + h] + *(const f32x4*)(st + o);
        }
    }
}
constexpr int S3_STG = 49152;
__device__ __forceinline__ void ph_ssd3(const Params& p, const Ctx& X) {
    LAS float* dtl = (LAS float*)(X.lds + 2 * S3_STG); LAS float* csl = dtl + 2048;
    constexpr int S3_TILE = 2 * S3_STG + 16384;
    static_assert(S3_TILE + 8 * 4096 <= TAB_OFF, "ssd3 LDS map");
    for (int unit = X.bid; unit < 256; unit += X.G) {
        const int b = unit >> 6, c = (unit >> 2) & 15, g = unit & 3, tl0 = c * 256, lane = fresh(X.lane), w = X.wave, ql = lane & 31, hf = lane >> 5, lq = 32 * w + ql;
        const size_t t0 = (size_t)b * S + tl0;
        LAS unsigned char* tile = X.lds + S3_TILE + w * 4096;
        const bf16_t* xg = (const bf16_t*)(X.ws + WS_XCT) + (size_t)(g * 512 + lane) * T + t0;
        const bf16_t* pg = (const bf16_t*)(X.ws + WS_PB) + ((size_t)(b * 16 + c) * 32 + g * 8) * 8192 + (size_t)lane * 128;
#define S3_ISSUE(h8, sbase) do { _Pragma("unroll") for (int cc_ = 0; cc_ < 4; ++cc_) DMA16(xg + (size_t)((h8) * 64) * T + 8 * (4 * w + cc_), X.lds + (sbase) + (4 * w + cc_) * 1024); \
            _Pragma("unroll") for (int cc_ = 0; cc_ < 2; ++cc_) DMA16(pg + (size_t)(h8) * 8192 + 8 * (2 * w + cc_), X.lds + (sbase) + 32768 + (2 * w + cc_) * 1024); } while (0)
        asm volatile("s_waitcnt vmcnt(0)" ::: "memory");
        S3_ISSUE(0, 0);
        { const int tidf = fresh(X.tid), h8 = tidf >> 6, l4 = (tidf & 63) * 4;
          *(LAS f32x4*)(dtl + h8 * 256 + l4) = *(const f32x4*)((const float*)(X.ws + WS_DT2) + (size_t)(b * 32 + g * 8 + h8) * S + tl0 + l4);
          *(LAS f32x4*)(csl + h8 * 256 + l4) = *(const f32x4*)((const float*)(X.ws + WS_CS) + (size_t)(b * 32 + g * 8 + h8) * S + tl0 + l4); }
        const bf16_t* bcm = (const bf16_t*)(X.ws + WS_BCM);
        u32x4 gp[8][2];
        {
        bf16x8 cf[8];
#pragma unroll
        for (int ks = 0; ks < 8; ++ks) cf[ks] = *(const bf16x8*)(bcm + (t0 + lq) * 1024 + 512 + g * 128 + 16 * ks + 8 * hf);
#pragma unroll
        for (int st = 0; st < 8; ++st) {
            if (st <= w) {
                f32x16 G;
#pragma unroll
                for (int i = 0; i < 16; ++i) G[i] = 0.f;
                const bf16_t* bp = bcm + (t0 + 32 * st + pi32(ql)) * 1024 + g * 128 + 8 * hf;
#pragma unroll
                for (int ks = 0; ks < 8; ++ks) G = __builtin_amdgcn_mfma_f32_32x32x16_bf16(*(const bf16x8*)(bp + 16 * ks), cf[ks], G, 0, 0, 0);
#pragma unroll
                for (int a2 = 0; a2 < 2; ++a2) { gp[st][a2].x = pk2(G[8 * a2], G[8 * a2 + 1]); gp[st][a2].y = pk2(G[8 * a2 + 2], G[8 * a2 + 3]); gp[st][a2].z = pk2(G[8 * a2 + 4], G[8 * a2 + 5]); gp[st][a2].w = pk2(G[8 * a2 + 6], G[8 * a2 + 7]); }
            } else { gp[st][0] = (u32x4){0u, 0u, 0u, 0u}; gp[st][1] = (u32x4){0u, 0u, 0u, 0u}; }
        }
        }
        float ss = 0.f;
        bf16_t* yrow = (bf16_t*)(X.ws + WS_O) + (t0 + 32 * w + (lane >> 1)) * SSM_INNER + g * 512 + 32 * (lane & 1);
        const bf16_t* zdma = (const bf16_t*)(X.ws + WS_ZBC) + (t0 + 32 * w + (lane >> 3)) * 3072 + g * 512 + 8 * ((lane & 7) ^ (lane >> 3));
        LAS unsigned char* trw = tile + (lane >> 1) * 128;
        LAS unsigned char* tac = tile + ql * 128 + 8 * hf;
#pragma unroll 1
        for (int h8 = 0; h8 < 8; ++h8) {
            const int sb = (h8 & 1) * S3_STG;
            asm volatile("s_waitcnt vmcnt(0) lgkmcnt(0)\n\ts_barrier" ::: "memory");
            if (h8 < 7) S3_ISSUE(h8 + 1, ((h8 + 1) & 1) * S3_STG);
#pragma unroll
            for (int k = 0; k < 4; ++k) DMA16(zdma + (size_t)(8 * k) * 3072 + h8 * 64, tile + k * 1024);
            f32x16 acc0, acc1;
#pragma unroll
            for (int i = 0; i < 16; ++i) { acc0[i] = 0.f; acc1[i] = 0.f; }
            {
                const LAS unsigned char* pp = X.lds + sb + 32768 + hf * 1024 + ql * 16;
                const bf16_t* cp = bcm + (t0 + 32 * w + (fresh(lane) & 31)) * 1024 + 512 + g * 128 + 8 * hf;
#pragma unroll
                for (int ks = 0; ks < 8; ++ks) { const bf16x8 cfk = *(const bf16x8*)(cp + 16 * ks);
                                                 acc0 = __builtin_amdgcn_mfma_f32_32x32x16_bf16(*(const LAS bf16x8*)(pp + ks * 2048), cfk, acc0, 0, 0, 0);
                                                 acc1 = __builtin_amdgcn_mfma_f32_32x32x16_bf16(*(const LAS bf16x8*)(pp + ks * 2048 + 512), cfk, acc1, 0, 0, 0); }
                const float e = __expf(csl[h8 * 256 + lq]);
#pragma unroll
                for (int i = 0; i < 16; ++i) { acc0[i] *= e; acc1[i] *= e; }
            }
            const float cl = csl[h8 * 256 + lq], dsk = p.in[21][g * 8 + h8];
#pragma unroll
            for (int st = 0; st < 8; ++st) {
                if (st <= w) {
                    const int s0 = 32 * st + 8 * hf;
#pragma unroll
                    for (int a2 = 0; a2 < 2; ++a2) {
                        const f32x4 d0 = *(const LAS f32x4*)(dtl + h8 * 256 + s0 + 16 * a2), d1 = *(const LAS f32x4*)(dtl + h8 * 256 + s0 + 16 * a2 + 4);
                        const f32x4 c0 = *(const LAS f32x4*)(csl + h8 * 256 + s0 + 16 * a2), c1 = *(const LAS f32x4*)(csl + h8 * 256 + s0 + 16 * a2 + 4);
                        const float dd[8] = {d0.x, d0.y, d0.z, d0.w, d1.x, d1.y, d1.z, d1.w}, cc[8] = {c0.x, c0.y, c0.z, c0.w, c1.x, c1.y, c1.z, c1.w};
                        const unsigned gw[4] = {gp[st][a2].x, gp[st][a2].y, gp[st][a2].z, gp[st][a2].w};
                        float m[8];
#pragma unroll
                        for (int j = 0; j < 8; ++j) { const int sidx = s0 + 16 * a2 + j;
                            const float gv = (j & 1) ? bfhi(gw[j >> 1]) : bflo(gw[j >> 1]);
                            float v = gv * dd[j] * __expf(fminf(cl - cc[j], 0.f));
                            if (st == w) { v = sidx > lq ? 0.f : v; v += sidx == lq ? dsk : 0.f; }
                            m[j] = v; }
                        u32x4 pw; pw.x = pk2(m[0], m[1]); pw.y = pk2(m[2], m[3]); pw.z = pk2(m[4], m[5]); pw.w = pk2(m[6], m[7]);
                        const bf16x8 pf = __builtin_bit_cast(bf16x8, pw);
                        const LAS unsigned char* xp = X.lds + sb + (4 * st + 2 * a2 + hf) * 1024 + ql * 16;
                        acc0 = __builtin_amdgcn_mfma_f32_32x32x16_bf16(*(const LAS bf16x8*)xp, pf, acc0, 0, 0, 0);
                        acc1 = __builtin_amdgcn_mfma_f32_32x32x16_bf16(*(const LAS bf16x8*)(xp + 512), pf, acc1, 0, 0, 0);
                        __builtin_amdgcn_sched_barrier(0);
                    }
                }
            }
            asm volatile("s_waitcnt vmcnt(0)" ::: "memory");
#pragma unroll
            for (int pt = 0; pt < 2; ++pt)
#pragma unroll
                for (int g4 = 0; g4 < 4; ++g4) {
                    const u32x2 z2 = *(const LAS u32x2*)(tac + (((4 * pt + g4) ^ (ql & 7)) * 16));
                    const float a0 = pt ? acc1[4 * g4] : acc0[4 * g4], a1 = pt ? acc1[4 * g4 + 1] : acc0[4 * g4 + 1], a2v = pt ? acc1[4 * g4 + 2] : acc0[4 * g4 + 2], a3 = pt ? acc1[4 * g4 + 3] : acc0[4 * g4 + 3];
                    const float v0 = a0 * silu_fast(bflo(z2.x)), v1 = a1 * silu_fast(bfhi(z2.x)), v2 = a2v * silu_fast(bflo(z2.y)), v3 = a3 * silu_fast(bfhi(z2.y));
                    ss += (v0 * v0 + v1 * v1) + (v2 * v2 + v3 * v3);
                    u32x2 o; o.x = pk2(v0, v1); o.y = pk2(v2, v3); *(LAS u32x2*)(tac + (((4 * pt + g4) ^ (ql & 7)) * 16)) = o;
                }
#pragma unroll
            for (int k = 0; k < 4; ++k) *(u32x4*)(yrow + h8 * 64 + 8 * k) = *(const LAS u32x4*)(trw + (((4 * (lane & 1) + k) ^ ((lane >> 1) & 7)) * 16));
        }
#undef S3_ISSUE
        ss += __shfl_xor(ss, 32);
        const float rs = rsqrtf(ss * (1.f / 512.f) + EPS);
        asm volatile("s_waitcnt vmcnt(0)" ::: "memory");
        {
            const int lf = fresh(lane);
            bf16_t* yb = (bf16_t*)(X.ws + WS_O) + (t0 + 32 * w) * SSM_INNER + g * 512 + 8 * lf;
            const f32x4 g0 = *(const f32x4*)(p.in[22] + g * 512 + 8 * lf), g1 = *(const f32x4*)(p.in[22] + g * 512 + 8 * lf + 4);
#pragma unroll 1
            for (int r0 = 0; r0 < 32; r0 += 8) {
                u32x4 q[8];
#pragma unroll
                for (int k = 0; k < 8; ++k) q[k] = *(const u32x4*)(yb + (size_t)(r0 + k) * SSM_INNER);
#pragma unroll
                for (int k = 0; k < 8; ++k) {
                    const float rk = __shfl(rs, r0 + k);
                    u32x4 o; o.x = pk2(bflo(q[k].x) * rk * g0.x, bfhi(q[k].x) * rk * g0.y); o.y = pk2(bflo(q[k].y) * rk * g0.z, bfhi(q[k].y) * rk * g0.w);
                    o.z = pk2(bflo(q[k].z) * rk * g1.x, bfhi(q[k].z) * rk * g1.y); o.w = pk2(bflo(q[k].w) * rk * g1.z, bfhi(q[k].w) * rk * g1.w);
                    *(u32x4*)(yb + (size_t)(r0 + k) * SSM_INNER) = o;
                }
            }
        }
        asm volatile("s_waitcnt lgkmcnt(0)\n\ts_barrier" ::: "memory");
    }
}

__device__ __forceinline__ void ph_moe_gu(const Params& p, const Ctx& X, int l) {
    moe_table(X, l);
    pg8::MoeOrder So{(const LAS int*)(X.lds + TAB_OFF), (const LAS int*)(X.lds + TAB_OFF) + 40, (const int*)(X.ws + WS_SLOT), 3, X.G, X.bid, true};
    pg8::Gemm g{(const bf16_t*)(X.ws + WS_U), (const bf16_t*)(X.ws + WS_WGU) + (size_t)l * NE * 2048 * 1024, 1024};
    pg8::EpiGu E{(bf16_t*)(X.ws + WS_ACT), p.in[27] + (size_t)l * NE * 2048};
    pg8::gemm_phase<pg8::EpiGu, pg8::MoeOrder>(X.lds, g, So, E, X.tid);
}
__device__ __forceinline__ void ph_moe_down(const Params& p, const Ctx& X, int l) {
    moe_table(X, l);
    pg8::MoeOrder So{(const LAS int*)(X.lds + TAB_OFF), (const LAS int*)(X.lds + TAB_OFF) + 40, (const int*)(X.ws + WS_SLOT), 2, X.G, X.bid, false};
    pg8::Gemm g{(const bf16_t*)(X.ws + WS_ACT), (const bf16_t*)(X.ws + WS_WDN) + (size_t)l * NE * 1024 * 1024, 1024};
    pg8::EpiDown E{(bf16_t*)(X.ws + WS_Y), p.in[29] + (size_t)l * NE * 1024};
    pg8::gemm_phase<pg8::EpiDown, pg8::MoeOrder>(X.lds, g, So, E, X.tid);
}

#ifndef PROBE_MASK
#define PROBE_MASK 0u
#endif
#ifndef PROBE_MULT
#define PROBE_MULT 8
#endif
__global__ void __launch_bounds__(NTHREADS, 2) fwd_kernel(Params p) {
    extern __shared__ __attribute__((aligned(16))) unsigned char lds_raw[];
    Ctx X;
    X.lds = (LAS unsigned char*)lds_raw; X.ws = p.ws;
    X.tid = threadIdx.x; X.lane = X.tid & 63; X.wave = __builtin_amdgcn_readfirstlane(X.tid >> 6);
    X.G = gridDim.x; X.bid = blockIdx.x; X.gw = X.bid * NWAVES + X.wave; X.ngw = X.G * NWAVES; X.sub = 0ull; X.subt = 0ull;
    if (X.tid < 4) ((LAS unsigned*)(X.lds + XB_OFF))[X.tid] = 0u;
    __syncthreads();
    XcdBarrier bar = xcd_barrier_post((unsigned*)(p.ws + WS_CTL) + CW_BAR, (volatile LAS unsigned*)(X.lds + XB_OFF));
#define PHASE_BEGIN Ctx Y = X; { GAS unsigned char* w_ = (GAS unsigned char*)p.ws; asm volatile("" : "+s"(w_)); Y.ws = (unsigned char*)w_; int t_ = threadIdx.x; asm volatile("" : "+v"(t_)); Y.tid = t_; Y.lane = t_ & 63; \
    Y.wave = __builtin_amdgcn_readfirstlane(t_ >> 6); Y.gw = Y.bid * NWAVES + Y.wave; }
#define WSF(off) ((float*)(Y.ws + (off)))
#define WSB(off) ((bf16_t*)(Y.ws + (off)))
#define PROBE_LDS(i) (((volatile LAS unsigned long long*)(X.lds + 150528))[2 * X.wave + (i)])
    if (PROBE_MASK || PROBE_SUB) { if (X.lane == 0) { PROBE_LDS(0) = __builtin_amdgcn_s_memrealtime(); PROBE_LDS(1) = 0ull; } }
#define PB(k) do { if (PROBE_MASK) { if (X.lane == 0) { const unsigned long long n_ = __builtin_amdgcn_s_memrealtime(); if ((PROBE_MASK >> (k)) & 1u) PROBE_LDS(1) += n_ - PROBE_LDS(0); PROBE_LDS(0) = n_; } } } while (0)
    { PHASE_BEGIN ph_prologue(p, Y); }                                    xcd_barrier(bar); PB(0);
    { PHASE_BEGIN ph_norm0(p, Y); }                                       xcd_barrier(bar); PB(1);
    {
        PHASE_BEGIN
        pg8::DenseOrder So; So.init(T, PROJ_LD, X.G, X.bid);
        pg8::Gemm g{WSB(WS_U), WSB(WS_WIN), 1024};
        pg8::EpiBf16 E{WSB(WS_BIG), PROJ_LD};
        pg8::gemm_phase<pg8::EpiBf16, pg8::DenseOrder>(X.lds, g, So, E, Y.tid);
    }
    {
        PHASE_BEGIN
        pg8::DenseOrder So; So.init(768, T, X.G, X.bid);
        pg8::Gemm g{WSB(WS_WV), WSB(WS_U), 1024};
        pg8::EpiBf16 E{WSB(WS_VT), T};
        pg8::gemm_phase<pg8::EpiBf16, pg8::DenseOrder>(X.lds, g, So, E, Y.tid);
    }
    xcd_barrier(bar); PB(2);
    { PHASE_BEGIN ph_attn_a(p, Y); }                                      xcd_barrier(bar); PB(3);
    { PHASE_BEGIN ph_nsa(p, Y); if (PROBE_SUB && X.lane == 0) PROBE_LDS(1) += Y.sub; }
    __syncthreads(); PB(19);
    { PHASE_BEGIN ph_sb(Y); if (PROBE_SUB && X.lane == 0) PROBE_LDS(1) += Y.sub; }                                             xcd_barrier(bar); PB(4);
    {
        PHASE_BEGIN
        pg8::DenseOrder So; So.init(T, D, X.G, X.bid);
        pg8::Gemm g{WSB(WS_O), WSB(WS_WOUT), 1024};
        pg8::EpiResid E{p.in[0], WSF(WS_H1), WSF(WS_MODF) + 2048};
        pg8::gemm_phase<pg8::EpiResid, pg8::DenseOrder>(X.lds, g, So, E, Y.tid);
    }
    xcd_barrier(bar); PB(5);
    { PHASE_BEGIN ph_token<0>(p, Y, 0, WSF(WS_H1), nullptr); }                       xcd_barrier(bar); PB(6);
    { PHASE_BEGIN ph_moe_gu(p, Y, 0); }                                   xcd_barrier(bar); PB(7);
    { PHASE_BEGIN ph_moe_down(p, Y, 0); }                                 xcd_barrier(bar); PB(8);
    { PHASE_BEGIN ph_token<1>(p, Y, 0, WSF(WS_H1), WSF(WS_H2)); }       xcd_barrier(bar); PB(9);
    {
        PHASE_BEGIN
        pg8::DenseOrder So; So.init(T, 3072, X.G, X.bid);
        pg8::Gemm g{WSB(WS_U), WSB(WS_WSIN), 1024};
        pg8::EpiBf16 E{WSB(WS_ZBC), 3072};
        pg8::gemm_phase<pg8::EpiBf16, pg8::DenseOrder>(X.lds, g, So, E, Y.tid);
    }
    {
        PHASE_BEGIN
        pg8::DenseOrder So; So.init(3072, T, X.G, X.bid);
        pg8::Gemm g{WSB(WS_WSIN) + (size_t)2048 * 1024, WSB(WS_U), 1024};
        pg8::EpiBf16 E{WSB(WS_XT), T};
        pg8::gemm_phase<pg8::EpiBf16, pg8::DenseOrder>(X.lds, g, So, E, Y.tid);
    }
    xcd_barrier(bar); PB(10);
    { PHASE_BEGIN ph_ssd1(p, Y); if (PROBE_SUB && X.lane == 0) PROBE_LDS(1) += Y.sub; }                                        xcd_barrier(bar); PB(11);
    { PHASE_BEGIN ph_ssd2(Y); }                                           xcd_barrier(bar); PB(12);
    { PHASE_BEGIN ph_ssd3(p, Y); if (PROBE_SUB && X.lane == 0) PROBE_LDS(1) += Y.sub; }                                        xcd_barrier(bar); PB(13);
    {
        PHASE_BEGIN
        pg8::DenseOrder So; So.init(T, D, X.G, X.bid);
        pg8::Gemm g{WSB(WS_O), WSB(WS_WSOUT), 2048};
        pg8::EpiResid E{WSF(WS_H2), WSF(WS_H1), WSF(WS_MODF) + 4 * 6144 + 2048};
        pg8::gemm_phase<pg8::EpiResid, pg8::DenseOrder>(X.lds, g, So, E, Y.tid);
    }
    xcd_barrier(bar); PB(14);
    { PHASE_BEGIN ph_token<0>(p, Y, 1, WSF(WS_H1), nullptr); }                       xcd_barrier(bar); PB(15);
    { PHASE_BEGIN ph_moe_gu(p, Y, 1); }                                   xcd_barrier(bar); PB(16);
    { PHASE_BEGIN ph_moe_down(p, Y, 1); }                                 xcd_barrier(bar); PB(17);
    { PHASE_BEGIN ph_token<2>(p, Y, 1, WSF(WS_H1), p.out); } PB(18);
    if (PROBE_MASK || PROBE_SUB) { asm volatile("s_waitcnt lgkmcnt(0)" ::: "memory"); const unsigned long long acc_ = PROBE_LDS(1); const unsigned long long t_end = __builtin_amdgcn_s_memrealtime() + (unsigned long long)PROBE_MULT * (unsigned long long)__builtin_amdgcn_readfirstlane((unsigned)acc_); while (__builtin_amdgcn_s_memrealtime() < t_end) __builtin_amdgcn_s_sleep(8); }
#undef PB
#undef PROBE_LDS
#undef PHASE_BEGIN
#undef WSF
#undef WSB
}
}

extern "C" void kernel_launch(void* const* d_in, const int* in_sizes, int n_in, void* d_out, int out_size, void* d_ws, size_t ws_size, hipStream_t stream) {
    static int grid = 0;
    if (grid == 0) {
        if (n_in != 30 || out_size != T * D || ws_size < WS_END) { fprintf(stderr, "kernel_launch: unexpected shapes / workspace (%d inputs, out %d, ws %zu < %zu)\n", n_in, out_size, ws_size, (size_t)WS_END); grid = -1; return; }
        int dev = 0, cus = 0, per_cu = 0;
        if (hipGetDevice(&dev) != hipSuccess || hipDeviceGetAttribute(&cus, hipDeviceAttributeMultiprocessorCount, dev) != hipSuccess) { grid = -1; return; }
        if (hipFuncSetAttribute((const void*)fwd_kernel, hipFuncAttributeMaxDynamicSharedMemorySize, LDS_BYTES) != hipSuccess) { fprintf(stderr, "kernel_launch: hipFuncSetAttribute failed\n"); grid = -1; return; }
        if (hipOccupancyMaxActiveBlocksPerMultiprocessor(&per_cu, (const void*)fwd_kernel, NTHREADS, LDS_BYTES) != hipSuccess || per_cu < 1) { fprintf(stderr, "kernel_launch: occupancy query reports %d\n", per_cu); }
        (void)hipGetLastError();
        grid = cus;
    }
    if (grid < 0) return;
    if (hipMemsetAsync((char*)d_ws + WS_CTL, 0, CTL_BYTES, stream) != hipSuccess) return;
    Params p{};
    for (int i = 0; i < 30; ++i) p.in[i] = (const float*)d_in[i];
    p.out = (float*)d_out; p.ws = (unsigned char*)d_ws;
    hipLaunchKernelGGL(fwd_kernel, dim3(grid), dim3(NTHREADS), LDS_BYTES, stream, p);
}
```

```cpp
#include <hip/hip_runtime.h>
#include <cstdio>
#include <cstdint>

#define LAS __attribute__((address_space(3)))
#define GAS __attribute__((address_space(1)))
typedef unsigned short bf16_t;
typedef short bf16x8 __attribute__((ext_vector_type(8)));
typedef float f32x4 __attribute__((ext_vector_type(4)));
typedef unsigned u32x4 __attribute__((ext_vector_type(4)));
typedef unsigned u32x2 __attribute__((ext_vector_type(2)));
typedef float f32x16 __attribute__((ext_vector_type(16)));

namespace {
constexpr int D = 1024, NB = 4, S = 4096, T = NB * S;
constexpr int ATTN_IN = 2840, PROJ_LD = 3072;
constexpr int OFF_SBQ = 0, OFF_SBK = 512, OFF_SBV = 1024, OFF_NQ = 1536, OFF_KC = 2048, OFF_VC = 2176, OFF_KS = 2304, OFF_VS = 2432,
              OFF_KW = 2560, OFF_VW = 2688, OFF_GATE = 2816;
constexpr int NCMP = 255;
constexpr int SSM_IN = 5152, SSM_INNER = 2048, CONV_DIM = 3072, ZX_LD = 5120;
constexpr int NE = 32, CAP = 16384, MAXTILES = 288;
constexpr float EPS = 1e-6f;
constexpr int NWAVES = 8, NTHREADS = 512;

constexpr size_t al4k(size_t x) { return (x + 4095) & ~(size_t)4095; }
constexpr size_t WS_CTL = 0, CTL_BYTES = 1u << 20;
constexpr int CW_CNT = 256;
constexpr int CW_BAR = 4096;
constexpr size_t CTL_MOD = 65536;
constexpr size_t WS_WIN = CTL_BYTES;
constexpr size_t WS_WOUT = WS_WIN + (size_t)3072 * 1024 * 2;
constexpr size_t WS_WSIN = WS_WOUT + (size_t)1024 * 1024 * 2;
constexpr size_t WS_WSOUT = WS_WSIN + (size_t)5120 * 1024 * 2;
constexpr size_t WS_WGU = WS_WSOUT + (size_t)1024 * 2048 * 2;
constexpr size_t WS_WDN = WS_WGU + (size_t)2 * 32 * 2048 * 1024 * 2;
constexpr size_t WS_U = WS_WDN + (size_t)2 * 32 * 1024 * 1024 * 2;
constexpr size_t WS_BIG = WS_U + (size_t)T * 1024 * 2;
constexpr size_t WS_O = WS_BIG + (size_t)T * 5120 * 2;
constexpr size_t WS_H1 = WS_O + (size_t)T * 2048 * 2;
constexpr size_t WS_H2 = WS_H1 + (size_t)T * 1024 * 4;
constexpr size_t WS_QN = WS_H2 + (size_t)T * 1024 * 4;
constexpr size_t WS_KN = WS_QN + (size_t)T * 512 * 4;
constexpr size_t WS_KCMP = WS_KN + (size_t)T * 256 * 4;
constexpr size_t WS_VCMP = WS_KCMP + al4k((size_t)NB * NCMP * 2 * 64 * 4);
constexpr size_t WS_ACT = WS_VCMP + al4k((size_t)NB * NCMP * 2 * 64 * 4);
constexpr size_t WS_Y = WS_ACT + (size_t)MAXTILES * 256 * 1024 * 2;
constexpr size_t WS_TOKE = WS_Y + (size_t)MAXTILES * 256 * 1024 * 2;
constexpr size_t WS_TOKW = WS_TOKE + (size_t)T * 16;
constexpr size_t WS_TOKP = WS_TOKW + (size_t)T * 16;
constexpr size_t WS_SLOT = WS_TOKP + (size_t)T * 16;
constexpr size_t WS_XC = WS_SLOT + (size_t)NE * CAP * 4;
constexpr size_t WS_YS = WS_XC + (size_t)T * 3072 * 4;
constexpr size_t WS_DT = WS_YS + (size_t)T * 2048 * 4;
constexpr size_t WS_MODF = WS_DT + (size_t)T * 32 * 4;
constexpr size_t WS_WV = WS_MODF + (size_t)2 * 4 * 6144 * 4;
constexpr size_t WS_VT = WS_WV + (size_t)768 * 1024 * 2;
constexpr size_t WS_QNB = WS_VT + (size_t)768 * T * 2;
constexpr size_t WS_KSN = WS_QNB + (size_t)T * 512 * 2;
constexpr size_t WS_KWN = WS_KSN + (size_t)T * 128 * 2;
constexpr size_t WS_KCB = WS_KWN + (size_t)T * 128 * 2;
constexpr size_t WS_VCT = WS_KCB + (size_t)8 * 256 * 64 * 2;
constexpr size_t WS_DT2 = WS_VCT + (size_t)8 * 64 * 256 * 2;
constexpr size_t WS_CS = WS_DT2 + (size_t)NB * 32 * S * 4;
constexpr size_t WS_DEC = WS_CS + (size_t)NB * 32 * S * 4;
constexpr size_t WS_W1T = WS_DEC + al4k((size_t)NB * 16 * 32 * 4);
constexpr size_t WS_SKW = WS_W1T + (size_t)2 * 128 * 2048 * 2;
constexpr size_t WS_END = WS_SKW + (size_t)3 * 2 * 32 * 1024 * 2;
constexpr size_t WS_ZBC = WS_BIG, WS_XT = WS_XC, WS_XCT = WS_XC + (size_t)3072 * T * 2, WS_ST = WS_YS, WS_PB = WS_YS + (size_t)NB * 16 * 32 * 8192 * 4, WS_BCM = WS_QN;
static_assert(WS_XCT + (size_t)2560 * T * 2 <= WS_YS && WS_PB + (size_t)NB * 16 * 32 * 8192 * 2 <= WS_DT && (size_t)T * 1024 * 2 <= (size_t)T * 512 * 4, "layer-1 overlays");

constexpr int RING_BYTES = 131072;
constexpr int EXTRA_OFF = RING_BYTES;
constexpr int TAB_OFF = 151552;
constexpr int XB_OFF = 152576;
constexpr int LDS_BYTES = 153600;

struct Params { const float* in[30]; float* out; unsigned char* ws; };

__device__ __forceinline__ float siluf(float v) { return v / (1.f + expf(-v)); }
__device__ __forceinline__ float logsig(float x) { return fminf(x, 0.f) - log1pf(expf(-fabsf(x))); }
__device__ __forceinline__ float wave_sum(float v) {
#pragma unroll
    for (int o = 32; o > 0; o >>= 1) v += __shfl_xor(v, o);
    return v;
}
__device__ __forceinline__ float wave_max(float v) {
#pragma unroll
    for (int o = 32; o > 0; o >>= 1) v = fmaxf(v, __shfl_xor(v, o));
    return v;
}
__device__ __forceinline__ unsigned f2bf(float f) { unsigned u = __builtin_bit_cast(unsigned, f); return (u + 0x7fffu + ((u >> 16) & 1u)) >> 16; }
typedef float f32x2_t __attribute__((ext_vector_type(2))); typedef __bf16 bf16x2_t __attribute__((ext_vector_type(2)));
__device__ __forceinline__ unsigned pk2(float lo, float hi) { f32x2_t v = {lo, hi}; bf16x2_t b = __builtin_convertvector(v, bf16x2_t); return __builtin_bit_cast(unsigned, b); }
__device__ __forceinline__ float bf2f(bf16_t v) { return __uint_as_float((unsigned)v << 16); }
__device__ __forceinline__ float bflo(unsigned w) { return __uint_as_float(w << 16); }
__device__ __forceinline__ float bfhi(unsigned w) { return __uint_as_float(w & 0xffff0000u); }
#define LDS_WAIT() asm volatile("s_waitcnt lgkmcnt(0)" ::: "memory")
__device__ __forceinline__ int fresh(int v) { asm volatile("" : "+v"(v)); return v; }
__device__ __forceinline__ int sfresh(int v) { asm volatile("" : "+s"(v)); return v; }

#define XB_TMO      128
#define XB_XCNT(j)  (256  + 64 * (j))
#define XB_XSUB(j)  (1280 + 64 * (j))
#define XB_XGEN(j)  (2304 + 64 * (j))
#define XB_TOP      3328
#define XB_TOPGEN   3392
#define XCD_BAR_WORDS 3456
#define XB_SPIN_CAP (1u << 18)
__device__ __forceinline__ unsigned xb_ld(unsigned* p)              { return __hip_atomic_load(p, __ATOMIC_RELAXED, __HIP_MEMORY_SCOPE_AGENT); }
__device__ __forceinline__ unsigned xb_add(unsigned* p, unsigned v) { return __hip_atomic_fetch_add(p, v, __ATOMIC_RELAXED, __HIP_MEMORY_SCOPE_AGENT); }
__device__ __forceinline__ unsigned xb_xcc_id() { return (unsigned)__builtin_amdgcn_s_getreg((3 << 11) | 20) & 0xFu; }
#define XB_SPIN(cond, bar) do { unsigned _sp = 0; while (cond) { __builtin_amdgcn_s_sleep(1); \
    if ((++_sp & 255u) == 0u) { if (xb_ld(&(bar)[XB_TMO])) break; if (_sp > XB_SPIN_CAP) { atomicAdd(&(bar)[XB_TMO], 1u); break; } } } } while (0)
struct XcdBarrier { unsigned* bar; unsigned x; volatile LAS unsigned* st; };
__device__ __forceinline__ XcdBarrier xcd_barrier_post(unsigned* bar, volatile LAS unsigned* st) {
    XcdBarrier b; b.bar = bar; b.x = xb_xcc_id(); b.st = st;
    if (threadIdx.x == 0) (void)xb_add(&bar[XB_XCNT(b.x)], 1u);
    return b;
}
__device__ __forceinline__ void xcd_barrier_complete(unsigned* bar, unsigned x, unsigned& nloc, unsigned& nx) {
    const unsigned G = gridDim.x * gridDim.y * gridDim.z;
    unsigned sum, cnt, mine, sp = 0u;
    for (;;) {
        sum = 0u; cnt = 0u; mine = 0u;
#pragma unroll
        for (unsigned j = 0; j < 16; ++j) { const unsigned c = xb_ld(&bar[XB_XCNT(j)]); sum += c; cnt += (c > 0u) ? 1u : 0u; mine = (j == x) ? c : mine; }
        if (sum == G) break;
        __builtin_amdgcn_s_sleep(1);
        if ((++sp & 255u) == 0u) { if (xb_ld(&bar[XB_TMO])) break; if (sp > XB_SPIN_CAP) { atomicAdd(&bar[XB_TMO], 1u); break; } }
    }
    nloc = mine > 0u ? mine : 1u; nx = cnt > 0u ? cnt : 1u;
}
__device__ __forceinline__ void xcd_barrier(const XcdBarrier& b) {
    asm volatile("s_waitcnt vmcnt(0)" ::: "memory");
    __syncthreads();
    if (threadIdx.x == 0) {
        unsigned* bar = b.bar;
        __builtin_amdgcn_s_waitcnt(0);
        unsigned nloc = b.st[0], nx = b.st[1];
        if (nloc == 0u) { xcd_barrier_complete(bar, b.x, nloc, nx); b.st[0] = nloc; b.st[1] = nx; }
        const unsigned old = xb_add(&bar[XB_XSUB(b.x)], 1u);
        const unsigned gen = old / nloc;
        if (old + 1u == (gen + 1u) * nloc) {
            __builtin_amdgcn_fence(__ATOMIC_RELEASE, "agent");
            asm volatile("s_waitcnt vmcnt(0)" ::: "memory");
            const unsigned og = xb_add(&bar[XB_TOP], 1u);
            const unsigned tg = og / nx;
            if (og + 1u == (tg + 1u) * nx) xb_add(&bar[XB_TOPGEN], 1u);
            else XB_SPIN(xb_ld(&bar[XB_TOPGEN]) == tg, bar);
            __builtin_amdgcn_fence(__ATOMIC_ACQUIRE, "agent");
            xb_add(&bar[XB_XGEN(b.x)], 1u);
            asm volatile("s_waitcnt vmcnt(0)" ::: "memory");
        } else {
            XB_SPIN(xb_ld(&bar[XB_XGEN(b.x)]) == gen, bar);
            __builtin_amdgcn_fence(__ATOMIC_ACQUIRE, "agent");
            asm volatile("s_waitcnt vmcnt(0)" ::: "memory");
        }
    }
    __syncthreads();
}

namespace pg8 {
constexpr int BM = 256, BK = 64, HALF = 128, HTB = HALF * BK * 2, STAGE_BYTES = 8 * HTB;
__device__ __forceinline__ int lds_byte(int r, int c) { const int st = (r >> 4) * 2 + (c >> 5), rr = r & 15, cc = c & 31, ob = rr * 64 + cc * 2; return st * 1024 + (ob ^ (((ob >> 9) & 1) << 5)); }
__device__ __forceinline__ void stage_rc(int b, int& R, int& C) { const int st = b / 1024, sb = b % 1024, swz = sb ^ (((sb >> 9) & 1) << 5); R = (st >> 1) * 16 + swz / 64; C = (st & 1) * 32 + (swz % 64) / 2; }
__device__ __forceinline__ int perm32(int rho) { const int n = rho >> 4, i = rho & 15; return 8 * (i >> 2) + 4 * n + (i & 3); }
struct Unit { int pm, pn, e; };
struct Gemm { const bf16_t* A; const bf16_t* Bt; int K; };
__device__ __forceinline__ unsigned cvt_pk_bf16(float lo, float hi) { unsigned r; asm volatile("v_cvt_pk_bf16_f32 %0, %1, %2" : "=v"(r) : "v"(lo), "v"(hi)); return r; }

struct DenseOrder {
    int nM, nN, nwg, G, c;
    __device__ void init(int M, int N, int G_, int c_) { nM = M / BM; nN = N / BM; nwg = nM * nN; G = G_; c = c_; }
    __device__ bool next(int i, Unit& u) const {
        const long L = (long)i * G + c; if (L >= nwg) return false;
        int wgid = (int)L; { const int q = nwg / 8, r = nwg % 8, xcd = wgid % 8, off = wgid / 8; wgid = (xcd < r ? xcd * (q + 1) : r * (q + 1) + (xcd - r) * q) + off; }
        const int nig = 8 * nN, gid = wgid / nig, fm = gid * 8, gsz = (nM - fm) < 8 ? (nM - fm) : 8;
        u.pm = fm + ((wgid % nig) % gsz); u.pn = (wgid % nig) / gsz; u.e = 0; return true;
    }
    __device__ __forceinline__ unsigned arow(const Unit& u, int r) const { return (unsigned)(u.pm * BM + r); }
};
struct MoeOrder {
    const LAS int* tb; const LAS int* cn; const int* slot_tok; int shift, G, c; bool gather;
    __device__ bool next(int i, Unit& u) const {
        const int L = i * G + c, tile = L >> shift; if (tile >= tb[NE]) return false;
        int e = 0; while (tb[e + 1] <= tile) ++e;
        u.pm = tile; u.pn = (e << shift) + (L & ((1 << shift) - 1)); u.e = e; return true;
    }
    __device__ __forceinline__ unsigned arow(const Unit& u, int r) const {
        if (!gather) return (unsigned)(u.pm * BM + r);
        const int pos = (u.pm - tb[u.e]) * BM + r;
        return pos < cn[u.e] ? (unsigned)slot_tok[u.e * CAP + pos] : 0u;
    }
};

struct EpiBf16 {
    static constexpr bool PERM = true;
    bf16_t* O; int ldc;
    __device__ __forceinline__ void operator()(const f32x4 (&acc)[2][2][4][2], const Unit& u, int wr, int wc, int fr, int fq) const {
        const int row0 = u.pm * BM + wr * 64 + fr, col0 = u.pn * BM + wc * 32 + 8 * fq;
#pragma unroll
        for (int ai = 0; ai < 2; ++ai)
#pragma unroll
            for (int m = 0; m < 4; ++m) { bf16_t* rowp = O + (size_t)(row0 + ai * HALF + m * 16) * ldc + col0;
#pragma unroll
                for (int bj = 0; bj < 2; ++bj) { const f32x4 v0 = acc[ai][bj][m][0], v1 = acc[ai][bj][m][1];
                    u32x4 w; w.x = cvt_pk_bf16(v0[0], v0[1]); w.y = cvt_pk_bf16(v0[2], v0[3]); w.z = cvt_pk_bf16(v1[0], v1[1]); w.w = cvt_pk_bf16(v1[2], v1[3]);
                    *(u32x4*)(rowp + bj * HALF) = w; } }
    }
};
struct EpiResid {
    static constexpr bool PERM = false;
    const float* base; float* out; const float* g;
    __device__ __forceinline__ void operator()(const f32x4 (&acc)[2][2][4][2], const Unit& u, int wr, int wc, int fr, int fq) const {
        const int row0 = u.pm * BM + wr * 64 + fr, col0 = u.pn * BM + wc * 32 + 4 * fq;
        const float* gb = g + (size_t)((u.pm * BM) / S) * 6144 + col0;
        f32x4 gv[2][2];
#pragma unroll
        for (int bj = 0; bj < 2; ++bj)
#pragma unroll
            for (int n = 0; n < 2; ++n) gv[bj][n] = *(const f32x4*)(gb + bj * HALF + n * 16);
#pragma unroll
        for (int ai = 0; ai < 2; ++ai)
#pragma unroll
            for (int m = 0; m < 4; ++m) { const size_t off = (size_t)(row0 + ai * HALF + m * 16) * D + col0;
#pragma unroll
                for (int bj = 0; bj < 2; ++bj)
#pragma unroll
                    for (int n = 0; n < 2; ++n) { const f32x4 bs = *(const f32x4*)(base + off + bj * HALF + n * 16);
                        *(f32x4*)(out + off + bj * HALF + n * 16) = bs + gv[bj][n] * acc[ai][bj][m][n]; } }
    }
};
struct EpiGu {
    static constexpr bool PERM = true;
    bf16_t* act; const float* bgu;
    __device__ __forceinline__ void operator()(const f32x4 (&acc)[2][2][4][2], const Unit& u, int wr, int wc, int fr, int fq) const {
        const int row0 = u.pm * BM + wr * 64 + fr, col0 = (u.pn & 7) * HALF + wc * 32 + 8 * fq;
        const float* bb = bgu + (size_t)u.e * 2048 + col0;
        const f32x4 bg0 = *(const f32x4*)(bb), bg1 = *(const f32x4*)(bb + 4), bu0 = *(const f32x4*)(bb + 1024), bu1 = *(const f32x4*)(bb + 1028);
#pragma unroll
        for (int ai = 0; ai < 2; ++ai)
#pragma unroll
            for (int m = 0; m < 4; ++m) {
                float r[8];
#pragma unroll
                for (int n = 0; n < 2; ++n) { const f32x4 gt = acc[ai][0][m][n] + (n ? bg1 : bg0), up = acc[ai][1][m][n] + (n ? bu1 : bu0);
#pragma unroll
                    for (int j = 0; j < 4; ++j) { const float gg = fminf(gt[j], 7.f), uu = fminf(fmaxf(up[j], -7.f), 7.f);
                        r[n * 4 + j] = (uu + 1.f) * gg * __builtin_amdgcn_rcpf(1.f + __expf(-1.702f * gg)); } }
                u32x4 w; w.x = cvt_pk_bf16(r[0], r[1]); w.y = cvt_pk_bf16(r[2], r[3]); w.z = cvt_pk_bf16(r[4], r[5]); w.w = cvt_pk_bf16(r[6], r[7]);
                *(u32x4*)(act + (size_t)(row0 + ai * HALF + m * 16) * D + col0) = w; }
    }
};
struct EpiDown {
    static constexpr bool PERM = true;
    bf16_t* y; const float* bd;
    __device__ __forceinline__ void operator()(const f32x4 (&acc)[2][2][4][2], const Unit& u, int wr, int wc, int fr, int fq) const {
        const int row0 = u.pm * BM + wr * 64 + fr, col0 = (u.pn & 3) * BM + wc * 32 + 8 * fq;
        const float* bb = bd + (size_t)u.e * 1024 + col0;
        f32x4 bv[2][2];
#pragma unroll
        for (int bj = 0; bj < 2; ++bj)
#pragma unroll
            for (int n = 0; n < 2; ++n) bv[bj][n] = *(const f32x4*)(bb + bj * HALF + 4 * n);
#pragma unroll
        for (int ai = 0; ai < 2; ++ai)
#pragma unroll
            for (int m = 0; m < 4; ++m) { bf16_t* rowp = y + (size_t)(row0 + ai * HALF + m * 16) * D + col0;
#pragma unroll
                for (int bj = 0; bj < 2; ++bj) { const f32x4 v0 = acc[ai][bj][m][0] + bv[bj][0], v1 = acc[ai][bj][m][1] + bv[bj][1];
                    u32x4 w; w.x = cvt_pk_bf16(v0[0], v0[1]); w.y = cvt_pk_bf16(v0[2], v0[3]); w.z = cvt_pk_bf16(v1[0], v1[1]); w.w = cvt_pk_bf16(v1[2], v1[3]);
                    *(u32x4*)(rowp + bj * HALF) = w; } }
    }
};

template <class Epi, class Sched>
__device__ __forceinline__ void gemm_phase(LAS unsigned char* lds, const Gemm g, const Sched& S, const Epi& E, const int tid) {
    const int wid = __builtin_amdgcn_readfirstlane(tid >> 6), lane = tid & 63, wr = wid >> 2, wc = wid & 3, fr = lane & 15, fq = lane >> 4;
    const int K = g.K, nt = K / BK;
    int RA[2], CA[2]; unsigned voffB[2];
#pragma unroll
    for (int i = 0; i < 2; ++i) { int R, C; stage_rc(tid * 16 + i * 8192, R, C); const int Rb = Epi::PERM ? ((R & ~31) + perm32(R & 31)) : R;
        RA[i] = R; CA[i] = C; voffB[i] = (unsigned)(Rb * K + C) * 2u; }
    const size_t kstep = (size_t)(BK * 2);
    const size_t hstep = (size_t)HALF * K * 2;
    const size_t tstep = 2 * hstep;
    const unsigned ldsw = (unsigned)wid * 1024u;
    const int aoff = lds_byte(wr * 64 + fr, fq * 8), boff = lds_byte(wc * 32 + fr, fq * 8);
#define PG8_SA(b, h) (((b) * 2 + (h)) * HTB)
#define PG8_SB(b, h) ((4 + (b) * 2 + (h)) * HTB)
#define PG8_STAGE(bufoff, gbase, voff) do { _Pragma("unroll") for (int _i = 0; _i < 2; ++_i) \
        __builtin_amdgcn_global_load_lds((const unsigned*)((const char*)(gbase) + (voff)[_i]), (LAS unsigned*)(lds + (bufoff) + ldsw + _i * 8192), 16, 0, 0); } while (0)
#define PG8_LDA(dst, b, h) do { _Pragma("unroll") for (int m = 0; m < 4; ++m) _Pragma("unroll") for (int k = 0; k < 2; ++k) dst[m][k] = *(const LAS bf16x8*)(lds + PG8_SA(b, h) + aoff + m * 2048 + k * 1024); } while (0)
#define PG8_LDB(dst, b, h) do { _Pragma("unroll") for (int n = 0; n < 2; ++n) _Pragma("unroll") for (int k = 0; k < 2; ++k) dst[n][k] = *(const LAS bf16x8*)(lds + PG8_SB(b, h) + boff + n * 2048 + k * 1024); } while (0)
#define PG8_MMA(ai, bj, At, Bt) do { __builtin_amdgcn_s_setprio(1); _Pragma("unroll") for (int m = 0; m < 4; ++m) _Pragma("unroll") for (int n = 0; n < 2; ++n) _Pragma("unroll") for (int k = 0; k < 2; ++k) \
        acc[ai][bj][m][n] = __builtin_amdgcn_mfma_f32_16x16x32_bf16(Bt[n][k], At[m][k], acc[ai][bj][m][n], 0, 0, 0); __builtin_amdgcn_s_setprio(0); } while (0)
#define PG8_WAIT_V(n) asm volatile("s_waitcnt vmcnt(" #n ")" ::: "memory")
#define PG8_WAIT_L(n) asm volatile("s_waitcnt lgkmcnt(" #n ")" ::: "memory")
#define PG8_BAR __builtin_amdgcn_s_barrier()
#define PG8_SCHED __builtin_amdgcn_sched_barrier(0)
#define PG8_AOFF(dst, u) do { _Pragma("unroll") for (int _h = 0; _h < 2; ++_h) _Pragma("unroll") for (int _i = 0; _i < 2; ++_i) dst[_h][_i] = (S.arow(u, _h * HALF + RA[_i]) * (unsigned)K + (unsigned)CA[_i]) * 2u; } while (0)
    Unit cur, nxt; int ui = 0;
    if (!S.next(0, cur)) return;
    f32x4 acc[2][2][4][2];
#pragma unroll
    for (int a = 0; a < 2; ++a)
#pragma unroll
        for (int b = 0; b < 2; ++b)
#pragma unroll
            for (int m = 0; m < 4; ++m)
#pragma unroll
                for (int n = 0; n < 2; ++n) acc[a][b][m][n] = (f32x4){0.f, 0.f, 0.f, 0.f};
    bf16x8 At[4][2], B0[2][2], B1[2][2];
    unsigned va[2][2], vn[2][2];
    PG8_AOFF(va, cur);
    const char* Ab = (const char*)g.A;
    const char* cB = (const char*)g.Bt + (size_t)cur.pn * tstep;
    PG8_STAGE(PG8_SB(0, 0), cB, voffB); PG8_STAGE(PG8_SB(0, 1), cB + hstep, voffB); PG8_STAGE(PG8_SA(0, 0), Ab, va[0]); PG8_STAGE(PG8_SA(0, 1), Ab, va[1]);
    if (wr == 1) PG8_BAR;
    PG8_WAIT_V(2); PG8_BAR;
    PG8_STAGE(PG8_SB(1, 0), cB + kstep, voffB); PG8_STAGE(PG8_SA(1, 0), Ab + kstep, va[0]); PG8_STAGE(PG8_SB(1, 1), cB + hstep + kstep, voffB);
    PG8_WAIT_V(6); PG8_BAR;
    for (;;) {
        const bool has_next = S.next(ui + 1, nxt);
        if (has_next) { PG8_AOFF(vn, nxt); }
        else {
#pragma unroll
            for (int h = 0; h < 2; ++h)
#pragma unroll
                for (int i = 0; i < 2; ++i) vn[h][i] = va[h][i]; }
        const char* nB = has_next ? (const char*)g.Bt + (size_t)nxt.pn * tstep : cB;
        for (int t = 0; t < nt; t += 2) {
            const bool last = (t == nt - 2);
            const char* a1 = Ab + (size_t)(t + 1) * kstep;
            const char* a2 = last ? Ab : Ab + (size_t)(t + 2) * kstep; const char* b2 = last ? nB : cB + (size_t)(t + 2) * kstep;
            const char* a3 = a2 + kstep; const char* b3 = b2 + kstep;
            unsigned o2[2][2];
#pragma unroll
            for (int h = 0; h < 2; ++h)
#pragma unroll
                for (int i = 0; i < 2; ++i) o2[h][i] = last ? vn[h][i] : va[h][i];
            PG8_LDB(B0, 0, 0); PG8_LDB(B1, 0, 1); PG8_SCHED; PG8_LDA(At, 0, 0); PG8_STAGE(PG8_SA(1, 1), a1, va[1]);
            PG8_WAIT_V(8); PG8_WAIT_L(0); PG8_BAR; PG8_MMA(0, 0, At, B0); PG8_MMA(0, 1, At, B1); PG8_BAR; PG8_SCHED;
            PG8_LDA(At, 0, 1); PG8_STAGE(PG8_SB(0, 0), b2, voffB); PG8_STAGE(PG8_SB(0, 1), b2 + hstep, voffB); PG8_STAGE(PG8_SA(0, 0), a2, o2[0]);
            PG8_WAIT_V(8); PG8_WAIT_L(0); PG8_BAR; PG8_MMA(1, 0, At, B0); PG8_MMA(1, 1, At, B1); PG8_BAR; PG8_SCHED;
            PG8_LDB(B0, 1, 0); PG8_LDB(B1, 1, 1); PG8_SCHED; PG8_LDA(At, 1, 0); PG8_STAGE(PG8_SA(0, 1), a2, o2[1]);
            PG8_WAIT_V(8); PG8_WAIT_L(0); PG8_BAR; PG8_MMA(0, 0, At, B0); PG8_MMA(0, 1, At, B1); PG8_BAR; PG8_SCHED;
            PG8_LDA(At, 1, 1); PG8_STAGE(PG8_SB(1, 0), b3, voffB); PG8_STAGE(PG8_SB(1, 1), b3 + hstep, voffB); PG8_STAGE(PG8_SA(1, 0), a3, o2[0]);
            PG8_WAIT_V(8); PG8_WAIT_L(0); PG8_BAR; PG8_MMA(1, 0, At, B0); PG8_MMA(1, 1, At, B1); PG8_BAR; PG8_SCHED;
        }
        if (wr == 0) PG8_BAR;
        E(acc, cur, wr, wc, fr, fq);
        if (!has_next) break;
#pragma unroll
        for (int a = 0; a < 2; ++a)
#pragma unroll
            for (int b = 0; b < 2; ++b)
#pragma unroll
                for (int m = 0; m < 4; ++m)
#pragma unroll
                    for (int n = 0; n < 2; ++n) acc[a][b][m][n] = (f32x4){0.f, 0.f, 0.f, 0.f};
        cur = nxt; cB = nB; ++ui;
#pragma unroll
        for (int h = 0; h < 2; ++h)
#pragma unroll
            for (int i = 0; i < 2; ++i) va[h][i] = vn[h][i];
        if (wr == 1) PG8_BAR;
    }
    PG8_WAIT_V(0);
    PG8_BAR;
#undef PG8_SA
#undef PG8_SB
#undef PG8_STAGE
#undef PG8_LDA
#undef PG8_LDB
#undef PG8_MMA
#undef PG8_WAIT_V
#undef PG8_WAIT_L
#undef PG8_BAR
#undef PG8_SCHED
#undef PG8_AOFF
}
}

#ifndef PROBE_SUB
#define PROBE_SUB 0
#endif
struct Ctx {
    LAS unsigned char* lds; unsigned char* ws;
    int tid, lane, wave, gw, ngw, G, bid;
    mutable unsigned long long sub, subt;
};
#define SUB_BEGIN(X, id) do { if (PROBE_SUB == (id)) (X).subt = __builtin_amdgcn_s_memrealtime(); } while (0)
#define SUB_END(X, id) do { if (PROBE_SUB == (id)) (X).sub += __builtin_amdgcn_s_memrealtime() - (X).subt; } while (0)

__device__ __forceinline__ void transpose_item(const float* W, int ldw, int K, int nvalid, int k0, int n0, bf16_t* WT, int row0, LAS float* scr, int lane) {
    const int c4 = (lane & 7) * 4, kr = lane >> 3;
    f32x4 v[8];
#pragma unroll
    for (int i = 0; i < 8; ++i) v[i] = (n0 + c4 < nvalid) ? *(const f32x4*)(W + (size_t)(k0 + kr + 8 * i) * ldw + n0 + c4) : (f32x4){0.f, 0.f, 0.f, 0.f};
#pragma unroll
    for (int i = 0; i < 8; ++i) { LAS float* d = scr + (kr + 8 * i) * 33 + c4; d[0] = v[i].x; d[1] = v[i].y; d[2] = v[i].z; d[3] = v[i].w; }
    LDS_WAIT(); asm volatile("" ::: "memory");
    const int c = lane & 7;
#pragma unroll
    for (int j = 0; j < 4; ++j) { const int n = (lane >> 3) + 8 * j; const LAS float* s = scr + (8 * c) * 33 + n;
        u32x4 o; o.x = pk2(s[0 * 33], s[1 * 33]); o.y = pk2(s[2 * 33], s[3 * 33]); o.z = pk2(s[4 * 33], s[5 * 33]); o.w = pk2(s[6 * 33], s[7 * 33]);
        *(u32x4*)(WT + (size_t)(row0 + n) * K + k0 + 8 * c) = o; }
    LDS_WAIT(); asm volatile("" ::: "memory");
}
__device__ __forceinline__ void ph_prologue(const Params& p, const Ctx& X) {
    LAS float* scr = (LAS float*)(X.lds + X.wave * 16384);
    unsigned char* ws = X.ws;
    constexpr int I_MOD = 2 * 96 * 8;
    constexpr int I_SK = 3 * 16, I_W1 = 2 * 32 * 4, I_WIN = 16 * 96, I_WV = 16 * 24, I_WOUT = 16 * 32, I_WSIN = 16 * 160, I_WSOUT = 32 * 32, I_GU = 64 * 1024, I_DN = 64 * 512;
    constexpr int NITEMS = I_MOD + I_SK + I_W1 + I_WIN + I_WV + I_WOUT + I_WSIN + I_WSOUT + I_GU + I_DN;
    for (int it = X.gw; it < NITEMS; it += X.ngw) {
        int r = it;
        if (r < I_MOD) {
            const int kp = r & 7, jb = (r >> 3) % 96, l = r / (8 * 96), j = jb * 64 + X.lane;
            const float* w = p.in[2] + (size_t)l * 1024 * 6144 + (size_t)(kp * 128) * 6144 + j;
            const float* c = p.in[1] + kp * 128;
            float a0 = 0.f, a1 = 0.f, a2 = 0.f, a3 = 0.f;
#pragma unroll 8
            for (int i = 0; i < 128; ++i) { const float wv = w[(size_t)i * 6144];
                a0 += siluf(c[i]) * wv; a1 += siluf(c[1024 + i]) * wv; a2 += siluf(c[2048 + i]) * wv; a3 += siluf(c[3072 + i]) * wv; }
            if (kp == 0) { const float bb = p.in[3][l * 6144 + j]; a0 += bb; a1 += bb; a2 += bb; a3 += bb; }
            unsigned long long* mq = (unsigned long long*)(ws + CTL_MOD) + (size_t)l * 4 * 6144 + j;
            atomicAdd(mq, (unsigned long long)__double2ll_rn((double)a0 * 1099511627776.0)); atomicAdd(mq + 6144, (unsigned long long)__double2ll_rn((double)a1 * 1099511627776.0));
            atomicAdd(mq + 2 * 6144, (unsigned long long)__double2ll_rn((double)a2 * 1099511627776.0)); atomicAdd(mq + 3 * 6144, (unsigned long long)__double2ll_rn((double)a3 * 1099511627776.0));
            continue;
        }
        r -= I_MOD;
        if (r < I_SK) {
            const int m = r >> 4, kb = r & 15, k0 = kb * 64;
            const float* W = m < 2 ? p.in[24] + (size_t)m * D * NE : p.in[16] + 5120; const int ldw = m < 2 ? NE : SSM_IN;
#pragma unroll 8
            for (int i = 0; i < 32; ++i) { const int kk = 2 * i + (X.lane >> 5); scr[kk * 33 + (X.lane & 31)] = W[(size_t)(k0 + kk) * ldw + (X.lane & 31)]; }
            LDS_WAIT(); asm volatile("" ::: "memory");
            const int c = X.lane & 7;
#pragma unroll
            for (int j = 0; j < 4; ++j) { const int n = (X.lane >> 3) + 8 * j; const LAS float* sp = scr + (8 * c) * 33 + n;
                float v[8]; unsigned hi[8];
#pragma unroll
                for (int q = 0; q < 8; ++q) { v[q] = sp[q * 33]; hi[q] = f2bf(v[q]); v[q] -= __uint_as_float(hi[q] << 16); }
                u32x4 oh, ol; oh.x = hi[0] | (hi[1] << 16); oh.y = hi[2] | (hi[3] << 16); oh.z = hi[4] | (hi[5] << 16); oh.w = hi[6] | (hi[7] << 16);
                ol.x = pk2(v[0], v[1]); ol.y = pk2(v[2], v[3]); ol.z = pk2(v[4], v[5]); ol.w = pk2(v[6], v[7]);
                bf16_t* dst = (bf16_t*)(ws + WS_SKW) + (size_t)m * 2 * 32 * 1024 + (size_t)n * 1024 + k0 + 8 * c;
                *(u32x4*)dst = oh; *(u32x4*)(dst + 32 * 1024) = ol; }
            LDS_WAIT(); asm volatile("" ::: "memory");
            continue; }
        r -= I_SK;
        if (r < I_W1) { const int kv = r >> 7, q = r & 127, kb = q >> 2, nb = q & 3;
            transpose_item(kv ? p.in[14] : p.in[12], 128, 2048, 128, kb * 64, nb * 32, (bf16_t*)(ws + WS_W1T) + (size_t)kv * 128 * 2048, nb * 32, scr, X.lane); continue; } r -= I_W1;
        if (r < I_WIN) { const int kb = r / 96, nb = r % 96; transpose_item(p.in[6], ATTN_IN, 1024, ATTN_IN, kb * 64, nb * 32, (bf16_t*)(ws + WS_WIN), nb * 32, scr, X.lane); continue; } r -= I_WIN;
        if (r < I_WV) { const int kb = r / 24, nb = r % 24, r0 = nb * 32, src = r0 < 512 ? OFF_SBV + r0 : (r0 < 640 ? OFF_VS + (r0 - 512) : OFF_VW + (r0 - 640));
            transpose_item(p.in[6], ATTN_IN, 1024, ATTN_IN, kb * 64, src, (bf16_t*)(ws + WS_WV), r0, scr, X.lane); continue; } r -= I_WV;
        if (r < I_WOUT) { const int kb = r / 32, nb = r % 32; transpose_item(p.in[7], 1024, 1024, 1024, kb * 64, nb * 32, (bf16_t*)(ws + WS_WOUT), nb * 32, scr, X.lane); continue; } r -= I_WOUT;
        if (r < I_WSIN) { const int kb = r / 160, nb = r % 160, n0 = nb * 32, row0 = n0 < 2048 ? n0 : (n0 < 4096 ? n0 + 1024 : n0 - 2048);
            transpose_item(p.in[16], SSM_IN, 1024, SSM_IN, kb * 64, n0, (bf16_t*)(ws + WS_WSIN), row0, scr, X.lane); continue; } r -= I_WSIN;
        if (r < I_WSOUT) { const int kb = r / 32, nb = r % 32; transpose_item(p.in[23], 1024, 2048, 1024, kb * 64, nb * 32, (bf16_t*)(ws + WS_WSOUT), nb * 32, scr, X.lane); continue; } r -= I_WSOUT;
        if (r < I_GU) { const int m = r >> 10, q = r & 1023, kb = q >> 6, nb = q & 63, n0 = nb * 32;
            const int row0 = ((n0 & 1023) >> 7) * 256 + (n0 >> 10) * 128 + (n0 & 127);
            transpose_item(p.in[26] + (size_t)m * 1024 * 2048, 2048, 1024, 2048, kb * 64, n0, (bf16_t*)(ws + WS_WGU) + (size_t)m * 2048 * 1024, row0, scr, X.lane); continue; } r -= I_GU;
        { const int m = r >> 9, q = r & 511, kb = q >> 5, nb = q & 31;
            transpose_item(p.in[28] + (size_t)m * 1024 * 1024, 1024, 1024, 1024, kb * 64, nb * 32, (bf16_t*)(ws + WS_WDN) + (size_t)m * 1024 * 1024, nb * 32, scr, X.lane); }
    }
}

struct Row { f32x4 v[4]; };
__device__ __forceinline__ void row_load(Row& r, const float* p, int lane) {
#pragma unroll
    for (int j = 0; j < 4; ++j) r.v[j] = ((const f32x4*)p)[64 * j + lane];
}
__device__ __forceinline__ void row_store(const Row& r, float* p, int lane) {
#pragma unroll
    for (int j = 0; j < 4; ++j) ((f32x4*)p)[64 * j + lane] = r.v[j];
}
template <class PV>
__device__ __forceinline__ void row_norm_mod(const Row& r, Row& o, const float* gain, PV sc, PV sh, int lane) {
    float ss = 0.f;
#pragma unroll
    for (int j = 0; j < 4; ++j) ss += (r.v[j].x * r.v[j].x + r.v[j].y * r.v[j].y) + (r.v[j].z * r.v[j].z + r.v[j].w * r.v[j].w);
    const float rs = rsqrtf(wave_sum(ss) * (1.f / 1024.f) + EPS);
#pragma unroll
    for (int j = 0; j < 4; ++j) { const f32x4 g = ((const f32x4*)gain)[64 * j + lane], a = sc[64 * j + lane], b = sh[64 * j + lane];
        o.v[j] = r.v[j] * rs * g * (a + 1.f) + b; }
}
__device__ __forceinline__ void row_store_bf16(const Row& r, bf16_t* p, int lane) {
#pragma unroll
    for (int j = 0; j < 4; ++j) { u32x2 w; w.x = pk2(r.v[j].x, r.v[j].y); w.y = pk2(r.v[j].z, r.v[j].w); ((u32x2*)p)[64 * j + lane] = w; }
}
__device__ __forceinline__ void row_store_lds(const Row& r, LAS float* p, int lane) {
#pragma unroll
    for (int j = 0; j < 4; ++j) ((LAS f32x4*)p)[64 * j + lane] = r.v[j];
}
__device__ __forceinline__ float modq2f(long long q) { return (float)((double)q * 9.094947017729282e-13); }
__device__ __forceinline__ void ph_norm0(const Params& p, const Ctx& X) {
    const long long* mq = (const long long*)(X.ws + CTL_MOD);
    float* modf = (float*)(X.ws + WS_MODF);
    for (int i = X.bid * NTHREADS + X.tid; i < 2 * 4 * 6144; i += X.G * NTHREADS) modf[i] = modq2f(mq[i]);
    LAS float* tab = (LAS float*)X.lds;
    for (int i = X.tid; i < 4 * 2048; i += NTHREADS) tab[i] = modq2f(mq[(size_t)(i >> 11) * 6144 + (i & 2047)]);
    __syncthreads();
    for (int t = X.gw; t < T; t += X.ngw) {
        Row r, o; row_load(r, p.in[0] + (size_t)t * D, X.lane);
        const LAS float* m = tab + (t / S) * 2048;
        row_norm_mod(r, o, p.in[4], (const LAS f32x4*)(m + 1024), (const LAS f32x4*)m, X.lane);
        row_store_bf16(o, (bf16_t*)(X.ws + WS_U) + (size_t)t * D, X.lane);
    }
}
__device__ __forceinline__ void route_select(float logit, int lane, LAS unsigned* lcnt, int& ev, float& wv, int& lpos) {
    const int e = lane & 31;
    float tl[4]; int te[4];
#pragma unroll
    for (int k = 0; k < 4; ++k) {
        float bv = logit; int bi = e;
#pragma unroll
        for (int o = 16; o > 0; o >>= 1) { const float ov = __shfl_xor(bv, o); const int oi = __shfl_xor(bi, o); if (ov > bv || (ov == bv && oi < bi)) { bv = ov; bi = oi; } }
        tl[k] = bv; te[k] = bi;
        if (e == bi) logit = -INFINITY;
    }
    ev = 0; wv = 0.f; lpos = 0;
    if (e < 4) {
        const float e1 = expf(tl[1] - tl[0]), e2 = expf(tl[2] - tl[0]), e3 = expf(tl[3] - tl[0]);
        const float inv = 1.f / (1.f + e1 + e2 + e3);
        wv = (e == 0 ? 1.f : e == 1 ? e1 : e == 2 ? e2 : e3) * inv;
        ev = e == 0 ? te[0] : e == 1 ? te[1] : e == 2 ? te[2] : te[3];
        lpos = (int)__hip_atomic_fetch_add(&lcnt[ev], 1u, __ATOMIC_RELAXED, __HIP_MEMORY_SCOPE_WORKGROUP);
    }
}
__device__ __forceinline__ void moe_table(const Ctx& X, int l) {
    LAS int* tb = (LAS int*)(X.lds + TAB_OFF);
    if (X.wave == 0) {
        const unsigned* cnt = (const unsigned*)(X.ws + WS_CTL) + CW_CNT + l * 32 * 32;
        const int e = X.lane & 31;
        const int c = (int)__hip_atomic_load(cnt + e * 32, __ATOMIC_RELAXED, __HIP_MEMORY_SCOPE_AGENT), nt = (c + 255) >> 8;
        int incl = nt;
#pragma unroll
        for (int o = 1; o < 32; o <<= 1) { const int u = __shfl_up(incl, o); if (e >= o) incl += u; }
        if (X.lane < 32) { tb[e] = incl - nt; tb[40 + e] = c; if (e == 31) tb[NE] = incl; }
    }
    __syncthreads();
}
template <int MODE>
__device__ __forceinline__ void ph_token(const Params& p, const Ctx& X, int l, const float* h, float* hn) {
    if (MODE != 0) moe_table(X, l);
    const LAS int* tb = (const LAS int*)(X.lds + TAB_OFF);
    const float* modl = (const float*)(X.ws + WS_MODF) + (size_t)l * 4 * 6144;
    const float* modn = (const float*)(X.ws + WS_MODF) + (size_t)(MODE == 1 ? 1 : l) * 4 * 6144;
    const float* gain = MODE == 1 ? p.in[4] + D : p.in[5] + l * D;
    const int sc_off = MODE == 1 ? 1024 : 4096, sh_off = MODE == 1 ? 0 : 3072;
    const bf16_t* y = (const bf16_t*)(X.ws + WS_Y);
    LAS float* rsl = (LAS float*)X.lds;
    LAS float* part = (LAS float*)(X.lds + 1024);
    if (MODE == 0 && X.tid < 32) ((LAS unsigned*)(X.lds + 1024 + 65536))[X.tid] = 0u;
    for (int tile = X.bid; tile < T / 64; tile += X.G) {
        const int lane = fresh(X.lane), w = X.wave, tb0 = tile * 64, bb = tb0 / S;
        int pe_ = 0, pp_ = 0; float pw_ = 0.f;
        if (MODE != 0 && lane < 32) { const int idx = (tb0 + 8 * w) * 4 + lane; pe_ = ((const int*)(X.ws + WS_TOKE))[idx]; pp_ = ((const int*)(X.ws + WS_TOKP))[idx]; pw_ = ((const float*)(X.ws + WS_TOKW))[idx]; }
#pragma unroll 1
        for (int k2 = 0; k2 < 4; ++k2) {
            Row r[2];
#pragma unroll
            for (int u = 0; u < 2; ++u) row_load(r[u], h + (size_t)(tb0 + 8 * w + 2 * k2 + u) * D, lane);
            if (MODE != 0) {
                const float* g2 = modl + (size_t)bb * 6144 + 5120;
                Row sacc[2];
#pragma unroll
                for (int u = 0; u < 2; ++u) {
#pragma unroll
                    for (int j = 0; j < 4; ++j) sacc[u].v[j] = (f32x4){0.f, 0.f, 0.f, 0.f};
#pragma unroll
                    for (int kk = 0; kk < 4; ++kk) {
                        const int sl = (2 * k2 + u) * 4 + kk;
                        const int e = __shfl(pe_, sl), pos = __shfl(pp_, sl); const float wt = __shfl(pw_, sl);
                        const bf16_t* yr = y + (size_t)(tb[e] * 256 + pos) * D;
#pragma unroll
                        for (int j = 0; j < 4; ++j) { const u32x2 q = ((const u32x2*)yr)[64 * j + lane];
                            sacc[u].v[j].x += wt * bflo(q.x); sacc[u].v[j].y += wt * bfhi(q.x); sacc[u].v[j].z += wt * bflo(q.y); sacc[u].v[j].w += wt * bfhi(q.y); }
                    }
                }
#pragma unroll
                for (int u = 0; u < 2; ++u) {
#pragma unroll
                    for (int j = 0; j < 4; ++j) r[u].v[j] = r[u].v[j] + ((const f32x4*)g2)[64 * j + lane] * sacc[u].v[j];
                    row_store(r[u], hn + (size_t)(tb0 + 8 * w + 2 * k2 + u) * D, lane);
                }
            }
            if (MODE != 2) {
                const float* m = modn + (size_t)bb * 6144;
#pragma unroll
                for (int u = 0; u < 2; ++u) {
                    float ssq = 0.f;
#pragma unroll
                    for (int j = 0; j < 4; ++j) ssq += (r[u].v[j].x * r[u].v[j].x + r[u].v[j].y * r[u].v[j].y) + (r[u].v[j].z * r[u].v[j].z + r[u].v[j].w * r[u].v[j].w);
                    const float rs = rsqrtf(wave_sum(ssq) * (1.f / 1024.f) + EPS);
                    Row o;
#pragma unroll
                    for (int j = 0; j < 4; ++j) { const f32x4 g = ((const f32x4*)gain)[64 * j + lane], a = ((const f32x4*)(m + sc_off))[64 * j + lane], b = ((const f32x4*)(m + sh_off))[64 * j + lane];
                        o.v[j] = r[u].v[j] * rs * g * (a + 1.f) + b; }
                    row_store_bf16(o, (bf16_t*)(X.ws + WS_U) + (size_t)(tb0 + 8 * w + 2 * k2 + u) * D, lane);
                    if (lane == 0) rsl[8 * w + 2 * k2 + u] = rs;
                }
            }
        }
        if (MODE == 2) continue;
        __syncthreads();
        {
            const int ql = lane & 31, hf = lane >> 5;
            const float* src = MODE == 0 ? h : hn;
            const float* m = modn + (size_t)bb * 6144;
            const bf16_t* wh = (const bf16_t*)(X.ws + WS_SKW) + (size_t)(MODE == 0 ? l : 2) * 2 * 32 * 1024 + (size_t)ql * 1024;
            const float rs0 = rsl[ql], rs1 = rsl[32 + ql];
            f32x16 acc0, acc1;
#pragma unroll
            for (int i = 0; i < 16; ++i) { acc0[i] = 0.f; acc1[i] = 0.f; }
#pragma unroll 2
            for (int ks = 0; ks < 8; ++ks) {
                const int k0 = 128 * w + 16 * ks + 8 * hf;
                float ca[8], cb[8];
                { const f32x4 g0 = *(const f32x4*)(gain + k0), g1 = *(const f32x4*)(gain + k0 + 4), a0 = *(const f32x4*)(m + sc_off + k0), a1 = *(const f32x4*)(m + sc_off + k0 + 4),
                              b0 = *(const f32x4*)(m + sh_off + k0), b1 = *(const f32x4*)(m + sh_off + k0 + 4);
                  ca[0] = g0.x * (1.f + a0.x); ca[1] = g0.y * (1.f + a0.y); ca[2] = g0.z * (1.f + a0.z); ca[3] = g0.w * (1.f + a0.w);
                  ca[4] = g1.x * (1.f + a1.x); ca[5] = g1.y * (1.f + a1.y); ca[6] = g1.z * (1.f + a1.z); ca[7] = g1.w * (1.f + a1.w);
                  cb[0] = b0.x; cb[1] = b0.y; cb[2] = b0.z; cb[3] = b0.w; cb[4] = b1.x; cb[5] = b1.y; cb[6] = b1.z; cb[7] = b1.w; }
                const bf16x8 whi = *(const bf16x8*)(wh + k0), wlo = *(const bf16x8*)(wh + 32 * 1024 + k0);
#pragma unroll
                for (int mt = 0; mt < 2; ++mt) {
                    const float* xr = src + (size_t)(tb0 + 32 * mt + ql) * D + k0;
                    const f32x4 x0 = *(const f32x4*)xr, x1 = *(const f32x4*)(xr + 4);
                    const float rs = mt ? rs1 : rs0;
                    const float xv[8] = {x0.x, x0.y, x0.z, x0.w, x1.x, x1.y, x1.z, x1.w};
                    float u[8]; unsigned hi[8];
#pragma unroll
                    for (int q = 0; q < 8; ++q) { u[q] = xv[q] * rs * ca[q] + cb[q]; hi[q] = f2bf(u[q]); u[q] -= __uint_as_float(hi[q] << 16); }
                    u32x4 oh, ol; oh.x = hi[0] | (hi[1] << 16); oh.y = hi[2] | (hi[3] << 16); oh.z = hi[4] | (hi[5] << 16); oh.w = hi[6] | (hi[7] << 16);
                    ol.x = pk2(u[0], u[1]); ol.y = pk2(u[2], u[3]); ol.z = pk2(u[4], u[5]); ol.w = pk2(u[6], u[7]);
                    const bf16x8 ah = __builtin_bit_cast(bf16x8, oh), al = __builtin_bit_cast(bf16x8, ol);
                    if (mt == 0) { acc0 = __builtin_amdgcn_mfma_f32_32x32x16_bf16(ah, whi, acc0, 0, 0, 0); acc0 = __builtin_amdgcn_mfma_f32_32x32x16_bf16(al, whi, acc0, 0, 0, 0); acc0 = __builtin_amdgcn_mfma_f32_32x32x16_bf16(ah, wlo, acc0, 0, 0, 0); }
                    else { acc1 = __builtin_amdgcn_mfma_f32_32x32x16_bf16(ah, whi, acc1, 0, 0, 0); acc1 = __builtin_amdgcn_mfma_f32_32x32x16_bf16(al, whi, acc1, 0, 0, 0); acc1 = __builtin_amdgcn_mfma_f32_32x32x16_bf16(ah, wlo, acc1, 0, 0, 0); }
                }
            }
#pragma unroll
            for (int i = 0; i < 16; ++i) { const int row = 8 * (i >> 2) + 4 * hf + (i & 3); part[(w * 64 + row) * 32 + ql] = acc0[i]; part[(w * 64 + 32 + row) * 32 + ql] = acc1[i]; }
        }
        __syncthreads();
        {
            const int e = lane & 31, hf = lane >> 5;
            LAS unsigned* lcnt = (LAS unsigned*)(X.lds + 1024 + 65536);
            int ev[4], lp[4]; float wv[4];
#pragma unroll
            for (int k = 0; k < 4; ++k) {
                const int tl = 8 * w + 4 * hf + k;
                float v = 0.f;
#pragma unroll
                for (int ww = 0; ww < 8; ++ww) v += part[(ww * 64 + tl) * 32 + e];
                if (MODE == 0) route_select(v + p.in[25][l * NE + e], lane, lcnt, ev[k], wv[k], lp[k]);
                else ((float*)(X.ws + WS_DT))[(size_t)(tb0 + tl) * 32 + e] = v;
            }
            if (MODE == 0) {
                __syncthreads();
                if (X.tid < 32) { const unsigned n = lcnt[X.tid]; unsigned* cnt = (unsigned*)(X.ws + WS_CTL) + CW_CNT + (l * 32 + X.tid) * 32;
                    lcnt[32 + X.tid] = n ? atomicAdd(cnt, n) : 0u; }
                __syncthreads();
                if (e < 4) {
#pragma unroll
                    for (int k = 0; k < 4; ++k) { const int t = tb0 + 8 * w + 4 * hf + k, pos = (int)lcnt[32 + ev[k]] + lp[k];
                        ((int*)(X.ws + WS_TOKE))[t * 4 + e] = ev[k]; ((float*)(X.ws + WS_TOKW))[t * 4 + e] = wv[k]; ((int*)(X.ws + WS_TOKP))[t * 4 + e] = pos;
                        ((int*)(X.ws + WS_SLOT))[ev[k] * CAP + pos] = t; }
                }
            }
        }
        __syncthreads();
        if (MODE == 0 && X.tid < 32) ((LAS unsigned*)(X.lds + 1024 + 65536))[X.tid] = 0u;
    }
}

__device__ __forceinline__ void ld64bf(const bf16_t* p, float (&q)[64]) {
#pragma unroll
    for (int i = 0; i < 8; ++i) { const u32x4 w = ((const u32x4*)p)[i];
        q[8 * i] = bflo(w.x); q[8 * i + 1] = bfhi(w.x); q[8 * i + 2] = bflo(w.y); q[8 * i + 3] = bfhi(w.y); q[8 * i + 4] = bflo(w.z); q[8 * i + 5] = bfhi(w.z); q[8 * i + 6] = bflo(w.w); q[8 * i + 7] = bfhi(w.w); }
}
__device__ __forceinline__ float dot64bf(const bf16_t* p, const float (&q)[64]) {
    float d = 0.f;
#pragma unroll
    for (int i = 0; i < 8; ++i) { const u32x4 w = ((const u32x4*)p)[i];
        d += q[8 * i] * bflo(w.x) + q[8 * i + 1] * bfhi(w.x) + q[8 * i + 2] * bflo(w.y) + q[8 * i + 3] * bfhi(w.y) + q[8 * i + 4] * bflo(w.z) + q[8 * i + 5] * bfhi(w.z) + q[8 * i + 6] * bflo(w.w) + q[8 * i + 7] * bfhi(w.w); }
    return d;
}
__device__ __forceinline__ float dot64f(const float* p, const float (&q)[64]) {
    float d = 0.f;
#pragma unroll
    for (int i = 0; i < 16; ++i) { const f32x4 w = ((const f32x4*)p)[i]; d += (q[4 * i] * w.x + q[4 * i + 1] * w.y) + (q[4 * i + 2] * w.z + q[4 * i + 3] * w.w); }
    return d;
}
__device__ __forceinline__ void sb_unit(const Ctx& X, int qt, int bh) {
    const int b = bh >> 3, hh = bh & 7, t = qt * 64 + X.lane;
    const bf16_t* base = (const bf16_t*)(X.ws + WS_BIG) + (size_t)b * S * PROJ_LD;
    float q[64], acc[64];
    ld64bf(base + (size_t)t * PROJ_LD + OFF_SBQ + hh * 64, q);
#pragma unroll
    for (int d = 0; d < 64; ++d) acc[d] = 0.f;
    float run = 0.f;
    for (int j = qt * 64 + 62; j >= 0; --j) {
        const bf16_t* kr = base + (size_t)j * PROJ_LD + OFF_SBK + hh * 64;
        const float logit = dot64bf(kr, q) * 0.125f;
        if (j < t) {
            const float w = expf(logsig(logit) + run);
            run += logsig(-logit);
            const bf16_t* vr = base + (size_t)j * PROJ_LD + OFF_SBV + hh * 64;
#pragma unroll
            for (int i = 0; i < 8; ++i) { const u32x4 v = ((const u32x4*)vr)[i];
                acc[8 * i] += w * bflo(v.x); acc[8 * i + 1] += w * bfhi(v.x); acc[8 * i + 2] += w * bflo(v.y); acc[8 * i + 3] += w * bfhi(v.y);
                acc[8 * i + 4] += w * bflo(v.z); acc[8 * i + 5] += w * bfhi(v.z); acc[8 * i + 6] += w * bflo(v.w); acc[8 * i + 7] += w * bfhi(v.w); }
        }
    }
    bf16_t* op = (bf16_t*)(X.ws + WS_O) + (size_t)(b * S + t) * D + hh * 64;
#pragma unroll
    for (int i = 0; i < 8; ++i) { u32x4 w; w.x = pk2(acc[8 * i], acc[8 * i + 1]); w.y = pk2(acc[8 * i + 2], acc[8 * i + 3]); w.z = pk2(acc[8 * i + 4], acc[8 * i + 5]); w.w = pk2(acc[8 * i + 6], acc[8 * i + 7]);
        ((u32x4*)op)[i] = w; }
}

#define DMA16(gptr, ldsptr) __builtin_amdgcn_global_load_lds((const unsigned*)(gptr), (LAS unsigned*)(ldsptr), 16, 0, 0)
#define RING2_WAIT_BAR(q, nb) do { const int issued_ = (q) + 6 < (nb) ? (q) + 6 : (nb); const int need_ = (q) + 2 < (nb) ? (q) + 2 : (nb); const int fl_ = issued_ - need_; \
        if (fl_ >= 4) asm volatile("s_waitcnt vmcnt(8)\n\ts_barrier" ::: "memory"); else if (fl_ == 3) asm volatile("s_waitcnt vmcnt(6)\n\ts_barrier" ::: "memory"); \
        else if (fl_ == 2) asm volatile("s_waitcnt vmcnt(4)\n\ts_barrier" ::: "memory"); else if (fl_ == 1) asm volatile("s_waitcnt vmcnt(2)\n\ts_barrier" ::: "memory"); \
        else asm volatile("s_waitcnt vmcnt(0)\n\ts_barrier" ::: "memory"); } while (0)
__device__ __forceinline__ int pi32(int r) { return (r & 0x13) | ((r & 4) << 1) | ((r & 8) >> 1); }
__device__ __forceinline__ void sb_attn_unit(const Ctx& X, int bh, int qb) {
    const int b = bh >> 3, h = bh & 7, q0 = qb * 256, lane = fresh(X.lane), w = X.wave, ql = lane & 31, hf = lane >> 5;
    const bf16_t* proj = (const bf16_t*)(X.ws + WS_BIG) + (size_t)b * S * PROJ_LD;
    const bf16_t* vt = (const bf16_t*)(X.ws + WS_VT) + (size_t)(h * 64) * T + (size_t)b * S;
    const int tq = q0 + 32 * w + ql;
    bf16x8 qf[4];
#pragma unroll
    for (int s = 0; s < 4; ++s) qf[s] = *(const bf16x8*)(proj + (size_t)tq * PROJ_LD + OFF_SBQ + h * 64 + 16 * s + 8 * hf);
    f32x16 o0, o1;
#pragma unroll
    for (int i = 0; i < 16; ++i) { o0[i] = 0.f; o1[i] = 0.f; }
    float run = 1.f;
    const int nblk = 4 * qb + 4, jw = (q0 + 32 * w + 30) >> 6;
    const float CS = 0.125f * 1.4426950408889634f;
    const bf16_t* kg = proj + (size_t)lane * PROJ_LD + OFF_SBK + h * 64 + 8 * w;
    const bf16_t* vg = vt + (size_t)lane * T + 8 * w;
    LAS unsigned char* ring = X.lds + w * 1024;
    const int krow = pi32(ql) * 16;
    asm volatile("s_waitcnt vmcnt(0)" ::: "memory");
#pragma unroll
    for (int d = 0; d < 6; ++d) if (d < nblk) { DMA16(kg + (size_t)(64 * (nblk - 1 - d)) * PROJ_LD, ring + d * 16384); DMA16(vg + 64 * (nblk - 1 - d), ring + d * 16384 + 8192); }
    for (int q = 0; q < nblk; ++q) {
        const int j = nblk - 1 - q;
        if ((q & 1) == 0) {
            SUB_BEGIN(X, 11);
            RING2_WAIT_BAR(q, nblk);
            SUB_END(X, 11);
#pragma unroll
            for (int d = 6; d < 8; ++d) if (q + d < nblk) { const int jj = nblk - 1 - (q + d), sl = (q + d) & 7; DMA16(kg + (size_t)(64 * jj) * PROJ_LD, ring + sl * 16384); DMA16(vg + 64 * jj, ring + sl * 16384 + 8192); }
        }
        LAS unsigned char* buf = X.lds + (q & 7) * 16384;
        SUB_BEGIN(X, 12);
        if (j <= jw) {
            const bool diag = 64 * j + 63 >= q0 + 32 * w;
#pragma unroll
            for (int kt = 1; kt >= 0; --kt) {
                f32x16 sc;
#pragma unroll
                for (int i = 0; i < 16; ++i) sc[i] = 0.f;
#pragma unroll
                for (int s = 0; s < 4; ++s) { const bf16x8 kf = *(const LAS bf16x8*)(buf + (2 * s + hf) * 1024 + kt * 512 + krow); sc = __builtin_amdgcn_mfma_f32_32x32x16_bf16(kf, qf[s], sc, 0, 0, 0); }
                f32x16 ee = sc * (-CS), be, kp;
#pragma unroll
                for (int i = 0; i < 16; ++i) ee[i] = __builtin_amdgcn_exp2f(ee[i]);
                be = ee + 1.f;
#pragma unroll
                for (int i = 0; i < 16; ++i) be[i] = __builtin_amdgcn_rcpf(be[i]);
                kp = ee * be;
                if (diag) {
                    asm volatile("; diagonal block: masks" ::: "memory");
                    const int pos0 = 64 * j + 32 * kt + 8 * hf;
#pragma unroll
                    for (int i = 0; i < 16; ++i) { const bool valid = (pos0 + 16 * (i >> 3) + (i & 7)) < tq; be[i] = valid ? be[i] : 0.f; kp[i] = valid ? kp[i] : 1.f; }
                }
                float l1 = 1.f, l0 = 1.f;
#pragma unroll
                for (int i = 15; i >= 8; --i) { const float t = be[i] * l1; l1 *= kp[i]; be[i] = t; }
#pragma unroll
                for (int i = 7; i >= 0; --i) { const float t = be[i] * l0; l0 *= kp[i]; be[i] = t; }
                const float p1 = __shfl_xor(l1, 32), p0 = __shfl_xor(l0, 32);
                const float hi1 = hf ? l1 : p1, lo1 = hf ? p1 : l1, hi0 = hf ? l0 : p0, lo0 = hf ? p0 : l0;
                const float r1 = run * hi1, r2 = r1 * lo1, r3 = r2 * hi0;
                const float pre_up = hf ? run : r1, pre_lo = hf ? r2 : r3;
                run = r3 * lo0;
#pragma unroll
                for (int a = 0; a < 2; ++a) {
                    const float pre = a ? pre_up : pre_lo;
                    u32x4 pw; pw.x = pk2(be[8 * a] * pre, be[8 * a + 1] * pre); pw.y = pk2(be[8 * a + 2] * pre, be[8 * a + 3] * pre); pw.z = pk2(be[8 * a + 4] * pre, be[8 * a + 5] * pre); pw.w = pk2(be[8 * a + 6] * pre, be[8 * a + 7] * pre);
                    const bf16x8 pf = __builtin_bit_cast(bf16x8, pw);
                    const bf16x8 v0 = *(const LAS bf16x8*)(buf + 8192 + (4 * kt + 2 * a + hf) * 1024 + ql * 16);
                    const bf16x8 v1 = *(const LAS bf16x8*)(buf + 8192 + (4 * kt + 2 * a + hf) * 1024 + 512 + ql * 16);
                    o0 = __builtin_amdgcn_mfma_f32_32x32x16_bf16(v0, pf, o0, 0, 0, 0);
                    o1 = __builtin_amdgcn_mfma_f32_32x32x16_bf16(v1, pf, o1, 0, 0, 0);
                }
            }
        }
        SUB_END(X, 12);
    }
    asm volatile("s_barrier" ::: "memory");
    bf16_t* op = (bf16_t*)(X.ws + WS_O) + (size_t)(b * S + fresh(tq)) * D + h * 64 + 4 * hf;
#pragma unroll
    for (int g4 = 0; g4 < 4; ++g4) {
        u32x2 w0; w0.x = pk2(o0[4 * g4], o0[4 * g4 + 1]); w0.y = pk2(o0[4 * g4 + 2], o0[4 * g4 + 3]); *(u32x2*)(op + 8 * g4) = w0;
        u32x2 w1; w1.x = pk2(o1[4 * g4], o1[4 * g4 + 1]); w1.y = pk2(o1[4 * g4 + 2], o1[4 * g4 + 3]); *(u32x2*)(op + 32 + 8 * g4) = w1;
    }
}
__device__ __forceinline__ void ph_sb(const Ctx& X) {
    for (int pr = X.bid; pr < 256; pr += X.G)
#pragma unroll 1
        for (int u = 0; u < 2; ++u) { const int bh = pr >> 3, qa = pr & 7; sb_attn_unit(X, bh, u ? qa : 15 - qa); }
}
__device__ __forceinline__ void ph_attn_a(const Params& p, const Ctx& X) {
    const bf16_t* proj = (const bf16_t*)(X.ws + WS_BIG);
    for (int unit = X.bid; unit < 128; unit += X.G) {
        const int kv = unit >> 6, bg = (unit >> 3) & 7, ntile = unit & 7, b = bg >> 1, g = bg & 1, lane = fresh(X.lane), w = X.wave, ql = lane & 31, hf = lane >> 5;
        const int n = min(32 * ntile + ql, NCMP - 1);
        const float* pe = kv ? p.in[11] : p.in[10];
        const bf16_t* w1t = (const bf16_t*)(X.ws + WS_W1T) + (size_t)kv * 128 * 2048;
        const bf16_t* arow = proj + (size_t)(b * S + n * 16) * PROJ_LD + (kv ? OFF_VC : OFF_KC) + g * 64;
        f32x16 acc[4];
#pragma unroll
        for (int ct = 0; ct < 4; ++ct)
#pragma unroll
            for (int i = 0; i < 16; ++i) acc[ct][i] = 0.f;
        for (int ks = 0; ks < 16; ++ks) {
            const int k0 = 256 * w + 16 * ks + 8 * hf, l = k0 >> 6, d = k0 & 63;
            const u32x4 q = *(const u32x4*)(arow + (size_t)l * PROJ_LD + d);
            const f32x4 e0 = *(const f32x4*)(pe + k0), e1 = *(const f32x4*)(pe + k0 + 4);
            u32x4 o; o.x = pk2(bflo(q.x) + e0.x, bfhi(q.x) + e0.y); o.y = pk2(bflo(q.y) + e0.z, bfhi(q.y) + e0.w); o.z = pk2(bflo(q.z) + e1.x, bfhi(q.z) + e1.y); o.w = pk2(bflo(q.w) + e1.z, bfhi(q.w) + e1.w);
            const bf16x8 af = __builtin_bit_cast(bf16x8, o);
#pragma unroll
            for (int ct = 0; ct < 4; ++ct) acc[ct] = __builtin_amdgcn_mfma_f32_32x32x16_bf16(af, *(const bf16x8*)(w1t + (size_t)(32 * ct + ql) * 2048 + k0), acc[ct], 0, 0, 0);
        }
        LAS float* part = (LAS float*)X.lds;
#pragma unroll
        for (int ct = 0; ct < 4; ++ct)
#pragma unroll
            for (int i = 0; i < 16; ++i) part[w * 4096 + (8 * (i >> 2) + 4 * hf + (i & 3)) * 128 + 32 * ct + ql] = acc[ct][i];
        __syncthreads();
        LAS float* hid = part;
        {
            const int tidf = fresh(X.tid);
#pragma unroll
            for (int k = 0; k < 8; ++k) { const int e = tidf + NTHREADS * k; float v = 0.f;
#pragma unroll
                for (int ww = 0; ww < 8; ++ww) v += part[ww * 4096 + e];
                hid[e] = siluf(v); }
        }
        __syncthreads();
        {
            const int tidf = fresh(X.tid), row = tidf >> 4, c4 = (tidf & 15) * 4;
            const float* w2 = kv ? p.in[15] : p.in[13];
            f32x4 o = (f32x4){0.f, 0.f, 0.f, 0.f};
            for (int j = 0; j < 128; ++j) o = o + *(const f32x4*)(w2 + j * 64 + c4) * hid[row * 128 + j];
            const int nn = 32 * ntile + row;
            if (kv == 0) {
                float ssq = (o.x * o.x + o.y * o.y) + (o.z * o.z + o.w * o.w);
                ssq += __shfl_xor(ssq, 1); ssq += __shfl_xor(ssq, 2); ssq += __shfl_xor(ssq, 4); ssq += __shfl_xor(ssq, 8);
                const float r = rsqrtf(ssq * (1.f / 64.f) + EPS); const f32x4 gn = *(const f32x4*)(p.in[9] + c4);
                o = o * r * gn;
                if (nn >= NCMP) o = (f32x4){0.f, 0.f, 0.f, 0.f};
                u32x2 wv; wv.x = pk2(o.x, o.y); wv.y = pk2(o.z, o.w);
                *(u32x2*)((bf16_t*)(X.ws + WS_KCB) + ((size_t)bg * 256 + nn) * 64 + c4) = wv;
            } else {
                if (nn >= NCMP) o = (f32x4){0.f, 0.f, 0.f, 0.f};
                bf16_t* vt = (bf16_t*)(X.ws + WS_VCT) + ((size_t)bg * 64 + c4) * 256 + nn;
                vt[0] = (bf16_t)f2bf(o.x); vt[256] = (bf16_t)f2bf(o.y); vt[512] = (bf16_t)f2bf(o.z); vt[768] = (bf16_t)f2bf(o.w);
            }
        }
        __syncthreads();
    }
    for (int t2 = X.gw; t2 < T / 2; t2 += X.ngw) {
        const int lane = fresh(X.lane), sub = lane & 7;
#pragma unroll
        for (int k = 0; k < 2; ++k) {
            const int t = 2 * t2 + k;
            const u32x4 q = *(const u32x4*)(proj + (size_t)t * PROJ_LD + OFF_NQ + 8 * lane);
            float v[8] = {bflo(q.x), bfhi(q.x), bflo(q.y), bfhi(q.y), bflo(q.z), bfhi(q.z), bflo(q.w), bfhi(q.w)};
            float ssq = 0.f;
#pragma unroll
            for (int i = 0; i < 8; ++i) ssq += v[i] * v[i];
            ssq += __shfl_xor(ssq, 1); ssq += __shfl_xor(ssq, 2); ssq += __shfl_xor(ssq, 4);
            const float r = rsqrtf(ssq * (1.f / 64.f) + EPS) * (0.125f * 1.4426950408889634f);
            const f32x4 g0 = *(const f32x4*)(p.in[8] + 8 * sub), g1 = *(const f32x4*)(p.in[8] + 8 * sub + 4);
            u32x4 o; o.x = pk2(v[0] * r * g0.x, v[1] * r * g0.y); o.y = pk2(v[2] * r * g0.z, v[3] * r * g0.w); o.z = pk2(v[4] * r * g1.x, v[5] * r * g1.y); o.w = pk2(v[6] * r * g1.z, v[7] * r * g1.w);
            *(u32x4*)((bf16_t*)(X.ws + WS_QNB) + (size_t)t * 512 + 8 * lane) = o;
        }
        {
            const int t = 2 * t2 + (lane >> 5), l32 = lane & 31, isw = l32 >> 4, c = 8 * (l32 & 15);
            const u32x4 q = *(const u32x4*)(proj + (size_t)t * PROJ_LD + (isw ? OFF_KW : OFF_KS) + c);
            float v[8] = {bflo(q.x), bfhi(q.x), bflo(q.y), bfhi(q.y), bflo(q.z), bfhi(q.z), bflo(q.w), bfhi(q.w)};
            float ssq = 0.f;
#pragma unroll
            for (int i = 0; i < 8; ++i) ssq += v[i] * v[i];
            ssq += __shfl_xor(ssq, 1); ssq += __shfl_xor(ssq, 2); ssq += __shfl_xor(ssq, 4);
            const float r = rsqrtf(ssq * (1.f / 64.f) + EPS);
            const float* gn = p.in[9] + (isw ? 128 : 64) + 8 * sub;
            const f32x4 g0 = *(const f32x4*)gn, g1 = *(const f32x4*)(gn + 4);
            u32x4 o; o.x = pk2(v[0] * r * g0.x, v[1] * r * g0.y); o.y = pk2(v[2] * r * g0.z, v[3] * r * g0.w); o.z = pk2(v[4] * r * g1.x, v[5] * r * g1.y); o.w = pk2(v[6] * r * g1.z, v[7] * r * g1.w);
            *(u32x4*)((bf16_t*)(X.ws + (isw ? WS_KWN : WS_KSN)) + (size_t)t * 128 + c) = o;
        }
    }
}
struct NsaSt { f32x16 o0, o1; float m, l; };
template <int MODE>
__device__ __forceinline__ void nsa_flash(const Ctx& X, const bf16_t* kg, const bf16_t* vg, int jlo, int jhi, const bf16x8 (&qf)[4], int tq, float slope2,
                                          unsigned long long mymask, unsigned long long wavemask, NsaSt& st) {
    const int lane = fresh(X.lane), w = X.wave, ql = lane & 31, hf = lane >> 5;
    LAS unsigned char* ring = X.lds + w * 1024;
    const int krow = pi32(ql) * 16, nb = jhi - jlo + 1;
    asm volatile("s_waitcnt vmcnt(0)" ::: "memory");
#pragma unroll
    for (int d = 0; d < 6; ++d) if (d < nb) { DMA16(kg + (size_t)(64 * (jhi - d)) * 128, ring + d * 16384); DMA16(vg + 64 * (jhi - d), ring + d * 16384 + 8192); }
    f32x16 sl;
#pragma unroll
    for (int i = 0; i < 16; ++i) sl[i] = slope2 * (float)(16 * (i >> 3) + (i & 7));
    const float k32 = slope2 * 32.f;
    for (int q = 0; q < nb; ++q) {
        const int j = jhi - q;
        if ((q & 1) == 0) {
            SUB_BEGIN(X, 21);
            RING2_WAIT_BAR(q, nb);
            SUB_END(X, 21);
#pragma unroll
            for (int d = 6; d < 8; ++d) if (q + d < nb) { const int jj = jhi - (q + d), sl2 = (q + d) & 7; DMA16(kg + (size_t)(64 * jj) * 128, ring + sl2 * 16384); DMA16(vg + 64 * jj, ring + sl2 * 16384 + 8192); }
        }
        LAS unsigned char* buf = X.lds + (q & 7) * 16384;
        SUB_BEGIN(X, 22);
        if (MODE == 1 || ((wavemask >> j) & 1ull)) {
            f32x16 s0, s1;
#pragma unroll
            for (int i = 0; i < 16; ++i) { s0[i] = 0.f; s1[i] = 0.f; }
#pragma unroll
            for (int s = 0; s < 4; ++s) {
                const bf16x8 k0 = *(const LAS bf16x8*)(buf + (2 * s + hf) * 1024 + krow), k1 = *(const LAS bf16x8*)(buf + (2 * s + hf) * 1024 + 512 + krow);
                s0 = __builtin_amdgcn_mfma_f32_32x32x16_bf16(k0, qf[s], s0, 0, 0, 0); s1 = __builtin_amdgcn_mfma_f32_32x32x16_bf16(k1, qf[s], s1, 0, 0, 0);
            }
            const int d0 = tq - (64 * j + 8 * hf);
            if (j == jhi || (MODE == 1 && j == jlo)) {
                asm volatile("; boundary block: masks" ::: "memory");
#pragma unroll
                for (int i = 0; i < 16; ++i) {
                    const int da = d0 - (16 * (i >> 3) + (i & 7)), db = da - 32;
                    s0[i] = (da >= 0 && (MODE == 0 || da < 512)) ? s0[i] : -INFINITY; s1[i] = (db >= 0 && (MODE == 0 || db < 512)) ? s1[i] : -INFINITY;
                }
            }
            s0 = s0 + sl; s1 = s1 + sl;
            float mb0 = fmaxf(s0[0], s0[1]), mb1 = fmaxf(s1[0], s1[1]);
#pragma unroll
            for (int i = 2; i < 16; ++i) { mb0 = fmaxf(mb0, s0[i]); mb1 = fmaxf(mb1, s1[i]); }
            const float base = slope2 * (float)d0;
            const bool sel = MODE == 1 || ((mymask >> j) & 1ull);
            float mb = fmaxf(mb0, mb1 + k32) - base;
            mb = sel ? mb : -INFINITY;
            mb = fmaxf(mb, __shfl_xor(mb, 32));
            const float mn = fmaxf(st.m, mb), ms = mn == -INFINITY ? 0.f : mn;
            if (__any(mn > st.m)) {
                const float alpha = __builtin_amdgcn_exp2f(st.m - ms);
                st.l *= alpha;
#pragma unroll
                for (int i = 0; i < 16; ++i) { st.o0[i] *= alpha; st.o1[i] *= alpha; }
                st.m = mn;
            }
            const float off0 = sel ? ms + base : INFINITY, off1 = off0 - k32;
            s0 = s0 - off0; s1 = s1 - off1;
            float ls = 0.f;
#pragma unroll
            for (int i = 0; i < 16; ++i) { s0[i] = __builtin_amdgcn_exp2f(s0[i]); s1[i] = __builtin_amdgcn_exp2f(s1[i]); ls += s0[i] + s1[i]; }
            st.l += ls;
#pragma unroll
            for (int kt = 0; kt < 2; ++kt)
#pragma unroll
                for (int a = 0; a < 2; ++a) {
                    u32x4 pw;
                    if (kt == 0) { pw.x = pk2(s0[8 * a], s0[8 * a + 1]); pw.y = pk2(s0[8 * a + 2], s0[8 * a + 3]); pw.z = pk2(s0[8 * a + 4], s0[8 * a + 5]); pw.w = pk2(s0[8 * a + 6], s0[8 * a + 7]); }
                    else { pw.x = pk2(s1[8 * a], s1[8 * a + 1]); pw.y = pk2(s1[8 * a + 2], s1[8 * a + 3]); pw.z = pk2(s1[8 * a + 4], s1[8 * a + 5]); pw.w = pk2(s1[8 * a + 6], s1[8 * a + 7]); }
                    const bf16x8 pf = __builtin_bit_cast(bf16x8, pw);
                    const bf16x8 v0 = *(const LAS bf16x8*)(buf + 8192 + (4 * kt + 2 * a + hf) * 1024 + ql * 16);
                    const bf16x8 v1 = *(const LAS bf16x8*)(buf + 8192 + (4 * kt + 2 * a + hf) * 1024 + 512 + ql * 16);
                    st.o0 = __builtin_amdgcn_mfma_f32_32x32x16_bf16(v0, pf, st.o0, 0, 0, 0);
                    st.o1 = __builtin_amdgcn_mfma_f32_32x32x16_bf16(v1, pf, st.o1, 0, 0, 0);
                }
        }
        SUB_END(X, 22);
    }
    asm volatile("s_barrier" ::: "memory");
}
__device__ __forceinline__ void nsa_unit(const Ctx& X, int bg, int qb) {
    const int b = bg >> 1, g = bg & 1, lane = fresh(X.lane), w = X.wave, ql = lane & 31, hf = lane >> 5, r = ql >> 3, hh = g * 4 + r;
    const int t0 = 64 * qb, tq = t0 + 8 * w + (ql & 7);
    const float slope2 = exp2f(-(float)(hh + 1)) * 1.4426950408889634f;
    const bf16_t* proj = (const bf16_t*)(X.ws + WS_BIG);
    bf16x8 qf[4];
    { const bf16_t* qp = (const bf16_t*)(X.ws + WS_QNB) + (size_t)(b * S + tq) * 512 + hh * 64 + 8 * hf;
#pragma unroll
      for (int s = 0; s < 4; ++s) qf[s] = *(const bf16x8*)(qp + 16 * s); }
    float gate[3];
    { const bf16_t* gp = proj + (size_t)(b * S + tq) * PROJ_LD + OFF_GATE + hh * 3;
#pragma unroll
      for (int i = 0; i < 3; ++i) gate[i] = 1.f / (1.f + __expf(-bf2f(gp[i]))); }
    f32x16 of0, of1;
#pragma unroll
    for (int i = 0; i < 16; ++i) { of0[i] = 0.f; of1[i] = 0.f; }
    NsaSt st;
    SUB_BEGIN(X, 23);
    LAS float* pacc = (LAS float*)(X.lds + 65536) + w * 2048;
    {
        const int ncm = t0 + 63 >= 31 ? (t0 + 63 - 31) / 16 + 1 : 0, nt = (ncm + 31) >> 5, ncv = tq >= 31 ? (tq - 31) / 16 + 1 : 0;
        {
            const bf16_t* kc = (const bf16_t*)(X.ws + WS_KCB) + (size_t)bg * 256 * 64; const bf16_t* vc = (const bf16_t*)(X.ws + WS_VCT) + (size_t)bg * 64 * 256;
            const int tidf = fresh(X.tid);
#pragma unroll
            for (int i = 0; i < 4; ++i) { const int pidx = tidf + NTHREADS * i;
                *(LAS u32x4*)(X.lds + (pidx >> 8) * 4096 + (pidx & 255) * 16) = *(const u32x4*)(kc + (size_t)(pidx & 255) * 64 + 8 * (pidx >> 8));
                *(LAS u32x4*)(X.lds + 32768 + (pidx >> 6) * 1024 + (pidx & 63) * 16) = *(const u32x4*)(vc + (size_t)(pidx & 63) * 256 + 8 * (pidx >> 6)); }
#pragma unroll
            for (int i = 0; i < 8; ++i) *(LAS f32x4*)(pacc + (i * 64 + lane) * 4) = (f32x4){0.f, 0.f, 0.f, 0.f};
        }
        __syncthreads();
        const int krow = pi32(ql) * 16;
        float ml = -INFINITY, ll = 0.f;
        for (int kt = 0; kt < nt; ++kt) {
            f32x16 sc;
#pragma unroll
            for (int i = 0; i < 16; ++i) sc[i] = 0.f;
#pragma unroll
            for (int s = 0; s < 4; ++s) { const bf16x8 kf = *(const LAS bf16x8*)(X.lds + (2 * s + hf) * 4096 + kt * 512 + krow); sc = __builtin_amdgcn_mfma_f32_32x32x16_bf16(kf, qf[s], sc, 0, 0, 0); }
            float tm = -INFINITY;
#pragma unroll
            for (int i = 0; i < 16; ++i) { const int n = 32 * kt + 16 * (i >> 3) + 8 * hf + (i & 7);
                sc[i] = n < ncv ? sc[i] - slope2 * (float)(tq - (16 * n + 31)) : -INFINITY; tm = fmaxf(tm, sc[i]); }
            const float mn = fmaxf(ml, tm), ms = mn == -INFINITY ? 0.f : mn;
            float ls = 0.f;
#pragma unroll
            for (int i = 0; i < 16; ++i) ls += __builtin_amdgcn_exp2f(sc[i] - ms);
            ll = ll * __builtin_amdgcn_exp2f(ml - ms) + ls; ml = mn;
        }
        float ms, inv;
        { const float mo = __shfl_xor(ml, 32), lo = __shfl_xor(ll, 32), mt = fmaxf(ml, mo); ms = mt == -INFINITY ? 0.f : mt;
          const float lt = ll * __builtin_amdgcn_exp2f(ml - ms) + lo * __builtin_amdgcn_exp2f(mo - ms); inv = lt > 0.f ? 1.f / lt : 0.f; }
#pragma unroll
        for (int i = 0; i < 16; ++i) { st.o0[i] = 0.f; st.o1[i] = 0.f; }
        float carry = 0.f;
        for (int kt = 0; kt < nt; ++kt) {
            f32x16 sc;
#pragma unroll
            for (int i = 0; i < 16; ++i) sc[i] = 0.f;
#pragma unroll
            for (int s = 0; s < 4; ++s) { const bf16x8 kf = *(const LAS bf16x8*)(X.lds + (2 * s + hf) * 4096 + kt * 512 + krow); sc = __builtin_amdgcn_mfma_f32_32x32x16_bf16(kf, qf[s], sc, 0, 0, 0); }
#pragma unroll
            for (int i = 0; i < 16; ++i) { const int n = 32 * kt + 16 * (i >> 3) + 8 * hf + (i & 7);
                sc[i] = n < ncv ? __builtin_amdgcn_exp2f(sc[i] - slope2 * (float)(tq - (16 * n + 31)) - ms) * inv : 0.f; }
            const float pa0 = __shfl_xor(sc[7], 32), pa1 = __shfl_xor(sc[15], 32);
            const float prev0 = hf ? pa0 : carry, prev1 = hf ? pa1 : pa0;
            carry = pa1;
            {
                typedef float f32x2 __attribute__((ext_vector_type(2)));
                f32x2 e0, e1;
                e0.x = prev0 + ((sc[0] + sc[1]) + (sc[2] + sc[3])); e0.y = sc[3] + ((sc[4] + sc[5]) + (sc[6] + sc[7]));
                e1.x = prev1 + ((sc[8] + sc[9]) + (sc[10] + sc[11])); e1.y = sc[11] + ((sc[12] + sc[13]) + (sc[14] + sc[15]));
                *(LAS f32x2*)(pacc + ql * 64 + 8 * kt + 2 * hf) = e0; *(LAS f32x2*)(pacc + ql * 64 + 8 * kt + 4 + 2 * hf) = e1;
            }
#pragma unroll
            for (int a = 0; a < 2; ++a) {
                u32x4 pw; pw.x = pk2(sc[8 * a], sc[8 * a + 1]); pw.y = pk2(sc[8 * a + 2], sc[8 * a + 3]); pw.z = pk2(sc[8 * a + 4], sc[8 * a + 5]); pw.w = pk2(sc[8 * a + 6], sc[8 * a + 7]);
                const bf16x8 pf = __builtin_bit_cast(bf16x8, pw);
                const bf16x8 v0 = *(const LAS bf16x8*)(X.lds + 32768 + (4 * kt + 2 * a + hf) * 1024 + ql * 16);
                const bf16x8 v1 = *(const LAS bf16x8*)(X.lds + 32768 + (4 * kt + 2 * a + hf) * 1024 + 512 + ql * 16);
                st.o0 = __builtin_amdgcn_mfma_f32_32x32x16_bf16(v0, pf, st.o0, 0, 0, 0);
                st.o1 = __builtin_amdgcn_mfma_f32_32x32x16_bf16(v1, pf, st.o1, 0, 0, 0);
            }
        }
#pragma unroll
        for (int i = 0; i < 16; ++i) { of0[i] = gate[0] * st.o0[i]; of1[i] = gate[0] * st.o1[i]; }
    }
    SUB_END(X, 23);
    SUB_BEGIN(X, 24);
    unsigned long long mymask = 0ull, wavemask = 0ull;
    LDS_WAIT();
    for (int q8 = 0; q8 < 8; ++q8) {
        const int t = t0 + 8 * w + q8;
        const float ps = (pacc[(0 * 8 + q8) * 64 + lane] + pacc[(1 * 8 + q8) * 64 + lane]) + (pacc[(2 * 8 + q8) * 64 + lane] + pacc[(3 * 8 + q8) * 64 + lane]);
        const bool valid = lane * 64 <= t, forced = (lane == 0) || (lane == qb) || (lane == qb - 1);
        const unsigned key = valid ? ((forced ? 0x7f000000u : (__float_as_uint(fmaxf(ps, 0.f)) & ~63u)) | (unsigned)(63 - lane)) : 0u;
        unsigned thr = 0u;
#pragma unroll 1
        for (int bit = 30; bit >= 0; --bit) { const unsigned cand = thr | (1u << bit); if (__builtin_popcountll(__ballot(key >= cand)) >= 16) thr = cand; }
        const unsigned long long mk = __ballot(key >= thr && key != 0u);
        wavemask |= mk; if ((ql & 7) == q8) mymask = mk;
    }
    SUB_END(X, 24);
    __syncthreads();
    {
#pragma unroll
        for (int i = 0; i < 16; ++i) { st.o0[i] = 0.f; st.o1[i] = 0.f; }
        st.m = -INFINITY; st.l = 0.f;
        const int lf = fresh(lane);
        const bf16_t* kg = (const bf16_t*)(X.ws + WS_KSN) + ((size_t)b * S + lf) * 128 + g * 64 + 8 * w;
        const bf16_t* vg = (const bf16_t*)(X.ws + WS_VT) + (size_t)(512 + g * 64 + lf) * T + (size_t)b * S + 8 * w;
        nsa_flash<0>(X, kg, vg, 0, qb, qf, tq, slope2, mymask, wavemask, st);
        const float lt = st.l + __shfl_xor(st.l, 32), sc = gate[1] / fmaxf(lt, 1e-30f);
#pragma unroll
        for (int i = 0; i < 16; ++i) { of0[i] += sc * st.o0[i]; of1[i] += sc * st.o1[i]; }
    }
    {
#pragma unroll
        for (int i = 0; i < 16; ++i) { st.o0[i] = 0.f; st.o1[i] = 0.f; }
        st.m = -INFINITY; st.l = 0.f;
        const int lf = fresh(lane);
        const bf16_t* kg = (const bf16_t*)(X.ws + WS_KWN) + ((size_t)b * S + lf) * 128 + g * 64 + 8 * w;
        const bf16_t* vg = (const bf16_t*)(X.ws + WS_VT) + (size_t)(640 + g * 64 + lf) * T + (size_t)b * S + 8 * w;
        nsa_flash<1>(X, kg, vg, qb >= 8 ? qb - 8 : 0, qb, qf, tq, slope2, 0ull, 0ull, st);
        const float lt = st.l + __shfl_xor(st.l, 32), sc = gate[2] / fmaxf(lt, 1e-30f);
#pragma unroll
        for (int i = 0; i < 16; ++i) { of0[i] += sc * st.o0[i]; of1[i] += sc * st.o1[i]; }
    }
    bf16_t* op = (bf16_t*)(X.ws + WS_O) + (size_t)(b * S + fresh(tq)) * D + 512 + hh * 64 + 4 * hf;
#pragma unroll
    for (int g4 = 0; g4 < 4; ++g4) {
        u32x2 w0; w0.x = pk2(of0[4 * g4], of0[4 * g4 + 1]); w0.y = pk2(of0[4 * g4 + 2], of0[4 * g4 + 3]); *(u32x2*)(op + 8 * g4) = w0;
        u32x2 w1; w1.x = pk2(of1[4 * g4], of1[4 * g4 + 1]); w1.y = pk2(of1[4 * g4 + 2], of1[4 * g4 + 3]); *(u32x2*)(op + 32 + 8 * g4) = w1;
    }
}
__device__ __forceinline__ void ph_nsa(const Params& p, const Ctx& X) {
    for (int pr = X.bid; pr < 256; pr += X.G)
#pragma unroll 1
        for (int u = 0; u < 2; ++u) { const int bg = pr >> 5, qa = pr & 31; nsa_unit(X, bg, u ? qa : 63 - qa); }
}

__device__ __forceinline__ float silu_fast(float v) { return v * __builtin_amdgcn_rcpf(1.f + __expf(-v)); }
constexpr int S1_WL = RING_BYTES + 4096;
__device__ __forceinline__ void ph_ssd1(const Params& p, const Ctx& X) {
    const float* cw = p.in[17]; const float* cb = p.in[18];
    LAS float* wl = (LAS float*)(X.lds + S1_WL);
    LAS unsigned char* ldsB = X.lds;
    LAS unsigned char* ldsX = X.lds + 65536;
    for (int unit = X.bid; unit < 256; unit += X.G) {
        const int b = unit >> 6, c = (unit >> 2) & 15, g = unit & 3, tl0 = c * 256, lane = fresh(X.lane), w = X.wave, ql = lane & 31, hf = lane >> 5;
        const size_t t0 = (size_t)b * S + tl0;
        {
            const int h = g * 8 + w;
            const float a = -expf(p.in[20][h]), dtb = p.in[19][h];
            const float* dr = (const float*)(X.ws + WS_DT) + (t0 + 4 * lane) * 32 + h;
            float dt[4], cs[4];
#pragma unroll
            for (int k = 0; k < 4; ++k) { const float raw = dr[k * 32] + dtb; dt[k] = raw > 20.f ? raw : log1pf(expf(raw)); }
            cs[0] = dt[0] * a; cs[1] = cs[0] + dt[1] * a; cs[2] = cs[1] + dt[2] * a; cs[3] = cs[2] + dt[3] * a;
            float incl = cs[3];
#pragma unroll
            for (int o = 1; o < 64; o <<= 1) { const float u = __shfl_up(incl, o); if (lane >= o) incl += u; }
            const float excl = incl - cs[3], last = __shfl(incl, 63);
#pragma unroll
            for (int k = 0; k < 4; ++k) cs[k] += excl;
            *(f32x4*)((float*)(X.ws + WS_DT2) + (size_t)(b * 32 + h) * S + tl0 + 4 * lane) = (f32x4){dt[0], dt[1], dt[2], dt[3]};
            *(f32x4*)((float*)(X.ws + WS_CS) + (size_t)(b * 32 + h) * S + tl0 + 4 * lane) = (f32x4){cs[0], cs[1], cs[2], cs[3]};
            *(LAS f32x4*)(wl + w * 256 + 4 * lane) = (f32x4){dt[0] * __expf(last - cs[0]), dt[1] * __expf(last - cs[1]), dt[2] * __expf(last - cs[2]), dt[3] * __expf(last - cs[3])};
            if (lane == 63) ((float*)(X.ws + WS_DEC))[(b * 16 + c) * 32 + h] = __expf(last);
        }
        const bf16_t* xt = (const bf16_t*)(X.ws + WS_XT); bf16_t* xct = (bf16_t*)(X.ws + WS_XCT);
        const int tidf = fresh(X.tid);
#define CONV8(rin, chg, seg, o) do { const bf16_t* src_ = xt + (size_t)(rin) * T + t0 + 8 * (seg); const u32x4 cur_ = *(const u32x4*)src_; u32x4 prv_ = (u32x4){0u, 0u, 0u, 0u}; \
            if (tl0 + 8 * (seg) >= 8) prv_ = *(const u32x4*)(src_ - 8); \
            const float x_[11] = {bfhi(prv_.z), bflo(prv_.w), bfhi(prv_.w), bflo(cur_.x), bfhi(cur_.x), bflo(cur_.y), bfhi(cur_.y), bflo(cur_.z), bfhi(cur_.z), bflo(cur_.w), bfhi(cur_.w)}; \
            const float w0_ = cw[chg], w1_ = cw[CONV_DIM + (chg)], w2_ = cw[2 * CONV_DIM + (chg)], w3_ = cw[3 * CONV_DIM + (chg)], bb_ = cb[chg]; \
            _Pragma("unroll") for (int j_ = 0; j_ < 8; ++j_) o[j_] = silu_fast(bb_ + w0_ * x_[j_] + w1_ * x_[j_ + 1] + w2_ * x_[j_ + 2] + w3_ * x_[j_ + 3]); } while (0)
        {
#pragma unroll
            for (int k = 0; k < 8; ++k) {
                const int it = tidf + NTHREADS * k, n = it >> 5, seg = it & 31, chg = 2048 + g * 128 + n;
                float o[8]; CONV8(g * 128 + n, chg, seg, o);
                u32x4 ov; ov.x = pk2(o[0], o[1]); ov.y = pk2(o[2], o[3]); ov.z = pk2(o[4], o[5]); ov.w = pk2(o[6], o[7]);
                *(u32x4*)(xct + (size_t)chg * T + t0 + 8 * seg) = ov;
                *(LAS u32x4*)(ldsB + seg * 2048 + n * 16) = ov;
            }
            const bf16_t* zbc = (const bf16_t*)(X.ws + WS_ZBC); bf16_t* bcm = (bf16_t*)(X.ws + WS_BCM);
#pragma unroll 4
            for (int k = 0; k < 16; ++k) {
                const int it = tidf + NTHREADS * k, l = it >> 5, c8 = it & 31;
                const int col = (c8 < 16 ? g * 128 + 8 * c8 : 512 + g * 128 + 8 * (c8 - 16));
                float acc[8];
                { const f32x4 b0 = *(const f32x4*)(cb + 2048 + col), b1 = *(const f32x4*)(cb + 2048 + col + 4); acc[0] = b0.x; acc[1] = b0.y; acc[2] = b0.z; acc[3] = b0.w; acc[4] = b1.x; acc[5] = b1.y; acc[6] = b1.z; acc[7] = b1.w; }
#pragma unroll
                for (int ww = 0; ww < 4; ++ww) {
                    if (tl0 + l - 3 + ww < 0) continue;
                    const u32x4 q = *(const u32x4*)(zbc + (t0 + l - 3 + ww) * 3072 + 2048 + col);
                    const f32x4 k0 = *(const f32x4*)(cw + ww * CONV_DIM + 2048 + col), k1 = *(const f32x4*)(cw + ww * CONV_DIM + 2048 + col + 4);
                    acc[0] += bflo(q.x) * k0.x; acc[1] += bfhi(q.x) * k0.y; acc[2] += bflo(q.y) * k0.z; acc[3] += bfhi(q.y) * k0.w;
                    acc[4] += bflo(q.z) * k1.x; acc[5] += bfhi(q.z) * k1.y; acc[6] += bflo(q.w) * k1.z; acc[7] += bfhi(q.w) * k1.w;
                }
                u32x4 ov; ov.x = pk2(silu_fast(acc[0]), silu_fast(acc[1])); ov.y = pk2(silu_fast(acc[2]), silu_fast(acc[3])); ov.z = pk2(silu_fast(acc[4]), silu_fast(acc[5])); ov.w = pk2(silu_fast(acc[6]), silu_fast(acc[7]));
                *(u32x4*)(bcm + (t0 + l) * 1024 + col) = ov;
            }
        }
#pragma unroll 1
        for (int hg = 0; hg < 4; ++hg) {
            __syncthreads();
#pragma unroll
            for (int k = 0; k < 8; ++k) {
                const int it = tidf + NTHREADS * k, chl = it >> 5, seg = it & 31, h8 = 2 * hg + (chl >> 6), chg = g * 512 + h8 * 64 + (chl & 63);
                float o[8]; CONV8(1024 + chg, chg, seg, o);
                u32x4 ov; ov.x = pk2(o[0], o[1]); ov.y = pk2(o[2], o[3]); ov.z = pk2(o[4], o[5]); ov.w = pk2(o[6], o[7]);
                *(u32x4*)(xct + (size_t)chg * T + t0 + 8 * seg) = ov;
                const f32x4 wa = *(const LAS f32x4*)(wl + h8 * 256 + 8 * seg), wb = *(const LAS f32x4*)(wl + h8 * 256 + 8 * seg + 4);
                u32x4 os; os.x = pk2(o[0] * wa.x, o[1] * wa.y); os.y = pk2(o[2] * wa.z, o[3] * wa.w); os.z = pk2(o[4] * wb.x, o[5] * wb.y); os.w = pk2(o[6] * wb.z, o[7] * wb.w);
                *(LAS u32x4*)(ldsX + (chl >> 6) * 32768 + seg * 1024 + (chl & 63) * 16) = os;
            }
            __syncthreads();
            {
                const int hl = w >> 2, pt = (w >> 1) & 1, nt0 = 2 * (w & 1), h = g * 8 + 2 * hg + hl;
                f32x16 acc0, acc1;
#pragma unroll
                for (int i = 0; i < 16; ++i) { acc0[i] = 0.f; acc1[i] = 0.f; }
#pragma unroll 4
                for (int ks = 0; ks < 16; ++ks) {
                    const bf16x8 af = *(const LAS bf16x8*)(ldsX + hl * 32768 + (2 * ks + hf) * 1024 + (32 * pt + ql) * 16);
                    const bf16x8 b0 = *(const LAS bf16x8*)(ldsB + (2 * ks + hf) * 2048 + (32 * nt0 + ql) * 16), b1 = *(const LAS bf16x8*)(ldsB + (2 * ks + hf) * 2048 + (32 * nt0 + 32 + ql) * 16);
                    acc0 = __builtin_amdgcn_mfma_f32_32x32x16_bf16(af, b0, acc0, 0, 0, 0); acc1 = __builtin_amdgcn_mfma_f32_32x32x16_bf16(af, b1, acc1, 0, 0, 0);
                }
                float* st = (float*)(X.ws + WS_ST) + ((size_t)(b * 16 + c) * 32 + h) * 8192 + 32 * nt0 + ql;
#pragma unroll
                for (int i = 0; i < 16; ++i) { const int pr = 32 * pt + 8 * (i >> 2) + 4 * hf + (i & 3); st[pr * 128] = acc0[i]; st[pr * 128 + 32] = acc1[i]; }
            }
        }
#undef CONV8
        __syncthreads();
    }
}
__device__ __forceinline__ void ph_ssd2(const Ctx& X) {
    const float* st = (const float*)(X.ws + WS_ST); const float* dec = (const float*)(X.ws + WS_DEC); bf16_t* pb = (bf16_t*)(X.ws + WS_PB);
    for (int e = X.bid * NTHREADS + X.tid; e < NB * 32 * 2048; e += X.G * NTHREADS) {
        const int b = e >> 16, h = (e >> 11) & 31, q4 = (e & 2047) * 4;
        f32x4 hs = (f32x4){0.f, 0.f, 0.f, 0.f};
        for (int c = 0; c < 16; ++c) {
            const size_t o = ((size_t)(b * 16 + c) * 32 + h) * 8192 + q4;
            u32x2 wv; wv.x = pk2(hs.x, hs.y); wv.y = pk2(hs.z, hs.w); *(u32x2*)(pb + o) = wv;
            hs = hs * dec[(b * 16 + c) * 32 + h] + *(const f32x4*)(st + o);
        }
    }
}
constexpr int S3_STG = 49152;
__device__ __forceinline__ void ph_ssd3(const Params& p, const Ctx& X) {
    LAS float* dtl = (LAS float*)(X.lds + 2 * S3_STG); LAS float* csl = dtl + 2048;
    constexpr int S3_TILE = 2 * S3_STG + 16384;
    static_assert(S3_TILE + 8 * 4096 <= TAB_OFF, "ssd3 LDS map");
    for (int unit = X.bid; unit < 256; unit += X.G) {
        const int b = unit >> 6, c = (unit >> 2) & 15, g = unit & 3, tl0 = c * 256, lane = fresh(X.lane), w = X.wave, ql = lane & 31, hf = lane >> 5, lq = 32 * w + ql;
        const size_t t0 = (size_t)b * S + tl0;
        LAS unsigned char* tile = X.lds + S3_TILE + w * 4096;
        const bf16_t* xg = (const bf16_t*)(X.ws + WS_XCT) + (size_t)(g * 512 + lane) * T + t0;
        const bf16_t* pg = (const bf16_t*)(X.ws + WS_PB) + ((size_t)(b * 16 + c) * 32 + g * 8) * 8192 + (size_t)lane * 128;
#define S3_ISSUE(h8, sbase) do { _Pragma("unroll") for (int cc_ = 0; cc_ < 4; ++cc_) DMA16(xg + (size_t)((h8) * 64) * T + 8 * (4 * w + cc_), X.lds + (sbase) + (4 * w + cc_) * 1024); \
            _Pragma("unroll") for (int cc_ = 0; cc_ < 2; ++cc_) DMA16(pg + (size_t)(h8) * 8192 + 8 * (2 * w + cc_), X.lds + (sbase) + 32768 + (2 * w + cc_) * 1024); } while (0)
        asm volatile("s_waitcnt vmcnt(0)" ::: "memory");
        S3_ISSUE(0, 0);
        { const int tidf = fresh(X.tid), h8 = tidf >> 6, l4 = (tidf & 63) * 4;
          *(LAS f32x4*)(dtl + h8 * 256 + l4) = *(const f32x4*)((const float*)(X.ws + WS_DT2) + (size_t)(b * 32 + g * 8 + h8) * S + tl0 + l4);
          *(LAS f32x4*)(csl + h8 * 256 + l4) = *(const f32x4*)((const float*)(X.ws + WS_CS) + (size_t)(b * 32 + g * 8 + h8) * S + tl0 + l4); }
        const bf16_t* bcm = (const bf16_t*)(X.ws + WS_BCM);
        u32x4 gp[8][2];
        {
        bf16x8 cf[8];
#pragma unroll
        for (int ks = 0; ks < 8; ++ks) cf[ks] = *(const bf16x8*)(bcm + (t0 + lq) * 1024 + 512 + g * 128 + 16 * ks + 8 * hf);
#pragma unroll
        for (int st = 0; st < 8; ++st) {
            if (st <= w) {
                f32x16 G;
#pragma unroll
                for (int i = 0; i < 16; ++i) G[i] = 0.f;
                const bf16_t* bp = bcm + (t0 + 32 * st + pi32(ql)) * 1024 + g * 128 + 8 * hf;
#pragma unroll
                for (int ks = 0; ks < 8; ++ks) G = __builtin_amdgcn_mfma_f32_32x32x16_bf16(*(const bf16x8*)(bp + 16 * ks), cf[ks], G, 0, 0, 0);
#pragma unroll
                for (int a2 = 0; a2 < 2; ++a2) { gp[st][a2].x = pk2(G[8 * a2], G[8 * a2 + 1]); gp[st][a2].y = pk2(G[8 * a2 + 2], G[8 * a2 + 3]); gp[st][a2].z = pk2(G[8 * a2 + 4], G[8 * a2 + 5]); gp[st][a2].w = pk2(G[8 * a2 + 6], G[8 * a2 + 7]); }
            } else { gp[st][0] = (u32x4){0u, 0u, 0u, 0u}; gp[st][1] = (u32x4){0u, 0u, 0u, 0u}; }
        }
        }
        float ss = 0.f;
        bf16_t* yrow = (bf16_t*)(X.ws + WS_O) + (t0 + 32 * w + (lane >> 1)) * SSM_INNER + g * 512 + 32 * (lane & 1);
        const bf16_t* zdma = (const bf16_t*)(X.ws + WS_ZBC) + (t0 + 32 * w + (lane >> 3)) * 3072 + g * 512 + 8 * ((lane & 7) ^ (lane >> 3));
        LAS unsigned char* trw = tile + (lane >> 1) * 128;
        LAS unsigned char* tac = tile + ql * 128 + 8 * hf;
#pragma unroll 1
        for (int h8 = 0; h8 < 8; ++h8) {
            const int sb = (h8 & 1) * S3_STG;
            asm volatile("s_waitcnt vmcnt(0) lgkmcnt(0)\n\ts_barrier" ::: "memory");
            if (h8 < 7) S3_ISSUE(h8 + 1, ((h8 + 1) & 1) * S3_STG);
#pragma unroll
            for (int k = 0; k < 4; ++k) DMA16(zdma + (size_t)(8 * k) * 3072 + h8 * 64, tile + k * 1024);
            f32x16 acc0, acc1;
#pragma unroll
            for (int i = 0; i < 16; ++i) { acc0[i] = 0.f; acc1[i] = 0.f; }
            {
                const LAS unsigned char* pp = X.lds + sb + 32768 + hf * 1024 + ql * 16;
                const bf16_t* cp = bcm + (t0 + 32 * w + (fresh(lane) & 31)) * 1024 + 512 + g * 128 + 8 * hf;
#pragma unroll
                for (int ks = 0; ks < 8; ++ks) { const bf16x8 cfk = *(const bf16x8*)(cp + 16 * ks);
                                                 acc0 = __builtin_amdgcn_mfma_f32_32x32x16_bf16(*(const LAS bf16x8*)(pp + ks * 2048), cfk, acc0, 0, 0, 0);
                                                 acc1 = __builtin_amdgcn_mfma_f32_32x32x16_bf16(*(const LAS bf16x8*)(pp + ks * 2048 + 512), cfk, acc1, 0, 0, 0); }
                const float e = __expf(csl[h8 * 256 + lq]);
#pragma unroll
                for (int i = 0; i < 16; ++i) { acc0[i] *= e; acc1[i] *= e; }
            }
            const float cl = csl[h8 * 256 + lq], dsk = p.in[21][g * 8 + h8];
#pragma unroll
            for (int st = 0; st < 8; ++st) {
                if (st <= w) {
                    const int s0 = 32 * st + 8 * hf;
#pragma unroll
                    for (int a2 = 0; a2 < 2; ++a2) {
                        const f32x4 d0 = *(const LAS f32x4*)(dtl + h8 * 256 + s0 + 16 * a2), d1 = *(const LAS f32x4*)(dtl + h8 * 256 + s0 + 16 * a2 + 4);
                        const f32x4 c0 = *(const LAS f32x4*)(csl + h8 * 256 + s0 + 16 * a2), c1 = *(const LAS f32x4*)(csl + h8 * 256 + s0 + 16 * a2 + 4);
                        const float dd[8] = {d0.x, d0.y, d0.z, d0.w, d1.x, d1.y, d1.z, d1.w}, cc[8] = {c0.x, c0.y, c0.z, c0.w, c1.x, c1.y, c1.z, c1.w};
                        const unsigned gw[4] = {gp[st][a2].x, gp[st][a2].y, gp[st][a2].z, gp[st][a2].w};
                        float m[8];
#pragma unroll
                        for (int j = 0; j < 8; ++j) { const int sidx = s0 + 16 * a2 + j;
                            const float gv = (j & 1) ? bfhi(gw[j >> 1]) : bflo(gw[j >> 1]);
                            float v = gv * dd[j] * __expf(fminf(cl - cc[j], 0.f));
                            if (st == w) { v = sidx > lq ? 0.f : v; v += sidx == lq ? dsk : 0.f; }
                            m[j] = v; }
                        u32x4 pw; pw.x = pk2(m[0], m[1]); pw.y = pk2(m[2], m[3]); pw.z = pk2(m[4], m[5]); pw.w = pk2(m[6], m[7]);
                        const bf16x8 pf = __builtin_bit_cast(bf16x8, pw);
                        const LAS unsigned char* xp = X.lds + sb + (4 * st + 2 * a2 + hf) * 1024 + ql * 16;
                        acc0 = __builtin_amdgcn_mfma_f32_32x32x16_bf16(*(const LAS bf16x8*)xp, pf, acc0, 0, 0, 0);
                        acc1 = __builtin_amdgcn_mfma_f32_32x32x16_bf16(*(const LAS bf16x8*)(xp + 512), pf, acc1, 0, 0, 0);
                        __builtin_amdgcn_sched_barrier(0);
                    }
                }
            }
            asm volatile("s_waitcnt vmcnt(0)" ::: "memory");
#pragma unroll
            for (int pt = 0; pt < 2; ++pt)
#pragma unroll
                for (int g4 = 0; g4 < 4; ++g4) {
                    const u32x2 z2 = *(const LAS u32x2*)(tac + (((4 * pt + g4) ^ (ql & 7)) * 16));
                    const float a0 = pt ? acc1[4 * g4] : acc0[4 * g4], a1 = pt ? acc1[4 * g4 + 1] : acc0[4 * g4 + 1], a2v = pt ? acc1[4 * g4 + 2] : acc0[4 * g4 + 2], a3 = pt ? acc1[4 * g4 + 3] : acc0[4 * g4 + 3];
                    const float v0 = a0 * silu_fast(bflo(z2.x)), v1 = a1 * silu_fast(bfhi(z2.x)), v2 = a2v * silu_fast(bflo(z2.y)), v3 = a3 * silu_fast(bfhi(z2.y));
                    ss += (v0 * v0 + v1 * v1) + (v2 * v2 + v3 * v3);
                    u32x2 o; o.x = pk2(v0, v1); o.y = pk2(v2, v3); *(LAS u32x2*)(tac + (((4 * pt + g4) ^ (ql & 7)) * 16)) = o;
                }
#pragma unroll
            for (int k = 0; k < 4; ++k) *(u32x4*)(yrow + h8 * 64 + 8 * k) = *(const LAS u32x4*)(trw + (((4 * (lane & 1) + k) ^ ((lane >> 1) & 7)) * 16));
        }
#undef S3_ISSUE
        ss += __shfl_xor(ss, 32);
        const float rs = rsqrtf(ss * (1.f / 512.f) + EPS);
        asm volatile("s_waitcnt vmcnt(0)" ::: "memory");
        {
            const int lf = fresh(lane);
            bf16_t* yb = (bf16_t*)(X.ws + WS_O) + (t0 + 32 * w) * SSM_INNER + g * 512 + 8 * lf;
            const f32x4 g0 = *(const f32x4*)(p.in[22] + g * 512 + 8 * lf), g1 = *(const f32x4*)(p.in[22] + g * 512 + 8 * lf + 4);
#pragma unroll 1
            for (int r0 = 0; r0 < 32; r0 += 8) {
                u32x4 q[8];
#pragma unroll
                for (int k = 0; k < 8; ++k) q[k] = *(const u32x4*)(yb + (size_t)(r0 + k) * SSM_INNER);
#pragma unroll
                for (int k = 0; k < 8; ++k) {
                    const float rk = __shfl(rs, r0 + k);
                    u32x4 o; o.x = pk2(bflo(q[k].x) * rk * g0.x, bfhi(q[k].x) * rk * g0.y); o.y = pk2(bflo(q[k].y) * rk * g0.z, bfhi(q[k].y) * rk * g0.w);
                    o.z = pk2(bflo(q[k].z) * rk * g1.x, bfhi(q[k].z) * rk * g1.y); o.w = pk2(bflo(q[k].w) * rk * g1.z, bfhi(q[k].w) * rk * g1.w);
                    *(u32x4*)(yb + (size_t)(r0 + k) * SSM_INNER) = o;
                }
            }
        }
        asm volatile("s_waitcnt lgkmcnt(0)\n\ts_barrier" ::: "memory");
    }
}

__device__ __forceinline__ void ph_moe_gu(const Params& p, const Ctx& X, int l) {
    moe_table(X, l);
    pg8::MoeOrder So{(const LAS int*)(X.lds + TAB_OFF), (const LAS int*)(X.lds + TAB_OFF) + 40, (const int*)(X.ws + WS_SLOT), 3, X.G, X.bid, true};
    pg8::Gemm g{(const bf16_t*)(X.ws + WS_U), (const bf16_t*)(X.ws + WS_WGU) + (size_t)l * NE * 2048 * 1024, 1024};
    pg8::EpiGu E{(bf16_t*)(X.ws + WS_ACT), p.in[27] + (size_t)l * NE * 2048};
    pg8::gemm_phase<pg8::EpiGu, pg8::MoeOrder>(X.lds, g, So, E, X.tid);
}
__device__ __forceinline__ void ph_moe_down(const Params& p, const Ctx& X, int l) {
    moe_table(X, l);
    pg8::MoeOrder So{(const LAS int*)(X.lds + TAB_OFF), (const LAS int*)(X.lds + TAB_OFF) + 40, (const int*)(X.ws + WS_SLOT), 2, X.G, X.bid, false};
    pg8::Gemm g{(const bf16_t*)(X.ws + WS_ACT), (const bf16_t*)(X.ws + WS_WDN) + (size_t)l * NE * 1024 * 1024, 1024};
    pg8::EpiDown E{(bf16_t*)(X.ws + WS_Y), p.in[29] + (size_t)l * NE * 1024};
    pg8::gemm_phase<pg8::EpiDown, pg8::MoeOrder>(X.lds, g, So, E, X.tid);
}

#ifndef PROBE_MASK
#define PROBE_MASK 0u
#endif
#ifndef PROBE_MULT
#define PROBE_MULT 8
#endif
__global__ void __launch_bounds__(NTHREADS, 2) fwd_kernel(Params p) {
    extern __shared__ __attribute__((aligned(16))) unsigned char lds_raw[];
    Ctx X;
    X.lds = (LAS unsigned char*)lds_raw; X.ws = p.ws;
    X.tid = threadIdx.x; X.lane = X.tid & 63; X.wave = __builtin_amdgcn_readfirstlane(X.tid >> 6);
    X.G = gridDim.x; X.bid = blockIdx.x; X.gw = X.bid * NWAVES + X.wave; X.ngw = X.G * NWAVES; X.sub = 0ull; X.subt = 0ull;
    if (X.tid < 4) ((LAS unsigned*)(X.lds + XB_OFF))[X.tid] = 0u;
    __syncthreads();
    XcdBarrier bar = xcd_barrier_post((unsigned*)(p.ws + WS_CTL) + CW_BAR, (volatile LAS unsigned*)(X.lds + XB_OFF));
#define PHASE_BEGIN Ctx Y = X; { GAS unsigned char* w_ = (GAS unsigned char*)p.ws; asm volatile("" : "+s"(w_)); Y.ws = (unsigned char*)w_; int t_ = threadIdx.x; asm volatile("" : "+v"(t_)); Y.tid = t_; Y.lane = t_ & 63; \
    Y.wave = __builtin_amdgcn_readfirstlane(t_ >> 6); Y.gw = Y.bid * NWAVES + Y.wave; }
#define WSF(off) ((float*)(Y.ws + (off)))
#define WSB(off) ((bf16_t*)(Y.ws + (off)))
#define PROBE_LDS(i) (((volatile LAS unsigned long long*)(X.lds + 150528))[2 * X.wave + (i)])
    if (PROBE_MASK || PROBE_SUB) { if (X.lane == 0) { PROBE_LDS(0) = __builtin_amdgcn_s_memrealtime(); PROBE_LDS(1) = 0ull; } }
#define PB(k) do { if (PROBE_MASK) { if (X.lane == 0) { const unsigned long long n_ = __builtin_amdgcn_s_memrealtime(); if ((PROBE_MASK >> (k)) & 1u) PROBE_LDS(1) += n_ - PROBE_LDS(0); PROBE_LDS(0) = n_; } } } while (0)
    { PHASE_BEGIN ph_prologue(p, Y); }                                    xcd_barrier(bar); PB(0);
    { PHASE_BEGIN ph_norm0(p, Y); }                                       xcd_barrier(bar); PB(1);
    {
        PHASE_BEGIN
        pg8::DenseOrder So; So.init(T, PROJ_LD, X.G, X.bid);
        pg8::Gemm g{WSB(WS_U), WSB(WS_WIN), 1024};
        pg8::EpiBf16 E{WSB(WS_BIG), PROJ_LD};
        pg8::gemm_phase<pg8::EpiBf16, pg8::DenseOrder>(X.lds, g, So, E, Y.tid);
    }
    {
        PHASE_BEGIN
        pg8::DenseOrder So; So.init(768, T, X.G, X.bid);
        pg8::Gemm g{WSB(WS_WV), WSB(WS_U), 1024};
        pg8::EpiBf16 E{WSB(WS_VT), T};
        pg8::gemm_phase<pg8::EpiBf16, pg8::DenseOrder>(X.lds, g, So, E, Y.tid);
    }
    xcd_barrier(bar); PB(2);
    { PHASE_BEGIN ph_attn_a(p, Y); }                                      xcd_barrier(bar); PB(3);
    { PHASE_BEGIN ph_nsa(p, Y); if (PROBE_SUB && X.lane == 0) PROBE_LDS(1) += Y.sub; }
    __syncthreads(); PB(19);
    { PHASE_BEGIN ph_sb(Y); if (PROBE_SUB && X.lane == 0) PROBE_LDS(1) += Y.sub; }                                             xcd_barrier(bar); PB(4);
    {
        PHASE_BEGIN
        pg8::DenseOrder So; So.init(T, D, X.G, X.bid);
        pg8::Gemm g{WSB(WS_O), WSB(WS_WOUT), 1024};
        pg8::EpiResid E{p.in[0], WSF(WS_H1), WSF(WS_MODF) + 2048};
        pg8::gemm_phase<pg8::EpiResid, pg8::DenseOrder>(X.lds, g, So, E, Y.tid);
    }
    xcd_barrier(bar); PB(5);
    { PHASE_BEGIN ph_token<0>(p, Y, 0, WSF(WS_H1), nullptr); }                       xcd_barrier(bar); PB(6);
    { PHASE_BEGIN ph_moe_gu(p, Y, 0); }                                   xcd_barrier(bar); PB(7);
    { PHASE_BEGIN ph_moe_down(p, Y, 0); }                                 xcd_barrier(bar); PB(8);
    { PHASE_BEGIN ph_token<1>(p, Y, 0, WSF(WS_H1), WSF(WS_H2)); }       xcd_barrier(bar); PB(9);
    {
        PHASE_BEGIN
        pg8::DenseOrder So; So.init(T, 3072, X.G, X.bid);
        pg8::Gemm g{WSB(WS_U), WSB(WS_WSIN), 1024};
        pg8::EpiBf16 E{WSB(WS_ZBC), 3072};
        pg8::gemm_phase<pg8::EpiBf16, pg8::DenseOrder>(X.lds, g, So, E, Y.tid);
    }
    {
        PHASE_BEGIN
        pg8::DenseOrder So; So.init(3072, T, X.G, X.bid);
        pg8::Gemm g{WSB(WS_WSIN) + (size_t)2048 * 1024, WSB(WS_U), 1024};
        pg8::EpiBf16 E{WSB(WS_XT), T};
        pg8::gemm_phase<pg8::EpiBf16, pg8::DenseOrder>(X.lds, g, So, E, Y.tid);
    }
    xcd_barrier(bar); PB(10);
    { PHASE_BEGIN ph_ssd1(p, Y); if (PROBE_SUB && X.lane == 0) PROBE_LDS(1) += Y.sub; }                                        xcd_barrier(bar); PB(11);
    { PHASE_BEGIN ph_ssd2(Y); }                                           xcd_barrier(bar); PB(12);
    { PHASE_BEGIN ph_ssd3(p, Y); if (PROBE_SUB && X.lane == 0) PROBE_LDS(1) += Y.sub; }                                        xcd_barrier(bar); PB(13);
    {
        PHASE_BEGIN
        pg8::DenseOrder So; So.init(T, D, X.G, X.bid);
        pg8::Gemm g{WSB(WS_O), WSB(WS_WSOUT), 2048};
        pg8::EpiResid E{WSF(WS_H2), WSF(WS_H1), WSF(WS_MODF) + 4 * 6144 + 2048};
        pg8::gemm_phase<pg8::EpiResid, pg8::DenseOrder>(X.lds, g, So, E, Y.tid);
    }
    xcd_barrier(bar); PB(14);
    { PHASE_BEGIN ph_token<0>(p, Y, 1, WSF(WS_H1), nullptr); }                       xcd_barrier(bar); PB(15);
    { PHASE_BEGIN ph_moe_gu(p, Y, 1); }                                   xcd_barrier(bar); PB(16);
    { PHASE_BEGIN ph_moe_down(p, Y, 1); }                                 xcd_barrier(bar); PB(17);
    { PHASE_BEGIN ph_token<2>(p, Y, 1, WSF(WS_H1), p.out); } PB(18);
    if (PROBE_MASK || PROBE_SUB) { asm volatile("s_waitcnt lgkmcnt(0)" ::: "memory"); const unsigned long long acc_ = PROBE_LDS(1); const unsigned long long t_end = __builtin_amdgcn_s_memrealtime() + (unsigned long long)PROBE_MULT * (unsigned long long)__builtin_amdgcn_readfirstlane((unsigned)acc_); while (__builtin_amdgcn_s_memrealtime() < t_end) __builtin_amdgcn_s_sleep(8); }
#undef PB
#undef PROBE_LDS
#undef PHASE_BEGIN
#undef WSF
#undef WSB
}
}

extern "C" void kernel_launch(void* const* d_in, const int* in_sizes, int n_in, void* d_out, int out_size, void* d_ws, size_t ws_size, hipStream_t stream) {
    static int grid = 0;
    if (grid == 0) {
        if (n_in != 30 || out_size != T * D || ws_size < WS_END) { fprintf(stderr, "kernel_launch: unexpected shapes / workspace (%d inputs, out %d, ws %zu < %zu)\n", n_in, out_size, ws_size, (size_t)WS_END); grid = -1; return; }
        int dev = 0, cus = 0, per_cu = 0;
        if (hipGetDevice(&dev) != hipSuccess || hipDeviceGetAttribute(&cus, hipDeviceAttributeMultiprocessorCount, dev) != hipSuccess) { grid = -1; return; }
        if (hipFuncSetAttribute((const void*)fwd_kernel, hipFuncAttributeMaxDynamicSharedMemorySize, LDS_BYTES) != hipSuccess) { fprintf(stderr, "kernel_launch: hipFuncSetAttribute failed\n"); grid = -1; return; }
        if (hipOccupancyMaxActiveBlocksPerMultiprocessor(&per_cu, (const void*)fwd_kernel, NTHREADS, LDS_BYTES) != hipSuccess || per_cu < 1) { fprintf(stderr, "kernel_launch: occupancy query reports %d\n", per_cu); }
        (void)hipGetLastError();
        grid = cus;
    }
    if (grid < 0) return;
    if (hipMemsetAsync((char*)d_ws + WS_CTL, 0, CTL_BYTES, stream) != hipSuccess) return;
    Params p{};
    for (int i = 0; i < 30; ++i) p.in[i] = (const float*)d_in[i];
    p.out = (float*)d_out; p.ws = (unsigned char*)d_ws;
    hipLaunchKernelGGL(fwd_kernel, dim3(grid), dim3(NTHREADS), LDS_BYTES, stream, p);
}
```

```cpp
#include <hip/hip_runtime.h>
#include <cstdio>
#include <cstdint>

#define LAS __attribute__((address_space(3)))
#define GAS __attribute__((address_space(1)))
typedef unsigned short bf16_t;
typedef short bf16x8 __attribute__((ext_vector_type(8)));
typedef float f32x4 __attribute__((ext_vector_type(4)));
typedef unsigned u32x4 __attribute__((ext_vector_type(4)));
typedef unsigned u32x2 __attribute__((ext_vector_type(2)));
typedef float f32x16 __attribute__((ext_vector_type(16)));

namespace {
constexpr int D = 1024, NB = 4, S = 4096, T = NB * S;
constexpr int ATTN_IN = 2840, PROJ_LD = 3072;
constexpr int OFF_SBQ = 0, OFF_SBK = 512, OFF_SBV = 1024, OFF_NQ = 1536, OFF_KC = 2048, OFF_VC = 2176, OFF_KS = 2304, OFF_VS = 2432,
              OFF_KW = 2560, OFF_VW = 2688, OFF_GATE = 2816;
constexpr int NCMP = 255;
constexpr int SSM_IN = 5152, SSM_INNER = 2048, CONV_DIM = 3072, ZX_LD = 5120;
constexpr int NE = 32, CAP = 16384, MAXTILES = 288;
constexpr float EPS = 1e-6f;
constexpr int NWAVES = 8, NTHREADS = 512;

constexpr size_t al4k(size_t x) { return (x + 4095) & ~(size_t)4095; }
constexpr size_t WS_CTL = 0, CTL_BYTES = 1u << 20;
constexpr int CW_CNT = 256;
constexpr int CW_BAR = 4096;
constexpr size_t CTL_MOD = 65536;
constexpr size_t WS_WIN = CTL_BYTES;
constexpr size_t WS_WOUT = WS_WIN + (size_t)3072 * 1024 * 2;
constexpr size_t WS_WSIN = WS_WOUT + (size_t)1024 * 1024 * 2;
constexpr size_t WS_WSOUT = WS_WSIN + (size_t)5120 * 1024 * 2;
constexpr size_t WS_WGU = WS_WSOUT + (size_t)1024 * 2048 * 2;
constexpr size_t WS_WDN = WS_WGU + (size_t)2 * 32 * 2048 * 1024 * 2;
constexpr size_t WS_U = WS_WDN + (size_t)2 * 32 * 1024 * 1024 * 2;
constexpr size_t WS_BIG = WS_U + (size_t)T * 1024 * 2;
constexpr size_t WS_O = WS_BIG + (size_t)T * 5120 * 2;
constexpr size_t WS_H1 = WS_O + (size_t)T * 2048 * 2;
constexpr size_t WS_H2 = WS_H1 + (size_t)T * 1024 * 4;
constexpr size_t WS_QN = WS_H2 + (size_t)T * 1024 * 4;
constexpr size_t WS_KN = WS_QN + (size_t)T * 512 * 4;
constexpr size_t WS_KCMP = WS_KN + (size_t)T * 256 * 4;
constexpr size_t WS_VCMP = WS_KCMP + al4k((size_t)NB * NCMP * 2 * 64 * 4);
constexpr size_t WS_ACT = WS_VCMP + al4k((size_t)NB * NCMP * 2 * 64 * 4);
constexpr size_t WS_Y = WS_ACT + (size_t)MAXTILES * 256 * 1024 * 2;
constexpr size_t WS_TOKE = WS_Y + (size_t)MAXTILES * 256 * 1024 * 2;
constexpr size_t WS_TOKW = WS_TOKE + (size_t)T * 16;
constexpr size_t WS_TOKP = WS_TOKW + (size_t)T * 16;
constexpr size_t WS_SLOT = WS_TOKP + (size_t)T * 16;
constexpr size_t WS_XC = WS_SLOT + (size_t)NE * CAP * 4;
constexpr size_t WS_YS = WS_XC + (size_t)T * 3072 * 4;
constexpr size_t WS_DT = WS_YS + (size_t)T * 2048 * 4;
constexpr size_t WS_MODF = WS_DT + (size_t)T * 32 * 4;
constexpr size_t WS_WV = WS_MODF + (size_t)2 * 4 * 6144 * 4;
constexpr size_t WS_VT = WS_WV + (size_t)768 * 1024 * 2;
constexpr size_t WS_QNB = WS_VT + (size_t)768 * T * 2;
constexpr size_t WS_KSN = WS_QNB + (size_t)T * 512 * 2;
constexpr size_t WS_KWN = WS_KSN + (size_t)T * 128 * 2;
constexpr size_t WS_KCB = WS_KWN + (size_t)T * 128 * 2;
constexpr size_t WS_VCT = WS_KCB + (size_t)8 * 256 * 64 * 2;
constexpr size_t WS_DT2 = WS_VCT + (size_t)8 * 64 * 256 * 2;
constexpr size_t WS_CS = WS_DT2 + (size_t)NB * 32 * S * 4;
constexpr size_t WS_DEC = WS_CS + (size_t)NB * 32 * S * 4;
constexpr size_t WS_W1T = WS_DEC + al4k((size_t)NB * 16 * 32 * 4);
constexpr size_t WS_SKW = WS_W1T + (size_t)2 * 128 * 2048 * 2;
constexpr size_t WS_ULO = WS_SKW + (size_t)3 * 2 * 32 * 1024 * 2;
constexpr size_t WS_END = WS_ULO + (size_t)T * 1024 * 2;
constexpr size_t WS_ZBC = WS_BIG, WS_XT = WS_XC, WS_XCT = WS_XC + (size_t)3072 * T * 2, WS_ST = WS_YS, WS_PB = WS_YS + (size_t)NB * 16 * 32 * 8192 * 4, WS_BCM = WS_QN;
static_assert(WS_XCT + (size_t)2560 * T * 2 <= WS_YS && WS_PB + (size_t)NB * 16 * 32 * 8192 * 2 <= WS_DT && (size_t)T * 1024 * 2 <= (size_t)T * 512 * 4, "layer-1 overlays");

constexpr int RING_BYTES = 131072;
constexpr int EXTRA_OFF = RING_BYTES;
constexpr int TAB_OFF = 151552;
constexpr int XB_OFF = 152576;
constexpr int LDS_BYTES = 153600;

struct Params { const float* in[30]; float* out; unsigned char* ws; };

__device__ __forceinline__ float siluf(float v) { return v / (1.f + expf(-v)); }
__device__ __forceinline__ float logsig(float x) { return fminf(x, 0.f) - log1pf(expf(-fabsf(x))); }
__device__ __forceinline__ float wave_sum(float v) {
#pragma unroll
    for (int o = 32; o > 0; o >>= 1) v += __shfl_xor(v, o);
    return v;
}
__device__ __forceinline__ float wave_max(float v) {
#pragma unroll
    for (int o = 32; o > 0; o >>= 1) v = fmaxf(v, __shfl_xor(v, o));
    return v;
}
__device__ __forceinline__ unsigned f2bf(float f) { unsigned u = __builtin_bit_cast(unsigned, f); return (u + 0x7fffu + ((u >> 16) & 1u)) >> 16; }
typedef float f32x2_t __attribute__((ext_vector_type(2))); typedef __bf16 bf16x2_t __attribute__((ext_vector_type(2)));
__device__ __forceinline__ unsigned pk2(float lo, float hi) { f32x2_t v = {lo, hi}; bf16x2_t b = __builtin_convertvector(v, bf16x2_t); return __builtin_bit_cast(unsigned, b); }
__device__ __forceinline__ float bf2f(bf16_t v) { return __uint_as_float((unsigned)v << 16); }
__device__ __forceinline__ float bflo(unsigned w) { return __uint_as_float(w << 16); }
__device__ __forceinline__ float bfhi(unsigned w) { return __uint_as_float(w & 0xffff0000u); }
#define LDS_WAIT() asm volatile("s_waitcnt lgkmcnt(0)" ::: "memory")
__device__ __forceinline__ int fresh(int v) { asm volatile("" : "+v"(v)); return v; }
__device__ __forceinline__ int sfresh(int v) { asm volatile("" : "+s"(v)); return v; }

#define XB_TMO      128
#define XB_XCNT(j)  (256  + 64 * (j))
#define XB_XSUB(j)  (1280 + 64 * (j))
#define XB_XGEN(j)  (2304 + 64 * (j))
#define XB_TOP      3328
#define XB_TOPGEN   3392
#define XCD_BAR_WORDS 3456
#define XB_SPIN_CAP (1u << 18)
__device__ __forceinline__ unsigned xb_ld(unsigned* p)              { return __hip_atomic_load(p, __ATOMIC_RELAXED, __HIP_MEMORY_SCOPE_AGENT); }
__device__ __forceinline__ unsigned xb_add(unsigned* p, unsigned v) { return __hip_atomic_fetch_add(p, v, __ATOMIC_RELAXED, __HIP_MEMORY_SCOPE_AGENT); }
__device__ __forceinline__ unsigned xb_xcc_id() { return (unsigned)__builtin_amdgcn_s_getreg((3 << 11) | 20) & 0xFu; }
#define XB_SPIN(cond, bar) do { unsigned _sp = 0; while (cond) { __builtin_amdgcn_s_sleep(1); \
    if ((++_sp & 255u) == 0u) { if (xb_ld(&(bar)[XB_TMO])) break; if (_sp > XB_SPIN_CAP) { atomicAdd(&(bar)[XB_TMO], 1u); break; } } } } while (0)
struct XcdBarrier { unsigned* bar; unsigned x; volatile LAS unsigned* st; };
__device__ __forceinline__ XcdBarrier xcd_barrier_post(unsigned* bar, volatile LAS unsigned* st) {
    XcdBarrier b; b.bar = bar; b.x = xb_xcc_id(); b.st = st;
    if (threadIdx.x == 0) (void)xb_add(&bar[XB_XCNT(b.x)], 1u);
    return b;
}
__device__ __forceinline__ void xcd_barrier_complete(unsigned* bar, unsigned x, unsigned& nloc, unsigned& nx) {
    const unsigned G = gridDim.x * gridDim.y * gridDim.z;
    unsigned sum, cnt, mine, sp = 0u;
    for (;;) {
        sum = 0u; cnt = 0u; mine = 0u;
#pragma unroll
        for (unsigned j = 0; j < 16; ++j) { const unsigned c = xb_ld(&bar[XB_XCNT(j)]); sum += c; cnt += (c > 0u) ? 1u : 0u; mine = (j == x) ? c : mine; }
        if (sum == G) break;
        __builtin_amdgcn_s_sleep(1);
        if ((++sp & 255u) == 0u) { if (xb_ld(&bar[XB_TMO])) break; if (sp > XB_SPIN_CAP) { atomicAdd(&bar[XB_TMO], 1u); break; } }
    }
    nloc = mine > 0u ? mine : 1u; nx = cnt > 0u ? cnt : 1u;
}
__device__ __forceinline__ void xcd_barrier(const XcdBarrier& b) {
    asm volatile("s_waitcnt vmcnt(0)" ::: "memory");
    __syncthreads();
    if (threadIdx.x == 0) {
        unsigned* bar = b.bar;
        __builtin_amdgcn_s_waitcnt(0);
        unsigned nloc = b.st[0], nx = b.st[1];
        if (nloc == 0u) { xcd_barrier_complete(bar, b.x, nloc, nx); b.st[0] = nloc; b.st[1] = nx; }
        const unsigned old = xb_add(&bar[XB_XSUB(b.x)], 1u);
        const unsigned gen = old / nloc;
        if (old + 1u == (gen + 1u) * nloc) {
            __builtin_amdgcn_fence(__ATOMIC_RELEASE, "agent");
            asm volatile("s_waitcnt vmcnt(0)" ::: "memory");
            const unsigned og = xb_add(&bar[XB_TOP], 1u);
            const unsigned tg = og / nx;
            if (og + 1u == (tg + 1u) * nx) xb_add(&bar[XB_TOPGEN], 1u);
            else XB_SPIN(xb_ld(&bar[XB_TOPGEN]) == tg, bar);
            __builtin_amdgcn_fence(__ATOMIC_ACQUIRE, "agent");
            xb_add(&bar[XB_XGEN(b.x)], 1u);
            asm volatile("s_waitcnt vmcnt(0)" ::: "memory");
        } else {
            XB_SPIN(xb_ld(&bar[XB_XGEN(b.x)]) == gen, bar);
            __builtin_amdgcn_fence(__ATOMIC_ACQUIRE, "agent");
            asm volatile("s_waitcnt vmcnt(0)" ::: "memory");
        }
    }
    __syncthreads();
}

namespace pg8 {
constexpr int BM = 256, BK = 64, HALF = 128, HTB = HALF * BK * 2, STAGE_BYTES = 8 * HTB;
__device__ __forceinline__ int lds_byte(int r, int c) { const int st = (r >> 4) * 2 + (c >> 5), rr = r & 15, cc = c & 31, ob = rr * 64 + cc * 2; return st * 1024 + (ob ^ (((ob >> 9) & 1) << 5)); }
__device__ __forceinline__ void stage_rc(int b, int& R, int& C) { const int st = b / 1024, sb = b % 1024, swz = sb ^ (((sb >> 9) & 1) << 5); R = (st >> 1) * 16 + swz / 64; C = (st & 1) * 32 + (swz % 64) / 2; }
__device__ __forceinline__ int perm32(int rho) { const int n = rho >> 4, i = rho & 15; return 8 * (i >> 2) + 4 * n + (i & 3); }
struct Unit { int pm, pn, e; };
struct Gemm { const bf16_t* A; const bf16_t* Bt; int K; };
__device__ __forceinline__ unsigned cvt_pk_bf16(float lo, float hi) { unsigned r; asm volatile("v_cvt_pk_bf16_f32 %0, %1, %2" : "=v"(r) : "v"(lo), "v"(hi)); return r; }

struct DenseOrder {
    int nM, nN, nwg, G, c;
    __device__ void init(int M, int N, int G_, int c_) { nM = M / BM; nN = N / BM; nwg = nM * nN; G = G_; c = c_; }
    __device__ bool next(int i, Unit& u) const {
        const long L = (long)i * G + c; if (L >= nwg) return false;
        int wgid = (int)L; { const int q = nwg / 8, r = nwg % 8, xcd = wgid % 8, off = wgid / 8; wgid = (xcd < r ? xcd * (q + 1) : r * (q + 1) + (xcd - r) * q) + off; }
        const int nig = 8 * nN, gid = wgid / nig, fm = gid * 8, gsz = (nM - fm) < 8 ? (nM - fm) : 8;
        u.pm = fm + ((wgid % nig) % gsz); u.pn = (wgid % nig) / gsz; u.e = 0; return true;
    }
    __device__ __forceinline__ unsigned arow(const Unit& u, int r) const { return (unsigned)(u.pm * BM + r); }
};
struct MoeOrder {
    const LAS int* tb; const LAS int* cn; const int* slot_tok; int shift, G, c; bool gather;
    __device__ bool next(int i, Unit& u) const {
        const int L = i * G + c, tile = L >> shift; if (tile >= tb[NE]) return false;
        int e = 0; while (tb[e + 1] <= tile) ++e;
        u.pm = tile; u.pn = (e << shift) + (L & ((1 << shift) - 1)); u.e = e; return true;
    }
    __device__ __forceinline__ unsigned arow(const Unit& u, int r) const {
        if (!gather) return (unsigned)(u.pm * BM + r);
        const int pos = (u.pm - tb[u.e]) * BM + r;
        return pos < cn[u.e] ? (unsigned)slot_tok[u.e * CAP + pos] : 0u;
    }
};

struct EpiBf16 {
    static constexpr bool PERM = true;
    bf16_t* O; int ldc;
    __device__ __forceinline__ void operator()(const f32x4 (&acc)[2][2][4][2], const Unit& u, int wr, int wc, int fr, int fq) const {
        const int row0 = u.pm * BM + wr * 64 + fr, col0 = u.pn * BM + wc * 32 + 8 * fq;
#pragma unroll
        for (int ai = 0; ai < 2; ++ai)
#pragma unroll
            for (int m = 0; m < 4; ++m) { bf16_t* rowp = O + (size_t)(row0 + ai * HALF + m * 16) * ldc + col0;
#pragma unroll
                for (int bj = 0; bj < 2; ++bj) { const f32x4 v0 = acc[ai][bj][m][0], v1 = acc[ai][bj][m][1];
                    u32x4 w; w.x = cvt_pk_bf16(v0[0], v0[1]); w.y = cvt_pk_bf16(v0[2], v0[3]); w.z = cvt_pk_bf16(v1[0], v1[1]); w.w = cvt_pk_bf16(v1[2], v1[3]);
                    *(u32x4*)(rowp + bj * HALF) = w; } }
    }
};
struct EpiResid {
    static constexpr bool PERM = false;
    const float* base; float* out; const float* g;
    __device__ __forceinline__ void operator()(const f32x4 (&acc)[2][2][4][2], const Unit& u, int wr, int wc, int fr, int fq) const {
        const int row0 = u.pm * BM + wr * 64 + fr, col0 = u.pn * BM + wc * 32 + 4 * fq;
        const float* gb = g + (size_t)((u.pm * BM) / S) * 6144 + col0;
        f32x4 gv[2][2];
#pragma unroll
        for (int bj = 0; bj < 2; ++bj)
#pragma unroll
            for (int n = 0; n < 2; ++n) gv[bj][n] = *(const f32x4*)(gb + bj * HALF + n * 16);
#pragma unroll
        for (int ai = 0; ai < 2; ++ai)
#pragma unroll
            for (int m = 0; m < 4; ++m) { const size_t off = (size_t)(row0 + ai * HALF + m * 16) * D + col0;
#pragma unroll
                for (int bj = 0; bj < 2; ++bj)
#pragma unroll
                    for (int n = 0; n < 2; ++n) { const f32x4 bs = *(const f32x4*)(base + off + bj * HALF + n * 16);
                        *(f32x4*)(out + off + bj * HALF + n * 16) = bs + gv[bj][n] * acc[ai][bj][m][n]; } }
    }
};
struct EpiGu {
    static constexpr bool PERM = true;
    bf16_t* act; const float* bgu;
    __device__ __forceinline__ void operator()(const f32x4 (&acc)[2][2][4][2], const Unit& u, int wr, int wc, int fr, int fq) const {
        const int row0 = u.pm * BM + wr * 64 + fr, col0 = (u.pn & 7) * HALF + wc * 32 + 8 * fq;
        const float* bb = bgu + (size_t)u.e * 2048 + col0;
        const f32x4 bg0 = *(const f32x4*)(bb), bg1 = *(const f32x4*)(bb + 4), bu0 = *(const f32x4*)(bb + 1024), bu1 = *(const f32x4*)(bb + 1028);
#pragma unroll
        for (int ai = 0; ai < 2; ++ai)
#pragma unroll
            for (int m = 0; m < 4; ++m) {
                float r[8];
#pragma unroll
                for (int n = 0; n < 2; ++n) { const f32x4 gt = acc[ai][0][m][n] + (n ? bg1 : bg0), up = acc[ai][1][m][n] + (n ? bu1 : bu0);
#pragma unroll
                    for (int j = 0; j < 4; ++j) { const float gg = fminf(gt[j], 7.f), uu = fminf(fmaxf(up[j], -7.f), 7.f);
                        r[n * 4 + j] = (uu + 1.f) * gg * __builtin_amdgcn_rcpf(1.f + __expf(-1.702f * gg)); } }
                u32x4 w; w.x = cvt_pk_bf16(r[0], r[1]); w.y = cvt_pk_bf16(r[2], r[3]); w.z = cvt_pk_bf16(r[4], r[5]); w.w = cvt_pk_bf16(r[6], r[7]);
                *(u32x4*)(act + (size_t)(row0 + ai * HALF + m * 16) * D + col0) = w; }
    }
};
struct EpiDown {
    static constexpr bool PERM = true;
    bf16_t* y; const float* bd;
    __device__ __forceinline__ void operator()(const f32x4 (&acc)[2][2][4][2], const Unit& u, int wr, int wc, int fr, int fq) const {
        const int row0 = u.pm * BM + wr * 64 + fr, col0 = (u.pn & 3) * BM + wc * 32 + 8 * fq;
        const float* bb = bd + (size_t)u.e * 1024 + col0;
        f32x4 bv[2][2];
#pragma unroll
        for (int bj = 0; bj < 2; ++bj)
#pragma unroll
            for (int n = 0; n < 2; ++n) bv[bj][n] = *(const f32x4*)(bb + bj * HALF + 4 * n);
#pragma unroll
        for (int ai = 0; ai < 2; ++ai)
#pragma unroll
            for (int m = 0; m < 4; ++m) { bf16_t* rowp = y + (size_t)(row0 + ai * HALF + m * 16) * D + col0;
#pragma unroll
                for (int bj = 0; bj < 2; ++bj) { const f32x4 v0 = acc[ai][bj][m][0] + bv[bj][0], v1 = acc[ai][bj][m][1] + bv[bj][1];
                    u32x4 w; w.x = cvt_pk_bf16(v0[0], v0[1]); w.y = cvt_pk_bf16(v0[2], v0[3]); w.z = cvt_pk_bf16(v1[0], v1[1]); w.w = cvt_pk_bf16(v1[2], v1[3]);
                    *(u32x4*)(rowp + bj * HALF) = w; } }
    }
};

template <class Epi, class Sched>
__device__ __forceinline__ void gemm_phase(LAS unsigned char* lds, const Gemm g, const Sched& S, const Epi& E, const int tid) {
    const int wid = __builtin_amdgcn_readfirstlane(tid >> 6), lane = tid & 63, wr = wid >> 2, wc = wid & 3, fr = lane & 15, fq = lane >> 4;
    const int K = g.K, nt = K / BK;
    int RA[2], CA[2]; unsigned voffB[2];
#pragma unroll
    for (int i = 0; i < 2; ++i) { int R, C; stage_rc(tid * 16 + i * 8192, R, C); const int Rb = Epi::PERM ? ((R & ~31) + perm32(R & 31)) : R;
        RA[i] = R; CA[i] = C; voffB[i] = (unsigned)(Rb * K + C) * 2u; }
    const size_t kstep = (size_t)(BK * 2);
    const size_t hstep = (size_t)HALF * K * 2;
    const size_t tstep = 2 * hstep;
    const unsigned ldsw = (unsigned)wid * 1024u;
    const int aoff = lds_byte(wr * 64 + fr, fq * 8), boff = lds_byte(wc * 32 + fr, fq * 8);
#define PG8_SA(b, h) (((b) * 2 + (h)) * HTB)
#define PG8_SB(b, h) ((4 + (b) * 2 + (h)) * HTB)
#define PG8_STAGE(bufoff, gbase, voff) do { _Pragma("unroll") for (int _i = 0; _i < 2; ++_i) \
        __builtin_amdgcn_global_load_lds((const unsigned*)((const char*)(gbase) + (voff)[_i]), (LAS unsigned*)(lds + (bufoff) + ldsw + _i * 8192), 16, 0, 0); } while (0)
#define PG8_LDA(dst, b, h) do { _Pragma("unroll") for (int m = 0; m < 4; ++m) _Pragma("unroll") for (int k = 0; k < 2; ++k) dst[m][k] = *(const LAS bf16x8*)(lds + PG8_SA(b, h) + aoff + m * 2048 + k * 1024); } while (0)
#define PG8_LDB(dst, b, h) do { _Pragma("unroll") for (int n = 0; n < 2; ++n) _Pragma("unroll") for (int k = 0; k < 2; ++k) dst[n][k] = *(const LAS bf16x8*)(lds + PG8_SB(b, h) + boff + n * 2048 + k * 1024); } while (0)
#define PG8_MMA(ai, bj, At, Bt) do { __builtin_amdgcn_s_setprio(1); _Pragma("unroll") for (int m = 0; m < 4; ++m) _Pragma("unroll") for (int n = 0; n < 2; ++n) _Pragma("unroll") for (int k = 0; k < 2; ++k) \
        acc[ai][bj][m][n] = __builtin_amdgcn_mfma_f32_16x16x32_bf16(Bt[n][k], At[m][k], acc[ai][bj][m][n], 0, 0, 0); __builtin_amdgcn_s_setprio(0); } while (0)
#define PG8_WAIT_V(n) asm volatile("s_waitcnt vmcnt(" #n ")" ::: "memory")
#define PG8_WAIT_L(n) asm volatile("s_waitcnt lgkmcnt(" #n ")" ::: "memory")
#define PG8_BAR __builtin_amdgcn_s_barrier()
#define PG8_SCHED __builtin_amdgcn_sched_barrier(0)
#define PG8_AOFF(dst, u) do { _Pragma("unroll") for (int _h = 0; _h < 2; ++_h) _Pragma("unroll") for (int _i = 0; _i < 2; ++_i) dst[_h][_i] = (S.arow(u, _h * HALF + RA[_i]) * (unsigned)K + (unsigned)CA[_i]) * 2u; } while (0)
    Unit cur, nxt; int ui = 0;
    if (!S.next(0, cur)) return;
    f32x4 acc[2][2][4][2];
#pragma unroll
    for (int a = 0; a < 2; ++a)
#pragma unroll
        for (int b = 0; b < 2; ++b)
#pragma unroll
            for (int m = 0; m < 4; ++m)
#pragma unroll
                for (int n = 0; n < 2; ++n) acc[a][b][m][n] = (f32x4){0.f, 0.f, 0.f, 0.f};
    bf16x8 At[4][2], B0[2][2], B1[2][2];
    unsigned va[2][2], vn[2][2];
    PG8_AOFF(va, cur);
    const char* Ab = (const char*)g.A;
    const char* cB = (const char*)g.Bt + (size_t)cur.pn * tstep;
    PG8_STAGE(PG8_SB(0, 0), cB, voffB); PG8_STAGE(PG8_SB(0, 1), cB + hstep, voffB); PG8_STAGE(PG8_SA(0, 0), Ab, va[0]); PG8_STAGE(PG8_SA(0, 1), Ab, va[1]);
    if (wr == 1) PG8_BAR;
    PG8_WAIT_V(2); PG8_BAR;
    PG8_STAGE(PG8_SB(1, 0), cB + kstep, voffB); PG8_STAGE(PG8_SA(1, 0), Ab + kstep, va[0]); PG8_STAGE(PG8_SB(1, 1), cB + hstep + kstep, voffB);
    PG8_WAIT_V(6); PG8_BAR;
    for (;;) {
        const bool has_next = S.next(ui + 1, nxt);
        if (has_next) { PG8_AOFF(vn, nxt); }
        else {
#pragma unroll
            for (int h = 0; h < 2; ++h)
#pragma unroll
                for (int i = 0; i < 2; ++i) vn[h][i] = va[h][i]; }
        const char* nB = has_next ? (const char*)g.Bt + (size_t)nxt.pn * tstep : cB;
        for (int t = 0; t < nt; t += 2) {
            const bool last = (t == nt - 2);
            const char* a1 = Ab + (size_t)(t + 1) * kstep;
            const char* a2 = last ? Ab : Ab + (size_t)(t + 2) * kstep; const char* b2 = last ? nB : cB + (size_t)(t + 2) * kstep;
            const char* a3 = a2 + kstep; const char* b3 = b2 + kstep;
            unsigned o2[2][2];
#pragma unroll
            for (int h = 0; h < 2; ++h)
#pragma unroll
                for (int i = 0; i < 2; ++i) o2[h][i] = last ? vn[h][i] : va[h][i];
            PG8_LDB(B0, 0, 0); PG8_LDB(B1, 0, 1); PG8_SCHED; PG8_LDA(At, 0, 0); PG8_STAGE(PG8_SA(1, 1), a1, va[1]);
            PG8_WAIT_V(8); PG8_WAIT_L(0); PG8_BAR; PG8_MMA(0, 0, At, B0); PG8_MMA(0, 1, At, B1); PG8_BAR; PG8_SCHED;
            PG8_LDA(At, 0, 1); PG8_STAGE(PG8_SB(0, 0), b2, voffB); PG8_STAGE(PG8_SB(0, 1), b2 + hstep, voffB); PG8_STAGE(PG8_SA(0, 0), a2, o2[0]);
            PG8_WAIT_V(8); PG8_WAIT_L(0); PG8_BAR; PG8_MMA(1, 0, At, B0); PG8_MMA(1, 1, At, B1); PG8_BAR; PG8_SCHED;
            PG8_LDB(B0, 1, 0); PG8_LDB(B1, 1, 1); PG8_SCHED; PG8_LDA(At, 1, 0); PG8_STAGE(PG8_SA(0, 1), a2, o2[1]);
            PG8_WAIT_V(8); PG8_WAIT_L(0); PG8_BAR; PG8_MMA(0, 0, At, B0); PG8_MMA(0, 1, At, B1); PG8_BAR; PG8_SCHED;
            PG8_LDA(At, 1, 1); PG8_STAGE(PG8_SB(1, 0), b3, voffB); PG8_STAGE(PG8_SB(1, 1), b3 + hstep, voffB); PG8_STAGE(PG8_SA(1, 0), a3, o2[0]);
            PG8_WAIT_V(8); PG8_WAIT_L(0); PG8_BAR; PG8_MMA(1, 0, At, B0); PG8_MMA(1, 1, At, B1); PG8_BAR; PG8_SCHED;
        }
        if (wr == 0) PG8_BAR;
        E(acc, cur, wr, wc, fr, fq);
        if (!has_next) break;
#pragma unroll
        for (int a = 0; a < 2; ++a)
#pragma unroll
            for (int b = 0; b < 2; ++b)
#pragma unroll
                for (int m = 0; m < 4; ++m)
#pragma unroll
                    for (int n = 0; n < 2; ++n) acc[a][b][m][n] = (f32x4){0.f, 0.f, 0.f, 0.f};
        cur = nxt; cB = nB; ++ui;
#pragma unroll
        for (int h = 0; h < 2; ++h)
#pragma unroll
            for (int i = 0; i < 2; ++i) va[h][i] = vn[h][i];
        if (wr == 1) PG8_BAR;
    }
    PG8_WAIT_V(0);
    PG8_BAR;
#undef PG8_SA
#undef PG8_SB
#undef PG8_STAGE
#undef PG8_LDA
#undef PG8_LDB
#undef PG8_MMA
#undef PG8_WAIT_V
#undef PG8_WAIT_L
#undef PG8_BAR
#undef PG8_SCHED
#undef PG8_AOFF
}
}

#ifndef PROBE_SUB
#define PROBE_SUB 0
#endif
struct Ctx {
    LAS unsigned char* lds; unsigned char* ws;
    int tid, lane, wave, gw, ngw, G, bid;
    mutable unsigned long long sub, subt;
};
#define SUB_BEGIN(X, id) do { if (PROBE_SUB == (id)) (X).subt = __builtin_amdgcn_s_memrealtime(); } while (0)
#define SUB_END(X, id) do { if (PROBE_SUB == (id)) (X).sub += __builtin_amdgcn_s_memrealtime() - (X).subt; } while (0)

__device__ __forceinline__ void transpose_item(const float* W, int ldw, int K, int nvalid, int k0, int n0, bf16_t* WT, int row0, LAS float* scr, int lane) {
    const int c4 = (lane & 7) * 4, kr = lane >> 3;
    f32x4 v[8];
#pragma unroll
    for (int i = 0; i < 8; ++i) v[i] = (n0 + c4 < nvalid) ? *(const f32x4*)(W + (size_t)(k0 + kr + 8 * i) * ldw + n0 + c4) : (f32x4){0.f, 0.f, 0.f, 0.f};
#pragma unroll
    for (int i = 0; i < 8; ++i) { LAS float* d = scr + (kr + 8 * i) * 33 + c4; d[0] = v[i].x; d[1] = v[i].y; d[2] = v[i].z; d[3] = v[i].w; }
    LDS_WAIT(); asm volatile("" ::: "memory");
    const int c = lane & 7;
#pragma unroll
    for (int j = 0; j < 4; ++j) { const int n = (lane >> 3) + 8 * j; const LAS float* s = scr + (8 * c) * 33 + n;
        u32x4 o; o.x = pk2(s[0 * 33], s[1 * 33]); o.y = pk2(s[2 * 33], s[3 * 33]); o.z = pk2(s[4 * 33], s[5 * 33]); o.w = pk2(s[6 * 33], s[7 * 33]);
        *(u32x4*)(WT + (size_t)(row0 + n) * K + k0 + 8 * c) = o; }
    LDS_WAIT(); asm volatile("" ::: "memory");
}
__device__ __forceinline__ void ph_prologue(const Params& p, const Ctx& X) {
    LAS float* scr = (LAS float*)(X.lds + X.wave * 16384);
    unsigned char* ws = X.ws;
    constexpr int I_MOD = 2 * 96 * 8;
    constexpr int I_SK = 3 * 16, I_W1 = 2 * 32 * 4, I_WIN = 16 * 96, I_WV = 16 * 24, I_WOUT = 16 * 32, I_WSIN = 16 * 160, I_WSOUT = 32 * 32, I_GU = 64 * 1024, I_DN = 64 * 512;
    constexpr int NITEMS = I_MOD + I_SK + I_W1 + I_WIN + I_WV + I_WOUT + I_WSIN + I_WSOUT + I_GU + I_DN;
    for (int it = X.gw; it < NITEMS; it += X.ngw) {
        int r = it;
        if (r < I_MOD) {
            const int kp = r & 7, jb = (r >> 3) % 96, l = r / (8 * 96), j = jb * 64 + X.lane;
            const float* w = p.in[2] + (size_t)l * 1024 * 6144 + (size_t)(kp * 128) * 6144 + j;
            const float* c = p.in[1] + kp * 128;
            float a0 = 0.f, a1 = 0.f, a2 = 0.f, a3 = 0.f;
#pragma unroll 8
            for (int i = 0; i < 128; ++i) { const float wv = w[(size_t)i * 6144];
                a0 += siluf(c[i]) * wv; a1 += siluf(c[1024 + i]) * wv; a2 += siluf(c[2048 + i]) * wv; a3 += siluf(c[3072 + i]) * wv; }
            if (kp == 0) { const float bb = p.in[3][l * 6144 + j]; a0 += bb; a1 += bb; a2 += bb; a3 += bb; }
            unsigned long long* mq = (unsigned long long*)(ws + CTL_MOD) + (size_t)l * 4 * 6144 + j;
            atomicAdd(mq, (unsigned long long)__double2ll_rn((double)a0 * 1099511627776.0)); atomicAdd(mq + 6144, (unsigned long long)__double2ll_rn((double)a1 * 1099511627776.0));
            atomicAdd(mq + 2 * 6144, (unsigned long long)__double2ll_rn((double)a2 * 1099511627776.0)); atomicAdd(mq + 3 * 6144, (unsigned long long)__double2ll_rn((double)a3 * 1099511627776.0));
            continue;
        }
        r -= I_MOD;
        if (r < I_SK) {
            const int m = r >> 4, kb = r & 15, k0 = kb * 64;
            const float* W = m < 2 ? p.in[24] + (size_t)m * D * NE : p.in[16] + 5120; const int ldw = m < 2 ? NE : SSM_IN;
#pragma unroll 8
            for (int i = 0; i < 32; ++i) { const int kk = 2 * i + (X.lane >> 5); scr[kk * 33 + (X.lane & 31)] = W[(size_t)(k0 + kk) * ldw + (X.lane & 31)]; }
            LDS_WAIT(); asm volatile("" ::: "memory");
            const int c = X.lane & 7;
#pragma unroll
            for (int j = 0; j < 4; ++j) { const int n = (X.lane >> 3) + 8 * j; const LAS float* sp = scr + (8 * c) * 33 + n;
                float v[8]; unsigned hi[8];
#pragma unroll
                for (int q = 0; q < 8; ++q) { v[q] = sp[q * 33]; hi[q] = f2bf(v[q]); v[q] -= __uint_as_float(hi[q] << 16); }
                u32x4 oh, ol; oh.x = hi[0] | (hi[1] << 16); oh.y = hi[2] | (hi[3] << 16); oh.z = hi[4] | (hi[5] << 16); oh.w = hi[6] | (hi[7] << 16);
                ol.x = pk2(v[0], v[1]); ol.y = pk2(v[2], v[3]); ol.z = pk2(v[4], v[5]); ol.w = pk2(v[6], v[7]);
                bf16_t* dst = (bf16_t*)(ws + WS_SKW) + (size_t)m * 2 * 32 * 1024 + (size_t)n * 1024 + k0 + 8 * c;
                *(u32x4*)dst = oh; *(u32x4*)(dst + 32 * 1024) = ol; }
            LDS_WAIT(); asm volatile("" ::: "memory");
            continue; }
        r -= I_SK;
        if (r < I_W1) { const int kv = r >> 7, q = r & 127, kb = q >> 2, nb = q & 3;
            transpose_item(kv ? p.in[14] : p.in[12], 128, 2048, 128, kb * 64, nb * 32, (bf16_t*)(ws + WS_W1T) + (size_t)kv * 128 * 2048, nb * 32, scr, X.lane); continue; } r -= I_W1;
        if (r < I_WIN) { const int kb = r / 96, nb = r % 96; transpose_item(p.in[6], ATTN_IN, 1024, ATTN_IN, kb * 64, nb * 32, (bf16_t*)(ws + WS_WIN), nb * 32, scr, X.lane); continue; } r -= I_WIN;
        if (r < I_WV) { const int kb = r / 24, nb = r % 24, r0 = nb * 32, src = r0 < 512 ? OFF_SBV + r0 : (r0 < 640 ? OFF_VS + (r0 - 512) : OFF_VW + (r0 - 640));
            transpose_item(p.in[6], ATTN_IN, 1024, ATTN_IN, kb * 64, src, (bf16_t*)(ws + WS_WV), r0, scr, X.lane); continue; } r -= I_WV;
        if (r < I_WOUT) { const int kb = r / 32, nb = r % 32; transpose_item(p.in[7], 1024, 1024, 1024, kb * 64, nb * 32, (bf16_t*)(ws + WS_WOUT), nb * 32, scr, X.lane); continue; } r -= I_WOUT;
        if (r < I_WSIN) { const int kb = r / 160, nb = r % 160, n0 = nb * 32, row0 = n0 < 2048 ? n0 : (n0 < 4096 ? n0 + 1024 : n0 - 2048);
            transpose_item(p.in[16], SSM_IN, 1024, SSM_IN, kb * 64, n0, (bf16_t*)(ws + WS_WSIN), row0, scr, X.lane); continue; } r -= I_WSIN;
        if (r < I_WSOUT) { const int kb = r / 32, nb = r % 32; transpose_item(p.in[23], 1024, 2048, 1024, kb * 64, nb * 32, (bf16_t*)(ws + WS_WSOUT), nb * 32, scr, X.lane); continue; } r -= I_WSOUT;
        if (r < I_GU) { const int m = r >> 10, q = r & 1023, kb = q >> 6, nb = q & 63, n0 = nb * 32;
            const int row0 = ((n0 & 1023) >> 7) * 256 + (n0 >> 10) * 128 + (n0 & 127);
            transpose_item(p.in[26] + (size_t)m * 1024 * 2048, 2048, 1024, 2048, kb * 64, n0, (bf16_t*)(ws + WS_WGU) + (size_t)m * 2048 * 1024, row0, scr, X.lane); continue; } r -= I_GU;
        { const int m = r >> 9, q = r & 511, kb = q >> 5, nb = q & 31;
            transpose_item(p.in[28] + (size_t)m * 1024 * 1024, 1024, 1024, 1024, kb * 64, nb * 32, (bf16_t*)(ws + WS_WDN) + (size_t)m * 1024 * 1024, nb * 32, scr, X.lane); }
    }
}

struct Row { f32x4 v[4]; };
__device__ __forceinline__ void row_load(Row& r, const float* p, int lane) {
#pragma unroll
    for (int j = 0; j < 4; ++j) r.v[j] = ((const f32x4*)p)[64 * j + lane];
}
__device__ __forceinline__ void row_store(const Row& r, float* p, int lane) {
#pragma unroll
    for (int j = 0; j < 4; ++j) ((f32x4*)p)[64 * j + lane] = r.v[j];
}
template <class PV>
__device__ __forceinline__ void row_norm_mod(const Row& r, Row& o, const float* gain, PV sc, PV sh, int lane) {
    float ss = 0.f;
#pragma unroll
    for (int j = 0; j < 4; ++j) ss += (r.v[j].x * r.v[j].x + r.v[j].y * r.v[j].y) + (r.v[j].z * r.v[j].z + r.v[j].w * r.v[j].w);
    const float rs = rsqrtf(wave_sum(ss) * (1.f / 1024.f) + EPS);
#pragma unroll
    for (int j = 0; j < 4; ++j) { const f32x4 g = ((const f32x4*)gain)[64 * j + lane], a = sc[64 * j + lane], b = sh[64 * j + lane];
        o.v[j] = r.v[j] * rs * g * (a + 1.f) + b; }
}
__device__ __forceinline__ void row_store_bf16(const Row& r, bf16_t* p, int lane) {
#pragma unroll
    for (int j = 0; j < 4; ++j) { u32x2 w; w.x = pk2(r.v[j].x, r.v[j].y); w.y = pk2(r.v[j].z, r.v[j].w); ((u32x2*)p)[64 * j + lane] = w; }
}
__device__ __forceinline__ void row_store_lds(const Row& r, LAS float* p, int lane) {
#pragma unroll
    for (int j = 0; j < 4; ++j) ((LAS f32x4*)p)[64 * j + lane] = r.v[j];
}
__device__ __forceinline__ float modq2f(long long q) { return (float)((double)q * 9.094947017729282e-13); }
__device__ __forceinline__ void ph_norm0(const Params& p, const Ctx& X) {
    const long long* mq = (const long long*)(X.ws + CTL_MOD);
    float* modf = (float*)(X.ws + WS_MODF);
    for (int i = X.bid * NTHREADS + X.tid; i < 2 * 4 * 6144; i += X.G * NTHREADS) modf[i] = modq2f(mq[i]);
    LAS float* tab = (LAS float*)X.lds;
    for (int i = X.tid; i < 4 * 2048; i += NTHREADS) tab[i] = modq2f(mq[(size_t)(i >> 11) * 6144 + (i & 2047)]);
    __syncthreads();
    for (int t = X.gw; t < T; t += X.ngw) {
        Row r, o; row_load(r, p.in[0] + (size_t)t * D, X.lane);
        const LAS float* m = tab + (t / S) * 2048;
        row_norm_mod(r, o, p.in[4], (const LAS f32x4*)(m + 1024), (const LAS f32x4*)m, X.lane);
        row_store_bf16(o, (bf16_t*)(X.ws + WS_U) + (size_t)t * D, X.lane);
    }
}
__device__ __forceinline__ void route_select(float logit, int lane, LAS unsigned* lcnt, int& ev, float& wv, int& lpos) {
    const int e = lane & 31;
    float tl[4]; int te[4];
#pragma unroll
    for (int k = 0; k < 4; ++k) {
        float bv = logit; int bi = e;
#pragma unroll
        for (int o = 16; o > 0; o >>= 1) { const float ov = __shfl_xor(bv, o); const int oi = __shfl_xor(bi, o); if (ov > bv || (ov == bv && oi < bi)) { bv = ov; bi = oi; } }
        tl[k] = bv; te[k] = bi;
        if (e == bi) logit = -INFINITY;
    }
    ev = 0; wv = 0.f; lpos = 0;
    if (e < 4) {
        const float e1 = expf(tl[1] - tl[0]), e2 = expf(tl[2] - tl[0]), e3 = expf(tl[3] - tl[0]);
        const float inv = 1.f / (1.f + e1 + e2 + e3);
        wv = (e == 0 ? 1.f : e == 1 ? e1 : e == 2 ? e2 : e3) * inv;
        ev = e == 0 ? te[0] : e == 1 ? te[1] : e == 2 ? te[2] : te[3];
        lpos = (int)__hip_atomic_fetch_add(&lcnt[ev], 1u, __ATOMIC_RELAXED, __HIP_MEMORY_SCOPE_WORKGROUP);
    }
}
__device__ __forceinline__ void moe_table(const Ctx& X, int l) {
    LAS int* tb = (LAS int*)(X.lds + TAB_OFF);
    if (X.wave == 0) {
        const unsigned* cnt = (const unsigned*)(X.ws + WS_CTL) + CW_CNT + l * 32 * 32;
        const int e = X.lane & 31;
        const int c = (int)__hip_atomic_load(cnt + e * 32, __ATOMIC_RELAXED, __HIP_MEMORY_SCOPE_AGENT), nt = (c + 255) >> 8;
        int incl = nt;
#pragma unroll
        for (int o = 1; o < 32; o <<= 1) { const int u = __shfl_up(incl, o); if (e >= o) incl += u; }
        if (X.lane < 32) { tb[e] = incl - nt; tb[40 + e] = c; if (e == 31) tb[NE] = incl; }
    }
    __syncthreads();
}
template <int MODE>
__device__ __forceinline__ void ph_token(const Params& p, const Ctx& X, int l, const float* h, float* hn) {
    if (MODE != 0) moe_table(X, l);
    const LAS int* tb = (const LAS int*)(X.lds + TAB_OFF);
    const float* modl = (const float*)(X.ws + WS_MODF) + (size_t)l * 4 * 6144;
    const float* modn = (const float*)(X.ws + WS_MODF) + (size_t)(MODE == 1 ? 1 : l) * 4 * 6144;
    const float* gain = MODE == 1 ? p.in[4] + D : p.in[5] + l * D;
    const int sc_off = MODE == 1 ? 1024 : 4096, sh_off = MODE == 1 ? 0 : 3072;
    const bf16_t* y = (const bf16_t*)(X.ws + WS_Y);
    LAS float* rsl = (LAS float*)X.lds;
    LAS float* part = (LAS float*)(X.lds + 1024);
    if (MODE == 0 && X.tid < 32) ((LAS unsigned*)(X.lds + 1024 + 65536))[X.tid] = 0u;
    for (int tile = X.bid; tile < T / 64; tile += X.G) {
        const int lane = fresh(X.lane), w = X.wave, tb0 = tile * 64, bb = tb0 / S;
        SUB_BEGIN(X, 31);
        Row ca_, cb_, cg_;
        { const float* m = modn + (size_t)bb * 6144;
#pragma unroll
          for (int j = 0; j < 4; ++j) { if (MODE != 2) { const f32x4 g = ((const f32x4*)gain)[64 * j + lane], a = ((const f32x4*)(m + sc_off))[64 * j + lane]; ca_.v[j] = g * (a + 1.f); cb_.v[j] = ((const f32x4*)(m + sh_off))[64 * j + lane]; }
                                        if (MODE != 0) cg_.v[j] = ((const f32x4*)(modl + (size_t)bb * 6144 + 5120))[64 * j + lane]; } }
        int pe_ = 0, pp_ = 0; float pw_ = 0.f;
        if (MODE != 0 && lane < 32) { const int idx = (tb0 + 8 * w) * 4 + lane; pe_ = ((const int*)(X.ws + WS_TOKE))[idx]; pp_ = ((const int*)(X.ws + WS_TOKP))[idx]; pw_ = ((const float*)(X.ws + WS_TOKW))[idx]; }
#pragma unroll 1
        for (int k2 = 0; k2 < 4; ++k2) {
            Row r[2];
#pragma unroll
            for (int u = 0; u < 2; ++u) row_load(r[u], h + (size_t)(tb0 + 8 * w + 2 * k2 + u) * D, lane);
            if (MODE != 0) {
#pragma unroll
                for (int u = 0; u < 2; ++u) {
#pragma unroll
                    for (int kk = 0; kk < 4; ++kk) {
                        const int sl = (2 * k2 + u) * 4 + kk;
                        const int e = __shfl(pe_, sl), pos = __shfl(pp_, sl); const float wt = __shfl(pw_, sl);
                        const bf16_t* yr = y + (size_t)(tb[e] * 256 + pos) * D;
#pragma unroll
                        for (int j = 0; j < 4; ++j) { const u32x2 q = ((const u32x2*)yr)[64 * j + lane]; const f32x4 gw = cg_.v[j] * wt;
                            r[u].v[j].x += gw.x * bflo(q.x); r[u].v[j].y += gw.y * bfhi(q.x); r[u].v[j].z += gw.z * bflo(q.y); r[u].v[j].w += gw.w * bfhi(q.y); }
                    }
                    row_store(r[u], hn + (size_t)(tb0 + 8 * w + 2 * k2 + u) * D, lane);
                    __builtin_amdgcn_sched_barrier(0);
                }
            }
            if (MODE != 2) {
#pragma unroll
                for (int u = 0; u < 2; ++u) {
                    float ssq = 0.f;
#pragma unroll
                    for (int j = 0; j < 4; ++j) ssq += (r[u].v[j].x * r[u].v[j].x + r[u].v[j].y * r[u].v[j].y) + (r[u].v[j].z * r[u].v[j].z + r[u].v[j].w * r[u].v[j].w);
                    const float rs = rsqrtf(wave_sum(ssq) * (1.f / 1024.f) + EPS);
                    bf16_t* uh = (bf16_t*)(X.ws + WS_U) + (size_t)(tb0 + 8 * w + 2 * k2 + u) * D; bf16_t* ul = (bf16_t*)(X.ws + WS_ULO) + (size_t)(tb0 + 8 * w + 2 * k2 + u) * D;
#pragma unroll
                    for (int j = 0; j < 4; ++j) { const f32x4 o = r[u].v[j] * rs * ca_.v[j] + cb_.v[j];
                        u32x2 hi; hi.x = pk2(o.x, o.y); hi.y = pk2(o.z, o.w); ((u32x2*)uh)[64 * j + lane] = hi;
                        u32x2 lo; lo.x = pk2(o.x - bflo(hi.x), o.y - bfhi(hi.x)); lo.y = pk2(o.z - bflo(hi.y), o.w - bfhi(hi.y)); ((u32x2*)ul)[64 * j + lane] = lo; }
                }
            }
        }
        SUB_END(X, 31);
        if (MODE == 2) continue;
        SUB_BEGIN(X, 32);
        __syncthreads();
        {
            const int ql = lane & 31, hf = lane >> 5;
            const bf16_t* wh = (const bf16_t*)(X.ws + WS_SKW) + (size_t)(MODE == 0 ? l : 2) * 2 * 32 * 1024 + (size_t)ql * 1024 + 128 * w + 8 * hf;
            const bf16_t* uh = (const bf16_t*)(X.ws + WS_U) + (size_t)(tb0 + ql) * D + 128 * w + 8 * hf; const bf16_t* ul = (const bf16_t*)(X.ws + WS_ULO) + (size_t)(tb0 + ql) * D + 128 * w + 8 * hf;
            f32x16 acc0, acc1;
#pragma unroll
            for (int i = 0; i < 16; ++i) { acc0[i] = 0.f; acc1[i] = 0.f; }
#pragma unroll 4
            for (int ks = 0; ks < 8; ++ks) {
                const bf16x8 whi = *(const bf16x8*)(wh + 16 * ks), wlo = *(const bf16x8*)(wh + 32 * 1024 + 16 * ks);
                const bf16x8 ah0 = *(const bf16x8*)(uh + 16 * ks), al0 = *(const bf16x8*)(ul + 16 * ks), ah1 = *(const bf16x8*)(uh + 32 * D + 16 * ks), al1 = *(const bf16x8*)(ul + 32 * D + 16 * ks);
                acc0 = __builtin_amdgcn_mfma_f32_32x32x16_bf16(ah0, whi, acc0, 0, 0, 0); acc0 = __builtin_amdgcn_mfma_f32_32x32x16_bf16(al0, whi, acc0, 0, 0, 0); acc0 = __builtin_amdgcn_mfma_f32_32x32x16_bf16(ah0, wlo, acc0, 0, 0, 0);
                acc1 = __builtin_amdgcn_mfma_f32_32x32x16_bf16(ah1, whi, acc1, 0, 0, 0); acc1 = __builtin_amdgcn_mfma_f32_32x32x16_bf16(al1, whi, acc1, 0, 0, 0); acc1 = __builtin_amdgcn_mfma_f32_32x32x16_bf16(ah1, wlo, acc1, 0, 0, 0);
            }
#pragma unroll
            for (int i = 0; i < 16; ++i) { const int row = 8 * (i >> 2) + 4 * hf + (i & 3); part[(w * 64 + row) * 32 + ql] = acc0[i]; part[(w * 64 + 32 + row) * 32 + ql] = acc1[i]; }
        }
        __syncthreads();
        SUB_END(X, 32);
        SUB_BEGIN(X, 33);
        {
            const int e = lane & 31, hf = lane >> 5;
            LAS unsigned* lcnt = (LAS unsigned*)(X.lds + 1024 + 65536);
            int ev[4], lp[4]; float wv[4];
#pragma unroll
            for (int k = 0; k < 4; ++k) {
                const int tl = 8 * w + 4 * hf + k;
                float v = 0.f;
#pragma unroll
                for (int ww = 0; ww < 8; ++ww) v += part[(ww * 64 + tl) * 32 + e];
                if (MODE == 0) route_select(v + p.in[25][l * NE + e], lane, lcnt, ev[k], wv[k], lp[k]);
                else ((float*)(X.ws + WS_DT))[(size_t)(tb0 + tl) * 32 + e] = v;
            }
            if (MODE == 0) {
                __syncthreads();
                if (X.tid < 32) { const unsigned n = lcnt[X.tid]; unsigned* cnt = (unsigned*)(X.ws + WS_CTL) + CW_CNT + (l * 32 + X.tid) * 32;
                    lcnt[32 + X.tid] = n ? atomicAdd(cnt, n) : 0u; }
                __syncthreads();
                if (e < 4) {
#pragma unroll
                    for (int k = 0; k < 4; ++k) { const int t = tb0 + 8 * w + 4 * hf + k, pos = (int)lcnt[32 + ev[k]] + lp[k];
                        ((int*)(X.ws + WS_TOKE))[t * 4 + e] = ev[k]; ((float*)(X.ws + WS_TOKW))[t * 4 + e] = wv[k]; ((int*)(X.ws + WS_TOKP))[t * 4 + e] = pos;
                        ((int*)(X.ws + WS_SLOT))[ev[k] * CAP + pos] = t; }
                }
            }
        }
        __syncthreads();
        SUB_END(X, 33);
        if (MODE == 0 && X.tid < 32) ((LAS unsigned*)(X.lds + 1024 + 65536))[X.tid] = 0u;
    }
}

__device__ __forceinline__ void ld64bf(const bf16_t* p, float (&q)[64]) {
#pragma unroll
    for (int i = 0; i < 8; ++i) { const u32x4 w = ((const u32x4*)p)[i];
        q[8 * i] = bflo(w.x); q[8 * i + 1] = bfhi(w.x); q[8 * i + 2] = bflo(w.y); q[8 * i + 3] = bfhi(w.y); q[8 * i + 4] = bflo(w.z); q[8 * i + 5] = bfhi(w.z); q[8 * i + 6] = bflo(w.w); q[8 * i + 7] = bfhi(w.w); }
}
__device__ __forceinline__ float dot64bf(const bf16_t* p, const float (&q)[64]) {
    float d = 0.f;
#pragma unroll
    for (int i = 0; i < 8; ++i) { const u32x4 w = ((const u32x4*)p)[i];
        d += q[8 * i] * bflo(w.x) + q[8 * i + 1] * bfhi(w.x) + q[8 * i + 2] * bflo(w.y) + q[8 * i + 3] * bfhi(w.y) + q[8 * i + 4] * bflo(w.z) + q[8 * i + 5] * bfhi(w.z) + q[8 * i + 6] * bflo(w.w) + q[8 * i + 7] * bfhi(w.w); }
    return d;
}
__device__ __forceinline__ float dot64f(const float* p, const float (&q)[64]) {
    float d = 0.f;
#pragma unroll
    for (int i = 0; i < 16; ++i) { const f32x4 w = ((const f32x4*)p)[i]; d += (q[4 * i] * w.x + q[4 * i + 1] * w.y) + (q[4 * i + 2] * w.z + q[4 * i + 3] * w.w); }
    return d;
}
__device__ __forceinline__ void sb_unit(const Ctx& X, int qt, int bh) {
    const int b = bh >> 3, hh = bh & 7, t = qt * 64 + X.lane;
    const bf16_t* base = (const bf16_t*)(X.ws + WS_BIG) + (size_t)b * S * PROJ_LD;
    float q[64], acc[64];
    ld64bf(base + (size_t)t * PROJ_LD + OFF_SBQ + hh * 64, q);
#pragma unroll
    for (int d = 0; d < 64; ++d) acc[d] = 0.f;
    float run = 0.f;
    for (int j = qt * 64 + 62; j >= 0; --j) {
        const bf16_t* kr = base + (size_t)j * PROJ_LD + OFF_SBK + hh * 64;
        const float logit = dot64bf(kr, q) * 0.125f;
        if (j < t) {
            const float w = expf(logsig(logit) + run);
            run += logsig(-logit);
            const bf16_t* vr = base + (size_t)j * PROJ_LD + OFF_SBV + hh * 64;
#pragma unroll
            for (int i = 0; i < 8; ++i) { const u32x4 v = ((const u32x4*)vr)[i];
                acc[8 * i] += w * bflo(v.x); acc[8 * i + 1] += w * bfhi(v.x); acc[8 * i + 2] += w * bflo(v.y); acc[8 * i + 3] += w * bfhi(v.y);
                acc[8 * i + 4] += w * bflo(v.z); acc[8 * i + 5] += w * bfhi(v.z); acc[8 * i + 6] += w * bflo(v.w); acc[8 * i + 7] += w * bfhi(v.w); }
        }
    }
    bf16_t* op = (bf16_t*)(X.ws + WS_O) + (size_t)(b * S + t) * D + hh * 64;
#pragma unroll
    for (int i = 0; i < 8; ++i) { u32x4 w; w.x = pk2(acc[8 * i], acc[8 * i + 1]); w.y = pk2(acc[8 * i + 2], acc[8 * i + 3]); w.z = pk2(acc[8 * i + 4], acc[8 * i + 5]); w.w = pk2(acc[8 * i + 6], acc[8 * i + 7]);
        ((u32x4*)op)[i] = w; }
}

#define DMA16(gptr, ldsptr) __builtin_amdgcn_global_load_lds((const unsigned*)(gptr), (LAS unsigned*)(ldsptr), 16, 0, 0)
#define RING2_WAIT_BAR(q, nb) do { const int issued_ = (q) + 6 < (nb) ? (q) + 6 : (nb); const int need_ = (q) + 2 < (nb) ? (q) + 2 : (nb); const int fl_ = issued_ - need_; \
        if (fl_ >= 4) asm volatile("s_waitcnt vmcnt(8)\n\ts_barrier" ::: "memory"); else if (fl_ == 3) asm volatile("s_waitcnt vmcnt(6)\n\ts_barrier" ::: "memory"); \
        else if (fl_ == 2) asm volatile("s_waitcnt vmcnt(4)\n\ts_barrier" ::: "memory"); else if (fl_ == 1) asm volatile("s_waitcnt vmcnt(2)\n\ts_barrier" ::: "memory"); \
        else asm volatile("s_waitcnt vmcnt(0)\n\ts_barrier" ::: "memory"); } while (0)
__device__ __forceinline__ int pi32(int r) { return (r & 0x13) | ((r & 4) << 1) | ((r & 8) >> 1); }
__device__ __forceinline__ void sb_attn_unit(const Ctx& X, int bh, int qb) {
    const int b = bh >> 3, h = bh & 7, q0 = qb * 256, lane = fresh(X.lane), w = X.wave, ql = lane & 31, hf = lane >> 5;
    const bf16_t* proj = (const bf16_t*)(X.ws + WS_BIG) + (size_t)b * S * PROJ_LD;
    const bf16_t* vt = (const bf16_t*)(X.ws + WS_VT) + (size_t)(h * 64) * T + (size_t)b * S;
    const int tq = q0 + 32 * w + ql;
    bf16x8 qf[4];
#pragma unroll
    for (int s = 0; s < 4; ++s) qf[s] = *(const bf16x8*)(proj + (size_t)tq * PROJ_LD + OFF_SBQ + h * 64 + 16 * s + 8 * hf);
    f32x16 o0, o1;
#pragma unroll
    for (int i = 0; i < 16; ++i) { o0[i] = 0.f; o1[i] = 0.f; }
    float run = 1.f;
    const int nblk = 4 * qb + 4, jw = (q0 + 32 * w + 30) >> 6;
    const float CS = 0.125f * 1.4426950408889634f;
    const bf16_t* kg = proj + (size_t)lane * PROJ_LD + OFF_SBK + h * 64 + 8 * w;
    const bf16_t* vg = vt + (size_t)lane * T + 8 * w;
    LAS unsigned char* ring = X.lds + w * 1024;
    const int krow = pi32(ql) * 16;
    asm volatile("s_waitcnt vmcnt(0)" ::: "memory");
#pragma unroll
    for (int d = 0; d < 6; ++d) if (d < nblk) { DMA16(kg + (size_t)(64 * (nblk - 1 - d)) * PROJ_LD, ring + d * 16384); DMA16(vg + 64 * (nblk - 1 - d), ring + d * 16384 + 8192); }
    for (int q = 0; q < nblk; ++q) {
        const int j = nblk - 1 - q;
        if ((q & 1) == 0) {
            SUB_BEGIN(X, 11);
            RING2_WAIT_BAR(q, nblk);
            SUB_END(X, 11);
#pragma unroll
            for (int d = 6; d < 8; ++d) if (q + d < nblk) { const int jj = nblk - 1 - (q + d), sl = (q + d) & 7; DMA16(kg + (size_t)(64 * jj) * PROJ_LD, ring + sl * 16384); DMA16(vg + 64 * jj, ring + sl * 16384 + 8192); }
        }
        LAS unsigned char* buf = X.lds + (q & 7) * 16384;
        SUB_BEGIN(X, 12);
        if (j <= jw) {
            const bool diag = 64 * j + 63 >= q0 + 32 * w;
#pragma unroll
            for (int kt = 1; kt >= 0; --kt) {
                f32x16 sc;
#pragma unroll
                for (int i = 0; i < 16; ++i) sc[i] = 0.f;
#pragma unroll
                for (int s = 0; s < 4; ++s) { const bf16x8 kf = *(const LAS bf16x8*)(buf + (2 * s + hf) * 1024 + kt * 512 + krow); sc = __builtin_amdgcn_mfma_f32_32x32x16_bf16(kf, qf[s], sc, 0, 0, 0); }
                f32x16 ee = sc * (-CS), be, kp;
#pragma unroll
                for (int i = 0; i < 16; ++i) ee[i] = __builtin_amdgcn_exp2f(ee[i]);
                be = ee + 1.f;
#pragma unroll
                for (int i = 0; i < 16; ++i) be[i] = __builtin_amdgcn_rcpf(be[i]);
                kp = ee * be;
                if (diag) {
                    asm volatile("; diagonal block: masks" ::: "memory");
                    const int pos0 = 64 * j + 32 * kt + 8 * hf;
#pragma unroll
                    for (int i = 0; i < 16; ++i) { const bool valid = (pos0 + 16 * (i >> 3) + (i & 7)) < tq; be[i] = valid ? be[i] : 0.f; kp[i] = valid ? kp[i] : 1.f; }
                }
                float l1 = 1.f, l0 = 1.f;
#pragma unroll
                for (int i = 15; i >= 8; --i) { const float t = be[i] * l1; l1 *= kp[i]; be[i] = t; }
#pragma unroll
                for (int i = 7; i >= 0; --i) { const float t = be[i] * l0; l0 *= kp[i]; be[i] = t; }
                const float p1 = __shfl_xor(l1, 32), p0 = __shfl_xor(l0, 32);
                const float hi1 = hf ? l1 : p1, lo1 = hf ? p1 : l1, hi0 = hf ? l0 : p0, lo0 = hf ? p0 : l0;
                const float r1 = run * hi1, r2 = r1 * lo1, r3 = r2 * hi0;
                const float pre_up = hf ? run : r1, pre_lo = hf ? r2 : r3;
                run = r3 * lo0;
#pragma unroll
                for (int a = 0; a < 2; ++a) {
                    const float pre = a ? pre_up : pre_lo;
                    u32x4 pw; pw.x = pk2(be[8 * a] * pre, be[8 * a + 1] * pre); pw.y = pk2(be[8 * a + 2] * pre, be[8 * a + 3] * pre); pw.z = pk2(be[8 * a + 4] * pre, be[8 * a + 5] * pre); pw.w = pk2(be[8 * a + 6] * pre, be[8 * a + 7] * pre);
                    const bf16x8 pf = __builtin_bit_cast(bf16x8, pw);
                    const bf16x8 v0 = *(const LAS bf16x8*)(buf + 8192 + (4 * kt + 2 * a + hf) * 1024 + ql * 16);
                    const bf16x8 v1 = *(const LAS bf16x8*)(buf + 8192 + (4 * kt + 2 * a + hf) * 1024 + 512 + ql * 16);
                    o0 = __builtin_amdgcn_mfma_f32_32x32x16_bf16(v0, pf, o0, 0, 0, 0);
                    o1 = __builtin_amdgcn_mfma_f32_32x32x16_bf16(v1, pf, o1, 0, 0, 0);
                }
            }
        }
        SUB_END(X, 12);
    }
    asm volatile("s_barrier" ::: "memory");
    bf16_t* op = (bf16_t*)(X.ws + WS_O) + (size_t)(b * S + fresh(tq)) * D + h * 64 + 4 * hf;
#pragma unroll
    for (int g4 = 0; g4 < 4; ++g4) {
        u32x2 w0; w0.x = pk2(o0[4 * g4], o0[4 * g4 + 1]); w0.y = pk2(o0[4 * g4 + 2], o0[4 * g4 + 3]); *(u32x2*)(op + 8 * g4) = w0;
        u32x2 w1; w1.x = pk2(o1[4 * g4], o1[4 * g4 + 1]); w1.y = pk2(o1[4 * g4 + 2], o1[4 * g4 + 3]); *(u32x2*)(op + 32 + 8 * g4) = w1;
    }
}
__device__ __forceinline__ void ph_sb(const Ctx& X) {
    for (int pr = X.bid; pr < 256; pr += X.G)
#pragma unroll 1
        for (int u = 0; u < 2; ++u) { const int bh = pr >> 3, qa = pr & 7; sb_attn_unit(X, bh, u ? qa : 15 - qa); }
}
__device__ __forceinline__ void ph_attn_a(const Params& p, const Ctx& X) {
    const bf16_t* proj = (const bf16_t*)(X.ws + WS_BIG);
    for (int unit = X.bid; unit < 128; unit += X.G) {
        const int kv = unit >> 6, bg = (unit >> 3) & 7, ntile = unit & 7, b = bg >> 1, g = bg & 1, lane = fresh(X.lane), w = X.wave, ql = lane & 31, hf = lane >> 5;
        const int n = min(32 * ntile + ql, NCMP - 1);
        const float* pe = kv ? p.in[11] : p.in[10];
        const bf16_t* w1t = (const bf16_t*)(X.ws + WS_W1T) + (size_t)kv * 128 * 2048;
        const bf16_t* arow = proj + (size_t)(b * S + n * 16) * PROJ_LD + (kv ? OFF_VC : OFF_KC) + g * 64;
        f32x16 acc[4];
#pragma unroll
        for (int ct = 0; ct < 4; ++ct)
#pragma unroll
            for (int i = 0; i < 16; ++i) acc[ct][i] = 0.f;
        for (int ks = 0; ks < 16; ++ks) {
            const int k0 = 256 * w + 16 * ks + 8 * hf, l = k0 >> 6, d = k0 & 63;
            const u32x4 q = *(const u32x4*)(arow + (size_t)l * PROJ_LD + d);
            const f32x4 e0 = *(const f32x4*)(pe + k0), e1 = *(const f32x4*)(pe + k0 + 4);
            u32x4 o; o.x = pk2(bflo(q.x) + e0.x, bfhi(q.x) + e0.y); o.y = pk2(bflo(q.y) + e0.z, bfhi(q.y) + e0.w); o.z = pk2(bflo(q.z) + e1.x, bfhi(q.z) + e1.y); o.w = pk2(bflo(q.w) + e1.z, bfhi(q.w) + e1.w);
            const bf16x8 af = __builtin_bit_cast(bf16x8, o);
#pragma unroll
            for (int ct = 0; ct < 4; ++ct) acc[ct] = __builtin_amdgcn_mfma_f32_32x32x16_bf16(af, *(const bf16x8*)(w1t + (size_t)(32 * ct + ql) * 2048 + k0), acc[ct], 0, 0, 0);
        }
        LAS float* part = (LAS float*)X.lds;
#pragma unroll
        for (int ct = 0; ct < 4; ++ct)
#pragma unroll
            for (int i = 0; i < 16; ++i) part[w * 4096 + (8 * (i >> 2) + 4 * hf + (i & 3)) * 128 + 32 * ct + ql] = acc[ct][i];
        __syncthreads();
        LAS float* hid = part;
        {
            const int tidf = fresh(X.tid);
#pragma unroll
            for (int k = 0; k < 8; ++k) { const int e = tidf + NTHREADS * k; float v = 0.f;
#pragma unroll
                for (int ww = 0; ww < 8; ++ww) v += part[ww * 4096 + e];
                hid[e] = siluf(v); }
        }
        __syncthreads();
        {
            const int tidf = fresh(X.tid), row = tidf >> 4, c4 = (tidf & 15) * 4;
            const float* w2 = kv ? p.in[15] : p.in[13];
            f32x4 o = (f32x4){0.f, 0.f, 0.f, 0.f};
            for (int j = 0; j < 128; ++j) o = o + *(const f32x4*)(w2 + j * 64 + c4) * hid[row * 128 + j];
            const int nn = 32 * ntile + row;
            if (kv == 0) {
                float ssq = (o.x * o.x + o.y * o.y) + (o.z * o.z + o.w * o.w);
                ssq += __shfl_xor(ssq, 1); ssq += __shfl_xor(ssq, 2); ssq += __shfl_xor(ssq, 4); ssq += __shfl_xor(ssq, 8);
                const float r = rsqrtf(ssq * (1.f / 64.f) + EPS); const f32x4 gn = *(const f32x4*)(p.in[9] + c4);
                o = o * r * gn;
                if (nn >= NCMP) o = (f32x4){0.f, 0.f, 0.f, 0.f};
                u32x2 wv; wv.x = pk2(o.x, o.y); wv.y = pk2(o.z, o.w);
                *(u32x2*)((bf16_t*)(X.ws + WS_KCB) + ((size_t)bg * 256 + nn) * 64 + c4) = wv;
            } else {
                if (nn >= NCMP) o = (f32x4){0.f, 0.f, 0.f, 0.f};
                bf16_t* vt = (bf16_t*)(X.ws + WS_VCT) + ((size_t)bg * 64 + c4) * 256 + nn;
                vt[0] = (bf16_t)f2bf(o.x); vt[256] = (bf16_t)f2bf(o.y); vt[512] = (bf16_t)f2bf(o.z); vt[768] = (bf16_t)f2bf(o.w);
            }
        }
        __syncthreads();
    }
    for (int t2 = X.gw; t2 < T / 2; t2 += X.ngw) {
        const int lane = fresh(X.lane), sub = lane & 7;
#pragma unroll
        for (int k = 0; k < 2; ++k) {
            const int t = 2 * t2 + k;
            const u32x4 q = *(const u32x4*)(proj + (size_t)t * PROJ_LD + OFF_NQ + 8 * lane);
            float v[8] = {bflo(q.x), bfhi(q.x), bflo(q.y), bfhi(q.y), bflo(q.z), bfhi(q.z), bflo(q.w), bfhi(q.w)};
            float ssq = 0.f;
#pragma unroll
            for (int i = 0; i < 8; ++i) ssq += v[i] * v[i];
            ssq += __shfl_xor(ssq, 1); ssq += __shfl_xor(ssq, 2); ssq += __shfl_xor(ssq, 4);
            const float r = rsqrtf(ssq * (1.f / 64.f) + EPS) * (0.125f * 1.4426950408889634f);
            const f32x4 g0 = *(const f32x4*)(p.in[8] + 8 * sub), g1 = *(const f32x4*)(p.in[8] + 8 * sub + 4);
            u32x4 o; o.x = pk2(v[0] * r * g0.x, v[1] * r * g0.y); o.y = pk2(v[2] * r * g0.z, v[3] * r * g0.w); o.z = pk2(v[4] * r * g1.x, v[5] * r * g1.y); o.w = pk2(v[6] * r * g1.z, v[7] * r * g1.w);
            *(u32x4*)((bf16_t*)(X.ws + WS_QNB) + (size_t)t * 512 + 8 * lane) = o;
        }
        {
            const int t = 2 * t2 + (lane >> 5), l32 = lane & 31, isw = l32 >> 4, c = 8 * (l32 & 15);
            const u32x4 q = *(const u32x4*)(proj + (size_t)t * PROJ_LD + (isw ? OFF_KW : OFF_KS) + c);
            float v[8] = {bflo(q.x), bfhi(q.x), bflo(q.y), bfhi(q.y), bflo(q.z), bfhi(q.z), bflo(q.w), bfhi(q.w)};
            float ssq = 0.f;
#pragma unroll
            for (int i = 0; i < 8; ++i) ssq += v[i] * v[i];
            ssq += __shfl_xor(ssq, 1); ssq += __shfl_xor(ssq, 2); ssq += __shfl_xor(ssq, 4);
            const float r = rsqrtf(ssq * (1.f / 64.f) + EPS);
            const float* gn = p.in[9] + (isw ? 128 : 64) + 8 * sub;
            const f32x4 g0 = *(const f32x4*)gn, g1 = *(const f32x4*)(gn + 4);
            u32x4 o; o.x = pk2(v[0] * r * g0.x, v[1] * r * g0.y); o.y = pk2(v[2] * r * g0.z, v[3] * r * g0.w); o.z = pk2(v[4] * r * g1.x, v[5] * r * g1.y); o.w = pk2(v[6] * r * g1.z, v[7] * r * g1.w);
            *(u32x4*)((bf16_t*)(X.ws + (isw ? WS_KWN : WS_KSN)) + (size_t)t * 128 + c) = o;
        }
    }
}
struct NsaSt { f32x16 o0, o1; float m, l; };
template <int MODE>
__device__ __forceinline__ void nsa_flash(const Ctx& X, const bf16_t* kg, const bf16_t* vg, int jlo, int jhi, const bf16x8 (&qf)[4], int tq, float slope2,
                                          unsigned long long mymask, unsigned long long wavemask, NsaSt& st) {
    const int lane = fresh(X.lane), w = X.wave, ql = lane & 31, hf = lane >> 5;
    LAS unsigned char* ring = X.lds + w * 1024;
    const int krow = pi32(ql) * 16, nb = jhi - jlo + 1;
    asm volatile("s_waitcnt vmcnt(0)" ::: "memory");
#pragma unroll
    for (int d = 0; d < 6; ++d) if (d < nb) { DMA16(kg + (size_t)(64 * (jhi - d)) * 128, ring + d * 16384); DMA16(vg + 64 * (jhi - d), ring + d * 16384 + 8192); }
    f32x16 sl;
#pragma unroll
    for (int i = 0; i < 16; ++i) sl[i] = slope2 * (float)(16 * (i >> 3) + (i & 7));
    const float k32 = slope2 * 32.f;
    for (int q = 0; q < nb; ++q) {
        const int j = jhi - q;
        if ((q & 1) == 0) {
            SUB_BEGIN(X, 21);
            RING2_WAIT_BAR(q, nb);
            SUB_END(X, 21);
#pragma unroll
            for (int d = 6; d < 8; ++d) if (q + d < nb) { const int jj = jhi - (q + d), sl2 = (q + d) & 7; DMA16(kg + (size_t)(64 * jj) * 128, ring + sl2 * 16384); DMA16(vg + 64 * jj, ring + sl2 * 16384 + 8192); }
        }
        LAS unsigned char* buf = X.lds + (q & 7) * 16384;
        SUB_BEGIN(X, 22);
        if (MODE == 1 || ((wavemask >> j) & 1ull)) {
            f32x16 s0, s1;
#pragma unroll
            for (int i = 0; i < 16; ++i) { s0[i] = 0.f; s1[i] = 0.f; }
#pragma unroll
            for (int s = 0; s < 4; ++s) {
                const bf16x8 k0 = *(const LAS bf16x8*)(buf + (2 * s + hf) * 1024 + krow), k1 = *(const LAS bf16x8*)(buf + (2 * s + hf) * 1024 + 512 + krow);
                s0 = __builtin_amdgcn_mfma_f32_32x32x16_bf16(k0, qf[s], s0, 0, 0, 0); s1 = __builtin_amdgcn_mfma_f32_32x32x16_bf16(k1, qf[s], s1, 0, 0, 0);
            }
            const int d0 = tq - (64 * j + 8 * hf);
            if (j == jhi || (MODE == 1 && j == jlo)) {
                asm volatile("; boundary block: masks" ::: "memory");
#pragma unroll
                for (int i = 0; i < 16; ++i) {
                    const int da = d0 - (16 * (i >> 3) + (i & 7)), db = da - 32;
                    s0[i] = (da >= 0 && (MODE == 0 || da < 512)) ? s0[i] : -INFINITY; s1[i] = (db >= 0 && (MODE == 0 || db < 512)) ? s1[i] : -INFINITY;
                }
            }
            s0 = s0 + sl; s1 = s1 + sl;
            float mb0 = fmaxf(s0[0], s0[1]), mb1 = fmaxf(s1[0], s1[1]);
#pragma unroll
            for (int i = 2; i < 16; ++i) { mb0 = fmaxf(mb0, s0[i]); mb1 = fmaxf(mb1, s1[i]); }
            const float base = slope2 * (float)d0;
            const bool sel = MODE == 1 || ((mymask >> j) & 1ull);
            float mb = fmaxf(mb0, mb1 + k32) - base;
            mb = sel ? mb : -INFINITY;
            mb = fmaxf(mb, __shfl_xor(mb, 32));
            const float mn = fmaxf(st.m, mb), ms = mn == -INFINITY ? 0.f : mn;
            if (__any(mn > st.m)) {
                const float alpha = __builtin_amdgcn_exp2f(st.m - ms);
                st.l *= alpha;
#pragma unroll
                for (int i = 0; i < 16; ++i) { st.o0[i] *= alpha; st.o1[i] *= alpha; }
                st.m = mn;
            }
            const float off0 = sel ? ms + base : INFINITY, off1 = off0 - k32;
            s0 = s0 - off0; s1 = s1 - off1;
            float ls = 0.f;
#pragma unroll
            for (int i = 0; i < 16; ++i) { s0[i] = __builtin_amdgcn_exp2f(s0[i]); s1[i] = __builtin_amdgcn_exp2f(s1[i]); ls += s0[i] + s1[i]; }
            st.l += ls;
#pragma unroll
            for (int kt = 0; kt < 2; ++kt)
#pragma unroll
                for (int a = 0; a < 2; ++a) {
                    u32x4 pw;
                    if (kt == 0) { pw.x = pk2(s0[8 * a], s0[8 * a + 1]); pw.y = pk2(s0[8 * a + 2], s0[8 * a + 3]); pw.z = pk2(s0[8 * a + 4], s0[8 * a + 5]); pw.w = pk2(s0[8 * a + 6], s0[8 * a + 7]); }
                    else { pw.x = pk2(s1[8 * a], s1[8 * a + 1]); pw.y = pk2(s1[8 * a + 2], s1[8 * a + 3]); pw.z = pk2(s1[8 * a + 4], s1[8 * a + 5]); pw.w = pk2(s1[8 * a + 6], s1[8 * a + 7]); }
                    const bf16x8 pf = __builtin_bit_cast(bf16x8, pw);
                    const bf16x8 v0 = *(const LAS bf16x8*)(buf + 8192 + (4 * kt + 2 * a + hf) * 1024 + ql * 16);
                    const bf16x8 v1 = *(const LAS bf16x8*)(buf + 8192 + (4 * kt + 2 * a + hf) * 1024 + 512 + ql * 16);
                    st.o0 = __builtin_amdgcn_mfma_f32_32x32x16_bf16(v0, pf, st.o0, 0, 0, 0);
                    st.o1 = __builtin_amdgcn_mfma_f32_32x32x16_bf16(v1, pf, st.o1, 0, 0, 0);
                }
        }
        SUB_END(X, 22);
    }
    asm volatile("s_barrier" ::: "memory");
}
__device__ __forceinline__ void nsa_unit(const Ctx& X, int bg, int qb) {
    const int b = bg >> 1, g = bg & 1, lane = fresh(X.lane), w = X.wave, ql = lane & 31, hf = lane >> 5, r = ql >> 3, hh = g * 4 + r;
    const int t0 = 64 * qb, tq = t0 + 8 * w + (ql & 7);
    const float slope2 = exp2f(-(float)(hh + 1)) * 1.4426950408889634f;
    const bf16_t* proj = (const bf16_t*)(X.ws + WS_BIG);
    bf16x8 qf[4];
    { const bf16_t* qp = (const bf16_t*)(X.ws + WS_QNB) + (size_t)(b * S + tq) * 512 + hh * 64 + 8 * hf;
#pragma unroll
      for (int s = 0; s < 4; ++s) qf[s] = *(const bf16x8*)(qp + 16 * s); }
    float gate[3];
    { const bf16_t* gp = proj + (size_t)(b * S + tq) * PROJ_LD + OFF_GATE + hh * 3;
#pragma unroll
      for (int i = 0; i < 3; ++i) gate[i] = 1.f / (1.f + __expf(-bf2f(gp[i]))); }
    f32x16 of0, of1;
#pragma unroll
    for (int i = 0; i < 16; ++i) { of0[i] = 0.f; of1[i] = 0.f; }
    NsaSt st;
    SUB_BEGIN(X, 23);
    LAS float* pacc = (LAS float*)(X.lds + 65536) + w * 2048;
    {
        const int ncm = t0 + 63 >= 31 ? (t0 + 63 - 31) / 16 + 1 : 0, nt = (ncm + 31) >> 5, ncv = tq >= 31 ? (tq - 31) / 16 + 1 : 0;
        {
            const bf16_t* kc = (const bf16_t*)(X.ws + WS_KCB) + (size_t)bg * 256 * 64; const bf16_t* vc = (const bf16_t*)(X.ws + WS_VCT) + (size_t)bg * 64 * 256;
            const int tidf = fresh(X.tid);
#pragma unroll
            for (int i = 0; i < 4; ++i) { const int pidx = tidf + NTHREADS * i;
                *(LAS u32x4*)(X.lds + (pidx >> 8) * 4096 + (pidx & 255) * 16) = *(const u32x4*)(kc + (size_t)(pidx & 255) * 64 + 8 * (pidx >> 8));
                *(LAS u32x4*)(X.lds + 32768 + (pidx >> 6) * 1024 + (pidx & 63) * 16) = *(const u32x4*)(vc + (size_t)(pidx & 63) * 256 + 8 * (pidx >> 6)); }
#pragma unroll
            for (int i = 0; i < 8; ++i) *(LAS f32x4*)(pacc + (i * 64 + lane) * 4) = (f32x4){0.f, 0.f, 0.f, 0.f};
        }
        __syncthreads();
        const int krow = pi32(ql) * 16;
        float ml = -INFINITY, ll = 0.f;
        for (int kt = 0; kt < nt; ++kt) {
            f32x16 sc;
#pragma unroll
            for (int i = 0; i < 16; ++i) sc[i] = 0.f;
#pragma unroll
            for (int s = 0; s < 4; ++s) { const bf16x8 kf = *(const LAS bf16x8*)(X.lds + (2 * s + hf) * 4096 + kt * 512 + krow); sc = __builtin_amdgcn_mfma_f32_32x32x16_bf16(kf, qf[s], sc, 0, 0, 0); }
            float tm = -INFINITY;
#pragma unroll
            for (int i = 0; i < 16; ++i) { const int n = 32 * kt + 16 * (i >> 3) + 8 * hf + (i & 7);
                sc[i] = n < ncv ? sc[i] - slope2 * (float)(tq - (16 * n + 31)) : -INFINITY; tm = fmaxf(tm, sc[i]); }
            const float mn = fmaxf(ml, tm), ms = mn == -INFINITY ? 0.f : mn;
            float ls = 0.f;
#pragma unroll
            for (int i = 0; i < 16; ++i) ls += __builtin_amdgcn_exp2f(sc[i] - ms);
            ll = ll * __builtin_amdgcn_exp2f(ml - ms) + ls; ml = mn;
        }
        float ms, inv;
        { const float mo = __shfl_xor(ml, 32), lo = __shfl_xor(ll, 32), mt = fmaxf(ml, mo); ms = mt == -INFINITY ? 0.f : mt;
          const float lt = ll * __builtin_amdgcn_exp2f(ml - ms) + lo * __builtin_amdgcn_exp2f(mo - ms); inv = lt > 0.f ? 1.f / lt : 0.f; }
#pragma unroll
        for (int i = 0; i < 16; ++i) { st.o0[i] = 0.f; st.o1[i] = 0.f; }
        float carry = 0.f;
        for (int kt = 0; kt < nt; ++kt) {
            f32x16 sc;
#pragma unroll
            for (int i = 0; i < 16; ++i) sc[i] = 0.f;
#pragma unroll
            for (int s = 0; s < 4; ++s) { const bf16x8 kf = *(const LAS bf16x8*)(X.lds + (2 * s + hf) * 4096 + kt * 512 + krow); sc = __builtin_amdgcn_mfma_f32_32x32x16_bf16(kf, qf[s], sc, 0, 0, 0); }
#pragma unroll
            for (int i = 0; i < 16; ++i) { const int n = 32 * kt + 16 * (i >> 3) + 8 * hf + (i & 7);
                sc[i] = n < ncv ? __builtin_amdgcn_exp2f(sc[i] - slope2 * (float)(tq - (16 * n + 31)) - ms) * inv : 0.f; }
            const float pa0 = __shfl_xor(sc[7], 32), pa1 = __shfl_xor(sc[15], 32);
            const float prev0 = hf ? pa0 : carry, prev1 = hf ? pa1 : pa0;
            carry = pa1;
            {
                typedef float f32x2 __attribute__((ext_vector_type(2)));
                f32x2 e0, e1;
                e0.x = prev0 + ((sc[0] + sc[1]) + (sc[2] + sc[3])); e0.y = sc[3] + ((sc[4] + sc[5]) + (sc[6] + sc[7]));
                e1.x = prev1 + ((sc[8] + sc[9]) + (sc[10] + sc[11])); e1.y = sc[11] + ((sc[12] + sc[13]) + (sc[14] + sc[15]));
                *(LAS f32x2*)(pacc + ql * 64 + 8 * kt + 2 * hf) = e0; *(LAS f32x2*)(pacc + ql * 64 + 8 * kt + 4 + 2 * hf) = e1;
            }
#pragma unroll
            for (int a = 0; a < 2; ++a) {
                u32x4 pw; pw.x = pk2(sc[8 * a], sc[8 * a + 1]); pw.y = pk2(sc[8 * a + 2], sc[8 * a + 3]); pw.z = pk2(sc[8 * a + 4], sc[8 * a + 5]); pw.w = pk2(sc[8 * a + 6], sc[8 * a + 7]);
                const bf16x8 pf = __builtin_bit_cast(bf16x8, pw);
                const bf16x8 v0 = *(const LAS bf16x8*)(X.lds + 32768 + (4 * kt + 2 * a + hf) * 1024 + ql * 16);
                const bf16x8 v1 = *(const LAS bf16x8*)(X.lds + 32768 + (4 * kt + 2 * a + hf) * 1024 + 512 + ql * 16);
                st.o0 = __builtin_amdgcn_mfma_f32_32x32x16_bf16(v0, pf, st.o0, 0, 0, 0);
                st.o1 = __builtin_amdgcn_mfma_f32_32x32x16_bf16(v1, pf, st.o1, 0, 0, 0);
            }
        }
#pragma unroll
        for (int i = 0; i < 16; ++i) { of0[i] = gate[0] * st.o0[i]; of1[i] = gate[0] * st.o1[i]; }
    }
    SUB_END(X, 23);
    SUB_BEGIN(X, 24);
    unsigned long long mymask = 0ull, wavemask = 0ull;
    LDS_WAIT();
    for (int q8 = 0; q8 < 8; ++q8) {
        const int t = t0 + 8 * w + q8;
        const float ps = (pacc[(0 * 8 + q8) * 64 + lane] + pacc[(1 * 8 + q8) * 64 + lane]) + (pacc[(2 * 8 + q8) * 64 + lane] + pacc[(3 * 8 + q8) * 64 + lane]);
        const bool valid = lane * 64 <= t, forced = (lane == 0) || (lane == qb) || (lane == qb - 1);
        const unsigned key = valid ? ((forced ? 0x7f000000u : (__float_as_uint(fmaxf(ps, 0.f)) & ~63u)) | (unsigned)(63 - lane)) : 0u;
        unsigned thr = 0u;
#pragma unroll 1
        for (int bit = 30; bit >= 0; --bit) { const unsigned cand = thr | (1u << bit); if (__builtin_popcountll(__ballot(key >= cand)) >= 16) thr = cand; }
        const unsigned long long mk = __ballot(key >= thr && key != 0u);
        wavemask |= mk; if ((ql & 7) == q8) mymask = mk;
    }
    SUB_END(X, 24);
    __syncthreads();
    {
#pragma unroll
        for (int i = 0; i < 16; ++i) { st.o0[i] = 0.f; st.o1[i] = 0.f; }
        st.m = -INFINITY; st.l = 0.f;
        const int lf = fresh(lane);
        const bf16_t* kg = (const bf16_t*)(X.ws + WS_KSN) + ((size_t)b * S + lf) * 128 + g * 64 + 8 * w;
        const bf16_t* vg = (const bf16_t*)(X.ws + WS_VT) + (size_t)(512 + g * 64 + lf) * T + (size_t)b * S + 8 * w;
        nsa_flash<0>(X, kg, vg, 0, qb, qf, tq, slope2, mymask, wavemask, st);
        const float lt = st.l + __shfl_xor(st.l, 32), sc = gate[1] / fmaxf(lt, 1e-30f);
#pragma unroll
        for (int i = 0; i < 16; ++i) { of0[i] += sc * st.o0[i]; of1[i] += sc * st.o1[i]; }
    }
    {
#pragma unroll
        for (int i = 0; i < 16; ++i) { st.o0[i] = 0.f; st.o1[i] = 0.f; }
        st.m = -INFINITY; st.l = 0.f;
        const int lf = fresh(lane);
        const bf16_t* kg = (const bf16_t*)(X.ws + WS_KWN) + ((size_t)b * S + lf) * 128 + g * 64 + 8 * w;
        const bf16_t* vg = (const bf16_t*)(X.ws + WS_VT) + (size_t)(640 + g * 64 + lf) * T + (size_t)b * S + 8 * w;
        nsa_flash<1>(X, kg, vg, qb >= 8 ? qb - 8 : 0, qb, qf, tq, slope2, 0ull, 0ull, st);
        const float lt = st.l + __shfl_xor(st.l, 32), sc = gate[2] / fmaxf(lt, 1e-30f);
#pragma unroll
        for (int i = 0; i < 16; ++i) { of0[i] += sc * st.o0[i]; of1[i] += sc * st.o1[i]; }
    }
    bf16_t* op = (bf16_t*)(X.ws + WS_O) + (size_t)(b * S + fresh(tq)) * D + 512 + hh * 64 + 4 * hf;
#pragma unroll
    for (int g4 = 0; g4 < 4; ++g4) {
        u32x2 w0; w0.x = pk2(of0[4 * g4], of0[4 * g4 + 1]); w0.y = pk2(of0[4 * g4 + 2], of0[4 * g4 + 3]); *(u32x2*)(op + 8 * g4) = w0;
        u32x2 w1; w1.x = pk2(of1[4 * g4], of1[4 * g4 + 1]); w1.y = pk2(of1[4 * g4 + 2], of1[4 * g4 + 3]); *(u32x2*)(op + 32 + 8 * g4) = w1;
    }
}
__device__ __forceinline__ void ph_nsa(const Params& p, const Ctx& X) {
    for (int pr = X.bid; pr < 256; pr += X.G)
#pragma unroll 1
        for (int u = 0; u < 2; ++u) { const int bg = pr >> 5, qa = pr & 31; nsa_unit(X, bg, u ? qa : 63 - qa); }
}

__device__ __forceinline__ float silu_fast(float v) { return v * __builtin_amdgcn_rcpf(1.f + __expf(-v)); }
constexpr int S1_WL = RING_BYTES + 4096;
__device__ __forceinline__ void ph_ssd1(const Params& p, const Ctx& X) {
    const float* cw = p.in[17]; const float* cb = p.in[18];
    LAS float* wl = (LAS float*)(X.lds + S1_WL);
    LAS unsigned char* ldsB = X.lds;
    LAS unsigned char* ldsX = X.lds + 65536;
    for (int unit = X.bid; unit < 256; unit += X.G) {
        const int b = unit >> 6, c = (unit >> 2) & 15, g = unit & 3, tl0 = c * 256, lane = fresh(X.lane), w = X.wave, ql = lane & 31, hf = lane >> 5;
        const size_t t0 = (size_t)b * S + tl0;
        SUB_BEGIN(X, 41);
        {
            const int h = g * 8 + w;
            const float a = -expf(p.in[20][h]), dtb = p.in[19][h];
            const float* dr = (const float*)(X.ws + WS_DT) + (t0 + 4 * lane) * 32 + h;
            float dt[4], cs[4];
#pragma unroll
            for (int k = 0; k < 4; ++k) { const float raw = dr[k * 32] + dtb; dt[k] = raw > 20.f ? raw : log1pf(expf(raw)); }
            cs[0] = dt[0] * a; cs[1] = cs[0] + dt[1] * a; cs[2] = cs[1] + dt[2] * a; cs[3] = cs[2] + dt[3] * a;
            float incl = cs[3];
#pragma unroll
            for (int o = 1; o < 64; o <<= 1) { const float u = __shfl_up(incl, o); if (lane >= o) incl += u; }
            const float excl = incl - cs[3], last = __shfl(incl, 63);
#pragma unroll
            for (int k = 0; k < 4; ++k) cs[k] += excl;
            *(f32x4*)((float*)(X.ws + WS_DT2) + (size_t)(b * 32 + h) * S + tl0 + 4 * lane) = (f32x4){dt[0], dt[1], dt[2], dt[3]};
            *(f32x4*)((float*)(X.ws + WS_CS) + (size_t)(b * 32 + h) * S + tl0 + 4 * lane) = (f32x4){cs[0], cs[1], cs[2], cs[3]};
            *(LAS f32x4*)(wl + w * 256 + 4 * lane) = (f32x4){dt[0] * __expf(last - cs[0]), dt[1] * __expf(last - cs[1]), dt[2] * __expf(last - cs[2]), dt[3] * __expf(last - cs[3])};
            if (lane == 63) ((float*)(X.ws + WS_DEC))[(b * 16 + c) * 32 + h] = __expf(last);
        }
        const bf16_t* xt = (const bf16_t*)(X.ws + WS_XT); bf16_t* xct = (bf16_t*)(X.ws + WS_XCT);
        const int tidf = fresh(X.tid);
#define CONV8(rin, chg, seg, o) do { const bf16_t* src_ = xt + (size_t)(rin) * T + t0 + 8 * (seg); const u32x4 cur_ = *(const u32x4*)src_; u32x4 prv_ = (u32x4){0u, 0u, 0u, 0u}; \
            if (tl0 + 8 * (seg) >= 8) prv_ = *(const u32x4*)(src_ - 8); \
            const float x_[11] = {bfhi(prv_.z), bflo(prv_.w), bfhi(prv_.w), bflo(cur_.x), bfhi(cur_.x), bflo(cur_.y), bfhi(cur_.y), bflo(cur_.z), bfhi(cur_.z), bflo(cur_.w), bfhi(cur_.w)}; \
            const float w0_ = cw[chg], w1_ = cw[CONV_DIM + (chg)], w2_ = cw[2 * CONV_DIM + (chg)], w3_ = cw[3 * CONV_DIM + (chg)], bb_ = cb[chg]; \
            _Pragma("unroll") for (int j_ = 0; j_ < 8; ++j_) o[j_] = silu_fast(bb_ + w0_ * x_[j_] + w1_ * x_[j_ + 1] + w2_ * x_[j_ + 2] + w3_ * x_[j_ + 3]); } while (0)
        SUB_END(X, 41);
        SUB_BEGIN(X, 42);
        {
#pragma unroll
            for (int k = 0; k < 8; ++k) {
                const int it = tidf + NTHREADS * k, n = it >> 5, seg = it & 31, chg = 2048 + g * 128 + n;
                float o[8]; CONV8(g * 128 + n, chg, seg, o);
                u32x4 ov; ov.x = pk2(o[0], o[1]); ov.y = pk2(o[2], o[3]); ov.z = pk2(o[4], o[5]); ov.w = pk2(o[6], o[7]);
                *(u32x4*)(xct + (size_t)chg * T + t0 + 8 * seg) = ov;
                *(LAS u32x4*)(ldsB + seg * 2048 + n * 16) = ov;
            }
            SUB_END(X, 42);
            SUB_BEGIN(X, 43);
            const bf16_t* zbc = (const bf16_t*)(X.ws + WS_ZBC); bf16_t* bcm = (bf16_t*)(X.ws + WS_BCM);
            {
                const int c8 = tidf & 31, l0 = (tidf >> 5) * 16;
                const int col = (c8 < 16 ? g * 128 + 8 * c8 : 512 + g * 128 + 8 * (c8 - 16));
                float wk[4][8], bb[8];
                { const f32x4 b0 = *(const f32x4*)(cb + 2048 + col), b1 = *(const f32x4*)(cb + 2048 + col + 4); bb[0] = b0.x; bb[1] = b0.y; bb[2] = b0.z; bb[3] = b0.w; bb[4] = b1.x; bb[5] = b1.y; bb[6] = b1.z; bb[7] = b1.w; }
#pragma unroll
                for (int ww = 0; ww < 4; ++ww) { const f32x4 k0 = *(const f32x4*)(cw + ww * CONV_DIM + 2048 + col), k1 = *(const f32x4*)(cw + ww * CONV_DIM + 2048 + col + 4);
                    wk[ww][0] = k0.x; wk[ww][1] = k0.y; wk[ww][2] = k0.z; wk[ww][3] = k0.w; wk[ww][4] = k1.x; wk[ww][5] = k1.y; wk[ww][6] = k1.z; wk[ww][7] = k1.w; }
                u32x4 rw[19];
#pragma unroll
                for (int r = 0; r < 19; ++r) rw[r] = (tl0 + l0 - 3 + r >= 0) ? *(const u32x4*)(zbc + (t0 + l0 - 3 + r) * 3072 + 2048 + col) : (u32x4){0u, 0u, 0u, 0u};
#pragma unroll
                for (int k = 0; k < 16; ++k) {
                    float acc[8];
#pragma unroll
                    for (int i = 0; i < 8; ++i) acc[i] = bb[i];
#pragma unroll
                    for (int ww = 0; ww < 4; ++ww) { const u32x4 q = rw[k + ww];
                        acc[0] += bflo(q.x) * wk[ww][0]; acc[1] += bfhi(q.x) * wk[ww][1]; acc[2] += bflo(q.y) * wk[ww][2]; acc[3] += bfhi(q.y) * wk[ww][3];
                        acc[4] += bflo(q.z) * wk[ww][4]; acc[5] += bfhi(q.z) * wk[ww][5]; acc[6] += bflo(q.w) * wk[ww][6]; acc[7] += bfhi(q.w) * wk[ww][7]; }
                    u32x4 ov; ov.x = pk2(silu_fast(acc[0]), silu_fast(acc[1])); ov.y = pk2(silu_fast(acc[2]), silu_fast(acc[3])); ov.z = pk2(silu_fast(acc[4]), silu_fast(acc[5])); ov.w = pk2(silu_fast(acc[6]), silu_fast(acc[7]));
                    *(u32x4*)(bcm + (t0 + l0 + k) * 1024 + col) = ov;
                }
            }
        }
        SUB_END(X, 43);
#pragma unroll 1
        for (int hg = 0; hg < 4; ++hg) {
            SUB_BEGIN(X, 44);
            asm volatile("s_waitcnt lgkmcnt(0)\n\ts_barrier" ::: "memory");
#pragma unroll
            for (int k = 0; k < 8; ++k) {
                const int it = tidf + NTHREADS * k, chl = it >> 5, seg = it & 31, h8 = 2 * hg + (chl >> 6), chg = g * 512 + h8 * 64 + (chl & 63);
                float o[8]; CONV8(1024 + chg, chg, seg, o);
                u32x4 ov; ov.x = pk2(o[0], o[1]); ov.y = pk2(o[2], o[3]); ov.z = pk2(o[4], o[5]); ov.w = pk2(o[6], o[7]);
                *(u32x4*)(xct + (size_t)chg * T + t0 + 8 * seg) = ov;
                const f32x4 wa = *(const LAS f32x4*)(wl + h8 * 256 + 8 * seg), wb = *(const LAS f32x4*)(wl + h8 * 256 + 8 * seg + 4);
                u32x4 os; os.x = pk2(o[0] * wa.x, o[1] * wa.y); os.y = pk2(o[2] * wa.z, o[3] * wa.w); os.z = pk2(o[4] * wb.x, o[5] * wb.y); os.w = pk2(o[6] * wb.z, o[7] * wb.w);
                *(LAS u32x4*)(ldsX + (chl >> 6) * 32768 + seg * 1024 + (chl & 63) * 16) = os;
            }
            asm volatile("s_waitcnt lgkmcnt(0)\n\ts_barrier" ::: "memory");
            SUB_END(X, 44);
            SUB_BEGIN(X, 45);
            {
                const int hl = w >> 2, pt = (w >> 1) & 1, nt0 = 2 * (w & 1), h = g * 8 + 2 * hg + hl;
                f32x16 acc0, acc1;
#pragma unroll
                for (int i = 0; i < 16; ++i) { acc0[i] = 0.f; acc1[i] = 0.f; }
#pragma unroll 4
                for (int ks = 0; ks < 16; ++ks) {
                    const bf16x8 af = *(const LAS bf16x8*)(ldsX + hl * 32768 + (2 * ks + hf) * 1024 + (32 * pt + ql) * 16);
                    const bf16x8 b0 = *(const LAS bf16x8*)(ldsB + (2 * ks + hf) * 2048 + (32 * nt0 + ql) * 16), b1 = *(const LAS bf16x8*)(ldsB + (2 * ks + hf) * 2048 + (32 * nt0 + 32 + ql) * 16);
                    acc0 = __builtin_amdgcn_mfma_f32_32x32x16_bf16(af, b0, acc0, 0, 0, 0); acc1 = __builtin_amdgcn_mfma_f32_32x32x16_bf16(af, b1, acc1, 0, 0, 0);
                }
                float* st = (float*)(X.ws + WS_ST) + ((size_t)(b * 16 + c) * 32 + h) * 8192 + 32 * nt0 + ql;
#pragma unroll
                for (int i = 0; i < 16; ++i) { const int pr = 32 * pt + 8 * (i >> 2) + 4 * hf + (i & 3); st[pr * 128] = acc0[i]; st[pr * 128 + 32] = acc1[i]; }
            }
            SUB_END(X, 45);
        }
#undef CONV8
        __syncthreads();
    }
}
__device__ __forceinline__ void ph_ssd2(const Ctx& X) {
    const float* st = (const float*)(X.ws + WS_ST); const float* dec = (const float*)(X.ws + WS_DEC); bf16_t* pb = (bf16_t*)(X.ws + WS_PB);
    for (int e = X.bid * NTHREADS + X.tid; e < NB * 32 * 2048; e += X.G * NTHREADS) {
        const int b = e >> 16, h = (e >> 11) & 31, q4 = (e & 2047) * 4;
        f32x4 hs = (f32x4){0.f, 0.f, 0.f, 0.f};
        for (int c = 0; c < 16; ++c) {
            const size_t o = ((size_t)(b * 16 + c) * 32 + h) * 8192 + q4;
            u32x2 wv; wv.x = pk2(hs.x, hs.y); wv.y = pk2(hs.z, hs.w); *(u32x2*)(pb + o) = wv;
            hs = hs * dec[(b * 16 + c) * 32 + h] + *(const f32x4*)(st + o);
        }
    }
}
constexpr int S3_STG = 49152;
__device__ __forceinline__ void ph_ssd3(const Params& p, const Ctx& X) {
    LAS float* dtl = (LAS float*)(X.lds + 2 * S3_STG); LAS float* csl = dtl + 2048;
    constexpr int S3_TILE = 2 * S3_STG + 16384;
    static_assert(S3_TILE + 8 * 4096 <= TAB_OFF, "ssd3 LDS map");
    for (int unit = X.bid; unit < 256; unit += X.G) {
        const int b = unit >> 6, c = (unit >> 2) & 15, g = unit & 3, tl0 = c * 256, lane = fresh(X.lane), w = X.wave, ql = lane & 31, hf = lane >> 5, lq = 32 * w + ql;
        const size_t t0 = (size_t)b * S + tl0;
        LAS unsigned char* tile = X.lds + S3_TILE + w * 4096;
        const bf16_t* xg = (const bf16_t*)(X.ws + WS_XCT) + (size_t)(g * 512 + lane) * T + t0;
        const bf16_t* pg = (const bf16_t*)(X.ws + WS_PB) + ((size_t)(b * 16 + c) * 32 + g * 8) * 8192 + (size_t)lane * 128;
#define S3_ISSUE(h8, sbase) do { _Pragma("unroll") for (int cc_ = 0; cc_ < 4; ++cc_) DMA16(xg + (size_t)((h8) * 64) * T + 8 * (4 * w + cc_), X.lds + (sbase) + (4 * w + cc_) * 1024); \
            _Pragma("unroll") for (int cc_ = 0; cc_ < 2; ++cc_) DMA16(pg + (size_t)(h8) * 8192 + 8 * (2 * w + cc_), X.lds + (sbase) + 32768 + (2 * w + cc_) * 1024); } while (0)
        asm volatile("s_waitcnt vmcnt(0)" ::: "memory");
        S3_ISSUE(0, 0);
        { const int tidf = fresh(X.tid), h8 = tidf >> 6, l4 = (tidf & 63) * 4;
          *(LAS f32x4*)(dtl + h8 * 256 + l4) = *(const f32x4*)((const float*)(X.ws + WS_DT2) + (size_t)(b * 32 + g * 8 + h8) * S + tl0 + l4);
          *(LAS f32x4*)(csl + h8 * 256 + l4) = *(const f32x4*)((const float*)(X.ws + WS_CS) + (size_t)(b * 32 + g * 8 + h8) * S + tl0 + l4); }
        const bf16_t* bcm = (const bf16_t*)(X.ws + WS_BCM);
        u32x4 gp[8][2];
        {
        bf16x8 cf[8];
#pragma unroll
        for (int ks = 0; ks < 8; ++ks) cf[ks] = *(const bf16x8*)(bcm + (t0 + lq) * 1024 + 512 + g * 128 + 16 * ks + 8 * hf);
#pragma unroll
        for (int st = 0; st < 8; ++st) {
            if (st <= w) {
                f32x16 G;
#pragma unroll
                for (int i = 0; i < 16; ++i) G[i] = 0.f;
                const bf16_t* bp = bcm + (t0 + 32 * st + pi32(ql)) * 1024 + g * 128 + 8 * hf;
#pragma unroll
                for (int ks = 0; ks < 8; ++ks) G = __builtin_amdgcn_mfma_f32_32x32x16_bf16(*(const bf16x8*)(bp + 16 * ks), cf[ks], G, 0, 0, 0);
#pragma unroll
                for (int a2 = 0; a2 < 2; ++a2) { gp[st][a2].x = pk2(G[8 * a2], G[8 * a2 + 1]); gp[st][a2].y = pk2(G[8 * a2 + 2], G[8 * a2 + 3]); gp[st][a2].z = pk2(G[8 * a2 + 4], G[8 * a2 + 5]); gp[st][a2].w = pk2(G[8 * a2 + 6], G[8 * a2 + 7]); }
            } else { gp[st][0] = (u32x4){0u, 0u, 0u, 0u}; gp[st][1] = (u32x4){0u, 0u, 0u, 0u}; }
        }
        }
        float ss = 0.f;
        bf16_t* yrow = (bf16_t*)(X.ws + WS_O) + (t0 + 32 * w + (lane >> 1)) * SSM_INNER + g * 512 + 32 * (lane & 1);
        const bf16_t* zdma = (const bf16_t*)(X.ws + WS_ZBC) + (t0 + 32 * w + (lane >> 3)) * 3072 + g * 512 + 8 * ((lane & 7) ^ (lane >> 3));
        LAS unsigned char* trw = tile + (lane >> 1) * 128;
        LAS unsigned char* tac = tile + ql * 128 + 8 * hf;
#pragma unroll 1
        for (int h8 = 0; h8 < 8; ++h8) {
            const int sb = (h8 & 1) * S3_STG;
            asm volatile("s_waitcnt vmcnt(0) lgkmcnt(0)\n\ts_barrier" ::: "memory");
            if (h8 < 7) S3_ISSUE(h8 + 1, ((h8 + 1) & 1) * S3_STG);
#pragma unroll
            for (int k = 0; k < 4; ++k) DMA16(zdma + (size_t)(8 * k) * 3072 + h8 * 64, tile + k * 1024);
            f32x16 acc0, acc1;
#pragma unroll
            for (int i = 0; i < 16; ++i) { acc0[i] = 0.f; acc1[i] = 0.f; }
            {
                const LAS unsigned char* pp = X.lds + sb + 32768 + hf * 1024 + ql * 16;
                const bf16_t* cp = bcm + (t0 + 32 * w + (fresh(lane) & 31)) * 1024 + 512 + g * 128 + 8 * hf;
#pragma unroll
                for (int ks = 0; ks < 8; ++ks) { const bf16x8 cfk = *(const bf16x8*)(cp + 16 * ks);
                                                 acc0 = __builtin_amdgcn_mfma_f32_32x32x16_bf16(*(const LAS bf16x8*)(pp + ks * 2048), cfk, acc0, 0, 0, 0);
                                                 acc1 = __builtin_amdgcn_mfma_f32_32x32x16_bf16(*(const LAS bf16x8*)(pp + ks * 2048 + 512), cfk, acc1, 0, 0, 0); }
                const float e = __expf(csl[h8 * 256 + lq]);
#pragma unroll
                for (int i = 0; i < 16; ++i) { acc0[i] *= e; acc1[i] *= e; }
            }
            const float cl = csl[h8 * 256 + lq], dsk = p.in[21][g * 8 + h8];
#pragma unroll
            for (int st = 0; st < 8; ++st) {
                if (st <= w) {
                    const int s0 = 32 * st + 8 * hf;
#pragma unroll
                    for (int a2 = 0; a2 < 2; ++a2) {
                        const f32x4 d0 = *(const LAS f32x4*)(dtl + h8 * 256 + s0 + 16 * a2), d1 = *(const LAS f32x4*)(dtl + h8 * 256 + s0 + 16 * a2 + 4);
                        const f32x4 c0 = *(const LAS f32x4*)(csl + h8 * 256 + s0 + 16 * a2), c1 = *(const LAS f32x4*)(csl + h8 * 256 + s0 + 16 * a2 + 4);
                        const float dd[8] = {d0.x, d0.y, d0.z, d0.w, d1.x, d1.y, d1.z, d1.w}, cc[8] = {c0.x, c0.y, c0.z, c0.w, c1.x, c1.y, c1.z, c1.w};
                        const unsigned gw[4] = {gp[st][a2].x, gp[st][a2].y, gp[st][a2].z, gp[st][a2].w};
                        float m[8];
#pragma unroll
                        for (int j = 0; j < 8; ++j) { const int sidx = s0 + 16 * a2 + j;
                            const float gv = (j & 1) ? bfhi(gw[j >> 1]) : bflo(gw[j >> 1]);
                            float v = gv * dd[j] * __expf(fminf(cl - cc[j], 0.f));
                            if (st == w) { v = sidx > lq ? 0.f : v; v += sidx == lq ? dsk : 0.f; }
                            m[j] = v; }
                        u32x4 pw; pw.x = pk2(m[0], m[1]); pw.y = pk2(m[2], m[3]); pw.z = pk2(m[4], m[5]); pw.w = pk2(m[6], m[7]);
                        const bf16x8 pf = __builtin_bit_cast(bf16x8, pw);
                        const LAS unsigned char* xp = X.lds + sb + (4 * st + 2 * a2 + hf) * 1024 + ql * 16;
                        acc0 = __builtin_amdgcn_mfma_f32_32x32x16_bf16(*(const LAS bf16x8*)xp, pf, acc0, 0, 0, 0);
                        acc1 = __builtin_amdgcn_mfma_f32_32x32x16_bf16(*(const LAS bf16x8*)(xp + 512), pf, acc1, 0, 0, 0);
                        __builtin_amdgcn_sched_barrier(0);
                    }
                }
            }
            asm volatile("s_waitcnt vmcnt(0)" ::: "memory");
#pragma unroll
            for (int pt = 0; pt < 2; ++pt)
#pragma unroll
                for (int g4 = 0; g4 < 4; ++g4) {
                    const u32x2 z2 = *(const LAS u32x2*)(tac + (((4 * pt + g4) ^ (ql & 7)) * 16));
                    const float a0 = pt ? acc1[4 * g4] : acc0[4 * g4], a1 = pt ? acc1[4 * g4 + 1] : acc0[4 * g4 + 1], a2v = pt ? acc1[4 * g4 + 2] : acc0[4 * g4 + 2], a3 = pt ? acc1[4 * g4 + 3] : acc0[4 * g4 + 3];
                    const float v0 = a0 * silu_fast(bflo(z2.x)), v1 = a1 * silu_fast(bfhi(z2.x)), v2 = a2v * silu_fast(bflo(z2.y)), v3 = a3 * silu_fast(bfhi(z2.y));
                    ss += (v0 * v0 + v1 * v1) + (v2 * v2 + v3 * v3);
                    u32x2 o; o.x = pk2(v0, v1); o.y = pk2(v2, v3); *(LAS u32x2*)(tac + (((4 * pt + g4) ^ (ql & 7)) * 16)) = o;
                }
#pragma unroll
            for (int k = 0; k < 4; ++k) *(u32x4*)(yrow + h8 * 64 + 8 * k) = *(const LAS u32x4*)(trw + (((4 * (lane & 1) + k) ^ ((lane >> 1) & 7)) * 16));
        }
#undef S3_ISSUE
        ss += __shfl_xor(ss, 32);
        const float rs = rsqrtf(ss * (1.f / 512.f) + EPS);
        asm volatile("s_waitcnt vmcnt(0)" ::: "memory");
        {
            const int lf = fresh(lane);
            bf16_t* yb = (bf16_t*)(X.ws + WS_O) + (t0 + 32 * w) * SSM_INNER + g * 512 + 8 * lf;
            const f32x4 g0 = *(const f32x4*)(p.in[22] + g * 512 + 8 * lf), g1 = *(const f32x4*)(p.in[22] + g * 512 + 8 * lf + 4);
#pragma unroll 1
            for (int r0 = 0; r0 < 32; r0 += 8) {
                u32x4 q[8];
#pragma unroll
                for (int k = 0; k < 8; ++k) q[k] = *(const u32x4*)(yb + (size_t)(r0 + k) * SSM_INNER);
#pragma unroll
                for (int k = 0; k < 8; ++k) {
                    const float rk = __shfl(rs, r0 + k);
                    u32x4 o; o.x = pk2(bflo(q[k].x) * rk * g0.x, bfhi(q[k].x) * rk * g0.y); o.y = pk2(bflo(q[k].y) * rk * g0.z, bfhi(q[k].y) * rk * g0.w);
                    o.z = pk2(bflo(q[k].z) * rk * g1.x, bfhi(q[k].z) * rk * g1.y); o.w = pk2(bflo(q[k].w) * rk * g1.z, bfhi(q[k].w) * rk * g1.w);
                    *(u32x4*)(yb + (size_t)(r0 + k) * SSM_INNER) = o;
                }
            }
        }
        asm volatile("s_waitcnt lgkmcnt(0)\n\ts_barrier" ::: "memory");
    }
}

__device__ __forceinline__ void ph_moe_gu(const Params& p, const Ctx& X, int l) {
    moe_table(X, l);
    pg8::MoeOrder So{(const LAS int*)(X.lds + TAB_OFF), (const LAS int*)(X.lds + TAB_OFF) + 40, (const int*)(X.ws + WS_SLOT), 3, X.G, X.bid, true};
    pg8::Gemm g{(const bf16_t*)(X.ws + WS_U), (const bf16_t*)(X.ws + WS_WGU) + (size_t)l * NE * 2048 * 1024, 1024};
    pg8::EpiGu E{(bf16_t*)(X.ws + WS_ACT), p.in[27] + (size_t)l * NE * 2048};
    pg8::gemm_phase<pg8::EpiGu, pg8::MoeOrder>(X.lds, g, So, E, X.tid);
}
__device__ __forceinline__ void ph_moe_down(const Params& p, const Ctx& X, int l) {
    moe_table(X, l);
    pg8::MoeOrder So{(const LAS int*)(X.lds + TAB_OFF), (const LAS int*)(X.lds + TAB_OFF) + 40, (const int*)(X.ws + WS_SLOT), 2, X.G, X.bid, false};
    pg8::Gemm g{(const bf16_t*)(X.ws + WS_ACT), (const bf16_t*)(X.ws + WS_WDN) + (size_t)l * NE * 1024 * 1024, 1024};
    pg8::EpiDown E{(bf16_t*)(X.ws + WS_Y), p.in[29] + (size_t)l * NE * 1024};
    pg8::gemm_phase<pg8::EpiDown, pg8::MoeOrder>(X.lds, g, So, E, X.tid);
}

#ifndef PROBE_MASK
#define PROBE_MASK 0u
#endif
#ifndef PROBE_MULT
#define PROBE_MULT 8
#endif
__global__ void __launch_bounds__(NTHREADS, 2) fwd_kernel(Params p) {
    extern __shared__ __attribute__((aligned(16))) unsigned char lds_raw[];
    Ctx X;
    X.lds = (LAS unsigned char*)lds_raw; X.ws = p.ws;
    X.tid = threadIdx.x; X.lane = X.tid & 63; X.wave = __builtin_amdgcn_readfirstlane(X.tid >> 6);
    X.G = gridDim.x; X.bid = blockIdx.x; X.gw = X.bid * NWAVES + X.wave; X.ngw = X.G * NWAVES; X.sub = 0ull; X.subt = 0ull;
    if (X.tid < 4) ((LAS unsigned*)(X.lds + XB_OFF))[X.tid] = 0u;
    __syncthreads();
    XcdBarrier bar = xcd_barrier_post((unsigned*)(p.ws + WS_CTL) + CW_BAR, (volatile LAS unsigned*)(X.lds + XB_OFF));
#define PHASE_BEGIN Ctx Y = X; { GAS unsigned char* w_ = (GAS unsigned char*)p.ws; asm volatile("" : "+s"(w_)); Y.ws = (unsigned char*)w_; int t_ = threadIdx.x; asm volatile("" : "+v"(t_)); Y.tid = t_; Y.lane = t_ & 63; \
    Y.wave = __builtin_amdgcn_readfirstlane(t_ >> 6); Y.gw = Y.bid * NWAVES + Y.wave; }
#define WSF(off) ((float*)(Y.ws + (off)))
#define WSB(off) ((bf16_t*)(Y.ws + (off)))
#define PROBE_LDS(i) (((volatile LAS unsigned long long*)(X.lds + 150528))[2 * X.wave + (i)])
    if (PROBE_MASK || PROBE_SUB) { if (X.lane == 0) { PROBE_LDS(0) = __builtin_amdgcn_s_memrealtime(); PROBE_LDS(1) = 0ull; } }
#define PB(k) do { if (PROBE_MASK) { if (X.lane == 0) { const unsigned long long n_ = __builtin_amdgcn_s_memrealtime(); if ((PROBE_MASK >> (k)) & 1u) PROBE_LDS(1) += n_ - PROBE_LDS(0); PROBE_LDS(0) = n_; } } } while (0)
    { PHASE_BEGIN ph_prologue(p, Y); }                                    xcd_barrier(bar); PB(0);
    { PHASE_BEGIN ph_norm0(p, Y); }                                       xcd_barrier(bar); PB(1);
    {
        PHASE_BEGIN
        pg8::DenseOrder So; So.init(T, PROJ_LD, X.G, X.bid);
        pg8::Gemm g{WSB(WS_U), WSB(WS_WIN), 1024};
        pg8::EpiBf16 E{WSB(WS_BIG), PROJ_LD};
        pg8::gemm_phase<pg8::EpiBf16, pg8::DenseOrder>(X.lds, g, So, E, Y.tid);
    }
    {
        PHASE_BEGIN
        pg8::DenseOrder So; So.init(768, T, X.G, X.bid);
        pg8::Gemm g{WSB(WS_WV), WSB(WS_U), 1024};
        pg8::EpiBf16 E{WSB(WS_VT), T};
        pg8::gemm_phase<pg8::EpiBf16, pg8::DenseOrder>(X.lds, g, So, E, Y.tid);
    }
    xcd_barrier(bar); PB(2);
    { PHASE_BEGIN ph_attn_a(p, Y); }                                      xcd_barrier(bar); PB(3);
    { PHASE_BEGIN ph_nsa(p, Y); if (PROBE_SUB && X.lane == 0) PROBE_LDS(1) += Y.sub; }
    __syncthreads(); PB(19);
    { PHASE_BEGIN ph_sb(Y); if (PROBE_SUB && X.lane == 0) PROBE_LDS(1) += Y.sub; }                                             xcd_barrier(bar); PB(4);
    {
        PHASE_BEGIN
        pg8::DenseOrder So; So.init(T, D, X.G, X.bid);
        pg8::Gemm g{WSB(WS_O), WSB(WS_WOUT), 1024};
        pg8::EpiResid E{p.in[0], WSF(WS_H1), WSF(WS_MODF) + 2048};
        pg8::gemm_phase<pg8::EpiResid, pg8::DenseOrder>(X.lds, g, So, E, Y.tid);
    }
    xcd_barrier(bar); PB(5);
    { PHASE_BEGIN ph_token<0>(p, Y, 0, WSF(WS_H1), nullptr); if (PROBE_SUB && X.lane == 0) PROBE_LDS(1) += Y.sub; }                       xcd_barrier(bar); PB(6);
    { PHASE_BEGIN ph_moe_gu(p, Y, 0); }                                   xcd_barrier(bar); PB(7);
    { PHASE_BEGIN ph_moe_down(p, Y, 0); }                                 xcd_barrier(bar); PB(8);
    { PHASE_BEGIN ph_token<1>(p, Y, 0, WSF(WS_H1), WSF(WS_H2)); if (PROBE_SUB && X.lane == 0) PROBE_LDS(1) += Y.sub; }       xcd_barrier(bar); PB(9);
    {
        PHASE_BEGIN
        pg8::DenseOrder So; So.init(T, 3072, X.G, X.bid);
        pg8::Gemm g{WSB(WS_U), WSB(WS_WSIN), 1024};
        pg8::EpiBf16 E{WSB(WS_ZBC), 3072};
        pg8::gemm_phase<pg8::EpiBf16, pg8::DenseOrder>(X.lds, g, So, E, Y.tid);
    }
    {
        PHASE_BEGIN
        pg8::DenseOrder So; So.init(3072, T, X.G, X.bid);
        pg8::Gemm g{WSB(WS_WSIN) + (size_t)2048 * 1024, WSB(WS_U), 1024};
        pg8::EpiBf16 E{WSB(WS_XT), T};
        pg8::gemm_phase<pg8::EpiBf16, pg8::DenseOrder>(X.lds, g, So, E, Y.tid);
    }
    xcd_barrier(bar); PB(10);
    { PHASE_BEGIN ph_ssd1(p, Y); if (PROBE_SUB && X.lane == 0) PROBE_LDS(1) += Y.sub; }                                        xcd_barrier(bar); PB(11);
    { PHASE_BEGIN ph_ssd2(Y); }                                           xcd_barrier(bar); PB(12);
    { PHASE_BEGIN ph_ssd3(p, Y); if (PROBE_SUB && X.lane == 0) PROBE_LDS(1) += Y.sub; }                                        xcd_barrier(bar); PB(13);
    {
        PHASE_BEGIN
        pg8::DenseOrder So; So.init(T, D, X.G, X.bid);
        pg8::Gemm g{WSB(WS_O), WSB(WS_WSOUT), 2048};
        pg8::EpiResid E{WSF(WS_H2), WSF(WS_H1), WSF(WS_MODF) + 4 * 6144 + 2048};
        pg8::gemm_phase<pg8::EpiResid, pg8::DenseOrder>(X.lds, g, So, E, Y.tid);
    }
    xcd_barrier(bar); PB(14);
    { PHASE_BEGIN ph_token<0>(p, Y, 1, WSF(WS_H1), nullptr); if (PROBE_SUB && X.lane == 0) PROBE_LDS(1) += Y.sub; }                       xcd_barrier(bar); PB(15);
    { PHASE_BEGIN ph_moe_gu(p, Y, 1); }                                   xcd_barrier(bar); PB(16);
    { PHASE_BEGIN ph_moe_down(p, Y, 1); }                                 xcd_barrier(bar); PB(17);
    { PHASE_BEGIN ph_token<2>(p, Y, 1, WSF(WS_H1), p.out); if (PROBE_SUB && X.lane == 0) PROBE_LDS(1) += Y.sub; } PB(18);
    if (PROBE_MASK || PROBE_SUB) { asm volatile("s_waitcnt lgkmcnt(0)" ::: "memory"); const unsigned long long acc_ = PROBE_LDS(1); const unsigned long long t_end = __builtin_amdgcn_s_memrealtime() + (unsigned long long)PROBE_MULT * (unsigned long long)__builtin_amdgcn_readfirstlane((unsigned)acc_); while (__builtin_amdgcn_s_memrealtime() < t_end) __builtin_amdgcn_s_sleep(8); }
#undef PB
#undef PROBE_LDS
#undef PHASE_BEGIN
#undef WSF
#undef WSB
}
}

extern "C" void kernel_launch(void* const* d_in, const int* in_sizes, int n_in, void* d_out, int out_size, void* d_ws, size_t ws_size, hipStream_t stream) {
    static int grid = 0;
    if (grid == 0) {
        if (n_in != 30 || out_size != T * D || ws_size < WS_END) { fprintf(stderr, "kernel_launch: unexpected shapes / workspace (%d inputs, out %d, ws %zu < %zu)\n", n_in, out_size, ws_size, (size_t)WS_END); grid = -1; return; }
        int dev = 0, cus = 0, per_cu = 0;
        if (hipGetDevice(&dev) != hipSuccess || hipDeviceGetAttribute(&cus, hipDeviceAttributeMultiprocessorCount, dev) != hipSuccess) { grid = -1; return; }
        if (hipFuncSetAttribute((const void*)fwd_kernel, hipFuncAttributeMaxDynamicSharedMemorySize, LDS_BYTES) != hipSuccess) { fprintf(stderr, "kernel_launch: hipFuncSetAttribute failed\n"); grid = -1; return; }
        if (hipOccupancyMaxActiveBlocksPerMultiprocessor(&per_cu, (const void*)fwd_kernel, NTHREADS, LDS_BYTES) != hipSuccess || per_cu < 1) { fprintf(stderr, "kernel_launch: occupancy query reports %d\n", per_cu); }
        (void)hipGetLastError();
        grid = cus;
    }
    if (grid < 0) return;
    if (hipMemsetAsync((char*)d_ws + WS_CTL, 0, CTL_BYTES, stream) != hipSuccess) return;
    Params p{};
    for (int i = 0; i < 30; ++i) p.in[i] = (const float*)d_in[i];
    p.out = (float*)d_out; p.ws = (unsigned char*)d_ws;
    hipLaunchKernelGGL(fwd_kernel, dim3(grid), dim3(NTHREADS), LDS_BYTES, stream, p);
}
```

```cpp
#include <hip/hip_runtime.h>
#include <cstdio>
#include <cstdint>

#define LAS __attribute__((address_space(3)))
#define GAS __attribute__((address_space(1)))
typedef unsigned short bf16_t;
typedef short bf16x8 __attribute__((ext_vector_type(8)));
typedef float f32x4 __attribute__((ext_vector_type(4)));
typedef unsigned u32x4 __attribute__((ext_vector_type(4)));
typedef unsigned u32x2 __attribute__((ext_vector_type(2)));
typedef float f32x16 __attribute__((ext_vector_type(16)));

namespace {
constexpr int D = 1024, NB = 4, S = 4096, T = NB * S;
constexpr int ATTN_IN = 2840, PROJ_LD = 3072;
constexpr int OFF_SBQ = 0, OFF_SBK = 512, OFF_SBV = 1024, OFF_NQ = 1536, OFF_KC = 2048, OFF_VC = 2176, OFF_KS = 2304, OFF_VS = 2432,
              OFF_KW = 2560, OFF_VW = 2688, OFF_GATE = 2816;
constexpr int NCMP = 255;
constexpr int SSM_IN = 5152, SSM_INNER = 2048, CONV_DIM = 3072, ZX_LD = 5120;
constexpr int NE = 32, CAP = 16384, MAXTILES = 288;
constexpr float EPS = 1e-6f;
constexpr int NWAVES = 8, NTHREADS = 512;

constexpr size_t al4k(size_t x) { return (x + 4095) & ~(size_t)4095; }
constexpr size_t WS_CTL = 0, CTL_BYTES = 1u << 20;
constexpr int CW_CNT = 256;
constexpr int CW_BAR = 4096;
constexpr size_t CTL_MOD = 65536;
constexpr size_t WS_WIN = CTL_BYTES;
constexpr size_t WS_WOUT = WS_WIN + (size_t)3072 * 1024 * 2;
constexpr size_t WS_WSIN = WS_WOUT + (size_t)1024 * 1024 * 2;
constexpr size_t WS_WSOUT = WS_WSIN + (size_t)5120 * 1024 * 2;
constexpr size_t WS_WGU = WS_WSOUT + (size_t)1024 * 2048 * 2;
constexpr size_t WS_WDN = WS_WGU + (size_t)2 * 32 * 2048 * 1024 * 2;
constexpr size_t WS_U = WS_WDN + (size_t)2 * 32 * 1024 * 1024 * 2;
constexpr size_t WS_BIG = WS_U + (size_t)T * 1024 * 2;
constexpr size_t WS_O = WS_BIG + (size_t)T * 5120 * 2;
constexpr size_t WS_H1 = WS_O + (size_t)T * 2048 * 2;
constexpr size_t WS_H2 = WS_H1 + (size_t)T * 1024 * 4;
constexpr size_t WS_QN = WS_H2 + (size_t)T * 1024 * 4;
constexpr size_t WS_KN = WS_QN + (size_t)T * 512 * 4;
constexpr size_t WS_KCMP = WS_KN + (size_t)T * 256 * 4;
constexpr size_t WS_VCMP = WS_KCMP + al4k((size_t)NB * NCMP * 2 * 64 * 4);
constexpr size_t WS_ACT = WS_VCMP + al4k((size_t)NB * NCMP * 2 * 64 * 4);
constexpr size_t WS_Y = WS_ACT + (size_t)MAXTILES * 256 * 1024 * 2;
constexpr size_t WS_TOKE = WS_Y + (size_t)MAXTILES * 256 * 1024 * 2;
constexpr size_t WS_TOKW = WS_TOKE + (size_t)T * 16;
constexpr size_t WS_TOKP = WS_TOKW + (size_t)T * 16;
constexpr size_t WS_SLOT = WS_TOKP + (size_t)T * 16;
constexpr size_t WS_XC = WS_SLOT + (size_t)NE * CAP * 4;
constexpr size_t WS_YS = WS_XC + (size_t)T * 3072 * 4;
constexpr size_t WS_DT = WS_YS + (size_t)T * 2048 * 4;
constexpr size_t WS_MODF = WS_DT + (size_t)T * 32 * 4;
constexpr size_t WS_WV = WS_MODF + (size_t)2 * 4 * 6144 * 4;
constexpr size_t WS_VT = WS_WV + (size_t)768 * 1024 * 2;
constexpr size_t WS_QNB = WS_VT + (size_t)768 * T * 2;
constexpr size_t WS_KSN = WS_QNB + (size_t)T * 512 * 2;
constexpr size_t WS_KWN = WS_KSN + (size_t)T * 128 * 2;
constexpr size_t WS_KCB = WS_KWN + (size_t)T * 128 * 2;
constexpr size_t WS_VCT = WS_KCB + (size_t)8 * 256 * 64 * 2;
constexpr size_t WS_DT2 = WS_VCT + (size_t)8 * 64 * 256 * 2;
constexpr size_t WS_CS = WS_DT2 + (size_t)NB * 32 * S * 4;
constexpr size_t WS_DEC = WS_CS + (size_t)NB * 32 * S * 4;
constexpr size_t WS_W1T = WS_DEC + al4k((size_t)NB * 16 * 32 * 4);
constexpr size_t WS_SKW = WS_W1T + (size_t)2 * 128 * 2048 * 2;
constexpr size_t WS_ULO = WS_SKW + (size_t)3 * 2 * 32 * 1024 * 2;
constexpr size_t WS_END = WS_ULO + (size_t)T * 1024 * 2;
constexpr size_t WS_ZBC = WS_BIG, WS_XT = WS_XC, WS_XCT = WS_XC + (size_t)3072 * T * 2, WS_ST = WS_YS, WS_PB = WS_YS + (size_t)NB * 16 * 32 * 8192 * 4, WS_BCM = WS_QN;
static_assert(WS_XCT + (size_t)2560 * T * 2 <= WS_YS && WS_PB + (size_t)NB * 16 * 32 * 8192 * 2 <= WS_DT && (size_t)T * 1024 * 2 <= (size_t)T * 512 * 4, "layer-1 overlays");

constexpr int RING_BYTES = 131072;
constexpr int EXTRA_OFF = RING_BYTES;
constexpr int TAB_OFF = 151552;
constexpr int XB_OFF = 152576;
constexpr int LDS_BYTES = 153600;

struct Params { const float* in[30]; float* out; unsigned char* ws; };

__device__ __forceinline__ float siluf(float v) { return v / (1.f + expf(-v)); }
__device__ __forceinline__ float logsig(float x) { return fminf(x, 0.f) - log1pf(expf(-fabsf(x))); }
__device__ __forceinline__ float wave_sum(float v) {
#pragma unroll
    for (int o = 32; o > 0; o >>= 1) v += __shfl_xor(v, o);
    return v;
}
__device__ __forceinline__ float wave_max(float v) {
#pragma unroll
    for (int o = 32; o > 0; o >>= 1) v = fmaxf(v, __shfl_xor(v, o));
    return v;
}
__device__ __forceinline__ unsigned f2bf(float f) { unsigned u = __builtin_bit_cast(unsigned, f); return (u + 0x7fffu + ((u >> 16) & 1u)) >> 16; }
typedef float f32x2_t __attribute__((ext_vector_type(2))); typedef __bf16 bf16x2_t __attribute__((ext_vector_type(2)));
__device__ __forceinline__ unsigned pk2(float lo, float hi) { f32x2_t v = {lo, hi}; bf16x2_t b = __builtin_convertvector(v, bf16x2_t); return __builtin_bit_cast(unsigned, b); }
__device__ __forceinline__ float bf2f(bf16_t v) { return __uint_as_float((unsigned)v << 16); }
__device__ __forceinline__ float bflo(unsigned w) { return __uint_as_float(w << 16); }
__device__ __forceinline__ float bfhi(unsigned w) { return __uint_as_float(w & 0xffff0000u); }
#define LDS_WAIT() asm volatile("s_waitcnt lgkmcnt(0)" ::: "memory")
__device__ __forceinline__ int fresh(int v) { asm volatile("" : "+v"(v)); return v; }
__device__ __forceinline__ int sfresh(int v) { asm volatile("" : "+s"(v)); return v; }

#define XB_TMO      128
#define XB_XCNT(j)  (256  + 64 * (j))
#define XB_XSUB(j)  (1280 + 64 * (j))
#define XB_XGEN(j)  (2304 + 64 * (j))
#define XB_TOP      3328
#define XB_TOPGEN   3392
#define XCD_BAR_WORDS 3456
#define XB_SPIN_CAP (1u << 18)
__device__ __forceinline__ unsigned xb_ld(unsigned* p)              { return __hip_atomic_load(p, __ATOMIC_RELAXED, __HIP_MEMORY_SCOPE_AGENT); }
__device__ __forceinline__ unsigned xb_add(unsigned* p, unsigned v) { return __hip_atomic_fetch_add(p, v, __ATOMIC_RELAXED, __HIP_MEMORY_SCOPE_AGENT); }
__device__ __forceinline__ unsigned xb_xcc_id() { return (unsigned)__builtin_amdgcn_s_getreg((3 << 11) | 20) & 0xFu; }
#define XB_SPIN(cond, bar) do { unsigned _sp = 0; while (cond) { __builtin_amdgcn_s_sleep(1); \
    if ((++_sp & 255u) == 0u) { if (xb_ld(&(bar)[XB_TMO])) break; if (_sp > XB_SPIN_CAP) { atomicAdd(&(bar)[XB_TMO], 1u); break; } } } } while (0)
struct XcdBarrier { unsigned* bar; unsigned x; volatile LAS unsigned* st; };
__device__ __forceinline__ XcdBarrier xcd_barrier_post(unsigned* bar, volatile LAS unsigned* st) {
    XcdBarrier b; b.bar = bar; b.x = xb_xcc_id(); b.st = st;
    if (threadIdx.x == 0) (void)xb_add(&bar[XB_XCNT(b.x)], 1u);
    return b;
}
__device__ __forceinline__ void xcd_barrier_complete(unsigned* bar, unsigned x, unsigned& nloc, unsigned& nx) {
    const unsigned G = gridDim.x * gridDim.y * gridDim.z;
    unsigned sum, cnt, mine, sp = 0u;
    for (;;) {
        sum = 0u; cnt = 0u; mine = 0u;
#pragma unroll
        for (unsigned j = 0; j < 16; ++j) { const unsigned c = xb_ld(&bar[XB_XCNT(j)]); sum += c; cnt += (c > 0u) ? 1u : 0u; mine = (j == x) ? c : mine; }
        if (sum == G) break;
        __builtin_amdgcn_s_sleep(1);
        if ((++sp & 255u) == 0u) { if (xb_ld(&bar[XB_TMO])) break; if (sp > XB_SPIN_CAP) { atomicAdd(&bar[XB_TMO], 1u); break; } }
    }
    nloc = mine > 0u ? mine : 1u; nx = cnt > 0u ? cnt : 1u;
}
__device__ __forceinline__ void xcd_barrier(const XcdBarrier& b) {
    asm volatile("s_waitcnt vmcnt(0)" ::: "memory");
    __syncthreads();
    if (threadIdx.x == 0) {
        unsigned* bar = b.bar;
        __builtin_amdgcn_s_waitcnt(0);
        unsigned nloc = b.st[0], nx = b.st[1];
        if (nloc == 0u) { xcd_barrier_complete(bar, b.x, nloc, nx); b.st[0] = nloc; b.st[1] = nx; }
        const unsigned old = xb_add(&bar[XB_XSUB(b.x)], 1u);
        const unsigned gen = old / nloc;
        if (old + 1u == (gen + 1u) * nloc) {
            __builtin_amdgcn_fence(__ATOMIC_RELEASE, "agent");
            asm volatile("s_waitcnt vmcnt(0)" ::: "memory");
            const unsigned og = xb_add(&bar[XB_TOP], 1u);
            const unsigned tg = og / nx;
            if (og + 1u == (tg + 1u) * nx) xb_add(&bar[XB_TOPGEN], 1u);
            else XB_SPIN(xb_ld(&bar[XB_TOPGEN]) == tg, bar);
            __builtin_amdgcn_fence(__ATOMIC_ACQUIRE, "agent");
            xb_add(&bar[XB_XGEN(b.x)], 1u);
            asm volatile("s_waitcnt vmcnt(0)" ::: "memory");
        } else {
            XB_SPIN(xb_ld(&bar[XB_XGEN(b.x)]) == gen, bar);
            __builtin_amdgcn_fence(__ATOMIC_ACQUIRE, "agent");
            asm volatile("s_waitcnt vmcnt(0)" ::: "memory");
        }
    }
    __syncthreads();
}

namespace pg8 {
constexpr int BM = 256, BK = 64, HALF = 128, HTB = HALF * BK * 2, STAGE_BYTES = 8 * HTB;
__device__ __forceinline__ int lds_byte(int r, int c) { const int st = (r >> 4) * 2 + (c >> 5), rr = r & 15, cc = c & 31, ob = rr * 64 + cc * 2; return st * 1024 + (ob ^ (((ob >> 9) & 1) << 5)); }
__device__ __forceinline__ void stage_rc(int b, int& R, int& C) { const int st = b / 1024, sb = b % 1024, swz = sb ^ (((sb >> 9) & 1) << 5); R = (st >> 1) * 16 + swz / 64; C = (st & 1) * 32 + (swz % 64) / 2; }
__device__ __forceinline__ int perm32(int rho) { const int n = rho >> 4, i = rho & 15; return 8 * (i >> 2) + 4 * n + (i & 3); }
struct Unit { int pm, pn, e; };
struct Gemm { const bf16_t* A; const bf16_t* Bt; int K; };
__device__ __forceinline__ unsigned cvt_pk_bf16(float lo, float hi) { unsigned r; asm volatile("v_cvt_pk_bf16_f32 %0, %1, %2" : "=v"(r) : "v"(lo), "v"(hi)); return r; }

struct DenseOrder {
    int nM, nN, nwg, G, c;
    __device__ void init(int M, int N, int G_, int c_) { nM = M / BM; nN = N / BM; nwg = nM * nN; G = G_; c = c_; }
    __device__ bool next(int i, Unit& u) const {
        const long L = (long)i * G + c; if (L >= nwg) return false;
        int wgid = (int)L; { const int q = nwg / 8, r = nwg % 8, xcd = wgid % 8, off = wgid / 8; wgid = (xcd < r ? xcd * (q + 1) : r * (q + 1) + (xcd - r) * q) + off; }
        const int nig = 8 * nN, gid = wgid / nig, fm = gid * 8, gsz = (nM - fm) < 8 ? (nM - fm) : 8;
        u.pm = fm + ((wgid % nig) % gsz); u.pn = (wgid % nig) / gsz; u.e = 0; return true;
    }
    __device__ __forceinline__ unsigned arow(const Unit& u, int r) const { return (unsigned)(u.pm * BM + r); }
};
struct MoeOrder {
    const LAS int* tb; const LAS int* cn; const int* slot_tok; int shift, G, c; bool gather;
    __device__ bool next(int i, Unit& u) const {
        const int L = i * G + c, tile = L >> shift; if (tile >= tb[NE]) return false;
        int e = 0; while (tb[e + 1] <= tile) ++e;
        u.pm = tile; u.pn = (e << shift) + (L & ((1 << shift) - 1)); u.e = e; return true;
    }
    __device__ __forceinline__ unsigned arow(const Unit& u, int r) const {
        if (!gather) return (unsigned)(u.pm * BM + r);
        const int pos = (u.pm - tb[u.e]) * BM + r;
        return pos < cn[u.e] ? (unsigned)slot_tok[u.e * CAP + pos] : 0u;
    }
};

struct EpiBf16 {
    static constexpr bool PERM = true;
    bf16_t* O; int ldc;
    __device__ __forceinline__ void operator()(const f32x4 (&acc)[2][2][4][2], const Unit& u, int wr, int wc, int fr, int fq) const {
        const int row0 = u.pm * BM + wr * 64 + fr, col0 = u.pn * BM + wc * 32 + 8 * fq;
#pragma unroll
        for (int ai = 0; ai < 2; ++ai)
#pragma unroll
            for (int m = 0; m < 4; ++m) { bf16_t* rowp = O + (size_t)(row0 + ai * HALF + m * 16) * ldc + col0;
#pragma unroll
                for (int bj = 0; bj < 2; ++bj) { const f32x4 v0 = acc[ai][bj][m][0], v1 = acc[ai][bj][m][1];
                    u32x4 w; w.x = cvt_pk_bf16(v0[0], v0[1]); w.y = cvt_pk_bf16(v0[2], v0[3]); w.z = cvt_pk_bf16(v1[0], v1[1]); w.w = cvt_pk_bf16(v1[2], v1[3]);
                    *(u32x4*)(rowp + bj * HALF) = w; } }
    }
};
struct EpiResid {
    static constexpr bool PERM = false;
    const float* base; float* out; const float* g;
    __device__ __forceinline__ void operator()(const f32x4 (&acc)[2][2][4][2], const Unit& u, int wr, int wc, int fr, int fq) const {
        const int row0 = u.pm * BM + wr * 64 + fr, col0 = u.pn * BM + wc * 32 + 4 * fq;
        const float* gb = g + (size_t)((u.pm * BM) / S) * 6144 + col0;
        f32x4 gv[2][2];
#pragma unroll
        for (int bj = 0; bj < 2; ++bj)
#pragma unroll
            for (int n = 0; n < 2; ++n) gv[bj][n] = *(const f32x4*)(gb + bj * HALF + n * 16);
#pragma unroll
        for (int ai = 0; ai < 2; ++ai)
#pragma unroll
            for (int m = 0; m < 4; ++m) { const size_t off = (size_t)(row0 + ai * HALF + m * 16) * D + col0;
#pragma unroll
                for (int bj = 0; bj < 2; ++bj)
#pragma unroll
                    for (int n = 0; n < 2; ++n) { const f32x4 bs = *(const f32x4*)(base + off + bj * HALF + n * 16);
                        *(f32x4*)(out + off + bj * HALF + n * 16) = bs + gv[bj][n] * acc[ai][bj][m][n]; } }
    }
};
struct EpiGu {
    static constexpr bool PERM = true;
    bf16_t* act; const float* bgu;
    __device__ __forceinline__ void operator()(const f32x4 (&acc)[2][2][4][2], const Unit& u, int wr, int wc, int fr, int fq) const {
        const int row0 = u.pm * BM + wr * 64 + fr, col0 = (u.pn & 7) * HALF + wc * 32 + 8 * fq;
        const float* bb = bgu + (size_t)u.e * 2048 + col0;
        const f32x4 bg0 = *(const f32x4*)(bb), bg1 = *(const f32x4*)(bb + 4), bu0 = *(const f32x4*)(bb + 1024), bu1 = *(const f32x4*)(bb + 1028);
#pragma unroll
        for (int ai = 0; ai < 2; ++ai)
#pragma unroll
            for (int m = 0; m < 4; ++m) {
                float r[8];
#pragma unroll
                for (int n = 0; n < 2; ++n) { const f32x4 gt = acc[ai][0][m][n] + (n ? bg1 : bg0), up = acc[ai][1][m][n] + (n ? bu1 : bu0);
#pragma unroll
                    for (int j = 0; j < 4; ++j) { const float gg = fminf(gt[j], 7.f), uu = fminf(fmaxf(up[j], -7.f), 7.f);
                        r[n * 4 + j] = (uu + 1.f) * gg * __builtin_amdgcn_rcpf(1.f + __expf(-1.702f * gg)); } }
                u32x4 w; w.x = cvt_pk_bf16(r[0], r[1]); w.y = cvt_pk_bf16(r[2], r[3]); w.z = cvt_pk_bf16(r[4], r[5]); w.w = cvt_pk_bf16(r[6], r[7]);
                *(u32x4*)(act + (size_t)(row0 + ai * HALF + m * 16) * D + col0) = w; }
    }
};
struct EpiDown {
    static constexpr bool PERM = true;
    bf16_t* y; const float* bd;
    __device__ __forceinline__ void operator()(const f32x4 (&acc)[2][2][4][2], const Unit& u, int wr, int wc, int fr, int fq) const {
        const int row0 = u.pm * BM + wr * 64 + fr, col0 = (u.pn & 3) * BM + wc * 32 + 8 * fq;
        const float* bb = bd + (size_t)u.e * 1024 + col0;
        f32x4 bv[2][2];
#pragma unroll
        for (int bj = 0; bj < 2; ++bj)
#pragma unroll
            for (int n = 0; n < 2; ++n) bv[bj][n] = *(const f32x4*)(bb + bj * HALF + 4 * n);
#pragma unroll
        for (int ai = 0; ai < 2; ++ai)
#pragma unroll
            for (int m = 0; m < 4; ++m) { bf16_t* rowp = y + (size_t)(row0 + ai * HALF + m * 16) * D + col0;
#pragma unroll
                for (int bj = 0; bj < 2; ++bj) { const f32x4 v0 = acc[ai][bj][m][0] + bv[bj][0], v1 = acc[ai][bj][m][1] + bv[bj][1];
                    u32x4 w; w.x = cvt_pk_bf16(v0[0], v0[1]); w.y = cvt_pk_bf16(v0[2], v0[3]); w.z = cvt_pk_bf16(v1[0], v1[1]); w.w = cvt_pk_bf16(v1[2], v1[3]);
                    *(u32x4*)(rowp + bj * HALF) = w; } }
    }
};

template <class Epi, class Sched>
__device__ __forceinline__ void gemm_phase(LAS unsigned char* lds, const Gemm g, const Sched& S, const Epi& E, const int tid) {
    const int wid = __builtin_amdgcn_readfirstlane(tid >> 6), lane = tid & 63, wr = wid >> 2, wc = wid & 3, fr = lane & 15, fq = lane >> 4;
    const int K = g.K, nt = K / BK;
    int RA[2], CA[2]; unsigned voffB[2];
#pragma unroll
    for (int i = 0; i < 2; ++i) { int R, C; stage_rc(tid * 16 + i * 8192, R, C); const int Rb = Epi::PERM ? ((R & ~31) + perm32(R & 31)) : R;
        RA[i] = R; CA[i] = C; voffB[i] = (unsigned)(Rb * K + C) * 2u; }
    const size_t kstep = (size_t)(BK * 2);
    const size_t hstep = (size_t)HALF * K * 2;
    const size_t tstep = 2 * hstep;
    const unsigned ldsw = (unsigned)wid * 1024u;
    const int aoff = lds_byte(wr * 64 + fr, fq * 8), boff = lds_byte(wc * 32 + fr, fq * 8);
#define PG8_SA(b, h) (((b) * 2 + (h)) * HTB)
#define PG8_SB(b, h) ((4 + (b) * 2 + (h)) * HTB)
#define PG8_STAGE(bufoff, gbase, voff) do { _Pragma("unroll") for (int _i = 0; _i < 2; ++_i) \
        __builtin_amdgcn_global_load_lds((const unsigned*)((const char*)(gbase) + (voff)[_i]), (LAS unsigned*)(lds + (bufoff) + ldsw + _i * 8192), 16, 0, 0); } while (0)
#define PG8_LDA(dst, b, h) do { _Pragma("unroll") for (int m = 0; m < 4; ++m) _Pragma("unroll") for (int k = 0; k < 2; ++k) dst[m][k] = *(const LAS bf16x8*)(lds + PG8_SA(b, h) + aoff + m * 2048 + k * 1024); } while (0)
#define PG8_LDB(dst, b, h) do { _Pragma("unroll") for (int n = 0; n < 2; ++n) _Pragma("unroll") for (int k = 0; k < 2; ++k) dst[n][k] = *(const LAS bf16x8*)(lds + PG8_SB(b, h) + boff + n * 2048 + k * 1024); } while (0)
#define PG8_MMA(ai, bj, At, Bt) do { __builtin_amdgcn_s_setprio(1); _Pragma("unroll") for (int m = 0; m < 4; ++m) _Pragma("unroll") for (int n = 0; n < 2; ++n) _Pragma("unroll") for (int k = 0; k < 2; ++k) \
        acc[ai][bj][m][n] = __builtin_amdgcn_mfma_f32_16x16x32_bf16(Bt[n][k], At[m][k], acc[ai][bj][m][n], 0, 0, 0); __builtin_amdgcn_s_setprio(0); } while (0)
#define PG8_WAIT_V(n) asm volatile("s_waitcnt vmcnt(" #n ")" ::: "memory")
#define PG8_WAIT_L(n) asm volatile("s_waitcnt lgkmcnt(" #n ")" ::: "memory")
#define PG8_BAR __builtin_amdgcn_s_barrier()
#define PG8_SCHED __builtin_amdgcn_sched_barrier(0)
#define PG8_AOFF(dst, u) do { _Pragma("unroll") for (int _h = 0; _h < 2; ++_h) _Pragma("unroll") for (int _i = 0; _i < 2; ++_i) dst[_h][_i] = (S.arow(u, _h * HALF + RA[_i]) * (unsigned)K + (unsigned)CA[_i]) * 2u; } while (0)
    Unit cur, nxt; int ui = 0;
    if (!S.next(0, cur)) return;
    f32x4 acc[2][2][4][2];
#pragma unroll
    for (int a = 0; a < 2; ++a)
#pragma unroll
        for (int b = 0; b < 2; ++b)
#pragma unroll
            for (int m = 0; m < 4; ++m)
#pragma unroll
                for (int n = 0; n < 2; ++n) acc[a][b][m][n] = (f32x4){0.f, 0.f, 0.f, 0.f};
    bf16x8 At[4][2], B0[2][2], B1[2][2];
    unsigned va[2][2], vn[2][2];
    PG8_AOFF(va, cur);
    const char* Ab = (const char*)g.A;
    const char* cB = (const char*)g.Bt + (size_t)cur.pn * tstep;
    PG8_STAGE(PG8_SB(0, 0), cB, voffB); PG8_STAGE(PG8_SB(0, 1), cB + hstep, voffB); PG8_STAGE(PG8_SA(0, 0), Ab, va[0]); PG8_STAGE(PG8_SA(0, 1), Ab, va[1]);
    if (wr == 1) PG8_BAR;
    PG8_WAIT_V(2); PG8_BAR;
    PG8_STAGE(PG8_SB(1, 0), cB + kstep, voffB); PG8_STAGE(PG8_SA(1, 0), Ab + kstep, va[0]); PG8_STAGE(PG8_SB(1, 1), cB + hstep + kstep, voffB);
    PG8_WAIT_V(6); PG8_BAR;
    for (;;) {
        const bool has_next = S.next(ui + 1, nxt);
        if (has_next) { PG8_AOFF(vn, nxt); }
        else {
#pragma unroll
            for (int h = 0; h < 2; ++h)
#pragma unroll
                for (int i = 0; i < 2; ++i) vn[h][i] = va[h][i]; }
        const char* nB = has_next ? (const char*)g.Bt + (size_t)nxt.pn * tstep : cB;
        for (int t = 0; t < nt; t += 2) {
            const bool last = (t == nt - 2);
            const char* a1 = Ab + (size_t)(t + 1) * kstep;
            const char* a2 = last ? Ab : Ab + (size_t)(t + 2) * kstep; const char* b2 = last ? nB : cB + (size_t)(t + 2) * kstep;
            const char* a3 = a2 + kstep; const char* b3 = b2 + kstep;
            unsigned o2[2][2];
#pragma unroll
            for (int h = 0; h < 2; ++h)
#pragma unroll
                for (int i = 0; i < 2; ++i) o2[h][i] = last ? vn[h][i] : va[h][i];
            PG8_LDB(B0, 0, 0); PG8_LDB(B1, 0, 1); PG8_SCHED; PG8_LDA(At, 0, 0); PG8_STAGE(PG8_SA(1, 1), a1, va[1]);
            PG8_WAIT_V(8); PG8_WAIT_L(0); PG8_BAR; PG8_MMA(0, 0, At, B0); PG8_MMA(0, 1, At, B1); PG8_BAR; PG8_SCHED;
            PG8_LDA(At, 0, 1); PG8_STAGE(PG8_SB(0, 0), b2, voffB); PG8_STAGE(PG8_SB(0, 1), b2 + hstep, voffB); PG8_STAGE(PG8_SA(0, 0), a2, o2[0]);
            PG8_WAIT_V(8); PG8_WAIT_L(0); PG8_BAR; PG8_MMA(1, 0, At, B0); PG8_MMA(1, 1, At, B1); PG8_BAR; PG8_SCHED;
            PG8_LDB(B0, 1, 0); PG8_LDB(B1, 1, 1); PG8_SCHED; PG8_LDA(At, 1, 0); PG8_STAGE(PG8_SA(0, 1), a2, o2[1]);
            PG8_WAIT_V(8); PG8_WAIT_L(0); PG8_BAR; PG8_MMA(0, 0, At, B0); PG8_MMA(0, 1, At, B1); PG8_BAR; PG8_SCHED;
            PG8_LDA(At, 1, 1); PG8_STAGE(PG8_SB(1, 0), b3, voffB); PG8_STAGE(PG8_SB(1, 1), b3 + hstep, voffB); PG8_STAGE(PG8_SA(1, 0), a3, o2[0]);
            PG8_WAIT_V(8); PG8_WAIT_L(0); PG8_BAR; PG8_MMA(1, 0, At, B0); PG8_MMA(1, 1, At, B1); PG8_BAR; PG8_SCHED;
        }
        if (wr == 0) PG8_BAR;
        E(acc, cur, wr, wc, fr, fq);
        if (!has_next) break;
#pragma unroll
        for (int a = 0; a < 2; ++a)
#pragma unroll
            for (int b = 0; b < 2; ++b)
#pragma unroll
                for (int m = 0; m < 4; ++m)
#pragma unroll
                    for (int n = 0; n < 2; ++n) acc[a][b][m][n] = (f32x4){0.f, 0.f, 0.f, 0.f};
        cur = nxt; cB = nB; ++ui;
#pragma unroll
        for (int h = 0; h < 2; ++h)
#pragma unroll
            for (int i = 0; i < 2; ++i) va[h][i] = vn[h][i];
        if (wr == 1) PG8_BAR;
    }
    PG8_WAIT_V(0);
    PG8_BAR;
#undef PG8_SA
#undef PG8_SB
#undef PG8_STAGE
#undef PG8_LDA
#undef PG8_LDB
#undef PG8_MMA
#undef PG8_WAIT_V
#undef PG8_WAIT_L
#undef PG8_BAR
#undef PG8_SCHED
#undef PG8_AOFF
}
}

#ifndef PROBE_SUB
#define PROBE_SUB 0
#endif
struct Ctx {
    LAS unsigned char* lds; unsigned char* ws;
    int tid, lane, wave, gw, ngw, G, bid;
    mutable unsigned long long sub, subt;
};
#define SUB_BEGIN(X, id) do { if (PROBE_SUB == (id)) (X).subt = __builtin_amdgcn_s_memrealtime(); } while (0)
#define SUB_END(X, id) do { if (PROBE_SUB == (id)) (X).sub += __builtin_amdgcn_s_memrealtime() - (X).subt; } while (0)

__device__ __forceinline__ void transpose_item(const float* W, int ldw, int K, int nvalid, int k0, int n0, bf16_t* WT, int row0, LAS float* scr, int lane) {
    const int c4 = (lane & 7) * 4, kr = lane >> 3;
    f32x4 v[8];
#pragma unroll
    for (int i = 0; i < 8; ++i) v[i] = (n0 + c4 < nvalid) ? *(const f32x4*)(W + (size_t)(k0 + kr + 8 * i) * ldw + n0 + c4) : (f32x4){0.f, 0.f, 0.f, 0.f};
#pragma unroll
    for (int i = 0; i < 8; ++i) { LAS float* d = scr + (kr + 8 * i) * 33 + c4; d[0] = v[i].x; d[1] = v[i].y; d[2] = v[i].z; d[3] = v[i].w; }
    LDS_WAIT(); asm volatile("" ::: "memory");
    const int c = lane & 7;
#pragma unroll
    for (int j = 0; j < 4; ++j) { const int n = (lane >> 3) + 8 * j; const LAS float* s = scr + (8 * c) * 33 + n;
        u32x4 o; o.x = pk2(s[0 * 33], s[1 * 33]); o.y = pk2(s[2 * 33], s[3 * 33]); o.z = pk2(s[4 * 33], s[5 * 33]); o.w = pk2(s[6 * 33], s[7 * 33]);
        *(u32x4*)(WT + (size_t)(row0 + n) * K + k0 + 8 * c) = o; }
    LDS_WAIT(); asm volatile("" ::: "memory");
}
__device__ __forceinline__ void ph_prologue(const Params& p, const Ctx& X) {
    LAS float* scr = (LAS float*)(X.lds + X.wave * 16384);
    unsigned char* ws = X.ws;
    constexpr int I_MOD = 2 * 96 * 8;
    constexpr int I_SK = 3 * 16, I_W1 = 2 * 32 * 4, I_WIN = 16 * 96, I_WV = 16 * 24, I_WOUT = 16 * 32, I_WSIN = 16 * 160, I_WSOUT = 32 * 32, I_GU = 64 * 1024, I_DN = 64 * 512;
    constexpr int NITEMS = I_MOD + I_SK + I_W1 + I_WIN + I_WV + I_WOUT + I_WSIN + I_WSOUT + I_GU + I_DN;
    for (int it = X.gw; it < NITEMS; it += X.ngw) {
        int r = it;
        if (r < I_MOD) {
            const int kp = r & 7, jb = (r >> 3) % 96, l = r / (8 * 96), j = jb * 64 + X.lane;
            const float* w = p.in[2] + (size_t)l * 1024 * 6144 + (size_t)(kp * 128) * 6144 + j;
            const float* c = p.in[1] + kp * 128;
            float a0 = 0.f, a1 = 0.f, a2 = 0.f, a3 = 0.f;
#pragma unroll 8
            for (int i = 0; i < 128; ++i) { const float wv = w[(size_t)i * 6144];
                a0 += siluf(c[i]) * wv; a1 += siluf(c[1024 + i]) * wv; a2 += siluf(c[2048 + i]) * wv; a3 += siluf(c[3072 + i]) * wv; }
            if (kp == 0) { const float bb = p.in[3][l * 6144 + j]; a0 += bb; a1 += bb; a2 += bb; a3 += bb; }
            unsigned long long* mq = (unsigned long long*)(ws + CTL_MOD) + (size_t)l * 4 * 6144 + j;
            atomicAdd(mq, (unsigned long long)__double2ll_rn((double)a0 * 1099511627776.0)); atomicAdd(mq + 6144, (unsigned long long)__double2ll_rn((double)a1 * 1099511627776.0));
            atomicAdd(mq + 2 * 6144, (unsigned long long)__double2ll_rn((double)a2 * 1099511627776.0)); atomicAdd(mq + 3 * 6144, (unsigned long long)__double2ll_rn((double)a3 * 1099511627776.0));
            continue;
        }
        r -= I_MOD;
        if (r < I_SK) {
            const int m = r >> 4, kb = r & 15, k0 = kb * 64;
            const float* W = m < 2 ? p.in[24] + (size_t)m * D * NE : p.in[16] + 5120; const int ldw = m < 2 ? NE : SSM_IN;
#pragma unroll 8
            for (int i = 0; i < 32; ++i) { const int kk = 2 * i + (X.lane >> 5); scr[kk * 33 + (X.lane & 31)] = W[(size_t)(k0 + kk) * ldw + (X.lane & 31)]; }
            LDS_WAIT(); asm volatile("" ::: "memory");
            const int c = X.lane & 7;
#pragma unroll
            for (int j = 0; j < 4; ++j) { const int n = (X.lane >> 3) + 8 * j; const LAS float* sp = scr + (8 * c) * 33 + n;
                float v[8]; unsigned hi[8];
#pragma unroll
                for (int q = 0; q < 8; ++q) { v[q] = sp[q * 33]; hi[q] = f2bf(v[q]); v[q] -= __uint_as_float(hi[q] << 16); }
                u32x4 oh, ol; oh.x = hi[0] | (hi[1] << 16); oh.y = hi[2] | (hi[3] << 16); oh.z = hi[4] | (hi[5] << 16); oh.w = hi[6] | (hi[7] << 16);
                ol.x = pk2(v[0], v[1]); ol.y = pk2(v[2], v[3]); ol.z = pk2(v[4], v[5]); ol.w = pk2(v[6], v[7]);
                bf16_t* dst = (bf16_t*)(ws + WS_SKW) + (size_t)m * 2 * 32 * 1024 + (size_t)n * 1024 + k0 + 8 * c;
                *(u32x4*)dst = oh; *(u32x4*)(dst + 32 * 1024) = ol; }
            LDS_WAIT(); asm volatile("" ::: "memory");
            continue; }
        r -= I_SK;
        if (r < I_W1) { const int kv = r >> 7, q = r & 127, kb = q >> 2, nb = q & 3;
            transpose_item(kv ? p.in[14] : p.in[12], 128, 2048, 128, kb * 64, nb * 32, (bf16_t*)(ws + WS_W1T) + (size_t)kv * 128 * 2048, nb * 32, scr, X.lane); continue; } r -= I_W1;
        if (r < I_WIN) { const int kb = r / 96, nb = r % 96; transpose_item(p.in[6], ATTN_IN, 1024, ATTN_IN, kb * 64, nb * 32, (bf16_t*)(ws + WS_WIN), nb * 32, scr, X.lane); continue; } r -= I_WIN;
        if (r < I_WV) { const int kb = r / 24, nb = r % 24, r0 = nb * 32, src = r0 < 512 ? OFF_SBV + r0 : (r0 < 640 ? OFF_VS + (r0 - 512) : OFF_VW + (r0 - 640));
            transpose_item(p.in[6], ATTN_IN, 1024, ATTN_IN, kb * 64, src, (bf16_t*)(ws + WS_WV), r0, scr, X.lane); continue; } r -= I_WV;
        if (r < I_WOUT) { const int kb = r / 32, nb = r % 32; transpose_item(p.in[7], 1024, 1024, 1024, kb * 64, nb * 32, (bf16_t*)(ws + WS_WOUT), nb * 32, scr, X.lane); continue; } r -= I_WOUT;
        if (r < I_WSIN) { const int kb = r / 160, nb = r % 160, n0 = nb * 32, row0 = n0 < 2048 ? n0 : (n0 < 4096 ? n0 + 1024 : n0 - 2048);
            transpose_item(p.in[16], SSM_IN, 1024, SSM_IN, kb * 64, n0, (bf16_t*)(ws + WS_WSIN), row0, scr, X.lane); continue; } r -= I_WSIN;
        if (r < I_WSOUT) { const int kb = r / 32, nb = r % 32; transpose_item(p.in[23], 1024, 2048, 1024, kb * 64, nb * 32, (bf16_t*)(ws + WS_WSOUT), nb * 32, scr, X.lane); continue; } r -= I_WSOUT;
        if (r < I_GU) { const int m = r >> 10, q = r & 1023, kb = q >> 6, nb = q & 63, n0 = nb * 32;
            const int row0 = ((n0 & 1023) >> 7) * 256 + (n0 >> 10) * 128 + (n0 & 127);
            transpose_item(p.in[26] + (size_t)m * 1024 * 2048, 2048, 1024, 2048, kb * 64, n0, (bf16_t*)(ws + WS_WGU) + (size_t)m * 2048 * 1024, row0, scr, X.lane); continue; } r -= I_GU;
        { const int m = r >> 9, q = r & 511, kb = q >> 5, nb = q & 31;
            transpose_item(p.in[28] + (size_t)m * 1024 * 1024, 1024, 1024, 1024, kb * 64, nb * 32, (bf16_t*)(ws + WS_WDN) + (size_t)m * 1024 * 1024, nb * 32, scr, X.lane); }
    }
}

struct Row { f32x4 v[4]; };
__device__ __forceinline__ void row_load(Row& r, const float* p, int lane) {
#pragma unroll
    for (int j = 0; j < 4; ++j) r.v[j] = ((const f32x4*)p)[64 * j + lane];
}
__device__ __forceinline__ void row_store(const Row& r, float* p, int lane) {
#pragma unroll
    for (int j = 0; j < 4; ++j) ((f32x4*)p)[64 * j + lane] = r.v[j];
}
template <class PV>
__device__ __forceinline__ void row_norm_mod(const Row& r, Row& o, const float* gain, PV sc, PV sh, int lane) {
    float ss = 0.f;
#pragma unroll
    for (int j = 0; j < 4; ++j) ss += (r.v[j].x * r.v[j].x + r.v[j].y * r.v[j].y) + (r.v[j].z * r.v[j].z + r.v[j].w * r.v[j].w);
    const float rs = rsqrtf(wave_sum(ss) * (1.f / 1024.f) + EPS);
#pragma unroll
    for (int j = 0; j < 4; ++j) { const f32x4 g = ((const f32x4*)gain)[64 * j + lane], a = sc[64 * j + lane], b = sh[64 * j + lane];
        o.v[j] = r.v[j] * rs * g * (a + 1.f) + b; }
}
__device__ __forceinline__ void row_store_bf16(const Row& r, bf16_t* p, int lane) {
#pragma unroll
    for (int j = 0; j < 4; ++j) { u32x2 w; w.x = pk2(r.v[j].x, r.v[j].y); w.y = pk2(r.v[j].z, r.v[j].w); ((u32x2*)p)[64 * j + lane] = w; }
}
__device__ __forceinline__ void row_store_lds(const Row& r, LAS float* p, int lane) {
#pragma unroll
    for (int j = 0; j < 4; ++j) ((LAS f32x4*)p)[64 * j + lane] = r.v[j];
}
__device__ __forceinline__ float modq2f(long long q) { return (float)((double)q * 9.094947017729282e-13); }
__device__ __forceinline__ void ph_norm0(const Params& p, const Ctx& X) {
    const long long* mq = (const long long*)(X.ws + CTL_MOD);
    float* modf = (float*)(X.ws + WS_MODF);
    for (int i = X.bid * NTHREADS + X.tid; i < 2 * 4 * 6144; i += X.G * NTHREADS) modf[i] = modq2f(mq[i]);
    LAS float* tab = (LAS float*)X.lds;
    for (int i = X.tid; i < 4 * 2048; i += NTHREADS) tab[i] = modq2f(mq[(size_t)(i >> 11) * 6144 + (i & 2047)]);
    __syncthreads();
    for (int t = X.gw; t < T; t += X.ngw) {
        Row r, o; row_load(r, p.in[0] + (size_t)t * D, X.lane);
        const LAS float* m = tab + (t / S) * 2048;
        row_norm_mod(r, o, p.in[4], (const LAS f32x4*)(m + 1024), (const LAS f32x4*)m, X.lane);
        row_store_bf16(o, (bf16_t*)(X.ws + WS_U) + (size_t)t * D, X.lane);
    }
}
__device__ __forceinline__ void route_select(float logit, int lane, LAS unsigned* lcnt, int& ev, float& wv, int& lpos) {
    const int e = lane & 31;
    float tl[4]; int te[4];
#pragma unroll
    for (int k = 0; k < 4; ++k) {
        float bv = logit; int bi = e;
#pragma unroll
        for (int o = 16; o > 0; o >>= 1) { const float ov = __shfl_xor(bv, o); const int oi = __shfl_xor(bi, o); if (ov > bv || (ov == bv && oi < bi)) { bv = ov; bi = oi; } }
        tl[k] = bv; te[k] = bi;
        if (e == bi) logit = -INFINITY;
    }
    ev = 0; wv = 0.f; lpos = 0;
    if (e < 4) {
        const float e1 = expf(tl[1] - tl[0]), e2 = expf(tl[2] - tl[0]), e3 = expf(tl[3] - tl[0]);
        const float inv = 1.f / (1.f + e1 + e2 + e3);
        wv = (e == 0 ? 1.f : e == 1 ? e1 : e == 2 ? e2 : e3) * inv;
        ev = e == 0 ? te[0] : e == 1 ? te[1] : e == 2 ? te[2] : te[3];
        lpos = (int)__hip_atomic_fetch_add(&lcnt[ev], 1u, __ATOMIC_RELAXED, __HIP_MEMORY_SCOPE_WORKGROUP);
    }
}
__device__ __forceinline__ void moe_table(const Ctx& X, int l) {
    LAS int* tb = (LAS int*)(X.lds + TAB_OFF);
    if (X.wave == 0) {
        const unsigned* cnt = (const unsigned*)(X.ws + WS_CTL) + CW_CNT + l * 32 * 32;
        const int e = X.lane & 31;
        const int c = (int)__hip_atomic_load(cnt + e * 32, __ATOMIC_RELAXED, __HIP_MEMORY_SCOPE_AGENT), nt = (c + 255) >> 8;
        int incl = nt;
#pragma unroll
        for (int o = 1; o < 32; o <<= 1) { const int u = __shfl_up(incl, o); if (e >= o) incl += u; }
        if (X.lane < 32) { tb[e] = incl - nt; tb[40 + e] = c; if (e == 31) tb[NE] = incl; }
    }
    __syncthreads();
}
template <int MODE>
__device__ __forceinline__ void ph_token(const Params& p, const Ctx& X, int l, const float* h, float* hn) {
    if (MODE != 0) moe_table(X, l);
    const LAS int* tb = (const LAS int*)(X.lds + TAB_OFF);
    const float* modl = (const float*)(X.ws + WS_MODF) + (size_t)l * 4 * 6144;
    const float* modn = (const float*)(X.ws + WS_MODF) + (size_t)(MODE == 1 ? 1 : l) * 4 * 6144;
    const float* gain = MODE == 1 ? p.in[4] + D : p.in[5] + l * D;
    const int sc_off = MODE == 1 ? 1024 : 4096, sh_off = MODE == 1 ? 0 : 3072;
    const bf16_t* y = (const bf16_t*)(X.ws + WS_Y);
    LAS float* rsl = (LAS float*)X.lds;
    LAS float* part = (LAS float*)(X.lds + 1024);
    if (MODE == 0 && X.tid < 32) ((LAS unsigned*)(X.lds + 1024 + 65536))[X.tid] = 0u;
    for (int tile = X.bid; tile < T / 64; tile += X.G) {
        const int lane = fresh(X.lane), w = X.wave, tb0 = tile * 64, bb = tb0 / S;
        SUB_BEGIN(X, 31);
        Row ca_, cb_, cg_;
        { const float* m = modn + (size_t)bb * 6144;
#pragma unroll
          for (int j = 0; j < 4; ++j) { if (MODE != 2) { const f32x4 g = ((const f32x4*)gain)[64 * j + lane], a = ((const f32x4*)(m + sc_off))[64 * j + lane]; ca_.v[j] = g * (a + 1.f); cb_.v[j] = ((const f32x4*)(m + sh_off))[64 * j + lane]; }
                                        if (MODE != 0) cg_.v[j] = ((const f32x4*)(modl + (size_t)bb * 6144 + 5120))[64 * j + lane]; } }
        int pe_ = 0, pp_ = 0; float pw_ = 0.f;
        if (MODE != 0 && lane < 32) { const int idx = (tb0 + 8 * w) * 4 + lane; pe_ = ((const int*)(X.ws + WS_TOKE))[idx]; pp_ = ((const int*)(X.ws + WS_TOKP))[idx]; pw_ = ((const float*)(X.ws + WS_TOKW))[idx]; }
#pragma unroll 1
        for (int k2 = 0; k2 < 4; ++k2) {
            Row r[2];
#pragma unroll
            for (int u = 0; u < 2; ++u) row_load(r[u], h + (size_t)(tb0 + 8 * w + 2 * k2 + u) * D, lane);
            if (MODE != 0) {
#pragma unroll
                for (int u = 0; u < 2; ++u) {
#pragma unroll
                    for (int kk = 0; kk < 4; ++kk) {
                        const int sl = (2 * k2 + u) * 4 + kk;
                        const int e = __shfl(pe_, sl), pos = __shfl(pp_, sl); const float wt = __shfl(pw_, sl);
                        const bf16_t* yr = y + (size_t)(tb[e] * 256 + pos) * D;
#pragma unroll
                        for (int j = 0; j < 4; ++j) { const u32x2 q = ((const u32x2*)yr)[64 * j + lane]; const f32x4 gw = cg_.v[j] * wt;
                            r[u].v[j].x += gw.x * bflo(q.x); r[u].v[j].y += gw.y * bfhi(q.x); r[u].v[j].z += gw.z * bflo(q.y); r[u].v[j].w += gw.w * bfhi(q.y); }
                    }
                    row_store(r[u], hn + (size_t)(tb0 + 8 * w + 2 * k2 + u) * D, lane);
                    __builtin_amdgcn_sched_barrier(0);
                }
            }
            if (MODE != 2) {
#pragma unroll
                for (int u = 0; u < 2; ++u) {
                    float ssq = 0.f;
#pragma unroll
                    for (int j = 0; j < 4; ++j) ssq += (r[u].v[j].x * r[u].v[j].x + r[u].v[j].y * r[u].v[j].y) + (r[u].v[j].z * r[u].v[j].z + r[u].v[j].w * r[u].v[j].w);
                    const float rs = rsqrtf(wave_sum(ssq) * (1.f / 1024.f) + EPS);
                    bf16_t* uh = (bf16_t*)(X.ws + WS_U) + (size_t)(tb0 + 8 * w + 2 * k2 + u) * D; bf16_t* ul = (bf16_t*)(X.ws + WS_ULO) + (size_t)(tb0 + 8 * w + 2 * k2 + u) * D;
#pragma unroll
                    for (int j = 0; j < 4; ++j) { const f32x4 o = r[u].v[j] * rs * ca_.v[j] + cb_.v[j];
                        u32x2 hi; hi.x = pk2(o.x, o.y); hi.y = pk2(o.z, o.w); ((u32x2*)uh)[64 * j + lane] = hi;
                        u32x2 lo; lo.x = pk2(o.x - bflo(hi.x), o.y - bfhi(hi.x)); lo.y = pk2(o.z - bflo(hi.y), o.w - bfhi(hi.y)); ((u32x2*)ul)[64 * j + lane] = lo; }
                }
            }
        }
        SUB_END(X, 31);
        if (MODE == 2) continue;
        SUB_BEGIN(X, 32);
        __syncthreads();
        {
            const int ql = lane & 31, hf = lane >> 5;
            const bf16_t* wh = (const bf16_t*)(X.ws + WS_SKW) + (size_t)(MODE == 0 ? l : 2) * 2 * 32 * 1024 + (size_t)ql * 1024 + 128 * w + 8 * hf;
            const bf16_t* uh = (const bf16_t*)(X.ws + WS_U) + (size_t)(tb0 + ql) * D + 128 * w + 8 * hf; const bf16_t* ul = (const bf16_t*)(X.ws + WS_ULO) + (size_t)(tb0 + ql) * D + 128 * w + 8 * hf;
            f32x16 acc0, acc1;
#pragma unroll
            for (int i = 0; i < 16; ++i) { acc0[i] = 0.f; acc1[i] = 0.f; }
#pragma unroll 4
            for (int ks = 0; ks < 8; ++ks) {
                const bf16x8 whi = *(const bf16x8*)(wh + 16 * ks), wlo = *(const bf16x8*)(wh + 32 * 1024 + 16 * ks);
                const bf16x8 ah0 = *(const bf16x8*)(uh + 16 * ks), al0 = *(const bf16x8*)(ul + 16 * ks), ah1 = *(const bf16x8*)(uh + 32 * D + 16 * ks), al1 = *(const bf16x8*)(ul + 32 * D + 16 * ks);
                acc0 = __builtin_amdgcn_mfma_f32_32x32x16_bf16(ah0, whi, acc0, 0, 0, 0); acc0 = __builtin_amdgcn_mfma_f32_32x32x16_bf16(al0, whi, acc0, 0, 0, 0); acc0 = __builtin_amdgcn_mfma_f32_32x32x16_bf16(ah0, wlo, acc0, 0, 0, 0);
                acc1 = __builtin_amdgcn_mfma_f32_32x32x16_bf16(ah1, whi, acc1, 0, 0, 0); acc1 = __builtin_amdgcn_mfma_f32_32x32x16_bf16(al1, whi, acc1, 0, 0, 0); acc1 = __builtin_amdgcn_mfma_f32_32x32x16_bf16(ah1, wlo, acc1, 0, 0, 0);
            }
#pragma unroll
            for (int i = 0; i < 16; ++i) { const int row = 8 * (i >> 2) + 4 * hf + (i & 3); part[(w * 64 + row) * 32 + ql] = acc0[i]; part[(w * 64 + 32 + row) * 32 + ql] = acc1[i]; }
        }
        __syncthreads();
        SUB_END(X, 32);
        SUB_BEGIN(X, 33);
        {
            const int e = lane & 31, hf = lane >> 5;
            LAS unsigned* lcnt = (LAS unsigned*)(X.lds + 1024 + 65536);
            int ev[4], lp[4]; float wv[4];
#pragma unroll
            for (int k = 0; k < 4; ++k) {
                const int tl = 8 * w + 4 * hf + k;
                float v = 0.f;
#pragma unroll
                for (int ww = 0; ww < 8; ++ww) v += part[(ww * 64 + tl) * 32 + e];
                if (MODE == 0) route_select(v + p.in[25][l * NE + e], lane, lcnt, ev[k], wv[k], lp[k]);
                else ((float*)(X.ws + WS_DT))[(size_t)(tb0 + tl) * 32 + e] = v;
            }
            if (MODE == 0) {
                __syncthreads();
                if (X.tid < 32) { const unsigned n = lcnt[X.tid]; unsigned* cnt = (unsigned*)(X.ws + WS_CTL) + CW_CNT + (l * 32 + X.tid) * 32;
                    lcnt[32 + X.tid] = n ? atomicAdd(cnt, n) : 0u; }
                __syncthreads();
                if (e < 4) {
#pragma unroll
                    for (int k = 0; k < 4; ++k) { const int t = tb0 + 8 * w + 4 * hf + k, pos = (int)lcnt[32 + ev[k]] + lp[k];
                        ((int*)(X.ws + WS_TOKE))[t * 4 + e] = ev[k]; ((float*)(X.ws + WS_TOKW))[t * 4 + e] = wv[k]; ((int*)(X.ws + WS_TOKP))[t * 4 + e] = pos;
                        ((int*)(X.ws + WS_SLOT))[ev[k] * CAP + pos] = t; }
                }
            }
        }
        __syncthreads();
        SUB_END(X, 33);
        if (MODE == 0 && X.tid < 32) ((LAS unsigned*)(X.lds + 1024 + 65536))[X.tid] = 0u;
    }
}

__device__ __forceinline__ void ld64bf(const bf16_t* p, float (&q)[64]) {
#pragma unroll
    for (int i = 0; i < 8; ++i) { const u32x4 w = ((const u32x4*)p)[i];
        q[8 * i] = bflo(w.x); q[8 * i + 1] = bfhi(w.x); q[8 * i + 2] = bflo(w.y); q[8 * i + 3] = bfhi(w.y); q[8 * i + 4] = bflo(w.z); q[8 * i + 5] = bfhi(w.z); q[8 * i + 6] = bflo(w.w); q[8 * i + 7] = bfhi(w.w); }
}
__device__ __forceinline__ float dot64bf(const bf16_t* p, const float (&q)[64]) {
    float d = 0.f;
#pragma unroll
    for (int i = 0; i < 8; ++i) { const u32x4 w = ((const u32x4*)p)[i];
        d += q[8 * i] * bflo(w.x) + q[8 * i + 1] * bfhi(w.x) + q[8 * i + 2] * bflo(w.y) + q[8 * i + 3] * bfhi(w.y) + q[8 * i + 4] * bflo(w.z) + q[8 * i + 5] * bfhi(w.z) + q[8 * i + 6] * bflo(w.w) + q[8 * i + 7] * bfhi(w.w); }
    return d;
}
__device__ __forceinline__ float dot64f(const float* p, const float (&q)[64]) {
    float d = 0.f;
#pragma unroll
    for (int i = 0; i < 16; ++i) { const f32x4 w = ((const f32x4*)p)[i]; d += (q[4 * i] * w.x + q[4 * i + 1] * w.y) + (q[4 * i + 2] * w.z + q[4 * i + 3] * w.w); }
    return d;
}
__device__ __forceinline__ void sb_unit(const Ctx& X, int qt, int bh) {
    const int b = bh >> 3, hh = bh & 7, t = qt * 64 + X.lane;
    const bf16_t* base = (const bf16_t*)(X.ws + WS_BIG) + (size_t)b * S * PROJ_LD;
    float q[64], acc[64];
    ld64bf(base + (size_t)t * PROJ_LD + OFF_SBQ + hh * 64, q);
#pragma unroll
    for (int d = 0; d < 64; ++d) acc[d] = 0.f;
    float run = 0.f;
    for (int j = qt * 64 + 62; j >= 0; --j) {
        const bf16_t* kr = base + (size_t)j * PROJ_LD + OFF_SBK + hh * 64;
        const float logit = dot64bf(kr, q) * 0.125f;
        if (j < t) {
            const float w = expf(logsig(logit) + run);
            run += logsig(-logit);
            const bf16_t* vr = base + (size_t)j * PROJ_LD + OFF_SBV + hh * 64;
#pragma unroll
            for (int i = 0; i < 8; ++i) { const u32x4 v = ((const u32x4*)vr)[i];
                acc[8 * i] += w * bflo(v.x); acc[8 * i + 1] += w * bfhi(v.x); acc[8 * i + 2] += w * bflo(v.y); acc[8 * i + 3] += w * bfhi(v.y);
                acc[8 * i + 4] += w * bflo(v.z); acc[8 * i + 5] += w * bfhi(v.z); acc[8 * i + 6] += w * bflo(v.w); acc[8 * i + 7] += w * bfhi(v.w); }
        }
    }
    bf16_t* op = (bf16_t*)(X.ws + WS_O) + (size_t)(b * S + t) * D + hh * 64;
#pragma unroll
    for (int i = 0; i < 8; ++i) { u32x4 w; w.x = pk2(acc[8 * i], acc[8 * i + 1]); w.y = pk2(acc[8 * i + 2], acc[8 * i + 3]); w.z = pk2(acc[8 * i + 4], acc[8 * i + 5]); w.w = pk2(acc[8 * i + 6], acc[8 * i + 7]);
        ((u32x4*)op)[i] = w; }
}

#define DMA16(gptr, ldsptr) __builtin_amdgcn_global_load_lds((const unsigned*)(gptr), (LAS unsigned*)(ldsptr), 16, 0, 0)
#define RING2_WAIT_BAR(q, nb) do { const int issued_ = (q) + 6 < (nb) ? (q) + 6 : (nb); const int need_ = (q) + 2 < (nb) ? (q) + 2 : (nb); const int fl_ = issued_ - need_; \
        if (fl_ >= 4) asm volatile("s_waitcnt vmcnt(8)\n\ts_barrier" ::: "memory"); else if (fl_ == 3) asm volatile("s_waitcnt vmcnt(6)\n\ts_barrier" ::: "memory"); \
        else if (fl_ == 2) asm volatile("s_waitcnt vmcnt(4)\n\ts_barrier" ::: "memory"); else if (fl_ == 1) asm volatile("s_waitcnt vmcnt(2)\n\ts_barrier" ::: "memory"); \
        else asm volatile("s_waitcnt vmcnt(0)\n\ts_barrier" ::: "memory"); } while (0)
__device__ __forceinline__ int pi32(int r) { return (r & 0x13) | ((r & 4) << 1) | ((r & 8) >> 1); }
__device__ __forceinline__ void sb_attn_unit(const Ctx& X, int bh, int qb) {
    const int b = bh >> 3, h = bh & 7, q0 = qb * 256, lane = fresh(X.lane), w = X.wave, ql = lane & 31, hf = lane >> 5;
    const bf16_t* proj = (const bf16_t*)(X.ws + WS_BIG) + (size_t)b * S * PROJ_LD;
    const bf16_t* vt = (const bf16_t*)(X.ws + WS_VT) + (size_t)(h * 64) * T + (size_t)b * S;
    const int tq = q0 + 32 * w + ql;
    bf16x8 qf[4];
#pragma unroll
    for (int s = 0; s < 4; ++s) qf[s] = *(const bf16x8*)(proj + (size_t)tq * PROJ_LD + OFF_SBQ + h * 64 + 16 * s + 8 * hf);
    f32x16 o0, o1;
#pragma unroll
    for (int i = 0; i < 16; ++i) { o0[i] = 0.f; o1[i] = 0.f; }
    float run = 1.f;
    const int nblk = 4 * qb + 4, jw = (q0 + 32 * w + 30) >> 6;
    const float CS = 0.125f * 1.4426950408889634f;
    const bf16_t* kg = proj + (size_t)lane * PROJ_LD + OFF_SBK + h * 64 + 8 * w;
    const bf16_t* vg = vt + (size_t)lane * T + 8 * w;
    LAS unsigned char* ring = X.lds + w * 1024;
    const int krow = pi32(ql) * 16;
    asm volatile("s_waitcnt vmcnt(0)" ::: "memory");
#pragma unroll
    for (int d = 0; d < 6; ++d) if (d < nblk) { DMA16(kg + (size_t)(64 * (nblk - 1 - d)) * PROJ_LD, ring + d * 16384); DMA16(vg + 64 * (nblk - 1 - d), ring + d * 16384 + 8192); }
    for (int q = 0; q < nblk; ++q) {
        const int j = nblk - 1 - q;
        if ((q & 1) == 0) {
            SUB_BEGIN(X, 11);
            RING2_WAIT_BAR(q, nblk);
            SUB_END(X, 11);
#pragma unroll
            for (int d = 6; d < 8; ++d) if (q + d < nblk) { const int jj = nblk - 1 - (q + d), sl = (q + d) & 7; DMA16(kg + (size_t)(64 * jj) * PROJ_LD, ring + sl * 16384); DMA16(vg + 64 * jj, ring + sl * 16384 + 8192); }
        }
        LAS unsigned char* buf = X.lds + (q & 7) * 16384;
        SUB_BEGIN(X, 12);
        if (j <= jw) {
            const bool diag = 64 * j + 63 >= q0 + 32 * w;
#pragma unroll
            for (int kt = 1; kt >= 0; --kt) {
                f32x16 sc;
#pragma unroll
                for (int i = 0; i < 16; ++i) sc[i] = 0.f;
#pragma unroll
                for (int s = 0; s < 4; ++s) { const bf16x8 kf = *(const LAS bf16x8*)(buf + (2 * s + hf) * 1024 + kt * 512 + krow); sc = __builtin_amdgcn_mfma_f32_32x32x16_bf16(kf, qf[s], sc, 0, 0, 0); }
                f32x16 ee = sc * (-CS), be, kp;
#pragma unroll
                for (int i = 0; i < 16; ++i) ee[i] = __builtin_amdgcn_exp2f(ee[i]);
                be = ee + 1.f;
#pragma unroll
                for (int i = 0; i < 16; ++i) be[i] = __builtin_amdgcn_rcpf(be[i]);
                kp = ee * be;
                if (diag) {
                    asm volatile("; diagonal block: masks" ::: "memory");
                    const int pos0 = 64 * j + 32 * kt + 8 * hf;
#pragma unroll
                    for (int i = 0; i < 16; ++i) { const bool valid = (pos0 + 16 * (i >> 3) + (i & 7)) < tq; be[i] = valid ? be[i] : 0.f; kp[i] = valid ? kp[i] : 1.f; }
                }
                float l1 = 1.f, l0 = 1.f;
#pragma unroll
                for (int i = 15; i >= 8; --i) { const float t = be[i] * l1; l1 *= kp[i]; be[i] = t; }
#pragma unroll
                for (int i = 7; i >= 0; --i) { const float t = be[i] * l0; l0 *= kp[i]; be[i] = t; }
                const float p1 = __shfl_xor(l1, 32), p0 = __shfl_xor(l0, 32);
                const float hi1 = hf ? l1 : p1, lo1 = hf ? p1 : l1, hi0 = hf ? l0 : p0, lo0 = hf ? p0 : l0;
                const float r1 = run * hi1, r2 = r1 * lo1, r3 = r2 * hi0;
                const float pre_up = hf ? run : r1, pre_lo = hf ? r2 : r3;
                run = r3 * lo0;
#pragma unroll
                for (int a = 0; a < 2; ++a) {
                    const float pre = a ? pre_up : pre_lo;
                    u32x4 pw; pw.x = pk2(be[8 * a] * pre, be[8 * a + 1] * pre); pw.y = pk2(be[8 * a + 2] * pre, be[8 * a + 3] * pre); pw.z = pk2(be[8 * a + 4] * pre, be[8 * a + 5] * pre); pw.w = pk2(be[8 * a + 6] * pre, be[8 * a + 7] * pre);
                    const bf16x8 pf = __builtin_bit_cast(bf16x8, pw);
                    const bf16x8 v0 = *(const LAS bf16x8*)(buf + 8192 + (4 * kt + 2 * a + hf) * 1024 + ql * 16);
                    const bf16x8 v1 = *(const LAS bf16x8*)(buf + 8192 + (4 * kt + 2 * a + hf) * 1024 + 512 + ql * 16);
                    o0 = __builtin_amdgcn_mfma_f32_32x32x16_bf16(v0, pf, o0, 0, 0, 0);
                    o1 = __builtin_amdgcn_mfma_f32_32x32x16_bf16(v1, pf, o1, 0, 0, 0);
                }
            }
        }
        SUB_END(X, 12);
    }
    asm volatile("s_barrier" ::: "memory");
    bf16_t* op = (bf16_t*)(X.ws + WS_O) + (size_t)(b * S + fresh(tq)) * D + h * 64 + 4 * hf;
#pragma unroll
    for (int g4 = 0; g4 < 4; ++g4) {
        u32x2 w0; w0.x = pk2(o0[4 * g4], o0[4 * g4 + 1]); w0.y = pk2(o0[4 * g4 + 2], o0[4 * g4 + 3]); *(u32x2*)(op + 8 * g4) = w0;
        u32x2 w1; w1.x = pk2(o1[4 * g4], o1[4 * g4 + 1]); w1.y = pk2(o1[4 * g4 + 2], o1[4 * g4 + 3]); *(u32x2*)(op + 32 + 8 * g4) = w1;
    }
}
__device__ __forceinline__ void ph_sb(const Ctx& X) {
    for (int pr = X.bid; pr < 256; pr += X.G)
#pragma unroll 1
        for (int u = 0; u < 2; ++u) { const int bh = pr >> 3, qa = pr & 7; sb_attn_unit(X, bh, u ? qa : 15 - qa); }
}
__device__ __forceinline__ void ph_attn_a(const Params& p, const Ctx& X) {
    const bf16_t* proj = (const bf16_t*)(X.ws + WS_BIG);
    for (int unit = X.bid; unit < 128; unit += X.G) {
        const int kv = unit >> 6, bg = (unit >> 3) & 7, ntile = unit & 7, b = bg >> 1, g = bg & 1, lane = fresh(X.lane), w = X.wave, ql = lane & 31, hf = lane >> 5;
        const int n = min(32 * ntile + ql, NCMP - 1);
        const float* pe = kv ? p.in[11] : p.in[10];
        const bf16_t* w1t = (const bf16_t*)(X.ws + WS_W1T) + (size_t)kv * 128 * 2048;
        const bf16_t* arow = proj + (size_t)(b * S + n * 16) * PROJ_LD + (kv ? OFF_VC : OFF_KC) + g * 64;
        f32x16 acc[4];
#pragma unroll
        for (int ct = 0; ct < 4; ++ct)
#pragma unroll
            for (int i = 0; i < 16; ++i) acc[ct][i] = 0.f;
        for (int ks = 0; ks < 16; ++ks) {
            const int k0 = 256 * w + 16 * ks + 8 * hf, l = k0 >> 6, d = k0 & 63;
            const u32x4 q = *(const u32x4*)(arow + (size_t)l * PROJ_LD + d);
            const f32x4 e0 = *(const f32x4*)(pe + k0), e1 = *(const f32x4*)(pe + k0 + 4);
            u32x4 o; o.x = pk2(bflo(q.x) + e0.x, bfhi(q.x) + e0.y); o.y = pk2(bflo(q.y) + e0.z, bfhi(q.y) + e0.w); o.z = pk2(bflo(q.z) + e1.x, bfhi(q.z) + e1.y); o.w = pk2(bflo(q.w) + e1.z, bfhi(q.w) + e1.w);
            const bf16x8 af = __builtin_bit_cast(bf16x8, o);
#pragma unroll
            for (int ct = 0; ct < 4; ++ct) acc[ct] = __builtin_amdgcn_mfma_f32_32x32x16_bf16(af, *(const bf16x8*)(w1t + (size_t)(32 * ct + ql) * 2048 + k0), acc[ct], 0, 0, 0);
        }
        LAS float* part = (LAS float*)X.lds;
#pragma unroll
        for (int ct = 0; ct < 4; ++ct)
#pragma unroll
            for (int i = 0; i < 16; ++i) part[w * 4096 + (8 * (i >> 2) + 4 * hf + (i & 3)) * 128 + 32 * ct + ql] = acc[ct][i];
        __syncthreads();
        LAS float* hid = part;
        {
            const int tidf = fresh(X.tid);
#pragma unroll
            for (int k = 0; k < 8; ++k) { const int e = tidf + NTHREADS * k; float v = 0.f;
#pragma unroll
                for (int ww = 0; ww < 8; ++ww) v += part[ww * 4096 + e];
                hid[e] = siluf(v); }
        }
        __syncthreads();
        {
            const int tidf = fresh(X.tid), row = tidf >> 4, c4 = (tidf & 15) * 4;
            const float* w2 = kv ? p.in[15] : p.in[13];
            f32x4 o = (f32x4){0.f, 0.f, 0.f, 0.f};
            for (int j = 0; j < 128; ++j) o = o + *(const f32x4*)(w2 + j * 64 + c4) * hid[row * 128 + j];
            const int nn = 32 * ntile + row;
            if (kv == 0) {
                float ssq = (o.x * o.x + o.y * o.y) + (o.z * o.z + o.w * o.w);
                ssq += __shfl_xor(ssq, 1); ssq += __shfl_xor(ssq, 2); ssq += __shfl_xor(ssq, 4); ssq += __shfl_xor(ssq, 8);
                const float r = rsqrtf(ssq * (1.f / 64.f) + EPS); const f32x4 gn = *(const f32x4*)(p.in[9] + c4);
                o = o * r * gn;
                if (nn >= NCMP) o = (f32x4){0.f, 0.f, 0.f, 0.f};
                u32x2 wv; wv.x = pk2(o.x, o.y); wv.y = pk2(o.z, o.w);
                *(u32x2*)((bf16_t*)(X.ws + WS_KCB) + ((size_t)bg * 256 + nn) * 64 + c4) = wv;
            } else {
                if (nn >= NCMP) o = (f32x4){0.f, 0.f, 0.f, 0.f};
                bf16_t* vt = (bf16_t*)(X.ws + WS_VCT) + ((size_t)bg * 64 + c4) * 256 + nn;
                vt[0] = (bf16_t)f2bf(o.x); vt[256] = (bf16_t)f2bf(o.y); vt[512] = (bf16_t)f2bf(o.z); vt[768] = (bf16_t)f2bf(o.w);
            }
        }
        __syncthreads();
    }
    for (int t2 = X.gw; t2 < T / 2; t2 += X.ngw) {
        const int lane = fresh(X.lane), sub = lane & 7;
#pragma unroll
        for (int k = 0; k < 2; ++k) {
            const int t = 2 * t2 + k;
            const u32x4 q = *(const u32x4*)(proj + (size_t)t * PROJ_LD + OFF_NQ + 8 * lane);
            float v[8] = {bflo(q.x), bfhi(q.x), bflo(q.y), bfhi(q.y), bflo(q.z), bfhi(q.z), bflo(q.w), bfhi(q.w)};
            float ssq = 0.f;
#pragma unroll
            for (int i = 0; i < 8; ++i) ssq += v[i] * v[i];
            ssq += __shfl_xor(ssq, 1); ssq += __shfl_xor(ssq, 2); ssq += __shfl_xor(ssq, 4);
            const float r = rsqrtf(ssq * (1.f / 64.f) + EPS) * (0.125f * 1.4426950408889634f);
            const f32x4 g0 = *(const f32x4*)(p.in[8] + 8 * sub), g1 = *(const f32x4*)(p.in[8] + 8 * sub + 4);
            u32x4 o; o.x = pk2(v[0] * r * g0.x, v[1] * r * g0.y); o.y = pk2(v[2] * r * g0.z, v[3] * r * g0.w); o.z = pk2(v[4] * r * g1.x, v[5] * r * g1.y); o.w = pk2(v[6] * r * g1.z, v[7] * r * g1.w);
            *(u32x4*)((bf16_t*)(X.ws + WS_QNB) + (size_t)t * 512 + 8 * lane) = o;
        }
        {
            const int t = 2 * t2 + (lane >> 5), l32 = lane & 31, isw = l32 >> 4, c = 8 * (l32 & 15);
            const u32x4 q = *(const u32x4*)(proj + (size_t)t * PROJ_LD + (isw ? OFF_KW : OFF_KS) + c);
            float v[8] = {bflo(q.x), bfhi(q.x), bflo(q.y), bfhi(q.y), bflo(q.z), bfhi(q.z), bflo(q.w), bfhi(q.w)};
            float ssq = 0.f;
#pragma unroll
            for (int i = 0; i < 8; ++i) ssq += v[i] * v[i];
            ssq += __shfl_xor(ssq, 1); ssq += __shfl_xor(ssq, 2); ssq += __shfl_xor(ssq, 4);
            const float r = rsqrtf(ssq * (1.f / 64.f) + EPS);
            const float* gn = p.in[9] + (isw ? 128 : 64) + 8 * sub;
            const f32x4 g0 = *(const f32x4*)gn, g1 = *(const f32x4*)(gn + 4);
            u32x4 o; o.x = pk2(v[0] * r * g0.x, v[1] * r * g0.y); o.y = pk2(v[2] * r * g0.z, v[3] * r * g0.w); o.z = pk2(v[4] * r * g1.x, v[5] * r * g1.y); o.w = pk2(v[6] * r * g1.z, v[7] * r * g1.w);
            *(u32x4*)((bf16_t*)(X.ws + (isw ? WS_KWN : WS_KSN)) + (size_t)t * 128 + c) = o;
        }
    }
}
struct NsaSt { f32x16 o0, o1; float m, l; };
template <int MODE>
__device__ __forceinline__ void nsa_flash(const Ctx& X, const bf16_t* kg, const bf16_t* vg, int jlo, int jhi, const bf16x8 (&qf)[4], int tq, float slope2,
                                          unsigned long long mymask, unsigned long long wavemask, NsaSt& st) {
    const int lane = fresh(X.lane), w = X.wave, ql = lane & 31, hf = lane >> 5;
    LAS unsigned char* ring = X.lds + w * 1024;
    const int krow = pi32(ql) * 16, nb = jhi - jlo + 1;
    asm volatile("s_waitcnt vmcnt(0)" ::: "memory");
#pragma unroll
    for (int d = 0; d < 6; ++d) if (d < nb) { DMA16(kg + (size_t)(64 * (jhi - d)) * 128, ring + d * 16384); DMA16(vg + 64 * (jhi - d), ring + d * 16384 + 8192); }
    f32x16 sl;
#pragma unroll
    for (int i = 0; i < 16; ++i) sl[i] = slope2 * (float)(16 * (i >> 3) + (i & 7));
    const float k32 = slope2 * 32.f;
    for (int q = 0; q < nb; ++q) {
        const int j = jhi - q;
        if ((q & 1) == 0) {
            SUB_BEGIN(X, 21);
            RING2_WAIT_BAR(q, nb);
            SUB_END(X, 21);
#pragma unroll
            for (int d = 6; d < 8; ++d) if (q + d < nb) { const int jj = jhi - (q + d), sl2 = (q + d) & 7; DMA16(kg + (size_t)(64 * jj) * 128, ring + sl2 * 16384); DMA16(vg + 64 * jj, ring + sl2 * 16384 + 8192); }
        }
        LAS unsigned char* buf = X.lds + (q & 7) * 16384;
        SUB_BEGIN(X, 22);
        if (MODE == 1 || ((wavemask >> j) & 1ull)) {
            f32x16 s0, s1;
#pragma unroll
            for (int i = 0; i < 16; ++i) { s0[i] = 0.f; s1[i] = 0.f; }
#pragma unroll
            for (int s = 0; s < 4; ++s) {
                const bf16x8 k0 = *(const LAS bf16x8*)(buf + (2 * s + hf) * 1024 + krow), k1 = *(const LAS bf16x8*)(buf + (2 * s + hf) * 1024 + 512 + krow);
                s0 = __builtin_amdgcn_mfma_f32_32x32x16_bf16(k0, qf[s], s0, 0, 0, 0); s1 = __builtin_amdgcn_mfma_f32_32x32x16_bf16(k1, qf[s], s1, 0, 0, 0);
            }
            const int d0 = tq - (64 * j + 8 * hf);
            if (j == jhi || (MODE == 1 && j == jlo)) {
                asm volatile("; boundary block: masks" ::: "memory");
#pragma unroll
                for (int i = 0; i < 16; ++i) {
                    const int da = d0 - (16 * (i >> 3) + (i & 7)), db = da - 32;
                    s0[i] = (da >= 0 && (MODE == 0 || da < 512)) ? s0[i] : -INFINITY; s1[i] = (db >= 0 && (MODE == 0 || db < 512)) ? s1[i] : -INFINITY;
                }
            }
            s0 = s0 + sl; s1 = s1 + sl;
            float mb0 = fmaxf(s0[0], s0[1]), mb1 = fmaxf(s1[0], s1[1]);
#pragma unroll
            for (int i = 2; i < 16; ++i) { mb0 = fmaxf(mb0, s0[i]); mb1 = fmaxf(mb1, s1[i]); }
            const float base = slope2 * (float)d0;
            const bool sel = MODE == 1 || ((mymask >> j) & 1ull);
            float mb = fmaxf(mb0, mb1 + k32) - base;
            mb = sel ? mb : -INFINITY;
            mb = fmaxf(mb, __shfl_xor(mb, 32));
            const float mn = fmaxf(st.m, mb), ms = mn == -INFINITY ? 0.f : mn;
            if (__any(mn > st.m)) {
                const float alpha = __builtin_amdgcn_exp2f(st.m - ms);
                st.l *= alpha;
#pragma unroll
                for (int i = 0; i < 16; ++i) { st.o0[i] *= alpha; st.o1[i] *= alpha; }
                st.m = mn;
            }
            const float off0 = sel ? ms + base : INFINITY, off1 = off0 - k32;
            s0 = s0 - off0; s1 = s1 - off1;
            float ls = 0.f;
#pragma unroll
            for (int i = 0; i < 16; ++i) { s0[i] = __builtin_amdgcn_exp2f(s0[i]); s1[i] = __builtin_amdgcn_exp2f(s1[i]); ls += s0[i] + s1[i]; }
            st.l += ls;
#pragma unroll
            for (int kt = 0; kt < 2; ++kt)
#pragma unroll
                for (int a = 0; a < 2; ++a) {
                    u32x4 pw;
                    if (kt == 0) { pw.x = pk2(s0[8 * a], s0[8 * a + 1]); pw.y = pk2(s0[8 * a + 2], s0[8 * a + 3]); pw.z = pk2(s0[8 * a + 4], s0[8 * a + 5]); pw.w = pk2(s0[8 * a + 6], s0[8 * a + 7]); }
                    else { pw.x = pk2(s1[8 * a], s1[8 * a + 1]); pw.y = pk2(s1[8 * a + 2], s1[8 * a + 3]); pw.z = pk2(s1[8 * a + 4], s1[8 * a + 5]); pw.w = pk2(s1[8 * a + 6], s1[8 * a + 7]); }
                    const bf16x8 pf = __builtin_bit_cast(bf16x8, pw);
                    const bf16x8 v0 = *(const LAS bf16x8*)(buf + 8192 + (4 * kt + 2 * a + hf) * 1024 + ql * 16);
                    const bf16x8 v1 = *(const LAS bf16x8*)(buf + 8192 + (4 * kt + 2 * a + hf) * 1024 + 512 + ql * 16);
                    st.o0 = __builtin_amdgcn_mfma_f32_32x32x16_bf16(v0, pf, st.o0, 0, 0, 0);
                    st.o1 = __builtin_amdgcn_mfma_f32_32x32x16_bf16(v1, pf, st.o1, 0, 0, 0);
                }
        }
        SUB_END(X, 22);
    }
    asm volatile("s_barrier" ::: "memory");
}
__device__ __forceinline__ void nsa_unit(const Ctx& X, int bg, int qb) {
    const int b = bg >> 1, g = bg & 1, lane = fresh(X.lane), w = X.wave, ql = lane & 31, hf = lane >> 5, r = ql >> 3, hh = g * 4 + r;
    const int t0 = 64 * qb, tq = t0 + 8 * w + (ql & 7);
    const float slope2 = exp2f(-(float)(hh + 1)) * 1.4426950408889634f;
    const bf16_t* proj = (const bf16_t*)(X.ws + WS_BIG);
    bf16x8 qf[4];
    { const bf16_t* qp = (const bf16_t*)(X.ws + WS_QNB) + (size_t)(b * S + tq) * 512 + hh * 64 + 8 * hf;
#pragma unroll
      for (int s = 0; s < 4; ++s) qf[s] = *(const bf16x8*)(qp + 16 * s); }
    float gate[3];
    { const bf16_t* gp = proj + (size_t)(b * S + tq) * PROJ_LD + OFF_GATE + hh * 3;
#pragma unroll
      for (int i = 0; i < 3; ++i) gate[i] = 1.f / (1.f + __expf(-bf2f(gp[i]))); }
    f32x16 of0, of1;
#pragma unroll
    for (int i = 0; i < 16; ++i) { of0[i] = 0.f; of1[i] = 0.f; }
    NsaSt st;
    SUB_BEGIN(X, 23);
    LAS float* pacc = (LAS float*)(X.lds + 65536) + w * 2048;
    {
        const int ncm = t0 + 63 >= 31 ? (t0 + 63 - 31) / 16 + 1 : 0, nt = (ncm + 31) >> 5, ncv = tq >= 31 ? (tq - 31) / 16 + 1 : 0;
        {
            const bf16_t* kc = (const bf16_t*)(X.ws + WS_KCB) + (size_t)bg * 256 * 64; const bf16_t* vc = (const bf16_t*)(X.ws + WS_VCT) + (size_t)bg * 64 * 256;
            const int tidf = fresh(X.tid);
#pragma unroll
            for (int i = 0; i < 4; ++i) { const int pidx = tidf + NTHREADS * i;
                *(LAS u32x4*)(X.lds + (pidx >> 8) * 4096 + (pidx & 255) * 16) = *(const u32x4*)(kc + (size_t)(pidx & 255) * 64 + 8 * (pidx >> 8));
                *(LAS u32x4*)(X.lds + 32768 + (pidx >> 6) * 1024 + (pidx & 63) * 16) = *(const u32x4*)(vc + (size_t)(pidx & 63) * 256 + 8 * (pidx >> 6)); }
#pragma unroll
            for (int i = 0; i < 8; ++i) *(LAS f32x4*)(pacc + (i * 64 + lane) * 4) = (f32x4){0.f, 0.f, 0.f, 0.f};
        }
        __syncthreads();
        const int krow = pi32(ql) * 16;
        float ml = -INFINITY, ll = 0.f;
        for (int kt = 0; kt < nt; ++kt) {
            f32x16 sc;
#pragma unroll
            for (int i = 0; i < 16; ++i) sc[i] = 0.f;
#pragma unroll
            for (int s = 0; s < 4; ++s) { const bf16x8 kf = *(const LAS bf16x8*)(X.lds + (2 * s + hf) * 4096 + kt * 512 + krow); sc = __builtin_amdgcn_mfma_f32_32x32x16_bf16(kf, qf[s], sc, 0, 0, 0); }
            float tm = -INFINITY;
#pragma unroll
            for (int i = 0; i < 16; ++i) { const int n = 32 * kt + 16 * (i >> 3) + 8 * hf + (i & 7);
                sc[i] = n < ncv ? sc[i] - slope2 * (float)(tq - (16 * n + 31)) : -INFINITY; tm = fmaxf(tm, sc[i]); }
            const float mn = fmaxf(ml, tm), ms = mn == -INFINITY ? 0.f : mn;
            float ls = 0.f;
#pragma unroll
            for (int i = 0; i < 16; ++i) ls += __builtin_amdgcn_exp2f(sc[i] - ms);
            ll = ll * __builtin_amdgcn_exp2f(ml - ms) + ls; ml = mn;
        }
        float ms, inv;
        { const float mo = __shfl_xor(ml, 32), lo = __shfl_xor(ll, 32), mt = fmaxf(ml, mo); ms = mt == -INFINITY ? 0.f : mt;
          const float lt = ll * __builtin_amdgcn_exp2f(ml - ms) + lo * __builtin_amdgcn_exp2f(mo - ms); inv = lt > 0.f ? 1.f / lt : 0.f; }
#pragma unroll
        for (int i = 0; i < 16; ++i) { st.o0[i] = 0.f; st.o1[i] = 0.f; }
        float carry = 0.f;
        for (int kt = 0; kt < nt; ++kt) {
            f32x16 sc;
#pragma unroll
            for (int i = 0; i < 16; ++i) sc[i] = 0.f;
#pragma unroll
            for (int s = 0; s < 4; ++s) { const bf16x8 kf = *(const LAS bf16x8*)(X.lds + (2 * s + hf) * 4096 + kt * 512 + krow); sc = __builtin_amdgcn_mfma_f32_32x32x16_bf16(kf, qf[s], sc, 0, 0, 0); }
#pragma unroll
            for (int i = 0; i < 16; ++i) { const int n = 32 * kt + 16 * (i >> 3) + 8 * hf + (i & 7);
                sc[i] = n < ncv ? __builtin_amdgcn_exp2f(sc[i] - slope2 * (float)(tq - (16 * n + 31)) - ms) * inv : 0.f; }
            const float pa0 = __shfl_xor(sc[7], 32), pa1 = __shfl_xor(sc[15], 32);
            const float prev0 = hf ? pa0 : carry, prev1 = hf ? pa1 : pa0;
            carry = pa1;
            {
                typedef float f32x2 __attribute__((ext_vector_type(2)));
                f32x2 e0, e1;
                e0.x = prev0 + ((sc[0] + sc[1]) + (sc[2] + sc[3])); e0.y = sc[3] + ((sc[4] + sc[5]) + (sc[6] + sc[7]));
                e1.x = prev1 + ((sc[8] + sc[9]) + (sc[10] + sc[11])); e1.y = sc[11] + ((sc[12] + sc[13]) + (sc[14] + sc[15]));
                *(LAS f32x2*)(pacc + ql * 64 + 8 * kt + 2 * hf) = e0; *(LAS f32x2*)(pacc + ql * 64 + 8 * kt + 4 + 2 * hf) = e1;
            }
#pragma unroll
            for (int a = 0; a < 2; ++a) {
                u32x4 pw; pw.x = pk2(sc[8 * a], sc[8 * a + 1]); pw.y = pk2(sc[8 * a + 2], sc[8 * a + 3]); pw.z = pk2(sc[8 * a + 4], sc[8 * a + 5]); pw.w = pk2(sc[8 * a + 6], sc[8 * a + 7]);
                const bf16x8 pf = __builtin_bit_cast(bf16x8, pw);
                const bf16x8 v0 = *(const LAS bf16x8*)(X.lds + 32768 + (4 * kt + 2 * a + hf) * 1024 + ql * 16);
                const bf16x8 v1 = *(const LAS bf16x8*)(X.lds + 32768 + (4 * kt + 2 * a + hf) * 1024 + 512 + ql * 16);
                st.o0 = __builtin_amdgcn_mfma_f32_32x32x16_bf16(v0, pf, st.o0, 0, 0, 0);
                st.o1 = __builtin_amdgcn_mfma_f32_32x32x16_bf16(v1, pf, st.o1, 0, 0, 0);
            }
        }
#pragma unroll
        for (int i = 0; i < 16; ++i) { of0[i] = gate[0] * st.o0[i]; of1[i] = gate[0] * st.o1[i]; }
    }
    SUB_END(X, 23);
    SUB_BEGIN(X, 24);
    unsigned long long mymask = 0ull, wavemask = 0ull;
    LDS_WAIT();
    for (int q8 = 0; q8 < 8; ++q8) {
        const int t = t0 + 8 * w + q8;
        const float ps = (pacc[(0 * 8 + q8) * 64 + lane] + pacc[(1 * 8 + q8) * 64 + lane]) + (pacc[(2 * 8 + q8) * 64 + lane] + pacc[(3 * 8 + q8) * 64 + lane]);
        const bool valid = lane * 64 <= t, forced = (lane == 0) || (lane == qb) || (lane == qb - 1);
        const unsigned key = valid ? ((forced ? 0x7f000000u : (__float_as_uint(fmaxf(ps, 0.f)) & ~63u)) | (unsigned)(63 - lane)) : 0u;
        unsigned thr = 0u;
#pragma unroll 1
        for (int bit = 30; bit >= 0; --bit) { const unsigned cand = thr | (1u << bit); if (__builtin_popcountll(__ballot(key >= cand)) >= 16) thr = cand; }
        const unsigned long long mk = __ballot(key >= thr && key != 0u);
        wavemask |= mk; if ((ql & 7) == q8) mymask = mk;
    }
    SUB_END(X, 24);
    __syncthreads();
    {
#pragma unroll
        for (int i = 0; i < 16; ++i) { st.o0[i] = 0.f; st.o1[i] = 0.f; }
        st.m = -INFINITY; st.l = 0.f;
        const int lf = fresh(lane);
        const bf16_t* kg = (const bf16_t*)(X.ws + WS_KSN) + ((size_t)b * S + lf) * 128 + g * 64 + 8 * w;
        const bf16_t* vg = (const bf16_t*)(X.ws + WS_VT) + (size_t)(512 + g * 64 + lf) * T + (size_t)b * S + 8 * w;
        nsa_flash<0>(X, kg, vg, 0, qb, qf, tq, slope2, mymask, wavemask, st);
        const float lt = st.l + __shfl_xor(st.l, 32), sc = gate[1] / fmaxf(lt, 1e-30f);
#pragma unroll
        for (int i = 0; i < 16; ++i) { of0[i] += sc * st.o0[i]; of1[i] += sc * st.o1[i]; }
    }
    {
#pragma unroll
        for (int i = 0; i < 16; ++i) { st.o0[i] = 0.f; st.o1[i] = 0.f; }
        st.m = -INFINITY; st.l = 0.f;
        const int lf = fresh(lane);
        const bf16_t* kg = (const bf16_t*)(X.ws + WS_KWN) + ((size_t)b * S + lf) * 128 + g * 64 + 8 * w;
        const bf16_t* vg = (const bf16_t*)(X.ws + WS_VT) + (size_t)(640 + g * 64 + lf) * T + (size_t)b * S + 8 * w;
        nsa_flash<1>(X, kg, vg, qb >= 8 ? qb - 8 : 0, qb, qf, tq, slope2, 0ull, 0ull, st);
        const float lt = st.l + __shfl_xor(st.l, 32), sc = gate[2] / fmaxf(lt, 1e-30f);
#pragma unroll
        for (int i = 0; i < 16; ++i) { of0[i] += sc * st.o0[i]; of1[i] += sc * st.o1[i]; }
    }
    bf16_t* op = (bf16_t*)(X.ws + WS_O) + (size_t)(b * S + fresh(tq)) * D + 512 + hh * 64 + 4 * hf;
#pragma unroll
    for (int g4 = 0; g4 < 4; ++g4) {
        u32x2 w0; w0.x = pk2(of0[4 * g4], of0[4 * g4 + 1]); w0.y = pk2(of0[4 * g4 + 2], of0[4 * g4 + 3]); *(u32x2*)(op + 8 * g4) = w0;
        u32x2 w1; w1.x = pk2(of1[4 * g4], of1[4 * g4 + 1]); w1.y = pk2(of1[4 * g4 + 2], of1[4 * g4 + 3]); *(u32x2*)(op + 32 + 8 * g4) = w1;
    }
}
__device__ __forceinline__ void ph_nsa(const Params& p, const Ctx& X) {
    for (int pr = X.bid; pr < 256; pr += X.G)
#pragma unroll 1
        for (int u = 0; u < 2; ++u) { const int bg = pr >> 5, qa = pr & 31; nsa_unit(X, bg, u ? qa : 63 - qa); }
}

__device__ __forceinline__ float silu_fast(float v) { return v * __builtin_amdgcn_rcpf(1.f + __expf(-v)); }
constexpr int S1_WL = RING_BYTES + 4096;
__device__ __forceinline__ void ph_ssd1(const Params& p, const Ctx& X) {
    const float* cw = p.in[17]; const float* cb = p.in[18];
    LAS float* wl = (LAS float*)(X.lds + S1_WL);
    LAS unsigned char* ldsB = X.lds;
    LAS unsigned char* ldsX = X.lds + 65536;
    for (int unit = X.bid; unit < 256; unit += X.G) {
        const int b = unit >> 6, c = (unit >> 2) & 15, g = unit & 3, tl0 = c * 256, lane = fresh(X.lane), w = X.wave, ql = lane & 31, hf = lane >> 5;
        const size_t t0 = (size_t)b * S + tl0;
        SUB_BEGIN(X, 41);
        {
            const int h = g * 8 + w;
            const float a = -expf(p.in[20][h]), dtb = p.in[19][h];
            const float* dr = (const float*)(X.ws + WS_DT) + (t0 + 4 * lane) * 32 + h;
            float dt[4], cs[4];
#pragma unroll
            for (int k = 0; k < 4; ++k) { const float raw = dr[k * 32] + dtb; dt[k] = raw > 20.f ? raw : log1pf(expf(raw)); }
            cs[0] = dt[0] * a; cs[1] = cs[0] + dt[1] * a; cs[2] = cs[1] + dt[2] * a; cs[3] = cs[2] + dt[3] * a;
            float incl = cs[3];
#pragma unroll
            for (int o = 1; o < 64; o <<= 1) { const float u = __shfl_up(incl, o); if (lane >= o) incl += u; }
            const float excl = incl - cs[3], last = __shfl(incl, 63);
#pragma unroll
            for (int k = 0; k < 4; ++k) cs[k] += excl;
            *(f32x4*)((float*)(X.ws + WS_DT2) + (size_t)(b * 32 + h) * S + tl0 + 4 * lane) = (f32x4){dt[0], dt[1], dt[2], dt[3]};
            *(f32x4*)((float*)(X.ws + WS_CS) + (size_t)(b * 32 + h) * S + tl0 + 4 * lane) = (f32x4){cs[0], cs[1], cs[2], cs[3]};
            *(LAS f32x4*)(wl + w * 256 + 4 * lane) = (f32x4){dt[0] * __expf(last - cs[0]), dt[1] * __expf(last - cs[1]), dt[2] * __expf(last - cs[2]), dt[3] * __expf(last - cs[3])};
            if (lane == 63) ((float*)(X.ws + WS_DEC))[(b * 16 + c) * 32 + h] = __expf(last);
        }
        const bf16_t* xt = (const bf16_t*)(X.ws + WS_XT); bf16_t* xct = (bf16_t*)(X.ws + WS_XCT);
        const int tidf = fresh(X.tid);
#define CONV8(rin, chg, seg, o) do { const bf16_t* src_ = xt + (size_t)(rin) * T + t0 + 8 * (seg); const u32x4 cur_ = *(const u32x4*)src_; u32x4 prv_ = (u32x4){0u, 0u, 0u, 0u}; \
            if (tl0 + 8 * (seg) >= 8) prv_ = *(const u32x4*)(src_ - 8); \
            const float x_[11] = {bfhi(prv_.z), bflo(prv_.w), bfhi(prv_.w), bflo(cur_.x), bfhi(cur_.x), bflo(cur_.y), bfhi(cur_.y), bflo(cur_.z), bfhi(cur_.z), bflo(cur_.w), bfhi(cur_.w)}; \
            const float w0_ = cw[chg], w1_ = cw[CONV_DIM + (chg)], w2_ = cw[2 * CONV_DIM + (chg)], w3_ = cw[3 * CONV_DIM + (chg)], bb_ = cb[chg]; \
            _Pragma("unroll") for (int j_ = 0; j_ < 8; ++j_) o[j_] = silu_fast(bb_ + w0_ * x_[j_] + w1_ * x_[j_ + 1] + w2_ * x_[j_ + 2] + w3_ * x_[j_ + 3]); } while (0)
        SUB_END(X, 41);
        SUB_BEGIN(X, 42);
        {
#pragma unroll
            for (int k = 0; k < 8; ++k) {
                const int it = tidf + NTHREADS * k, n = it >> 5, seg = it & 31, chg = 2048 + g * 128 + n;
                float o[8]; CONV8(g * 128 + n, chg, seg, o);
                u32x4 ov; ov.x = pk2(o[0], o[1]); ov.y = pk2(o[2], o[3]); ov.z = pk2(o[4], o[5]); ov.w = pk2(o[6], o[7]);
                *(u32x4*)(xct + (size_t)chg * T + t0 + 8 * seg) = ov;
                *(LAS u32x4*)(ldsB + seg * 2048 + n * 16) = ov;
            }
            SUB_END(X, 42);
            SUB_BEGIN(X, 43);
            const bf16_t* zbc = (const bf16_t*)(X.ws + WS_ZBC); bf16_t* bcm = (bf16_t*)(X.ws + WS_BCM);
            {
                const int c8 = tidf & 31, l0 = (tidf >> 5) * 16;
                const int col = (c8 < 16 ? g * 128 + 8 * c8 : 512 + g * 128 + 8 * (c8 - 16));
                float wk[4][8], bb[8];
                { const f32x4 b0 = *(const f32x4*)(cb + 2048 + col), b1 = *(const f32x4*)(cb + 2048 + col + 4); bb[0] = b0.x; bb[1] = b0.y; bb[2] = b0.z; bb[3] = b0.w; bb[4] = b1.x; bb[5] = b1.y; bb[6] = b1.z; bb[7] = b1.w; }
#pragma unroll
                for (int ww = 0; ww < 4; ++ww) { const f32x4 k0 = *(const f32x4*)(cw + ww * CONV_DIM + 2048 + col), k1 = *(const f32x4*)(cw + ww * CONV_DIM + 2048 + col + 4);
                    wk[ww][0] = k0.x; wk[ww][1] = k0.y; wk[ww][2] = k0.z; wk[ww][3] = k0.w; wk[ww][4] = k1.x; wk[ww][5] = k1.y; wk[ww][6] = k1.z; wk[ww][7] = k1.w; }
                u32x4 rw[19];
#pragma unroll
                for (int r = 0; r < 19; ++r) rw[r] = (tl0 + l0 - 3 + r >= 0) ? *(const u32x4*)(zbc + (t0 + l0 - 3 + r) * 3072 + 2048 + col) : (u32x4){0u, 0u, 0u, 0u};
#pragma unroll
                for (int k = 0; k < 16; ++k) {
                    float acc[8];
#pragma unroll
                    for (int i = 0; i < 8; ++i) acc[i] = bb[i];
#pragma unroll
                    for (int ww = 0; ww < 4; ++ww) { const u32x4 q = rw[k + ww];
                        acc[0] += bflo(q.x) * wk[ww][0]; acc[1] += bfhi(q.x) * wk[ww][1]; acc[2] += bflo(q.y) * wk[ww][2]; acc[3] += bfhi(q.y) * wk[ww][3];
                        acc[4] += bflo(q.z) * wk[ww][4]; acc[5] += bfhi(q.z) * wk[ww][5]; acc[6] += bflo(q.w) * wk[ww][6]; acc[7] += bfhi(q.w) * wk[ww][7]; }
                    u32x4 ov; ov.x = pk2(silu_fast(acc[0]), silu_fast(acc[1])); ov.y = pk2(silu_fast(acc[2]), silu_fast(acc[3])); ov.z = pk2(silu_fast(acc[4]), silu_fast(acc[5])); ov.w = pk2(silu_fast(acc[6]), silu_fast(acc[7]));
                    *(u32x4*)(bcm + (t0 + l0 + k) * 1024 + col) = ov;
                }
            }
        }
        SUB_END(X, 43);
#pragma unroll 1
        for (int hg = 0; hg < 4; ++hg) {
            SUB_BEGIN(X, 44);
            asm volatile("s_waitcnt lgkmcnt(0)\n\ts_barrier" ::: "memory");
#pragma unroll
            for (int k = 0; k < 8; ++k) {
                const int it = tidf + NTHREADS * k, chl = it >> 5, seg = it & 31, h8 = 2 * hg + (chl >> 6), chg = g * 512 + h8 * 64 + (chl & 63);
                float o[8]; CONV8(1024 + chg, chg, seg, o);
                u32x4 ov; ov.x = pk2(o[0], o[1]); ov.y = pk2(o[2], o[3]); ov.z = pk2(o[4], o[5]); ov.w = pk2(o[6], o[7]);
                *(u32x4*)(xct + (size_t)chg * T + t0 + 8 * seg) = ov;
                const f32x4 wa = *(const LAS f32x4*)(wl + h8 * 256 + 8 * seg), wb = *(const LAS f32x4*)(wl + h8 * 256 + 8 * seg + 4);
                u32x4 os; os.x = pk2(o[0] * wa.x, o[1] * wa.y); os.y = pk2(o[2] * wa.z, o[3] * wa.w); os.z = pk2(o[4] * wb.x, o[5] * wb.y); os.w = pk2(o[6] * wb.z, o[7] * wb.w);
                *(LAS u32x4*)(ldsX + (chl >> 6) * 32768 + seg * 1024 + (chl & 63) * 16) = os;
            }
            asm volatile("s_waitcnt lgkmcnt(0)\n\ts_barrier" ::: "memory");
            SUB_END(X, 44);
            SUB_BEGIN(X, 45);
            {
                const int hl = w >> 2, pt = (w >> 1) & 1, nt0 = 2 * (w & 1), h = g * 8 + 2 * hg + hl;
                f32x16 acc0, acc1;
#pragma unroll
                for (int i = 0; i < 16; ++i) { acc0[i] = 0.f; acc1[i] = 0.f; }
#pragma unroll 4
                for (int ks = 0; ks < 16; ++ks) {
                    const bf16x8 af = *(const LAS bf16x8*)(ldsX + hl * 32768 + (2 * ks + hf) * 1024 + (32 * pt + ql) * 16);
                    const bf16x8 b0 = *(const LAS bf16x8*)(ldsB + (2 * ks + hf) * 2048 + (32 * nt0 + ql) * 16), b1 = *(const LAS bf16x8*)(ldsB + (2 * ks + hf) * 2048 + (32 * nt0 + 32 + ql) * 16);
                    acc0 = __builtin_amdgcn_mfma_f32_32x32x16_bf16(af, b0, acc0, 0, 0, 0); acc1 = __builtin_amdgcn_mfma_f32_32x32x16_bf16(af, b1, acc1, 0, 0, 0);
                }
                float* st = (float*)(X.ws + WS_ST) + ((size_t)(b * 16 + c) * 32 + h) * 8192 + 32 * nt0 + ql;
#pragma unroll
                for (int i = 0; i < 16; ++i) { const int pr = 32 * pt + 8 * (i >> 2) + 4 * hf + (i & 3); st[pr * 128] = acc0[i]; st[pr * 128 + 32] = acc1[i]; }
            }
            SUB_END(X, 45);
        }
#undef CONV8
        __syncthreads();
    }
}
__device__ __forceinline__ void ph_ssd2(const Ctx& X) {
    const float* st = (const float*)(X.ws + WS_ST); const float* dec = (const float*)(X.ws + WS_DEC); bf16_t* pb = (bf16_t*)(X.ws + WS_PB);
    for (int e = X.bid * NTHREADS + X.tid; e < NB * 32 * 2048; e += X.G * NTHREADS) {
        const int b = e >> 16, h = (e >> 11) & 31, q4 = (e & 2047) * 4;
        f32x4 hs = (f32x4){0.f, 0.f, 0.f, 0.f};
        for (int c = 0; c < 16; ++c) {
            const size_t o = ((size_t)(b * 16 + c) * 32 + h) * 8192 + q4;
            u32x2 wv; wv.x = pk2(hs.x, hs.y); wv.y = pk2(hs.z, hs.w); *(u32x2*)(pb + o) = wv;
            hs = hs * dec[(b * 16 + c) * 32 + h] + *(const f32x4*)(st + o);
        }
    }
}
constexpr int S3_STG = 49152;
__device__ __forceinline__ void ph_ssd3(const Params& p, const Ctx& X) {
    LAS float* dtl = (LAS float*)(X.lds + 2 * S3_STG); LAS float* csl = dtl + 2048;
    constexpr int S3_TILE = 2 * S3_STG + 16384;
    static_assert(S3_TILE + 8 * 4096 <= TAB_OFF, "ssd3 LDS map");
    for (int unit = X.bid; unit < 256; unit += X.G) {
        const int b = unit >> 6, c = (unit >> 2) & 15, g = unit & 3, tl0 = c * 256, lane = fresh(X.lane), w = X.wave, ql = lane & 31, hf = lane >> 5, lq = 32 * w + ql;
        const size_t t0 = (size_t)b * S + tl0;
        LAS unsigned char* tile = X.lds + S3_TILE + w * 4096;
        const bf16_t* xg = (const bf16_t*)(X.ws + WS_XCT) + (size_t)(g * 512 + lane) * T + t0;
        const bf16_t* pg = (const bf16_t*)(X.ws + WS_PB) + ((size_t)(b * 16 + c) * 32 + g * 8) * 8192 + (size_t)lane * 128;
#define S3_ISSUE(h8, sbase) do { _Pragma("unroll") for (int cc_ = 0; cc_ < 4; ++cc_) DMA16(xg + (size_t)((h8) * 64) * T + 8 * (4 * w + cc_), X.lds + (sbase) + (4 * w + cc_) * 1024); \
            _Pragma("unroll") for (int cc_ = 0; cc_ < 2; ++cc_) DMA16(pg + (size_t)(h8) * 8192 + 8 * (2 * w + cc_), X.lds + (sbase) + 32768 + (2 * w + cc_) * 1024); } while (0)
        asm volatile("s_waitcnt vmcnt(0)" ::: "memory");
        S3_ISSUE(0, 0);
        { const int tidf = fresh(X.tid), h8 = tidf >> 6, l4 = (tidf & 63) * 4;
          *(LAS f32x4*)(dtl + h8 * 256 + l4) = *(const f32x4*)((const float*)(X.ws + WS_DT2) + (size_t)(b * 32 + g * 8 + h8) * S + tl0 + l4);
          *(LAS f32x4*)(csl + h8 * 256 + l4) = *(const f32x4*)((const float*)(X.ws + WS_CS) + (size_t)(b * 32 + g * 8 + h8) * S + tl0 + l4); }
        const bf16_t* bcm = (const bf16_t*)(X.ws + WS_BCM);
        bf16x8 cf[8];
#pragma unroll
        for (int ks = 0; ks < 8; ++ks) cf[ks] = *(const bf16x8*)(bcm + (t0 + lq) * 1024 + 512 + g * 128 + 16 * ks + 8 * hf);
        u32x4 gp[8][2];
        {
#pragma unroll
        for (int st = 0; st < 8; ++st) {
            if (st <= w) {
                f32x16 G;
#pragma unroll
                for (int i = 0; i < 16; ++i) G[i] = 0.f;
                const bf16_t* bp = bcm + (t0 + 32 * st + pi32(ql)) * 1024 + g * 128 + 8 * hf;
#pragma unroll
                for (int ks = 0; ks < 8; ++ks) G = __builtin_amdgcn_mfma_f32_32x32x16_bf16(*(const bf16x8*)(bp + 16 * ks), cf[ks], G, 0, 0, 0);
#pragma unroll
                for (int a2 = 0; a2 < 2; ++a2) { gp[st][a2].x = pk2(G[8 * a2], G[8 * a2 + 1]); gp[st][a2].y = pk2(G[8 * a2 + 2], G[8 * a2 + 3]); gp[st][a2].z = pk2(G[8 * a2 + 4], G[8 * a2 + 5]); gp[st][a2].w = pk2(G[8 * a2 + 6], G[8 * a2 + 7]); }
            } else { gp[st][0] = (u32x4){0u, 0u, 0u, 0u}; gp[st][1] = (u32x4){0u, 0u, 0u, 0u}; }
        }
        }
        float ss = 0.f;
        bf16_t* yrow = (bf16_t*)(X.ws + WS_O) + (t0 + 32 * w + (lane >> 1)) * SSM_INNER + g * 512 + 32 * (lane & 1);
        const bf16_t* zdma = (const bf16_t*)(X.ws + WS_ZBC) + (t0 + 32 * w + (lane >> 3)) * 3072 + g * 512 + 8 * ((lane & 7) ^ (lane >> 3));
        LAS unsigned char* trw = tile + (lane >> 1) * 128;
        LAS unsigned char* tac = tile + ql * 128 + 8 * hf;
#pragma unroll 1
        for (int h8 = 0; h8 < 8; ++h8) {
            const int sb = (h8 & 1) * S3_STG;
            asm volatile("s_waitcnt vmcnt(0) lgkmcnt(0)\n\ts_barrier" ::: "memory");
            if (h8 < 7) S3_ISSUE(h8 + 1, ((h8 + 1) & 1) * S3_STG);
#pragma unroll
            for (int k = 0; k < 4; ++k) DMA16(zdma + (size_t)(8 * k) * 3072 + h8 * 64, tile + k * 1024);
            f32x16 acc0, acc1;
#pragma unroll
            for (int i = 0; i < 16; ++i) { acc0[i] = 0.f; acc1[i] = 0.f; }
            {
                const LAS unsigned char* pp = X.lds + sb + 32768 + hf * 1024 + ql * 16;
#pragma unroll
                for (int ks = 0; ks < 8; ++ks) { acc0 = __builtin_amdgcn_mfma_f32_32x32x16_bf16(*(const LAS bf16x8*)(pp + ks * 2048), cf[ks], acc0, 0, 0, 0);
                                                 acc1 = __builtin_amdgcn_mfma_f32_32x32x16_bf16(*(const LAS bf16x8*)(pp + ks * 2048 + 512), cf[ks], acc1, 0, 0, 0); }
                const float e = __expf(csl[h8 * 256 + lq]);
#pragma unroll
                for (int i = 0; i < 16; ++i) { acc0[i] *= e; acc1[i] *= e; }
            }
            const float cl = csl[h8 * 256 + lq], dsk = p.in[21][g * 8 + h8];
#pragma unroll
            for (int st = 0; st < 8; ++st) {
                if (st <= w) {
                    const int s0 = 32 * st + 8 * hf;
#pragma unroll
                    for (int a2 = 0; a2 < 2; ++a2) {
                        const f32x4 d0 = *(const LAS f32x4*)(dtl + h8 * 256 + s0 + 16 * a2), d1 = *(const LAS f32x4*)(dtl + h8 * 256 + s0 + 16 * a2 + 4);
                        const f32x4 c0 = *(const LAS f32x4*)(csl + h8 * 256 + s0 + 16 * a2), c1 = *(const LAS f32x4*)(csl + h8 * 256 + s0 + 16 * a2 + 4);
                        const float dd[8] = {d0.x, d0.y, d0.z, d0.w, d1.x, d1.y, d1.z, d1.w}, cc[8] = {c0.x, c0.y, c0.z, c0.w, c1.x, c1.y, c1.z, c1.w};
                        const unsigned gw[4] = {gp[st][a2].x, gp[st][a2].y, gp[st][a2].z, gp[st][a2].w};
                        float m[8];
#pragma unroll
                        for (int j = 0; j < 8; ++j) { const int sidx = s0 + 16 * a2 + j;
                            const float gv = (j & 1) ? bfhi(gw[j >> 1]) : bflo(gw[j >> 1]);
                            float v = gv * dd[j] * __expf(fminf(cl - cc[j], 0.f));
                            if (st == w) { v = sidx > lq ? 0.f : v; v += sidx == lq ? dsk : 0.f; }
                            m[j] = v; }
                        u32x4 pw; pw.x = pk2(m[0], m[1]); pw.y = pk2(m[2], m[3]); pw.z = pk2(m[4], m[5]); pw.w = pk2(m[6], m[7]);
                        const bf16x8 pf = __builtin_bit_cast(bf16x8, pw);
                        const LAS unsigned char* xp = X.lds + sb + (4 * st + 2 * a2 + hf) * 1024 + ql * 16;
                        acc0 = __builtin_amdgcn_mfma_f32_32x32x16_bf16(*(const LAS bf16x8*)xp, pf, acc0, 0, 0, 0);
                        acc1 = __builtin_amdgcn_mfma_f32_32x32x16_bf16(*(const LAS bf16x8*)(xp + 512), pf, acc1, 0, 0, 0);
                        __builtin_amdgcn_sched_barrier(0);
                    }
                }
            }
            asm volatile("s_waitcnt vmcnt(0)" ::: "memory");
#pragma unroll
            for (int pt = 0; pt < 2; ++pt)
#pragma unroll
                for (int g4 = 0; g4 < 4; ++g4) {
                    const u32x2 z2 = *(const LAS u32x2*)(tac + (((4 * pt + g4) ^ (ql & 7)) * 16));
                    const float a0 = pt ? acc1[4 * g4] : acc0[4 * g4], a1 = pt ? acc1[4 * g4 + 1] : acc0[4 * g4 + 1], a2v = pt ? acc1[4 * g4 + 2] : acc0[4 * g4 + 2], a3 = pt ? acc1[4 * g4 + 3] : acc0[4 * g4 + 3];
                    const float v0 = a0 * silu_fast(bflo(z2.x)), v1 = a1 * silu_fast(bfhi(z2.x)), v2 = a2v * silu_fast(bflo(z2.y)), v3 = a3 * silu_fast(bfhi(z2.y));
                    ss += (v0 * v0 + v1 * v1) + (v2 * v2 + v3 * v3);
                    u32x2 o; o.x = pk2(v0, v1); o.y = pk2(v2, v3); *(LAS u32x2*)(tac + (((4 * pt + g4) ^ (ql & 7)) * 16)) = o;
                }
#pragma unroll
            for (int k = 0; k < 4; ++k) *(u32x4*)(yrow + h8 * 64 + 8 * k) = *(const LAS u32x4*)(trw + (((4 * (lane & 1) + k) ^ ((lane >> 1) & 7)) * 16));
        }
#undef S3_ISSUE
        ss += __shfl_xor(ss, 32);
        const float rs = rsqrtf(ss * (1.f / 512.f) + EPS);
        asm volatile("s_waitcnt vmcnt(0)" ::: "memory");
        {
            const int lf = fresh(lane);
            bf16_t* yb = (bf16_t*)(X.ws + WS_O) + (t0 + 32 * w) * SSM_INNER + g * 512 + 8 * lf;
            const f32x4 g0 = *(const f32x4*)(p.in[22] + g * 512 + 8 * lf), g1 = *(const f32x4*)(p.in[22] + g * 512 + 8 * lf + 4);
#pragma unroll 1
            for (int r0 = 0; r0 < 32; r0 += 8) {
                u32x4 q[8];
#pragma unroll
                for (int k = 0; k < 8; ++k) q[k] = *(const u32x4*)(yb + (size_t)(r0 + k) * SSM_INNER);
#pragma unroll
                for (int k = 0; k < 8; ++k) {
                    const float rk = __shfl(rs, r0 + k);
                    u32x4 o; o.x = pk2(bflo(q[k].x) * rk * g0.x, bfhi(q[k].x) * rk * g0.y); o.y = pk2(bflo(q[k].y) * rk * g0.z, bfhi(q[k].y) * rk * g0.w);
                    o.z = pk2(bflo(q[k].z) * rk * g1.x, bfhi(q[k].z) * rk * g1.y); o.w = pk2(bflo(q[k].w) * rk * g1.z, bfhi(q[k].w) * rk * g1.w);
                    *(u32x4*)(yb + (size_t)(r0 + k) * SSM_INNER) = o;
                }
            }
        }
        asm volatile("s_waitcnt lgkmcnt(0)\n\ts_barrier" ::: "memory");
    }
}

__device__ __forceinline__ void ph_moe_gu(const Params& p, const Ctx& X, int l) {
    moe_table(X, l);
    pg8::MoeOrder So{(const LAS int*)(X.lds + TAB_OFF), (const LAS int*)(X.lds + TAB_OFF) + 40, (const int*)(X.ws + WS_SLOT), 3, X.G, X.bid, true};
    pg8::Gemm g{(const bf16_t*)(X.ws + WS_U), (const bf16_t*)(X.ws + WS_WGU) + (size_t)l * NE * 2048 * 1024, 1024};
    pg8::EpiGu E{(bf16_t*)(X.ws + WS_ACT), p.in[27] + (size_t)l * NE * 2048};
    pg8::gemm_phase<pg8::EpiGu, pg8::MoeOrder>(X.lds, g, So, E, X.tid);
}
__device__ __forceinline__ void ph_moe_down(const Params& p, const Ctx& X, int l) {
    moe_table(X, l);
    pg8::MoeOrder So{(const LAS int*)(X.lds + TAB_OFF), (const LAS int*)(X.lds + TAB_OFF) + 40, (const int*)(X.ws + WS_SLOT), 2, X.G, X.bid, false};
    pg8::Gemm g{(const bf16_t*)(X.ws + WS_ACT), (const bf16_t*)(X.ws + WS_WDN) + (size_t)l * NE * 1024 * 1024, 1024};
    pg8::EpiDown E{(bf16_t*)(X.ws + WS_Y), p.in[29] + (size_t)l * NE * 1024};
    pg8::gemm_phase<pg8::EpiDown, pg8::MoeOrder>(X.lds, g, So, E, X.tid);
}

#ifndef PROBE_MASK
#define PROBE_MASK 0u
#endif
#ifndef PROBE_MULT
#define PROBE_MULT 8
#endif
__global__ void __launch_bounds__(NTHREADS, 2) fwd_kernel(Params p) {
    extern __shared__ __attribute__((aligned(16))) unsigned char lds_raw[];
    Ctx X;
    X.lds = (LAS unsigned char*)lds_raw; X.ws = p.ws;
    X.tid = threadIdx.x; X.lane = X.tid & 63; X.wave = __builtin_amdgcn_readfirstlane(X.tid >> 6);
    X.G = gridDim.x; X.bid = blockIdx.x; X.gw = X.bid * NWAVES + X.wave; X.ngw = X.G * NWAVES; X.sub = 0ull; X.subt = 0ull;
    if (X.tid < 4) ((LAS unsigned*)(X.lds + XB_OFF))[X.tid] = 0u;
    __syncthreads();
    XcdBarrier bar = xcd_barrier_post((unsigned*)(p.ws + WS_CTL) + CW_BAR, (volatile LAS unsigned*)(X.lds + XB_OFF));
#define PHASE_BEGIN Ctx Y = X; { GAS unsigned char* w_ = (GAS unsigned char*)p.ws; asm volatile("" : "+s"(w_)); Y.ws = (unsigned char*)w_; int t_ = threadIdx.x; asm volatile("" : "+v"(t_)); Y.tid = t_; Y.lane = t_ & 63; \
    Y.wave = __builtin_amdgcn_readfirstlane(t_ >> 6); Y.gw = Y.bid * NWAVES + Y.wave; }
#define WSF(off) ((float*)(Y.ws + (off)))
#define WSB(off) ((bf16_t*)(Y.ws + (off)))
#define PROBE_LDS(i) (((volatile LAS unsigned long long*)(X.lds + 150528))[2 * X.wave + (i)])
    if (PROBE_MASK || PROBE_SUB) { if (X.lane == 0) { PROBE_LDS(0) = __builtin_amdgcn_s_memrealtime(); PROBE_LDS(1) = 0ull; } }
#define PB(k) do { if (PROBE_MASK) { if (X.lane == 0) { const unsigned long long n_ = __builtin_amdgcn_s_memrealtime(); if ((PROBE_MASK >> (k)) & 1u) PROBE_LDS(1) += n_ - PROBE_LDS(0); PROBE_LDS(0) = n_; } } } while (0)
    { PHASE_BEGIN ph_prologue(p, Y); }                                    xcd_barrier(bar); PB(0);
    { PHASE_BEGIN ph_norm0(p, Y); }                                       xcd_barrier(bar); PB(1);
    {
        PHASE_BEGIN
        pg8::DenseOrder So; So.init(T, PROJ_LD, X.G, X.bid);
        pg8::Gemm g{WSB(WS_U), WSB(WS_WIN), 1024};
        pg8::EpiBf16 E{WSB(WS_BIG), PROJ_LD};
        pg8::gemm_phase<pg8::EpiBf16, pg8::DenseOrder>(X.lds, g, So, E, Y.tid);
    }
    {
        PHASE_BEGIN
        pg8::DenseOrder So; So.init(768, T, X.G, X.bid);
        pg8::Gemm g{WSB(WS_WV), WSB(WS_U), 1024};
        pg8::EpiBf16 E{WSB(WS_VT), T};
        pg8::gemm_phase<pg8::EpiBf16, pg8::DenseOrder>(X.lds, g, So, E, Y.tid);
    }
    xcd_barrier(bar); PB(2);
    { PHASE_BEGIN ph_attn_a(p, Y); }                                      xcd_barrier(bar); PB(3);
    { PHASE_BEGIN ph_nsa(p, Y); if (PROBE_SUB && X.lane == 0) PROBE_LDS(1) += Y.sub; }
    __syncthreads(); PB(19);
    { PHASE_BEGIN ph_sb(Y); if (PROBE_SUB && X.lane == 0) PROBE_LDS(1) += Y.sub; }                                             xcd_barrier(bar); PB(4);
    {
        PHASE_BEGIN
        pg8::DenseOrder So; So.init(T, D, X.G, X.bid);
        pg8::Gemm g{WSB(WS_O), WSB(WS_WOUT), 1024};
        pg8::EpiResid E{p.in[0], WSF(WS_H1), WSF(WS_MODF) + 2048};
        pg8::gemm_phase<pg8::EpiResid, pg8::DenseOrder>(X.lds, g, So, E, Y.tid);
    }
    xcd_barrier(bar); PB(5);
    { PHASE_BEGIN ph_token<0>(p, Y, 0, WSF(WS_H1), nullptr); if (PROBE_SUB && X.lane == 0) PROBE_LDS(1) += Y.sub; }                       xcd_barrier(bar); PB(6);
    { PHASE_BEGIN ph_moe_gu(p, Y, 0); }                                   xcd_barrier(bar); PB(7);
    { PHASE_BEGIN ph_moe_down(p, Y, 0); }                                 xcd_barrier(bar); PB(8);
    { PHASE_BEGIN ph_token<1>(p, Y, 0, WSF(WS_H1), WSF(WS_H2)); if (PROBE_SUB && X.lane == 0) PROBE_LDS(1) += Y.sub; }       xcd_barrier(bar); PB(9);
    {
        PHASE_BEGIN
        pg8::DenseOrder So; So.init(T, 3072, X.G, X.bid);
        pg8::Gemm g{WSB(WS_U), WSB(WS_WSIN), 1024};
        pg8::EpiBf16 E{WSB(WS_ZBC), 3072};
        pg8::gemm_phase<pg8::EpiBf16, pg8::DenseOrder>(X.lds, g, So, E, Y.tid);
    }
    {
        PHASE_BEGIN
        pg8::DenseOrder So; So.init(3072, T, X.G, X.bid);
        pg8::Gemm g{WSB(WS_WSIN) + (size_t)2048 * 1024, WSB(WS_U), 1024};
        pg8::EpiBf16 E{WSB(WS_XT), T};
        pg8::gemm_phase<pg8::EpiBf16, pg8::DenseOrder>(X.lds, g, So, E, Y.tid);
    }
    xcd_barrier(bar); PB(10);
    { PHASE_BEGIN ph_ssd1(p, Y); if (PROBE_SUB && X.lane == 0) PROBE_LDS(1) += Y.sub; }                                        xcd_barrier(bar); PB(11);
    { PHASE_BEGIN ph_ssd2(Y); }                                           xcd_barrier(bar); PB(12);
    { PHASE_BEGIN ph_ssd3(p, Y); if (PROBE_SUB && X.lane == 0) PROBE_LDS(1) += Y.sub; }                                        xcd_barrier(bar); PB(13);
    {
        PHASE_BEGIN
        pg8::DenseOrder So; So.init(T, D, X.G, X.bid);
        pg8::Gemm g{WSB(WS_O), WSB(WS_WSOUT), 2048};
        pg8::EpiResid E{WSF(WS_H2), WSF(WS_H1), WSF(WS_MODF) + 4 * 6144 + 2048};
        pg8::gemm_phase<pg8::EpiResid, pg8::DenseOrder>(X.lds, g, So, E, Y.tid);
    }
    xcd_barrier(bar); PB(14);
    { PHASE_BEGIN ph_token<0>(p, Y, 1, WSF(WS_H1), nullptr); if (PROBE_SUB && X.lane == 0) PROBE_LDS(1) += Y.sub; }                       xcd_barrier(bar); PB(15);
    { PHASE_BEGIN ph_moe_gu(p, Y, 1); }                                   xcd_barrier(bar); PB(16);
    { PHASE_BEGIN ph_moe_down(p, Y, 1); }                                 xcd_barrier(bar); PB(17);
    { PHASE_BEGIN ph_token<2>(p, Y, 1, WSF(WS_H1), p.out); if (PROBE_SUB && X.lane == 0) PROBE_LDS(1) += Y.sub; } PB(18);
    if (PROBE_MASK || PROBE_SUB) { asm volatile("s_waitcnt lgkmcnt(0)" ::: "memory"); const unsigned long long acc_ = PROBE_LDS(1); const unsigned long long t_end = __builtin_amdgcn_s_memrealtime() + (unsigned long long)PROBE_MULT * (unsigned long long)__builtin_amdgcn_readfirstlane((unsigned)acc_); while (__builtin_amdgcn_s_memrealtime() < t_end) __builtin_amdgcn_s_sleep(8); }
#undef PB
#undef PROBE_LDS
#undef PHASE_BEGIN
#undef WSF
#undef WSB
}
}

extern "C" void kernel_launch(void* const* d_in, const int* in_sizes, int n_in, void* d_out, int out_size, void* d_ws, size_t ws_size, hipStream_t stream) {
    static int grid = 0;
    if (grid == 0) {
        if (n_in != 30 || out_size != T * D || ws_size < WS_END) { fprintf(stderr, "kernel_launch: unexpected shapes / workspace (%d inputs, out %d, ws %zu < %zu)\n", n_in, out_size, ws_size, (size_t)WS_END); grid = -1; return; }
        int dev = 0, cus = 0, per_cu = 0;
        if (hipGetDevice(&dev) != hipSuccess || hipDeviceGetAttribute(&cus, hipDeviceAttributeMultiprocessorCount, dev) != hipSuccess) { grid = -1; return; }
        if (hipFuncSetAttribute((const void*)fwd_kernel, hipFuncAttributeMaxDynamicSharedMemorySize, LDS_BYTES) != hipSuccess) { fprintf(stderr, "kernel_launch: hipFuncSetAttribute failed\n"); grid = -1; return; }
        if (hipOccupancyMaxActiveBlocksPerMultiprocessor(&per_cu, (const void*)fwd_kernel, NTHREADS, LDS_BYTES) != hipSuccess || per_cu < 1) { fprintf(stderr, "kernel_launch: occupancy query reports %d\n", per_cu); }
        (void)hipGetLastError();
        grid = cus;
    }
    if (grid < 0) return;
    if (hipMemsetAsync((char*)d_ws + WS_CTL, 0, CTL_BYTES, stream) != hipSuccess) return;
    Params p{};
    for (int i = 0; i < 30; ++i) p.in[i] = (const float*)d_in[i];
    p.out = (float*)d_out; p.ws = (unsigned char*)d_ws;
    hipLaunchKernelGGL(fwd_kernel, dim3(grid), dim3(NTHREADS), LDS_BYTES, stream, p);
}
```

```cpp
#include <hip/hip_runtime.h>
#include <cstdio>
#include <cstdint>

#define LAS __attribute__((address_space(3)))
#define GAS __attribute__((address_space(1)))
typedef unsigned short bf16_t;
typedef short bf16x8 __attribute__((ext_vector_type(8)));
typedef float f32x4 __attribute__((ext_vector_type(4)));
typedef unsigned u32x4 __attribute__((ext_vector_type(4)));
typedef unsigned u32x2 __attribute__((ext_vector_type(2)));
typedef float f32x16 __attribute__((ext_vector_type(16)));

namespace {
constexpr int D = 1024, NB = 4, S = 4096, T = NB * S;
constexpr int ATTN_IN = 2840, PROJ_LD = 3072;
constexpr int OFF_SBQ = 0, OFF_SBK = 512, OFF_SBV = 1024, OFF_NQ = 1536, OFF_KC = 2048, OFF_VC = 2176, OFF_KS = 2304, OFF_VS = 2432,
              OFF_KW = 2560, OFF_VW = 2688, OFF_GATE = 2816;
constexpr int NCMP = 255;
constexpr int SSM_IN = 5152, SSM_INNER = 2048, CONV_DIM = 3072, ZX_LD = 5120;
constexpr int NE = 32, CAP = 16384, MAXTILES = 288;
constexpr float EPS = 1e-6f;
constexpr int NWAVES = 8, NTHREADS = 512;

constexpr size_t al4k(size_t x) { return (x + 4095) & ~(size_t)4095; }
constexpr size_t WS_CTL = 0, CTL_BYTES = 1u << 20;
constexpr int CW_CNT = 256;
constexpr int CW_BAR = 4096;
constexpr size_t CTL_MOD = 65536;
constexpr size_t WS_WIN = CTL_BYTES;
constexpr size_t WS_WOUT = WS_WIN + (size_t)3072 * 1024 * 2;
constexpr size_t WS_WSIN = WS_WOUT + (size_t)1024 * 1024 * 2;
constexpr size_t WS_WSOUT = WS_WSIN + (size_t)5120 * 1024 * 2;
constexpr size_t WS_WGU = WS_WSOUT + (size_t)1024 * 2048 * 2;
constexpr size_t WS_WDN = WS_WGU + (size_t)2 * 32 * 2048 * 1024 * 2;
constexpr size_t WS_U = WS_WDN + (size_t)2 * 32 * 1024 * 1024 * 2;
constexpr size_t WS_BIG = WS_U + (size_t)T * 1024 * 2;
constexpr size_t WS_O = WS_BIG + (size_t)T * 5120 * 2;
constexpr size_t WS_H1 = WS_O + (size_t)T * 2048 * 2;
constexpr size_t WS_H2 = WS_H1 + (size_t)T * 1024 * 4;
constexpr size_t WS_QN = WS_H2 + (size_t)T * 1024 * 4;
constexpr size_t WS_KN = WS_QN + (size_t)T * 512 * 4;
constexpr size_t WS_KCMP = WS_KN + (size_t)T * 256 * 4;
constexpr size_t WS_VCMP = WS_KCMP + al4k((size_t)NB * NCMP * 2 * 64 * 4);
constexpr size_t WS_ACT = WS_VCMP + al4k((size_t)NB * NCMP * 2 * 64 * 4);
constexpr size_t WS_Y = WS_ACT + (size_t)MAXTILES * 256 * 1024 * 2;
constexpr size_t WS_TOKE = WS_Y + (size_t)MAXTILES * 256 * 1024 * 2;
constexpr size_t WS_TOKW = WS_TOKE + (size_t)T * 16;
constexpr size_t WS_TOKP = WS_TOKW + (size_t)T * 16;
constexpr size_t WS_SLOT = WS_TOKP + (size_t)T * 16;
constexpr size_t WS_XC = WS_SLOT + (size_t)NE * CAP * 4;
constexpr size_t WS_YS = WS_XC + (size_t)T * 3072 * 4;
constexpr size_t WS_DT = WS_YS + (size_t)T * 2048 * 4;
constexpr size_t WS_MODF = WS_DT + (size_t)T * 32 * 4;
constexpr size_t WS_WV = WS_MODF + (size_t)2 * 4 * 6144 * 4;
constexpr size_t WS_VT = WS_WV + (size_t)768 * 1024 * 2;
constexpr size_t WS_QNB = WS_VT + (size_t)768 * T * 2;
constexpr size_t WS_KSN = WS_QNB + (size_t)T * 512 * 2;
constexpr size_t WS_KWN = WS_KSN + (size_t)T * 128 * 2;
constexpr size_t WS_KCB = WS_KWN + (size_t)T * 128 * 2;
constexpr size_t WS_VCT = WS_KCB + (size_t)8 * 256 * 64 * 2;
constexpr size_t WS_DT2 = WS_VCT + (size_t)8 * 64 * 256 * 2;
constexpr size_t WS_CS = WS_DT2 + (size_t)NB * 32 * S * 4;
constexpr size_t WS_DEC = WS_CS + (size_t)NB * 32 * S * 4;
constexpr size_t WS_W1T = WS_DEC + al4k((size_t)NB * 16 * 32 * 4);
constexpr size_t WS_SKW = WS_W1T + (size_t)2 * 128 * 2048 * 2;
constexpr size_t WS_ULO = WS_SKW + (size_t)3 * 2 * 32 * 1024 * 2;
constexpr size_t WS_END = WS_ULO + (size_t)T * 1024 * 2;
constexpr size_t WS_ZBC = WS_BIG, WS_XT = WS_XC, WS_XCT = WS_XC + (size_t)3072 * T * 2, WS_ST = WS_YS, WS_PB = WS_YS + (size_t)NB * 16 * 32 * 8192 * 4, WS_BCM = WS_QN;
static_assert(WS_XCT + (size_t)2560 * T * 2 <= WS_YS && WS_PB + (size_t)NB * 16 * 32 * 8192 * 2 <= WS_DT && (size_t)T * 1024 * 2 <= (size_t)T * 512 * 4, "layer-1 overlays");

constexpr int RING_BYTES = 131072;
constexpr int EXTRA_OFF = RING_BYTES;
constexpr int TAB_OFF = 151552;
constexpr int XB_OFF = 152576;
constexpr int LDS_BYTES = 153600;

struct Params { const float* in[30]; float* out; unsigned char* ws; };

__device__ __forceinline__ float siluf(float v) { return v / (1.f + expf(-v)); }
__device__ __forceinline__ float logsig(float x) { return fminf(x, 0.f) - log1pf(expf(-fabsf(x))); }
__device__ __forceinline__ float wave_sum(float v) {
#pragma unroll
    for (int o = 32; o > 0; o >>= 1) v += __shfl_xor(v, o);
    return v;
}
__device__ __forceinline__ float wave_max(float v) {
#pragma unroll
    for (int o = 32; o > 0; o >>= 1) v = fmaxf(v, __shfl_xor(v, o));
    return v;
}
__device__ __forceinline__ unsigned f2bf(float f) { unsigned u = __builtin_bit_cast(unsigned, f); return (u + 0x7fffu + ((u >> 16) & 1u)) >> 16; }
typedef float f32x2_t __attribute__((ext_vector_type(2))); typedef __bf16 bf16x2_t __attribute__((ext_vector_type(2)));
__device__ __forceinline__ unsigned pk2(float lo, float hi) { f32x2_t v = {lo, hi}; bf16x2_t b = __builtin_convertvector(v, bf16x2_t); return __builtin_bit_cast(unsigned, b); }
__device__ __forceinline__ float bf2f(bf16_t v) { return __uint_as_float((unsigned)v << 16); }
__device__ __forceinline__ float bflo(unsigned w) { return __uint_as_float(w << 16); }
__device__ __forceinline__ float bfhi(unsigned w) { return __uint_as_float(w & 0xffff0000u); }
#define LDS_WAIT() asm volatile("s_waitcnt lgkmcnt(0)" ::: "memory")
__device__ __forceinline__ int fresh(int v) { asm volatile("" : "+v"(v)); return v; }
__device__ __forceinline__ int sfresh(int v) { asm volatile("" : "+s"(v)); return v; }

#define XB_TMO      128
#define XB_XCNT(j)  (256  + 64 * (j))
#define XB_XSUB(j)  (1280 + 64 * (j))
#define XB_XGEN(j)  (2304 + 64 * (j))
#define XB_TOP      3328
#define XB_TOPGEN   3392
#define XCD_BAR_WORDS 3456
#define XB_SPIN_CAP (1u << 18)
__device__ __forceinline__ unsigned xb_ld(unsigned* p)              { return __hip_atomic_load(p, __ATOMIC_RELAXED, __HIP_MEMORY_SCOPE_AGENT); }
__device__ __forceinline__ unsigned xb_add(unsigned* p, unsigned v) { return __hip_atomic_fetch_add(p, v, __ATOMIC_RELAXED, __HIP_MEMORY_SCOPE_AGENT); }
__device__ __forceinline__ unsigned xb_xcc_id() { return (unsigned)__builtin_amdgcn_s_getreg((3 << 11) | 20) & 0xFu; }
#define XB_SPIN(cond, bar) do { unsigned _sp = 0; while (cond) { __builtin_amdgcn_s_sleep(1); \
    if ((++_sp & 255u) == 0u) { if (xb_ld(&(bar)[XB_TMO])) break; if (_sp > XB_SPIN_CAP) { atomicAdd(&(bar)[XB_TMO], 1u); break; } } } } while (0)
struct XcdBarrier { unsigned* bar; unsigned x; volatile LAS unsigned* st; };
__device__ __forceinline__ XcdBarrier xcd_barrier_post(unsigned* bar, volatile LAS unsigned* st) {
    XcdBarrier b; b.bar = bar; b.x = xb_xcc_id(); b.st = st;
    if (threadIdx.x == 0) (void)xb_add(&bar[XB_XCNT(b.x)], 1u);
    return b;
}
__device__ __forceinline__ void xcd_barrier_complete(unsigned* bar, unsigned x, unsigned& nloc, unsigned& nx) {
    const unsigned G = gridDim.x * gridDim.y * gridDim.z;
    unsigned sum, cnt, mine, sp = 0u;
    for (;;) {
        sum = 0u; cnt = 0u; mine = 0u;
#pragma unroll
        for (unsigned j = 0; j < 16; ++j) { const unsigned c = xb_ld(&bar[XB_XCNT(j)]); sum += c; cnt += (c > 0u) ? 1u : 0u; mine = (j == x) ? c : mine; }
        if (sum == G) break;
        __builtin_amdgcn_s_sleep(1);
        if ((++sp & 255u) == 0u) { if (xb_ld(&bar[XB_TMO])) break; if (sp > XB_SPIN_CAP) { atomicAdd(&bar[XB_TMO], 1u); break; } }
    }
    nloc = mine > 0u ? mine : 1u; nx = cnt > 0u ? cnt : 1u;
}
__device__ __forceinline__ void xcd_barrier(const XcdBarrier& b) {
    asm volatile("s_waitcnt vmcnt(0)" ::: "memory");
    __syncthreads();
    if (threadIdx.x == 0) {
        unsigned* bar = b.bar;
        __builtin_amdgcn_s_waitcnt(0);
        unsigned nloc = b.st[0], nx = b.st[1];
        if (nloc == 0u) { xcd_barrier_complete(bar, b.x, nloc, nx); b.st[0] = nloc; b.st[1] = nx; }
        const unsigned old = xb_add(&bar[XB_XSUB(b.x)], 1u);
        const unsigned gen = old / nloc;
        if (old + 1u == (gen + 1u) * nloc) {
            __builtin_amdgcn_fence(__ATOMIC_RELEASE, "agent");
            asm volatile("s_waitcnt vmcnt(0)" ::: "memory");
            const unsigned og = xb_add(&bar[XB_TOP], 1u);
            const unsigned tg = og / nx;
            if (og + 1u == (tg + 1u) * nx) xb_add(&bar[XB_TOPGEN], 1u);
            else XB_SPIN(xb_ld(&bar[XB_TOPGEN]) == tg, bar);
            __builtin_amdgcn_fence(__ATOMIC_ACQUIRE, "agent");
            xb_add(&bar[XB_XGEN(b.x)], 1u);
            asm volatile("s_waitcnt vmcnt(0)" ::: "memory");
        } else {
            XB_SPIN(xb_ld(&bar[XB_XGEN(b.x)]) == gen, bar);
            __builtin_amdgcn_fence(__ATOMIC_ACQUIRE, "agent");
            asm volatile("s_waitcnt vmcnt(0)" ::: "memory");
        }
    }
    __syncthreads();
}

namespace pg8 {
constexpr int BM = 256, BK = 64, HALF = 128, HTB = HALF * BK * 2, STAGE_BYTES = 8 * HTB;
__device__ __forceinline__ int lds_byte(int r, int c) { const int st = (r >> 4) * 2 + (c >> 5), rr = r & 15, cc = c & 31, ob = rr * 64 + cc * 2; return st * 1024 + (ob ^ (((ob >> 9) & 1) << 5)); }
__device__ __forceinline__ void stage_rc(int b, int& R, int& C) { const int st = b / 1024, sb = b % 1024, swz = sb ^ (((sb >> 9) & 1) << 5); R = (st >> 1) * 16 + swz / 64; C = (st & 1) * 32 + (swz % 64) / 2; }
__device__ __forceinline__ int perm32(int rho) { const int n = rho >> 4, i = rho & 15; return 8 * (i >> 2) + 4 * n + (i & 3); }
struct Unit { int pm, pn, e; };
struct Gemm { const bf16_t* A; const bf16_t* Bt; int K; };
__device__ __forceinline__ unsigned cvt_pk_bf16(float lo, float hi) { unsigned r; asm volatile("v_cvt_pk_bf16_f32 %0, %1, %2" : "=v"(r) : "v"(lo), "v"(hi)); return r; }

struct DenseOrder {
    int nM, nN, nwg, G, c;
    __device__ void init(int M, int N, int G_, int c_) { nM = M / BM; nN = N / BM; nwg = nM * nN; G = G_; c = c_; }
    __device__ bool next(int i, Unit& u) const {
        const long L = (long)i * G + c; if (L >= nwg) return false;
        int wgid = (int)L; { const int q = nwg / 8, r = nwg % 8, xcd = wgid % 8, off = wgid / 8; wgid = (xcd < r ? xcd * (q + 1) : r * (q + 1) + (xcd - r) * q) + off; }
        const int nig = 8 * nN, gid = wgid / nig, fm = gid * 8, gsz = (nM - fm) < 8 ? (nM - fm) : 8;
        u.pm = fm + ((wgid % nig) % gsz); u.pn = (wgid % nig) / gsz; u.e = 0; return true;
    }
    __device__ __forceinline__ unsigned arow(const Unit& u, int r) const { return (unsigned)(u.pm * BM + r); }
};
struct MoeOrder {
    const LAS int* tb; const LAS int* cn; const int* slot_tok; int shift, G, c; bool gather;
    __device__ bool next(int i, Unit& u) const {
        const int L = i * G + c, tile = L >> shift; if (tile >= tb[NE]) return false;
        int e = 0; while (tb[e + 1] <= tile) ++e;
        u.pm = tile; u.pn = (e << shift) + (L & ((1 << shift) - 1)); u.e = e; return true;
    }
    __device__ __forceinline__ unsigned arow(const Unit& u, int r) const {
        if (!gather) return (unsigned)(u.pm * BM + r);
        const int pos = (u.pm - tb[u.e]) * BM + r;
        return pos < cn[u.e] ? (unsigned)slot_tok[u.e * CAP + pos] : 0u;
    }
};

struct EpiBf16 {
    static constexpr bool PERM = true;
    bf16_t* O; int ldc;
    __device__ __forceinline__ void operator()(const f32x4 (&acc)[2][2][4][2], const Unit& u, int wr, int wc, int fr, int fq) const {
        const int row0 = u.pm * BM + wr * 64 + fr, col0 = u.pn * BM + wc * 32 + 8 * fq;
#pragma unroll
        for (int ai = 0; ai < 2; ++ai)
#pragma unroll
            for (int m = 0; m < 4; ++m) { bf16_t* rowp = O + (size_t)(row0 + ai * HALF + m * 16) * ldc + col0;
#pragma unroll
                for (int bj = 0; bj < 2; ++bj) { const f32x4 v0 = acc[ai][bj][m][0], v1 = acc[ai][bj][m][1];
                    u32x4 w; w.x = cvt_pk_bf16(v0[0], v0[1]); w.y = cvt_pk_bf16(v0[2], v0[3]); w.z = cvt_pk_bf16(v1[0], v1[1]); w.w = cvt_pk_bf16(v1[2], v1[3]);
                    *(u32x4*)(rowp + bj * HALF) = w; } }
    }
};
struct EpiResid {
    static constexpr bool PERM = false;
    const float* base; float* out; const float* g;
    __device__ __forceinline__ void operator()(const f32x4 (&acc)[2][2][4][2], const Unit& u, int wr, int wc, int fr, int fq) const {
        const int row0 = u.pm * BM + wr * 64 + fr, col0 = u.pn * BM + wc * 32 + 4 * fq;
        const float* gb = g + (size_t)((u.pm * BM) / S) * 6144 + col0;
        f32x4 gv[2][2];
#pragma unroll
        for (int bj = 0; bj < 2; ++bj)
#pragma unroll
            for (int n = 0; n < 2; ++n) gv[bj][n] = *(const f32x4*)(gb + bj * HALF + n * 16);
#pragma unroll
        for (int ai = 0; ai < 2; ++ai)
#pragma unroll
            for (int m = 0; m < 4; ++m) { const size_t off = (size_t)(row0 + ai * HALF + m * 16) * D + col0;
#pragma unroll
                for (int bj = 0; bj < 2; ++bj)
#pragma unroll
                    for (int n = 0; n < 2; ++n) { const f32x4 bs = *(const f32x4*)(base + off + bj * HALF + n * 16);
                        *(f32x4*)(out + off + bj * HALF + n * 16) = bs + gv[bj][n] * acc[ai][bj][m][n]; } }
    }
};
struct EpiGu {
    static constexpr bool PERM = true;
    bf16_t* act; const float* bgu;
    __device__ __forceinline__ void operator()(const f32x4 (&acc)[2][2][4][2], const Unit& u, int wr, int wc, int fr, int fq) const {
        const int row0 = u.pm * BM + wr * 64 + fr, col0 = (u.pn & 7) * HALF + wc * 32 + 8 * fq;
        const float* bb = bgu + (size_t)u.e * 2048 + col0;
        const f32x4 bg0 = *(const f32x4*)(bb), bg1 = *(const f32x4*)(bb + 4), bu0 = *(const f32x4*)(bb + 1024), bu1 = *(const f32x4*)(bb + 1028);
#pragma unroll
        for (int ai = 0; ai < 2; ++ai)
#pragma unroll
            for (int m = 0; m < 4; ++m) {
                float r[8];
#pragma unroll
                for (int n = 0; n < 2; ++n) { const f32x4 gt = acc[ai][0][m][n] + (n ? bg1 : bg0), up = acc[ai][1][m][n] + (n ? bu1 : bu0);
#pragma unroll
                    for (int j = 0; j < 4; ++j) { const float gg = fminf(gt[j], 7.f), uu = fminf(fmaxf(up[j], -7.f), 7.f);
                        r[n * 4 + j] = (uu + 1.f) * gg * __builtin_amdgcn_rcpf(1.f + __expf(-1.702f * gg)); } }
                u32x4 w; w.x = cvt_pk_bf16(r[0], r[1]); w.y = cvt_pk_bf16(r[2], r[3]); w.z = cvt_pk_bf16(r[4], r[5]); w.w = cvt_pk_bf16(r[6], r[7]);
                *(u32x4*)(act + (size_t)(row0 + ai * HALF + m * 16) * D + col0) = w; }
    }
};
struct EpiDown {
    static constexpr bool PERM = true;
    bf16_t* y; const float* bd;
    __device__ __forceinline__ void operator()(const f32x4 (&acc)[2][2][4][2], const Unit& u, int wr, int wc, int fr, int fq) const {
        const int row0 = u.pm * BM + wr * 64 + fr, col0 = (u.pn & 3) * BM + wc * 32 + 8 * fq;
        const float* bb = bd + (size_t)u.e * 1024 + col0;
        f32x4 bv[2][2];
#pragma unroll
        for (int bj = 0; bj < 2; ++bj)
#pragma unroll
            for (int n = 0; n < 2; ++n) bv[bj][n] = *(const f32x4*)(bb + bj * HALF + 4 * n);
#pragma unroll
        for (int ai = 0; ai < 2; ++ai)
#pragma unroll
            for (int m = 0; m < 4; ++m) { bf16_t* rowp = y + (size_t)(row0 + ai * HALF + m * 16) * D + col0;
#pragma unroll
                for (int bj = 0; bj < 2; ++bj) { const f32x4 v0 = acc[ai][bj][m][0] + bv[bj][0], v1 = acc[ai][bj][m][1] + bv[bj][1];
                    u32x4 w; w.x = cvt_pk_bf16(v0[0], v0[1]); w.y = cvt_pk_bf16(v0[2], v0[3]); w.z = cvt_pk_bf16(v1[0], v1[1]); w.w = cvt_pk_bf16(v1[2], v1[3]);
                    *(u32x4*)(rowp + bj * HALF) = w; } }
    }
};

template <class Epi, class Sched>
__device__ __forceinline__ void gemm_phase(LAS unsigned char* lds, const Gemm g, const Sched& S, const Epi& E, const int tid) {
    const int wid = __builtin_amdgcn_readfirstlane(tid >> 6), lane = tid & 63, wr = wid >> 2, wc = wid & 3, fr = lane & 15, fq = lane >> 4;
    const int K = g.K, nt = K / BK;
    int RA[2], CA[2]; unsigned voffB[2];
#pragma unroll
    for (int i = 0; i < 2; ++i) { int R, C; stage_rc(tid * 16 + i * 8192, R, C); const int Rb = Epi::PERM ? ((R & ~31) + perm32(R & 31)) : R;
        RA[i] = R; CA[i] = C; voffB[i] = (unsigned)(Rb * K + C) * 2u; }
    const size_t kstep = (size_t)(BK * 2);
    const size_t hstep = (size_t)HALF * K * 2;
    const size_t tstep = 2 * hstep;
    const unsigned ldsw = (unsigned)wid * 1024u;
    const int aoff = lds_byte(wr * 64 + fr, fq * 8), boff = lds_byte(wc * 32 + fr, fq * 8);
#define PG8_SA(b, h) (((b) * 2 + (h)) * HTB)
#define PG8_SB(b, h) ((4 + (b) * 2 + (h)) * HTB)
#define PG8_STAGE(bufoff, gbase, voff) do { _Pragma("unroll") for (int _i = 0; _i < 2; ++_i) \
        __builtin_amdgcn_global_load_lds((const unsigned*)((const char*)(gbase) + (voff)[_i]), (LAS unsigned*)(lds + (bufoff) + ldsw + _i * 8192), 16, 0, 0); } while (0)
#define PG8_LDA(dst, b, h) do { _Pragma("unroll") for (int m = 0; m < 4; ++m) _Pragma("unroll") for (int k = 0; k < 2; ++k) dst[m][k] = *(const LAS bf16x8*)(lds + PG8_SA(b, h) + aoff + m * 2048 + k * 1024); } while (0)
#define PG8_LDB(dst, b, h) do { _Pragma("unroll") for (int n = 0; n < 2; ++n) _Pragma("unroll") for (int k = 0; k < 2; ++k) dst[n][k] = *(const LAS bf16x8*)(lds + PG8_SB(b, h) + boff + n * 2048 + k * 1024); } while (0)
#define PG8_MMA(ai, bj, At, Bt) do { __builtin_amdgcn_s_setprio(1); _Pragma("unroll") for (int m = 0; m < 4; ++m) _Pragma("unroll") for (int n = 0; n < 2; ++n) _Pragma("unroll") for (int k = 0; k < 2; ++k) \
        acc[ai][bj][m][n] = __builtin_amdgcn_mfma_f32_16x16x32_bf16(Bt[n][k], At[m][k], acc[ai][bj][m][n], 0, 0, 0); __builtin_amdgcn_s_setprio(0); } while (0)
#define PG8_WAIT_V(n) asm volatile("s_waitcnt vmcnt(" #n ")" ::: "memory")
#define PG8_WAIT_L(n) asm volatile("s_waitcnt lgkmcnt(" #n ")" ::: "memory")
#define PG8_BAR __builtin_amdgcn_s_barrier()
#define PG8_SCHED __builtin_amdgcn_sched_barrier(0)
#define PG8_AOFF(dst, u) do { _Pragma("unroll") for (int _h = 0; _h < 2; ++_h) _Pragma("unroll") for (int _i = 0; _i < 2; ++_i) dst[_h][_i] = (S.arow(u, _h * HALF + RA[_i]) * (unsigned)K + (unsigned)CA[_i]) * 2u; } while (0)
    Unit cur, nxt; int ui = 0;
    if (!S.next(0, cur)) return;
    f32x4 acc[2][2][4][2];
#pragma unroll
    for (int a = 0; a < 2; ++a)
#pragma unroll
        for (int b = 0; b < 2; ++b)
#pragma unroll
            for (int m = 0; m < 4; ++m)
#pragma unroll
                for (int n = 0; n < 2; ++n) acc[a][b][m][n] = (f32x4){0.f, 0.f, 0.f, 0.f};
    bf16x8 At[4][2], B0[2][2], B1[2][2];
    unsigned va[2][2], vn[2][2];
    PG8_AOFF(va, cur);
    const char* Ab = (const char*)g.A;
    const char* cB = (const char*)g.Bt + (size_t)cur.pn * tstep;
    PG8_STAGE(PG8_SB(0, 0), cB, voffB); PG8_STAGE(PG8_SB(0, 1), cB + hstep, voffB); PG8_STAGE(PG8_SA(0, 0), Ab, va[0]); PG8_STAGE(PG8_SA(0, 1), Ab, va[1]);
    if (wr == 1) PG8_BAR;
    PG8_WAIT_V(2); PG8_BAR;
    PG8_STAGE(PG8_SB(1, 0), cB + kstep, voffB); PG8_STAGE(PG8_SA(1, 0), Ab + kstep, va[0]); PG8_STAGE(PG8_SB(1, 1), cB + hstep + kstep, voffB);
    PG8_WAIT_V(6); PG8_BAR;
    for (;;) {
        const bool has_next = S.next(ui + 1, nxt);
        if (has_next) { PG8_AOFF(vn, nxt); }
        else {
#pragma unroll
            for (int h = 0; h < 2; ++h)
#pragma unroll
                for (int i = 0; i < 2; ++i) vn[h][i] = va[h][i]; }
        const char* nB = has_next ? (const char*)g.Bt + (size_t)nxt.pn * tstep : cB;
        for (int t = 0; t < nt; t += 2) {
            const bool last = (t == nt - 2);
            const char* a1 = Ab + (size_t)(t + 1) * kstep;
            const char* a2 = last ? Ab : Ab + (size_t)(t + 2) * kstep; const char* b2 = last ? nB : cB + (size_t)(t + 2) * kstep;
            const char* a3 = a2 + kstep; const char* b3 = b2 + kstep;
            unsigned o2[2][2];
#pragma unroll
            for (int h = 0; h < 2; ++h)
#pragma unroll
                for (int i = 0; i < 2; ++i) o2[h][i] = last ? vn[h][i] : va[h][i];
            PG8_LDB(B0, 0, 0); PG8_LDB(B1, 0, 1); PG8_SCHED; PG8_LDA(At, 0, 0); PG8_STAGE(PG8_SA(1, 1), a1, va[1]);
            PG8_WAIT_V(8); PG8_WAIT_L(0); PG8_BAR; PG8_MMA(0, 0, At, B0); PG8_MMA(0, 1, At, B1); PG8_BAR; PG8_SCHED;
            PG8_LDA(At, 0, 1); PG8_STAGE(PG8_SB(0, 0), b2, voffB); PG8_STAGE(PG8_SB(0, 1), b2 + hstep, voffB); PG8_STAGE(PG8_SA(0, 0), a2, o2[0]);
            PG8_WAIT_V(8); PG8_WAIT_L(0); PG8_BAR; PG8_MMA(1, 0, At, B0); PG8_MMA(1, 1, At, B1); PG8_BAR; PG8_SCHED;
            PG8_LDB(B0, 1, 0); PG8_LDB(B1, 1, 1); PG8_SCHED; PG8_LDA(At, 1, 0); PG8_STAGE(PG8_SA(0, 1), a2, o2[1]);
            PG8_WAIT_V(8); PG8_WAIT_L(0); PG8_BAR; PG8_MMA(0, 0, At, B0); PG8_MMA(0, 1, At, B1); PG8_BAR; PG8_SCHED;
            PG8_LDA(At, 1, 1); PG8_STAGE(PG8_SB(1, 0), b3, voffB); PG8_STAGE(PG8_SB(1, 1), b3 + hstep, voffB); PG8_STAGE(PG8_SA(1, 0), a3, o2[0]);
            PG8_WAIT_V(8); PG8_WAIT_L(0); PG8_BAR; PG8_MMA(1, 0, At, B0); PG8_MMA(1, 1, At, B1); PG8_BAR; PG8_SCHED;
        }
        if (wr == 0) PG8_BAR;
        E(acc, cur, wr, wc, fr, fq);
        if (!has_next) break;
#pragma unroll
        for (int a = 0; a < 2; ++a)
#pragma unroll
            for (int b = 0; b < 2; ++b)
#pragma unroll
                for (int m = 0; m < 4; ++m)
#pragma unroll
                    for (int n = 0; n < 2; ++n) acc[a][b][m][n] = (f32x4){0.f, 0.f, 0.f, 0.f};
        cur = nxt; cB = nB; ++ui;
#pragma unroll
        for (int h = 0; h < 2; ++h)
#pragma unroll
            for (int i = 0; i < 2; ++i) va[h][i] = vn[h][i];
        if (wr == 1) PG8_BAR;
    }
    PG8_WAIT_V(0);
    PG8_BAR;
#undef PG8_SA
#undef PG8_SB
#undef PG8_STAGE
#undef PG8_LDA
#undef PG8_LDB
#undef PG8_MMA
#undef PG8_WAIT_V
#undef PG8_WAIT_L
#undef PG8_BAR
#undef PG8_SCHED
#undef PG8_AOFF
}
}

#ifndef PROBE_SUB
#define PROBE_SUB 0
#endif
struct Ctx {
    LAS unsigned char* lds; unsigned char* ws;
    int tid, lane, wave, gw, ngw, G, bid;
    mutable unsigned long long sub, subt;
};
#define SUB_BEGIN(X, id) do { if (PROBE_SUB == (id)) (X).subt = __builtin_amdgcn_s_memrealtime(); } while (0)
#define SUB_END(X, id) do { if (PROBE_SUB == (id)) (X).sub += __builtin_amdgcn_s_memrealtime() - (X).subt; } while (0)

__device__ __forceinline__ void transpose_item(const float* W, int ldw, int K, int nvalid, int k0, int n0, bf16_t* WT, int row0, LAS float* scr, int lane) {
    const int c4 = (lane & 7) * 4, kr = lane >> 3;
    f32x4 v[8];
#pragma unroll
    for (int i = 0; i < 8; ++i) v[i] = (n0 + c4 < nvalid) ? *(const f32x4*)(W + (size_t)(k0 + kr + 8 * i) * ldw + n0 + c4) : (f32x4){0.f, 0.f, 0.f, 0.f};
#pragma unroll
    for (int i = 0; i < 8; ++i) { LAS float* d = scr + (kr + 8 * i) * 33 + c4; d[0] = v[i].x; d[1] = v[i].y; d[2] = v[i].z; d[3] = v[i].w; }
    LDS_WAIT(); asm volatile("" ::: "memory");
    const int c = lane & 7;
#pragma unroll
    for (int j = 0; j < 4; ++j) { const int n = (lane >> 3) + 8 * j; const LAS float* s = scr + (8 * c) * 33 + n;
        u32x4 o; o.x = pk2(s[0 * 33], s[1 * 33]); o.y = pk2(s[2 * 33], s[3 * 33]); o.z = pk2(s[4 * 33], s[5 * 33]); o.w = pk2(s[6 * 33], s[7 * 33]);
        *(u32x4*)(WT + (size_t)(row0 + n) * K + k0 + 8 * c) = o; }
    LDS_WAIT(); asm volatile("" ::: "memory");
}
__device__ __forceinline__ void ph_prologue(const Params& p, const Ctx& X) {
    LAS float* scr = (LAS float*)(X.lds + X.wave * 16384);
    unsigned char* ws = X.ws;
    constexpr int I_MOD = 2 * 96 * 8;
    constexpr int I_SK = 3 * 16, I_W1 = 2 * 32 * 4, I_WIN = 16 * 96, I_WV = 16 * 24, I_WOUT = 16 * 32, I_WSIN = 16 * 160, I_WSOUT = 32 * 32, I_GU = 64 * 1024, I_DN = 64 * 512;
    constexpr int NITEMS = I_MOD + I_SK + I_W1 + I_WIN + I_WV + I_WOUT + I_WSIN + I_WSOUT + I_GU + I_DN;
    for (int it = X.gw; it < NITEMS; it += X.ngw) {
        int r = it;
        if (r < I_MOD) {
            const int kp = r & 7, jb = (r >> 3) % 96, l = r / (8 * 96), j = jb * 64 + X.lane;
            const float* w = p.in[2] + (size_t)l * 1024 * 6144 + (size_t)(kp * 128) * 6144 + j;
            const float* c = p.in[1] + kp * 128;
            float a0 = 0.f, a1 = 0.f, a2 = 0.f, a3 = 0.f;
#pragma unroll 8
            for (int i = 0; i < 128; ++i) { const float wv = w[(size_t)i * 6144];
                a0 += siluf(c[i]) * wv; a1 += siluf(c[1024 + i]) * wv; a2 += siluf(c[2048 + i]) * wv; a3 += siluf(c[3072 + i]) * wv; }
            if (kp == 0) { const float bb = p.in[3][l * 6144 + j]; a0 += bb; a1 += bb; a2 += bb; a3 += bb; }
            unsigned long long* mq = (unsigned long long*)(ws + CTL_MOD) + (size_t)l * 4 * 6144 + j;
            atomicAdd(mq, (unsigned long long)__double2ll_rn((double)a0 * 1099511627776.0)); atomicAdd(mq + 6144, (unsigned long long)__double2ll_rn((double)a1 * 1099511627776.0));
            atomicAdd(mq + 2 * 6144, (unsigned long long)__double2ll_rn((double)a2 * 1099511627776.0)); atomicAdd(mq + 3 * 6144, (unsigned long long)__double2ll_rn((double)a3 * 1099511627776.0));
            continue;
        }
        r -= I_MOD;
        if (r < I_SK) {
            const int m = r >> 4, kb = r & 15, k0 = kb * 64;
            const float* W = m < 2 ? p.in[24] + (size_t)m * D * NE : p.in[16] + 5120; const int ldw = m < 2 ? NE : SSM_IN;
#pragma unroll 8
            for (int i = 0; i < 32; ++i) { const int kk = 2 * i + (X.lane >> 5); scr[kk * 33 + (X.lane & 31)] = W[(size_t)(k0 + kk) * ldw + (X.lane & 31)]; }
            LDS_WAIT(); asm volatile("" ::: "memory");
            const int c = X.lane & 7;
#pragma unroll
            for (int j = 0; j < 4; ++j) { const int n = (X.lane >> 3) + 8 * j; const LAS float* sp = scr + (8 * c) * 33 + n;
                float v[8]; unsigned hi[8];
#pragma unroll
                for (int q = 0; q < 8; ++q) { v[q] = sp[q * 33]; hi[q] = f2bf(v[q]); v[q] -= __uint_as_float(hi[q] << 16); }
                u32x4 oh, ol; oh.x = hi[0] | (hi[1] << 16); oh.y = hi[2] | (hi[3] << 16); oh.z = hi[4] | (hi[5] << 16); oh.w = hi[6] | (hi[7] << 16);
                ol.x = pk2(v[0], v[1]); ol.y = pk2(v[2], v[3]); ol.z = pk2(v[4], v[5]); ol.w = pk2(v[6], v[7]);
                bf16_t* dst = (bf16_t*)(ws + WS_SKW) + (size_t)m * 2 * 32 * 1024 + (size_t)n * 1024 + k0 + 8 * c;
                *(u32x4*)dst = oh; *(u32x4*)(dst + 32 * 1024) = ol; }
            LDS_WAIT(); asm volatile("" ::: "memory");
            continue; }
        r -= I_SK;
        if (r < I_W1) { const int kv = r >> 7, q = r & 127, kb = q >> 2, nb = q & 3;
            transpose_item(kv ? p.in[14] : p.in[12], 128, 2048, 128, kb * 64, nb * 32, (bf16_t*)(ws + WS_W1T) + (size_t)kv * 128 * 2048, nb * 32, scr, X.lane); continue; } r -= I_W1;
        if (r < I_WIN) { const int kb = r / 96, nb = r % 96; transpose_item(p.in[6], ATTN_IN, 1024, ATTN_IN, kb * 64, nb * 32, (bf16_t*)(ws + WS_WIN), nb * 32, scr, X.lane); continue; } r -= I_WIN;
        if (r < I_WV) { const int kb = r / 24, nb = r % 24, r0 = nb * 32, src = r0 < 512 ? OFF_SBV + r0 : (r0 < 640 ? OFF_VS + (r0 - 512) : OFF_VW + (r0 - 640));
            transpose_item(p.in[6], ATTN_IN, 1024, ATTN_IN, kb * 64, src, (bf16_t*)(ws + WS_WV), r0, scr, X.lane); continue; } r -= I_WV;
        if (r < I_WOUT) { const int kb = r / 32, nb = r % 32; transpose_item(p.in[7], 1024, 1024, 1024, kb * 64, nb * 32, (bf16_t*)(ws + WS_WOUT), nb * 32, scr, X.lane); continue; } r -= I_WOUT;
        if (r < I_WSIN) { const int kb = r / 160, nb = r % 160, n0 = nb * 32, row0 = n0 < 2048 ? n0 : (n0 < 4096 ? n0 + 1024 : n0 - 2048);
            transpose_item(p.in[16], SSM_IN, 1024, SSM_IN, kb * 64, n0, (bf16_t*)(ws + WS_WSIN), row0, scr, X.lane); continue; } r -= I_WSIN;
        if (r < I_WSOUT) { const int kb = r / 32, nb = r % 32; transpose_item(p.in[23], 1024, 2048, 1024, kb * 64, nb * 32, (bf16_t*)(ws + WS_WSOUT), nb * 32, scr, X.lane); continue; } r -= I_WSOUT;
        if (r < I_GU) { const int m = r >> 10, q = r & 1023, kb = q >> 6, nb = q & 63, n0 = nb * 32;
            const int row0 = ((n0 & 1023) >> 7) * 256 + (n0 >> 10) * 128 + (n0 & 127);
            transpose_item(p.in[26] + (size_t)m * 1024 * 2048, 2048, 1024, 2048, kb * 64, n0, (bf16_t*)(ws + WS_WGU) + (size_t)m * 2048 * 1024, row0, scr, X.lane); continue; } r -= I_GU;
        { const int m = r >> 9, q = r & 511, kb = q >> 5, nb = q & 31;
            transpose_item(p.in[28] + (size_t)m * 1024 * 1024, 1024, 1024, 1024, kb * 64, nb * 32, (bf16_t*)(ws + WS_WDN) + (size_t)m * 1024 * 1024, nb * 32, scr, X.lane); }
    }
}

struct Row { f32x4 v[4]; };
__device__ __forceinline__ void row_load(Row& r, const float* p, int lane) {
#pragma unroll
    for (int j = 0; j < 4; ++j) r.v[j] = ((const f32x4*)p)[64 * j + lane];
}
__device__ __forceinline__ void row_store(const Row& r, float* p, int lane) {
#pragma unroll
    for (int j = 0; j < 4; ++j) ((f32x4*)p)[64 * j + lane] = r.v[j];
}
template <class PV>
__device__ __forceinline__ void row_norm_mod(const Row& r, Row& o, const float* gain, PV sc, PV sh, int lane) {
    float ss = 0.f;
#pragma unroll
    for (int j = 0; j < 4; ++j) ss += (r.v[j].x * r.v[j].x + r.v[j].y * r.v[j].y) + (r.v[j].z * r.v[j].z + r.v[j].w * r.v[j].w);
    const float rs = rsqrtf(wave_sum(ss) * (1.f / 1024.f) + EPS);
#pragma unroll
    for (int j = 0; j < 4; ++j) { const f32x4 g = ((const f32x4*)gain)[64 * j + lane], a = sc[64 * j + lane], b = sh[64 * j + lane];
        o.v[j] = r.v[j] * rs * g * (a + 1.f) + b; }
}
__device__ __forceinline__ void row_store_bf16(const Row& r, bf16_t* p, int lane) {
#pragma unroll
    for (int j = 0; j < 4; ++j) { u32x2 w; w.x = pk2(r.v[j].x, r.v[j].y); w.y = pk2(r.v[j].z, r.v[j].w); ((u32x2*)p)[64 * j + lane] = w; }
}
__device__ __forceinline__ void row_store_lds(const Row& r, LAS float* p, int lane) {
#pragma unroll
    for (int j = 0; j < 4; ++j) ((LAS f32x4*)p)[64 * j + lane] = r.v[j];
}
__device__ __forceinline__ float modq2f(long long q) { return (float)((double)q * 9.094947017729282e-13); }
__device__ __forceinline__ void ph_norm0(const Params& p, const Ctx& X) {
    const long long* mq = (const long long*)(X.ws + CTL_MOD);
    float* modf = (float*)(X.ws + WS_MODF);
    for (int i = X.bid * NTHREADS + X.tid; i < 2 * 4 * 6144; i += X.G * NTHREADS) modf[i] = modq2f(mq[i]);
    LAS float* tab = (LAS float*)X.lds;
    for (int i = X.tid; i < 4 * 2048; i += NTHREADS) tab[i] = modq2f(mq[(size_t)(i >> 11) * 6144 + (i & 2047)]);
    __syncthreads();
    for (int t = X.gw; t < T; t += X.ngw) {
        Row r, o; row_load(r, p.in[0] + (size_t)t * D, X.lane);
        const LAS float* m = tab + (t / S) * 2048;
        row_norm_mod(r, o, p.in[4], (const LAS f32x4*)(m + 1024), (const LAS f32x4*)m, X.lane);
        row_store_bf16(o, (bf16_t*)(X.ws + WS_U) + (size_t)t * D, X.lane);
    }
}
__device__ __forceinline__ void route_select(float logit, int lane, LAS unsigned* lcnt, int& ev, float& wv, int& lpos) {
    const int e = lane & 31;
    float tl[4]; int te[4];
#pragma unroll
    for (int k = 0; k < 4; ++k) {
        float bv = logit; int bi = e;
#pragma unroll
        for (int o = 16; o > 0; o >>= 1) { const float ov = __shfl_xor(bv, o); const int oi = __shfl_xor(bi, o); if (ov > bv || (ov == bv && oi < bi)) { bv = ov; bi = oi; } }
        tl[k] = bv; te[k] = bi;
        if (e == bi) logit = -INFINITY;
    }
    ev = 0; wv = 0.f; lpos = 0;
    if (e < 4) {
        const float e1 = expf(tl[1] - tl[0]), e2 = expf(tl[2] - tl[0]), e3 = expf(tl[3] - tl[0]);
        const float inv = 1.f / (1.f + e1 + e2 + e3);
        wv = (e == 0 ? 1.f : e == 1 ? e1 : e == 2 ? e2 : e3) * inv;
        ev = e == 0 ? te[0] : e == 1 ? te[1] : e == 2 ? te[2] : te[3];
        lpos = (int)__hip_atomic_fetch_add(&lcnt[ev], 1u, __ATOMIC_RELAXED, __HIP_MEMORY_SCOPE_WORKGROUP);
    }
}
__device__ __forceinline__ void moe_table(const Ctx& X, int l) {
    LAS int* tb = (LAS int*)(X.lds + TAB_OFF);
    if (X.wave == 0) {
        const unsigned* cnt = (const unsigned*)(X.ws + WS_CTL) + CW_CNT + l * 32 * 32;
        const int e = X.lane & 31;
        const int c = (int)__hip_atomic_load(cnt + e * 32, __ATOMIC_RELAXED, __HIP_MEMORY_SCOPE_AGENT), nt = (c + 255) >> 8;
        int incl = nt;
#pragma unroll
        for (int o = 1; o < 32; o <<= 1) { const int u = __shfl_up(incl, o); if (e >= o) incl += u; }
        if (X.lane < 32) { tb[e] = incl - nt; tb[40 + e] = c; if (e == 31) tb[NE] = incl; }
    }
    __syncthreads();
}
template <int MODE>
__device__ __forceinline__ void ph_token(const Params& p, const Ctx& X, int l, const float* h, float* hn) {
    if (MODE != 0) moe_table(X, l);
    const LAS int* tb = (const LAS int*)(X.lds + TAB_OFF);
    const float* modl = (const float*)(X.ws + WS_MODF) + (size_t)l * 4 * 6144;
    const float* modn = (const float*)(X.ws + WS_MODF) + (size_t)(MODE == 1 ? 1 : l) * 4 * 6144;
    const float* gain = MODE == 1 ? p.in[4] + D : p.in[5] + l * D;
    const int sc_off = MODE == 1 ? 1024 : 4096, sh_off = MODE == 1 ? 0 : 3072;
    const bf16_t* y = (const bf16_t*)(X.ws + WS_Y);
    LAS float* rsl = (LAS float*)X.lds;
    LAS float* part = (LAS float*)(X.lds + 1024);
    if (MODE == 0 && X.tid < 32) ((LAS unsigned*)(X.lds + 1024 + 65536))[X.tid] = 0u;
    for (int tile = X.bid; tile < T / 64; tile += X.G) {
        const int lane = fresh(X.lane), w = X.wave, tb0 = tile * 64, bb = tb0 / S;
        SUB_BEGIN(X, 31);
        Row ca_, cb_, cg_;
        { const float* m = modn + (size_t)bb * 6144;
#pragma unroll
          for (int j = 0; j < 4; ++j) { if (MODE != 2) { const f32x4 g = ((const f32x4*)gain)[64 * j + lane], a = ((const f32x4*)(m + sc_off))[64 * j + lane]; ca_.v[j] = g * (a + 1.f); cb_.v[j] = ((const f32x4*)(m + sh_off))[64 * j + lane]; }
                                        if (MODE != 0) cg_.v[j] = ((const f32x4*)(modl + (size_t)bb * 6144 + 5120))[64 * j + lane]; } }
        int pe_ = 0, pp_ = 0; float pw_ = 0.f;
        if (MODE != 0 && lane < 32) { const int idx = (tb0 + 8 * w) * 4 + lane; pe_ = ((const int*)(X.ws + WS_TOKE))[idx]; pp_ = ((const int*)(X.ws + WS_TOKP))[idx]; pw_ = ((const float*)(X.ws + WS_TOKW))[idx]; }
#pragma unroll 1
        for (int k2 = 0; k2 < 4; ++k2) {
            Row r[2];
#pragma unroll
            for (int u = 0; u < 2; ++u) row_load(r[u], h + (size_t)(tb0 + 8 * w + 2 * k2 + u) * D, lane);
            if (MODE != 0) {
#pragma unroll
                for (int u = 0; u < 2; ++u) {
#pragma unroll
                    for (int kk = 0; kk < 4; ++kk) {
                        const int sl = (2 * k2 + u) * 4 + kk;
                        const int e = __shfl(pe_, sl), pos = __shfl(pp_, sl); const float wt = __shfl(pw_, sl);
                        const bf16_t* yr = y + (size_t)(tb[e] * 256 + pos) * D;
#pragma unroll
                        for (int j = 0; j < 4; ++j) { const u32x2 q = ((const u32x2*)yr)[64 * j + lane]; const f32x4 gw = cg_.v[j] * wt;
                            r[u].v[j].x += gw.x * bflo(q.x); r[u].v[j].y += gw.y * bfhi(q.x); r[u].v[j].z += gw.z * bflo(q.y); r[u].v[j].w += gw.w * bfhi(q.y); }
                    }
                    row_store(r[u], hn + (size_t)(tb0 + 8 * w + 2 * k2 + u) * D, lane);
                    __builtin_amdgcn_sched_barrier(0);
                }
            }
            if (MODE != 2) {
#pragma unroll
                for (int u = 0; u < 2; ++u) {
                    float ssq = 0.f;
#pragma unroll
                    for (int j = 0; j < 4; ++j) ssq += (r[u].v[j].x * r[u].v[j].x + r[u].v[j].y * r[u].v[j].y) + (r[u].v[j].z * r[u].v[j].z + r[u].v[j].w * r[u].v[j].w);
                    const float rs = rsqrtf(wave_sum(ssq) * (1.f / 1024.f) + EPS);
                    bf16_t* uh = (bf16_t*)(X.ws + WS_U) + (size_t)(tb0 + 8 * w + 2 * k2 + u) * D;
#pragma unroll
                    for (int j = 0; j < 4; ++j) { const f32x4 o = r[u].v[j] * rs * ca_.v[j] + cb_.v[j];
                        u32x2 hi; hi.x = pk2(o.x, o.y); hi.y = pk2(o.z, o.w); ((u32x2*)uh)[64 * j + lane] = hi; }
                }
            }
        }
        SUB_END(X, 31);
        if (MODE == 2) continue;
        SUB_BEGIN(X, 32);
        __syncthreads();
        {
            const int ql = lane & 31, hf = lane >> 5;
            const bf16_t* wh = (const bf16_t*)(X.ws + WS_SKW) + (size_t)(MODE == 0 ? l : 2) * 2 * 32 * 1024 + (size_t)ql * 1024 + 128 * w + 8 * hf;
            const bf16_t* uh = (const bf16_t*)(X.ws + WS_U) + (size_t)(tb0 + ql) * D + 128 * w + 8 * hf;
            f32x16 acc0, acc1;
#pragma unroll
            for (int i = 0; i < 16; ++i) { acc0[i] = 0.f; acc1[i] = 0.f; }
#pragma unroll
            for (int ks = 0; ks < 8; ++ks) {
                const bf16x8 whi = *(const bf16x8*)(wh + 16 * ks), wlo = *(const bf16x8*)(wh + 32 * 1024 + 16 * ks);
                const bf16x8 ah0 = *(const bf16x8*)(uh + 16 * ks), ah1 = *(const bf16x8*)(uh + 32 * D + 16 * ks);
                acc0 = __builtin_amdgcn_mfma_f32_32x32x16_bf16(ah0, whi, acc0, 0, 0, 0); acc0 = __builtin_amdgcn_mfma_f32_32x32x16_bf16(ah0, wlo, acc0, 0, 0, 0);
                acc1 = __builtin_amdgcn_mfma_f32_32x32x16_bf16(ah1, whi, acc1, 0, 0, 0); acc1 = __builtin_amdgcn_mfma_f32_32x32x16_bf16(ah1, wlo, acc1, 0, 0, 0);
            }
#pragma unroll
            for (int i = 0; i < 16; ++i) { const int row = 8 * (i >> 2) + 4 * hf + (i & 3); part[(w * 64 + row) * 32 + ql] = acc0[i]; part[(w * 64 + 32 + row) * 32 + ql] = acc1[i]; }
        }
        __syncthreads();
        SUB_END(X, 32);
        SUB_BEGIN(X, 33);
        {
            const int e = lane & 31, hf = lane >> 5;
            LAS unsigned* lcnt = (LAS unsigned*)(X.lds + 1024 + 65536);
            int ev[4], lp[4]; float wv[4];
#pragma unroll
            for (int k = 0; k < 4; ++k) {
                const int tl = 8 * w + 4 * hf + k;
                float v = 0.f;
#pragma unroll
                for (int ww = 0; ww < 8; ++ww) v += part[(ww * 64 + tl) * 32 + e];
                if (MODE == 0) route_select(v + p.in[25][l * NE + e], lane, lcnt, ev[k], wv[k], lp[k]);
                else ((float*)(X.ws + WS_DT))[(size_t)(tb0 + tl) * 32 + e] = v;
            }
            if (MODE == 0) {
                __syncthreads();
                if (X.tid < 32) { const unsigned n = lcnt[X.tid]; unsigned* cnt = (unsigned*)(X.ws + WS_CTL) + CW_CNT + (l * 32 + X.tid) * 32;
                    lcnt[32 + X.tid] = n ? atomicAdd(cnt, n) : 0u; }
                __syncthreads();
                if (e < 4) {
#pragma unroll
                    for (int k = 0; k < 4; ++k) { const int t = tb0 + 8 * w + 4 * hf + k, pos = (int)lcnt[32 + ev[k]] + lp[k];
                        ((int*)(X.ws + WS_TOKE))[t * 4 + e] = ev[k]; ((float*)(X.ws + WS_TOKW))[t * 4 + e] = wv[k]; ((int*)(X.ws + WS_TOKP))[t * 4 + e] = pos;
                        ((int*)(X.ws + WS_SLOT))[ev[k] * CAP + pos] = t; }
                }
            }
        }
        __syncthreads();
        SUB_END(X, 33);
        if (MODE == 0 && X.tid < 32) ((LAS unsigned*)(X.lds + 1024 + 65536))[X.tid] = 0u;
    }
}

__device__ __forceinline__ void ld64bf(const bf16_t* p, float (&q)[64]) {
#pragma unroll
    for (int i = 0; i < 8; ++i) { const u32x4 w = ((const u32x4*)p)[i];
        q[8 * i] = bflo(w.x); q[8 * i + 1] = bfhi(w.x); q[8 * i + 2] = bflo(w.y); q[8 * i + 3] = bfhi(w.y); q[8 * i + 4] = bflo(w.z); q[8 * i + 5] = bfhi(w.z); q[8 * i + 6] = bflo(w.w); q[8 * i + 7] = bfhi(w.w); }
}
__device__ __forceinline__ float dot64bf(const bf16_t* p, const float (&q)[64]) {
    float d = 0.f;
#pragma unroll
    for (int i = 0; i < 8; ++i) { const u32x4 w = ((const u32x4*)p)[i];
        d += q[8 * i] * bflo(w.x) + q[8 * i + 1] * bfhi(w.x) + q[8 * i + 2] * bflo(w.y) + q[8 * i + 3] * bfhi(w.y) + q[8 * i + 4] * bflo(w.z) + q[8 * i + 5] * bfhi(w.z) + q[8 * i + 6] * bflo(w.w) + q[8 * i + 7] * bfhi(w.w); }
    return d;
}
__device__ __forceinline__ float dot64f(const float* p, const float (&q)[64]) {
    float d = 0.f;
#pragma unroll
    for (int i = 0; i < 16; ++i) { const f32x4 w = ((const f32x4*)p)[i]; d += (q[4 * i] * w.x + q[4 * i + 1] * w.y) + (q[4 * i + 2] * w.z + q[4 * i + 3] * w.w); }
    return d;
}
__device__ __forceinline__ void sb_unit(const Ctx& X, int qt, int bh) {
    const int b = bh >> 3, hh = bh & 7, t = qt * 64 + X.lane;
    const bf16_t* base = (const bf16_t*)(X.ws + WS_BIG) + (size_t)b * S * PROJ_LD;
    float q[64], acc[64];
    ld64bf(base + (size_t)t * PROJ_LD + OFF_SBQ + hh * 64, q);
#pragma unroll
    for (int d = 0; d < 64; ++d) acc[d] = 0.f;
    float run = 0.f;
    for (int j = qt * 64 + 62; j >= 0; --j) {
        const bf16_t* kr = base + (size_t)j * PROJ_LD + OFF_SBK + hh * 64;
        const float logit = dot64bf(kr, q) * 0.125f;
        if (j < t) {
            const float w = expf(logsig(logit) + run);
            run += logsig(-logit);
            const bf16_t* vr = base + (size_t)j * PROJ_LD + OFF_SBV + hh * 64;
#pragma unroll
            for (int i = 0; i < 8; ++i) { const u32x4 v = ((const u32x4*)vr)[i];
                acc[8 * i] += w * bflo(v.x); acc[8 * i + 1] += w * bfhi(v.x); acc[8 * i + 2] += w * bflo(v.y); acc[8 * i + 3] += w * bfhi(v.y);
                acc[8 * i + 4] += w * bflo(v.z); acc[8 * i + 5] += w * bfhi(v.z); acc[8 * i + 6] += w * bflo(v.w); acc[8 * i + 7] += w * bfhi(v.w); }
        }
    }
    bf16_t* op = (bf16_t*)(X.ws + WS_O) + (size_t)(b * S + t) * D + hh * 64;
#pragma unroll
    for (int i = 0; i < 8; ++i) { u32x4 w; w.x = pk2(acc[8 * i], acc[8 * i + 1]); w.y = pk2(acc[8 * i + 2], acc[8 * i + 3]); w.z = pk2(acc[8 * i + 4], acc[8 * i + 5]); w.w = pk2(acc[8 * i + 6], acc[8 * i + 7]);
        ((u32x4*)op)[i] = w; }
}

#define DMA16(gptr, ldsptr) __builtin_amdgcn_global_load_lds((const unsigned*)(gptr), (LAS unsigned*)(ldsptr), 16, 0, 0)
#define RING2_WAIT_BAR(q, nb) do { const int issued_ = (q) + 6 < (nb) ? (q) + 6 : (nb); const int need_ = (q) + 2 < (nb) ? (q) + 2 : (nb); const int fl_ = issued_ - need_; \
        if (fl_ >= 4) asm volatile("s_waitcnt vmcnt(8)\n\ts_barrier" ::: "memory"); else if (fl_ == 3) asm volatile("s_waitcnt vmcnt(6)\n\ts_barrier" ::: "memory"); \
        else if (fl_ == 2) asm volatile("s_waitcnt vmcnt(4)\n\ts_barrier" ::: "memory"); else if (fl_ == 1) asm volatile("s_waitcnt vmcnt(2)\n\ts_barrier" ::: "memory"); \
        else asm volatile("s_waitcnt vmcnt(0)\n\ts_barrier" ::: "memory"); } while (0)
__device__ __forceinline__ int pi32(int r) { return (r & 0x13) | ((r & 4) << 1) | ((r & 8) >> 1); }
__device__ __forceinline__ void sb_attn_unit(const Ctx& X, int bh, int qb) {
    const int b = bh >> 3, h = bh & 7, q0 = qb * 256, lane = fresh(X.lane), w = X.wave, ql = lane & 31, hf = lane >> 5;
    const bf16_t* proj = (const bf16_t*)(X.ws + WS_BIG) + (size_t)b * S * PROJ_LD;
    const bf16_t* vt = (const bf16_t*)(X.ws + WS_VT) + (size_t)(h * 64) * T + (size_t)b * S;
    const int tq = q0 + 32 * w + ql;
    bf16x8 qf[4];
#pragma unroll
    for (int s = 0; s < 4; ++s) qf[s] = *(const bf16x8*)(proj + (size_t)tq * PROJ_LD + OFF_SBQ + h * 64 + 16 * s + 8 * hf);
    f32x16 o0, o1;
#pragma unroll
    for (int i = 0; i < 16; ++i) { o0[i] = 0.f; o1[i] = 0.f; }
    float run = 1.f;
    const int nblk = 4 * qb + 4, jw = (q0 + 32 * w + 30) >> 6;
    const float CS = 0.125f * 1.4426950408889634f;
    const bf16_t* kg = proj + (size_t)lane * PROJ_LD + OFF_SBK + h * 64 + 8 * w;
    const bf16_t* vg = vt + (size_t)lane * T + 8 * w;
    LAS unsigned char* ring = X.lds + w * 1024;
    const int krow = pi32(ql) * 16;
    asm volatile("s_waitcnt vmcnt(0)" ::: "memory");
#pragma unroll
    for (int d = 0; d < 6; ++d) if (d < nblk) { DMA16(kg + (size_t)(64 * (nblk - 1 - d)) * PROJ_LD, ring + d * 16384); DMA16(vg + 64 * (nblk - 1 - d), ring + d * 16384 + 8192); }
    for (int q = 0; q < nblk; ++q) {
        const int j = nblk - 1 - q;
        if ((q & 1) == 0) {
            SUB_BEGIN(X, 11);
            RING2_WAIT_BAR(q, nblk);
            SUB_END(X, 11);
#pragma unroll
            for (int d = 6; d < 8; ++d) if (q + d < nblk) { const int jj = nblk - 1 - (q + d), sl = (q + d) & 7; DMA16(kg + (size_t)(64 * jj) * PROJ_LD, ring + sl * 16384); DMA16(vg + 64 * jj, ring + sl * 16384 + 8192); }
        }
        LAS unsigned char* buf = X.lds + (q & 7) * 16384;
        SUB_BEGIN(X, 12);
        if (j <= jw) {
            const bool diag = 64 * j + 63 >= q0 + 32 * w;
#pragma unroll
            for (int kt = 1; kt >= 0; --kt) {
                f32x16 sc;
#pragma unroll
                for (int i = 0; i < 16; ++i) sc[i] = 0.f;
#pragma unroll
                for (int s = 0; s < 4; ++s) { const bf16x8 kf = *(const LAS bf16x8*)(buf + (2 * s + hf) * 1024 + kt * 512 + krow); sc = __builtin_amdgcn_mfma_f32_32x32x16_bf16(kf, qf[s], sc, 0, 0, 0); }
                f32x16 ee = sc * (-CS), be, kp;
#pragma unroll
                for (int i = 0; i < 16; ++i) ee[i] = __builtin_amdgcn_exp2f(ee[i]);
                be = ee + 1.f;
#pragma unroll
                for (int i = 0; i < 16; ++i) be[i] = __builtin_amdgcn_rcpf(be[i]);
                kp = ee * be;
                if (diag) {
                    asm volatile("; diagonal block: masks" ::: "memory");
                    const int pos0 = 64 * j + 32 * kt + 8 * hf;
#pragma unroll
                    for (int i = 0; i < 16; ++i) { const bool valid = (pos0 + 16 * (i >> 3) + (i & 7)) < tq; be[i] = valid ? be[i] : 0.f; kp[i] = valid ? kp[i] : 1.f; }
                }
                float l1 = 1.f, l0 = 1.f;
#pragma unroll
                for (int i = 15; i >= 8; --i) { const float t = be[i] * l1; l1 *= kp[i]; be[i] = t; }
#pragma unroll
                for (int i = 7; i >= 0; --i) { const float t = be[i] * l0; l0 *= kp[i]; be[i] = t; }
                const float p1 = __shfl_xor(l1, 32), p0 = __shfl_xor(l0, 32);
                const float hi1 = hf ? l1 : p1, lo1 = hf ? p1 : l1, hi0 = hf ? l0 : p0, lo0 = hf ? p0 : l0;
                const float r1 = run * hi1, r2 = r1 * lo1, r3 = r2 * hi0;
                const float pre_up = hf ? run : r1, pre_lo = hf ? r2 : r3;
                run = r3 * lo0;
#pragma unroll
                for (int a = 0; a < 2; ++a) {
                    const float pre = a ? pre_up : pre_lo;
                    u32x4 pw; pw.x = pk2(be[8 * a] * pre, be[8 * a + 1] * pre); pw.y = pk2(be[8 * a + 2] * pre, be[8 * a + 3] * pre); pw.z = pk2(be[8 * a + 4] * pre, be[8 * a + 5] * pre); pw.w = pk2(be[8 * a + 6] * pre, be[8 * a + 7] * pre);
                    const bf16x8 pf = __builtin_bit_cast(bf16x8, pw);
                    const bf16x8 v0 = *(const LAS bf16x8*)(buf + 8192 + (4 * kt + 2 * a + hf) * 1024 + ql * 16);
                    const bf16x8 v1 = *(const LAS bf16x8*)(buf + 8192 + (4 * kt + 2 * a + hf) * 1024 + 512 + ql * 16);
                    o0 = __builtin_amdgcn_mfma_f32_32x32x16_bf16(v0, pf, o0, 0, 0, 0);
                    o1 = __builtin_amdgcn_mfma_f32_32x32x16_bf16(v1, pf, o1, 0, 0, 0);
                }
            }
        }
        SUB_END(X, 12);
    }
    asm volatile("s_barrier" ::: "memory");
    bf16_t* op = (bf16_t*)(X.ws + WS_O) + (size_t)(b * S + fresh(tq)) * D + h * 64 + 4 * hf;
#pragma unroll
    for (int g4 = 0; g4 < 4; ++g4) {
        u32x2 w0; w0.x = pk2(o0[4 * g4], o0[4 * g4 + 1]); w0.y = pk2(o0[4 * g4 + 2], o0[4 * g4 + 3]); *(u32x2*)(op + 8 * g4) = w0;
        u32x2 w1; w1.x = pk2(o1[4 * g4], o1[4 * g4 + 1]); w1.y = pk2(o1[4 * g4 + 2], o1[4 * g4 + 3]); *(u32x2*)(op + 32 + 8 * g4) = w1;
    }
}
__device__ __forceinline__ void ph_sb(const Ctx& X) {
    for (int pr = X.bid; pr < 256; pr += X.G)
#pragma unroll 1
        for (int u = 0; u < 2; ++u) { const int bh = pr >> 3, qa = pr & 7; sb_attn_unit(X, bh, u ? qa : 15 - qa); }
}
__device__ __forceinline__ void ph_attn_a(const Params& p, const Ctx& X) {
    const bf16_t* proj = (const bf16_t*)(X.ws + WS_BIG);
    for (int unit = X.bid; unit < 128; unit += X.G) {
        const int kv = unit >> 6, bg = (unit >> 3) & 7, ntile = unit & 7, b = bg >> 1, g = bg & 1, lane = fresh(X.lane), w = X.wave, ql = lane & 31, hf = lane >> 5;
        const int n = min(32 * ntile + ql, NCMP - 1);
        const float* pe = kv ? p.in[11] : p.in[10];
        const bf16_t* w1t = (const bf16_t*)(X.ws + WS_W1T) + (size_t)kv * 128 * 2048;
        const bf16_t* arow = proj + (size_t)(b * S + n * 16) * PROJ_LD + (kv ? OFF_VC : OFF_KC) + g * 64;
        f32x16 acc[4];
#pragma unroll
        for (int ct = 0; ct < 4; ++ct)
#pragma unroll
            for (int i = 0; i < 16; ++i) acc[ct][i] = 0.f;
        for (int ks = 0; ks < 16; ++ks) {
            const int k0 = 256 * w + 16 * ks + 8 * hf, l = k0 >> 6, d = k0 & 63;
            const u32x4 q = *(const u32x4*)(arow + (size_t)l * PROJ_LD + d);
            const f32x4 e0 = *(const f32x4*)(pe + k0), e1 = *(const f32x4*)(pe + k0 + 4);
            u32x4 o; o.x = pk2(bflo(q.x) + e0.x, bfhi(q.x) + e0.y); o.y = pk2(bflo(q.y) + e0.z, bfhi(q.y) + e0.w); o.z = pk2(bflo(q.z) + e1.x, bfhi(q.z) + e1.y); o.w = pk2(bflo(q.w) + e1.z, bfhi(q.w) + e1.w);
            const bf16x8 af = __builtin_bit_cast(bf16x8, o);
#pragma unroll
            for (int ct = 0; ct < 4; ++ct) acc[ct] = __builtin_amdgcn_mfma_f32_32x32x16_bf16(af, *(const bf16x8*)(w1t + (size_t)(32 * ct + ql) * 2048 + k0), acc[ct], 0, 0, 0);
        }
        LAS float* part = (LAS float*)X.lds;
#pragma unroll
        for (int ct = 0; ct < 4; ++ct)
#pragma unroll
            for (int i = 0; i < 16; ++i) part[w * 4096 + (8 * (i >> 2) + 4 * hf + (i & 3)) * 128 + 32 * ct + ql] = acc[ct][i];
        __syncthreads();
        LAS float* hid = part;
        {
            const int tidf = fresh(X.tid);
#pragma unroll
            for (int k = 0; k < 8; ++k) { const int e = tidf + NTHREADS * k; float v = 0.f;
#pragma unroll
                for (int ww = 0; ww < 8; ++ww) v += part[ww * 4096 + e];
                hid[e] = siluf(v); }
        }
        __syncthreads();
        {
            const int tidf = fresh(X.tid), row = tidf >> 4, c4 = (tidf & 15) * 4;
            const float* w2 = kv ? p.in[15] : p.in[13];
            f32x4 o = (f32x4){0.f, 0.f, 0.f, 0.f};
            for (int j = 0; j < 128; ++j) o = o + *(const f32x4*)(w2 + j * 64 + c4) * hid[row * 128 + j];
            const int nn = 32 * ntile + row;
            if (kv == 0) {
                float ssq = (o.x * o.x + o.y * o.y) + (o.z * o.z + o.w * o.w);
                ssq += __shfl_xor(ssq, 1); ssq += __shfl_xor(ssq, 2); ssq += __shfl_xor(ssq, 4); ssq += __shfl_xor(ssq, 8);
                const float r = rsqrtf(ssq * (1.f / 64.f) + EPS); const f32x4 gn = *(const f32x4*)(p.in[9] + c4);
                o = o * r * gn;
                if (nn >= NCMP) o = (f32x4){0.f, 0.f, 0.f, 0.f};
                u32x2 wv; wv.x = pk2(o.x, o.y); wv.y = pk2(o.z, o.w);
                *(u32x2*)((bf16_t*)(X.ws + WS_KCB) + ((size_t)bg * 256 + nn) * 64 + c4) = wv;
            } else {
                if (nn >= NCMP) o = (f32x4){0.f, 0.f, 0.f, 0.f};
                bf16_t* vt = (bf16_t*)(X.ws + WS_VCT) + ((size_t)bg * 64 + c4) * 256 + nn;
                vt[0] = (bf16_t)f2bf(o.x); vt[256] = (bf16_t)f2bf(o.y); vt[512] = (bf16_t)f2bf(o.z); vt[768] = (bf16_t)f2bf(o.w);
            }
        }
        __syncthreads();
    }
    for (int t2 = X.gw; t2 < T / 2; t2 += X.ngw) {
        const int lane = fresh(X.lane), sub = lane & 7;
#pragma unroll
        for (int k = 0; k < 2; ++k) {
            const int t = 2 * t2 + k;
            const u32x4 q = *(const u32x4*)(proj + (size_t)t * PROJ_LD + OFF_NQ + 8 * lane);
            float v[8] = {bflo(q.x), bfhi(q.x), bflo(q.y), bfhi(q.y), bflo(q.z), bfhi(q.z), bflo(q.w), bfhi(q.w)};
            float ssq = 0.f;
#pragma unroll
            for (int i = 0; i < 8; ++i) ssq += v[i] * v[i];
            ssq += __shfl_xor(ssq, 1); ssq += __shfl_xor(ssq, 2); ssq += __shfl_xor(ssq, 4);
            const float r = rsqrtf(ssq * (1.f / 64.f) + EPS) * (0.125f * 1.4426950408889634f);
            const f32x4 g0 = *(const f32x4*)(p.in[8] + 8 * sub), g1 = *(const f32x4*)(p.in[8] + 8 * sub + 4);
            u32x4 o; o.x = pk2(v[0] * r * g0.x, v[1] * r * g0.y); o.y = pk2(v[2] * r * g0.z, v[3] * r * g0.w); o.z = pk2(v[4] * r * g1.x, v[5] * r * g1.y); o.w = pk2(v[6] * r * g1.z, v[7] * r * g1.w);
            *(u32x4*)((bf16_t*)(X.ws + WS_QNB) + (size_t)t * 512 + 8 * lane) = o;
        }
        {
            const int t = 2 * t2 + (lane >> 5), l32 = lane & 31, isw = l32 >> 4, c = 8 * (l32 & 15);
            const u32x4 q = *(const u32x4*)(proj + (size_t)t * PROJ_LD + (isw ? OFF_KW : OFF_KS) + c);
            float v[8] = {bflo(q.x), bfhi(q.x), bflo(q.y), bfhi(q.y), bflo(q.z), bfhi(q.z), bflo(q.w), bfhi(q.w)};
            float ssq = 0.f;
#pragma unroll
            for (int i = 0; i < 8; ++i) ssq += v[i] * v[i];
            ssq += __shfl_xor(ssq, 1); ssq += __shfl_xor(ssq, 2); ssq += __shfl_xor(ssq, 4);
            const float r = rsqrtf(ssq * (1.f / 64.f) + EPS);
            const float* gn = p.in[9] + (isw ? 128 : 64) + 8 * sub;
            const f32x4 g0 = *(const f32x4*)gn, g1 = *(const f32x4*)(gn + 4);
            u32x4 o; o.x = pk2(v[0] * r * g0.x, v[1] * r * g0.y); o.y = pk2(v[2] * r * g0.z, v[3] * r * g0.w); o.z = pk2(v[4] * r * g1.x, v[5] * r * g1.y); o.w = pk2(v[6] * r * g1.z, v[7] * r * g1.w);
            *(u32x4*)((bf16_t*)(X.ws + (isw ? WS_KWN : WS_KSN)) + (size_t)t * 128 + c) = o;
        }
    }
}
struct NsaSt { f32x16 o0, o1; float m, l; };
template <int MODE>
__device__ __forceinline__ void nsa_flash(const Ctx& X, const bf16_t* kg, const bf16_t* vg, int jlo, int jhi, const bf16x8 (&qf)[4], int tq, float slope2,
                                          unsigned long long mymask, unsigned long long wavemask, NsaSt& st) {
    const int lane = fresh(X.lane), w = X.wave, ql = lane & 31, hf = lane >> 5;
    LAS unsigned char* ring = X.lds + w * 1024;
    const int krow = pi32(ql) * 16, nb = jhi - jlo + 1;
    asm volatile("s_waitcnt vmcnt(0)" ::: "memory");
#pragma unroll
    for (int d = 0; d < 6; ++d) if (d < nb) { DMA16(kg + (size_t)(64 * (jhi - d)) * 128, ring + d * 16384); DMA16(vg + 64 * (jhi - d), ring + d * 16384 + 8192); }
    f32x16 sl;
#pragma unroll
    for (int i = 0; i < 16; ++i) sl[i] = slope2 * (float)(16 * (i >> 3) + (i & 7));
    const float k32 = slope2 * 32.f;
    for (int q = 0; q < nb; ++q) {
        const int j = jhi - q;
        if ((q & 1) == 0) {
            SUB_BEGIN(X, 21);
            RING2_WAIT_BAR(q, nb);
            SUB_END(X, 21);
#pragma unroll
            for (int d = 6; d < 8; ++d) if (q + d < nb) { const int jj = jhi - (q + d), sl2 = (q + d) & 7; DMA16(kg + (size_t)(64 * jj) * 128, ring + sl2 * 16384); DMA16(vg + 64 * jj, ring + sl2 * 16384 + 8192); }
        }
        LAS unsigned char* buf = X.lds + (q & 7) * 16384;
        SUB_BEGIN(X, 22);
        if (MODE == 1 || ((wavemask >> j) & 1ull)) {
            f32x16 s0, s1;
#pragma unroll
            for (int i = 0; i < 16; ++i) { s0[i] = 0.f; s1[i] = 0.f; }
#pragma unroll
            for (int s = 0; s < 4; ++s) {
                const bf16x8 k0 = *(const LAS bf16x8*)(buf + (2 * s + hf) * 1024 + krow), k1 = *(const LAS bf16x8*)(buf + (2 * s + hf) * 1024 + 512 + krow);
                s0 = __builtin_amdgcn_mfma_f32_32x32x16_bf16(k0, qf[s], s0, 0, 0, 0); s1 = __builtin_amdgcn_mfma_f32_32x32x16_bf16(k1, qf[s], s1, 0, 0, 0);
            }
            const int d0 = tq - (64 * j + 8 * hf);
            if (j == jhi || (MODE == 1 && j == jlo)) {
                asm volatile("; boundary block: masks" ::: "memory");
#pragma unroll
                for (int i = 0; i < 16; ++i) {
                    const int da = d0 - (16 * (i >> 3) + (i & 7)), db = da - 32;
                    s0[i] = (da >= 0 && (MODE == 0 || da < 512)) ? s0[i] : -INFINITY; s1[i] = (db >= 0 && (MODE == 0 || db < 512)) ? s1[i] : -INFINITY;
                }
            }
            s0 = s0 + sl; s1 = s1 + sl;
            float mb0 = fmaxf(s0[0], s0[1]), mb1 = fmaxf(s1[0], s1[1]);
#pragma unroll
            for (int i = 2; i < 16; ++i) { mb0 = fmaxf(mb0, s0[i]); mb1 = fmaxf(mb1, s1[i]); }
            const float base = slope2 * (float)d0;
            const bool sel = MODE == 1 || ((mymask >> j) & 1ull);
            float mb = fmaxf(mb0, mb1 + k32) - base;
            mb = sel ? mb : -INFINITY;
            mb = fmaxf(mb, __shfl_xor(mb, 32));
            const float mn = fmaxf(st.m, mb), ms = mn == -INFINITY ? 0.f : mn;
            if (__any(mn > st.m)) {
                const float alpha = __builtin_amdgcn_exp2f(st.m - ms);
                st.l *= alpha;
#pragma unroll
                for (int i = 0; i < 16; ++i) { st.o0[i] *= alpha; st.o1[i] *= alpha; }
                st.m = mn;
            }
            const float off0 = sel ? ms + base : INFINITY, off1 = off0 - k32;
            s0 = s0 - off0; s1 = s1 - off1;
            float ls = 0.f;
#pragma unroll
            for (int i = 0; i < 16; ++i) { s0[i] = __builtin_amdgcn_exp2f(s0[i]); s1[i] = __builtin_amdgcn_exp2f(s1[i]); ls += s0[i] + s1[i]; }
            st.l += ls;
#pragma unroll
            for (int kt = 0; kt < 2; ++kt)
#pragma unroll
                for (int a = 0; a < 2; ++a) {
                    u32x4 pw;
                    if (kt == 0) { pw.x = pk2(s0[8 * a], s0[8 * a + 1]); pw.y = pk2(s0[8 * a + 2], s0[8 * a + 3]); pw.z = pk2(s0[8 * a + 4], s0[8 * a + 5]); pw.w = pk2(s0[8 * a + 6], s0[8 * a + 7]); }
                    else { pw.x = pk2(s1[8 * a], s1[8 * a + 1]); pw.y = pk2(s1[8 * a + 2], s1[8 * a + 3]); pw.z = pk2(s1[8 * a + 4], s1[8 * a + 5]); pw.w = pk2(s1[8 * a + 6], s1[8 * a + 7]); }
                    const bf16x8 pf = __builtin_bit_cast(bf16x8, pw);
                    const bf16x8 v0 = *(const LAS bf16x8*)(buf + 8192 + (4 * kt + 2 * a + hf) * 1024 + ql * 16);
                    const bf16x8 v1 = *(const LAS bf16x8*)(buf + 8192 + (4 * kt + 2 * a + hf) * 1024 + 512 + ql * 16);
                    st.o0 = __builtin_amdgcn_mfma_f32_32x32x16_bf16(v0, pf, st.o0, 0, 0, 0);
                    st.o1 = __builtin_amdgcn_mfma_f32_32x32x16_bf16(v1, pf, st.o1, 0, 0, 0);
                }
        }
        SUB_END(X, 22);
    }
    asm volatile("s_barrier" ::: "memory");
}
__device__ __forceinline__ void nsa_unit(const Ctx& X, int bg, int qb) {
    const int b = bg >> 1, g = bg & 1, lane = fresh(X.lane), w = X.wave, ql = lane & 31, hf = lane >> 5, r = ql >> 3, hh = g * 4 + r;
    const int t0 = 64 * qb, tq = t0 + 8 * w + (ql & 7);
    const float slope2 = exp2f(-(float)(hh + 1)) * 1.4426950408889634f;
    const bf16_t* proj = (const bf16_t*)(X.ws + WS_BIG);
    bf16x8 qf[4];
    { const bf16_t* qp = (const bf16_t*)(X.ws + WS_QNB) + (size_t)(b * S + tq) * 512 + hh * 64 + 8 * hf;
#pragma unroll
      for (int s = 0; s < 4; ++s) qf[s] = *(const bf16x8*)(qp + 16 * s); }
    float gate[3];
    { const bf16_t* gp = proj + (size_t)(b * S + tq) * PROJ_LD + OFF_GATE + hh * 3;
#pragma unroll
      for (int i = 0; i < 3; ++i) gate[i] = 1.f / (1.f + __expf(-bf2f(gp[i]))); }
    f32x16 of0, of1;
#pragma unroll
    for (int i = 0; i < 16; ++i) { of0[i] = 0.f; of1[i] = 0.f; }
    NsaSt st;
    SUB_BEGIN(X, 23);
    LAS float* pacc = (LAS float*)(X.lds + 65536) + w * 2048;
    {
        const int ncm = t0 + 63 >= 31 ? (t0 + 63 - 31) / 16 + 1 : 0, nt = (ncm + 31) >> 5, ncv = tq >= 31 ? (tq - 31) / 16 + 1 : 0;
        {
            const bf16_t* kc = (const bf16_t*)(X.ws + WS_KCB) + (size_t)bg * 256 * 64; const bf16_t* vc = (const bf16_t*)(X.ws + WS_VCT) + (size_t)bg * 64 * 256;
            const int tidf = fresh(X.tid);
#pragma unroll
            for (int i = 0; i < 4; ++i) { const int pidx = tidf + NTHREADS * i;
                *(LAS u32x4*)(X.lds + (pidx >> 8) * 4096 + (pidx & 255) * 16) = *(const u32x4*)(kc + (size_t)(pidx & 255) * 64 + 8 * (pidx >> 8));
                *(LAS u32x4*)(X.lds + 32768 + (pidx >> 6) * 1024 + (pidx & 63) * 16) = *(const u32x4*)(vc + (size_t)(pidx & 63) * 256 + 8 * (pidx >> 6)); }
#pragma unroll
            for (int i = 0; i < 8; ++i) *(LAS f32x4*)(pacc + (i * 64 + lane) * 4) = (f32x4){0.f, 0.f, 0.f, 0.f};
        }
        __syncthreads();
        const int krow = pi32(ql) * 16;
        float ml = -INFINITY, ll = 0.f;
        for (int kt = 0; kt < nt; ++kt) {
            f32x16 sc;
#pragma unroll
            for (int i = 0; i < 16; ++i) sc[i] = 0.f;
#pragma unroll
            for (int s = 0; s < 4; ++s) { const bf16x8 kf = *(const LAS bf16x8*)(X.lds + (2 * s + hf) * 4096 + kt * 512 + krow); sc = __builtin_amdgcn_mfma_f32_32x32x16_bf16(kf, qf[s], sc, 0, 0, 0); }
            float tm = -INFINITY;
#pragma unroll
            for (int i = 0; i < 16; ++i) { const int n = 32 * kt + 16 * (i >> 3) + 8 * hf + (i & 7);
                sc[i] = n < ncv ? sc[i] - slope2 * (float)(tq - (16 * n + 31)) : -INFINITY; tm = fmaxf(tm, sc[i]); }
            const float mn = fmaxf(ml, tm), ms = mn == -INFINITY ? 0.f : mn;
            float ls = 0.f;
#pragma unroll
            for (int i = 0; i < 16; ++i) ls += __builtin_amdgcn_exp2f(sc[i] - ms);
            ll = ll * __builtin_amdgcn_exp2f(ml - ms) + ls; ml = mn;
        }
        float ms, inv;
        { const float mo = __shfl_xor(ml, 32), lo = __shfl_xor(ll, 32), mt = fmaxf(ml, mo); ms = mt == -INFINITY ? 0.f : mt;
          const float lt = ll * __builtin_amdgcn_exp2f(ml - ms) + lo * __builtin_amdgcn_exp2f(mo - ms); inv = lt > 0.f ? 1.f / lt : 0.f; }
#pragma unroll
        for (int i = 0; i < 16; ++i) { st.o0[i] = 0.f; st.o1[i] = 0.f; }
        float carry = 0.f;
        for (int kt = 0; kt < nt; ++kt) {
            f32x16 sc;
#pragma unroll
            for (int i = 0; i < 16; ++i) sc[i] = 0.f;
#pragma unroll
            for (int s = 0; s < 4; ++s) { const bf16x8 kf = *(const LAS bf16x8*)(X.lds + (2 * s + hf) * 4096 + kt * 512 + krow); sc = __builtin_amdgcn_mfma_f32_32x32x16_bf16(kf, qf[s], sc, 0, 0, 0); }
#pragma unroll
            for (int i = 0; i < 16; ++i) { const int n = 32 * kt + 16 * (i >> 3) + 8 * hf + (i & 7);
                sc[i] = n < ncv ? __builtin_amdgcn_exp2f(sc[i] - slope2 * (float)(tq - (16 * n + 31)) - ms) * inv : 0.f; }
            const float pa0 = __shfl_xor(sc[7], 32), pa1 = __shfl_xor(sc[15], 32);
            const float prev0 = hf ? pa0 : carry, prev1 = hf ? pa1 : pa0;
            carry = pa1;
            {
                typedef float f32x2 __attribute__((ext_vector_type(2)));
                f32x2 e0, e1;
                e0.x = prev0 + ((sc[0] + sc[1]) + (sc[2] + sc[3])); e0.y = sc[3] + ((sc[4] + sc[5]) + (sc[6] + sc[7]));
                e1.x = prev1 + ((sc[8] + sc[9]) + (sc[10] + sc[11])); e1.y = sc[11] + ((sc[12] + sc[13]) + (sc[14] + sc[15]));
                *(LAS f32x2*)(pacc + ql * 64 + 8 * kt + 2 * hf) = e0; *(LAS f32x2*)(pacc + ql * 64 + 8 * kt + 4 + 2 * hf) = e1;
            }
#pragma unroll
            for (int a = 0; a < 2; ++a) {
                u32x4 pw; pw.x = pk2(sc[8 * a], sc[8 * a + 1]); pw.y = pk2(sc[8 * a + 2], sc[8 * a + 3]); pw.z = pk2(sc[8 * a + 4], sc[8 * a + 5]); pw.w = pk2(sc[8 * a + 6], sc[8 * a + 7]);
                const bf16x8 pf = __builtin_bit_cast(bf16x8, pw);
                const bf16x8 v0 = *(const LAS bf16x8*)(X.lds + 32768 + (4 * kt + 2 * a + hf) * 1024 + ql * 16);
                const bf16x8 v1 = *(const LAS bf16x8*)(X.lds + 32768 + (4 * kt + 2 * a + hf) * 1024 + 512 + ql * 16);
                st.o0 = __builtin_amdgcn_mfma_f32_32x32x16_bf16(v0, pf, st.o0, 0, 0, 0);
                st.o1 = __builtin_amdgcn_mfma_f32_32x32x16_bf16(v1, pf, st.o1, 0, 0, 0);
            }
        }
#pragma unroll
        for (int i = 0; i < 16; ++i) { of0[i] = gate[0] * st.o0[i]; of1[i] = gate[0] * st.o1[i]; }
    }
    SUB_END(X, 23);
    SUB_BEGIN(X, 24);
    unsigned long long mymask = 0ull, wavemask = 0ull;
    LDS_WAIT();
    for (int q8 = 0; q8 < 8; ++q8) {
        const int t = t0 + 8 * w + q8;
        const float ps = (pacc[(0 * 8 + q8) * 64 + lane] + pacc[(1 * 8 + q8) * 64 + lane]) + (pacc[(2 * 8 + q8) * 64 + lane] + pacc[(3 * 8 + q8) * 64 + lane]);
        const bool valid = lane * 64 <= t, forced = (lane == 0) || (lane == qb) || (lane == qb - 1);
        const unsigned key = valid ? ((forced ? 0x7f000000u : (__float_as_uint(fmaxf(ps, 0.f)) & ~63u)) | (unsigned)(63 - lane)) : 0u;
        unsigned thr = 0u;
#pragma unroll 1
        for (int bit = 30; bit >= 0; --bit) { const unsigned cand = thr | (1u << bit); if (__builtin_popcountll(__ballot(key >= cand)) >= 16) thr = cand; }
        const unsigned long long mk = __ballot(key >= thr && key != 0u);
        wavemask |= mk; if ((ql & 7) == q8) mymask = mk;
    }
    SUB_END(X, 24);
    __syncthreads();
    {
#pragma unroll
        for (int i = 0; i < 16; ++i) { st.o0[i] = 0.f; st.o1[i] = 0.f; }
        st.m = -INFINITY; st.l = 0.f;
        const int lf = fresh(lane);
        const bf16_t* kg = (const bf16_t*)(X.ws + WS_KSN) + ((size_t)b * S + lf) * 128 + g * 64 + 8 * w;
        const bf16_t* vg = (const bf16_t*)(X.ws + WS_VT) + (size_t)(512 + g * 64 + lf) * T + (size_t)b * S + 8 * w;
        nsa_flash<0>(X, kg, vg, 0, qb, qf, tq, slope2, mymask, wavemask, st);
        const float lt = st.l + __shfl_xor(st.l, 32), sc = gate[1] / fmaxf(lt, 1e-30f);
#pragma unroll
        for (int i = 0; i < 16; ++i) { of0[i] += sc * st.o0[i]; of1[i] += sc * st.o1[i]; }
    }
    {
#pragma unroll
        for (int i = 0; i < 16; ++i) { st.o0[i] = 0.f; st.o1[i] = 0.f; }
        st.m = -INFINITY; st.l = 0.f;
        const int lf = fresh(lane);
        const bf16_t* kg = (const bf16_t*)(X.ws + WS_KWN) + ((size_t)b * S + lf) * 128 + g * 64 + 8 * w;
        const bf16_t* vg = (const bf16_t*)(X.ws + WS_VT) + (size_t)(640 + g * 64 + lf) * T + (size_t)b * S + 8 * w;
        nsa_flash<1>(X, kg, vg, qb >= 8 ? qb - 8 : 0, qb, qf, tq, slope2, 0ull, 0ull, st);
        const float lt = st.l + __shfl_xor(st.l, 32), sc = gate[2] / fmaxf(lt, 1e-30f);
#pragma unroll
        for (int i = 0; i < 16; ++i) { of0[i] += sc * st.o0[i]; of1[i] += sc * st.o1[i]; }
    }
    bf16_t* op = (bf16_t*)(X.ws + WS_O) + (size_t)(b * S + fresh(tq)) * D + 512 + hh * 64 + 4 * hf;
#pragma unroll
    for (int g4 = 0; g4 < 4; ++g4) {
        u32x2 w0; w0.x = pk2(of0[4 * g4], of0[4 * g4 + 1]); w0.y = pk2(of0[4 * g4 + 2], of0[4 * g4 + 3]); *(u32x2*)(op + 8 * g4) = w0;
        u32x2 w1; w1.x = pk2(of1[4 * g4], of1[4 * g4 + 1]); w1.y = pk2(of1[4 * g4 + 2], of1[4 * g4 + 3]); *(u32x2*)(op + 32 + 8 * g4) = w1;
    }
}
__device__ __forceinline__ void ph_nsa(const Params& p, const Ctx& X) {
    for (int pr = X.bid; pr < 256; pr += X.G)
#pragma unroll 1
        for (int u = 0; u < 2; ++u) { const int bg = pr >> 5, qa = pr & 31; nsa_unit(X, bg, u ? qa : 63 - qa); }
}

__device__ __forceinline__ float silu_fast(float v) { return v * __builtin_amdgcn_rcpf(1.f + __expf(-v)); }
constexpr int S1_WL = RING_BYTES + 4096;
__device__ __forceinline__ void ph_ssd1(const Params& p, const Ctx& X) {
    const float* cw = p.in[17]; const float* cb = p.in[18];
    LAS float* wl = (LAS float*)(X.lds + S1_WL);
    LAS unsigned char* ldsB = X.lds;
    LAS unsigned char* ldsX = X.lds + 65536;
    for (int unit = X.bid; unit < 256; unit += X.G) {
        const int b = unit >> 6, c = (unit >> 2) & 15, g = unit & 3, tl0 = c * 256, lane = fresh(X.lane), w = X.wave, ql = lane & 31, hf = lane >> 5;
        const size_t t0 = (size_t)b * S + tl0;
        SUB_BEGIN(X, 41);
        {
            const int h = g * 8 + w;
            const float a = -expf(p.in[20][h]), dtb = p.in[19][h];
            const float* dr = (const float*)(X.ws + WS_DT) + (t0 + 4 * lane) * 32 + h;
            float dt[4], cs[4];
#pragma unroll
            for (int k = 0; k < 4; ++k) { const float raw = dr[k * 32] + dtb; dt[k] = raw > 20.f ? raw : log1pf(expf(raw)); }
            cs[0] = dt[0] * a; cs[1] = cs[0] + dt[1] * a; cs[2] = cs[1] + dt[2] * a; cs[3] = cs[2] + dt[3] * a;
            float incl = cs[3];
#pragma unroll
            for (int o = 1; o < 64; o <<= 1) { const float u = __shfl_up(incl, o); if (lane >= o) incl += u; }
            const float excl = incl - cs[3], last = __shfl(incl, 63);
#pragma unroll
            for (int k = 0; k < 4; ++k) cs[k] += excl;
            *(f32x4*)((float*)(X.ws + WS_DT2) + (size_t)(b * 32 + h) * S + tl0 + 4 * lane) = (f32x4){dt[0], dt[1], dt[2], dt[3]};
            *(f32x4*)((float*)(X.ws + WS_CS) + (size_t)(b * 32 + h) * S + tl0 + 4 * lane) = (f32x4){cs[0], cs[1], cs[2], cs[3]};
            *(LAS f32x4*)(wl + w * 256 + 4 * lane) = (f32x4){dt[0] * __expf(last - cs[0]), dt[1] * __expf(last - cs[1]), dt[2] * __expf(last - cs[2]), dt[3] * __expf(last - cs[3])};
            if (lane == 63) ((float*)(X.ws + WS_DEC))[(b * 16 + c) * 32 + h] = __expf(last);
        }
        const bf16_t* xt = (const bf16_t*)(X.ws + WS_XT); bf16_t* xct = (bf16_t*)(X.ws + WS_XCT);
        const int tidf = fresh(X.tid);
#define CONV8(rin, chg, seg, o) do { const bf16_t* src_ = xt + (size_t)(rin) * T + t0 + 8 * (seg); const u32x4 cur_ = *(const u32x4*)src_; u32x4 prv_ = (u32x4){0u, 0u, 0u, 0u}; \
            if (tl0 + 8 * (seg) >= 8) prv_ = *(const u32x4*)(src_ - 8); \
            const float x_[11] = {bfhi(prv_.z), bflo(prv_.w), bfhi(prv_.w), bflo(cur_.x), bfhi(cur_.x), bflo(cur_.y), bfhi(cur_.y), bflo(cur_.z), bfhi(cur_.z), bflo(cur_.w), bfhi(cur_.w)}; \
            const float w0_ = cw[chg], w1_ = cw[CONV_DIM + (chg)], w2_ = cw[2 * CONV_DIM + (chg)], w3_ = cw[3 * CONV_DIM + (chg)], bb_ = cb[chg]; \
            _Pragma("unroll") for (int j_ = 0; j_ < 8; ++j_) o[j_] = silu_fast(bb_ + w0_ * x_[j_] + w1_ * x_[j_ + 1] + w2_ * x_[j_ + 2] + w3_ * x_[j_ + 3]); } while (0)
        SUB_END(X, 41);
        SUB_BEGIN(X, 42);
        {
#pragma unroll
            for (int k = 0; k < 8; ++k) {
                const int it = tidf + NTHREADS * k, n = it >> 5, seg = it & 31, chg = 2048 + g * 128 + n;
                float o[8]; CONV8(g * 128 + n, chg, seg, o);
                u32x4 ov; ov.x = pk2(o[0], o[1]); ov.y = pk2(o[2], o[3]); ov.z = pk2(o[4], o[5]); ov.w = pk2(o[6], o[7]);
                *(u32x4*)(xct + (size_t)chg * T + t0 + 8 * seg) = ov;
                *(LAS u32x4*)(ldsB + seg * 2048 + n * 16) = ov;
            }
            SUB_END(X, 42);
            SUB_BEGIN(X, 43);
            const bf16_t* zbc = (const bf16_t*)(X.ws + WS_ZBC); bf16_t* bcm = (bf16_t*)(X.ws + WS_BCM);
            {
                const int c8 = tidf & 31, l0 = (tidf >> 5) * 16;
                const int col = (c8 < 16 ? g * 128 + 8 * c8 : 512 + g * 128 + 8 * (c8 - 16));
                float wk[4][8], bb[8];
                { const f32x4 b0 = *(const f32x4*)(cb + 2048 + col), b1 = *(const f32x4*)(cb + 2048 + col + 4); bb[0] = b0.x; bb[1] = b0.y; bb[2] = b0.z; bb[3] = b0.w; bb[4] = b1.x; bb[5] = b1.y; bb[6] = b1.z; bb[7] = b1.w; }
#pragma unroll
                for (int ww = 0; ww < 4; ++ww) { const f32x4 k0 = *(const f32x4*)(cw + ww * CONV_DIM + 2048 + col), k1 = *(const f32x4*)(cw + ww * CONV_DIM + 2048 + col + 4);
                    wk[ww][0] = k0.x; wk[ww][1] = k0.y; wk[ww][2] = k0.z; wk[ww][3] = k0.w; wk[ww][4] = k1.x; wk[ww][5] = k1.y; wk[ww][6] = k1.z; wk[ww][7] = k1.w; }
                u32x4 rw[19];
#pragma unroll
                for (int r = 0; r < 19; ++r) rw[r] = (tl0 + l0 - 3 + r >= 0) ? *(const u32x4*)(zbc + (t0 + l0 - 3 + r) * 3072 + 2048 + col) : (u32x4){0u, 0u, 0u, 0u};
#pragma unroll
                for (int k = 0; k < 16; ++k) {
                    float acc[8];
#pragma unroll
                    for (int i = 0; i < 8; ++i) acc[i] = bb[i];
#pragma unroll
                    for (int ww = 0; ww < 4; ++ww) { const u32x4 q = rw[k + ww];
                        acc[0] += bflo(q.x) * wk[ww][0]; acc[1] += bfhi(q.x) * wk[ww][1]; acc[2] += bflo(q.y) * wk[ww][2]; acc[3] += bfhi(q.y) * wk[ww][3];
                        acc[4] += bflo(q.z) * wk[ww][4]; acc[5] += bfhi(q.z) * wk[ww][5]; acc[6] += bflo(q.w) * wk[ww][6]; acc[7] += bfhi(q.w) * wk[ww][7]; }
                    u32x4 ov; ov.x = pk2(silu_fast(acc[0]), silu_fast(acc[1])); ov.y = pk2(silu_fast(acc[2]), silu_fast(acc[3])); ov.z = pk2(silu_fast(acc[4]), silu_fast(acc[5])); ov.w = pk2(silu_fast(acc[6]), silu_fast(acc[7]));
                    *(u32x4*)(bcm + (t0 + l0 + k) * 1024 + col) = ov;
                }
            }
        }
        SUB_END(X, 43);
#pragma unroll 1
        for (int hg = 0; hg < 4; ++hg) {
            SUB_BEGIN(X, 44);
            asm volatile("s_waitcnt lgkmcnt(0)\n\ts_barrier" ::: "memory");
#pragma unroll
            for (int k = 0; k < 8; ++k) {
                const int it = tidf + NTHREADS * k, chl = it >> 5, seg = it & 31, h8 = 2 * hg + (chl >> 6), chg = g * 512 + h8 * 64 + (chl & 63);
                float o[8]; CONV8(1024 + chg, chg, seg, o);
                u32x4 ov; ov.x = pk2(o[0], o[1]); ov.y = pk2(o[2], o[3]); ov.z = pk2(o[4], o[5]); ov.w = pk2(o[6], o[7]);
                *(u32x4*)(xct + (size_t)chg * T + t0 + 8 * seg) = ov;
                const f32x4 wa = *(const LAS f32x4*)(wl + h8 * 256 + 8 * seg), wb = *(const LAS f32x4*)(wl + h8 * 256 + 8 * seg + 4);
                u32x4 os; os.x = pk2(o[0] * wa.x, o[1] * wa.y); os.y = pk2(o[2] * wa.z, o[3] * wa.w); os.z = pk2(o[4] * wb.x, o[5] * wb.y); os.w = pk2(o[6] * wb.z, o[7] * wb.w);
                *(LAS u32x4*)(ldsX + (chl >> 6) * 32768 + seg * 1024 + (chl & 63) * 16) = os;
            }
            asm volatile("s_waitcnt lgkmcnt(0)\n\ts_barrier" ::: "memory");
            SUB_END(X, 44);
            SUB_BEGIN(X, 45);
            {
                const int hl = w >> 2, pt = (w >> 1) & 1, nt0 = 2 * (w & 1), h = g * 8 + 2 * hg + hl;
                f32x16 acc0, acc1;
#pragma unroll
                for (int i = 0; i < 16; ++i) { acc0[i] = 0.f; acc1[i] = 0.f; }
#pragma unroll 4
                for (int ks = 0; ks < 16; ++ks) {
                    const bf16x8 af = *(const LAS bf16x8*)(ldsX + hl * 32768 + (2 * ks + hf) * 1024 + (32 * pt + ql) * 16);
                    const bf16x8 b0 = *(const LAS bf16x8*)(ldsB + (2 * ks + hf) * 2048 + (32 * nt0 + ql) * 16), b1 = *(const LAS bf16x8*)(ldsB + (2 * ks + hf) * 2048 + (32 * nt0 + 32 + ql) * 16);
                    acc0 = __builtin_amdgcn_mfma_f32_32x32x16_bf16(af, b0, acc0, 0, 0, 0); acc1 = __builtin_amdgcn_mfma_f32_32x32x16_bf16(af, b1, acc1, 0, 0, 0);
                }
                float* st = (float*)(X.ws + WS_ST) + ((size_t)(b * 16 + c) * 32 + h) * 8192 + 32 * nt0 + ql;
#pragma unroll
                for (int i = 0; i < 16; ++i) { const int pr = 32 * pt + 8 * (i >> 2) + 4 * hf + (i & 3); st[pr * 128] = acc0[i]; st[pr * 128 + 32] = acc1[i]; }
            }
            SUB_END(X, 45);
        }
#undef CONV8
        __syncthreads();
    }
}
__device__ __forceinline__ void ph_ssd2(const Ctx& X) {
    const float* st = (const float*)(X.ws + WS_ST); const float* dec = (const float*)(X.ws + WS_DEC); bf16_t* pb = (bf16_t*)(X.ws + WS_PB);
    for (int e = X.bid * NTHREADS + X.tid; e < NB * 32 * 2048; e += X.G * NTHREADS) {
        const int b = e >> 16, h = (e >> 11) & 31, q4 = (e & 2047) * 4;
        f32x4 hs = (f32x4){0.f, 0.f, 0.f, 0.f};
        for (int c = 0; c < 16; ++c) {
            const size_t o = ((size_t)(b * 16 + c) * 32 + h) * 8192 + q4;
            u32x2 wv; wv.x = pk2(hs.x, hs.y); wv.y = pk2(hs.z, hs.w); *(u32x2*)(pb + o) = wv;
            hs = hs * dec[(b * 16 + c) * 32 + h] + *(const f32x4*)(st + o);
        }
    }
}
constexpr int S3_STG = 49152;
__device__ __forceinline__ void ph_ssd3(const Params& p, const Ctx& X) {
    LAS float* dtl = (LAS float*)(X.lds + 2 * S3_STG); LAS float* csl = dtl + 2048;
    constexpr int S3_TILE = 2 * S3_STG + 16384;
    static_assert(S3_TILE + 8 * 4096 <= TAB_OFF, "ssd3 LDS map");
    for (int unit = X.bid; unit < 256; unit += X.G) {
        const int b = unit >> 6, c = (unit >> 2) & 15, g = unit & 3, tl0 = c * 256, lane = fresh(X.lane), w = X.wave, ql = lane & 31, hf = lane >> 5, lq = 32 * w + ql;
        const size_t t0 = (size_t)b * S + tl0;
        LAS unsigned char* tile = X.lds + S3_TILE + w * 4096;
        const bf16_t* xg = (const bf16_t*)(X.ws + WS_XCT) + (size_t)(g * 512 + lane) * T + t0;
        const bf16_t* pg = (const bf16_t*)(X.ws + WS_PB) + ((size_t)(b * 16 + c) * 32 + g * 8) * 8192 + (size_t)lane * 128;
#define S3_ISSUE(h8, sbase) do { _Pragma("unroll") for (int cc_ = 0; cc_ < 4; ++cc_) DMA16(xg + (size_t)((h8) * 64) * T + 8 * (4 * w + cc_), X.lds + (sbase) + (4 * w + cc_) * 1024); \
            _Pragma("unroll") for (int cc_ = 0; cc_ < 2; ++cc_) DMA16(pg + (size_t)(h8) * 8192 + 8 * (2 * w + cc_), X.lds + (sbase) + 32768 + (2 * w + cc_) * 1024); } while (0)
        asm volatile("s_waitcnt vmcnt(0)" ::: "memory");
        S3_ISSUE(0, 0);
        { const int tidf = fresh(X.tid), h8 = tidf >> 6, l4 = (tidf & 63) * 4;
          *(LAS f32x4*)(dtl + h8 * 256 + l4) = *(const f32x4*)((const float*)(X.ws + WS_DT2) + (size_t)(b * 32 + g * 8 + h8) * S + tl0 + l4);
          *(LAS f32x4*)(csl + h8 * 256 + l4) = *(const f32x4*)((const float*)(X.ws + WS_CS) + (size_t)(b * 32 + g * 8 + h8) * S + tl0 + l4); }
        const bf16_t* bcm = (const bf16_t*)(X.ws + WS_BCM);
        bf16x8 cf[8];
#pragma unroll
        for (int ks = 0; ks < 8; ++ks) cf[ks] = *(const bf16x8*)(bcm + (t0 + lq) * 1024 + 512 + g * 128 + 16 * ks + 8 * hf);
        u32x4 gp[8][2];
        {
#pragma unroll
        for (int st = 0; st < 8; ++st) {
            if (st <= w) {
                f32x16 G;
#pragma unroll
                for (int i = 0; i < 16; ++i) G[i] = 0.f;
                const bf16_t* bp = bcm + (t0 + 32 * st + pi32(ql)) * 1024 + g * 128 + 8 * hf;
#pragma unroll
                for (int ks = 0; ks < 8; ++ks) G = __builtin_amdgcn_mfma_f32_32x32x16_bf16(*(const bf16x8*)(bp + 16 * ks), cf[ks], G, 0, 0, 0);
#pragma unroll
                for (int a2 = 0; a2 < 2; ++a2) { gp[st][a2].x = pk2(G[8 * a2], G[8 * a2 + 1]); gp[st][a2].y = pk2(G[8 * a2 + 2], G[8 * a2 + 3]); gp[st][a2].z = pk2(G[8 * a2 + 4], G[8 * a2 + 5]); gp[st][a2].w = pk2(G[8 * a2 + 6], G[8 * a2 + 7]); }
            } else { gp[st][0] = (u32x4){0u, 0u, 0u, 0u}; gp[st][1] = (u32x4){0u, 0u, 0u, 0u}; }
        }
        }
        float ss = 0.f;
        bf16_t* yrow = (bf16_t*)(X.ws + WS_O) + (t0 + 32 * w + (lane >> 1)) * SSM_INNER + g * 512 + 32 * (lane & 1);
        const bf16_t* zdma = (const bf16_t*)(X.ws + WS_ZBC) + (t0 + 32 * w + (lane >> 3)) * 3072 + g * 512 + 8 * ((lane & 7) ^ (lane >> 3));
        LAS unsigned char* trw = tile + (lane >> 1) * 128;
        LAS unsigned char* tac = tile + ql * 128 + 8 * hf;
#pragma unroll 1
        for (int h8 = 0; h8 < 8; ++h8) {
            const int sb = (h8 & 1) * S3_STG;
            asm volatile("s_waitcnt vmcnt(0) lgkmcnt(0)\n\ts_barrier" ::: "memory");
            if (h8 < 7) S3_ISSUE(h8 + 1, ((h8 + 1) & 1) * S3_STG);
#pragma unroll
            for (int k = 0; k < 4; ++k) DMA16(zdma + (size_t)(8 * k) * 3072 + h8 * 64, tile + k * 1024);
            f32x16 acc0, acc1;
#pragma unroll
            for (int i = 0; i < 16; ++i) { acc0[i] = 0.f; acc1[i] = 0.f; }
            {
                const LAS unsigned char* pp = X.lds + sb + 32768 + hf * 1024 + ql * 16;
#pragma unroll
                for (int ks = 0; ks < 8; ++ks) { acc0 = __builtin_amdgcn_mfma_f32_32x32x16_bf16(*(const LAS bf16x8*)(pp + ks * 2048), cf[ks], acc0, 0, 0, 0);
                                                 acc1 = __builtin_amdgcn_mfma_f32_32x32x16_bf16(*(const LAS bf16x8*)(pp + ks * 2048 + 512), cf[ks], acc1, 0, 0, 0); }
                const float e = __expf(csl[h8 * 256 + lq]);
#pragma unroll
                for (int i = 0; i < 16; ++i) { acc0[i] *= e; acc1[i] *= e; }
            }
            const float cl = csl[h8 * 256 + lq], dsk = p.in[21][g * 8 + h8];
#pragma unroll
            for (int st = 0; st < 8; ++st) {
                if (st <= w) {
                    const int s0 = 32 * st + 8 * hf;
#pragma unroll
                    for (int a2 = 0; a2 < 2; ++a2) {
                        const f32x4 d0 = *(const LAS f32x4*)(dtl + h8 * 256 + s0 + 16 * a2), d1 = *(const LAS f32x4*)(dtl + h8 * 256 + s0 + 16 * a2 + 4);
                        const f32x4 c0 = *(const LAS f32x4*)(csl + h8 * 256 + s0 + 16 * a2), c1 = *(const LAS f32x4*)(csl + h8 * 256 + s0 + 16 * a2 + 4);
                        const float dd[8] = {d0.x, d0.y, d0.z, d0.w, d1.x, d1.y, d1.z, d1.w}, cc[8] = {c0.x, c0.y, c0.z, c0.w, c1.x, c1.y, c1.z, c1.w};
                        const unsigned gw[4] = {gp[st][a2].x, gp[st][a2].y, gp[st][a2].z, gp[st][a2].w};
                        float m[8];
#pragma unroll
                        for (int j = 0; j < 8; ++j) { const int sidx = s0 + 16 * a2 + j;
                            const float gv = (j & 1) ? bfhi(gw[j >> 1]) : bflo(gw[j >> 1]);
                            float v = gv * dd[j] * __expf(fminf(cl - cc[j], 0.f));
                            if (st == w) { v = sidx > lq ? 0.f : v; v += sidx == lq ? dsk : 0.f; }
                            m[j] = v; }
                        u32x4 pw; pw.x = pk2(m[0], m[1]); pw.y = pk2(m[2], m[3]); pw.z = pk2(m[4], m[5]); pw.w = pk2(m[6], m[7]);
                        const bf16x8 pf = __builtin_bit_cast(bf16x8, pw);
                        const LAS unsigned char* xp = X.lds + sb + (4 * st + 2 * a2 + hf) * 1024 + ql * 16;
                        acc0 = __builtin_amdgcn_mfma_f32_32x32x16_bf16(*(const LAS bf16x8*)xp, pf, acc0, 0, 0, 0);
                        acc1 = __builtin_amdgcn_mfma_f32_32x32x16_bf16(*(const LAS bf16x8*)(xp + 512), pf, acc1, 0, 0, 0);
                        __builtin_amdgcn_sched_barrier(0);
                    }
                }
            }
            asm volatile("s_waitcnt vmcnt(0)" ::: "memory");
#pragma unroll
            for (int pt = 0; pt < 2; ++pt)
#pragma unroll
                for (int g4 = 0; g4 < 4; ++g4) {
                    const u32x2 z2 = *(const LAS u32x2*)(tac + (((4 * pt + g4) ^ (ql & 7)) * 16));
                    const float a0 = pt ? acc1[4 * g4] : acc0[4 * g4], a1 = pt ? acc1[4 * g4 + 1] : acc0[4 * g4 + 1], a2v = pt ? acc1[4 * g4 + 2] : acc0[4 * g4 + 2], a3 = pt ? acc1[4 * g4 + 3] : acc0[4 * g4 + 3];
                    const float v0 = a0 * silu_fast(bflo(z2.x)), v1 = a1 * silu_fast(bfhi(z2.x)), v2 = a2v * silu_fast(bflo(z2.y)), v3 = a3 * silu_fast(bfhi(z2.y));
                    ss += (v0 * v0 + v1 * v1) + (v2 * v2 + v3 * v3);
                    u32x2 o; o.x = pk2(v0, v1); o.y = pk2(v2, v3); *(LAS u32x2*)(tac + (((4 * pt + g4) ^ (ql & 7)) * 16)) = o;
                }
#pragma unroll
            for (int k = 0; k < 4; ++k) *(u32x4*)(yrow + h8 * 64 + 8 * k) = *(const LAS u32x4*)(trw + (((4 * (lane & 1) + k) ^ ((lane >> 1) & 7)) * 16));
        }
#undef S3_ISSUE
        ss += __shfl_xor(ss, 32);
        const float rs = rsqrtf(ss * (1.f / 512.f) + EPS);
        asm volatile("s_waitcnt vmcnt(0)" ::: "memory");
        {
            const int lf = fresh(lane);
            bf16_t* yb = (bf16_t*)(X.ws + WS_O) + (t0 + 32 * w) * SSM_INNER + g * 512 + 8 * lf;
            const f32x4 g0 = *(const f32x4*)(p.in[22] + g * 512 + 8 * lf), g1 = *(const f32x4*)(p.in[22] + g * 512 + 8 * lf + 4);
#pragma unroll 1
            for (int r0 = 0; r0 < 32; r0 += 8) {
                u32x4 q[8];
#pragma unroll
                for (int k = 0; k < 8; ++k) q[k] = *(const u32x4*)(yb + (size_t)(r0 + k) * SSM_INNER);
#pragma unroll
                for (int k = 0; k < 8; ++k) {
                    const float rk = __shfl(rs, r0 + k);
                    u32x4 o; o.x = pk2(bflo(q[k].x) * rk * g0.x, bfhi(q[k].x) * rk * g0.y); o.y = pk2(bflo(q[k].y) * rk * g0.z, bfhi(q[k].y) * rk * g0.w);
                    o.z = pk2(bflo(q[k].z) * rk * g1.x, bfhi(q[k].z) * rk * g1.y); o.w = pk2(bflo(q[k].w) * rk * g1.z, bfhi(q[k].w) * rk * g1.w);
                    *(u32x4*)(yb + (size_t)(r0 + k) * SSM_INNER) = o;
                }
            }
        }
        asm volatile("s_waitcnt lgkmcnt(0)\n\ts_barrier" ::: "memory");
    }
}

__device__ __forceinline__ void ph_moe_gu(const Params& p, const Ctx& X, int l) {
    moe_table(X, l);
    pg8::MoeOrder So{(const LAS int*)(X.lds + TAB_OFF), (const LAS int*)(X.lds + TAB_OFF) + 40, (const int*)(X.ws + WS_SLOT), 3, X.G, X.bid, true};
    pg8::Gemm g{(const bf16_t*)(X.ws + WS_U), (const bf16_t*)(X.ws + WS_WGU) + (size_t)l * NE * 2048 * 1024, 1024};
    pg8::EpiGu E{(bf16_t*)(X.ws + WS_ACT), p.in[27] + (size_t)l * NE * 2048};
    pg8::gemm_phase<pg8::EpiGu, pg8::MoeOrder>(X.lds, g, So, E, X.tid);
}
__device__ __forceinline__ void ph_moe_down(const Params& p, const Ctx& X, int l) {
    moe_table(X, l);
    pg8::MoeOrder So{(const LAS int*)(X.lds + TAB_OFF), (const LAS int*)(X.lds + TAB_OFF) + 40, (const int*)(X.ws + WS_SLOT), 2, X.G, X.bid, false};
    pg8::Gemm g{(const bf16_t*)(X.ws + WS_ACT), (const bf16_t*)(X.ws + WS_WDN) + (size_t)l * NE * 1024 * 1024, 1024};
    pg8::EpiDown E{(bf16_t*)(X.ws + WS_Y), p.in[29] + (size_t)l * NE * 1024};
    pg8::gemm_phase<pg8::EpiDown, pg8::MoeOrder>(X.lds, g, So, E, X.tid);
}

#ifndef PROBE_MASK
#define PROBE_MASK 0u
#endif
#ifndef PROBE_MULT
#define PROBE_MULT 8
#endif
__global__ void __launch_bounds__(NTHREADS, 2) fwd_kernel(Params p) {
    extern __shared__ __attribute__((aligned(16))) unsigned char lds_raw[];
    Ctx X;
    X.lds = (LAS unsigned char*)lds_raw; X.ws = p.ws;
    X.tid = threadIdx.x; X.lane = X.tid & 63; X.wave = __builtin_amdgcn_readfirstlane(X.tid >> 6);
    X.G = gridDim.x; X.bid = blockIdx.x; X.gw = X.bid * NWAVES + X.wave; X.ngw = X.G * NWAVES; X.sub = 0ull; X.subt = 0ull;
    if (X.tid < 4) ((LAS unsigned*)(X.lds + XB_OFF))[X.tid] = 0u;
    __syncthreads();
    XcdBarrier bar = xcd_barrier_post((unsigned*)(p.ws + WS_CTL) + CW_BAR, (volatile LAS unsigned*)(X.lds + XB_OFF));
#define PHASE_BEGIN Ctx Y = X; { GAS unsigned char* w_ = (GAS unsigned char*)p.ws; asm volatile("" : "+s"(w_)); Y.ws = (unsigned char*)w_; int t_ = threadIdx.x; asm volatile("" : "+v"(t_)); Y.tid = t_; Y.lane = t_ & 63; \
    Y.wave = __builtin_amdgcn_readfirstlane(t_ >> 6); Y.gw = Y.bid * NWAVES + Y.wave; }
#define WSF(off) ((float*)(Y.ws + (off)))
#define WSB(off) ((bf16_t*)(Y.ws + (off)))
#define PROBE_LDS(i) (((volatile LAS unsigned long long*)(X.lds + 150528))[2 * X.wave + (i)])
    if (PROBE_MASK || PROBE_SUB) { if (X.lane == 0) { PROBE_LDS(0) = __builtin_amdgcn_s_memrealtime(); PROBE_LDS(1) = 0ull; } }
#define PB(k) do { if (PROBE_MASK) { if (X.lane == 0) { const unsigned long long n_ = __builtin_amdgcn_s_memrealtime(); if ((PROBE_MASK >> (k)) & 1u) PROBE_LDS(1) += n_ - PROBE_LDS(0); PROBE_LDS(0) = n_; } } } while (0)
    { PHASE_BEGIN ph_prologue(p, Y); }                                    xcd_barrier(bar); PB(0);
    { PHASE_BEGIN ph_norm0(p, Y); }                                       xcd_barrier(bar); PB(1);
    {
        PHASE_BEGIN
        pg8::DenseOrder So; So.init(T, PROJ_LD, X.G, X.bid);
        pg8::Gemm g{WSB(WS_U), WSB(WS_WIN), 1024};
        pg8::EpiBf16 E{WSB(WS_BIG), PROJ_LD};
        pg8::gemm_phase<pg8::EpiBf16, pg8::DenseOrder>(X.lds, g, So, E, Y.tid);
    }
    {
        PHASE_BEGIN
        pg8::DenseOrder So; So.init(768, T, X.G, X.bid);
        pg8::Gemm g{WSB(WS_WV), WSB(WS_U), 1024};
        pg8::EpiBf16 E{WSB(WS_VT), T};
        pg8::gemm_phase<pg8::EpiBf16, pg8::DenseOrder>(X.lds, g, So, E, Y.tid);
    }
    xcd_barrier(bar); PB(2);
    { PHASE_BEGIN ph_attn_a(p, Y); }                                      xcd_barrier(bar); PB(3);
    { PHASE_BEGIN ph_nsa(p, Y); if (PROBE_SUB && X.lane == 0) PROBE_LDS(1) += Y.sub; }
    __syncthreads(); PB(19);
    { PHASE_BEGIN ph_sb(Y); if (PROBE_SUB && X.lane == 0) PROBE_LDS(1) += Y.sub; }                                             xcd_barrier(bar); PB(4);
    {
        PHASE_BEGIN
        pg8::DenseOrder So; So.init(T, D, X.G, X.bid);
        pg8::Gemm g{WSB(WS_O), WSB(WS_WOUT), 1024};
        pg8::EpiResid E{p.in[0], WSF(WS_H1), WSF(WS_MODF) + 2048};
        pg8::gemm_phase<pg8::EpiResid, pg8::DenseOrder>(X.lds, g, So, E, Y.tid);
    }
    xcd_barrier(bar); PB(5);
    { PHASE_BEGIN ph_token<0>(p, Y, 0, WSF(WS_H1), nullptr); if (PROBE_SUB && X.lane == 0) PROBE_LDS(1) += Y.sub; }                       xcd_barrier(bar); PB(6);
    { PHASE_BEGIN ph_moe_gu(p, Y, 0); }                                   xcd_barrier(bar); PB(7);
    { PHASE_BEGIN ph_moe_down(p, Y, 0); }                                 xcd_barrier(bar); PB(8);
    { PHASE_BEGIN ph_token<1>(p, Y, 0, WSF(WS_H1), WSF(WS_H2)); if (PROBE_SUB && X.lane == 0) PROBE_LDS(1) += Y.sub; }       xcd_barrier(bar); PB(9);
    {
        PHASE_BEGIN
        pg8::DenseOrder So; So.init(T, 3072, X.G, X.bid);
        pg8::Gemm g{WSB(WS_U), WSB(WS_WSIN), 1024};
        pg8::EpiBf16 E{WSB(WS_ZBC), 3072};
        pg8::gemm_phase<pg8::EpiBf16, pg8::DenseOrder>(X.lds, g, So, E, Y.tid);
    }
    {
        PHASE_BEGIN
        pg8::DenseOrder So; So.init(3072, T, X.G, X.bid);
        pg8::Gemm g{WSB(WS_WSIN) + (size_t)2048 * 1024, WSB(WS_U), 1024};
        pg8::EpiBf16 E{WSB(WS_XT), T};
        pg8::gemm_phase<pg8::EpiBf16, pg8::DenseOrder>(X.lds, g, So, E, Y.tid);
    }
    xcd_barrier(bar); PB(10);
    { PHASE_BEGIN ph_ssd1(p, Y); if (PROBE_SUB && X.lane == 0) PROBE_LDS(1) += Y.sub; }                                        xcd_barrier(bar); PB(11);
    { PHASE_BEGIN ph_ssd2(Y); }                                           xcd_barrier(bar); PB(12);
    { PHASE_BEGIN ph_ssd3(p, Y); if (PROBE_SUB && X.lane == 0) PROBE_LDS(1) += Y.sub; }                                        xcd_barrier(bar); PB(13);
    {
        PHASE_BEGIN
        pg8::DenseOrder So; So.init(T, D, X.G, X.bid);
        pg8::Gemm g{WSB(WS_O), WSB(WS_WSOUT), 2048};
        pg8::EpiResid E{WSF(WS_H2), WSF(WS_H1), WSF(WS_MODF) + 4 * 6144 + 2048};
        pg8::gemm_phase<pg8::EpiResid, pg8::DenseOrder>(X.lds, g, So, E, Y.tid);
    }
    xcd_barrier(bar); PB(14);
    { PHASE_BEGIN ph_token<0>(p, Y, 1, WSF(WS_H1), nullptr); if (PROBE_SUB && X.lane == 0) PROBE_LDS(1) += Y.sub; }                       xcd_barrier(bar); PB(15);
    { PHASE_BEGIN ph_moe_gu(p, Y, 1); }                                   xcd_barrier(bar); PB(16);
    { PHASE_BEGIN ph_moe_down(p, Y, 1); }                                 xcd_barrier(bar); PB(17);
    { PHASE_BEGIN ph_token<2>(p, Y, 1, WSF(WS_H1), p.out); if (PROBE_SUB && X.lane == 0) PROBE_LDS(1) += Y.sub; } PB(18);
    if (PROBE_MASK || PROBE_SUB) { asm volatile("s_waitcnt lgkmcnt(0)" ::: "memory"); const unsigned long long acc_ = PROBE_LDS(1); const unsigned long long t_end = __builtin_amdgcn_s_memrealtime() + (unsigned long long)PROBE_MULT * (unsigned long long)__builtin_amdgcn_readfirstlane((unsigned)acc_); while (__builtin_amdgcn_s_memrealtime() < t_end) __builtin_amdgcn_s_sleep(8); }
#undef PB
#undef PROBE_LDS
#undef PHASE_BEGIN
#undef WSF
#undef WSB
}
}

extern "C" void kernel_launch(void* const* d_in, const int* in_sizes, int n_in, void* d_out, int out_size, void* d_ws, size_t ws_size, hipStream_t stream) {
    static int grid = 0;
    if (grid == 0) {
        if (n_in != 30 || out_size != T * D || ws_size < WS_END) { fprintf(stderr, "kernel_launch: unexpected shapes / workspace (%d inputs, out %d, ws %zu < %zu)\n", n_in, out_size, ws_size, (size_t)WS_END); grid = -1; return; }
        int dev = 0, cus = 0, per_cu = 0;
        if (hipGetDevice(&dev) != hipSuccess || hipDeviceGetAttribute(&cus, hipDeviceAttributeMultiprocessorCount, dev) != hipSuccess) { grid = -1; return; }
        if (hipFuncSetAttribute((const void*)fwd_kernel, hipFuncAttributeMaxDynamicSharedMemorySize, LDS_BYTES) != hipSuccess) { fprintf(stderr, "kernel_launch: hipFuncSetAttribute failed\n"); grid = -1; return; }
        if (hipOccupancyMaxActiveBlocksPerMultiprocessor(&per_cu, (const void*)fwd_kernel, NTHREADS, LDS_BYTES) != hipSuccess || per_cu < 1) { fprintf(stderr, "kernel_launch: occupancy query reports %d\n", per_cu); }
        (void)hipGetLastError();
        grid = cus;
    }
    if (grid < 0) return;
    if (hipMemsetAsync((char*)d_ws + WS_CTL, 0, CTL_BYTES, stream) != hipSuccess) return;
    Params p{};
    for (int i = 0; i < 30; ++i) p.in[i] = (const float*)d_in[i];
    p.out = (float*)d_out; p.ws = (unsigned char*)d_ws;
    hipLaunchKernelGGL(fwd_kernel, dim3(grid), dim3(NTHREADS), LDS_BYTES, stream, p);
}
```

```cpp
#include <hip/hip_runtime.h>
#include <cstdio>
#include <cstdint>

#define LAS __attribute__((address_space(3)))
#define GAS __attribute__((address_space(1)))
typedef unsigned short bf16_t;
typedef short bf16x8 __attribute__((ext_vector_type(8)));
typedef float f32x4 __attribute__((ext_vector_type(4)));
typedef unsigned u32x4 __attribute__((ext_vector_type(4)));
typedef unsigned u32x2 __attribute__((ext_vector_type(2)));
typedef float f32x16 __attribute__((ext_vector_type(16)));

namespace {
constexpr int D = 1024, NB = 4, S = 4096, T = NB * S;
constexpr int ATTN_IN = 2840, PROJ_LD = 3072;
constexpr int OFF_SBQ = 0, OFF_SBK = 512, OFF_SBV = 1024, OFF_NQ = 1536, OFF_KC = 2048, OFF_VC = 2176, OFF_KS = 2304, OFF_VS = 2432,
              OFF_KW = 2560, OFF_VW = 2688, OFF_GATE = 2816;
constexpr int NCMP = 255;
constexpr int SSM_IN = 5152, SSM_INNER = 2048, CONV_DIM = 3072, ZX_LD = 5120;
constexpr int NE = 32, CAP = 16384, MAXTILES = 288;
constexpr float EPS = 1e-6f;
constexpr int NWAVES = 8, NTHREADS = 512;

constexpr size_t al4k(size_t x) { return (x + 4095) & ~(size_t)4095; }
constexpr size_t WS_CTL = 0, CTL_BYTES = 1u << 20;
constexpr int CW_CNT = 256;
constexpr int CW_BAR = 4096;
constexpr size_t CTL_MOD = 65536;
constexpr size_t WS_WIN = CTL_BYTES;
constexpr size_t WS_WOUT = WS_WIN + (size_t)3072 * 1024 * 2;
constexpr size_t WS_WSIN = WS_WOUT + (size_t)1024 * 1024 * 2;
constexpr size_t WS_WSOUT = WS_WSIN + (size_t)5120 * 1024 * 2;
constexpr size_t WS_WGU = WS_WSOUT + (size_t)1024 * 2048 * 2;
constexpr size_t WS_WDN = WS_WGU + (size_t)2 * 32 * 2048 * 1024 * 2;
constexpr size_t WS_U = WS_WDN + (size_t)2 * 32 * 1024 * 1024 * 2;
constexpr size_t WS_BIG = WS_U + (size_t)T * 1024 * 2;
constexpr size_t WS_O = WS_BIG + (size_t)T * 5120 * 2;
constexpr size_t WS_H1 = WS_O + (size_t)T * 2048 * 2;
constexpr size_t WS_H2 = WS_H1 + (size_t)T * 1024 * 4;
constexpr size_t WS_QN = WS_H2 + (size_t)T * 1024 * 4;
constexpr size_t WS_KN = WS_QN + (size_t)T * 512 * 4;
constexpr size_t WS_KCMP = WS_KN + (size_t)T * 256 * 4;
constexpr size_t WS_VCMP = WS_KCMP + al4k((size_t)NB * NCMP * 2 * 64 * 4);
constexpr size_t WS_ACT = WS_VCMP + al4k((size_t)NB * NCMP * 2 * 64 * 4);
constexpr size_t WS_Y = WS_ACT + (size_t)MAXTILES * 256 * 1024 * 2;
constexpr size_t WS_TOKE = WS_Y + (size_t)MAXTILES * 256 * 1024 * 2;
constexpr size_t WS_TOKW = WS_TOKE + (size_t)T * 16;
constexpr size_t WS_TOKP = WS_TOKW + (size_t)T * 16;
constexpr size_t WS_SLOT = WS_TOKP + (size_t)T * 16;
constexpr size_t WS_XC = WS_SLOT + (size_t)NE * CAP * 4;
constexpr size_t WS_YS = WS_XC + (size_t)T * 3072 * 4;
constexpr size_t WS_DT = WS_YS + (size_t)T * 2048 * 4;
constexpr size_t WS_MODF = WS_DT + (size_t)T * 32 * 4;
constexpr size_t WS_WV = WS_MODF + (size_t)2 * 4 * 6144 * 4;
constexpr size_t WS_VT = WS_WV + (size_t)768 * 1024 * 2;
constexpr size_t WS_QNB = WS_VT + (size_t)768 * T * 2;
constexpr size_t WS_KSN = WS_QNB + (size_t)T * 512 * 2;
constexpr size_t WS_KWN = WS_KSN + (size_t)T * 128 * 2;
constexpr size_t WS_KCB = WS_KWN + (size_t)T * 128 * 2;
constexpr size_t WS_VCT = WS_KCB + (size_t)8 * 256 * 64 * 2;
constexpr size_t WS_DT2 = WS_VCT + (size_t)8 * 64 * 256 * 2;
constexpr size_t WS_CS = WS_DT2 + (size_t)NB * 32 * S * 4;
constexpr size_t WS_DEC = WS_CS + (size_t)NB * 32 * S * 4;
constexpr size_t WS_W1T = WS_DEC + al4k((size_t)NB * 16 * 32 * 4);
constexpr size_t WS_SKW = WS_W1T + (size_t)2 * 128 * 2048 * 2;
constexpr size_t WS_ULO = WS_SKW + (size_t)3 * 2 * 32 * 1024 * 2;
constexpr size_t WS_END = WS_ULO + (size_t)T * 1024 * 2;
constexpr size_t WS_ZBC = WS_BIG, WS_XT = WS_XC, WS_XCT = WS_XC + (size_t)3072 * T * 2, WS_ST = WS_YS, WS_PB = WS_YS + (size_t)NB * 16 * 32 * 8192 * 4, WS_BCM = WS_QN;
static_assert(WS_XCT + (size_t)2560 * T * 2 <= WS_YS && WS_PB + (size_t)NB * 16 * 32 * 8192 * 2 <= WS_DT && (size_t)T * 1024 * 2 <= (size_t)T * 512 * 4, "layer-1 overlays");

constexpr int RING_BYTES = 131072;
constexpr int EXTRA_OFF = RING_BYTES;
constexpr int TAB_OFF = 151552;
constexpr int XB_OFF = 152576;
constexpr int LDS_BYTES = 153600;

struct Params { const float* in[30]; float* out; unsigned char* ws; };

__device__ __forceinline__ float siluf(float v) { return v / (1.f + expf(-v)); }
__device__ __forceinline__ float logsig(float x) { return fminf(x, 0.f) - log1pf(expf(-fabsf(x))); }
__device__ __forceinline__ float wave_sum(float v) {
#pragma unroll
    for (int o = 32; o > 0; o >>= 1) v += __shfl_xor(v, o);
    return v;
}
__device__ __forceinline__ float wave_max(float v) {
#pragma unroll
    for (int o = 32; o > 0; o >>= 1) v = fmaxf(v, __shfl_xor(v, o));
    return v;
}
__device__ __forceinline__ unsigned f2bf(float f) { unsigned u = __builtin_bit_cast(unsigned, f); return (u + 0x7fffu + ((u >> 16) & 1u)) >> 16; }
typedef float f32x2_t __attribute__((ext_vector_type(2))); typedef __bf16 bf16x2_t __attribute__((ext_vector_type(2)));
__device__ __forceinline__ unsigned pk2(float lo, float hi) { f32x2_t v = {lo, hi}; bf16x2_t b = __builtin_convertvector(v, bf16x2_t); return __builtin_bit_cast(unsigned, b); }
__device__ __forceinline__ float bf2f(bf16_t v) { return __uint_as_float((unsigned)v << 16); }
__device__ __forceinline__ float bflo(unsigned w) { return __uint_as_float(w << 16); }
__device__ __forceinline__ float bfhi(unsigned w) { return __uint_as_float(w & 0xffff0000u); }
#define LDS_WAIT() asm volatile("s_waitcnt lgkmcnt(0)" ::: "memory")
__device__ __forceinline__ int fresh(int v) { asm volatile("" : "+v"(v)); return v; }
__device__ __forceinline__ int sfresh(int v) { asm volatile("" : "+s"(v)); return v; }

#define XB_TMO      128
#define XB_XCNT(j)  (256  + 64 * (j))
#define XB_XSUB(j)  (1280 + 64 * (j))
#define XB_XGEN(j)  (2304 + 64 * (j))
#define XB_TOP      3328
#define XB_TOPGEN   3392
#define XCD_BAR_WORDS 3456
#define XB_SPIN_CAP (1u << 18)
__device__ __forceinline__ unsigned xb_ld(unsigned* p)              { return __hip_atomic_load(p, __ATOMIC_RELAXED, __HIP_MEMORY_SCOPE_AGENT); }
__device__ __forceinline__ unsigned xb_add(unsigned* p, unsigned v) { return __hip_atomic_fetch_add(p, v, __ATOMIC_RELAXED, __HIP_MEMORY_SCOPE_AGENT); }
__device__ __forceinline__ unsigned xb_xcc_id() { return (unsigned)__builtin_amdgcn_s_getreg((3 << 11) | 20) & 0xFu; }
#define XB_SPIN(cond, bar) do { unsigned _sp = 0; while (cond) { __builtin_amdgcn_s_sleep(1); \
    if ((++_sp & 255u) == 0u) { if (xb_ld(&(bar)[XB_TMO])) break; if (_sp > XB_SPIN_CAP) { atomicAdd(&(bar)[XB_TMO], 1u); break; } } } } while (0)
struct XcdBarrier { unsigned* bar; unsigned x; volatile LAS unsigned* st; };
__device__ __forceinline__ XcdBarrier xcd_barrier_post(unsigned* bar, volatile LAS unsigned* st) {
    XcdBarrier b; b.bar = bar; b.x = xb_xcc_id(); b.st = st;
    if (threadIdx.x == 0) (void)xb_add(&bar[XB_XCNT(b.x)], 1u);
    return b;
}
__device__ __forceinline__ void xcd_barrier_complete(unsigned* bar, unsigned x, unsigned& nloc, unsigned& nx) {
    const unsigned G = gridDim.x * gridDim.y * gridDim.z;
    unsigned sum, cnt, mine, sp = 0u;
    for (;;) {
        sum = 0u; cnt = 0u; mine = 0u;
#pragma unroll
        for (unsigned j = 0; j < 16; ++j) { const unsigned c = xb_ld(&bar[XB_XCNT(j)]); sum += c; cnt += (c > 0u) ? 1u : 0u; mine = (j == x) ? c : mine; }
        if (sum == G) break;
        __builtin_amdgcn_s_sleep(1);
        if ((++sp & 255u) == 0u) { if (xb_ld(&bar[XB_TMO])) break; if (sp > XB_SPIN_CAP) { atomicAdd(&bar[XB_TMO], 1u); break; } }
    }
    nloc = mine > 0u ? mine : 1u; nx = cnt > 0u ? cnt : 1u;
}
__device__ __forceinline__ void xcd_barrier(const XcdBarrier& b) {
    asm volatile("s_waitcnt vmcnt(0)" ::: "memory");
    __syncthreads();
    if (threadIdx.x == 0) {
        unsigned* bar = b.bar;
        __builtin_amdgcn_s_waitcnt(0);
        unsigned nloc = b.st[0], nx = b.st[1];
        if (nloc == 0u) { xcd_barrier_complete(bar, b.x, nloc, nx); b.st[0] = nloc; b.st[1] = nx; }
        const unsigned old = xb_add(&bar[XB_XSUB(b.x)], 1u);
        const unsigned gen = old / nloc;
        if (old + 1u == (gen + 1u) * nloc) {
            __builtin_amdgcn_fence(__ATOMIC_RELEASE, "agent");
            asm volatile("s_waitcnt vmcnt(0)" ::: "memory");
            const unsigned og = xb_add(&bar[XB_TOP], 1u);
            const unsigned tg = og / nx;
            if (og + 1u == (tg + 1u) * nx) xb_add(&bar[XB_TOPGEN], 1u);
            else XB_SPIN(xb_ld(&bar[XB_TOPGEN]) == tg, bar);
            __builtin_amdgcn_fence(__ATOMIC_ACQUIRE, "agent");
            xb_add(&bar[XB_XGEN(b.x)], 1u);
            asm volatile("s_waitcnt vmcnt(0)" ::: "memory");
        } else {
            XB_SPIN(xb_ld(&bar[XB_XGEN(b.x)]) == gen, bar);
            __builtin_amdgcn_fence(__ATOMIC_ACQUIRE, "agent");
            asm volatile("s_waitcnt vmcnt(0)" ::: "memory");
        }
    }
    __syncthreads();
}

namespace pg8 {
constexpr int BM = 256, BK = 64, HALF = 128, HTB = HALF * BK * 2, STAGE_BYTES = 8 * HTB;
__device__ __forceinline__ int lds_byte(int r, int c) { const int st = (r >> 4) * 2 + (c >> 5), rr = r & 15, cc = c & 31, ob = rr * 64 + cc * 2; return st * 1024 + (ob ^ (((ob >> 9) & 1) << 5)); }
__device__ __forceinline__ void stage_rc(int b, int& R, int& C) { const int st = b / 1024, sb = b % 1024, swz = sb ^ (((sb >> 9) & 1) << 5); R = (st >> 1) * 16 + swz / 64; C = (st & 1) * 32 + (swz % 64) / 2; }
__device__ __forceinline__ int perm32(int rho) { const int n = rho >> 4, i = rho & 15; return 8 * (i >> 2) + 4 * n + (i & 3); }
struct Unit { int pm, pn, e; };
struct Gemm { const bf16_t* A; const bf16_t* Bt; int K; };
__device__ __forceinline__ unsigned cvt_pk_bf16(float lo, float hi) { unsigned r; asm volatile("v_cvt_pk_bf16_f32 %0, %1, %2" : "=v"(r) : "v"(lo), "v"(hi)); return r; }

struct DenseOrder {
    int nM, nN, nwg, G, c;
    __device__ void init(int M, int N, int G_, int c_) { nM = M / BM; nN = N / BM; nwg = nM * nN; G = G_; c = c_; }
    __device__ bool next(int i, Unit& u) const {
        const long L = (long)i * G + c; if (L >= nwg) return false;
        int wgid = (int)L; { const int q = nwg / 8, r = nwg % 8, xcd = wgid % 8, off = wgid / 8; wgid = (xcd < r ? xcd * (q + 1) : r * (q + 1) + (xcd - r) * q) + off; }
        const int nig = 8 * nN, gid = wgid / nig, fm = gid * 8, gsz = (nM - fm) < 8 ? (nM - fm) : 8;
        u.pm = fm + ((wgid % nig) % gsz); u.pn = (wgid % nig) / gsz; u.e = 0; return true;
    }
    __device__ __forceinline__ unsigned arow(const Unit& u, int r) const { return (unsigned)(u.pm * BM + r); }
};
struct MoeOrder {
    const LAS int* tb; const LAS int* cn; const int* slot_tok; int shift, G, c; bool gather;
    __device__ bool next(int i, Unit& u) const {
        const int L = i * G + c, tile = L >> shift; if (tile >= tb[NE]) return false;
        int e = 0; while (tb[e + 1] <= tile) ++e;
        u.pm = tile; u.pn = (e << shift) + (L & ((1 << shift) - 1)); u.e = e; return true;
    }
    __device__ __forceinline__ unsigned arow(const Unit& u, int r) const {
        if (!gather) return (unsigned)(u.pm * BM + r);
        const int pos = (u.pm - tb[u.e]) * BM + r;
        return pos < cn[u.e] ? (unsigned)slot_tok[u.e * CAP + pos] : 0u;
    }
};

struct EpiBf16 {
    static constexpr bool PERM = true;
    bf16_t* O; int ldc;
    __device__ __forceinline__ void operator()(const f32x4 (&acc)[2][2][4][2], const Unit& u, int wr, int wc, int fr, int fq) const {
        const int row0 = u.pm * BM + wr * 64 + fr, col0 = u.pn * BM + wc * 32 + 8 * fq;
#pragma unroll
        for (int ai = 0; ai < 2; ++ai)
#pragma unroll
            for (int m = 0; m < 4; ++m) { bf16_t* rowp = O + (size_t)(row0 + ai * HALF + m * 16) * ldc + col0;
#pragma unroll
                for (int bj = 0; bj < 2; ++bj) { const f32x4 v0 = acc[ai][bj][m][0], v1 = acc[ai][bj][m][1];
                    u32x4 w; w.x = cvt_pk_bf16(v0[0], v0[1]); w.y = cvt_pk_bf16(v0[2], v0[3]); w.z = cvt_pk_bf16(v1[0], v1[1]); w.w = cvt_pk_bf16(v1[2], v1[3]);
                    *(u32x4*)(rowp + bj * HALF) = w; } }
    }
};
template <bool BASE_BF16>
struct EpiResid {
    static constexpr bool PERM = true;
    const void* base; bf16_t* out; const float* g;
    __device__ __forceinline__ void operator()(const f32x4 (&acc)[2][2][4][2], const Unit& u, int wr, int wc, int fr, int fq) const {
        const int row0 = u.pm * BM + wr * 64 + fr, col0 = u.pn * BM + wc * 32 + 8 * fq;
        const float* gb = g + (size_t)((u.pm * BM) / S) * 6144 + col0;
        f32x4 gv[2][2];
#pragma unroll
        for (int bj = 0; bj < 2; ++bj)
#pragma unroll
            for (int n = 0; n < 2; ++n) gv[bj][n] = *(const f32x4*)(gb + bj * HALF + n * 4);
#pragma unroll
        for (int ai = 0; ai < 2; ++ai)
#pragma unroll
            for (int m = 0; m < 4; ++m) { const size_t off = (size_t)(row0 + ai * HALF + m * 16) * D + col0;
#pragma unroll
                for (int bj = 0; bj < 2; ++bj) {
                    f32x4 b0, b1;
                    if (BASE_BF16) { const u32x4 q = *(const u32x4*)((const bf16_t*)base + off + bj * HALF); b0 = (f32x4){bflo(q.x), bfhi(q.x), bflo(q.y), bfhi(q.y)}; b1 = (f32x4){bflo(q.z), bfhi(q.z), bflo(q.w), bfhi(q.w)}; }
                    else { b0 = *(const f32x4*)((const float*)base + off + bj * HALF); b1 = *(const f32x4*)((const float*)base + off + bj * HALF + 4); }
                    const f32x4 v0 = b0 + gv[bj][0] * acc[ai][bj][m][0], v1 = b1 + gv[bj][1] * acc[ai][bj][m][1];
                    u32x4 w; w.x = cvt_pk_bf16(v0[0], v0[1]); w.y = cvt_pk_bf16(v0[2], v0[3]); w.z = cvt_pk_bf16(v1[0], v1[1]); w.w = cvt_pk_bf16(v1[2], v1[3]);
                    *(u32x4*)(out + off + bj * HALF) = w; } }
    }
};
struct EpiGu {
    static constexpr bool PERM = true;
    bf16_t* act; const float* bgu;
    __device__ __forceinline__ void operator()(const f32x4 (&acc)[2][2][4][2], const Unit& u, int wr, int wc, int fr, int fq) const {
        const int row0 = u.pm * BM + wr * 64 + fr, col0 = (u.pn & 7) * HALF + wc * 32 + 8 * fq;
        const float* bb = bgu + (size_t)u.e * 2048 + col0;
        const f32x4 bg0 = *(const f32x4*)(bb), bg1 = *(const f32x4*)(bb + 4), bu0 = *(const f32x4*)(bb + 1024), bu1 = *(const f32x4*)(bb + 1028);
#pragma unroll
        for (int ai = 0; ai < 2; ++ai)
#pragma unroll
            for (int m = 0; m < 4; ++m) {
                float r[8];
#pragma unroll
                for (int n = 0; n < 2; ++n) { const f32x4 gt = acc[ai][0][m][n] + (n ? bg1 : bg0), up = acc[ai][1][m][n] + (n ? bu1 : bu0);
#pragma unroll
                    for (int j = 0; j < 4; ++j) { const float gg = fminf(gt[j], 7.f), uu = fminf(fmaxf(up[j], -7.f), 7.f);
                        r[n * 4 + j] = (uu + 1.f) * gg * __builtin_amdgcn_rcpf(1.f + __expf(-1.702f * gg)); } }
                u32x4 w; w.x = cvt_pk_bf16(r[0], r[1]); w.y = cvt_pk_bf16(r[2], r[3]); w.z = cvt_pk_bf16(r[4], r[5]); w.w = cvt_pk_bf16(r[6], r[7]);
                *(u32x4*)(act + (size_t)(row0 + ai * HALF + m * 16) * D + col0) = w; }
    }
};
struct EpiDown {
    static constexpr bool PERM = true;
    bf16_t* y; const float* bd;
    __device__ __forceinline__ void operator()(const f32x4 (&acc)[2][2][4][2], const Unit& u, int wr, int wc, int fr, int fq) const {
        const int row0 = u.pm * BM + wr * 64 + fr, col0 = (u.pn & 3) * BM + wc * 32 + 8 * fq;
        const float* bb = bd + (size_t)u.e * 1024 + col0;
        f32x4 bv[2][2];
#pragma unroll
        for (int bj = 0; bj < 2; ++bj)
#pragma unroll
            for (int n = 0; n < 2; ++n) bv[bj][n] = *(const f32x4*)(bb + bj * HALF + 4 * n);
#pragma unroll
        for (int ai = 0; ai < 2; ++ai)
#pragma unroll
            for (int m = 0; m < 4; ++m) { bf16_t* rowp = y + (size_t)(row0 + ai * HALF + m * 16) * D + col0;
#pragma unroll
                for (int bj = 0; bj < 2; ++bj) { const f32x4 v0 = acc[ai][bj][m][0] + bv[bj][0], v1 = acc[ai][bj][m][1] + bv[bj][1];
                    u32x4 w; w.x = cvt_pk_bf16(v0[0], v0[1]); w.y = cvt_pk_bf16(v0[2], v0[3]); w.z = cvt_pk_bf16(v1[0], v1[1]); w.w = cvt_pk_bf16(v1[2], v1[3]);
                    *(u32x4*)(rowp + bj * HALF) = w; } }
    }
};

template <class Epi, class Sched>
__device__ __forceinline__ void gemm_phase(LAS unsigned char* lds, const Gemm g, const Sched& S, const Epi& E, const int tid) {
    const int wid = __builtin_amdgcn_readfirstlane(tid >> 6), lane = tid & 63, wr = wid >> 2, wc = wid & 3, fr = lane & 15, fq = lane >> 4;
    const int K = g.K, nt = K / BK;
    int RA[2], CA[2]; unsigned voffB[2];
#pragma unroll
    for (int i = 0; i < 2; ++i) { int R, C; stage_rc(tid * 16 + i * 8192, R, C); const int Rb = Epi::PERM ? ((R & ~31) + perm32(R & 31)) : R;
        RA[i] = R; CA[i] = C; voffB[i] = (unsigned)(Rb * K + C) * 2u; }
    const size_t kstep = (size_t)(BK * 2);
    const size_t hstep = (size_t)HALF * K * 2;
    const size_t tstep = 2 * hstep;
    const unsigned ldsw = (unsigned)wid * 1024u;
    const int aoff = lds_byte(wr * 64 + fr, fq * 8), boff = lds_byte(wc * 32 + fr, fq * 8);
#define PG8_SA(b, h) (((b) * 2 + (h)) * HTB)
#define PG8_SB(b, h) ((4 + (b) * 2 + (h)) * HTB)
#define PG8_STAGE(bufoff, gbase, voff) do { _Pragma("unroll") for (int _i = 0; _i < 2; ++_i) \
        __builtin_amdgcn_global_load_lds((const unsigned*)((const char*)(gbase) + (voff)[_i]), (LAS unsigned*)(lds + (bufoff) + ldsw + _i * 8192), 16, 0, 0); } while (0)
#define PG8_LDA(dst, b, h) do { _Pragma("unroll") for (int m = 0; m < 4; ++m) _Pragma("unroll") for (int k = 0; k < 2; ++k) dst[m][k] = *(const LAS bf16x8*)(lds + PG8_SA(b, h) + aoff + m * 2048 + k * 1024); } while (0)
#define PG8_LDB(dst, b, h) do { _Pragma("unroll") for (int n = 0; n < 2; ++n) _Pragma("unroll") for (int k = 0; k < 2; ++k) dst[n][k] = *(const LAS bf16x8*)(lds + PG8_SB(b, h) + boff + n * 2048 + k * 1024); } while (0)
#define PG8_MMA(ai, bj, At, Bt) do { __builtin_amdgcn_s_setprio(1); _Pragma("unroll") for (int m = 0; m < 4; ++m) _Pragma("unroll") for (int n = 0; n < 2; ++n) _Pragma("unroll") for (int k = 0; k < 2; ++k) \
        acc[ai][bj][m][n] = __builtin_amdgcn_mfma_f32_16x16x32_bf16(Bt[n][k], At[m][k], acc[ai][bj][m][n], 0, 0, 0); __builtin_amdgcn_s_setprio(0); } while (0)
#define PG8_WAIT_V(n) asm volatile("s_waitcnt vmcnt(" #n ")" ::: "memory")
#define PG8_WAIT_L(n) asm volatile("s_waitcnt lgkmcnt(" #n ")" ::: "memory")
#define PG8_BAR __builtin_amdgcn_s_barrier()
#define PG8_SCHED __builtin_amdgcn_sched_barrier(0)
#define PG8_AOFF(dst, u) do { _Pragma("unroll") for (int _h = 0; _h < 2; ++_h) _Pragma("unroll") for (int _i = 0; _i < 2; ++_i) dst[_h][_i] = (S.arow(u, _h * HALF + RA[_i]) * (unsigned)K + (unsigned)CA[_i]) * 2u; } while (0)
    Unit cur, nxt; int ui = 0;
    if (!S.next(0, cur)) return;
    f32x4 acc[2][2][4][2];
#pragma unroll
    for (int a = 0; a < 2; ++a)
#pragma unroll
        for (int b = 0; b < 2; ++b)
#pragma unroll
            for (int m = 0; m < 4; ++m)
#pragma unroll
                for (int n = 0; n < 2; ++n) acc[a][b][m][n] = (f32x4){0.f, 0.f, 0.f, 0.f};
    bf16x8 At[4][2], B0[2][2], B1[2][2];
    unsigned va[2][2], vn[2][2];
    PG8_AOFF(va, cur);
    const char* Ab = (const char*)g.A;
    const char* cB = (const char*)g.Bt + (size_t)cur.pn * tstep;
    PG8_STAGE(PG8_SB(0, 0), cB, voffB); PG8_STAGE(PG8_SB(0, 1), cB + hstep, voffB); PG8_STAGE(PG8_SA(0, 0), Ab, va[0]); PG8_STAGE(PG8_SA(0, 1), Ab, va[1]);
    if (wr == 1) PG8_BAR;
    PG8_WAIT_V(2); PG8_BAR;
    PG8_STAGE(PG8_SB(1, 0), cB + kstep, voffB); PG8_STAGE(PG8_SA(1, 0), Ab + kstep, va[0]); PG8_STAGE(PG8_SB(1, 1), cB + hstep + kstep, voffB);
    PG8_WAIT_V(6); PG8_BAR;
    for (;;) {
        const bool has_next = S.next(ui + 1, nxt);
        if (has_next) { PG8_AOFF(vn, nxt); }
        else {
#pragma unroll
            for (int h = 0; h < 2; ++h)
#pragma unroll
                for (int i = 0; i < 2; ++i) vn[h][i] = va[h][i]; }
        const char* nB = has_next ? (const char*)g.Bt + (size_t)nxt.pn * tstep : cB;
        for (int t = 0; t < nt; t += 2) {
            const bool last = (t == nt - 2);
            const char* a1 = Ab + (size_t)(t + 1) * kstep;
            const char* a2 = last ? Ab : Ab + (size_t)(t + 2) * kstep; const char* b2 = last ? nB : cB + (size_t)(t + 2) * kstep;
            const char* a3 = a2 + kstep; const char* b3 = b2 + kstep;
            unsigned o2[2][2];
#pragma unroll
            for (int h = 0; h < 2; ++h)
#pragma unroll
                for (int i = 0; i < 2; ++i) o2[h][i] = last ? vn[h][i] : va[h][i];
            PG8_LDB(B0, 0, 0); PG8_LDB(B1, 0, 1); PG8_SCHED; PG8_LDA(At, 0, 0); PG8_STAGE(PG8_SA(1, 1), a1, va[1]);
            PG8_WAIT_V(8); PG8_WAIT_L(0); PG8_BAR; PG8_MMA(0, 0, At, B0); PG8_MMA(0, 1, At, B1); PG8_BAR; PG8_SCHED;
            PG8_LDA(At, 0, 1); PG8_STAGE(PG8_SB(0, 0), b2, voffB); PG8_STAGE(PG8_SB(0, 1), b2 + hstep, voffB); PG8_STAGE(PG8_SA(0, 0), a2, o2[0]);
            PG8_WAIT_V(8); PG8_WAIT_L(0); PG8_BAR; PG8_MMA(1, 0, At, B0); PG8_MMA(1, 1, At, B1); PG8_BAR; PG8_SCHED;
            PG8_LDB(B0, 1, 0); PG8_LDB(B1, 1, 1); PG8_SCHED; PG8_LDA(At, 1, 0); PG8_STAGE(PG8_SA(0, 1), a2, o2[1]);
            PG8_WAIT_V(8); PG8_WAIT_L(0); PG8_BAR; PG8_MMA(0, 0, At, B0); PG8_MMA(0, 1, At, B1); PG8_BAR; PG8_SCHED;
            PG8_LDA(At, 1, 1); PG8_STAGE(PG8_SB(1, 0), b3, voffB); PG8_STAGE(PG8_SB(1, 1), b3 + hstep, voffB); PG8_STAGE(PG8_SA(1, 0), a3, o2[0]);
            PG8_WAIT_V(8); PG8_WAIT_L(0); PG8_BAR; PG8_MMA(1, 0, At, B0); PG8_MMA(1, 1, At, B1); PG8_BAR; PG8_SCHED;
        }
        if (wr == 0) PG8_BAR;
        E(acc, cur, wr, wc, fr, fq);
        if (!has_next) break;
#pragma unroll
        for (int a = 0; a < 2; ++a)
#pragma unroll
            for (int b = 0; b < 2; ++b)
#pragma unroll
                for (int m = 0; m < 4; ++m)
#pragma unroll
                    for (int n = 0; n < 2; ++n) acc[a][b][m][n] = (f32x4){0.f, 0.f, 0.f, 0.f};
        cur = nxt; cB = nB; ++ui;
#pragma unroll
        for (int h = 0; h < 2; ++h)
#pragma unroll
            for (int i = 0; i < 2; ++i) va[h][i] = vn[h][i];
        if (wr == 1) PG8_BAR;
    }
    PG8_WAIT_V(0);
    PG8_BAR;
#undef PG8_SA
#undef PG8_SB
#undef PG8_STAGE
#undef PG8_LDA
#undef PG8_LDB
#undef PG8_MMA
#undef PG8_WAIT_V
#undef PG8_WAIT_L
#undef PG8_BAR
#undef PG8_SCHED
#undef PG8_AOFF
}
}

#ifndef PROBE_SUB
#define PROBE_SUB 0
#endif
struct Ctx {
    LAS unsigned char* lds; unsigned char* ws;
    int tid, lane, wave, gw, ngw, G, bid;
    mutable unsigned long long sub, subt;
};
#define SUB_BEGIN(X, id) do { if (PROBE_SUB == (id)) (X).subt = __builtin_amdgcn_s_memrealtime(); } while (0)
#define SUB_END(X, id) do { if (PROBE_SUB == (id)) (X).sub += __builtin_amdgcn_s_memrealtime() - (X).subt; } while (0)

__device__ __forceinline__ void transpose_item(const float* W, int ldw, int K, int nvalid, int k0, int n0, bf16_t* WT, int row0, LAS float* scr, int lane) {
    const int c4 = (lane & 7) * 4, kr = lane >> 3;
    f32x4 v[8];
#pragma unroll
    for (int i = 0; i < 8; ++i) v[i] = (n0 + c4 < nvalid) ? *(const f32x4*)(W + (size_t)(k0 + kr + 8 * i) * ldw + n0 + c4) : (f32x4){0.f, 0.f, 0.f, 0.f};
#pragma unroll
    for (int i = 0; i < 8; ++i) { LAS float* d = scr + (kr + 8 * i) * 33 + c4; d[0] = v[i].x; d[1] = v[i].y; d[2] = v[i].z; d[3] = v[i].w; }
    LDS_WAIT(); asm volatile("" ::: "memory");
    const int c = lane & 7;
#pragma unroll
    for (int j = 0; j < 4; ++j) { const int n = (lane >> 3) + 8 * j; const LAS float* s = scr + (8 * c) * 33 + n;
        u32x4 o; o.x = pk2(s[0 * 33], s[1 * 33]); o.y = pk2(s[2 * 33], s[3 * 33]); o.z = pk2(s[4 * 33], s[5 * 33]); o.w = pk2(s[6 * 33], s[7 * 33]);
        *(u32x4*)(WT + (size_t)(row0 + n) * K + k0 + 8 * c) = o; }
    LDS_WAIT(); asm volatile("" ::: "memory");
}
__device__ __forceinline__ void ph_prologue(const Params& p, const Ctx& X) {
    LAS float* scr = (LAS float*)(X.lds + X.wave * 16384);
    unsigned char* ws = X.ws;
    constexpr int I_MOD = 2 * 96 * 8;
    constexpr int I_SK = 3 * 16, I_W1 = 2 * 32 * 4, I_WIN = 16 * 96, I_WV = 16 * 24, I_WOUT = 16 * 32, I_WSIN = 16 * 160, I_WSOUT = 32 * 32, I_GU = 64 * 1024, I_DN = 64 * 512;
    constexpr int NITEMS = I_MOD + I_SK + I_W1 + I_WIN + I_WV + I_WOUT + I_WSIN + I_WSOUT + I_GU + I_DN;
    for (int it = X.gw; it < NITEMS; it += X.ngw) {
        int r = it;
        if (r < I_MOD) {
            const int kp = r & 7, jb = (r >> 3) % 96, l = r / (8 * 96), j = jb * 64 + X.lane;
            const float* w = p.in[2] + (size_t)l * 1024 * 6144 + (size_t)(kp * 128) * 6144 + j;
            const float* c = p.in[1] + kp * 128;
            float a0 = 0.f, a1 = 0.f, a2 = 0.f, a3 = 0.f;
#pragma unroll 8
            for (int i = 0; i < 128; ++i) { const float wv = w[(size_t)i * 6144];
                a0 += siluf(c[i]) * wv; a1 += siluf(c[1024 + i]) * wv; a2 += siluf(c[2048 + i]) * wv; a3 += siluf(c[3072 + i]) * wv; }
            if (kp == 0) { const float bb = p.in[3][l * 6144 + j]; a0 += bb; a1 += bb; a2 += bb; a3 += bb; }
            unsigned long long* mq = (unsigned long long*)(ws + CTL_MOD) + (size_t)l * 4 * 6144 + j;
            atomicAdd(mq, (unsigned long long)__double2ll_rn((double)a0 * 1099511627776.0)); atomicAdd(mq + 6144, (unsigned long long)__double2ll_rn((double)a1 * 1099511627776.0));
            atomicAdd(mq + 2 * 6144, (unsigned long long)__double2ll_rn((double)a2 * 1099511627776.0)); atomicAdd(mq + 3 * 6144, (unsigned long long)__double2ll_rn((double)a3 * 1099511627776.0));
            continue;
        }
        r -= I_MOD;
        if (r < I_SK) {
            const int m = r >> 4, kb = r & 15, k0 = kb * 64;
            const float* W = m < 2 ? p.in[24] + (size_t)m * D * NE : p.in[16] + 5120; const int ldw = m < 2 ? NE : SSM_IN;
#pragma unroll 8
            for (int i = 0; i < 32; ++i) { const int kk = 2 * i + (X.lane >> 5); scr[kk * 33 + (X.lane & 31)] = W[(size_t)(k0 + kk) * ldw + (X.lane & 31)]; }
            LDS_WAIT(); asm volatile("" ::: "memory");
            const int c = X.lane & 7;
#pragma unroll
            for (int j = 0; j < 4; ++j) { const int n = (X.lane >> 3) + 8 * j; const LAS float* sp = scr + (8 * c) * 33 + n;
                float v[8]; unsigned hi[8];
#pragma unroll
                for (int q = 0; q < 8; ++q) { v[q] = sp[q * 33]; hi[q] = f2bf(v[q]); v[q] -= __uint_as_float(hi[q] << 16); }
                u32x4 oh, ol; oh.x = hi[0] | (hi[1] << 16); oh.y = hi[2] | (hi[3] << 16); oh.z = hi[4] | (hi[5] << 16); oh.w = hi[6] | (hi[7] << 16);
                ol.x = pk2(v[0], v[1]); ol.y = pk2(v[2], v[3]); ol.z = pk2(v[4], v[5]); ol.w = pk2(v[6], v[7]);
                bf16_t* dst = (bf16_t*)(ws + WS_SKW) + (size_t)m * 2 * 32 * 1024 + (size_t)n * 1024 + k0 + 8 * c;
                *(u32x4*)dst = oh; *(u32x4*)(dst + 32 * 1024) = ol; }
            LDS_WAIT(); asm volatile("" ::: "memory");
            continue; }
        r -= I_SK;
        if (r < I_W1) { const int kv = r >> 7, q = r & 127, kb = q >> 2, nb = q & 3;
            transpose_item(kv ? p.in[14] : p.in[12], 128, 2048, 128, kb * 64, nb * 32, (bf16_t*)(ws + WS_W1T) + (size_t)kv * 128 * 2048, nb * 32, scr, X.lane); continue; } r -= I_W1;
        if (r < I_WIN) { const int kb = r / 96, nb = r % 96; transpose_item(p.in[6], ATTN_IN, 1024, ATTN_IN, kb * 64, nb * 32, (bf16_t*)(ws + WS_WIN), nb * 32, scr, X.lane); continue; } r -= I_WIN;
        if (r < I_WV) { const int kb = r / 24, nb = r % 24, r0 = nb * 32, src = r0 < 512 ? OFF_SBV + r0 : (r0 < 640 ? OFF_VS + (r0 - 512) : OFF_VW + (r0 - 640));
            transpose_item(p.in[6], ATTN_IN, 1024, ATTN_IN, kb * 64, src, (bf16_t*)(ws + WS_WV), r0, scr, X.lane); continue; } r -= I_WV;
        if (r < I_WOUT) { const int kb = r / 32, nb = r % 32; transpose_item(p.in[7], 1024, 1024, 1024, kb * 64, nb * 32, (bf16_t*)(ws + WS_WOUT), nb * 32, scr, X.lane); continue; } r -= I_WOUT;
        if (r < I_WSIN) { const int kb = r / 160, nb = r % 160, n0 = nb * 32, row0 = n0 < 2048 ? n0 : (n0 < 4096 ? n0 + 1024 : n0 - 2048);
            transpose_item(p.in[16], SSM_IN, 1024, SSM_IN, kb * 64, n0, (bf16_t*)(ws + WS_WSIN), row0, scr, X.lane); continue; } r -= I_WSIN;
        if (r < I_WSOUT) { const int kb = r / 32, nb = r % 32; transpose_item(p.in[23], 1024, 2048, 1024, kb * 64, nb * 32, (bf16_t*)(ws + WS_WSOUT), nb * 32, scr, X.lane); continue; } r -= I_WSOUT;
        if (r < I_GU) { const int m = r >> 10, q = r & 1023, kb = q >> 6, nb = q & 63, n0 = nb * 32;
            const int row0 = ((n0 & 1023) >> 7) * 256 + (n0 >> 10) * 128 + (n0 & 127);
            transpose_item(p.in[26] + (size_t)m * 1024 * 2048, 2048, 1024, 2048, kb * 64, n0, (bf16_t*)(ws + WS_WGU) + (size_t)m * 2048 * 1024, row0, scr, X.lane); continue; } r -= I_GU;
        { const int m = r >> 9, q = r & 511, kb = q >> 5, nb = q & 31;
            transpose_item(p.in[28] + (size_t)m * 1024 * 1024, 1024, 1024, 1024, kb * 64, nb * 32, (bf16_t*)(ws + WS_WDN) + (size_t)m * 1024 * 1024, nb * 32, scr, X.lane); }
    }
}

struct Row { f32x4 v[4]; };
__device__ __forceinline__ void row_load(Row& r, const float* p, int lane) {
#pragma unroll
    for (int j = 0; j < 4; ++j) r.v[j] = ((const f32x4*)p)[64 * j + lane];
}
__device__ __forceinline__ void row_load_bf16(Row& r, const bf16_t* p, int lane) {
#pragma unroll
    for (int j = 0; j < 4; ++j) { const u32x2 q = ((const u32x2*)p)[64 * j + lane]; r.v[j] = (f32x4){bflo(q.x), bfhi(q.x), bflo(q.y), bfhi(q.y)}; }
}
__device__ __forceinline__ void row_store(const Row& r, float* p, int lane) {
#pragma unroll
    for (int j = 0; j < 4; ++j) ((f32x4*)p)[64 * j + lane] = r.v[j];
}
template <class PV>
__device__ __forceinline__ void row_norm_mod(const Row& r, Row& o, const float* gain, PV sc, PV sh, int lane) {
    float ss = 0.f;
#pragma unroll
    for (int j = 0; j < 4; ++j) ss += (r.v[j].x * r.v[j].x + r.v[j].y * r.v[j].y) + (r.v[j].z * r.v[j].z + r.v[j].w * r.v[j].w);
    const float rs = rsqrtf(wave_sum(ss) * (1.f / 1024.f) + EPS);
#pragma unroll
    for (int j = 0; j < 4; ++j) { const f32x4 g = ((const f32x4*)gain)[64 * j + lane], a = sc[64 * j + lane], b = sh[64 * j + lane];
        o.v[j] = r.v[j] * rs * g * (a + 1.f) + b; }
}
__device__ __forceinline__ void row_store_bf16(const Row& r, bf16_t* p, int lane) {
#pragma unroll
    for (int j = 0; j < 4; ++j) { u32x2 w; w.x = pk2(r.v[j].x, r.v[j].y); w.y = pk2(r.v[j].z, r.v[j].w); ((u32x2*)p)[64 * j + lane] = w; }
}
__device__ __forceinline__ void row_store_lds(const Row& r, LAS float* p, int lane) {
#pragma unroll
    for (int j = 0; j < 4; ++j) ((LAS f32x4*)p)[64 * j + lane] = r.v[j];
}
__device__ __forceinline__ float modq2f(long long q) { return (float)((double)q * 9.094947017729282e-13); }
__device__ __forceinline__ void ph_norm0(const Params& p, const Ctx& X) {
    const long long* mq = (const long long*)(X.ws + CTL_MOD);
    float* modf = (float*)(X.ws + WS_MODF);
    for (int i = X.bid * NTHREADS + X.tid; i < 2 * 4 * 6144; i += X.G * NTHREADS) modf[i] = modq2f(mq[i]);
    LAS float* tab = (LAS float*)X.lds;
    for (int i = X.tid; i < 4 * 2048; i += NTHREADS) tab[i] = modq2f(mq[(size_t)(i >> 11) * 6144 + (i & 2047)]);
    __syncthreads();
    for (int t = X.gw; t < T; t += X.ngw) {
        Row r, o; row_load(r, p.in[0] + (size_t)t * D, X.lane);
        const LAS float* m = tab + (t / S) * 2048;
        row_norm_mod(r, o, p.in[4], (const LAS f32x4*)(m + 1024), (const LAS f32x4*)m, X.lane);
        row_store_bf16(o, (bf16_t*)(X.ws + WS_U) + (size_t)t * D, X.lane);
    }
}
__device__ __forceinline__ void route_select(float logit, int lane, LAS unsigned* lcnt, int& ev, float& wv, int& lpos) {
    const int e = lane & 31;
    float tl[4]; int te[4];
#pragma unroll
    for (int k = 0; k < 4; ++k) {
        float bv = logit; int bi = e;
#pragma unroll
        for (int o = 16; o > 0; o >>= 1) { const float ov = __shfl_xor(bv, o); const int oi = __shfl_xor(bi, o); if (ov > bv || (ov == bv && oi < bi)) { bv = ov; bi = oi; } }
        tl[k] = bv; te[k] = bi;
        if (e == bi) logit = -INFINITY;
    }
    ev = 0; wv = 0.f; lpos = 0;
    if (e < 4) {
        const float e1 = expf(tl[1] - tl[0]), e2 = expf(tl[2] - tl[0]), e3 = expf(tl[3] - tl[0]);
        const float inv = 1.f / (1.f + e1 + e2 + e3);
        wv = (e == 0 ? 1.f : e == 1 ? e1 : e == 2 ? e2 : e3) * inv;
        ev = e == 0 ? te[0] : e == 1 ? te[1] : e == 2 ? te[2] : te[3];
        lpos = (int)__hip_atomic_fetch_add(&lcnt[ev], 1u, __ATOMIC_RELAXED, __HIP_MEMORY_SCOPE_WORKGROUP);
    }
}
__device__ __forceinline__ void moe_table(const Ctx& X, int l) {
    LAS int* tb = (LAS int*)(X.lds + TAB_OFF);
    if (X.wave == 0) {
        const unsigned* cnt = (const unsigned*)(X.ws + WS_CTL) + CW_CNT + l * 32 * 32;
        const int e = X.lane & 31;
        const int c = (int)__hip_atomic_load(cnt + e * 32, __ATOMIC_RELAXED, __HIP_MEMORY_SCOPE_AGENT), nt = (c + 255) >> 8;
        int incl = nt;
#pragma unroll
        for (int o = 1; o < 32; o <<= 1) { const int u = __shfl_up(incl, o); if (e >= o) incl += u; }
        if (X.lane < 32) { tb[e] = incl - nt; tb[40 + e] = c; if (e == 31) tb[NE] = incl; }
    }
    __syncthreads();
}
template <int MODE>
__device__ __forceinline__ void ph_token(const Params& p, const Ctx& X, int l, const bf16_t* h, void* hn) {
    if (MODE != 0) moe_table(X, l);
    const LAS int* tb = (const LAS int*)(X.lds + TAB_OFF);
    const float* modl = (const float*)(X.ws + WS_MODF) + (size_t)l * 4 * 6144;
    const float* modn = (const float*)(X.ws + WS_MODF) + (size_t)(MODE == 1 ? 1 : l) * 4 * 6144;
    const float* gain = MODE == 1 ? p.in[4] + D : p.in[5] + l * D;
    const int sc_off = MODE == 1 ? 1024 : 4096, sh_off = MODE == 1 ? 0 : 3072;
    const bf16_t* y = (const bf16_t*)(X.ws + WS_Y);
    LAS float* rsl = (LAS float*)X.lds;
    LAS float* part = (LAS float*)(X.lds + 1024);
    if (MODE == 0 && X.tid < 32) ((LAS unsigned*)(X.lds + 1024 + 65536))[X.tid] = 0u;
    for (int tile = X.bid; tile < T / 64; tile += X.G) {
        const int lane = fresh(X.lane), w = X.wave, tb0 = tile * 64, bb = tb0 / S;
        SUB_BEGIN(X, 31);
        Row ca_, cb_, cg_;
        { const float* m = modn + (size_t)bb * 6144;
#pragma unroll
          for (int j = 0; j < 4; ++j) { if (MODE != 2) { const f32x4 g = ((const f32x4*)gain)[64 * j + lane], a = ((const f32x4*)(m + sc_off))[64 * j + lane]; ca_.v[j] = g * (a + 1.f); cb_.v[j] = ((const f32x4*)(m + sh_off))[64 * j + lane]; }
                                        if (MODE != 0) cg_.v[j] = ((const f32x4*)(modl + (size_t)bb * 6144 + 5120))[64 * j + lane]; } }
        int pe_ = 0, pp_ = 0; float pw_ = 0.f;
        if (MODE != 0 && lane < 32) { const int idx = (tb0 + 8 * w) * 4 + lane; pe_ = ((const int*)(X.ws + WS_TOKE))[idx]; pp_ = ((const int*)(X.ws + WS_TOKP))[idx]; pw_ = ((const float*)(X.ws + WS_TOKW))[idx]; }
#pragma unroll 1
        for (int k2 = 0; k2 < 4; ++k2) {
            Row r[2];
#pragma unroll
            for (int u = 0; u < 2; ++u) row_load_bf16(r[u], h + (size_t)(tb0 + 8 * w + 2 * k2 + u) * D, lane);
            if (MODE != 0) {
#pragma unroll
                for (int u = 0; u < 2; ++u) {
#pragma unroll
                    for (int kk = 0; kk < 4; ++kk) {
                        const int sl = (2 * k2 + u) * 4 + kk;
                        const int e = __shfl(pe_, sl), pos = __shfl(pp_, sl); const float wt = __shfl(pw_, sl);
                        const bf16_t* yr = y + (size_t)(tb[e] * 256 + pos) * D;
#pragma unroll
                        for (int j = 0; j < 4; ++j) { const u32x2 q = ((const u32x2*)yr)[64 * j + lane]; const f32x4 gw = cg_.v[j] * wt;
                            r[u].v[j].x += gw.x * bflo(q.x); r[u].v[j].y += gw.y * bfhi(q.x); r[u].v[j].z += gw.z * bflo(q.y); r[u].v[j].w += gw.w * bfhi(q.y); }
                    }
                    if (MODE == 2) row_store(r[u], (float*)hn + (size_t)(tb0 + 8 * w + 2 * k2 + u) * D, lane); else row_store_bf16(r[u], (bf16_t*)hn + (size_t)(tb0 + 8 * w + 2 * k2 + u) * D, lane);
                    __builtin_amdgcn_sched_barrier(0);
                }
            }
            if (MODE != 2) {
#pragma unroll
                for (int u = 0; u < 2; ++u) {
                    float ssq = 0.f;
#pragma unroll
                    for (int j = 0; j < 4; ++j) ssq += (r[u].v[j].x * r[u].v[j].x + r[u].v[j].y * r[u].v[j].y) + (r[u].v[j].z * r[u].v[j].z + r[u].v[j].w * r[u].v[j].w);
                    const float rs = rsqrtf(wave_sum(ssq) * (1.f / 1024.f) + EPS);
                    bf16_t* uh = (bf16_t*)(X.ws + WS_U) + (size_t)(tb0 + 8 * w + 2 * k2 + u) * D;
#pragma unroll
                    for (int j = 0; j < 4; ++j) { const f32x4 o = r[u].v[j] * rs * ca_.v[j] + cb_.v[j];
                        u32x2 hi; hi.x = pk2(o.x, o.y); hi.y = pk2(o.z, o.w); ((u32x2*)uh)[64 * j + lane] = hi; }
                }
            }
        }
        SUB_END(X, 31);
        if (MODE == 2) continue;
        SUB_BEGIN(X, 32);
        __syncthreads();
        {
            const int ql = lane & 31, hf = lane >> 5;
            const bf16_t* wh = (const bf16_t*)(X.ws + WS_SKW) + (size_t)(MODE == 0 ? l : 2) * 2 * 32 * 1024 + (size_t)ql * 1024 + 128 * w + 8 * hf;
            const bf16_t* uh = (const bf16_t*)(X.ws + WS_U) + (size_t)(tb0 + ql) * D + 128 * w + 8 * hf;
            f32x16 acc0, acc1;
#pragma unroll
            for (int i = 0; i < 16; ++i) { acc0[i] = 0.f; acc1[i] = 0.f; }
#pragma unroll
            for (int ks = 0; ks < 8; ++ks) {
                const bf16x8 whi = *(const bf16x8*)(wh + 16 * ks), wlo = *(const bf16x8*)(wh + 32 * 1024 + 16 * ks);
                const bf16x8 ah0 = *(const bf16x8*)(uh + 16 * ks), ah1 = *(const bf16x8*)(uh + 32 * D + 16 * ks);
                acc0 = __builtin_amdgcn_mfma_f32_32x32x16_bf16(ah0, whi, acc0, 0, 0, 0); acc0 = __builtin_amdgcn_mfma_f32_32x32x16_bf16(ah0, wlo, acc0, 0, 0, 0);
                acc1 = __builtin_amdgcn_mfma_f32_32x32x16_bf16(ah1, whi, acc1, 0, 0, 0); acc1 = __builtin_amdgcn_mfma_f32_32x32x16_bf16(ah1, wlo, acc1, 0, 0, 0);
            }
#pragma unroll
            for (int i = 0; i < 16; ++i) { const int row = 8 * (i >> 2) + 4 * hf + (i & 3); part[(w * 64 + row) * 32 + ql] = acc0[i]; part[(w * 64 + 32 + row) * 32 + ql] = acc1[i]; }
        }
        __syncthreads();
        SUB_END(X, 32);
        SUB_BEGIN(X, 33);
        {
            const int e = lane & 31, hf = lane >> 5;
            LAS unsigned* lcnt = (LAS unsigned*)(X.lds + 1024 + 65536);
            int ev[4], lp[4]; float wv[4];
#pragma unroll
            for (int k = 0; k < 4; ++k) {
                const int tl = 8 * w + 4 * hf + k;
                float v = 0.f;
#pragma unroll
                for (int ww = 0; ww < 8; ++ww) v += part[(ww * 64 + tl) * 32 + e];
                if (MODE == 0) route_select(v + p.in[25][l * NE + e], lane, lcnt, ev[k], wv[k], lp[k]);
                else ((float*)(X.ws + WS_DT))[(size_t)(tb0 + tl) * 32 + e] = v;
            }
            if (MODE == 0) {
                __syncthreads();
                if (X.tid < 32) { const unsigned n = lcnt[X.tid]; unsigned* cnt = (unsigned*)(X.ws + WS_CTL) + CW_CNT + (l * 32 + X.tid) * 32;
                    lcnt[32 + X.tid] = n ? atomicAdd(cnt, n) : 0u; }
                __syncthreads();
                if (e < 4) {
#pragma unroll
                    for (int k = 0; k < 4; ++k) { const int t = tb0 + 8 * w + 4 * hf + k, pos = (int)lcnt[32 + ev[k]] + lp[k];
                        ((int*)(X.ws + WS_TOKE))[t * 4 + e] = ev[k]; ((float*)(X.ws + WS_TOKW))[t * 4 + e] = wv[k]; ((int*)(X.ws + WS_TOKP))[t * 4 + e] = pos;
                        ((int*)(X.ws + WS_SLOT))[ev[k] * CAP + pos] = t; }
                }
            }
        }
        __syncthreads();
        SUB_END(X, 33);
        if (MODE == 0 && X.tid < 32) ((LAS unsigned*)(X.lds + 1024 + 65536))[X.tid] = 0u;
    }
}

__device__ __forceinline__ void ld64bf(const bf16_t* p, float (&q)[64]) {
#pragma unroll
    for (int i = 0; i < 8; ++i) { const u32x4 w = ((const u32x4*)p)[i];
        q[8 * i] = bflo(w.x); q[8 * i + 1] = bfhi(w.x); q[8 * i + 2] = bflo(w.y); q[8 * i + 3] = bfhi(w.y); q[8 * i + 4] = bflo(w.z); q[8 * i + 5] = bfhi(w.z); q[8 * i + 6] = bflo(w.w); q[8 * i + 7] = bfhi(w.w); }
}
__device__ __forceinline__ float dot64bf(const bf16_t* p, const float (&q)[64]) {
    float d = 0.f;
#pragma unroll
    for (int i = 0; i < 8; ++i) { const u32x4 w = ((const u32x4*)p)[i];
        d += q[8 * i] * bflo(w.x) + q[8 * i + 1] * bfhi(w.x) + q[8 * i + 2] * bflo(w.y) + q[8 * i + 3] * bfhi(w.y) + q[8 * i + 4] * bflo(w.z) + q[8 * i + 5] * bfhi(w.z) + q[8 * i + 6] * bflo(w.w) + q[8 * i + 7] * bfhi(w.w); }
    return d;
}
__device__ __forceinline__ float dot64f(const float* p, const float (&q)[64]) {
    float d = 0.f;
#pragma unroll
    for (int i = 0; i < 16; ++i) { const f32x4 w = ((const f32x4*)p)[i]; d += (q[4 * i] * w.x + q[4 * i + 1] * w.y) + (q[4 * i + 2] * w.z + q[4 * i + 3] * w.w); }
    return d;
}
__device__ __forceinline__ void sb_unit(const Ctx& X, int qt, int bh) {
    const int b = bh >> 3, hh = bh & 7, t = qt * 64 + X.lane;
    const bf16_t* base = (const bf16_t*)(X.ws + WS_BIG) + (size_t)b * S * PROJ_LD;
    float q[64], acc[64];
    ld64bf(base + (size_t)t * PROJ_LD + OFF_SBQ + hh * 64, q);
#pragma unroll
    for (int d = 0; d < 64; ++d) acc[d] = 0.f;
    float run = 0.f;
    for (int j = qt * 64 + 62; j >= 0; --j) {
        const bf16_t* kr = base + (size_t)j * PROJ_LD + OFF_SBK + hh * 64;
        const float logit = dot64bf(kr, q) * 0.125f;
        if (j < t) {
            const float w = expf(logsig(logit) + run);
            run += logsig(-logit);
            const bf16_t* vr = base + (size_t)j * PROJ_LD + OFF_SBV + hh * 64;
#pragma unroll
            for (int i = 0; i < 8; ++i) { const u32x4 v = ((const u32x4*)vr)[i];
                acc[8 * i] += w * bflo(v.x); acc[8 * i + 1] += w * bfhi(v.x); acc[8 * i + 2] += w * bflo(v.y); acc[8 * i + 3] += w * bfhi(v.y);
                acc[8 * i + 4] += w * bflo(v.z); acc[8 * i + 5] += w * bfhi(v.z); acc[8 * i + 6] += w * bflo(v.w); acc[8 * i + 7] += w * bfhi(v.w); }
        }
    }
    bf16_t* op = (bf16_t*)(X.ws + WS_O) + (size_t)(b * S + t) * D + hh * 64;
#pragma unroll
    for (int i = 0; i < 8; ++i) { u32x4 w; w.x = pk2(acc[8 * i], acc[8 * i + 1]); w.y = pk2(acc[8 * i + 2], acc[8 * i + 3]); w.z = pk2(acc[8 * i + 4], acc[8 * i + 5]); w.w = pk2(acc[8 * i + 6], acc[8 * i + 7]);
        ((u32x4*)op)[i] = w; }
}

#define DMA16(gptr, ldsptr) __builtin_amdgcn_global_load_lds((const unsigned*)(gptr), (LAS unsigned*)(ldsptr), 16, 0, 0)
#define RING2_WAIT_BAR(q, nb) do { const int issued_ = (q) + 6 < (nb) ? (q) + 6 : (nb); const int need_ = (q) + 2 < (nb) ? (q) + 2 : (nb); const int fl_ = issued_ - need_; \
        if (fl_ >= 4) asm volatile("s_waitcnt vmcnt(8)\n\ts_barrier" ::: "memory"); else if (fl_ == 3) asm volatile("s_waitcnt vmcnt(6)\n\ts_barrier" ::: "memory"); \
        else if (fl_ == 2) asm volatile("s_waitcnt vmcnt(4)\n\ts_barrier" ::: "memory"); else if (fl_ == 1) asm volatile("s_waitcnt vmcnt(2)\n\ts_barrier" ::: "memory"); \
        else asm volatile("s_waitcnt vmcnt(0)\n\ts_barrier" ::: "memory"); } while (0)
__device__ __forceinline__ int pi32(int r) { return (r & 0x13) | ((r & 4) << 1) | ((r & 8) >> 1); }
__device__ __forceinline__ void sb_attn_unit(const Ctx& X, int bh, int qb) {
    const int b = bh >> 3, h = bh & 7, q0 = qb * 256, lane = fresh(X.lane), w = X.wave, ql = lane & 31, hf = lane >> 5;
    const bf16_t* proj = (const bf16_t*)(X.ws + WS_BIG) + (size_t)b * S * PROJ_LD;
    const bf16_t* vt = (const bf16_t*)(X.ws + WS_VT) + (size_t)(h * 64) * T + (size_t)b * S;
    const int tq = q0 + 32 * w + ql;
    bf16x8 qf[4];
#pragma unroll
    for (int s = 0; s < 4; ++s) qf[s] = *(const bf16x8*)(proj + (size_t)tq * PROJ_LD + OFF_SBQ + h * 64 + 16 * s + 8 * hf);
    f32x16 o0, o1;
#pragma unroll
    for (int i = 0; i < 16; ++i) { o0[i] = 0.f; o1[i] = 0.f; }
    float run = 1.f;
    const int nblk = 4 * qb + 4, jw = (q0 + 32 * w + 30) >> 6;
    const float CS = 0.125f * 1.4426950408889634f;
    const bf16_t* kg = proj + (size_t)lane * PROJ_LD + OFF_SBK + h * 64 + 8 * w;
    const bf16_t* vg = vt + (size_t)lane * T + 8 * w;
    LAS unsigned char* ring = X.lds + w * 1024;
    const int krow = pi32(ql) * 16;
    asm volatile("s_waitcnt vmcnt(0)" ::: "memory");
#pragma unroll
    for (int d = 0; d < 6; ++d) if (d < nblk) { DMA16(kg + (size_t)(64 * (nblk - 1 - d)) * PROJ_LD, ring + d * 16384); DMA16(vg + 64 * (nblk - 1 - d), ring + d * 16384 + 8192); }
    for (int q = 0; q < nblk; ++q) {
        const int j = nblk - 1 - q;
        if ((q & 1) == 0) {
            SUB_BEGIN(X, 11);
            RING2_WAIT_BAR(q, nblk);
            SUB_END(X, 11);
#pragma unroll
            for (int d = 6; d < 8; ++d) if (q + d < nblk) { const int jj = nblk - 1 - (q + d), sl = (q + d) & 7; DMA16(kg + (size_t)(64 * jj) * PROJ_LD, ring + sl * 16384); DMA16(vg + 64 * jj, ring + sl * 16384 + 8192); }
        }
        LAS unsigned char* buf = X.lds + (q & 7) * 16384;
        SUB_BEGIN(X, 12);
        if (j <= jw) {
            const bool diag = 64 * j + 63 >= q0 + 32 * w;
#pragma unroll
            for (int kt = 1; kt >= 0; --kt) {
                f32x16 sc;
#pragma unroll
                for (int i = 0; i < 16; ++i) sc[i] = 0.f;
#pragma unroll
                for (int s = 0; s < 4; ++s) { const bf16x8 kf = *(const LAS bf16x8*)(buf + (2 * s + hf) * 1024 + kt * 512 + krow); sc = __builtin_amdgcn_mfma_f32_32x32x16_bf16(kf, qf[s], sc, 0, 0, 0); }
                f32x16 ee = sc * (-CS), be, kp;
#pragma unroll
                for (int i = 0; i < 16; ++i) ee[i] = __builtin_amdgcn_exp2f(ee[i]);
                be = ee + 1.f;
#pragma unroll
                for (int i = 0; i < 16; ++i) be[i] = __builtin_amdgcn_rcpf(be[i]);
                kp = ee * be;
                if (diag) {
                    asm volatile("; diagonal block: masks" ::: "memory");
                    const int pos0 = 64 * j + 32 * kt + 8 * hf;
#pragma unroll
                    for (int i = 0; i < 16; ++i) { const bool valid = (pos0 + 16 * (i >> 3) + (i & 7)) < tq; be[i] = valid ? be[i] : 0.f; kp[i] = valid ? kp[i] : 1.f; }
                }
                float l1 = 1.f, l0 = 1.f;
#pragma unroll
                for (int i = 15; i >= 8; --i) { const float t = be[i] * l1; l1 *= kp[i]; be[i] = t; }
#pragma unroll
                for (int i = 7; i >= 0; --i) { const float t = be[i] * l0; l0 *= kp[i]; be[i] = t; }
                const float p1 = __shfl_xor(l1, 32), p0 = __shfl_xor(l0, 32);
                const float hi1 = hf ? l1 : p1, lo1 = hf ? p1 : l1, hi0 = hf ? l0 : p0, lo0 = hf ? p0 : l0;
                const float r1 = run * hi1, r2 = r1 * lo1, r3 = r2 * hi0;
                const float pre_up = hf ? run : r1, pre_lo = hf ? r2 : r3;
                run = r3 * lo0;
#pragma unroll
                for (int a = 0; a < 2; ++a) {
                    const float pre = a ? pre_up : pre_lo;
                    u32x4 pw; pw.x = pk2(be[8 * a] * pre, be[8 * a + 1] * pre); pw.y = pk2(be[8 * a + 2] * pre, be[8 * a + 3] * pre); pw.z = pk2(be[8 * a + 4] * pre, be[8 * a + 5] * pre); pw.w = pk2(be[8 * a + 6] * pre, be[8 * a + 7] * pre);
                    const bf16x8 pf = __builtin_bit_cast(bf16x8, pw);
                    const bf16x8 v0 = *(const LAS bf16x8*)(buf + 8192 + (4 * kt + 2 * a + hf) * 1024 + ql * 16);
                    const bf16x8 v1 = *(const LAS bf16x8*)(buf + 8192 + (4 * kt + 2 * a + hf) * 1024 + 512 + ql * 16);
                    o0 = __builtin_amdgcn_mfma_f32_32x32x16_bf16(v0, pf, o0, 0, 0, 0);
                    o1 = __builtin_amdgcn_mfma_f32_32x32x16_bf16(v1, pf, o1, 0, 0, 0);
                }
            }
        }
        SUB_END(X, 12);
    }
    asm volatile("s_barrier" ::: "memory");
    bf16_t* op = (bf16_t*)(X.ws + WS_O) + (size_t)(b * S + fresh(tq)) * D + h * 64 + 4 * hf;
#pragma unroll
    for (int g4 = 0; g4 < 4; ++g4) {
        u32x2 w0; w0.x = pk2(o0[4 * g4], o0[4 * g4 + 1]); w0.y = pk2(o0[4 * g4 + 2], o0[4 * g4 + 3]); *(u32x2*)(op + 8 * g4) = w0;
        u32x2 w1; w1.x = pk2(o1[4 * g4], o1[4 * g4 + 1]); w1.y = pk2(o1[4 * g4 + 2], o1[4 * g4 + 3]); *(u32x2*)(op + 32 + 8 * g4) = w1;
    }
}
__device__ __forceinline__ void ph_sb(const Ctx& X) {
    for (int pr = X.bid; pr < 256; pr += X.G)
#pragma unroll 1
        for (int u = 0; u < 2; ++u) { const int bh = pr >> 3, qa = pr & 7; sb_attn_unit(X, bh, u ? qa : 15 - qa); }
}
__device__ __forceinline__ void ph_attn_a(const Params& p, const Ctx& X) {
    const bf16_t* proj = (const bf16_t*)(X.ws + WS_BIG);
    for (int unit = X.bid; unit < 128; unit += X.G) {
        const int kv = unit >> 6, bg = (unit >> 3) & 7, ntile = unit & 7, b = bg >> 1, g = bg & 1, lane = fresh(X.lane), w = X.wave, ql = lane & 31, hf = lane >> 5;
        const int n = min(32 * ntile + ql, NCMP - 1);
        const float* pe = kv ? p.in[11] : p.in[10];
        const bf16_t* w1t = (const bf16_t*)(X.ws + WS_W1T) + (size_t)kv * 128 * 2048;
        const bf16_t* arow = proj + (size_t)(b * S + n * 16) * PROJ_LD + (kv ? OFF_VC : OFF_KC) + g * 64;
        f32x16 acc[4];
#pragma unroll
        for (int ct = 0; ct < 4; ++ct)
#pragma unroll
            for (int i = 0; i < 16; ++i) acc[ct][i] = 0.f;
        for (int ks = 0; ks < 16; ++ks) {
            const int k0 = 256 * w + 16 * ks + 8 * hf, l = k0 >> 6, d = k0 & 63;
            const u32x4 q = *(const u32x4*)(arow + (size_t)l * PROJ_LD + d);
            const f32x4 e0 = *(const f32x4*)(pe + k0), e1 = *(const f32x4*)(pe + k0 + 4);
            u32x4 o; o.x = pk2(bflo(q.x) + e0.x, bfhi(q.x) + e0.y); o.y = pk2(bflo(q.y) + e0.z, bfhi(q.y) + e0.w); o.z = pk2(bflo(q.z) + e1.x, bfhi(q.z) + e1.y); o.w = pk2(bflo(q.w) + e1.z, bfhi(q.w) + e1.w);
            const bf16x8 af = __builtin_bit_cast(bf16x8, o);
#pragma unroll
            for (int ct = 0; ct < 4; ++ct) acc[ct] = __builtin_amdgcn_mfma_f32_32x32x16_bf16(af, *(const bf16x8*)(w1t + (size_t)(32 * ct + ql) * 2048 + k0), acc[ct], 0, 0, 0);
        }
        LAS float* part = (LAS float*)X.lds;
#pragma unroll
        for (int ct = 0; ct < 4; ++ct)
#pragma unroll
            for (int i = 0; i < 16; ++i) part[w * 4096 + (8 * (i >> 2) + 4 * hf + (i & 3)) * 128 + 32 * ct + ql] = acc[ct][i];
        __syncthreads();
        LAS float* hid = part;
        {
            const int tidf = fresh(X.tid);
#pragma unroll
            for (int k = 0; k < 8; ++k) { const int e = tidf + NTHREADS * k; float v = 0.f;
#pragma unroll
                for (int ww = 0; ww < 8; ++ww) v += part[ww * 4096 + e];
                hid[e] = siluf(v); }
        }
        __syncthreads();
        {
            const int tidf = fresh(X.tid), row = tidf >> 4, c4 = (tidf & 15) * 4;
            const float* w2 = kv ? p.in[15] : p.in[13];
            f32x4 o = (f32x4){0.f, 0.f, 0.f, 0.f};
            for (int j = 0; j < 128; ++j) o = o + *(const f32x4*)(w2 + j * 64 + c4) * hid[row * 128 + j];
            const int nn = 32 * ntile + row;
            if (kv == 0) {
                float ssq = (o.x * o.x + o.y * o.y) + (o.z * o.z + o.w * o.w);
                ssq += __shfl_xor(ssq, 1); ssq += __shfl_xor(ssq, 2); ssq += __shfl_xor(ssq, 4); ssq += __shfl_xor(ssq, 8);
                const float r = rsqrtf(ssq * (1.f / 64.f) + EPS); const f32x4 gn = *(const f32x4*)(p.in[9] + c4);
                o = o * r * gn;
                if (nn >= NCMP) o = (f32x4){0.f, 0.f, 0.f, 0.f};
                u32x2 wv; wv.x = pk2(o.x, o.y); wv.y = pk2(o.z, o.w);
                *(u32x2*)((bf16_t*)(X.ws + WS_KCB) + ((size_t)bg * 256 + nn) * 64 + c4) = wv;
            } else {
                if (nn >= NCMP) o = (f32x4){0.f, 0.f, 0.f, 0.f};
                bf16_t* vt = (bf16_t*)(X.ws + WS_VCT) + ((size_t)bg * 64 + c4) * 256 + nn;
                vt[0] = (bf16_t)f2bf(o.x); vt[256] = (bf16_t)f2bf(o.y); vt[512] = (bf16_t)f2bf(o.z); vt[768] = (bf16_t)f2bf(o.w);
            }
        }
        __syncthreads();
    }
    for (int t2 = X.gw; t2 < T / 2; t2 += X.ngw) {
        const int lane = fresh(X.lane), sub = lane & 7;
#pragma unroll
        for (int k = 0; k < 2; ++k) {
            const int t = 2 * t2 + k;
            const u32x4 q = *(const u32x4*)(proj + (size_t)t * PROJ_LD + OFF_NQ + 8 * lane);
            float v[8] = {bflo(q.x), bfhi(q.x), bflo(q.y), bfhi(q.y), bflo(q.z), bfhi(q.z), bflo(q.w), bfhi(q.w)};
            float ssq = 0.f;
#pragma unroll
            for (int i = 0; i < 8; ++i) ssq += v[i] * v[i];
            ssq += __shfl_xor(ssq, 1); ssq += __shfl_xor(ssq, 2); ssq += __shfl_xor(ssq, 4);
            const float r = rsqrtf(ssq * (1.f / 64.f) + EPS) * (0.125f * 1.4426950408889634f);
            const f32x4 g0 = *(const f32x4*)(p.in[8] + 8 * sub), g1 = *(const f32x4*)(p.in[8] + 8 * sub + 4);
            u32x4 o; o.x = pk2(v[0] * r * g0.x, v[1] * r * g0.y); o.y = pk2(v[2] * r * g0.z, v[3] * r * g0.w); o.z = pk2(v[4] * r * g1.x, v[5] * r * g1.y); o.w = pk2(v[6] * r * g1.z, v[7] * r * g1.w);
            *(u32x4*)((bf16_t*)(X.ws + WS_QNB) + (size_t)t * 512 + 8 * lane) = o;
        }
        {
            const int t = 2 * t2 + (lane >> 5), l32 = lane & 31, isw = l32 >> 4, c = 8 * (l32 & 15);
            const u32x4 q = *(const u32x4*)(proj + (size_t)t * PROJ_LD + (isw ? OFF_KW : OFF_KS) + c);
            float v[8] = {bflo(q.x), bfhi(q.x), bflo(q.y), bfhi(q.y), bflo(q.z), bfhi(q.z), bflo(q.w), bfhi(q.w)};
            float ssq = 0.f;
#pragma unroll
            for (int i = 0; i < 8; ++i) ssq += v[i] * v[i];
            ssq += __shfl_xor(ssq, 1); ssq += __shfl_xor(ssq, 2); ssq += __shfl_xor(ssq, 4);
            const float r = rsqrtf(ssq * (1.f / 64.f) + EPS);
            const float* gn = p.in[9] + (isw ? 128 : 64) + 8 * sub;
            const f32x4 g0 = *(const f32x4*)gn, g1 = *(const f32x4*)(gn + 4);
            u32x4 o; o.x = pk2(v[0] * r * g0.x, v[1] * r * g0.y); o.y = pk2(v[2] * r * g0.z, v[3] * r * g0.w); o.z = pk2(v[4] * r * g1.x, v[5] * r * g1.y); o.w = pk2(v[6] * r * g1.z, v[7] * r * g1.w);
            *(u32x4*)((bf16_t*)(X.ws + (isw ? WS_KWN : WS_KSN)) + (size_t)t * 128 + c) = o;
        }
    }
}
struct NsaSt { f32x16 o0, o1; float m, l; };
template <int MODE>
__device__ __forceinline__ void nsa_flash(const Ctx& X, const bf16_t* kg, const bf16_t* vg, int jlo, int jhi, const bf16x8 (&qf)[4], int tq, float slope2,
                                          unsigned long long mymask, unsigned long long wavemask, NsaSt& st) {
    const int lane = fresh(X.lane), w = X.wave, ql = lane & 31, hf = lane >> 5;
    LAS unsigned char* ring = X.lds + w * 1024;
    const int krow = pi32(ql) * 16, nb = jhi - jlo + 1;
    asm volatile("s_waitcnt vmcnt(0)" ::: "memory");
#pragma unroll
    for (int d = 0; d < 6; ++d) if (d < nb) { DMA16(kg + (size_t)(64 * (jhi - d)) * 128, ring + d * 16384); DMA16(vg + 64 * (jhi - d), ring + d * 16384 + 8192); }
    f32x16 sl;
#pragma unroll
    for (int i = 0; i < 16; ++i) sl[i] = slope2 * (float)(16 * (i >> 3) + (i & 7));
    const float k32 = slope2 * 32.f;
    for (int q = 0; q < nb; ++q) {
        const int j = jhi - q;
        if ((q & 1) == 0) {
            SUB_BEGIN(X, 21);
            RING2_WAIT_BAR(q, nb);
            SUB_END(X, 21);
#pragma unroll
            for (int d = 6; d < 8; ++d) if (q + d < nb) { const int jj = jhi - (q + d), sl2 = (q + d) & 7; DMA16(kg + (size_t)(64 * jj) * 128, ring + sl2 * 16384); DMA16(vg + 64 * jj, ring + sl2 * 16384 + 8192); }
        }
        LAS unsigned char* buf = X.lds + (q & 7) * 16384;
        SUB_BEGIN(X, 22);
        if (MODE == 1 || ((wavemask >> j) & 1ull)) {
            f32x16 s0, s1;
#pragma unroll
            for (int i = 0; i < 16; ++i) { s0[i] = 0.f; s1[i] = 0.f; }
#pragma unroll
            for (int s = 0; s < 4; ++s) {
                const bf16x8 k0 = *(const LAS bf16x8*)(buf + (2 * s + hf) * 1024 + krow), k1 = *(const LAS bf16x8*)(buf + (2 * s + hf) * 1024 + 512 + krow);
                s0 = __builtin_amdgcn_mfma_f32_32x32x16_bf16(k0, qf[s], s0, 0, 0, 0); s1 = __builtin_amdgcn_mfma_f32_32x32x16_bf16(k1, qf[s], s1, 0, 0, 0);
            }
            const int d0 = tq - (64 * j + 8 * hf);
            if (j == jhi || (MODE == 1 && j == jlo)) {
                asm volatile("; boundary block: masks" ::: "memory");
#pragma unroll
                for (int i = 0; i < 16; ++i) {
                    const int da = d0 - (16 * (i >> 3) + (i & 7)), db = da - 32;
                    s0[i] = (da >= 0 && (MODE == 0 || da < 512)) ? s0[i] : -INFINITY; s1[i] = (db >= 0 && (MODE == 0 || db < 512)) ? s1[i] : -INFINITY;
                }
            }
            s0 = s0 + sl; s1 = s1 + sl;
            float mb0 = fmaxf(s0[0], s0[1]), mb1 = fmaxf(s1[0], s1[1]);
#pragma unroll
            for (int i = 2; i < 16; ++i) { mb0 = fmaxf(mb0, s0[i]); mb1 = fmaxf(mb1, s1[i]); }
            const float base = slope2 * (float)d0;
            const bool sel = MODE == 1 || ((mymask >> j) & 1ull);
            float mb = fmaxf(mb0, mb1 + k32) - base;
            mb = sel ? mb : -INFINITY;
            mb = fmaxf(mb, __shfl_xor(mb, 32));
            const float mn = fmaxf(st.m, mb), ms = mn == -INFINITY ? 0.f : mn;
            if (__any(mn > st.m)) {
                const float alpha = __builtin_amdgcn_exp2f(st.m - ms);
                st.l *= alpha;
#pragma unroll
                for (int i = 0; i < 16; ++i) { st.o0[i] *= alpha; st.o1[i] *= alpha; }
                st.m = mn;
            }
            const float off0 = sel ? ms + base : INFINITY, off1 = off0 - k32;
            s0 = s0 - off0; s1 = s1 - off1;
            float ls = 0.f;
#pragma unroll
            for (int i = 0; i < 16; ++i) { s0[i] = __builtin_amdgcn_exp2f(s0[i]); s1[i] = __builtin_amdgcn_exp2f(s1[i]); ls += s0[i] + s1[i]; }
            st.l += ls;
#pragma unroll
            for (int kt = 0; kt < 2; ++kt)
#pragma unroll
                for (int a = 0; a < 2; ++a) {
                    u32x4 pw;
                    if (kt == 0) { pw.x = pk2(s0[8 * a], s0[8 * a + 1]); pw.y = pk2(s0[8 * a + 2], s0[8 * a + 3]); pw.z = pk2(s0[8 * a + 4], s0[8 * a + 5]); pw.w = pk2(s0[8 * a + 6], s0[8 * a + 7]); }
                    else { pw.x = pk2(s1[8 * a], s1[8 * a + 1]); pw.y = pk2(s1[8 * a + 2], s1[8 * a + 3]); pw.z = pk2(s1[8 * a + 4], s1[8 * a + 5]); pw.w = pk2(s1[8 * a + 6], s1[8 * a + 7]); }
                    const bf16x8 pf = __builtin_bit_cast(bf16x8, pw);
                    const bf16x8 v0 = *(const LAS bf16x8*)(buf + 8192 + (4 * kt + 2 * a + hf) * 1024 + ql * 16);
                    const bf16x8 v1 = *(const LAS bf16x8*)(buf + 8192 + (4 * kt + 2 * a + hf) * 1024 + 512 + ql * 16);
                    st.o0 = __builtin_amdgcn_mfma_f32_32x32x16_bf16(v0, pf, st.o0, 0, 0, 0);
                    st.o1 = __builtin_amdgcn_mfma_f32_32x32x16_bf16(v1, pf, st.o1, 0, 0, 0);
                }
        }
        SUB_END(X, 22);
    }
    asm volatile("s_barrier" ::: "memory");
}
__device__ __forceinline__ void nsa_unit(const Ctx& X, int bg, int qb) {
    const int b = bg >> 1, g = bg & 1, lane = fresh(X.lane), w = X.wave, ql = lane & 31, hf = lane >> 5, r = ql >> 3, hh = g * 4 + r;
    const int t0 = 64 * qb, tq = t0 + 8 * w + (ql & 7);
    const float slope2 = exp2f(-(float)(hh + 1)) * 1.4426950408889634f;
    const bf16_t* proj = (const bf16_t*)(X.ws + WS_BIG);
    bf16x8 qf[4];
    { const bf16_t* qp = (const bf16_t*)(X.ws + WS_QNB) + (size_t)(b * S + tq) * 512 + hh * 64 + 8 * hf;
#pragma unroll
      for (int s = 0; s < 4; ++s) qf[s] = *(const bf16x8*)(qp + 16 * s); }
    float gate[3];
    { const bf16_t* gp = proj + (size_t)(b * S + tq) * PROJ_LD + OFF_GATE + hh * 3;
#pragma unroll
      for (int i = 0; i < 3; ++i) gate[i] = 1.f / (1.f + __expf(-bf2f(gp[i]))); }
    f32x16 of0, of1;
#pragma unroll
    for (int i = 0; i < 16; ++i) { of0[i] = 0.f; of1[i] = 0.f; }
    NsaSt st;
    SUB_BEGIN(X, 23);
    LAS float* pacc = (LAS float*)(X.lds + 65536) + w * 2048;
    {
        const int ncm = t0 + 63 >= 31 ? (t0 + 63 - 31) / 16 + 1 : 0, nt = (ncm + 31) >> 5, ncv = tq >= 31 ? (tq - 31) / 16 + 1 : 0;
        {
            const bf16_t* kc = (const bf16_t*)(X.ws + WS_KCB) + (size_t)bg * 256 * 64; const bf16_t* vc = (const bf16_t*)(X.ws + WS_VCT) + (size_t)bg * 64 * 256;
            const int tidf = fresh(X.tid);
#pragma unroll
            for (int i = 0; i < 4; ++i) { const int pidx = tidf + NTHREADS * i;
                *(LAS u32x4*)(X.lds + (pidx >> 8) * 4096 + (pidx & 255) * 16) = *(const u32x4*)(kc + (size_t)(pidx & 255) * 64 + 8 * (pidx >> 8));
                *(LAS u32x4*)(X.lds + 32768 + (pidx >> 6) * 1024 + (pidx & 63) * 16) = *(const u32x4*)(vc + (size_t)(pidx & 63) * 256 + 8 * (pidx >> 6)); }
#pragma unroll
            for (int i = 0; i < 8; ++i) *(LAS f32x4*)(pacc + (i * 64 + lane) * 4) = (f32x4){0.f, 0.f, 0.f, 0.f};
        }
        __syncthreads();
        const int krow = pi32(ql) * 16;
        float ml = -INFINITY, ll = 0.f;
        for (int kt = 0; kt < nt; ++kt) {
            f32x16 sc;
#pragma unroll
            for (int i = 0; i < 16; ++i) sc[i] = 0.f;
#pragma unroll
            for (int s = 0; s < 4; ++s) { const bf16x8 kf = *(const LAS bf16x8*)(X.lds + (2 * s + hf) * 4096 + kt * 512 + krow); sc = __builtin_amdgcn_mfma_f32_32x32x16_bf16(kf, qf[s], sc, 0, 0, 0); }
            float tm = -INFINITY;
#pragma unroll
            for (int i = 0; i < 16; ++i) { const int n = 32 * kt + 16 * (i >> 3) + 8 * hf + (i & 7);
                sc[i] = n < ncv ? sc[i] - slope2 * (float)(tq - (16 * n + 31)) : -INFINITY; tm = fmaxf(tm, sc[i]); }
            const float mn = fmaxf(ml, tm), ms = mn == -INFINITY ? 0.f : mn;
            float ls = 0.f;
#pragma unroll
            for (int i = 0; i < 16; ++i) ls += __builtin_amdgcn_exp2f(sc[i] - ms);
            ll = ll * __builtin_amdgcn_exp2f(ml - ms) + ls; ml = mn;
        }
        float ms, inv;
        { const float mo = __shfl_xor(ml, 32), lo = __shfl_xor(ll, 32), mt = fmaxf(ml, mo); ms = mt == -INFINITY ? 0.f : mt;
          const float lt = ll * __builtin_amdgcn_exp2f(ml - ms) + lo * __builtin_amdgcn_exp2f(mo - ms); inv = lt > 0.f ? 1.f / lt : 0.f; }
#pragma unroll
        for (int i = 0; i < 16; ++i) { st.o0[i] = 0.f; st.o1[i] = 0.f; }
        float carry = 0.f;
        for (int kt = 0; kt < nt; ++kt) {
            f32x16 sc;
#pragma unroll
            for (int i = 0; i < 16; ++i) sc[i] = 0.f;
#pragma unroll
            for (int s = 0; s < 4; ++s) { const bf16x8 kf = *(const LAS bf16x8*)(X.lds + (2 * s + hf) * 4096 + kt * 512 + krow); sc = __builtin_amdgcn_mfma_f32_32x32x16_bf16(kf, qf[s], sc, 0, 0, 0); }
#pragma unroll
            for (int i = 0; i < 16; ++i) { const int n = 32 * kt + 16 * (i >> 3) + 8 * hf + (i & 7);
                sc[i] = n < ncv ? __builtin_amdgcn_exp2f(sc[i] - slope2 * (float)(tq - (16 * n + 31)) - ms) * inv : 0.f; }
            const float pa0 = __shfl_xor(sc[7], 32), pa1 = __shfl_xor(sc[15], 32);
            const float prev0 = hf ? pa0 : carry, prev1 = hf ? pa1 : pa0;
            carry = pa1;
            {
                typedef float f32x2 __attribute__((ext_vector_type(2)));
                f32x2 e0, e1;
                e0.x = prev0 + ((sc[0] + sc[1]) + (sc[2] + sc[3])); e0.y = sc[3] + ((sc[4] + sc[5]) + (sc[6] + sc[7]));
                e1.x = prev1 + ((sc[8] + sc[9]) + (sc[10] + sc[11])); e1.y = sc[11] + ((sc[12] + sc[13]) + (sc[14] + sc[15]));
                *(LAS f32x2*)(pacc + ql * 64 + 8 * kt + 2 * hf) = e0; *(LAS f32x2*)(pacc + ql * 64 + 8 * kt + 4 + 2 * hf) = e1;
            }
#pragma unroll
            for (int a = 0; a < 2; ++a) {
                u32x4 pw; pw.x = pk2(sc[8 * a], sc[8 * a + 1]); pw.y = pk2(sc[8 * a + 2], sc[8 * a + 3]); pw.z = pk2(sc[8 * a + 4], sc[8 * a + 5]); pw.w = pk2(sc[8 * a + 6], sc[8 * a + 7]);
                const bf16x8 pf = __builtin_bit_cast(bf16x8, pw);
                const bf16x8 v0 = *(const LAS bf16x8*)(X.lds + 32768 + (4 * kt + 2 * a + hf) * 1024 + ql * 16);
                const bf16x8 v1 = *(const LAS bf16x8*)(X.lds + 32768 + (4 * kt + 2 * a + hf) * 1024 + 512 + ql * 16);
                st.o0 = __builtin_amdgcn_mfma_f32_32x32x16_bf16(v0, pf, st.o0, 0, 0, 0);
                st.o1 = __builtin_amdgcn_mfma_f32_32x32x16_bf16(v1, pf, st.o1, 0, 0, 0);
            }
        }
#pragma unroll
        for (int i = 0; i < 16; ++i) { of0[i] = gate[0] * st.o0[i]; of1[i] = gate[0] * st.o1[i]; }
    }
    SUB_END(X, 23);
    SUB_BEGIN(X, 24);
    unsigned long long mymask = 0ull, wavemask = 0ull;
    LDS_WAIT();
    for (int q8 = 0; q8 < 8; ++q8) {
        const int t = t0 + 8 * w + q8;
        const float ps = (pacc[(0 * 8 + q8) * 64 + lane] + pacc[(1 * 8 + q8) * 64 + lane]) + (pacc[(2 * 8 + q8) * 64 + lane] + pacc[(3 * 8 + q8) * 64 + lane]);
        const bool valid = lane * 64 <= t, forced = (lane == 0) || (lane == qb) || (lane == qb - 1);
        const unsigned key = valid ? ((forced ? 0x7f000000u : (__float_as_uint(fmaxf(ps, 0.f)) & ~63u)) | (unsigned)(63 - lane)) : 0u;
        unsigned thr = 0u;
#pragma unroll 1
        for (int bit = 30; bit >= 0; --bit) { const unsigned cand = thr | (1u << bit); if (__builtin_popcountll(__ballot(key >= cand)) >= 16) thr = cand; }
        const unsigned long long mk = __ballot(key >= thr && key != 0u);
        wavemask |= mk; if ((ql & 7) == q8) mymask = mk;
    }
    SUB_END(X, 24);
    __syncthreads();
    {
#pragma unroll
        for (int i = 0; i < 16; ++i) { st.o0[i] = 0.f; st.o1[i] = 0.f; }
        st.m = -INFINITY; st.l = 0.f;
        const int lf = fresh(lane);
        const bf16_t* kg = (const bf16_t*)(X.ws + WS_KSN) + ((size_t)b * S + lf) * 128 + g * 64 + 8 * w;
        const bf16_t* vg = (const bf16_t*)(X.ws + WS_VT) + (size_t)(512 + g * 64 + lf) * T + (size_t)b * S + 8 * w;
        nsa_flash<0>(X, kg, vg, 0, qb, qf, tq, slope2, mymask, wavemask, st);
        const float lt = st.l + __shfl_xor(st.l, 32), sc = gate[1] / fmaxf(lt, 1e-30f);
#pragma unroll
        for (int i = 0; i < 16; ++i) { of0[i] += sc * st.o0[i]; of1[i] += sc * st.o1[i]; }
    }
    {
#pragma unroll
        for (int i = 0; i < 16; ++i) { st.o0[i] = 0.f; st.o1[i] = 0.f; }
        st.m = -INFINITY; st.l = 0.f;
        const int lf = fresh(lane);
        const bf16_t* kg = (const bf16_t*)(X.ws + WS_KWN) + ((size_t)b * S + lf) * 128 + g * 64 + 8 * w;
        const bf16_t* vg = (const bf16_t*)(X.ws + WS_VT) + (size_t)(640 + g * 64 + lf) * T + (size_t)b * S + 8 * w;
        nsa_flash<1>(X, kg, vg, qb >= 8 ? qb - 8 : 0, qb, qf, tq, slope2, 0ull, 0ull, st);
        const float lt = st.l + __shfl_xor(st.l, 32), sc = gate[2] / fmaxf(lt, 1e-30f);
#pragma unroll
        for (int i = 0; i < 16; ++i) { of0[i] += sc * st.o0[i]; of1[i] += sc * st.o1[i]; }
    }
    bf16_t* op = (bf16_t*)(X.ws + WS_O) + (size_t)(b * S + fresh(tq)) * D + 512 + hh * 64 + 4 * hf;
#pragma unroll
    for (int g4 = 0; g4 < 4; ++g4) {
        u32x2 w0; w0.x = pk2(of0[4 * g4], of0[4 * g4 + 1]); w0.y = pk2(of0[4 * g4 + 2], of0[4 * g4 + 3]); *(u32x2*)(op + 8 * g4) = w0;
        u32x2 w1; w1.x = pk2(of1[4 * g4], of1[4 * g4 + 1]); w1.y = pk2(of1[4 * g4 + 2], of1[4 * g4 + 3]); *(u32x2*)(op + 32 + 8 * g4) = w1;
    }
}
__device__ __forceinline__ void ph_nsa(const Params& p, const Ctx& X) {
    for (int pr = X.bid; pr < 256; pr += X.G)
#pragma unroll 1
        for (int u = 0; u < 2; ++u) { const int bg = pr >> 5, qa = pr & 31; nsa_unit(X, bg, u ? qa : 63 - qa); }
}

__device__ __forceinline__ float silu_fast(float v) { return v * __builtin_amdgcn_rcpf(1.f + __expf(-v)); }
constexpr int S1_WL = RING_BYTES + 4096;
__device__ __forceinline__ void ph_ssd1(const Params& p, const Ctx& X) {
    const float* cw = p.in[17]; const float* cb = p.in[18];
    LAS float* wl = (LAS float*)(X.lds + S1_WL);
    LAS unsigned char* ldsB = X.lds;
    LAS unsigned char* ldsX = X.lds + 65536;
    for (int unit = X.bid; unit < 256; unit += X.G) {
        const int b = unit >> 6, c = (unit >> 2) & 15, g = unit & 3, tl0 = c * 256, lane = fresh(X.lane), w = X.wave, ql = lane & 31, hf = lane >> 5;
        const size_t t0 = (size_t)b * S + tl0;
        SUB_BEGIN(X, 41);
        {
            const int h = g * 8 + w;
            const float a = -expf(p.in[20][h]), dtb = p.in[19][h];
            const float* dr = (const float*)(X.ws + WS_DT) + (t0 + 4 * lane) * 32 + h;
            float dt[4], cs[4];
#pragma unroll
            for (int k = 0; k < 4; ++k) { const float raw = dr[k * 32] + dtb; dt[k] = raw > 20.f ? raw : log1pf(expf(raw)); }
            cs[0] = dt[0] * a; cs[1] = cs[0] + dt[1] * a; cs[2] = cs[1] + dt[2] * a; cs[3] = cs[2] + dt[3] * a;
            float incl = cs[3];
#pragma unroll
            for (int o = 1; o < 64; o <<= 1) { const float u = __shfl_up(incl, o); if (lane >= o) incl += u; }
            const float excl = incl - cs[3], last = __shfl(incl, 63);
#pragma unroll
            for (int k = 0; k < 4; ++k) cs[k] += excl;
            *(f32x4*)((float*)(X.ws + WS_DT2) + (size_t)(b * 32 + h) * S + tl0 + 4 * lane) = (f32x4){dt[0], dt[1], dt[2], dt[3]};
            *(f32x4*)((float*)(X.ws + WS_CS) + (size_t)(b * 32 + h) * S + tl0 + 4 * lane) = (f32x4){cs[0], cs[1], cs[2], cs[3]};
            *(LAS f32x4*)(wl + w * 256 + 4 * lane) = (f32x4){dt[0] * __expf(last - cs[0]), dt[1] * __expf(last - cs[1]), dt[2] * __expf(last - cs[2]), dt[3] * __expf(last - cs[3])};
            if (lane == 63) ((float*)(X.ws + WS_DEC))[(b * 16 + c) * 32 + h] = __expf(last);
        }
        const bf16_t* xt = (const bf16_t*)(X.ws + WS_XT); bf16_t* xct = (bf16_t*)(X.ws + WS_XCT);
        const int tidf = fresh(X.tid);
#define CONV8(rin, chg, seg, o) do { const bf16_t* src_ = xt + (size_t)(rin) * T + t0 + 8 * (seg); const u32x4 cur_ = *(const u32x4*)src_; u32x4 prv_ = (u32x4){0u, 0u, 0u, 0u}; \
            if (tl0 + 8 * (seg) >= 8) prv_ = *(const u32x4*)(src_ - 8); \
            const float x_[11] = {bfhi(prv_.z), bflo(prv_.w), bfhi(prv_.w), bflo(cur_.x), bfhi(cur_.x), bflo(cur_.y), bfhi(cur_.y), bflo(cur_.z), bfhi(cur_.z), bflo(cur_.w), bfhi(cur_.w)}; \
            const float w0_ = cw[chg], w1_ = cw[CONV_DIM + (chg)], w2_ = cw[2 * CONV_DIM + (chg)], w3_ = cw[3 * CONV_DIM + (chg)], bb_ = cb[chg]; \
            _Pragma("unroll") for (int j_ = 0; j_ < 8; ++j_) o[j_] = silu_fast(bb_ + w0_ * x_[j_] + w1_ * x_[j_ + 1] + w2_ * x_[j_ + 2] + w3_ * x_[j_ + 3]); } while (0)
        SUB_END(X, 41);
        SUB_BEGIN(X, 42);
        {
#pragma unroll
            for (int k = 0; k < 8; ++k) {
                const int it = tidf + NTHREADS * k, n = it >> 5, seg = it & 31, chg = 2048 + g * 128 + n;
                float o[8]; CONV8(g * 128 + n, chg, seg, o);
                u32x4 ov; ov.x = pk2(o[0], o[1]); ov.y = pk2(o[2], o[3]); ov.z = pk2(o[4], o[5]); ov.w = pk2(o[6], o[7]);
                *(u32x4*)(xct + (size_t)chg * T + t0 + 8 * seg) = ov;
                *(LAS u32x4*)(ldsB + seg * 2048 + n * 16) = ov;
            }
            SUB_END(X, 42);
            SUB_BEGIN(X, 43);
            const bf16_t* zbc = (const bf16_t*)(X.ws + WS_ZBC); bf16_t* bcm = (bf16_t*)(X.ws + WS_BCM);
            {
                const int c8 = tidf & 31, l0 = (tidf >> 5) * 16;
                const int col = (c8 < 16 ? g * 128 + 8 * c8 : 512 + g * 128 + 8 * (c8 - 16));
                float wk[4][8], bb[8];
                { const f32x4 b0 = *(const f32x4*)(cb + 2048 + col), b1 = *(const f32x4*)(cb + 2048 + col + 4); bb[0] = b0.x; bb[1] = b0.y; bb[2] = b0.z; bb[3] = b0.w; bb[4] = b1.x; bb[5] = b1.y; bb[6] = b1.z; bb[7] = b1.w; }
#pragma unroll
                for (int ww = 0; ww < 4; ++ww) { const f32x4 k0 = *(const f32x4*)(cw + ww * CONV_DIM + 2048 + col), k1 = *(const f32x4*)(cw + ww * CONV_DIM + 2048 + col + 4);
                    wk[ww][0] = k0.x; wk[ww][1] = k0.y; wk[ww][2] = k0.z; wk[ww][3] = k0.w; wk[ww][4] = k1.x; wk[ww][5] = k1.y; wk[ww][6] = k1.z; wk[ww][7] = k1.w; }
                u32x4 rw[19];
#pragma unroll
                for (int r = 0; r < 19; ++r) rw[r] = (tl0 + l0 - 3 + r >= 0) ? *(const u32x4*)(zbc + (t0 + l0 - 3 + r) * 3072 + 2048 + col) : (u32x4){0u, 0u, 0u, 0u};
#pragma unroll
                for (int k = 0; k < 16; ++k) {
                    float acc[8];
#pragma unroll
                    for (int i = 0; i < 8; ++i) acc[i] = bb[i];
#pragma unroll
                    for (int ww = 0; ww < 4; ++ww) { const u32x4 q = rw[k + ww];
                        acc[0] += bflo(q.x) * wk[ww][0]; acc[1] += bfhi(q.x) * wk[ww][1]; acc[2] += bflo(q.y) * wk[ww][2]; acc[3] += bfhi(q.y) * wk[ww][3];
                        acc[4] += bflo(q.z) * wk[ww][4]; acc[5] += bfhi(q.z) * wk[ww][5]; acc[6] += bflo(q.w) * wk[ww][6]; acc[7] += bfhi(q.w) * wk[ww][7]; }
                    u32x4 ov; ov.x = pk2(silu_fast(acc[0]), silu_fast(acc[1])); ov.y = pk2(silu_fast(acc[2]), silu_fast(acc[3])); ov.z = pk2(silu_fast(acc[4]), silu_fast(acc[5])); ov.w = pk2(silu_fast(acc[6]), silu_fast(acc[7]));
                    *(u32x4*)(bcm + (t0 + l0 + k) * 1024 + col) = ov;
                }
            }
        }
        SUB_END(X, 43);
#pragma unroll 1
        for (int hg = 0; hg < 4; ++hg) {
            SUB_BEGIN(X, 44);
            asm volatile("s_waitcnt lgkmcnt(0)\n\ts_barrier" ::: "memory");
#pragma unroll
            for (int k = 0; k < 8; ++k) {
                const int it = tidf + NTHREADS * k, chl = it >> 5, seg = it & 31, h8 = 2 * hg + (chl >> 6), chg = g * 512 + h8 * 64 + (chl & 63);
                float o[8]; CONV8(1024 + chg, chg, seg, o);
                u32x4 ov; ov.x = pk2(o[0], o[1]); ov.y = pk2(o[2], o[3]); ov.z = pk2(o[4], o[5]); ov.w = pk2(o[6], o[7]);
                *(u32x4*)(xct + (size_t)chg * T + t0 + 8 * seg) = ov;
                const f32x4 wa = *(const LAS f32x4*)(wl + h8 * 256 + 8 * seg), wb = *(const LAS f32x4*)(wl + h8 * 256 + 8 * seg + 4);
                u32x4 os; os.x = pk2(o[0] * wa.x, o[1] * wa.y); os.y = pk2(o[2] * wa.z, o[3] * wa.w); os.z = pk2(o[4] * wb.x, o[5] * wb.y); os.w = pk2(o[6] * wb.z, o[7] * wb.w);
                *(LAS u32x4*)(ldsX + (chl >> 6) * 32768 + seg * 1024 + (chl & 63) * 16) = os;
            }
            asm volatile("s_waitcnt lgkmcnt(0)\n\ts_barrier" ::: "memory");
            SUB_END(X, 44);
            SUB_BEGIN(X, 45);
            {
                const int hl = w >> 2, pt = (w >> 1) & 1, nt0 = 2 * (w & 1), h = g * 8 + 2 * hg + hl;
                f32x16 acc0, acc1;
#pragma unroll
                for (int i = 0; i < 16; ++i) { acc0[i] = 0.f; acc1[i] = 0.f; }
#pragma unroll 4
                for (int ks = 0; ks < 16; ++ks) {
                    const bf16x8 af = *(const LAS bf16x8*)(ldsX + hl * 32768 + (2 * ks + hf) * 1024 + (32 * pt + ql) * 16);
                    const bf16x8 b0 = *(const LAS bf16x8*)(ldsB + (2 * ks + hf) * 2048 + (32 * nt0 + ql) * 16), b1 = *(const LAS bf16x8*)(ldsB + (2 * ks + hf) * 2048 + (32 * nt0 + 32 + ql) * 16);
                    acc0 = __builtin_amdgcn_mfma_f32_32x32x16_bf16(af, b0, acc0, 0, 0, 0); acc1 = __builtin_amdgcn_mfma_f32_32x32x16_bf16(af, b1, acc1, 0, 0, 0);
                }
                float* st = (float*)(X.ws + WS_ST) + ((size_t)(b * 16 + c) * 32 + h) * 8192 + 32 * nt0 + ql;
#pragma unroll
                for (int i = 0; i < 16; ++i) { const int pr = 32 * pt + 8 * (i >> 2) + 4 * hf + (i & 3); st[pr * 128] = acc0[i]; st[pr * 128 + 32] = acc1[i]; }
            }
            SUB_END(X, 45);
        }
#undef CONV8
        __syncthreads();
    }
}
__device__ __forceinline__ void ph_ssd2(const Ctx& X) {
    const float* st = (const float*)(X.ws + WS_ST); const float* dec = (const float*)(X.ws + WS_DEC); bf16_t* pb = (bf16_t*)(X.ws + WS_PB);
    for (int e = X.bid * NTHREADS + X.tid; e < NB * 32 * 2048; e += X.G * NTHREADS) {
        const int b = e >> 16, h = (e >> 11) & 31, q4 = (e & 2047) * 4;
        f32x4 hs = (f32x4){0.f, 0.f, 0.f, 0.f};
        for (int c = 0; c < 16; ++c) {
            const size_t o = ((size_t)(b * 16 + c) * 32 + h) * 8192 + q4;
            u32x2 wv; wv.x = pk2(hs.x, hs.y); wv.y = pk2(hs.z, hs.w); *(u32x2*)(pb + o) = wv;
            hs = hs * dec[(b * 16 + c) * 32 + h] + *(const f32x4*)(st + o);
        }
    }
}
constexpr int S3_STG = 49152;
__device__ __forceinline__ void ph_ssd3(const Params& p, const Ctx& X) {
    LAS float* dtl = (LAS float*)(X.lds + 2 * S3_STG); LAS float* csl = dtl + 2048;
    constexpr int S3_TILE = 2 * S3_STG + 16384;
    static_assert(S3_TILE + 8 * 4096 <= TAB_OFF, "ssd3 LDS map");
    for (int unit = X.bid; unit < 256; unit += X.G) {
        const int b = unit >> 6, c = (unit >> 2) & 15, g = unit & 3, tl0 = c * 256, lane = fresh(X.lane), w = X.wave, ql = lane & 31, hf = lane >> 5, lq = 32 * w + ql;
        const size_t t0 = (size_t)b * S + tl0;
        LAS unsigned char* tile = X.lds + S3_TILE + w * 4096;
        const bf16_t* xg = (const bf16_t*)(X.ws + WS_XCT) + (size_t)(g * 512 + lane) * T + t0;
        const bf16_t* pg = (const bf16_t*)(X.ws + WS_PB) + ((size_t)(b * 16 + c) * 32 + g * 8) * 8192 + (size_t)lane * 128;
#define S3_ISSUE(h8, sbase) do { _Pragma("unroll") for (int cc_ = 0; cc_ < 4; ++cc_) DMA16(xg + (size_t)((h8) * 64) * T + 8 * (4 * w + cc_), X.lds + (sbase) + (4 * w + cc_) * 1024); \
            _Pragma("unroll") for (int cc_ = 0; cc_ < 2; ++cc_) DMA16(pg + (size_t)(h8) * 8192 + 8 * (2 * w + cc_), X.lds + (sbase) + 32768 + (2 * w + cc_) * 1024); } while (0)
        asm volatile("s_waitcnt vmcnt(0)" ::: "memory");
        S3_ISSUE(0, 0);
        { const int tidf = fresh(X.tid), h8 = tidf >> 6, l4 = (tidf & 63) * 4;
          *(LAS f32x4*)(dtl + h8 * 256 + l4) = *(const f32x4*)((const float*)(X.ws + WS_DT2) + (size_t)(b * 32 + g * 8 + h8) * S + tl0 + l4);
          *(LAS f32x4*)(csl + h8 * 256 + l4) = *(const f32x4*)((const float*)(X.ws + WS_CS) + (size_t)(b * 32 + g * 8 + h8) * S + tl0 + l4); }
        const bf16_t* bcm = (const bf16_t*)(X.ws + WS_BCM);
        bf16x8 cf[8];
#pragma unroll
        for (int ks = 0; ks < 8; ++ks) cf[ks] = *(const bf16x8*)(bcm + (t0 + lq) * 1024 + 512 + g * 128 + 16 * ks + 8 * hf);
        u32x4 gp[8][2];
        {
#pragma unroll
        for (int st = 0; st < 8; ++st) {
            if (st <= w) {
                f32x16 G;
#pragma unroll
                for (int i = 0; i < 16; ++i) G[i] = 0.f;
                const bf16_t* bp = bcm + (t0 + 32 * st + pi32(ql)) * 1024 + g * 128 + 8 * hf;
#pragma unroll
                for (int ks = 0; ks < 8; ++ks) G = __builtin_amdgcn_mfma_f32_32x32x16_bf16(*(const bf16x8*)(bp + 16 * ks), cf[ks], G, 0, 0, 0);
#pragma unroll
                for (int a2 = 0; a2 < 2; ++a2) { gp[st][a2].x = pk2(G[8 * a2], G[8 * a2 + 1]); gp[st][a2].y = pk2(G[8 * a2 + 2], G[8 * a2 + 3]); gp[st][a2].z = pk2(G[8 * a2 + 4], G[8 * a2 + 5]); gp[st][a2].w = pk2(G[8 * a2 + 6], G[8 * a2 + 7]); }
            } else { gp[st][0] = (u32x4){0u, 0u, 0u, 0u}; gp[st][1] = (u32x4){0u, 0u, 0u, 0u}; }
        }
        }
        float ss = 0.f;
        bf16_t* yrow = (bf16_t*)(X.ws + WS_O) + (t0 + 32 * w + (lane >> 1)) * SSM_INNER + g * 512 + 32 * (lane & 1);
        const bf16_t* zdma = (const bf16_t*)(X.ws + WS_ZBC) + (t0 + 32 * w + (lane >> 3)) * 3072 + g * 512 + 8 * ((lane & 7) ^ (lane >> 3));
        LAS unsigned char* trw = tile + (lane >> 1) * 128;
        LAS unsigned char* tac = tile + ql * 128 + 8 * hf;
#pragma unroll 1
        for (int h8 = 0; h8 < 8; ++h8) {
            const int sb = (h8 & 1) * S3_STG;
            asm volatile("s_waitcnt vmcnt(0) lgkmcnt(0)\n\ts_barrier" ::: "memory");
            if (h8 < 7) S3_ISSUE(h8 + 1, ((h8 + 1) & 1) * S3_STG);
#pragma unroll
            for (int k = 0; k < 4; ++k) DMA16(zdma + (size_t)(8 * k) * 3072 + h8 * 64, tile + k * 1024);
            f32x16 acc0, acc1;
#pragma unroll
            for (int i = 0; i < 16; ++i) { acc0[i] = 0.f; acc1[i] = 0.f; }
            {
                const LAS unsigned char* pp = X.lds + sb + 32768 + hf * 1024 + ql * 16;
#pragma unroll
                for (int ks = 0; ks < 8; ++ks) { acc0 = __builtin_amdgcn_mfma_f32_32x32x16_bf16(*(const LAS bf16x8*)(pp + ks * 2048), cf[ks], acc0, 0, 0, 0);
                                                 acc1 = __builtin_amdgcn_mfma_f32_32x32x16_bf16(*(const LAS bf16x8*)(pp + ks * 2048 + 512), cf[ks], acc1, 0, 0, 0); }
                const float e = __expf(csl[h8 * 256 + lq]);
#pragma unroll
                for (int i = 0; i < 16; ++i) { acc0[i] *= e; acc1[i] *= e; }
            }
            const float cl = csl[h8 * 256 + lq], dsk = p.in[21][g * 8 + h8];
#pragma unroll
            for (int st = 0; st < 8; ++st) {
                if (st <= w) {
                    const int s0 = 32 * st + 8 * hf;
#pragma unroll
                    for (int a2 = 0; a2 < 2; ++a2) {
                        const f32x4 d0 = *(const LAS f32x4*)(dtl + h8 * 256 + s0 + 16 * a2), d1 = *(const LAS f32x4*)(dtl + h8 * 256 + s0 + 16 * a2 + 4);
                        const f32x4 c0 = *(const LAS f32x4*)(csl + h8 * 256 + s0 + 16 * a2), c1 = *(const LAS f32x4*)(csl + h8 * 256 + s0 + 16 * a2 + 4);
                        const float dd[8] = {d0.x, d0.y, d0.z, d0.w, d1.x, d1.y, d1.z, d1.w}, cc[8] = {c0.x, c0.y, c0.z, c0.w, c1.x, c1.y, c1.z, c1.w};
                        const unsigned gw[4] = {gp[st][a2].x, gp[st][a2].y, gp[st][a2].z, gp[st][a2].w};
                        float m[8];
#pragma unroll
                        for (int j = 0; j < 8; ++j) { const int sidx = s0 + 16 * a2 + j;
                            const float gv = (j & 1) ? bfhi(gw[j >> 1]) : bflo(gw[j >> 1]);
                            float v = gv * dd[j] * __expf(fminf(cl - cc[j], 0.f));
                            if (st == w) { v = sidx > lq ? 0.f : v; v += sidx == lq ? dsk : 0.f; }
                            m[j] = v; }
                        u32x4 pw; pw.x = pk2(m[0], m[1]); pw.y = pk2(m[2], m[3]); pw.z = pk2(m[4], m[5]); pw.w = pk2(m[6], m[7]);
                        const bf16x8 pf = __builtin_bit_cast(bf16x8, pw);
                        const LAS unsigned char* xp = X.lds + sb + (4 * st + 2 * a2 + hf) * 1024 + ql * 16;
                        acc0 = __builtin_amdgcn_mfma_f32_32x32x16_bf16(*(const LAS bf16x8*)xp, pf, acc0, 0, 0, 0);
                        acc1 = __builtin_amdgcn_mfma_f32_32x32x16_bf16(*(const LAS bf16x8*)(xp + 512), pf, acc1, 0, 0, 0);
                        __builtin_amdgcn_sched_barrier(0);
                    }
                }
            }
            asm volatile("s_waitcnt vmcnt(0)" ::: "memory");
#pragma unroll
            for (int pt = 0; pt < 2; ++pt)
#pragma unroll
                for (int g4 = 0; g4 < 4; ++g4) {
                    const u32x2 z2 = *(const LAS u32x2*)(tac + (((4 * pt + g4) ^ (ql & 7)) * 16));
                    const float a0 = pt ? acc1[4 * g4] : acc0[4 * g4], a1 = pt ? acc1[4 * g4 + 1] : acc0[4 * g4 + 1], a2v = pt ? acc1[4 * g4 + 2] : acc0[4 * g4 + 2], a3 = pt ? acc1[4 * g4 + 3] : acc0[4 * g4 + 3];
                    const float v0 = a0 * silu_fast(bflo(z2.x)), v1 = a1 * silu_fast(bfhi(z2.x)), v2 = a2v * silu_fast(bflo(z2.y)), v3 = a3 * silu_fast(bfhi(z2.y));
                    ss += (v0 * v0 + v1 * v1) + (v2 * v2 + v3 * v3);
                    u32x2 o; o.x = pk2(v0, v1); o.y = pk2(v2, v3); *(LAS u32x2*)(tac + (((4 * pt + g4) ^ (ql & 7)) * 16)) = o;
                }
#pragma unroll
            for (int k = 0; k < 4; ++k) *(u32x4*)(yrow + h8 * 64 + 8 * k) = *(const LAS u32x4*)(trw + (((4 * (lane & 1) + k) ^ ((lane >> 1) & 7)) * 16));
        }
#undef S3_ISSUE
        ss += __shfl_xor(ss, 32);
        const float rs = rsqrtf(ss * (1.f / 512.f) + EPS);
        asm volatile("s_waitcnt vmcnt(0)" ::: "memory");
        {
            const int lf = fresh(lane);
            bf16_t* yb = (bf16_t*)(X.ws + WS_O) + (t0 + 32 * w) * SSM_INNER + g * 512 + 8 * lf;
            const f32x4 g0 = *(const f32x4*)(p.in[22] + g * 512 + 8 * lf), g1 = *(const f32x4*)(p.in[22] + g * 512 + 8 * lf + 4);
#pragma unroll 1
            for (int r0 = 0; r0 < 32; r0 += 8) {
                u32x4 q[8];
#pragma unroll
                for (int k = 0; k < 8; ++k) q[k] = *(const u32x4*)(yb + (size_t)(r0 + k) * SSM_INNER);
#pragma unroll
                for (int k = 0; k < 8; ++k) {
                    const float rk = __shfl(rs, r0 + k);
                    u32x4 o; o.x = pk2(bflo(q[k].x) * rk * g0.x, bfhi(q[k].x) * rk * g0.y); o.y = pk2(bflo(q[k].y) * rk * g0.z, bfhi(q[k].y) * rk * g0.w);
                    o.z = pk2(bflo(q[k].z) * rk * g1.x, bfhi(q[k].z) * rk * g1.y); o.w = pk2(bflo(q[k].w) * rk * g1.z, bfhi(q[k].w) * rk * g1.w);
                    *(u32x4*)(yb + (size_t)(r0 + k) * SSM_INNER) = o;
                }
            }
        }
        asm volatile("s_waitcnt lgkmcnt(0)\n\ts_barrier" ::: "memory");
    }
}

__device__ __forceinline__ void ph_moe_gu(const Params& p, const Ctx& X, int l) {
    moe_table(X, l);
    pg8::MoeOrder So{(const LAS int*)(X.lds + TAB_OFF), (const LAS int*)(X.lds + TAB_OFF) + 40, (const int*)(X.ws + WS_SLOT), 3, X.G, X.bid, true};
    pg8::Gemm g{(const bf16_t*)(X.ws + WS_U), (const bf16_t*)(X.ws + WS_WGU) + (size_t)l * NE * 2048 * 1024, 1024};
    pg8::EpiGu E{(bf16_t*)(X.ws + WS_ACT), p.in[27] + (size_t)l * NE * 2048};
    pg8::gemm_phase<pg8::EpiGu, pg8::MoeOrder>(X.lds, g, So, E, X.tid);
}
__device__ __forceinline__ void ph_moe_down(const Params& p, const Ctx& X, int l) {
    moe_table(X, l);
    pg8::MoeOrder So{(const LAS int*)(X.lds + TAB_OFF), (const LAS int*)(X.lds + TAB_OFF) + 40, (const int*)(X.ws + WS_SLOT), 2, X.G, X.bid, false};
    pg8::Gemm g{(const bf16_t*)(X.ws + WS_ACT), (const bf16_t*)(X.ws + WS_WDN) + (size_t)l * NE * 1024 * 1024, 1024};
    pg8::EpiDown E{(bf16_t*)(X.ws + WS_Y), p.in[29] + (size_t)l * NE * 1024};
    pg8::gemm_phase<pg8::EpiDown, pg8::MoeOrder>(X.lds, g, So, E, X.tid);
}

#ifndef PROBE_MASK
#define PROBE_MASK 0u
#endif
#ifndef PROBE_MULT
#define PROBE_MULT 8
#endif
__global__ void __launch_bounds__(NTHREADS, 2) fwd_kernel(Params p) {
    extern __shared__ __attribute__((aligned(16))) unsigned char lds_raw[];
    Ctx X;
    X.lds = (LAS unsigned char*)lds_raw; X.ws = p.ws;
    X.tid = threadIdx.x; X.lane = X.tid & 63; X.wave = __builtin_amdgcn_readfirstlane(X.tid >> 6);
    X.G = gridDim.x; X.bid = blockIdx.x; X.gw = X.bid * NWAVES + X.wave; X.ngw = X.G * NWAVES; X.sub = 0ull; X.subt = 0ull;
    if (X.tid < 4) ((LAS unsigned*)(X.lds + XB_OFF))[X.tid] = 0u;
    __syncthreads();
    XcdBarrier bar = xcd_barrier_post((unsigned*)(p.ws + WS_CTL) + CW_BAR, (volatile LAS unsigned*)(X.lds + XB_OFF));
#define PHASE_BEGIN Ctx Y = X; { GAS unsigned char* w_ = (GAS unsigned char*)p.ws; asm volatile("" : "+s"(w_)); Y.ws = (unsigned char*)w_; int t_ = threadIdx.x; asm volatile("" : "+v"(t_)); Y.tid = t_; Y.lane = t_ & 63; \
    Y.wave = __builtin_amdgcn_readfirstlane(t_ >> 6); Y.gw = Y.bid * NWAVES + Y.wave; }
#define WSF(off) ((float*)(Y.ws + (off)))
#define WSB(off) ((bf16_t*)(Y.ws + (off)))
#define PROBE_LDS(i) (((volatile LAS unsigned long long*)(X.lds + 150528))[2 * X.wave + (i)])
    if (PROBE_MASK || PROBE_SUB) { if (X.lane == 0) { PROBE_LDS(0) = __builtin_amdgcn_s_memrealtime(); PROBE_LDS(1) = 0ull; } }
#define PB(k) do { if (PROBE_MASK) { if (X.lane == 0) { const unsigned long long n_ = __builtin_amdgcn_s_memrealtime(); if ((PROBE_MASK >> (k)) & 1u) PROBE_LDS(1) += n_ - PROBE_LDS(0); PROBE_LDS(0) = n_; } } } while (0)
    { PHASE_BEGIN ph_prologue(p, Y); }                                    xcd_barrier(bar); PB(0);
    { PHASE_BEGIN ph_norm0(p, Y); }                                       xcd_barrier(bar); PB(1);
    {
        PHASE_BEGIN
        pg8::DenseOrder So; So.init(T, PROJ_LD, X.G, X.bid);
        pg8::Gemm g{WSB(WS_U), WSB(WS_WIN), 1024};
        pg8::EpiBf16 E{WSB(WS_BIG), PROJ_LD};
        pg8::gemm_phase<pg8::EpiBf16, pg8::DenseOrder>(X.lds, g, So, E, Y.tid);
    }
    {
        PHASE_BEGIN
        pg8::DenseOrder So; So.init(768, T, X.G, X.bid);
        pg8::Gemm g{WSB(WS_WV), WSB(WS_U), 1024};
        pg8::EpiBf16 E{WSB(WS_VT), T};
        pg8::gemm_phase<pg8::EpiBf16, pg8::DenseOrder>(X.lds, g, So, E, Y.tid);
    }
    xcd_barrier(bar); PB(2);
    { PHASE_BEGIN ph_attn_a(p, Y); }                                      xcd_barrier(bar); PB(3);
    { PHASE_BEGIN ph_nsa(p, Y); if (PROBE_SUB && X.lane == 0) PROBE_LDS(1) += Y.sub; }
    __syncthreads(); PB(19);
    { PHASE_BEGIN ph_sb(Y); if (PROBE_SUB && X.lane == 0) PROBE_LDS(1) += Y.sub; }                                             xcd_barrier(bar); PB(4);
    {
        PHASE_BEGIN
        pg8::DenseOrder So; So.init(T, D, X.G, X.bid);
        pg8::Gemm g{WSB(WS_O), WSB(WS_WOUT), 1024};
        pg8::EpiResid<false> E{p.in[0], WSB(WS_H1), WSF(WS_MODF) + 2048};
        pg8::gemm_phase<pg8::EpiResid<false>, pg8::DenseOrder>(X.lds, g, So, E, Y.tid);
    }
    xcd_barrier(bar); PB(5);
    { PHASE_BEGIN ph_token<0>(p, Y, 0, WSB(WS_H1), nullptr); if (PROBE_SUB && X.lane == 0) PROBE_LDS(1) += Y.sub; }                       xcd_barrier(bar); PB(6);
    { PHASE_BEGIN ph_moe_gu(p, Y, 0); }                                   xcd_barrier(bar); PB(7);
    { PHASE_BEGIN ph_moe_down(p, Y, 0); }                                 xcd_barrier(bar); PB(8);
    { PHASE_BEGIN ph_token<1>(p, Y, 0, WSB(WS_H1), WSB(WS_H2)); if (PROBE_SUB && X.lane == 0) PROBE_LDS(1) += Y.sub; }       xcd_barrier(bar); PB(9);
    {
        PHASE_BEGIN
        pg8::DenseOrder So; So.init(T, 3072, X.G, X.bid);
        pg8::Gemm g{WSB(WS_U), WSB(WS_WSIN), 1024};
        pg8::EpiBf16 E{WSB(WS_ZBC), 3072};
        pg8::gemm_phase<pg8::EpiBf16, pg8::DenseOrder>(X.lds, g, So, E, Y.tid);
    }
    {
        PHASE_BEGIN
        pg8::DenseOrder So; So.init(3072, T, X.G, X.bid);
        pg8::Gemm g{WSB(WS_WSIN) + (size_t)2048 * 1024, WSB(WS_U), 1024};
        pg8::EpiBf16 E{WSB(WS_XT), T};
        pg8::gemm_phase<pg8::EpiBf16, pg8::DenseOrder>(X.lds, g, So, E, Y.tid);
    }
    xcd_barrier(bar); PB(10);
    { PHASE_BEGIN ph_ssd1(p, Y); if (PROBE_SUB && X.lane == 0) PROBE_LDS(1) += Y.sub; }                                        xcd_barrier(bar); PB(11);
    { PHASE_BEGIN ph_ssd2(Y); }                                           xcd_barrier(bar); PB(12);
    { PHASE_BEGIN ph_ssd3(p, Y); if (PROBE_SUB && X.lane == 0) PROBE_LDS(1) += Y.sub; }                                        xcd_barrier(bar); PB(13);
    {
        PHASE_BEGIN
        pg8::DenseOrder So; So.init(T, D, X.G, X.bid);
        pg8::Gemm g{WSB(WS_O), WSB(WS_WSOUT), 2048};
        pg8::EpiResid<true> E{WSB(WS_H2), WSB(WS_H1), WSF(WS_MODF) + 4 * 6144 + 2048};
        pg8::gemm_phase<pg8::EpiResid<true>, pg8::DenseOrder>(X.lds, g, So, E, Y.tid);
    }
    xcd_barrier(bar); PB(14);
    { PHASE_BEGIN ph_token<0>(p, Y, 1, WSB(WS_H1), nullptr); if (PROBE_SUB && X.lane == 0) PROBE_LDS(1) += Y.sub; }                       xcd_barrier(bar); PB(15);
    { PHASE_BEGIN ph_moe_gu(p, Y, 1); }                                   xcd_barrier(bar); PB(16);
    { PHASE_BEGIN ph_moe_down(p, Y, 1); }                                 xcd_barrier(bar); PB(17);
    { PHASE_BEGIN ph_token<2>(p, Y, 1, WSB(WS_H1), p.out); if (PROBE_SUB && X.lane == 0) PROBE_LDS(1) += Y.sub; } PB(18);
    if (PROBE_MASK || PROBE_SUB) { asm volatile("s_waitcnt lgkmcnt(0)" ::: "memory"); const unsigned long long acc_ = PROBE_LDS(1); const unsigned long long t_end = __builtin_amdgcn_s_memrealtime() + (unsigned long long)PROBE_MULT * (unsigned long long)__builtin_amdgcn_readfirstlane((unsigned)acc_); while (__builtin_amdgcn_s_memrealtime() < t_end) __builtin_amdgcn_s_sleep(8); }
#undef PB
#undef PROBE_LDS
#undef PHASE_BEGIN
#undef WSF
#undef WSB
}
}

extern "C" void kernel_launch(void* const* d_in, const int* in_sizes, int n_in, void* d_out, int out_size, void* d_ws, size_t ws_size, hipStream_t stream) {
    static int grid = 0;
    if (grid == 0) {
        if (n_in != 30 || out_size != T * D || ws_size < WS_END) { fprintf(stderr, "kernel_launch: unexpected shapes / workspace (%d inputs, out %d, ws %zu < %zu)\n", n_in, out_size, ws_size, (size_t)WS_END); grid = -1; return; }
        int dev = 0, cus = 0, per_cu = 0;
        if (hipGetDevice(&dev) != hipSuccess || hipDeviceGetAttribute(&cus, hipDeviceAttributeMultiprocessorCount, dev) != hipSuccess) { grid = -1; return; }
        if (hipFuncSetAttribute((const void*)fwd_kernel, hipFuncAttributeMaxDynamicSharedMemorySize, LDS_BYTES) != hipSuccess) { fprintf(stderr, "kernel_launch: hipFuncSetAttribute failed\n"); grid = -1; return; }
        if (hipOccupancyMaxActiveBlocksPerMultiprocessor(&per_cu, (const void*)fwd_kernel, NTHREADS, LDS_BYTES) != hipSuccess || per_cu < 1) { fprintf(stderr, "kernel_launch: occupancy query reports %d\n", per_cu); }
        (void)hipGetLastError();
        grid = cus;
    }
    if (grid < 0) return;
    if (hipMemsetAsync((char*)d_ws + WS_CTL, 0, CTL_BYTES, stream) != hipSuccess) return;
    Params p{};
    for (int i = 0; i < 30; ++i) p.in[i] = (const float*)d_in[i];
    p.out = (float*)d_out; p.ws = (unsigned char*)d_ws;
    hipLaunchKernelGGL(fwd_kernel, dim3(grid), dim3(NTHREADS), LDS_BYTES, stream, p);
}
```

```cpp
#include <hip/hip_runtime.h>
#include <cstdio>
#include <cstdint>

#define LAS __attribute__((address_space(3)))
#ifndef PROBE_MASK
#define PROBE_MASK 0
#endif
#ifndef PROBE_SUB
#define PROBE_SUB 0
#endif
#define GAS __attribute__((address_space(1)))
typedef unsigned short bf16_t;
typedef short bf16x8 __attribute__((ext_vector_type(8)));
typedef float f32x4 __attribute__((ext_vector_type(4)));
typedef unsigned u32x4 __attribute__((ext_vector_type(4)));
typedef unsigned u32x2 __attribute__((ext_vector_type(2)));
typedef float f32x16 __attribute__((ext_vector_type(16)));

namespace {
constexpr int D = 1024, NB = 4, S = 4096, T = NB * S;
constexpr int ATTN_IN = 2840, PROJ_LD = 3072;
constexpr int OFF_SBQ = 0, OFF_SBK = 512, OFF_SBV = 1024, OFF_NQ = 1536, OFF_KC = 2048, OFF_VC = 2176, OFF_KS = 2304, OFF_VS = 2432,
              OFF_KW = 2560, OFF_VW = 2688, OFF_GATE = 2816;
constexpr int NCMP = 255;
constexpr int SSM_IN = 5152, SSM_INNER = 2048, CONV_DIM = 3072, ZX_LD = 5120;
constexpr int NE = 32, CAP = 16384, MAXTILES = 288;
constexpr float EPS = 1e-6f;
constexpr int NWAVES = 8, NTHREADS = 512;

constexpr size_t al4k(size_t x) { return (x + 4095) & ~(size_t)4095; }
constexpr size_t WS_CTL = 0, CTL_BYTES = 1u << 20;
constexpr int CW_CNT = 256;
constexpr int CW_BAR = 4096;
constexpr size_t CTL_MOD = 65536;
constexpr size_t WS_WIN = CTL_BYTES;
constexpr size_t WS_WOUT = WS_WIN + (size_t)3072 * 1024 * 2;
constexpr size_t WS_WSIN = WS_WOUT + (size_t)1024 * 1024 * 2;
constexpr size_t WS_WSOUT = WS_WSIN + (size_t)5120 * 1024 * 2;
constexpr size_t WS_WGU = WS_WSOUT + (size_t)1024 * 2048 * 2;
constexpr size_t WS_WDN = WS_WGU + (size_t)2 * 32 * 2048 * 1024 * 2;
constexpr size_t WS_U = WS_WDN + (size_t)2 * 32 * 1024 * 1024 * 2;
constexpr size_t WS_BIG = WS_U + (size_t)T * 1024 * 2;
constexpr size_t WS_O = WS_BIG + (size_t)T * 5120 * 2;
constexpr size_t WS_H1 = WS_O + (size_t)T * 2048 * 2;
constexpr size_t WS_H2 = WS_H1 + (size_t)T * 1024 * 4;
constexpr size_t WS_QN = WS_H2 + (size_t)T * 1024 * 4;
constexpr size_t WS_KN = WS_QN + (size_t)T * 512 * 4;
constexpr size_t WS_KCMP = WS_KN + (size_t)T * 256 * 4;
constexpr size_t WS_VCMP = WS_KCMP + al4k((size_t)NB * NCMP * 2 * 64 * 4);
constexpr size_t WS_ACT = WS_VCMP + al4k((size_t)NB * NCMP * 2 * 64 * 4);
constexpr size_t WS_Y = WS_ACT + (size_t)MAXTILES * 256 * 1024 * 2;
constexpr size_t WS_TOKE = WS_Y + (size_t)MAXTILES * 256 * 1024 * 2;
constexpr size_t WS_TOKW = WS_TOKE + (size_t)T * 16;
constexpr size_t WS_TOKP = WS_TOKW + (size_t)T * 16;
constexpr size_t WS_SLOT = WS_TOKP + (size_t)T * 16;
constexpr size_t WS_XC = WS_SLOT + (size_t)NE * CAP * 4;
constexpr size_t WS_YS = WS_XC + (size_t)T * 3072 * 4;
constexpr size_t WS_DT = WS_YS + (size_t)T * 2048 * 4;
constexpr size_t WS_MODF = WS_DT + (size_t)T * 32 * 4;
constexpr size_t WS_WV = WS_MODF + (size_t)2 * 4 * 6144 * 4;
constexpr size_t WS_VT = WS_WV + (size_t)768 * 1024 * 2;
constexpr size_t WS_QNB = WS_VT + (size_t)768 * T * 2;
constexpr size_t WS_KSN = WS_QNB + (size_t)T * 512 * 2;
constexpr size_t WS_KWN = WS_KSN + (size_t)T * 128 * 2;
constexpr size_t WS_KCB = WS_KWN + (size_t)T * 128 * 2;
constexpr size_t WS_VCT = WS_KCB + (size_t)8 * 256 * 64 * 2;
constexpr size_t WS_DT2 = WS_VCT + (size_t)8 * 64 * 256 * 2;
constexpr size_t WS_CS = WS_DT2 + (size_t)NB * 32 * S * 4;
constexpr size_t WS_DEC = WS_CS + (size_t)NB * 32 * S * 4;
constexpr size_t WS_W1T = WS_DEC + al4k((size_t)NB * 16 * 32 * 4);
constexpr size_t WS_SKW = WS_W1T + (size_t)2 * 128 * 2048 * 2;
constexpr size_t WS_ULO = WS_SKW + (size_t)3 * 2 * 32 * 1024 * 2;
constexpr size_t WS_END = WS_ULO + (size_t)T * 1024 * 2;
constexpr size_t WS_ZBC = WS_BIG, WS_XT = WS_XC, WS_XCT = WS_XC + (size_t)3072 * T * 2, WS_ST = WS_YS, WS_PB = WS_YS + (size_t)NB * 16 * 32 * 8192 * 4, WS_BCM = WS_QN;
static_assert(WS_XCT + (size_t)2560 * T * 2 <= WS_YS && WS_PB + (size_t)NB * 16 * 32 * 8192 * 2 <= WS_DT && (size_t)T * 1024 * 2 <= (size_t)T * 512 * 4, "layer-1 overlays");

constexpr int RING_BYTES = 131072;
constexpr int EXTRA_OFF = RING_BYTES;
constexpr int TAB_OFF = 151552;
constexpr int XB_OFF = 152576;
constexpr int LDS_BYTES = 153600;

struct Params { const float* in[30]; float* out; unsigned char* ws; };

__device__ __forceinline__ float siluf(float v) { return v / (1.f + expf(-v)); }
__device__ __forceinline__ float logsig(float x) { return fminf(x, 0.f) - log1pf(expf(-fabsf(x))); }
__device__ __forceinline__ float wave_sum(float v) {
#pragma unroll
    for (int o = 32; o > 0; o >>= 1) v += __shfl_xor(v, o);
    return v;
}
__device__ __forceinline__ float wave_max(float v) {
#pragma unroll
    for (int o = 32; o > 0; o >>= 1) v = fmaxf(v, __shfl_xor(v, o));
    return v;
}
__device__ __forceinline__ unsigned f2bf(float f) { unsigned u = __builtin_bit_cast(unsigned, f); return (u + 0x7fffu + ((u >> 16) & 1u)) >> 16; }
typedef float f32x2_t __attribute__((ext_vector_type(2))); typedef __bf16 bf16x2_t __attribute__((ext_vector_type(2)));
__device__ __forceinline__ unsigned pk2(float lo, float hi) { f32x2_t v = {lo, hi}; bf16x2_t b = __builtin_convertvector(v, bf16x2_t); return __builtin_bit_cast(unsigned, b); }
__device__ __forceinline__ float bf2f(bf16_t v) { return __uint_as_float((unsigned)v << 16); }
__device__ __forceinline__ float bflo(unsigned w) { return __uint_as_float(w << 16); }
__device__ __forceinline__ float bfhi(unsigned w) { return __uint_as_float(w & 0xffff0000u); }
#define LDS_WAIT() asm volatile("s_waitcnt lgkmcnt(0)" ::: "memory")
__device__ __forceinline__ int fresh(int v) { asm volatile("" : "+v"(v)); return v; }
__device__ __forceinline__ int sfresh(int v) { asm volatile("" : "+s"(v)); return v; }

#define XB_TMO      128
#define XB_XCNT(j)  (256  + 64 * (j))
#define XB_XSUB(j)  (1280 + 64 * (j))
#define XB_XGEN(j)  (2304 + 64 * (j))
#define XB_TOP      3328
#define XB_TOPGEN   3392
#define XCD_BAR_WORDS 3456
#define XB_SPIN_CAP (1u << 18)
__device__ __forceinline__ unsigned xb_ld(unsigned* p)              { return __hip_atomic_load(p, __ATOMIC_RELAXED, __HIP_MEMORY_SCOPE_AGENT); }
__device__ __forceinline__ unsigned xb_add(unsigned* p, unsigned v) { return __hip_atomic_fetch_add(p, v, __ATOMIC_RELAXED, __HIP_MEMORY_SCOPE_AGENT); }
__device__ __forceinline__ unsigned xb_xcc_id() { return (unsigned)__builtin_amdgcn_s_getreg((3 << 11) | 20) & 0xFu; }
#define XB_SPIN(cond, bar) do { unsigned _sp = 0; while (cond) { __builtin_amdgcn_s_sleep(1); \
    if ((++_sp & 255u) == 0u) { if (xb_ld(&(bar)[XB_TMO])) break; if (_sp > XB_SPIN_CAP) { atomicAdd(&(bar)[XB_TMO], 1u); break; } } } } while (0)
struct XcdBarrier { unsigned* bar; unsigned x; volatile LAS unsigned* st; };
__device__ __forceinline__ XcdBarrier xcd_barrier_post(unsigned* bar, volatile LAS unsigned* st) {
    XcdBarrier b; b.bar = bar; b.x = xb_xcc_id(); b.st = st;
    if (threadIdx.x == 0) (void)xb_add(&bar[XB_XCNT(b.x)], 1u);
    return b;
}
__device__ __forceinline__ void xcd_barrier_complete(unsigned* bar, unsigned x, unsigned& nloc, unsigned& nx) {
    const unsigned G = gridDim.x * gridDim.y * gridDim.z;
    unsigned sum, cnt, mine, sp = 0u;
    for (;;) {
        sum = 0u; cnt = 0u; mine = 0u;
#pragma unroll
        for (unsigned j = 0; j < 16; ++j) { const unsigned c = xb_ld(&bar[XB_XCNT(j)]); sum += c; cnt += (c > 0u) ? 1u : 0u; mine = (j == x) ? c : mine; }
        if (sum == G) break;
        __builtin_amdgcn_s_sleep(1);
        if ((++sp & 255u) == 0u) { if (xb_ld(&bar[XB_TMO])) break; if (sp > XB_SPIN_CAP) { atomicAdd(&bar[XB_TMO], 1u); break; } }
    }
    nloc = mine > 0u ? mine : 1u; nx = cnt > 0u ? cnt : 1u;
}
__device__ __forceinline__ void xcd_barrier(const XcdBarrier& b) {
    asm volatile("s_waitcnt vmcnt(0)" ::: "memory");
    __syncthreads();
    if (threadIdx.x == 0) {
        unsigned* bar = b.bar;
        __builtin_amdgcn_s_waitcnt(0);
        unsigned nloc = b.st[0], nx = b.st[1];
        if (nloc == 0u) { xcd_barrier_complete(bar, b.x, nloc, nx); b.st[0] = nloc; b.st[1] = nx; }
        const unsigned old = xb_add(&bar[XB_XSUB(b.x)], 1u);
        const unsigned gen = old / nloc;
        if (old + 1u == (gen + 1u) * nloc) {
            __builtin_amdgcn_fence(__ATOMIC_RELEASE, "agent");
            asm volatile("s_waitcnt vmcnt(0)" ::: "memory");
            const unsigned og = xb_add(&bar[XB_TOP], 1u);
            const unsigned tg = og / nx;
            if (og + 1u == (tg + 1u) * nx) xb_add(&bar[XB_TOPGEN], 1u);
            else XB_SPIN(xb_ld(&bar[XB_TOPGEN]) == tg, bar);
            __builtin_amdgcn_fence(__ATOMIC_ACQUIRE, "agent");
            xb_add(&bar[XB_XGEN(b.x)], 1u);
            asm volatile("s_waitcnt vmcnt(0)" ::: "memory");
        } else {
            XB_SPIN(xb_ld(&bar[XB_XGEN(b.x)]) == gen, bar);
            __builtin_amdgcn_fence(__ATOMIC_ACQUIRE, "agent");
            asm volatile("s_waitcnt vmcnt(0)" ::: "memory");
        }
    }
    __syncthreads();
}

namespace pg8 {
constexpr int BM = 256, BK = 64, HALF = 128, HTB = HALF * BK * 2, STAGE_BYTES = 8 * HTB;
__device__ __forceinline__ int lds_byte(int r, int c) { const int st = (r >> 4) * 2 + (c >> 5), rr = r & 15, cc = c & 31, ob = rr * 64 + cc * 2; return st * 1024 + (ob ^ (((ob >> 9) & 1) << 5)); }
__device__ __forceinline__ void stage_rc(int b, int& R, int& C) { const int st = b / 1024, sb = b % 1024, swz = sb ^ (((sb >> 9) & 1) << 5); R = (st >> 1) * 16 + swz / 64; C = (st & 1) * 32 + (swz % 64) / 2; }
__device__ __forceinline__ int perm32(int rho) { const int n = rho >> 4, i = rho & 15; return 8 * (i >> 2) + 4 * n + (i & 3); }
struct Unit { int pm, pn, e; };
struct Gemm { const bf16_t* A; const bf16_t* Bt; int K; };
__device__ __forceinline__ unsigned cvt_pk_bf16(float lo, float hi) { unsigned r; asm volatile("v_cvt_pk_bf16_f32 %0, %1, %2" : "=v"(r) : "v"(lo), "v"(hi)); return r; }

struct DenseOrder {
    int nM, nN, nwg, G, c;
    __device__ void init(int M, int N, int G_, int c_) { nM = M / BM; nN = N / BM; nwg = nM * nN; G = G_; c = c_; }
    __device__ bool next(int i, Unit& u) const {
        const long L = (long)i * G + c; if (L >= nwg) return false;
        int wgid = (int)L; { const int q = nwg / 8, r = nwg % 8, xcd = wgid % 8, off = wgid / 8; wgid = (xcd < r ? xcd * (q + 1) : r * (q + 1) + (xcd - r) * q) + off; }
        const int nig = 8 * nN, gid = wgid / nig, fm = gid * 8, gsz = (nM - fm) < 8 ? (nM - fm) : 8;
        u.pm = fm + ((wgid % nig) % gsz); u.pn = (wgid % nig) / gsz; u.e = 0; return true;
    }
    __device__ __forceinline__ unsigned arow(const Unit& u, int r) const { return (unsigned)(u.pm * BM + r); }
};
struct MoeOrder {
    const LAS int* tb; const LAS int* cn; const int* slot_tok; int shift, G, c; bool gather;
    __device__ bool next(int i, Unit& u) const {
        const int L = i * G + c, tile = L >> shift; if (tile >= tb[NE]) return false;
        int e = 0; while (tb[e + 1] <= tile) ++e;
        u.pm = tile; u.pn = (e << shift) + (L & ((1 << shift) - 1)); u.e = e; return true;
    }
    __device__ __forceinline__ unsigned arow(const Unit& u, int r) const {
        if (!gather) return (unsigned)(u.pm * BM + r);
        const int pos = (u.pm - tb[u.e]) * BM + r;
        return pos < cn[u.e] ? (unsigned)slot_tok[u.e * CAP + pos] : 0u;
    }
};

struct EpiBf16 {
    static constexpr bool PERM = true;
    bf16_t* O; int ldc;
    __device__ __forceinline__ void operator()(const f32x4 (&acc)[2][2][4][2], const Unit& u, int wr, int wc, int fr, int fq) const {
        const int row0 = u.pm * BM + wr * 64 + fr, col0 = u.pn * BM + wc * 32 + 8 * fq;
#pragma unroll
        for (int ai = 0; ai < 2; ++ai)
#pragma unroll
            for (int m = 0; m < 4; ++m) { bf16_t* rowp = O + (size_t)(row0 + ai * HALF + m * 16) * ldc + col0;
#pragma unroll
                for (int bj = 0; bj < 2; ++bj) { const f32x4 v0 = acc[ai][bj][m][0], v1 = acc[ai][bj][m][1];
                    u32x4 w; w.x = cvt_pk_bf16(v0[0], v0[1]); w.y = cvt_pk_bf16(v0[2], v0[3]); w.z = cvt_pk_bf16(v1[0], v1[1]); w.w = cvt_pk_bf16(v1[2], v1[3]);
                    *(u32x4*)(rowp + bj * HALF) = w; } }
    }
};
template <bool BASE_BF16>
struct EpiResid {
    static constexpr bool PERM = true;
    const void* base; bf16_t* out; const float* g;
    __device__ __forceinline__ void operator()(const f32x4 (&acc)[2][2][4][2], const Unit& u, int wr, int wc, int fr, int fq) const {
        const int row0 = u.pm * BM + wr * 64 + fr, col0 = u.pn * BM + wc * 32 + 8 * fq;
        const float* gb = g + (size_t)((u.pm * BM) / S) * 6144 + col0;
        f32x4 gv[2][2];
#pragma unroll
        for (int bj = 0; bj < 2; ++bj)
#pragma unroll
            for (int n = 0; n < 2; ++n) gv[bj][n] = *(const f32x4*)(gb + bj * HALF + n * 4);
#pragma unroll
        for (int ai = 0; ai < 2; ++ai) {
            f32x4 b0[4][2], b1[4][2];
#pragma unroll
            for (int m = 0; m < 4; ++m) { const size_t off = (size_t)(row0 + ai * HALF + m * 16) * D + col0;
#pragma unroll
                for (int bj = 0; bj < 2; ++bj) {
                    if (BASE_BF16) { const u32x4 q = *(const u32x4*)((const bf16_t*)base + off + bj * HALF); b0[m][bj] = (f32x4){bflo(q.x), bfhi(q.x), bflo(q.y), bfhi(q.y)}; b1[m][bj] = (f32x4){bflo(q.z), bfhi(q.z), bflo(q.w), bfhi(q.w)}; }
                    else { b0[m][bj] = *(const f32x4*)((const float*)base + off + bj * HALF); b1[m][bj] = *(const f32x4*)((const float*)base + off + bj * HALF + 4); } } }
            asm volatile("" ::: "memory");
#pragma unroll
            for (int m = 0; m < 4; ++m) { const size_t off = (size_t)(row0 + ai * HALF + m * 16) * D + col0;
#pragma unroll
                for (int bj = 0; bj < 2; ++bj) {
                    const f32x4 v0 = b0[m][bj] + gv[bj][0] * acc[ai][bj][m][0], v1 = b1[m][bj] + gv[bj][1] * acc[ai][bj][m][1];
                    u32x4 w; w.x = cvt_pk_bf16(v0[0], v0[1]); w.y = cvt_pk_bf16(v0[2], v0[3]); w.z = cvt_pk_bf16(v1[0], v1[1]); w.w = cvt_pk_bf16(v1[2], v1[3]);
                    *(u32x4*)(out + off + bj * HALF) = w; } }
        }
    }
};
struct EpiGu {
    static constexpr bool PERM = true;
    bf16_t* act; const float* bgu;
    __device__ __forceinline__ void operator()(const f32x4 (&acc)[2][2][4][2], const Unit& u, int wr, int wc, int fr, int fq) const {
        const int row0 = u.pm * BM + wr * 64 + fr, col0 = (u.pn & 7) * HALF + wc * 32 + 8 * fq;
        const float* bb = bgu + (size_t)u.e * 2048 + col0;
        const f32x4 bg0 = *(const f32x4*)(bb), bg1 = *(const f32x4*)(bb + 4), bu0 = *(const f32x4*)(bb + 1024), bu1 = *(const f32x4*)(bb + 1028);
#pragma unroll
        for (int ai = 0; ai < 2; ++ai)
#pragma unroll
            for (int m = 0; m < 4; ++m) {
                float r[8];
#pragma unroll
                for (int n = 0; n < 2; ++n) { const f32x4 gt = acc[ai][0][m][n] + (n ? bg1 : bg0), up = acc[ai][1][m][n] + (n ? bu1 : bu0);
#pragma unroll
                    for (int j = 0; j < 4; ++j) { const float gg = fminf(gt[j], 7.f), uu = fminf(fmaxf(up[j], -7.f), 7.f);
                        r[n * 4 + j] = (uu + 1.f) * gg * __builtin_amdgcn_rcpf(1.f + __expf(-1.702f * gg)); } }
                u32x4 w; w.x = cvt_pk_bf16(r[0], r[1]); w.y = cvt_pk_bf16(r[2], r[3]); w.z = cvt_pk_bf16(r[4], r[5]); w.w = cvt_pk_bf16(r[6], r[7]);
                *(u32x4*)(act + (size_t)(row0 + ai * HALF + m * 16) * D + col0) = w; }
    }
};
struct EpiDown {
    static constexpr bool PERM = true;
    bf16_t* y; const float* bd;
    __device__ __forceinline__ void operator()(const f32x4 (&acc)[2][2][4][2], const Unit& u, int wr, int wc, int fr, int fq) const {
        const int row0 = u.pm * BM + wr * 64 + fr, col0 = (u.pn & 3) * BM + wc * 32 + 8 * fq;
        const float* bb = bd + (size_t)u.e * 1024 + col0;
        f32x4 bv[2][2];
#pragma unroll
        for (int bj = 0; bj < 2; ++bj)
#pragma unroll
            for (int n = 0; n < 2; ++n) bv[bj][n] = *(const f32x4*)(bb + bj * HALF + 4 * n);
#pragma unroll
        for (int ai = 0; ai < 2; ++ai)
#pragma unroll
            for (int m = 0; m < 4; ++m) { bf16_t* rowp = y + (size_t)(row0 + ai * HALF + m * 16) * D + col0;
#pragma unroll
                for (int bj = 0; bj < 2; ++bj) { const f32x4 v0 = acc[ai][bj][m][0] + bv[bj][0], v1 = acc[ai][bj][m][1] + bv[bj][1];
                    u32x4 w; w.x = cvt_pk_bf16(v0[0], v0[1]); w.y = cvt_pk_bf16(v0[2], v0[3]); w.z = cvt_pk_bf16(v1[0], v1[1]); w.w = cvt_pk_bf16(v1[2], v1[3]);
                    *(u32x4*)(rowp + bj * HALF) = w; } }
    }
};

template <class Epi, class Sched>
__device__ __forceinline__ void gemm_phase(LAS unsigned char* lds, const Gemm g, const Sched& S, const Epi& E, const int tid) {
    const int wid = __builtin_amdgcn_readfirstlane(tid >> 6), lane = tid & 63, wr = wid >> 2, wc = wid & 3, fr = lane & 15, fq = lane >> 4;
    const int K = g.K, nt = K / BK;
    int RA[2], CA[2]; unsigned voffB[2];
#pragma unroll
    for (int i = 0; i < 2; ++i) { int R, C; stage_rc(tid * 16 + i * 8192, R, C); const int Rb = Epi::PERM ? ((R & ~31) + perm32(R & 31)) : R;
        RA[i] = R; CA[i] = C; voffB[i] = (unsigned)(Rb * K + C) * 2u; }
    const size_t kstep = (size_t)(BK * 2);
    const size_t hstep = (size_t)HALF * K * 2;
    const size_t tstep = 2 * hstep;
    const unsigned ldsw = (unsigned)wid * 1024u;
    const int aoff = lds_byte(wr * 64 + fr, fq * 8), boff = lds_byte(wc * 32 + fr, fq * 8);
#define PG8_SA(b, h) (((b) * 2 + (h)) * HTB)
#define PG8_SB(b, h) ((4 + (b) * 2 + (h)) * HTB)
#define PG8_STAGE(bufoff, gbase, voff) do { _Pragma("unroll") for (int _i = 0; _i < 2; ++_i) \
        __builtin_amdgcn_global_load_lds((const unsigned*)((const char*)(gbase) + (voff)[_i]), (LAS unsigned*)(lds + (bufoff) + ldsw + _i * 8192), 16, 0, 0); } while (0)
#define PG8_LDA(dst, b, h) do { _Pragma("unroll") for (int m = 0; m < 4; ++m) _Pragma("unroll") for (int k = 0; k < 2; ++k) dst[m][k] = *(const LAS bf16x8*)(lds + PG8_SA(b, h) + aoff + m * 2048 + k * 1024); } while (0)
#define PG8_LDB(dst, b, h) do { _Pragma("unroll") for (int n = 0; n < 2; ++n) _Pragma("unroll") for (int k = 0; k < 2; ++k) dst[n][k] = *(const LAS bf16x8*)(lds + PG8_SB(b, h) + boff + n * 2048 + k * 1024); } while (0)
#define PG8_MMA(ai, bj, At, Bt) do { __builtin_amdgcn_s_setprio(1); _Pragma("unroll") for (int m = 0; m < 4; ++m) _Pragma("unroll") for (int n = 0; n < 2; ++n) _Pragma("unroll") for (int k = 0; k < 2; ++k) \
        acc[ai][bj][m][n] = __builtin_amdgcn_mfma_f32_16x16x32_bf16(Bt[n][k], At[m][k], acc[ai][bj][m][n], 0, 0, 0); __builtin_amdgcn_s_setprio(0); } while (0)
#define PG8_WAIT_V(n) asm volatile("s_waitcnt vmcnt(" #n ")" ::: "memory")
#define PG8_WAIT_L(n) asm volatile("s_waitcnt lgkmcnt(" #n ")" ::: "memory")
#define PG8_BAR __builtin_amdgcn_s_barrier()
#define PG8_SCHED __builtin_amdgcn_sched_barrier(0)
#define PG8_AOFF(dst, u) do { _Pragma("unroll") for (int _h = 0; _h < 2; ++_h) _Pragma("unroll") for (int _i = 0; _i < 2; ++_i) dst[_h][_i] = (S.arow(u, _h * HALF + RA[_i]) * (unsigned)K + (unsigned)CA[_i]) * 2u; } while (0)
    Unit cur, nxt; int ui = 0;
    if (!S.next(0, cur)) return;
    f32x4 acc[2][2][4][2];
#pragma unroll
    for (int a = 0; a < 2; ++a)
#pragma unroll
        for (int b = 0; b < 2; ++b)
#pragma unroll
            for (int m = 0; m < 4; ++m)
#pragma unroll
                for (int n = 0; n < 2; ++n) acc[a][b][m][n] = (f32x4){0.f, 0.f, 0.f, 0.f};
    bf16x8 At[4][2], B0[2][2], B1[2][2];
    unsigned va[2][2], vn[2][2];
    PG8_AOFF(va, cur);
    const char* Ab = (const char*)g.A;
    const char* cB = (const char*)g.Bt + (size_t)cur.pn * tstep;
    PG8_STAGE(PG8_SB(0, 0), cB, voffB); PG8_STAGE(PG8_SB(0, 1), cB + hstep, voffB); PG8_STAGE(PG8_SA(0, 0), Ab, va[0]); PG8_STAGE(PG8_SA(0, 1), Ab, va[1]);
    if (wr == 1) PG8_BAR;
    PG8_WAIT_V(2); PG8_BAR;
    PG8_STAGE(PG8_SB(1, 0), cB + kstep, voffB); PG8_STAGE(PG8_SA(1, 0), Ab + kstep, va[0]); PG8_STAGE(PG8_SB(1, 1), cB + hstep + kstep, voffB);
    PG8_WAIT_V(6); PG8_BAR;
    for (;;) {
        const bool has_next = S.next(ui + 1, nxt);
        if (has_next) { PG8_AOFF(vn, nxt); }
        else {
#pragma unroll
            for (int h = 0; h < 2; ++h)
#pragma unroll
                for (int i = 0; i < 2; ++i) vn[h][i] = va[h][i]; }
        const char* nB = has_next ? (const char*)g.Bt + (size_t)nxt.pn * tstep : cB;
        for (int t = 0; t < nt; t += 2) {
            const bool last = (t == nt - 2);
            const char* a1 = Ab + (size_t)(t + 1) * kstep;
            const char* a2 = last ? Ab : Ab + (size_t)(t + 2) * kstep; const char* b2 = last ? nB : cB + (size_t)(t + 2) * kstep;
            const char* a3 = a2 + kstep; const char* b3 = b2 + kstep;
            unsigned o2[2][2];
#pragma unroll
            for (int h = 0; h < 2; ++h)
#pragma unroll
                for (int i = 0; i < 2; ++i) o2[h][i] = last ? vn[h][i] : va[h][i];
            PG8_LDB(B0, 0, 0); PG8_LDB(B1, 0, 1); PG8_SCHED; PG8_LDA(At, 0, 0); PG8_STAGE(PG8_SA(1, 1), a1, va[1]);
            PG8_WAIT_V(8); PG8_WAIT_L(0); PG8_BAR; PG8_MMA(0, 0, At, B0); PG8_MMA(0, 1, At, B1); PG8_BAR; PG8_SCHED;
            PG8_LDA(At, 0, 1); PG8_STAGE(PG8_SB(0, 0), b2, voffB); PG8_STAGE(PG8_SB(0, 1), b2 + hstep, voffB); PG8_STAGE(PG8_SA(0, 0), a2, o2[0]);
            PG8_WAIT_V(8); PG8_WAIT_L(0); PG8_BAR; PG8_MMA(1, 0, At, B0); PG8_MMA(1, 1, At, B1); PG8_BAR; PG8_SCHED;
            PG8_LDB(B0, 1, 0); PG8_LDB(B1, 1, 1); PG8_SCHED; PG8_LDA(At, 1, 0); PG8_STAGE(PG8_SA(0, 1), a2, o2[1]);
            PG8_WAIT_V(8); PG8_WAIT_L(0); PG8_BAR; PG8_MMA(0, 0, At, B0); PG8_MMA(0, 1, At, B1); PG8_BAR; PG8_SCHED;
            PG8_LDA(At, 1, 1); PG8_STAGE(PG8_SB(1, 0), b3, voffB); PG8_STAGE(PG8_SB(1, 1), b3 + hstep, voffB); PG8_STAGE(PG8_SA(1, 0), a3, o2[0]);
            PG8_WAIT_V(8); PG8_WAIT_L(0); PG8_BAR; PG8_MMA(1, 0, At, B0); PG8_MMA(1, 1, At, B1); PG8_BAR; PG8_SCHED;
        }
        if (wr == 0) PG8_BAR;
        E(acc, cur, wr, wc, fr, fq);
        if (!has_next) break;
#pragma unroll
        for (int a = 0; a < 2; ++a)
#pragma unroll
            for (int b = 0; b < 2; ++b)
#pragma unroll
                for (int m = 0; m < 4; ++m)
#pragma unroll
                    for (int n = 0; n < 2; ++n) acc[a][b][m][n] = (f32x4){0.f, 0.f, 0.f, 0.f};
        cur = nxt; cB = nB; ++ui;
#pragma unroll
        for (int h = 0; h < 2; ++h)
#pragma unroll
            for (int i = 0; i < 2; ++i) va[h][i] = vn[h][i];
        if (wr == 1) PG8_BAR;
    }
    PG8_WAIT_V(0);
    PG8_BAR;
#undef PG8_SA
#undef PG8_SB
#undef PG8_STAGE
#undef PG8_LDA
#undef PG8_LDB
#undef PG8_MMA
#undef PG8_WAIT_V
#undef PG8_WAIT_L
#undef PG8_BAR
#undef PG8_SCHED
#undef PG8_AOFF
}
}

struct Ctx {
    LAS unsigned char* lds; unsigned char* ws;
    int tid, lane, wave, gw, ngw, G, bid;
    mutable unsigned long long sub, subt;
};
#define SUB_BEGIN(X, id) do { if (PROBE_SUB == (id)) (X).subt = __builtin_amdgcn_s_memrealtime(); } while (0)
#define SUB_END(X, id) do { if (PROBE_SUB == (id)) (X).sub += __builtin_amdgcn_s_memrealtime() - (X).subt; } while (0)

__device__ __forceinline__ void transpose_item(const float* W, int ldw, int K, int nvalid, int k0, int n0, bf16_t* WT, int row0, LAS float* scr, int lane) {
    const int c4 = (lane & 7) * 4, kr = lane >> 3;
    f32x4 v[8];
#pragma unroll
    for (int i = 0; i < 8; ++i) v[i] = (n0 + c4 < nvalid) ? *(const f32x4*)(W + (size_t)(k0 + kr + 8 * i) * ldw + n0 + c4) : (f32x4){0.f, 0.f, 0.f, 0.f};
#pragma unroll
    for (int i = 0; i < 8; ++i) { LAS float* d = scr + (kr + 8 * i) * 33 + c4; d[0] = v[i].x; d[1] = v[i].y; d[2] = v[i].z; d[3] = v[i].w; }
    LDS_WAIT(); asm volatile("" ::: "memory");
    const int c = lane & 7;
#pragma unroll
    for (int j = 0; j < 4; ++j) { const int n = (lane >> 3) + 8 * j; const LAS float* s = scr + (8 * c) * 33 + n;
        u32x4 o; o.x = pk2(s[0 * 33], s[1 * 33]); o.y = pk2(s[2 * 33], s[3 * 33]); o.z = pk2(s[4 * 33], s[5 * 33]); o.w = pk2(s[6 * 33], s[7 * 33]);
        *(u32x4*)(WT + (size_t)(row0 + n) * K + k0 + 8 * c) = o; }
    LDS_WAIT(); asm volatile("" ::: "memory");
}
__device__ __forceinline__ void ph_prologue(const Params& p, const Ctx& X) {
    LAS float* scr = (LAS float*)(X.lds + X.wave * 16384);
    unsigned char* ws = X.ws;
    constexpr int I_MOD = 2 * 96 * 8;
    constexpr int I_SK = 3 * 16, I_W1 = 2 * 32 * 4, I_WIN = 16 * 96, I_WV = 16 * 24, I_WOUT = 16 * 32, I_WSIN = 16 * 160, I_WSOUT = 32 * 32;
    constexpr int NITEMS = I_MOD + I_SK + I_W1 + I_WIN + I_WV + I_WOUT + I_WSIN + I_WSOUT;
    for (int it = X.gw; it < NITEMS; it += X.ngw) {
        int r = it;
        if (r < I_MOD) {
            const int kp = r & 7, jb = (r >> 3) % 96, l = r / (8 * 96), j = jb * 64 + X.lane;
            const float* w = p.in[2] + (size_t)l * 1024 * 6144 + (size_t)(kp * 128) * 6144 + j;
            const float* c = p.in[1] + kp * 128;
            float a0 = 0.f, a1 = 0.f, a2 = 0.f, a3 = 0.f;
#pragma unroll 8
            for (int i = 0; i < 128; ++i) { const float wv = w[(size_t)i * 6144];
                a0 += siluf(c[i]) * wv; a1 += siluf(c[1024 + i]) * wv; a2 += siluf(c[2048 + i]) * wv; a3 += siluf(c[3072 + i]) * wv; }
            if (kp == 0) { const float bb = p.in[3][l * 6144 + j]; a0 += bb; a1 += bb; a2 += bb; a3 += bb; }
            unsigned long long* mq = (unsigned long long*)(ws + CTL_MOD) + (size_t)l * 4 * 6144 + j;
            atomicAdd(mq, (unsigned long long)__double2ll_rn((double)a0 * 1099511627776.0)); atomicAdd(mq + 6144, (unsigned long long)__double2ll_rn((double)a1 * 1099511627776.0));
            atomicAdd(mq + 2 * 6144, (unsigned long long)__double2ll_rn((double)a2 * 1099511627776.0)); atomicAdd(mq + 3 * 6144, (unsigned long long)__double2ll_rn((double)a3 * 1099511627776.0));
            continue;
        }
        r -= I_MOD;
        if (r < I_SK) {
            const int m = r >> 4, kb = r & 15, k0 = kb * 64;
            const float* W = m < 2 ? p.in[24] + (size_t)m * D * NE : p.in[16] + 5120; const int ldw = m < 2 ? NE : SSM_IN;
#pragma unroll 8
            for (int i = 0; i < 32; ++i) { const int kk = 2 * i + (X.lane >> 5); scr[kk * 33 + (X.lane & 31)] = W[(size_t)(k0 + kk) * ldw + (X.lane & 31)]; }
            LDS_WAIT(); asm volatile("" ::: "memory");
            const int c = X.lane & 7;
#pragma unroll
            for (int j = 0; j < 4; ++j) { const int n = (X.lane >> 3) + 8 * j; const LAS float* sp = scr + (8 * c) * 33 + n;
                float v[8]; unsigned hi[8];
#pragma unroll
                for (int q = 0; q < 8; ++q) { v[q] = sp[q * 33]; hi[q] = f2bf(v[q]); v[q] -= __uint_as_float(hi[q] << 16); }
                u32x4 oh, ol; oh.x = hi[0] | (hi[1] << 16); oh.y = hi[2] | (hi[3] << 16); oh.z = hi[4] | (hi[5] << 16); oh.w = hi[6] | (hi[7] << 16);
                ol.x = pk2(v[0], v[1]); ol.y = pk2(v[2], v[3]); ol.z = pk2(v[4], v[5]); ol.w = pk2(v[6], v[7]);
                bf16_t* dst = (bf16_t*)(ws + WS_SKW) + (size_t)m * 2 * 32 * 1024 + (size_t)n * 1024 + k0 + 8 * c;
                *(u32x4*)dst = oh; *(u32x4*)(dst + 32 * 1024) = ol; }
            LDS_WAIT(); asm volatile("" ::: "memory");
            continue; }
        r -= I_SK;
        if (r < I_W1) { const int kv = r >> 7, q = r & 127, kb = q >> 2, nb = q & 3;
            transpose_item(kv ? p.in[14] : p.in[12], 128, 2048, 128, kb * 64, nb * 32, (bf16_t*)(ws + WS_W1T) + (size_t)kv * 128 * 2048, nb * 32, scr, X.lane); continue; } r -= I_W1;
        if (r < I_WIN) { const int kb = r / 96, nb = r % 96; transpose_item(p.in[6], ATTN_IN, 1024, ATTN_IN, kb * 64, nb * 32, (bf16_t*)(ws + WS_WIN), nb * 32, scr, X.lane); continue; } r -= I_WIN;
        if (r < I_WV) { const int kb = r / 24, nb = r % 24, r0 = nb * 32, src = r0 < 512 ? OFF_SBV + r0 : (r0 < 640 ? OFF_VS + (r0 - 512) : OFF_VW + (r0 - 640));
            transpose_item(p.in[6], ATTN_IN, 1024, ATTN_IN, kb * 64, src, (bf16_t*)(ws + WS_WV), r0, scr, X.lane); continue; } r -= I_WV;
        if (r < I_WOUT) { const int kb = r / 32, nb = r % 32; transpose_item(p.in[7], 1024, 1024, 1024, kb * 64, nb * 32, (bf16_t*)(ws + WS_WOUT), nb * 32, scr, X.lane); continue; } r -= I_WOUT;
        if (r < I_WSIN) { const int kb = r / 160, nb = r % 160, n0 = nb * 32, row0 = n0 < 2048 ? n0 : (n0 < 4096 ? n0 + 1024 : n0 - 2048);
            transpose_item(p.in[16], SSM_IN, 1024, SSM_IN, kb * 64, n0, (bf16_t*)(ws + WS_WSIN), row0, scr, X.lane); continue; } r -= I_WSIN;
        { const int kb = r / 32, nb = r % 32; transpose_item(p.in[23], 1024, 2048, 1024, kb * 64, nb * 32, (bf16_t*)(ws + WS_WSOUT), nb * 32, scr, X.lane); }
    }
}

struct Row { f32x4 v[4]; };
__device__ __forceinline__ void row_load(Row& r, const float* p, int lane) {
#pragma unroll
    for (int j = 0; j < 4; ++j) r.v[j] = ((const f32x4*)p)[64 * j + lane];
}
__device__ __forceinline__ void row_load_bf16(Row& r, const bf16_t* p, int lane) {
#pragma unroll
    for (int j = 0; j < 4; ++j) { const u32x2 q = ((const u32x2*)p)[64 * j + lane]; r.v[j] = (f32x4){bflo(q.x), bfhi(q.x), bflo(q.y), bfhi(q.y)}; }
}
__device__ __forceinline__ void row_store(const Row& r, float* p, int lane) {
#pragma unroll
    for (int j = 0; j < 4; ++j) ((f32x4*)p)[64 * j + lane] = r.v[j];
}
template <class PV>
__device__ __forceinline__ void row_norm_mod(const Row& r, Row& o, const float* gain, PV sc, PV sh, int lane) {
    float ss = 0.f;
#pragma unroll
    for (int j = 0; j < 4; ++j) ss += (r.v[j].x * r.v[j].x + r.v[j].y * r.v[j].y) + (r.v[j].z * r.v[j].z + r.v[j].w * r.v[j].w);
    const float rs = rsqrtf(wave_sum(ss) * (1.f / 1024.f) + EPS);
#pragma unroll
    for (int j = 0; j < 4; ++j) { const f32x4 g = ((const f32x4*)gain)[64 * j + lane], a = sc[64 * j + lane], b = sh[64 * j + lane];
        o.v[j] = r.v[j] * rs * g * (a + 1.f) + b; }
}
__device__ __forceinline__ void row_store_bf16(const Row& r, bf16_t* p, int lane) {
#pragma unroll
    for (int j = 0; j < 4; ++j) { u32x2 w; w.x = pk2(r.v[j].x, r.v[j].y); w.y = pk2(r.v[j].z, r.v[j].w); ((u32x2*)p)[64 * j + lane] = w; }
}
__device__ __forceinline__ void row_store_lds(const Row& r, LAS float* p, int lane) {
#pragma unroll
    for (int j = 0; j < 4; ++j) ((LAS f32x4*)p)[64 * j + lane] = r.v[j];
}
__device__ __forceinline__ float modq2f(long long q) { return (float)((double)q * 9.094947017729282e-13); }
__device__ __forceinline__ void ph_norm0(const Params& p, const Ctx& X) {
    const long long* mq = (const long long*)(X.ws + CTL_MOD);
    float* modf = (float*)(X.ws + WS_MODF);
    for (int i = X.bid * NTHREADS + X.tid; i < 2 * 4 * 6144; i += X.G * NTHREADS) modf[i] = modq2f(mq[i]);
    LAS float* tab = (LAS float*)X.lds;
    for (int i = X.tid; i < 4 * 2048; i += NTHREADS) tab[i] = modq2f(mq[(size_t)(i >> 11) * 6144 + (i & 2047)]);
    __syncthreads();
    for (int t = X.gw; t < T; t += X.ngw) {
        Row r, o; row_load(r, p.in[0] + (size_t)t * D, X.lane);
        const LAS float* m = tab + (t / S) * 2048;
        row_norm_mod(r, o, p.in[4], (const LAS f32x4*)(m + 1024), (const LAS f32x4*)m, X.lane);
        row_store_bf16(o, (bf16_t*)(X.ws + WS_U) + (size_t)t * D, X.lane);
    }
}
__device__ __forceinline__ void route_select(float logit, int lane, LAS unsigned* lcnt, int& ev, float& wv, int& lpos) {
    const int e = lane & 31;
    float tl[4]; int te[4];
#pragma unroll
    for (int k = 0; k < 4; ++k) {
        float bv = logit; int bi = e;
#pragma unroll
        for (int o = 16; o > 0; o >>= 1) { const float ov = __shfl_xor(bv, o); const int oi = __shfl_xor(bi, o); if (ov > bv || (ov == bv && oi < bi)) { bv = ov; bi = oi; } }
        tl[k] = bv; te[k] = bi;
        if (e == bi) logit = -INFINITY;
    }
    ev = 0; wv = 0.f; lpos = 0;
    if (e < 4) {
        const float e1 = expf(tl[1] - tl[0]), e2 = expf(tl[2] - tl[0]), e3 = expf(tl[3] - tl[0]);
        const float inv = 1.f / (1.f + e1 + e2 + e3);
        wv = (e == 0 ? 1.f : e == 1 ? e1 : e == 2 ? e2 : e3) * inv;
        ev = e == 0 ? te[0] : e == 1 ? te[1] : e == 2 ? te[2] : te[3];
        lpos = (int)__hip_atomic_fetch_add(&lcnt[ev], 1u, __ATOMIC_RELAXED, __HIP_MEMORY_SCOPE_WORKGROUP);
    }
}
__device__ __forceinline__ void moe_table(const Ctx& X, int l) {
    LAS int* tb = (LAS int*)(X.lds + TAB_OFF);
    if (X.wave == 0) {
        const unsigned* cnt = (const unsigned*)(X.ws + WS_CTL) + CW_CNT + l * 32 * 32;
        const int e = X.lane & 31;
        const int c = (int)__hip_atomic_load(cnt + e * 32, __ATOMIC_RELAXED, __HIP_MEMORY_SCOPE_AGENT), nt = (c + 255) >> 8;
        int incl = nt;
#pragma unroll
        for (int o = 1; o < 32; o <<= 1) { const int u = __shfl_up(incl, o); if (e >= o) incl += u; }
        if (X.lane < 32) { tb[e] = incl - nt; tb[40 + e] = c; if (e == 31) tb[NE] = incl; }
    }
    __syncthreads();
}
template <int MODE>
__device__ __forceinline__ void ph_token(const Params& p, const Ctx& X, int l, const bf16_t* h, void* hn) {
    if (MODE != 0) moe_table(X, l);
    const LAS int* tb = (const LAS int*)(X.lds + TAB_OFF);
    const float* modl = (const float*)(X.ws + WS_MODF) + (size_t)l * 4 * 6144;
    const float* modn = (const float*)(X.ws + WS_MODF) + (size_t)(MODE == 1 ? 1 : l) * 4 * 6144;
    const float* gain = MODE == 1 ? p.in[4] + D : p.in[5] + l * D;
    const int sc_off = MODE == 1 ? 1024 : 4096, sh_off = MODE == 1 ? 0 : 3072;
    const bf16_t* y = (const bf16_t*)(X.ws + WS_Y);
    LAS float* rsl = (LAS float*)X.lds;
    LAS float* part = (LAS float*)(X.lds + 1024);
    if (MODE == 0 && X.tid < 32) ((LAS unsigned*)(X.lds + 1024 + 65536))[X.tid] = 0u;
    for (int tile = X.bid; tile < T / 64; tile += X.G) {
        const int lane = fresh(X.lane), w = X.wave, tb0 = tile * 64, bb = tb0 / S;
        SUB_BEGIN(X, 31);
        Row ca_, cb_, cg_;
        { const float* m = modn + (size_t)bb * 6144;
#pragma unroll
          for (int j = 0; j < 4; ++j) { if (MODE != 2) { const f32x4 g = ((const f32x4*)gain)[64 * j + lane], a = ((const f32x4*)(m + sc_off))[64 * j + lane]; ca_.v[j] = g * (a + 1.f); cb_.v[j] = ((const f32x4*)(m + sh_off))[64 * j + lane]; }
                                        if (MODE != 0) cg_.v[j] = ((const f32x4*)(modl + (size_t)bb * 6144 + 5120))[64 * j + lane]; } }
        int pe_ = 0, pp_ = 0; float pw_ = 0.f;
        if (MODE != 0 && lane < 32) { const int idx = (tb0 + 8 * w) * 4 + lane; pe_ = ((const int*)(X.ws + WS_TOKE))[idx]; pp_ = ((const int*)(X.ws + WS_TOKP))[idx]; pw_ = ((const float*)(X.ws + WS_TOKW))[idx]; }
#pragma unroll 1
        for (int k2 = 0; k2 < 4; ++k2) {
            Row r[2];
#pragma unroll
            for (int u = 0; u < 2; ++u) row_load_bf16(r[u], h + (size_t)(tb0 + 8 * w + 2 * k2 + u) * D, lane);
            if (MODE != 0) {
#pragma unroll
                for (int u = 0; u < 2; ++u) {
#pragma unroll
                    for (int kk = 0; kk < 4; ++kk) {
                        const int sl = (2 * k2 + u) * 4 + kk;
                        const int e = __shfl(pe_, sl), pos = __shfl(pp_, sl); const float wt = __shfl(pw_, sl);
                        const bf16_t* yr = y + (size_t)(tb[e] * 256 + pos) * D;
#pragma unroll
                        for (int j = 0; j < 4; ++j) { const u32x2 q = ((const u32x2*)yr)[64 * j + lane]; const f32x4 gw = cg_.v[j] * wt;
                            r[u].v[j].x += gw.x * bflo(q.x); r[u].v[j].y += gw.y * bfhi(q.x); r[u].v[j].z += gw.z * bflo(q.y); r[u].v[j].w += gw.w * bfhi(q.y); }
                    }
                    if (MODE == 2) row_store(r[u], (float*)hn + (size_t)(tb0 + 8 * w + 2 * k2 + u) * D, lane); else row_store_bf16(r[u], (bf16_t*)hn + (size_t)(tb0 + 8 * w + 2 * k2 + u) * D, lane);
                    __builtin_amdgcn_sched_barrier(0);
                }
            }
            if (MODE != 2) {
#pragma unroll
                for (int u = 0; u < 2; ++u) {
                    float ssq = 0.f;
#pragma unroll
                    for (int j = 0; j < 4; ++j) ssq += (r[u].v[j].x * r[u].v[j].x + r[u].v[j].y * r[u].v[j].y) + (r[u].v[j].z * r[u].v[j].z + r[u].v[j].w * r[u].v[j].w);
                    const float rs = rsqrtf(wave_sum(ssq) * (1.f / 1024.f) + EPS);
                    bf16_t* uh = (bf16_t*)(X.ws + WS_U) + (size_t)(tb0 + 8 * w + 2 * k2 + u) * D;
#pragma unroll
                    for (int j = 0; j < 4; ++j) { const f32x4 o = r[u].v[j] * rs * ca_.v[j] + cb_.v[j];
                        u32x2 hi; hi.x = pk2(o.x, o.y); hi.y = pk2(o.z, o.w); ((u32x2*)uh)[64 * j + lane] = hi; }
                }
            }
        }
        SUB_END(X, 31);
        if (MODE == 2) continue;
        SUB_BEGIN(X, 32);
        __syncthreads();
        {
            const int ql = lane & 31, hf = lane >> 5;
            const bf16_t* wh = (const bf16_t*)(X.ws + WS_SKW) + (size_t)(MODE == 0 ? l : 2) * 2 * 32 * 1024 + (size_t)ql * 1024 + 128 * w + 8 * hf;
            const bf16_t* uh = (const bf16_t*)(X.ws + WS_U) + (size_t)(tb0 + ql) * D + 128 * w + 8 * hf;
            f32x16 acc0, acc1;
#pragma unroll
            for (int i = 0; i < 16; ++i) { acc0[i] = 0.f; acc1[i] = 0.f; }
#pragma unroll
            for (int ks = 0; ks < 8; ++ks) {
                const bf16x8 whi = *(const bf16x8*)(wh + 16 * ks), wlo = *(const bf16x8*)(wh + 32 * 1024 + 16 * ks);
                const bf16x8 ah0 = *(const bf16x8*)(uh + 16 * ks), ah1 = *(const bf16x8*)(uh + 32 * D + 16 * ks);
                acc0 = __builtin_amdgcn_mfma_f32_32x32x16_bf16(ah0, whi, acc0, 0, 0, 0); acc0 = __builtin_amdgcn_mfma_f32_32x32x16_bf16(ah0, wlo, acc0, 0, 0, 0);
                acc1 = __builtin_amdgcn_mfma_f32_32x32x16_bf16(ah1, whi, acc1, 0, 0, 0); acc1 = __builtin_amdgcn_mfma_f32_32x32x16_bf16(ah1, wlo, acc1, 0, 0, 0);
            }
#pragma unroll
            for (int i = 0; i < 16; ++i) { const int row = 8 * (i >> 2) + 4 * hf + (i & 3); part[(w * 64 + row) * 32 + ql] = acc0[i]; part[(w * 64 + 32 + row) * 32 + ql] = acc1[i]; }
        }
        __syncthreads();
        SUB_END(X, 32);
        SUB_BEGIN(X, 33);
        {
            const int e = lane & 31, hf = lane >> 5;
            LAS unsigned* lcnt = (LAS unsigned*)(X.lds + 1024 + 65536);
            int ev[4], lp[4]; float wv[4];
#pragma unroll
            for (int k = 0; k < 4; ++k) {
                const int tl = 8 * w + 4 * hf + k;
                float v = 0.f;
#pragma unroll
                for (int ww = 0; ww < 8; ++ww) v += part[(ww * 64 + tl) * 32 + e];
                if (MODE == 0) route_select(v + p.in[25][l * NE + e], lane, lcnt, ev[k], wv[k], lp[k]);
                else ((float*)(X.ws + WS_DT))[(size_t)(tb0 + tl) * 32 + e] = v;
            }
            if (MODE == 0) {
                __syncthreads();
                if (X.tid < 32) { const unsigned n = lcnt[X.tid]; unsigned* cnt = (unsigned*)(X.ws + WS_CTL) + CW_CNT + (l * 32 + X.tid) * 32;
                    lcnt[32 + X.tid] = n ? atomicAdd(cnt, n) : 0u; }
                __syncthreads();
                if (e < 4) {
#pragma unroll
                    for (int k = 0; k < 4; ++k) { const int t = tb0 + 8 * w + 4 * hf + k, pos = (int)lcnt[32 + ev[k]] + lp[k];
                        ((int*)(X.ws + WS_TOKE))[t * 4 + e] = ev[k]; ((float*)(X.ws + WS_TOKW))[t * 4 + e] = wv[k]; ((int*)(X.ws + WS_TOKP))[t * 4 + e] = pos;
                        ((int*)(X.ws + WS_SLOT))[ev[k] * CAP + pos] = t; }
                }
            }
        }
        __syncthreads();
        SUB_END(X, 33);
        if (MODE == 0 && X.tid < 32) ((LAS unsigned*)(X.lds + 1024 + 65536))[X.tid] = 0u;
    }
}

__device__ __forceinline__ void ld64bf(const bf16_t* p, float (&q)[64]) {
#pragma unroll
    for (int i = 0; i < 8; ++i) { const u32x4 w = ((const u32x4*)p)[i];
        q[8 * i] = bflo(w.x); q[8 * i + 1] = bfhi(w.x); q[8 * i + 2] = bflo(w.y); q[8 * i + 3] = bfhi(w.y); q[8 * i + 4] = bflo(w.z); q[8 * i + 5] = bfhi(w.z); q[8 * i + 6] = bflo(w.w); q[8 * i + 7] = bfhi(w.w); }
}
__device__ __forceinline__ float dot64bf(const bf16_t* p, const float (&q)[64]) {
    float d = 0.f;
#pragma unroll
    for (int i = 0; i < 8; ++i) { const u32x4 w = ((const u32x4*)p)[i];
        d += q[8 * i] * bflo(w.x) + q[8 * i + 1] * bfhi(w.x) + q[8 * i + 2] * bflo(w.y) + q[8 * i + 3] * bfhi(w.y) + q[8 * i + 4] * bflo(w.z) + q[8 * i + 5] * bfhi(w.z) + q[8 * i + 6] * bflo(w.w) + q[8 * i + 7] * bfhi(w.w); }
    return d;
}
__device__ __forceinline__ float dot64f(const float* p, const float (&q)[64]) {
    float d = 0.f;
#pragma unroll
    for (int i = 0; i < 16; ++i) { const f32x4 w = ((const f32x4*)p)[i]; d += (q[4 * i] * w.x + q[4 * i + 1] * w.y) + (q[4 * i + 2] * w.z + q[4 * i + 3] * w.w); }
    return d;
}
__device__ __forceinline__ void sb_unit(const Ctx& X, int qt, int bh) {
    const int b = bh >> 3, hh = bh & 7, t = qt * 64 + X.lane;
    const bf16_t* base = (const bf16_t*)(X.ws + WS_BIG) + (size_t)b * S * PROJ_LD;
    float q[64], acc[64];
    ld64bf(base + (size_t)t * PROJ_LD + OFF_SBQ + hh * 64, q);
#pragma unroll
    for (int d = 0; d < 64; ++d) acc[d] = 0.f;
    float run = 0.f;
    for (int j = qt * 64 + 62; j >= 0; --j) {
        const bf16_t* kr = base + (size_t)j * PROJ_LD + OFF_SBK + hh * 64;
        const float logit = dot64bf(kr, q) * 0.125f;
        if (j < t) {
            const float w = expf(logsig(logit) + run);
            run += logsig(-logit);
            const bf16_t* vr = base + (size_t)j * PROJ_LD + OFF_SBV + hh * 64;
#pragma unroll
            for (int i = 0; i < 8; ++i) { const u32x4 v = ((const u32x4*)vr)[i];
                acc[8 * i] += w * bflo(v.x); acc[8 * i + 1] += w * bfhi(v.x); acc[8 * i + 2] += w * bflo(v.y); acc[8 * i + 3] += w * bfhi(v.y);
                acc[8 * i + 4] += w * bflo(v.z); acc[8 * i + 5] += w * bfhi(v.z); acc[8 * i + 6] += w * bflo(v.w); acc[8 * i + 7] += w * bfhi(v.w); }
        }
    }
    bf16_t* op = (bf16_t*)(X.ws + WS_O) + (size_t)(b * S + t) * D + hh * 64;
#pragma unroll
    for (int i = 0; i < 8; ++i) { u32x4 w; w.x = pk2(acc[8 * i], acc[8 * i + 1]); w.y = pk2(acc[8 * i + 2], acc[8 * i + 3]); w.z = pk2(acc[8 * i + 4], acc[8 * i + 5]); w.w = pk2(acc[8 * i + 6], acc[8 * i + 7]);
        ((u32x4*)op)[i] = w; }
}

#define DMA16(gptr, ldsptr) __builtin_amdgcn_global_load_lds((const unsigned*)(gptr), (LAS unsigned*)(ldsptr), 16, 0, 0)
#define RING2_WAIT_BAR(q, nb) do { const int issued_ = (q) + 6 < (nb) ? (q) + 6 : (nb); const int need_ = (q) + 2 < (nb) ? (q) + 2 : (nb); const int fl_ = issued_ - need_; \
        if (fl_ >= 4) asm volatile("s_waitcnt vmcnt(8)\n\ts_barrier" ::: "memory"); else if (fl_ == 3) asm volatile("s_waitcnt vmcnt(6)\n\ts_barrier" ::: "memory"); \
        else if (fl_ == 2) asm volatile("s_waitcnt vmcnt(4)\n\ts_barrier" ::: "memory"); else if (fl_ == 1) asm volatile("s_waitcnt vmcnt(2)\n\ts_barrier" ::: "memory"); \
        else asm volatile("s_waitcnt vmcnt(0)\n\ts_barrier" ::: "memory"); } while (0)
#define RING6_WAIT_BAR(q, nb) do { const int issued_ = (q) + 4 < (nb) ? (q) + 4 : (nb); const int need_ = (q) + 2 < (nb) ? (q) + 2 : (nb); const int fl_ = issued_ - need_; \
        if (fl_ >= 2) asm volatile("s_waitcnt vmcnt(4)\n\ts_barrier" ::: "memory"); else if (fl_ == 1) asm volatile("s_waitcnt vmcnt(2)\n\ts_barrier" ::: "memory"); \
        else asm volatile("s_waitcnt vmcnt(0)\n\ts_barrier" ::: "memory"); } while (0)
constexpr int CV_NITEMS = 64 * 1024 + 64 * 512;
constexpr int CV_SCR = 6 * 16384, CV_ROW = 72;
struct Conv { int it, step, stage; const float* src; bf16_t* dst; int ldw; f32x4 v[4]; };
struct ConvCur { int it, step; };
__device__ __forceinline__ void conv_init(Conv& c, const ConvCur& cur) { c.it = cur.it; c.step = cur.step; c.stage = 0; c.src = nullptr; c.dst = nullptr; c.ldw = 0; }
__device__ __forceinline__ void conv_rows_to_lds(const Conv& c, LAS unsigned char* scr, int lane, int half) {
    const int c4 = (lane & 7) * 4, kr = lane >> 3;
#pragma unroll
    for (int i = 0; i < 4; ++i) { u32x2 h; h.x = pk2(c.v[i].x, c.v[i].y); h.y = pk2(c.v[i].z, c.v[i].w); *(LAS u32x2*)(scr + (32 * half + kr + 8 * i) * CV_ROW + c4 * 2) = h; }
}
__device__ __forceinline__ void conv_load_rows(Conv& c, int lane, int half) {
    const int c4 = (lane & 7) * 4, kr = lane >> 3;
#pragma unroll
    for (int i = 0; i < 4; ++i) c.v[i] = *(const f32x4*)(c.src + (size_t)(32 * half + kr + 8 * i) * c.ldw + c4);
}
__device__ __forceinline__ void conv_even(Conv& c, const Params& p, unsigned char* ws, LAS unsigned char* scr, int lane, bool start) {
    if (c.stage == 2) {
        asm volatile("s_waitcnt vmcnt(0)" ::: "memory");
        conv_rows_to_lds(c, scr, lane, 1);
        LDS_WAIT(); asm volatile("" ::: "memory");
        const int cc = lane & 7;
#pragma unroll 1
        for (int j = 0; j < 4; ++j) { const int n = (lane >> 3) + 8 * j; const LAS unsigned short* sp = (const LAS unsigned short*)(scr + (8 * cc) * CV_ROW + 2 * n);
            u32x4 o; o.x = (unsigned)sp[0] | ((unsigned)sp[CV_ROW / 2] << 16); o.y = (unsigned)sp[2 * (CV_ROW / 2)] | ((unsigned)sp[3 * (CV_ROW / 2)] << 16);
            o.z = (unsigned)sp[4 * (CV_ROW / 2)] | ((unsigned)sp[5 * (CV_ROW / 2)] << 16); o.w = (unsigned)sp[6 * (CV_ROW / 2)] | ((unsigned)sp[7 * (CV_ROW / 2)] << 16);
            *(u32x4*)(c.dst + (size_t)n * 1024 + 8 * cc) = o; }
        LDS_WAIT(); asm volatile("" ::: "memory");
        c.stage = 0;
    }
    if (start && c.it < CV_NITEMS) {
        const int r = c.it; c.it += c.step;
        if (r < 65536) { const int m = r >> 10, q = r & 1023, kb = q >> 6, n0 = (q & 63) * 32, row0 = ((n0 & 1023) >> 7) * 256 + (n0 >> 10) * 128 + (n0 & 127);
            c.src = p.in[26] + (size_t)m * 1024 * 2048 + (size_t)(kb * 64) * 2048 + n0; c.ldw = 2048; c.dst = (bf16_t*)(ws + WS_WGU) + (size_t)m * 2048 * 1024 + (size_t)row0 * 1024 + kb * 64; }
        else { const int r2 = r - 65536, m = r2 >> 9, q = r2 & 511, kb = q >> 5, n0 = (q & 31) * 32;
            c.src = p.in[28] + (size_t)m * 1024 * 1024 + (size_t)(kb * 64) * 1024 + n0; c.ldw = 1024; c.dst = (bf16_t*)(ws + WS_WDN) + (size_t)m * 1024 * 1024 + (size_t)n0 * 1024 + kb * 64; }
        conv_load_rows(c, lane, 0);
        c.stage = 1;
    }
}
__device__ __forceinline__ void conv_odd(Conv& c, LAS unsigned char* scr, int lane) {
    if (c.stage == 1) {
        asm volatile("s_waitcnt vmcnt(0)" ::: "memory");
        conv_rows_to_lds(c, scr, lane, 0);
        conv_load_rows(c, lane, 1);
        c.stage = 2;
    }
}
__device__ __forceinline__ int pi32(int r) { return (r & 0x13) | ((r & 4) << 1) | ((r & 8) >> 1); }
__device__ __forceinline__ void sb_attn_unit(const Params& p, const Ctx& X, ConvCur& cur, int bh, int qb) {
    Conv cv; conv_init(cv, cur);
    const int b = bh >> 3, h = bh & 7, q0 = qb * 256, lane = fresh(X.lane), w = X.wave, ql = lane & 31, hf = lane >> 5;
    const bf16_t* proj = (const bf16_t*)(X.ws + WS_BIG) + (size_t)b * S * PROJ_LD;
    const bf16_t* vt = (const bf16_t*)(X.ws + WS_VT) + (size_t)(h * 64) * T + (size_t)b * S;
    const int tq = q0 + 32 * w + ql;
    bf16x8 qf[4];
#pragma unroll
    for (int s = 0; s < 4; ++s) qf[s] = *(const bf16x8*)(proj + (size_t)tq * PROJ_LD + OFF_SBQ + h * 64 + 16 * s + 8 * hf);
    f32x16 o0, o1;
#pragma unroll
    for (int i = 0; i < 16; ++i) { o0[i] = 0.f; o1[i] = 0.f; }
    float run = 1.f;
    const int nblk = 4 * qb + 4, jw = (q0 + 32 * w + 30) >> 6;
    const float CS = 0.125f * 1.4426950408889634f;
    const bf16_t* kg = proj + (size_t)lane * PROJ_LD + OFF_SBK + h * 64 + 8 * w;
    const bf16_t* vg = vt + (size_t)lane * T + 8 * w;
    LAS unsigned char* ring = X.lds + w * 1024;
    const int krow = pi32(ql) * 16;
    asm volatile("s_waitcnt vmcnt(0)" ::: "memory");
    LAS unsigned char* cscr = X.lds + CV_SCR + w * (64 * CV_ROW);
#pragma unroll
    for (int d = 0; d < 4; ++d) if (d < nblk) { DMA16(kg + (size_t)(64 * (nblk - 1 - d)) * PROJ_LD, ring + d * 16384); DMA16(vg + 64 * (nblk - 1 - d), ring + d * 16384 + 8192); }
    int slot = 0, islot = 4;
    for (int q = 0; q < nblk; ++q) {
        const int j = nblk - 1 - q;
        if ((q & 1) == 0) {
            SUB_BEGIN(X, 11);
            RING6_WAIT_BAR(q, nblk);
            SUB_END(X, 11);
            conv_even(cv, p, X.ws, cscr, lane, q + 2 < nblk);
#pragma unroll
            for (int d = 4; d < 6; ++d) if (q + d < nblk) { const int jj = nblk - 1 - (q + d); DMA16(kg + (size_t)(64 * jj) * PROJ_LD, ring + islot * 16384); DMA16(vg + 64 * jj, ring + islot * 16384 + 8192); islot = islot == 5 ? 0 : islot + 1; }
        } else conv_odd(cv, cscr, lane);
        LAS unsigned char* buf = X.lds + slot * 16384; slot = slot == 5 ? 0 : slot + 1;
        SUB_BEGIN(X, 12);
        if (j <= jw) {
            const bool diag = 64 * j + 63 >= q0 + 32 * w;
#pragma unroll
            for (int kt = 1; kt >= 0; --kt) {
                f32x16 sc;
#pragma unroll
                for (int i = 0; i < 16; ++i) sc[i] = 0.f;
#pragma unroll
                for (int s = 0; s < 4; ++s) { const bf16x8 kf = *(const LAS bf16x8*)(buf + (2 * s + hf) * 1024 + kt * 512 + krow); sc = __builtin_amdgcn_mfma_f32_32x32x16_bf16(kf, qf[s], sc, 0, 0, 0); }
                f32x16 ee = sc * (-CS), be, kp;
#pragma unroll
                for (int i = 0; i < 16; ++i) ee[i] = __builtin_amdgcn_exp2f(ee[i]);
                be = ee + 1.f;
#pragma unroll
                for (int i = 0; i < 16; ++i) be[i] = __builtin_amdgcn_rcpf(be[i]);
                kp = 1.f - be;
                if (diag) {
                    asm volatile("; diagonal block: masks" ::: "memory");
                    const int pos0 = 64 * j + 32 * kt + 8 * hf;
#pragma unroll
                    for (int i = 0; i < 16; ++i) { const bool valid = (pos0 + 16 * (i >> 3) + (i & 7)) < tq; be[i] = valid ? be[i] : 0.f; kp[i] = valid ? kp[i] : 1.f; }
                }
                float l1 = 1.f, l0 = 1.f;
#pragma unroll
                for (int i = 15; i >= 8; --i) { const float t = be[i] * l1; l1 *= kp[i]; be[i] = t; }
#pragma unroll
                for (int i = 7; i >= 0; --i) { const float t = be[i] * l0; l0 *= kp[i]; be[i] = t; }
                const float p1 = __shfl_xor(l1, 32), p0 = __shfl_xor(l0, 32);
                const float hi1 = hf ? l1 : p1, lo1 = hf ? p1 : l1, hi0 = hf ? l0 : p0, lo0 = hf ? p0 : l0;
                const float r1 = run * hi1, r2 = r1 * lo1, r3 = r2 * hi0;
                const float pre_up = hf ? run : r1, pre_lo = hf ? r2 : r3;
                run = r3 * lo0;
#pragma unroll
                for (int a = 0; a < 2; ++a) {
                    const float pre = a ? pre_up : pre_lo;
                    u32x4 pw; pw.x = pk2(be[8 * a] * pre, be[8 * a + 1] * pre); pw.y = pk2(be[8 * a + 2] * pre, be[8 * a + 3] * pre); pw.z = pk2(be[8 * a + 4] * pre, be[8 * a + 5] * pre); pw.w = pk2(be[8 * a + 6] * pre, be[8 * a + 7] * pre);
                    const bf16x8 pf = __builtin_bit_cast(bf16x8, pw);
                    const bf16x8 v0 = *(const LAS bf16x8*)(buf + 8192 + (4 * kt + 2 * a + hf) * 1024 + ql * 16);
                    const bf16x8 v1 = *(const LAS bf16x8*)(buf + 8192 + (4 * kt + 2 * a + hf) * 1024 + 512 + ql * 16);
                    o0 = __builtin_amdgcn_mfma_f32_32x32x16_bf16(v0, pf, o0, 0, 0, 0);
                    o1 = __builtin_amdgcn_mfma_f32_32x32x16_bf16(v1, pf, o1, 0, 0, 0);
                }
            }
        }
        SUB_END(X, 12);
    }
    asm volatile("s_barrier" ::: "memory");
    cur.it = cv.it;
    bf16_t* op = (bf16_t*)(X.ws + WS_O) + (size_t)(b * S + fresh(tq)) * D + h * 64 + 4 * hf;
#pragma unroll
    for (int g4 = 0; g4 < 4; ++g4) {
        u32x2 w0; w0.x = pk2(o0[4 * g4], o0[4 * g4 + 1]); w0.y = pk2(o0[4 * g4 + 2], o0[4 * g4 + 3]); *(u32x2*)(op + 8 * g4) = w0;
        u32x2 w1; w1.x = pk2(o1[4 * g4], o1[4 * g4 + 1]); w1.y = pk2(o1[4 * g4 + 2], o1[4 * g4 + 3]); *(u32x2*)(op + 32 + 8 * g4) = w1;
    }
}
__device__ __forceinline__ void ph_sb(const Params& p, const Ctx& X, ConvCur& cur) {
    for (int pr = X.bid; pr < 256; pr += X.G)
#pragma unroll 1
        for (int u = 0; u < 2; ++u) { const int bh = pr >> 3, qa = pr & 7; sb_attn_unit(p, X, cur, bh, u ? qa : 15 - qa); }
    {
        LAS unsigned char* cscr = X.lds + CV_SCR + X.wave * (64 * CV_ROW);
        Conv cv; conv_init(cv, cur);
#pragma unroll 1
        while (cv.it < CV_NITEMS || cv.stage != 0) { conv_even(cv, p, X.ws, cscr, X.lane, true); conv_odd(cv, cscr, X.lane); }
        cur.it = cv.it;
    }
}
__device__ __forceinline__ void ph_attn_a(const Params& p, const Ctx& X) {
    const bf16_t* proj = (const bf16_t*)(X.ws + WS_BIG);
    for (int unit = X.bid; unit < 128; unit += X.G) {
        const int kv = unit >> 6, bg = (unit >> 3) & 7, ntile = unit & 7, b = bg >> 1, g = bg & 1, lane = fresh(X.lane), w = X.wave, ql = lane & 31, hf = lane >> 5;
        const int n = min(32 * ntile + ql, NCMP - 1);
        const float* pe = kv ? p.in[11] : p.in[10];
        const bf16_t* w1t = (const bf16_t*)(X.ws + WS_W1T) + (size_t)kv * 128 * 2048;
        const bf16_t* arow = proj + (size_t)(b * S + n * 16) * PROJ_LD + (kv ? OFF_VC : OFF_KC) + g * 64;
        f32x16 acc[4];
#pragma unroll
        for (int ct = 0; ct < 4; ++ct)
#pragma unroll
            for (int i = 0; i < 16; ++i) acc[ct][i] = 0.f;
        for (int ks = 0; ks < 16; ++ks) {
            const int k0 = 256 * w + 16 * ks + 8 * hf, l = k0 >> 6, d = k0 & 63;
            const u32x4 q = *(const u32x4*)(arow + (size_t)l * PROJ_LD + d);
            const f32x4 e0 = *(const f32x4*)(pe + k0), e1 = *(const f32x4*)(pe + k0 + 4);
            u32x4 o; o.x = pk2(bflo(q.x) + e0.x, bfhi(q.x) + e0.y); o.y = pk2(bflo(q.y) + e0.z, bfhi(q.y) + e0.w); o.z = pk2(bflo(q.z) + e1.x, bfhi(q.z) + e1.y); o.w = pk2(bflo(q.w) + e1.z, bfhi(q.w) + e1.w);
            const bf16x8 af = __builtin_bit_cast(bf16x8, o);
#pragma unroll
            for (int ct = 0; ct < 4; ++ct) acc[ct] = __builtin_amdgcn_mfma_f32_32x32x16_bf16(af, *(const bf16x8*)(w1t + (size_t)(32 * ct + ql) * 2048 + k0), acc[ct], 0, 0, 0);
        }
        LAS float* part = (LAS float*)X.lds;
#pragma unroll
        for (int ct = 0; ct < 4; ++ct)
#pragma unroll
            for (int i = 0; i < 16; ++i) part[w * 4096 + (8 * (i >> 2) + 4 * hf + (i & 3)) * 128 + 32 * ct + ql] = acc[ct][i];
        __syncthreads();
        LAS float* hid = part;
        {
            const int tidf = fresh(X.tid);
#pragma unroll
            for (int k = 0; k < 8; ++k) { const int e = tidf + NTHREADS * k; float v = 0.f;
#pragma unroll
                for (int ww = 0; ww < 8; ++ww) v += part[ww * 4096 + e];
                hid[e] = siluf(v); }
        }
        __syncthreads();
        {
            const int tidf = fresh(X.tid), row = tidf >> 4, c4 = (tidf & 15) * 4;
            const float* w2 = kv ? p.in[15] : p.in[13];
            f32x4 o = (f32x4){0.f, 0.f, 0.f, 0.f};
            for (int j = 0; j < 128; ++j) o = o + *(const f32x4*)(w2 + j * 64 + c4) * hid[row * 128 + j];
            const int nn = 32 * ntile + row;
            if (kv == 0) {
                float ssq = (o.x * o.x + o.y * o.y) + (o.z * o.z + o.w * o.w);
                ssq += __shfl_xor(ssq, 1); ssq += __shfl_xor(ssq, 2); ssq += __shfl_xor(ssq, 4); ssq += __shfl_xor(ssq, 8);
                const float r = rsqrtf(ssq * (1.f / 64.f) + EPS); const f32x4 gn = *(const f32x4*)(p.in[9] + c4);
                o = o * r * gn;
                if (nn >= NCMP) o = (f32x4){0.f, 0.f, 0.f, 0.f};
                u32x2 wv; wv.x = pk2(o.x, o.y); wv.y = pk2(o.z, o.w);
                *(u32x2*)((bf16_t*)(X.ws + WS_KCB) + ((size_t)bg * 256 + nn) * 64 + c4) = wv;
            } else {
                if (nn >= NCMP) o = (f32x4){0.f, 0.f, 0.f, 0.f};
                bf16_t* vt = (bf16_t*)(X.ws + WS_VCT) + ((size_t)bg * 64 + c4) * 256 + nn;
                vt[0] = (bf16_t)f2bf(o.x); vt[256] = (bf16_t)f2bf(o.y); vt[512] = (bf16_t)f2bf(o.z); vt[768] = (bf16_t)f2bf(o.w);
            }
        }
        __syncthreads();
    }
    for (int t2 = X.gw; t2 < T / 2; t2 += X.ngw) {
        const int lane = fresh(X.lane), sub = lane & 7;
#pragma unroll
        for (int k = 0; k < 2; ++k) {
            const int t = 2 * t2 + k;
            const u32x4 q = *(const u32x4*)(proj + (size_t)t * PROJ_LD + OFF_NQ + 8 * lane);
            float v[8] = {bflo(q.x), bfhi(q.x), bflo(q.y), bfhi(q.y), bflo(q.z), bfhi(q.z), bflo(q.w), bfhi(q.w)};
            float ssq = 0.f;
#pragma unroll
            for (int i = 0; i < 8; ++i) ssq += v[i] * v[i];
            ssq += __shfl_xor(ssq, 1); ssq += __shfl_xor(ssq, 2); ssq += __shfl_xor(ssq, 4);
            const float r = rsqrtf(ssq * (1.f / 64.f) + EPS) * (0.125f * 1.4426950408889634f);
            const f32x4 g0 = *(const f32x4*)(p.in[8] + 8 * sub), g1 = *(const f32x4*)(p.in[8] + 8 * sub + 4);
            u32x4 o; o.x = pk2(v[0] * r * g0.x, v[1] * r * g0.y); o.y = pk2(v[2] * r * g0.z, v[3] * r * g0.w); o.z = pk2(v[4] * r * g1.x, v[5] * r * g1.y); o.w = pk2(v[6] * r * g1.z, v[7] * r * g1.w);
            *(u32x4*)((bf16_t*)(X.ws + WS_QNB) + (size_t)t * 512 + 8 * lane) = o;
        }
        {
            const int t = 2 * t2 + (lane >> 5), l32 = lane & 31, isw = l32 >> 4, c = 8 * (l32 & 15);
            const u32x4 q = *(const u32x4*)(proj + (size_t)t * PROJ_LD + (isw ? OFF_KW : OFF_KS) + c);
            float v[8] = {bflo(q.x), bfhi(q.x), bflo(q.y), bfhi(q.y), bflo(q.z), bfhi(q.z), bflo(q.w), bfhi(q.w)};
            float ssq = 0.f;
#pragma unroll
            for (int i = 0; i < 8; ++i) ssq += v[i] * v[i];
            ssq += __shfl_xor(ssq, 1); ssq += __shfl_xor(ssq, 2); ssq += __shfl_xor(ssq, 4);
            const float r = rsqrtf(ssq * (1.f / 64.f) + EPS);
            const float* gn = p.in[9] + (isw ? 128 : 64) + 8 * sub;
            const f32x4 g0 = *(const f32x4*)gn, g1 = *(const f32x4*)(gn + 4);
            u32x4 o; o.x = pk2(v[0] * r * g0.x, v[1] * r * g0.y); o.y = pk2(v[2] * r * g0.z, v[3] * r * g0.w); o.z = pk2(v[4] * r * g1.x, v[5] * r * g1.y); o.w = pk2(v[6] * r * g1.z, v[7] * r * g1.w);
            *(u32x4*)((bf16_t*)(X.ws + (isw ? WS_KWN : WS_KSN)) + (size_t)t * 128 + c) = o;
        }
    }
}
struct NsaSt { f32x16 o0, o1; float m, l; };
template <int MODE>
__device__ __forceinline__ void nsa_flash(const Ctx& X, const unsigned char* kbase, unsigned koff, const unsigned char* vbase, unsigned voff, int jlo, int jhi, const bf16x8 (&qf)[4], int tq, float slope2,
                                          unsigned long long mymask, unsigned long long wavemask, NsaSt& st, float cbound, const Params& p, ConvCur& cur) {
    Conv cv; conv_init(cv, cur);
    const int lane = fresh(X.lane), w = X.wave, ql = lane & 31, hf = lane >> 5;
    LAS unsigned char* ring = X.lds + w * 1024;
    const int krow = pi32(ql) * 16, nb = jhi - jlo + 1;
    asm volatile("s_waitcnt vmcnt(0)" ::: "memory");
    LAS unsigned char* cscr = X.lds + CV_SCR + w * (64 * CV_ROW);
#pragma unroll
    for (int d = 0; d < 4; ++d) if (d < nb) { DMA16(kbase + (koff + (unsigned)(jhi - d) * 16384u), ring + d * 16384); DMA16(vbase + (voff + (unsigned)(jhi - d) * 128u), ring + d * 16384 + 8192); }
    int slot = 0, islot = 4;
    const float k32 = slope2 * 32.f;
    for (int q = 0; q < nb; ++q) {
        const int j = jhi - q;
        if ((q & 1) == 0) {
            SUB_BEGIN(X, 21);
            RING6_WAIT_BAR(q, nb);
            SUB_END(X, 21);
            conv_even(cv, p, X.ws, cscr, lane, q + 2 < nb);
#pragma unroll
            for (int d = 4; d < 6; ++d) if (q + d < nb) { const int jj = jhi - (q + d); DMA16(kbase + (koff + (unsigned)jj * 16384u), ring + islot * 16384); DMA16(vbase + (voff + (unsigned)jj * 128u), ring + islot * 16384 + 8192); islot = islot == 5 ? 0 : islot + 1; }
        } else conv_odd(cv, cscr, lane);
        LAS unsigned char* buf = X.lds + slot * 16384; slot = slot == 5 ? 0 : slot + 1;
        SUB_BEGIN(X, 22);
        if (MODE == 1 || ((wavemask >> j) & 1ull)) {
            f32x16 s0, s1;
#pragma unroll
            for (int i = 0; i < 16; ++i) { s0[i] = 0.f; s1[i] = 0.f; }
#pragma unroll
            for (int s = 0; s < 4; ++s) {
                const bf16x8 k0 = *(const LAS bf16x8*)(buf + (2 * s + hf) * 1024 + krow), k1 = *(const LAS bf16x8*)(buf + (2 * s + hf) * 1024 + 512 + krow);
                s0 = __builtin_amdgcn_mfma_f32_32x32x16_bf16(k0, qf[s], s0, 0, 0, 0); s1 = __builtin_amdgcn_mfma_f32_32x32x16_bf16(k1, qf[s], s1, 0, 0, 0);
            }
            const int d0 = tq - (64 * j + 8 * hf);
            if (j == jhi || (MODE == 1 && j == jlo)) {
                asm volatile("; boundary block: masks" ::: "memory");
#pragma unroll
                for (int i = 0; i < 16; ++i) {
                    const int da = d0 - (16 * (i >> 3) + (i & 7)), db = da - 32;
                    s0[i] = (da >= 0 && (MODE == 0 || da < 512)) ? s0[i] : -INFINITY; s1[i] = (db >= 0 && (MODE == 0 || db < 512)) ? s1[i] : -INFINITY;
                }
            }
#pragma unroll
            for (int i = 0; i < 16; ++i) { const float kof = (float)(16 * (i >> 3) + (i & 7)); s0[i] = fmaf(slope2, kof, s0[i]); s1[i] = fmaf(slope2, kof, s1[i]); }
            const float base = slope2 * (float)d0;
            const bool sel = MODE == 1 || ((mymask >> j) & 1ull);
            const float off0 = sel ? cbound + base : INFINITY, off1 = off0 - k32;
            s0 = s0 - off0; s1 = s1 - off1;
            float ls = 0.f;
#pragma unroll
            for (int i = 0; i < 16; ++i) { s0[i] = __builtin_amdgcn_exp2f(s0[i]); s1[i] = __builtin_amdgcn_exp2f(s1[i]); ls += s0[i] + s1[i]; }
            st.l += ls;
#pragma unroll
            for (int kt = 0; kt < 2; ++kt)
#pragma unroll
                for (int a = 0; a < 2; ++a) {
                    u32x4 pw;
                    if (kt == 0) { pw.x = pk2(s0[8 * a], s0[8 * a + 1]); pw.y = pk2(s0[8 * a + 2], s0[8 * a + 3]); pw.z = pk2(s0[8 * a + 4], s0[8 * a + 5]); pw.w = pk2(s0[8 * a + 6], s0[8 * a + 7]); }
                    else { pw.x = pk2(s1[8 * a], s1[8 * a + 1]); pw.y = pk2(s1[8 * a + 2], s1[8 * a + 3]); pw.z = pk2(s1[8 * a + 4], s1[8 * a + 5]); pw.w = pk2(s1[8 * a + 6], s1[8 * a + 7]); }
                    const bf16x8 pf = __builtin_bit_cast(bf16x8, pw);
                    const bf16x8 v0 = *(const LAS bf16x8*)(buf + 8192 + (4 * kt + 2 * a + hf) * 1024 + ql * 16);
                    const bf16x8 v1 = *(const LAS bf16x8*)(buf + 8192 + (4 * kt + 2 * a + hf) * 1024 + 512 + ql * 16);
                    st.o0 = __builtin_amdgcn_mfma_f32_32x32x16_bf16(v0, pf, st.o0, 0, 0, 0);
                    st.o1 = __builtin_amdgcn_mfma_f32_32x32x16_bf16(v1, pf, st.o1, 0, 0, 0);
                }
        }
        SUB_END(X, 22);
    }
    asm volatile("s_barrier" ::: "memory");
    cur.it = cv.it;
}
__device__ __forceinline__ void nsa_unit(const Params& p, const Ctx& X, ConvCur& cur, int bg, int qb) {
    const int b = bg >> 1, g = bg & 1, lane = fresh(X.lane), w = X.wave, ql = lane & 31, hf = lane >> 5, r = ql >> 3, hh = g * 4 + r;
    const int t0 = 64 * qb, tq = t0 + 8 * w + (ql & 7);
    const float slope2 = exp2f(-(float)(hh + 1)) * 1.4426950408889634f;
    const bf16_t* proj = (const bf16_t*)(X.ws + WS_BIG);
    bf16x8 qf[4];
    { const bf16_t* qp = (const bf16_t*)(X.ws + WS_QNB) + (size_t)(b * S + tq) * 512 + hh * 64 + 8 * hf;
#pragma unroll
      for (int s = 0; s < 4; ++s) qf[s] = *(const bf16x8*)(qp + 16 * s); }
    float cb_sel, cb_win;
    { const float gq = wave_max(fabsf(p.in[8][lane])), g1 = wave_max(fabsf(p.in[9][64 + lane])), g2 = wave_max(fabsf(p.in[9][128 + lane]));
      cb_sel = 1.03f * 8.f * 0.125f * 1.4426950408889634f * 8.f * gq * g1; cb_win = 1.03f * 8.f * 0.125f * 1.4426950408889634f * 8.f * gq * g2; }
#define NSA_GATE(i) (1.f / (1.f + __expf(-bf2f(proj[(size_t)(b * S + fresh(tq)) * PROJ_LD + OFF_GATE + hh * 3 + (i)]))))
    unsigned ofp0[8], ofp1[8];
    NsaSt st;
    SUB_BEGIN(X, 23);
    LAS float* pacc = (LAS float*)(X.lds + 65536) + w * 2048;
    {
        const int ncm = t0 + 63 >= 31 ? (t0 + 63 - 31) / 16 + 1 : 0, nt = (ncm + 31) >> 5, ncv = tq >= 31 ? (tq - 31) / 16 + 1 : 0;
        {
            const bf16_t* kc = (const bf16_t*)(X.ws + WS_KCB) + (size_t)bg * 256 * 64; const bf16_t* vc = (const bf16_t*)(X.ws + WS_VCT) + (size_t)bg * 64 * 256;
            const int tidf = fresh(X.tid);
#pragma unroll
            for (int i = 0; i < 4; ++i) { const int pidx = tidf + NTHREADS * i;
                *(LAS u32x4*)(X.lds + (pidx >> 8) * 4096 + (pidx & 255) * 16) = *(const u32x4*)(kc + (size_t)(pidx & 255) * 64 + 8 * (pidx >> 8));
                *(LAS u32x4*)(X.lds + 32768 + (pidx >> 6) * 1024 + (pidx & 63) * 16) = *(const u32x4*)(vc + (size_t)(pidx & 63) * 256 + 8 * (pidx >> 6)); }
#pragma unroll
            for (int i = 0; i < 8; ++i) *(LAS f32x4*)(pacc + (i * 64 + lane) * 4) = (f32x4){0.f, 0.f, 0.f, 0.f};
        }
        __syncthreads();
        const int krow = pi32(ql) * 16;
        float ml = -INFINITY, ll = 0.f;
        for (int kt = 0; kt < nt; ++kt) {
            f32x16 sc;
#pragma unroll
            for (int i = 0; i < 16; ++i) sc[i] = 0.f;
#pragma unroll
            for (int s = 0; s < 4; ++s) { const bf16x8 kf = *(const LAS bf16x8*)(X.lds + (2 * s + hf) * 4096 + kt * 512 + krow); sc = __builtin_amdgcn_mfma_f32_32x32x16_bf16(kf, qf[s], sc, 0, 0, 0); }
            float tm = -INFINITY;
#pragma unroll
            for (int i = 0; i < 16; ++i) { const int n = 32 * kt + 16 * (i >> 3) + 8 * hf + (i & 7);
                sc[i] = n < ncv ? sc[i] - slope2 * (float)(tq - (16 * n + 31)) : -INFINITY; tm = fmaxf(tm, sc[i]); }
            const float mn = fmaxf(ml, tm), ms = mn == -INFINITY ? 0.f : mn;
            float ls = 0.f;
#pragma unroll
            for (int i = 0; i < 16; ++i) ls += __builtin_amdgcn_exp2f(sc[i] - ms);
            ll = ll * __builtin_amdgcn_exp2f(ml - ms) + ls; ml = mn;
        }
        float ms, inv;
        { const float mo = __shfl_xor(ml, 32), lo = __shfl_xor(ll, 32), mt = fmaxf(ml, mo); ms = mt == -INFINITY ? 0.f : mt;
          const float lt = ll * __builtin_amdgcn_exp2f(ml - ms) + lo * __builtin_amdgcn_exp2f(mo - ms); inv = lt > 0.f ? 1.f / lt : 0.f; }
#pragma unroll
        for (int i = 0; i < 16; ++i) { st.o0[i] = 0.f; st.o1[i] = 0.f; }
        float carry = 0.f;
        for (int kt = 0; kt < nt; ++kt) {
            f32x16 sc;
#pragma unroll
            for (int i = 0; i < 16; ++i) sc[i] = 0.f;
#pragma unroll
            for (int s = 0; s < 4; ++s) { const bf16x8 kf = *(const LAS bf16x8*)(X.lds + (2 * s + hf) * 4096 + kt * 512 + krow); sc = __builtin_amdgcn_mfma_f32_32x32x16_bf16(kf, qf[s], sc, 0, 0, 0); }
#pragma unroll
            for (int i = 0; i < 16; ++i) { const int n = 32 * kt + 16 * (i >> 3) + 8 * hf + (i & 7);
                sc[i] = n < ncv ? __builtin_amdgcn_exp2f(sc[i] - slope2 * (float)(tq - (16 * n + 31)) - ms) * inv : 0.f; }
            const float pa0 = __shfl_xor(sc[7], 32), pa1 = __shfl_xor(sc[15], 32);
            const float prev0 = hf ? pa0 : carry, prev1 = hf ? pa1 : pa0;
            carry = pa1;
            {
                typedef float f32x2 __attribute__((ext_vector_type(2)));
                f32x2 e0, e1;
                e0.x = prev0 + ((sc[0] + sc[1]) + (sc[2] + sc[3])); e0.y = sc[3] + ((sc[4] + sc[5]) + (sc[6] + sc[7]));
                e1.x = prev1 + ((sc[8] + sc[9]) + (sc[10] + sc[11])); e1.y = sc[11] + ((sc[12] + sc[13]) + (sc[14] + sc[15]));
                *(LAS f32x2*)(pacc + ql * 64 + 8 * kt + 2 * hf) = e0; *(LAS f32x2*)(pacc + ql * 64 + 8 * kt + 4 + 2 * hf) = e1;
            }
#pragma unroll
            for (int a = 0; a < 2; ++a) {
                u32x4 pw; pw.x = pk2(sc[8 * a], sc[8 * a + 1]); pw.y = pk2(sc[8 * a + 2], sc[8 * a + 3]); pw.z = pk2(sc[8 * a + 4], sc[8 * a + 5]); pw.w = pk2(sc[8 * a + 6], sc[8 * a + 7]);
                const bf16x8 pf = __builtin_bit_cast(bf16x8, pw);
                const bf16x8 v0 = *(const LAS bf16x8*)(X.lds + 32768 + (4 * kt + 2 * a + hf) * 1024 + ql * 16);
                const bf16x8 v1 = *(const LAS bf16x8*)(X.lds + 32768 + (4 * kt + 2 * a + hf) * 1024 + 512 + ql * 16);
                st.o0 = __builtin_amdgcn_mfma_f32_32x32x16_bf16(v0, pf, st.o0, 0, 0, 0);
                st.o1 = __builtin_amdgcn_mfma_f32_32x32x16_bf16(v1, pf, st.o1, 0, 0, 0);
            }
        }
        { const float g0 = NSA_GATE(0);
#pragma unroll
        for (int i = 0; i < 8; ++i) { ofp0[i] = pk2(g0 * st.o0[2 * i], g0 * st.o0[2 * i + 1]); ofp1[i] = pk2(g0 * st.o1[2 * i], g0 * st.o1[2 * i + 1]); } }
    }
    SUB_END(X, 23);
    SUB_BEGIN(X, 24);
    unsigned long long mymask = 0ull, wavemask = 0ull;
    LDS_WAIT();
    for (int q8 = 0; q8 < 8; ++q8) {
        const int t = t0 + 8 * w + q8;
        const float ps = (pacc[(0 * 8 + q8) * 64 + lane] + pacc[(1 * 8 + q8) * 64 + lane]) + (pacc[(2 * 8 + q8) * 64 + lane] + pacc[(3 * 8 + q8) * 64 + lane]);
        const bool valid = lane * 64 <= t, forced = (lane == 0) || (lane == qb) || (lane == qb - 1);
        const unsigned key = valid ? ((forced ? 0x7f000000u : (__float_as_uint(fmaxf(ps, 0.f)) & ~63u)) | (unsigned)(63 - lane)) : 0u;
        unsigned thr = 0u;
#pragma unroll 1
        for (int bit = 30; bit >= 0; --bit) { const unsigned cand = thr | (1u << bit); if (__builtin_popcountll(__ballot(key >= cand)) >= 16) thr = cand; }
        const unsigned long long mk = __ballot(key >= thr && key != 0u);
        wavemask |= mk; if ((ql & 7) == q8) mymask = mk;
    }
    SUB_END(X, 24);
    __syncthreads();
    {
#pragma unroll
        for (int i = 0; i < 16; ++i) { st.o0[i] = 0.f; st.o1[i] = 0.f; }
        st.m = -INFINITY; st.l = 0.f;
        const int lf = fresh(lane);
        const unsigned koff = (unsigned)(((b * S + lf) * 128 + g * 64 + 8 * w) * 2), voff = (unsigned)(((512 + g * 64 + lf) * T + b * S + 8 * w) * 2);
        nsa_flash<0>(X, X.ws + WS_KSN, koff, X.ws + WS_VT, voff, 0, qb, qf, tq, slope2, mymask, wavemask, st, cb_sel, p, cur);
        const float lt = st.l + __shfl_xor(st.l, 32), sc = NSA_GATE(1) / fmaxf(lt, 1e-30f);
#pragma unroll
        for (int i = 0; i < 8; ++i) { ofp0[i] = pk2(bflo(ofp0[i]) + sc * st.o0[2 * i], bfhi(ofp0[i]) + sc * st.o0[2 * i + 1]); ofp1[i] = pk2(bflo(ofp1[i]) + sc * st.o1[2 * i], bfhi(ofp1[i]) + sc * st.o1[2 * i + 1]); }
    }
    {
#pragma unroll
        for (int i = 0; i < 16; ++i) { st.o0[i] = 0.f; st.o1[i] = 0.f; }
        st.m = -INFINITY; st.l = 0.f;
        const int lf = fresh(lane);
        const unsigned koff = (unsigned)(((b * S + lf) * 128 + g * 64 + 8 * w) * 2), voff = (unsigned)(((640 + g * 64 + lf) * T + b * S + 8 * w) * 2);
        nsa_flash<1>(X, X.ws + WS_KWN, koff, X.ws + WS_VT, voff, qb >= 8 ? qb - 8 : 0, qb, qf, tq, slope2, 0ull, 0ull, st, cb_win, p, cur);
        const float lt = st.l + __shfl_xor(st.l, 32), sc = NSA_GATE(2) / fmaxf(lt, 1e-30f);
#pragma unroll
        for (int i = 0; i < 8; ++i) { ofp0[i] = pk2(bflo(ofp0[i]) + sc * st.o0[2 * i], bfhi(ofp0[i]) + sc * st.o0[2 * i + 1]); ofp1[i] = pk2(bflo(ofp1[i]) + sc * st.o1[2 * i], bfhi(ofp1[i]) + sc * st.o1[2 * i + 1]); }
    }
    bf16_t* op = (bf16_t*)(X.ws + WS_O) + (size_t)(b * S + fresh(tq)) * D + 512 + hh * 64 + 4 * hf;
#pragma unroll
    for (int g4 = 0; g4 < 4; ++g4) {
        u32x2 w0; w0.x = ofp0[2 * g4]; w0.y = ofp0[2 * g4 + 1]; *(u32x2*)(op + 8 * g4) = w0;
        u32x2 w1; w1.x = ofp1[2 * g4]; w1.y = ofp1[2 * g4 + 1]; *(u32x2*)(op + 32 + 8 * g4) = w1;
    }
}
__device__ __forceinline__ void ph_nsa(const Params& p, const Ctx& X, ConvCur& cur) {
    for (int pr = X.bid; pr < 256; pr += X.G)
#pragma unroll 1
        for (int u = 0; u < 2; ++u) { const int bg = pr >> 5, qa = pr & 31; nsa_unit(p, X, cur, bg, u ? qa : 63 - qa); }
}

__device__ __forceinline__ float silu_fast(float v) { return v * __builtin_amdgcn_rcpf(1.f + __expf(-v)); }
constexpr int S1_WL = RING_BYTES + 4096;
__device__ __forceinline__ void ph_ssd1(const Params& p, const Ctx& X) {
    const float* cw = p.in[17]; const float* cb = p.in[18];
    LAS float* wl = (LAS float*)(X.lds + S1_WL);
    LAS unsigned char* ldsB = X.lds;
    LAS unsigned char* ldsX = X.lds + 65536;
    for (int unit = X.bid; unit < 256; unit += X.G) {
        const int b = unit >> 6, c = (unit >> 2) & 15, g = unit & 3, tl0 = c * 256, lane = fresh(X.lane), w = X.wave, ql = lane & 31, hf = lane >> 5;
        const size_t t0 = (size_t)b * S + tl0;
        SUB_BEGIN(X, 41);
        {
            const int h = g * 8 + w;
            const float a = -expf(p.in[20][h]), dtb = p.in[19][h];
            const float* dr = (const float*)(X.ws + WS_DT) + (t0 + 4 * lane) * 32 + h;
            float dt[4], cs[4];
#pragma unroll
            for (int k = 0; k < 4; ++k) { const float raw = dr[k * 32] + dtb; dt[k] = raw > 20.f ? raw : log1pf(expf(raw)); }
            cs[0] = dt[0] * a; cs[1] = cs[0] + dt[1] * a; cs[2] = cs[1] + dt[2] * a; cs[3] = cs[2] + dt[3] * a;
            float incl = cs[3];
#pragma unroll
            for (int o = 1; o < 64; o <<= 1) { const float u = __shfl_up(incl, o); if (lane >= o) incl += u; }
            const float excl = incl - cs[3], last = __shfl(incl, 63);
#pragma unroll
            for (int k = 0; k < 4; ++k) cs[k] += excl;
            *(f32x4*)((float*)(X.ws + WS_DT2) + (size_t)(b * 32 + h) * S + tl0 + 4 * lane) = (f32x4){dt[0], dt[1], dt[2], dt[3]};
            *(f32x4*)((float*)(X.ws + WS_CS) + (size_t)(b * 32 + h) * S + tl0 + 4 * lane) = (f32x4){cs[0], cs[1], cs[2], cs[3]};
            *(LAS f32x4*)(wl + w * 256 + 4 * lane) = (f32x4){dt[0] * __expf(last - cs[0]), dt[1] * __expf(last - cs[1]), dt[2] * __expf(last - cs[2]), dt[3] * __expf(last - cs[3])};
            if (lane == 63) ((float*)(X.ws + WS_DEC))[(b * 16 + c) * 32 + h] = __expf(last);
        }
        const bf16_t* xt = (const bf16_t*)(X.ws + WS_XT); bf16_t* xct = (bf16_t*)(X.ws + WS_XCT);
        const int tidf = fresh(X.tid);
#define CONV8(rin, chg, seg, o) do { const bf16_t* src_ = xt + (size_t)(rin) * T + t0 + 8 * (seg); const u32x4 cur_ = *(const u32x4*)src_; u32x4 prv_ = (u32x4){0u, 0u, 0u, 0u}; \
            if (tl0 + 8 * (seg) >= 8) prv_ = *(const u32x4*)(src_ - 8); \
            const float x_[11] = {bfhi(prv_.z), bflo(prv_.w), bfhi(prv_.w), bflo(cur_.x), bfhi(cur_.x), bflo(cur_.y), bfhi(cur_.y), bflo(cur_.z), bfhi(cur_.z), bflo(cur_.w), bfhi(cur_.w)}; \
            const float w0_ = cw[chg], w1_ = cw[CONV_DIM + (chg)], w2_ = cw[2 * CONV_DIM + (chg)], w3_ = cw[3 * CONV_DIM + (chg)], bb_ = cb[chg]; \
            _Pragma("unroll") for (int j_ = 0; j_ < 8; ++j_) o[j_] = silu_fast(bb_ + w0_ * x_[j_] + w1_ * x_[j_ + 1] + w2_ * x_[j_ + 2] + w3_ * x_[j_ + 3]); } while (0)
        SUB_END(X, 41);
        SUB_BEGIN(X, 42);
        {
#pragma unroll
            for (int k = 0; k < 8; ++k) {
                const int it = tidf + NTHREADS * k, n = it >> 5, seg = it & 31, chg = 2048 + g * 128 + n;
                float o[8]; CONV8(g * 128 + n, chg, seg, o);
                u32x4 ov; ov.x = pk2(o[0], o[1]); ov.y = pk2(o[2], o[3]); ov.z = pk2(o[4], o[5]); ov.w = pk2(o[6], o[7]);
                *(u32x4*)(xct + (size_t)chg * T + t0 + 8 * seg) = ov;
                *(LAS u32x4*)(ldsB + seg * 2048 + n * 16) = ov;
            }
            SUB_END(X, 42);
            SUB_BEGIN(X, 43);
            const bf16_t* zbc = (const bf16_t*)(X.ws + WS_ZBC); bf16_t* bcm = (bf16_t*)(X.ws + WS_BCM);
            {
                const int c8 = tidf & 31, l0 = (tidf >> 5) * 16;
                const int col = (c8 < 16 ? g * 128 + 8 * c8 : 512 + g * 128 + 8 * (c8 - 16));
                float wk[4][8], bb[8];
                { const f32x4 b0 = *(const f32x4*)(cb + 2048 + col), b1 = *(const f32x4*)(cb + 2048 + col + 4); bb[0] = b0.x; bb[1] = b0.y; bb[2] = b0.z; bb[3] = b0.w; bb[4] = b1.x; bb[5] = b1.y; bb[6] = b1.z; bb[7] = b1.w; }
#pragma unroll
                for (int ww = 0; ww < 4; ++ww) { const f32x4 k0 = *(const f32x4*)(cw + ww * CONV_DIM + 2048 + col), k1 = *(const f32x4*)(cw + ww * CONV_DIM + 2048 + col + 4);
                    wk[ww][0] = k0.x; wk[ww][1] = k0.y; wk[ww][2] = k0.z; wk[ww][3] = k0.w; wk[ww][4] = k1.x; wk[ww][5] = k1.y; wk[ww][6] = k1.z; wk[ww][7] = k1.w; }
                u32x4 rw[19];
#pragma unroll
                for (int r = 0; r < 19; ++r) rw[r] = (tl0 + l0 - 3 + r >= 0) ? *(const u32x4*)(zbc + (t0 + l0 - 3 + r) * 3072 + 2048 + col) : (u32x4){0u, 0u, 0u, 0u};
#pragma unroll
                for (int k = 0; k < 16; ++k) {
                    float acc[8];
#pragma unroll
                    for (int i = 0; i < 8; ++i) acc[i] = bb[i];
#pragma unroll
                    for (int ww = 0; ww < 4; ++ww) { const u32x4 q = rw[k + ww];
                        acc[0] += bflo(q.x) * wk[ww][0]; acc[1] += bfhi(q.x) * wk[ww][1]; acc[2] += bflo(q.y) * wk[ww][2]; acc[3] += bfhi(q.y) * wk[ww][3];
                        acc[4] += bflo(q.z) * wk[ww][4]; acc[5] += bfhi(q.z) * wk[ww][5]; acc[6] += bflo(q.w) * wk[ww][6]; acc[7] += bfhi(q.w) * wk[ww][7]; }
                    u32x4 ov; ov.x = pk2(silu_fast(acc[0]), silu_fast(acc[1])); ov.y = pk2(silu_fast(acc[2]), silu_fast(acc[3])); ov.z = pk2(silu_fast(acc[4]), silu_fast(acc[5])); ov.w = pk2(silu_fast(acc[6]), silu_fast(acc[7]));
                    *(u32x4*)(bcm + (t0 + l0 + k) * 1024 + col) = ov;
                }
            }
        }
        SUB_END(X, 43);
#pragma unroll 1
        for (int hg = 0; hg < 4; ++hg) {
            SUB_BEGIN(X, 44);
            asm volatile("s_waitcnt lgkmcnt(0)\n\ts_barrier" ::: "memory");
#pragma unroll
            for (int k = 0; k < 8; ++k) {
                const int it = tidf + NTHREADS * k, chl = it >> 5, seg = it & 31, h8 = 2 * hg + (chl >> 6), chg = g * 512 + h8 * 64 + (chl & 63);
                float o[8]; CONV8(1024 + chg, chg, seg, o);
                u32x4 ov; ov.x = pk2(o[0], o[1]); ov.y = pk2(o[2], o[3]); ov.z = pk2(o[4], o[5]); ov.w = pk2(o[6], o[7]);
                *(u32x4*)(xct + (size_t)chg * T + t0 + 8 * seg) = ov;
                const f32x4 wa = *(const LAS f32x4*)(wl + h8 * 256 + 8 * seg), wb = *(const LAS f32x4*)(wl + h8 * 256 + 8 * seg + 4);
                u32x4 os; os.x = pk2(o[0] * wa.x, o[1] * wa.y); os.y = pk2(o[2] * wa.z, o[3] * wa.w); os.z = pk2(o[4] * wb.x, o[5] * wb.y); os.w = pk2(o[6] * wb.z, o[7] * wb.w);
                *(LAS u32x4*)(ldsX + (chl >> 6) * 32768 + seg * 1024 + (chl & 63) * 16) = os;
            }
            asm volatile("s_waitcnt lgkmcnt(0)\n\ts_barrier" ::: "memory");
            SUB_END(X, 44);
            SUB_BEGIN(X, 45);
            {
                const int hl = w >> 2, pt = (w >> 1) & 1, nt0 = 2 * (w & 1), h = g * 8 + 2 * hg + hl;
                f32x16 acc0, acc1;
#pragma unroll
                for (int i = 0; i < 16; ++i) { acc0[i] = 0.f; acc1[i] = 0.f; }
#pragma unroll 4
                for (int ks = 0; ks < 16; ++ks) {
                    const bf16x8 af = *(const LAS bf16x8*)(ldsX + hl * 32768 + (2 * ks + hf) * 1024 + (32 * pt + ql) * 16);
                    const bf16x8 b0 = *(const LAS bf16x8*)(ldsB + (2 * ks + hf) * 2048 + (32 * nt0 + ql) * 16), b1 = *(const LAS bf16x8*)(ldsB + (2 * ks + hf) * 2048 + (32 * nt0 + 32 + ql) * 16);
                    acc0 = __builtin_amdgcn_mfma_f32_32x32x16_bf16(af, b0, acc0, 0, 0, 0); acc1 = __builtin_amdgcn_mfma_f32_32x32x16_bf16(af, b1, acc1, 0, 0, 0);
                }
                float* st = (float*)(X.ws + WS_ST) + ((size_t)(b * 16 + c) * 32 + h) * 8192 + 32 * nt0 + ql;
#pragma unroll
                for (int i = 0; i < 16; ++i) { const int pr = 32 * pt + 8 * (i >> 2) + 4 * hf + (i & 3); st[pr * 128] = acc0[i]; st[pr * 128 + 32] = acc1[i]; }
            }
            SUB_END(X, 45);
        }
#undef CONV8
        __syncthreads();
    }
}
__device__ __forceinline__ void ph_ssd2(const Ctx& X) {
    const float* st = (const float*)(X.ws + WS_ST); const float* dec = (const float*)(X.ws + WS_DEC); bf16_t* pb = (bf16_t*)(X.ws + WS_PB);
    for (int e = X.bid * NTHREADS + X.tid; e < NB * 32 * 2048; e += X.G * NTHREADS) {
        const int b = e >> 16, h = (e >> 11) & 31, q4 = (e & 2047) * 4;
        f32x4 hs = (f32x4){0.f, 0.f, 0.f, 0.f};
        for (int c = 0; c < 16; ++c) {
            const size_t o = ((size_t)(b * 16 + c) * 32 + h) * 8192 + q4;
            u32x2 wv; wv.x = pk2(hs.x, hs.y); wv.y = pk2(hs.z, hs.w); *(u32x2*)(pb + o) = wv;
            hs = hs * dec[(b * 16 + c) * 32 + h] + *(const f32x4*)(st + o);
        }
    }
}
constexpr int S3_STG = 49152;
__device__ __forceinline__ void ph_ssd3(const Params& p, const Ctx& X) {
    LAS float* dtl = (LAS float*)(X.lds + 2 * S3_STG); LAS float* csl = dtl + 2048;
    constexpr int S3_TILE = 2 * S3_STG + 16384;
    static_assert(S3_TILE + 8 * 4096 <= TAB_OFF, "ssd3 LDS map");
    for (int unit = X.bid; unit < 256; unit += X.G) {
        const int b = unit >> 6, c = (unit >> 2) & 15, g = unit & 3, tl0 = c * 256, lane = fresh(X.lane), w = X.wave, ql = lane & 31, hf = lane >> 5, lq = 32 * w + ql;
        const size_t t0 = (size_t)b * S + tl0;
        LAS unsigned char* tile = X.lds + S3_TILE + w * 4096;
        const bf16_t* xg = (const bf16_t*)(X.ws + WS_XCT) + (size_t)(g * 512 + lane) * T + t0;
        const bf16_t* pg = (const bf16_t*)(X.ws + WS_PB) + ((size_t)(b * 16 + c) * 32 + g * 8) * 8192 + (size_t)lane * 128;
#define S3_ISSUE(h8, sbase) do { _Pragma("unroll") for (int cc_ = 0; cc_ < 4; ++cc_) DMA16(xg + (size_t)((h8) * 64) * T + 8 * (4 * w + cc_), X.lds + (sbase) + (4 * w + cc_) * 1024); \
            _Pragma("unroll") for (int cc_ = 0; cc_ < 2; ++cc_) DMA16(pg + (size_t)(h8) * 8192 + 8 * (2 * w + cc_), X.lds + (sbase) + 32768 + (2 * w + cc_) * 1024); } while (0)
        asm volatile("s_waitcnt vmcnt(0)" ::: "memory");
        S3_ISSUE(0, 0);
        { const int tidf = fresh(X.tid), h8 = tidf >> 6, l4 = (tidf & 63) * 4;
          *(LAS f32x4*)(dtl + h8 * 256 + l4) = *(const f32x4*)((const float*)(X.ws + WS_DT2) + (size_t)(b * 32 + g * 8 + h8) * S + tl0 + l4);
          *(LAS f32x4*)(csl + h8 * 256 + l4) = *(const f32x4*)((const float*)(X.ws + WS_CS) + (size_t)(b * 32 + g * 8 + h8) * S + tl0 + l4); }
        const bf16_t* bcm = (const bf16_t*)(X.ws + WS_BCM);
        bf16x8 cf[8];
#pragma unroll
        for (int ks = 0; ks < 8; ++ks) cf[ks] = *(const bf16x8*)(bcm + (t0 + lq) * 1024 + 512 + g * 128 + 16 * ks + 8 * hf);
        u32x4 gp[8][2];
        {
#pragma unroll
        for (int st = 0; st < 8; ++st) {
            if (st <= w) {
                f32x16 G;
#pragma unroll
                for (int i = 0; i < 16; ++i) G[i] = 0.f;
                const bf16_t* bp = bcm + (t0 + 32 * st + pi32(ql)) * 1024 + g * 128 + 8 * hf;
#pragma unroll
                for (int ks = 0; ks < 8; ++ks) G = __builtin_amdgcn_mfma_f32_32x32x16_bf16(*(const bf16x8*)(bp + 16 * ks), cf[ks], G, 0, 0, 0);
#pragma unroll
                for (int a2 = 0; a2 < 2; ++a2) { gp[st][a2].x = pk2(G[8 * a2], G[8 * a2 + 1]); gp[st][a2].y = pk2(G[8 * a2 + 2], G[8 * a2 + 3]); gp[st][a2].z = pk2(G[8 * a2 + 4], G[8 * a2 + 5]); gp[st][a2].w = pk2(G[8 * a2 + 6], G[8 * a2 + 7]); }
            } else { gp[st][0] = (u32x4){0u, 0u, 0u, 0u}; gp[st][1] = (u32x4){0u, 0u, 0u, 0u}; }
        }
        }
        float ss = 0.f;
        bf16_t* yrow = (bf16_t*)(X.ws + WS_O) + (t0 + 32 * w + (lane >> 1)) * SSM_INNER + g * 512 + 32 * (lane & 1);
        const bf16_t* zdma = (const bf16_t*)(X.ws + WS_ZBC) + (t0 + 32 * w + (lane >> 3)) * 3072 + g * 512 + 8 * ((lane & 7) ^ (lane >> 3));
        LAS unsigned char* trw = tile + (lane >> 1) * 128;
        LAS unsigned char* tac = tile + ql * 128 + 8 * hf;
#pragma unroll 1
        for (int h8 = 0; h8 < 8; ++h8) {
            const int sb = (h8 & 1) * S3_STG;
            asm volatile("s_waitcnt vmcnt(0) lgkmcnt(0)\n\ts_barrier" ::: "memory");
            if (h8 < 7) S3_ISSUE(h8 + 1, ((h8 + 1) & 1) * S3_STG);
#pragma unroll
            for (int k = 0; k < 4; ++k) DMA16(zdma + (size_t)(8 * k) * 3072 + h8 * 64, tile + k * 1024);
            f32x16 acc0, acc1;
#pragma unroll
            for (int i = 0; i < 16; ++i) { acc0[i] = 0.f; acc1[i] = 0.f; }
            {
                const LAS unsigned char* pp = X.lds + sb + 32768 + hf * 1024 + ql * 16;
#if 1
                const bf16_t* cp = bcm + (t0 + 32 * w + (fresh(lane) & 31)) * 1024 + 512 + g * 128 + 8 * hf;
#pragma unroll
                for (int ks = 0; ks < 8; ++ks) { const bf16x8 cfk = *(const bf16x8*)(cp + 16 * ks);
                                                 acc0 = __builtin_amdgcn_mfma_f32_32x32x16_bf16(*(const LAS bf16x8*)(pp + ks * 2048), cfk, acc0, 0, 0, 0);
                                                 acc1 = __builtin_amdgcn_mfma_f32_32x32x16_bf16(*(const LAS bf16x8*)(pp + ks * 2048 + 512), cfk, acc1, 0, 0, 0); }
#else
#pragma unroll
                for (int ks = 0; ks < 8; ++ks) { acc0 = __builtin_amdgcn_mfma_f32_32x32x16_bf16(*(const LAS bf16x8*)(pp + ks * 2048), cf[ks], acc0, 0, 0, 0);
                                                 acc1 = __builtin_amdgcn_mfma_f32_32x32x16_bf16(*(const LAS bf16x8*)(pp + ks * 2048 + 512), cf[ks], acc1, 0, 0, 0); }
#endif
                const float e = __expf(csl[h8 * 256 + lq]);
#pragma unroll
                for (int i = 0; i < 16; ++i) { acc0[i] *= e; acc1[i] *= e; }
            }
            const float cl = csl[h8 * 256 + lq], dsk = p.in[21][g * 8 + h8];
#pragma unroll
            for (int st = 0; st < 8; ++st) {
                if (st <= w) {
                    const int s0 = 32 * st + 8 * hf;
#pragma unroll
                    for (int a2 = 0; a2 < 2; ++a2) {
                        const f32x4 d0 = *(const LAS f32x4*)(dtl + h8 * 256 + s0 + 16 * a2), d1 = *(const LAS f32x4*)(dtl + h8 * 256 + s0 + 16 * a2 + 4);
                        const f32x4 c0 = *(const LAS f32x4*)(csl + h8 * 256 + s0 + 16 * a2), c1 = *(const LAS f32x4*)(csl + h8 * 256 + s0 + 16 * a2 + 4);
                        const float dd[8] = {d0.x, d0.y, d0.z, d0.w, d1.x, d1.y, d1.z, d1.w}, cc[8] = {c0.x, c0.y, c0.z, c0.w, c1.x, c1.y, c1.z, c1.w};
                        const unsigned gw[4] = {gp[st][a2].x, gp[st][a2].y, gp[st][a2].z, gp[st][a2].w};
                        float m[8];
#pragma unroll
                        for (int j = 0; j < 8; ++j) { const int sidx = s0 + 16 * a2 + j;
                            const float gv = (j & 1) ? bfhi(gw[j >> 1]) : bflo(gw[j >> 1]);
                            float v = gv * dd[j] * __expf(fminf(cl - cc[j], 0.f));
                            if (st == w) { v = sidx > lq ? 0.f : v; v += sidx == lq ? dsk : 0.f; }
                            m[j] = v; }
                        u32x4 pw; pw.x = pk2(m[0], m[1]); pw.y = pk2(m[2], m[3]); pw.z = pk2(m[4], m[5]); pw.w = pk2(m[6], m[7]);
                        const bf16x8 pf = __builtin_bit_cast(bf16x8, pw);
                        const LAS unsigned char* xp = X.lds + sb + (4 * st + 2 * a2 + hf) * 1024 + ql * 16;
                        acc0 = __builtin_amdgcn_mfma_f32_32x32x16_bf16(*(const LAS bf16x8*)xp, pf, acc0, 0, 0, 0);
                        acc1 = __builtin_amdgcn_mfma_f32_32x32x16_bf16(*(const LAS bf16x8*)(xp + 512), pf, acc1, 0, 0, 0);
                        __builtin_amdgcn_sched_barrier(0);
                    }
                }
            }
            asm volatile("s_waitcnt vmcnt(0)" ::: "memory");
#pragma unroll
            for (int pt = 0; pt < 2; ++pt)
#pragma unroll
                for (int g4 = 0; g4 < 4; ++g4) {
                    const u32x2 z2 = *(const LAS u32x2*)(tac + (((4 * pt + g4) ^ (ql & 7)) * 16));
                    const float a0 = pt ? acc1[4 * g4] : acc0[4 * g4], a1 = pt ? acc1[4 * g4 + 1] : acc0[4 * g4 + 1], a2v = pt ? acc1[4 * g4 + 2] : acc0[4 * g4 + 2], a3 = pt ? acc1[4 * g4 + 3] : acc0[4 * g4 + 3];
                    const float v0 = a0 * silu_fast(bflo(z2.x)), v1 = a1 * silu_fast(bfhi(z2.x)), v2 = a2v * silu_fast(bflo(z2.y)), v3 = a3 * silu_fast(bfhi(z2.y));
                    ss += (v0 * v0 + v1 * v1) + (v2 * v2 + v3 * v3);
                    u32x2 o; o.x = pk2(v0, v1); o.y = pk2(v2, v3); *(LAS u32x2*)(tac + (((4 * pt + g4) ^ (ql & 7)) * 16)) = o;
                }
#pragma unroll
            for (int k = 0; k < 4; ++k) *(u32x4*)(yrow + h8 * 64 + 8 * k) = *(const LAS u32x4*)(trw + (((4 * (lane & 1) + k) ^ ((lane >> 1) & 7)) * 16));
        }
#undef S3_ISSUE
        ss += __shfl_xor(ss, 32);
        const float rs = rsqrtf(ss * (1.f / 512.f) + EPS);
        asm volatile("s_waitcnt vmcnt(0)" ::: "memory");
        {
            const int lf = fresh(lane);
            bf16_t* yb = (bf16_t*)(X.ws + WS_O) + (t0 + 32 * w) * SSM_INNER + g * 512 + 8 * lf;
            const f32x4 g0 = *(const f32x4*)(p.in[22] + g * 512 + 8 * lf), g1 = *(const f32x4*)(p.in[22] + g * 512 + 8 * lf + 4);
#pragma unroll 1
            for (int r0 = 0; r0 < 32; r0 += 8) {
                u32x4 q[8];
#pragma unroll
                for (int k = 0; k < 8; ++k) q[k] = *(const u32x4*)(yb + (size_t)(r0 + k) * SSM_INNER);
#pragma unroll
                for (int k = 0; k < 8; ++k) {
                    const float rk = __shfl(rs, r0 + k);
                    u32x4 o; o.x = pk2(bflo(q[k].x) * rk * g0.x, bfhi(q[k].x) * rk * g0.y); o.y = pk2(bflo(q[k].y) * rk * g0.z, bfhi(q[k].y) * rk * g0.w);
                    o.z = pk2(bflo(q[k].z) * rk * g1.x, bfhi(q[k].z) * rk * g1.y); o.w = pk2(bflo(q[k].w) * rk * g1.z, bfhi(q[k].w) * rk * g1.w);
                    *(u32x4*)(yb + (size_t)(r0 + k) * SSM_INNER) = o;
                }
            }
        }
        asm volatile("s_waitcnt lgkmcnt(0)\n\ts_barrier" ::: "memory");
    }
}

__device__ __forceinline__ void ph_moe_gu(const Params& p, const Ctx& X, int l) {
    moe_table(X, l);
    pg8::MoeOrder So{(const LAS int*)(X.lds + TAB_OFF), (const LAS int*)(X.lds + TAB_OFF) + 40, (const int*)(X.ws + WS_SLOT), 3, X.G, X.bid, true};
    pg8::Gemm g{(const bf16_t*)(X.ws + WS_U), (const bf16_t*)(X.ws + WS_WGU) + (size_t)l * NE * 2048 * 1024, 1024};
    pg8::EpiGu E{(bf16_t*)(X.ws + WS_ACT), p.in[27] + (size_t)l * NE * 2048};
    pg8::gemm_phase<pg8::EpiGu, pg8::MoeOrder>(X.lds, g, So, E, X.tid);
}
__device__ __forceinline__ void ph_moe_down(const Params& p, const Ctx& X, int l) {
    moe_table(X, l);
    pg8::MoeOrder So{(const LAS int*)(X.lds + TAB_OFF), (const LAS int*)(X.lds + TAB_OFF) + 40, (const int*)(X.ws + WS_SLOT), 2, X.G, X.bid, false};
    pg8::Gemm g{(const bf16_t*)(X.ws + WS_ACT), (const bf16_t*)(X.ws + WS_WDN) + (size_t)l * NE * 1024 * 1024, 1024};
    pg8::EpiDown E{(bf16_t*)(X.ws + WS_Y), p.in[29] + (size_t)l * NE * 1024};
    pg8::gemm_phase<pg8::EpiDown, pg8::MoeOrder>(X.lds, g, So, E, X.tid);
}

#ifndef PROBE_MULT
#define PROBE_MULT 8
#endif
__global__ void __launch_bounds__(NTHREADS, 2) fwd_kernel(Params p) {
    extern __shared__ __attribute__((aligned(16))) unsigned char lds_raw[];
    Ctx X;
    X.lds = (LAS unsigned char*)lds_raw; X.ws = p.ws;
    X.tid = threadIdx.x; X.lane = X.tid & 63; X.wave = __builtin_amdgcn_readfirstlane(X.tid >> 6);
    X.G = gridDim.x; X.bid = blockIdx.x; X.gw = X.bid * NWAVES + X.wave; X.ngw = X.G * NWAVES; X.sub = 0ull; X.subt = 0ull;
    if (X.tid < 4) ((LAS unsigned*)(X.lds + XB_OFF))[X.tid] = 0u;
    __syncthreads();
    XcdBarrier bar = xcd_barrier_post((unsigned*)(p.ws + WS_CTL) + CW_BAR, (volatile LAS unsigned*)(X.lds + XB_OFF));
#define PHASE_BEGIN Ctx Y = X; { GAS unsigned char* w_ = (GAS unsigned char*)p.ws; asm volatile("" : "+s"(w_)); Y.ws = (unsigned char*)w_; int t_ = threadIdx.x; asm volatile("" : "+v"(t_)); Y.tid = t_; Y.lane = t_ & 63; \
    Y.wave = __builtin_amdgcn_readfirstlane(t_ >> 6); Y.gw = Y.bid * NWAVES + Y.wave; }
#define WSF(off) ((float*)(Y.ws + (off)))
#define WSB(off) ((bf16_t*)(Y.ws + (off)))
#define PROBE_LDS(i) (((volatile LAS unsigned long long*)(X.lds + 150528))[2 * X.wave + (i)])
    if (PROBE_MASK || PROBE_SUB) { if (X.lane == 0) { PROBE_LDS(0) = __builtin_amdgcn_s_memrealtime(); PROBE_LDS(1) = 0ull; } }
#define PB(k) do { if (PROBE_MASK) { if (X.lane == 0) { const unsigned long long n_ = __builtin_amdgcn_s_memrealtime(); if ((PROBE_MASK >> (k)) & 1u) PROBE_LDS(1) += n_ - PROBE_LDS(0); PROBE_LDS(0) = n_; } } } while (0)
    { PHASE_BEGIN ph_prologue(p, Y); }                                    xcd_barrier(bar); PB(0);
    { PHASE_BEGIN ph_norm0(p, Y); }                                       xcd_barrier(bar); PB(1);
    {
        PHASE_BEGIN
        pg8::DenseOrder So; So.init(T, PROJ_LD, X.G, X.bid);
        pg8::Gemm g{WSB(WS_U), WSB(WS_WIN), 1024};
        pg8::EpiBf16 E{WSB(WS_BIG), PROJ_LD};
        pg8::gemm_phase<pg8::EpiBf16, pg8::DenseOrder>(X.lds, g, So, E, Y.tid);
    }
    {
        PHASE_BEGIN
        pg8::DenseOrder So; So.init(768, T, X.G, X.bid);
        pg8::Gemm g{WSB(WS_WV), WSB(WS_U), 1024};
        pg8::EpiBf16 E{WSB(WS_VT), T};
        pg8::gemm_phase<pg8::EpiBf16, pg8::DenseOrder>(X.lds, g, So, E, Y.tid);
    }
    xcd_barrier(bar); PB(2);
    { PHASE_BEGIN ph_attn_a(p, Y); }                                      xcd_barrier(bar); PB(3);
    ConvCur ccur; ccur.it = X.gw; ccur.step = X.ngw;
    { PHASE_BEGIN ph_nsa(p, Y, ccur); if (PROBE_SUB && X.lane == 0) PROBE_LDS(1) += Y.sub; }
    __syncthreads(); PB(19);
    { PHASE_BEGIN ph_sb(p, Y, ccur); if (PROBE_SUB && X.lane == 0) PROBE_LDS(1) += Y.sub; }                                             xcd_barrier(bar); PB(4);
    {
        PHASE_BEGIN
        pg8::DenseOrder So; So.init(T, D, X.G, X.bid);
        pg8::Gemm g{WSB(WS_O), WSB(WS_WOUT), 1024};
        pg8::EpiResid<false> E{p.in[0], WSB(WS_H1), WSF(WS_MODF) + 2048};
        pg8::gemm_phase<pg8::EpiResid<false>, pg8::DenseOrder>(X.lds, g, So, E, Y.tid);
    }
    xcd_barrier(bar); PB(5);
    { PHASE_BEGIN ph_token<0>(p, Y, 0, WSB(WS_H1), nullptr); if (PROBE_SUB && X.lane == 0) PROBE_LDS(1) += Y.sub; }                       xcd_barrier(bar); PB(6);
    { PHASE_BEGIN ph_moe_gu(p, Y, 0); }                                   xcd_barrier(bar); PB(7);
    { PHASE_BEGIN ph_moe_down(p, Y, 0); }                                 xcd_barrier(bar); PB(8);
    { PHASE_BEGIN ph_token<1>(p, Y, 0, WSB(WS_H1), WSB(WS_H2)); if (PROBE_SUB && X.lane == 0) PROBE_LDS(1) += Y.sub; }       xcd_barrier(bar); PB(9);
    {
        PHASE_BEGIN
        pg8::DenseOrder So; So.init(T, 3072, X.G, X.bid);
        pg8::Gemm g{WSB(WS_U), WSB(WS_WSIN), 1024};
        pg8::EpiBf16 E{WSB(WS_ZBC), 3072};
        pg8::gemm_phase<pg8::EpiBf16, pg8::DenseOrder>(X.lds, g, So, E, Y.tid);
    }
    {
        PHASE_BEGIN
        pg8::DenseOrder So; So.init(3072, T, X.G, X.bid);
        pg8::Gemm g{WSB(WS_WSIN) + (size_t)2048 * 1024, WSB(WS_U), 1024};
        pg8::EpiBf16 E{WSB(WS_XT), T};
        pg8::gemm_phase<pg8::EpiBf16, pg8::DenseOrder>(X.lds, g, So, E, Y.tid);
    }
    xcd_barrier(bar); PB(10);
    { PHASE_BEGIN ph_ssd1(p, Y); if (PROBE_SUB && X.lane == 0) PROBE_LDS(1) += Y.sub; }                                        xcd_barrier(bar); PB(11);
    { PHASE_BEGIN ph_ssd2(Y); }                                           xcd_barrier(bar); PB(12);
    { PHASE_BEGIN ph_ssd3(p, Y); if (PROBE_SUB && X.lane == 0) PROBE_LDS(1) += Y.sub; }                                        xcd_barrier(bar); PB(13);
    {
        PHASE_BEGIN
        pg8::DenseOrder So; So.init(T, D, X.G, X.bid);
        pg8::Gemm g{WSB(WS_O), WSB(WS_WSOUT), 2048};
        pg8::EpiResid<true> E{WSB(WS_H2), WSB(WS_H1), WSF(WS_MODF) + 4 * 6144 + 2048};
        pg8::gemm_phase<pg8::EpiResid<true>, pg8::DenseOrder>(X.lds, g, So, E, Y.tid);
    }
    xcd_barrier(bar); PB(14);
    { PHASE_BEGIN ph_token<0>(p, Y, 1, WSB(WS_H1), nullptr); if (PROBE_SUB && X.lane == 0) PROBE_LDS(1) += Y.sub; }                       xcd_barrier(bar); PB(15);
    { PHASE_BEGIN ph_moe_gu(p, Y, 1); }                                   xcd_barrier(bar); PB(16);
    { PHASE_BEGIN ph_moe_down(p, Y, 1); }                                 xcd_barrier(bar); PB(17);
    if (PROBE_MASK & 0x100000) { for (int xb_ = 0; xb_ < 8; ++xb_) xcd_barrier(bar); }
    { PHASE_BEGIN ph_token<2>(p, Y, 1, WSB(WS_H1), p.out); if (PROBE_SUB && X.lane == 0) PROBE_LDS(1) += Y.sub; } PB(18);
    if (PROBE_MASK || PROBE_SUB) { asm volatile("s_waitcnt lgkmcnt(0)" ::: "memory"); const unsigned long long acc_ = PROBE_LDS(1); const unsigned long long t_end = __builtin_amdgcn_s_memrealtime() + (unsigned long long)PROBE_MULT * (unsigned long long)__builtin_amdgcn_readfirstlane((unsigned)acc_); while (__builtin_amdgcn_s_memrealtime() < t_end) __builtin_amdgcn_s_sleep(8); }
#undef PB
#undef PROBE_LDS
#undef PHASE_BEGIN
#undef WSF
#undef WSB
}
}

extern "C" void kernel_launch(void* const* d_in, const int* in_sizes, int n_in, void* d_out, int out_size, void* d_ws, size_t ws_size, hipStream_t stream) {
    static int grid = 0;
    if (grid == 0) {
        if (n_in != 30 || out_size != T * D || ws_size < WS_END) { fprintf(stderr, "kernel_launch: unexpected shapes / workspace (%d inputs, out %d, ws %zu < %zu)\n", n_in, out_size, ws_size, (size_t)WS_END); grid = -1; return; }
        int dev = 0, cus = 0, per_cu = 0;
        if (hipGetDevice(&dev) != hipSuccess || hipDeviceGetAttribute(&cus, hipDeviceAttributeMultiprocessorCount, dev) != hipSuccess) { grid = -1; return; }
        if (hipFuncSetAttribute((const void*)fwd_kernel, hipFuncAttributeMaxDynamicSharedMemorySize, LDS_BYTES) != hipSuccess) { fprintf(stderr, "kernel_launch: hipFuncSetAttribute failed\n"); grid = -1; return; }
        if (hipOccupancyMaxActiveBlocksPerMultiprocessor(&per_cu, (const void*)fwd_kernel, NTHREADS, LDS_BYTES) != hipSuccess || per_cu < 1) { fprintf(stderr, "kernel_launch: occupancy query reports %d\n", per_cu); }
        (void)hipGetLastError();
        grid = cus;
    }
    if (grid < 0) return;
    if (hipMemsetAsync((char*)d_ws + WS_CTL, 0, CTL_BYTES, stream) != hipSuccess) return;
    Params p{};
    for (int i = 0; i < 30; ++i) p.in[i] = (const float*)d_in[i];
    p.out = (float*)d_out; p.ws = (unsigned char*)d_ws;
    hipLaunchKernelGGL(fwd_kernel, dim3(grid), dim3(NTHREADS), LDS_BYTES, stream, p);
}
```

```cpp
#include <hip/hip_runtime.h>
#include <cstdio>
#include <cstdint>

#define LAS __attribute__((address_space(3)))
#ifndef PROBE_MASK
#define PROBE_MASK 0
#endif
#ifndef PROBE_SUB
#define PROBE_SUB 0
#endif
#define GAS __attribute__((address_space(1)))
typedef unsigned short bf16_t;
typedef short bf16x8 __attribute__((ext_vector_type(8)));
typedef float f32x4 __attribute__((ext_vector_type(4)));
typedef unsigned u32x4 __attribute__((ext_vector_type(4)));
typedef unsigned u32x2 __attribute__((ext_vector_type(2)));
typedef float f32x16 __attribute__((ext_vector_type(16)));

namespace {
constexpr int D = 1024, NB = 4, S = 4096, T = NB * S;
constexpr int ATTN_IN = 2840, PROJ_LD = 3072;
constexpr int OFF_SBQ = 0, OFF_SBK = 512, OFF_SBV = 1024, OFF_NQ = 1536, OFF_KC = 2048, OFF_VC = 2176, OFF_KS = 2304, OFF_VS = 2432,
              OFF_KW = 2560, OFF_VW = 2688, OFF_GATE = 2816;
constexpr int NCMP = 255;
constexpr int SSM_IN = 5152, SSM_INNER = 2048, CONV_DIM = 3072, ZX_LD = 5120;
constexpr int NE = 32, CAP = 16384, MAXTILES = 288;
constexpr float EPS = 1e-6f;
constexpr int NWAVES = 8, NTHREADS = 512;

constexpr size_t al4k(size_t x) { return (x + 4095) & ~(size_t)4095; }
constexpr size_t WS_CTL = 0, CTL_BYTES = 1u << 20;
constexpr int CW_CNT = 256;
constexpr int CW_BAR = 4096;
constexpr size_t CTL_MOD = 65536;
constexpr size_t WS_WIN = CTL_BYTES;
constexpr size_t WS_WOUT = WS_WIN + (size_t)3072 * 1024 * 2;
constexpr size_t WS_WSIN = WS_WOUT + (size_t)1024 * 1024 * 2;
constexpr size_t WS_WSOUT = WS_WSIN + (size_t)5120 * 1024 * 2;
constexpr size_t WS_WGU = WS_WSOUT + (size_t)1024 * 2048 * 2;
constexpr size_t WS_WDN = WS_WGU + (size_t)2 * 32 * 2048 * 1024 * 2;
constexpr size_t WS_U = WS_WDN + (size_t)2 * 32 * 1024 * 1024 * 2;
constexpr size_t WS_BIG = WS_U + (size_t)T * 1024 * 2;
constexpr size_t WS_O = WS_BIG + (size_t)T * 5120 * 2;
constexpr size_t WS_H1 = WS_O + (size_t)T * 2048 * 2;
constexpr size_t WS_H2 = WS_H1 + (size_t)T * 1024 * 4;
constexpr size_t WS_QN = WS_H2 + (size_t)T * 1024 * 4;
constexpr size_t WS_KN = WS_QN + (size_t)T * 512 * 4;
constexpr size_t WS_KCMP = WS_KN + (size_t)T * 256 * 4;
constexpr size_t WS_VCMP = WS_KCMP + al4k((size_t)NB * NCMP * 2 * 64 * 4);
constexpr size_t WS_ACT = WS_VCMP + al4k((size_t)NB * NCMP * 2 * 64 * 4);
constexpr size_t WS_Y = WS_ACT + (size_t)MAXTILES * 256 * 1024 * 2;
constexpr size_t WS_TOKE = WS_Y + (size_t)MAXTILES * 256 * 1024 * 2;
constexpr size_t WS_TOKW = WS_TOKE + (size_t)T * 16;
constexpr size_t WS_TOKP = WS_TOKW + (size_t)T * 16;
constexpr size_t WS_SLOT = WS_TOKP + (size_t)T * 16;
constexpr size_t WS_XC = WS_SLOT + (size_t)NE * CAP * 4;
constexpr size_t WS_YS = WS_XC + (size_t)T * 3072 * 4;
constexpr size_t WS_DT = WS_YS + (size_t)T * 2048 * 4;
constexpr size_t WS_MODF = WS_DT + (size_t)T * 32 * 4;
constexpr size_t WS_WV = WS_MODF + (size_t)2 * 4 * 6144 * 4;
constexpr size_t WS_VT = WS_WV + (size_t)768 * 1024 * 2;
constexpr size_t WS_QNB = WS_VT + (size_t)768 * T * 2;
constexpr size_t WS_KSN = WS_QNB + (size_t)T * 512 * 2;
constexpr size_t WS_KWN = WS_KSN + (size_t)T * 128 * 2;
constexpr size_t WS_KCB = WS_KWN + (size_t)T * 128 * 2;
constexpr size_t WS_VCT = WS_KCB + (size_t)8 * 256 * 64 * 2;
constexpr size_t WS_DT2 = WS_VCT + (size_t)8 * 64 * 256 * 2;
constexpr size_t WS_CS = WS_DT2 + (size_t)NB * 32 * S * 4;
constexpr size_t WS_DEC = WS_CS + (size_t)NB * 32 * S * 4;
constexpr size_t WS_W1T = WS_DEC + al4k((size_t)NB * 16 * 32 * 4);
constexpr size_t WS_SKW = WS_W1T + (size_t)2 * 128 * 2048 * 2;
constexpr size_t WS_ULO = WS_SKW + (size_t)3 * 2 * 32 * 1024 * 2;
constexpr size_t WS_END = WS_ULO + (size_t)T * 1024 * 2;
constexpr size_t WS_ZBC = WS_BIG, WS_XT = WS_XC, WS_XCT = WS_XC + (size_t)3072 * T * 2, WS_ST = WS_YS, WS_PB = WS_YS + (size_t)NB * 16 * 32 * 8192 * 4, WS_BCM = WS_QN;
static_assert(WS_XCT + (size_t)2560 * T * 2 <= WS_YS && WS_PB + (size_t)NB * 16 * 32 * 8192 * 2 <= WS_DT && (size_t)T * 1024 * 2 <= (size_t)T * 512 * 4, "layer-1 overlays");

constexpr int RING_BYTES = 131072;
constexpr int EXTRA_OFF = RING_BYTES;
constexpr int TAB_OFF = 151552;
constexpr int XB_OFF = 152576;
constexpr int LDS_BYTES = 153600;

struct Params { const float* in[30]; float* out; unsigned char* ws; };

__device__ __forceinline__ float siluf(float v) { return v / (1.f + expf(-v)); }
__device__ __forceinline__ float logsig(float x) { return fminf(x, 0.f) - log1pf(expf(-fabsf(x))); }
__device__ __forceinline__ float wave_sum(float v) {
#pragma unroll
    for (int o = 32; o > 0; o >>= 1) v += __shfl_xor(v, o);
    return v;
}
__device__ __forceinline__ float wave_max(float v) {
#pragma unroll
    for (int o = 32; o > 0; o >>= 1) v = fmaxf(v, __shfl_xor(v, o));
    return v;
}
__device__ __forceinline__ unsigned f2bf(float f) { unsigned u = __builtin_bit_cast(unsigned, f); return (u + 0x7fffu + ((u >> 16) & 1u)) >> 16; }
typedef float f32x2_t __attribute__((ext_vector_type(2))); typedef __bf16 bf16x2_t __attribute__((ext_vector_type(2)));
__device__ __forceinline__ unsigned pk2(float lo, float hi) { f32x2_t v = {lo, hi}; bf16x2_t b = __builtin_convertvector(v, bf16x2_t); return __builtin_bit_cast(unsigned, b); }
__device__ __forceinline__ float bf2f(bf16_t v) { return __uint_as_float((unsigned)v << 16); }
__device__ __forceinline__ float bflo(unsigned w) { return __uint_as_float(w << 16); }
__device__ __forceinline__ float bfhi(unsigned w) { return __uint_as_float(w & 0xffff0000u); }
#define LDS_WAIT() asm volatile("s_waitcnt lgkmcnt(0)" ::: "memory")
__device__ __forceinline__ int fresh(int v) { asm volatile("" : "+v"(v)); return v; }
__device__ __forceinline__ int sfresh(int v) { asm volatile("" : "+s"(v)); return v; }

#define XB_TMO      128
#define XB_XCNT(j)  (256  + 64 * (j))
#define XB_XSUB(j)  (1280 + 64 * (j))
#define XB_XGEN(j)  (2304 + 64 * (j))
#define XB_TOP      3328
#define XB_TOPGEN   3392
#define XCD_BAR_WORDS 3456
#define XB_SPIN_CAP (1u << 18)
__device__ __forceinline__ unsigned xb_ld(unsigned* p)              { return __hip_atomic_load(p, __ATOMIC_RELAXED, __HIP_MEMORY_SCOPE_AGENT); }
__device__ __forceinline__ unsigned xb_add(unsigned* p, unsigned v) { return __hip_atomic_fetch_add(p, v, __ATOMIC_RELAXED, __HIP_MEMORY_SCOPE_AGENT); }
__device__ __forceinline__ unsigned xb_xcc_id() { return (unsigned)__builtin_amdgcn_s_getreg((3 << 11) | 20) & 0xFu; }
#define XB_SPIN(cond, bar) do { unsigned _sp = 0; while (cond) { __builtin_amdgcn_s_sleep(1); \
    if ((++_sp & 255u) == 0u) { if (xb_ld(&(bar)[XB_TMO])) break; if (_sp > XB_SPIN_CAP) { atomicAdd(&(bar)[XB_TMO], 1u); break; } } } } while (0)
struct XcdBarrier { unsigned* bar; unsigned x; volatile LAS unsigned* st; };
__device__ __forceinline__ XcdBarrier xcd_barrier_post(unsigned* bar, volatile LAS unsigned* st) {
    XcdBarrier b; b.bar = bar; b.x = xb_xcc_id(); b.st = st;
    if (threadIdx.x == 0) (void)xb_add(&bar[XB_XCNT(b.x)], 1u);
    return b;
}
__device__ __forceinline__ void xcd_barrier_complete(unsigned* bar, unsigned x, unsigned& nloc, unsigned& nx) {
    const unsigned G = gridDim.x * gridDim.y * gridDim.z;
    unsigned sum, cnt, mine, sp = 0u;
    for (;;) {
        sum = 0u; cnt = 0u; mine = 0u;
#pragma unroll
        for (unsigned j = 0; j < 16; ++j) { const unsigned c = xb_ld(&bar[XB_XCNT(j)]); sum += c; cnt += (c > 0u) ? 1u : 0u; mine = (j == x) ? c : mine; }
        if (sum == G) break;
        __builtin_amdgcn_s_sleep(1);
        if ((++sp & 255u) == 0u) { if (xb_ld(&bar[XB_TMO])) break; if (sp > XB_SPIN_CAP) { atomicAdd(&bar[XB_TMO], 1u); break; } }
    }
    nloc = mine > 0u ? mine : 1u; nx = cnt > 0u ? cnt : 1u;
}
__device__ __forceinline__ void xcd_barrier(const XcdBarrier& b) {
    asm volatile("s_waitcnt vmcnt(0)" ::: "memory");
    __syncthreads();
    if (threadIdx.x == 0) {
        unsigned* bar = b.bar;
        __builtin_amdgcn_s_waitcnt(0);
        unsigned nloc = b.st[0], nx = b.st[1];
        if (nloc == 0u) { xcd_barrier_complete(bar, b.x, nloc, nx); b.st[0] = nloc; b.st[1] = nx; }
        const unsigned old = xb_add(&bar[XB_XSUB(b.x)], 1u);
        const unsigned gen = old / nloc;
        if (old + 1u == (gen + 1u) * nloc) {
            __builtin_amdgcn_fence(__ATOMIC_RELEASE, "agent");
            asm volatile("s_waitcnt vmcnt(0)" ::: "memory");
            const unsigned og = xb_add(&bar[XB_TOP], 1u);
            const unsigned tg = og / nx;
            if (og + 1u == (tg + 1u) * nx) xb_add(&bar[XB_TOPGEN], 1u);
            else XB_SPIN(xb_ld(&bar[XB_TOPGEN]) == tg, bar);
            __builtin_amdgcn_fence(__ATOMIC_ACQUIRE, "agent");
            xb_add(&bar[XB_XGEN(b.x)], 1u);
            asm volatile("s_waitcnt vmcnt(0)" ::: "memory");
        } else {
            XB_SPIN(xb_ld(&bar[XB_XGEN(b.x)]) == gen, bar);
            __builtin_amdgcn_fence(__ATOMIC_ACQUIRE, "agent");
            asm volatile("s_waitcnt vmcnt(0)" ::: "memory");
        }
    }
    __syncthreads();
}

namespace pg8 {
constexpr int BM = 256, BK = 64, HALF = 128, HTB = HALF * BK * 2, STAGE_BYTES = 8 * HTB;
__device__ __forceinline__ int lds_byte(int r, int c) { const int st = (r >> 4) * 2 + (c >> 5), rr = r & 15, cc = c & 31, ob = rr * 64 + cc * 2; return st * 1024 + (ob ^ (((ob >> 9) & 1) << 5)); }
__device__ __forceinline__ void stage_rc(int b, int& R, int& C) { const int st = b / 1024, sb = b % 1024, swz = sb ^ (((sb >> 9) & 1) << 5); R = (st >> 1) * 16 + swz / 64; C = (st & 1) * 32 + (swz % 64) / 2; }
__device__ __forceinline__ int perm32(int rho) { const int n = rho >> 4, i = rho & 15; return 8 * (i >> 2) + 4 * n + (i & 3); }
struct Unit { int pm, pn, e; };
struct Gemm { const bf16_t* A; const bf16_t* Bt; int K; };
__device__ __forceinline__ unsigned cvt_pk_bf16(float lo, float hi) { unsigned r; asm volatile("v_cvt_pk_bf16_f32 %0, %1, %2" : "=v"(r) : "v"(lo), "v"(hi)); return r; }

struct DenseOrder {
    int nM, nN, nwg, G, c;
    __device__ void init(int M, int N, int G_, int c_) { nM = M / BM; nN = N / BM; nwg = nM * nN; G = G_; c = c_; }
    __device__ bool next(int i, Unit& u) const {
        const long L = (long)i * G + c; if (L >= nwg) return false;
        int wgid = (int)L; { const int q = nwg / 8, r = nwg % 8, xcd = wgid % 8, off = wgid / 8; wgid = (xcd < r ? xcd * (q + 1) : r * (q + 1) + (xcd - r) * q) + off; }
        const int nig = 8 * nN, gid = wgid / nig, fm = gid * 8, gsz = (nM - fm) < 8 ? (nM - fm) : 8;
        u.pm = fm + ((wgid % nig) % gsz); u.pn = (wgid % nig) / gsz; u.e = 0; return true;
    }
    __device__ __forceinline__ unsigned arow(const Unit& u, int r) const { return (unsigned)(u.pm * BM + r); }
};
struct MoeOrder {
    const LAS int* tb; const LAS int* cn; const int* slot_tok; int shift, G, c; bool gather;
    __device__ bool next(int i, Unit& u) const {
        const int L = i * G + c, tile = L >> shift; if (tile >= tb[NE]) return false;
        int e = 0; while (tb[e + 1] <= tile) ++e;
        u.pm = tile; u.pn = (e << shift) + (L & ((1 << shift) - 1)); u.e = e; return true;
    }
    __device__ __forceinline__ unsigned arow(const Unit& u, int r) const {
        if (!gather) return (unsigned)(u.pm * BM + r);
        const int pos = (u.pm - tb[u.e]) * BM + r;
        return pos < cn[u.e] ? (unsigned)slot_tok[u.e * CAP + pos] : 0u;
    }
};

struct EpiBf16 {
    static constexpr bool PERM = true;
    bf16_t* O; int ldc;
    __device__ __forceinline__ void operator()(const f32x4 (&acc)[2][2][4][2], const Unit& u, int wr, int wc, int fr, int fq) const {
        const int row0 = u.pm * BM + wr * 64 + fr, col0 = u.pn * BM + wc * 32 + 8 * fq;
#pragma unroll
        for (int ai = 0; ai < 2; ++ai)
#pragma unroll
            for (int m = 0; m < 4; ++m) { bf16_t* rowp = O + (size_t)(row0 + ai * HALF + m * 16) * ldc + col0;
#pragma unroll
                for (int bj = 0; bj < 2; ++bj) { const f32x4 v0 = acc[ai][bj][m][0], v1 = acc[ai][bj][m][1];
                    u32x4 w; w.x = cvt_pk_bf16(v0[0], v0[1]); w.y = cvt_pk_bf16(v0[2], v0[3]); w.z = cvt_pk_bf16(v1[0], v1[1]); w.w = cvt_pk_bf16(v1[2], v1[3]);
                    *(u32x4*)(rowp + bj * HALF) = w; } }
    }
};
template <bool BASE_BF16>
struct EpiResid {
    static constexpr bool PERM = true;
    const void* base; bf16_t* out; const float* g;
    __device__ __forceinline__ void operator()(const f32x4 (&acc)[2][2][4][2], const Unit& u, int wr, int wc, int fr, int fq) const {
        const int row0 = u.pm * BM + wr * 64 + fr, col0 = u.pn * BM + wc * 32 + 8 * fq;
        const float* gb = g + (size_t)((u.pm * BM) / S) * 6144 + col0;
        f32x4 gv[2][2];
#pragma unroll
        for (int bj = 0; bj < 2; ++bj)
#pragma unroll
            for (int n = 0; n < 2; ++n) gv[bj][n] = *(const f32x4*)(gb + bj * HALF + n * 4);
#pragma unroll
        for (int ai = 0; ai < 2; ++ai) {
            f32x4 b0[4][2], b1[4][2];
#pragma unroll
            for (int m = 0; m < 4; ++m) { const size_t off = (size_t)(row0 + ai * HALF + m * 16) * D + col0;
#pragma unroll
                for (int bj = 0; bj < 2; ++bj) {
                    if (BASE_BF16) { const u32x4 q = *(const u32x4*)((const bf16_t*)base + off + bj * HALF); b0[m][bj] = (f32x4){bflo(q.x), bfhi(q.x), bflo(q.y), bfhi(q.y)}; b1[m][bj] = (f32x4){bflo(q.z), bfhi(q.z), bflo(q.w), bfhi(q.w)}; }
                    else { b0[m][bj] = *(const f32x4*)((const float*)base + off + bj * HALF); b1[m][bj] = *(const f32x4*)((const float*)base + off + bj * HALF + 4); } } }
            asm volatile("" ::: "memory");
#pragma unroll
            for (int m = 0; m < 4; ++m) { const size_t off = (size_t)(row0 + ai * HALF + m * 16) * D + col0;
#pragma unroll
                for (int bj = 0; bj < 2; ++bj) {
                    const f32x4 v0 = b0[m][bj] + gv[bj][0] * acc[ai][bj][m][0], v1 = b1[m][bj] + gv[bj][1] * acc[ai][bj][m][1];
                    u32x4 w; w.x = cvt_pk_bf16(v0[0], v0[1]); w.y = cvt_pk_bf16(v0[2], v0[3]); w.z = cvt_pk_bf16(v1[0], v1[1]); w.w = cvt_pk_bf16(v1[2], v1[3]);
                    *(u32x4*)(out + off + bj * HALF) = w; } }
        }
    }
};
struct EpiGu {
    static constexpr bool PERM = true;
    bf16_t* act; const float* bgu;
    __device__ __forceinline__ void operator()(const f32x4 (&acc)[2][2][4][2], const Unit& u, int wr, int wc, int fr, int fq) const {
        const int row0 = u.pm * BM + wr * 64 + fr, col0 = (u.pn & 7) * HALF + wc * 32 + 8 * fq;
        const float* bb = bgu + (size_t)u.e * 2048 + col0;
        const f32x4 bg0 = *(const f32x4*)(bb), bg1 = *(const f32x4*)(bb + 4), bu0 = *(const f32x4*)(bb + 1024), bu1 = *(const f32x4*)(bb + 1028);
#pragma unroll
        for (int ai = 0; ai < 2; ++ai)
#pragma unroll
            for (int m = 0; m < 4; ++m) {
                float r[8];
#pragma unroll
                for (int n = 0; n < 2; ++n) { const f32x4 gt = acc[ai][0][m][n] + (n ? bg1 : bg0), up = acc[ai][1][m][n] + (n ? bu1 : bu0);
#pragma unroll
                    for (int j = 0; j < 4; ++j) { const float gg = fminf(gt[j], 7.f), uu = fminf(fmaxf(up[j], -7.f), 7.f);
                        r[n * 4 + j] = (uu + 1.f) * gg * __builtin_amdgcn_rcpf(1.f + __expf(-1.702f * gg)); } }
                u32x4 w; w.x = cvt_pk_bf16(r[0], r[1]); w.y = cvt_pk_bf16(r[2], r[3]); w.z = cvt_pk_bf16(r[4], r[5]); w.w = cvt_pk_bf16(r[6], r[7]);
                *(u32x4*)(act + (size_t)(row0 + ai * HALF + m * 16) * D + col0) = w; }
    }
};
struct EpiDown {
    static constexpr bool PERM = true;
    bf16_t* y; const float* bd;
    __device__ __forceinline__ void operator()(const f32x4 (&acc)[2][2][4][2], const Unit& u, int wr, int wc, int fr, int fq) const {
        const int row0 = u.pm * BM + wr * 64 + fr, col0 = (u.pn & 3) * BM + wc * 32 + 8 * fq;
        const float* bb = bd + (size_t)u.e * 1024 + col0;
        f32x4 bv[2][2];
#pragma unroll
        for (int bj = 0; bj < 2; ++bj)
#pragma unroll
            for (int n = 0; n < 2; ++n) bv[bj][n] = *(const f32x4*)(bb + bj * HALF + 4 * n);
#pragma unroll
        for (int ai = 0; ai < 2; ++ai)
#pragma unroll
            for (int m = 0; m < 4; ++m) { bf16_t* rowp = y + (size_t)(row0 + ai * HALF + m * 16) * D + col0;
#pragma unroll
                for (int bj = 0; bj < 2; ++bj) { const f32x4 v0 = acc[ai][bj][m][0] + bv[bj][0], v1 = acc[ai][bj][m][1] + bv[bj][1];
                    u32x4 w; w.x = cvt_pk_bf16(v0[0], v0[1]); w.y = cvt_pk_bf16(v0[2], v0[3]); w.z = cvt_pk_bf16(v1[0], v1[1]); w.w = cvt_pk_bf16(v1[2], v1[3]);
                    *(u32x4*)(rowp + bj * HALF) = w; } }
    }
};

template <class Epi, class Sched>
__device__ __forceinline__ void gemm_phase(LAS unsigned char* lds, const Gemm g, const Sched& S, const Epi& E, const int tid) {
    const int wid = __builtin_amdgcn_readfirstlane(tid >> 6), lane = tid & 63, wr = wid >> 2, wc = wid & 3, fr = lane & 15, fq = lane >> 4;
    const int K = g.K, nt = K / BK;
    int RA[2], CA[2]; unsigned voffB[2];
#pragma unroll
    for (int i = 0; i < 2; ++i) { int R, C; stage_rc(tid * 16 + i * 8192, R, C); const int Rb = Epi::PERM ? ((R & ~31) + perm32(R & 31)) : R;
        RA[i] = R; CA[i] = C; voffB[i] = (unsigned)(Rb * K + C) * 2u; }
    const size_t kstep = (size_t)(BK * 2);
    const size_t hstep = (size_t)HALF * K * 2;
    const size_t tstep = 2 * hstep;
    const unsigned ldsw = (unsigned)wid * 1024u;
    const int aoff = lds_byte(wr * 64 + fr, fq * 8), boff = lds_byte(wc * 32 + fr, fq * 8);
#define PG8_SA(b, h) (((b) * 2 + (h)) * HTB)
#define PG8_SB(b, h) ((4 + (b) * 2 + (h)) * HTB)
#define PG8_STAGE(bufoff, gbase, voff) do { _Pragma("unroll") for (int _i = 0; _i < 2; ++_i) \
        __builtin_amdgcn_global_load_lds((const unsigned*)((const char*)(gbase) + (voff)[_i]), (LAS unsigned*)(lds + (bufoff) + ldsw + _i * 8192), 16, 0, 0); } while (0)
#define PG8_LDA(dst, b, h) do { _Pragma("unroll") for (int m = 0; m < 4; ++m) _Pragma("unroll") for (int k = 0; k < 2; ++k) dst[m][k] = *(const LAS bf16x8*)(lds + PG8_SA(b, h) + aoff + m * 2048 + k * 1024); } while (0)
#define PG8_LDB(dst, b, h) do { _Pragma("unroll") for (int n = 0; n < 2; ++n) _Pragma("unroll") for (int k = 0; k < 2; ++k) dst[n][k] = *(const LAS bf16x8*)(lds + PG8_SB(b, h) + boff + n * 2048 + k * 1024); } while (0)
#define PG8_MMA(ai, bj, At, Bt) do { __builtin_amdgcn_s_setprio(1); _Pragma("unroll") for (int m = 0; m < 4; ++m) _Pragma("unroll") for (int n = 0; n < 2; ++n) _Pragma("unroll") for (int k = 0; k < 2; ++k) \
        acc[ai][bj][m][n] = __builtin_amdgcn_mfma_f32_16x16x32_bf16(Bt[n][k], At[m][k], acc[ai][bj][m][n], 0, 0, 0); __builtin_amdgcn_s_setprio(0); } while (0)
#define PG8_WAIT_V(n) asm volatile("s_waitcnt vmcnt(" #n ")" ::: "memory")
#define PG8_WAIT_L(n) asm volatile("s_waitcnt lgkmcnt(" #n ")" ::: "memory")
#define PG8_BAR __builtin_amdgcn_s_barrier()
#define PG8_SCHED __builtin_amdgcn_sched_barrier(0)
#define PG8_AOFF(dst, u) do { _Pragma("unroll") for (int _h = 0; _h < 2; ++_h) _Pragma("unroll") for (int _i = 0; _i < 2; ++_i) dst[_h][_i] = (S.arow(u, _h * HALF + RA[_i]) * (unsigned)K + (unsigned)CA[_i]) * 2u; } while (0)
    Unit cur, nxt; int ui = 0;
    if (!S.next(0, cur)) return;
    f32x4 acc[2][2][4][2];
#pragma unroll
    for (int a = 0; a < 2; ++a)
#pragma unroll
        for (int b = 0; b < 2; ++b)
#pragma unroll
            for (int m = 0; m < 4; ++m)
#pragma unroll
                for (int n = 0; n < 2; ++n) acc[a][b][m][n] = (f32x4){0.f, 0.f, 0.f, 0.f};
    bf16x8 At[4][2], B0[2][2], B1[2][2];
    unsigned va[2][2], vn[2][2];
    PG8_AOFF(va, cur);
    const char* Ab = (const char*)g.A;
    const char* cB = (const char*)g.Bt + (size_t)cur.pn * tstep;
    PG8_STAGE(PG8_SB(0, 0), cB, voffB); PG8_STAGE(PG8_SB(0, 1), cB + hstep, voffB); PG8_STAGE(PG8_SA(0, 0), Ab, va[0]); PG8_STAGE(PG8_SA(0, 1), Ab, va[1]);
    if (wr == 1) PG8_BAR;
    PG8_WAIT_V(2); PG8_BAR;
    PG8_STAGE(PG8_SB(1, 0), cB + kstep, voffB); PG8_STAGE(PG8_SA(1, 0), Ab + kstep, va[0]); PG8_STAGE(PG8_SB(1, 1), cB + hstep + kstep, voffB);
    PG8_WAIT_V(6); PG8_BAR;
    for (;;) {
        const bool has_next = S.next(ui + 1, nxt);
        if (has_next) { PG8_AOFF(vn, nxt); }
        else {
#pragma unroll
            for (int h = 0; h < 2; ++h)
#pragma unroll
                for (int i = 0; i < 2; ++i) vn[h][i] = va[h][i]; }
        const char* nB = has_next ? (const char*)g.Bt + (size_t)nxt.pn * tstep : cB;
        for (int t = 0; t < nt; t += 2) {
            const bool last = (t == nt - 2);
            const char* a1 = Ab + (size_t)(t + 1) * kstep;
            const char* a2 = last ? Ab : Ab + (size_t)(t + 2) * kstep; const char* b2 = last ? nB : cB + (size_t)(t + 2) * kstep;
            const char* a3 = a2 + kstep; const char* b3 = b2 + kstep;
            unsigned o2[2][2];
#pragma unroll
            for (int h = 0; h < 2; ++h)
#pragma unroll
                for (int i = 0; i < 2; ++i) o2[h][i] = last ? vn[h][i] : va[h][i];
            PG8_LDB(B0, 0, 0); PG8_LDB(B1, 0, 1); PG8_SCHED; PG8_LDA(At, 0, 0); PG8_STAGE(PG8_SA(1, 1), a1, va[1]);
            PG8_WAIT_V(8); PG8_WAIT_L(0); PG8_BAR; PG8_MMA(0, 0, At, B0); PG8_MMA(0, 1, At, B1); PG8_BAR; PG8_SCHED;
            PG8_LDA(At, 0, 1); PG8_STAGE(PG8_SB(0, 0), b2, voffB); PG8_STAGE(PG8_SB(0, 1), b2 + hstep, voffB); PG8_STAGE(PG8_SA(0, 0), a2, o2[0]);
            PG8_WAIT_V(8); PG8_WAIT_L(0); PG8_BAR; PG8_MMA(1, 0, At, B0); PG8_MMA(1, 1, At, B1); PG8_BAR; PG8_SCHED;
            PG8_LDB(B0, 1, 0); PG8_LDB(B1, 1, 1); PG8_SCHED; PG8_LDA(At, 1, 0); PG8_STAGE(PG8_SA(0, 1), a2, o2[1]);
            PG8_WAIT_V(8); PG8_WAIT_L(0); PG8_BAR; PG8_MMA(0, 0, At, B0); PG8_MMA(0, 1, At, B1); PG8_BAR; PG8_SCHED;
            PG8_LDA(At, 1, 1); PG8_STAGE(PG8_SB(1, 0), b3, voffB); PG8_STAGE(PG8_SB(1, 1), b3 + hstep, voffB); PG8_STAGE(PG8_SA(1, 0), a3, o2[0]);
            PG8_WAIT_V(8); PG8_WAIT_L(0); PG8_BAR; PG8_MMA(1, 0, At, B0); PG8_MMA(1, 1, At, B1); PG8_BAR; PG8_SCHED;
        }
        if (wr == 0) PG8_BAR;
        E(acc, cur, wr, wc, fr, fq);
        if (!has_next) break;
#pragma unroll
        for (int a = 0; a < 2; ++a)
#pragma unroll
            for (int b = 0; b < 2; ++b)
#pragma unroll
                for (int m = 0; m < 4; ++m)
#pragma unroll
                    for (int n = 0; n < 2; ++n) acc[a][b][m][n] = (f32x4){0.f, 0.f, 0.f, 0.f};
        cur = nxt; cB = nB; ++ui;
#pragma unroll
        for (int h = 0; h < 2; ++h)
#pragma unroll
            for (int i = 0; i < 2; ++i) va[h][i] = vn[h][i];
        if (wr == 1) PG8_BAR;
    }
    PG8_WAIT_V(0);
    PG8_BAR;
#undef PG8_SA
#undef PG8_SB
#undef PG8_STAGE
#undef PG8_LDA
#undef PG8_LDB
#undef PG8_MMA
#undef PG8_WAIT_V
#undef PG8_WAIT_L
#undef PG8_BAR
#undef PG8_SCHED
#undef PG8_AOFF
}
}

struct Ctx {
    LAS unsigned char* lds; unsigned char* ws;
    int tid, lane, wave, gw, ngw, G, bid;
    mutable unsigned long long sub, subt;
};
#define SUB_BEGIN(X, id) do { if (PROBE_SUB == (id)) (X).subt = __builtin_amdgcn_s_memrealtime(); } while (0)
#define SUB_END(X, id) do { if (PROBE_SUB == (id)) (X).sub += __builtin_amdgcn_s_memrealtime() - (X).subt; } while (0)

__device__ __forceinline__ void transpose_item(const float* W, int ldw, int K, int nvalid, int k0, int n0, bf16_t* WT, int row0, LAS float* scr, int lane) {
    const int c4 = (lane & 7) * 4, kr = lane >> 3;
    f32x4 v[8];
#pragma unroll
    for (int i = 0; i < 8; ++i) v[i] = (n0 + c4 < nvalid) ? *(const f32x4*)(W + (size_t)(k0 + kr + 8 * i) * ldw + n0 + c4) : (f32x4){0.f, 0.f, 0.f, 0.f};
#pragma unroll
    for (int i = 0; i < 8; ++i) { LAS float* d = scr + (kr + 8 * i) * 33 + c4; d[0] = v[i].x; d[1] = v[i].y; d[2] = v[i].z; d[3] = v[i].w; }
    LDS_WAIT(); asm volatile("" ::: "memory");
    const int c = lane & 7;
#pragma unroll
    for (int j = 0; j < 4; ++j) { const int n = (lane >> 3) + 8 * j; const LAS float* s = scr + (8 * c) * 33 + n;
        u32x4 o; o.x = pk2(s[0 * 33], s[1 * 33]); o.y = pk2(s[2 * 33], s[3 * 33]); o.z = pk2(s[4 * 33], s[5 * 33]); o.w = pk2(s[6 * 33], s[7 * 33]);
        *(u32x4*)(WT + (size_t)(row0 + n) * K + k0 + 8 * c) = o; }
    LDS_WAIT(); asm volatile("" ::: "memory");
}
__device__ __forceinline__ void ph_prologue(const Params& p, const Ctx& X) {
    LAS float* scr = (LAS float*)(X.lds + X.wave * 16384);
    unsigned char* ws = X.ws;
    constexpr int I_MOD = 2 * 96 * 8;
    constexpr int I_SK = 3 * 16, I_W1 = 2 * 32 * 4, I_WIN = 16 * 96, I_WV = 16 * 24, I_WOUT = 16 * 32, I_WSIN = 16 * 160, I_WSOUT = 32 * 32;
    constexpr int NITEMS = I_MOD + I_SK + I_W1 + I_WIN + I_WV + I_WOUT + I_WSIN + I_WSOUT;
    for (int it = X.gw; it < NITEMS; it += X.ngw) {
        int r = it;
        if (r < I_MOD) {
            const int kp = r & 7, jb = (r >> 3) % 96, l = r / (8 * 96), j = jb * 64 + X.lane;
            const float* w = p.in[2] + (size_t)l * 1024 * 6144 + (size_t)(kp * 128) * 6144 + j;
            const float* c = p.in[1] + kp * 128;
            float a0 = 0.f, a1 = 0.f, a2 = 0.f, a3 = 0.f;
#pragma unroll 8
            for (int i = 0; i < 128; ++i) { const float wv = w[(size_t)i * 6144];
                a0 += siluf(c[i]) * wv; a1 += siluf(c[1024 + i]) * wv; a2 += siluf(c[2048 + i]) * wv; a3 += siluf(c[3072 + i]) * wv; }
            if (kp == 0) { const float bb = p.in[3][l * 6144 + j]; a0 += bb; a1 += bb; a2 += bb; a3 += bb; }
            unsigned long long* mq = (unsigned long long*)(ws + CTL_MOD) + (size_t)l * 4 * 6144 + j;
            atomicAdd(mq, (unsigned long long)__double2ll_rn((double)a0 * 1099511627776.0)); atomicAdd(mq + 6144, (unsigned long long)__double2ll_rn((double)a1 * 1099511627776.0));
            atomicAdd(mq + 2 * 6144, (unsigned long long)__double2ll_rn((double)a2 * 1099511627776.0)); atomicAdd(mq + 3 * 6144, (unsigned long long)__double2ll_rn((double)a3 * 1099511627776.0));
            continue;
        }
        r -= I_MOD;
        if (r < I_SK) {
            const int m = r >> 4, kb = r & 15, k0 = kb * 64;
            const float* W = m < 2 ? p.in[24] + (size_t)m * D * NE : p.in[16] + 5120; const int ldw = m < 2 ? NE : SSM_IN;
#pragma unroll 8
            for (int i = 0; i < 32; ++i) { const int kk = 2 * i + (X.lane >> 5); scr[kk * 33 + (X.lane & 31)] = W[(size_t)(k0 + kk) * ldw + (X.lane & 31)]; }
            LDS_WAIT(); asm volatile("" ::: "memory");
            const int c = X.lane & 7;
#pragma unroll
            for (int j = 0; j < 4; ++j) { const int n = (X.lane >> 3) + 8 * j; const LAS float* sp = scr + (8 * c) * 33 + n;
                float v[8]; unsigned hi[8];
#pragma unroll
                for (int q = 0; q < 8; ++q) { v[q] = sp[q * 33]; hi[q] = f2bf(v[q]); v[q] -= __uint_as_float(hi[q] << 16); }
                u32x4 oh, ol; oh.x = hi[0] | (hi[1] << 16); oh.y = hi[2] | (hi[3] << 16); oh.z = hi[4] | (hi[5] << 16); oh.w = hi[6] | (hi[7] << 16);
                ol.x = pk2(v[0], v[1]); ol.y = pk2(v[2], v[3]); ol.z = pk2(v[4], v[5]); ol.w = pk2(v[6], v[7]);
                bf16_t* dst = (bf16_t*)(ws + WS_SKW) + (size_t)m * 2 * 32 * 1024 + (size_t)n * 1024 + k0 + 8 * c;
                *(u32x4*)dst = oh; *(u32x4*)(dst + 32 * 1024) = ol; }
            LDS_WAIT(); asm volatile("" ::: "memory");
            continue; }
        r -= I_SK;
        if (r < I_W1) { const int kv = r >> 7, q = r & 127, kb = q >> 2, nb = q & 3;
            transpose_item(kv ? p.in[14] : p.in[12], 128, 2048, 128, kb * 64, nb * 32, (bf16_t*)(ws + WS_W1T) + (size_t)kv * 128 * 2048, nb * 32, scr, X.lane); continue; } r -= I_W1;
        if (r < I_WIN) { const int kb = r / 96, nb = r % 96; transpose_item(p.in[6], ATTN_IN, 1024, ATTN_IN, kb * 64, nb * 32, (bf16_t*)(ws + WS_WIN), nb * 32, scr, X.lane); continue; } r -= I_WIN;
        if (r < I_WV) { const int kb = r / 24, nb = r % 24, r0 = nb * 32, src = r0 < 512 ? OFF_SBV + r0 : (r0 < 640 ? OFF_VS + (r0 - 512) : OFF_VW + (r0 - 640));
            transpose_item(p.in[6], ATTN_IN, 1024, ATTN_IN, kb * 64, src, (bf16_t*)(ws + WS_WV), r0, scr, X.lane); continue; } r -= I_WV;
        if (r < I_WOUT) { const int kb = r / 32, nb = r % 32; transpose_item(p.in[7], 1024, 1024, 1024, kb * 64, nb * 32, (bf16_t*)(ws + WS_WOUT), nb * 32, scr, X.lane); continue; } r -= I_WOUT;
        if (r < I_WSIN) { const int kb = r / 160, nb = r % 160, n0 = nb * 32, row0 = n0 < 2048 ? n0 : (n0 < 4096 ? n0 + 1024 : n0 - 2048);
            transpose_item(p.in[16], SSM_IN, 1024, SSM_IN, kb * 64, n0, (bf16_t*)(ws + WS_WSIN), row0, scr, X.lane); continue; } r -= I_WSIN;
        { const int kb = r / 32, nb = r % 32; transpose_item(p.in[23], 1024, 2048, 1024, kb * 64, nb * 32, (bf16_t*)(ws + WS_WSOUT), nb * 32, scr, X.lane); }
    }
}

struct Row { f32x4 v[4]; };
__device__ __forceinline__ void row_load(Row& r, const float* p, int lane) {
#pragma unroll
    for (int j = 0; j < 4; ++j) r.v[j] = ((const f32x4*)p)[64 * j + lane];
}
__device__ __forceinline__ void row_load_bf16(Row& r, const bf16_t* p, int lane) {
#pragma unroll
    for (int j = 0; j < 4; ++j) { const u32x2 q = ((const u32x2*)p)[64 * j + lane]; r.v[j] = (f32x4){bflo(q.x), bfhi(q.x), bflo(q.y), bfhi(q.y)}; }
}
__device__ __forceinline__ void row_store(const Row& r, float* p, int lane) {
#pragma unroll
    for (int j = 0; j < 4; ++j) ((f32x4*)p)[64 * j + lane] = r.v[j];
}
template <class PV>
__device__ __forceinline__ void row_norm_mod(const Row& r, Row& o, const float* gain, PV sc, PV sh, int lane) {
    float ss = 0.f;
#pragma unroll
    for (int j = 0; j < 4; ++j) ss += (r.v[j].x * r.v[j].x + r.v[j].y * r.v[j].y) + (r.v[j].z * r.v[j].z + r.v[j].w * r.v[j].w);
    const float rs = rsqrtf(wave_sum(ss) * (1.f / 1024.f) + EPS);
#pragma unroll
    for (int j = 0; j < 4; ++j) { const f32x4 g = ((const f32x4*)gain)[64 * j + lane], a = sc[64 * j + lane], b = sh[64 * j + lane];
        o.v[j] = r.v[j] * rs * g * (a + 1.f) + b; }
}
__device__ __forceinline__ void row_store_bf16(const Row& r, bf16_t* p, int lane) {
#pragma unroll
    for (int j = 0; j < 4; ++j) { u32x2 w; w.x = pk2(r.v[j].x, r.v[j].y); w.y = pk2(r.v[j].z, r.v[j].w); ((u32x2*)p)[64 * j + lane] = w; }
}
__device__ __forceinline__ void row_store_lds(const Row& r, LAS float* p, int lane) {
#pragma unroll
    for (int j = 0; j < 4; ++j) ((LAS f32x4*)p)[64 * j + lane] = r.v[j];
}
__device__ __forceinline__ float modq2f(long long q) { return (float)((double)q * 9.094947017729282e-13); }
__device__ __forceinline__ void ph_norm0(const Params& p, const Ctx& X) {
    const long long* mq = (const long long*)(X.ws + CTL_MOD);
    float* modf = (float*)(X.ws + WS_MODF);
    for (int i = X.bid * NTHREADS + X.tid; i < 2 * 4 * 6144; i += X.G * NTHREADS) modf[i] = modq2f(mq[i]);
    LAS float* tab = (LAS float*)X.lds;
    for (int i = X.tid; i < 4 * 2048; i += NTHREADS) tab[i] = modq2f(mq[(size_t)(i >> 11) * 6144 + (i & 2047)]);
    __syncthreads();
    for (int t = X.gw; t < T; t += X.ngw) {
        Row r, o; row_load(r, p.in[0] + (size_t)t * D, X.lane);
        const LAS float* m = tab + (t / S) * 2048;
        row_norm_mod(r, o, p.in[4], (const LAS f32x4*)(m + 1024), (const LAS f32x4*)m, X.lane);
        row_store_bf16(o, (bf16_t*)(X.ws + WS_U) + (size_t)t * D, X.lane);
    }
}
__device__ __forceinline__ void route_select(float logit, int lane, LAS unsigned* lcnt, int& ev, float& wv, int& lpos) {
    const int e = lane & 31;
    float tl[4]; int te[4];
#pragma unroll
    for (int k = 0; k < 4; ++k) {
        float bv = logit; int bi = e;
#pragma unroll
        for (int o = 16; o > 0; o >>= 1) { const float ov = __shfl_xor(bv, o); const int oi = __shfl_xor(bi, o); if (ov > bv || (ov == bv && oi < bi)) { bv = ov; bi = oi; } }
        tl[k] = bv; te[k] = bi;
        if (e == bi) logit = -INFINITY;
    }
    ev = 0; wv = 0.f; lpos = 0;
    if (e < 4) {
        const float e1 = expf(tl[1] - tl[0]), e2 = expf(tl[2] - tl[0]), e3 = expf(tl[3] - tl[0]);
        const float inv = 1.f / (1.f + e1 + e2 + e3);
        wv = (e == 0 ? 1.f : e == 1 ? e1 : e == 2 ? e2 : e3) * inv;
        ev = e == 0 ? te[0] : e == 1 ? te[1] : e == 2 ? te[2] : te[3];
        lpos = (int)__hip_atomic_fetch_add(&lcnt[ev], 1u, __ATOMIC_RELAXED, __HIP_MEMORY_SCOPE_WORKGROUP);
    }
}
__device__ __forceinline__ void moe_table(const Ctx& X, int l) {
    LAS int* tb = (LAS int*)(X.lds + TAB_OFF);
    if (X.wave == 0) {
        const unsigned* cnt = (const unsigned*)(X.ws + WS_CTL) + CW_CNT + l * 32 * 32;
        const int e = X.lane & 31;
        const int c = (int)__hip_atomic_load(cnt + e * 32, __ATOMIC_RELAXED, __HIP_MEMORY_SCOPE_AGENT), nt = (c + 255) >> 8;
        int incl = nt;
#pragma unroll
        for (int o = 1; o < 32; o <<= 1) { const int u = __shfl_up(incl, o); if (e >= o) incl += u; }
        if (X.lane < 32) { tb[e] = incl - nt; tb[40 + e] = c; if (e == 31) tb[NE] = incl; }
    }
    __syncthreads();
}
template <int MODE>
__device__ __forceinline__ void ph_token(const Params& p, const Ctx& X, int l, const bf16_t* h, void* hn) {
    if (MODE != 0) moe_table(X, l);
    const LAS int* tb = (const LAS int*)(X.lds + TAB_OFF);
    const float* modl = (const float*)(X.ws + WS_MODF) + (size_t)l * 4 * 6144;
    const float* modn = (const float*)(X.ws + WS_MODF) + (size_t)(MODE == 1 ? 1 : l) * 4 * 6144;
    const float* gain = MODE == 1 ? p.in[4] + D : p.in[5] + l * D;
    const int sc_off = MODE == 1 ? 1024 : 4096, sh_off = MODE == 1 ? 0 : 3072;
    const bf16_t* y = (const bf16_t*)(X.ws + WS_Y);
    LAS float* rsl = (LAS float*)X.lds;
    LAS float* part = (LAS float*)(X.lds + 1024);
    if (MODE == 0 && X.tid < 32) ((LAS unsigned*)(X.lds + 1024 + 65536))[X.tid] = 0u;
    for (int tile = X.bid; tile < T / 64; tile += X.G) {
        const int lane = fresh(X.lane), w = X.wave, tb0 = tile * 64, bb = tb0 / S;
        SUB_BEGIN(X, 31);
        Row ca_, cb_, cg_;
        { const float* m = modn + (size_t)bb * 6144;
#pragma unroll
          for (int j = 0; j < 4; ++j) { if (MODE != 2) { const f32x4 g = ((const f32x4*)gain)[64 * j + lane], a = ((const f32x4*)(m + sc_off))[64 * j + lane]; ca_.v[j] = g * (a + 1.f); cb_.v[j] = ((const f32x4*)(m + sh_off))[64 * j + lane]; }
                                        if (MODE != 0) cg_.v[j] = ((const f32x4*)(modl + (size_t)bb * 6144 + 5120))[64 * j + lane]; } }
        int pe_ = 0, pp_ = 0; float pw_ = 0.f;
        if (MODE != 0 && lane < 32) { const int idx = (tb0 + 8 * w) * 4 + lane; pe_ = ((const int*)(X.ws + WS_TOKE))[idx]; pp_ = ((const int*)(X.ws + WS_TOKP))[idx]; pw_ = ((const float*)(X.ws + WS_TOKW))[idx]; }
#pragma unroll 1
        for (int k2 = 0; k2 < 4; ++k2) {
            Row r[2];
#pragma unroll
            for (int u = 0; u < 2; ++u) row_load_bf16(r[u], h + (size_t)(tb0 + 8 * w + 2 * k2 + u) * D, lane);
            if (MODE != 0) {
#pragma unroll
                for (int u = 0; u < 2; ++u) {
#pragma unroll
                    for (int kk = 0; kk < 4; ++kk) {
                        const int sl = (2 * k2 + u) * 4 + kk;
                        const int e = __shfl(pe_, sl), pos = __shfl(pp_, sl); const float wt = __shfl(pw_, sl);
                        const bf16_t* yr = y + (size_t)(tb[e] * 256 + pos) * D;
#pragma unroll
                        for (int j = 0; j < 4; ++j) { const u32x2 q = ((const u32x2*)yr)[64 * j + lane]; const f32x4 gw = cg_.v[j] * wt;
                            r[u].v[j].x += gw.x * bflo(q.x); r[u].v[j].y += gw.y * bfhi(q.x); r[u].v[j].z += gw.z * bflo(q.y); r[u].v[j].w += gw.w * bfhi(q.y); }
                    }
                    if (MODE == 2) row_store(r[u], (float*)hn + (size_t)(tb0 + 8 * w + 2 * k2 + u) * D, lane); else row_store_bf16(r[u], (bf16_t*)hn + (size_t)(tb0 + 8 * w + 2 * k2 + u) * D, lane);
                    __builtin_amdgcn_sched_barrier(0);
                }
            }
            if (MODE != 2) {
#pragma unroll
                for (int u = 0; u < 2; ++u) {
                    float ssq = 0.f;
#pragma unroll
                    for (int j = 0; j < 4; ++j) ssq += (r[u].v[j].x * r[u].v[j].x + r[u].v[j].y * r[u].v[j].y) + (r[u].v[j].z * r[u].v[j].z + r[u].v[j].w * r[u].v[j].w);
                    const float rs = rsqrtf(wave_sum(ssq) * (1.f / 1024.f) + EPS);
                    bf16_t* uh = (bf16_t*)(X.ws + WS_U) + (size_t)(tb0 + 8 * w + 2 * k2 + u) * D;
#pragma unroll
                    for (int j = 0; j < 4; ++j) { const f32x4 o = r[u].v[j] * rs * ca_.v[j] + cb_.v[j];
                        u32x2 hi; hi.x = pk2(o.x, o.y); hi.y = pk2(o.z, o.w); ((u32x2*)uh)[64 * j + lane] = hi; }
                }
            }
        }
        SUB_END(X, 31);
        if (MODE == 2) continue;
        SUB_BEGIN(X, 32);
        __syncthreads();
        {
            const int ql = lane & 31, hf = lane >> 5;
            const bf16_t* wh = (const bf16_t*)(X.ws + WS_SKW) + (size_t)(MODE == 0 ? l : 2) * 2 * 32 * 1024 + (size_t)ql * 1024 + 128 * w + 8 * hf;
            const bf16_t* uh = (const bf16_t*)(X.ws + WS_U) + (size_t)(tb0 + ql) * D + 128 * w + 8 * hf;
            f32x16 acc0, acc1;
#pragma unroll
            for (int i = 0; i < 16; ++i) { acc0[i] = 0.f; acc1[i] = 0.f; }
#pragma unroll
            for (int ks = 0; ks < 8; ++ks) {
                const bf16x8 whi = *(const bf16x8*)(wh + 16 * ks), wlo = *(const bf16x8*)(wh + 32 * 1024 + 16 * ks);
                const bf16x8 ah0 = *(const bf16x8*)(uh + 16 * ks), ah1 = *(const bf16x8*)(uh + 32 * D + 16 * ks);
                acc0 = __builtin_amdgcn_mfma_f32_32x32x16_bf16(ah0, whi, acc0, 0, 0, 0); acc0 = __builtin_amdgcn_mfma_f32_32x32x16_bf16(ah0, wlo, acc0, 0, 0, 0);
                acc1 = __builtin_amdgcn_mfma_f32_32x32x16_bf16(ah1, whi, acc1, 0, 0, 0); acc1 = __builtin_amdgcn_mfma_f32_32x32x16_bf16(ah1, wlo, acc1, 0, 0, 0);
            }
#pragma unroll
            for (int i = 0; i < 16; ++i) { const int row = 8 * (i >> 2) + 4 * hf + (i & 3); part[(w * 64 + row) * 32 + ql] = acc0[i]; part[(w * 64 + 32 + row) * 32 + ql] = acc1[i]; }
        }
        __syncthreads();
        SUB_END(X, 32);
        SUB_BEGIN(X, 33);
        {
            const int e = lane & 31, hf = lane >> 5;
            LAS unsigned* lcnt = (LAS unsigned*)(X.lds + 1024 + 65536);
            int ev[4], lp[4]; float wv[4];
#pragma unroll
            for (int k = 0; k < 4; ++k) {
                const int tl = 8 * w + 4 * hf + k;
                float v = 0.f;
#pragma unroll
                for (int ww = 0; ww < 8; ++ww) v += part[(ww * 64 + tl) * 32 + e];
                if (MODE == 0) route_select(v + p.in[25][l * NE + e], lane, lcnt, ev[k], wv[k], lp[k]);
                else ((float*)(X.ws + WS_DT))[(size_t)(tb0 + tl) * 32 + e] = v;
            }
            if (MODE == 0) {
                __syncthreads();
                if (X.tid < 32) { const unsigned n = lcnt[X.tid]; unsigned* cnt = (unsigned*)(X.ws + WS_CTL) + CW_CNT + (l * 32 + X.tid) * 32;
                    lcnt[32 + X.tid] = n ? atomicAdd(cnt, n) : 0u; }
                __syncthreads();
                if (e < 4) {
#pragma unroll
                    for (int k = 0; k < 4; ++k) { const int t = tb0 + 8 * w + 4 * hf + k, pos = (int)lcnt[32 + ev[k]] + lp[k];
                        ((int*)(X.ws + WS_TOKE))[t * 4 + e] = ev[k]; ((float*)(X.ws + WS_TOKW))[t * 4 + e] = wv[k]; ((int*)(X.ws + WS_TOKP))[t * 4 + e] = pos;
                        ((int*)(X.ws + WS_SLOT))[ev[k] * CAP + pos] = t; }
                }
            }
        }
        __syncthreads();
        SUB_END(X, 33);
        if (MODE == 0 && X.tid < 32) ((LAS unsigned*)(X.lds + 1024 + 65536))[X.tid] = 0u;
    }
}

__device__ __forceinline__ void ld64bf(const bf16_t* p, float (&q)[64]) {
#pragma unroll
    for (int i = 0; i < 8; ++i) { const u32x4 w = ((const u32x4*)p)[i];
        q[8 * i] = bflo(w.x); q[8 * i + 1] = bfhi(w.x); q[8 * i + 2] = bflo(w.y); q[8 * i + 3] = bfhi(w.y); q[8 * i + 4] = bflo(w.z); q[8 * i + 5] = bfhi(w.z); q[8 * i + 6] = bflo(w.w); q[8 * i + 7] = bfhi(w.w); }
}
__device__ __forceinline__ float dot64bf(const bf16_t* p, const float (&q)[64]) {
    float d = 0.f;
#pragma unroll
    for (int i = 0; i < 8; ++i) { const u32x4 w = ((const u32x4*)p)[i];
        d += q[8 * i] * bflo(w.x) + q[8 * i + 1] * bfhi(w.x) + q[8 * i + 2] * bflo(w.y) + q[8 * i + 3] * bfhi(w.y) + q[8 * i + 4] * bflo(w.z) + q[8 * i + 5] * bfhi(w.z) + q[8 * i + 6] * bflo(w.w) + q[8 * i + 7] * bfhi(w.w); }
    return d;
}
__device__ __forceinline__ float dot64f(const float* p, const float (&q)[64]) {
    float d = 0.f;
#pragma unroll
    for (int i = 0; i < 16; ++i) { const f32x4 w = ((const f32x4*)p)[i]; d += (q[4 * i] * w.x + q[4 * i + 1] * w.y) + (q[4 * i + 2] * w.z + q[4 * i + 3] * w.w); }
    return d;
}
__device__ __forceinline__ void sb_unit(const Ctx& X, int qt, int bh) {
    const int b = bh >> 3, hh = bh & 7, t = qt * 64 + X.lane;
    const bf16_t* base = (const bf16_t*)(X.ws + WS_BIG) + (size_t)b * S * PROJ_LD;
    float q[64], acc[64];
    ld64bf(base + (size_t)t * PROJ_LD + OFF_SBQ + hh * 64, q);
#pragma unroll
    for (int d = 0; d < 64; ++d) acc[d] = 0.f;
    float run = 0.f;
    for (int j = qt * 64 + 62; j >= 0; --j) {
        const bf16_t* kr = base + (size_t)j * PROJ_LD + OFF_SBK + hh * 64;
        const float logit = dot64bf(kr, q) * 0.125f;
        if (j < t) {
            const float w = expf(logsig(logit) + run);
            run += logsig(-logit);
            const bf16_t* vr = base + (size_t)j * PROJ_LD + OFF_SBV + hh * 64;
#pragma unroll
            for (int i = 0; i < 8; ++i) { const u32x4 v = ((const u32x4*)vr)[i];
                acc[8 * i] += w * bflo(v.x); acc[8 * i + 1] += w * bfhi(v.x); acc[8 * i + 2] += w * bflo(v.y); acc[8 * i + 3] += w * bfhi(v.y);
                acc[8 * i + 4] += w * bflo(v.z); acc[8 * i + 5] += w * bfhi(v.z); acc[8 * i + 6] += w * bflo(v.w); acc[8 * i + 7] += w * bfhi(v.w); }
        }
    }
    bf16_t* op = (bf16_t*)(X.ws + WS_O) + (size_t)(b * S + t) * D + hh * 64;
#pragma unroll
    for (int i = 0; i < 8; ++i) { u32x4 w; w.x = pk2(acc[8 * i], acc[8 * i + 1]); w.y = pk2(acc[8 * i + 2], acc[8 * i + 3]); w.z = pk2(acc[8 * i + 4], acc[8 * i + 5]); w.w = pk2(acc[8 * i + 6], acc[8 * i + 7]);
        ((u32x4*)op)[i] = w; }
}

#define DMA16(gptr, ldsptr) __builtin_amdgcn_global_load_lds((const unsigned*)(gptr), (LAS unsigned*)(ldsptr), 16, 0, 0)
#define RING2_WAIT_BAR(q, nb) do { const int issued_ = (q) + 6 < (nb) ? (q) + 6 : (nb); const int need_ = (q) + 2 < (nb) ? (q) + 2 : (nb); const int fl_ = issued_ - need_; \
        if (fl_ >= 4) asm volatile("s_waitcnt vmcnt(8)\n\ts_barrier" ::: "memory"); else if (fl_ == 3) asm volatile("s_waitcnt vmcnt(6)\n\ts_barrier" ::: "memory"); \
        else if (fl_ == 2) asm volatile("s_waitcnt vmcnt(4)\n\ts_barrier" ::: "memory"); else if (fl_ == 1) asm volatile("s_waitcnt vmcnt(2)\n\ts_barrier" ::: "memory"); \
        else asm volatile("s_waitcnt vmcnt(0)\n\ts_barrier" ::: "memory"); } while (0)
constexpr int CV_NITEMS = 64 * 1024 + 64 * 512;
constexpr int CV_LZ = 4 * 16384;
struct Conv { int it, step; bool pending; bf16_t* dst; };
struct ConvCur { int it, step; };
__device__ __forceinline__ void conv_init(Conv& c, const ConvCur& cur) { c.it = cur.it; c.step = cur.step; c.pending = false; c.dst = nullptr; }
__device__ __forceinline__ void conv_issue(Conv& c, const Params& p, unsigned char* ws, LAS unsigned char* lz, int lane) {
    const int r = c.it;
    if (r >= CV_NITEMS) return;
    c.it += c.step;
    const float* src; int ldw;
    if (r < 65536) { const int m = r >> 10, q = r & 1023, kb = q >> 6, n0 = (q & 63) * 32, row0 = ((n0 & 1023) >> 7) * 256 + (n0 >> 10) * 128 + (n0 & 127);
        src = p.in[26] + (size_t)m * 1024 * 2048 + (size_t)(kb * 64) * 2048 + n0; ldw = 2048; c.dst = (bf16_t*)(ws + WS_WGU) + (size_t)m * 2048 * 1024 + (size_t)row0 * 1024 + kb * 64; }
    else { const int r2 = r - 65536, m = r2 >> 9, q = r2 & 511, kb = q >> 5, n0 = (q & 31) * 32;
        src = p.in[28] + (size_t)m * 1024 * 1024 + (size_t)(kb * 64) * 1024 + n0; ldw = 1024; c.dst = (bf16_t*)(ws + WS_WDN) + (size_t)m * 1024 * 1024 + (size_t)n0 * 1024 + kb * 64; }
    const float* ls = src + (size_t)(lane >> 3) * ldw;
#pragma unroll
    for (int i = 0; i < 8; ++i) DMA16(ls + (size_t)(8 * i) * ldw + 4 * ((lane & 7) ^ i), lz + i * 1024);
    c.pending = true;
}
__device__ __forceinline__ void conv_consume(Conv& c, LAS unsigned char* lz, int lane) {
    if (!c.pending) return;
    const int cc = lane & 7;
#pragma unroll 1
    for (int j = 0; j < 4; ++j) { const int n = (lane >> 3) + 8 * j; const LAS float* sp = (const LAS float*)(lz + (8 * cc) * 128 + (((n >> 2) ^ cc) * 16) + (n & 3) * 4);
        u32x4 o; o.x = pk2(sp[0], sp[32]); o.y = pk2(sp[64], sp[96]); o.z = pk2(sp[128], sp[160]); o.w = pk2(sp[192], sp[224]);
        *(u32x4*)(c.dst + (size_t)n * 1024 + 8 * cc) = o; }
    LDS_WAIT(); asm volatile("" ::: "memory");
    c.pending = false;
}
#define PAIR_WAIT_BAR() asm volatile("s_waitcnt vmcnt(0)\n\ts_barrier" ::: "memory")
__device__ __forceinline__ int pi32(int r) { return (r & 0x13) | ((r & 4) << 1) | ((r & 8) >> 1); }
__device__ __forceinline__ void sb_attn_unit(const Params& p, const Ctx& X, ConvCur& cur, int bh, int qb) {
    Conv cv; conv_init(cv, cur);
    const int b = bh >> 3, h = bh & 7, q0 = qb * 256, lane = fresh(X.lane), w = X.wave, ql = lane & 31, hf = lane >> 5;
    const bf16_t* proj = (const bf16_t*)(X.ws + WS_BIG) + (size_t)b * S * PROJ_LD;
    const bf16_t* vt = (const bf16_t*)(X.ws + WS_VT) + (size_t)(h * 64) * T + (size_t)b * S;
    const int tq = q0 + 32 * w + ql;
    bf16x8 qf[4];
#pragma unroll
    for (int s = 0; s < 4; ++s) qf[s] = *(const bf16x8*)(proj + (size_t)tq * PROJ_LD + OFF_SBQ + h * 64 + 16 * s + 8 * hf);
    f32x16 o0, o1;
#pragma unroll
    for (int i = 0; i < 16; ++i) { o0[i] = 0.f; o1[i] = 0.f; }
    float run = 1.f;
    const int nblk = 4 * qb + 4, jw = (q0 + 32 * w + 30) >> 6;
    const float CS = 0.125f * 1.4426950408889634f;
    const bf16_t* kg = proj + (size_t)lane * PROJ_LD + OFF_SBK + h * 64 + 8 * w;
    const bf16_t* vg = vt + (size_t)lane * T + 8 * w;
    LAS unsigned char* ring = X.lds + w * 1024;
    const int krow = pi32(ql) * 16;
    asm volatile("s_waitcnt vmcnt(0)" ::: "memory");
    LAS unsigned char* lz = X.lds + CV_LZ + w * 8192;
#pragma unroll
    for (int d = 0; d < 2; ++d) { DMA16(kg + (size_t)(64 * (nblk - 1 - d)) * PROJ_LD, ring + d * 16384); DMA16(vg + 64 * (nblk - 1 - d), ring + d * 16384 + 8192); }
    for (int q = 0; q < nblk; ++q) {
        const int j = nblk - 1 - q;
        if ((q & 1) == 0) {
            SUB_BEGIN(X, 11);
            PAIR_WAIT_BAR();
            SUB_END(X, 11);
#pragma unroll
            for (int d = 2; d < 4; ++d) if (q + d < nblk) { const int jj = nblk - 1 - (q + d), sl = (q + d) & 3; DMA16(kg + (size_t)(64 * jj) * PROJ_LD, ring + sl * 16384); DMA16(vg + 64 * jj, ring + sl * 16384 + 8192); }
            conv_consume(cv, lz, lane);
            if (q + 2 < nblk) conv_issue(cv, p, X.ws, lz, lane);
        }
        LAS unsigned char* buf = X.lds + (q & 3) * 16384;
        SUB_BEGIN(X, 12);
        if (j <= jw) {
            const bool diag = 64 * j + 63 >= q0 + 32 * w;
#pragma unroll
            for (int kt = 1; kt >= 0; --kt) {
                f32x16 sc;
#pragma unroll
                for (int i = 0; i < 16; ++i) sc[i] = 0.f;
#pragma unroll
                for (int s = 0; s < 4; ++s) { const bf16x8 kf = *(const LAS bf16x8*)(buf + (2 * s + hf) * 1024 + kt * 512 + krow); sc = __builtin_amdgcn_mfma_f32_32x32x16_bf16(kf, qf[s], sc, 0, 0, 0); }
                f32x16 ee = sc * (-CS), be, kp;
#pragma unroll
                for (int i = 0; i < 16; ++i) ee[i] = __builtin_amdgcn_exp2f(ee[i]);
                be = ee + 1.f;
#pragma unroll
                for (int i = 0; i < 16; ++i) be[i] = __builtin_amdgcn_rcpf(be[i]);
                kp = 1.f - be;
                if (diag) {
                    asm volatile("; diagonal block: masks" ::: "memory");
                    const int pos0 = 64 * j + 32 * kt + 8 * hf;
#pragma unroll
                    for (int i = 0; i < 16; ++i) { const bool valid = (pos0 + 16 * (i >> 3) + (i & 7)) < tq; be[i] = valid ? be[i] : 0.f; kp[i] = valid ? kp[i] : 1.f; }
                }
                float l1 = 1.f, l0 = 1.f;
#pragma unroll
                for (int i = 15; i >= 8; --i) { const float t = be[i] * l1; l1 *= kp[i]; be[i] = t; }
#pragma unroll
                for (int i = 7; i >= 0; --i) { const float t = be[i] * l0; l0 *= kp[i]; be[i] = t; }
                const float p1 = __shfl_xor(l1, 32), p0 = __shfl_xor(l0, 32);
                const float hi1 = hf ? l1 : p1, lo1 = hf ? p1 : l1, hi0 = hf ? l0 : p0, lo0 = hf ? p0 : l0;
                const float r1 = run * hi1, r2 = r1 * lo1, r3 = r2 * hi0;
                const float pre_up = hf ? run : r1, pre_lo = hf ? r2 : r3;
                run = r3 * lo0;
#pragma unroll
                for (int a = 0; a < 2; ++a) {
                    const float pre = a ? pre_up : pre_lo;
                    u32x4 pw; pw.x = pk2(be[8 * a] * pre, be[8 * a + 1] * pre); pw.y = pk2(be[8 * a + 2] * pre, be[8 * a + 3] * pre); pw.z = pk2(be[8 * a + 4] * pre, be[8 * a + 5] * pre); pw.w = pk2(be[8 * a + 6] * pre, be[8 * a + 7] * pre);
                    const bf16x8 pf = __builtin_bit_cast(bf16x8, pw);
                    const bf16x8 v0 = *(const LAS bf16x8*)(buf + 8192 + (4 * kt + 2 * a + hf) * 1024 + ql * 16);
                    const bf16x8 v1 = *(const LAS bf16x8*)(buf + 8192 + (4 * kt + 2 * a + hf) * 1024 + 512 + ql * 16);
                    o0 = __builtin_amdgcn_mfma_f32_32x32x16_bf16(v0, pf, o0, 0, 0, 0);
                    o1 = __builtin_amdgcn_mfma_f32_32x32x16_bf16(v1, pf, o1, 0, 0, 0);
                }
            }
        }
        SUB_END(X, 12);
    }
    asm volatile("s_barrier" ::: "memory");
    cur.it = cv.it;
    bf16_t* op = (bf16_t*)(X.ws + WS_O) + (size_t)(b * S + fresh(tq)) * D + h * 64 + 4 * hf;
#pragma unroll
    for (int g4 = 0; g4 < 4; ++g4) {
        u32x2 w0; w0.x = pk2(o0[4 * g4], o0[4 * g4 + 1]); w0.y = pk2(o0[4 * g4 + 2], o0[4 * g4 + 3]); *(u32x2*)(op + 8 * g4) = w0;
        u32x2 w1; w1.x = pk2(o1[4 * g4], o1[4 * g4 + 1]); w1.y = pk2(o1[4 * g4 + 2], o1[4 * g4 + 3]); *(u32x2*)(op + 32 + 8 * g4) = w1;
    }
}
__device__ __forceinline__ void ph_sb(const Params& p, const Ctx& X, ConvCur& cur) {
    for (int pr = X.bid; pr < 256; pr += X.G)
#pragma unroll 1
        for (int u = 0; u < 2; ++u) { const int bh = pr >> 3, qa = pr & 7; sb_attn_unit(p, X, cur, bh, u ? qa : 15 - qa); }
    {
        LAS unsigned char* lz = X.lds + CV_LZ + X.wave * 8192;
        Conv cv; conv_init(cv, cur);
#pragma unroll 1
        while (cv.it < CV_NITEMS) { conv_issue(cv, p, X.ws, lz, X.lane); asm volatile("s_waitcnt vmcnt(0)" ::: "memory"); conv_consume(cv, lz, X.lane); }
        cur.it = cv.it;
    }
}
__device__ __forceinline__ void ph_attn_a(const Params& p, const Ctx& X) {
    const bf16_t* proj = (const bf16_t*)(X.ws + WS_BIG);
    for (int unit = X.bid; unit < 128; unit += X.G) {
        const int kv = unit >> 6, bg = (unit >> 3) & 7, ntile = unit & 7, b = bg >> 1, g = bg & 1, lane = fresh(X.lane), w = X.wave, ql = lane & 31, hf = lane >> 5;
        const int n = min(32 * ntile + ql, NCMP - 1);
        const float* pe = kv ? p.in[11] : p.in[10];
        const bf16_t* w1t = (const bf16_t*)(X.ws + WS_W1T) + (size_t)kv * 128 * 2048;
        const bf16_t* arow = proj + (size_t)(b * S + n * 16) * PROJ_LD + (kv ? OFF_VC : OFF_KC) + g * 64;
        f32x16 acc[4];
#pragma unroll
        for (int ct = 0; ct < 4; ++ct)
#pragma unroll
            for (int i = 0; i < 16; ++i) acc[ct][i] = 0.f;
        for (int ks = 0; ks < 16; ++ks) {
            const int k0 = 256 * w + 16 * ks + 8 * hf, l = k0 >> 6, d = k0 & 63;
            const u32x4 q = *(const u32x4*)(arow + (size_t)l * PROJ_LD + d);
            const f32x4 e0 = *(const f32x4*)(pe + k0), e1 = *(const f32x4*)(pe + k0 + 4);
            u32x4 o; o.x = pk2(bflo(q.x) + e0.x, bfhi(q.x) + e0.y); o.y = pk2(bflo(q.y) + e0.z, bfhi(q.y) + e0.w); o.z = pk2(bflo(q.z) + e1.x, bfhi(q.z) + e1.y); o.w = pk2(bflo(q.w) + e1.z, bfhi(q.w) + e1.w);
            const bf16x8 af = __builtin_bit_cast(bf16x8, o);
#pragma unroll
            for (int ct = 0; ct < 4; ++ct) acc[ct] = __builtin_amdgcn_mfma_f32_32x32x16_bf16(af, *(const bf16x8*)(w1t + (size_t)(32 * ct + ql) * 2048 + k0), acc[ct], 0, 0, 0);
        }
        LAS float* part = (LAS float*)X.lds;
#pragma unroll
        for (int ct = 0; ct < 4; ++ct)
#pragma unroll
            for (int i = 0; i < 16; ++i) part[w * 4096 + (8 * (i >> 2) + 4 * hf + (i & 3)) * 128 + 32 * ct + ql] = acc[ct][i];
        __syncthreads();
        LAS float* hid = part;
        {
            const int tidf = fresh(X.tid);
#pragma unroll
            for (int k = 0; k < 8; ++k) { const int e = tidf + NTHREADS * k; float v = 0.f;
#pragma unroll
                for (int ww = 0; ww < 8; ++ww) v += part[ww * 4096 + e];
                hid[e] = siluf(v); }
        }
        __syncthreads();
        {
            const int tidf = fresh(X.tid), row = tidf >> 4, c4 = (tidf & 15) * 4;
            const float* w2 = kv ? p.in[15] : p.in[13];
            f32x4 o = (f32x4){0.f, 0.f, 0.f, 0.f};
            for (int j = 0; j < 128; ++j) o = o + *(const f32x4*)(w2 + j * 64 + c4) * hid[row * 128 + j];
            const int nn = 32 * ntile + row;
            if (kv == 0) {
                float ssq = (o.x * o.x + o.y * o.y) + (o.z * o.z + o.w * o.w);
                ssq += __shfl_xor(ssq, 1); ssq += __shfl_xor(ssq, 2); ssq += __shfl_xor(ssq, 4); ssq += __shfl_xor(ssq, 8);
                const float r = rsqrtf(ssq * (1.f / 64.f) + EPS); const f32x4 gn = *(const f32x4*)(p.in[9] + c4);
                o = o * r * gn;
                if (nn >= NCMP) o = (f32x4){0.f, 0.f, 0.f, 0.f};
                u32x2 wv; wv.x = pk2(o.x, o.y); wv.y = pk2(o.z, o.w);
                *(u32x2*)((bf16_t*)(X.ws + WS_KCB) + ((size_t)bg * 256 + nn) * 64 + c4) = wv;
            } else {
                if (nn >= NCMP) o = (f32x4){0.f, 0.f, 0.f, 0.f};
                bf16_t* vt = (bf16_t*)(X.ws + WS_VCT) + ((size_t)bg * 64 + c4) * 256 + nn;
                vt[0] = (bf16_t)f2bf(o.x); vt[256] = (bf16_t)f2bf(o.y); vt[512] = (bf16_t)f2bf(o.z); vt[768] = (bf16_t)f2bf(o.w);
            }
        }
        __syncthreads();
    }
    for (int t2 = X.gw; t2 < T / 2; t2 += X.ngw) {
        const int lane = fresh(X.lane), sub = lane & 7;
#pragma unroll
        for (int k = 0; k < 2; ++k) {
            const int t = 2 * t2 + k;
            const u32x4 q = *(const u32x4*)(proj + (size_t)t * PROJ_LD + OFF_NQ + 8 * lane);
            float v[8] = {bflo(q.x), bfhi(q.x), bflo(q.y), bfhi(q.y), bflo(q.z), bfhi(q.z), bflo(q.w), bfhi(q.w)};
            float ssq = 0.f;
#pragma unroll
            for (int i = 0; i < 8; ++i) ssq += v[i] * v[i];
            ssq += __shfl_xor(ssq, 1); ssq += __shfl_xor(ssq, 2); ssq += __shfl_xor(ssq, 4);
            const float r = rsqrtf(ssq * (1.f / 64.f) + EPS) * (0.125f * 1.4426950408889634f);
            const f32x4 g0 = *(const f32x4*)(p.in[8] + 8 * sub), g1 = *(const f32x4*)(p.in[8] + 8 * sub + 4);
            u32x4 o; o.x = pk2(v[0] * r * g0.x, v[1] * r * g0.y); o.y = pk2(v[2] * r * g0.z, v[3] * r * g0.w); o.z = pk2(v[4] * r * g1.x, v[5] * r * g1.y); o.w = pk2(v[6] * r * g1.z, v[7] * r * g1.w);
            *(u32x4*)((bf16_t*)(X.ws + WS_QNB) + (size_t)t * 512 + 8 * lane) = o;
        }
        {
            const int t = 2 * t2 + (lane >> 5), l32 = lane & 31, isw = l32 >> 4, c = 8 * (l32 & 15);
            const u32x4 q = *(const u32x4*)(proj + (size_t)t * PROJ_LD + (isw ? OFF_KW : OFF_KS) + c);
            float v[8] = {bflo(q.x), bfhi(q.x), bflo(q.y), bfhi(q.y), bflo(q.z), bfhi(q.z), bflo(q.w), bfhi(q.w)};
            float ssq = 0.f;
#pragma unroll
            for (int i = 0; i < 8; ++i) ssq += v[i] * v[i];
            ssq += __shfl_xor(ssq, 1); ssq += __shfl_xor(ssq, 2); ssq += __shfl_xor(ssq, 4);
            const float r = rsqrtf(ssq * (1.f / 64.f) + EPS);
            const float* gn = p.in[9] + (isw ? 128 : 64) + 8 * sub;
            const f32x4 g0 = *(const f32x4*)gn, g1 = *(const f32x4*)(gn + 4);
            u32x4 o; o.x = pk2(v[0] * r * g0.x, v[1] * r * g0.y); o.y = pk2(v[2] * r * g0.z, v[3] * r * g0.w); o.z = pk2(v[4] * r * g1.x, v[5] * r * g1.y); o.w = pk2(v[6] * r * g1.z, v[7] * r * g1.w);
            *(u32x4*)((bf16_t*)(X.ws + (isw ? WS_KWN : WS_KSN)) + (size_t)t * 128 + c) = o;
        }
    }
}
struct NsaSt { f32x16 o0, o1; float m, l; };
template <int MODE>
__device__ __forceinline__ void nsa_flash(const Ctx& X, const unsigned char* kbase, unsigned koff, const unsigned char* vbase, unsigned voff, int jlo, int jhi, const bf16x8 (&qf)[4], int tq, float slope2,
                                          unsigned long long mymask, unsigned long long wavemask, NsaSt& st, float cbound, const Params& p, ConvCur& cur) {
    Conv cv; conv_init(cv, cur);
    const int lane = fresh(X.lane), w = X.wave, ql = lane & 31, hf = lane >> 5;
    LAS unsigned char* ring = X.lds + w * 1024;
    const int krow = pi32(ql) * 16, nb = jhi - jlo + 1;
    asm volatile("s_waitcnt vmcnt(0)" ::: "memory");
    LAS unsigned char* lz = X.lds + CV_LZ + w * 8192;
#pragma unroll
    for (int d = 0; d < 2; ++d) if (d < nb) { DMA16(kbase + (koff + (unsigned)(jhi - d) * 16384u), ring + d * 16384); DMA16(vbase + (voff + (unsigned)(jhi - d) * 128u), ring + d * 16384 + 8192); }
    const float k32 = slope2 * 32.f;
    for (int q = 0; q < nb; ++q) {
        const int j = jhi - q;
        if ((q & 1) == 0) {
            SUB_BEGIN(X, 21);
            PAIR_WAIT_BAR();
            SUB_END(X, 21);
#pragma unroll
            for (int d = 2; d < 4; ++d) if (q + d < nb) { const int jj = jhi - (q + d), sl2 = (q + d) & 3; DMA16(kbase + (koff + (unsigned)jj * 16384u), ring + sl2 * 16384); DMA16(vbase + (voff + (unsigned)jj * 128u), ring + sl2 * 16384 + 8192); }
            conv_consume(cv, lz, lane);
            if (q + 2 < nb) conv_issue(cv, p, X.ws, lz, lane);
        }
        LAS unsigned char* buf = X.lds + (q & 3) * 16384;
        SUB_BEGIN(X, 22);
        if (MODE == 1 || ((wavemask >> j) & 1ull)) {
            f32x16 s0, s1;
#pragma unroll
            for (int i = 0; i < 16; ++i) { s0[i] = 0.f; s1[i] = 0.f; }
#pragma unroll
            for (int s = 0; s < 4; ++s) {
                const bf16x8 k0 = *(const LAS bf16x8*)(buf + (2 * s + hf) * 1024 + krow), k1 = *(const LAS bf16x8*)(buf + (2 * s + hf) * 1024 + 512 + krow);
                s0 = __builtin_amdgcn_mfma_f32_32x32x16_bf16(k0, qf[s], s0, 0, 0, 0); s1 = __builtin_amdgcn_mfma_f32_32x32x16_bf16(k1, qf[s], s1, 0, 0, 0);
            }
            const int d0 = tq - (64 * j + 8 * hf);
            if (j == jhi || (MODE == 1 && j == jlo)) {
                asm volatile("; boundary block: masks" ::: "memory");
#pragma unroll
                for (int i = 0; i < 16; ++i) {
                    const int da = d0 - (16 * (i >> 3) + (i & 7)), db = da - 32;
                    s0[i] = (da >= 0 && (MODE == 0 || da < 512)) ? s0[i] : -INFINITY; s1[i] = (db >= 0 && (MODE == 0 || db < 512)) ? s1[i] : -INFINITY;
                }
            }
#pragma unroll
            for (int i = 0; i < 16; ++i) { const float kof = (float)(16 * (i >> 3) + (i & 7)); s0[i] = fmaf(slope2, kof, s0[i]); s1[i] = fmaf(slope2, kof, s1[i]); }
            const float base = slope2 * (float)d0;
            const bool sel = MODE == 1 || ((mymask >> j) & 1ull);
            const float off0 = sel ? cbound + base : INFINITY, off1 = off0 - k32;
            s0 = s0 - off0; s1 = s1 - off1;
            float ls = 0.f;
#pragma unroll
            for (int i = 0; i < 16; ++i) { s0[i] = __builtin_amdgcn_exp2f(s0[i]); s1[i] = __builtin_amdgcn_exp2f(s1[i]); ls += s0[i] + s1[i]; }
            st.l += ls;
#pragma unroll
            for (int kt = 0; kt < 2; ++kt)
#pragma unroll
                for (int a = 0; a < 2; ++a) {
                    u32x4 pw;
                    if (kt == 0) { pw.x = pk2(s0[8 * a], s0[8 * a + 1]); pw.y = pk2(s0[8 * a + 2], s0[8 * a + 3]); pw.z = pk2(s0[8 * a + 4], s0[8 * a + 5]); pw.w = pk2(s0[8 * a + 6], s0[8 * a + 7]); }
                    else { pw.x = pk2(s1[8 * a], s1[8 * a + 1]); pw.y = pk2(s1[8 * a + 2], s1[8 * a + 3]); pw.z = pk2(s1[8 * a + 4], s1[8 * a + 5]); pw.w = pk2(s1[8 * a + 6], s1[8 * a + 7]); }
                    const bf16x8 pf = __builtin_bit_cast(bf16x8, pw);
                    const bf16x8 v0 = *(const LAS bf16x8*)(buf + 8192 + (4 * kt + 2 * a + hf) * 1024 + ql * 16);
                    const bf16x8 v1 = *(const LAS bf16x8*)(buf + 8192 + (4 * kt + 2 * a + hf) * 1024 + 512 + ql * 16);
                    st.o0 = __builtin_amdgcn_mfma_f32_32x32x16_bf16(v0, pf, st.o0, 0, 0, 0);
                    st.o1 = __builtin_amdgcn_mfma_f32_32x32x16_bf16(v1, pf, st.o1, 0, 0, 0);
                }
        }
        SUB_END(X, 22);
    }
    asm volatile("s_barrier" ::: "memory");
    cur.it = cv.it;
}
__device__ __forceinline__ void nsa_unit(const Params& p, const Ctx& X, ConvCur& cur, int bg, int qb) {
    const int b = bg >> 1, g = bg & 1, lane = fresh(X.lane), w = X.wave, ql = lane & 31, hf = lane >> 5, r = ql >> 3, hh = g * 4 + r;
    const int t0 = 64 * qb, tq = t0 + 8 * w + (ql & 7);
    const float slope2 = exp2f(-(float)(hh + 1)) * 1.4426950408889634f;
    const bf16_t* proj = (const bf16_t*)(X.ws + WS_BIG);
    bf16x8 qf[4];
    { const bf16_t* qp = (const bf16_t*)(X.ws + WS_QNB) + (size_t)(b * S + tq) * 512 + hh * 64 + 8 * hf;
#pragma unroll
      for (int s = 0; s < 4; ++s) qf[s] = *(const bf16x8*)(qp + 16 * s); }
    float cb_sel, cb_win;
    { const float gq = wave_max(fabsf(p.in[8][lane])), g1 = wave_max(fabsf(p.in[9][64 + lane])), g2 = wave_max(fabsf(p.in[9][128 + lane]));
      cb_sel = 1.03f * 8.f * 0.125f * 1.4426950408889634f * 8.f * gq * g1; cb_win = 1.03f * 8.f * 0.125f * 1.4426950408889634f * 8.f * gq * g2; }
#define NSA_GATE(i) (1.f / (1.f + __expf(-bf2f(proj[(size_t)(b * S + fresh(tq)) * PROJ_LD + OFF_GATE + hh * 3 + (i)]))))
    unsigned ofp0[8], ofp1[8];
    NsaSt st;
    SUB_BEGIN(X, 23);
    LAS float* pacc = (LAS float*)(X.lds + 65536) + w * 2048;
    {
        const int ncm = t0 + 63 >= 31 ? (t0 + 63 - 31) / 16 + 1 : 0, nt = (ncm + 31) >> 5, ncv = tq >= 31 ? (tq - 31) / 16 + 1 : 0;
        {
            const bf16_t* kc = (const bf16_t*)(X.ws + WS_KCB) + (size_t)bg * 256 * 64; const bf16_t* vc = (const bf16_t*)(X.ws + WS_VCT) + (size_t)bg * 64 * 256;
            const int tidf = fresh(X.tid);
#pragma unroll
            for (int i = 0; i < 4; ++i) { const int pidx = tidf + NTHREADS * i;
                *(LAS u32x4*)(X.lds + (pidx >> 8) * 4096 + (pidx & 255) * 16) = *(const u32x4*)(kc + (size_t)(pidx & 255) * 64 + 8 * (pidx >> 8));
                *(LAS u32x4*)(X.lds + 32768 + (pidx >> 6) * 1024 + (pidx & 63) * 16) = *(const u32x4*)(vc + (size_t)(pidx & 63) * 256 + 8 * (pidx >> 6)); }
#pragma unroll
            for (int i = 0; i < 8; ++i) *(LAS f32x4*)(pacc + (i * 64 + lane) * 4) = (f32x4){0.f, 0.f, 0.f, 0.f};
        }
        __syncthreads();
        const int krow = pi32(ql) * 16;
        float ml = -INFINITY, ll = 0.f;
        for (int kt = 0; kt < nt; ++kt) {
            f32x16 sc;
#pragma unroll
            for (int i = 0; i < 16; ++i) sc[i] = 0.f;
#pragma unroll
            for (int s = 0; s < 4; ++s) { const bf16x8 kf = *(const LAS bf16x8*)(X.lds + (2 * s + hf) * 4096 + kt * 512 + krow); sc = __builtin_amdgcn_mfma_f32_32x32x16_bf16(kf, qf[s], sc, 0, 0, 0); }
            float tm = -INFINITY;
#pragma unroll
            for (int i = 0; i < 16; ++i) { const int n = 32 * kt + 16 * (i >> 3) + 8 * hf + (i & 7);
                sc[i] = n < ncv ? sc[i] - slope2 * (float)(tq - (16 * n + 31)) : -INFINITY; tm = fmaxf(tm, sc[i]); }
            const float mn = fmaxf(ml, tm), ms = mn == -INFINITY ? 0.f : mn;
            float ls = 0.f;
#pragma unroll
            for (int i = 0; i < 16; ++i) ls += __builtin_amdgcn_exp2f(sc[i] - ms);
            ll = ll * __builtin_amdgcn_exp2f(ml - ms) + ls; ml = mn;
        }
        float ms, inv;
        { const float mo = __shfl_xor(ml, 32), lo = __shfl_xor(ll, 32), mt = fmaxf(ml, mo); ms = mt == -INFINITY ? 0.f : mt;
          const float lt = ll * __builtin_amdgcn_exp2f(ml - ms) + lo * __builtin_amdgcn_exp2f(mo - ms); inv = lt > 0.f ? 1.f / lt : 0.f; }
#pragma unroll
        for (int i = 0; i < 16; ++i) { st.o0[i] = 0.f; st.o1[i] = 0.f; }
        float carry = 0.f;
        for (int kt = 0; kt < nt; ++kt) {
            f32x16 sc;
#pragma unroll
            for (int i = 0; i < 16; ++i) sc[i] = 0.f;
#pragma unroll
            for (int s = 0; s < 4; ++s) { const bf16x8 kf = *(const LAS bf16x8*)(X.lds + (2 * s + hf) * 4096 + kt * 512 + krow); sc = __builtin_amdgcn_mfma_f32_32x32x16_bf16(kf, qf[s], sc, 0, 0, 0); }
#pragma unroll
            for (int i = 0; i < 16; ++i) { const int n = 32 * kt + 16 * (i >> 3) + 8 * hf + (i & 7);
                sc[i] = n < ncv ? __builtin_amdgcn_exp2f(sc[i] - slope2 * (float)(tq - (16 * n + 31)) - ms) * inv : 0.f; }
            const float pa0 = __shfl_xor(sc[7], 32), pa1 = __shfl_xor(sc[15], 32);
            const float prev0 = hf ? pa0 : carry, prev1 = hf ? pa1 : pa0;
            carry = pa1;
            {
                typedef float f32x2 __attribute__((ext_vector_type(2)));
                f32x2 e0, e1;
                e0.x = prev0 + ((sc[0] + sc[1]) + (sc[2] + sc[3])); e0.y = sc[3] + ((sc[4] + sc[5]) + (sc[6] + sc[7]));
                e1.x = prev1 + ((sc[8] + sc[9]) + (sc[10] + sc[11])); e1.y = sc[11] + ((sc[12] + sc[13]) + (sc[14] + sc[15]));
                *(LAS f32x2*)(pacc + ql * 64 + 8 * kt + 2 * hf) = e0; *(LAS f32x2*)(pacc + ql * 64 + 8 * kt + 4 + 2 * hf) = e1;
            }
#pragma unroll
            for (int a = 0; a < 2; ++a) {
                u32x4 pw; pw.x = pk2(sc[8 * a], sc[8 * a + 1]); pw.y = pk2(sc[8 * a + 2], sc[8 * a + 3]); pw.z = pk2(sc[8 * a + 4], sc[8 * a + 5]); pw.w = pk2(sc[8 * a + 6], sc[8 * a + 7]);
                const bf16x8 pf = __builtin_bit_cast(bf16x8, pw);
                const bf16x8 v0 = *(const LAS bf16x8*)(X.lds + 32768 + (4 * kt + 2 * a + hf) * 1024 + ql * 16);
                const bf16x8 v1 = *(const LAS bf16x8*)(X.lds + 32768 + (4 * kt + 2 * a + hf) * 1024 + 512 + ql * 16);
                st.o0 = __builtin_amdgcn_mfma_f32_32x32x16_bf16(v0, pf, st.o0, 0, 0, 0);
                st.o1 = __builtin_amdgcn_mfma_f32_32x32x16_bf16(v1, pf, st.o1, 0, 0, 0);
            }
        }
        { const float g0 = NSA_GATE(0);
#pragma unroll
        for (int i = 0; i < 8; ++i) { ofp0[i] = pk2(g0 * st.o0[2 * i], g0 * st.o0[2 * i + 1]); ofp1[i] = pk2(g0 * st.o1[2 * i], g0 * st.o1[2 * i + 1]); } }
    }
    SUB_END(X, 23);
    SUB_BEGIN(X, 24);
    unsigned long long mymask = 0ull, wavemask = 0ull;
    LDS_WAIT();
    for (int q8 = 0; q8 < 8; ++q8) {
        const int t = t0 + 8 * w + q8;
        const float ps = (pacc[(0 * 8 + q8) * 64 + lane] + pacc[(1 * 8 + q8) * 64 + lane]) + (pacc[(2 * 8 + q8) * 64 + lane] + pacc[(3 * 8 + q8) * 64 + lane]);
        const bool valid = lane * 64 <= t, forced = (lane == 0) || (lane == qb) || (lane == qb - 1);
        const unsigned key = valid ? ((forced ? 0x7f000000u : (__float_as_uint(fmaxf(ps, 0.f)) & ~63u)) | (unsigned)(63 - lane)) : 0u;
        unsigned thr = 0u;
#pragma unroll 1
        for (int bit = 30; bit >= 0; --bit) { const unsigned cand = thr | (1u << bit); if (__builtin_popcountll(__ballot(key >= cand)) >= 16) thr = cand; }
        const unsigned long long mk = __ballot(key >= thr && key != 0u);
        wavemask |= mk; if ((ql & 7) == q8) mymask = mk;
    }
    SUB_END(X, 24);
    __syncthreads();
    {
#pragma unroll
        for (int i = 0; i < 16; ++i) { st.o0[i] = 0.f; st.o1[i] = 0.f; }
        st.m = -INFINITY; st.l = 0.f;
        const int lf = fresh(lane);
        const unsigned koff = (unsigned)(((b * S + lf) * 128 + g * 64 + 8 * w) * 2), voff = (unsigned)(((512 + g * 64 + lf) * T + b * S + 8 * w) * 2);
        nsa_flash<0>(X, X.ws + WS_KSN, koff, X.ws + WS_VT, voff, 0, qb, qf, tq, slope2, mymask, wavemask, st, cb_sel, p, cur);
        const float lt = st.l + __shfl_xor(st.l, 32), sc = NSA_GATE(1) / fmaxf(lt, 1e-30f);
#pragma unroll
        for (int i = 0; i < 8; ++i) { ofp0[i] = pk2(bflo(ofp0[i]) + sc * st.o0[2 * i], bfhi(ofp0[i]) + sc * st.o0[2 * i + 1]); ofp1[i] = pk2(bflo(ofp1[i]) + sc * st.o1[2 * i], bfhi(ofp1[i]) + sc * st.o1[2 * i + 1]); }
    }
    {
#pragma unroll
        for (int i = 0; i < 16; ++i) { st.o0[i] = 0.f; st.o1[i] = 0.f; }
        st.m = -INFINITY; st.l = 0.f;
        const int lf = fresh(lane);
        const unsigned koff = (unsigned)(((b * S + lf) * 128 + g * 64 + 8 * w) * 2), voff = (unsigned)(((640 + g * 64 + lf) * T + b * S + 8 * w) * 2);
        nsa_flash<1>(X, X.ws + WS_KWN, koff, X.ws + WS_VT, voff, qb >= 8 ? qb - 8 : 0, qb, qf, tq, slope2, 0ull, 0ull, st, cb_win, p, cur);
        const float lt = st.l + __shfl_xor(st.l, 32), sc = NSA_GATE(2) / fmaxf(lt, 1e-30f);
#pragma unroll
        for (int i = 0; i < 8; ++i) { ofp0[i] = pk2(bflo(ofp0[i]) + sc * st.o0[2 * i], bfhi(ofp0[i]) + sc * st.o0[2 * i + 1]); ofp1[i] = pk2(bflo(ofp1[i]) + sc * st.o1[2 * i], bfhi(ofp1[i]) + sc * st.o1[2 * i + 1]); }
    }
    bf16_t* op = (bf16_t*)(X.ws + WS_O) + (size_t)(b * S + fresh(tq)) * D + 512 + hh * 64 + 4 * hf;
#pragma unroll
    for (int g4 = 0; g4 < 4; ++g4) {
        u32x2 w0; w0.x = ofp0[2 * g4]; w0.y = ofp0[2 * g4 + 1]; *(u32x2*)(op + 8 * g4) = w0;
        u32x2 w1; w1.x = ofp1[2 * g4]; w1.y = ofp1[2 * g4 + 1]; *(u32x2*)(op + 32 + 8 * g4) = w1;
    }
}
__device__ __forceinline__ void ph_nsa(const Params& p, const Ctx& X, ConvCur& cur) {
    for (int pr = X.bid; pr < 256; pr += X.G)
#pragma unroll 1
        for (int u = 0; u < 2; ++u) { const int bg = pr >> 5, qa = pr & 31; nsa_unit(p, X, cur, bg, u ? qa : 63 - qa); }
}

__device__ __forceinline__ float silu_fast(float v) { return v * __builtin_amdgcn_rcpf(1.f + __expf(-v)); }
constexpr int S1_WL = RING_BYTES + 4096;
__device__ __forceinline__ void ph_ssd1(const Params& p, const Ctx& X) {
    const float* cw = p.in[17]; const float* cb = p.in[18];
    LAS float* wl = (LAS float*)(X.lds + S1_WL);
    LAS unsigned char* ldsB = X.lds;
    LAS unsigned char* ldsX = X.lds + 65536;
    for (int unit = X.bid; unit < 256; unit += X.G) {
        const int b = unit >> 6, c = (unit >> 2) & 15, g = unit & 3, tl0 = c * 256, lane = fresh(X.lane), w = X.wave, ql = lane & 31, hf = lane >> 5;
        const size_t t0 = (size_t)b * S + tl0;
        SUB_BEGIN(X, 41);
        {
            const int h = g * 8 + w;
            const float a = -expf(p.in[20][h]), dtb = p.in[19][h];
            const float* dr = (const float*)(X.ws + WS_DT) + (t0 + 4 * lane) * 32 + h;
            float dt[4], cs[4];
#pragma unroll
            for (int k = 0; k < 4; ++k) { const float raw = dr[k * 32] + dtb; dt[k] = raw > 20.f ? raw : log1pf(expf(raw)); }
            cs[0] = dt[0] * a; cs[1] = cs[0] + dt[1] * a; cs[2] = cs[1] + dt[2] * a; cs[3] = cs[2] + dt[3] * a;
            float incl = cs[3];
#pragma unroll
            for (int o = 1; o < 64; o <<= 1) { const float u = __shfl_up(incl, o); if (lane >= o) incl += u; }
            const float excl = incl - cs[3], last = __shfl(incl, 63);
#pragma unroll
            for (int k = 0; k < 4; ++k) cs[k] += excl;
            *(f32x4*)((float*)(X.ws + WS_DT2) + (size_t)(b * 32 + h) * S + tl0 + 4 * lane) = (f32x4){dt[0], dt[1], dt[2], dt[3]};
            *(f32x4*)((float*)(X.ws + WS_CS) + (size_t)(b * 32 + h) * S + tl0 + 4 * lane) = (f32x4){cs[0], cs[1], cs[2], cs[3]};
            *(LAS f32x4*)(wl + w * 256 + 4 * lane) = (f32x4){dt[0] * __expf(last - cs[0]), dt[1] * __expf(last - cs[1]), dt[2] * __expf(last - cs[2]), dt[3] * __expf(last - cs[3])};
            if (lane == 63) ((float*)(X.ws + WS_DEC))[(b * 16 + c) * 32 + h] = __expf(last);
        }
        const bf16_t* xt = (const bf16_t*)(X.ws + WS_XT); bf16_t* xct = (bf16_t*)(X.ws + WS_XCT);
        const int tidf = fresh(X.tid);
#define CONV8(rin, chg, seg, o) do { const bf16_t* src_ = xt + (size_t)(rin) * T + t0 + 8 * (seg); const u32x4 cur_ = *(const u32x4*)src_; u32x4 prv_ = (u32x4){0u, 0u, 0u, 0u}; \
            if (tl0 + 8 * (seg) >= 8) prv_ = *(const u32x4*)(src_ - 8); \
            const float x_[11] = {bfhi(prv_.z), bflo(prv_.w), bfhi(prv_.w), bflo(cur_.x), bfhi(cur_.x), bflo(cur_.y), bfhi(cur_.y), bflo(cur_.z), bfhi(cur_.z), bflo(cur_.w), bfhi(cur_.w)}; \
            const float w0_ = cw[chg], w1_ = cw[CONV_DIM + (chg)], w2_ = cw[2 * CONV_DIM + (chg)], w3_ = cw[3 * CONV_DIM + (chg)], bb_ = cb[chg]; \
            _Pragma("unroll") for (int j_ = 0; j_ < 8; ++j_) o[j_] = silu_fast(bb_ + w0_ * x_[j_] + w1_ * x_[j_ + 1] + w2_ * x_[j_ + 2] + w3_ * x_[j_ + 3]); } while (0)
        SUB_END(X, 41);
        SUB_BEGIN(X, 42);
        {
#pragma unroll
            for (int k = 0; k < 8; ++k) {
                const int it = tidf + NTHREADS * k, n = it >> 5, seg = it & 31, chg = 2048 + g * 128 + n;
                float o[8]; CONV8(g * 128 + n, chg, seg, o);
                u32x4 ov; ov.x = pk2(o[0], o[1]); ov.y = pk2(o[2], o[3]); ov.z = pk2(o[4], o[5]); ov.w = pk2(o[6], o[7]);
                *(u32x4*)(xct + (size_t)chg * T + t0 + 8 * seg) = ov;
                *(LAS u32x4*)(ldsB + seg * 2048 + n * 16) = ov;
            }
            SUB_END(X, 42);
            SUB_BEGIN(X, 43);
            const bf16_t* zbc = (const bf16_t*)(X.ws + WS_ZBC); bf16_t* bcm = (bf16_t*)(X.ws + WS_BCM);
            {
                const int c8 = tidf & 31, l0 = (tidf >> 5) * 16;
                const int col = (c8 < 16 ? g * 128 + 8 * c8 : 512 + g * 128 + 8 * (c8 - 16));
                float wk[4][8], bb[8];
                { const f32x4 b0 = *(const f32x4*)(cb + 2048 + col), b1 = *(const f32x4*)(cb + 2048 + col + 4); bb[0] = b0.x; bb[1] = b0.y; bb[2] = b0.z; bb[3] = b0.w; bb[4] = b1.x; bb[5] = b1.y; bb[6] = b1.z; bb[7] = b1.w; }
#pragma unroll
                for (int ww = 0; ww < 4; ++ww) { const f32x4 k0 = *(const f32x4*)(cw + ww * CONV_DIM + 2048 + col), k1 = *(const f32x4*)(cw + ww * CONV_DIM + 2048 + col + 4);
                    wk[ww][0] = k0.x; wk[ww][1] = k0.y; wk[ww][2] = k0.z; wk[ww][3] = k0.w; wk[ww][4] = k1.x; wk[ww][5] = k1.y; wk[ww][6] = k1.z; wk[ww][7] = k1.w; }
                u32x4 rw[19];
#pragma unroll
                for (int r = 0; r < 19; ++r) rw[r] = (tl0 + l0 - 3 + r >= 0) ? *(const u32x4*)(zbc + (t0 + l0 - 3 + r) * 3072 + 2048 + col) : (u32x4){0u, 0u, 0u, 0u};
#pragma unroll
                for (int k = 0; k < 16; ++k) {
                    float acc[8];
#pragma unroll
                    for (int i = 0; i < 8; ++i) acc[i] = bb[i];
#pragma unroll
                    for (int ww = 0; ww < 4; ++ww) { const u32x4 q = rw[k + ww];
                        acc[0] += bflo(q.x) * wk[ww][0]; acc[1] += bfhi(q.x) * wk[ww][1]; acc[2] += bflo(q.y) * wk[ww][2]; acc[3] += bfhi(q.y) * wk[ww][3];
                        acc[4] += bflo(q.z) * wk[ww][4]; acc[5] += bfhi(q.z) * wk[ww][5]; acc[6] += bflo(q.w) * wk[ww][6]; acc[7] += bfhi(q.w) * wk[ww][7]; }
                    u32x4 ov; ov.x = pk2(silu_fast(acc[0]), silu_fast(acc[1])); ov.y = pk2(silu_fast(acc[2]), silu_fast(acc[3])); ov.z = pk2(silu_fast(acc[4]), silu_fast(acc[5])); ov.w = pk2(silu_fast(acc[6]), silu_fast(acc[7]));
                    *(u32x4*)(bcm + (t0 + l0 + k) * 1024 + col) = ov;
                }
            }
        }
        SUB_END(X, 43);
#pragma unroll 1
        for (int hg = 0; hg < 4; ++hg) {
            SUB_BEGIN(X, 44);
            asm volatile("s_waitcnt lgkmcnt(0)\n\ts_barrier" ::: "memory");
#pragma unroll
            for (int k = 0; k < 8; ++k) {
                const int it = tidf + NTHREADS * k, chl = it >> 5, seg = it & 31, h8 = 2 * hg + (chl >> 6), chg = g * 512 + h8 * 64 + (chl & 63);
                float o[8]; CONV8(1024 + chg, chg, seg, o);
                u32x4 ov; ov.x = pk2(o[0], o[1]); ov.y = pk2(o[2], o[3]); ov.z = pk2(o[4], o[5]); ov.w = pk2(o[6], o[7]);
                *(u32x4*)(xct + (size_t)chg * T + t0 + 8 * seg) = ov;
                const f32x4 wa = *(const LAS f32x4*)(wl + h8 * 256 + 8 * seg), wb = *(const LAS f32x4*)(wl + h8 * 256 + 8 * seg + 4);
                u32x4 os; os.x = pk2(o[0] * wa.x, o[1] * wa.y); os.y = pk2(o[2] * wa.z, o[3] * wa.w); os.z = pk2(o[4] * wb.x, o[5] * wb.y); os.w = pk2(o[6] * wb.z, o[7] * wb.w);
                *(LAS u32x4*)(ldsX + (chl >> 6) * 32768 + seg * 1024 + (chl & 63) * 16) = os;
            }
            asm volatile("s_waitcnt lgkmcnt(0)\n\ts_barrier" ::: "memory");
            SUB_END(X, 44);
            SUB_BEGIN(X, 45);
            {
                const int hl = w >> 2, pt = (w >> 1) & 1, nt0 = 2 * (w & 1), h = g * 8 + 2 * hg + hl;
                f32x16 acc0, acc1;
#pragma unroll
                for (int i = 0; i < 16; ++i) { acc0[i] = 0.f; acc1[i] = 0.f; }
#pragma unroll 4
                for (int ks = 0; ks < 16; ++ks) {
                    const bf16x8 af = *(const LAS bf16x8*)(ldsX + hl * 32768 + (2 * ks + hf) * 1024 + (32 * pt + ql) * 16);
                    const bf16x8 b0 = *(const LAS bf16x8*)(ldsB + (2 * ks + hf) * 2048 + (32 * nt0 + ql) * 16), b1 = *(const LAS bf16x8*)(ldsB + (2 * ks + hf) * 2048 + (32 * nt0 + 32 + ql) * 16);
                    acc0 = __builtin_amdgcn_mfma_f32_32x32x16_bf16(af, b0, acc0, 0, 0, 0); acc1 = __builtin_amdgcn_mfma_f32_32x32x16_bf16(af, b1, acc1, 0, 0, 0);
                }
                float* st = (float*)(X.ws + WS_ST) + ((size_t)(b * 16 + c) * 32 + h) * 8192 + 32 * nt0 + ql;
#pragma unroll
                for (int i = 0; i < 16; ++i) { const int pr = 32 * pt + 8 * (i >> 2) + 4 * hf + (i & 3); st[pr * 128] = acc0[i]; st[pr * 128 + 32] = acc1[i]; }
            }
            SUB_END(X, 45);
        }
#undef CONV8
        __syncthreads();
    }
}
__device__ __forceinline__ void ph_ssd2(const Ctx& X) {
    const float* st = (const float*)(X.ws + WS_ST); const float* dec = (const float*)(X.ws + WS_DEC); bf16_t* pb = (bf16_t*)(X.ws + WS_PB);
    for (int e = X.bid * NTHREADS + X.tid; e < NB * 32 * 2048; e += X.G * NTHREADS) {
        const int b = e >> 16, h = (e >> 11) & 31, q4 = (e & 2047) * 4;
        f32x4 hs = (f32x4){0.f, 0.f, 0.f, 0.f};
        for (int c = 0; c < 16; ++c) {
            const size_t o = ((size_t)(b * 16 + c) * 32 + h) * 8192 + q4;
            u32x2 wv; wv.x = pk2(hs.x, hs.y); wv.y = pk2(hs.z, hs.w); *(u32x2*)(pb + o) = wv;
            hs = hs * dec[(b * 16 + c) * 32 + h] + *(const f32x4*)(st + o);
        }
    }
}
constexpr int S3_STG = 49152;
__device__ __forceinline__ void ph_ssd3(const Params& p, const Ctx& X) {
    LAS float* dtl = (LAS float*)(X.lds + 2 * S3_STG); LAS float* csl = dtl + 2048;
    constexpr int S3_TILE = 2 * S3_STG + 16384;
    static_assert(S3_TILE + 8 * 4096 <= TAB_OFF, "ssd3 LDS map");
    for (int unit = X.bid; unit < 256; unit += X.G) {
        const int b = unit >> 6, c = (unit >> 2) & 15, g = unit & 3, tl0 = c * 256, lane = fresh(X.lane), w = X.wave, ql = lane & 31, hf = lane >> 5, lq = 32 * w + ql;
        const size_t t0 = (size_t)b * S + tl0;
        LAS unsigned char* tile = X.lds + S3_TILE + w * 4096;
        const bf16_t* xg = (const bf16_t*)(X.ws + WS_XCT) + (size_t)(g * 512 + lane) * T + t0;
        const bf16_t* pg = (const bf16_t*)(X.ws + WS_PB) + ((size_t)(b * 16 + c) * 32 + g * 8) * 8192 + (size_t)lane * 128;
#define S3_ISSUE(h8, sbase) do { _Pragma("unroll") for (int cc_ = 0; cc_ < 4; ++cc_) DMA16(xg + (size_t)((h8) * 64) * T + 8 * (4 * w + cc_), X.lds + (sbase) + (4 * w + cc_) * 1024); \
            _Pragma("unroll") for (int cc_ = 0; cc_ < 2; ++cc_) DMA16(pg + (size_t)(h8) * 8192 + 8 * (2 * w + cc_), X.lds + (sbase) + 32768 + (2 * w + cc_) * 1024); } while (0)
        asm volatile("s_waitcnt vmcnt(0)" ::: "memory");
        S3_ISSUE(0, 0);
        { const int tidf = fresh(X.tid), h8 = tidf >> 6, l4 = (tidf & 63) * 4;
          *(LAS f32x4*)(dtl + h8 * 256 + l4) = *(const f32x4*)((const float*)(X.ws + WS_DT2) + (size_t)(b * 32 + g * 8 + h8) * S + tl0 + l4);
          *(LAS f32x4*)(csl + h8 * 256 + l4) = *(const f32x4*)((const float*)(X.ws + WS_CS) + (size_t)(b * 32 + g * 8 + h8) * S + tl0 + l4); }
        const bf16_t* bcm = (const bf16_t*)(X.ws + WS_BCM);
        bf16x8 cf[8];
#pragma unroll
        for (int ks = 0; ks < 8; ++ks) cf[ks] = *(const bf16x8*)(bcm + (t0 + lq) * 1024 + 512 + g * 128 + 16 * ks + 8 * hf);
        u32x4 gp[8][2];
        {
#pragma unroll
        for (int st = 0; st < 8; ++st) {
            if (st <= w) {
                f32x16 G;
#pragma unroll
                for (int i = 0; i < 16; ++i) G[i] = 0.f;
                const bf16_t* bp = bcm + (t0 + 32 * st + pi32(ql)) * 1024 + g * 128 + 8 * hf;
#pragma unroll
                for (int ks = 0; ks < 8; ++ks) G = __builtin_amdgcn_mfma_f32_32x32x16_bf16(*(const bf16x8*)(bp + 16 * ks), cf[ks], G, 0, 0, 0);
#pragma unroll
                for (int a2 = 0; a2 < 2; ++a2) { gp[st][a2].x = pk2(G[8 * a2], G[8 * a2 + 1]); gp[st][a2].y = pk2(G[8 * a2 + 2], G[8 * a2 + 3]); gp[st][a2].z = pk2(G[8 * a2 + 4], G[8 * a2 + 5]); gp[st][a2].w = pk2(G[8 * a2 + 6], G[8 * a2 + 7]); }
            } else { gp[st][0] = (u32x4){0u, 0u, 0u, 0u}; gp[st][1] = (u32x4){0u, 0u, 0u, 0u}; }
        }
        }
        float ss = 0.f;
        bf16_t* yrow = (bf16_t*)(X.ws + WS_O) + (t0 + 32 * w + (lane >> 1)) * SSM_INNER + g * 512 + 32 * (lane & 1);
        const bf16_t* zdma = (const bf16_t*)(X.ws + WS_ZBC) + (t0 + 32 * w + (lane >> 3)) * 3072 + g * 512 + 8 * ((lane & 7) ^ (lane >> 3));
        LAS unsigned char* trw = tile + (lane >> 1) * 128;
        LAS unsigned char* tac = tile + ql * 128 + 8 * hf;
#pragma unroll 1
        for (int h8 = 0; h8 < 8; ++h8) {
            const int sb = (h8 & 1) * S3_STG;
            asm volatile("s_waitcnt vmcnt(0) lgkmcnt(0)\n\ts_barrier" ::: "memory");
            if (h8 < 7) S3_ISSUE(h8 + 1, ((h8 + 1) & 1) * S3_STG);
#pragma unroll
            for (int k = 0; k < 4; ++k) DMA16(zdma + (size_t)(8 * k) * 3072 + h8 * 64, tile + k * 1024);
            f32x16 acc0, acc1;
#pragma unroll
            for (int i = 0; i < 16; ++i) { acc0[i] = 0.f; acc1[i] = 0.f; }
            {
                const LAS unsigned char* pp = X.lds + sb + 32768 + hf * 1024 + ql * 16;
#if 1
                const bf16_t* cp = bcm + (t0 + 32 * w + (fresh(lane) & 31)) * 1024 + 512 + g * 128 + 8 * hf;
#pragma unroll
                for (int ks = 0; ks < 8; ++ks) { const bf16x8 cfk = *(const bf16x8*)(cp + 16 * ks);
                                                 acc0 = __builtin_amdgcn_mfma_f32_32x32x16_bf16(*(const LAS bf16x8*)(pp + ks * 2048), cfk, acc0, 0, 0, 0);
                                                 acc1 = __builtin_amdgcn_mfma_f32_32x32x16_bf16(*(const LAS bf16x8*)(pp + ks * 2048 + 512), cfk, acc1, 0, 0, 0); }
#else
#pragma unroll
                for (int ks = 0; ks < 8; ++ks) { acc0 = __builtin_amdgcn_mfma_f32_32x32x16_bf16(*(const LAS bf16x8*)(pp + ks * 2048), cf[ks], acc0, 0, 0, 0);
                                                 acc1 = __builtin_amdgcn_mfma_f32_32x32x16_bf16(*(const LAS bf16x8*)(pp + ks * 2048 + 512), cf[ks], acc1, 0, 0, 0); }
#endif
                const float e = __expf(csl[h8 * 256 + lq]);
#pragma unroll
                for (int i = 0; i < 16; ++i) { acc0[i] *= e; acc1[i] *= e; }
            }
            const float cl = csl[h8 * 256 + lq], dsk = p.in[21][g * 8 + h8];
#pragma unroll
            for (int st = 0; st < 8; ++st) {
                if (st <= w) {
                    const int s0 = 32 * st + 8 * hf;
#pragma unroll
                    for (int a2 = 0; a2 < 2; ++a2) {
                        const f32x4 d0 = *(const LAS f32x4*)(dtl + h8 * 256 + s0 + 16 * a2), d1 = *(const LAS f32x4*)(dtl + h8 * 256 + s0 + 16 * a2 + 4);
                        const f32x4 c0 = *(const LAS f32x4*)(csl + h8 * 256 + s0 + 16 * a2), c1 = *(const LAS f32x4*)(csl + h8 * 256 + s0 + 16 * a2 + 4);
                        const float dd[8] = {d0.x, d0.y, d0.z, d0.w, d1.x, d1.y, d1.z, d1.w}, cc[8] = {c0.x, c0.y, c0.z, c0.w, c1.x, c1.y, c1.z, c1.w};
                        const unsigned gw[4] = {gp[st][a2].x, gp[st][a2].y, gp[st][a2].z, gp[st][a2].w};
                        float m[8];
#pragma unroll
                        for (int j = 0; j < 8; ++j) { const int sidx = s0 + 16 * a2 + j;
                            const float gv = (j & 1) ? bfhi(gw[j >> 1]) : bflo(gw[j >> 1]);
                            float v = gv * dd[j] * __expf(fminf(cl - cc[j], 0.f));
                            if (st == w) { v = sidx > lq ? 0.f : v; v += sidx == lq ? dsk : 0.f; }
                            m[j] = v; }
                        u32x4 pw; pw.x = pk2(m[0], m[1]); pw.y = pk2(m[2], m[3]); pw.z = pk2(m[4], m[5]); pw.w = pk2(m[6], m[7]);
                        const bf16x8 pf = __builtin_bit_cast(bf16x8, pw);
                        const LAS unsigned char* xp = X.lds + sb + (4 * st + 2 * a2 + hf) * 1024 + ql * 16;
                        acc0 = __builtin_amdgcn_mfma_f32_32x32x16_bf16(*(const LAS bf16x8*)xp, pf, acc0, 0, 0, 0);
                        acc1 = __builtin_amdgcn_mfma_f32_32x32x16_bf16(*(const LAS bf16x8*)(xp + 512), pf, acc1, 0, 0, 0);
                        __builtin_amdgcn_sched_barrier(0);
                    }
                }
            }
            asm volatile("s_waitcnt vmcnt(0)" ::: "memory");
#pragma unroll
            for (int pt = 0; pt < 2; ++pt)
#pragma unroll
                for (int g4 = 0; g4 < 4; ++g4) {
                    const u32x2 z2 = *(const LAS u32x2*)(tac + (((4 * pt + g4) ^ (ql & 7)) * 16));
                    const float a0 = pt ? acc1[4 * g4] : acc0[4 * g4], a1 = pt ? acc1[4 * g4 + 1] : acc0[4 * g4 + 1], a2v = pt ? acc1[4 * g4 + 2] : acc0[4 * g4 + 2], a3 = pt ? acc1[4 * g4 + 3] : acc0[4 * g4 + 3];
                    const float v0 = a0 * silu_fast(bflo(z2.x)), v1 = a1 * silu_fast(bfhi(z2.x)), v2 = a2v * silu_fast(bflo(z2.y)), v3 = a3 * silu_fast(bfhi(z2.y));
                    ss += (v0 * v0 + v1 * v1) + (v2 * v2 + v3 * v3);
                    u32x2 o; o.x = pk2(v0, v1); o.y = pk2(v2, v3); *(LAS u32x2*)(tac + (((4 * pt + g4) ^ (ql & 7)) * 16)) = o;
                }
#pragma unroll
            for (int k = 0; k < 4; ++k) *(u32x4*)(yrow + h8 * 64 + 8 * k) = *(const LAS u32x4*)(trw + (((4 * (lane & 1) + k) ^ ((lane >> 1) & 7)) * 16));
        }
#undef S3_ISSUE
        ss += __shfl_xor(ss, 32);
        const float rs = rsqrtf(ss * (1.f / 512.f) + EPS);
        asm volatile("s_waitcnt vmcnt(0)" ::: "memory");
        {
            const int lf = fresh(lane);
            bf16_t* yb = (bf16_t*)(X.ws + WS_O) + (t0 + 32 * w) * SSM_INNER + g * 512 + 8 * lf;
            const f32x4 g0 = *(const f32x4*)(p.in[22] + g * 512 + 8 * lf), g1 = *(const f32x4*)(p.in[22] + g * 512 + 8 * lf + 4);
#pragma unroll 1
            for (int r0 = 0; r0 < 32; r0 += 8) {
                u32x4 q[8];
#pragma unroll
                for (int k = 0; k < 8; ++k) q[k] = *(const u32x4*)(yb + (size_t)(r0 + k) * SSM_INNER);
#pragma unroll
                for (int k = 0; k < 8; ++k) {
                    const float rk = __shfl(rs, r0 + k);
                    u32x4 o; o.x = pk2(bflo(q[k].x) * rk * g0.x, bfhi(q[k].x) * rk * g0.y); o.y = pk2(bflo(q[k].y) * rk * g0.z, bfhi(q[k].y) * rk * g0.w);
                    o.z = pk2(bflo(q[k].z) * rk * g1.x, bfhi(q[k].z) * rk * g1.y); o.w = pk2(bflo(q[k].w) * rk * g1.z, bfhi(q[k].w) * rk * g1.w);
                    *(u32x4*)(yb + (size_t)(r0 + k) * SSM_INNER) = o;
                }
            }
        }
        asm volatile("s_waitcnt lgkmcnt(0)\n\ts_barrier" ::: "memory");
    }
}

__device__ __forceinline__ void ph_moe_gu(const Params& p, const Ctx& X, int l) {
    moe_table(X, l);
    pg8::MoeOrder So{(const LAS int*)(X.lds + TAB_OFF), (const LAS int*)(X.lds + TAB_OFF) + 40, (const int*)(X.ws + WS_SLOT), 3, X.G, X.bid, true};
    pg8::Gemm g{(const bf16_t*)(X.ws + WS_U), (const bf16_t*)(X.ws + WS_WGU) + (size_t)l * NE * 2048 * 1024, 1024};
    pg8::EpiGu E{(bf16_t*)(X.ws + WS_ACT), p.in[27] + (size_t)l * NE * 2048};
    pg8::gemm_phase<pg8::EpiGu, pg8::MoeOrder>(X.lds, g, So, E, X.tid);
}
__device__ __forceinline__ void ph_moe_down(const Params& p, const Ctx& X, int l) {
    moe_table(X, l);
    pg8::MoeOrder So{(const LAS int*)(X.lds + TAB_OFF), (const LAS int*)(X.lds + TAB_OFF) + 40, (const int*)(X.ws + WS_SLOT), 2, X.G, X.bid, false};
    pg8::Gemm g{(const bf16_t*)(X.ws + WS_ACT), (const bf16_t*)(X.ws + WS_WDN) + (size_t)l * NE * 1024 * 1024, 1024};
    pg8::EpiDown E{(bf16_t*)(X.ws + WS_Y), p.in[29] + (size_t)l * NE * 1024};
    pg8::gemm_phase<pg8::EpiDown, pg8::MoeOrder>(X.lds, g, So, E, X.tid);
}

#ifndef PROBE_MULT
#define PROBE_MULT 8
#endif
__global__ void __launch_bounds__(NTHREADS, 2) fwd_kernel(Params p) {
    extern __shared__ __attribute__((aligned(16))) unsigned char lds_raw[];
    Ctx X;
    X.lds = (LAS unsigned char*)lds_raw; X.ws = p.ws;
    X.tid = threadIdx.x; X.lane = X.tid & 63; X.wave = __builtin_amdgcn_readfirstlane(X.tid >> 6);
    X.G = gridDim.x; X.bid = blockIdx.x; X.gw = X.bid * NWAVES + X.wave; X.ngw = X.G * NWAVES; X.sub = 0ull; X.subt = 0ull;
    if (X.tid < 4) ((LAS unsigned*)(X.lds + XB_OFF))[X.tid] = 0u;
    __syncthreads();
    XcdBarrier bar = xcd_barrier_post((unsigned*)(p.ws + WS_CTL) + CW_BAR, (volatile LAS unsigned*)(X.lds + XB_OFF));
#define PHASE_BEGIN Ctx Y = X; { GAS unsigned char* w_ = (GAS unsigned char*)p.ws; asm volatile("" : "+s"(w_)); Y.ws = (unsigned char*)w_; int t_ = threadIdx.x; asm volatile("" : "+v"(t_)); Y.tid = t_; Y.lane = t_ & 63; \
    Y.wave = __builtin_amdgcn_readfirstlane(t_ >> 6); Y.gw = Y.bid * NWAVES + Y.wave; }
#define WSF(off) ((float*)(Y.ws + (off)))
#define WSB(off) ((bf16_t*)(Y.ws + (off)))
#define PROBE_LDS(i) (((volatile LAS unsigned long long*)(X.lds + 150528))[2 * X.wave + (i)])
    if (PROBE_MASK || PROBE_SUB) { if (X.lane == 0) { PROBE_LDS(0) = __builtin_amdgcn_s_memrealtime(); PROBE_LDS(1) = 0ull; } }
#define PB(k) do { if (PROBE_MASK) { if (X.lane == 0) { const unsigned long long n_ = __builtin_amdgcn_s_memrealtime(); if ((PROBE_MASK >> (k)) & 1u) PROBE_LDS(1) += n_ - PROBE_LDS(0); PROBE_LDS(0) = n_; } } } while (0)
    { PHASE_BEGIN ph_prologue(p, Y); }                                    xcd_barrier(bar); PB(0);
    { PHASE_BEGIN ph_norm0(p, Y); }                                       xcd_barrier(bar); PB(1);
    {
        PHASE_BEGIN
        pg8::DenseOrder So; So.init(T, PROJ_LD, X.G, X.bid);
        pg8::Gemm g{WSB(WS_U), WSB(WS_WIN), 1024};
        pg8::EpiBf16 E{WSB(WS_BIG), PROJ_LD};
        pg8::gemm_phase<pg8::EpiBf16, pg8::DenseOrder>(X.lds, g, So, E, Y.tid);
    }
    {
        PHASE_BEGIN
        pg8::DenseOrder So; So.init(768, T, X.G, X.bid);
        pg8::Gemm g{WSB(WS_WV), WSB(WS_U), 1024};
        pg8::EpiBf16 E{WSB(WS_VT), T};
        pg8::gemm_phase<pg8::EpiBf16, pg8::DenseOrder>(X.lds, g, So, E, Y.tid);
    }
    xcd_barrier(bar); PB(2);
    { PHASE_BEGIN ph_attn_a(p, Y); }                                      xcd_barrier(bar); PB(3);
    ConvCur ccur; ccur.it = X.gw; ccur.step = X.ngw;
    { PHASE_BEGIN ph_nsa(p, Y, ccur); if (PROBE_SUB && X.lane == 0) PROBE_LDS(1) += Y.sub; }
    __syncthreads(); PB(19);
    { PHASE_BEGIN ph_sb(p, Y, ccur); if (PROBE_SUB && X.lane == 0) PROBE_LDS(1) += Y.sub; }                                             xcd_barrier(bar); PB(4);
    {
        PHASE_BEGIN
        pg8::DenseOrder So; So.init(T, D, X.G, X.bid);
        pg8::Gemm g{WSB(WS_O), WSB(WS_WOUT), 1024};
        pg8::EpiResid<false> E{p.in[0], WSB(WS_H1), WSF(WS_MODF) + 2048};
        pg8::gemm_phase<pg8::EpiResid<false>, pg8::DenseOrder>(X.lds, g, So, E, Y.tid);
    }
    xcd_barrier(bar); PB(5);
    { PHASE_BEGIN ph_token<0>(p, Y, 0, WSB(WS_H1), nullptr); if (PROBE_SUB && X.lane == 0) PROBE_LDS(1) += Y.sub; }                       xcd_barrier(bar); PB(6);
    { PHASE_BEGIN ph_moe_gu(p, Y, 0); }                                   xcd_barrier(bar); PB(7);
    { PHASE_BEGIN ph_moe_down(p, Y, 0); }                                 xcd_barrier(bar); PB(8);
    { PHASE_BEGIN ph_token<1>(p, Y, 0, WSB(WS_H1), WSB(WS_H2)); if (PROBE_SUB && X.lane == 0) PROBE_LDS(1) += Y.sub; }       xcd_barrier(bar); PB(9);
    {
        PHASE_BEGIN
        pg8::DenseOrder So; So.init(T, 3072, X.G, X.bid);
        pg8::Gemm g{WSB(WS_U), WSB(WS_WSIN), 1024};
        pg8::EpiBf16 E{WSB(WS_ZBC), 3072};
        pg8::gemm_phase<pg8::EpiBf16, pg8::DenseOrder>(X.lds, g, So, E, Y.tid);
    }
    {
        PHASE_BEGIN
        pg8::DenseOrder So; So.init(3072, T, X.G, X.bid);
        pg8::Gemm g{WSB(WS_WSIN) + (size_t)2048 * 1024, WSB(WS_U), 1024};
        pg8::EpiBf16 E{WSB(WS_XT), T};
        pg8::gemm_phase<pg8::EpiBf16, pg8::DenseOrder>(X.lds, g, So, E, Y.tid);
    }
    xcd_barrier(bar); PB(10);
    { PHASE_BEGIN ph_ssd1(p, Y); if (PROBE_SUB && X.lane == 0) PROBE_LDS(1) += Y.sub; }                                        xcd_barrier(bar); PB(11);
    { PHASE_BEGIN ph_ssd2(Y); }                                           xcd_barrier(bar); PB(12);
    { PHASE_BEGIN ph_ssd3(p, Y); if (PROBE_SUB && X.lane == 0) PROBE_LDS(1) += Y.sub; }                                        xcd_barrier(bar); PB(13);
    {
        PHASE_BEGIN
        pg8::DenseOrder So; So.init(T, D, X.G, X.bid);
        pg8::Gemm g{WSB(WS_O), WSB(WS_WSOUT), 2048};
        pg8::EpiResid<true> E{WSB(WS_H2), WSB(WS_H1), WSF(WS_MODF) + 4 * 6144 + 2048};
        pg8::gemm_phase<pg8::EpiResid<true>, pg8::DenseOrder>(X.lds, g, So, E, Y.tid);
    }
    xcd_barrier(bar); PB(14);
    { PHASE_BEGIN ph_token<0>(p, Y, 1, WSB(WS_H1), nullptr); if (PROBE_SUB && X.lane == 0) PROBE_LDS(1) += Y.sub; }                       xcd_barrier(bar); PB(15);
    { PHASE_BEGIN ph_moe_gu(p, Y, 1); }                                   xcd_barrier(bar); PB(16);
    { PHASE_BEGIN ph_moe_down(p, Y, 1); }                                 xcd_barrier(bar); PB(17);
    if (PROBE_MASK & 0x100000) { for (int xb_ = 0; xb_ < 8; ++xb_) xcd_barrier(bar); }
    { PHASE_BEGIN ph_token<2>(p, Y, 1, WSB(WS_H1), p.out); if (PROBE_SUB && X.lane == 0) PROBE_LDS(1) += Y.sub; } PB(18);
    if (PROBE_MASK || PROBE_SUB) { asm volatile("s_waitcnt lgkmcnt(0)" ::: "memory"); const unsigned long long acc_ = PROBE_LDS(1); const unsigned long long t_end = __builtin_amdgcn_s_memrealtime() + (unsigned long long)PROBE_MULT * (unsigned long long)__builtin_amdgcn_readfirstlane((unsigned)acc_); while (__builtin_amdgcn_s_memrealtime() < t_end) __builtin_amdgcn_s_sleep(8); }
#undef PB
#undef PROBE_LDS
#undef PHASE_BEGIN
#undef WSF
#undef WSB
}
}

extern "C" void kernel_launch(void* const* d_in, const int* in_sizes, int n_in, void* d_out, int out_size, void* d_ws, size_t ws_size, hipStream_t stream) {
    static int grid = 0;
    if (grid == 0) {
        if (n_in != 30 || out_size != T * D || ws_size < WS_END) { fprintf(stderr, "kernel_launch: unexpected shapes / workspace (%d inputs, out %d, ws %zu < %zu)\n", n_in, out_size, ws_size, (size_t)WS_END); grid = -1; return; }
        int dev = 0, cus = 0, per_cu = 0;
        if (hipGetDevice(&dev) != hipSuccess || hipDeviceGetAttribute(&cus, hipDeviceAttributeMultiprocessorCount, dev) != hipSuccess) { grid = -1; return; }
        if (hipFuncSetAttribute((const void*)fwd_kernel, hipFuncAttributeMaxDynamicSharedMemorySize, LDS_BYTES) != hipSuccess) { fprintf(stderr, "kernel_launch: hipFuncSetAttribute failed\n"); grid = -1; return; }
        if (hipOccupancyMaxActiveBlocksPerMultiprocessor(&per_cu, (const void*)fwd_kernel, NTHREADS, LDS_BYTES) != hipSuccess || per_cu < 1) { fprintf(stderr, "kernel_launch: occupancy query reports %d\n", per_cu); }
        (void)hipGetLastError();
        grid = cus;
    }
    if (grid < 0) return;
    if (hipMemsetAsync((char*)d_ws + WS_CTL, 0, CTL_BYTES, stream) != hipSuccess) return;
    Params p{};
    for (int i = 0; i < 30; ++i) p.in[i] = (const float*)d_in[i];
    p.out = (float*)d_out; p.ws = (unsigned char*)d_ws;
    hipLaunchKernelGGL(fwd_kernel, dim3(grid), dim3(NTHREADS), LDS_BYTES, stream, p);
}
```

```cpp
#include <hip/hip_runtime.h>
#include <cstdio>
#include <cstdint>

#define LAS __attribute__((address_space(3)))
#ifndef PROBE_MASK
#define PROBE_MASK 0
#endif
#ifndef PROBE_SUB
#define PROBE_SUB 0
#endif
#define GAS __attribute__((address_space(1)))
typedef unsigned short bf16_t;
typedef short bf16x8 __attribute__((ext_vector_type(8)));
typedef float f32x4 __attribute__((ext_vector_type(4)));
typedef unsigned u32x4 __attribute__((ext_vector_type(4)));
typedef unsigned u32x2 __attribute__((ext_vector_type(2)));
typedef float f32x16 __attribute__((ext_vector_type(16)));

namespace {
constexpr int D = 1024, NB = 4, S = 4096, T = NB * S;
constexpr int ATTN_IN = 2840, PROJ_LD = 3072;
constexpr int OFF_SBQ = 0, OFF_SBK = 512, OFF_SBV = 1024, OFF_NQ = 1536, OFF_KC = 2048, OFF_VC = 2176, OFF_KS = 2304, OFF_VS = 2432,
              OFF_KW = 2560, OFF_VW = 2688, OFF_GATE = 2816;
constexpr int NCMP = 255;
constexpr int SSM_IN = 5152, SSM_INNER = 2048, CONV_DIM = 3072, ZX_LD = 5120;
constexpr int NE = 32, CAP = 16384, MAXTILES = 288;
constexpr float EPS = 1e-6f;
constexpr int NWAVES = 8, NTHREADS = 512;

constexpr size_t al4k(size_t x) { return (x + 4095) & ~(size_t)4095; }
constexpr size_t WS_CTL = 0, CTL_BYTES = 1u << 20;
constexpr int CW_CNT = 256;
constexpr int CW_BAR = 4096;
constexpr size_t CTL_MOD = 65536;
constexpr size_t WS_WIN = CTL_BYTES;
constexpr size_t WS_WOUT = WS_WIN + (size_t)3072 * 1024 * 2;
constexpr size_t WS_WSIN = WS_WOUT + (size_t)1024 * 1024 * 2;
constexpr size_t WS_WSOUT = WS_WSIN + (size_t)5120 * 1024 * 2;
constexpr size_t WS_WGU = WS_WSOUT + (size_t)1024 * 2048 * 2;
constexpr size_t WS_WDN = WS_WGU + (size_t)2 * 32 * 2048 * 1024 * 2;
constexpr size_t WS_U = WS_WDN + (size_t)2 * 32 * 1024 * 1024 * 2;
constexpr size_t WS_BIG = WS_U + (size_t)T * 1024 * 2;
constexpr size_t WS_O = WS_BIG + (size_t)T * 5120 * 2;
constexpr size_t WS_H1 = WS_O + (size_t)T * 2048 * 2;
constexpr size_t WS_H2 = WS_H1 + (size_t)T * 1024 * 4;
constexpr size_t WS_QN = WS_H2 + (size_t)T * 1024 * 4;
constexpr size_t WS_KN = WS_QN + (size_t)T * 512 * 4;
constexpr size_t WS_KCMP = WS_KN + (size_t)T * 256 * 4;
constexpr size_t WS_VCMP = WS_KCMP + al4k((size_t)NB * NCMP * 2 * 64 * 4);
constexpr size_t WS_ACT = WS_VCMP + al4k((size_t)NB * NCMP * 2 * 64 * 4);
constexpr size_t WS_Y = WS_ACT + (size_t)MAXTILES * 256 * 1024 * 2;
constexpr size_t WS_TOKE = WS_Y + (size_t)MAXTILES * 256 * 1024 * 2;
constexpr size_t WS_TOKW = WS_TOKE + (size_t)T * 16;
constexpr size_t WS_TOKP = WS_TOKW + (size_t)T * 16;
constexpr size_t WS_SLOT = WS_TOKP + (size_t)T * 16;
constexpr size_t WS_XC = WS_SLOT + (size_t)NE * CAP * 4;
constexpr size_t WS_YS = WS_XC + (size_t)T * 3072 * 4;
constexpr size_t WS_DT = WS_YS + (size_t)T * 2048 * 4;
constexpr size_t WS_MODF = WS_DT + (size_t)T * 32 * 4;
constexpr size_t WS_WV = WS_MODF + (size_t)2 * 4 * 6144 * 4;
constexpr size_t WS_VT = WS_WV + (size_t)768 * 1024 * 2;
constexpr size_t WS_QNB = WS_VT + (size_t)768 * T * 2;
constexpr size_t WS_KSN = WS_QNB + (size_t)T * 512 * 2;
constexpr size_t WS_KWN = WS_KSN + (size_t)T * 128 * 2;
constexpr size_t WS_KCB = WS_KWN + (size_t)T * 128 * 2;
constexpr size_t WS_VCT = WS_KCB + (size_t)8 * 256 * 64 * 2;
constexpr size_t WS_DT2 = WS_VCT + (size_t)8 * 64 * 256 * 2;
constexpr size_t WS_CS = WS_DT2 + (size_t)NB * 32 * S * 4;
constexpr size_t WS_DEC = WS_CS + (size_t)NB * 32 * S * 4;
constexpr size_t WS_W1T = WS_DEC + al4k((size_t)NB * 16 * 32 * 4);
constexpr size_t WS_SKW = WS_W1T + (size_t)2 * 128 * 2048 * 2;
constexpr size_t WS_ULO = WS_SKW + (size_t)3 * 2 * 32 * 1024 * 2;
constexpr size_t WS_END = WS_ULO + (size_t)T * 1024 * 2;
constexpr size_t WS_ZBC = WS_BIG, WS_XT = WS_XC, WS_XCT = WS_XC + (size_t)3072 * T * 2, WS_ST = WS_YS, WS_PB = WS_YS + (size_t)NB * 16 * 32 * 8192 * 4, WS_BCM = WS_QN;
static_assert(WS_XCT + (size_t)2560 * T * 2 <= WS_YS && WS_PB + (size_t)NB * 16 * 32 * 8192 * 2 <= WS_DT && (size_t)T * 1024 * 2 <= (size_t)T * 512 * 4, "layer-1 overlays");

constexpr int RING_BYTES = 131072;
constexpr int EXTRA_OFF = RING_BYTES;
constexpr int TAB_OFF = 151552;
constexpr int XB_OFF = 152576;
constexpr int LDS_BYTES = 153600;

struct Params { const float* in[30]; float* out; unsigned char* ws; };

__device__ __forceinline__ float siluf(float v) { return v / (1.f + expf(-v)); }
__device__ __forceinline__ float logsig(float x) { return fminf(x, 0.f) - log1pf(expf(-fabsf(x))); }
__device__ __forceinline__ float wave_sum(float v) {
#pragma unroll
    for (int o = 32; o > 0; o >>= 1) v += __shfl_xor(v, o);
    return v;
}
__device__ __forceinline__ float wave_max(float v) {
#pragma unroll
    for (int o = 32; o > 0; o >>= 1) v = fmaxf(v, __shfl_xor(v, o));
    return v;
}
__device__ __forceinline__ unsigned f2bf(float f) { unsigned u = __builtin_bit_cast(unsigned, f); return (u + 0x7fffu + ((u >> 16) & 1u)) >> 16; }
typedef float f32x2_t __attribute__((ext_vector_type(2))); typedef __bf16 bf16x2_t __attribute__((ext_vector_type(2)));
__device__ __forceinline__ unsigned pk2(float lo, float hi) { f32x2_t v = {lo, hi}; bf16x2_t b = __builtin_convertvector(v, bf16x2_t); return __builtin_bit_cast(unsigned, b); }
__device__ __forceinline__ float bf2f(bf16_t v) { return __uint_as_float((unsigned)v << 16); }
__device__ __forceinline__ float bflo(unsigned w) { return __uint_as_float(w << 16); }
__device__ __forceinline__ float bfhi(unsigned w) { return __uint_as_float(w & 0xffff0000u); }
#define LDS_WAIT() asm volatile("s_waitcnt lgkmcnt(0)" ::: "memory")
__device__ __forceinline__ int fresh(int v) { asm volatile("" : "+v"(v)); return v; }
__device__ __forceinline__ int sfresh(int v) { asm volatile("" : "+s"(v)); return v; }

#define XB_TMO      128
#define XB_XCNT(j)  (256  + 64 * (j))
#define XB_XSUB(j)  (1280 + 64 * (j))
#define XB_XGEN(j)  (2304 + 64 * (j))
#define XB_TOP      3328
#define XB_TOPGEN   3392
#define XCD_BAR_WORDS 3456
#define XB_SPIN_CAP (1u << 18)
__device__ __forceinline__ unsigned xb_ld(unsigned* p)              { return __hip_atomic_load(p, __ATOMIC_RELAXED, __HIP_MEMORY_SCOPE_AGENT); }
__device__ __forceinline__ unsigned xb_add(unsigned* p, unsigned v) { return __hip_atomic_fetch_add(p, v, __ATOMIC_RELAXED, __HIP_MEMORY_SCOPE_AGENT); }
__device__ __forceinline__ unsigned xb_xcc_id() { return (unsigned)__builtin_amdgcn_s_getreg((3 << 11) | 20) & 0xFu; }
#define XB_SPIN(cond, bar) do { unsigned _sp = 0; while (cond) { __builtin_amdgcn_s_sleep(1); \
    if ((++_sp & 255u) == 0u) { if (xb_ld(&(bar)[XB_TMO])) break; if (_sp > XB_SPIN_CAP) { atomicAdd(&(bar)[XB_TMO], 1u); break; } } } } while (0)
struct XcdBarrier { unsigned* bar; unsigned x; volatile LAS unsigned* st; };
__device__ __forceinline__ XcdBarrier xcd_barrier_post(unsigned* bar, volatile LAS unsigned* st) {
    XcdBarrier b; b.bar = bar; b.x = xb_xcc_id(); b.st = st;
    if (threadIdx.x == 0) (void)xb_add(&bar[XB_XCNT(b.x)], 1u);
    return b;
}
__device__ __forceinline__ void xcd_barrier_complete(unsigned* bar, unsigned x, unsigned& nloc, unsigned& nx) {
    const unsigned G = gridDim.x * gridDim.y * gridDim.z;
    unsigned sum, cnt, mine, sp = 0u;
    for (;;) {
        sum = 0u; cnt = 0u; mine = 0u;
#pragma unroll
        for (unsigned j = 0; j < 16; ++j) { const unsigned c = xb_ld(&bar[XB_XCNT(j)]); sum += c; cnt += (c > 0u) ? 1u : 0u; mine = (j == x) ? c : mine; }
        if (sum == G) break;
        __builtin_amdgcn_s_sleep(1);
        if ((++sp & 255u) == 0u) { if (xb_ld(&bar[XB_TMO])) break; if (sp > XB_SPIN_CAP) { atomicAdd(&bar[XB_TMO], 1u); break; } }
    }
    nloc = mine > 0u ? mine : 1u; nx = cnt > 0u ? cnt : 1u;
}
__device__ __forceinline__ void xcd_barrier(const XcdBarrier& b) {
    asm volatile("s_waitcnt vmcnt(0)" ::: "memory");
    __syncthreads();
    if (threadIdx.x == 0) {
        unsigned* bar = b.bar;
        __builtin_amdgcn_s_waitcnt(0);
        unsigned nloc = b.st[0], nx = b.st[1];
        if (nloc == 0u) { xcd_barrier_complete(bar, b.x, nloc, nx); b.st[0] = nloc; b.st[1] = nx; }
        const unsigned old = xb_add(&bar[XB_XSUB(b.x)], 1u);
        const unsigned gen = old / nloc;
        if (old + 1u == (gen + 1u) * nloc) {
            __builtin_amdgcn_fence(__ATOMIC_RELEASE, "agent");
            asm volatile("s_waitcnt vmcnt(0)" ::: "memory");
            const unsigned og = xb_add(&bar[XB_TOP], 1u);
            const unsigned tg = og / nx;
            if (og + 1u == (tg + 1u) * nx) xb_add(&bar[XB_TOPGEN], 1u);
            else XB_SPIN(xb_ld(&bar[XB_TOPGEN]) == tg, bar);
            __builtin_amdgcn_fence(__ATOMIC_ACQUIRE, "agent");
            xb_add(&bar[XB_XGEN(b.x)], 1u);
            asm volatile("s_waitcnt vmcnt(0)" ::: "memory");
        } else {
            XB_SPIN(xb_ld(&bar[XB_XGEN(b.x)]) == gen, bar);
            __builtin_amdgcn_fence(__ATOMIC_ACQUIRE, "agent");
            asm volatile("s_waitcnt vmcnt(0)" ::: "memory");
        }
    }
    __syncthreads();
}

namespace pg8 {
constexpr int BM = 256, BK = 64, HALF = 128, HTB = HALF * BK * 2, STAGE_BYTES = 8 * HTB;
__device__ __forceinline__ int lds_byte(int r, int c) { const int st = (r >> 4) * 2 + (c >> 5), rr = r & 15, cc = c & 31, ob = rr * 64 + cc * 2; return st * 1024 + (ob ^ (((ob >> 9) & 1) << 5)); }
__device__ __forceinline__ void stage_rc(int b, int& R, int& C) { const int st = b / 1024, sb = b % 1024, swz = sb ^ (((sb >> 9) & 1) << 5); R = (st >> 1) * 16 + swz / 64; C = (st & 1) * 32 + (swz % 64) / 2; }
__device__ __forceinline__ int perm32(int rho) { const int n = rho >> 4, i = rho & 15; return 8 * (i >> 2) + 4 * n + (i & 3); }
struct Unit { int pm, pn, e; };
struct Gemm { const bf16_t* A; const bf16_t* Bt; int K; };
__device__ __forceinline__ unsigned cvt_pk_bf16(float lo, float hi) { unsigned r; asm volatile("v_cvt_pk_bf16_f32 %0, %1, %2" : "=v"(r) : "v"(lo), "v"(hi)); return r; }

struct DenseOrder {
    int nM, nN, nwg, G, c;
    __device__ void init(int M, int N, int G_, int c_) { nM = M / BM; nN = N / BM; nwg = nM * nN; G = G_; c = c_; }
    __device__ bool next(int i, Unit& u) const {
        const long L = (long)i * G + c; if (L >= nwg) return false;
        int wgid = (int)L; { const int q = nwg / 8, r = nwg % 8, xcd = wgid % 8, off = wgid / 8; wgid = (xcd < r ? xcd * (q + 1) : r * (q + 1) + (xcd - r) * q) + off; }
        const int nig = 8 * nN, gid = wgid / nig, fm = gid * 8, gsz = (nM - fm) < 8 ? (nM - fm) : 8;
        u.pm = fm + ((wgid % nig) % gsz); u.pn = (wgid % nig) / gsz; u.e = 0; return true;
    }
    __device__ __forceinline__ unsigned arow(const Unit& u, int r) const { return (unsigned)(u.pm * BM + r); }
};
struct MoeOrder {
    const LAS int* tb; const LAS int* cn; const int* slot_tok; int shift, G, c; bool gather;
    __device__ bool next(int i, Unit& u) const {
        const int L = i * G + c, tile = L >> shift; if (tile >= tb[NE]) return false;
        int e = 0; while (tb[e + 1] <= tile) ++e;
        u.pm = tile; u.pn = (e << shift) + (L & ((1 << shift) - 1)); u.e = e; return true;
    }
    __device__ __forceinline__ unsigned arow(const Unit& u, int r) const {
        if (!gather) return (unsigned)(u.pm * BM + r);
        const int pos = (u.pm - tb[u.e]) * BM + r;
        return pos < cn[u.e] ? (unsigned)slot_tok[u.e * CAP + pos] : 0u;
    }
};

struct EpiBf16 {
    static constexpr bool PERM = true;
    bf16_t* O; int ldc;
    __device__ __forceinline__ void operator()(const f32x4 (&acc)[2][2][4][2], const Unit& u, int wr, int wc, int fr, int fq) const {
        const int row0 = u.pm * BM + wr * 64 + fr, col0 = u.pn * BM + wc * 32 + 8 * fq;
#pragma unroll
        for (int ai = 0; ai < 2; ++ai)
#pragma unroll
            for (int m = 0; m < 4; ++m) { bf16_t* rowp = O + (size_t)(row0 + ai * HALF + m * 16) * ldc + col0;
#pragma unroll
                for (int bj = 0; bj < 2; ++bj) { const f32x4 v0 = acc[ai][bj][m][0], v1 = acc[ai][bj][m][1];
                    u32x4 w; w.x = cvt_pk_bf16(v0[0], v0[1]); w.y = cvt_pk_bf16(v0[2], v0[3]); w.z = cvt_pk_bf16(v1[0], v1[1]); w.w = cvt_pk_bf16(v1[2], v1[3]);
                    *(u32x4*)(rowp + bj * HALF) = w; } }
    }
};
template <bool BASE_BF16>
struct EpiResid {
    static constexpr bool PERM = true;
    const void* base; bf16_t* out; const float* g;
    __device__ __forceinline__ void operator()(const f32x4 (&acc)[2][2][4][2], const Unit& u, int wr, int wc, int fr, int fq) const {
        const int row0 = u.pm * BM + wr * 64 + fr, col0 = u.pn * BM + wc * 32 + 8 * fq;
        const float* gb = g + (size_t)((u.pm * BM) / S) * 6144 + col0;
        f32x4 gv[2][2];
#pragma unroll
        for (int bj = 0; bj < 2; ++bj)
#pragma unroll
            for (int n = 0; n < 2; ++n) gv[bj][n] = *(const f32x4*)(gb + bj * HALF + n * 4);
#pragma unroll
        for (int ai = 0; ai < 2; ++ai) {
            f32x4 b0[4][2], b1[4][2];
#pragma unroll
            for (int m = 0; m < 4; ++m) { const size_t off = (size_t)(row0 + ai * HALF + m * 16) * D + col0;
#pragma unroll
                for (int bj = 0; bj < 2; ++bj) {
                    if (BASE_BF16) { const u32x4 q = *(const u32x4*)((const bf16_t*)base + off + bj * HALF); b0[m][bj] = (f32x4){bflo(q.x), bfhi(q.x), bflo(q.y), bfhi(q.y)}; b1[m][bj] = (f32x4){bflo(q.z), bfhi(q.z), bflo(q.w), bfhi(q.w)}; }
                    else { b0[m][bj] = *(const f32x4*)((const float*)base + off + bj * HALF); b1[m][bj] = *(const f32x4*)((const float*)base + off + bj * HALF + 4); } } }
            asm volatile("" ::: "memory");
#pragma unroll
            for (int m = 0; m < 4; ++m) { const size_t off = (size_t)(row0 + ai * HALF + m * 16) * D + col0;
#pragma unroll
                for (int bj = 0; bj < 2; ++bj) {
                    const f32x4 v0 = b0[m][bj] + gv[bj][0] * acc[ai][bj][m][0], v1 = b1[m][bj] + gv[bj][1] * acc[ai][bj][m][1];
                    u32x4 w; w.x = cvt_pk_bf16(v0[0], v0[1]); w.y = cvt_pk_bf16(v0[2], v0[3]); w.z = cvt_pk_bf16(v1[0], v1[1]); w.w = cvt_pk_bf16(v1[2], v1[3]);
                    *(u32x4*)(out + off + bj * HALF) = w; } }
        }
    }
};
struct EpiGu {
    static constexpr bool PERM = true;
    bf16_t* act; const float* bgu;
    __device__ __forceinline__ void operator()(const f32x4 (&acc)[2][2][4][2], const Unit& u, int wr, int wc, int fr, int fq) const {
        const int row0 = u.pm * BM + wr * 64 + fr, col0 = (u.pn & 7) * HALF + wc * 32 + 8 * fq;
        const float* bb = bgu + (size_t)u.e * 2048 + col0;
        const f32x4 bg0 = *(const f32x4*)(bb), bg1 = *(const f32x4*)(bb + 4), bu0 = *(const f32x4*)(bb + 1024), bu1 = *(const f32x4*)(bb + 1028);
#pragma unroll
        for (int ai = 0; ai < 2; ++ai)
#pragma unroll
            for (int m = 0; m < 4; ++m) {
                float r[8];
#pragma unroll
                for (int n = 0; n < 2; ++n) { const f32x4 gt = acc[ai][0][m][n] + (n ? bg1 : bg0), up = acc[ai][1][m][n] + (n ? bu1 : bu0);
#pragma unroll
                    for (int j = 0; j < 4; ++j) { const float gg = fminf(gt[j], 7.f), uu = fminf(fmaxf(up[j], -7.f), 7.f);
                        r[n * 4 + j] = (uu + 1.f) * gg * __builtin_amdgcn_rcpf(1.f + __expf(-1.702f * gg)); } }
                u32x4 w; w.x = cvt_pk_bf16(r[0], r[1]); w.y = cvt_pk_bf16(r[2], r[3]); w.z = cvt_pk_bf16(r[4], r[5]); w.w = cvt_pk_bf16(r[6], r[7]);
                *(u32x4*)(act + (size_t)(row0 + ai * HALF + m * 16) * D + col0) = w; }
    }
};
struct EpiDown {
    static constexpr bool PERM = true;
    bf16_t* y; const float* bd;
    __device__ __forceinline__ void operator()(const f32x4 (&acc)[2][2][4][2], const Unit& u, int wr, int wc, int fr, int fq) const {
        const int row0 = u.pm * BM + wr * 64 + fr, col0 = (u.pn & 3) * BM + wc * 32 + 8 * fq;
        const float* bb = bd + (size_t)u.e * 1024 + col0;
        f32x4 bv[2][2];
#pragma unroll
        for (int bj = 0; bj < 2; ++bj)
#pragma unroll
            for (int n = 0; n < 2; ++n) bv[bj][n] = *(const f32x4*)(bb + bj * HALF + 4 * n);
#pragma unroll
        for (int ai = 0; ai < 2; ++ai)
#pragma unroll
            for (int m = 0; m < 4; ++m) { bf16_t* rowp = y + (size_t)(row0 + ai * HALF + m * 16) * D + col0;
#pragma unroll
                for (int bj = 0; bj < 2; ++bj) { const f32x4 v0 = acc[ai][bj][m][0] + bv[bj][0], v1 = acc[ai][bj][m][1] + bv[bj][1];
                    u32x4 w; w.x = cvt_pk_bf16(v0[0], v0[1]); w.y = cvt_pk_bf16(v0[2], v0[3]); w.z = cvt_pk_bf16(v1[0], v1[1]); w.w = cvt_pk_bf16(v1[2], v1[3]);
                    *(u32x4*)(rowp + bj * HALF) = w; } }
    }
};

template <class Epi, class Sched>
__device__ __forceinline__ void gemm_phase(LAS unsigned char* lds, const Gemm g, const Sched& S, const Epi& E, const int tid) {
    const int wid = __builtin_amdgcn_readfirstlane(tid >> 6), lane = tid & 63, wr = wid >> 2, wc = wid & 3, fr = lane & 15, fq = lane >> 4;
    const int K = g.K, nt = K / BK;
    int RA[2], CA[2]; unsigned voffB[2];
#pragma unroll
    for (int i = 0; i < 2; ++i) { int R, C; stage_rc(tid * 16 + i * 8192, R, C); const int Rb = Epi::PERM ? ((R & ~31) + perm32(R & 31)) : R;
        RA[i] = R; CA[i] = C; voffB[i] = (unsigned)(Rb * K + C) * 2u; }
    const size_t kstep = (size_t)(BK * 2);
    const size_t hstep = (size_t)HALF * K * 2;
    const size_t tstep = 2 * hstep;
    const unsigned ldsw = (unsigned)wid * 1024u;
    const int aoff = lds_byte(wr * 64 + fr, fq * 8), boff = lds_byte(wc * 32 + fr, fq * 8);
#define PG8_SA(b, h) (((b) * 2 + (h)) * HTB)
#define PG8_SB(b, h) ((4 + (b) * 2 + (h)) * HTB)
#define PG8_STAGE(bufoff, gbase, voff) do { _Pragma("unroll") for (int _i = 0; _i < 2; ++_i) \
        __builtin_amdgcn_global_load_lds((const unsigned*)((const char*)(gbase) + (voff)[_i]), (LAS unsigned*)(lds + (bufoff) + ldsw + _i * 8192), 16, 0, 0); } while (0)
#define PG8_LDA(dst, b, h) do { _Pragma("unroll") for (int m = 0; m < 4; ++m) _Pragma("unroll") for (int k = 0; k < 2; ++k) dst[m][k] = *(const LAS bf16x8*)(lds + PG8_SA(b, h) + aoff + m * 2048 + k * 1024); } while (0)
#define PG8_LDB(dst, b, h) do { _Pragma("unroll") for (int n = 0; n < 2; ++n) _Pragma("unroll") for (int k = 0; k < 2; ++k) dst[n][k] = *(const LAS bf16x8*)(lds + PG8_SB(b, h) + boff + n * 2048 + k * 1024); } while (0)
#define PG8_MMA(ai, bj, At, Bt) do { __builtin_amdgcn_s_setprio(1); _Pragma("unroll") for (int m = 0; m < 4; ++m) _Pragma("unroll") for (int n = 0; n < 2; ++n) _Pragma("unroll") for (int k = 0; k < 2; ++k) \
        acc[ai][bj][m][n] = __builtin_amdgcn_mfma_f32_16x16x32_bf16(Bt[n][k], At[m][k], acc[ai][bj][m][n], 0, 0, 0); __builtin_amdgcn_s_setprio(0); } while (0)
#define PG8_WAIT_V(n) asm volatile("s_waitcnt vmcnt(" #n ")" ::: "memory")
#define PG8_WAIT_L(n) asm volatile("s_waitcnt lgkmcnt(" #n ")" ::: "memory")
#define PG8_BAR __builtin_amdgcn_s_barrier()
#define PG8_SCHED __builtin_amdgcn_sched_barrier(0)
#define PG8_AOFF(dst, u) do { _Pragma("unroll") for (int _h = 0; _h < 2; ++_h) _Pragma("unroll") for (int _i = 0; _i < 2; ++_i) dst[_h][_i] = (S.arow(u, _h * HALF + RA[_i]) * (unsigned)K + (unsigned)CA[_i]) * 2u; } while (0)
    Unit cur, nxt; int ui = 0;
    if (!S.next(0, cur)) return;
    f32x4 acc[2][2][4][2];
#pragma unroll
    for (int a = 0; a < 2; ++a)
#pragma unroll
        for (int b = 0; b < 2; ++b)
#pragma unroll
            for (int m = 0; m < 4; ++m)
#pragma unroll
                for (int n = 0; n < 2; ++n) acc[a][b][m][n] = (f32x4){0.f, 0.f, 0.f, 0.f};
    bf16x8 At[4][2], B0[2][2], B1[2][2];
    unsigned va[2][2], vn[2][2];
    PG8_AOFF(va, cur);
    const char* Ab = (const char*)g.A;
    const char* cB = (const char*)g.Bt + (size_t)cur.pn * tstep;
    PG8_STAGE(PG8_SB(0, 0), cB, voffB); PG8_STAGE(PG8_SB(0, 1), cB + hstep, voffB); PG8_STAGE(PG8_SA(0, 0), Ab, va[0]); PG8_STAGE(PG8_SA(0, 1), Ab, va[1]);
    if (wr == 1) PG8_BAR;
    PG8_WAIT_V(2); PG8_BAR;
    PG8_STAGE(PG8_SB(1, 0), cB + kstep, voffB); PG8_STAGE(PG8_SA(1, 0), Ab + kstep, va[0]); PG8_STAGE(PG8_SB(1, 1), cB + hstep + kstep, voffB);
    PG8_WAIT_V(6); PG8_BAR;
    for (;;) {
        const bool has_next = S.next(ui + 1, nxt);
        if (has_next) { PG8_AOFF(vn, nxt); }
        else {
#pragma unroll
            for (int h = 0; h < 2; ++h)
#pragma unroll
                for (int i = 0; i < 2; ++i) vn[h][i] = va[h][i]; }
        const char* nB = has_next ? (const char*)g.Bt + (size_t)nxt.pn * tstep : cB;
        for (int t = 0; t < nt; t += 2) {
            const bool last = (t == nt - 2);
            const char* a1 = Ab + (size_t)(t + 1) * kstep;
            const char* a2 = last ? Ab : Ab + (size_t)(t + 2) * kstep; const char* b2 = last ? nB : cB + (size_t)(t + 2) * kstep;
            const char* a3 = a2 + kstep; const char* b3 = b2 + kstep;
            unsigned o2[2][2];
#pragma unroll
            for (int h = 0; h < 2; ++h)
#pragma unroll
                for (int i = 0; i < 2; ++i) o2[h][i] = last ? vn[h][i] : va[h][i];
            PG8_LDB(B0, 0, 0); PG8_LDB(B1, 0, 1); PG8_SCHED; PG8_LDA(At, 0, 0); PG8_STAGE(PG8_SA(1, 1), a1, va[1]);
            PG8_WAIT_V(8); PG8_WAIT_L(0); PG8_BAR; PG8_MMA(0, 0, At, B0); PG8_MMA(0, 1, At, B1); PG8_BAR; PG8_SCHED;
            PG8_LDA(At, 0, 1); PG8_STAGE(PG8_SB(0, 0), b2, voffB); PG8_STAGE(PG8_SB(0, 1), b2 + hstep, voffB); PG8_STAGE(PG8_SA(0, 0), a2, o2[0]);
            PG8_WAIT_V(8); PG8_WAIT_L(0); PG8_BAR; PG8_MMA(1, 0, At, B0); PG8_MMA(1, 1, At, B1); PG8_BAR; PG8_SCHED;
            PG8_LDB(B0, 1, 0); PG8_LDB(B1, 1, 1); PG8_SCHED; PG8_LDA(At, 1, 0); PG8_STAGE(PG8_SA(0, 1), a2, o2[1]);
            PG8_WAIT_V(8); PG8_WAIT_L(0); PG8_BAR; PG8_MMA(0, 0, At, B0); PG8_MMA(0, 1, At, B1); PG8_BAR; PG8_SCHED;
            PG8_LDA(At, 1, 1); PG8_STAGE(PG8_SB(1, 0), b3, voffB); PG8_STAGE(PG8_SB(1, 1), b3 + hstep, voffB); PG8_STAGE(PG8_SA(1, 0), a3, o2[0]);
            PG8_WAIT_V(8); PG8_WAIT_L(0); PG8_BAR; PG8_MMA(1, 0, At, B0); PG8_MMA(1, 1, At, B1); PG8_BAR; PG8_SCHED;
        }
        if (wr == 0) PG8_BAR;
        E(acc, cur, wr, wc, fr, fq);
        if (!has_next) break;
#pragma unroll
        for (int a = 0; a < 2; ++a)
#pragma unroll
            for (int b = 0; b < 2; ++b)
#pragma unroll
                for (int m = 0; m < 4; ++m)
#pragma unroll
                    for (int n = 0; n < 2; ++n) acc[a][b][m][n] = (f32x4){0.f, 0.f, 0.f, 0.f};
        cur = nxt; cB = nB; ++ui;
#pragma unroll
        for (int h = 0; h < 2; ++h)
#pragma unroll
            for (int i = 0; i < 2; ++i) va[h][i] = vn[h][i];
        if (wr == 1) PG8_BAR;
    }
    PG8_WAIT_V(0);
    PG8_BAR;
#undef PG8_SA
#undef PG8_SB
#undef PG8_STAGE
#undef PG8_LDA
#undef PG8_LDB
#undef PG8_MMA
#undef PG8_WAIT_V
#undef PG8_WAIT_L
#undef PG8_BAR
#undef PG8_SCHED
#undef PG8_AOFF
}
}

struct Ctx {
    LAS unsigned char* lds; unsigned char* ws;
    int tid, lane, wave, gw, ngw, G, bid;
    mutable unsigned long long sub, subt;
};
#define SUB_BEGIN(X, id) do { if (PROBE_SUB == (id)) (X).subt = __builtin_amdgcn_s_memrealtime(); } while (0)
#define SUB_END(X, id) do { if (PROBE_SUB == (id)) (X).sub += __builtin_amdgcn_s_memrealtime() - (X).subt; } while (0)

__device__ __forceinline__ void transpose_item(const float* W, int ldw, int K, int nvalid, int k0, int n0, bf16_t* WT, int row0, LAS float* scr, int lane) {
    const int c4 = (lane & 7) * 4, kr = lane >> 3;
    f32x4 v[8];
#pragma unroll
    for (int i = 0; i < 8; ++i) v[i] = (n0 + c4 < nvalid) ? *(const f32x4*)(W + (size_t)(k0 + kr + 8 * i) * ldw + n0 + c4) : (f32x4){0.f, 0.f, 0.f, 0.f};
#pragma unroll
    for (int i = 0; i < 8; ++i) { LAS float* d = scr + (kr + 8 * i) * 33 + c4; d[0] = v[i].x; d[1] = v[i].y; d[2] = v[i].z; d[3] = v[i].w; }
    LDS_WAIT(); asm volatile("" ::: "memory");
    const int c = lane & 7;
#pragma unroll
    for (int j = 0; j < 4; ++j) { const int n = (lane >> 3) + 8 * j; const LAS float* s = scr + (8 * c) * 33 + n;
        u32x4 o; o.x = pk2(s[0 * 33], s[1 * 33]); o.y = pk2(s[2 * 33], s[3 * 33]); o.z = pk2(s[4 * 33], s[5 * 33]); o.w = pk2(s[6 * 33], s[7 * 33]);
        *(u32x4*)(WT + (size_t)(row0 + n) * K + k0 + 8 * c) = o; }
    LDS_WAIT(); asm volatile("" ::: "memory");
}
__device__ __forceinline__ void ph_prologue(const Params& p, const Ctx& X) {
    LAS float* scr = (LAS float*)(X.lds + X.wave * 16384);
    unsigned char* ws = X.ws;
    constexpr int I_MOD = 2 * 96 * 8;
    constexpr int I_SK = 3 * 16, I_W1 = 2 * 32 * 4, I_WIN = 16 * 96, I_WV = 16 * 24, I_WOUT = 16 * 32, I_WSIN = 16 * 160, I_WSOUT = 32 * 32;
    constexpr int NITEMS = I_MOD + I_SK + I_W1 + I_WIN + I_WV + I_WOUT + I_WSIN + I_WSOUT;
    for (int it = X.gw; it < NITEMS; it += X.ngw) {
        int r = it;
        if (r < I_MOD) {
            const int kp = r & 7, jb = (r >> 3) % 96, l = r / (8 * 96), j = jb * 64 + X.lane;
            const float* w = p.in[2] + (size_t)l * 1024 * 6144 + (size_t)(kp * 128) * 6144 + j;
            const float* c = p.in[1] + kp * 128;
            float a0 = 0.f, a1 = 0.f, a2 = 0.f, a3 = 0.f;
#pragma unroll 8
            for (int i = 0; i < 128; ++i) { const float wv = w[(size_t)i * 6144];
                a0 += siluf(c[i]) * wv; a1 += siluf(c[1024 + i]) * wv; a2 += siluf(c[2048 + i]) * wv; a3 += siluf(c[3072 + i]) * wv; }
            if (kp == 0) { const float bb = p.in[3][l * 6144 + j]; a0 += bb; a1 += bb; a2 += bb; a3 += bb; }
            unsigned long long* mq = (unsigned long long*)(ws + CTL_MOD) + (size_t)l * 4 * 6144 + j;
            atomicAdd(mq, (unsigned long long)__double2ll_rn((double)a0 * 1099511627776.0)); atomicAdd(mq + 6144, (unsigned long long)__double2ll_rn((double)a1 * 1099511627776.0));
            atomicAdd(mq + 2 * 6144, (unsigned long long)__double2ll_rn((double)a2 * 1099511627776.0)); atomicAdd(mq + 3 * 6144, (unsigned long long)__double2ll_rn((double)a3 * 1099511627776.0));
            continue;
        }
        r -= I_MOD;
        if (r < I_SK) {
            const int m = r >> 4, kb = r & 15, k0 = kb * 64;
            const float* W = m < 2 ? p.in[24] + (size_t)m * D * NE : p.in[16] + 5120; const int ldw = m < 2 ? NE : SSM_IN;
#pragma unroll 8
            for (int i = 0; i < 32; ++i) { const int kk = 2 * i + (X.lane >> 5); scr[kk * 33 + (X.lane & 31)] = W[(size_t)(k0 + kk) * ldw + (X.lane & 31)]; }
            LDS_WAIT(); asm volatile("" ::: "memory");
            const int c = X.lane & 7;
#pragma unroll
            for (int j = 0; j < 4; ++j) { const int n = (X.lane >> 3) + 8 * j; const LAS float* sp = scr + (8 * c) * 33 + n;
                float v[8]; unsigned hi[8];
#pragma unroll
                for (int q = 0; q < 8; ++q) { v[q] = sp[q * 33]; hi[q] = f2bf(v[q]); v[q] -= __uint_as_float(hi[q] << 16); }
                u32x4 oh, ol; oh.x = hi[0] | (hi[1] << 16); oh.y = hi[2] | (hi[3] << 16); oh.z = hi[4] | (hi[5] << 16); oh.w = hi[6] | (hi[7] << 16);
                ol.x = pk2(v[0], v[1]); ol.y = pk2(v[2], v[3]); ol.z = pk2(v[4], v[5]); ol.w = pk2(v[6], v[7]);
                bf16_t* dst = (bf16_t*)(ws + WS_SKW) + (size_t)m * 2 * 32 * 1024 + (size_t)n * 1024 + k0 + 8 * c;
                *(u32x4*)dst = oh; *(u32x4*)(dst + 32 * 1024) = ol; }
            LDS_WAIT(); asm volatile("" ::: "memory");
            continue; }
        r -= I_SK;
        if (r < I_W1) { const int kv = r >> 7, q = r & 127, kb = q >> 2, nb = q & 3;
            transpose_item(kv ? p.in[14] : p.in[12], 128, 2048, 128, kb * 64, nb * 32, (bf16_t*)(ws + WS_W1T) + (size_t)kv * 128 * 2048, nb * 32, scr, X.lane); continue; } r -= I_W1;
        if (r < I_WIN) { const int kb = r / 96, nb = r % 96; transpose_item(p.in[6], ATTN_IN, 1024, ATTN_IN, kb * 64, nb * 32, (bf16_t*)(ws + WS_WIN), nb * 32, scr, X.lane); continue; } r -= I_WIN;
        if (r < I_WV) { const int kb = r / 24, nb = r % 24, r0 = nb * 32, src = r0 < 512 ? OFF_SBV + r0 : (r0 < 640 ? OFF_VS + (r0 - 512) : OFF_VW + (r0 - 640));
            transpose_item(p.in[6], ATTN_IN, 1024, ATTN_IN, kb * 64, src, (bf16_t*)(ws + WS_WV), r0, scr, X.lane); continue; } r -= I_WV;
        if (r < I_WOUT) { const int kb = r / 32, nb = r % 32; transpose_item(p.in[7], 1024, 1024, 1024, kb * 64, nb * 32, (bf16_t*)(ws + WS_WOUT), nb * 32, scr, X.lane); continue; } r -= I_WOUT;
        if (r < I_WSIN) { const int kb = r / 160, nb = r % 160, n0 = nb * 32, row0 = n0 < 2048 ? n0 : (n0 < 4096 ? n0 + 1024 : n0 - 2048);
            transpose_item(p.in[16], SSM_IN, 1024, SSM_IN, kb * 64, n0, (bf16_t*)(ws + WS_WSIN), row0, scr, X.lane); continue; } r -= I_WSIN;
        { const int kb = r / 32, nb = r % 32; transpose_item(p.in[23], 1024, 2048, 1024, kb * 64, nb * 32, (bf16_t*)(ws + WS_WSOUT), nb * 32, scr, X.lane); }
    }
}

struct Row { f32x4 v[4]; };
__device__ __forceinline__ void row_load(Row& r, const float* p, int lane) {
#pragma unroll
    for (int j = 0; j < 4; ++j) r.v[j] = ((const f32x4*)p)[64 * j + lane];
}
__device__ __forceinline__ void row_load_bf16(Row& r, const bf16_t* p, int lane) {
#pragma unroll
    for (int j = 0; j < 4; ++j) { const u32x2 q = ((const u32x2*)p)[64 * j + lane]; r.v[j] = (f32x4){bflo(q.x), bfhi(q.x), bflo(q.y), bfhi(q.y)}; }
}
__device__ __forceinline__ void row_store(const Row& r, float* p, int lane) {
#pragma unroll
    for (int j = 0; j < 4; ++j) ((f32x4*)p)[64 * j + lane] = r.v[j];
}
template <class PV>
__device__ __forceinline__ void row_norm_mod(const Row& r, Row& o, const float* gain, PV sc, PV sh, int lane) {
    float ss = 0.f;
#pragma unroll
    for (int j = 0; j < 4; ++j) ss += (r.v[j].x * r.v[j].x + r.v[j].y * r.v[j].y) + (r.v[j].z * r.v[j].z + r.v[j].w * r.v[j].w);
    const float rs = rsqrtf(wave_sum(ss) * (1.f / 1024.f) + EPS);
#pragma unroll
    for (int j = 0; j < 4; ++j) { const f32x4 g = ((const f32x4*)gain)[64 * j + lane], a = sc[64 * j + lane], b = sh[64 * j + lane];
        o.v[j] = r.v[j] * rs * g * (a + 1.f) + b; }
}
__device__ __forceinline__ void row_store_bf16(const Row& r, bf16_t* p, int lane) {
#pragma unroll
    for (int j = 0; j < 4; ++j) { u32x2 w; w.x = pk2(r.v[j].x, r.v[j].y); w.y = pk2(r.v[j].z, r.v[j].w); ((u32x2*)p)[64 * j + lane] = w; }
}
__device__ __forceinline__ void row_store_lds(const Row& r, LAS float* p, int lane) {
#pragma unroll
    for (int j = 0; j < 4; ++j) ((LAS f32x4*)p)[64 * j + lane] = r.v[j];
}
__device__ __forceinline__ float modq2f(long long q) { return (float)((double)q * 9.094947017729282e-13); }
__device__ __forceinline__ void ph_norm0(const Params& p, const Ctx& X) {
    const long long* mq = (const long long*)(X.ws + CTL_MOD);
    float* modf = (float*)(X.ws + WS_MODF);
    for (int i = X.bid * NTHREADS + X.tid; i < 2 * 4 * 6144; i += X.G * NTHREADS) modf[i] = modq2f(mq[i]);
    LAS float* tab = (LAS float*)X.lds;
    for (int i = X.tid; i < 4 * 2048; i += NTHREADS) tab[i] = modq2f(mq[(size_t)(i >> 11) * 6144 + (i & 2047)]);
    __syncthreads();
    for (int t = X.gw; t < T; t += X.ngw) {
        Row r, o; row_load(r, p.in[0] + (size_t)t * D, X.lane);
        const LAS float* m = tab + (t / S) * 2048;
        row_norm_mod(r, o, p.in[4], (const LAS f32x4*)(m + 1024), (const LAS f32x4*)m, X.lane);
        row_store_bf16(o, (bf16_t*)(X.ws + WS_U) + (size_t)t * D, X.lane);
    }
}
__device__ __forceinline__ void route_select(float logit, int lane, LAS unsigned* lcnt, int& ev, float& wv, int& lpos) {
    const int e = lane & 31;
    float tl[4]; int te[4];
#pragma unroll
    for (int k = 0; k < 4; ++k) {
        float bv = logit; int bi = e;
#pragma unroll
        for (int o = 16; o > 0; o >>= 1) { const float ov = __shfl_xor(bv, o); const int oi = __shfl_xor(bi, o); if (ov > bv || (ov == bv && oi < bi)) { bv = ov; bi = oi; } }
        tl[k] = bv; te[k] = bi;
        if (e == bi) logit = -INFINITY;
    }
    ev = 0; wv = 0.f; lpos = 0;
    if (e < 4) {
        const float e1 = expf(tl[1] - tl[0]), e2 = expf(tl[2] - tl[0]), e3 = expf(tl[3] - tl[0]);
        const float inv = 1.f / (1.f + e1 + e2 + e3);
        wv = (e == 0 ? 1.f : e == 1 ? e1 : e == 2 ? e2 : e3) * inv;
        ev = e == 0 ? te[0] : e == 1 ? te[1] : e == 2 ? te[2] : te[3];
        lpos = (int)__hip_atomic_fetch_add(&lcnt[ev], 1u, __ATOMIC_RELAXED, __HIP_MEMORY_SCOPE_WORKGROUP);
    }
}
__device__ __forceinline__ void moe_table(const Ctx& X, int l) {
    LAS int* tb = (LAS int*)(X.lds + TAB_OFF);
    if (X.wave == 0) {
        const unsigned* cnt = (const unsigned*)(X.ws + WS_CTL) + CW_CNT + l * 32 * 32;
        const int e = X.lane & 31;
        const int c = (int)__hip_atomic_load(cnt + e * 32, __ATOMIC_RELAXED, __HIP_MEMORY_SCOPE_AGENT), nt = (c + 255) >> 8;
        int incl = nt;
#pragma unroll
        for (int o = 1; o < 32; o <<= 1) { const int u = __shfl_up(incl, o); if (e >= o) incl += u; }
        if (X.lane < 32) { tb[e] = incl - nt; tb[40 + e] = c; if (e == 31) tb[NE] = incl; }
    }
    __syncthreads();
}
template <int MODE>
__device__ __forceinline__ void ph_token(const Params& p, const Ctx& X, int l, const bf16_t* h, void* hn) {
    if (MODE != 0) moe_table(X, l);
    const LAS int* tb = (const LAS int*)(X.lds + TAB_OFF);
    const float* modl = (const float*)(X.ws + WS_MODF) + (size_t)l * 4 * 6144;
    const float* modn = (const float*)(X.ws + WS_MODF) + (size_t)(MODE == 1 ? 1 : l) * 4 * 6144;
    const float* gain = MODE == 1 ? p.in[4] + D : p.in[5] + l * D;
    const int sc_off = MODE == 1 ? 1024 : 4096, sh_off = MODE == 1 ? 0 : 3072;
    const bf16_t* y = (const bf16_t*)(X.ws + WS_Y);
    LAS float* rsl = (LAS float*)X.lds;
    LAS float* part = (LAS float*)(X.lds + 1024);
    if (MODE == 0 && X.tid < 32) ((LAS unsigned*)(X.lds + 1024 + 65536))[X.tid] = 0u;
    for (int tile = X.bid; tile < T / 64; tile += X.G) {
        const int lane = fresh(X.lane), w = X.wave, tb0 = tile * 64, bb = tb0 / S;
        SUB_BEGIN(X, 31);
        Row ca_, cb_, cg_;
        { const float* m = modn + (size_t)bb * 6144;
#pragma unroll
          for (int j = 0; j < 4; ++j) { if (MODE != 2) { const f32x4 g = ((const f32x4*)gain)[64 * j + lane], a = ((const f32x4*)(m + sc_off))[64 * j + lane]; ca_.v[j] = g * (a + 1.f); cb_.v[j] = ((const f32x4*)(m + sh_off))[64 * j + lane]; }
                                        if (MODE != 0) cg_.v[j] = ((const f32x4*)(modl + (size_t)bb * 6144 + 5120))[64 * j + lane]; } }
        int pe_ = 0, pp_ = 0; float pw_ = 0.f;
        if (MODE != 0 && lane < 32) { const int idx = (tb0 + 8 * w) * 4 + lane; pe_ = ((const int*)(X.ws + WS_TOKE))[idx]; pp_ = ((const int*)(X.ws + WS_TOKP))[idx]; pw_ = ((const float*)(X.ws + WS_TOKW))[idx]; }
#pragma unroll 1
        for (int k2 = 0; k2 < 4; ++k2) {
            Row r[2];
#pragma unroll
            for (int u = 0; u < 2; ++u) row_load_bf16(r[u], h + (size_t)(tb0 + 8 * w + 2 * k2 + u) * D, lane);
            if (MODE != 0) {
#pragma unroll
                for (int u = 0; u < 2; ++u) {
#pragma unroll
                    for (int kk = 0; kk < 4; ++kk) {
                        const int sl = (2 * k2 + u) * 4 + kk;
                        const int e = __shfl(pe_, sl), pos = __shfl(pp_, sl); const float wt = __shfl(pw_, sl);
                        const bf16_t* yr = y + (size_t)(tb[e] * 256 + pos) * D;
#pragma unroll
                        for (int j = 0; j < 4; ++j) { const u32x2 q = ((const u32x2*)yr)[64 * j + lane]; const f32x4 gw = cg_.v[j] * wt;
                            r[u].v[j].x += gw.x * bflo(q.x); r[u].v[j].y += gw.y * bfhi(q.x); r[u].v[j].z += gw.z * bflo(q.y); r[u].v[j].w += gw.w * bfhi(q.y); }
                    }
                    if (MODE == 2) row_store(r[u], (float*)hn + (size_t)(tb0 + 8 * w + 2 * k2 + u) * D, lane); else row_store_bf16(r[u], (bf16_t*)hn + (size_t)(tb0 + 8 * w + 2 * k2 + u) * D, lane);
                    __builtin_amdgcn_sched_barrier(0);
                }
            }
            if (MODE != 2) {
#pragma unroll
                for (int u = 0; u < 2; ++u) {
                    float ssq = 0.f;
#pragma unroll
                    for (int j = 0; j < 4; ++j) ssq += (r[u].v[j].x * r[u].v[j].x + r[u].v[j].y * r[u].v[j].y) + (r[u].v[j].z * r[u].v[j].z + r[u].v[j].w * r[u].v[j].w);
                    const float rs = rsqrtf(wave_sum(ssq) * (1.f / 1024.f) + EPS);
                    bf16_t* uh = (bf16_t*)(X.ws + WS_U) + (size_t)(tb0 + 8 * w + 2 * k2 + u) * D;
#pragma unroll
                    for (int j = 0; j < 4; ++j) { const f32x4 o = r[u].v[j] * rs * ca_.v[j] + cb_.v[j];
                        u32x2 hi; hi.x = pk2(o.x, o.y); hi.y = pk2(o.z, o.w); ((u32x2*)uh)[64 * j + lane] = hi; }
                }
            }
        }
        SUB_END(X, 31);
        if (MODE == 2) continue;
        SUB_BEGIN(X, 32);
        __syncthreads();
        {
            const int ql = lane & 31, hf = lane >> 5;
            const bf16_t* wh = (const bf16_t*)(X.ws + WS_SKW) + (size_t)(MODE == 0 ? l : 2) * 2 * 32 * 1024 + (size_t)ql * 1024 + 128 * w + 8 * hf;
            const bf16_t* uh = (const bf16_t*)(X.ws + WS_U) + (size_t)(tb0 + ql) * D + 128 * w + 8 * hf;
            f32x16 acc0, acc1;
#pragma unroll
            for (int i = 0; i < 16; ++i) { acc0[i] = 0.f; acc1[i] = 0.f; }
#pragma unroll
            for (int ks = 0; ks < 8; ++ks) {
                const bf16x8 whi = *(const bf16x8*)(wh + 16 * ks), wlo = *(const bf16x8*)(wh + 32 * 1024 + 16 * ks);
                const bf16x8 ah0 = *(const bf16x8*)(uh + 16 * ks), ah1 = *(const bf16x8*)(uh + 32 * D + 16 * ks);
                acc0 = __builtin_amdgcn_mfma_f32_32x32x16_bf16(ah0, whi, acc0, 0, 0, 0); acc0 = __builtin_amdgcn_mfma_f32_32x32x16_bf16(ah0, wlo, acc0, 0, 0, 0);
                acc1 = __builtin_amdgcn_mfma_f32_32x32x16_bf16(ah1, whi, acc1, 0, 0, 0); acc1 = __builtin_amdgcn_mfma_f32_32x32x16_bf16(ah1, wlo, acc1, 0, 0, 0);
            }
#pragma unroll
            for (int i = 0; i < 16; ++i) { const int row = 8 * (i >> 2) + 4 * hf + (i & 3); part[(w * 64 + row) * 32 + ql] = acc0[i]; part[(w * 64 + 32 + row) * 32 + ql] = acc1[i]; }
        }
        __syncthreads();
        SUB_END(X, 32);
        SUB_BEGIN(X, 33);
        {
            const int e = lane & 31, hf = lane >> 5;
            LAS unsigned* lcnt = (LAS unsigned*)(X.lds + 1024 + 65536);
            int ev[4], lp[4]; float wv[4];
#pragma unroll
            for (int k = 0; k < 4; ++k) {
                const int tl = 8 * w + 4 * hf + k;
                float v = 0.f;
#pragma unroll
                for (int ww = 0; ww < 8; ++ww) v += part[(ww * 64 + tl) * 32 + e];
                if (MODE == 0) route_select(v + p.in[25][l * NE + e], lane, lcnt, ev[k], wv[k], lp[k]);
                else ((float*)(X.ws + WS_DT))[(size_t)(tb0 + tl) * 32 + e] = v;
            }
            if (MODE == 0) {
                __syncthreads();
                if (X.tid < 32) { const unsigned n = lcnt[X.tid]; unsigned* cnt = (unsigned*)(X.ws + WS_CTL) + CW_CNT + (l * 32 + X.tid) * 32;
                    lcnt[32 + X.tid] = n ? atomicAdd(cnt, n) : 0u; }
                __syncthreads();
                if (e < 4) {
#pragma unroll
                    for (int k = 0; k < 4; ++k) { const int t = tb0 + 8 * w + 4 * hf + k, pos = (int)lcnt[32 + ev[k]] + lp[k];
                        ((int*)(X.ws + WS_TOKE))[t * 4 + e] = ev[k]; ((float*)(X.ws + WS_TOKW))[t * 4 + e] = wv[k]; ((int*)(X.ws + WS_TOKP))[t * 4 + e] = pos;
                        ((int*)(X.ws + WS_SLOT))[ev[k] * CAP + pos] = t; }
                }
            }
        }
        __syncthreads();
        SUB_END(X, 33);
        if (MODE == 0 && X.tid < 32) ((LAS unsigned*)(X.lds + 1024 + 65536))[X.tid] = 0u;
    }
}

__device__ __forceinline__ void ld64bf(const bf16_t* p, float (&q)[64]) {
#pragma unroll
    for (int i = 0; i < 8; ++i) { const u32x4 w = ((const u32x4*)p)[i];
        q[8 * i] = bflo(w.x); q[8 * i + 1] = bfhi(w.x); q[8 * i + 2] = bflo(w.y); q[8 * i + 3] = bfhi(w.y); q[8 * i + 4] = bflo(w.z); q[8 * i + 5] = bfhi(w.z); q[8 * i + 6] = bflo(w.w); q[8 * i + 7] = bfhi(w.w); }
}
__device__ __forceinline__ float dot64bf(const bf16_t* p, const float (&q)[64]) {
    float d = 0.f;
#pragma unroll
    for (int i = 0; i < 8; ++i) { const u32x4 w = ((const u32x4*)p)[i];
        d += q[8 * i] * bflo(w.x) + q[8 * i + 1] * bfhi(w.x) + q[8 * i + 2] * bflo(w.y) + q[8 * i + 3] * bfhi(w.y) + q[8 * i + 4] * bflo(w.z) + q[8 * i + 5] * bfhi(w.z) + q[8 * i + 6] * bflo(w.w) + q[8 * i + 7] * bfhi(w.w); }
    return d;
}
__device__ __forceinline__ float dot64f(const float* p, const float (&q)[64]) {
    float d = 0.f;
#pragma unroll
    for (int i = 0; i < 16; ++i) { const f32x4 w = ((const f32x4*)p)[i]; d += (q[4 * i] * w.x + q[4 * i + 1] * w.y) + (q[4 * i + 2] * w.z + q[4 * i + 3] * w.w); }
    return d;
}
__device__ __forceinline__ void sb_unit(const Ctx& X, int qt, int bh) {
    const int b = bh >> 3, hh = bh & 7, t = qt * 64 + X.lane;
    const bf16_t* base = (const bf16_t*)(X.ws + WS_BIG) + (size_t)b * S * PROJ_LD;
    float q[64], acc[64];
    ld64bf(base + (size_t)t * PROJ_LD + OFF_SBQ + hh * 64, q);
#pragma unroll
    for (int d = 0; d < 64; ++d) acc[d] = 0.f;
    float run = 0.f;
    for (int j = qt * 64 + 62; j >= 0; --j) {
        const bf16_t* kr = base + (size_t)j * PROJ_LD + OFF_SBK + hh * 64;
        const float logit = dot64bf(kr, q) * 0.125f;
        if (j < t) {
            const float w = expf(logsig(logit) + run);
            run += logsig(-logit);
            const bf16_t* vr = base + (size_t)j * PROJ_LD + OFF_SBV + hh * 64;
#pragma unroll
            for (int i = 0; i < 8; ++i) { const u32x4 v = ((const u32x4*)vr)[i];
                acc[8 * i] += w * bflo(v.x); acc[8 * i + 1] += w * bfhi(v.x); acc[8 * i + 2] += w * bflo(v.y); acc[8 * i + 3] += w * bfhi(v.y);
                acc[8 * i + 4] += w * bflo(v.z); acc[8 * i + 5] += w * bfhi(v.z); acc[8 * i + 6] += w * bflo(v.w); acc[8 * i + 7] += w * bfhi(v.w); }
        }
    }
    bf16_t* op = (bf16_t*)(X.ws + WS_O) + (size_t)(b * S + t) * D + hh * 64;
#pragma unroll
    for (int i = 0; i < 8; ++i) { u32x4 w; w.x = pk2(acc[8 * i], acc[8 * i + 1]); w.y = pk2(acc[8 * i + 2], acc[8 * i + 3]); w.z = pk2(acc[8 * i + 4], acc[8 * i + 5]); w.w = pk2(acc[8 * i + 6], acc[8 * i + 7]);
        ((u32x4*)op)[i] = w; }
}

#define DMA16(gptr, ldsptr) __builtin_amdgcn_global_load_lds((const unsigned*)(gptr), (LAS unsigned*)(ldsptr), 16, 0, 0)
#define RING2_WAIT_BAR(q, nb) do { const int issued_ = (q) + 6 < (nb) ? (q) + 6 : (nb); const int need_ = (q) + 2 < (nb) ? (q) + 2 : (nb); const int fl_ = issued_ - need_; \
        if (fl_ >= 4) asm volatile("s_waitcnt vmcnt(8)\n\ts_barrier" ::: "memory"); else if (fl_ == 3) asm volatile("s_waitcnt vmcnt(6)\n\ts_barrier" ::: "memory"); \
        else if (fl_ == 2) asm volatile("s_waitcnt vmcnt(4)\n\ts_barrier" ::: "memory"); else if (fl_ == 1) asm volatile("s_waitcnt vmcnt(2)\n\ts_barrier" ::: "memory"); \
        else asm volatile("s_waitcnt vmcnt(0)\n\ts_barrier" ::: "memory"); } while (0)
constexpr int CV_NITEMS = 64 * 1024 + 64 * 512;
constexpr int CV_LZ = 4 * 16384;
struct Conv { int it, step; bool pending; bf16_t* dst; };
struct ConvCur { int it, step; };
__device__ __forceinline__ void conv_init(Conv& c, const ConvCur& cur) { c.it = cur.it; c.step = cur.step; c.pending = false; c.dst = nullptr; }
__device__ __forceinline__ void conv_issue(Conv& c, const Params& p, unsigned char* ws, LAS unsigned char* lz, int lane) {
    const int r = c.it;
    if (r >= CV_NITEMS) return;
    c.it += c.step;
    const float* src; int ldw;
    if (r < 65536) { const int m = r >> 10, q = r & 1023, kb = q >> 6, n0 = (q & 63) * 32, row0 = ((n0 & 1023) >> 7) * 256 + (n0 >> 10) * 128 + (n0 & 127);
        src = p.in[26] + (size_t)m * 1024 * 2048 + (size_t)(kb * 64) * 2048 + n0; ldw = 2048; c.dst = (bf16_t*)(ws + WS_WGU) + (size_t)m * 2048 * 1024 + (size_t)row0 * 1024 + kb * 64; }
    else { const int r2 = r - 65536, m = r2 >> 9, q = r2 & 511, kb = q >> 5, n0 = (q & 31) * 32;
        src = p.in[28] + (size_t)m * 1024 * 1024 + (size_t)(kb * 64) * 1024 + n0; ldw = 1024; c.dst = (bf16_t*)(ws + WS_WDN) + (size_t)m * 1024 * 1024 + (size_t)n0 * 1024 + kb * 64; }
    const float* ls = src + (size_t)(lane >> 3) * ldw;
#pragma unroll
    for (int i = 0; i < 8; ++i) DMA16(ls + (size_t)(8 * i) * ldw + 4 * ((lane & 7) ^ i), lz + i * 1024);
    c.pending = true;
}
__device__ __forceinline__ void conv_consume(Conv& c, LAS unsigned char* lz, int lane) {
    if (!c.pending) return;
    const int cc = lane & 7;
#pragma unroll 2
    for (int j = 0; j < 4; ++j) { const int n = (lane >> 3) + 8 * j; const LAS float* sp = (const LAS float*)(lz + (8 * cc) * 128 + (((n >> 2) ^ cc) * 16) + (n & 3) * 4);
        u32x4 o; o.x = pk2(sp[0], sp[32]); o.y = pk2(sp[64], sp[96]); o.z = pk2(sp[128], sp[160]); o.w = pk2(sp[192], sp[224]);
        *(u32x4*)(c.dst + (size_t)n * 1024 + 8 * cc) = o; }
    LDS_WAIT(); asm volatile("" ::: "memory");
    c.pending = false;
}
#define PAIR_WAIT_BAR() asm volatile("s_waitcnt vmcnt(0)\n\ts_barrier" ::: "memory")
__device__ __forceinline__ int pi32(int r) { return (r & 0x13) | ((r & 4) << 1) | ((r & 8) >> 1); }
__device__ __forceinline__ void sb_attn_unit(const Params& p, const Ctx& X, ConvCur& cur, int bh, int qb) {
    Conv cv; conv_init(cv, cur);
    const int b = bh >> 3, h = bh & 7, q0 = qb * 256, lane = fresh(X.lane), w = X.wave, ql = lane & 31, hf = lane >> 5;
    const bf16_t* proj = (const bf16_t*)(X.ws + WS_BIG) + (size_t)b * S * PROJ_LD;
    const bf16_t* vt = (const bf16_t*)(X.ws + WS_VT) + (size_t)(h * 64) * T + (size_t)b * S;
    const int tq = q0 + 32 * w + ql;
    bf16x8 qf[4];
#pragma unroll
    for (int s = 0; s < 4; ++s) qf[s] = *(const bf16x8*)(proj + (size_t)tq * PROJ_LD + OFF_SBQ + h * 64 + 16 * s + 8 * hf);
    f32x16 o0, o1;
#pragma unroll
    for (int i = 0; i < 16; ++i) { o0[i] = 0.f; o1[i] = 0.f; }
    float run = 1.f;
    const int nblk = 4 * qb + 4, jw = (q0 + 32 * w + 30) >> 6;
    const float CS = 0.125f * 1.4426950408889634f;
    const bf16_t* kg = proj + (size_t)lane * PROJ_LD + OFF_SBK + h * 64 + 8 * w;
    const bf16_t* vg = vt + (size_t)lane * T + 8 * w;
    LAS unsigned char* ring = X.lds + w * 1024;
    const int krow = pi32(ql) * 16;
    asm volatile("s_waitcnt vmcnt(0)" ::: "memory");
    LAS unsigned char* lz = X.lds + CV_LZ + w * 8192;
#pragma unroll
    for (int d = 0; d < 2; ++d) { DMA16(kg + (size_t)(64 * (nblk - 1 - d)) * PROJ_LD, ring + d * 16384); DMA16(vg + 64 * (nblk - 1 - d), ring + d * 16384 + 8192); }
    for (int q = 0; q < nblk; ++q) {
        const int j = nblk - 1 - q;
        if ((q & 1) == 0) {
            SUB_BEGIN(X, 11);
            PAIR_WAIT_BAR();
            SUB_END(X, 11);
#pragma unroll
            for (int d = 2; d < 4; ++d) if (q + d < nblk) { const int jj = nblk - 1 - (q + d), sl = (q + d) & 3; DMA16(kg + (size_t)(64 * jj) * PROJ_LD, ring + sl * 16384); DMA16(vg + 64 * jj, ring + sl * 16384 + 8192); }
            conv_consume(cv, lz, lane);
            if (q + 2 < nblk) conv_issue(cv, p, X.ws, lz, lane);
        }
        LAS unsigned char* buf = X.lds + (q & 3) * 16384;
        SUB_BEGIN(X, 12);
        if (j <= jw) {
            const bool diag = 64 * j + 63 >= q0 + 32 * w;
#pragma unroll
            for (int kt = 1; kt >= 0; --kt) {
                f32x16 sc;
#pragma unroll
                for (int i = 0; i < 16; ++i) sc[i] = 0.f;
#pragma unroll
                for (int s = 0; s < 4; ++s) { const bf16x8 kf = *(const LAS bf16x8*)(buf + (2 * s + hf) * 1024 + kt * 512 + krow); sc = __builtin_amdgcn_mfma_f32_32x32x16_bf16(kf, qf[s], sc, 0, 0, 0); }
                f32x16 ee = sc * (-CS), be, kp;
#pragma unroll
                for (int i = 0; i < 16; ++i) ee[i] = __builtin_amdgcn_exp2f(ee[i]);
                be = ee + 1.f;
#pragma unroll
                for (int i = 0; i < 16; ++i) be[i] = __builtin_amdgcn_rcpf(be[i]);
                kp = 1.f - be;
                if (diag) {
                    asm volatile("; diagonal block: masks" ::: "memory");
                    const int pos0 = 64 * j + 32 * kt + 8 * hf;
#pragma unroll
                    for (int i = 0; i < 16; ++i) { const bool valid = (pos0 + 16 * (i >> 3) + (i & 7)) < tq; be[i] = valid ? be[i] : 0.f; kp[i] = valid ? kp[i] : 1.f; }
                }
                float l1 = 1.f, l0 = 1.f;
#pragma unroll
                for (int i = 15; i >= 8; --i) { const float t = be[i] * l1; l1 *= kp[i]; be[i] = t; }
#pragma unroll
                for (int i = 7; i >= 0; --i) { const float t = be[i] * l0; l0 *= kp[i]; be[i] = t; }
                const float p1 = __shfl_xor(l1, 32), p0 = __shfl_xor(l0, 32);
                const float hi1 = hf ? l1 : p1, lo1 = hf ? p1 : l1, hi0 = hf ? l0 : p0, lo0 = hf ? p0 : l0;
                const float r1 = run * hi1, r2 = r1 * lo1, r3 = r2 * hi0;
                const float pre_up = hf ? run : r1, pre_lo = hf ? r2 : r3;
                run = r3 * lo0;
#pragma unroll
                for (int a = 0; a < 2; ++a) {
                    const float pre = a ? pre_up : pre_lo;
                    u32x4 pw; pw.x = pk2(be[8 * a] * pre, be[8 * a + 1] * pre); pw.y = pk2(be[8 * a + 2] * pre, be[8 * a + 3] * pre); pw.z = pk2(be[8 * a + 4] * pre, be[8 * a + 5] * pre); pw.w = pk2(be[8 * a + 6] * pre, be[8 * a + 7] * pre);
                    const bf16x8 pf = __builtin_bit_cast(bf16x8, pw);
                    const bf16x8 v0 = *(const LAS bf16x8*)(buf + 8192 + (4 * kt + 2 * a + hf) * 1024 + ql * 16);
                    const bf16x8 v1 = *(const LAS bf16x8*)(buf + 8192 + (4 * kt + 2 * a + hf) * 1024 + 512 + ql * 16);
                    o0 = __builtin_amdgcn_mfma_f32_32x32x16_bf16(v0, pf, o0, 0, 0, 0);
                    o1 = __builtin_amdgcn_mfma_f32_32x32x16_bf16(v1, pf, o1, 0, 0, 0);
                }
            }
        }
        SUB_END(X, 12);
    }
    asm volatile("s_barrier" ::: "memory");
    cur.it = cv.it;
    bf16_t* op = (bf16_t*)(X.ws + WS_O) + (size_t)(b * S + fresh(tq)) * D + h * 64 + 4 * hf;
#pragma unroll
    for (int g4 = 0; g4 < 4; ++g4) {
        u32x2 w0; w0.x = pk2(o0[4 * g4], o0[4 * g4 + 1]); w0.y = pk2(o0[4 * g4 + 2], o0[4 * g4 + 3]); *(u32x2*)(op + 8 * g4) = w0;
        u32x2 w1; w1.x = pk2(o1[4 * g4], o1[4 * g4 + 1]); w1.y = pk2(o1[4 * g4 + 2], o1[4 * g4 + 3]); *(u32x2*)(op + 32 + 8 * g4) = w1;
    }
}
__device__ __forceinline__ void ph_sb(const Params& p, const Ctx& X, ConvCur& cur) {
    for (int pr = X.bid; pr < 256; pr += X.G)
#pragma unroll 1
        for (int u = 0; u < 2; ++u) { const int bh = pr >> 3, qa = pr & 7; sb_attn_unit(p, X, cur, bh, u ? qa : 15 - qa); }
    {
        LAS unsigned char* lz = X.lds + CV_LZ + X.wave * 8192;
        Conv cv; conv_init(cv, cur);
#pragma unroll 1
        while (cv.it < CV_NITEMS) { conv_issue(cv, p, X.ws, lz, X.lane); asm volatile("s_waitcnt vmcnt(0)" ::: "memory"); conv_consume(cv, lz, X.lane); }
        cur.it = cv.it;
    }
}
__device__ __forceinline__ void ph_attn_a(const Params& p, const Ctx& X) {
    const bf16_t* proj = (const bf16_t*)(X.ws + WS_BIG);
    for (int unit = X.bid; unit < 128; unit += X.G) {
        const int kv = unit >> 6, bg = (unit >> 3) & 7, ntile = unit & 7, b = bg >> 1, g = bg & 1, lane = fresh(X.lane), w = X.wave, ql = lane & 31, hf = lane >> 5;
        const int n = min(32 * ntile + ql, NCMP - 1);
        const float* pe = kv ? p.in[11] : p.in[10];
        const bf16_t* w1t = (const bf16_t*)(X.ws + WS_W1T) + (size_t)kv * 128 * 2048;
        const bf16_t* arow = proj + (size_t)(b * S + n * 16) * PROJ_LD + (kv ? OFF_VC : OFF_KC) + g * 64;
        f32x16 acc[4];
#pragma unroll
        for (int ct = 0; ct < 4; ++ct)
#pragma unroll
            for (int i = 0; i < 16; ++i) acc[ct][i] = 0.f;
        for (int ks = 0; ks < 16; ++ks) {
            const int k0 = 256 * w + 16 * ks + 8 * hf, l = k0 >> 6, d = k0 & 63;
            const u32x4 q = *(const u32x4*)(arow + (size_t)l * PROJ_LD + d);
            const f32x4 e0 = *(const f32x4*)(pe + k0), e1 = *(const f32x4*)(pe + k0 + 4);
            u32x4 o; o.x = pk2(bflo(q.x) + e0.x, bfhi(q.x) + e0.y); o.y = pk2(bflo(q.y) + e0.z, bfhi(q.y) + e0.w); o.z = pk2(bflo(q.z) + e1.x, bfhi(q.z) + e1.y); o.w = pk2(bflo(q.w) + e1.z, bfhi(q.w) + e1.w);
            const bf16x8 af = __builtin_bit_cast(bf16x8, o);
#pragma unroll
            for (int ct = 0; ct < 4; ++ct) acc[ct] = __builtin_amdgcn_mfma_f32_32x32x16_bf16(af, *(const bf16x8*)(w1t + (size_t)(32 * ct + ql) * 2048 + k0), acc[ct], 0, 0, 0);
        }
        LAS float* part = (LAS float*)X.lds;
#pragma unroll
        for (int ct = 0; ct < 4; ++ct)
#pragma unroll
            for (int i = 0; i < 16; ++i) part[w * 4096 + (8 * (i >> 2) + 4 * hf + (i & 3)) * 128 + 32 * ct + ql] = acc[ct][i];
        __syncthreads();
        LAS float* hid = part;
        {
            const int tidf = fresh(X.tid);
#pragma unroll
            for (int k = 0; k < 8; ++k) { const int e = tidf + NTHREADS * k; float v = 0.f;
#pragma unroll
                for (int ww = 0; ww < 8; ++ww) v += part[ww * 4096 + e];
                hid[e] = siluf(v); }
        }
        __syncthreads();
        {
            const int tidf = fresh(X.tid), row = tidf >> 4, c4 = (tidf & 15) * 4;
            const float* w2 = kv ? p.in[15] : p.in[13];
            f32x4 o = (f32x4){0.f, 0.f, 0.f, 0.f};
            for (int j = 0; j < 128; ++j) o = o + *(const f32x4*)(w2 + j * 64 + c4) * hid[row * 128 + j];
            const int nn = 32 * ntile + row;
            if (kv == 0) {
                float ssq = (o.x * o.x + o.y * o.y) + (o.z * o.z + o.w * o.w);
                ssq += __shfl_xor(ssq, 1); ssq += __shfl_xor(ssq, 2); ssq += __shfl_xor(ssq, 4); ssq += __shfl_xor(ssq, 8);
                const float r = rsqrtf(ssq * (1.f / 64.f) + EPS); const f32x4 gn = *(const f32x4*)(p.in[9] + c4);
                o = o * r * gn;
                if (nn >= NCMP) o = (f32x4){0.f, 0.f, 0.f, 0.f};
                u32x2 wv; wv.x = pk2(o.x, o.y); wv.y = pk2(o.z, o.w);
                *(u32x2*)((bf16_t*)(X.ws + WS_KCB) + ((size_t)bg * 256 + nn) * 64 + c4) = wv;
            } else {
                if (nn >= NCMP) o = (f32x4){0.f, 0.f, 0.f, 0.f};
                bf16_t* vt = (bf16_t*)(X.ws + WS_VCT) + ((size_t)bg * 64 + c4) * 256 + nn;
                vt[0] = (bf16_t)f2bf(o.x); vt[256] = (bf16_t)f2bf(o.y); vt[512] = (bf16_t)f2bf(o.z); vt[768] = (bf16_t)f2bf(o.w);
            }
        }
        __syncthreads();
    }
    for (int t2 = X.gw; t2 < T / 2; t2 += X.ngw) {
        const int lane = fresh(X.lane), sub = lane & 7;
#pragma unroll
        for (int k = 0; k < 2; ++k) {
            const int t = 2 * t2 + k;
            const u32x4 q = *(const u32x4*)(proj + (size_t)t * PROJ_LD + OFF_NQ + 8 * lane);
            float v[8] = {bflo(q.x), bfhi(q.x), bflo(q.y), bfhi(q.y), bflo(q.z), bfhi(q.z), bflo(q.w), bfhi(q.w)};
            float ssq = 0.f;
#pragma unroll
            for (int i = 0; i < 8; ++i) ssq += v[i] * v[i];
            ssq += __shfl_xor(ssq, 1); ssq += __shfl_xor(ssq, 2); ssq += __shfl_xor(ssq, 4);
            const float r = rsqrtf(ssq * (1.f / 64.f) + EPS) * (0.125f * 1.4426950408889634f);
            const f32x4 g0 = *(const f32x4*)(p.in[8] + 8 * sub), g1 = *(const f32x4*)(p.in[8] + 8 * sub + 4);
            u32x4 o; o.x = pk2(v[0] * r * g0.x, v[1] * r * g0.y); o.y = pk2(v[2] * r * g0.z, v[3] * r * g0.w); o.z = pk2(v[4] * r * g1.x, v[5] * r * g1.y); o.w = pk2(v[6] * r * g1.z, v[7] * r * g1.w);
            *(u32x4*)((bf16_t*)(X.ws + WS_QNB) + (size_t)t * 512 + 8 * lane) = o;
        }
        {
            const int t = 2 * t2 + (lane >> 5), l32 = lane & 31, isw = l32 >> 4, c = 8 * (l32 & 15);
            const u32x4 q = *(const u32x4*)(proj + (size_t)t * PROJ_LD + (isw ? OFF_KW : OFF_KS) + c);
            float v[8] = {bflo(q.x), bfhi(q.x), bflo(q.y), bfhi(q.y), bflo(q.z), bfhi(q.z), bflo(q.w), bfhi(q.w)};
            float ssq = 0.f;
#pragma unroll
            for (int i = 0; i < 8; ++i) ssq += v[i] * v[i];
            ssq += __shfl_xor(ssq, 1); ssq += __shfl_xor(ssq, 2); ssq += __shfl_xor(ssq, 4);
            const float r = rsqrtf(ssq * (1.f / 64.f) + EPS);
            const float* gn = p.in[9] + (isw ? 128 : 64) + 8 * sub;
            const f32x4 g0 = *(const f32x4*)gn, g1 = *(const f32x4*)(gn + 4);
            u32x4 o; o.x = pk2(v[0] * r * g0.x, v[1] * r * g0.y); o.y = pk2(v[2] * r * g0.z, v[3] * r * g0.w); o.z = pk2(v[4] * r * g1.x, v[5] * r * g1.y); o.w = pk2(v[6] * r * g1.z, v[7] * r * g1.w);
            *(u32x4*)((bf16_t*)(X.ws + (isw ? WS_KWN : WS_KSN)) + (size_t)t * 128 + c) = o;
        }
    }
}
struct NsaSt { f32x16 o0, o1; float m, l; };
template <int MODE>
__device__ __forceinline__ void nsa_flash(const Ctx& X, const unsigned char* kbase, unsigned koff, const unsigned char* vbase, unsigned voff, int jlo, int jhi, const bf16x8 (&qf)[4], int tq, float slope2,
                                          unsigned long long mymask, unsigned long long wavemask, NsaSt& st, float cbound, const Params& p, ConvCur& cur) {
    Conv cv; conv_init(cv, cur);
    const int lane = fresh(X.lane), w = X.wave, ql = lane & 31, hf = lane >> 5;
    LAS unsigned char* ring = X.lds + w * 1024;
    const int krow = pi32(ql) * 16, nb = jhi - jlo + 1;
    asm volatile("s_waitcnt vmcnt(0)" ::: "memory");
    LAS unsigned char* lz = X.lds + CV_LZ + w * 8192;
#pragma unroll
    for (int d = 0; d < 2; ++d) if (d < nb) { DMA16(kbase + (koff + (unsigned)(jhi - d) * 16384u), ring + d * 16384); DMA16(vbase + (voff + (unsigned)(jhi - d) * 128u), ring + d * 16384 + 8192); }
    const float k32 = slope2 * 32.f;
    for (int q = 0; q < nb; ++q) {
        const int j = jhi - q;
        if ((q & 1) == 0) {
            SUB_BEGIN(X, 21);
            PAIR_WAIT_BAR();
            SUB_END(X, 21);
#pragma unroll
            for (int d = 2; d < 4; ++d) if (q + d < nb) { const int jj = jhi - (q + d), sl2 = (q + d) & 3; DMA16(kbase + (koff + (unsigned)jj * 16384u), ring + sl2 * 16384); DMA16(vbase + (voff + (unsigned)jj * 128u), ring + sl2 * 16384 + 8192); }
            conv_consume(cv, lz, lane);
            if (q + 2 < nb) conv_issue(cv, p, X.ws, lz, lane);
        }
        LAS unsigned char* buf = X.lds + (q & 3) * 16384;
        SUB_BEGIN(X, 22);
        if (MODE == 1 || ((wavemask >> j) & 1ull)) {
            f32x16 s0, s1;
#pragma unroll
            for (int i = 0; i < 16; ++i) { s0[i] = 0.f; s1[i] = 0.f; }
#pragma unroll
            for (int s = 0; s < 4; ++s) {
                const bf16x8 k0 = *(const LAS bf16x8*)(buf + (2 * s + hf) * 1024 + krow), k1 = *(const LAS bf16x8*)(buf + (2 * s + hf) * 1024 + 512 + krow);
                s0 = __builtin_amdgcn_mfma_f32_32x32x16_bf16(k0, qf[s], s0, 0, 0, 0); s1 = __builtin_amdgcn_mfma_f32_32x32x16_bf16(k1, qf[s], s1, 0, 0, 0);
            }
            const int d0 = tq - (64 * j + 8 * hf);
            if (j == jhi || (MODE == 1 && j == jlo)) {
                asm volatile("; boundary block: masks" ::: "memory");
#pragma unroll
                for (int i = 0; i < 16; ++i) {
                    const int da = d0 - (16 * (i >> 3) + (i & 7)), db = da - 32;
                    s0[i] = (da >= 0 && (MODE == 0 || da < 512)) ? s0[i] : -INFINITY; s1[i] = (db >= 0 && (MODE == 0 || db < 512)) ? s1[i] : -INFINITY;
                }
            }
#pragma unroll
            for (int i = 0; i < 16; ++i) { const float kof = (float)(16 * (i >> 3) + (i & 7)); s0[i] = fmaf(slope2, kof, s0[i]); s1[i] = fmaf(slope2, kof, s1[i]); }
            const float base = slope2 * (float)d0;
            const bool sel = MODE == 1 || ((mymask >> j) & 1ull);
            const float off0 = sel ? cbound + base : INFINITY, off1 = off0 - k32;
            s0 = s0 - off0; s1 = s1 - off1;
            float ls = 0.f;
#pragma unroll
            for (int i = 0; i < 16; ++i) { s0[i] = __builtin_amdgcn_exp2f(s0[i]); s1[i] = __builtin_amdgcn_exp2f(s1[i]); ls += s0[i] + s1[i]; }
            st.l += ls;
#pragma unroll
            for (int kt = 0; kt < 2; ++kt)
#pragma unroll
                for (int a = 0; a < 2; ++a) {
                    u32x4 pw;
                    if (kt == 0) { pw.x = pk2(s0[8 * a], s0[8 * a + 1]); pw.y = pk2(s0[8 * a + 2], s0[8 * a + 3]); pw.z = pk2(s0[8 * a + 4], s0[8 * a + 5]); pw.w = pk2(s0[8 * a + 6], s0[8 * a + 7]); }
                    else { pw.x = pk2(s1[8 * a], s1[8 * a + 1]); pw.y = pk2(s1[8 * a + 2], s1[8 * a + 3]); pw.z = pk2(s1[8 * a + 4], s1[8 * a + 5]); pw.w = pk2(s1[8 * a + 6], s1[8 * a + 7]); }
                    const bf16x8 pf = __builtin_bit_cast(bf16x8, pw);
                    const bf16x8 v0 = *(const LAS bf16x8*)(buf + 8192 + (4 * kt + 2 * a + hf) * 1024 + ql * 16);
                    const bf16x8 v1 = *(const LAS bf16x8*)(buf + 8192 + (4 * kt + 2 * a + hf) * 1024 + 512 + ql * 16);
                    st.o0 = __builtin_amdgcn_mfma_f32_32x32x16_bf16(v0, pf, st.o0, 0, 0, 0);
                    st.o1 = __builtin_amdgcn_mfma_f32_32x32x16_bf16(v1, pf, st.o1, 0, 0, 0);
                }
        }
        SUB_END(X, 22);
    }
    asm volatile("s_barrier" ::: "memory");
    cur.it = cv.it;
}
__device__ __forceinline__ void nsa_unit(const Params& p, const Ctx& X, ConvCur& cur, int bg, int qb) {
    const int b = bg >> 1, g = bg & 1, lane = fresh(X.lane), w = X.wave, ql = lane & 31, hf = lane >> 5, r = ql >> 3, hh = g * 4 + r;
    const int t0 = 64 * qb, tq = t0 + 8 * w + (ql & 7);
    const float slope2 = exp2f(-(float)(hh + 1)) * 1.4426950408889634f;
    const bf16_t* proj = (const bf16_t*)(X.ws + WS_BIG);
    bf16x8 qf[4];
    { const bf16_t* qp = (const bf16_t*)(X.ws + WS_QNB) + (size_t)(b * S + tq) * 512 + hh * 64 + 8 * hf;
#pragma unroll
      for (int s = 0; s < 4; ++s) qf[s] = *(const bf16x8*)(qp + 16 * s); }
    float cb_sel, cb_win;
    { const float gq = wave_max(fabsf(p.in[8][lane])), g1 = wave_max(fabsf(p.in[9][64 + lane])), g2 = wave_max(fabsf(p.in[9][128 + lane]));
      cb_sel = 1.03f * 8.f * 0.125f * 1.4426950408889634f * 8.f * gq * g1; cb_win = 1.03f * 8.f * 0.125f * 1.4426950408889634f * 8.f * gq * g2; }
#define NSA_GATE(i) (1.f / (1.f + __expf(-bf2f(proj[(size_t)(b * S + fresh(tq)) * PROJ_LD + OFF_GATE + hh * 3 + (i)]))))
    unsigned ofp0[8], ofp1[8];
    NsaSt st;
    SUB_BEGIN(X, 23);
    LAS float* pacc = (LAS float*)(X.lds + 65536) + w * 2048;
    {
        const int ncm = t0 + 63 >= 31 ? (t0 + 63 - 31) / 16 + 1 : 0, nt = (ncm + 31) >> 5, ncv = tq >= 31 ? (tq - 31) / 16 + 1 : 0;
        {
            const bf16_t* kc = (const bf16_t*)(X.ws + WS_KCB) + (size_t)bg * 256 * 64; const bf16_t* vc = (const bf16_t*)(X.ws + WS_VCT) + (size_t)bg * 64 * 256;
            const int tidf = fresh(X.tid);
#pragma unroll
            for (int i = 0; i < 4; ++i) { const int pidx = tidf + NTHREADS * i;
                *(LAS u32x4*)(X.lds + (pidx >> 8) * 4096 + (pidx & 255) * 16) = *(const u32x4*)(kc + (size_t)(pidx & 255) * 64 + 8 * (pidx >> 8));
                *(LAS u32x4*)(X.lds + 32768 + (pidx >> 6) * 1024 + (pidx & 63) * 16) = *(const u32x4*)(vc + (size_t)(pidx & 63) * 256 + 8 * (pidx >> 6)); }
#pragma unroll
            for (int i = 0; i < 8; ++i) *(LAS f32x4*)(pacc + (i * 64 + lane) * 4) = (f32x4){0.f, 0.f, 0.f, 0.f};
        }
        __syncthreads();
        const int krow = pi32(ql) * 16;
        float ml = -INFINITY, ll = 0.f;
        for (int kt = 0; kt < nt; ++kt) {
            f32x16 sc;
#pragma unroll
            for (int i = 0; i < 16; ++i) sc[i] = 0.f;
#pragma unroll
            for (int s = 0; s < 4; ++s) { const bf16x8 kf = *(const LAS bf16x8*)(X.lds + (2 * s + hf) * 4096 + kt * 512 + krow); sc = __builtin_amdgcn_mfma_f32_32x32x16_bf16(kf, qf[s], sc, 0, 0, 0); }
            float tm = -INFINITY;
#pragma unroll
            for (int i = 0; i < 16; ++i) { const int n = 32 * kt + 16 * (i >> 3) + 8 * hf + (i & 7);
                sc[i] = n < ncv ? sc[i] - slope2 * (float)(tq - (16 * n + 31)) : -INFINITY; tm = fmaxf(tm, sc[i]); }
            const float mn = fmaxf(ml, tm), ms = mn == -INFINITY ? 0.f : mn;
            float ls = 0.f;
#pragma unroll
            for (int i = 0; i < 16; ++i) ls += __builtin_amdgcn_exp2f(sc[i] - ms);
            ll = ll * __builtin_amdgcn_exp2f(ml - ms) + ls; ml = mn;
        }
        float ms, inv;
        { const float mo = __shfl_xor(ml, 32), lo = __shfl_xor(ll, 32), mt = fmaxf(ml, mo); ms = mt == -INFINITY ? 0.f : mt;
          const float lt = ll * __builtin_amdgcn_exp2f(ml - ms) + lo * __builtin_amdgcn_exp2f(mo - ms); inv = lt > 0.f ? 1.f / lt : 0.f; }
#pragma unroll
        for (int i = 0; i < 16; ++i) { st.o0[i] = 0.f; st.o1[i] = 0.f; }
        float carry = 0.f;
        for (int kt = 0; kt < nt; ++kt) {
            f32x16 sc;
#pragma unroll
            for (int i = 0; i < 16; ++i) sc[i] = 0.f;
#pragma unroll
            for (int s = 0; s < 4; ++s) { const bf16x8 kf = *(const LAS bf16x8*)(X.lds + (2 * s + hf) * 4096 + kt * 512 + krow); sc = __builtin_amdgcn_mfma_f32_32x32x16_bf16(kf, qf[s], sc, 0, 0, 0); }
#pragma unroll
            for (int i = 0; i < 16; ++i) { const int n = 32 * kt + 16 * (i >> 3) + 8 * hf + (i & 7);
                sc[i] = n < ncv ? __builtin_amdgcn_exp2f(sc[i] - slope2 * (float)(tq - (16 * n + 31)) - ms) * inv : 0.f; }
            const float pa0 = __shfl_xor(sc[7], 32), pa1 = __shfl_xor(sc[15], 32);
            const float prev0 = hf ? pa0 : carry, prev1 = hf ? pa1 : pa0;
            carry = pa1;
            {
                typedef float f32x2 __attribute__((ext_vector_type(2)));
                f32x2 e0, e1;
                e0.x = prev0 + ((sc[0] + sc[1]) + (sc[2] + sc[3])); e0.y = sc[3] + ((sc[4] + sc[5]) + (sc[6] + sc[7]));
                e1.x = prev1 + ((sc[8] + sc[9]) + (sc[10] + sc[11])); e1.y = sc[11] + ((sc[12] + sc[13]) + (sc[14] + sc[15]));
                *(LAS f32x2*)(pacc + ql * 64 + 8 * kt + 2 * hf) = e0; *(LAS f32x2*)(pacc + ql * 64 + 8 * kt + 4 + 2 * hf) = e1;
            }
#pragma unroll
            for (int a = 0; a < 2; ++a) {
                u32x4 pw; pw.x = pk2(sc[8 * a], sc[8 * a + 1]); pw.y = pk2(sc[8 * a + 2], sc[8 * a + 3]); pw.z = pk2(sc[8 * a + 4], sc[8 * a + 5]); pw.w = pk2(sc[8 * a + 6], sc[8 * a + 7]);
                const bf16x8 pf = __builtin_bit_cast(bf16x8, pw);
                const bf16x8 v0 = *(const LAS bf16x8*)(X.lds + 32768 + (4 * kt + 2 * a + hf) * 1024 + ql * 16);
                const bf16x8 v1 = *(const LAS bf16x8*)(X.lds + 32768 + (4 * kt + 2 * a + hf) * 1024 + 512 + ql * 16);
                st.o0 = __builtin_amdgcn_mfma_f32_32x32x16_bf16(v0, pf, st.o0, 0, 0, 0);
                st.o1 = __builtin_amdgcn_mfma_f32_32x32x16_bf16(v1, pf, st.o1, 0, 0, 0);
            }
        }
        { const float g0 = NSA_GATE(0);
#pragma unroll
        for (int i = 0; i < 8; ++i) { ofp0[i] = pk2(g0 * st.o0[2 * i], g0 * st.o0[2 * i + 1]); ofp1[i] = pk2(g0 * st.o1[2 * i], g0 * st.o1[2 * i + 1]); } }
    }
    SUB_END(X, 23);
    SUB_BEGIN(X, 24);
    unsigned long long mymask = 0ull, wavemask = 0ull;
    LDS_WAIT();
    for (int q8 = 0; q8 < 8; ++q8) {
        const int t = t0 + 8 * w + q8;
        const float ps = (pacc[(0 * 8 + q8) * 64 + lane] + pacc[(1 * 8 + q8) * 64 + lane]) + (pacc[(2 * 8 + q8) * 64 + lane] + pacc[(3 * 8 + q8) * 64 + lane]);
        const bool valid = lane * 64 <= t, forced = (lane == 0) || (lane == qb) || (lane == qb - 1);
        const unsigned key = valid ? ((forced ? 0x7f000000u : (__float_as_uint(fmaxf(ps, 0.f)) & ~63u)) | (unsigned)(63 - lane)) : 0u;
        unsigned thr = 0u;
#pragma unroll 1
        for (int bit = 30; bit >= 0; --bit) { const unsigned cand = thr | (1u << bit); if (__builtin_popcountll(__ballot(key >= cand)) >= 16) thr = cand; }
        const unsigned long long mk = __ballot(key >= thr && key != 0u);
        wavemask |= mk; if ((ql & 7) == q8) mymask = mk;
    }
    SUB_END(X, 24);
    __syncthreads();
    {
#pragma unroll
        for (int i = 0; i < 16; ++i) { st.o0[i] = 0.f; st.o1[i] = 0.f; }
        st.m = -INFINITY; st.l = 0.f;
        const int lf = fresh(lane);
        const unsigned koff = (unsigned)(((b * S + lf) * 128 + g * 64 + 8 * w) * 2), voff = (unsigned)(((512 + g * 64 + lf) * T + b * S + 8 * w) * 2);
        nsa_flash<0>(X, X.ws + WS_KSN, koff, X.ws + WS_VT, voff, 0, qb, qf, tq, slope2, mymask, wavemask, st, cb_sel, p, cur);
        const float lt = st.l + __shfl_xor(st.l, 32), sc = NSA_GATE(1) / fmaxf(lt, 1e-30f);
#pragma unroll
        for (int i = 0; i < 8; ++i) { ofp0[i] = pk2(bflo(ofp0[i]) + sc * st.o0[2 * i], bfhi(ofp0[i]) + sc * st.o0[2 * i + 1]); ofp1[i] = pk2(bflo(ofp1[i]) + sc * st.o1[2 * i], bfhi(ofp1[i]) + sc * st.o1[2 * i + 1]); }
    }
    {
#pragma unroll
        for (int i = 0; i < 16; ++i) { st.o0[i] = 0.f; st.o1[i] = 0.f; }
        st.m = -INFINITY; st.l = 0.f;
        const int lf = fresh(lane);
        const unsigned koff = (unsigned)(((b * S + lf) * 128 + g * 64 + 8 * w) * 2), voff = (unsigned)(((640 + g * 64 + lf) * T + b * S + 8 * w) * 2);
        nsa_flash<1>(X, X.ws + WS_KWN, koff, X.ws + WS_VT, voff, qb >= 8 ? qb - 8 : 0, qb, qf, tq, slope2, 0ull, 0ull, st, cb_win, p, cur);
        const float lt = st.l + __shfl_xor(st.l, 32), sc = NSA_GATE(2) / fmaxf(lt, 1e-30f);
#pragma unroll
        for (int i = 0; i < 8; ++i) { ofp0[i] = pk2(bflo(ofp0[i]) + sc * st.o0[2 * i], bfhi(ofp0[i]) + sc * st.o0[2 * i + 1]); ofp1[i] = pk2(bflo(ofp1[i]) + sc * st.o1[2 * i], bfhi(ofp1[i]) + sc * st.o1[2 * i + 1]); }
    }
    bf16_t* op = (bf16_t*)(X.ws + WS_O) + (size_t)(b * S + fresh(tq)) * D + 512 + hh * 64 + 4 * hf;
#pragma unroll
    for (int g4 = 0; g4 < 4; ++g4) {
        u32x2 w0; w0.x = ofp0[2 * g4]; w0.y = ofp0[2 * g4 + 1]; *(u32x2*)(op + 8 * g4) = w0;
        u32x2 w1; w1.x = ofp1[2 * g4]; w1.y = ofp1[2 * g4 + 1]; *(u32x2*)(op + 32 + 8 * g4) = w1;
    }
}
__device__ __forceinline__ void ph_nsa(const Params& p, const Ctx& X, ConvCur& cur) {
    for (int pr = X.bid; pr < 256; pr += X.G)
#pragma unroll 1
        for (int u = 0; u < 2; ++u) { const int bg = pr >> 5, qa = pr & 31; nsa_unit(p, X, cur, bg, u ? qa : 63 - qa); }
}

__device__ __forceinline__ float silu_fast(float v) { return v * __builtin_amdgcn_rcpf(1.f + __expf(-v)); }
constexpr int S1_WL = RING_BYTES + 4096;
__device__ __forceinline__ void ph_ssd1(const Params& p, const Ctx& X) {
    const float* cw = p.in[17]; const float* cb = p.in[18];
    LAS float* wl = (LAS float*)(X.lds + S1_WL);
    LAS unsigned char* ldsB = X.lds;
    LAS unsigned char* ldsX = X.lds + 65536;
    for (int unit = X.bid; unit < 256; unit += X.G) {
        const int b = unit >> 6, c = (unit >> 2) & 15, g = unit & 3, tl0 = c * 256, lane = fresh(X.lane), w = X.wave, ql = lane & 31, hf = lane >> 5;
        const size_t t0 = (size_t)b * S + tl0;
        SUB_BEGIN(X, 41);
        {
            const int h = g * 8 + w;
            const float a = -expf(p.in[20][h]), dtb = p.in[19][h];
            const float* dr = (const float*)(X.ws + WS_DT) + (t0 + 4 * lane) * 32 + h;
            float dt[4], cs[4];
#pragma unroll
            for (int k = 0; k < 4; ++k) { const float raw = dr[k * 32] + dtb; dt[k] = raw > 20.f ? raw : log1pf(expf(raw)); }
            cs[0] = dt[0] * a; cs[1] = cs[0] + dt[1] * a; cs[2] = cs[1] + dt[2] * a; cs[3] = cs[2] + dt[3] * a;
            float incl = cs[3];
#pragma unroll
            for (int o = 1; o < 64; o <<= 1) { const float u = __shfl_up(incl, o); if (lane >= o) incl += u; }
            const float excl = incl - cs[3], last = __shfl(incl, 63);
#pragma unroll
            for (int k = 0; k < 4; ++k) cs[k] += excl;
            *(f32x4*)((float*)(X.ws + WS_DT2) + (size_t)(b * 32 + h) * S + tl0 + 4 * lane) = (f32x4){dt[0], dt[1], dt[2], dt[3]};
            *(f32x4*)((float*)(X.ws + WS_CS) + (size_t)(b * 32 + h) * S + tl0 + 4 * lane) = (f32x4){cs[0], cs[1], cs[2], cs[3]};
            *(LAS f32x4*)(wl + w * 256 + 4 * lane) = (f32x4){dt[0] * __expf(last - cs[0]), dt[1] * __expf(last - cs[1]), dt[2] * __expf(last - cs[2]), dt[3] * __expf(last - cs[3])};
            if (lane == 63) ((float*)(X.ws + WS_DEC))[(b * 16 + c) * 32 + h] = __expf(last);
        }
        const bf16_t* xt = (const bf16_t*)(X.ws + WS_XT); bf16_t* xct = (bf16_t*)(X.ws + WS_XCT);
        const int tidf = fresh(X.tid);
#define CONV8(rin, chg, seg, o) do { const bf16_t* src_ = xt + (size_t)(rin) * T + t0 + 8 * (seg); const u32x4 cur_ = *(const u32x4*)src_; u32x4 prv_ = (u32x4){0u, 0u, 0u, 0u}; \
            if (tl0 + 8 * (seg) >= 8) prv_ = *(const u32x4*)(src_ - 8); \
            const float x_[11] = {bfhi(prv_.z), bflo(prv_.w), bfhi(prv_.w), bflo(cur_.x), bfhi(cur_.x), bflo(cur_.y), bfhi(cur_.y), bflo(cur_.z), bfhi(cur_.z), bflo(cur_.w), bfhi(cur_.w)}; \
            const float w0_ = cw[chg], w1_ = cw[CONV_DIM + (chg)], w2_ = cw[2 * CONV_DIM + (chg)], w3_ = cw[3 * CONV_DIM + (chg)], bb_ = cb[chg]; \
            _Pragma("unroll") for (int j_ = 0; j_ < 8; ++j_) o[j_] = silu_fast(bb_ + w0_ * x_[j_] + w1_ * x_[j_ + 1] + w2_ * x_[j_ + 2] + w3_ * x_[j_ + 3]); } while (0)
        SUB_END(X, 41);
        SUB_BEGIN(X, 42);
        {
#pragma unroll
            for (int k = 0; k < 8; ++k) {
                const int it = tidf + NTHREADS * k, n = it >> 5, seg = it & 31, chg = 2048 + g * 128 + n;
                float o[8]; CONV8(g * 128 + n, chg, seg, o);
                u32x4 ov; ov.x = pk2(o[0], o[1]); ov.y = pk2(o[2], o[3]); ov.z = pk2(o[4], o[5]); ov.w = pk2(o[6], o[7]);
                *(u32x4*)(xct + (size_t)chg * T + t0 + 8 * seg) = ov;
                *(LAS u32x4*)(ldsB + seg * 2048 + n * 16) = ov;
            }
            SUB_END(X, 42);
            SUB_BEGIN(X, 43);
            const bf16_t* zbc = (const bf16_t*)(X.ws + WS_ZBC); bf16_t* bcm = (bf16_t*)(X.ws + WS_BCM);
            {
                const int c8 = tidf & 31, l0 = (tidf >> 5) * 16;
                const int col = (c8 < 16 ? g * 128 + 8 * c8 : 512 + g * 128 + 8 * (c8 - 16));
                float wk[4][8], bb[8];
                { const f32x4 b0 = *(const f32x4*)(cb + 2048 + col), b1 = *(const f32x4*)(cb + 2048 + col + 4); bb[0] = b0.x; bb[1] = b0.y; bb[2] = b0.z; bb[3] = b0.w; bb[4] = b1.x; bb[5] = b1.y; bb[6] = b1.z; bb[7] = b1.w; }
#pragma unroll
                for (int ww = 0; ww < 4; ++ww) { const f32x4 k0 = *(const f32x4*)(cw + ww * CONV_DIM + 2048 + col), k1 = *(const f32x4*)(cw + ww * CONV_DIM + 2048 + col + 4);
                    wk[ww][0] = k0.x; wk[ww][1] = k0.y; wk[ww][2] = k0.z; wk[ww][3] = k0.w; wk[ww][4] = k1.x; wk[ww][5] = k1.y; wk[ww][6] = k1.z; wk[ww][7] = k1.w; }
                u32x4 rw[19];
#pragma unroll
                for (int r = 0; r < 19; ++r) rw[r] = (tl0 + l0 - 3 + r >= 0) ? *(const u32x4*)(zbc + (t0 + l0 - 3 + r) * 3072 + 2048 + col) : (u32x4){0u, 0u, 0u, 0u};
#pragma unroll
                for (int k = 0; k < 16; ++k) {
                    float acc[8];
#pragma unroll
                    for (int i = 0; i < 8; ++i) acc[i] = bb[i];
#pragma unroll
                    for (int ww = 0; ww < 4; ++ww) { const u32x4 q = rw[k + ww];
                        acc[0] += bflo(q.x) * wk[ww][0]; acc[1] += bfhi(q.x) * wk[ww][1]; acc[2] += bflo(q.y) * wk[ww][2]; acc[3] += bfhi(q.y) * wk[ww][3];
                        acc[4] += bflo(q.z) * wk[ww][4]; acc[5] += bfhi(q.z) * wk[ww][5]; acc[6] += bflo(q.w) * wk[ww][6]; acc[7] += bfhi(q.w) * wk[ww][7]; }
                    u32x4 ov; ov.x = pk2(silu_fast(acc[0]), silu_fast(acc[1])); ov.y = pk2(silu_fast(acc[2]), silu_fast(acc[3])); ov.z = pk2(silu_fast(acc[4]), silu_fast(acc[5])); ov.w = pk2(silu_fast(acc[6]), silu_fast(acc[7]));
                    *(u32x4*)(bcm + (t0 + l0 + k) * 1024 + col) = ov;
                }
            }
        }
        SUB_END(X, 43);
#pragma unroll 1
        for (int hg = 0; hg < 4; ++hg) {
            SUB_BEGIN(X, 44);
            asm volatile("s_waitcnt lgkmcnt(0)\n\ts_barrier" ::: "memory");
#pragma unroll
            for (int k = 0; k < 8; ++k) {
                const int it = tidf + NTHREADS * k, chl = it >> 5, seg = it & 31, h8 = 2 * hg + (chl >> 6), chg = g * 512 + h8 * 64 + (chl & 63);
                float o[8]; CONV8(1024 + chg, chg, seg, o);
                u32x4 ov; ov.x = pk2(o[0], o[1]); ov.y = pk2(o[2], o[3]); ov.z = pk2(o[4], o[5]); ov.w = pk2(o[6], o[7]);
                *(u32x4*)(xct + (size_t)chg * T + t0 + 8 * seg) = ov;
                const f32x4 wa = *(const LAS f32x4*)(wl + h8 * 256 + 8 * seg), wb = *(const LAS f32x4*)(wl + h8 * 256 + 8 * seg + 4);
                u32x4 os; os.x = pk2(o[0] * wa.x, o[1] * wa.y); os.y = pk2(o[2] * wa.z, o[3] * wa.w); os.z = pk2(o[4] * wb.x, o[5] * wb.y); os.w = pk2(o[6] * wb.z, o[7] * wb.w);
                *(LAS u32x4*)(ldsX + (chl >> 6) * 32768 + seg * 1024 + (chl & 63) * 16) = os;
            }
            asm volatile("s_waitcnt lgkmcnt(0)\n\ts_barrier" ::: "memory");
            SUB_END(X, 44);
            SUB_BEGIN(X, 45);
            {
                const int hl = w >> 2, pt = (w >> 1) & 1, nt0 = 2 * (w & 1), h = g * 8 + 2 * hg + hl;
                f32x16 acc0, acc1;
#pragma unroll
                for (int i = 0; i < 16; ++i) { acc0[i] = 0.f; acc1[i] = 0.f; }
#pragma unroll 4
                for (int ks = 0; ks < 16; ++ks) {
                    const bf16x8 af = *(const LAS bf16x8*)(ldsX + hl * 32768 + (2 * ks + hf) * 1024 + (32 * pt + ql) * 16);
                    const bf16x8 b0 = *(const LAS bf16x8*)(ldsB + (2 * ks + hf) * 2048 + (32 * nt0 + ql) * 16), b1 = *(const LAS bf16x8*)(ldsB + (2 * ks + hf) * 2048 + (32 * nt0 + 32 + ql) * 16);
                    acc0 = __builtin_amdgcn_mfma_f32_32x32x16_bf16(af, b0, acc0, 0, 0, 0); acc1 = __builtin_amdgcn_mfma_f32_32x32x16_bf16(af, b1, acc1, 0, 0, 0);
                }
                float* st = (float*)(X.ws + WS_ST) + ((size_t)(b * 16 + c) * 32 + h) * 8192 + 32 * nt0 + ql;
#pragma unroll
                for (int i = 0; i < 16; ++i) { const int pr = 32 * pt + 8 * (i >> 2) + 4 * hf + (i & 3); st[pr * 128] = acc0[i]; st[pr * 128 + 32] = acc1[i]; }
            }
            SUB_END(X, 45);
        }
#undef CONV8
        __syncthreads();
    }
}
__device__ __forceinline__ void ph_ssd2(const Ctx& X) {
    const float* st = (const float*)(X.ws + WS_ST); const float* dec = (const float*)(X.ws + WS_DEC); bf16_t* pb = (bf16_t*)(X.ws + WS_PB);
    for (int e = X.bid * NTHREADS + X.tid; e < NB * 32 * 2048; e += X.G * NTHREADS) {
        const int b = e >> 16, h = (e >> 11) & 31, q4 = (e & 2047) * 4;
        f32x4 hs = (f32x4){0.f, 0.f, 0.f, 0.f};
        for (int c = 0; c < 16; ++c) {
            const size_t o = ((size_t)(b * 16 + c) * 32 + h) * 8192 + q4;
            u32x2 wv; wv.x = pk2(hs.x, hs.y); wv.y = pk2(hs.z, hs.w); *(u32x2*)(pb + o) = wv;
            hs = hs * dec[(b * 16 + c) * 32 + h] + *(const f32x4*)(st + o);
        }
    }
}
constexpr int S3_STG = 49152;
__device__ __forceinline__ void ph_ssd3(const Params& p, const Ctx& X) {
    LAS float* dtl = (LAS float*)(X.lds + 2 * S3_STG); LAS float* csl = dtl + 2048;
    constexpr int S3_TILE = 2 * S3_STG + 16384;
    static_assert(S3_TILE + 8 * 4096 <= TAB_OFF, "ssd3 LDS map");
    for (int unit = X.bid; unit < 256; unit += X.G) {
        const int b = unit >> 6, c = (unit >> 2) & 15, g = unit & 3, tl0 = c * 256, lane = fresh(X.lane), w = X.wave, ql = lane & 31, hf = lane >> 5, lq = 32 * w + ql;
        const size_t t0 = (size_t)b * S + tl0;
        LAS unsigned char* tile = X.lds + S3_TILE + w * 4096;
        const bf16_t* xg = (const bf16_t*)(X.ws + WS_XCT) + (size_t)(g * 512 + lane) * T + t0;
        const bf16_t* pg = (const bf16_t*)(X.ws + WS_PB) + ((size_t)(b * 16 + c) * 32 + g * 8) * 8192 + (size_t)lane * 128;
#define S3_ISSUE(h8, sbase) do { _Pragma("unroll") for (int cc_ = 0; cc_ < 4; ++cc_) DMA16(xg + (size_t)((h8) * 64) * T + 8 * (4 * w + cc_), X.lds + (sbase) + (4 * w + cc_) * 1024); \
            _Pragma("unroll") for (int cc_ = 0; cc_ < 2; ++cc_) DMA16(pg + (size_t)(h8) * 8192 + 8 * (2 * w + cc_), X.lds + (sbase) + 32768 + (2 * w + cc_) * 1024); } while (0)
        asm volatile("s_waitcnt vmcnt(0)" ::: "memory");
        S3_ISSUE(0, 0);
        { const int tidf = fresh(X.tid), h8 = tidf >> 6, l4 = (tidf & 63) * 4;
          *(LAS f32x4*)(dtl + h8 * 256 + l4) = *(const f32x4*)((const float*)(X.ws + WS_DT2) + (size_t)(b * 32 + g * 8 + h8) * S + tl0 + l4);
          *(LAS f32x4*)(csl + h8 * 256 + l4) = *(const f32x4*)((const float*)(X.ws + WS_CS) + (size_t)(b * 32 + g * 8 + h8) * S + tl0 + l4); }
        const bf16_t* bcm = (const bf16_t*)(X.ws + WS_BCM);
        bf16x8 cf[8];
#pragma unroll
        for (int ks = 0; ks < 8; ++ks) cf[ks] = *(const bf16x8*)(bcm + (t0 + lq) * 1024 + 512 + g * 128 + 16 * ks + 8 * hf);
        u32x4 gp[8][2];
        {
#pragma unroll
        for (int st = 0; st < 8; ++st) {
            if (st <= w) {
                f32x16 G;
#pragma unroll
                for (int i = 0; i < 16; ++i) G[i] = 0.f;
                const bf16_t* bp = bcm + (t0 + 32 * st + pi32(ql)) * 1024 + g * 128 + 8 * hf;
#pragma unroll
                for (int ks = 0; ks < 8; ++ks) G = __builtin_amdgcn_mfma_f32_32x32x16_bf16(*(const bf16x8*)(bp + 16 * ks), cf[ks], G, 0, 0, 0);
#pragma unroll
                for (int a2 = 0; a2 < 2; ++a2) { gp[st][a2].x = pk2(G[8 * a2], G[8 * a2 + 1]); gp[st][a2].y = pk2(G[8 * a2 + 2], G[8 * a2 + 3]); gp[st][a2].z = pk2(G[8 * a2 + 4], G[8 * a2 + 5]); gp[st][a2].w = pk2(G[8 * a2 + 6], G[8 * a2 + 7]); }
            } else { gp[st][0] = (u32x4){0u, 0u, 0u, 0u}; gp[st][1] = (u32x4){0u, 0u, 0u, 0u}; }
        }
        }
        float ss = 0.f;
        bf16_t* yrow = (bf16_t*)(X.ws + WS_O) + (t0 + 32 * w + (lane >> 1)) * SSM_INNER + g * 512 + 32 * (lane & 1);
        const bf16_t* zdma = (const bf16_t*)(X.ws + WS_ZBC) + (t0 + 32 * w + (lane >> 3)) * 3072 + g * 512 + 8 * ((lane & 7) ^ (lane >> 3));
        LAS unsigned char* trw = tile + (lane >> 1) * 128;
        LAS unsigned char* tac = tile + ql * 128 + 8 * hf;
#pragma unroll 1
        for (int h8 = 0; h8 < 8; ++h8) {
            const int sb = (h8 & 1) * S3_STG;
            asm volatile("s_waitcnt vmcnt(0) lgkmcnt(0)\n\ts_barrier" ::: "memory");
            if (h8 < 7) S3_ISSUE(h8 + 1, ((h8 + 1) & 1) * S3_STG);
#pragma unroll
            for (int k = 0; k < 4; ++k) DMA16(zdma + (size_t)(8 * k) * 3072 + h8 * 64, tile + k * 1024);
            f32x16 acc0, acc1;
#pragma unroll
            for (int i = 0; i < 16; ++i) { acc0[i] = 0.f; acc1[i] = 0.f; }
            {
                const LAS unsigned char* pp = X.lds + sb + 32768 + hf * 1024 + ql * 16;
#if 1
                const bf16_t* cp = bcm + (t0 + 32 * w + (fresh(lane) & 31)) * 1024 + 512 + g * 128 + 8 * hf;
#pragma unroll
                for (int ks = 0; ks < 8; ++ks) { const bf16x8 cfk = *(const bf16x8*)(cp + 16 * ks);
                                                 acc0 = __builtin_amdgcn_mfma_f32_32x32x16_bf16(*(const LAS bf16x8*)(pp + ks * 2048), cfk, acc0, 0, 0, 0);
                                                 acc1 = __builtin_amdgcn_mfma_f32_32x32x16_bf16(*(const LAS bf16x8*)(pp + ks * 2048 + 512), cfk, acc1, 0, 0, 0); }
#else
#pragma unroll
                for (int ks = 0; ks < 8; ++ks) { acc0 = __builtin_amdgcn_mfma_f32_32x32x16_bf16(*(const LAS bf16x8*)(pp + ks * 2048), cf[ks], acc0, 0, 0, 0);
                                                 acc1 = __builtin_amdgcn_mfma_f32_32x32x16_bf16(*(const LAS bf16x8*)(pp + ks * 2048 + 512), cf[ks], acc1, 0, 0, 0); }
#endif
                const float e = __expf(csl[h8 * 256 + lq]);
#pragma unroll
                for (int i = 0; i < 16; ++i) { acc0[i] *= e; acc1[i] *= e; }
            }
            const float cl = csl[h8 * 256 + lq], dsk = p.in[21][g * 8 + h8];
#pragma unroll
            for (int st = 0; st < 8; ++st) {
                if (st <= w) {
                    const int s0 = 32 * st + 8 * hf;
#pragma unroll
                    for (int a2 = 0; a2 < 2; ++a2) {
                        const f32x4 d0 = *(const LAS f32x4*)(dtl + h8 * 256 + s0 + 16 * a2), d1 = *(const LAS f32x4*)(dtl + h8 * 256 + s0 + 16 * a2 + 4);
                        const f32x4 c0 = *(const LAS f32x4*)(csl + h8 * 256 + s0 + 16 * a2), c1 = *(const LAS f32x4*)(csl + h8 * 256 + s0 + 16 * a2 + 4);
                        const float dd[8] = {d0.x, d0.y, d0.z, d0.w, d1.x, d1.y, d1.z, d1.w}, cc[8] = {c0.x, c0.y, c0.z, c0.w, c1.x, c1.y, c1.z, c1.w};
                        const unsigned gw[4] = {gp[st][a2].x, gp[st][a2].y, gp[st][a2].z, gp[st][a2].w};
                        float m[8];
#pragma unroll
                        for (int j = 0; j < 8; ++j) { const int sidx = s0 + 16 * a2 + j;
                            const float gv = (j & 1) ? bfhi(gw[j >> 1]) : bflo(gw[j >> 1]);
                            float v = gv * dd[j] * __expf(fminf(cl - cc[j], 0.f));
                            if (st == w) { v = sidx > lq ? 0.f : v; v += sidx == lq ? dsk : 0.f; }
                            m[j] = v; }
                        u32x4 pw; pw.x = pk2(m[0], m[1]); pw.y = pk2(m[2], m[3]); pw.z = pk2(m[4], m[5]); pw.w = pk2(m[6], m[7]);
                        const bf16x8 pf = __builtin_bit_cast(bf16x8, pw);
                        const LAS unsigned char* xp = X.lds + sb + (4 * st + 2 * a2 + hf) * 1024 + ql * 16;
                        acc0 = __builtin_amdgcn_mfma_f32_32x32x16_bf16(*(const LAS bf16x8*)xp, pf, acc0, 0, 0, 0);
                        acc1 = __builtin_amdgcn_mfma_f32_32x32x16_bf16(*(const LAS bf16x8*)(xp + 512), pf, acc1, 0, 0, 0);
                        __builtin_amdgcn_sched_barrier(0);
                    }
                }
            }
            asm volatile("s_waitcnt vmcnt(0)" ::: "memory");
#pragma unroll
            for (int pt = 0; pt < 2; ++pt)
#pragma unroll
                for (int g4 = 0; g4 < 4; ++g4) {
                    const u32x2 z2 = *(const LAS u32x2*)(tac + (((4 * pt + g4) ^ (ql & 7)) * 16));
                    const float a0 = pt ? acc1[4 * g4] : acc0[4 * g4], a1 = pt ? acc1[4 * g4 + 1] : acc0[4 * g4 + 1], a2v = pt ? acc1[4 * g4 + 2] : acc0[4 * g4 + 2], a3 = pt ? acc1[4 * g4 + 3] : acc0[4 * g4 + 3];
                    const float v0 = a0 * silu_fast(bflo(z2.x)), v1 = a1 * silu_fast(bfhi(z2.x)), v2 = a2v * silu_fast(bflo(z2.y)), v3 = a3 * silu_fast(bfhi(z2.y));
                    ss += (v0 * v0 + v1 * v1) + (v2 * v2 + v3 * v3);
                    u32x2 o; o.x = pk2(v0, v1); o.y = pk2(v2, v3); *(LAS u32x2*)(tac + (((4 * pt + g4) ^ (ql & 7)) * 16)) = o;
                }
#pragma unroll
            for (int k = 0; k < 4; ++k) *(u32x4*)(yrow + h8 * 64 + 8 * k) = *(const LAS u32x4*)(trw + (((4 * (lane & 1) + k) ^ ((lane >> 1) & 7)) * 16));
        }
#undef S3_ISSUE
        ss += __shfl_xor(ss, 32);
        const float rs = rsqrtf(ss * (1.f / 512.f) + EPS);
        asm volatile("s_waitcnt vmcnt(0)" ::: "memory");
        {
            const int lf = fresh(lane);
            bf16_t* yb = (bf16_t*)(X.ws + WS_O) + (t0 + 32 * w) * SSM_INNER + g * 512 + 8 * lf;
            const f32x4 g0 = *(const f32x4*)(p.in[22] + g * 512 + 8 * lf), g1 = *(const f32x4*)(p.in[22] + g * 512 + 8 * lf + 4);
#pragma unroll 1
            for (int r0 = 0; r0 < 32; r0 += 8) {
                u32x4 q[8];
#pragma unroll
                for (int k = 0; k < 8; ++k) q[k] = *(const u32x4*)(yb + (size_t)(r0 + k) * SSM_INNER);
#pragma unroll
                for (int k = 0; k < 8; ++k) {
                    const float rk = __shfl(rs, r0 + k);
                    u32x4 o; o.x = pk2(bflo(q[k].x) * rk * g0.x, bfhi(q[k].x) * rk * g0.y); o.y = pk2(bflo(q[k].y) * rk * g0.z, bfhi(q[k].y) * rk * g0.w);
                    o.z = pk2(bflo(q[k].z) * rk * g1.x, bfhi(q[k].z) * rk * g1.y); o.w = pk2(bflo(q[k].w) * rk * g1.z, bfhi(q[k].w) * rk * g1.w);
                    *(u32x4*)(yb + (size_t)(r0 + k) * SSM_INNER) = o;
                }
            }
        }
        asm volatile("s_waitcnt lgkmcnt(0)\n\ts_barrier" ::: "memory");
    }
}

__device__ __forceinline__ void ph_moe_gu(const Params& p, const Ctx& X, int l) {
    moe_table(X, l);
    pg8::MoeOrder So{(const LAS int*)(X.lds + TAB_OFF), (const LAS int*)(X.lds + TAB_OFF) + 40, (const int*)(X.ws + WS_SLOT), 3, X.G, X.bid, true};
    pg8::Gemm g{(const bf16_t*)(X.ws + WS_U), (const bf16_t*)(X.ws + WS_WGU) + (size_t)l * NE * 2048 * 1024, 1024};
    pg8::EpiGu E{(bf16_t*)(X.ws + WS_ACT), p.in[27] + (size_t)l * NE * 2048};
    pg8::gemm_phase<pg8::EpiGu, pg8::MoeOrder>(X.lds, g, So, E, X.tid);
}
__device__ __forceinline__ void ph_moe_down(const Params& p, const Ctx& X, int l) {
    moe_table(X, l);
    pg8::MoeOrder So{(const LAS int*)(X.lds + TAB_OFF), (const LAS int*)(X.lds + TAB_OFF) + 40, (const int*)(X.ws + WS_SLOT), 2, X.G, X.bid, false};
    pg8::Gemm g{(const bf16_t*)(X.ws + WS_ACT), (const bf16_t*)(X.ws + WS_WDN) + (size_t)l * NE * 1024 * 1024, 1024};
    pg8::EpiDown E{(bf16_t*)(X.ws + WS_Y), p.in[29] + (size_t)l * NE * 1024};
    pg8::gemm_phase<pg8::EpiDown, pg8::MoeOrder>(X.lds, g, So, E, X.tid);
}

#ifndef PROBE_MULT
#define PROBE_MULT 8
#endif
__global__ void __launch_bounds__(NTHREADS, 2) fwd_kernel(Params p) {
    extern __shared__ __attribute__((aligned(16))) unsigned char lds_raw[];
    Ctx X;
    X.lds = (LAS unsigned char*)lds_raw; X.ws = p.ws;
    X.tid = threadIdx.x; X.lane = X.tid & 63; X.wave = __builtin_amdgcn_readfirstlane(X.tid >> 6);
    X.G = gridDim.x; X.bid = blockIdx.x; X.gw = X.bid * NWAVES + X.wave; X.ngw = X.G * NWAVES; X.sub = 0ull; X.subt = 0ull;
    if (X.tid < 4) ((LAS unsigned*)(X.lds + XB_OFF))[X.tid] = 0u;
    __syncthreads();
    XcdBarrier bar = xcd_barrier_post((unsigned*)(p.ws + WS_CTL) + CW_BAR, (volatile LAS unsigned*)(X.lds + XB_OFF));
#define PHASE_BEGIN Ctx Y = X; { GAS unsigned char* w_ = (GAS unsigned char*)p.ws; asm volatile("" : "+s"(w_)); Y.ws = (unsigned char*)w_; int t_ = threadIdx.x; asm volatile("" : "+v"(t_)); Y.tid = t_; Y.lane = t_ & 63; \
    Y.wave = __builtin_amdgcn_readfirstlane(t_ >> 6); Y.gw = Y.bid * NWAVES + Y.wave; }
#define WSF(off) ((float*)(Y.ws + (off)))
#define WSB(off) ((bf16_t*)(Y.ws + (off)))
#define PROBE_LDS(i) (((volatile LAS unsigned long long*)(X.lds + 150528))[2 * X.wave + (i)])
    if (PROBE_MASK || PROBE_SUB) { if (X.lane == 0) { PROBE_LDS(0) = __builtin_amdgcn_s_memrealtime(); PROBE_LDS(1) = 0ull; } }
#define PB(k) do { if (PROBE_MASK) { if (X.lane == 0) { const unsigned long long n_ = __builtin_amdgcn_s_memrealtime(); if ((PROBE_MASK >> (k)) & 1u) PROBE_LDS(1) += n_ - PROBE_LDS(0); PROBE_LDS(0) = n_; } } } while (0)
    { PHASE_BEGIN ph_prologue(p, Y); }                                    xcd_barrier(bar); PB(0);
    { PHASE_BEGIN ph_norm0(p, Y); }                                       xcd_barrier(bar); PB(1);
    {
        PHASE_BEGIN
        pg8::DenseOrder So; So.init(T, PROJ_LD, X.G, X.bid);
        pg8::Gemm g{WSB(WS_U), WSB(WS_WIN), 1024};
        pg8::EpiBf16 E{WSB(WS_BIG), PROJ_LD};
        pg8::gemm_phase<pg8::EpiBf16, pg8::DenseOrder>(X.lds, g, So, E, Y.tid);
    }
    {
        PHASE_BEGIN
        pg8::DenseOrder So; So.init(768, T, X.G, X.bid);
        pg8::Gemm g{WSB(WS_WV), WSB(WS_U), 1024};
        pg8::EpiBf16 E{WSB(WS_VT), T};
        pg8::gemm_phase<pg8::EpiBf16, pg8::DenseOrder>(X.lds, g, So, E, Y.tid);
    }
    xcd_barrier(bar); PB(2);
    { PHASE_BEGIN ph_attn_a(p, Y); }                                      xcd_barrier(bar); PB(3);
    ConvCur ccur; ccur.it = X.gw; ccur.step = X.ngw;
    { PHASE_BEGIN ph_nsa(p, Y, ccur); if (PROBE_SUB && X.lane == 0) PROBE_LDS(1) += Y.sub; }
    __syncthreads(); PB(19);
    { PHASE_BEGIN ph_sb(p, Y, ccur); if (PROBE_SUB && X.lane == 0) PROBE_LDS(1) += Y.sub; }                                             xcd_barrier(bar); PB(4);
    {
        PHASE_BEGIN
        pg8::DenseOrder So; So.init(T, D, X.G, X.bid);
        pg8::Gemm g{WSB(WS_O), WSB(WS_WOUT), 1024};
        pg8::EpiResid<false> E{p.in[0], WSB(WS_H1), WSF(WS_MODF) + 2048};
        pg8::gemm_phase<pg8::EpiResid<false>, pg8::DenseOrder>(X.lds, g, So, E, Y.tid);
    }
    xcd_barrier(bar); PB(5);
    { PHASE_BEGIN ph_token<0>(p, Y, 0, WSB(WS_H1), nullptr); if (PROBE_SUB && X.lane == 0) PROBE_LDS(1) += Y.sub; }                       xcd_barrier(bar); PB(6);
    { PHASE_BEGIN ph_moe_gu(p, Y, 0); }                                   xcd_barrier(bar); PB(7);
    { PHASE_BEGIN ph_moe_down(p, Y, 0); }                                 xcd_barrier(bar); PB(8);
    { PHASE_BEGIN ph_token<1>(p, Y, 0, WSB(WS_H1), WSB(WS_H2)); if (PROBE_SUB && X.lane == 0) PROBE_LDS(1) += Y.sub; }       xcd_barrier(bar); PB(9);
    {
        PHASE_BEGIN
        pg8::DenseOrder So; So.init(T, 3072, X.G, X.bid);
        pg8::Gemm g{WSB(WS_U), WSB(WS_WSIN), 1024};
        pg8::EpiBf16 E{WSB(WS_ZBC), 3072};
        pg8::gemm_phase<pg8::EpiBf16, pg8::DenseOrder>(X.lds, g, So, E, Y.tid);
    }
    {
        PHASE_BEGIN
        pg8::DenseOrder So; So.init(3072, T, X.G, X.bid);
        pg8::Gemm g{WSB(WS_WSIN) + (size_t)2048 * 1024, WSB(WS_U), 1024};
        pg8::EpiBf16 E{WSB(WS_XT), T};
        pg8::gemm_phase<pg8::EpiBf16, pg8::DenseOrder>(X.lds, g, So, E, Y.tid);
    }
    xcd_barrier(bar); PB(10);
    { PHASE_BEGIN ph_ssd1(p, Y); if (PROBE_SUB && X.lane == 0) PROBE_LDS(1) += Y.sub; }                                        xcd_barrier(bar); PB(11);
    { PHASE_BEGIN ph_ssd2(Y); }                                           xcd_barrier(bar); PB(12);
    { PHASE_BEGIN ph_ssd3(p, Y); if (PROBE_SUB && X.lane == 0) PROBE_LDS(1) += Y.sub; }                                        xcd_barrier(bar); PB(13);
    {
        PHASE_BEGIN
        pg8::DenseOrder So; So.init(T, D, X.G, X.bid);
        pg8::Gemm g{WSB(WS_O), WSB(WS_WSOUT), 2048};
        pg8::EpiResid<true> E{WSB(WS_H2), WSB(WS_H1), WSF(WS_MODF) + 4 * 6144 + 2048};
        pg8::gemm_phase<pg8::EpiResid<true>, pg8::DenseOrder>(X.lds, g, So, E, Y.tid);
    }
    xcd_barrier(bar); PB(14);
    { PHASE_BEGIN ph_token<0>(p, Y, 1, WSB(WS_H1), nullptr); if (PROBE_SUB && X.lane == 0) PROBE_LDS(1) += Y.sub; }                       xcd_barrier(bar); PB(15);
    { PHASE_BEGIN ph_moe_gu(p, Y, 1); }                                   xcd_barrier(bar); PB(16);
    { PHASE_BEGIN ph_moe_down(p, Y, 1); }                                 xcd_barrier(bar); PB(17);
    if (PROBE_MASK & 0x100000) { for (int xb_ = 0; xb_ < 8; ++xb_) xcd_barrier(bar); }
    { PHASE_BEGIN ph_token<2>(p, Y, 1, WSB(WS_H1), p.out); if (PROBE_SUB && X.lane == 0) PROBE_LDS(1) += Y.sub; } PB(18);
    if (PROBE_MASK || PROBE_SUB) { asm volatile("s_waitcnt lgkmcnt(0)" ::: "memory"); const unsigned long long acc_ = PROBE_LDS(1); const unsigned long long t_end = __builtin_amdgcn_s_memrealtime() + (unsigned long long)PROBE_MULT * (unsigned long long)__builtin_amdgcn_readfirstlane((unsigned)acc_); while (__builtin_amdgcn_s_memrealtime() < t_end) __builtin_amdgcn_s_sleep(8); }
#undef PB
#undef PROBE_LDS
#undef PHASE_BEGIN
#undef WSF
#undef WSB
}
}

extern "C" void kernel_launch(void* const* d_in, const int* in_sizes, int n_in, void* d_out, int out_size, void* d_ws, size_t ws_size, hipStream_t stream) {
    static int grid = 0;
    if (grid == 0) {
        if (n_in != 30 || out_size != T * D || ws_size < WS_END) { fprintf(stderr, "kernel_launch: unexpected shapes / workspace (%d inputs, out %d, ws %zu < %zu)\n", n_in, out_size, ws_size, (size_t)WS_END); grid = -1; return; }
        int dev = 0, cus = 0, per_cu = 0;
        if (hipGetDevice(&dev) != hipSuccess || hipDeviceGetAttribute(&cus, hipDeviceAttributeMultiprocessorCount, dev) != hipSuccess) { grid = -1; return; }
        if (hipFuncSetAttribute((const void*)fwd_kernel, hipFuncAttributeMaxDynamicSharedMemorySize, LDS_BYTES) != hipSuccess) { fprintf(stderr, "kernel_launch: hipFuncSetAttribute failed\n"); grid = -1; return; }
        if (hipOccupancyMaxActiveBlocksPerMultiprocessor(&per_cu, (const void*)fwd_kernel, NTHREADS, LDS_BYTES) != hipSuccess || per_cu < 1) { fprintf(stderr, "kernel_launch: occupancy query reports %d\n", per_cu); }
        (void)hipGetLastError();
        grid = cus;
    }
    if (grid < 0) return;
    if (hipMemsetAsync((char*)d_ws + WS_CTL, 0, CTL_BYTES, stream) != hipSuccess) return;
    Params p{};
    for (int i = 0; i < 30; ++i) p.in[i] = (const float*)d_in[i];
    p.out = (float*)d_out; p.ws = (unsigned char*)d_ws;
    hipLaunchKernelGGL(fwd_kernel, dim3(grid), dim3(NTHREADS), LDS_BYTES, stream, p);
}
```
